# Optimizing an MI355X kernel written in HIP

```python
import jax, jax.numpy as jnp
from jax import lax
import numpy as np

D_MODEL = 1024
BATCH = 8
SEQ = 2048
DEPTH = 1
DEC_BATCH = 32
DEC_SEQ = 1
PAST_LEN = 16384
PAGE_SIZE = 128

N_META = 16
FFN_DIM = 2816
MLA_HEADS = 8
MLA_NOPE = 64
MLA_ROPE = 32
MLA_V = 64
Q_RANK = 384
KV_RANK = 256
MLA_SCALE = (MLA_NOPE + MLA_ROPE) ** -0.5
Q_BLOCK = 128
RET_HEADS = 4
RET_DK = 128
RET_DV = 256
RET_CHUNK = 128
ROPE_BASE = 10000.0
NORM_EPS = 1e-6
SPLITS = (Q_RANK, KV_RANK, MLA_ROPE, RET_HEADS * RET_DK, RET_HEADS * RET_DK,
          RET_HEADS * RET_DV, RET_HEADS * RET_DV, D_MODEL, D_MODEL)
IN_DIM = Q_RANK + KV_RANK + MLA_ROPE + 2 * RET_HEADS * RET_DK + 2 * RET_HEADS * RET_DV + 2 * D_MODEL

kernel_name = "mla_retention_gated_macaron_step"


def rms_norm(x, g):
    xf = x.astype(jnp.float32)
    y = xf * lax.rsqrt(jnp.mean(xf * xf, axis=-1, keepdims=True) + NORM_EPS)
    return (y * g.astype(jnp.float32)).astype(x.dtype)


def half_ffn(h, norm, w_gate, w_up, w_down):
    u = rms_norm(h, norm)
    return h + 0.5 * ((jax.nn.silu(u @ w_gate) * (u @ w_up)) @ w_down)


def rope(x, pos):
    half = x.shape[-1] // 2
    inv_freq = ROPE_BASE ** (-jnp.arange(half, dtype=jnp.float32) / half)
    ang = pos.astype(jnp.float32)[:, None] * inv_freq[None, :]
    ang = ang.reshape((ang.shape[0],) + (1,) * (x.ndim - 3) + (half,))
    cos, sin = jnp.cos(ang), jnp.sin(ang)
    xf = x.astype(jnp.float32)
    x1, x2 = xf[..., :half], xf[..., half:]
    return jnp.concatenate([x1 * cos - x2 * sin, x1 * sin + x2 * cos], axis=-1).astype(x.dtype)


def ret_log_gamma():
    return jnp.log1p(-jnp.exp2(-5.0 - jnp.arange(RET_HEADS, dtype=jnp.float32)))


def mixer_inputs(u, pos, W):
    B, T, _ = u.shape
    z = u @ W["w_in"]
    c_q, c_kv, k_r, rq, rk, rv, rg, ga, gb = jnp.split(z, np.cumsum(SPLITS)[:-1].tolist(), axis=-1)
    c_q = rms_norm(c_q, W["q_norm"])
    q = (c_q @ W["w_uq"]).reshape(B, T, MLA_HEADS, MLA_NOPE + MLA_ROPE)
    q_lat = jnp.einsum("bthn,rhn->bthr", q[..., :MLA_NOPE], W["w_uk"])
    q_rope = rope(q[..., MLA_NOPE:], pos)
    c_kv = rms_norm(c_kv, W["kv_norm"])
    k_r = rope(k_r, pos)
    rq = rope(rq.reshape(B, T, RET_HEADS, RET_DK), pos)
    rk = rope(rk.reshape(B, T, RET_HEADS, RET_DK), pos) * (RET_DK ** -0.5)
    rv = rv.reshape(B, T, RET_HEADS, RET_DV)
    return q_lat, q_rope, c_kv, k_r, rq, rk, rv, rg, ga, gb


def latent_attend(q_lat, q_rope, ckv, krope, q_pos, k_pos):
    s = (jnp.einsum("bqhr,bkr->bhqk", q_lat, ckv, preferred_element_type=jnp.float32)
         + jnp.einsum("bqhp,bkp->bhqk", q_rope, krope, preferred_element_type=jnp.float32))
    s = jnp.where(k_pos[None, :] <= q_pos[:, None], s * MLA_SCALE, -jnp.inf)
    p = jax.nn.softmax(s, axis=-1)
    return jnp.einsum("bhqk,bkr->bqhr", p.astype(ckv.dtype), ckv)


def prompt_latent_attention(q_lat, q_rope, c_kv, k_r):
    B, T = q_lat.shape[:2]
    n_blk = -(-T // Q_BLOCK)
    pad = n_blk * Q_BLOCK - T

    def blocks(a):
        a = jnp.pad(a, ((0, 0), (0, pad)) + ((0, 0),) * (a.ndim - 2))
        return jnp.moveaxis(a.reshape((B, n_blk, Q_BLOCK) + a.shape[2:]), 1, 0)

    q_pos = jnp.arange(n_blk * Q_BLOCK).reshape(n_blk, Q_BLOCK)
    k_pos = jnp.arange(T)
    o = lax.map(lambda blk: latent_attend(blk[0], blk[1], c_kv, k_r, blk[2], k_pos),
                (blocks(q_lat), blocks(q_rope), q_pos))
    o = jnp.moveaxis(o, 0, 1).reshape((B, n_blk * Q_BLOCK) + o.shape[3:])
    return o[:, :T]


def ret_chunk(q, k, v, S, log_gamma):
    C = q.shape[1]
    q, k, v, S = (a.astype(jnp.float32) for a in (q, k, v, S))
    idx = jnp.arange(C, dtype=jnp.float32)
    diff = idx[:, None] - idx[None, :]
    decay = jnp.where(diff >= 0, jnp.exp(log_gamma[:, None, None] * jnp.maximum(diff, 0.0)), 0.0)
    scores = jnp.einsum("bihd,bjhd->bhij", q, k) * decay
    o = jnp.einsum("bhij,bjhe->bihe", scores, v)
    q_decay = jnp.exp(log_gamma[None, :] * (idx[:, None] + 1.0))
    o = o + jnp.einsum("bihd,bhde->bihe", q, S) * q_decay[None, :, :, None]
    k_decay = jnp.exp(log_gamma[None, :] * (C - 1.0 - idx[:, None]))
    S_new = (jnp.exp(log_gamma * C)[None, :, None, None] * S
             + jnp.einsum("bjhd,bjhe->bhde", k * k_decay[None, :, :, None], v))
    return o, S_new


def prompt_retention(rq, rk, rv):
    B, T, H = rq.shape[:3]
    lg = ret_log_gamma()
    S0 = jnp.zeros((B, H, RET_DK, RET_DV), jnp.float32)
    o_meta, S = ret_chunk(rq[:, :N_META], rk[:, :N_META], rv[:, :N_META], S0, lg)
    n_c = (T - N_META) // RET_CHUNK

    def chunks(a):
        return jnp.moveaxis(a[:, N_META:].reshape((B, n_c, RET_CHUNK) + a.shape[2:]), 1, 0)

    def step(S, qkv):
        o, S = ret_chunk(qkv[0], qkv[1], qkv[2], S, lg)
        return S, o

    S, o = lax.scan(step, S, (chunks(rq), chunks(rk), chunks(rv)))
    o = jnp.moveaxis(o, 0, 1).reshape(B, T - N_META, H, RET_DV)
    return jnp.concatenate([o_meta, o], axis=1), S


def mixer_output(h, o_lat, o_ret, rg, ga, gb, W):
    B, T = h.shape[:2]
    a = jnp.einsum("bthr,rhv->bthv", o_lat, W["w_uv"]).reshape(B, T, MLA_HEADS * MLA_V) @ W["w_mla_o"]
    of = o_ret.astype(jnp.float32)
    mu = jnp.mean(of, axis=-1, keepdims=True)
    var = jnp.mean(jnp.square(of - mu), axis=-1, keepdims=True)
    on = ((of - mu) * lax.rsqrt(var + NORM_EPS)).reshape(B, T, RET_HEADS * RET_DV) * W["ret_gn"].astype(jnp.float32)
    r = (jax.nn.silu(rg) * on.astype(h.dtype)) @ W["w_ret_o"]
    m = jax.nn.sigmoid(ga) * a + jax.nn.sigmoid(gb) * r
    return h + m @ W["w_out"]


def prompt_layer(x, W):
    T = x.shape[1]
    pos = jnp.arange(T)
    h = half_ffn(x, W["ffn1_norm"], W["ffn1_gate"], W["ffn1_up"], W["ffn1_down"])
    u = rms_norm(h, W["mix_norm"])
    q_lat, q_rope, c_kv, k_r, rq, rk, rv, rg, ga, gb = mixer_inputs(u, pos, W)
    o_lat = prompt_latent_attention(q_lat, q_rope, c_kv, k_r)
    o_ret, s_ret = prompt_retention(rq, rk, rv)
    h = mixer_output(h, o_lat, o_ret, rg, ga, gb, W)
    h = half_ffn(h, W["ffn2_norm"], W["ffn2_gate"], W["ffn2_up"], W["ffn2_down"])
    return h, c_kv, k_r, s_ret


def sample_layer(x, ckv_pool, kr_pool, s_ret, page_table, W):
    B, S, _ = x.shape
    past_len = page_table.shape[1] * PAGE_SIZE
    pos = past_len + jnp.arange(S)
    h = half_ffn(x, W["ffn1_norm"], W["ffn1_gate"], W["ffn1_up"], W["ffn1_down"])
    u = rms_norm(h, W["mix_norm"])
    q_lat, q_rope, c_kv, k_r, rq, rk, rv, rg, ga, gb = mixer_inputs(u, pos, W)
    past_ckv = ckv_pool[page_table].reshape(B, past_len, KV_RANK)
    past_kr = kr_pool[page_table].reshape(B, past_len, MLA_ROPE)
    keys_ckv = jnp.concatenate([past_ckv, c_kv.astype(past_ckv.dtype)], axis=1)
    keys_kr = jnp.concatenate([past_kr, k_r.astype(past_kr.dtype)], axis=1)
    o_lat = latent_attend(q_lat, q_rope, keys_ckv, keys_kr, pos, jnp.arange(past_len + S))
    o_ret, s_new = ret_chunk(rq, rk, rv, s_ret, ret_log_gamma())
    h = mixer_output(h, o_lat, o_ret, rg, ga, gb, W)
    h = half_ffn(h, W["ffn2_norm"], W["ffn2_gate"], W["ffn2_up"], W["ffn2_down"])
    return h, c_kv, k_r, s_new


def setup_inputs(seed: int = 0) -> dict:
    key = jax.random.key(seed)
    ks = iter(jax.random.split(key, 32))
    f32 = jnp.float32
    L = DEPTH

    def nrm(shape, scale=1.0):
        return jax.random.normal(next(ks), shape, f32) * scale

    def gain(shape):
        return 1.0 + nrm(shape, 0.02)

    n_pages = PAST_LEN // PAGE_SIZE
    n_used = DEC_BATCH * n_pages
    n_pool = n_used + n_used // 4
    x_prompt = nrm((BATCH, SEQ, D_MODEL))
    x_sample = nrm((DEC_BATCH, DEC_SEQ, D_MODEL))
    cache_ckv = nrm((L, n_pool, PAGE_SIZE, KV_RANK))
    cache_krope = nrm((L, n_pool, PAGE_SIZE, MLA_ROPE))
    state_ret = nrm((L, DEC_BATCH, RET_HEADS, RET_DK, RET_DV), 0.5)
    page_table = jax.random.permutation(next(ks), n_pool)[:n_used].reshape(DEC_BATCH, n_pages).astype(jnp.int32)
    return {
        "x_prompt": x_prompt,
        "x_sample": x_sample,
        "cache_ckv": cache_ckv,
        "cache_krope": cache_krope,
        "state_ret": state_ret,
        "page_table": page_table,
        "meta_tokens": nrm((N_META, D_MODEL)),
        "ffn1_norm": gain((L, D_MODEL)),
        "ffn1_gate": nrm((L, D_MODEL, FFN_DIM), D_MODEL ** -0.5),
        "ffn1_up": nrm((L, D_MODEL, FFN_DIM), D_MODEL ** -0.5),
        "ffn1_down": nrm((L, FFN_DIM, D_MODEL), FFN_DIM ** -0.5),
        "mix_norm": gain((L, D_MODEL)),
        "w_in": nrm((L, D_MODEL, IN_DIM), D_MODEL ** -0.5),
        "q_norm": gain((L, Q_RANK)),
        "kv_norm": gain((L, KV_RANK)),
        "w_uq": nrm((L, Q_RANK, MLA_HEADS * (MLA_NOPE + MLA_ROPE)), Q_RANK ** -0.5),
        "w_uk": nrm((L, KV_RANK, MLA_HEADS, MLA_NOPE), KV_RANK ** -0.5),
        "w_uv": nrm((L, KV_RANK, MLA_HEADS, MLA_V), KV_RANK ** -0.5),
        "w_mla_o": nrm((L, MLA_HEADS * MLA_V, D_MODEL), (MLA_HEADS * MLA_V) ** -0.5),
        "ret_gn": gain((L, RET_HEADS * RET_DV)),
        "w_ret_o": nrm((L, RET_HEADS * RET_DV, D_MODEL), (RET_HEADS * RET_DV) ** -0.5),
        "w_out": nrm((L, D_MODEL, D_MODEL), D_MODEL ** -0.5),
        "ffn2_norm": gain((L, D_MODEL)),
        "ffn2_gate": nrm((L, D_MODEL, FFN_DIM), D_MODEL ** -0.5),
        "ffn2_up": nrm((L, D_MODEL, FFN_DIM), D_MODEL ** -0.5),
        "ffn2_down": nrm((L, FFN_DIM, D_MODEL), FFN_DIM ** -0.5),
        "final_norm": gain((D_MODEL,)),
    }


def reference(x_prompt, x_sample, cache_ckv, cache_krope, state_ret, page_table, meta_tokens,
              ffn1_norm, ffn1_gate, ffn1_up, ffn1_down, mix_norm, w_in, q_norm, kv_norm,
              w_uq, w_uk, w_uv, w_mla_o, ret_gn, w_ret_o, w_out,
              ffn2_norm, ffn2_gate, ffn2_up, ffn2_down, final_norm):
    B = x_prompt.shape[0]
    meta = jnp.broadcast_to(meta_tokens[None].astype(x_prompt.dtype), (B, N_META, D_MODEL))
    hp = jnp.concatenate([meta, x_prompt], axis=1)
    hs = x_sample
    ckv_p, kr_p, sr_p, ckv_s, kr_s, sr_s = [], [], [], [], [], []
    for l in range(DEPTH):
        W = dict(ffn1_norm=ffn1_norm[l], ffn1_gate=ffn1_gate[l], ffn1_up=ffn1_up[l], ffn1_down=ffn1_down[l],
                 mix_norm=mix_norm[l], w_in=w_in[l], q_norm=q_norm[l], kv_norm=kv_norm[l],
                 w_uq=w_uq[l], w_uk=w_uk[l], w_uv=w_uv[l], w_mla_o=w_mla_o[l],
                 ret_gn=ret_gn[l], w_ret_o=w_ret_o[l], w_out=w_out[l],
                 ffn2_norm=ffn2_norm[l], ffn2_gate=ffn2_gate[l], ffn2_up=ffn2_up[l], ffn2_down=ffn2_down[l])
        hp, c1, k1, s1 = prompt_layer(hp, W)
        hs, c2, k2, s2 = sample_layer(hs, cache_ckv[l], cache_krope[l], state_ret[l], page_table, W)
        ckv_p.append(c1); kr_p.append(k1); sr_p.append(s1)
        ckv_s.append(c2); kr_s.append(k2); sr_s.append(s2)
    y_prompt = rms_norm(hp[:, N_META:], final_norm)
    y_sample = rms_norm(hs, final_norm)
    return (y_prompt, y_sample, jnp.stack(ckv_p), jnp.stack(kr_p), jnp.stack(sr_p),
            jnp.stack(ckv_s), jnp.stack(kr_s), jnp.stack(sr_s))
```

```cpp
#include <hip/hip_runtime.h>
#include <cstdio>
#include <cstdint>
#include <cmath>
namespace ref {
constexpr int D = 1024, NB = 8, SEQ = 2048, NMETA = 16, T = SEQ + NMETA, NS = 32, PAST = 16384, PAGE = 128, NPAGES = PAST / PAGE;
constexpr int FFN = 2816, NH = 8, NOPE = 64, ROPE = 32, QR = 384, KVR = 256, RH = 4, RDK = 128, RDV = 256;
constexpr int IN_DIM = 5792;
constexpr int RP = NB * T;
constexpr int R = RP + NS;
constexpr int O_CQ = 0, O_CKV = 384, O_KR = 640, O_RQ = 672, O_RK = 1184, O_RV = 1696, O_RG = 2720, O_GA = 3744, O_GB = 4768;
constexpr float EPS = 1e-6f;

__device__ __forceinline__ int row_pos(int row) { return row < RP ? (row % T) : PAST; }

__device__ __forceinline__ float block_sum(float v, float* red) {
    for (int o = 32; o > 0; o >>= 1) v += __shfl_down(v, o);
    const int w = threadIdx.x >> 6, l = threadIdx.x & 63;
    __syncthreads();
    if (l == 0) red[w] = v;
    __syncthreads();
    float s = 0.f;
    for (int i = 0; i < (int)(blockDim.x >> 6); ++i) s += red[i];
    return s;
}
__device__ __forceinline__ float block_max(float v, float* red) {
    for (int o = 32; o > 0; o >>= 1) v = fmaxf(v, __shfl_down(v, o));
    const int w = threadIdx.x >> 6, l = threadIdx.x & 63;
    __syncthreads();
    if (l == 0) red[w] = v;
    __syncthreads();
    float s = -INFINITY;
    for (int i = 0; i < (int)(blockDim.x >> 6); ++i) s = fmaxf(s, red[i]);
    return s;
}

__global__ void build_x(const float* xp, const float* xs, const float* meta, float* X) {
    const int row = blockIdx.x;
    const float* src;
    if (row < RP) { const int b = row / T, t = row % T; src = t < NMETA ? meta + (size_t)t * D : xp + ((size_t)b * SEQ + (t - NMETA)) * D; }
    else src = xs + (size_t)(row - RP) * D;
    for (int i = threadIdx.x; i < D; i += blockDim.x) X[(size_t)row * D + i] = src[i];
}
__global__ void rmsnorm_rows(const float* in, int ldi, int n, const float* g, float* out, int ldo) {
    __shared__ float red[8];
    const int row = blockIdx.x;
    const float* x = in + (size_t)row * ldi;
    float s = 0.f;
    for (int i = threadIdx.x; i < n; i += blockDim.x) s += x[i] * x[i];
    s = block_sum(s, red);
    const float r = rsqrtf(s / (float)n + EPS);
    for (int i = threadIdx.x; i < n; i += blockDim.x) out[(size_t)row * ldo + i] = x[i] * r * g[i];
}
__global__ void __launch_bounds__(256) gemm_f32(const float* A, int lda, const float* B, int ldb, float* C, int ldc, int M, int N, int K) {
    __shared__ float As[16][64 + 1];
    __shared__ float Bs[16][64 + 1];
    const int tx = threadIdx.x & 15, ty = threadIdx.x >> 4;
    const int m0 = blockIdx.y * 64, n0 = blockIdx.x * 64;
    float acc[4][4];
#pragma unroll
    for (int i = 0; i < 4; ++i)
#pragma unroll
        for (int j = 0; j < 4; ++j) acc[i][j] = 0.f;
    for (int k0 = 0; k0 < K; k0 += 16) {
        for (int e = threadIdx.x; e < 64 * 16; e += 256) {
            const int m = e >> 4, k = e & 15;
            As[k][m] = (m0 + m < M && k0 + k < K) ? A[(size_t)(m0 + m) * lda + k0 + k] : 0.f;
        }
        for (int e = threadIdx.x; e < 64 * 16; e += 256) {
            const int k = e >> 6, n = e & 63;
            Bs[k][n] = (n0 + n < N && k0 + k < K) ? B[(size_t)(k0 + k) * ldb + n0 + n] : 0.f;
        }
        __syncthreads();
#pragma unroll
        for (int k = 0; k < 16; ++k) {
            float a[4], b[4];
#pragma unroll
            for (int i = 0; i < 4; ++i) a[i] = As[k][ty * 4 + i];
#pragma unroll
            for (int j = 0; j < 4; ++j) b[j] = Bs[k][tx * 4 + j];
#pragma unroll
            for (int i = 0; i < 4; ++i)
#pragma unroll
                for (int j = 0; j < 4; ++j) acc[i][j] += a[i] * b[j];
        }
        __syncthreads();
    }
#pragma unroll
    for (int i = 0; i < 4; ++i)
#pragma unroll
        for (int j = 0; j < 4; ++j) {
            const int m = m0 + ty * 4 + i, n = n0 + tx * 4 + j;
            if (m < M && n < N) C[(size_t)m * ldc + n] = acc[i][j];
        }
}
__device__ __forceinline__ float silu(float x) { return x / (1.f + expf(-x)); }
__device__ __forceinline__ float sigm(float x) { return 1.f / (1.f + expf(-x)); }
__global__ void swiglu(float* G, const float* U, size_t n) {
    for (size_t i = (size_t)blockIdx.x * blockDim.x + threadIdx.x; i < n; i += (size_t)gridDim.x * blockDim.x) G[i] = silu(G[i]) * U[i];
}
__global__ void resid(const float* X, const float* Dl, float s, float* H, size_t n) {
    for (size_t i = (size_t)blockIdx.x * blockDim.x + threadIdx.x; i < n; i += (size_t)gridDim.x * blockDim.x) H[i] = X[i] + s * Dl[i];
}
__device__ __forceinline__ void rope_pair(float x1, float x2, int pos, int i, int half, float& y1, float& y2) {
    const float invf = (float)pow(10000.0, -(double)i / (double)half);
    const float ang = (float)pos * invf;
    const double c = cos((double)ang), s = sin((double)ang);
    y1 = (float)(x1 * c - x2 * s); y2 = (float)(x1 * s + x2 * c);
}
__global__ void q_post(const float* Q, const float* w_uk, float* QLAT, float* QROPE) {
    __shared__ float q[NH * 96];
    const int row = blockIdx.x;
    for (int i = threadIdx.x; i < NH * 96; i += blockDim.x) q[i] = Q[(size_t)row * (NH * 96) + i];
    __syncthreads();
    const int r = threadIdx.x;
    for (int h = 0; h < NH; ++h) {
        float s = 0.f;
        for (int n = 0; n < NOPE; ++n) s += q[h * 96 + n] * w_uk[((size_t)r * NH + h) * NOPE + n];
        QLAT[((size_t)row * NH + h) * KVR + r] = s;
    }
    const int pos = row_pos(row);
    if (threadIdx.x < NH * 16) {
        const int h = threadIdx.x / 16, i = threadIdx.x % 16;
        float y1, y2; rope_pair(q[h * 96 + 64 + i], q[h * 96 + 64 + 16 + i], pos, i, 16, y1, y2);
        QROPE[((size_t)row * NH + h) * ROPE + i] = y1; QROPE[((size_t)row * NH + h) * ROPE + 16 + i] = y2;
    }
}
__global__ void z_post(const float* Z, float* KR, float* RQ, float* RK) {
    const int row = blockIdx.x, pos = row_pos(row);
    const float* z = Z + (size_t)row * IN_DIM;
    const int t = threadIdx.x;
    if (t < 16) { float y1, y2; rope_pair(z[O_KR + t], z[O_KR + 16 + t], pos, t, 16, y1, y2); KR[(size_t)row * ROPE + t] = y1; KR[(size_t)row * ROPE + 16 + t] = y2; }
    {
        const int h = t >> 6, i = t & 63;
        float y1, y2;
        rope_pair(z[O_RQ + h * 128 + i], z[O_RQ + h * 128 + 64 + i], pos, i, 64, y1, y2);
        RQ[(size_t)row * 512 + h * 128 + i] = y1; RQ[(size_t)row * 512 + h * 128 + 64 + i] = y2;
        rope_pair(z[O_RK + h * 128 + i], z[O_RK + h * 128 + 64 + i], pos, i, 64, y1, y2);
        const float sc = 0.08838834764831845f;
        RK[(size_t)row * 512 + h * 128 + i] = y1 * sc; RK[(size_t)row * 512 + h * 128 + 64 + i] = y2 * sc;
    }
}
__global__ void write_kv_out(const float* CKV, const float* KR, float* ckv_p, float* kr_p, float* ckv_s, float* kr_s) {
    const int row = blockIdx.x;
    float* dc = row < RP ? ckv_p + (size_t)row * KVR : ckv_s + (size_t)(row - RP) * KVR;
    float* dk = row < RP ? kr_p + (size_t)row * ROPE : kr_s + (size_t)(row - RP) * ROPE;
    for (int i = threadIdx.x; i < KVR; i += blockDim.x) dc[i] = CKV[(size_t)row * KVR + i];
    for (int i = threadIdx.x; i < ROPE; i += blockDim.x) dk[i] = KR[(size_t)row * ROPE + i];
}
constexpr int ACH = 1024;
__global__ void __launch_bounds__(256) attn_naive(const float* QLAT, const float* QROPE, const float* CKV, const float* KR,
                           const float* cache_ckv, const float* cache_kr, const int* page_table, float* OLAT) {
    __shared__ float ql[NH * KVR];
    __shared__ float qr[NH * ROPE];
    __shared__ float sc[NH][ACH];
    __shared__ float red[8];
    const int row = blockIdx.x, tid = threadIdx.x;
    for (int i = tid; i < NH * KVR; i += 256) ql[i] = QLAT[(size_t)row * NH * KVR + i];
    for (int i = tid; i < NH * ROPE; i += 256) qr[i] = QROPE[(size_t)row * NH * ROPE + i];
    __syncthreads();
    int L, b = 0, s = 0;
    const bool prompt = row < RP;
    if (prompt) { b = row / T; L = (row % T) + 1; } else { s = row - RP; L = PAST + 1; }
    const float scale = 0.10206207261596577f;
    float m[NH], l[NH], o[NH];
#pragma unroll
    for (int h = 0; h < NH; ++h) { m[h] = -INFINITY; l[h] = 0.f; o[h] = 0.f; }
    for (int k0 = 0; k0 < L; k0 += ACH) {
        const int n = min(ACH, L - k0);
        for (int kk = tid; kk < n; kk += 256) {
            const int k = k0 + kk;
            const float *ck, *kr;
            if (prompt) { ck = CKV + ((size_t)b * T + k) * KVR; kr = KR + ((size_t)b * T + k) * ROPE; }
            else if (k < PAST) { const int pg = page_table[s * NPAGES + k / PAGE]; ck = cache_ckv + ((size_t)pg * PAGE + k % PAGE) * KVR; kr = cache_kr + ((size_t)pg * PAGE + k % PAGE) * ROPE; }
            else { ck = CKV + (size_t)row * KVR; kr = KR + (size_t)row * ROPE; }
            float a[NH];
#pragma unroll
            for (int h = 0; h < NH; ++h) a[h] = 0.f;
            for (int r = 0; r < KVR; ++r) { const float c = ck[r];
#pragma unroll
                for (int h = 0; h < NH; ++h) a[h] += ql[h * KVR + r] * c; }
            for (int r = 0; r < ROPE; ++r) { const float c = kr[r];
#pragma unroll
                for (int h = 0; h < NH; ++h) a[h] += qr[h * ROPE + r] * c; }
#pragma unroll
            for (int h = 0; h < NH; ++h) sc[h][kk] = a[h] * scale;
        }
        __syncthreads();
        float f[NH];
#pragma unroll
        for (int h = 0; h < NH; ++h) {
            float mx = -INFINITY;
            for (int kk = tid; kk < n; kk += 256) mx = fmaxf(mx, sc[h][kk]);
            mx = block_max(mx, red);
            const float mn = fmaxf(m[h], mx);
            f[h] = expf(m[h] - mn);
            m[h] = mn;
            float ps = 0.f;
            for (int kk = tid; kk < n; kk += 256) { const float p = expf(sc[h][kk] - mn); sc[h][kk] = p; ps += p; }
            ps = block_sum(ps, red);
            l[h] = l[h] * f[h] + ps;
        }
        __syncthreads();
        float acc[NH];
#pragma unroll
        for (int h = 0; h < NH; ++h) acc[h] = 0.f;
        for (int kk = 0; kk < n; ++kk) {
            const int k = k0 + kk;
            const float* ck;
            if (prompt) ck = CKV + ((size_t)b * T + k) * KVR;
            else if (k < PAST) { const int pg = page_table[s * NPAGES + k / PAGE]; ck = cache_ckv + ((size_t)pg * PAGE + k % PAGE) * KVR; }
            else ck = CKV + (size_t)row * KVR;
            const float c = ck[tid];
#pragma unroll
            for (int h = 0; h < NH; ++h) acc[h] += sc[h][kk] * c;
        }
#pragma unroll
        for (int h = 0; h < NH; ++h) o[h] = o[h] * f[h] + acc[h];
        __syncthreads();
    }
#pragma unroll
    for (int h = 0; h < NH; ++h) OLAT[((size_t)row * NH + h) * KVR + tid] = o[h] / l[h];
}
__global__ void __launch_bounds__(256) ret_naive(const float* RQ, const float* RK, const float* Z, const float* S0, float* ORET, float* SOUT, int row0, int rows_per_seq, int nsteps) {
    __shared__ float red[8][32];
    const int blk = blockIdx.x, sl = blk & 7, h = (blk >> 3) & 3, sq = blk >> 5;
    const int j = threadIdx.x & 31, g = threadIdx.x >> 5;
    const float gamma = 1.f - exp2f(-5.f - (float)h);
    float s[16];
#pragma unroll
    for (int i = 0; i < 16; ++i) s[i] = S0 ? S0[(((size_t)sq * RH + h) * RDK + 16 * g + i) * RDV + 32 * sl + j] : 0.f;
    for (int t = 0; t < nsteps; ++t) {
        const int row = row0 + sq * rows_per_seq + t;
        const float v = Z[(size_t)row * IN_DIM + O_RV + h * RDV + 32 * sl + j];
        const float* k = RK + (size_t)row * 512 + h * 128 + 16 * g;
        const float* q = RQ + (size_t)row * 512 + h * 128 + 16 * g;
        float p = 0.f;
#pragma unroll
        for (int i = 0; i < 16; ++i) { s[i] = gamma * s[i] + k[i] * v; p += q[i] * s[i]; }
        red[g][j] = p;
        __syncthreads();
        if (g == 0) { float o = 0.f; for (int gg = 0; gg < 8; ++gg) o += red[gg][j]; ORET[(size_t)row * 1024 + h * RDV + 32 * sl + j] = o; }
        __syncthreads();
    }
#pragma unroll
    for (int i = 0; i < 16; ++i) SOUT[(((size_t)sq * RH + h) * RDK + 16 * g + i) * RDV + 32 * sl + j] = s[i];
}
__global__ void av_proj(const float* OLAT, const float* w_uv, float* AV) {
    __shared__ float o[NH * KVR];
    const int row = blockIdx.x;
    for (int i = threadIdx.x; i < NH * KVR; i += blockDim.x) o[i] = OLAT[(size_t)row * NH * KVR + i];
    __syncthreads();
    for (int c = threadIdx.x; c < NH * 64; c += blockDim.x) {
        const int h = c / 64, v = c % 64;
        float s = 0.f;
        for (int r = 0; r < KVR; ++r) s += o[h * KVR + r] * w_uv[((size_t)r * NH + h) * 64 + v];
        AV[(size_t)row * 512 + c] = s;
    }
}
__global__ void ret_post(const float* ORET, const float* Z, const float* gn, float* RIN) {
    __shared__ float red[8];
    const int row = blockIdx.x, e = threadIdx.x;
    for (int h = 0; h < RH; ++h) {
        const float x = ORET[(size_t)row * 1024 + h * 256 + e];
        const float mu = block_sum(x, red) / 256.f;
        const float d = x - mu;
        const float var = block_sum(d * d, red) / 256.f;
        const float on = d * rsqrtf(var + EPS) * gn[h * 256 + e];
        RIN[(size_t)row * 1024 + h * 256 + e] = silu(Z[(size_t)row * IN_DIM + O_RG + h * 256 + e]) * on;
    }
}
__global__ void gate_mix(const float* Z, const float* A, const float* RR, float* MX) {
    const int row = blockIdx.x;
    for (int i = threadIdx.x; i < D; i += blockDim.x)
        MX[(size_t)row * D + i] = sigm(Z[(size_t)row * IN_DIM + O_GA + i]) * A[(size_t)row * D + i] + sigm(Z[(size_t)row * IN_DIM + O_GB + i]) * RR[(size_t)row * D + i];
}
__global__ void final_out(const float* H, const float* g, float* yp, float* ys) {
    __shared__ float red[8];
    const int row = blockIdx.x;
    float* dst;
    if (row < RP) { const int b = row / T, t = row % T; if (t < NMETA) return; dst = yp + ((size_t)b * SEQ + (t - NMETA)) * D; }
    else dst = ys + (size_t)(row - RP) * D;
    const float* x = H + (size_t)row * D;
    float s = 0.f;
    for (int i = threadIdx.x; i < D; i += blockDim.x) s += x[i] * x[i];
    s = block_sum(s, red);
    const float r = rsqrtf(s / (float)D + EPS);
    for (int i = threadIdx.x; i < D; i += blockDim.x) dst[i] = x[i] * r * g[i];
}

struct Bufs { float *X, *U, *G, *UP, *DL, *H, *Z, *CQ, *Q, *QLAT, *QROPE, *CKV, *KR, *RQ, *RK, *OLAT, *ORET, *AV, *A, *RIN, *RR, *MX, *H2, *H3; };

inline void gemm(hipStream_t st, const float* A, int lda, const float* B, int ldb, float* C, int ldc, int M, int N, int K) {
    dim3 grid((N + 63) / 64, (M + 63) / 64);
    gemm_f32<<<grid, 256, 0, st>>>(A, lda, B, ldb, C, ldc, M, N, K);
}
inline void half_ffn(hipStream_t st, const Bufs& w, const float* Xin, const float* norm, const float* Wg, const float* Wu, const float* Wd, float* Hout) {
    rmsnorm_rows<<<R, 256, 0, st>>>(Xin, D, D, norm, w.U, D);
    gemm(st, w.U, D, Wg, FFN, w.G, FFN, R, FFN, D);
    gemm(st, w.U, D, Wu, FFN, w.UP, FFN, R, FFN, D);
    swiglu<<<4096, 256, 0, st>>>(w.G, w.UP, (size_t)R * FFN);
    gemm(st, w.G, FFN, Wd, D, w.DL, D, R, D, FFN);
    resid<<<4096, 256, 0, st>>>(Xin, w.DL, 0.5f, Hout, (size_t)R * D);
}
struct Io {
    const float *x_prompt, *x_sample, *cache_ckv, *cache_kr, *state_ret; const int* page_table; const float* meta;
    const float *ffn1_norm, *ffn1_gate, *ffn1_up, *ffn1_down, *mix_norm, *w_in, *q_norm, *kv_norm, *w_uq, *w_uk, *w_uv, *w_mla_o, *ret_gn, *w_ret_o, *w_out;
    const float *ffn2_norm, *ffn2_gate, *ffn2_up, *ffn2_down, *final_norm;
    float *y_prompt, *y_sample, *ckv_p, *kr_p, *sr_p, *ckv_s, *kr_s, *sr_s;
};
inline Io make_io(void* const* d_in, float* out) {
    Io io;
    io.x_prompt = (const float*)d_in[0]; io.x_sample = (const float*)d_in[1]; io.cache_ckv = (const float*)d_in[2]; io.cache_kr = (const float*)d_in[3];
    io.state_ret = (const float*)d_in[4]; io.page_table = (const int*)d_in[5]; io.meta = (const float*)d_in[6];
    io.ffn1_norm = (const float*)d_in[7]; io.ffn1_gate = (const float*)d_in[8]; io.ffn1_up = (const float*)d_in[9]; io.ffn1_down = (const float*)d_in[10];
    io.mix_norm = (const float*)d_in[11]; io.w_in = (const float*)d_in[12]; io.q_norm = (const float*)d_in[13]; io.kv_norm = (const float*)d_in[14];
    io.w_uq = (const float*)d_in[15]; io.w_uk = (const float*)d_in[16]; io.w_uv = (const float*)d_in[17]; io.w_mla_o = (const float*)d_in[18];
    io.ret_gn = (const float*)d_in[19]; io.w_ret_o = (const float*)d_in[20]; io.w_out = (const float*)d_in[21];
    io.ffn2_norm = (const float*)d_in[22]; io.ffn2_gate = (const float*)d_in[23]; io.ffn2_up = (const float*)d_in[24]; io.ffn2_down = (const float*)d_in[25];
    io.final_norm = (const float*)d_in[26];
    io.y_prompt = out; io.y_sample = io.y_prompt + (size_t)NB * SEQ * D; io.ckv_p = io.y_sample + (size_t)NS * D; io.kr_p = io.ckv_p + (size_t)NB * T * KVR;
    io.sr_p = io.kr_p + (size_t)NB * T * ROPE; io.ckv_s = io.sr_p + (size_t)NB * RH * RDK * RDV; io.kr_s = io.ckv_s + (size_t)NS * KVR; io.sr_s = io.kr_s + (size_t)NS * ROPE;
    return io;
}
inline Bufs make_bufs(void* ws_base, size_t* used) {
    Bufs w; float* p = (float*)ws_base;
    auto take = [&](size_t n) { float* r = p; p += (n + 63) / 64 * 64; return r; };
    w.X = take((size_t)R * D); w.U = take((size_t)R * D); w.G = take((size_t)R * FFN); w.UP = take((size_t)R * FFN); w.DL = take((size_t)R * D); w.H = take((size_t)R * D);
    w.Z = take((size_t)R * IN_DIM); w.CQ = take((size_t)R * QR); w.Q = take((size_t)R * 768); w.QLAT = take((size_t)R * NH * KVR); w.QROPE = take((size_t)R * NH * ROPE);
    w.CKV = take((size_t)R * KVR); w.KR = take((size_t)R * ROPE); w.RQ = take((size_t)R * 512); w.RK = take((size_t)R * 512); w.OLAT = take((size_t)R * NH * KVR);
    w.ORET = take((size_t)R * 1024); w.AV = take((size_t)R * 512); w.A = take((size_t)R * D); w.RIN = take((size_t)R * D); w.RR = take((size_t)R * D); w.MX = take((size_t)R * D);
    w.H2 = take((size_t)R * D); w.H3 = take((size_t)R * D);
    if (used) *used = (size_t)((char*)p - (char*)ws_base);
    return w;
}
inline void forward(const Io& io, const Bufs& w, hipStream_t st) {
    build_x<<<R, 256, 0, st>>>(io.x_prompt, io.x_sample, io.meta, w.X);
    half_ffn(st, w, w.X, io.ffn1_norm, io.ffn1_gate, io.ffn1_up, io.ffn1_down, w.H);
    rmsnorm_rows<<<R, 256, 0, st>>>(w.H, D, D, io.mix_norm, w.U, D);
    gemm(st, w.U, D, io.w_in, IN_DIM, w.Z, IN_DIM, R, IN_DIM, D);
    rmsnorm_rows<<<R, 256, 0, st>>>(w.Z + O_CQ, IN_DIM, QR, io.q_norm, w.CQ, QR);
    gemm(st, w.CQ, QR, io.w_uq, 768, w.Q, 768, R, 768, QR);
    q_post<<<R, 256, 0, st>>>(w.Q, io.w_uk, w.QLAT, w.QROPE);
    rmsnorm_rows<<<R, 256, 0, st>>>(w.Z + O_CKV, IN_DIM, KVR, io.kv_norm, w.CKV, KVR);
    z_post<<<R, 256, 0, st>>>(w.Z, w.KR, w.RQ, w.RK);
    write_kv_out<<<R, 256, 0, st>>>(w.CKV, w.KR, io.ckv_p, io.kr_p, io.ckv_s, io.kr_s);
    attn_naive<<<R, 256, 0, st>>>(w.QLAT, w.QROPE, w.CKV, w.KR, io.cache_ckv, io.cache_kr, io.page_table, w.OLAT);
    ret_naive<<<NB * RH * 8, 256, 0, st>>>(w.RQ, w.RK, w.Z, nullptr, w.ORET, io.sr_p, 0, T, T);
    ret_naive<<<NS * RH * 8, 256, 0, st>>>(w.RQ, w.RK, w.Z, io.state_ret, w.ORET, io.sr_s, RP, 1, 1);
    av_proj<<<R, 256, 0, st>>>(w.OLAT, io.w_uv, w.AV);
    gemm(st, w.AV, 512, io.w_mla_o, D, w.A, D, R, D, 512);
    ret_post<<<R, 256, 0, st>>>(w.ORET, w.Z, io.ret_gn, w.RIN);
    gemm(st, w.RIN, D, io.w_ret_o, D, w.RR, D, R, D, D);
    gate_mix<<<R, 256, 0, st>>>(w.Z, w.A, w.RR, w.MX);
    gemm(st, w.MX, D, io.w_out, D, w.DL, D, R, D, D);
    resid<<<4096, 256, 0, st>>>(w.H, w.DL, 1.0f, w.H2, (size_t)R * D);
    half_ffn(st, w, w.H2, io.ffn2_norm, io.ffn2_gate, io.ffn2_up, io.ffn2_down, w.H3);
    final_out<<<R, 256, 0, st>>>(w.H3, io.final_norm, io.y_prompt, io.y_sample);
}
}

extern "C" void kernel_launch(void* const* d_in, const int* in_sizes, int n_in,
                              void* d_out, int out_size, void* d_ws, size_t ws_size,
                              hipStream_t stream) {
    const ref::Io io = ref::make_io(d_in, (float*)d_out);
    const ref::Bufs w = ref::make_bufs(d_ws, nullptr);
    ref::forward(io, w, stream);
}
```

```cpp
#include <hip/hip_runtime.h>
#include <cstdio>
#include <cstdint>
#include <cmath>
#define MK_DEBUG 0
__device__ __forceinline__ int lane_fresh() { int l; asm volatile("v_mbcnt_lo_u32_b32 %0, -1, 0\n\tv_mbcnt_hi_u32_b32 %0, -1, %0" : "=v"(l)); return l; }
namespace pg8 {
#define PG8_LAS __attribute__((address_space(3)))
typedef unsigned short bf16_t;
typedef short bf16x8 __attribute__((ext_vector_type(8)));
typedef float f32x4 __attribute__((ext_vector_type(4)));
typedef unsigned u32x4 __attribute__((ext_vector_type(4)));
constexpr int BM = 256, BK = 64, HALF = 128, HTB = HALF * BK * 2  , STAGE_BYTES = 8 * HTB, NXCD = 8, WGM = 8;

__host__ __device__ __forceinline__ int lds_byte(int r, int c) { const int st = (r >> 4) * 2 + (c >> 5), rr = r & 15, cc = c & 31, ob = rr * 64 + cc * 2; return st * 1024 + (ob ^ (((ob >> 9) & 1) << 5)); }
__host__ __device__ __forceinline__ void stage_rc(int b, int& R, int& C) { const int st = b / 1024, sb = b % 1024, swz = sb ^ (((sb >> 9) & 1) << 5); R = (st >> 1) * 16 + swz / 64; C = (st & 1) * 32 + (swz % 64) / 2; }
__host__ __device__ __forceinline__ int perm32(int rho) { const int n = rho >> 4, i = rho & 15; return 8 * (i >> 2) + 4 * n + (i & 3); }

struct Unit { int pm, pn; };
struct Gemm { const bf16_t* A; const bf16_t* Bt; int M, N, K; };

struct StaticOrder {
    int nM, nN, nwg, G, c;
    __host__ __device__ void init(int M, int N, int G_, int c_) { nM = M / BM; nN = N / BM; nwg = nM * nN; G = G_; c = c_; }
    __host__ __device__ bool next(int i, Unit& u) const {
        const long L = (long)i * G + c; if (L >= nwg) return false;
        int wgid = (int)L; { const int q = nwg / NXCD, r = nwg % NXCD, xcd = wgid % NXCD, off = wgid / NXCD; wgid = (xcd < r ? xcd * (q + 1) : r * (q + 1) + (xcd - r) * q) + off; }
        const int nig = WGM * nN, gid = wgid / nig, fm = gid * WGM, gsz = (nM - fm) < WGM ? (nM - fm) : WGM;
        u.pm = fm + ((wgid % nig) % gsz); u.pn = (wgid % nig) / gsz; return true;
    }
    __device__ __forceinline__ void a_ready(const Unit&) const {}
    __device__ __forceinline__ void done(const Unit&) const {}
};

__device__ __forceinline__ unsigned cvt_pk_bf16(float lo, float hi) { unsigned r; asm volatile("v_cvt_pk_bf16_f32 %0, %1, %2" : "=v"(r) : "v"(lo), "v"(hi)); return r; }
typedef float f32x2 __attribute__((ext_vector_type(2)));
template <class Epi, class Sched, bool ALIGN_EPI = false, bool SP2 = false>
__device__ __forceinline__ void gemm_phase(PG8_LAS unsigned char* lds, const Gemm g, const Sched& S, const Epi& E, const int wave_in  ) {
    int tid_ = lane_fresh() + 64 * wave_in; asm volatile("" : "+v"(tid_));
    const int tid = tid_, wid = __builtin_amdgcn_readfirstlane(tid >> 6), lane = tid & 63, wr = wid >> 2, wc = wid & 3, fr = lane & 15, fq = lane >> 4;
    const int K = g.K, nt = K / BK;
    unsigned voffA[2], voffB[2];
#pragma unroll
    for (int i = 0; i < 2; ++i) { int R, C; stage_rc(tid * 16 + i * 8192, R, C); const int Rb = Epi::PERM ? ((R & ~31) + perm32(R & 31)) : R;
        voffA[i] = (unsigned)(R * K + C) * 2u; voffB[i] = (unsigned)(Rb * K + C) * 2u; }
    const size_t kstep = (size_t)(BK * 2);
    const size_t hstep = (size_t)HALF * K * 2;
    const size_t tstep = 2 * hstep;
    const unsigned ldsw = (unsigned)wid * 1024u;
    const int aoff = lds_byte(wr * 64 + fr, fq * 8), boff = lds_byte(wc * 32 + fr, fq * 8);
#define PG8_SA(b, h) (((b) * 2 + (h)) * HTB)
#define PG8_SB(b, h) ((4 + (b) * 2 + (h)) * HTB)
#define PG8_STAGE(bufoff, gbase, voff) do { _Pragma("unroll") for (int _i = 0; _i < 2; ++_i) \
        __builtin_amdgcn_global_load_lds((const unsigned*)((const char*)(gbase) + (voff)[_i]), (PG8_LAS unsigned*)(lds + (bufoff) + ldsw + _i * 8192), 16, 0, 0); } while (0)
#define PG8_LDA(dst, b, h) do { _Pragma("unroll") for (int m = 0; m < 4; ++m) _Pragma("unroll") for (int k = 0; k < 2; ++k) dst[m][k] = *(const PG8_LAS bf16x8*)(lds + PG8_SA(b, h) + aoff + m * 2048 + k * 1024); } while (0)
#define PG8_LDB(dst, b, h) do { _Pragma("unroll") for (int n = 0; n < 2; ++n) _Pragma("unroll") for (int k = 0; k < 2; ++k) dst[n][k] = *(const PG8_LAS bf16x8*)(lds + PG8_SB(b, h) + boff + n * 2048 + k * 1024); } while (0)
#define PG8_MMA(ai, bj, At, Bt) do { __builtin_amdgcn_s_setprio(1); _Pragma("unroll") for (int m = 0; m < 4; ++m) _Pragma("unroll") for (int n = 0; n < 2; ++n) _Pragma("unroll") for (int k = 0; k < 2; ++k) \
        acc[ai][bj][m][n] = __builtin_amdgcn_mfma_f32_16x16x32_bf16(Bt[n][k], At[m][k], acc[ai][bj][m][n], 0, 0, 0); __builtin_amdgcn_s_setprio(0); } while (0)
#define PG8_WAIT_V(n) asm volatile("s_waitcnt vmcnt(" #n ")" ::: "memory")
#define PG8_WAIT_L(n) asm volatile("s_waitcnt lgkmcnt(" #n ")" ::: "memory")
#define PG8_BAR __builtin_amdgcn_s_barrier()
#define PG8_SCHED __builtin_amdgcn_sched_barrier(0)
    Unit cur, nxt; int ui = 0;
    if (!S.next(0, cur)) return;
    f32x4 acc[2][2][4][2];
#pragma unroll
    for (int a = 0; a < 2; ++a)
#pragma unroll
        for (int b = 0; b < 2; ++b)
#pragma unroll
            for (int m = 0; m < 4; ++m)
#pragma unroll
                for (int n = 0; n < 2; ++n) acc[a][b][m][n] = (f32x4){0.f, 0.f, 0.f, 0.f};
    bf16x8 At[4][2], B0[2][2], B1[2][2];
    const char* cA = (const char*)g.A + (size_t)cur.pm * tstep; const char* cB = (const char*)g.Bt + (size_t)cur.pn * tstep;
    S.a_ready(cur);
    if constexpr (SP2) {
        PG8_STAGE(PG8_SB(0, 0), cB, voffB); PG8_STAGE(PG8_SB(0, 1), cB + hstep, voffB); PG8_STAGE(PG8_SA(0, 0), cA, voffA); PG8_STAGE(PG8_SA(0, 1), cA + hstep, voffA);
        if (wr == 1) PG8_BAR;
        PG8_WAIT_V(2); PG8_BAR;
        PG8_STAGE(PG8_SB(1, 0), cB + kstep, voffB); PG8_STAGE(PG8_SA(1, 0), cA + kstep, voffA); PG8_STAGE(PG8_SB(1, 1), cB + hstep + kstep, voffB);
        PG8_WAIT_V(6); PG8_BAR;
    } else {
        PG8_STAGE(PG8_SB(0, 0), cB, voffB); PG8_STAGE(PG8_SA(0, 0), cA, voffA); PG8_STAGE(PG8_SB(0, 1), cB + hstep, voffB); PG8_STAGE(PG8_SA(0, 1), cA + hstep, voffA);
        if (wr == 1) PG8_BAR;
        PG8_WAIT_V(4); PG8_BAR;
        PG8_STAGE(PG8_SB(1, 0), cB + kstep, voffB); PG8_STAGE(PG8_SA(1, 0), cA + kstep, voffA); PG8_STAGE(PG8_SB(1, 1), cB + hstep + kstep, voffB);
        PG8_WAIT_V(6); PG8_BAR;
    }
    for (;;) {
        const bool has_next = S.next(ui + 1, nxt);
        const char* nA = has_next ? (const char*)g.A + (size_t)nxt.pm * tstep : cA; const char* nB = has_next ? (const char*)g.Bt + (size_t)nxt.pn * tstep : cB;
        for (int t = 0; t < nt; t += 2) {
            const bool last = (t == nt - 2);
            const char* a1 = cA + (size_t)(t + 1) * kstep;
            const char* a2 = last ? nA : cA + (size_t)(t + 2) * kstep; const char* b2 = last ? nB : cB + (size_t)(t + 2) * kstep;
            const char* a3 = a2 + kstep; const char* b3 = b2 + kstep;
            if (last && has_next) S.a_ready(nxt);
            if constexpr (SP2) {
            PG8_LDB(B0, 0, 0); PG8_LDB(B1, 0, 1); PG8_SCHED; PG8_LDA(At, 0, 0); PG8_STAGE(PG8_SA(1, 1), a1 + hstep, voffA);
            PG8_WAIT_V(8); PG8_WAIT_L(0); PG8_BAR; PG8_MMA(0, 0, At, B0); PG8_MMA(0, 1, At, B1); PG8_BAR; PG8_SCHED;
            PG8_LDA(At, 0, 1); PG8_STAGE(PG8_SB(0, 0), b2, voffB); PG8_STAGE(PG8_SB(0, 1), b2 + hstep, voffB); PG8_STAGE(PG8_SA(0, 0), a2, voffA);
            PG8_WAIT_V(8); PG8_WAIT_L(0); PG8_BAR; PG8_MMA(1, 0, At, B0); PG8_MMA(1, 1, At, B1); PG8_BAR; PG8_SCHED;
            PG8_LDB(B0, 1, 0); PG8_LDB(B1, 1, 1); PG8_SCHED; PG8_LDA(At, 1, 0); PG8_STAGE(PG8_SA(0, 1), a2 + hstep, voffA);
            PG8_WAIT_V(8); PG8_WAIT_L(0); PG8_BAR; PG8_MMA(0, 0, At, B0); PG8_MMA(0, 1, At, B1); PG8_BAR; PG8_SCHED;
            PG8_LDA(At, 1, 1); PG8_STAGE(PG8_SB(1, 0), b3, voffB); PG8_STAGE(PG8_SB(1, 1), b3 + hstep, voffB); PG8_STAGE(PG8_SA(1, 0), a3, voffA);
            PG8_WAIT_V(8); PG8_WAIT_L(0); PG8_BAR; PG8_MMA(1, 0, At, B0); PG8_MMA(1, 1, At, B1); PG8_BAR; PG8_SCHED;
            } else {
            PG8_LDB(B0, 0, 0); PG8_SCHED; PG8_LDA(At, 0, 0); PG8_STAGE(PG8_SA(1, 1), a1 + hstep, voffA);
            PG8_WAIT_L(8); PG8_BAR; PG8_WAIT_L(0); PG8_MMA(0, 0, At, B0); PG8_BAR; PG8_SCHED;
            PG8_LDB(B1, 0, 1); PG8_STAGE(PG8_SB(0, 0), b2, voffB);
            PG8_BAR; PG8_WAIT_L(0); PG8_MMA(0, 1, At, B1); PG8_BAR;
            PG8_LDA(At, 0, 1); PG8_STAGE(PG8_SA(0, 0), a2, voffA);
            PG8_BAR; PG8_WAIT_L(0); PG8_MMA(1, 0, At, B0); PG8_BAR; PG8_SCHED;
            PG8_STAGE(PG8_SB(0, 1), b2 + hstep, voffB);
            PG8_WAIT_V(6); PG8_BAR; PG8_MMA(1, 1, At, B1); PG8_BAR;
            PG8_LDB(B0, 1, 0); PG8_SCHED; PG8_LDA(At, 1, 0); PG8_STAGE(PG8_SA(0, 1), a2 + hstep, voffA);
            PG8_WAIT_L(8); PG8_BAR; PG8_WAIT_L(0); PG8_MMA(0, 0, At, B0); PG8_BAR; PG8_SCHED;
            PG8_LDB(B1, 1, 1); PG8_STAGE(PG8_SB(1, 0), b3, voffB);
            PG8_BAR; PG8_WAIT_L(0); PG8_MMA(0, 1, At, B1); PG8_BAR;
            PG8_LDA(At, 1, 1); PG8_STAGE(PG8_SA(1, 0), a3, voffA);
            PG8_BAR; PG8_WAIT_L(0); PG8_MMA(1, 0, At, B0); PG8_BAR; PG8_SCHED;
            PG8_STAGE(PG8_SB(1, 1), b3 + hstep, voffB);
            PG8_WAIT_V(6); PG8_BAR; PG8_MMA(1, 1, At, B1); PG8_BAR;
            }
        }
        if constexpr (ALIGN_EPI) { if (wr == 0) PG8_BAR; }
        if constexpr (!Epi::AFTER_DRAIN) { E(acc, cur, wr, wc, fr, fq); S.done(cur); }
        if (!has_next) break;
#pragma unroll
        for (int a = 0; a < 2; ++a)
#pragma unroll
            for (int b = 0; b < 2; ++b)
#pragma unroll
                for (int m = 0; m < 4; ++m)
#pragma unroll
                    for (int n = 0; n < 2; ++n) acc[a][b][m][n] = (f32x4){0.f, 0.f, 0.f, 0.f};
        cur = nxt; cA = nA; cB = nB; ++ui;
        if constexpr (ALIGN_EPI) { if (wr == 1) PG8_BAR; }
    }
    PG8_WAIT_V(0);
    if constexpr (!ALIGN_EPI) { if (wr == 0) PG8_BAR; }
    PG8_BAR;
    if constexpr (Epi::AFTER_DRAIN) { E.fused(acc, cur, wr, wc, fr, fq, lds, wid, lane); S.done(cur); }
#undef PG8_SA
#undef PG8_SB
#undef PG8_STAGE
#undef PG8_LDA
#undef PG8_LDB
#undef PG8_MMA
#undef PG8_WAIT_V
#undef PG8_WAIT_L
#undef PG8_BAR
#undef PG8_SCHED
}
}
#define GAS __attribute__((address_space(1)))
#define LAS __attribute__((address_space(3)))
typedef unsigned short bf16;
typedef unsigned v4u __attribute__((ext_vector_type(4)));
typedef float f32x4 __attribute__((ext_vector_type(4)));
typedef short bf16x8 __attribute__((ext_vector_type(8)));
typedef GAS unsigned gu32;
typedef GAS unsigned long long gu64;
#define RLX_AGENT __ATOMIC_RELAXED, __HIP_MEMORY_SCOPE_AGENT
#define LDS_WAIT() asm volatile("s_waitcnt lgkmcnt(0)" ::: "memory")
#define VM_WAIT() asm volatile("s_waitcnt vmcnt(0)" ::: "memory")
__device__ __forceinline__ unsigned long long rt() { return __builtin_amdgcn_s_memrealtime(); }
__device__ __forceinline__ unsigned f2bf(float f) { unsigned u = __builtin_bit_cast(unsigned, f); return (u + 0x7fffu + ((u >> 16) & 1u)) >> 16; }
__device__ __forceinline__ unsigned pk2(float lo, float hi) { return f2bf(lo) | (f2bf(hi) << 16); }

#define XB_TMO      128
#define XB_XCNT(j)  (256  + 64 * (j))
#define XB_XSUB(j)  (1280 + 64 * (j))
#define XB_XGEN(j)  (2304 + 64 * (j))
#define XB_TOP      3328
#define XB_TOPGEN   3392
#define XCD_BAR_WORDS 3456
#define XB_SPIN_CAP (1u << 18)

__device__ __forceinline__ unsigned xb_ld(unsigned* p)              { return __hip_atomic_load(p, __ATOMIC_RELAXED, __HIP_MEMORY_SCOPE_AGENT); }
__device__ __forceinline__ unsigned xb_add(unsigned* p, unsigned v) { return __hip_atomic_fetch_add(p, v, __ATOMIC_RELAXED, __HIP_MEMORY_SCOPE_AGENT); }
__device__ __forceinline__ unsigned xb_xcc_id() { return (unsigned)__builtin_amdgcn_s_getreg((3 << 11) | 20) & 0xFu; }
#define XB_SPIN(cond, bar) do { unsigned _sp = 0; while (cond) { __builtin_amdgcn_s_sleep(1); \
    if ((++_sp & 255u) == 0u) { if (xb_ld(&(bar)[XB_TMO])) break; if (_sp > XB_SPIN_CAP) { atomicAdd(&(bar)[XB_TMO], 1u); break; } } } } while (0)

struct XcdBarrier {
    unsigned* bar; unsigned x; int wave;
    volatile LAS unsigned* st;
};

#define XB_IS_T0(wave) ((wave) == 0 && lane_fresh() == 0)
__device__ __forceinline__ XcdBarrier xcd_barrier_post(unsigned* bar, volatile LAS unsigned* st, int wave) {
    XcdBarrier b; b.bar = bar; b.x = xb_xcc_id(); b.st = st; b.wave = wave;
    if (XB_IS_T0(wave)) (void)xb_add(&bar[XB_XCNT(b.x)], 1u);
    return b;
}
__device__ __forceinline__ void xcd_barrier_complete(unsigned* bar, unsigned x, unsigned& nloc, unsigned& nx) {
    const unsigned G = gridDim.x * gridDim.y * gridDim.z;
    unsigned sum, cnt, mine, sp = 0u;
    for (;;) {
        sum = 0u; cnt = 0u; mine = 0u;
#pragma unroll
        for (unsigned j = 0; j < 16; ++j) { const unsigned c = xb_ld(&bar[XB_XCNT(j)]); sum += c; cnt += (c > 0u) ? 1u : 0u; mine = (j == x) ? c : mine; }
        if (sum == G) break;
        __builtin_amdgcn_s_sleep(1);
        if ((++sp & 255u) == 0u) { if (xb_ld(&bar[XB_TMO])) break; if (sp > XB_SPIN_CAP) { atomicAdd(&bar[XB_TMO], 1u); break; } }
    }
    nloc = mine > 0u ? mine : 1u; nx = cnt > 0u ? cnt : 1u;
}

__device__ __forceinline__ void xcd_barrier(const XcdBarrier& b) {
    asm volatile("s_waitcnt vmcnt(0)" ::: "memory");
    __syncthreads();
    if (XB_IS_T0(b.wave)) {
        unsigned* bar = b.bar;
        __builtin_amdgcn_s_waitcnt(0);
        unsigned nloc = b.st[0], nx = b.st[1];
        if (nloc == 0u) { xcd_barrier_complete(bar, b.x, nloc, nx); b.st[0] = nloc; b.st[1] = nx; }
        const unsigned old = xb_add(&bar[XB_XSUB(b.x)], 1u);
        const unsigned gen = old / nloc;
        if (old + 1u == (gen + 1u) * nloc) {
            __builtin_amdgcn_fence(__ATOMIC_RELEASE, "agent");
            asm volatile("s_waitcnt vmcnt(0)" ::: "memory");
            const unsigned og = xb_add(&bar[XB_TOP], 1u);
            const unsigned tg = og / nx;
            if (og + 1u == (tg + 1u) * nx) xb_add(&bar[XB_TOPGEN], 1u);
            else XB_SPIN(xb_ld(&bar[XB_TOPGEN]) == tg, bar);
            __builtin_amdgcn_fence(__ATOMIC_ACQUIRE, "agent");
            xb_add(&bar[XB_XGEN(b.x)], 1u);
            asm volatile("s_waitcnt vmcnt(0)" ::: "memory");
        } else {
            XB_SPIN(xb_ld(&bar[XB_XGEN(b.x)]) == gen, bar);
            __builtin_amdgcn_fence(__ATOMIC_ACQUIRE, "agent");
            asm volatile("s_waitcnt vmcnt(0)" ::: "memory");
        }
    }
    __syncthreads();
}
namespace mk {
constexpr int D = 1024, NB = 8, SEQ = 2048, NMETA = 16, T = SEQ + NMETA, NS = 32, PAST = 16384, PAGE = 128, NPAGES = PAST / PAGE;
constexpr int FFN = 2816, NH = 8, QR = 384, KVR = 256, RH = 4, RDK = 128, RDV = 256, IN_DIM = 5792;
constexpr int O_CQ = 0, O_CKV = 384, O_KR = 640, O_RQ = 672, O_RK = 1184, O_RV = 1696, O_RG = 2720, O_GA = 3744, O_GB = 4768;
constexpr int MMAIN = NB * SEQ;
constexpr int ROW_META = MMAIN;
constexpr int ROW_SMP = MMAIN + NMETA;
constexpr int ROW_PAD = ROW_SMP + NS;
constexpr int MP = MMAIN + 256;
constexpr int NWIN = 5888;
constexpr int NPOS = T + 1;
constexpr float EPS = 1e-6f;
constexpr int NWAVES = 8;

constexpr size_t MiB = 1u << 20;
constexpr size_t al(size_t x) { return (x + 255) / 256 * 256; }
constexpr size_t WS_CTL = 0, CTL_ZERO_BYTES = 1 * MiB;
constexpr size_t WS_W1T = 1 * MiB;
constexpr size_t WS_W1D = WS_W1T + al((size_t)2 * FFN * D * 2);
constexpr size_t WS_WIN = WS_W1D + al((size_t)D * FFN * 2);
constexpr size_t WS_WUQ = WS_WIN + al((size_t)NWIN * D * 2);
constexpr size_t WS_WUK = WS_WUQ + al((size_t)768 * QR * 2);
constexpr size_t WS_WUV = WS_WUK + al((size_t)512 * KVR * 2);
constexpr size_t WS_WMO = WS_WUV + al((size_t)512 * KVR * 2);
constexpr size_t WS_WRO = WS_WMO + al((size_t)D * 512 * 2);
constexpr size_t WS_WOUT = WS_WRO + al((size_t)D * D * 2);
constexpr size_t WS_W2T = WS_WOUT + al((size_t)D * D * 2);
constexpr size_t WS_W2D = WS_W2T + al((size_t)2 * FFN * D * 2);
constexpr size_t WS_TAB = WS_W2D + al((size_t)D * FFN * 2);
constexpr size_t TAB_C64 = 0, TAB_S64 = (size_t)NPOS * 64 * 4, TAB_C16 = 2 * TAB_S64, TAB_S16 = TAB_C16 + (size_t)NPOS * 16 * 4, TAB_GP = TAB_S16 + (size_t)NPOS * 16 * 4, TAB_GN = TAB_GP + 512 * 4, TAB_END = TAB_GN + 512 * 4;
constexpr size_t WS_XB = WS_TAB + al(TAB_END);
constexpr size_t WS_XE = WS_XB + al((size_t)MP * D * 2);
constexpr size_t WS_R1 = WS_XE + al((size_t)256 * D * 4);
constexpr size_t WS_ACT = WS_R1 + al((size_t)MP * 4);
constexpr size_t WS_H = WS_ACT + al((size_t)MP * FFN * 2);
constexpr size_t WS_HB = WS_H + al((size_t)MP * D * 4);
constexpr size_t WS_SSQH = WS_HB + al((size_t)MP * D * 2);
constexpr size_t WS_END1 = WS_SSQH + al((size_t)MP * 16 * 4);

constexpr int CW_BAR = 4096;

constexpr int RING_OFF = 0, RING_BYTES = 131072, LDSCTL_OFF = RING_BYTES, MISC_OFF = LDSCTL_OFF + 320, LDS_BYTES = 147456;

struct Args {
    const float* in[27]; float* out; unsigned char* ws;
};

struct Frame {
    LAS unsigned char* lds;
    volatile LAS unsigned* MISC;
    int wave, vcu, G;
};
__device__ __forceinline__ int fresh_tid(int wave) { int t = lane_fresh() + 64 * wave; asm volatile("" : "+v"(t)); return t; }

__device__ __forceinline__ float lx(float v, int lane, int mask) { return __int_as_float(__builtin_amdgcn_ds_bpermute((lane ^ mask) << 2, __float_as_int(v))); }
__device__ __forceinline__ float wave_sum(float v, int lane) {
#pragma unroll
    for (int o = 1; o < 64; o <<= 1) v += lx(v, lane, o);
    return v;
}
__device__ __forceinline__ int row_pos(int row) { return row < MMAIN ? (row & (SEQ - 1)) + NMETA : (row < ROW_SMP ? row - ROW_META : (row < ROW_PAD ? PAST : 0)); }
__device__ __forceinline__ int row_pidx(int row) { return row < MMAIN ? (row & (SEQ - 1)) + NMETA : (row < ROW_SMP ? row - ROW_META : (row < ROW_PAD ? T : 0)); }
__device__ __forceinline__ int row_jtok(int row) { return row < MMAIN ? (row & 127) : (row < ROW_SMP ? row - ROW_META : 0); }

struct WSrc { const float* W; int ld; int col0; const float* g; };
__device__ __forceinline__ void wmat_dims(int id, int& K, int& ngrp) {
    switch (id) {
        case 0: case 9: K = D; ngrp = 2 * FFN / 32; break;
        case 1: case 10: K = FFN; ngrp = D / 32; break;
        case 2: K = D; ngrp = NWIN / 32; break;
        case 3: K = QR; ngrp = 768 / 32; break;
        case 4: case 5: K = KVR; ngrp = 512 / 32; break;
        case 6: K = 512; ngrp = D / 32; break;
        default: K = D; ngrp = D / 32; break;
    }
}
__device__ __forceinline__ size_t wmat_off(int id) {
    switch (id) { case 0: return WS_W1T; case 1: return WS_W1D; case 2: return WS_WIN; case 3: return WS_WUQ; case 4: return WS_WUK; case 5: return WS_WUV;
                  case 6: return WS_WMO; case 7: return WS_WRO; case 8: return WS_WOUT; case 9: return WS_W2T; default: return WS_W2D; }
}
__device__ __forceinline__ WSrc wmat_src(const Args& a, int id, int g) {
    WSrc s; s.W = nullptr; s.ld = 0; s.col0 = 0; s.g = nullptr;
    switch (id) {
        case 0: case 9: { const int pn = g >> 3, gg = g & 7; const int o = id == 0 ? 7 : 22;
            s.W = gg < 4 ? a.in[o + 1] : a.in[o + 2]; s.ld = FFN; s.col0 = 128 * pn + 32 * (gg & 3); s.g = a.in[o]; break; }
        case 1: s.W = a.in[10]; s.ld = D; s.col0 = 32 * g; break;
        case 10: s.W = a.in[25]; s.ld = D; s.col0 = 32 * g; break;
        case 2: { s.ld = IN_DIM; s.g = a.in[11]; int zc = -1;
            if (g < 8) zc = 32 * g;
            else if (g < 16) { const int gg = g - 8; zc = gg < 4 ? 256 + 32 * gg : (gg == 4 ? O_KR : -1); }
            else if (g < 24) zc = O_CKV + 32 * (g - 16);
            else if (g < 56) { const int base = g < 40 ? O_RQ : O_RK; const int q = (g - 24) & 15, t = q >> 3, gg = q & 7;
                const int h = 2 * t + ((gg >> 1) & 1), part = (gg >> 2) * 64 + (gg & 1) * 32; zc = base + h * 128 + part; }
            else if (g < 88) zc = O_RV + 32 * (g - 56);
            else if (g < 120) zc = O_RG + 32 * (g - 88);
            else if (g < 152) zc = O_GA + 32 * (g - 120);
            else zc = O_GB + 32 * (g - 152);
            if (zc >= 0) { s.W = a.in[12]; s.col0 = zc; }
            break; }
        case 3: s.W = a.in[15]; s.ld = 768; s.col0 = 32 * g; s.g = a.in[13]; break;
        case 4: s.W = a.in[16]; s.ld = 512; s.col0 = 32 * g; s.g = a.in[14]; break;
        case 5: s.W = a.in[17]; s.ld = 512; s.col0 = 32 * g; s.g = a.in[14]; break;
        case 6: s.W = a.in[18]; s.ld = D; s.col0 = 32 * g; break;
        case 7: s.W = a.in[20]; s.ld = D; s.col0 = 32 * g; break;
        default: s.W = a.in[21]; s.ld = D; s.col0 = 32 * g; break;
    }
    return s;
}
__device__ __forceinline__ void p0_transpose_item(const WSrc s, int K, bf16* WT, int n0, int k0, LAS float* scr, int lane) {
    if (s.W) {
#pragma unroll 8
        for (int i = 0; i < 32; ++i) { const int kk = 2 * i + (lane >> 5); float v = s.W[(size_t)(k0 + kk) * s.ld + s.col0 + (lane & 31)]; if (s.g) v *= s.g[k0 + kk]; scr[kk * 33 + (lane & 31)] = v; }
    } else {
#pragma unroll 8
        for (int i = 0; i < 32; ++i) { const int kk = 2 * i + (lane >> 5); scr[kk * 33 + (lane & 31)] = 0.f; }
    }
    LDS_WAIT(); asm volatile("" ::: "memory");
    const int c = lane & 7;
#pragma unroll
    for (int j = 0; j < 4; ++j) { const int n = (lane >> 3) + 8 * j; const LAS float* sp = scr + (8 * c) * 33 + n;
        v4u o; o.x = pk2(sp[0 * 33], sp[1 * 33]); o.y = pk2(sp[2 * 33], sp[3 * 33]); o.z = pk2(sp[4 * 33], sp[5 * 33]); o.w = pk2(sp[6 * 33], sp[7 * 33]);
        *(GAS v4u*)(WT + (size_t)(n0 + n) * K + k0 + 8 * c) = o; }
    LDS_WAIT(); asm volatile("" ::: "memory");
}
__device__ __forceinline__ const float* x_src(const Args& a, int row) {
    if (row < MMAIN) return a.in[0] + (size_t)row * D;
    if (row < ROW_SMP) return a.in[6] + (size_t)(row - ROW_META) * D;
    if (row < ROW_PAD) return a.in[1] + (size_t)(row - ROW_SMP) * D;
    return nullptr;
}
__device__ __forceinline__ void p0_prologue(Frame& F, const Args& a) {
    const int lane = fresh_tid(F.wave) & 63;
    LAS float* scr = (LAS float*)(F.lds + RING_OFF + F.wave * 16384);
    const int gw = F.vcu * NWAVES + F.wave, NGW = F.G * NWAVES;
    unsigned char* ws = a.ws;
    int base = 0;
#pragma unroll 1
    for (int id = 0; id < 11; ++id) {
        int K, ngrp; wmat_dims(id, K, ngrp);
        const int nk = K / 64, nitems = nk * ngrp;
        bf16* WT = (bf16*)(ws + wmat_off(id));
        int first = (gw - (base % NGW) + NGW) % NGW;
        for (int it = first; it < nitems; it += NGW) { const int g = it % ngrp, kb = it / ngrp; p0_transpose_item(wmat_src(a, id, g), K, WT, 32 * g, 64 * kb, scr, lane); }
        base += nitems;
    }
    bf16* XB = (bf16*)(ws + WS_XB); float* XE = (float*)(ws + WS_XE); float* R1 = (float*)(ws + WS_R1);
    for (int m = gw; m < MP; m += NGW) {
        const float* xr = x_src(a, m);
        f32x4 v[4]; float s = 0.f;
#pragma unroll
        for (int j = 0; j < 4; ++j) { v[j] = xr ? *((const GAS f32x4*)xr + lane + 64 * j) : (f32x4){0.f, 0.f, 0.f, 0.f}; s += (v[j].x * v[j].x + v[j].y * v[j].y) + (v[j].z * v[j].z + v[j].w * v[j].w); }
        s = wave_sum(s, lane);
        if (lane == 0) R1[m] = 1.0f / sqrtf(s * (1.f / D) + EPS);
        GAS unsigned long long* o8 = (GAS unsigned long long*)(XB + (size_t)m * D) + lane;
#pragma unroll
        for (int j = 0; j < 4; ++j) o8[64 * j] = (unsigned long long)pk2(v[j].x, v[j].y) | ((unsigned long long)pk2(v[j].z, v[j].w) << 32);
        if (m >= MMAIN) {
#pragma unroll
            for (int j = 0; j < 4; ++j) *((GAS f32x4*)(XE + (size_t)(m - MMAIN) * D) + lane + 64 * j) = v[j];
        }
    }
    float* TAB = (float*)(ws + WS_TAB);
    const int gt = (F.vcu * NWAVES + F.wave) * 64 + lane, NGT = NGW * 64;
    for (int e = gt; e < NPOS * 64; e += NGT) { const int p = e >> 6, i = e & 63; const int pos = p < T ? p : PAST;
        const float invf = (float)pow(10000.0, -(double)i / 64.0); const float ang = (float)pos * invf;
        TAB[TAB_C64 / 4 + e] = (float)cos((double)ang); TAB[TAB_S64 / 4 + e] = (float)sin((double)ang); }
    for (int e = gt; e < NPOS * 16; e += NGT) { const int p = e >> 4, i = e & 15; const int pos = p < T ? p : PAST;
        const float invf = (float)pow(10000.0, -(double)i / 16.0); const float ang = (float)pos * invf;
        TAB[TAB_C16 / 4 + e] = (float)cos((double)ang); TAB[TAB_S16 / 4 + e] = (float)sin((double)ang); }
    for (int e = gt; e < 512; e += NGT) { const int h = e >> 7, j = e & 127; const double lg = log1p(-exp2(-5.0 - (double)h));
        TAB[TAB_GP / 4 + e] = (float)exp(lg * (double)j); TAB[TAB_GN / 4 + e] = (float)exp(-lg * (double)j); }
}

using pg8::f32x4; using pg8::u32x4; using pg8::Unit; using pg8::BM; using pg8::HALF;
typedef unsigned u32x2 __attribute__((ext_vector_type(2)));
__device__ __forceinline__ float fast_sigmoid(float x) { return __builtin_amdgcn_rcpf(1.f + __builtin_amdgcn_exp2f(-1.4426950408889634f * x)); }
__device__ __forceinline__ float fast_silu(float x) { return x * fast_sigmoid(x); }

struct EpiSwiGLU {
    static constexpr bool PERM = true, AFTER_DRAIN = false;
    bf16* ACT; const float* rs;
    __device__ __forceinline__ void operator()(const f32x4 (&acc)[2][2][4][2], const Unit& u, int wr, int wc, int fr, int fq) const {
        int l_ = lane_fresh(); asm volatile("" : "+v"(l_)); fr = l_ & 15; fq = l_ >> 4;
        const int row0 = u.pm * BM + wr * 64 + fr, col0 = u.pn * HALF + wc * 32 + 8 * fq;
#pragma unroll
        for (int ai = 0; ai < 2; ++ai)
#pragma unroll
            for (int m = 0; m < 4; ++m) { const int row = row0 + ai * HALF + m * 16; const float r = rs[row];
                f32x4 o[2];
#pragma unroll
                for (int n = 0; n < 2; ++n)
#pragma unroll
                    for (int j = 0; j < 4; ++j) { const float g = acc[ai][0][m][n][j] * r, up = acc[ai][1][m][n][j] * r; o[n][j] = fast_silu(g) * up; }
                u32x4 w; w.x = pg8::cvt_pk_bf16(o[0][0], o[0][1]); w.y = pg8::cvt_pk_bf16(o[0][2], o[0][3]); w.z = pg8::cvt_pk_bf16(o[1][0], o[1][1]); w.w = pg8::cvt_pk_bf16(o[1][2], o[1][3]);
                *(u32x4*)(ACT + (size_t)row * FFN + col0) = w; }
    }
};
template <class T> __device__ __forceinline__ T* at(unsigned char* w, unsigned byte_off) { return (T*)(w + byte_off); }
template <unsigned RES_OFF, bool RES_X, unsigned OUT_OFF, unsigned OUTB_OFF, unsigned SSQ_OFF, int SCALE2  > struct EpiResid {
    static constexpr bool PERM = false, AFTER_DRAIN = false;
    unsigned char* ws_; const float* xin;
    __device__ __forceinline__ void operator()(const f32x4 (&acc)[2][2][4][2], const Unit& u, int wr, int wc, int fr, int fq) const {
        int l_ = lane_fresh(); asm volatile("" : "+v"(l_)); fr = l_ & 15; fq = l_ >> 4;
        unsigned char* w = ws_; asm volatile("" : "+s"(w));
        const unsigned row0 = u.pm * BM + wr * 64 + fr, col0 = u.pn * BM + wc * 32 + 4 * fq;
        constexpr float scale = 0.5f * SCALE2;
#pragma unroll
        for (int ai = 0; ai < 2; ++ai)
#pragma unroll
            for (int m = 0; m < 4; ++m) { unsigned row = row0 + ai * HALF + m * 16; asm volatile("" : "+v"(row));
                const float* rp;
                if (RES_X) rp = row < (unsigned)MMAIN ? xin + row * D + col0 : at<const float>(w, RES_OFF + ((row - MMAIN) * D + col0) * 4);
                else rp = at<const float>(w, RES_OFF + (row * D + col0) * 4);
                float ss = 0.f;
#pragma unroll
                for (int bj = 0; bj < 2; ++bj)
#pragma unroll
                    for (int n = 0; n < 2; ++n) { const f32x4 b = *(const f32x4*)(rp + bj * HALF + n * 16); const f32x4 o = b + acc[ai][bj][m][n] * scale;
                        const unsigned e = row * D + col0 + bj * HALF + n * 16;
                        *at<f32x4>(w, OUT_OFF + e * 4) = o;
                        ss += (o[0] * o[0] + o[1] * o[1]) + (o[2] * o[2] + o[3] * o[3]);
                        if (OUTB_OFF) { u32x2 pk; pk.x = pg8::cvt_pk_bf16(o[0], o[1]); pk.y = pg8::cvt_pk_bf16(o[2], o[3]); *at<u32x2>(w, OUTB_OFF + e * 2) = pk; } }
                ss += lx(ss, l_, 16); ss += lx(ss, l_, 32);
                if (fq == 0) *at<float>(w, SSQ_OFF + (row * 16 + u.pn * 4 + wc) * 4) = ss;
                asm volatile("" ::: "memory"); }
    }
};
}
namespace mk {
constexpr size_t WS_CQ = WS_END1;
constexpr size_t WS_SSQCQ = WS_CQ + al((size_t)MP * QR * 2);
constexpr size_t WS_CKVF = WS_SSQCQ + al((size_t)MP * 8 * 4);
constexpr size_t WS_CKVB = WS_CKVF + al((size_t)MP * KVR * 4);
constexpr size_t WS_SSQKV = WS_CKVB + al((size_t)MP * KVR * 2);
constexpr size_t WS_KRB = WS_SSQKV + al((size_t)MP * 4 * 4);
constexpr size_t WS_RQ = WS_KRB + al((size_t)MP * 32 * 2);
constexpr size_t WS_RK = WS_RQ + al((size_t)MP * 512 * 2);
constexpr size_t WS_RKT = WS_RK + al((size_t)MP * 512 * 2);
constexpr size_t WS_RVT = WS_RKT + al((size_t)MP * 512 * 2);
constexpr size_t WS_SRG = WS_RVT + al((size_t)MP * 1024 * 2);
constexpr size_t WS_SGA = WS_SRG + al((size_t)MP * 1024 * 2);
constexpr size_t WS_SGB = WS_SGA + al((size_t)MP * 1024 * 2);
constexpr size_t WS_QA = WS_SGB + al((size_t)MP * 1024 * 2);
constexpr size_t WS_KN = WS_QA + al((size_t)MP * 768 * 2);
constexpr size_t WS_VT = WS_KN + al((size_t)MP * 512 * 2);
constexpr size_t WS_KRF = WS_VT + al((size_t)MP * 512 * 2);
constexpr size_t WS_END2 = WS_KRF + al((size_t)MP * 32 * 4);
constexpr float SC_Q = 0.14724444348433683f;
constexpr float RK_SCALE = 0.08838834764831845f;

constexpr size_t OUT_YP = 0, OUT_YS = OUT_YP + (size_t)NB * SEQ * D, OUT_CKVP = OUT_YS + (size_t)NS * D, OUT_KRP = OUT_CKVP + (size_t)NB * T * KVR,
                 OUT_SRP = OUT_KRP + (size_t)NB * T * 32, OUT_CKVS = OUT_SRP + (size_t)NB * RH * RDK * RDV, OUT_KRS = OUT_CKVS + (size_t)NS * KVR, OUT_SRS = OUT_KRS + (size_t)NS * 32,
                 OUT_END = OUT_SRS + (size_t)NS * RH * RDK * RDV;

__device__ __forceinline__ float row_rscale16(const float* SSQ, int row, float inv_n) {
    const f32x4* p = (const f32x4*)(SSQ + (size_t)row * 16); const f32x4 a = p[0], b = p[1], c = p[2], d = p[3];
    const float s = ((a[0] + a[1]) + (a[2] + a[3])) + ((b[0] + b[1]) + (b[2] + b[3])) + ((c[0] + c[1]) + (c[2] + c[3])) + ((d[0] + d[1]) + (d[2] + d[3]));
    return 1.0f / sqrtf(s * inv_n + EPS);
}
__device__ __forceinline__ float row_rscale8(const float* SSQ, int row, float inv_n) {
    const f32x4* p = (const f32x4*)(SSQ + (size_t)row * 8); const f32x4 a = p[0], b = p[1];
    return 1.0f / sqrtf((((a[0] + a[1]) + (a[2] + a[3])) + ((b[0] + b[1]) + (b[2] + b[3]))) * inv_n + EPS);
}
__device__ __forceinline__ float row_rscale4(const float* SSQ, int row, float inv_n) {
    const f32x4 a = *(const f32x4*)(SSQ + (size_t)row * 4);
    return 1.0f / sqrtf(((a[0] + a[1]) + (a[2] + a[3])) * inv_n + EPS);
}
__device__ __forceinline__ u32x2 pack4(const f32x4 v) { u32x2 w; w.x = pg8::cvt_pk_bf16(v[0], v[1]); w.y = pg8::cvt_pk_bf16(v[2], v[3]); return w; }
__device__ __forceinline__ float ssq4(const f32x4 v) { return (v[0] * v[0] + v[1] * v[1]) + (v[2] * v[2] + v[3] * v[3]); }
__device__ __forceinline__ bf16 bf1(float x) { return (bf16)f2bf(x); }

static_assert(WS_END2 < ((size_t)1 << 31), "32-bit workspace offsets");
struct EpiWin {
    static constexpr bool PERM = false, AFTER_DRAIN = false;
    unsigned char* ws_;
#define MK_WS(var) unsigned char* var = ws_; asm volatile("" : "+s"(var))
#define MK_ROWS_BEGIN _Pragma("unroll") for (int ai = 0; ai < 2; ++ai) _Pragma("unroll") for (int m = 0; m < 4; ++m) { \
        unsigned row = row0 + ai * HALF + m * 16; asm volatile("" : "+v"(row)); const float r = row_rscale16(at<const float>(w, (unsigned)WS_SSQH), (int)row, 1.f / D);
#define MK_ROWS_END asm volatile("" ::: "memory"); }
    __device__ __forceinline__ void operator()(const f32x4 (&acc)[2][2][4][2], const Unit& u, int wr, int wc, int fr, int fq) const {
        int l_ = lane_fresh(); asm volatile("" : "+v"(l_)); fr = l_ & 15; fq = l_ >> 4;
        const unsigned row0 = u.pm * BM + wr * 64 + fr; const int pn = u.pn;
        MK_WS(w);
        if (pn == 0) {
            MK_ROWS_BEGIN
                float ss = 0.f;
#pragma unroll
                for (int bj = 0; bj < 2; ++bj)
#pragma unroll
                    for (int n = 0; n < 2; ++n) { const f32x4 v = acc[ai][bj][m][n] * r; ss += ssq4(v); *at<u32x2>(w, (unsigned)WS_CQ + (row * QR + bj * HALF + wc * 32 + n * 16 + 4 * fq) * 2) = pack4(v); }
                ss += lx(ss, l_, 16); ss += lx(ss, l_, 32);
                if (fq == 0) *at<float>(w, (unsigned)WS_SSQCQ + (row * 8 + wc) * 4) = ss;
            MK_ROWS_END
        } else if (pn == 1) {
            MK_ROWS_BEGIN
                float ss = 0.f;
#pragma unroll
                for (int n = 0; n < 2; ++n) { const f32x4 v = acc[ai][0][m][n] * r; ss += ssq4(v); *at<u32x2>(w, (unsigned)WS_CQ + (row * QR + 256 + wc * 32 + n * 16 + 4 * fq) * 2) = pack4(v); }
                ss += lx(ss, l_, 16); ss += lx(ss, l_, 32);
                if (fq == 0) *at<float>(w, (unsigned)WS_SSQCQ + (row * 8 + 4 + wc) * 4) = ss;
                if (wc == 0) {
                    const f32x4 x1 = acc[ai][1][m][0] * r, x2 = acc[ai][1][m][1] * r;
                    const unsigned pi = row_pidx((int)row);
                    const f32x4 c = *at<const f32x4>(w, (unsigned)(WS_TAB + TAB_C16) + (pi * 16 + 4 * fq) * 4), s = *at<const f32x4>(w, (unsigned)(WS_TAB + TAB_S16) + (pi * 16 + 4 * fq) * 4);
                    const f32x4 y1 = x1 * c - x2 * s, y2 = x1 * s + x2 * c;
                    *at<u32x2>(w, (unsigned)WS_KRB + (row * 32 + 4 * fq) * 2) = pack4(y1); *at<u32x2>(w, (unsigned)WS_KRB + (row * 32 + 16 + 4 * fq) * 2) = pack4(y2);
                    *at<f32x4>(w, (unsigned)WS_KRF + (row * 32 + 4 * fq) * 4) = y1; *at<f32x4>(w, (unsigned)WS_KRF + (row * 32 + 16 + 4 * fq) * 4) = y2;
                }
            MK_ROWS_END
        } else if (pn == 2) {
            MK_ROWS_BEGIN
                float ss = 0.f;
#pragma unroll
                for (int bj = 0; bj < 2; ++bj)
#pragma unroll
                    for (int n = 0; n < 2; ++n) { const f32x4 v = acc[ai][bj][m][n] * r; ss += ssq4(v); const unsigned e = row * KVR + bj * HALF + wc * 32 + n * 16 + 4 * fq;
                        *at<f32x4>(w, (unsigned)WS_CKVF + e * 4) = v; *at<u32x2>(w, (unsigned)WS_CKVB + e * 2) = pack4(v); }
                ss += lx(ss, l_, 16); ss += lx(ss, l_, 32);
                if (fq == 0) *at<float>(w, (unsigned)WS_SSQKV + (row * 4 + wc) * 4) = ss;
            MK_ROWS_END
        } else if (pn < 7) {
            const bool isk = pn >= 5; const unsigned hh = 2 * ((pn - 3) & 1) + (wc >> 1);
            const unsigned dbase = (unsigned)(isk ? WS_RK : WS_RQ) + hh * 256, gbase = (unsigned)(WS_TAB + (isk ? TAB_GN : TAB_GP)) + hh * 512;
            MK_ROWS_BEGIN
                const unsigned pi = row_pidx((int)row), jt = row_jtok((int)row);
                const float mult = *at<const float>(w, gbase + jt * 4) * (isk ? RK_SCALE : 1.f);
#pragma unroll
                for (int n = 0; n < 2; ++n) { const unsigned i0 = 32 * (wc & 1) + 16 * n + 4 * fq;
                    const f32x4 x1 = acc[ai][0][m][n] * r, x2 = acc[ai][1][m][n] * r;
                    const f32x4 c = *at<const f32x4>(w, (unsigned)(WS_TAB + TAB_C64) + (pi * 64 + i0) * 4), s = *at<const f32x4>(w, (unsigned)(WS_TAB + TAB_S64) + (pi * 64 + i0) * 4);
                    const f32x4 y1 = (x1 * c - x2 * s) * mult, y2 = (x1 * s + x2 * c) * mult;
                    *at<u32x2>(w, dbase + (row * 512 + i0) * 2) = pack4(y1); *at<u32x2>(w, dbase + (row * 512 + 64 + i0) * 2) = pack4(y2);
                    if (isk) {
#pragma unroll
                        for (int j = 0; j < 4; ++j) { *at<bf16>(w, (unsigned)WS_RKT + ((hh * 128 + i0 + j) * MP + row) * 2) = bf1(y1[j]); *at<bf16>(w, (unsigned)WS_RKT + ((hh * 128 + 64 + i0 + j) * MP + row) * 2) = bf1(y2[j]); } } }
            MK_ROWS_END
        } else if (pn < 11) {
            const unsigned cbase = (unsigned)WS_RVT + ((pn - 7) * 256 + wc * 32 + 4 * fq) * (MP * 2);
            MK_ROWS_BEGIN
#pragma unroll
                for (int bj = 0; bj < 2; ++bj)
#pragma unroll
                    for (int n = 0; n < 2; ++n) { const f32x4 v = acc[ai][bj][m][n] * r;
#pragma unroll
                        for (int j = 0; j < 4; ++j) *at<bf16>(w, cbase + ((bj * HALF + n * 16 + j) * MP + row) * 2) = bf1(v[j]); }
            MK_ROWS_END
        } else {
            const int t = (pn - 11) >> 2; const unsigned dbase = (unsigned)WS_SRG + (unsigned)t * (unsigned)(WS_SGA - WS_SRG) + (((pn - 11) & 3) * 256 + wc * 32 + 4 * fq) * 2;
            MK_ROWS_BEGIN
#pragma unroll
                for (int bj = 0; bj < 2; ++bj)
#pragma unroll
                    for (int n = 0; n < 2; ++n) { const f32x4 v = acc[ai][bj][m][n] * r; f32x4 o;
#pragma unroll
                        for (int j = 0; j < 4; ++j) { const float sg = fast_sigmoid(v[j]); o[j] = t == 0 ? v[j] * sg : sg; }
                        *at<u32x2>(w, dbase + (row * 1024 + bj * HALF + n * 16) * 2) = pack4(o); }
            MK_ROWS_END
        }
    }
};
static_assert(WS_SGB - WS_SGA == WS_SGA - WS_SRG, "gate arrays equally spaced");
struct EpiQ {
    static constexpr bool PERM = false, AFTER_DRAIN = false;
    unsigned char* ws;
    __device__ __forceinline__ void operator()(const f32x4 (&acc)[2][2][4][2], const Unit& u, int wr, int wc, int fr, int fq) const {
        int l_ = lane_fresh(); asm volatile("" : "+v"(l_)); fr = l_ & 15; fq = l_ >> 4;
        const float* SSQCQ = (const float*)(ws + WS_SSQCQ); bf16* QA = (bf16*)(ws + WS_QA); const float* TAB = (const float*)(ws + WS_TAB);
        const int row0 = u.pm * BM + wr * 64 + fr;
#pragma unroll
        for (int ai = 0; ai < 2; ++ai)
#pragma unroll
            for (int m = 0; m < 4; ++m) {
                int row = row0 + ai * HALF + m * 16; asm volatile("" : "+v"(row));
                const float r = row_rscale8(SSQCQ, row, 1.f / QR) * SC_Q;
#pragma unroll
                for (int bj = 0; bj < 2; ++bj) {
                    const int grp = 8 * u.pn + 4 * bj + wc;
                    bf16* dst = QA + (size_t)row * 768 + 32 * grp + 4 * fq;
                    const bool rope = (grp % 3) == 2;
                    const int pi = row_pidx(row);
                    f32x4 c = *(const f32x4*)(TAB + TAB_C16 / 4 + pi * 16 + 4 * fq), s = *(const f32x4*)(TAB + TAB_S16 / 4 + pi * 16 + 4 * fq);
                    if (!rope) { c = (f32x4){1.f, 1.f, 1.f, 1.f}; s = (f32x4){0.f, 0.f, 0.f, 0.f}; }
                    const f32x4 x1 = acc[ai][bj][m][0] * r, x2 = acc[ai][bj][m][1] * r;
                    *(u32x2*)dst = pack4(x1 * c - x2 * s); *(u32x2*)(dst + 16) = pack4(x1 * s + x2 * c);
                }
                asm volatile("" ::: "memory");
            }
    }
};
template <bool ROWS> struct EpiScaleBf16 {
    static constexpr bool PERM = true, AFTER_DRAIN = false;
    const float* SSQKV; bf16* O; int ldc;
    __device__ __forceinline__ void operator()(const f32x4 (&acc)[2][2][4][2], const Unit& u, int wr, int wc, int fr, int fq) const {
        int l_ = lane_fresh(); asm volatile("" : "+v"(l_)); fr = l_ & 15; fq = l_ >> 4;
        const int row0 = u.pm * BM + wr * 64 + fr, col0 = u.pn * BM + wc * 32 + 8 * fq;
        float cs[2][8];
        if (!ROWS) {
#pragma unroll
            for (int bj = 0; bj < 2; ++bj)
#pragma unroll
                for (int k = 0; k < 8; ++k) cs[bj][k] = row_rscale4(SSQKV, col0 + bj * HALF + k, 1.f / KVR);
        }
#pragma unroll
        for (int ai = 0; ai < 2; ++ai)
#pragma unroll
            for (int m = 0; m < 4; ++m) { int row = row0 + ai * HALF + m * 16; asm volatile("" : "+v"(row)); const float r = ROWS ? row_rscale4(SSQKV, row, 1.f / KVR) : 1.f;
#pragma unroll
                for (int bj = 0; bj < 2; ++bj) { f32x4 v0 = acc[ai][bj][m][0], v1 = acc[ai][bj][m][1];
                    if (ROWS) { v0 = v0 * r; v1 = v1 * r; }
                    else {
#pragma unroll
                        for (int j = 0; j < 4; ++j) { v0[j] *= cs[bj][j]; v1[j] *= cs[bj][4 + j]; } }
                    u32x4 w; w.x = pg8::cvt_pk_bf16(v0[0], v0[1]); w.y = pg8::cvt_pk_bf16(v0[2], v0[3]); w.z = pg8::cvt_pk_bf16(v1[0], v1[1]); w.w = pg8::cvt_pk_bf16(v1[2], v1[3]);
                    *(u32x4*)(O + (size_t)row * ldc + col0 + bj * HALF) = w; } }
    }
};
__device__ __forceinline__ void finalize_ckv(Frame& F, const Args& a) {
    const int lane = fresh_tid(F.wave) & 63;
    const int gw = F.vcu * NWAVES + F.wave, NGW = F.G * NWAVES;
    const float* CKVF = (const float*)(a.ws + WS_CKVF); const float* SSQKV = (const float*)(a.ws + WS_SSQKV); const float* KRF = (const float*)(a.ws + WS_KRF);
    const f32x4 g = *((const f32x4*)a.in[14] + lane);
    for (int row = gw; row < ROW_PAD; row += NGW) {
        const float r = row_rscale4(SSQKV, row, 1.f / KVR);
        const f32x4 o = *((const f32x4*)(CKVF + (size_t)row * KVR) + lane) * r * g;
        const f32x4 kr = *((const f32x4*)(KRF + (size_t)row * 32) + (lane & 7));
        if (row < MMAIN) { const size_t t = (size_t)(row >> 11) * T + NMETA + (row & (SEQ - 1)); *((f32x4*)(a.out + OUT_CKVP + t * KVR) + lane) = o; if (lane < 8) *((f32x4*)(a.out + OUT_KRP + t * 32) + lane) = kr; }
        else if (row < ROW_SMP) { for (int b = 0; b < NB; ++b) { const size_t t = (size_t)b * T + (row - ROW_META); *((f32x4*)(a.out + OUT_CKVP + t * KVR) + lane) = o; if (lane < 8) *((f32x4*)(a.out + OUT_KRP + t * 32) + lane) = kr; } }
        else { *((f32x4*)(a.out + OUT_CKVS + (size_t)(row - ROW_SMP) * KVR) + lane) = o; if (lane < 8) *((f32x4*)(a.out + OUT_KRS + (size_t)(row - ROW_SMP) * 32) + lane) = kr; }
    }
}
}
namespace mk {
constexpr size_t WS_AV = WS_END2;
constexpr size_t WS_END3 = WS_AV + al((size_t)MP * 512 * 2);
typedef float f32x16 __attribute__((ext_vector_type(16)));
constexpr int AT_KSTR = 208, AT_VSTR = 144, AT_KBUF = 64 * AT_KSTR, AT_VBUF = 64 * AT_VSTR, AT_VOFF = 2 * AT_KBUF;
__device__ __forceinline__ int crow(int i, int half) { return (i & 3) + 8 * (i >> 2) + 4 * half; }

__device__ __forceinline__ void attn_unit(Frame& F, unsigned char* ws, int b, int h, int qb) {
    const int tid = fresh_tid(F.wave), lane = tid & 63, w = F.wave, q = lane & 31, half = lane >> 5;
    LAS unsigned char* L = F.lds + RING_OFF;
    const bf16* QA = (const bf16*)(ws + WS_QA); const bf16* KN = (const bf16*)(ws + WS_KN); const bf16* KRB = (const bf16*)(ws + WS_KRB); const bf16* VT = (const bf16*)(ws + WS_VT);
    const int qrow = b * SEQ + qb * 256 + w * 32 + q, q_main = qb * 256 + w * 32 + q, wq0 = qb * 256 + w * 32;
    bf16x8 qf[6];
#pragma unroll
    for (int s = 0; s < 6; ++s) qf[s] = *(const bf16x8*)(QA + (size_t)qrow * 768 + h * 96 + 16 * s + 8 * half);
    f32x16 ot[2];
#pragma unroll
    for (int i = 0; i < 16; ++i) { ot[0][i] = 0.f; ot[1][i] = 0.f; }
    float m = -INFINITY, l = 0.f;
    const int NT = 4 * (qb + 1);
    v4u kreg, rreg, vreg; rreg = (v4u){0u, 0u, 0u, 0u};
#define AT_LOAD(tt) do { const int t0_ = (tt) == 0 ? ROW_META : b * SEQ + 64 * ((tt) - 1); \
        kreg = *(const v4u*)(KN + (size_t)(t0_ + (tid >> 3)) * 512 + h * 64 + (tid & 7) * 8); \
        if (tid < 256) rreg = *(const v4u*)(KRB + (size_t)(t0_ + (tid >> 2)) * 32 + (tid & 3) * 8); \
        vreg = *(const v4u*)(VT + (size_t)(h * 64 + (tid >> 3)) * MP + t0_ + (tid & 7) * 8); } while (0)
#define AT_STORE(buf) do { LAS unsigned char* kb_ = L + (buf) * AT_KBUF; \
        *(LAS v4u*)(kb_ + (tid >> 3) * AT_KSTR + (tid & 7) * 16) = kreg; \
        if (tid < 256) *(LAS v4u*)(kb_ + (tid >> 2) * AT_KSTR + 128 + (tid & 3) * 16) = rreg; \
        LAS unsigned char* vb_ = L + AT_VOFF + (buf) * AT_VBUF + (tid >> 3) * AT_VSTR + (32 * ((tid & 7) >> 1) + 8 * (tid & 1)); \
        *(LAS u32x2*)(vb_) = (u32x2){vreg.x, vreg.y}; *(LAS u32x2*)(vb_ + 16) = (u32x2){vreg.z, vreg.w}; } while (0)
    AT_LOAD(0); AT_STORE(0);
    __syncthreads();
    for (int tt = 0; tt <= NT; ++tt) {
        const int buf = tt & 1;
        if (tt < NT) AT_LOAD(tt + 1);
        const int kmin = tt == 0 ? 0 : 64 * (tt - 1);
        if (tt == 0 || kmin <= wq0 + 31) {
            const LAS unsigned char* Kb = L + buf * AT_KBUF + q * AT_KSTR + 16 * half;
            const LAS unsigned char* Vb = L + AT_VOFF + buf * AT_VBUF + q * AT_VSTR + 16 * half;
            f32x16 st[2];
#pragma unroll
            for (int kb = 0; kb < 2; ++kb) {
#pragma unroll
                for (int i = 0; i < 16; ++i) st[kb][i] = 0.f;
#pragma unroll
                for (int s = 0; s < 6; ++s) { const bf16x8 kf = *(const LAS bf16x8*)(Kb + kb * 32 * AT_KSTR + 32 * s); st[kb] = __builtin_amdgcn_mfma_f32_32x32x16_bf16(kf, qf[s], st[kb], 0, 0, 0); }
            }
            if (tt == 0) {
#pragma unroll
                for (int kb = 0; kb < 2; ++kb)
#pragma unroll
                    for (int i = 0; i < 16; ++i) if (32 * kb + crow(i, half) >= NMETA) st[kb][i] = -INFINITY;
            } else if (kmin + 63 > wq0) {
#pragma unroll
                for (int kb = 0; kb < 2; ++kb)
#pragma unroll
                    for (int i = 0; i < 16; ++i) if (kmin + 32 * kb + crow(i, half) > q_main) st[kb][i] = -INFINITY;
            }
            float mx = st[0][0];
#pragma unroll
            for (int i = 1; i < 16; ++i) mx = fmaxf(mx, st[0][i]);
#pragma unroll
            for (int i = 0; i < 16; ++i) mx = fmaxf(mx, st[1][i]);
            mx = fmaxf(mx, lx(mx, lane, 32));
            const float mn = fmaxf(m, mx), alpha = __builtin_amdgcn_exp2f(m - mn);
            m = mn;
            float ps = 0.f;
#pragma unroll
            for (int kb = 0; kb < 2; ++kb)
#pragma unroll
                for (int i = 0; i < 16; ++i) { st[kb][i] = __builtin_amdgcn_exp2f(st[kb][i] - mn); ps += st[kb][i]; }
            l = l * alpha + ps;
#pragma unroll
            for (int i = 0; i < 16; ++i) { ot[0][i] *= alpha; ot[1][i] *= alpha; }
#pragma unroll
            for (int kb = 0; kb < 2; ++kb)
#pragma unroll
                for (int s2 = 0; s2 < 2; ++s2) {
                    u32x4 pw; pw.x = pg8::cvt_pk_bf16(st[kb][8 * s2 + 0], st[kb][8 * s2 + 1]); pw.y = pg8::cvt_pk_bf16(st[kb][8 * s2 + 2], st[kb][8 * s2 + 3]);
                    pw.z = pg8::cvt_pk_bf16(st[kb][8 * s2 + 4], st[kb][8 * s2 + 5]); pw.w = pg8::cvt_pk_bf16(st[kb][8 * s2 + 6], st[kb][8 * s2 + 7]);
                    const bf16x8 pf = __builtin_bit_cast(bf16x8, pw);
#pragma unroll
                    for (int vb = 0; vb < 2; ++vb) { const bf16x8 vf = *(const LAS bf16x8*)(Vb + vb * 32 * AT_VSTR + (32 * kb + 16 * s2) * 2); ot[vb] = __builtin_amdgcn_mfma_f32_32x32x16_bf16(vf, pf, ot[vb], 0, 0, 0); }
                }
        }
        if (tt < NT) AT_STORE(buf ^ 1);
        __syncthreads();
    }
#undef AT_LOAD
#undef AT_STORE
    l += lx(l, lane, 32);
    const float inv = 1.0f / l;
    bf16* AV = (bf16*)(ws + WS_AV) + (size_t)qrow * 512 + h * 64 + 4 * half;
#pragma unroll
    for (int vb = 0; vb < 2; ++vb)
#pragma unroll
        for (int g = 0; g < 4; ++g) { f32x4 o; o[0] = ot[vb][4 * g] * inv; o[1] = ot[vb][4 * g + 1] * inv; o[2] = ot[vb][4 * g + 2] * inv; o[3] = ot[vb][4 * g + 3] * inv; *(u32x2*)(AV + 32 * vb + 8 * g) = pack4(o); }
}
__device__ __forceinline__ void attn_phase(Frame& F, unsigned char* ws) {
    const int c = F.vcu;
    if (c >= 256) return;
    const int bh = c >> 2, p = c & 3;
    attn_unit(F, ws, bh >> 3, bh & 7, 7 - p);
    attn_unit(F, ws, bh >> 3, bh & 7, p);
}
}
namespace mk {
constexpr size_t WS_UMETA = WS_END3;
constexpr size_t WS_UT = WS_UMETA + al((size_t)RH * RDV * RDK * 4);
constexpr size_t WS_SPREV = WS_UT + al((size_t)32 * 16 * RDV * RDK * 4);
constexpr size_t WS_RIN = WS_SPREV + al((size_t)32 * 16 * RDV * RDK * 2);
constexpr size_t WS_DPART = WS_RIN + al((size_t)MP * 1024 * 2);
constexpr size_t WS_END4 = WS_DPART + al((size_t)32 * 8 * 8 * 264 * 4);
static_assert(WS_END4 < ((size_t)1 << 31), "32-bit workspace offsets");
__device__ __forceinline__ float gamma_of(int h) { return 1.0f - exp2f(-5.0f - (float)h); }
__device__ __forceinline__ float gpow(int h, int n) { return (float)exp((double)n * log1p(-exp2(-5.0 - (double)h))); }

__device__ __forceinline__ void ret_u_unit(Frame& F, unsigned char* ws, int u) {
    const int tid = fresh_tid(F.wave), lane = tid & 63, w = F.wave, r32 = lane & 31, half = lane >> 5;
    const bool meta = u >= 512; const int hh = meta ? u - 512 : (u >> 4) & 3;
    const int tok0 = meta ? ROW_META : (u >> 6) * SEQ + (u & 15) * 128, nks = meta ? 1 : 8;
    const bf16* RVT = (const bf16*)(ws + WS_RVT); const bf16* RKT = (const bf16*)(ws + WS_RKT);
    f32x16 acc[4];
#pragma unroll
    for (int db = 0; db < 4; ++db)
#pragma unroll
        for (int i = 0; i < 16; ++i) acc[db][i] = 0.f;
    const bf16* ap = RVT + (size_t)(hh * 256 + 32 * w + r32) * MP + tok0 + 8 * half;
    const bf16* bp = RKT + (size_t)(hh * 128 + r32) * MP + tok0 + 8 * half;
    for (int s = 0; s < nks; ++s) {
        const bf16x8 af = *(const bf16x8*)(ap + 16 * s);
#pragma unroll
        for (int db = 0; db < 4; ++db) { const bf16x8 bf = *(const bf16x8*)(bp + (size_t)(32 * db) * MP + 16 * s); acc[db] = __builtin_amdgcn_mfma_f32_32x32x16_bf16(af, bf, acc[db], 0, 0, 0); }
    }
    const float sc = gpow(hh, meta ? NMETA - 1 : 127);
    float* dst = meta ? (float*)(ws + WS_UMETA) + (size_t)hh * RDV * RDK : (float*)(ws + WS_UT) + (size_t)u * RDV * RDK;
#pragma unroll
    for (int db = 0; db < 4; ++db)
#pragma unroll
        for (int i = 0; i < 16; ++i) dst[(size_t)(32 * w + crow(i, half)) * RDK + 32 * db + r32] = acc[db][i] * sc;
}
__device__ __forceinline__ void ret_scan(Frame& F, const Args& a) {
    const int tid = fresh_tid(F.wave);
    const int gt = (F.vcu * NWAVES * 64) + tid, NGT = F.G * NWAVES * 64;
    const float* UM = (const float*)(a.ws + WS_UMETA); const float* UT = (const float*)(a.ws + WS_UT); bf16* SP = (bf16*)(a.ws + WS_SPREV);
    for (int e = gt; e < 32 * RDV * RDK; e += NGT) {
        const int bh = e >> 15, idx = e & 32767, hh = bh & 3;
        const float g128 = gpow(hh, 128);
        float S = UM[(size_t)hh * 32768 + idx];
        for (int c = 0; c < 16; ++c) { const size_t o = ((size_t)bh * 16 + c) * 32768 + idx; SP[o] = bf1(S); S = g128 * S + UT[o]; }
        const int ee = idx >> 7, d = idx & 127;
        a.out[OUT_SRP + ((size_t)bh * RDK + d) * RDV + ee] = S;
    }
}
__device__ __forceinline__ void ret_o_unit(Frame& F, const Args& a, int u) {
    unsigned char* ws = a.ws;
    const int tid = fresh_tid(F.wave), lane = tid & 63, w = F.wave, r32 = lane & 31, half = lane >> 5;
    const int bh = u >> 4, c = u & 15, hh = bh & 3, tok0 = (bh >> 2) * SEQ + c * 128;
    const int ib = w & 3, eh = w >> 2;
    LAS float* red = (LAS float*)(F.lds + RING_OFF);
    const bf16* RQ = (const bf16*)(ws + WS_RQ); const bf16* RK = (const bf16*)(ws + WS_RK); const bf16* RVT = (const bf16*)(ws + WS_RVT);
    const bf16* SP = (const bf16*)(ws + WS_SPREV) + (size_t)u * 32768;
    const int irow = tok0 + 32 * ib + r32;
    bf16x8 qf[8];
#pragma unroll
    for (int s = 0; s < 8; ++s) qf[s] = *(const bf16x8*)(RQ + (size_t)irow * 512 + hh * 128 + 16 * s + 8 * half);
    f32x16 ot[4];
#pragma unroll
    for (int eb = 0; eb < 4; ++eb) {
#pragma unroll
        for (int i = 0; i < 16; ++i) ot[eb][i] = 0.f;
        const bf16* sp = SP + (size_t)(128 * eh + 32 * eb + r32) * RDK + 8 * half;
#pragma unroll
        for (int s = 0; s < 8; ++s) { const bf16x8 sf = *(const bf16x8*)(sp + 16 * s); ot[eb] = __builtin_amdgcn_mfma_f32_32x32x16_bf16(sf, qf[s], ot[eb], 0, 0, 0); }
    }
    const float g = gamma_of(hh);
#pragma unroll
    for (int eb = 0; eb < 4; ++eb)
#pragma unroll
        for (int i = 0; i < 16; ++i) ot[eb][i] *= g;
    for (int jb = 0; jb <= ib; ++jb) {
        f32x16 at;
#pragma unroll
        for (int i = 0; i < 16; ++i) at[i] = 0.f;
        const bf16* kp = RK + (size_t)(tok0 + 32 * jb + r32) * 512 + hh * 128 + 8 * half;
#pragma unroll
        for (int s = 0; s < 8; ++s) { const bf16x8 kf = *(const bf16x8*)(kp + 16 * s); at = __builtin_amdgcn_mfma_f32_32x32x16_bf16(kf, qf[s], at, 0, 0, 0); }
        if (jb == ib) {
#pragma unroll
            for (int i = 0; i < 16; ++i) if (crow(i, half) > r32) at[i] = 0.f;
        }
#pragma unroll
        for (int s2 = 0; s2 < 2; ++s2) {
            u32x4 pw; pw.x = pg8::cvt_pk_bf16(at[8 * s2 + 0], at[8 * s2 + 1]); pw.y = pg8::cvt_pk_bf16(at[8 * s2 + 2], at[8 * s2 + 3]);
            pw.z = pg8::cvt_pk_bf16(at[8 * s2 + 4], at[8 * s2 + 5]); pw.w = pg8::cvt_pk_bf16(at[8 * s2 + 6], at[8 * s2 + 7]);
            const bf16x8 pf = __builtin_bit_cast(bf16x8, pw);
#pragma unroll
            for (int eb = 0; eb < 4; ++eb) {
                const bf16* vp = RVT + (size_t)(hh * 256 + 128 * eh + 32 * eb + r32) * MP + tok0 + 32 * jb + 16 * s2 + 4 * half;
                const u32x2 lo = *(const u32x2*)vp, hi = *(const u32x2*)(vp + 8);
                u32x4 vw; vw.x = lo.x; vw.y = lo.y; vw.z = hi.x; vw.w = hi.y;
                ot[eb] = __builtin_amdgcn_mfma_f32_32x32x16_bf16(__builtin_bit_cast(bf16x8, vw), pf, ot[eb], 0, 0, 0);
            }
        }
    }
    float s1 = 0.f;
#pragma unroll
    for (int eb = 0; eb < 4; ++eb)
#pragma unroll
        for (int i = 0; i < 16; ++i) s1 += ot[eb][i];
    s1 += lx(s1, lane, 32);
    if (half == 0) red[w * 32 + r32] = s1;
    __syncthreads();
    const float mu = (red[w * 32 + r32] + red[(w ^ 4) * 32 + r32]) * (1.f / 256.f);
    float s2 = 0.f;
#pragma unroll
    for (int eb = 0; eb < 4; ++eb)
#pragma unroll
        for (int i = 0; i < 16; ++i) { ot[eb][i] -= mu; s2 += ot[eb][i] * ot[eb][i]; }
    s2 += lx(s2, lane, 32);
    if (half == 0) red[256 + w * 32 + r32] = s2;
    __syncthreads();
    const float rstd = 1.0f / sqrtf((red[256 + w * 32 + r32] + red[256 + (w ^ 4) * 32 + r32]) * (1.f / 256.f) + EPS);
    __syncthreads();
    const bf16* SRG = (const bf16*)(ws + WS_SRG) + (size_t)irow * 1024 + hh * 256 + 128 * eh + 4 * half;
    bf16* RIN = (bf16*)(ws + WS_RIN) + (size_t)irow * 1024 + hh * 256 + 128 * eh + 4 * half;
    const float* gn = a.in[19] + hh * 256 + 128 * eh + 4 * half;
#pragma unroll
    for (int eb = 0; eb < 4; ++eb)
#pragma unroll
        for (int gq = 0; gq < 4; ++gq) {
            const int eo = 32 * eb + 8 * gq;
            const u32x2 sg = *(const u32x2*)(SRG + eo); const f32x4 gv = *(const f32x4*)(gn + eo);
            f32x4 o;
            o[0] = ot[eb][4 * gq + 0] * rstd * gv[0] * __uint_as_float(sg.x << 16); o[1] = ot[eb][4 * gq + 1] * rstd * gv[1] * __uint_as_float(sg.x & 0xffff0000u);
            o[2] = ot[eb][4 * gq + 2] * rstd * gv[2] * __uint_as_float(sg.y << 16); o[3] = ot[eb][4 * gq + 3] * rstd * gv[3] * __uint_as_float(sg.y & 0xffff0000u);
            *(u32x2*)(RIN + eo) = pack4(o);
        }
}
__device__ __forceinline__ void ret_sample_unit(Frame& F, const Args& a, int u) {
    unsigned char* ws = a.ws;
    const int tid = fresh_tid(F.wave), lane = tid & 63, s = u >> 2, hh = u & 3, e = tid & 255, dh = tid >> 8, row = ROW_SMP + s;
    LAS float* sh = (LAS float*)(F.lds + RING_OFF);
    const bf16* RQ = (const bf16*)(ws + WS_RQ); const bf16* RK = (const bf16*)(ws + WS_RK); const bf16* RVT = (const bf16*)(ws + WS_RVT);
    if (tid < 128) sh[tid] = __uint_as_float((unsigned)RQ[(size_t)row * 512 + hh * 128 + tid] << 16);
    else if (tid < 256) sh[tid] = __uint_as_float((unsigned)RK[(size_t)row * 512 + hh * 128 + tid - 128] << 16);
    __syncthreads();
    const float v = __uint_as_float((unsigned)RVT[(size_t)(hh * 256 + e) * MP + row] << 16);
    const float g = gamma_of(hh);
    const float* S0 = a.in[4] + ((size_t)(s * RH + hh) * RDK) * RDV + e;
    float* S1 = a.out + OUT_SRS + ((size_t)(s * RH + hh) * RDK) * RDV + e;
    float o = 0.f;
#pragma unroll 8
    for (int d = 64 * dh; d < 64 * dh + 64; ++d) { const float sn = g * S0[(size_t)d * RDV] + sh[128 + d] * v; S1[(size_t)d * RDV] = sn; o += sh[d] * sn; }
    sh[256 + dh * 256 + e] = o;
    __syncthreads();
    o = sh[256 + e] + sh[512 + e];
    float t1 = o;
#pragma unroll
    for (int off = 32; off > 0; off >>= 1) t1 += lx(t1, lane, off);
    if ((tid & 63) == 0) sh[768 + (tid >> 6)] = t1;
    __syncthreads();
    const float mu = (sh[768] + sh[769] + sh[770] + sh[771]) * (1.f / 256.f);
    const float dlt = o - mu;
    float t2 = dlt * dlt;
#pragma unroll
    for (int off = 32; off > 0; off >>= 1) t2 += lx(t2, lane, off);
    if ((tid & 63) == 0) sh[776 + (tid >> 6)] = t2;
    __syncthreads();
    const float rstd = 1.0f / sqrtf((sh[776] + sh[777] + sh[778] + sh[779]) * (1.f / 256.f) + EPS);
    if (dh == 0) { const float sg = __uint_as_float((unsigned)((const bf16*)(ws + WS_SRG))[(size_t)row * 1024 + hh * 256 + e] << 16);
        ((bf16*)(ws + WS_RIN))[(size_t)row * 1024 + hh * 256 + e] = bf1(dlt * rstd * a.in[19][hh * 256 + e] * sg); }
    __syncthreads();
}
}
namespace mk {
__device__ __forceinline__ int dlane_of(int h) { return ((h >> 2) & 1) * 32 + ((h >> 1) & 1) * 16 + (h & 1) * 8; }
__device__ __forceinline__ void decode_unit(Frame& F, const Args& a, int u) {
    unsigned char* ws = a.ws;
    const int tid = fresh_tid(F.wave), lane = tid & 63, w = F.wave, s = u >> 3, sp = u & 7, row = ROW_SMP + s;
    LAS float* sh = (LAS float*)(F.lds + RING_OFF);
    const bf16* QA = (const bf16*)(ws + WS_QA) + (size_t)row * 768;
    { const int r = tid & 255, hg = tid >> 8; const float* wuk = a.in[16] + (size_t)r * 512;
#pragma unroll 1
      for (int hh = 4 * hg; hh < 4 * hg + 4; ++hh) { float acc = 0.f;
          for (int n = 0; n < 64; ++n) acc += __uint_as_float((unsigned)QA[hh * 96 + n] << 16) * wuk[hh * 64 + n];
          sh[hh * 256 + r] = acc; }
      if (tid < 256) { const int hh = tid >> 5, i = tid & 31; sh[2048 + tid] = __uint_as_float((unsigned)QA[hh * 96 + 64 + i] << 16); } }
    __syncthreads();
    f32x4 ql[8], qr[8];
#pragma unroll
    for (int h = 0; h < 8; ++h) { ql[h] = *(const LAS f32x4*)(sh + h * 256 + 4 * lane); qr[h] = lane < 8 ? *(const LAS f32x4*)(sh + 2048 + h * 32 + 4 * lane) : (f32x4){0.f, 0.f, 0.f, 0.f}; }
    __syncthreads();
    f32x4 O[8];
#pragma unroll
    for (int h = 0; h < 8; ++h) O[h] = (f32x4){0.f, 0.f, 0.f, 0.f};
    float m = -INFINITY, l = 0.f;
    const int* pt = (const int*)a.in[5] + s * NPAGES + sp * 16 + 2 * w;
#pragma unroll 1
    for (int pg = 0; pg < 2; ++pg) {
        const int page = pt[pg];
        const float* ck = a.in[2] + (size_t)page * PAGE * KVR + 4 * lane;
        const float* kr = a.in[3] + (size_t)page * PAGE * 32 + 4 * (lane & 7);
#pragma unroll 1
        for (int k0 = 0; k0 < PAGE; k0 += 4) {
            f32x4 kv[4], rv[4]; float sc[4];
#pragma unroll
            for (int kk = 0; kk < 4; ++kk) { kv[kk] = *(const f32x4*)(ck + (size_t)(k0 + kk) * KVR); rv[kk] = *(const f32x4*)(kr + (size_t)(k0 + kk) * 32); }
#pragma unroll
            for (int kk = 0; kk < 4; ++kk) {
                float p[8];
#pragma unroll
                for (int h = 0; h < 8; ++h) { const f32x4 t = ql[h] * kv[kk] + qr[h] * rv[kk]; p[h] = (t[0] + t[1]) + (t[2] + t[3]); }
                float k4[4], k2[2];
#pragma unroll
                for (int k = 0; k < 4; ++k) { const float snd = lane < 32 ? p[4 + k] : p[k]; const float rcv = lx(snd, lane, 32); k4[k] = (lane < 32 ? p[k] : p[4 + k]) + rcv; }
#pragma unroll
                for (int k = 0; k < 2; ++k) { const float snd = (lane & 16) ? k4[k] : k4[2 + k]; const float rcv = lx(snd, lane, 16); k2[k] = ((lane & 16) ? k4[2 + k] : k4[k]) + rcv; }
                float v1; { const float snd = (lane & 8) ? k2[0] : k2[1]; const float rcv = lx(snd, lane, 8); v1 = ((lane & 8) ? k2[1] : k2[0]) + rcv; }
                v1 += lx(v1, lane, 4); v1 += lx(v1, lane, 2); v1 += lx(v1, lane, 1);
                sc[kk] = v1;
            }
            const float mx = fmaxf(fmaxf(sc[0], sc[1]), fmaxf(sc[2], sc[3]));
            const float mn = fmaxf(m, mx), alpha = __builtin_amdgcn_exp2f(m - mn);
            m = mn;
            float pe[4];
#pragma unroll
            for (int kk = 0; kk < 4; ++kk) pe[kk] = __builtin_amdgcn_exp2f(sc[kk] - mn);
            l = l * alpha + ((pe[0] + pe[1]) + (pe[2] + pe[3]));
#pragma unroll
            for (int h = 0; h < 8; ++h) {
                const int src = dlane_of(h);
                const float ah = __int_as_float(__builtin_amdgcn_readlane(__float_as_int(alpha), src)), p0 = __int_as_float(__builtin_amdgcn_readlane(__float_as_int(pe[0]), src)), p1 = __int_as_float(__builtin_amdgcn_readlane(__float_as_int(pe[1]), src)),
                            p2 = __int_as_float(__builtin_amdgcn_readlane(__float_as_int(pe[2]), src)), p3 = __int_as_float(__builtin_amdgcn_readlane(__float_as_int(pe[3]), src));
                O[h] = O[h] * ah + kv[0] * p0 + kv[1] * p1 + kv[2] * p2 + kv[3] * p3;
            }
        }
    }
    LAS float* wm = sh + 2304 + w * 16;
    LAS float* wo = sh + 2304 + 128 + w * 2048;
    { const int hd = 4 * (lane >> 5) + 2 * ((lane >> 4) & 1) + ((lane >> 3) & 1); if ((lane & 7) == 0) { wm[hd] = m; wm[8 + hd] = l; } }
#pragma unroll
    for (int h = 0; h < 8; ++h) *(LAS f32x4*)(wo + h * 256 + 4 * lane) = O[h];
    __syncthreads();
    float* part = (float*)(ws + WS_DPART) + (size_t)u * 8 * 264;
    for (int e = tid; e < 2048; e += 512) {
        const int h = e >> 8;
        float M = -INFINITY;
#pragma unroll
        for (int ww = 0; ww < 8; ++ww) M = fmaxf(M, sh[2304 + ww * 16 + h]);
        float acc = 0.f, L = 0.f;
#pragma unroll
        for (int ww = 0; ww < 8; ++ww) { const float f = __builtin_amdgcn_exp2f(sh[2304 + ww * 16 + h] - M); acc += f * sh[2304 + 128 + ww * 2048 + e]; L += f * sh[2304 + ww * 16 + 8 + h]; }
        part[h * 264 + (e & 255)] = acc;
        if ((e & 255) == 0) { part[h * 264 + 256] = M; part[h * 264 + 257] = L; }
    }
    __syncthreads();
}
__device__ __forceinline__ void decode_combine_unit(Frame& F, const Args& a, int s) {
    unsigned char* ws = a.ws;
    const int tid = fresh_tid(F.wave), row = ROW_SMP + s;
    LAS float* sh = (LAS float*)(F.lds + RING_OFF);
    const bf16* QA = (const bf16*)(ws + WS_QA) + (size_t)row * 768;
    const float* part = (const float*)(ws + WS_DPART) + (size_t)s * 8 * 8 * 264;
    if (tid < 256) { const float r = row_rscale4((const float*)(ws + WS_SSQKV), row, 1.f / KVR); sh[2056 + tid] = ((const float*)(ws + WS_CKVF))[(size_t)row * KVR + tid] * r * a.in[14][tid]; }
    __syncthreads();
    { const int h = tid >> 6, lane = tid & 63; float acc = 0.f;
      for (int r = lane; r < 256; r += 64) { const float* wuk = a.in[16] + (size_t)r * 512 + h * 64; float ql = 0.f;
          for (int n = 0; n < 64; ++n) ql += __uint_as_float((unsigned)QA[h * 96 + n] << 16) * wuk[n];
          acc += ql * sh[2056 + r]; }
      if (lane < 32) acc += __uint_as_float((unsigned)QA[h * 96 + 64 + lane] << 16) * ((const float*)(ws + WS_KRF))[(size_t)row * 32 + lane];
#pragma unroll
      for (int off = 32; off > 0; off >>= 1) acc += lx(acc, lane, off);
      if (lane == 0) sh[2048 + h] = acc; }
    __syncthreads();
    for (int e = tid; e < 2048; e += 512) {
        const int h = e >> 8, r = e & 255;
        const float sn = sh[2048 + h];
        float M = sn;
#pragma unroll
        for (int p = 0; p < 8; ++p) M = fmaxf(M, part[(p * 8 + h) * 264 + 256]);
        const float fn = __builtin_amdgcn_exp2f(sn - M);
        float acc = fn * sh[2056 + r], L = fn;
#pragma unroll
        for (int p = 0; p < 8; ++p) { const float f = __builtin_amdgcn_exp2f(part[(p * 8 + h) * 264 + 256] - M); acc += f * part[(p * 8 + h) * 264 + r]; L += f * part[(p * 8 + h) * 264 + 257]; }
        sh[e] = acc / L;
    }
    __syncthreads();
    { const int h = tid >> 6, v = tid & 63; float acc = 0.f;
      for (int r = 0; r < 256; ++r) acc += sh[h * 256 + r] * a.in[17][(size_t)r * 512 + h * 64 + v];
      ((bf16*)(ws + WS_AV))[(size_t)row * 512 + h * 64 + v] = bf1(acc); }
    __syncthreads();
}
}
namespace mk {
constexpr size_t WS_TMP = WS_ACT;
constexpr size_t WS_MX = WS_RQ;
constexpr size_t WS_H2B = WS_MX + al((size_t)MP * 1024 * 2);
constexpr size_t WS_H2 = WS_UT;
constexpr size_t WS_SSQH2 = WS_END4;
constexpr size_t WS_SSQH3 = WS_SSQH2 + al((size_t)MP * 16 * 4);
constexpr size_t WS_H3 = WS_H;
constexpr size_t WS_END6 = WS_SSQH3 + al((size_t)MP * 16 * 4);
static_assert(WS_H2B + (size_t)MP * 1024 * 2 <= WS_SRG && WS_H2 + (size_t)MP * 1024 * 4 <= WS_RIN && (size_t)MP * 1024 * 4 <= (size_t)MP * FFN * 2, "overlays");
static_assert(WS_END6 < ((size_t)1 << 31), "32-bit workspace offsets");

template <int STEP, unsigned GATE_OFF> struct EpiGate {
    static constexpr bool PERM = false, AFTER_DRAIN = false;
    unsigned char* ws_;
    __device__ __forceinline__ void operator()(const f32x4 (&acc)[2][2][4][2], const Unit& u, int wr, int wc, int fr, int fq) const {
        int l_ = lane_fresh(); asm volatile("" : "+v"(l_)); fr = l_ & 15; fq = l_ >> 4;
        unsigned char* w = ws_; asm volatile("" : "+s"(w));
        const unsigned row0 = u.pm * BM + wr * 64 + fr, col0 = u.pn * BM + wc * 32 + 4 * fq;
#pragma unroll
        for (int ai = 0; ai < 2; ++ai)
#pragma unroll
            for (int m = 0; m < 4; ++m) { unsigned row = row0 + ai * HALF + m * 16; asm volatile("" : "+v"(row));
#pragma unroll
                for (int bj = 0; bj < 2; ++bj)
#pragma unroll
                    for (int n = 0; n < 2; ++n) { const unsigned e = row * 1024 + col0 + bj * HALF + n * 16;
                        const u32x2 gw = *at<const u32x2>(w, GATE_OFF + e * 2);
                        f32x4 g; g[0] = __uint_as_float(gw.x << 16); g[1] = __uint_as_float(gw.x & 0xffff0000u); g[2] = __uint_as_float(gw.y << 16); g[3] = __uint_as_float(gw.y & 0xffff0000u);
                        f32x4 o = acc[ai][bj][m][n] * g;
                        if (STEP == 0) *at<f32x4>(w, (unsigned)WS_TMP + e * 4) = o;
                        else { o = o + *at<const f32x4>(w, (unsigned)WS_TMP + e * 4); *at<u32x2>(w, (unsigned)WS_MX + e * 2) = pack4(o); } }
                asm volatile("" ::: "memory"); }
    }
};
struct EpiSwiGLU2 {
    static constexpr bool PERM = true, AFTER_DRAIN = false;
    unsigned char* ws_;
    __device__ __forceinline__ void operator()(const f32x4 (&acc)[2][2][4][2], const Unit& u, int wr, int wc, int fr, int fq) const {
        int l_ = lane_fresh(); asm volatile("" : "+v"(l_)); fr = l_ & 15; fq = l_ >> 4;
        unsigned char* w = ws_; asm volatile("" : "+s"(w));
        const unsigned row0 = u.pm * BM + wr * 64 + fr, col0 = u.pn * HALF + wc * 32 + 8 * fq;
#pragma unroll
        for (int ai = 0; ai < 2; ++ai)
#pragma unroll
            for (int m = 0; m < 4; ++m) { unsigned row = row0 + ai * HALF + m * 16; asm volatile("" : "+v"(row));
                const float r = row_rscale16(at<const float>(w, (unsigned)WS_SSQH2), (int)row, 1.f / D);
                f32x4 o[2];
#pragma unroll
                for (int n = 0; n < 2; ++n)
#pragma unroll
                    for (int j = 0; j < 4; ++j) { const float g = acc[ai][0][m][n][j] * r, up = acc[ai][1][m][n][j] * r; o[n][j] = fast_silu(g) * up; }
                u32x4 pk; pk.x = pg8::cvt_pk_bf16(o[0][0], o[0][1]); pk.y = pg8::cvt_pk_bf16(o[0][2], o[0][3]); pk.z = pg8::cvt_pk_bf16(o[1][0], o[1][1]); pk.w = pg8::cvt_pk_bf16(o[1][2], o[1][3]);
                *at<u32x4>(w, (unsigned)WS_ACT + (row * FFN + col0) * 2) = pk;
                asm volatile("" ::: "memory"); }
    }
};
__device__ __forceinline__ void final_norm_phase(Frame& F, const Args& a) {
    const int lane = fresh_tid(F.wave) & 63;
    const int gw = F.vcu * NWAVES + F.wave, NGW = F.G * NWAVES;
    const float* H3 = (const float*)(a.ws + WS_H3); const float* SSQ = (const float*)(a.ws + WS_SSQH3);
    f32x4 g[4];
#pragma unroll
    for (int j = 0; j < 4; ++j) g[j] = *((const f32x4*)a.in[26] + lane + 64 * j);
    for (int row = gw; row < ROW_PAD; row += NGW) {
        if (row >= MMAIN && row < ROW_SMP) continue;
        const float r = row_rscale16(SSQ, row, 1.f / D);
        float* dst = row < MMAIN ? a.out + OUT_YP + (size_t)row * D : a.out + OUT_YS + (size_t)(row - ROW_SMP) * D;
#pragma unroll
        for (int j = 0; j < 4; ++j) *((f32x4*)dst + lane + 64 * j) = *((const f32x4*)(H3 + (size_t)row * D) + lane + 64 * j) * r * g[j];
    }
}
}
namespace mk {
__global__ void __launch_bounds__(NWAVES * 64, 2) mega_fwd(Args args) {
    extern __shared__ __attribute__((aligned(16))) unsigned char lds[];
    Frame F;
    F.lds = (LAS unsigned char*)lds;
    F.MISC = (volatile LAS unsigned*)(F.lds + MISC_OFF);
    F.wave = __builtin_amdgcn_readfirstlane((int)threadIdx.x >> 6);
    F.G = gridDim.x; { const int bx = blockIdx.x; F.vcu = (F.G % 8 == 0) ? (bx % 8) * (F.G / 8) + bx / 8 : bx; }
    unsigned char* ws = args.ws;
    gu32* ctl = (gu32*)(ws + WS_CTL);
    for (int u = threadIdx.x; u < (LDS_BYTES - LDSCTL_OFF) / 4; u += NWAVES * 64) ((LAS unsigned*)(F.lds + LDSCTL_OFF))[u] = 0u;
    __syncthreads();
    XcdBarrier bar = xcd_barrier_post((unsigned*)(ctl + CW_BAR), F.MISC + 8, F.wave);
#define GRID_BAR() xcd_barrier(bar)

    p0_prologue(F, args);
    GRID_BAR();
    {
        pg8::Gemm g{(const pg8::bf16_t*)(ws + WS_XB), (const pg8::bf16_t*)(ws + WS_W1T), MP, 2 * FFN, D};
        pg8::StaticOrder S; S.init(MP, 2 * FFN, F.G, (int)blockIdx.x);
        EpiSwiGLU E{(bf16*)(ws + WS_ACT), (const float*)(ws + WS_R1)};
        pg8::gemm_phase<EpiSwiGLU, pg8::StaticOrder, true, true>(F.lds + RING_OFF, g, S, E, F.wave);
    }
    GRID_BAR();
    {
        pg8::Gemm g{(const pg8::bf16_t*)(ws + WS_ACT), (const pg8::bf16_t*)(ws + WS_W1D), MP, D, FFN};
        pg8::StaticOrder S; S.init(MP, D, F.G, (int)blockIdx.x);
        typedef EpiResid<(unsigned)WS_XE, true, (unsigned)WS_H, (unsigned)WS_HB, (unsigned)WS_SSQH, 1> EpiDown1;
        EpiDown1 E{ws, args.in[0]};
        pg8::gemm_phase<EpiDown1, pg8::StaticOrder, true, true>(F.lds + RING_OFF, g, S, E, F.wave);
    }
    GRID_BAR();
#ifndef NO_P3
    {
        pg8::Gemm g{(const pg8::bf16_t*)(ws + WS_HB), (const pg8::bf16_t*)(ws + WS_WIN), MP, NWIN, D};
        pg8::StaticOrder S; S.init(MP, NWIN, F.G, (int)blockIdx.x);
        EpiWin E{ws};
        pg8::gemm_phase<EpiWin, pg8::StaticOrder, true, true>(F.lds + RING_OFF, g, S, E, F.wave);
    }
#endif
    GRID_BAR();
    {
        finalize_ckv(F, args);
#ifndef NO_P4Q
        {   pg8::Gemm g{(const pg8::bf16_t*)(ws + WS_CQ), (const pg8::bf16_t*)(ws + WS_WUQ), MP, 768, QR};
            pg8::StaticOrder S; S.init(MP, 768, F.G, (int)blockIdx.x);
            EpiQ E{ws};
            pg8::gemm_phase<EpiQ, pg8::StaticOrder, true, true>(F.lds + RING_OFF, g, S, E, F.wave); }
#endif
#ifndef NO_P4K
        {   pg8::Gemm g{(const pg8::bf16_t*)(ws + WS_CKVB), (const pg8::bf16_t*)(ws + WS_WUK), MP, 512, KVR};
            pg8::StaticOrder S; S.init(MP, 512, F.G, (int)((blockIdx.x + 61) % F.G));
            EpiScaleBf16<true> E{(const float*)(ws + WS_SSQKV), (bf16*)(ws + WS_KN), 512};
            pg8::gemm_phase<EpiScaleBf16<true>, pg8::StaticOrder, true, true>(F.lds + RING_OFF, g, S, E, F.wave); }
#endif
#ifndef NO_P4V
        {   pg8::Gemm g{(const pg8::bf16_t*)(ws + WS_WUV), (const pg8::bf16_t*)(ws + WS_CKVB), 512, MP, KVR};
            pg8::StaticOrder S; S.init(512, MP, F.G, (int)((blockIdx.x + F.G - 69) % F.G));
            EpiScaleBf16<false> E{(const float*)(ws + WS_SSQKV), (bf16*)(ws + WS_VT), MP};
            pg8::gemm_phase<EpiScaleBf16<false>, pg8::StaticOrder, true, true>(F.lds + RING_OFF, g, S, E, F.wave); }
#endif
        for (int u = (int)blockIdx.x; u < 516; u += F.G) ret_u_unit(F, ws, u);
    }
    GRID_BAR();
    attn_phase(F, ws);
    ret_scan(F, args);
    for (int u = F.vcu; u < 256; u += F.G) decode_unit(F, args, u);
    for (int u = (int)blockIdx.x; u < 128; u += F.G) ret_sample_unit(F, args, u);
    GRID_BAR();
    for (int u = F.vcu; u < 512; u += F.G) ret_o_unit(F, args, u);
    for (int u = (int)blockIdx.x; u < 32; u += F.G) decode_combine_unit(F, args, u);
    GRID_BAR();
    {
        {   pg8::Gemm g{(const pg8::bf16_t*)(ws + WS_AV), (const pg8::bf16_t*)(ws + WS_WMO), MP, D, 512};
            pg8::StaticOrder S; S.init(MP, D, F.G, (int)blockIdx.x);
            typedef EpiGate<0, (unsigned)WS_SGA> EpiGA; EpiGA E{ws};
            pg8::gemm_phase<EpiGA, pg8::StaticOrder, true, true>(F.lds + RING_OFF, g, S, E, F.wave); }
        {   pg8::Gemm g{(const pg8::bf16_t*)(ws + WS_RIN), (const pg8::bf16_t*)(ws + WS_WRO), MP, D, D};
            pg8::StaticOrder S; S.init(MP, D, F.G, (int)blockIdx.x);
            typedef EpiGate<1, (unsigned)WS_SGB> EpiGB; EpiGB E{ws};
            pg8::gemm_phase<EpiGB, pg8::StaticOrder, true, true>(F.lds + RING_OFF, g, S, E, F.wave); }
    }
    GRID_BAR();
    {
        pg8::Gemm g{(const pg8::bf16_t*)(ws + WS_MX), (const pg8::bf16_t*)(ws + WS_WOUT), MP, D, D};
        pg8::StaticOrder S; S.init(MP, D, F.G, (int)blockIdx.x);
        typedef EpiResid<(unsigned)WS_H, false, (unsigned)WS_H2, (unsigned)WS_H2B, (unsigned)WS_SSQH2, 2> EpiOut;
        EpiOut E{ws, nullptr};
        pg8::gemm_phase<EpiOut, pg8::StaticOrder, true, true>(F.lds + RING_OFF, g, S, E, F.wave);
    }
    GRID_BAR();
    {
        pg8::Gemm g{(const pg8::bf16_t*)(ws + WS_H2B), (const pg8::bf16_t*)(ws + WS_W2T), MP, 2 * FFN, D};
        pg8::StaticOrder S; S.init(MP, 2 * FFN, F.G, (int)blockIdx.x);
        EpiSwiGLU2 E{ws};
        pg8::gemm_phase<EpiSwiGLU2, pg8::StaticOrder, true, true>(F.lds + RING_OFF, g, S, E, F.wave);
    }
    GRID_BAR();
    {
        pg8::Gemm g{(const pg8::bf16_t*)(ws + WS_ACT), (const pg8::bf16_t*)(ws + WS_W2D), MP, D, FFN};
        pg8::StaticOrder S; S.init(MP, D, F.G, (int)blockIdx.x);
        typedef EpiResid<(unsigned)WS_H2, false, (unsigned)WS_H3, 0u, (unsigned)WS_SSQH3, 1> EpiDown2;
        EpiDown2 E{ws, nullptr};
        pg8::gemm_phase<EpiDown2, pg8::StaticOrder, true, true>(F.lds + RING_OFF, g, S, E, F.wave);
    }
    GRID_BAR();
    final_norm_phase(F, args);
#undef GRID_BAR
}
}
extern "C" void kernel_launch(void* const* d_in, const int* in_sizes, int n_in, void* d_out, int out_size, void* d_ws, size_t ws_size, hipStream_t stream) {
    static int grid = 0;
    if (grid == 0) {
        int dev = 0, cus = 0;
        if (n_in != 27 || out_size != (int)mk::OUT_END || ws_size < mk::WS_END6) { fprintf(stderr, "kernel_launch: unexpected problem shape (n_in %d, out %d, ws %zu); nothing launched\n", n_in, out_size, ws_size); grid = -1; return; }
        if (hipGetDevice(&dev) != hipSuccess || hipDeviceGetAttribute(&cus, hipDeviceAttributeMultiprocessorCount, dev) != hipSuccess) { fprintf(stderr, "kernel_launch: device query failed\n"); grid = -1; return; }
        if (hipFuncSetAttribute((const void*)mk::mega_fwd, hipFuncAttributeMaxDynamicSharedMemorySize, mk::LDS_BYTES) != hipSuccess) { fprintf(stderr, "kernel_launch: hipFuncSetAttribute failed\n"); grid = -1; return; }
        int per_cu = 0;
        if (hipOccupancyMaxActiveBlocksPerMultiprocessor(&per_cu, (const void*)mk::mega_fwd, mk::NWAVES * 64, mk::LDS_BYTES) != hipSuccess || per_cu < 1) fprintf(stderr, "kernel_launch: note: occupancy query reports %d workgroups per CU\n", per_cu);
        (void)hipGetLastError();
        grid = cus;
    }
    if (grid < 0) return;
    unsigned char* ws = (unsigned char*)d_ws;
    (void)hipMemsetAsync(ws + mk::WS_CTL, 0, mk::CTL_ZERO_BYTES, stream);
    mk::Args a{};
    for (int i = 0; i < 27; ++i) a.in[i] = (const float*)d_in[i];
    a.out = (float*)d_out; a.ws = ws;
    hipLaunchKernelGGL(mk::mega_fwd, dim3(grid), dim3(mk::NWAVES * 64), mk::LDS_BYTES, stream, a);
}
```

```cpp
#include <hip/hip_runtime.h>
#include <cstdio>
#include <cstdint>
#include <cmath>
#define MK_DEBUG 0
#ifndef MK_PROBE
#define MK_PROBE 0
#define MK_PROBE_A 0
#define MK_PROBE_B 1
#endif
__device__ __forceinline__ int lane_fresh() { int l; asm volatile("v_mbcnt_lo_u32_b32 %0, -1, 0\n\tv_mbcnt_hi_u32_b32 %0, -1, %0" : "=v"(l)); return l; }
namespace pg8 {
#define PG8_LAS __attribute__((address_space(3)))
typedef unsigned short bf16_t;
typedef short bf16x8 __attribute__((ext_vector_type(8)));
typedef float f32x4 __attribute__((ext_vector_type(4)));
typedef unsigned u32x4 __attribute__((ext_vector_type(4)));
constexpr int BM = 256, BK = 64, HALF = 128, HTB = HALF * BK * 2  , STAGE_BYTES = 8 * HTB, NXCD = 8, WGM = 8;

__host__ __device__ __forceinline__ int lds_byte(int r, int c) { const int st = (r >> 4) * 2 + (c >> 5), rr = r & 15, cc = c & 31, ob = rr * 64 + cc * 2; return st * 1024 + (ob ^ (((ob >> 9) & 1) << 5)); }
__host__ __device__ __forceinline__ void stage_rc(int b, int& R, int& C) { const int st = b / 1024, sb = b % 1024, swz = sb ^ (((sb >> 9) & 1) << 5); R = (st >> 1) * 16 + swz / 64; C = (st & 1) * 32 + (swz % 64) / 2; }
__host__ __device__ __forceinline__ int perm32(int rho) { const int n = rho >> 4, i = rho & 15; return 8 * (i >> 2) + 4 * n + (i & 3); }

struct Unit { int pm, pn; };
struct Gemm { const bf16_t* A; const bf16_t* Bt; int M, N, K; };

struct StaticOrder {
    int nM, nN, nwg, G, c;
    __host__ __device__ void init(int M, int N, int G_, int c_) { nM = M / BM; nN = N / BM; nwg = nM * nN; G = G_; c = c_; }
    __host__ __device__ bool next(int i, Unit& u) const {
        const long L = (long)i * G + c; if (L >= nwg) return false;
        int wgid = (int)L; { const int q = nwg / NXCD, r = nwg % NXCD, xcd = wgid % NXCD, off = wgid / NXCD; wgid = (xcd < r ? xcd * (q + 1) : r * (q + 1) + (xcd - r) * q) + off; }
        const int nig = WGM * nN, gid = wgid / nig, fm = gid * WGM, gsz = (nM - fm) < WGM ? (nM - fm) : WGM;
        u.pm = fm + ((wgid % nig) % gsz); u.pn = (wgid % nig) / gsz; return true;
    }
    __device__ __forceinline__ void a_ready(const Unit&) const {}
    __device__ __forceinline__ void done(const Unit&) const {}
};

__device__ __forceinline__ unsigned cvt_pk_bf16(float lo, float hi) { unsigned r; asm volatile("v_cvt_pk_bf16_f32 %0, %1, %2" : "=v"(r) : "v"(lo), "v"(hi)); return r; }
typedef float f32x2 __attribute__((ext_vector_type(2)));
template <class Epi, class Sched, bool ALIGN_EPI = false, bool SP2 = false>
__device__ __forceinline__ void gemm_phase(PG8_LAS unsigned char* lds, const Gemm g, const Sched& S, const Epi& E, const int wave_in  ) {
    int tid_ = lane_fresh() + 64 * wave_in; asm volatile("" : "+v"(tid_));
    const int tid = tid_, wid = __builtin_amdgcn_readfirstlane(tid >> 6), lane = tid & 63, wr = wid >> 2, wc = wid & 3, fr = lane & 15, fq = lane >> 4;
    const int K = g.K, nt = K / BK;
    unsigned voffA[2], voffB[2];
#pragma unroll
    for (int i = 0; i < 2; ++i) { int R, C; stage_rc(tid * 16 + i * 8192, R, C); const int Rb = Epi::PERM ? ((R & ~31) + perm32(R & 31)) : R;
        voffA[i] = (unsigned)(R * K + C) * 2u; voffB[i] = (unsigned)(Rb * K + C) * 2u; }
    const size_t kstep = (size_t)(BK * 2);
    const size_t hstep = (size_t)HALF * K * 2;
    const size_t tstep = 2 * hstep;
    const unsigned ldsw = (unsigned)wid * 1024u;
    const int aoff = lds_byte(wr * 64 + fr, fq * 8), boff = lds_byte(wc * 32 + fr, fq * 8);
#define PG8_SA(b, h) (((b) * 2 + (h)) * HTB)
#define PG8_SB(b, h) ((4 + (b) * 2 + (h)) * HTB)
#define PG8_STAGE(bufoff, gbase, voff) do { _Pragma("unroll") for (int _i = 0; _i < 2; ++_i) \
        __builtin_amdgcn_global_load_lds((const unsigned*)((const char*)(gbase) + (voff)[_i]), (PG8_LAS unsigned*)(lds + (bufoff) + ldsw + _i * 8192), 16, 0, 0); } while (0)
#define PG8_LDA(dst, b, h) do { _Pragma("unroll") for (int m = 0; m < 4; ++m) _Pragma("unroll") for (int k = 0; k < 2; ++k) dst[m][k] = *(const PG8_LAS bf16x8*)(lds + PG8_SA(b, h) + aoff + m * 2048 + k * 1024); } while (0)
#define PG8_LDB(dst, b, h) do { _Pragma("unroll") for (int n = 0; n < 2; ++n) _Pragma("unroll") for (int k = 0; k < 2; ++k) dst[n][k] = *(const PG8_LAS bf16x8*)(lds + PG8_SB(b, h) + boff + n * 2048 + k * 1024); } while (0)
#define PG8_MMA(ai, bj, At, Bt) do { __builtin_amdgcn_s_setprio(1); _Pragma("unroll") for (int m = 0; m < 4; ++m) _Pragma("unroll") for (int n = 0; n < 2; ++n) _Pragma("unroll") for (int k = 0; k < 2; ++k) \
        acc[ai][bj][m][n] = __builtin_amdgcn_mfma_f32_16x16x32_bf16(Bt[n][k], At[m][k], acc[ai][bj][m][n], 0, 0, 0); __builtin_amdgcn_s_setprio(0); } while (0)
#define PG8_WAIT_V(n) asm volatile("s_waitcnt vmcnt(" #n ")" ::: "memory")
#define PG8_WAIT_L(n) asm volatile("s_waitcnt lgkmcnt(" #n ")" ::: "memory")
#define PG8_BAR __builtin_amdgcn_s_barrier()
#define PG8_SCHED __builtin_amdgcn_sched_barrier(0)
    Unit cur, nxt; int ui = 0;
    if (!S.next(0, cur)) return;
    f32x4 acc[2][2][4][2];
#pragma unroll
    for (int a = 0; a < 2; ++a)
#pragma unroll
        for (int b = 0; b < 2; ++b)
#pragma unroll
            for (int m = 0; m < 4; ++m)
#pragma unroll
                for (int n = 0; n < 2; ++n) acc[a][b][m][n] = (f32x4){0.f, 0.f, 0.f, 0.f};
    bf16x8 At[4][2], B0[2][2], B1[2][2];
    const char* cA = (const char*)g.A + (size_t)cur.pm * tstep; const char* cB = (const char*)g.Bt + (size_t)cur.pn * tstep;
    S.a_ready(cur);
    if constexpr (SP2) {
        PG8_STAGE(PG8_SB(0, 0), cB, voffB); PG8_STAGE(PG8_SB(0, 1), cB + hstep, voffB); PG8_STAGE(PG8_SA(0, 0), cA, voffA); PG8_STAGE(PG8_SA(0, 1), cA + hstep, voffA);
        if (wr == 1) PG8_BAR;
        PG8_WAIT_V(2); PG8_BAR;
        PG8_STAGE(PG8_SB(1, 0), cB + kstep, voffB); PG8_STAGE(PG8_SA(1, 0), cA + kstep, voffA); PG8_STAGE(PG8_SB(1, 1), cB + hstep + kstep, voffB);
        PG8_WAIT_V(6); PG8_BAR;
    } else {
        PG8_STAGE(PG8_SB(0, 0), cB, voffB); PG8_STAGE(PG8_SA(0, 0), cA, voffA); PG8_STAGE(PG8_SB(0, 1), cB + hstep, voffB); PG8_STAGE(PG8_SA(0, 1), cA + hstep, voffA);
        if (wr == 1) PG8_BAR;
        PG8_WAIT_V(4); PG8_BAR;
        PG8_STAGE(PG8_SB(1, 0), cB + kstep, voffB); PG8_STAGE(PG8_SA(1, 0), cA + kstep, voffA); PG8_STAGE(PG8_SB(1, 1), cB + hstep + kstep, voffB);
        PG8_WAIT_V(6); PG8_BAR;
    }
    for (;;) {
        const bool has_next = S.next(ui + 1, nxt);
        const char* nA = has_next ? (const char*)g.A + (size_t)nxt.pm * tstep : cA; const char* nB = has_next ? (const char*)g.Bt + (size_t)nxt.pn * tstep : cB;
        for (int t = 0; t < nt; t += 2) {
            const bool last = (t == nt - 2);
            const char* a1 = cA + (size_t)(t + 1) * kstep;
            const char* a2 = last ? nA : cA + (size_t)(t + 2) * kstep; const char* b2 = last ? nB : cB + (size_t)(t + 2) * kstep;
            const char* a3 = a2 + kstep; const char* b3 = b2 + kstep;
            if (last && has_next) S.a_ready(nxt);
            if constexpr (SP2) {
            PG8_LDB(B0, 0, 0); PG8_LDB(B1, 0, 1); PG8_SCHED; PG8_LDA(At, 0, 0); PG8_STAGE(PG8_SA(1, 1), a1 + hstep, voffA);
            PG8_WAIT_V(8); PG8_WAIT_L(0); PG8_BAR; PG8_MMA(0, 0, At, B0); PG8_MMA(0, 1, At, B1); PG8_BAR; PG8_SCHED;
            PG8_LDA(At, 0, 1); PG8_STAGE(PG8_SB(0, 0), b2, voffB); PG8_STAGE(PG8_SB(0, 1), b2 + hstep, voffB); PG8_STAGE(PG8_SA(0, 0), a2, voffA);
            PG8_WAIT_V(8); PG8_WAIT_L(0); PG8_BAR; PG8_MMA(1, 0, At, B0); PG8_MMA(1, 1, At, B1); PG8_BAR; PG8_SCHED;
            PG8_LDB(B0, 1, 0); PG8_LDB(B1, 1, 1); PG8_SCHED; PG8_LDA(At, 1, 0); PG8_STAGE(PG8_SA(0, 1), a2 + hstep, voffA);
            PG8_WAIT_V(8); PG8_WAIT_L(0); PG8_BAR; PG8_MMA(0, 0, At, B0); PG8_MMA(0, 1, At, B1); PG8_BAR; PG8_SCHED;
            PG8_LDA(At, 1, 1); PG8_STAGE(PG8_SB(1, 0), b3, voffB); PG8_STAGE(PG8_SB(1, 1), b3 + hstep, voffB); PG8_STAGE(PG8_SA(1, 0), a3, voffA);
            PG8_WAIT_V(8); PG8_WAIT_L(0); PG8_BAR; PG8_MMA(1, 0, At, B0); PG8_MMA(1, 1, At, B1); PG8_BAR; PG8_SCHED;
            } else {
            PG8_LDB(B0, 0, 0); PG8_SCHED; PG8_LDA(At, 0, 0); PG8_STAGE(PG8_SA(1, 1), a1 + hstep, voffA);
            PG8_WAIT_L(8); PG8_BAR; PG8_WAIT_L(0); PG8_MMA(0, 0, At, B0); PG8_BAR; PG8_SCHED;
            PG8_LDB(B1, 0, 1); PG8_STAGE(PG8_SB(0, 0), b2, voffB);
            PG8_BAR; PG8_WAIT_L(0); PG8_MMA(0, 1, At, B1); PG8_BAR;
            PG8_LDA(At, 0, 1); PG8_STAGE(PG8_SA(0, 0), a2, voffA);
            PG8_BAR; PG8_WAIT_L(0); PG8_MMA(1, 0, At, B0); PG8_BAR; PG8_SCHED;
            PG8_STAGE(PG8_SB(0, 1), b2 + hstep, voffB);
            PG8_WAIT_V(6); PG8_BAR; PG8_MMA(1, 1, At, B1); PG8_BAR;
            PG8_LDB(B0, 1, 0); PG8_SCHED; PG8_LDA(At, 1, 0); PG8_STAGE(PG8_SA(0, 1), a2 + hstep, voffA);
            PG8_WAIT_L(8); PG8_BAR; PG8_WAIT_L(0); PG8_MMA(0, 0, At, B0); PG8_BAR; PG8_SCHED;
            PG8_LDB(B1, 1, 1); PG8_STAGE(PG8_SB(1, 0), b3, voffB);
            PG8_BAR; PG8_WAIT_L(0); PG8_MMA(0, 1, At, B1); PG8_BAR;
            PG8_LDA(At, 1, 1); PG8_STAGE(PG8_SA(1, 0), a3, voffA);
            PG8_BAR; PG8_WAIT_L(0); PG8_MMA(1, 0, At, B0); PG8_BAR; PG8_SCHED;
            PG8_STAGE(PG8_SB(1, 1), b3 + hstep, voffB);
            PG8_WAIT_V(6); PG8_BAR; PG8_MMA(1, 1, At, B1); PG8_BAR;
            }
        }
        if constexpr (ALIGN_EPI) { if (wr == 0) PG8_BAR; }
        if constexpr (!Epi::AFTER_DRAIN) { E(acc, cur, wr, wc, fr, fq); S.done(cur); }
        if (!has_next) break;
#pragma unroll
        for (int a = 0; a < 2; ++a)
#pragma unroll
            for (int b = 0; b < 2; ++b)
#pragma unroll
                for (int m = 0; m < 4; ++m)
#pragma unroll
                    for (int n = 0; n < 2; ++n) acc[a][b][m][n] = (f32x4){0.f, 0.f, 0.f, 0.f};
        cur = nxt; cA = nA; cB = nB; ++ui;
        if constexpr (ALIGN_EPI) { if (wr == 1) PG8_BAR; }
    }
    PG8_WAIT_V(0);
    if constexpr (!ALIGN_EPI) { if (wr == 0) PG8_BAR; }
    PG8_BAR;
    if constexpr (Epi::AFTER_DRAIN) { E.fused(acc, cur, wr, wc, fr, fq, lds, wid, lane); S.done(cur); }
#undef PG8_SA
#undef PG8_SB
#undef PG8_STAGE
#undef PG8_LDA
#undef PG8_LDB
#undef PG8_MMA
#undef PG8_WAIT_V
#undef PG8_WAIT_L
#undef PG8_BAR
#undef PG8_SCHED
}
}
#define GAS __attribute__((address_space(1)))
#define LAS __attribute__((address_space(3)))
typedef unsigned short bf16;
typedef unsigned v4u __attribute__((ext_vector_type(4)));
typedef float f32x4 __attribute__((ext_vector_type(4)));
typedef short bf16x8 __attribute__((ext_vector_type(8)));
typedef GAS unsigned gu32;
typedef GAS unsigned long long gu64;
#define RLX_AGENT __ATOMIC_RELAXED, __HIP_MEMORY_SCOPE_AGENT
#define LDS_WAIT() asm volatile("s_waitcnt lgkmcnt(0)" ::: "memory")
#define VM_WAIT() asm volatile("s_waitcnt vmcnt(0)" ::: "memory")
__device__ __forceinline__ unsigned long long rt() { return __builtin_amdgcn_s_memrealtime(); }
__device__ __forceinline__ unsigned f2bf(float f) { unsigned u = __builtin_bit_cast(unsigned, f); return (u + 0x7fffu + ((u >> 16) & 1u)) >> 16; }
__device__ __forceinline__ unsigned pk2(float lo, float hi) { return f2bf(lo) | (f2bf(hi) << 16); }

#define XB_TMO      128
#define XB_XCNT(j)  (256  + 64 * (j))
#define XB_XSUB(j)  (1280 + 64 * (j))
#define XB_XGEN(j)  (2304 + 64 * (j))
#define XB_TOP      3328
#define XB_TOPGEN   3392
#define XCD_BAR_WORDS 3456
#define XB_SPIN_CAP (1u << 18)

__device__ __forceinline__ unsigned xb_ld(unsigned* p)              { return __hip_atomic_load(p, __ATOMIC_RELAXED, __HIP_MEMORY_SCOPE_AGENT); }
__device__ __forceinline__ unsigned xb_add(unsigned* p, unsigned v) { return __hip_atomic_fetch_add(p, v, __ATOMIC_RELAXED, __HIP_MEMORY_SCOPE_AGENT); }
__device__ __forceinline__ unsigned xb_xcc_id() { return (unsigned)__builtin_amdgcn_s_getreg((3 << 11) | 20) & 0xFu; }
#define XB_SPIN(cond, bar) do { unsigned _sp = 0; while (cond) { __builtin_amdgcn_s_sleep(1); \
    if ((++_sp & 255u) == 0u) { if (xb_ld(&(bar)[XB_TMO])) break; if (_sp > XB_SPIN_CAP) { atomicAdd(&(bar)[XB_TMO], 1u); break; } } } } while (0)

struct XcdBarrier {
    unsigned* bar; unsigned x; int wave;
    volatile LAS unsigned* st;
};

#define XB_IS_T0(wave) ((wave) == 0 && lane_fresh() == 0)
__device__ __forceinline__ XcdBarrier xcd_barrier_post(unsigned* bar, volatile LAS unsigned* st, int wave) {
    XcdBarrier b; b.bar = bar; b.x = xb_xcc_id(); b.st = st; b.wave = wave;
    if (XB_IS_T0(wave)) (void)xb_add(&bar[XB_XCNT(b.x)], 1u);
    return b;
}
__device__ __forceinline__ void xcd_barrier_complete(unsigned* bar, unsigned x, unsigned& nloc, unsigned& nx) {
    const unsigned G = gridDim.x * gridDim.y * gridDim.z;
    unsigned sum, cnt, mine, sp = 0u;
    for (;;) {
        sum = 0u; cnt = 0u; mine = 0u;
#pragma unroll
        for (unsigned j = 0; j < 16; ++j) { const unsigned c = xb_ld(&bar[XB_XCNT(j)]); sum += c; cnt += (c > 0u) ? 1u : 0u; mine = (j == x) ? c : mine; }
        if (sum == G) break;
        __builtin_amdgcn_s_sleep(1);
        if ((++sp & 255u) == 0u) { if (xb_ld(&bar[XB_TMO])) break; if (sp > XB_SPIN_CAP) { atomicAdd(&bar[XB_TMO], 1u); break; } }
    }
    nloc = mine > 0u ? mine : 1u; nx = cnt > 0u ? cnt : 1u;
}

__device__ __forceinline__ void xcd_barrier(const XcdBarrier& b) {
    asm volatile("s_waitcnt vmcnt(0)" ::: "memory");
    __syncthreads();
    if (XB_IS_T0(b.wave)) {
        unsigned* bar = b.bar;
        __builtin_amdgcn_s_waitcnt(0);
        unsigned nloc = b.st[0], nx = b.st[1];
        if (nloc == 0u) { xcd_barrier_complete(bar, b.x, nloc, nx); b.st[0] = nloc; b.st[1] = nx; }
        const unsigned old = xb_add(&bar[XB_XSUB(b.x)], 1u);
        const unsigned gen = old / nloc;
        if (old + 1u == (gen + 1u) * nloc) {
            __builtin_amdgcn_fence(__ATOMIC_RELEASE, "agent");
            asm volatile("s_waitcnt vmcnt(0)" ::: "memory");
            const unsigned og = xb_add(&bar[XB_TOP], 1u);
            const unsigned tg = og / nx;
            if (og + 1u == (tg + 1u) * nx) xb_add(&bar[XB_TOPGEN], 1u);
            else XB_SPIN(xb_ld(&bar[XB_TOPGEN]) == tg, bar);
            __builtin_amdgcn_fence(__ATOMIC_ACQUIRE, "agent");
            xb_add(&bar[XB_XGEN(b.x)], 1u);
            asm volatile("s_waitcnt vmcnt(0)" ::: "memory");
        } else {
            XB_SPIN(xb_ld(&bar[XB_XGEN(b.x)]) == gen, bar);
            __builtin_amdgcn_fence(__ATOMIC_ACQUIRE, "agent");
            asm volatile("s_waitcnt vmcnt(0)" ::: "memory");
        }
    }
    __syncthreads();
}
namespace mk {
constexpr int D = 1024, NB = 8, SEQ = 2048, NMETA = 16, T = SEQ + NMETA, NS = 32, PAST = 16384, PAGE = 128, NPAGES = PAST / PAGE;
constexpr int FFN = 2816, NH = 8, QR = 384, KVR = 256, RH = 4, RDK = 128, RDV = 256, IN_DIM = 5792;
constexpr int O_CQ = 0, O_CKV = 384, O_KR = 640, O_RQ = 672, O_RK = 1184, O_RV = 1696, O_RG = 2720, O_GA = 3744, O_GB = 4768;
constexpr int MMAIN = NB * SEQ;
constexpr int ROW_META = MMAIN;
constexpr int ROW_SMP = MMAIN + NMETA;
constexpr int ROW_PAD = ROW_SMP + NS;
constexpr int MP = MMAIN + 256;
constexpr int NWIN = 5888;
constexpr int NPOS = T + 1;
constexpr float EPS = 1e-6f;
constexpr int NWAVES = 8;

constexpr size_t MiB = 1u << 20;
constexpr size_t al(size_t x) { return (x + 255) / 256 * 256; }
constexpr size_t WS_CTL = 0, CTL_ZERO_BYTES = 1 * MiB;
constexpr size_t WS_W1T = 1 * MiB;
constexpr size_t WS_W1D = WS_W1T + al((size_t)2 * FFN * D * 2);
constexpr size_t WS_WIN = WS_W1D + al((size_t)D * FFN * 2);
constexpr size_t WS_WUQ = WS_WIN + al((size_t)NWIN * D * 2);
constexpr size_t WS_WUK = WS_WUQ + al((size_t)768 * QR * 2);
constexpr size_t WS_WUV = WS_WUK + al((size_t)512 * KVR * 2);
constexpr size_t WS_WMO = WS_WUV + al((size_t)512 * KVR * 2);
constexpr size_t WS_WRO = WS_WMO + al((size_t)D * 512 * 2);
constexpr size_t WS_WOUT = WS_WRO + al((size_t)D * D * 2);
constexpr size_t WS_W2T = WS_WOUT + al((size_t)D * D * 2);
constexpr size_t WS_W2D = WS_W2T + al((size_t)2 * FFN * D * 2);
constexpr size_t WS_TAB = WS_W2D + al((size_t)D * FFN * 2);
constexpr size_t TAB_C64 = 0, TAB_S64 = (size_t)NPOS * 64 * 4, TAB_C16 = 2 * TAB_S64, TAB_S16 = TAB_C16 + (size_t)NPOS * 16 * 4, TAB_GP = TAB_S16 + (size_t)NPOS * 16 * 4, TAB_GN = TAB_GP + 512 * 4, TAB_END = TAB_GN + 512 * 4;
constexpr size_t WS_XB = WS_TAB + al(TAB_END);
constexpr size_t WS_XE = WS_XB + al((size_t)MP * D * 2);
constexpr size_t WS_R1 = WS_XE + al((size_t)256 * D * 4);
constexpr size_t WS_ACT = WS_R1 + al((size_t)MP * 4);
constexpr size_t WS_H = WS_ACT + al((size_t)MP * FFN * 2);
constexpr size_t WS_HB = WS_H + al((size_t)MP * D * 4);
constexpr size_t WS_SSQH = WS_HB + al((size_t)MP * D * 2);
constexpr size_t WS_END1 = WS_SSQH + al((size_t)MP * 16 * 4);

constexpr int CW_BAR = 4096;

constexpr int RING_OFF = 0, RING_BYTES = 131072, LDSCTL_OFF = RING_BYTES, MISC_OFF = LDSCTL_OFF + 320, LDS_BYTES = 147456;

struct Args {
    const float* in[27]; float* out; unsigned char* ws;
};

struct Frame {
    LAS unsigned char* lds;
    volatile LAS unsigned* MISC;
    int wave, vcu, G;
};
__device__ __forceinline__ int fresh_tid(int wave) { int t = lane_fresh() + 64 * wave; asm volatile("" : "+v"(t)); return t; }

__device__ __forceinline__ float lx(float v, int lane, int mask) { return __int_as_float(__builtin_amdgcn_ds_bpermute((lane ^ mask) << 2, __float_as_int(v))); }
__device__ __forceinline__ float wave_sum(float v, int lane) {
#pragma unroll
    for (int o = 1; o < 64; o <<= 1) v += lx(v, lane, o);
    return v;
}
__device__ __forceinline__ int row_pos(int row) { return row < MMAIN ? (row & (SEQ - 1)) + NMETA : (row < ROW_SMP ? row - ROW_META : (row < ROW_PAD ? PAST : 0)); }
__device__ __forceinline__ int row_pidx(int row) { return row < MMAIN ? (row & (SEQ - 1)) + NMETA : (row < ROW_SMP ? row - ROW_META : (row < ROW_PAD ? T : 0)); }
__device__ __forceinline__ int row_jtok(int row) { return row < MMAIN ? (row & 127) : (row < ROW_SMP ? row - ROW_META : 0); }

struct WSrc { const float* W; int ld; int col0; const float* g; };
__device__ __forceinline__ void wmat_dims(int id, int& K, int& ngrp) {
    switch (id) {
        case 0: case 9: K = D; ngrp = 2 * FFN / 32; break;
        case 1: case 10: K = FFN; ngrp = D / 32; break;
        case 2: K = D; ngrp = NWIN / 32; break;
        case 3: K = QR; ngrp = 768 / 32; break;
        case 4: case 5: K = KVR; ngrp = 512 / 32; break;
        case 6: K = 512; ngrp = D / 32; break;
        default: K = D; ngrp = D / 32; break;
    }
}
__device__ __forceinline__ size_t wmat_off(int id) {
    switch (id) { case 0: return WS_W1T; case 1: return WS_W1D; case 2: return WS_WIN; case 3: return WS_WUQ; case 4: return WS_WUK; case 5: return WS_WUV;
                  case 6: return WS_WMO; case 7: return WS_WRO; case 8: return WS_WOUT; case 9: return WS_W2T; default: return WS_W2D; }
}
__device__ __forceinline__ WSrc wmat_src(const Args& a, int id, int g) {
    WSrc s; s.W = nullptr; s.ld = 0; s.col0 = 0; s.g = nullptr;
    switch (id) {
        case 0: case 9: { const int pn = g >> 3, gg = g & 7; const int o = id == 0 ? 7 : 22;
            s.W = gg < 4 ? a.in[o + 1] : a.in[o + 2]; s.ld = FFN; s.col0 = 128 * pn + 32 * (gg & 3); s.g = a.in[o]; break; }
        case 1: s.W = a.in[10]; s.ld = D; s.col0 = 32 * g; break;
        case 10: s.W = a.in[25]; s.ld = D; s.col0 = 32 * g; break;
        case 2: { s.ld = IN_DIM; s.g = a.in[11]; int zc = -1;
            if (g < 8) zc = 32 * g;
            else if (g < 16) { const int gg = g - 8; zc = gg < 4 ? 256 + 32 * gg : (gg == 4 ? O_KR : -1); }
            else if (g < 24) zc = O_CKV + 32 * (g - 16);
            else if (g < 56) { const int base = g < 40 ? O_RQ : O_RK; const int q = (g - 24) & 15, t = q >> 3, gg = q & 7;
                const int h = 2 * t + ((gg >> 1) & 1), part = (gg >> 2) * 64 + (gg & 1) * 32; zc = base + h * 128 + part; }
            else if (g < 88) zc = O_RV + 32 * (g - 56);
            else if (g < 120) zc = O_RG + 32 * (g - 88);
            else if (g < 152) zc = O_GA + 32 * (g - 120);
            else zc = O_GB + 32 * (g - 152);
            if (zc >= 0) { s.W = a.in[12]; s.col0 = zc; }
            break; }
        case 3: s.W = a.in[15]; s.ld = 768; s.col0 = 32 * g; s.g = a.in[13]; break;
        case 4: s.W = a.in[16]; s.ld = 512; s.col0 = 32 * g; s.g = a.in[14]; break;
        case 5: s.W = a.in[17]; s.ld = 512; s.col0 = 32 * g; s.g = a.in[14]; break;
        case 6: s.W = a.in[18]; s.ld = D; s.col0 = 32 * g; break;
        case 7: s.W = a.in[20]; s.ld = D; s.col0 = 32 * g; break;
        default: s.W = a.in[21]; s.ld = D; s.col0 = 32 * g; break;
    }
    return s;
}
__device__ __forceinline__ void p0_transpose_item(const WSrc s, int K, bf16* WT, int n0, int k0, LAS float* scr, int lane) {
    if (s.W) {
#pragma unroll 8
        for (int i = 0; i < 32; ++i) { const int kk = 2 * i + (lane >> 5); float v = s.W[(size_t)(k0 + kk) * s.ld + s.col0 + (lane & 31)]; if (s.g) v *= s.g[k0 + kk]; scr[kk * 33 + (lane & 31)] = v; }
    } else {
#pragma unroll 8
        for (int i = 0; i < 32; ++i) { const int kk = 2 * i + (lane >> 5); scr[kk * 33 + (lane & 31)] = 0.f; }
    }
    LDS_WAIT(); asm volatile("" ::: "memory");
    const int c = lane & 7;
#pragma unroll
    for (int j = 0; j < 4; ++j) { const int n = (lane >> 3) + 8 * j; const LAS float* sp = scr + (8 * c) * 33 + n;
        v4u o; o.x = pk2(sp[0 * 33], sp[1 * 33]); o.y = pk2(sp[2 * 33], sp[3 * 33]); o.z = pk2(sp[4 * 33], sp[5 * 33]); o.w = pk2(sp[6 * 33], sp[7 * 33]);
        *(GAS v4u*)(WT + (size_t)(n0 + n) * K + k0 + 8 * c) = o; }
    LDS_WAIT(); asm volatile("" ::: "memory");
}
__device__ __forceinline__ const float* x_src(const Args& a, int row) {
    if (row < MMAIN) return a.in[0] + (size_t)row * D;
    if (row < ROW_SMP) return a.in[6] + (size_t)(row - ROW_META) * D;
    if (row < ROW_PAD) return a.in[1] + (size_t)(row - ROW_SMP) * D;
    return nullptr;
}
__device__ __forceinline__ void p0_prologue(Frame& F, const Args& a) {
    const int lane = fresh_tid(F.wave) & 63;
    LAS float* scr = (LAS float*)(F.lds + RING_OFF + F.wave * 16384);
    const int gw = F.vcu * NWAVES + F.wave, NGW = F.G * NWAVES;
    unsigned char* ws = a.ws;
    int base = 0;
#pragma unroll 1
    for (int id = 0; id < 11; ++id) {
        int K, ngrp; wmat_dims(id, K, ngrp);
        const int nk = K / 64, nitems = nk * ngrp;
        bf16* WT = (bf16*)(ws + wmat_off(id));
        int first = (gw - (base % NGW) + NGW) % NGW;
        for (int it = first; it < nitems; it += NGW) { const int g = it % ngrp, kb = it / ngrp; p0_transpose_item(wmat_src(a, id, g), K, WT, 32 * g, 64 * kb, scr, lane); }
        base += nitems;
    }
    bf16* XB = (bf16*)(ws + WS_XB); float* XE = (float*)(ws + WS_XE); float* R1 = (float*)(ws + WS_R1);
    for (int m = gw; m < MP; m += NGW) {
        const float* xr = x_src(a, m);
        f32x4 v[4]; float s = 0.f;
#pragma unroll
        for (int j = 0; j < 4; ++j) { v[j] = xr ? *((const GAS f32x4*)xr + lane + 64 * j) : (f32x4){0.f, 0.f, 0.f, 0.f}; s += (v[j].x * v[j].x + v[j].y * v[j].y) + (v[j].z * v[j].z + v[j].w * v[j].w); }
        s = wave_sum(s, lane);
        if (lane == 0) R1[m] = 1.0f / sqrtf(s * (1.f / D) + EPS);
        GAS unsigned long long* o8 = (GAS unsigned long long*)(XB + (size_t)m * D) + lane;
#pragma unroll
        for (int j = 0; j < 4; ++j) o8[64 * j] = (unsigned long long)pk2(v[j].x, v[j].y) | ((unsigned long long)pk2(v[j].z, v[j].w) << 32);
        if (m >= MMAIN) {
#pragma unroll
            for (int j = 0; j < 4; ++j) *((GAS f32x4*)(XE + (size_t)(m - MMAIN) * D) + lane + 64 * j) = v[j];
        }
    }
    float* TAB = (float*)(ws + WS_TAB);
    const int gt = (F.vcu * NWAVES + F.wave) * 64 + lane, NGT = NGW * 64;
    for (int e = gt; e < NPOS * 64; e += NGT) { const int p = e >> 6, i = e & 63; const int pos = p < T ? p : PAST;
        const float invf = (float)pow(10000.0, -(double)i / 64.0); const float ang = (float)pos * invf;
        TAB[TAB_C64 / 4 + e] = (float)cos((double)ang); TAB[TAB_S64 / 4 + e] = (float)sin((double)ang); }
    for (int e = gt; e < NPOS * 16; e += NGT) { const int p = e >> 4, i = e & 15; const int pos = p < T ? p : PAST;
        const float invf = (float)pow(10000.0, -(double)i / 16.0); const float ang = (float)pos * invf;
        TAB[TAB_C16 / 4 + e] = (float)cos((double)ang); TAB[TAB_S16 / 4 + e] = (float)sin((double)ang); }
    for (int e = gt; e < 512; e += NGT) { const int h = e >> 7, j = e & 127; const double lg = log1p(-exp2(-5.0 - (double)h));
        TAB[TAB_GP / 4 + e] = (float)exp(lg * (double)j); TAB[TAB_GN / 4 + e] = (float)exp(-lg * (double)j); }
}

using pg8::f32x4; using pg8::u32x4; using pg8::Unit; using pg8::BM; using pg8::HALF;
typedef unsigned u32x2 __attribute__((ext_vector_type(2)));
__device__ __forceinline__ float fast_sigmoid(float x) { return __builtin_amdgcn_rcpf(1.f + __builtin_amdgcn_exp2f(-1.4426950408889634f * x)); }
__device__ __forceinline__ float fast_silu(float x) { return x * fast_sigmoid(x); }

struct EpiSwiGLU {
    static constexpr bool PERM = true, AFTER_DRAIN = false;
    bf16* ACT; const float* rs;
    __device__ __forceinline__ void operator()(const f32x4 (&acc)[2][2][4][2], const Unit& u, int wr, int wc, int fr, int fq) const {
        int l_ = lane_fresh(); asm volatile("" : "+v"(l_)); fr = l_ & 15; fq = l_ >> 4;
        const int row0 = u.pm * BM + wr * 64 + fr, col0 = u.pn * HALF + wc * 32 + 8 * fq;
#pragma unroll
        for (int ai = 0; ai < 2; ++ai)
#pragma unroll
            for (int m = 0; m < 4; ++m) { const int row = row0 + ai * HALF + m * 16; const float r = rs[row];
                f32x4 o[2];
#pragma unroll
                for (int n = 0; n < 2; ++n)
#pragma unroll
                    for (int j = 0; j < 4; ++j) { const float g = acc[ai][0][m][n][j] * r, up = acc[ai][1][m][n][j] * r; o[n][j] = fast_silu(g) * up; }
                u32x4 w; w.x = pg8::cvt_pk_bf16(o[0][0], o[0][1]); w.y = pg8::cvt_pk_bf16(o[0][2], o[0][3]); w.z = pg8::cvt_pk_bf16(o[1][0], o[1][1]); w.w = pg8::cvt_pk_bf16(o[1][2], o[1][3]);
                *(u32x4*)(ACT + (size_t)row * FFN + col0) = w; }
    }
};
template <class T> __device__ __forceinline__ T* at(unsigned char* w, unsigned byte_off) { return (T*)(w + byte_off); }
template <unsigned RES_OFF, bool RES_X, unsigned OUT_OFF, unsigned OUTB_OFF, unsigned SSQ_OFF, int SCALE2  > struct EpiResid {
    static constexpr bool PERM = false, AFTER_DRAIN = false;
    unsigned char* ws_; const float* xin;
    __device__ __forceinline__ void operator()(const f32x4 (&acc)[2][2][4][2], const Unit& u, int wr, int wc, int fr, int fq) const {
        int l_ = lane_fresh(); asm volatile("" : "+v"(l_)); fr = l_ & 15; fq = l_ >> 4;
        unsigned char* w = ws_; asm volatile("" : "+s"(w));
        const unsigned row0 = u.pm * BM + wr * 64 + fr, col0 = u.pn * BM + wc * 32 + 4 * fq;
        constexpr float scale = 0.5f * SCALE2;
#pragma unroll
        for (int ai = 0; ai < 2; ++ai)
#pragma unroll
            for (int m = 0; m < 4; ++m) { unsigned row = row0 + ai * HALF + m * 16; asm volatile("" : "+v"(row));
                const float* rp;
                if (RES_X) rp = row < (unsigned)MMAIN ? xin + row * D + col0 : at<const float>(w, RES_OFF + ((row - MMAIN) * D + col0) * 4);
                else rp = at<const float>(w, RES_OFF + (row * D + col0) * 4);
                float ss = 0.f;
#pragma unroll
                for (int bj = 0; bj < 2; ++bj)
#pragma unroll
                    for (int n = 0; n < 2; ++n) { const f32x4 b = *(const f32x4*)(rp + bj * HALF + n * 16); const f32x4 o = b + acc[ai][bj][m][n] * scale;
                        const unsigned e = row * D + col0 + bj * HALF + n * 16;
                        *at<f32x4>(w, OUT_OFF + e * 4) = o;
                        ss += (o[0] * o[0] + o[1] * o[1]) + (o[2] * o[2] + o[3] * o[3]);
                        if (OUTB_OFF) { u32x2 pk; pk.x = pg8::cvt_pk_bf16(o[0], o[1]); pk.y = pg8::cvt_pk_bf16(o[2], o[3]); *at<u32x2>(w, OUTB_OFF + e * 2) = pk; } }
                ss += lx(ss, l_, 16); ss += lx(ss, l_, 32);
                if (fq == 0) *at<float>(w, SSQ_OFF + (row * 16 + u.pn * 4 + wc) * 4) = ss;
                asm volatile("" ::: "memory"); }
    }
};
}
namespace mk {
constexpr size_t WS_CQ = WS_END1;
constexpr size_t WS_SSQCQ = WS_CQ + al((size_t)MP * QR * 2);
constexpr size_t WS_CKVF = WS_SSQCQ + al((size_t)MP * 8 * 4);
constexpr size_t WS_CKVB = WS_CKVF + al((size_t)MP * KVR * 4);
constexpr size_t WS_SSQKV = WS_CKVB + al((size_t)MP * KVR * 2);
constexpr size_t WS_KRB = WS_SSQKV + al((size_t)MP * 4 * 4);
constexpr size_t WS_RQ = WS_KRB + al((size_t)MP * 32 * 2);
constexpr size_t WS_RK = WS_RQ + al((size_t)MP * 512 * 2);
constexpr size_t WS_RKT = WS_RK + al((size_t)MP * 512 * 2);
constexpr size_t WS_RVT = WS_RKT + al((size_t)MP * 512 * 2);
constexpr size_t WS_SRG = WS_RVT + al((size_t)MP * 1024 * 2);
constexpr size_t WS_SGA = WS_SRG + al((size_t)MP * 1024 * 2);
constexpr size_t WS_SGB = WS_SGA + al((size_t)MP * 1024 * 2);
constexpr size_t WS_QA = WS_SGB + al((size_t)MP * 1024 * 2);
constexpr size_t WS_KN = WS_QA + al((size_t)MP * 768 * 2);
constexpr size_t WS_VT = WS_KN + al((size_t)MP * 512 * 2);
constexpr size_t WS_KRF = WS_VT + al((size_t)MP * 512 * 2);
constexpr size_t WS_END2 = WS_KRF + al((size_t)MP * 32 * 4);
constexpr float SC_Q = 0.14724444348433683f;
constexpr float RK_SCALE = 0.08838834764831845f;

constexpr size_t OUT_YP = 0, OUT_YS = OUT_YP + (size_t)NB * SEQ * D, OUT_CKVP = OUT_YS + (size_t)NS * D, OUT_KRP = OUT_CKVP + (size_t)NB * T * KVR,
                 OUT_SRP = OUT_KRP + (size_t)NB * T * 32, OUT_CKVS = OUT_SRP + (size_t)NB * RH * RDK * RDV, OUT_KRS = OUT_CKVS + (size_t)NS * KVR, OUT_SRS = OUT_KRS + (size_t)NS * 32,
                 OUT_END = OUT_SRS + (size_t)NS * RH * RDK * RDV;

__device__ __forceinline__ float row_rscale16(const float* SSQ, int row, float inv_n) {
    const f32x4* p = (const f32x4*)(SSQ + (size_t)row * 16); const f32x4 a = p[0], b = p[1], c = p[2], d = p[3];
    const float s = ((a[0] + a[1]) + (a[2] + a[3])) + ((b[0] + b[1]) + (b[2] + b[3])) + ((c[0] + c[1]) + (c[2] + c[3])) + ((d[0] + d[1]) + (d[2] + d[3]));
    return 1.0f / sqrtf(s * inv_n + EPS);
}
__device__ __forceinline__ float row_rscale8(const float* SSQ, int row, float inv_n) {
    const f32x4* p = (const f32x4*)(SSQ + (size_t)row * 8); const f32x4 a = p[0], b = p[1];
    return 1.0f / sqrtf((((a[0] + a[1]) + (a[2] + a[3])) + ((b[0] + b[1]) + (b[2] + b[3]))) * inv_n + EPS);
}
__device__ __forceinline__ float row_rscale4(const float* SSQ, int row, float inv_n) {
    const f32x4 a = *(const f32x4*)(SSQ + (size_t)row * 4);
    return 1.0f / sqrtf(((a[0] + a[1]) + (a[2] + a[3])) * inv_n + EPS);
}
__device__ __forceinline__ u32x2 pack4(const f32x4 v) { u32x2 w; w.x = pg8::cvt_pk_bf16(v[0], v[1]); w.y = pg8::cvt_pk_bf16(v[2], v[3]); return w; }
__device__ __forceinline__ float ssq4(const f32x4 v) { return (v[0] * v[0] + v[1] * v[1]) + (v[2] * v[2] + v[3] * v[3]); }
__device__ __forceinline__ bf16 bf1(float x) { return (bf16)f2bf(x); }

static_assert(WS_END2 < ((size_t)1 << 31), "32-bit workspace offsets");
struct EpiWin {
    static constexpr bool PERM = false, AFTER_DRAIN = false;
    unsigned char* ws_;
#define MK_WS(var) unsigned char* var = ws_; asm volatile("" : "+s"(var))
#define MK_ROWS_BEGIN _Pragma("unroll") for (int ai = 0; ai < 2; ++ai) _Pragma("unroll") for (int m = 0; m < 4; ++m) { \
        unsigned row = row0 + ai * HALF + m * 16; asm volatile("" : "+v"(row)); const float r = row_rscale16(at<const float>(w, (unsigned)WS_SSQH), (int)row, 1.f / D);
#define MK_ROWS_END asm volatile("" ::: "memory"); }
    __device__ __forceinline__ void operator()(const f32x4 (&acc)[2][2][4][2], const Unit& u, int wr, int wc, int fr, int fq) const {
        int l_ = lane_fresh(); asm volatile("" : "+v"(l_)); fr = l_ & 15; fq = l_ >> 4;
        const unsigned row0 = u.pm * BM + wr * 64 + fr; const int pn = u.pn;
        MK_WS(w);
        if (pn == 0) {
            MK_ROWS_BEGIN
                float ss = 0.f;
#pragma unroll
                for (int bj = 0; bj < 2; ++bj)
#pragma unroll
                    for (int n = 0; n < 2; ++n) { const f32x4 v = acc[ai][bj][m][n] * r; ss += ssq4(v); *at<u32x2>(w, (unsigned)WS_CQ + (row * QR + bj * HALF + wc * 32 + n * 16 + 4 * fq) * 2) = pack4(v); }
                ss += lx(ss, l_, 16); ss += lx(ss, l_, 32);
                if (fq == 0) *at<float>(w, (unsigned)WS_SSQCQ + (row * 8 + wc) * 4) = ss;
            MK_ROWS_END
        } else if (pn == 1) {
            MK_ROWS_BEGIN
                float ss = 0.f;
#pragma unroll
                for (int n = 0; n < 2; ++n) { const f32x4 v = acc[ai][0][m][n] * r; ss += ssq4(v); *at<u32x2>(w, (unsigned)WS_CQ + (row * QR + 256 + wc * 32 + n * 16 + 4 * fq) * 2) = pack4(v); }
                ss += lx(ss, l_, 16); ss += lx(ss, l_, 32);
                if (fq == 0) *at<float>(w, (unsigned)WS_SSQCQ + (row * 8 + 4 + wc) * 4) = ss;
                if (wc == 0) {
                    const f32x4 x1 = acc[ai][1][m][0] * r, x2 = acc[ai][1][m][1] * r;
                    const unsigned pi = row_pidx((int)row);
                    const f32x4 c = *at<const f32x4>(w, (unsigned)(WS_TAB + TAB_C16) + (pi * 16 + 4 * fq) * 4), s = *at<const f32x4>(w, (unsigned)(WS_TAB + TAB_S16) + (pi * 16 + 4 * fq) * 4);
                    const f32x4 y1 = x1 * c - x2 * s, y2 = x1 * s + x2 * c;
                    *at<u32x2>(w, (unsigned)WS_KRB + (row * 32 + 4 * fq) * 2) = pack4(y1); *at<u32x2>(w, (unsigned)WS_KRB + (row * 32 + 16 + 4 * fq) * 2) = pack4(y2);
                    *at<f32x4>(w, (unsigned)WS_KRF + (row * 32 + 4 * fq) * 4) = y1; *at<f32x4>(w, (unsigned)WS_KRF + (row * 32 + 16 + 4 * fq) * 4) = y2;
                }
            MK_ROWS_END
        } else if (pn == 2) {
            MK_ROWS_BEGIN
                float ss = 0.f;
#pragma unroll
                for (int bj = 0; bj < 2; ++bj)
#pragma unroll
                    for (int n = 0; n < 2; ++n) { const f32x4 v = acc[ai][bj][m][n] * r; ss += ssq4(v); const unsigned e = row * KVR + bj * HALF + wc * 32 + n * 16 + 4 * fq;
                        *at<f32x4>(w, (unsigned)WS_CKVF + e * 4) = v; *at<u32x2>(w, (unsigned)WS_CKVB + e * 2) = pack4(v); }
                ss += lx(ss, l_, 16); ss += lx(ss, l_, 32);
                if (fq == 0) *at<float>(w, (unsigned)WS_SSQKV + (row * 4 + wc) * 4) = ss;
            MK_ROWS_END
        } else if (pn < 7) {
            const bool isk = pn >= 5; const unsigned hh = 2 * ((pn - 3) & 1) + (wc >> 1);
            const unsigned dbase = (unsigned)(isk ? WS_RK : WS_RQ) + hh * 256, gbase = (unsigned)(WS_TAB + (isk ? TAB_GN : TAB_GP)) + hh * 512;
            MK_ROWS_BEGIN
                const unsigned pi = row_pidx((int)row), jt = row_jtok((int)row);
                const float mult = *at<const float>(w, gbase + jt * 4) * (isk ? RK_SCALE : 1.f);
#pragma unroll
                for (int n = 0; n < 2; ++n) { const unsigned i0 = 32 * (wc & 1) + 16 * n + 4 * fq;
                    const f32x4 x1 = acc[ai][0][m][n] * r, x2 = acc[ai][1][m][n] * r;
                    const f32x4 c = *at<const f32x4>(w, (unsigned)(WS_TAB + TAB_C64) + (pi * 64 + i0) * 4), s = *at<const f32x4>(w, (unsigned)(WS_TAB + TAB_S64) + (pi * 64 + i0) * 4);
                    const f32x4 y1 = (x1 * c - x2 * s) * mult, y2 = (x1 * s + x2 * c) * mult;
                    *at<u32x2>(w, dbase + (row * 512 + i0) * 2) = pack4(y1); *at<u32x2>(w, dbase + (row * 512 + 64 + i0) * 2) = pack4(y2);
                    if (isk) {
#pragma unroll
                        for (int j = 0; j < 4; ++j) { *at<bf16>(w, (unsigned)WS_RKT + ((hh * 128 + i0 + j) * MP + row) * 2) = bf1(y1[j]); *at<bf16>(w, (unsigned)WS_RKT + ((hh * 128 + 64 + i0 + j) * MP + row) * 2) = bf1(y2[j]); } } }
            MK_ROWS_END
        } else if (pn < 11) {
            const unsigned cbase = (unsigned)WS_RVT + ((pn - 7) * 256 + wc * 32 + 4 * fq) * (MP * 2);
            MK_ROWS_BEGIN
#pragma unroll
                for (int bj = 0; bj < 2; ++bj)
#pragma unroll
                    for (int n = 0; n < 2; ++n) { const f32x4 v = acc[ai][bj][m][n] * r;
#pragma unroll
                        for (int j = 0; j < 4; ++j) *at<bf16>(w, cbase + ((bj * HALF + n * 16 + j) * MP + row) * 2) = bf1(v[j]); }
            MK_ROWS_END
        } else {
            const int t = (pn - 11) >> 2; const unsigned dbase = (unsigned)WS_SRG + (unsigned)t * (unsigned)(WS_SGA - WS_SRG) + (((pn - 11) & 3) * 256 + wc * 32 + 4 * fq) * 2;
            MK_ROWS_BEGIN
#pragma unroll
                for (int bj = 0; bj < 2; ++bj)
#pragma unroll
                    for (int n = 0; n < 2; ++n) { const f32x4 v = acc[ai][bj][m][n] * r; f32x4 o;
#pragma unroll
                        for (int j = 0; j < 4; ++j) { const float sg = fast_sigmoid(v[j]); o[j] = t == 0 ? v[j] * sg : sg; }
                        *at<u32x2>(w, dbase + (row * 1024 + bj * HALF + n * 16) * 2) = pack4(o); }
            MK_ROWS_END
        }
    }
};
static_assert(WS_SGB - WS_SGA == WS_SGA - WS_SRG, "gate arrays equally spaced");
struct EpiQ {
    static constexpr bool PERM = false, AFTER_DRAIN = false;
    unsigned char* ws;
    __device__ __forceinline__ void operator()(const f32x4 (&acc)[2][2][4][2], const Unit& u, int wr, int wc, int fr, int fq) const {
        int l_ = lane_fresh(); asm volatile("" : "+v"(l_)); fr = l_ & 15; fq = l_ >> 4;
        const float* SSQCQ = (const float*)(ws + WS_SSQCQ); bf16* QA = (bf16*)(ws + WS_QA); const float* TAB = (const float*)(ws + WS_TAB);
        const int row0 = u.pm * BM + wr * 64 + fr;
#pragma unroll
        for (int ai = 0; ai < 2; ++ai)
#pragma unroll
            for (int m = 0; m < 4; ++m) {
                int row = row0 + ai * HALF + m * 16; asm volatile("" : "+v"(row));
                const float r = row_rscale8(SSQCQ, row, 1.f / QR) * SC_Q;
#pragma unroll
                for (int bj = 0; bj < 2; ++bj) {
                    const int grp = 8 * u.pn + 4 * bj + wc;
                    bf16* dst = QA + (size_t)row * 768 + 32 * grp + 4 * fq;
                    const bool rope = (grp % 3) == 2;
                    const int pi = row_pidx(row);
                    f32x4 c = *(const f32x4*)(TAB + TAB_C16 / 4 + pi * 16 + 4 * fq), s = *(const f32x4*)(TAB + TAB_S16 / 4 + pi * 16 + 4 * fq);
                    if (!rope) { c = (f32x4){1.f, 1.f, 1.f, 1.f}; s = (f32x4){0.f, 0.f, 0.f, 0.f}; }
                    const f32x4 x1 = acc[ai][bj][m][0] * r, x2 = acc[ai][bj][m][1] * r;
                    *(u32x2*)dst = pack4(x1 * c - x2 * s); *(u32x2*)(dst + 16) = pack4(x1 * s + x2 * c);
                }
                asm volatile("" ::: "memory");
            }
    }
};
template <bool ROWS> struct EpiScaleBf16 {
    static constexpr bool PERM = true, AFTER_DRAIN = false;
    const float* SSQKV; bf16* O; int ldc;
    __device__ __forceinline__ void operator()(const f32x4 (&acc)[2][2][4][2], const Unit& u, int wr, int wc, int fr, int fq) const {
        int l_ = lane_fresh(); asm volatile("" : "+v"(l_)); fr = l_ & 15; fq = l_ >> 4;
        const int row0 = u.pm * BM + wr * 64 + fr, col0 = u.pn * BM + wc * 32 + 8 * fq;
        float cs[2][8];
        if (!ROWS) {
#pragma unroll
            for (int bj = 0; bj < 2; ++bj)
#pragma unroll
                for (int k = 0; k < 8; ++k) cs[bj][k] = row_rscale4(SSQKV, col0 + bj * HALF + k, 1.f / KVR);
        }
#pragma unroll
        for (int ai = 0; ai < 2; ++ai)
#pragma unroll
            for (int m = 0; m < 4; ++m) { int row = row0 + ai * HALF + m * 16; asm volatile("" : "+v"(row)); const float r = ROWS ? row_rscale4(SSQKV, row, 1.f / KVR) : 1.f;
#pragma unroll
                for (int bj = 0; bj < 2; ++bj) { f32x4 v0 = acc[ai][bj][m][0], v1 = acc[ai][bj][m][1];
                    if (ROWS) { v0 = v0 * r; v1 = v1 * r; }
                    else {
#pragma unroll
                        for (int j = 0; j < 4; ++j) { v0[j] *= cs[bj][j]; v1[j] *= cs[bj][4 + j]; } }
                    u32x4 w; w.x = pg8::cvt_pk_bf16(v0[0], v0[1]); w.y = pg8::cvt_pk_bf16(v0[2], v0[3]); w.z = pg8::cvt_pk_bf16(v1[0], v1[1]); w.w = pg8::cvt_pk_bf16(v1[2], v1[3]);
                    *(u32x4*)(O + (size_t)row * ldc + col0 + bj * HALF) = w; } }
    }
};
__device__ __forceinline__ void finalize_ckv(Frame& F, const Args& a) {
    const int lane = fresh_tid(F.wave) & 63;
    const int gw = F.vcu * NWAVES + F.wave, NGW = F.G * NWAVES;
    const float* CKVF = (const float*)(a.ws + WS_CKVF); const float* SSQKV = (const float*)(a.ws + WS_SSQKV); const float* KRF = (const float*)(a.ws + WS_KRF);
    const f32x4 g = *((const f32x4*)a.in[14] + lane);
    for (int row = gw; row < ROW_PAD; row += NGW) {
        const float r = row_rscale4(SSQKV, row, 1.f / KVR);
        const f32x4 o = *((const f32x4*)(CKVF + (size_t)row * KVR) + lane) * r * g;
        const f32x4 kr = *((const f32x4*)(KRF + (size_t)row * 32) + (lane & 7));
        if (row < MMAIN) { const size_t t = (size_t)(row >> 11) * T + NMETA + (row & (SEQ - 1)); *((f32x4*)(a.out + OUT_CKVP + t * KVR) + lane) = o; if (lane < 8) *((f32x4*)(a.out + OUT_KRP + t * 32) + lane) = kr; }
        else if (row < ROW_SMP) { for (int b = 0; b < NB; ++b) { const size_t t = (size_t)b * T + (row - ROW_META); *((f32x4*)(a.out + OUT_CKVP + t * KVR) + lane) = o; if (lane < 8) *((f32x4*)(a.out + OUT_KRP + t * 32) + lane) = kr; } }
        else { *((f32x4*)(a.out + OUT_CKVS + (size_t)(row - ROW_SMP) * KVR) + lane) = o; if (lane < 8) *((f32x4*)(a.out + OUT_KRS + (size_t)(row - ROW_SMP) * 32) + lane) = kr; }
    }
}
}
namespace mk {
constexpr size_t WS_AV = WS_END2;
constexpr size_t WS_END3 = WS_AV + al((size_t)MP * 512 * 2);
typedef float f32x16 __attribute__((ext_vector_type(16)));
constexpr int AT_KSTR = 208, AT_VSTR = 144, AT_KBUF = 64 * AT_KSTR, AT_VBUF = 64 * AT_VSTR, AT_VOFF = 2 * AT_KBUF;
__device__ __forceinline__ int crow(int i, int half) { return (i & 3) + 8 * (i >> 2) + 4 * half; }

__device__ __forceinline__ void attn_unit(Frame& F, unsigned char* ws, int b, int h, int qb) {
    const int tid = fresh_tid(F.wave), lane = tid & 63, w = F.wave, q = lane & 31, half = lane >> 5;
    LAS unsigned char* L = F.lds + RING_OFF;
    const bf16* QA = (const bf16*)(ws + WS_QA); const bf16* KN = (const bf16*)(ws + WS_KN); const bf16* KRB = (const bf16*)(ws + WS_KRB); const bf16* VT = (const bf16*)(ws + WS_VT);
    const int qrow = b * SEQ + qb * 256 + w * 32 + q, q_main = qb * 256 + w * 32 + q, wq0 = qb * 256 + w * 32;
    bf16x8 qf[6];
#pragma unroll
    for (int s = 0; s < 6; ++s) qf[s] = *(const bf16x8*)(QA + (size_t)qrow * 768 + h * 96 + 16 * s + 8 * half);
    f32x16 ot[2];
#pragma unroll
    for (int i = 0; i < 16; ++i) { ot[0][i] = 0.f; ot[1][i] = 0.f; }
    float m = -INFINITY, l = 0.f;
    const int NT = 4 * (qb + 1);
    v4u kreg, rreg, vreg; rreg = (v4u){0u, 0u, 0u, 0u};
#define AT_LOAD(tt) do { const int t0_ = (tt) == 0 ? ROW_META : b * SEQ + 64 * ((tt) - 1); \
        kreg = *(const v4u*)(KN + (size_t)(t0_ + (tid >> 3)) * 512 + h * 64 + (tid & 7) * 8); \
        if (tid < 256) rreg = *(const v4u*)(KRB + (size_t)(t0_ + (tid >> 2)) * 32 + (tid & 3) * 8); \
        vreg = *(const v4u*)(VT + (size_t)(h * 64 + (tid >> 3)) * MP + t0_ + (tid & 7) * 8); } while (0)
#define AT_STORE(buf) do { LAS unsigned char* kb_ = L + (buf) * AT_KBUF; \
        *(LAS v4u*)(kb_ + (tid >> 3) * AT_KSTR + (tid & 7) * 16) = kreg; \
        if (tid < 256) *(LAS v4u*)(kb_ + (tid >> 2) * AT_KSTR + 128 + (tid & 3) * 16) = rreg; \
        LAS unsigned char* vb_ = L + AT_VOFF + (buf) * AT_VBUF + (tid >> 3) * AT_VSTR + (32 * ((tid & 7) >> 1) + 8 * (tid & 1)); \
        *(LAS u32x2*)(vb_) = (u32x2){vreg.x, vreg.y}; *(LAS u32x2*)(vb_ + 16) = (u32x2){vreg.z, vreg.w}; } while (0)
    AT_LOAD(0); AT_STORE(0);
    __syncthreads();
    for (int tt = 0; tt <= NT; ++tt) {
        const int buf = tt & 1;
        if (tt < NT) AT_LOAD(tt + 1);
        const int kmin = tt == 0 ? 0 : 64 * (tt - 1);
        if (tt == 0 || kmin <= wq0 + 31) {
            const LAS unsigned char* Kb = L + buf * AT_KBUF + q * AT_KSTR + 16 * half;
            const LAS unsigned char* Vb = L + AT_VOFF + buf * AT_VBUF + q * AT_VSTR + 16 * half;
            f32x16 st[2];
#pragma unroll
            for (int kb = 0; kb < 2; ++kb) {
#pragma unroll
                for (int i = 0; i < 16; ++i) st[kb][i] = 0.f;
#pragma unroll
                for (int s = 0; s < 6; ++s) { const bf16x8 kf = *(const LAS bf16x8*)(Kb + kb * 32 * AT_KSTR + 32 * s); st[kb] = __builtin_amdgcn_mfma_f32_32x32x16_bf16(kf, qf[s], st[kb], 0, 0, 0); }
            }
            if (tt == 0) {
#pragma unroll
                for (int kb = 0; kb < 2; ++kb)
#pragma unroll
                    for (int i = 0; i < 16; ++i) if (32 * kb + crow(i, half) >= NMETA) st[kb][i] = -INFINITY;
            } else if (kmin + 63 > wq0) {
#pragma unroll
                for (int kb = 0; kb < 2; ++kb)
#pragma unroll
                    for (int i = 0; i < 16; ++i) if (kmin + 32 * kb + crow(i, half) > q_main) st[kb][i] = -INFINITY;
            }
            float mx = st[0][0];
#pragma unroll
            for (int i = 1; i < 16; ++i) mx = fmaxf(mx, st[0][i]);
#pragma unroll
            for (int i = 0; i < 16; ++i) mx = fmaxf(mx, st[1][i]);
            mx = fmaxf(mx, lx(mx, lane, 32));
            const float mn = fmaxf(m, mx), alpha = __builtin_amdgcn_exp2f(m - mn);
            m = mn;
            float ps = 0.f;
#pragma unroll
            for (int kb = 0; kb < 2; ++kb)
#pragma unroll
                for (int i = 0; i < 16; ++i) { st[kb][i] = __builtin_amdgcn_exp2f(st[kb][i] - mn); ps += st[kb][i]; }
            l = l * alpha + ps;
#pragma unroll
            for (int i = 0; i < 16; ++i) { ot[0][i] *= alpha; ot[1][i] *= alpha; }
#pragma unroll
            for (int kb = 0; kb < 2; ++kb)
#pragma unroll
                for (int s2 = 0; s2 < 2; ++s2) {
                    u32x4 pw; pw.x = pg8::cvt_pk_bf16(st[kb][8 * s2 + 0], st[kb][8 * s2 + 1]); pw.y = pg8::cvt_pk_bf16(st[kb][8 * s2 + 2], st[kb][8 * s2 + 3]);
                    pw.z = pg8::cvt_pk_bf16(st[kb][8 * s2 + 4], st[kb][8 * s2 + 5]); pw.w = pg8::cvt_pk_bf16(st[kb][8 * s2 + 6], st[kb][8 * s2 + 7]);
                    const bf16x8 pf = __builtin_bit_cast(bf16x8, pw);
#pragma unroll
                    for (int vb = 0; vb < 2; ++vb) { const bf16x8 vf = *(const LAS bf16x8*)(Vb + vb * 32 * AT_VSTR + (32 * kb + 16 * s2) * 2); ot[vb] = __builtin_amdgcn_mfma_f32_32x32x16_bf16(vf, pf, ot[vb], 0, 0, 0); }
                }
        }
        if (tt < NT) AT_STORE(buf ^ 1);
        __syncthreads();
    }
#undef AT_LOAD
#undef AT_STORE
    l += lx(l, lane, 32);
    const float inv = 1.0f / l;
    bf16* AV = (bf16*)(ws + WS_AV) + (size_t)qrow * 512 + h * 64 + 4 * half;
#pragma unroll
    for (int vb = 0; vb < 2; ++vb)
#pragma unroll
        for (int g = 0; g < 4; ++g) { f32x4 o; o[0] = ot[vb][4 * g] * inv; o[1] = ot[vb][4 * g + 1] * inv; o[2] = ot[vb][4 * g + 2] * inv; o[3] = ot[vb][4 * g + 3] * inv; *(u32x2*)(AV + 32 * vb + 8 * g) = pack4(o); }
}
__device__ __forceinline__ void attn_phase(Frame& F, unsigned char* ws) {
    const int c = F.vcu;
    if (c >= 256) return;
    const int bh = c >> 2, p = c & 3;
    attn_unit(F, ws, bh >> 3, bh & 7, 7 - p);
    attn_unit(F, ws, bh >> 3, bh & 7, p);
}
}
namespace mk {
constexpr size_t WS_UMETA = WS_END3;
constexpr size_t WS_UT = WS_UMETA + al((size_t)RH * RDV * RDK * 4);
constexpr size_t WS_SPREV = WS_UT + al((size_t)32 * 16 * RDV * RDK * 4);
constexpr size_t WS_RIN = WS_SPREV + al((size_t)32 * 16 * RDV * RDK * 2);
constexpr size_t WS_DPART = WS_RIN + al((size_t)MP * 1024 * 2);
constexpr size_t WS_END4 = WS_DPART + al((size_t)32 * 8 * 8 * 264 * 4);
static_assert(WS_END4 < ((size_t)1 << 31), "32-bit workspace offsets");
__device__ __forceinline__ float gamma_of(int h) { return 1.0f - exp2f(-5.0f - (float)h); }
__device__ __forceinline__ float gpow(int h, int n) { return (float)exp((double)n * log1p(-exp2(-5.0 - (double)h))); }

__device__ __forceinline__ void ret_u_unit(Frame& F, unsigned char* ws, int u) {
    const int tid = fresh_tid(F.wave), lane = tid & 63, w = F.wave, r32 = lane & 31, half = lane >> 5;
    const bool meta = u >= 512; const int hh = meta ? u - 512 : (u >> 4) & 3;
    const int tok0 = meta ? ROW_META : (u >> 6) * SEQ + (u & 15) * 128, nks = meta ? 1 : 8;
    const bf16* RVT = (const bf16*)(ws + WS_RVT); const bf16* RKT = (const bf16*)(ws + WS_RKT);
    f32x16 acc[4];
#pragma unroll
    for (int db = 0; db < 4; ++db)
#pragma unroll
        for (int i = 0; i < 16; ++i) acc[db][i] = 0.f;
    const bf16* ap = RVT + (size_t)(hh * 256 + 32 * w + r32) * MP + tok0 + 8 * half;
    const bf16* bp = RKT + (size_t)(hh * 128 + r32) * MP + tok0 + 8 * half;
    for (int s = 0; s < nks; ++s) {
        const bf16x8 af = *(const bf16x8*)(ap + 16 * s);
#pragma unroll
        for (int db = 0; db < 4; ++db) { const bf16x8 bf = *(const bf16x8*)(bp + (size_t)(32 * db) * MP + 16 * s); acc[db] = __builtin_amdgcn_mfma_f32_32x32x16_bf16(af, bf, acc[db], 0, 0, 0); }
    }
    const float sc = gpow(hh, meta ? NMETA - 1 : 127);
    float* dst = meta ? (float*)(ws + WS_UMETA) + (size_t)hh * RDV * RDK : (float*)(ws + WS_UT) + (size_t)u * RDV * RDK;
#pragma unroll
    for (int db = 0; db < 4; ++db)
#pragma unroll
        for (int i = 0; i < 16; ++i) dst[(size_t)(32 * w + crow(i, half)) * RDK + 32 * db + r32] = acc[db][i] * sc;
}
__device__ __forceinline__ void ret_scan(Frame& F, const Args& a) {
    const int tid = fresh_tid(F.wave);
    const int gt = (F.vcu * NWAVES * 64) + tid, NGT = F.G * NWAVES * 64;
    const float* UM = (const float*)(a.ws + WS_UMETA); const float* UT = (const float*)(a.ws + WS_UT); bf16* SP = (bf16*)(a.ws + WS_SPREV);
    for (int e = gt; e < 32 * RDV * RDK; e += NGT) {
        const int bh = e >> 15, idx = e & 32767, hh = bh & 3;
        const float g128 = gpow(hh, 128);
        float S = UM[(size_t)hh * 32768 + idx];
        for (int c = 0; c < 16; ++c) { const size_t o = ((size_t)bh * 16 + c) * 32768 + idx; SP[o] = bf1(S); S = g128 * S + UT[o]; }
        const int ee = idx >> 7, d = idx & 127;
        a.out[OUT_SRP + ((size_t)bh * RDK + d) * RDV + ee] = S;
    }
}
__device__ __forceinline__ void ret_o_unit(Frame& F, const Args& a, int u) {
    unsigned char* ws = a.ws;
    const int tid = fresh_tid(F.wave), lane = tid & 63, w = F.wave, r32 = lane & 31, half = lane >> 5;
    const int bh = u >> 4, c = u & 15, hh = bh & 3, tok0 = (bh >> 2) * SEQ + c * 128;
    const int ib = w & 3, eh = w >> 2;
    LAS float* red = (LAS float*)(F.lds + RING_OFF);
    const bf16* RQ = (const bf16*)(ws + WS_RQ); const bf16* RK = (const bf16*)(ws + WS_RK); const bf16* RVT = (const bf16*)(ws + WS_RVT);
    const bf16* SP = (const bf16*)(ws + WS_SPREV) + (size_t)u * 32768;
    const int irow = tok0 + 32 * ib + r32;
    bf16x8 qf[8];
#pragma unroll
    for (int s = 0; s < 8; ++s) qf[s] = *(const bf16x8*)(RQ + (size_t)irow * 512 + hh * 128 + 16 * s + 8 * half);
    f32x16 ot[4];
#pragma unroll
    for (int eb = 0; eb < 4; ++eb) {
#pragma unroll
        for (int i = 0; i < 16; ++i) ot[eb][i] = 0.f;
        const bf16* sp = SP + (size_t)(128 * eh + 32 * eb + r32) * RDK + 8 * half;
#pragma unroll
        for (int s = 0; s < 8; ++s) { const bf16x8 sf = *(const bf16x8*)(sp + 16 * s); ot[eb] = __builtin_amdgcn_mfma_f32_32x32x16_bf16(sf, qf[s], ot[eb], 0, 0, 0); }
    }
    const float g = gamma_of(hh);
#pragma unroll
    for (int eb = 0; eb < 4; ++eb)
#pragma unroll
        for (int i = 0; i < 16; ++i) ot[eb][i] *= g;
    for (int jb = 0; jb <= ib; ++jb) {
        f32x16 at;
#pragma unroll
        for (int i = 0; i < 16; ++i) at[i] = 0.f;
        const bf16* kp = RK + (size_t)(tok0 + 32 * jb + r32) * 512 + hh * 128 + 8 * half;
#pragma unroll
        for (int s = 0; s < 8; ++s) { const bf16x8 kf = *(const bf16x8*)(kp + 16 * s); at = __builtin_amdgcn_mfma_f32_32x32x16_bf16(kf, qf[s], at, 0, 0, 0); }
        if (jb == ib) {
#pragma unroll
            for (int i = 0; i < 16; ++i) if (crow(i, half) > r32) at[i] = 0.f;
        }
#pragma unroll
        for (int s2 = 0; s2 < 2; ++s2) {
            u32x4 pw; pw.x = pg8::cvt_pk_bf16(at[8 * s2 + 0], at[8 * s2 + 1]); pw.y = pg8::cvt_pk_bf16(at[8 * s2 + 2], at[8 * s2 + 3]);
            pw.z = pg8::cvt_pk_bf16(at[8 * s2 + 4], at[8 * s2 + 5]); pw.w = pg8::cvt_pk_bf16(at[8 * s2 + 6], at[8 * s2 + 7]);
            const bf16x8 pf = __builtin_bit_cast(bf16x8, pw);
#pragma unroll
            for (int eb = 0; eb < 4; ++eb) {
                const bf16* vp = RVT + (size_t)(hh * 256 + 128 * eh + 32 * eb + r32) * MP + tok0 + 32 * jb + 16 * s2 + 4 * half;
                const u32x2 lo = *(const u32x2*)vp, hi = *(const u32x2*)(vp + 8);
                u32x4 vw; vw.x = lo.x; vw.y = lo.y; vw.z = hi.x; vw.w = hi.y;
                ot[eb] = __builtin_amdgcn_mfma_f32_32x32x16_bf16(__builtin_bit_cast(bf16x8, vw), pf, ot[eb], 0, 0, 0);
            }
        }
    }
    float s1 = 0.f;
#pragma unroll
    for (int eb = 0; eb < 4; ++eb)
#pragma unroll
        for (int i = 0; i < 16; ++i) s1 += ot[eb][i];
    s1 += lx(s1, lane, 32);
    if (half == 0) red[w * 32 + r32] = s1;
    __syncthreads();
    const float mu = (red[w * 32 + r32] + red[(w ^ 4) * 32 + r32]) * (1.f / 256.f);
    float s2 = 0.f;
#pragma unroll
    for (int eb = 0; eb < 4; ++eb)
#pragma unroll
        for (int i = 0; i < 16; ++i) { ot[eb][i] -= mu; s2 += ot[eb][i] * ot[eb][i]; }
    s2 += lx(s2, lane, 32);
    if (half == 0) red[256 + w * 32 + r32] = s2;
    __syncthreads();
    const float rstd = 1.0f / sqrtf((red[256 + w * 32 + r32] + red[256 + (w ^ 4) * 32 + r32]) * (1.f / 256.f) + EPS);
    __syncthreads();
    const bf16* SRG = (const bf16*)(ws + WS_SRG) + (size_t)irow * 1024 + hh * 256 + 128 * eh + 4 * half;
    bf16* RIN = (bf16*)(ws + WS_RIN) + (size_t)irow * 1024 + hh * 256 + 128 * eh + 4 * half;
    const float* gn = a.in[19] + hh * 256 + 128 * eh + 4 * half;
#pragma unroll
    for (int eb = 0; eb < 4; ++eb)
#pragma unroll
        for (int gq = 0; gq < 4; ++gq) {
            const int eo = 32 * eb + 8 * gq;
            const u32x2 sg = *(const u32x2*)(SRG + eo); const f32x4 gv = *(const f32x4*)(gn + eo);
            f32x4 o;
            o[0] = ot[eb][4 * gq + 0] * rstd * gv[0] * __uint_as_float(sg.x << 16); o[1] = ot[eb][4 * gq + 1] * rstd * gv[1] * __uint_as_float(sg.x & 0xffff0000u);
            o[2] = ot[eb][4 * gq + 2] * rstd * gv[2] * __uint_as_float(sg.y << 16); o[3] = ot[eb][4 * gq + 3] * rstd * gv[3] * __uint_as_float(sg.y & 0xffff0000u);
            *(u32x2*)(RIN + eo) = pack4(o);
        }
}
__device__ __forceinline__ void ret_sample_unit(Frame& F, const Args& a, int u) {
    unsigned char* ws = a.ws;
    const int tid = fresh_tid(F.wave), lane = tid & 63, s = u >> 2, hh = u & 3, e = tid & 255, dh = tid >> 8, row = ROW_SMP + s;
    LAS float* sh = (LAS float*)(F.lds + RING_OFF);
    const bf16* RQ = (const bf16*)(ws + WS_RQ); const bf16* RK = (const bf16*)(ws + WS_RK); const bf16* RVT = (const bf16*)(ws + WS_RVT);
    if (tid < 128) sh[tid] = __uint_as_float((unsigned)RQ[(size_t)row * 512 + hh * 128 + tid] << 16);
    else if (tid < 256) sh[tid] = __uint_as_float((unsigned)RK[(size_t)row * 512 + hh * 128 + tid - 128] << 16);
    __syncthreads();
    const float v = __uint_as_float((unsigned)RVT[(size_t)(hh * 256 + e) * MP + row] << 16);
    const float g = gamma_of(hh);
    const float* S0 = a.in[4] + ((size_t)(s * RH + hh) * RDK) * RDV + e;
    float* S1 = a.out + OUT_SRS + ((size_t)(s * RH + hh) * RDK) * RDV + e;
    float o = 0.f;
#pragma unroll 8
    for (int d = 64 * dh; d < 64 * dh + 64; ++d) { const float sn = g * S0[(size_t)d * RDV] + sh[128 + d] * v; S1[(size_t)d * RDV] = sn; o += sh[d] * sn; }
    sh[256 + dh * 256 + e] = o;
    __syncthreads();
    o = sh[256 + e] + sh[512 + e];
    float t1 = o;
#pragma unroll
    for (int off = 32; off > 0; off >>= 1) t1 += lx(t1, lane, off);
    if ((tid & 63) == 0) sh[768 + (tid >> 6)] = t1;
    __syncthreads();
    const float mu = (sh[768] + sh[769] + sh[770] + sh[771]) * (1.f / 256.f);
    const float dlt = o - mu;
    float t2 = dlt * dlt;
#pragma unroll
    for (int off = 32; off > 0; off >>= 1) t2 += lx(t2, lane, off);
    if ((tid & 63) == 0) sh[776 + (tid >> 6)] = t2;
    __syncthreads();
    const float rstd = 1.0f / sqrtf((sh[776] + sh[777] + sh[778] + sh[779]) * (1.f / 256.f) + EPS);
    if (dh == 0) { const float sg = __uint_as_float((unsigned)((const bf16*)(ws + WS_SRG))[(size_t)row * 1024 + hh * 256 + e] << 16);
        ((bf16*)(ws + WS_RIN))[(size_t)row * 1024 + hh * 256 + e] = bf1(dlt * rstd * a.in[19][hh * 256 + e] * sg); }
    __syncthreads();
}
}
namespace mk {
__device__ __forceinline__ int dlane_of(int h) { return ((h >> 2) & 1) * 32 + ((h >> 1) & 1) * 16 + (h & 1) * 8; }
__device__ __forceinline__ void decode_unit(Frame& F, const Args& a, int u) {
    unsigned char* ws = a.ws;
    const int tid = fresh_tid(F.wave), lane = tid & 63, w = F.wave, s = u >> 3, sp = u & 7, row = ROW_SMP + s;
    LAS float* sh = (LAS float*)(F.lds + RING_OFF);
    const bf16* QA = (const bf16*)(ws + WS_QA) + (size_t)row * 768;
    { const int r = tid & 255, hg = tid >> 8; const float* wuk = a.in[16] + (size_t)r * 512;
#pragma unroll 1
      for (int hh = 4 * hg; hh < 4 * hg + 4; ++hh) { float acc = 0.f;
          for (int n = 0; n < 64; ++n) acc += __uint_as_float((unsigned)QA[hh * 96 + n] << 16) * wuk[hh * 64 + n];
          sh[hh * 256 + r] = acc; }
      if (tid < 256) { const int hh = tid >> 5, i = tid & 31; sh[2048 + tid] = __uint_as_float((unsigned)QA[hh * 96 + 64 + i] << 16); } }
    __syncthreads();
    f32x4 ql[8], qr[8];
#pragma unroll
    for (int h = 0; h < 8; ++h) { ql[h] = *(const LAS f32x4*)(sh + h * 256 + 4 * lane); qr[h] = lane < 8 ? *(const LAS f32x4*)(sh + 2048 + h * 32 + 4 * lane) : (f32x4){0.f, 0.f, 0.f, 0.f}; }
    __syncthreads();
    f32x4 O[8];
#pragma unroll
    for (int h = 0; h < 8; ++h) O[h] = (f32x4){0.f, 0.f, 0.f, 0.f};
    float m = -INFINITY, l = 0.f;
    const int* pt = (const int*)a.in[5] + s * NPAGES + sp * 16 + 2 * w;
#pragma unroll 1
    for (int pg = 0; pg < 2; ++pg) {
        const int page = pt[pg];
        const float* ck = a.in[2] + (size_t)page * PAGE * KVR + 4 * lane;
        const float* kr = a.in[3] + (size_t)page * PAGE * 32 + 4 * (lane & 7);
#pragma unroll 1
        for (int k0 = 0; k0 < PAGE; k0 += 4) {
            f32x4 kv[4], rv[4]; float sc[4];
#pragma unroll
            for (int kk = 0; kk < 4; ++kk) { kv[kk] = *(const f32x4*)(ck + (size_t)(k0 + kk) * KVR); rv[kk] = *(const f32x4*)(kr + (size_t)(k0 + kk) * 32); }
#pragma unroll
            for (int kk = 0; kk < 4; ++kk) {
                float p[8];
#pragma unroll
                for (int h = 0; h < 8; ++h) { const f32x4 t = ql[h] * kv[kk] + qr[h] * rv[kk]; p[h] = (t[0] + t[1]) + (t[2] + t[3]); }
                float k4[4], k2[2];
#pragma unroll
                for (int k = 0; k < 4; ++k) { const float snd = lane < 32 ? p[4 + k] : p[k]; const float rcv = lx(snd, lane, 32); k4[k] = (lane < 32 ? p[k] : p[4 + k]) + rcv; }
#pragma unroll
                for (int k = 0; k < 2; ++k) { const float snd = (lane & 16) ? k4[k] : k4[2 + k]; const float rcv = lx(snd, lane, 16); k2[k] = ((lane & 16) ? k4[2 + k] : k4[k]) + rcv; }
                float v1; { const float snd = (lane & 8) ? k2[0] : k2[1]; const float rcv = lx(snd, lane, 8); v1 = ((lane & 8) ? k2[1] : k2[0]) + rcv; }
                v1 += lx(v1, lane, 4); v1 += lx(v1, lane, 2); v1 += lx(v1, lane, 1);
                sc[kk] = v1;
            }
            const float mx = fmaxf(fmaxf(sc[0], sc[1]), fmaxf(sc[2], sc[3]));
            const float mn = fmaxf(m, mx), alpha = __builtin_amdgcn_exp2f(m - mn);
            m = mn;
            float pe[4];
#pragma unroll
            for (int kk = 0; kk < 4; ++kk) pe[kk] = __builtin_amdgcn_exp2f(sc[kk] - mn);
            l = l * alpha + ((pe[0] + pe[1]) + (pe[2] + pe[3]));
#pragma unroll
            for (int h = 0; h < 8; ++h) {
                const int src = dlane_of(h);
                const float ah = __int_as_float(__builtin_amdgcn_readlane(__float_as_int(alpha), src)), p0 = __int_as_float(__builtin_amdgcn_readlane(__float_as_int(pe[0]), src)), p1 = __int_as_float(__builtin_amdgcn_readlane(__float_as_int(pe[1]), src)),
                            p2 = __int_as_float(__builtin_amdgcn_readlane(__float_as_int(pe[2]), src)), p3 = __int_as_float(__builtin_amdgcn_readlane(__float_as_int(pe[3]), src));
                O[h] = O[h] * ah + kv[0] * p0 + kv[1] * p1 + kv[2] * p2 + kv[3] * p3;
            }
        }
    }
    LAS float* wm = sh + 2304 + w * 16;
    LAS float* wo = sh + 2304 + 128 + w * 2048;
    { const int hd = 4 * (lane >> 5) + 2 * ((lane >> 4) & 1) + ((lane >> 3) & 1); if ((lane & 7) == 0) { wm[hd] = m; wm[8 + hd] = l; } }
#pragma unroll
    for (int h = 0; h < 8; ++h) *(LAS f32x4*)(wo + h * 256 + 4 * lane) = O[h];
    __syncthreads();
    float* part = (float*)(ws + WS_DPART) + (size_t)u * 8 * 264;
    for (int e = tid; e < 2048; e += 512) {
        const int h = e >> 8;
        float M = -INFINITY;
#pragma unroll
        for (int ww = 0; ww < 8; ++ww) M = fmaxf(M, sh[2304 + ww * 16 + h]);
        float acc = 0.f, L = 0.f;
#pragma unroll
        for (int ww = 0; ww < 8; ++ww) { const float f = __builtin_amdgcn_exp2f(sh[2304 + ww * 16 + h] - M); acc += f * sh[2304 + 128 + ww * 2048 + e]; L += f * sh[2304 + ww * 16 + 8 + h]; }
        part[h * 264 + (e & 255)] = acc;
        if ((e & 255) == 0) { part[h * 264 + 256] = M; part[h * 264 + 257] = L; }
    }
    __syncthreads();
}
__device__ __forceinline__ void decode_combine_unit(Frame& F, const Args& a, int s) {
    unsigned char* ws = a.ws;
    const int tid = fresh_tid(F.wave), row = ROW_SMP + s;
    LAS float* sh = (LAS float*)(F.lds + RING_OFF);
    const bf16* QA = (const bf16*)(ws + WS_QA) + (size_t)row * 768;
    const float* part = (const float*)(ws + WS_DPART) + (size_t)s * 8 * 8 * 264;
    if (tid < 256) { const float r = row_rscale4((const float*)(ws + WS_SSQKV), row, 1.f / KVR); sh[2056 + tid] = ((const float*)(ws + WS_CKVF))[(size_t)row * KVR + tid] * r * a.in[14][tid]; }
    __syncthreads();
    { const int h = tid >> 6, lane = tid & 63; float acc = 0.f;
      for (int r = lane; r < 256; r += 64) { const float* wuk = a.in[16] + (size_t)r * 512 + h * 64; float ql = 0.f;
          for (int n = 0; n < 64; ++n) ql += __uint_as_float((unsigned)QA[h * 96 + n] << 16) * wuk[n];
          acc += ql * sh[2056 + r]; }
      if (lane < 32) acc += __uint_as_float((unsigned)QA[h * 96 + 64 + lane] << 16) * ((const float*)(ws + WS_KRF))[(size_t)row * 32 + lane];
#pragma unroll
      for (int off = 32; off > 0; off >>= 1) acc += lx(acc, lane, off);
      if (lane == 0) sh[2048 + h] = acc; }
    __syncthreads();
    for (int e = tid; e < 2048; e += 512) {
        const int h = e >> 8, r = e & 255;
        const float sn = sh[2048 + h];
        float M = sn;
#pragma unroll
        for (int p = 0; p < 8; ++p) M = fmaxf(M, part[(p * 8 + h) * 264 + 256]);
        const float fn = __builtin_amdgcn_exp2f(sn - M);
        float acc = fn * sh[2056 + r], L = fn;
#pragma unroll
        for (int p = 0; p < 8; ++p) { const float f = __builtin_amdgcn_exp2f(part[(p * 8 + h) * 264 + 256] - M); acc += f * part[(p * 8 + h) * 264 + r]; L += f * part[(p * 8 + h) * 264 + 257]; }
        sh[e] = acc / L;
    }
    __syncthreads();
    { const int h = tid >> 6, v = tid & 63; float acc = 0.f;
      for (int r = 0; r < 256; ++r) acc += sh[h * 256 + r] * a.in[17][(size_t)r * 512 + h * 64 + v];
      ((bf16*)(ws + WS_AV))[(size_t)row * 512 + h * 64 + v] = bf1(acc); }
    __syncthreads();
}
}
namespace mk {
constexpr size_t WS_TMP = WS_ACT;
constexpr size_t WS_MX = WS_RQ;
constexpr size_t WS_H2B = WS_MX + al((size_t)MP * 1024 * 2);
constexpr size_t WS_H2 = WS_UT;
constexpr size_t WS_SSQH2 = WS_END4;
constexpr size_t WS_SSQH3 = WS_SSQH2 + al((size_t)MP * 16 * 4);
constexpr size_t WS_H3 = WS_H;
constexpr size_t WS_END6 = WS_SSQH3 + al((size_t)MP * 16 * 4);
static_assert(WS_H2B + (size_t)MP * 1024 * 2 <= WS_SRG && WS_H2 + (size_t)MP * 1024 * 4 <= WS_RIN && (size_t)MP * 1024 * 4 <= (size_t)MP * FFN * 2, "overlays");
static_assert(WS_END6 < ((size_t)1 << 31), "32-bit workspace offsets");

template <int STEP, unsigned GATE_OFF> struct EpiGate {
    static constexpr bool PERM = false, AFTER_DRAIN = false;
    unsigned char* ws_;
    __device__ __forceinline__ void operator()(const f32x4 (&acc)[2][2][4][2], const Unit& u, int wr, int wc, int fr, int fq) const {
        int l_ = lane_fresh(); asm volatile("" : "+v"(l_)); fr = l_ & 15; fq = l_ >> 4;
        unsigned char* w = ws_; asm volatile("" : "+s"(w));
        const unsigned row0 = u.pm * BM + wr * 64 + fr, col0 = u.pn * BM + wc * 32 + 4 * fq;
#pragma unroll
        for (int ai = 0; ai < 2; ++ai)
#pragma unroll
            for (int m = 0; m < 4; ++m) { unsigned row = row0 + ai * HALF + m * 16; asm volatile("" : "+v"(row));
#pragma unroll
                for (int bj = 0; bj < 2; ++bj)
#pragma unroll
                    for (int n = 0; n < 2; ++n) { const unsigned e = row * 1024 + col0 + bj * HALF + n * 16;
                        const u32x2 gw = *at<const u32x2>(w, GATE_OFF + e * 2);
                        f32x4 g; g[0] = __uint_as_float(gw.x << 16); g[1] = __uint_as_float(gw.x & 0xffff0000u); g[2] = __uint_as_float(gw.y << 16); g[3] = __uint_as_float(gw.y & 0xffff0000u);
                        f32x4 o = acc[ai][bj][m][n] * g;
                        if (STEP == 0) *at<f32x4>(w, (unsigned)WS_TMP + e * 4) = o;
                        else { o = o + *at<const f32x4>(w, (unsigned)WS_TMP + e * 4); *at<u32x2>(w, (unsigned)WS_MX + e * 2) = pack4(o); } }
                asm volatile("" ::: "memory"); }
    }
};
struct EpiSwiGLU2 {
    static constexpr bool PERM = true, AFTER_DRAIN = false;
    unsigned char* ws_;
    __device__ __forceinline__ void operator()(const f32x4 (&acc)[2][2][4][2], const Unit& u, int wr, int wc, int fr, int fq) const {
        int l_ = lane_fresh(); asm volatile("" : "+v"(l_)); fr = l_ & 15; fq = l_ >> 4;
        unsigned char* w = ws_; asm volatile("" : "+s"(w));
        const unsigned row0 = u.pm * BM + wr * 64 + fr, col0 = u.pn * HALF + wc * 32 + 8 * fq;
#pragma unroll
        for (int ai = 0; ai < 2; ++ai)
#pragma unroll
            for (int m = 0; m < 4; ++m) { unsigned row = row0 + ai * HALF + m * 16; asm volatile("" : "+v"(row));
                const float r = row_rscale16(at<const float>(w, (unsigned)WS_SSQH2), (int)row, 1.f / D);
                f32x4 o[2];
#pragma unroll
                for (int n = 0; n < 2; ++n)
#pragma unroll
                    for (int j = 0; j < 4; ++j) { const float g = acc[ai][0][m][n][j] * r, up = acc[ai][1][m][n][j] * r; o[n][j] = fast_silu(g) * up; }
                u32x4 pk; pk.x = pg8::cvt_pk_bf16(o[0][0], o[0][1]); pk.y = pg8::cvt_pk_bf16(o[0][2], o[0][3]); pk.z = pg8::cvt_pk_bf16(o[1][0], o[1][1]); pk.w = pg8::cvt_pk_bf16(o[1][2], o[1][3]);
                *at<u32x4>(w, (unsigned)WS_ACT + (row * FFN + col0) * 2) = pk;
                asm volatile("" ::: "memory"); }
    }
};
__device__ __forceinline__ void final_norm_phase(Frame& F, const Args& a) {
    const int lane = fresh_tid(F.wave) & 63;
    const int gw = F.vcu * NWAVES + F.wave, NGW = F.G * NWAVES;
    const float* H3 = (const float*)(a.ws + WS_H3); const float* SSQ = (const float*)(a.ws + WS_SSQH3);
    f32x4 g[4];
#pragma unroll
    for (int j = 0; j < 4; ++j) g[j] = *((const f32x4*)a.in[26] + lane + 64 * j);
    for (int row = gw; row < ROW_PAD; row += NGW) {
        if (row >= MMAIN && row < ROW_SMP) continue;
        const float r = row_rscale16(SSQ, row, 1.f / D);
        float* dst = row < MMAIN ? a.out + OUT_YP + (size_t)row * D : a.out + OUT_YS + (size_t)(row - ROW_SMP) * D;
#pragma unroll
        for (int j = 0; j < 4; ++j) *((f32x4*)dst + lane + 64 * j) = *((const f32x4*)(H3 + (size_t)row * D) + lane + 64 * j) * r * g[j];
    }
}
}
namespace mk {
typedef float f32x4_t __attribute__((ext_vector_type(4)));
constexpr int XROW0 = MMAIN, SK_C = 64 * 64;
__device__ __forceinline__ void skinny64(int wave, int tid, const bf16* A, int K, const bf16* Bt, int brow0, LAS float* P, float (&out)[8]) {
    const int lane = tid & 63, r16 = lane & 15, kq = lane >> 4;
    const bf16* ap = A + (size_t)(XROW0 + r16) * K + 8 * kq;
    const bf16* bp = Bt + (size_t)(brow0 + r16) * K + 8 * kq;
    f32x4 acc[4][4];
#pragma unroll
    for (int mf = 0; mf < 4; ++mf)
#pragma unroll
        for (int nf = 0; nf < 4; ++nf) acc[mf][nf] = (f32x4){0.f, 0.f, 0.f, 0.f};
    const int KS = K / 32;
    bf16x8 a0[4], b0[4], a1[4], b1[4], a2[4], b2[4];
#define SK_LOAD(a_, b_, kk_) do { _Pragma("unroll") for (int f = 0; f < 4; ++f) { a_[f] = *(const bf16x8*)(ap + (size_t)(16 * f) * K + 32 * (kk_)); b_[f] = *(const bf16x8*)(bp + (size_t)(16 * f) * K + 32 * (kk_)); } } while (0)
#define SK_MMA(a_, b_) do { _Pragma("unroll") for (int mf = 0; mf < 4; ++mf) _Pragma("unroll") for (int nf = 0; nf < 4; ++nf) acc[mf][nf] = __builtin_amdgcn_mfma_f32_16x16x32_bf16(a_[mf], b_[nf], acc[mf][nf], 0, 0, 0); } while (0)
    int kk = wave;
    if (kk < KS) SK_LOAD(a0, b0, kk);
    if (kk + 8 < KS) SK_LOAD(a1, b1, kk + 8);
    if (kk + 16 < KS) SK_LOAD(a2, b2, kk + 16);
    for (; kk < KS; kk += 24) {
        SK_MMA(a0, b0); if (kk + 24 < KS) SK_LOAD(a0, b0, kk + 24);
        if (kk + 8 < KS) { SK_MMA(a1, b1); if (kk + 32 < KS) SK_LOAD(a1, b1, kk + 32); }
        if (kk + 16 < KS) { SK_MMA(a2, b2); if (kk + 40 < KS) SK_LOAD(a2, b2, kk + 40); }
    }
#undef SK_LOAD
#undef SK_MMA
    LAS float* Pw = P + wave * SK_C;
#pragma unroll
    for (int mf = 0; mf < 4; ++mf)
#pragma unroll
        for (int nf = 0; nf < 4; ++nf)
#pragma unroll
            for (int i = 0; i < 4; ++i) Pw[(16 * mf + 4 * kq + i) * 64 + 16 * nf + r16] = acc[mf][nf][i];
    __syncthreads();
    const LAS float* pr = P + (tid >> 3) * 64 + 8 * (tid & 7);
    f32x4 s0 = *(const LAS f32x4*)pr, s1 = *(const LAS f32x4*)(pr + 4);
#pragma unroll
    for (int w = 1; w < 8; ++w) { s0 = s0 + *(const LAS f32x4*)(pr + w * SK_C); s1 = s1 + *(const LAS f32x4*)(pr + w * SK_C + 4); }
    out[0] = s0[0]; out[1] = s0[1]; out[2] = s0[2]; out[3] = s0[3]; out[4] = s1[0]; out[5] = s1[1]; out[6] = s1[2]; out[7] = s1[3];
    __syncthreads();
}
__device__ __forceinline__ float sum8(float v, int lane) { v += lx(v, lane, 1); v += lx(v, lane, 2); v += lx(v, lane, 4); return v; }
__device__ __forceinline__ void st8_bf16(bf16* p, const float* v) { u32x4 w; w.x = pg8::cvt_pk_bf16(v[0], v[1]); w.y = pg8::cvt_pk_bf16(v[2], v[3]); w.z = pg8::cvt_pk_bf16(v[4], v[5]); w.w = pg8::cvt_pk_bf16(v[6], v[7]); *(u32x4*)p = w; }
__device__ __forceinline__ void ld8(const LAS float* p, float* v) { const f32x4 a = *(const LAS f32x4*)p, b = *(const LAS f32x4*)(p + 4); v[0] = a[0]; v[1] = a[1]; v[2] = a[2]; v[3] = a[3]; v[4] = b[0]; v[5] = b[1]; v[6] = b[2]; v[7] = b[3]; }

__device__ __forceinline__ void xjob_ffn_up(Frame& F, unsigned char* ws, int j, size_t a_off, size_t w_off, int rs_mode) {
    const int tid = fresh_tid(F.wave);
    LAS float* P = (LAS float*)(F.lds + RING_OFF);
    const int brow0 = 256 * (j >> 1) + 64 * (j & 1);
    float g[8], u[8], o[8];
    skinny64(F.wave, tid, (const bf16*)(ws + a_off), D, (const bf16*)(ws + w_off), brow0, P, g);
    skinny64(F.wave, tid, (const bf16*)(ws + a_off), D, (const bf16*)(ws + w_off), brow0 + 128, P, u);
    const int r = tid >> 3, cg = tid & 7, row = XROW0 + r;
    const float rs = rs_mode == 0 ? ((const float*)(ws + WS_R1))[row] : row_rscale16((const float*)(ws + WS_SSQH2), row, 1.f / D);
#pragma unroll
    for (int k = 0; k < 8; ++k) o[k] = fast_silu(g[k] * rs) * (u[k] * rs);
    st8_bf16((bf16*)(ws + WS_ACT) + (size_t)row * FFN + 64 * j + 8 * cg, o);
}
__device__ __forceinline__ void xjob_resid(Frame& F, unsigned char* ws, int j, size_t a_off, int K, size_t w_off, const float* res  , float scale, size_t out_off, size_t outb_off, size_t ssq_off) {
    const int tid = fresh_tid(F.wave), lane = tid & 63;
    LAS float* P = (LAS float*)(F.lds + RING_OFF);
    float v[8], o[8];
    skinny64(F.wave, tid, (const bf16*)(ws + a_off), K, (const bf16*)(ws + w_off), 64 * j, P, v);
    const int r = tid >> 3, cg = tid & 7, row = XROW0 + r, col = 64 * j + 8 * cg;
    const f32x4 b0 = *(const f32x4*)(res + (size_t)r * D + col), b1 = *(const f32x4*)(res + (size_t)r * D + col + 4);
    float ss = 0.f;
#pragma unroll
    for (int k = 0; k < 8; ++k) { o[k] = (k < 4 ? b0[k] : b1[k - 4]) + scale * v[k]; ss += o[k] * o[k]; }
    float* op = (float*)(ws + out_off) + (size_t)row * D + col;
    *(f32x4*)op = (f32x4){o[0], o[1], o[2], o[3]}; *(f32x4*)(op + 4) = (f32x4){o[4], o[5], o[6], o[7]};
    if (outb_off) st8_bf16((bf16*)(ws + outb_off) + (size_t)row * D + col, o);
    ss = sum8(ss, lane);
    if (cg == 0) ((float*)(ws + ssq_off))[(size_t)row * 16 + j] = ss;
}
__device__ __forceinline__ void xjob_win(Frame& F, unsigned char* ws, int j) {
    const int tid = fresh_tid(F.wave), lane = tid & 63;
    LAS float* P = (LAS float*)(F.lds + RING_OFF);
    const int pn = j >> 1, q = j & 1;
    float v0[8], v1[8];
    skinny64(F.wave, tid, (const bf16*)(ws + WS_HB), D, (const bf16*)(ws + WS_WIN), 256 * pn + 64 * q, P, v0);
    skinny64(F.wave, tid, (const bf16*)(ws + WS_HB), D, (const bf16*)(ws + WS_WIN), 256 * pn + 64 * q + 128, P, v1);
    const int r = tid >> 3, cg = tid & 7, row = XROW0 + r;
    const float rs = row_rscale16((const float*)(ws + WS_SSQH), row, 1.f / D);
    const float* TAB = (const float*)(ws + WS_TAB);
#pragma unroll
    for (int k = 0; k < 8; ++k) { v0[k] *= rs; v1[k] *= rs; }
    const int tc0 = 64 * q + 8 * cg;
    if (pn == 0) {
        bf16* CQ = (bf16*)(ws + WS_CQ) + (size_t)row * QR; float* SSQCQ = (float*)(ws + WS_SSQCQ) + (size_t)row * 8;
        st8_bf16(CQ + tc0, v0); st8_bf16(CQ + tc0 + 128, v1);
        float s0 = 0.f, s1 = 0.f;
#pragma unroll
        for (int k = 0; k < 8; ++k) { s0 += v0[k] * v0[k]; s1 += v1[k] * v1[k]; }
        s0 = sum8(s0, lane); s1 = sum8(s1, lane);
        if (cg == 0) { SSQCQ[2 * q] = s0; SSQCQ[2 * q + 1] = s1; }
    } else if (pn == 1) {
        bf16* CQ = (bf16*)(ws + WS_CQ) + (size_t)row * QR; float* SSQCQ = (float*)(ws + WS_SSQCQ) + (size_t)row * 8;
        st8_bf16(CQ + 256 + tc0, v0);
        float s0 = 0.f;
#pragma unroll
        for (int k = 0; k < 8; ++k) s0 += v0[k] * v0[k];
        s0 = sum8(s0, lane);
        if (cg == 0) { SSQCQ[4 + q] = s0; SSQCQ[6 + q] = 0.f; }
        float x2[8];
#pragma unroll
        for (int k = 0; k < 8; ++k) x2[k] = lx(v1[k], lane, 2);
        if (q == 0 && cg < 2) {
            const int pi = row_pidx(row), i0 = 8 * cg;
            float y1[8], y2[8];
#pragma unroll
            for (int k = 0; k < 8; ++k) { const float c = TAB[TAB_C16 / 4 + pi * 16 + i0 + k], s = TAB[TAB_S16 / 4 + pi * 16 + i0 + k]; y1[k] = v1[k] * c - x2[k] * s; y2[k] = v1[k] * s + x2[k] * c; }
            st8_bf16((bf16*)(ws + WS_KRB) + (size_t)row * 32 + i0, y1); st8_bf16((bf16*)(ws + WS_KRB) + (size_t)row * 32 + 16 + i0, y2);
            float* kf = (float*)(ws + WS_KRF) + (size_t)row * 32;
#pragma unroll
            for (int k = 0; k < 8; ++k) { kf[i0 + k] = y1[k]; kf[16 + i0 + k] = y2[k]; }
        }
    } else if (pn == 2) {
        float* CKVF = (float*)(ws + WS_CKVF) + (size_t)row * KVR; bf16* CKVB = (bf16*)(ws + WS_CKVB) + (size_t)row * KVR; float* SSQKV = (float*)(ws + WS_SSQKV) + (size_t)row * 4;
        float s0 = 0.f, s1 = 0.f;
#pragma unroll
        for (int k = 0; k < 8; ++k) { CKVF[tc0 + k] = v0[k]; CKVF[tc0 + 128 + k] = v1[k]; s0 += v0[k] * v0[k]; s1 += v1[k] * v1[k]; }
        st8_bf16(CKVB + tc0, v0); st8_bf16(CKVB + tc0 + 128, v1);
        s0 = sum8(s0, lane); s1 = sum8(s1, lane);
        if (cg == 0) { SSQKV[2 * q] = s0; SSQKV[2 * q + 1] = s1; }
    } else if (pn < 7) {
        const bool isk = pn >= 5; const int hh = 2 * ((pn - 3) & 1) + q, i0 = 8 * cg;
        const int pi = row_pidx(row), jt = row_jtok(row);
        const float mult = isk ? RK_SCALE * TAB[TAB_GN / 4 + hh * 128 + jt] : TAB[TAB_GP / 4 + hh * 128 + jt];
        float y1[8], y2[8];
#pragma unroll
        for (int k = 0; k < 8; ++k) { const float c = TAB[TAB_C64 / 4 + pi * 64 + i0 + k], s = TAB[TAB_S64 / 4 + pi * 64 + i0 + k]; y1[k] = (v0[k] * c - v1[k] * s) * mult; y2[k] = (v0[k] * s + v1[k] * c) * mult; }
        bf16* dst = (bf16*)(ws + (isk ? WS_RK : WS_RQ)) + (size_t)row * 512 + hh * 128;
        st8_bf16(dst + i0, y1); st8_bf16(dst + 64 + i0, y2);
        if (isk) { bf16* RKT = (bf16*)(ws + WS_RKT);
#pragma unroll
            for (int k = 0; k < 8; ++k) { RKT[(size_t)(hh * 128 + i0 + k) * MP + row] = bf1(y1[k]); RKT[(size_t)(hh * 128 + 64 + i0 + k) * MP + row] = bf1(y2[k]); } }
    } else if (pn < 11) {
        bf16* RVT = (bf16*)(ws + WS_RVT);
#pragma unroll
        for (int k = 0; k < 8; ++k) { RVT[(size_t)((pn - 7) * 256 + tc0 + k) * MP + row] = bf1(v0[k]); RVT[(size_t)((pn - 7) * 256 + tc0 + 128 + k) * MP + row] = bf1(v1[k]); }
    } else {
        const int t = (pn - 11) >> 2; bf16* dst = (bf16*)(ws + WS_SRG + (size_t)t * (WS_SGA - WS_SRG)) + (size_t)row * 1024 + ((pn - 11) & 3) * 256;
        float o0[8], o1[8];
#pragma unroll
        for (int k = 0; k < 8; ++k) { const float g0 = fast_sigmoid(v0[k]), g1 = fast_sigmoid(v1[k]); o0[k] = t == 0 ? v0[k] * g0 : g0; o1[k] = t == 0 ? v1[k] * g1 : g1; }
        st8_bf16(dst + tc0, o0); st8_bf16(dst + tc0 + 128, o1);
    }
}
__device__ __forceinline__ void xjob_q(Frame& F, unsigned char* ws, int j) {
    const int tid = fresh_tid(F.wave), lane = tid & 63;
    LAS float* P = (LAS float*)(F.lds + RING_OFF);
    float v[8], p[8], o[8];
    skinny64(F.wave, tid, (const bf16*)(ws + WS_CQ), QR, (const bf16*)(ws + WS_WUQ), 64 * j, P, v);
    const int r = tid >> 3, cg = tid & 7, row = XROW0 + r;
    const float rs = row_rscale8((const float*)(ws + WS_SSQCQ), row, 1.f / QR) * SC_Q;
    const float* TAB = (const float*)(ws + WS_TAB);
    const int pi = row_pidx(row), col = 64 * j + 8 * cg, grp = col >> 5, w32 = col & 31;
#pragma unroll
    for (int k = 0; k < 8; ++k) p[k] = lx(v[k], lane, 2);
    if (grp % 3 == 2) {
        const int i0 = w32 & 15;
#pragma unroll
        for (int k = 0; k < 8; ++k) { const float c = TAB[TAB_C16 / 4 + pi * 16 + i0 + k], sn = TAB[TAB_S16 / 4 + pi * 16 + i0 + k];
            o[k] = (w32 < 16 ? v[k] * c - p[k] * sn : p[k] * sn + v[k] * c) * rs; }
    } else {
#pragma unroll
        for (int k = 0; k < 8; ++k) o[k] = v[k] * rs;
    }
    st8_bf16((bf16*)(ws + WS_QA) + (size_t)row * 768 + col, o);
}
__device__ __forceinline__ void xjob_kv(Frame& F, unsigned char* ws, int j, bool is_v) {
    const int tid = fresh_tid(F.wave);
    LAS float* P = (LAS float*)(F.lds + RING_OFF);
    float v[8];
    skinny64(F.wave, tid, (const bf16*)(ws + WS_CKVB), KVR, (const bf16*)(ws + (is_v ? WS_WUV : WS_WUK)), 64 * j, P, v);
    const int r = tid >> 3, cg = tid & 7, row = XROW0 + r, col = 64 * j + 8 * cg;
    const float rs = row_rscale4((const float*)(ws + WS_SSQKV), row, 1.f / KVR);
#pragma unroll
    for (int k = 0; k < 8; ++k) v[k] *= rs;
    if (!is_v) st8_bf16((bf16*)(ws + WS_KN) + (size_t)row * 512 + col, v);
    else { bf16* VT = (bf16*)(ws + WS_VT);
#pragma unroll
        for (int k = 0; k < 8; ++k) VT[(size_t)(col + k) * MP + row] = bf1(v[k]); }
}
__device__ __forceinline__ void xjob_mix(Frame& F, unsigned char* ws, int j) {
    const int tid = fresh_tid(F.wave);
    LAS float* P = (LAS float*)(F.lds + RING_OFF);
    float a[8], b[8], o[8];
    skinny64(F.wave, tid, (const bf16*)(ws + WS_AV), 512, (const bf16*)(ws + WS_WMO), 64 * j, P, a);
    skinny64(F.wave, tid, (const bf16*)(ws + WS_RIN), D, (const bf16*)(ws + WS_WRO), 64 * j, P, b);
    const int r = tid >> 3, cg = tid & 7, row = XROW0 + r, col = 64 * j + 8 * cg;
    const u32x4 ga = *(const u32x4*)((const bf16*)(ws + WS_SGA) + (size_t)row * 1024 + col), gb = *(const u32x4*)((const bf16*)(ws + WS_SGB) + (size_t)row * 1024 + col);
#pragma unroll
    for (int k = 0; k < 8; ++k) { const unsigned wa = ga[k >> 1], wb = gb[k >> 1];
        const float fa = __uint_as_float((k & 1) ? (wa & 0xffff0000u) : (wa << 16)), fb = __uint_as_float((k & 1) ? (wb & 0xffff0000u) : (wb << 16));
        o[k] = fa * a[k] + fb * b[k]; }
    st8_bf16((bf16*)(ws + WS_MX) + (size_t)row * 1024 + col, o);
}
}
namespace mk {
__global__ void __launch_bounds__(NWAVES * 64, 2) mega_fwd(Args args) {
    extern __shared__ __attribute__((aligned(16))) unsigned char lds[];
    Frame F;
    F.lds = (LAS unsigned char*)lds;
    F.MISC = (volatile LAS unsigned*)(F.lds + MISC_OFF);
    F.wave = __builtin_amdgcn_readfirstlane((int)threadIdx.x >> 6);
    F.G = gridDim.x; { const int bx = blockIdx.x; F.vcu = (F.G % 8 == 0) ? (bx % 8) * (F.G / 8) + bx / 8 : bx; }
    unsigned char* ws = args.ws;
    gu32* ctl = (gu32*)(ws + WS_CTL);
    for (int u = threadIdx.x; u < (LDS_BYTES - LDSCTL_OFF) / 4; u += NWAVES * 64) ((LAS unsigned*)(F.lds + LDSCTL_OFF))[u] = 0u;
    __syncthreads();
    XcdBarrier bar = xcd_barrier_post((unsigned*)(ctl + CW_BAR), F.MISC + 8, F.wave);
#if MK_PROBE
#define STAMP(k) do { if (blockIdx.x == 0 && F.wave == 0 && lane_fresh() == 0) ((unsigned long long*)(ws + WS_CTL + 512 * 1024))[k] = __builtin_amdgcn_s_memrealtime(); } while (0)
    STAMP(0);
#else
#define STAMP(k) do { } while (0)
#endif
#define GRID_BAR() xcd_barrier(bar)

    p0_prologue(F, args);
    GRID_BAR(); STAMP(1);
    {
        { const int bx = (int)blockIdx.x; if (bx >= 128 && bx < 172) xjob_ffn_up(F, ws, bx - 128, WS_XB, WS_W1T, 0); }
        pg8::Gemm g{(const pg8::bf16_t*)(ws + WS_XB), (const pg8::bf16_t*)(ws + WS_W1T), MMAIN, 2 * FFN, D};
        pg8::StaticOrder S; S.init(MMAIN, 2 * FFN, F.G, (int)blockIdx.x);
        EpiSwiGLU E{(bf16*)(ws + WS_ACT), (const float*)(ws + WS_R1)};
        pg8::gemm_phase<EpiSwiGLU, pg8::StaticOrder, true, true>(F.lds + RING_OFF, g, S, E, F.wave);
    }
    GRID_BAR(); STAMP(2);
    {
        { const int bx = (int)blockIdx.x; if (bx < 16) xjob_resid(F, ws, bx, WS_ACT, FFN, WS_W1D, (const float*)(ws + WS_XE), 0.5f, WS_H, WS_HB, WS_SSQH); }
        pg8::Gemm g{(const pg8::bf16_t*)(ws + WS_ACT), (const pg8::bf16_t*)(ws + WS_W1D), MMAIN, D, FFN};
        pg8::StaticOrder S; S.init(MMAIN, D, F.G, (int)blockIdx.x);
        typedef EpiResid<(unsigned)WS_XE, true, (unsigned)WS_H, (unsigned)WS_HB, (unsigned)WS_SSQH, 1> EpiDown1;
        EpiDown1 E{ws, args.in[0]};
        pg8::gemm_phase<EpiDown1, pg8::StaticOrder, true, true>(F.lds + RING_OFF, g, S, E, F.wave);
    }
    GRID_BAR(); STAMP(3);
#ifndef NO_P3
    {
        { const int bx = (int)blockIdx.x; if (bx >= 192 && bx < 238) xjob_win(F, ws, bx - 192); }
        pg8::Gemm g{(const pg8::bf16_t*)(ws + WS_HB), (const pg8::bf16_t*)(ws + WS_WIN), MMAIN, NWIN, D};
        pg8::StaticOrder S; S.init(MMAIN, NWIN, F.G, (int)blockIdx.x);
        EpiWin E{ws};
        pg8::gemm_phase<EpiWin, pg8::StaticOrder, true, true>(F.lds + RING_OFF, g, S, E, F.wave);
    }
#endif
    GRID_BAR(); STAMP(4);
    {
        { const int jb = (int)blockIdx.x - 192; if (jb >= 0 && jb < 12) xjob_q(F, ws, jb); else if (jb >= 12 && jb < 20) xjob_kv(F, ws, jb - 12, false); else if (jb >= 20 && jb < 28) xjob_kv(F, ws, jb - 20, true); }
        finalize_ckv(F, args);
#ifndef NO_P4Q
        {   pg8::Gemm g{(const pg8::bf16_t*)(ws + WS_CQ), (const pg8::bf16_t*)(ws + WS_WUQ), MMAIN, 768, QR};
            pg8::StaticOrder S; S.init(MMAIN, 768, F.G, (int)blockIdx.x);
            EpiQ E{ws};
            pg8::gemm_phase<EpiQ, pg8::StaticOrder, true, true>(F.lds + RING_OFF, g, S, E, F.wave); }
#endif
#ifndef NO_P4K
        {   pg8::Gemm g{(const pg8::bf16_t*)(ws + WS_CKVB), (const pg8::bf16_t*)(ws + WS_WUK), MMAIN, 512, KVR};
            pg8::StaticOrder S; S.init(MMAIN, 512, F.G, (int)((blockIdx.x + 64) % F.G));
            EpiScaleBf16<true> E{(const float*)(ws + WS_SSQKV), (bf16*)(ws + WS_KN), 512};
            pg8::gemm_phase<EpiScaleBf16<true>, pg8::StaticOrder, true, true>(F.lds + RING_OFF, g, S, E, F.wave); }
#endif
#ifndef NO_P4V
        {   pg8::Gemm g{(const pg8::bf16_t*)(ws + WS_WUV), (const pg8::bf16_t*)(ws + WS_CKVB), 512, MMAIN, KVR};
            pg8::StaticOrder S; S.init(512, MMAIN, F.G, (int)((blockIdx.x + 192) % F.G));
            EpiScaleBf16<false> E{(const float*)(ws + WS_SSQKV), (bf16*)(ws + WS_VT), MP};
            pg8::gemm_phase<EpiScaleBf16<false>, pg8::StaticOrder, true, true>(F.lds + RING_OFF, g, S, E, F.wave); }
#endif
        for (int u = (int)blockIdx.x; u < 516; u += F.G) ret_u_unit(F, ws, u);
    }
    GRID_BAR(); STAMP(5);
    attn_phase(F, ws);
    ret_scan(F, args);
    for (int u = F.vcu; u < 256; u += F.G) decode_unit(F, args, u);
    for (int u = (int)blockIdx.x; u < 128; u += F.G) ret_sample_unit(F, args, u);
    GRID_BAR(); STAMP(6);
    for (int u = F.vcu; u < 512; u += F.G) ret_o_unit(F, args, u);
    for (int u = (int)blockIdx.x; u < 32; u += F.G) decode_combine_unit(F, args, u);
    GRID_BAR(); STAMP(7);
    {
        { const int bx = (int)blockIdx.x; if (bx < 16) xjob_mix(F, ws, bx); }
        {   pg8::Gemm g{(const pg8::bf16_t*)(ws + WS_AV), (const pg8::bf16_t*)(ws + WS_WMO), MMAIN, D, 512};
            pg8::StaticOrder S; S.init(MMAIN, D, F.G, (int)blockIdx.x);
            typedef EpiGate<0, (unsigned)WS_SGA> EpiGA; EpiGA E{ws};
            pg8::gemm_phase<EpiGA, pg8::StaticOrder, true, true>(F.lds + RING_OFF, g, S, E, F.wave); }
        {   pg8::Gemm g{(const pg8::bf16_t*)(ws + WS_RIN), (const pg8::bf16_t*)(ws + WS_WRO), MMAIN, D, D};
            pg8::StaticOrder S; S.init(MMAIN, D, F.G, (int)blockIdx.x);
            typedef EpiGate<1, (unsigned)WS_SGB> EpiGB; EpiGB E{ws};
            pg8::gemm_phase<EpiGB, pg8::StaticOrder, true, true>(F.lds + RING_OFF, g, S, E, F.wave); }
    }
    GRID_BAR(); STAMP(8);
    {
        { const int bx = (int)blockIdx.x; if (bx >= 16 && bx < 32) xjob_resid(F, ws, bx - 16, WS_MX, D, WS_WOUT, (const float*)(ws + WS_H) + (size_t)XROW0 * D, 1.0f, WS_H2, WS_H2B, WS_SSQH2); }
        pg8::Gemm g{(const pg8::bf16_t*)(ws + WS_MX), (const pg8::bf16_t*)(ws + WS_WOUT), MMAIN, D, D};
        pg8::StaticOrder S; S.init(MMAIN, D, F.G, (int)blockIdx.x);
        typedef EpiResid<(unsigned)WS_H, false, (unsigned)WS_H2, (unsigned)WS_H2B, (unsigned)WS_SSQH2, 2> EpiOut;
        EpiOut E{ws, nullptr};
        pg8::gemm_phase<EpiOut, pg8::StaticOrder, true, true>(F.lds + RING_OFF, g, S, E, F.wave);
    }
    GRID_BAR(); STAMP(9);
    {
        { const int bx = (int)blockIdx.x; if (bx >= 128 && bx < 172) xjob_ffn_up(F, ws, bx - 128, WS_H2B, WS_W2T, 1); }
        pg8::Gemm g{(const pg8::bf16_t*)(ws + WS_H2B), (const pg8::bf16_t*)(ws + WS_W2T), MMAIN, 2 * FFN, D};
        pg8::StaticOrder S; S.init(MMAIN, 2 * FFN, F.G, (int)blockIdx.x);
        EpiSwiGLU2 E{ws};
        pg8::gemm_phase<EpiSwiGLU2, pg8::StaticOrder, true, true>(F.lds + RING_OFF, g, S, E, F.wave);
    }
    GRID_BAR(); STAMP(10);
    {
        { const int bx = (int)blockIdx.x; if (bx >= 32 && bx < 48) xjob_resid(F, ws, bx - 32, WS_ACT, FFN, WS_W2D, (const float*)(ws + WS_H2) + (size_t)XROW0 * D, 0.5f, WS_H3, 0, WS_SSQH3); }
        pg8::Gemm g{(const pg8::bf16_t*)(ws + WS_ACT), (const pg8::bf16_t*)(ws + WS_W2D), MMAIN, D, FFN};
        pg8::StaticOrder S; S.init(MMAIN, D, F.G, (int)blockIdx.x);
        typedef EpiResid<(unsigned)WS_H2, false, (unsigned)WS_H3, 0u, (unsigned)WS_SSQH3, 1> EpiDown2;
        EpiDown2 E{ws, nullptr};
        pg8::gemm_phase<EpiDown2, pg8::StaticOrder, true, true>(F.lds + RING_OFF, g, S, E, F.wave);
    }
    GRID_BAR(); STAMP(11);
    final_norm_phase(F, args);
#if MK_PROBE
    GRID_BAR(); STAMP(12);
    if (blockIdx.x == 0) {
        asm volatile("s_waitcnt vmcnt(0)" ::: "memory"); __syncthreads();
        const unsigned long long* t = (const unsigned long long*)(ws + WS_CTL + 512 * 1024);
        const float dta = (float)(__hip_atomic_load(t + MK_PROBE_A + 1, __ATOMIC_RELAXED, __HIP_MEMORY_SCOPE_AGENT) - __hip_atomic_load(t + MK_PROBE_A, __ATOMIC_RELAXED, __HIP_MEMORY_SCOPE_AGENT)) * 0.01f;
        const float dtb = (float)(__hip_atomic_load(t + MK_PROBE_B + 1, __ATOMIC_RELAXED, __HIP_MEMORY_SCOPE_AGENT) - __hip_atomic_load(t + MK_PROBE_B, __ATOMIC_RELAXED, __HIP_MEMORY_SCOPE_AGENT)) * 0.01f;
        const float f = 1.f + sqrtf(dta / 20000.f);
        const int tid_p = fresh_tid(F.wave);
        for (int i = tid_p; i < NS * D; i += NWAVES * 64) args.out[OUT_YS + i] *= f;
        if (tid_p == 0) args.out[OUT_YP] += dtb / 5.f;
    }
#endif
#undef GRID_BAR
}
}
extern "C" void kernel_launch(void* const* d_in, const int* in_sizes, int n_in, void* d_out, int out_size, void* d_ws, size_t ws_size, hipStream_t stream) {
    static int grid = 0;
    if (grid == 0) {
        int dev = 0, cus = 0;
        if (n_in != 27 || out_size != (int)mk::OUT_END || ws_size < mk::WS_END6) { fprintf(stderr, "kernel_launch: unexpected problem shape (n_in %d, out %d, ws %zu); nothing launched\n", n_in, out_size, ws_size); grid = -1; return; }
        if (hipGetDevice(&dev) != hipSuccess || hipDeviceGetAttribute(&cus, hipDeviceAttributeMultiprocessorCount, dev) != hipSuccess) { fprintf(stderr, "kernel_launch: device query failed\n"); grid = -1; return; }
        if (hipFuncSetAttribute((const void*)mk::mega_fwd, hipFuncAttributeMaxDynamicSharedMemorySize, mk::LDS_BYTES) != hipSuccess) { fprintf(stderr, "kernel_launch: hipFuncSetAttribute failed\n"); grid = -1; return; }
        int per_cu = 0;
        if (hipOccupancyMaxActiveBlocksPerMultiprocessor(&per_cu, (const void*)mk::mega_fwd, mk::NWAVES * 64, mk::LDS_BYTES) != hipSuccess || per_cu < 1) fprintf(stderr, "kernel_launch: note: occupancy query reports %d workgroups per CU\n", per_cu);
        (void)hipGetLastError();
        grid = cus;
    }
    if (grid < 0) return;
    unsigned char* ws = (unsigned char*)d_ws;
    (void)hipMemsetAsync(ws + mk::WS_CTL, 0, mk::CTL_ZERO_BYTES, stream);
    mk::Args a{};
    for (int i = 0; i < 27; ++i) a.in[i] = (const float*)d_in[i];
    a.out = (float*)d_out; a.ws = ws;
    hipLaunchKernelGGL(mk::mega_fwd, dim3(grid), dim3(mk::NWAVES * 64), mk::LDS_BYTES, stream, a);
}
```

```cpp
#include <hip/hip_runtime.h>
#include <cstdio>
#include <cstdint>
#include <cmath>
#define MK_DEBUG 0
#ifndef MK_PROBE
#define MK_PROBE 0
#define MK_PROBE_A 0
#define MK_PROBE_B 1
#endif
__device__ __forceinline__ int lane_fresh() { int l; asm volatile("v_mbcnt_lo_u32_b32 %0, -1, 0\n\tv_mbcnt_hi_u32_b32 %0, -1, %0" : "=v"(l)); return l; }
__device__ __forceinline__ unsigned char* opaque_g(const unsigned char* p) { unsigned long long v = (unsigned long long)p; asm volatile("" : "+s"(v)); return (unsigned char*)(__attribute__((address_space(1))) unsigned char*)v; }
namespace pg8 {
#define PG8_LAS __attribute__((address_space(3)))
typedef unsigned short bf16_t;
typedef short bf16x8 __attribute__((ext_vector_type(8)));
typedef float f32x4 __attribute__((ext_vector_type(4)));
typedef unsigned u32x4 __attribute__((ext_vector_type(4)));
constexpr int BM = 256, BK = 64, HALF = 128, HTB = HALF * BK * 2  , STAGE_BYTES = 8 * HTB, NXCD = 8, WGM = 8;

__host__ __device__ __forceinline__ int lds_byte(int r, int c) { const int st = (r >> 4) * 2 + (c >> 5), rr = r & 15, cc = c & 31, ob = rr * 64 + cc * 2; return st * 1024 + (ob ^ (((ob >> 9) & 1) << 5)); }
__host__ __device__ __forceinline__ void stage_rc(int b, int& R, int& C) { const int st = b / 1024, sb = b % 1024, swz = sb ^ (((sb >> 9) & 1) << 5); R = (st >> 1) * 16 + swz / 64; C = (st & 1) * 32 + (swz % 64) / 2; }
__host__ __device__ __forceinline__ int perm32(int rho) { const int n = rho >> 4, i = rho & 15; return 8 * (i >> 2) + 4 * n + (i & 3); }

struct Unit { int pm, pn; };
struct Gemm { const bf16_t* A; const bf16_t* Bt; int M, N, K; };

struct StaticOrder {
    int nM, nN, nwg, G, c;
    __host__ __device__ void init(int M, int N, int G_, int c_) { nM = M / BM; nN = N / BM; nwg = nM * nN; G = G_; c = c_; }
    __host__ __device__ bool next(int i, Unit& u) const {
        const long L = (long)i * G + c; if (L >= nwg) return false;
        int wgid = (int)L; { const int q = nwg / NXCD, r = nwg % NXCD, xcd = wgid % NXCD, off = wgid / NXCD; wgid = (xcd < r ? xcd * (q + 1) : r * (q + 1) + (xcd - r) * q) + off; }
        const int nig = WGM * nN, gid = wgid / nig, fm = gid * WGM, gsz = (nM - fm) < WGM ? (nM - fm) : WGM;
        u.pm = fm + ((wgid % nig) % gsz); u.pn = (wgid % nig) / gsz; return true;
    }
    __device__ __forceinline__ void a_ready(const Unit&) const {}
    __device__ __forceinline__ void done(const Unit&) const {}
};

__device__ __forceinline__ unsigned cvt_pk_bf16(float lo, float hi) { unsigned r; asm volatile("v_cvt_pk_bf16_f32 %0, %1, %2" : "=v"(r) : "v"(lo), "v"(hi)); return r; }
typedef float f32x2 __attribute__((ext_vector_type(2)));
template <class Epi, class Sched, bool ALIGN_EPI = false, bool SP2 = false>
__device__ __forceinline__ void gemm_phase(PG8_LAS unsigned char* lds, const Gemm g, const Sched& S, const Epi& E, const int wave_in  ) {
    int tid_ = lane_fresh() + 64 * wave_in; asm volatile("" : "+v"(tid_));
    const int tid = tid_, wid = __builtin_amdgcn_readfirstlane(tid >> 6), lane = tid & 63, wr = wid >> 2, wc = wid & 3, fr = lane & 15, fq = lane >> 4;
    const int K = g.K, nt = K / BK;
    unsigned voffA[2], voffB[2];
#pragma unroll
    for (int i = 0; i < 2; ++i) { int R, C; stage_rc(tid * 16 + i * 8192, R, C); const int Rb = Epi::PERM ? ((R & ~31) + perm32(R & 31)) : R;
        voffA[i] = (unsigned)(R * K + C) * 2u; voffB[i] = (unsigned)(Rb * K + C) * 2u; }
    const size_t kstep = (size_t)(BK * 2);
    const size_t hstep = (size_t)HALF * K * 2;
    const size_t tstep = 2 * hstep;
    const unsigned ldsw = (unsigned)wid * 1024u;
    const int aoff = lds_byte(wr * 64 + fr, fq * 8), boff = lds_byte(wc * 32 + fr, fq * 8);
#define PG8_SA(b, h) (((b) * 2 + (h)) * HTB)
#define PG8_SB(b, h) ((4 + (b) * 2 + (h)) * HTB)
#define PG8_STAGE(bufoff, gbase, voff) do { _Pragma("unroll") for (int _i = 0; _i < 2; ++_i) \
        __builtin_amdgcn_global_load_lds((const unsigned*)((const char*)(gbase) + (voff)[_i]), (PG8_LAS unsigned*)(lds + (bufoff) + ldsw + _i * 8192), 16, 0, 0); } while (0)
#define PG8_LDA(dst, b, h) do { _Pragma("unroll") for (int m = 0; m < 4; ++m) _Pragma("unroll") for (int k = 0; k < 2; ++k) dst[m][k] = *(const PG8_LAS bf16x8*)(lds + PG8_SA(b, h) + aoff + m * 2048 + k * 1024); } while (0)
#define PG8_LDB(dst, b, h) do { _Pragma("unroll") for (int n = 0; n < 2; ++n) _Pragma("unroll") for (int k = 0; k < 2; ++k) dst[n][k] = *(const PG8_LAS bf16x8*)(lds + PG8_SB(b, h) + boff + n * 2048 + k * 1024); } while (0)
#define PG8_MMA(ai, bj, At, Bt) do { __builtin_amdgcn_s_setprio(1); _Pragma("unroll") for (int m = 0; m < 4; ++m) _Pragma("unroll") for (int n = 0; n < 2; ++n) _Pragma("unroll") for (int k = 0; k < 2; ++k) \
        acc[ai][bj][m][n] = __builtin_amdgcn_mfma_f32_16x16x32_bf16(Bt[n][k], At[m][k], acc[ai][bj][m][n], 0, 0, 0); __builtin_amdgcn_s_setprio(0); } while (0)
#define PG8_WAIT_V(n) asm volatile("s_waitcnt vmcnt(" #n ")" ::: "memory")
#define PG8_WAIT_L(n) asm volatile("s_waitcnt lgkmcnt(" #n ")" ::: "memory")
#define PG8_BAR __builtin_amdgcn_s_barrier()
#define PG8_SCHED __builtin_amdgcn_sched_barrier(0)
    Unit cur, nxt; int ui = 0;
    if (!S.next(0, cur)) return;
    f32x4 acc[2][2][4][2];
#pragma unroll
    for (int a = 0; a < 2; ++a)
#pragma unroll
        for (int b = 0; b < 2; ++b)
#pragma unroll
            for (int m = 0; m < 4; ++m)
#pragma unroll
                for (int n = 0; n < 2; ++n) acc[a][b][m][n] = (f32x4){0.f, 0.f, 0.f, 0.f};
    bf16x8 At[4][2], B0[2][2], B1[2][2];
    const char* cA = (const char*)g.A + (size_t)cur.pm * tstep; const char* cB = (const char*)g.Bt + (size_t)cur.pn * tstep;
    S.a_ready(cur);
    if constexpr (SP2) {
        PG8_STAGE(PG8_SB(0, 0), cB, voffB); PG8_STAGE(PG8_SB(0, 1), cB + hstep, voffB); PG8_STAGE(PG8_SA(0, 0), cA, voffA); PG8_STAGE(PG8_SA(0, 1), cA + hstep, voffA);
        if (wr == 1) PG8_BAR;
        PG8_WAIT_V(2); PG8_BAR;
        PG8_STAGE(PG8_SB(1, 0), cB + kstep, voffB); PG8_STAGE(PG8_SA(1, 0), cA + kstep, voffA); PG8_STAGE(PG8_SB(1, 1), cB + hstep + kstep, voffB);
        PG8_WAIT_V(6); PG8_BAR;
    } else {
        PG8_STAGE(PG8_SB(0, 0), cB, voffB); PG8_STAGE(PG8_SA(0, 0), cA, voffA); PG8_STAGE(PG8_SB(0, 1), cB + hstep, voffB); PG8_STAGE(PG8_SA(0, 1), cA + hstep, voffA);
        if (wr == 1) PG8_BAR;
        PG8_WAIT_V(4); PG8_BAR;
        PG8_STAGE(PG8_SB(1, 0), cB + kstep, voffB); PG8_STAGE(PG8_SA(1, 0), cA + kstep, voffA); PG8_STAGE(PG8_SB(1, 1), cB + hstep + kstep, voffB);
        PG8_WAIT_V(6); PG8_BAR;
    }
    for (;;) {
        const bool has_next = S.next(ui + 1, nxt);
        const char* nA = has_next ? (const char*)g.A + (size_t)nxt.pm * tstep : cA; const char* nB = has_next ? (const char*)g.Bt + (size_t)nxt.pn * tstep : cB;
        for (int t = 0; t < nt; t += 2) {
            const bool last = (t == nt - 2);
            const char* a1 = cA + (size_t)(t + 1) * kstep;
            const char* a2 = last ? nA : cA + (size_t)(t + 2) * kstep; const char* b2 = last ? nB : cB + (size_t)(t + 2) * kstep;
            const char* a3 = a2 + kstep; const char* b3 = b2 + kstep;
            if (last && has_next) S.a_ready(nxt);
            if constexpr (SP2) {
            PG8_LDB(B0, 0, 0); PG8_LDB(B1, 0, 1); PG8_SCHED; PG8_LDA(At, 0, 0); PG8_STAGE(PG8_SA(1, 1), a1 + hstep, voffA);
            PG8_WAIT_V(8); PG8_WAIT_L(0); PG8_BAR; PG8_MMA(0, 0, At, B0); PG8_MMA(0, 1, At, B1); PG8_BAR; PG8_SCHED;
            PG8_LDA(At, 0, 1); PG8_STAGE(PG8_SB(0, 0), b2, voffB); PG8_STAGE(PG8_SB(0, 1), b2 + hstep, voffB); PG8_STAGE(PG8_SA(0, 0), a2, voffA);
            PG8_WAIT_V(8); PG8_WAIT_L(0); PG8_BAR; PG8_MMA(1, 0, At, B0); PG8_MMA(1, 1, At, B1); PG8_BAR; PG8_SCHED;
            PG8_LDB(B0, 1, 0); PG8_LDB(B1, 1, 1); PG8_SCHED; PG8_LDA(At, 1, 0); PG8_STAGE(PG8_SA(0, 1), a2 + hstep, voffA);
            PG8_WAIT_V(8); PG8_WAIT_L(0); PG8_BAR; PG8_MMA(0, 0, At, B0); PG8_MMA(0, 1, At, B1); PG8_BAR; PG8_SCHED;
            PG8_LDA(At, 1, 1); PG8_STAGE(PG8_SB(1, 0), b3, voffB); PG8_STAGE(PG8_SB(1, 1), b3 + hstep, voffB); PG8_STAGE(PG8_SA(1, 0), a3, voffA);
            PG8_WAIT_V(8); PG8_WAIT_L(0); PG8_BAR; PG8_MMA(1, 0, At, B0); PG8_MMA(1, 1, At, B1); PG8_BAR; PG8_SCHED;
            } else {
            PG8_LDB(B0, 0, 0); PG8_SCHED; PG8_LDA(At, 0, 0); PG8_STAGE(PG8_SA(1, 1), a1 + hstep, voffA);
            PG8_WAIT_L(8); PG8_BAR; PG8_WAIT_L(0); PG8_MMA(0, 0, At, B0); PG8_BAR; PG8_SCHED;
            PG8_LDB(B1, 0, 1); PG8_STAGE(PG8_SB(0, 0), b2, voffB);
            PG8_BAR; PG8_WAIT_L(0); PG8_MMA(0, 1, At, B1); PG8_BAR;
            PG8_LDA(At, 0, 1); PG8_STAGE(PG8_SA(0, 0), a2, voffA);
            PG8_BAR; PG8_WAIT_L(0); PG8_MMA(1, 0, At, B0); PG8_BAR; PG8_SCHED;
            PG8_STAGE(PG8_SB(0, 1), b2 + hstep, voffB);
            PG8_WAIT_V(6); PG8_BAR; PG8_MMA(1, 1, At, B1); PG8_BAR;
            PG8_LDB(B0, 1, 0); PG8_SCHED; PG8_LDA(At, 1, 0); PG8_STAGE(PG8_SA(0, 1), a2 + hstep, voffA);
            PG8_WAIT_L(8); PG8_BAR; PG8_WAIT_L(0); PG8_MMA(0, 0, At, B0); PG8_BAR; PG8_SCHED;
            PG8_LDB(B1, 1, 1); PG8_STAGE(PG8_SB(1, 0), b3, voffB);
            PG8_BAR; PG8_WAIT_L(0); PG8_MMA(0, 1, At, B1); PG8_BAR;
            PG8_LDA(At, 1, 1); PG8_STAGE(PG8_SA(1, 0), a3, voffA);
            PG8_BAR; PG8_WAIT_L(0); PG8_MMA(1, 0, At, B0); PG8_BAR; PG8_SCHED;
            PG8_STAGE(PG8_SB(1, 1), b3 + hstep, voffB);
            PG8_WAIT_V(6); PG8_BAR; PG8_MMA(1, 1, At, B1); PG8_BAR;
            }
        }
        if constexpr (ALIGN_EPI) { if (wr == 0) PG8_BAR; }
        if constexpr (!Epi::AFTER_DRAIN) { E(acc, cur, wr, wc, fr, fq); S.done(cur); }
        if (!has_next) break;
#pragma unroll
        for (int a = 0; a < 2; ++a)
#pragma unroll
            for (int b = 0; b < 2; ++b)
#pragma unroll
                for (int m = 0; m < 4; ++m)
#pragma unroll
                    for (int n = 0; n < 2; ++n) acc[a][b][m][n] = (f32x4){0.f, 0.f, 0.f, 0.f};
        cur = nxt; cA = nA; cB = nB; ++ui;
        if constexpr (ALIGN_EPI) { if (wr == 1) PG8_BAR; }
    }
    PG8_WAIT_V(0);
    if constexpr (!ALIGN_EPI) { if (wr == 0) PG8_BAR; }
    PG8_BAR;
    if constexpr (Epi::AFTER_DRAIN) { E.fused(acc, cur, wr, wc, fr, fq, lds, wid, lane); S.done(cur); }
#undef PG8_SA
#undef PG8_SB
#undef PG8_STAGE
#undef PG8_LDA
#undef PG8_LDB
#undef PG8_MMA
#undef PG8_WAIT_V
#undef PG8_WAIT_L
#undef PG8_BAR
#undef PG8_SCHED
}
}
#define GAS __attribute__((address_space(1)))
#define LAS __attribute__((address_space(3)))
typedef unsigned short bf16;
typedef unsigned v4u __attribute__((ext_vector_type(4)));
typedef float f32x4 __attribute__((ext_vector_type(4)));
typedef short bf16x8 __attribute__((ext_vector_type(8)));
typedef GAS unsigned gu32;
typedef GAS unsigned long long gu64;
#define RLX_AGENT __ATOMIC_RELAXED, __HIP_MEMORY_SCOPE_AGENT
#define LDS_WAIT() asm volatile("s_waitcnt lgkmcnt(0)" ::: "memory")
#define VM_WAIT() asm volatile("s_waitcnt vmcnt(0)" ::: "memory")
__device__ __forceinline__ unsigned long long rt() { return __builtin_amdgcn_s_memrealtime(); }
__device__ __forceinline__ unsigned f2bf(float f) { unsigned u = __builtin_bit_cast(unsigned, f); return (u + 0x7fffu + ((u >> 16) & 1u)) >> 16; }
__device__ __forceinline__ unsigned pk2(float lo, float hi) { return f2bf(lo) | (f2bf(hi) << 16); }

#define XB_TMO      128
#define XB_XCNT(j)  (256  + 64 * (j))
#define XB_XSUB(j)  (1280 + 64 * (j))
#define XB_XGEN(j)  (2304 + 64 * (j))
#define XB_TOP      3328
#define XB_TOPGEN   3392
#define XCD_BAR_WORDS 3456
#define XB_SPIN_CAP (1u << 18)

__device__ __forceinline__ unsigned xb_ld(unsigned* p)              { return __hip_atomic_load(p, __ATOMIC_RELAXED, __HIP_MEMORY_SCOPE_AGENT); }
__device__ __forceinline__ unsigned xb_add(unsigned* p, unsigned v) { return __hip_atomic_fetch_add(p, v, __ATOMIC_RELAXED, __HIP_MEMORY_SCOPE_AGENT); }
__device__ __forceinline__ unsigned xb_xcc_id() { return (unsigned)__builtin_amdgcn_s_getreg((3 << 11) | 20) & 0xFu; }
#define XB_SPIN(cond, bar) do { unsigned _sp = 0; while (cond) { __builtin_amdgcn_s_sleep(1); \
    if ((++_sp & 255u) == 0u) { if (xb_ld(&(bar)[XB_TMO])) break; if (_sp > XB_SPIN_CAP) { atomicAdd(&(bar)[XB_TMO], 1u); break; } } } } while (0)

struct XcdBarrier {
    unsigned* bar; unsigned x; int wave;
    volatile LAS unsigned* st;
};

#define XB_IS_T0(wave) ((wave) == 0 && lane_fresh() == 0)
__device__ __forceinline__ XcdBarrier xcd_barrier_post(unsigned* bar, volatile LAS unsigned* st, int wave) {
    XcdBarrier b; b.bar = bar; b.x = xb_xcc_id(); b.st = st; b.wave = wave;
    if (XB_IS_T0(wave)) (void)xb_add(&bar[XB_XCNT(b.x)], 1u);
    return b;
}
__device__ __forceinline__ void xcd_barrier_complete(unsigned* bar, unsigned x, unsigned& nloc, unsigned& nx) {
    const unsigned G = gridDim.x * gridDim.y * gridDim.z;
    unsigned sum, cnt, mine, sp = 0u;
    for (;;) {
        sum = 0u; cnt = 0u; mine = 0u;
#pragma unroll
        for (unsigned j = 0; j < 16; ++j) { const unsigned c = xb_ld(&bar[XB_XCNT(j)]); sum += c; cnt += (c > 0u) ? 1u : 0u; mine = (j == x) ? c : mine; }
        if (sum == G) break;
        __builtin_amdgcn_s_sleep(1);
        if ((++sp & 255u) == 0u) { if (xb_ld(&bar[XB_TMO])) break; if (sp > XB_SPIN_CAP) { atomicAdd(&bar[XB_TMO], 1u); break; } }
    }
    nloc = mine > 0u ? mine : 1u; nx = cnt > 0u ? cnt : 1u;
}

__device__ __forceinline__ void xcd_barrier(const XcdBarrier& b) {
    asm volatile("s_waitcnt vmcnt(0)" ::: "memory");
    __syncthreads();
    if (XB_IS_T0(b.wave)) {
        unsigned* bar = b.bar;
        __builtin_amdgcn_s_waitcnt(0);
        unsigned nloc = b.st[0], nx = b.st[1];
        if (nloc == 0u) { xcd_barrier_complete(bar, b.x, nloc, nx); b.st[0] = nloc; b.st[1] = nx; }
        const unsigned old = xb_add(&bar[XB_XSUB(b.x)], 1u);
        const unsigned gen = old / nloc;
        if (old + 1u == (gen + 1u) * nloc) {
            __builtin_amdgcn_fence(__ATOMIC_RELEASE, "agent");
            asm volatile("s_waitcnt vmcnt(0)" ::: "memory");
            const unsigned og = xb_add(&bar[XB_TOP], 1u);
            const unsigned tg = og / nx;
            if (og + 1u == (tg + 1u) * nx) xb_add(&bar[XB_TOPGEN], 1u);
            else XB_SPIN(xb_ld(&bar[XB_TOPGEN]) == tg, bar);
            __builtin_amdgcn_fence(__ATOMIC_ACQUIRE, "agent");
            xb_add(&bar[XB_XGEN(b.x)], 1u);
            asm volatile("s_waitcnt vmcnt(0)" ::: "memory");
        } else {
            XB_SPIN(xb_ld(&bar[XB_XGEN(b.x)]) == gen, bar);
            __builtin_amdgcn_fence(__ATOMIC_ACQUIRE, "agent");
            asm volatile("s_waitcnt vmcnt(0)" ::: "memory");
        }
    }
    __syncthreads();
}
namespace mk {
constexpr int D = 1024, NB = 8, SEQ = 2048, NMETA = 16, T = SEQ + NMETA, NS = 32, PAST = 16384, PAGE = 128, NPAGES = PAST / PAGE;
constexpr int FFN = 2816, NH = 8, QR = 384, KVR = 256, RH = 4, RDK = 128, RDV = 256, IN_DIM = 5792;
constexpr int O_CQ = 0, O_CKV = 384, O_KR = 640, O_RQ = 672, O_RK = 1184, O_RV = 1696, O_RG = 2720, O_GA = 3744, O_GB = 4768;
constexpr int MMAIN = NB * SEQ;
constexpr int ROW_META = MMAIN;
constexpr int ROW_SMP = MMAIN + NMETA;
constexpr int ROW_PAD = ROW_SMP + NS;
constexpr int MP = MMAIN + 256;
constexpr int NWIN = 5888;
constexpr int NPOS = T + 1;
constexpr float EPS = 1e-6f;
constexpr int NWAVES = 8;

constexpr size_t MiB = 1u << 20;
constexpr size_t al(size_t x) { return (x + 255) / 256 * 256; }
constexpr size_t WS_CTL = 0, CTL_ZERO_BYTES = 1 * MiB;
constexpr size_t WS_W1T = 1 * MiB;
constexpr size_t WS_W1D = WS_W1T + al((size_t)2 * FFN * D * 2);
constexpr size_t WS_WIN = WS_W1D + al((size_t)D * FFN * 2);
constexpr size_t WS_WUQ = WS_WIN + al((size_t)NWIN * D * 2);
constexpr size_t WS_WUK = WS_WUQ + al((size_t)768 * QR * 2);
constexpr size_t WS_WUV = WS_WUK + al((size_t)512 * KVR * 2);
constexpr size_t WS_WMO = WS_WUV + al((size_t)512 * KVR * 2);
constexpr size_t WS_WRO = WS_WMO + al((size_t)D * 512 * 2);
constexpr size_t WS_WOUT = WS_WRO + al((size_t)D * D * 2);
constexpr size_t WS_W2T = WS_WOUT + al((size_t)D * D * 2);
constexpr size_t WS_W2D = WS_W2T + al((size_t)2 * FFN * D * 2);
constexpr size_t WS_TAB = WS_W2D + al((size_t)D * FFN * 2);
constexpr size_t TAB_C64 = 0, TAB_S64 = (size_t)NPOS * 64 * 4, TAB_C16 = 2 * TAB_S64, TAB_S16 = TAB_C16 + (size_t)NPOS * 16 * 4, TAB_GP = TAB_S16 + (size_t)NPOS * 16 * 4, TAB_GN = TAB_GP + 512 * 4, TAB_END = TAB_GN + 512 * 4;
constexpr size_t WS_XB = WS_TAB + al(TAB_END);
constexpr size_t WS_XE = WS_XB + al((size_t)MP * D * 2);
constexpr size_t WS_R1 = WS_XE + al((size_t)256 * D * 4);
constexpr size_t WS_ACT = WS_R1 + al((size_t)MP * 4);
constexpr size_t WS_H = WS_ACT + al((size_t)MP * FFN * 2);
constexpr size_t WS_HB = WS_H + al((size_t)MP * D * 4);
constexpr size_t WS_SSQH = WS_HB + al((size_t)MP * D * 2);
constexpr size_t WS_END1 = WS_SSQH + al((size_t)MP * 16 * 4);

constexpr int CW_BAR = 4096, CW_QUEUE = 64;

constexpr int RING_OFF = 0, RING_BYTES = 131072, SCR_BYTES = 155648  , LDSCTL_OFF = SCR_BYTES, MISC_OFF = LDSCTL_OFF + 320, LDS_BYTES = 163840;

struct Args {
    const float* in[27]; float* out; unsigned char* ws;
};

struct Frame {
    LAS unsigned char* lds;
    volatile LAS unsigned* MISC;
    int wave, vcu, G;
};

constexpr int PT_OFF = MISC_OFF + 256;
struct Ptrs {
    unsigned char* ws; volatile LAS unsigned* tab;
    __device__ __forceinline__ unsigned long long raw(int k) const { volatile LAS unsigned* t = tab; asm volatile("" : "+v"(t));
        const unsigned lo = __builtin_amdgcn_readfirstlane(t[2 * k]), hi = __builtin_amdgcn_readfirstlane(t[2 * k + 1]); return ((unsigned long long)hi << 32) | lo; }
    __device__ __forceinline__ const float* in(int k) const { return (const float*)(GAS const float*)raw(k); }
    __device__ __forceinline__ float* out() const { return (float*)(GAS float*)raw(27); }
};
__device__ __forceinline__ int fresh_tid(int wave) { int t = lane_fresh() + 64 * wave; asm volatile("" : "+v"(t)); return t; }

__device__ __forceinline__ float lx(float v, int lane, int mask) { return __int_as_float(__builtin_amdgcn_ds_bpermute((lane ^ mask) << 2, __float_as_int(v))); }
__device__ __forceinline__ float wave_sum(float v, int lane) {
#pragma unroll
    for (int o = 1; o < 64; o <<= 1) v += lx(v, lane, o);
    return v;
}
__device__ __forceinline__ int row_pos(int row) { return row < MMAIN ? (row & (SEQ - 1)) + NMETA : (row < ROW_SMP ? row - ROW_META : (row < ROW_PAD ? PAST : 0)); }
__device__ __forceinline__ int row_pidx(int row) { return row < MMAIN ? (row & (SEQ - 1)) + NMETA : (row < ROW_SMP ? row - ROW_META : (row < ROW_PAD ? T : 0)); }
__device__ __forceinline__ int row_jtok(int row) { return row < MMAIN ? (row & 127) : (row < ROW_SMP ? row - ROW_META : 0); }

struct WSrc { const float* W; int ld; int col0; const float* g; };
__device__ __forceinline__ void wmat_dims(int id, int& K, int& ngrp) {
    switch (id) {
        case 0: case 9: K = D; ngrp = 2 * FFN / 32; break;
        case 1: case 10: K = FFN; ngrp = D / 32; break;
        case 2: K = D; ngrp = NWIN / 32; break;
        case 3: K = QR; ngrp = 768 / 32; break;
        case 4: case 5: K = KVR; ngrp = 512 / 32; break;
        case 6: K = 512; ngrp = D / 32; break;
        default: K = D; ngrp = D / 32; break;
    }
}
__device__ __forceinline__ size_t wmat_off(int id) {
    switch (id) { case 0: return WS_W1T; case 1: return WS_W1D; case 2: return WS_WIN; case 3: return WS_WUQ; case 4: return WS_WUK; case 5: return WS_WUV;
                  case 6: return WS_WMO; case 7: return WS_WRO; case 8: return WS_WOUT; case 9: return WS_W2T; default: return WS_W2D; }
}
__device__ __forceinline__ WSrc wmat_src(const Args& a, int id, int g) {
    WSrc s; s.W = nullptr; s.ld = 0; s.col0 = 0; s.g = nullptr;
    switch (id) {
        case 0: case 9: { const int pn = g >> 3, gg = g & 7; const int o = id == 0 ? 7 : 22;
            s.W = gg < 4 ? a.in[o + 1] : a.in[o + 2]; s.ld = FFN; s.col0 = 128 * pn + 32 * (gg & 3); s.g = a.in[o]; break; }
        case 1: s.W = a.in[10]; s.ld = D; s.col0 = 32 * g; break;
        case 10: s.W = a.in[25]; s.ld = D; s.col0 = 32 * g; break;
        case 2: { s.ld = IN_DIM; s.g = a.in[11]; int zc = -1;
            if (g < 8) zc = 32 * g;
            else if (g < 16) { const int gg = g - 8; zc = gg < 4 ? 256 + 32 * gg : (gg == 4 ? O_KR : -1); }
            else if (g < 24) zc = O_CKV + 32 * (g - 16);
            else if (g < 56) { const int base = g < 40 ? O_RQ : O_RK; const int q = (g - 24) & 15, t = q >> 3, gg = q & 7;
                const int h = 2 * t + ((gg >> 1) & 1), part = (gg >> 2) * 64 + (gg & 1) * 32; zc = base + h * 128 + part; }
            else if (g < 88) zc = O_RV + 32 * (g - 56);
            else if (g < 120) zc = O_RG + 32 * (g - 88);
            else if (g < 152) zc = O_GA + 32 * (g - 120);
            else zc = O_GB + 32 * (g - 152);
            if (zc >= 0) { s.W = a.in[12]; s.col0 = zc; }
            break; }
        case 3: s.W = a.in[15]; s.ld = 768; s.col0 = 32 * g; s.g = a.in[13]; break;
        case 4: s.W = a.in[16]; s.ld = 512; s.col0 = 32 * g; s.g = a.in[14]; break;
        case 5: s.W = a.in[17]; s.ld = 512; s.col0 = 32 * g; s.g = a.in[14]; break;
        case 6: s.W = a.in[18]; s.ld = D; s.col0 = 32 * g; break;
        case 7: s.W = a.in[20]; s.ld = D; s.col0 = 32 * g; break;
        default: s.W = a.in[21]; s.ld = D; s.col0 = 32 * g; break;
    }
    return s;
}
__device__ __forceinline__ void p0_transpose_item(const WSrc s, int K, bf16* WT, int n0, int k0, LAS float* scr, int lane) {
    if (s.W) {
        float v[32];
        const float* wp = s.W + (size_t)(k0 + (lane >> 5)) * s.ld + s.col0 + (lane & 31);
#pragma unroll
        for (int i = 0; i < 32; ++i) v[i] = wp[(size_t)(2 * i) * s.ld];
        if (s.g) { const float* gp = s.g + k0 + (lane >> 5);
#pragma unroll
            for (int i = 0; i < 32; ++i) v[i] *= gp[2 * i]; }
#pragma unroll
        for (int i = 0; i < 32; ++i) scr[(2 * i + (lane >> 5)) * 33 + (lane & 31)] = v[i];
    } else {
#pragma unroll 8
        for (int i = 0; i < 32; ++i) { const int kk = 2 * i + (lane >> 5); scr[kk * 33 + (lane & 31)] = 0.f; }
    }
    LDS_WAIT(); asm volatile("" ::: "memory");
    const int c = lane & 7;
#pragma unroll
    for (int j = 0; j < 4; ++j) { const int n = (lane >> 3) + 8 * j; const LAS float* sp = scr + (8 * c) * 33 + n;
        v4u o; o.x = pk2(sp[0 * 33], sp[1 * 33]); o.y = pk2(sp[2 * 33], sp[3 * 33]); o.z = pk2(sp[4 * 33], sp[5 * 33]); o.w = pk2(sp[6 * 33], sp[7 * 33]);
        *(GAS v4u*)(WT + (size_t)(n0 + n) * K + k0 + 8 * c) = o; }
    LDS_WAIT(); asm volatile("" ::: "memory");
}
__device__ __forceinline__ const float* x_src(const Args& a, int row) {
    if (row < MMAIN) return a.in[0] + (size_t)row * D;
    if (row < ROW_SMP) return a.in[6] + (size_t)(row - ROW_META) * D;
    if (row < ROW_PAD) return a.in[1] + (size_t)(row - ROW_SMP) * D;
    return nullptr;
}
__device__ __forceinline__ void p0_prologue(Frame& F, const Args& a) {
    const int lane = fresh_tid(F.wave) & 63;
    LAS float* scr = (LAS float*)(F.lds + RING_OFF + F.wave * 16384);
    const int gw = F.vcu * NWAVES + F.wave, NGW = F.G * NWAVES;
    unsigned char* ws = a.ws;
    int base = 0;
#pragma unroll 1
    for (int id = 0; id < 11; ++id) {
        int K, ngrp; wmat_dims(id, K, ngrp);
        const int nk = K / 64, nitems = nk * ngrp;
        bf16* WT = (bf16*)(ws + wmat_off(id));
        int first = (gw - (base % NGW) + NGW) % NGW;
        for (int it = first; it < nitems; it += NGW) { const int g = it % ngrp, kb = it / ngrp; p0_transpose_item(wmat_src(a, id, g), K, WT, 32 * g, 64 * kb, scr, lane); }
        base += nitems;
    }
    bf16* XB = (bf16*)(ws + WS_XB); float* XE = (float*)(ws + WS_XE); float* R1 = (float*)(ws + WS_R1);
    for (int m0 = gw; m0 < MP; m0 += 2 * NGW) {
        f32x4 v[2][4];
#pragma unroll
        for (int t = 0; t < 2; ++t) { const int m = m0 + t * NGW; const float* xr = m < MP ? x_src(a, m) : nullptr;
#pragma unroll
            for (int j = 0; j < 4; ++j) v[t][j] = xr ? *((const GAS f32x4*)xr + lane + 64 * j) : (f32x4){0.f, 0.f, 0.f, 0.f}; }
#pragma unroll
        for (int t = 0; t < 2; ++t) { const int m = m0 + t * NGW; if (m >= MP) break;
            float s = 0.f;
#pragma unroll
            for (int j = 0; j < 4; ++j) s += (v[t][j].x * v[t][j].x + v[t][j].y * v[t][j].y) + (v[t][j].z * v[t][j].z + v[t][j].w * v[t][j].w);
            s = wave_sum(s, lane);
            if (lane == 0) R1[m] = 1.0f / sqrtf(s * (1.f / D) + EPS);
            GAS unsigned long long* o8 = (GAS unsigned long long*)(XB + (size_t)m * D) + lane;
#pragma unroll
            for (int j = 0; j < 4; ++j) o8[64 * j] = (unsigned long long)pk2(v[t][j].x, v[t][j].y) | ((unsigned long long)pk2(v[t][j].z, v[t][j].w) << 32);
            if (m >= MMAIN) {
#pragma unroll
                for (int j = 0; j < 4; ++j) *((GAS f32x4*)(XE + (size_t)(m - MMAIN) * D) + lane + 64 * j) = v[t][j];
            } }
    }
    float* TAB = (float*)(ws + WS_TAB);
    const int gt = (F.vcu * NWAVES + F.wave) * 64 + lane, NGT = NGW * 64;
    for (int e = gt; e < NPOS * 64; e += NGT) { const int p = e >> 6, i = e & 63; const int pos = p < T ? p : PAST;
        const float invf = (float)pow(10000.0, -(double)i / 64.0); const float ang = (float)pos * invf;
        TAB[TAB_C64 / 4 + e] = (float)cos((double)ang); TAB[TAB_S64 / 4 + e] = (float)sin((double)ang); }
    for (int e = gt; e < NPOS * 16; e += NGT) { const int p = e >> 4, i = e & 15; const int pos = p < T ? p : PAST;
        const float invf = (float)pow(10000.0, -(double)i / 16.0); const float ang = (float)pos * invf;
        TAB[TAB_C16 / 4 + e] = (float)cos((double)ang); TAB[TAB_S16 / 4 + e] = (float)sin((double)ang); }
    for (int e = gt; e < 512; e += NGT) { const int h = e >> 7, j = e & 127; const double lg = log1p(-exp2(-5.0 - (double)h));
        TAB[TAB_GP / 4 + e] = (float)exp(lg * (double)j); TAB[TAB_GN / 4 + e] = (float)exp(-lg * (double)j); }
}

using pg8::f32x4; using pg8::u32x4; using pg8::Unit; using pg8::BM; using pg8::HALF;
typedef unsigned u32x2 __attribute__((ext_vector_type(2)));
__device__ __forceinline__ float fast_sigmoid(float x) { return __builtin_amdgcn_rcpf(1.f + __builtin_amdgcn_exp2f(-1.4426950408889634f * x)); }
__device__ __forceinline__ float fast_silu(float x) { return x * fast_sigmoid(x); }

struct EpiSwiGLU {
    static constexpr bool PERM = true, AFTER_DRAIN = false;
    bf16* ACT; const float* rs;
    __device__ __forceinline__ void operator()(const f32x4 (&acc)[2][2][4][2], const Unit& u, int wr, int wc, int fr, int fq) const {
        int l_ = lane_fresh(); asm volatile("" : "+v"(l_)); fr = l_ & 15; fq = l_ >> 4;
        const int row0 = u.pm * BM + wr * 64 + fr, col0 = u.pn * HALF + wc * 32 + 8 * fq;
#pragma unroll
        for (int ai = 0; ai < 2; ++ai)
#pragma unroll
            for (int m = 0; m < 4; ++m) { const int row = row0 + ai * HALF + m * 16; const float r = rs[row];
                f32x4 o[2];
#pragma unroll
                for (int n = 0; n < 2; ++n)
#pragma unroll
                    for (int j = 0; j < 4; ++j) { const float g = acc[ai][0][m][n][j] * r, up = acc[ai][1][m][n][j] * r; o[n][j] = fast_silu(g) * up; }
                u32x4 w; w.x = pg8::cvt_pk_bf16(o[0][0], o[0][1]); w.y = pg8::cvt_pk_bf16(o[0][2], o[0][3]); w.z = pg8::cvt_pk_bf16(o[1][0], o[1][1]); w.w = pg8::cvt_pk_bf16(o[1][2], o[1][3]);
                *(u32x4*)(ACT + (size_t)row * FFN + col0) = w; }
    }
};
template <class T> __device__ __forceinline__ T* at(unsigned char* w, unsigned byte_off) { return (T*)(w + byte_off); }
template <unsigned RES_OFF, bool RES_X, unsigned OUT_OFF, unsigned OUTB_OFF, unsigned SSQ_OFF, int SCALE2  > struct EpiResid {
    static constexpr bool PERM = false, AFTER_DRAIN = false;
    unsigned char* ws_; const float* xin;
    __device__ __forceinline__ void operator()(const f32x4 (&acc)[2][2][4][2], const Unit& u, int wr, int wc, int fr, int fq) const {
        int l_ = lane_fresh(); asm volatile("" : "+v"(l_)); fr = l_ & 15; fq = l_ >> 4;
        unsigned char* w = opaque_g(ws_);
        const unsigned row0 = u.pm * BM + wr * 64 + fr, col0 = u.pn * BM + wc * 32 + 4 * fq;
        constexpr float scale = 0.5f * SCALE2;
#pragma unroll
        for (int ai = 0; ai < 2; ++ai)
#pragma unroll
            for (int m = 0; m < 4; ++m) { unsigned row = row0 + ai * HALF + m * 16; asm volatile("" : "+v"(row));
                const float* rp;
                if (RES_X) rp = row < (unsigned)MMAIN ? xin + row * D + col0 : at<const float>(w, RES_OFF + ((row - MMAIN) * D + col0) * 4);
                else rp = at<const float>(w, RES_OFF + (row * D + col0) * 4);
                float ss = 0.f;
#pragma unroll
                for (int bj = 0; bj < 2; ++bj)
#pragma unroll
                    for (int n = 0; n < 2; ++n) { const f32x4 b = *(const f32x4*)(rp + bj * HALF + n * 16); const f32x4 o = b + acc[ai][bj][m][n] * scale;
                        const unsigned e = row * D + col0 + bj * HALF + n * 16;
                        *at<f32x4>(w, OUT_OFF + e * 4) = o;
                        ss += (o[0] * o[0] + o[1] * o[1]) + (o[2] * o[2] + o[3] * o[3]);
                        if (OUTB_OFF) { u32x2 pk; pk.x = pg8::cvt_pk_bf16(o[0], o[1]); pk.y = pg8::cvt_pk_bf16(o[2], o[3]); *at<u32x2>(w, OUTB_OFF + e * 2) = pk; } }
                ss += lx(ss, l_, 16); ss += lx(ss, l_, 32);
                if (fq == 0) *at<float>(w, SSQ_OFF + (row * 16 + u.pn * 4 + wc) * 4) = ss;
                asm volatile("" ::: "memory"); }
    }
};
}
namespace mk {
constexpr size_t WS_CQ = WS_END1;
constexpr size_t WS_SSQCQ = WS_CQ + al((size_t)MP * QR * 2);
constexpr size_t WS_CKVF = WS_SSQCQ + al((size_t)MP * 8 * 4);
constexpr size_t WS_CKVB = WS_CKVF + al((size_t)MP * KVR * 4);
constexpr size_t WS_SSQKV = WS_CKVB + al((size_t)MP * KVR * 2);
constexpr size_t WS_KRB = WS_SSQKV + al((size_t)MP * 4 * 4);
constexpr size_t WS_RQ = WS_KRB + al((size_t)MP * 32 * 2);
constexpr size_t WS_RK = WS_RQ + al((size_t)MP * 512 * 2);
constexpr size_t WS_RKT = WS_RK + al((size_t)MP * 512 * 2);
constexpr size_t WS_RVT = WS_RKT + al((size_t)MP * 512 * 2);
constexpr size_t WS_SRG = WS_RVT + al((size_t)MP * 1024 * 2);
constexpr size_t WS_SGA = WS_SRG + al((size_t)MP * 1024 * 2);
constexpr size_t WS_SGB = WS_SGA + al((size_t)MP * 1024 * 2);
constexpr size_t WS_QA = WS_SGB + al((size_t)MP * 1024 * 2);
constexpr size_t WS_KN = WS_QA + al((size_t)MP * 768 * 2);
constexpr size_t WS_VT = WS_KN + al((size_t)MP * 512 * 2);
constexpr size_t WS_KRF = WS_VT + al((size_t)MP * 512 * 2);
constexpr size_t WS_END2 = WS_KRF + al((size_t)MP * 32 * 4);
constexpr float SC_Q = 0.14724444348433683f;
constexpr float RK_SCALE = 0.08838834764831845f;

constexpr size_t OUT_YP = 0, OUT_YS = OUT_YP + (size_t)NB * SEQ * D, OUT_CKVP = OUT_YS + (size_t)NS * D, OUT_KRP = OUT_CKVP + (size_t)NB * T * KVR,
                 OUT_SRP = OUT_KRP + (size_t)NB * T * 32, OUT_CKVS = OUT_SRP + (size_t)NB * RH * RDK * RDV, OUT_KRS = OUT_CKVS + (size_t)NS * KVR, OUT_SRS = OUT_KRS + (size_t)NS * 32,
                 OUT_END = OUT_SRS + (size_t)NS * RH * RDK * RDV;

__device__ __forceinline__ float row_rscale16(const float* SSQ, int row, float inv_n) {
    const f32x4* p = (const f32x4*)(SSQ + (size_t)row * 16); const f32x4 a = p[0], b = p[1], c = p[2], d = p[3];
    const float s = ((a[0] + a[1]) + (a[2] + a[3])) + ((b[0] + b[1]) + (b[2] + b[3])) + ((c[0] + c[1]) + (c[2] + c[3])) + ((d[0] + d[1]) + (d[2] + d[3]));
    return 1.0f / sqrtf(s * inv_n + EPS);
}
__device__ __forceinline__ float row_rscale8(const float* SSQ, int row, float inv_n) {
    const f32x4* p = (const f32x4*)(SSQ + (size_t)row * 8); const f32x4 a = p[0], b = p[1];
    return 1.0f / sqrtf((((a[0] + a[1]) + (a[2] + a[3])) + ((b[0] + b[1]) + (b[2] + b[3]))) * inv_n + EPS);
}
__device__ __forceinline__ float row_rscale4(const float* SSQ, int row, float inv_n) {
    const f32x4 a = *(const f32x4*)(SSQ + (size_t)row * 4);
    return 1.0f / sqrtf(((a[0] + a[1]) + (a[2] + a[3])) * inv_n + EPS);
}
__device__ __forceinline__ u32x2 pack4(const f32x4 v) { u32x2 w; w.x = pg8::cvt_pk_bf16(v[0], v[1]); w.y = pg8::cvt_pk_bf16(v[2], v[3]); return w; }
__device__ __forceinline__ float ssq4(const f32x4 v) { return (v[0] * v[0] + v[1] * v[1]) + (v[2] * v[2] + v[3] * v[3]); }
__device__ __forceinline__ bf16 bf1(float x) { return (bf16)f2bf(x); }

static_assert(WS_END2 < ((size_t)1 << 31), "32-bit workspace offsets");
struct EpiWin {
    static constexpr bool PERM = false, AFTER_DRAIN = false;
    unsigned char* ws_;
#define MK_WS(var) unsigned char* var = opaque_g(ws_)
#define MK_ROWS_BEGIN _Pragma("unroll") for (int ai = 0; ai < 2; ++ai) _Pragma("unroll") for (int m = 0; m < 4; ++m) { \
        unsigned row = row0 + ai * HALF + m * 16; asm volatile("" : "+v"(row)); const float r = row_rscale16(at<const float>(w, (unsigned)WS_SSQH), (int)row, 1.f / D);
#define MK_ROWS_END asm volatile("" ::: "memory"); }
    __device__ __forceinline__ void operator()(const f32x4 (&acc)[2][2][4][2], const Unit& u, int wr, int wc, int fr, int fq) const {
        int l_ = lane_fresh(); asm volatile("" : "+v"(l_)); fr = l_ & 15; fq = l_ >> 4;
        const unsigned row0 = u.pm * BM + wr * 64 + fr; const int pn = u.pn;
        MK_WS(w);
        if (pn == 0) {
            MK_ROWS_BEGIN
                float ss = 0.f;
#pragma unroll
                for (int bj = 0; bj < 2; ++bj)
#pragma unroll
                    for (int n = 0; n < 2; ++n) { const f32x4 v = acc[ai][bj][m][n] * r; ss += ssq4(v); *at<u32x2>(w, (unsigned)WS_CQ + (row * QR + bj * HALF + wc * 32 + n * 16 + 4 * fq) * 2) = pack4(v); }
                ss += lx(ss, l_, 16); ss += lx(ss, l_, 32);
                if (fq == 0) *at<float>(w, (unsigned)WS_SSQCQ + (row * 8 + wc) * 4) = ss;
            MK_ROWS_END
        } else if (pn == 1) {
            MK_ROWS_BEGIN
                float ss = 0.f;
#pragma unroll
                for (int n = 0; n < 2; ++n) { const f32x4 v = acc[ai][0][m][n] * r; ss += ssq4(v); *at<u32x2>(w, (unsigned)WS_CQ + (row * QR + 256 + wc * 32 + n * 16 + 4 * fq) * 2) = pack4(v); }
                ss += lx(ss, l_, 16); ss += lx(ss, l_, 32);
                if (fq == 0) *at<float>(w, (unsigned)WS_SSQCQ + (row * 8 + 4 + wc) * 4) = ss;
                if (wc == 0) {
                    const f32x4 x1 = acc[ai][1][m][0] * r, x2 = acc[ai][1][m][1] * r;
                    const unsigned pi = row_pidx((int)row);
                    const f32x4 c = *at<const f32x4>(w, (unsigned)(WS_TAB + TAB_C16) + (pi * 16 + 4 * fq) * 4), s = *at<const f32x4>(w, (unsigned)(WS_TAB + TAB_S16) + (pi * 16 + 4 * fq) * 4);
                    const f32x4 y1 = x1 * c - x2 * s, y2 = x1 * s + x2 * c;
                    *at<u32x2>(w, (unsigned)WS_KRB + (row * 32 + 4 * fq) * 2) = pack4(y1); *at<u32x2>(w, (unsigned)WS_KRB + (row * 32 + 16 + 4 * fq) * 2) = pack4(y2);
                    *at<f32x4>(w, (unsigned)WS_KRF + (row * 32 + 4 * fq) * 4) = y1; *at<f32x4>(w, (unsigned)WS_KRF + (row * 32 + 16 + 4 * fq) * 4) = y2;
                }
            MK_ROWS_END
        } else if (pn == 2) {
            MK_ROWS_BEGIN
                float ss = 0.f;
#pragma unroll
                for (int bj = 0; bj < 2; ++bj)
#pragma unroll
                    for (int n = 0; n < 2; ++n) { const f32x4 v = acc[ai][bj][m][n] * r; ss += ssq4(v); const unsigned e = row * KVR + bj * HALF + wc * 32 + n * 16 + 4 * fq;
                        *at<f32x4>(w, (unsigned)WS_CKVF + e * 4) = v; *at<u32x2>(w, (unsigned)WS_CKVB + e * 2) = pack4(v); }
                ss += lx(ss, l_, 16); ss += lx(ss, l_, 32);
                if (fq == 0) *at<float>(w, (unsigned)WS_SSQKV + (row * 4 + wc) * 4) = ss;
            MK_ROWS_END
        } else if (pn < 7) {
            const bool isk = pn >= 5; const unsigned hh = 2 * ((pn - 3) & 1) + (wc >> 1);
            const unsigned dbase = (unsigned)(isk ? WS_RK : WS_RQ) + hh * 256, gbase = (unsigned)(WS_TAB + (isk ? TAB_GN : TAB_GP)) + hh * 512;
            MK_ROWS_BEGIN
                const unsigned pi = row_pidx((int)row), jt = row_jtok((int)row);
                const float mult = *at<const float>(w, gbase + jt * 4) * (isk ? RK_SCALE : 1.f);
#pragma unroll
                for (int n = 0; n < 2; ++n) { const unsigned i0 = 32 * (wc & 1) + 16 * n + 4 * fq;
                    const f32x4 x1 = acc[ai][0][m][n] * r, x2 = acc[ai][1][m][n] * r;
                    const f32x4 c = *at<const f32x4>(w, (unsigned)(WS_TAB + TAB_C64) + (pi * 64 + i0) * 4), s = *at<const f32x4>(w, (unsigned)(WS_TAB + TAB_S64) + (pi * 64 + i0) * 4);
                    const f32x4 y1 = (x1 * c - x2 * s) * mult, y2 = (x1 * s + x2 * c) * mult;
                    *at<u32x2>(w, dbase + (row * 512 + i0) * 2) = pack4(y1); *at<u32x2>(w, dbase + (row * 512 + 64 + i0) * 2) = pack4(y2);
                    if (isk) {
#pragma unroll
                        for (int j = 0; j < 4; ++j) { *at<bf16>(w, (unsigned)WS_RKT + ((hh * 128 + i0 + j) * MP + row) * 2) = bf1(y1[j]); *at<bf16>(w, (unsigned)WS_RKT + ((hh * 128 + 64 + i0 + j) * MP + row) * 2) = bf1(y2[j]); } } }
            MK_ROWS_END
        } else if (pn < 11) {
            const unsigned cbase = (unsigned)WS_RVT + ((pn - 7) * 256 + wc * 32 + 4 * fq) * (MP * 2);
            MK_ROWS_BEGIN
#pragma unroll
                for (int bj = 0; bj < 2; ++bj)
#pragma unroll
                    for (int n = 0; n < 2; ++n) { const f32x4 v = acc[ai][bj][m][n] * r;
#pragma unroll
                        for (int j = 0; j < 4; ++j) *at<bf16>(w, cbase + ((bj * HALF + n * 16 + j) * MP + row) * 2) = bf1(v[j]); }
            MK_ROWS_END
        } else {
            const int t = (pn - 11) >> 2; const unsigned dbase = (unsigned)WS_SRG + (unsigned)t * (unsigned)(WS_SGA - WS_SRG) + (((pn - 11) & 3) * 256 + wc * 32 + 4 * fq) * 2;
            MK_ROWS_BEGIN
#pragma unroll
                for (int bj = 0; bj < 2; ++bj)
#pragma unroll
                    for (int n = 0; n < 2; ++n) { const f32x4 v = acc[ai][bj][m][n] * r; f32x4 o;
#pragma unroll
                        for (int j = 0; j < 4; ++j) { const float sg = fast_sigmoid(v[j]); o[j] = t == 0 ? v[j] * sg : sg; }
                        *at<u32x2>(w, dbase + (row * 1024 + bj * HALF + n * 16) * 2) = pack4(o); }
            MK_ROWS_END
        }
    }
};
static_assert(WS_SGB - WS_SGA == WS_SGA - WS_SRG, "gate arrays equally spaced");
struct EpiQ {
    static constexpr bool PERM = false, AFTER_DRAIN = false;
    unsigned char* ws;
    __device__ __forceinline__ void operator()(const f32x4 (&acc)[2][2][4][2], const Unit& u, int wr, int wc, int fr, int fq) const {
        int l_ = lane_fresh(); asm volatile("" : "+v"(l_)); fr = l_ & 15; fq = l_ >> 4;
        const float* SSQCQ = (const float*)(ws + WS_SSQCQ); bf16* QA = (bf16*)(ws + WS_QA); const float* TAB = (const float*)(ws + WS_TAB);
        const int row0 = u.pm * BM + wr * 64 + fr;
#pragma unroll
        for (int ai = 0; ai < 2; ++ai)
#pragma unroll
            for (int m = 0; m < 4; ++m) {
                int row = row0 + ai * HALF + m * 16; asm volatile("" : "+v"(row));
                const float r = row_rscale8(SSQCQ, row, 1.f / QR) * SC_Q;
#pragma unroll
                for (int bj = 0; bj < 2; ++bj) {
                    const int grp = 8 * u.pn + 4 * bj + wc;
                    bf16* dst = QA + (size_t)row * 768 + 32 * grp + 4 * fq;
                    const bool rope = (grp % 3) == 2;
                    const int pi = row_pidx(row);
                    f32x4 c = *(const f32x4*)(TAB + TAB_C16 / 4 + pi * 16 + 4 * fq), s = *(const f32x4*)(TAB + TAB_S16 / 4 + pi * 16 + 4 * fq);
                    if (!rope) { c = (f32x4){1.f, 1.f, 1.f, 1.f}; s = (f32x4){0.f, 0.f, 0.f, 0.f}; }
                    const f32x4 x1 = acc[ai][bj][m][0] * r, x2 = acc[ai][bj][m][1] * r;
                    *(u32x2*)dst = pack4(x1 * c - x2 * s); *(u32x2*)(dst + 16) = pack4(x1 * s + x2 * c);
                }
                asm volatile("" ::: "memory");
            }
    }
};
template <bool ROWS> struct EpiScaleBf16 {
    static constexpr bool PERM = true, AFTER_DRAIN = false;
    const float* SSQKV; bf16* O; int ldc;
    __device__ __forceinline__ void operator()(const f32x4 (&acc)[2][2][4][2], const Unit& u, int wr, int wc, int fr, int fq) const {
        int l_ = lane_fresh(); asm volatile("" : "+v"(l_)); fr = l_ & 15; fq = l_ >> 4;
        const int row0 = u.pm * BM + wr * 64 + fr, col0 = u.pn * BM + wc * 32 + 8 * fq;
        float cs[2][8];
        if (!ROWS) {
#pragma unroll
            for (int bj = 0; bj < 2; ++bj)
#pragma unroll
                for (int k = 0; k < 8; ++k) cs[bj][k] = row_rscale4(SSQKV, col0 + bj * HALF + k, 1.f / KVR);
        }
#pragma unroll
        for (int ai = 0; ai < 2; ++ai)
#pragma unroll
            for (int m = 0; m < 4; ++m) { int row = row0 + ai * HALF + m * 16; asm volatile("" : "+v"(row)); const float r = ROWS ? row_rscale4(SSQKV, row, 1.f / KVR) : 1.f;
#pragma unroll
                for (int bj = 0; bj < 2; ++bj) { f32x4 v0 = acc[ai][bj][m][0], v1 = acc[ai][bj][m][1];
                    if (ROWS) { v0 = v0 * r; v1 = v1 * r; }
                    else {
#pragma unroll
                        for (int j = 0; j < 4; ++j) { v0[j] *= cs[bj][j]; v1[j] *= cs[bj][4 + j]; } }
                    u32x4 w; w.x = pg8::cvt_pk_bf16(v0[0], v0[1]); w.y = pg8::cvt_pk_bf16(v0[2], v0[3]); w.z = pg8::cvt_pk_bf16(v1[0], v1[1]); w.w = pg8::cvt_pk_bf16(v1[2], v1[3]);
                    *(u32x4*)(O + (size_t)row * ldc + col0 + bj * HALF) = w; } }
    }
};
__device__ __forceinline__ void finalize_ckv(Frame& F, const Ptrs& a) {
    const int lane = fresh_tid(F.wave) & 63;
    const int gw = F.vcu * NWAVES + F.wave, NGW = F.G * NWAVES;
    const float* CKVF = (const float*)(a.ws + WS_CKVF); const float* SSQKV = (const float*)(a.ws + WS_SSQKV); const float* KRF = (const float*)(a.ws + WS_KRF);
    const f32x4 g = *((const f32x4*)a.in(14) + lane);
    for (int row = gw; row < ROW_PAD; row += NGW) {
        const float r = row_rscale4(SSQKV, row, 1.f / KVR);
        const f32x4 o = *((const f32x4*)(CKVF + (size_t)row * KVR) + lane) * r * g;
        const f32x4 kr = *((const f32x4*)(KRF + (size_t)row * 32) + (lane & 7));
        if (row < MMAIN) { const size_t t = (size_t)(row >> 11) * T + NMETA + (row & (SEQ - 1)); *((f32x4*)(a.out() + OUT_CKVP + t * KVR) + lane) = o; if (lane < 8) *((f32x4*)(a.out() + OUT_KRP + t * 32) + lane) = kr; }
        else if (row < ROW_SMP) { for (int b = 0; b < NB; ++b) { const size_t t = (size_t)b * T + (row - ROW_META); *((f32x4*)(a.out() + OUT_CKVP + t * KVR) + lane) = o; if (lane < 8) *((f32x4*)(a.out() + OUT_KRP + t * 32) + lane) = kr; } }
        else { *((f32x4*)(a.out() + OUT_CKVS + (size_t)(row - ROW_SMP) * KVR) + lane) = o; if (lane < 8) *((f32x4*)(a.out() + OUT_KRS + (size_t)(row - ROW_SMP) * 32) + lane) = kr; }
    }
}
}
namespace mk {
constexpr size_t WS_AV = WS_END2;
constexpr size_t WS_END3 = WS_AV + al((size_t)MP * 512 * 2);
typedef float f32x16 __attribute__((ext_vector_type(16)));
constexpr int AT_KSTR = 208, AT_VSTR = 144, AT_KBUF = 64 * AT_KSTR, AT_VBUF = 64 * AT_VSTR, AT_VOFF = 2 * AT_KBUF;
__device__ __forceinline__ int crow(int i, int half) { return (i & 3) + 8 * (i >> 2) + 4 * half; }

__device__ __forceinline__ void attn_unit(Frame& F, unsigned char* ws, int b, int h, int qb) {
    ws = opaque_g(ws);
    const int tid = fresh_tid(F.wave), lane = tid & 63, w = F.wave, q = lane & 31, half = lane >> 5;
    LAS unsigned char* L = F.lds + RING_OFF;
    const bf16* QA = (const bf16*)(ws + WS_QA); const bf16* KN = (const bf16*)(ws + WS_KN); const bf16* KRB = (const bf16*)(ws + WS_KRB); const bf16* VT = (const bf16*)(ws + WS_VT);
    const int qrow = b * SEQ + qb * 256 + w * 32 + q, q_main = qb * 256 + w * 32 + q, wq0 = qb * 256 + w * 32;
    bf16x8 qf[6];
#pragma unroll
    for (int s = 0; s < 6; ++s) qf[s] = *(const bf16x8*)(QA + (size_t)qrow * 768 + h * 96 + 16 * s + 8 * half);
    f32x16 ot[2];
#pragma unroll
    for (int i = 0; i < 16; ++i) { ot[0][i] = 0.f; ot[1][i] = 0.f; }
    float m = -INFINITY, l = 0.f;
    const int NT = 4 * (qb + 1);
    v4u kreg, rreg, vreg; rreg = (v4u){0u, 0u, 0u, 0u};
#define AT_LOAD(tt) do { const int t0_ = (tt) == 0 ? ROW_META : b * SEQ + 64 * ((tt) - 1); \
        kreg = *(const v4u*)(KN + (size_t)(t0_ + (tid >> 3)) * 512 + h * 64 + (tid & 7) * 8); \
        if (tid < 256) rreg = *(const v4u*)(KRB + (size_t)(t0_ + (tid >> 2)) * 32 + (tid & 3) * 8); \
        vreg = *(const v4u*)(VT + (size_t)(h * 64 + (tid >> 3)) * MP + t0_ + (tid & 7) * 8); } while (0)
#define AT_STORE(buf) do { LAS unsigned char* kb_ = L + (buf) * AT_KBUF; \
        *(LAS v4u*)(kb_ + (tid >> 3) * AT_KSTR + (tid & 7) * 16) = kreg; \
        if (tid < 256) *(LAS v4u*)(kb_ + (tid >> 2) * AT_KSTR + 128 + (tid & 3) * 16) = rreg; \
        LAS unsigned char* vb_ = L + AT_VOFF + (buf) * AT_VBUF + (tid >> 3) * AT_VSTR + (32 * ((tid & 7) >> 1) + 8 * (tid & 1)); \
        *(LAS u32x2*)(vb_) = (u32x2){vreg.x, vreg.y}; *(LAS u32x2*)(vb_ + 16) = (u32x2){vreg.z, vreg.w}; } while (0)
    AT_LOAD(0); AT_STORE(0);
    __syncthreads();
    for (int tt = 0; tt <= NT; ++tt) {
        const int buf = tt & 1;
        if (tt < NT) AT_LOAD(tt + 1);
        const int kmin = tt == 0 ? 0 : 64 * (tt - 1);
        if (tt == 0 || kmin <= wq0 + 31) {
            const LAS unsigned char* Kb = L + buf * AT_KBUF + q * AT_KSTR + 16 * half;
            const LAS unsigned char* Vb = L + AT_VOFF + buf * AT_VBUF + q * AT_VSTR + 16 * half;
            f32x16 st[2];
#pragma unroll
            for (int kb = 0; kb < 2; ++kb) {
#pragma unroll
                for (int i = 0; i < 16; ++i) st[kb][i] = 0.f;
#pragma unroll
                for (int s = 0; s < 6; ++s) { const bf16x8 kf = *(const LAS bf16x8*)(Kb + kb * 32 * AT_KSTR + 32 * s); st[kb] = __builtin_amdgcn_mfma_f32_32x32x16_bf16(kf, qf[s], st[kb], 0, 0, 0); }
            }
            if (tt == 0) {
#pragma unroll
                for (int kb = 0; kb < 2; ++kb)
#pragma unroll
                    for (int i = 0; i < 16; ++i) if (32 * kb + crow(i, half) >= NMETA) st[kb][i] = -INFINITY;
            } else if (kmin + 63 > wq0) {
#pragma unroll
                for (int kb = 0; kb < 2; ++kb)
#pragma unroll
                    for (int i = 0; i < 16; ++i) if (kmin + 32 * kb + crow(i, half) > q_main) st[kb][i] = -INFINITY;
            }
            float mx = st[0][0];
#pragma unroll
            for (int i = 1; i < 16; ++i) mx = fmaxf(mx, st[0][i]);
#pragma unroll
            for (int i = 0; i < 16; ++i) mx = fmaxf(mx, st[1][i]);
            mx = fmaxf(mx, lx(mx, lane, 32));
            const float mn = fmaxf(m, mx), alpha = __builtin_amdgcn_exp2f(m - mn);
            m = mn;
            float ps = 0.f;
#pragma unroll
            for (int kb = 0; kb < 2; ++kb)
#pragma unroll
                for (int i = 0; i < 16; ++i) { st[kb][i] = __builtin_amdgcn_exp2f(st[kb][i] - mn); ps += st[kb][i]; }
            l = l * alpha + ps;
#pragma unroll
            for (int i = 0; i < 16; ++i) { ot[0][i] *= alpha; ot[1][i] *= alpha; }
#pragma unroll
            for (int kb = 0; kb < 2; ++kb)
#pragma unroll
                for (int s2 = 0; s2 < 2; ++s2) {
                    u32x4 pw; pw.x = pg8::cvt_pk_bf16(st[kb][8 * s2 + 0], st[kb][8 * s2 + 1]); pw.y = pg8::cvt_pk_bf16(st[kb][8 * s2 + 2], st[kb][8 * s2 + 3]);
                    pw.z = pg8::cvt_pk_bf16(st[kb][8 * s2 + 4], st[kb][8 * s2 + 5]); pw.w = pg8::cvt_pk_bf16(st[kb][8 * s2 + 6], st[kb][8 * s2 + 7]);
                    const bf16x8 pf = __builtin_bit_cast(bf16x8, pw);
#pragma unroll
                    for (int vb = 0; vb < 2; ++vb) { const bf16x8 vf = *(const LAS bf16x8*)(Vb + vb * 32 * AT_VSTR + (32 * kb + 16 * s2) * 2); ot[vb] = __builtin_amdgcn_mfma_f32_32x32x16_bf16(vf, pf, ot[vb], 0, 0, 0); }
                }
        }
        if (tt < NT) AT_STORE(buf ^ 1);
        __syncthreads();
    }
#undef AT_LOAD
#undef AT_STORE
    l += lx(l, lane, 32);
    const float inv = 1.0f / l;
    bf16* AV = (bf16*)(ws + WS_AV) + (size_t)qrow * 512 + h * 64 + 4 * half;
#pragma unroll
    for (int vb = 0; vb < 2; ++vb)
#pragma unroll
        for (int g = 0; g < 4; ++g) { f32x4 o; o[0] = ot[vb][4 * g] * inv; o[1] = ot[vb][4 * g + 1] * inv; o[2] = ot[vb][4 * g + 2] * inv; o[3] = ot[vb][4 * g + 3] * inv; *(u32x2*)(AV + 32 * vb + 8 * g) = pack4(o); }
}
__device__ __forceinline__ void attn_item(Frame& F, unsigned char* ws, int i) { const int bh = i & 63; attn_unit(F, ws, bh >> 3, bh & 7, 7 - (i >> 6)); }
__device__ __forceinline__ void attn_phase(Frame& F, unsigned char* ws) {
    const int c = F.vcu;
    if (c >= 256) return;
    const int bh = c >> 2, p = c & 3;
    attn_unit(F, ws, bh >> 3, bh & 7, 7 - p);
    attn_unit(F, ws, bh >> 3, bh & 7, p);
}
}
namespace mk {
constexpr size_t WS_UMETA = WS_END3;
constexpr size_t WS_UT = WS_UMETA + al((size_t)RH * RDV * RDK * 4);
constexpr size_t WS_SPREV = WS_UT + al((size_t)32 * 16 * RDV * RDK * 4);
constexpr size_t WS_RIN = WS_SPREV + al((size_t)32 * 16 * RDV * RDK * 2);
constexpr size_t WS_DPART = WS_RIN + al((size_t)MP * 1024 * 2);
constexpr size_t WS_END4 = WS_DPART + al((size_t)32 * 16 * 8 * 264 * 4);
static_assert(WS_END4 < ((size_t)1 << 31), "32-bit workspace offsets");
__device__ __forceinline__ float gpow_t(const unsigned char* ws, int h, int n) { return ((const float*)(ws + WS_TAB + TAB_GP))[h * 128 + n]; }

__device__ __forceinline__ void ret_u_unit(Frame& F, unsigned char* ws, int u) {
    ws = opaque_g(ws);
    const int tid = fresh_tid(F.wave), lane = tid & 63, w = F.wave, r32 = lane & 31, half = lane >> 5;
    const bool meta = u >= 512; const int hh = meta ? u - 512 : (u >> 4) & 3;
    const int tok0 = meta ? ROW_META : (u >> 6) * SEQ + (u & 15) * 128, nks = meta ? 1 : 8;
    const bf16* RVT = (const bf16*)(ws + WS_RVT); const bf16* RKT = (const bf16*)(ws + WS_RKT);
    f32x16 acc[4];
#pragma unroll
    for (int db = 0; db < 4; ++db)
#pragma unroll
        for (int i = 0; i < 16; ++i) acc[db][i] = 0.f;
    const bf16* ap = RVT + (size_t)(hh * 256 + 32 * w + r32) * MP + tok0 + 8 * half;
    const bf16* bp = RKT + (size_t)(hh * 128 + r32) * MP + tok0 + 8 * half;
    for (int s = 0; s < nks; ++s) {
        const bf16x8 af = *(const bf16x8*)(ap + 16 * s);
#pragma unroll
        for (int db = 0; db < 4; ++db) { const bf16x8 bf = *(const bf16x8*)(bp + (size_t)(32 * db) * MP + 16 * s); acc[db] = __builtin_amdgcn_mfma_f32_32x32x16_bf16(af, bf, acc[db], 0, 0, 0); }
    }
    const float sc = gpow_t(ws, hh, meta ? NMETA - 1 : 127);
    float* dst = meta ? (float*)(ws + WS_UMETA) + (size_t)hh * RDV * RDK : (float*)(ws + WS_UT) + (size_t)u * RDV * RDK;
#pragma unroll
    for (int db = 0; db < 4; ++db)
#pragma unroll
        for (int i = 0; i < 16; ++i) dst[(size_t)(32 * w + crow(i, half)) * RDK + 32 * db + r32] = acc[db][i] * sc;
}
__device__ __forceinline__ void ret_scan(Frame& F, const Ptrs& a) {
    const int tid = fresh_tid(F.wave);
    const int gt = (F.vcu * NWAVES * 64) + tid, NGT = F.G * NWAVES * 64;
    const float* UM = (const float*)(a.ws + WS_UMETA); const float* UT = (const float*)(a.ws + WS_UT); bf16* SP = (bf16*)(a.ws + WS_SPREV);
    for (int e = gt; e < 32 * RDV * RDK; e += NGT) {
        const int bh = e >> 15, idx = e & 32767, hh = bh & 3;
        const float g128 = gpow_t(a.ws, hh, 127) * gpow_t(a.ws, hh, 1);
        float S = UM[(size_t)hh * 32768 + idx];
        for (int c = 0; c < 16; ++c) { const size_t o = ((size_t)bh * 16 + c) * 32768 + idx; SP[o] = bf1(S); S = g128 * S + UT[o]; }
        const int ee = idx >> 7, d = idx & 127;
        a.out()[OUT_SRP + ((size_t)bh * RDK + d) * RDV + ee] = S;
    }
}
__device__ __forceinline__ void ret_o_unit(Frame& F, const Ptrs& a, int u) {
    unsigned char* ws = a.ws; ws = opaque_g(ws);
    const int tid = fresh_tid(F.wave), lane = tid & 63, w = F.wave, r32 = lane & 31, half = lane >> 5;
    const int bh = u >> 4, c = u & 15, hh = bh & 3, tok0 = (bh >> 2) * SEQ + c * 128;
    const int ib = w & 3, eh = w >> 2;
    LAS float* red = (LAS float*)(F.lds + RING_OFF);
    const bf16* RQ = (const bf16*)(ws + WS_RQ); const bf16* RK = (const bf16*)(ws + WS_RK); const bf16* RVT = (const bf16*)(ws + WS_RVT);
    const bf16* SP = (const bf16*)(ws + WS_SPREV) + (size_t)u * 32768;
    const int irow = tok0 + 32 * ib + r32;
    bf16x8 qf[8];
#pragma unroll
    for (int s = 0; s < 8; ++s) qf[s] = *(const bf16x8*)(RQ + (size_t)irow * 512 + hh * 128 + 16 * s + 8 * half);
    f32x16 ot[4];
#pragma unroll
    for (int eb = 0; eb < 4; ++eb) {
#pragma unroll
        for (int i = 0; i < 16; ++i) ot[eb][i] = 0.f;
        const bf16* sp = SP + (size_t)(128 * eh + 32 * eb + r32) * RDK + 8 * half;
#pragma unroll
        for (int s = 0; s < 8; ++s) { const bf16x8 sf = *(const bf16x8*)(sp + 16 * s); ot[eb] = __builtin_amdgcn_mfma_f32_32x32x16_bf16(sf, qf[s], ot[eb], 0, 0, 0); }
    }
    const float g = gpow_t(ws, hh, 1);
#pragma unroll
    for (int eb = 0; eb < 4; ++eb)
#pragma unroll
        for (int i = 0; i < 16; ++i) ot[eb][i] *= g;
    for (int jb = 0; jb <= ib; ++jb) {
        f32x16 at;
#pragma unroll
        for (int i = 0; i < 16; ++i) at[i] = 0.f;
        const bf16* kp = RK + (size_t)(tok0 + 32 * jb + r32) * 512 + hh * 128 + 8 * half;
#pragma unroll
        for (int s = 0; s < 8; ++s) { const bf16x8 kf = *(const bf16x8*)(kp + 16 * s); at = __builtin_amdgcn_mfma_f32_32x32x16_bf16(kf, qf[s], at, 0, 0, 0); }
        if (jb == ib) {
#pragma unroll
            for (int i = 0; i < 16; ++i) if (crow(i, half) > r32) at[i] = 0.f;
        }
#pragma unroll
        for (int s2 = 0; s2 < 2; ++s2) {
            u32x4 pw; pw.x = pg8::cvt_pk_bf16(at[8 * s2 + 0], at[8 * s2 + 1]); pw.y = pg8::cvt_pk_bf16(at[8 * s2 + 2], at[8 * s2 + 3]);
            pw.z = pg8::cvt_pk_bf16(at[8 * s2 + 4], at[8 * s2 + 5]); pw.w = pg8::cvt_pk_bf16(at[8 * s2 + 6], at[8 * s2 + 7]);
            const bf16x8 pf = __builtin_bit_cast(bf16x8, pw);
#pragma unroll
            for (int eb = 0; eb < 4; ++eb) {
                const bf16* vp = RVT + (size_t)(hh * 256 + 128 * eh + 32 * eb + r32) * MP + tok0 + 32 * jb + 16 * s2 + 4 * half;
                const u32x2 lo = *(const u32x2*)vp, hi = *(const u32x2*)(vp + 8);
                u32x4 vw; vw.x = lo.x; vw.y = lo.y; vw.z = hi.x; vw.w = hi.y;
                ot[eb] = __builtin_amdgcn_mfma_f32_32x32x16_bf16(__builtin_bit_cast(bf16x8, vw), pf, ot[eb], 0, 0, 0);
            }
        }
    }
    float s1 = 0.f;
#pragma unroll
    for (int eb = 0; eb < 4; ++eb)
#pragma unroll
        for (int i = 0; i < 16; ++i) s1 += ot[eb][i];
    s1 += lx(s1, lane, 32);
    if (half == 0) red[w * 32 + r32] = s1;
    __syncthreads();
    const float mu = (red[w * 32 + r32] + red[(w ^ 4) * 32 + r32]) * (1.f / 256.f);
    float s2 = 0.f;
#pragma unroll
    for (int eb = 0; eb < 4; ++eb)
#pragma unroll
        for (int i = 0; i < 16; ++i) { ot[eb][i] -= mu; s2 += ot[eb][i] * ot[eb][i]; }
    s2 += lx(s2, lane, 32);
    if (half == 0) red[256 + w * 32 + r32] = s2;
    __syncthreads();
    const float rstd = 1.0f / sqrtf((red[256 + w * 32 + r32] + red[256 + (w ^ 4) * 32 + r32]) * (1.f / 256.f) + EPS);
    __syncthreads();
    const bf16* SRG = (const bf16*)(ws + WS_SRG) + (size_t)irow * 1024 + hh * 256 + 128 * eh + 4 * half;
    bf16* RIN = (bf16*)(ws + WS_RIN) + (size_t)irow * 1024 + hh * 256 + 128 * eh + 4 * half;
    const float* gn = a.in(19) + hh * 256 + 128 * eh + 4 * half;
#pragma unroll
    for (int eb = 0; eb < 4; ++eb)
#pragma unroll
        for (int gq = 0; gq < 4; ++gq) {
            const int eo = 32 * eb + 8 * gq;
            const u32x2 sg = *(const u32x2*)(SRG + eo); const f32x4 gv = *(const f32x4*)(gn + eo);
            f32x4 o;
            o[0] = ot[eb][4 * gq + 0] * rstd * gv[0] * __uint_as_float(sg.x << 16); o[1] = ot[eb][4 * gq + 1] * rstd * gv[1] * __uint_as_float(sg.x & 0xffff0000u);
            o[2] = ot[eb][4 * gq + 2] * rstd * gv[2] * __uint_as_float(sg.y << 16); o[3] = ot[eb][4 * gq + 3] * rstd * gv[3] * __uint_as_float(sg.y & 0xffff0000u);
            *(u32x2*)(RIN + eo) = pack4(o);
        }
}
__device__ __forceinline__ void ret_sample_unit(Frame& F, const Ptrs& a, int u) {
    unsigned char* ws = a.ws; ws = opaque_g(ws);
    const int tid = fresh_tid(F.wave), lane = tid & 63, s = u >> 2, hh = u & 3, e = tid & 255, dh = tid >> 8, row = ROW_SMP + s;
    LAS float* sh = (LAS float*)(F.lds + RING_OFF);
    const bf16* RQ = (const bf16*)(ws + WS_RQ); const bf16* RK = (const bf16*)(ws + WS_RK); const bf16* RVT = (const bf16*)(ws + WS_RVT);
    if (tid < 128) sh[tid] = __uint_as_float((unsigned)RQ[(size_t)row * 512 + hh * 128 + tid] << 16);
    else if (tid < 256) sh[tid] = __uint_as_float((unsigned)RK[(size_t)row * 512 + hh * 128 + tid - 128] << 16);
    __syncthreads();
    const float v = __uint_as_float((unsigned)RVT[(size_t)(hh * 256 + e) * MP + row] << 16);
    const float g = gpow_t(ws, hh, 1);
    const float* S0 = a.in(4) + ((size_t)(s * RH + hh) * RDK) * RDV + e;
    float* S1 = a.out() + OUT_SRS + ((size_t)(s * RH + hh) * RDK) * RDV + e;
    float o = 0.f;
#pragma unroll 8
    for (int d = 64 * dh; d < 64 * dh + 64; ++d) { const float sn = g * S0[(size_t)d * RDV] + sh[128 + d] * v; S1[(size_t)d * RDV] = sn; o += sh[d] * sn; }
    sh[256 + dh * 256 + e] = o;
    __syncthreads();
    o = sh[256 + e] + sh[512 + e];
    float t1 = o;
#pragma unroll
    for (int off = 32; off > 0; off >>= 1) t1 += lx(t1, lane, off);
    if ((tid & 63) == 0) sh[768 + (tid >> 6)] = t1;
    __syncthreads();
    const float mu = (sh[768] + sh[769] + sh[770] + sh[771]) * (1.f / 256.f);
    const float dlt = o - mu;
    float t2 = dlt * dlt;
#pragma unroll
    for (int off = 32; off > 0; off >>= 1) t2 += lx(t2, lane, off);
    if ((tid & 63) == 0) sh[776 + (tid >> 6)] = t2;
    __syncthreads();
    const float rstd = 1.0f / sqrtf((sh[776] + sh[777] + sh[778] + sh[779]) * (1.f / 256.f) + EPS);
    if (dh == 0) { const float sg = __uint_as_float((unsigned)((const bf16*)(ws + WS_SRG))[(size_t)row * 1024 + hh * 256 + e] << 16);
        ((bf16*)(ws + WS_RIN))[(size_t)row * 1024 + hh * 256 + e] = bf1(dlt * rstd * a.in(19)[hh * 256 + e] * sg); }
    __syncthreads();
}
}
namespace mk {
template <int CTRL> __device__ __forceinline__ float dppf(float v) { return __int_as_float(__builtin_amdgcn_update_dpp(0, __float_as_int(v), CTRL, 0xF, 0xF, false)); }
__device__ __forceinline__ float swap32_add(float a, float b) { const auto r = __builtin_amdgcn_permlane32_swap(__float_as_uint(a), __float_as_uint(b), false, false); return __uint_as_float(r[0]) + __uint_as_float(r[1]); }
__device__ __forceinline__ float swap16_add(float a, float b) { const auto r = __builtin_amdgcn_permlane16_swap(__float_as_uint(a), __float_as_uint(b), false, false); return __uint_as_float(r[0]) + __uint_as_float(r[1]); }
__device__ __forceinline__ int dlane_of(int h) { return ((h >> 2) & 1) * 32 + ((h >> 1) & 1) * 16 + (h & 1) * 8; }
__device__ __forceinline__ void decode_unit(Frame& F, const Ptrs& a, int u) {
    unsigned char* ws = a.ws; ws = opaque_g(ws);
    const int tid = fresh_tid(F.wave), lane = tid & 63, w = F.wave, s = u >> 4, sp = u & 15, row = ROW_SMP + s;
    LAS float* sh = (LAS float*)(F.lds + RING_OFF);
    const bf16* QA = (const bf16*)(ws + WS_QA) + (size_t)row * 768;
    { const int r = tid & 255, hg = tid >> 8; const float* wuk = a.in(16) + (size_t)r * 512;
#pragma unroll 1
      for (int hh = 4 * hg; hh < 4 * hg + 4; ++hh) { float acc = 0.f;
          for (int n = 0; n < 64; ++n) acc += __uint_as_float((unsigned)QA[hh * 96 + n] << 16) * wuk[hh * 64 + n];
          sh[hh * 256 + r] = acc; }
      if (tid < 256) { const int hh = tid >> 5, i = tid & 31; sh[2048 + tid] = __uint_as_float((unsigned)QA[hh * 96 + 64 + i] << 16); } }
    __syncthreads();
    f32x4 ql[8]; float qr[8];
#pragma unroll
    for (int h = 0; h < 8; ++h) { ql[h] = *(const LAS f32x4*)(sh + h * 256 + 4 * lane); qr[h] = lane < 32 ? sh[2048 + h * 32 + lane] : 0.f; }
    __syncthreads();
    f32x4 O[8];
#pragma unroll
    for (int h = 0; h < 8; ++h) O[h] = (f32x4){0.f, 0.f, 0.f, 0.f};
    float m = -INFINITY, l = 0.f;
    const int page = ((const int*)a.in(5))[s * NPAGES + sp * 8 + w];
    const float* ck0 = a.in(2) + (size_t)page * PAGE * KVR + 4 * lane;
    const float* kr0 = a.in(3) + (size_t)page * PAGE * 32 + (lane & 31);
#define DC_LOAD(kv_, rv_, bi_) do { const float* c_ = ck0; const float* r_ = kr0; const int k0_ = (bi_) * 4; \
        _Pragma("unroll") for (int kk = 0; kk < 4; ++kk) { kv_[kk] = *(const f32x4*)(c_ + (size_t)(k0_ + kk) * KVR); rv_[kk] = r_[(size_t)(k0_ + kk) * 32]; } } while (0)
#define DC_COMPUTE(kv_, rv_) do { float sc[4]; \
        _Pragma("unroll") for (int kk = 0; kk < 4; ++kk) { float p[8]; \
            _Pragma("unroll") for (int h = 0; h < 8; ++h) p[h] = fmaf(ql[h][0], kv_[kk][0], fmaf(ql[h][1], kv_[kk][1], fmaf(ql[h][2], kv_[kk][2], fmaf(ql[h][3], kv_[kk][3], qr[h] * rv_[kk])))); \
              \
            const float a0 = swap32_add(p[0], p[4]), a1 = swap32_add(p[1], p[5]), a2 = swap32_add(p[2], p[6]), a3 = swap32_add(p[3], p[7]); \
            const float b0 = swap16_add(a0, a2), b1 = swap16_add(a1, a3); \
            const float c0 = b0 + dppf<0x128>(b0), c1 = b1 + dppf<0x128>(b1); \
            float v1 = (lane & 8) ? c1 : c0; \
            v1 += dppf<0xB1>(v1); v1 += dppf<0x4E>(v1); v1 += dppf<0x141>(v1); sc[kk] = v1; } \
        const float mx = fmaxf(fmaxf(sc[0], sc[1]), fmaxf(sc[2], sc[3])); \
        const float mn = fmaxf(m, mx), alpha = __builtin_amdgcn_exp2f(m - mn); m = mn; \
        float pe[4]; \
        _Pragma("unroll") for (int kk = 0; kk < 4; ++kk) pe[kk] = __builtin_amdgcn_exp2f(sc[kk] - mn); \
        l = l * alpha + ((pe[0] + pe[1]) + (pe[2] + pe[3])); \
        _Pragma("unroll") for (int h = 0; h < 8; ++h) { const int src = dlane_of(h); \
            const float ah = __int_as_float(__builtin_amdgcn_readlane(__float_as_int(alpha), src)), p0 = __int_as_float(__builtin_amdgcn_readlane(__float_as_int(pe[0]), src)), p1 = __int_as_float(__builtin_amdgcn_readlane(__float_as_int(pe[1]), src)), \
                        p2 = __int_as_float(__builtin_amdgcn_readlane(__float_as_int(pe[2]), src)), p3 = __int_as_float(__builtin_amdgcn_readlane(__float_as_int(pe[3]), src)); \
            O[h] = O[h] * ah + kv_[0] * p0 + kv_[1] * p1 + kv_[2] * p2 + kv_[3] * p3; } } while (0)
    f32x4 kvA[4], kvB[4], kvC[4]; float rvA[4], rvB[4], rvC[4];
    DC_LOAD(kvA, rvA, 0); DC_LOAD(kvB, rvB, 1);
#pragma unroll 1
    for (int bi = 0; bi < 30; bi += 3) {
        DC_LOAD(kvC, rvC, bi + 2);
        DC_COMPUTE(kvA, rvA);
        DC_LOAD(kvA, rvA, bi + 3);
        DC_COMPUTE(kvB, rvB);
        DC_LOAD(kvB, rvB, bi + 4);
        DC_COMPUTE(kvC, rvC);
    }
    DC_COMPUTE(kvA, rvA);
    DC_COMPUTE(kvB, rvB);
#undef DC_LOAD
#undef DC_COMPUTE
    LAS float* wm = sh + 2304 + w * 16;
    LAS float* wo = sh + 2304 + 128 + w * 2048;
    { const int hd = 4 * (lane >> 5) + 2 * ((lane >> 4) & 1) + ((lane >> 3) & 1); if ((lane & 7) == 0) { wm[hd] = m; wm[8 + hd] = l; } }
#pragma unroll
    for (int h = 0; h < 8; ++h) *(LAS f32x4*)(wo + h * 256 + 4 * lane) = O[h];
    __syncthreads();
    float* part = (float*)(ws + WS_DPART) + (size_t)u * 8 * 264;
    for (int e = tid; e < 2048; e += 512) {
        const int h = e >> 8;
        float M = -INFINITY;
#pragma unroll
        for (int ww = 0; ww < 8; ++ww) M = fmaxf(M, sh[2304 + ww * 16 + h]);
        float acc = 0.f, L = 0.f;
#pragma unroll
        for (int ww = 0; ww < 8; ++ww) { const float f = __builtin_amdgcn_exp2f(sh[2304 + ww * 16 + h] - M); acc += f * sh[2304 + 128 + ww * 2048 + e]; L += f * sh[2304 + ww * 16 + 8 + h]; }
        part[h * 264 + (e & 255)] = acc;
        if ((e & 255) == 0) { part[h * 264 + 256] = M; part[h * 264 + 257] = L; }
    }
    __syncthreads();
}
__device__ __forceinline__ void decode_combine_unit(Frame& F, const Ptrs& a, int u) {
    unsigned char* ws = opaque_g(a.ws);
    const int tid = fresh_tid(F.wave), lane = tid & 63, s = u >> 3, h = u & 7, row = ROW_SMP + s;
    LAS float* sh = (LAS float*)(F.lds + RING_OFF);
    const bf16* QA = (const bf16*)(ws + WS_QA) + (size_t)row * 768;
    const float* part = (const float*)(ws + WS_DPART) + (size_t)s * 16 * 8 * 264;
    if (tid < 64) { const bf16* KNr = (const bf16*)(ws + WS_KN) + (size_t)row * 512;
        float acc = __uint_as_float((unsigned)QA[h * 96 + lane] << 16) * __uint_as_float((unsigned)KNr[h * 64 + lane] << 16);
        if (lane < 32) acc += __uint_as_float((unsigned)QA[h * 96 + 64 + lane] << 16) * ((const float*)(ws + WS_KRF))[(size_t)row * 32 + lane];
#pragma unroll
        for (int off = 32; off > 0; off >>= 1) acc += lx(acc, lane, off);
        if (lane == 0) sh[256] = acc; }
    __syncthreads();
    if (tid < 256) {
        const int r = tid;
        const float sn = sh[256];
        float pm[16];
#pragma unroll
        for (int p = 0; p < 16; ++p) pm[p] = part[(p * 8 + h) * 264 + 256];
        float M = sn;
#pragma unroll
        for (int p = 0; p < 16; ++p) M = fmaxf(M, pm[p]);
        const float rkv = row_rscale4((const float*)(ws + WS_SSQKV), row, 1.f / KVR);
        const float cn = ((const float*)(ws + WS_CKVF))[(size_t)row * KVR + r] * rkv * a.in(14)[r];
        const float fn = __builtin_amdgcn_exp2f(sn - M);
        float acc = fn * cn, Lq = fn;
#pragma unroll
        for (int p = 0; p < 16; ++p) { const float f = __builtin_amdgcn_exp2f(pm[p] - M); acc += f * part[(p * 8 + h) * 264 + r]; Lq += f * part[(p * 8 + h) * 264 + 257]; }
        sh[r] = acc / Lq;
    }
    __syncthreads();
    { const int v = tid & 63, rg = tid >> 6; const float* wuv = a.in(17) + (size_t)(32 * rg) * 512 + h * 64 + v;
      float wv[32];
#pragma unroll
      for (int k = 0; k < 32; ++k) wv[k] = wuv[(size_t)k * 512];
      float acc = 0.f;
#pragma unroll
      for (int k = 0; k < 32; ++k) acc += sh[32 * rg + k] * wv[k];
      sh[264 + rg * 64 + v] = acc; }
    __syncthreads();
    if (tid < 64) { float acc = 0.f;
#pragma unroll
        for (int rg = 0; rg < 8; ++rg) acc += sh[264 + rg * 64 + tid];
        ((bf16*)(ws + WS_AV))[(size_t)row * 512 + h * 64 + tid] = bf1(acc); }
    __syncthreads();
}
}
namespace mk {
constexpr size_t WS_TMP = WS_ACT;
constexpr size_t WS_MX = WS_RQ;
constexpr size_t WS_H2B = WS_MX + al((size_t)MP * 1024 * 2);
constexpr size_t WS_H2 = WS_UT;
constexpr size_t WS_SSQH2 = WS_END4;
constexpr size_t WS_SSQH3 = WS_SSQH2 + al((size_t)MP * 16 * 4);
constexpr size_t WS_H3 = WS_H;
constexpr size_t WS_END6 = WS_SSQH3 + al((size_t)MP * 16 * 4);
static_assert(WS_H2B + (size_t)MP * 1024 * 2 <= WS_SRG && WS_H2 + (size_t)MP * 1024 * 4 <= WS_RIN && (size_t)MP * 1024 * 4 <= (size_t)MP * FFN * 2, "overlays");
static_assert(WS_END6 < ((size_t)1 << 31), "32-bit workspace offsets");

template <int STEP, unsigned GATE_OFF> struct EpiGate {
    static constexpr bool PERM = false, AFTER_DRAIN = false;
    unsigned char* ws_;
    __device__ __forceinline__ void operator()(const f32x4 (&acc)[2][2][4][2], const Unit& u, int wr, int wc, int fr, int fq) const {
        int l_ = lane_fresh(); asm volatile("" : "+v"(l_)); fr = l_ & 15; fq = l_ >> 4;
        unsigned char* w = opaque_g(ws_);
        const unsigned row0 = u.pm * BM + wr * 64 + fr, col0 = u.pn * BM + wc * 32 + 4 * fq;
#pragma unroll
        for (int ai = 0; ai < 2; ++ai)
#pragma unroll
            for (int m = 0; m < 4; ++m) { unsigned row = row0 + ai * HALF + m * 16; asm volatile("" : "+v"(row));
#pragma unroll
                for (int bj = 0; bj < 2; ++bj)
#pragma unroll
                    for (int n = 0; n < 2; ++n) { const unsigned e = row * 1024 + col0 + bj * HALF + n * 16;
                        const u32x2 gw = *at<const u32x2>(w, GATE_OFF + e * 2);
                        f32x4 g; g[0] = __uint_as_float(gw.x << 16); g[1] = __uint_as_float(gw.x & 0xffff0000u); g[2] = __uint_as_float(gw.y << 16); g[3] = __uint_as_float(gw.y & 0xffff0000u);
                        f32x4 o = acc[ai][bj][m][n] * g;
                        if (STEP == 0) *at<f32x4>(w, (unsigned)WS_TMP + e * 4) = o;
                        else { o = o + *at<const f32x4>(w, (unsigned)WS_TMP + e * 4); *at<u32x2>(w, (unsigned)WS_MX + e * 2) = pack4(o); } }
                asm volatile("" ::: "memory"); }
    }
};
struct EpiSwiGLU2 {
    static constexpr bool PERM = true, AFTER_DRAIN = false;
    unsigned char* ws_;
    __device__ __forceinline__ void operator()(const f32x4 (&acc)[2][2][4][2], const Unit& u, int wr, int wc, int fr, int fq) const {
        int l_ = lane_fresh(); asm volatile("" : "+v"(l_)); fr = l_ & 15; fq = l_ >> 4;
        unsigned char* w = opaque_g(ws_);
        const unsigned row0 = u.pm * BM + wr * 64 + fr, col0 = u.pn * HALF + wc * 32 + 8 * fq;
#pragma unroll
        for (int ai = 0; ai < 2; ++ai)
#pragma unroll
            for (int m = 0; m < 4; ++m) { unsigned row = row0 + ai * HALF + m * 16; asm volatile("" : "+v"(row));
                const float r = row_rscale16(at<const float>(w, (unsigned)WS_SSQH2), (int)row, 1.f / D);
                f32x4 o[2];
#pragma unroll
                for (int n = 0; n < 2; ++n)
#pragma unroll
                    for (int j = 0; j < 4; ++j) { const float g = acc[ai][0][m][n][j] * r, up = acc[ai][1][m][n][j] * r; o[n][j] = fast_silu(g) * up; }
                u32x4 pk; pk.x = pg8::cvt_pk_bf16(o[0][0], o[0][1]); pk.y = pg8::cvt_pk_bf16(o[0][2], o[0][3]); pk.z = pg8::cvt_pk_bf16(o[1][0], o[1][1]); pk.w = pg8::cvt_pk_bf16(o[1][2], o[1][3]);
                *at<u32x4>(w, (unsigned)WS_ACT + (row * FFN + col0) * 2) = pk;
                asm volatile("" ::: "memory"); }
    }
};
__device__ __forceinline__ void final_norm_phase(Frame& F, const Ptrs& a) {
    const int lane = fresh_tid(F.wave) & 63;
    const int gw = F.vcu * NWAVES + F.wave, NGW = F.G * NWAVES;
    const float* H3 = (const float*)(a.ws + WS_H3); const float* SSQ = (const float*)(a.ws + WS_SSQH3);
    f32x4 g[4];
#pragma unroll
    for (int j = 0; j < 4; ++j) g[j] = *((const f32x4*)a.in(26) + lane + 64 * j);
    for (int row0 = gw; row0 < ROW_PAD; row0 += 2 * NGW) {
        f32x4 v[2][4]; float r[2];
#pragma unroll
        for (int t = 0; t < 2; ++t) { const int row = row0 + t * NGW; const bool ok = row < ROW_PAD && !(row >= MMAIN && row < ROW_SMP);
            r[t] = ok ? row_rscale16(SSQ, row, 1.f / D) : 0.f;
#pragma unroll
            for (int j = 0; j < 4; ++j) v[t][j] = ok ? *((const f32x4*)(H3 + (size_t)row * D) + lane + 64 * j) : (f32x4){0.f, 0.f, 0.f, 0.f}; }
#pragma unroll
        for (int t = 0; t < 2; ++t) { const int row = row0 + t * NGW; if (row >= ROW_PAD || (row >= MMAIN && row < ROW_SMP)) continue;
            float* dst = row < MMAIN ? a.out() + OUT_YP + (size_t)row * D : a.out() + OUT_YS + (size_t)(row - ROW_SMP) * D;
#pragma unroll
            for (int j = 0; j < 4; ++j) *((f32x4*)dst + lane + 64 * j) = v[t][j] * r[t] * g[j]; }
    }
}
}
namespace mk {
typedef float f32x4_t __attribute__((ext_vector_type(4)));
constexpr int XROW0 = MMAIN, SK_C = 64 * 64;
__device__ __forceinline__ void skinny64(int wave, int tid, const bf16* A, int K, const bf16* Bt, int brow0, LAS float* P, float (&out)[8]) {
    const int lane = tid & 63, r16 = lane & 15, kq = lane >> 4;
    const bf16* ap = A + (size_t)(XROW0 + r16) * K + 8 * kq;
    const bf16* bp = Bt + (size_t)(brow0 + r16) * K + 8 * kq;
    f32x4 acc[4][4];
#pragma unroll
    for (int mf = 0; mf < 4; ++mf)
#pragma unroll
        for (int nf = 0; nf < 4; ++nf) acc[mf][nf] = (f32x4){0.f, 0.f, 0.f, 0.f};
    const int KS = K / 32;
    bf16x8 a0[4], b0[4], a1[4], b1[4], a2[4], b2[4];
#define SK_LOAD(a_, b_, kk_) do { _Pragma("unroll") for (int f = 0; f < 4; ++f) { a_[f] = *(const bf16x8*)(ap + (size_t)(16 * f) * K + 32 * (kk_)); b_[f] = *(const bf16x8*)(bp + (size_t)(16 * f) * K + 32 * (kk_)); } } while (0)
#define SK_MMA(a_, b_) do { _Pragma("unroll") for (int mf = 0; mf < 4; ++mf) _Pragma("unroll") for (int nf = 0; nf < 4; ++nf) acc[mf][nf] = __builtin_amdgcn_mfma_f32_16x16x32_bf16(a_[mf], b_[nf], acc[mf][nf], 0, 0, 0); } while (0)
    int kk = wave;
    if (kk < KS) SK_LOAD(a0, b0, kk);
    if (kk + 8 < KS) SK_LOAD(a1, b1, kk + 8);
    if (kk + 16 < KS) SK_LOAD(a2, b2, kk + 16);
    for (; kk < KS; kk += 24) {
        SK_MMA(a0, b0); if (kk + 24 < KS) SK_LOAD(a0, b0, kk + 24);
        if (kk + 8 < KS) { SK_MMA(a1, b1); if (kk + 32 < KS) SK_LOAD(a1, b1, kk + 32); }
        if (kk + 16 < KS) { SK_MMA(a2, b2); if (kk + 40 < KS) SK_LOAD(a2, b2, kk + 40); }
    }
#undef SK_LOAD
#undef SK_MMA
    LAS float* Pw = P + wave * SK_C;
#pragma unroll
    for (int mf = 0; mf < 4; ++mf)
#pragma unroll
        for (int nf = 0; nf < 4; ++nf)
#pragma unroll
            for (int i = 0; i < 4; ++i) Pw[(16 * mf + 4 * kq + i) * 64 + 16 * nf + r16] = acc[mf][nf][i];
    __syncthreads();
    const LAS float* pr = P + (tid >> 3) * 64 + 8 * (tid & 7);
    f32x4 s0 = *(const LAS f32x4*)pr, s1 = *(const LAS f32x4*)(pr + 4);
#pragma unroll
    for (int w = 1; w < 8; ++w) { s0 = s0 + *(const LAS f32x4*)(pr + w * SK_C); s1 = s1 + *(const LAS f32x4*)(pr + w * SK_C + 4); }
    out[0] = s0[0]; out[1] = s0[1]; out[2] = s0[2]; out[3] = s0[3]; out[4] = s1[0]; out[5] = s1[1]; out[6] = s1[2]; out[7] = s1[3];
    __syncthreads();
}
__device__ __forceinline__ float sum8(float v, int lane) { v += lx(v, lane, 1); v += lx(v, lane, 2); v += lx(v, lane, 4); return v; }
__device__ __forceinline__ void st8_bf16(bf16* p, const float* v) { u32x4 w; w.x = pg8::cvt_pk_bf16(v[0], v[1]); w.y = pg8::cvt_pk_bf16(v[2], v[3]); w.z = pg8::cvt_pk_bf16(v[4], v[5]); w.w = pg8::cvt_pk_bf16(v[6], v[7]); *(u32x4*)p = w; }
__device__ __forceinline__ void ld8(const LAS float* p, float* v) { const f32x4 a = *(const LAS f32x4*)p, b = *(const LAS f32x4*)(p + 4); v[0] = a[0]; v[1] = a[1]; v[2] = a[2]; v[3] = a[3]; v[4] = b[0]; v[5] = b[1]; v[6] = b[2]; v[7] = b[3]; }

__device__ __forceinline__ void xjob_ffn_up(Frame& F, unsigned char* ws, int j, size_t a_off, size_t w_off, int rs_mode) {
    ws = opaque_g(ws);
    const int tid = fresh_tid(F.wave);
    LAS float* P = (LAS float*)(F.lds + RING_OFF);
    const int brow0 = 256 * (j >> 1) + 64 * (j & 1);
    float g[8], u[8], o[8];
    skinny64(F.wave, tid, (const bf16*)(ws + a_off), D, (const bf16*)(ws + w_off), brow0, P, g);
    skinny64(F.wave, tid, (const bf16*)(ws + a_off), D, (const bf16*)(ws + w_off), brow0 + 128, P, u);
    const int r = tid >> 3, cg = tid & 7, row = XROW0 + r;
    const float rs = rs_mode == 0 ? ((const float*)(ws + WS_R1))[row] : row_rscale16((const float*)(ws + WS_SSQH2), row, 1.f / D);
#pragma unroll
    for (int k = 0; k < 8; ++k) o[k] = fast_silu(g[k] * rs) * (u[k] * rs);
    st8_bf16((bf16*)(ws + WS_ACT) + (size_t)row * FFN + 64 * j + 8 * cg, o);
}
__device__ __forceinline__ void xjob_resid(Frame& F, unsigned char* ws, int j, size_t a_off, int K, size_t w_off, const float* res  , float scale, size_t out_off, size_t outb_off, size_t ssq_off) {
    ws = opaque_g(ws);
    const int tid = fresh_tid(F.wave), lane = tid & 63;
    LAS float* P = (LAS float*)(F.lds + RING_OFF);
    float v[8], o[8];
    skinny64(F.wave, tid, (const bf16*)(ws + a_off), K, (const bf16*)(ws + w_off), 64 * j, P, v);
    const int r = tid >> 3, cg = tid & 7, row = XROW0 + r, col = 64 * j + 8 * cg;
    const f32x4 b0 = *(const f32x4*)(res + (size_t)r * D + col), b1 = *(const f32x4*)(res + (size_t)r * D + col + 4);
    float ss = 0.f;
#pragma unroll
    for (int k = 0; k < 8; ++k) { o[k] = (k < 4 ? b0[k] : b1[k - 4]) + scale * v[k]; ss += o[k] * o[k]; }
    float* op = (float*)(ws + out_off) + (size_t)row * D + col;
    *(f32x4*)op = (f32x4){o[0], o[1], o[2], o[3]}; *(f32x4*)(op + 4) = (f32x4){o[4], o[5], o[6], o[7]};
    if (outb_off) st8_bf16((bf16*)(ws + outb_off) + (size_t)row * D + col, o);
    ss = sum8(ss, lane);
    if (cg == 0) ((float*)(ws + ssq_off))[(size_t)row * 16 + j] = ss;
}
__device__ __forceinline__ void xjob_win(Frame& F, unsigned char* ws, int j) {
    ws = opaque_g(ws);
    const int tid = fresh_tid(F.wave), lane = tid & 63;
    LAS float* P = (LAS float*)(F.lds + RING_OFF);
    const int pn = j >> 1, q = j & 1;
    float v0[8], v1[8];
    skinny64(F.wave, tid, (const bf16*)(ws + WS_HB), D, (const bf16*)(ws + WS_WIN), 256 * pn + 64 * q, P, v0);
    skinny64(F.wave, tid, (const bf16*)(ws + WS_HB), D, (const bf16*)(ws + WS_WIN), 256 * pn + 64 * q + 128, P, v1);
    const int r = tid >> 3, cg = tid & 7, row = XROW0 + r;
    const float rs = row_rscale16((const float*)(ws + WS_SSQH), row, 1.f / D);
    const float* TAB = (const float*)(ws + WS_TAB);
#pragma unroll
    for (int k = 0; k < 8; ++k) { v0[k] *= rs; v1[k] *= rs; }
    const int tc0 = 64 * q + 8 * cg;
    if (pn == 0) {
        bf16* CQ = (bf16*)(ws + WS_CQ) + (size_t)row * QR; float* SSQCQ = (float*)(ws + WS_SSQCQ) + (size_t)row * 8;
        st8_bf16(CQ + tc0, v0); st8_bf16(CQ + tc0 + 128, v1);
        float s0 = 0.f, s1 = 0.f;
#pragma unroll
        for (int k = 0; k < 8; ++k) { s0 += v0[k] * v0[k]; s1 += v1[k] * v1[k]; }
        s0 = sum8(s0, lane); s1 = sum8(s1, lane);
        if (cg == 0) { SSQCQ[2 * q] = s0; SSQCQ[2 * q + 1] = s1; }
    } else if (pn == 1) {
        bf16* CQ = (bf16*)(ws + WS_CQ) + (size_t)row * QR; float* SSQCQ = (float*)(ws + WS_SSQCQ) + (size_t)row * 8;
        st8_bf16(CQ + 256 + tc0, v0);
        float s0 = 0.f;
#pragma unroll
        for (int k = 0; k < 8; ++k) s0 += v0[k] * v0[k];
        s0 = sum8(s0, lane);
        if (cg == 0) { SSQCQ[4 + q] = s0; SSQCQ[6 + q] = 0.f; }
        float x2[8];
#pragma unroll
        for (int k = 0; k < 8; ++k) x2[k] = lx(v1[k], lane, 2);
        if (q == 0 && cg < 2) {
            const int pi = row_pidx(row), i0 = 8 * cg;
            float y1[8], y2[8];
#pragma unroll
            for (int k = 0; k < 8; ++k) { const float c = TAB[TAB_C16 / 4 + pi * 16 + i0 + k], s = TAB[TAB_S16 / 4 + pi * 16 + i0 + k]; y1[k] = v1[k] * c - x2[k] * s; y2[k] = v1[k] * s + x2[k] * c; }
            st8_bf16((bf16*)(ws + WS_KRB) + (size_t)row * 32 + i0, y1); st8_bf16((bf16*)(ws + WS_KRB) + (size_t)row * 32 + 16 + i0, y2);
            float* kf = (float*)(ws + WS_KRF) + (size_t)row * 32;
#pragma unroll
            for (int k = 0; k < 8; ++k) { kf[i0 + k] = y1[k]; kf[16 + i0 + k] = y2[k]; }
        }
    } else if (pn == 2) {
        float* CKVF = (float*)(ws + WS_CKVF) + (size_t)row * KVR; bf16* CKVB = (bf16*)(ws + WS_CKVB) + (size_t)row * KVR; float* SSQKV = (float*)(ws + WS_SSQKV) + (size_t)row * 4;
        float s0 = 0.f, s1 = 0.f;
#pragma unroll
        for (int k = 0; k < 8; ++k) { CKVF[tc0 + k] = v0[k]; CKVF[tc0 + 128 + k] = v1[k]; s0 += v0[k] * v0[k]; s1 += v1[k] * v1[k]; }
        st8_bf16(CKVB + tc0, v0); st8_bf16(CKVB + tc0 + 128, v1);
        s0 = sum8(s0, lane); s1 = sum8(s1, lane);
        if (cg == 0) { SSQKV[2 * q] = s0; SSQKV[2 * q + 1] = s1; }
    } else if (pn < 7) {
        const bool isk = pn >= 5; const int hh = 2 * ((pn - 3) & 1) + q, i0 = 8 * cg;
        const int pi = row_pidx(row), jt = row_jtok(row);
        const float mult = isk ? RK_SCALE * TAB[TAB_GN / 4 + hh * 128 + jt] : TAB[TAB_GP / 4 + hh * 128 + jt];
        float y1[8], y2[8];
#pragma unroll
        for (int k = 0; k < 8; ++k) { const float c = TAB[TAB_C64 / 4 + pi * 64 + i0 + k], s = TAB[TAB_S64 / 4 + pi * 64 + i0 + k]; y1[k] = (v0[k] * c - v1[k] * s) * mult; y2[k] = (v0[k] * s + v1[k] * c) * mult; }
        bf16* dst = (bf16*)(ws + (isk ? WS_RK : WS_RQ)) + (size_t)row * 512 + hh * 128;
        st8_bf16(dst + i0, y1); st8_bf16(dst + 64 + i0, y2);
        if (isk) { bf16* RKT = (bf16*)(ws + WS_RKT);
#pragma unroll
            for (int k = 0; k < 8; ++k) { RKT[(size_t)(hh * 128 + i0 + k) * MP + row] = bf1(y1[k]); RKT[(size_t)(hh * 128 + 64 + i0 + k) * MP + row] = bf1(y2[k]); } }
    } else if (pn < 11) {
        bf16* RVT = (bf16*)(ws + WS_RVT);
#pragma unroll
        for (int k = 0; k < 8; ++k) { RVT[(size_t)((pn - 7) * 256 + tc0 + k) * MP + row] = bf1(v0[k]); RVT[(size_t)((pn - 7) * 256 + tc0 + 128 + k) * MP + row] = bf1(v1[k]); }
    } else {
        const int t = (pn - 11) >> 2; bf16* dst = (bf16*)(ws + WS_SRG + (size_t)t * (WS_SGA - WS_SRG)) + (size_t)row * 1024 + ((pn - 11) & 3) * 256;
        float o0[8], o1[8];
#pragma unroll
        for (int k = 0; k < 8; ++k) { const float g0 = fast_sigmoid(v0[k]), g1 = fast_sigmoid(v1[k]); o0[k] = t == 0 ? v0[k] * g0 : g0; o1[k] = t == 0 ? v1[k] * g1 : g1; }
        st8_bf16(dst + tc0, o0); st8_bf16(dst + tc0 + 128, o1);
    }
}
__device__ __forceinline__ void xjob_q(Frame& F, unsigned char* ws, int j) {
    ws = opaque_g(ws);
    const int tid = fresh_tid(F.wave), lane = tid & 63;
    LAS float* P = (LAS float*)(F.lds + RING_OFF);
    float v[8], p[8], o[8];
    skinny64(F.wave, tid, (const bf16*)(ws + WS_CQ), QR, (const bf16*)(ws + WS_WUQ), 64 * j, P, v);
    const int r = tid >> 3, cg = tid & 7, row = XROW0 + r;
    const float rs = row_rscale8((const float*)(ws + WS_SSQCQ), row, 1.f / QR) * SC_Q;
    const float* TAB = (const float*)(ws + WS_TAB);
    const int pi = row_pidx(row), col = 64 * j + 8 * cg, grp = col >> 5, w32 = col & 31;
#pragma unroll
    for (int k = 0; k < 8; ++k) p[k] = lx(v[k], lane, 2);
    if (grp % 3 == 2) {
        const int i0 = w32 & 15;
#pragma unroll
        for (int k = 0; k < 8; ++k) { const float c = TAB[TAB_C16 / 4 + pi * 16 + i0 + k], sn = TAB[TAB_S16 / 4 + pi * 16 + i0 + k];
            o[k] = (w32 < 16 ? v[k] * c - p[k] * sn : p[k] * sn + v[k] * c) * rs; }
    } else {
#pragma unroll
        for (int k = 0; k < 8; ++k) o[k] = v[k] * rs;
    }
    st8_bf16((bf16*)(ws + WS_QA) + (size_t)row * 768 + col, o);
}
__device__ __forceinline__ void xjob_kv(Frame& F, unsigned char* ws, int j, bool is_v) {
    ws = opaque_g(ws);
    const int tid = fresh_tid(F.wave);
    LAS float* P = (LAS float*)(F.lds + RING_OFF);
    float v[8];
    skinny64(F.wave, tid, (const bf16*)(ws + WS_CKVB), KVR, (const bf16*)(ws + (is_v ? WS_WUV : WS_WUK)), 64 * j, P, v);
    const int r = tid >> 3, cg = tid & 7, row = XROW0 + r, col = 64 * j + 8 * cg;
    const float rs = row_rscale4((const float*)(ws + WS_SSQKV), row, 1.f / KVR);
#pragma unroll
    for (int k = 0; k < 8; ++k) v[k] *= rs;
    if (!is_v) st8_bf16((bf16*)(ws + WS_KN) + (size_t)row * 512 + col, v);
    else { bf16* VT = (bf16*)(ws + WS_VT);
#pragma unroll
        for (int k = 0; k < 8; ++k) VT[(size_t)(col + k) * MP + row] = bf1(v[k]); }
}
__device__ __forceinline__ void xjob_mix(Frame& F, unsigned char* ws, int j) {
    ws = opaque_g(ws);
    const int tid = fresh_tid(F.wave);
    LAS float* P = (LAS float*)(F.lds + RING_OFF);
    float a[8], b[8], o[8];
    skinny64(F.wave, tid, (const bf16*)(ws + WS_AV), 512, (const bf16*)(ws + WS_WMO), 64 * j, P, a);
    skinny64(F.wave, tid, (const bf16*)(ws + WS_RIN), D, (const bf16*)(ws + WS_WRO), 64 * j, P, b);
    const int r = tid >> 3, cg = tid & 7, row = XROW0 + r, col = 64 * j + 8 * cg;
    const u32x4 ga = *(const u32x4*)((const bf16*)(ws + WS_SGA) + (size_t)row * 1024 + col), gb = *(const u32x4*)((const bf16*)(ws + WS_SGB) + (size_t)row * 1024 + col);
#pragma unroll
    for (int k = 0; k < 8; ++k) { const unsigned wa = ga[k >> 1], wb = gb[k >> 1];
        const float fa = __uint_as_float((k & 1) ? (wa & 0xffff0000u) : (wa << 16)), fb = __uint_as_float((k & 1) ? (wb & 0xffff0000u) : (wb << 16));
        o[k] = fa * a[k] + fb * b[k]; }
    st8_bf16((bf16*)(ws + WS_MX) + (size_t)row * 1024 + col, o);
}
}
namespace mk {
constexpr int RC_STR = 272;
constexpr int RC_S = 0, RC_KT = 0  , RC_Q = 256 * RC_STR, RC_A = RC_Q + 128 * RC_STR, RC_RED = RC_A + 128 * RC_STR, RC_END = RC_RED + 2 * 8 * 128 * 4;
static_assert(RC_END <= SCR_BYTES, "chain LDS map");
__device__ __forceinline__ void ret_chain_unit(Frame& F, const Ptrs& a, int bh) {
    unsigned char* ws = a.ws; ws = opaque_g(ws);
    const int tid_k = fresh_tid(F.wave), w = F.wave;
    const int hh = bh & 3, b = bh >> 2;
    LAS unsigned char* L = F.lds + RING_OFF;
    LAS float* red = (LAS float*)(L + RC_RED);
    const bf16* RQ = (const bf16*)(ws + WS_RQ); const bf16* RK = (const bf16*)(ws + WS_RK); const bf16* RKT = (const bf16*)(ws + WS_RKT); const bf16* RVT = (const bf16*)(ws + WS_RVT);
    const float g = gpow_t(ws, hh, 1), g127 = gpow_t(ws, hh, 127);
    f32x16 S[4];
    {
        const int lane = tid_k & 63, r32 = lane & 31, half = lane >> 5;
#pragma unroll
        for (int db = 0; db < 4; ++db)
#pragma unroll
            for (int i = 0; i < 16; ++i) S[db][i] = 0.f;
        const bf16x8 af = *(const bf16x8*)(RVT + (size_t)(hh * 256 + 32 * w + r32) * MP + ROW_META + 8 * half);
#pragma unroll
        for (int db = 0; db < 4; ++db) { const bf16x8 bf = *(const bf16x8*)(RKT + (size_t)(hh * 128 + 32 * db + r32) * MP + ROW_META + 8 * half); S[db] = __builtin_amdgcn_mfma_f32_32x32x16_bf16(af, bf, S[db], 0, 0, 0); }
        const float sc = gpow_t(ws, hh, NMETA - 1);
#pragma unroll
        for (int db = 0; db < 4; ++db)
#pragma unroll
            for (int i = 0; i < 16; ++i) S[db][i] *= sc;
    }
    v4u qreg[4], jreg[4];
#define RC_FETCH_QK(tok0_) do { _Pragma("unroll") for (int k = 0; k < 4; ++k) { const int ch = tid + 512 * k; \
        qreg[k] = *(const v4u*)(RQ + (size_t)((tok0_) + (ch >> 4)) * 512 + hh * 128 + 8 * (ch & 15)); jreg[k] = *(const v4u*)(RK + (size_t)((tok0_) + (ch >> 4)) * 512 + hh * 128 + 8 * (ch & 15)); } } while (0)
    { const int tid = tid_k; RC_FETCH_QK(b * SEQ); }
#define RC_BLK_IB(n) ((n) < 1 ? 0 : (n) < 3 ? 1 : (n) < 6 ? 2 : 3)
#define RC_BLK_JB(n) ((n) - ((n) < 1 ? 0 : (n) < 3 ? 1 : (n) < 6 ? 3 : 6))
#pragma unroll 1
    for (int c = 0; c < 16; ++c) {
        const int tok0 = b * SEQ + c * 128;
        int tid_c = tid_k; asm volatile("" : "+v"(tid_c));
        const int tid = tid_c, lane = tid & 63, r32 = lane & 31, half = lane >> 5;
#pragma unroll
        for (int k = 0; k < 4; ++k) { const int ch = tid + 512 * k; *(LAS v4u*)(L + RC_Q + (ch >> 4) * RC_STR + 16 * (ch & 15)) = qreg[k]; *(LAS v4u*)(L + RC_S + (ch >> 4) * RC_STR + 16 * (ch & 15)) = jreg[k]; }
        __syncthreads();
        v4u kreg[4];
#pragma unroll
        for (int k = 0; k < 4; ++k) { const int ch = tid + 512 * k; kreg[k] = *(const v4u*)(RKT + (size_t)(hh * 128 + (ch >> 4)) * MP + tok0 + 8 * (ch & 15)); }
        for (int n = w; n < 10; n += 8) {
            const int ib_ = RC_BLK_IB(n), jb_ = RC_BLK_JB(n);
            f32x16 at;
#pragma unroll
            for (int i = 0; i < 16; ++i) at[i] = 0.f;
#pragma unroll
            for (int s = 0; s < 8; ++s) { const bf16x8 kf = *(const LAS bf16x8*)(L + RC_S + (32 * jb_ + r32) * RC_STR + (16 * s + 8 * half) * 2); const bf16x8 qf = *(const LAS bf16x8*)(L + RC_Q + (32 * ib_ + r32) * RC_STR + (16 * s + 8 * half) * 2); at = __builtin_amdgcn_mfma_f32_32x32x16_bf16(kf, qf, at, 0, 0, 0); }
            if (jb_ == ib_) {
#pragma unroll
                for (int i = 0; i < 16; ++i) if (crow(i, half) > r32) at[i] = 0.f; }
#pragma unroll
            for (int gq = 0; gq < 4; ++gq) { f32x4 o_; o_[0] = at[4 * gq]; o_[1] = at[4 * gq + 1]; o_[2] = at[4 * gq + 2]; o_[3] = at[4 * gq + 3];
                *(LAS u32x2*)(L + RC_A + (32 * ib_ + r32) * RC_STR + (32 * jb_ + 8 * gq + 4 * half) * 2) = pack4(o_); }
        }
        __syncthreads();
#pragma unroll
        for (int db = 0; db < 4; ++db)
#pragma unroll
            for (int i = 0; i < 16; ++i) *(LAS bf16*)(L + RC_S + (32 * w + crow(i, half)) * RC_STR + (32 * db + r32) * 2) = bf1(S[db][i]);
        f32x16 ot[4];
#pragma unroll
        for (int ib = 0; ib < 4; ++ib)
#pragma unroll
            for (int i = 0; i < 16; ++i) ot[ib][i] = 0.f;
#pragma unroll 2
        for (int s = 0; s < 8; ++s) {
            const bf16x8 sf = *(const LAS bf16x8*)(L + RC_S + (32 * w + r32) * RC_STR + (16 * s + 8 * half) * 2);
#pragma unroll
            for (int ib = 0; ib < 4; ++ib) { const bf16x8 qf = *(const LAS bf16x8*)(L + RC_Q + (32 * ib + r32) * RC_STR + (16 * s + 8 * half) * 2); ot[ib] = __builtin_amdgcn_mfma_f32_32x32x16_bf16(sf, qf, ot[ib], 0, 0, 0); }
        }
#pragma unroll
        for (int ib = 0; ib < 4; ++ib)
#pragma unroll
            for (int i = 0; i < 16; ++i) ot[ib][i] *= g;
        __syncthreads();
#pragma unroll
        for (int k = 0; k < 4; ++k) { const int ch = tid + 512 * k; *(LAS v4u*)(L + RC_KT + (ch >> 4) * RC_STR + 16 * (ch & 15)) = kreg[k]; }
        __syncthreads();
        if (c < 15) RC_FETCH_QK(tok0 + 128);
#pragma unroll
        for (int db = 0; db < 4; ++db)
#pragma unroll
            for (int i = 0; i < 16; ++i) S[db][i] *= g;
        {
            const bf16* vp = RVT + (size_t)(hh * 256 + 32 * w + r32) * MP + tok0 + 8 * half;
            bf16x8 v0 = *(const bf16x8*)(vp), v1 = *(const bf16x8*)(vp + 16), v2 = v1;
#pragma unroll 1
            for (int s = 0; s < 8; ++s) {
                if (s + 2 < 8) v2 = *(const bf16x8*)(vp + 16 * (s + 2));
#pragma unroll
                for (int ib = 0; ib < 4; ++ib) if (s < 2 * (ib + 1)) { const bf16x8 af = *(const LAS bf16x8*)(L + RC_A + (32 * ib + r32) * RC_STR + (16 * s + 8 * half) * 2); ot[ib] = __builtin_amdgcn_mfma_f32_32x32x16_bf16(v0, af, ot[ib], 0, 0, 0); }
#pragma unroll
                for (int db = 0; db < 4; ++db) { const bf16x8 kf = *(const LAS bf16x8*)(L + RC_KT + (32 * db + r32) * RC_STR + (16 * s + 8 * half) * 2); S[db] = __builtin_amdgcn_mfma_f32_32x32x16_bf16(v0, kf, S[db], 0, 0, 0); }
                v0 = v1; v1 = v2;
            }
        }
#pragma unroll
        for (int db = 0; db < 4; ++db)
#pragma unroll
            for (int i = 0; i < 16; ++i) S[db][i] *= g127;
#pragma unroll
        for (int ib = 0; ib < 4; ++ib) { float t = 0.f;
#pragma unroll
            for (int i = 0; i < 16; ++i) t += ot[ib][i];
            t += lx(t, lane, 32); if (half == 0) red[w * 128 + 32 * ib + r32] = t; }
        __syncthreads();
        float mu[4];
#pragma unroll
        for (int ib = 0; ib < 4; ++ib) { float t = 0.f;
#pragma unroll
            for (int ww = 0; ww < 8; ++ww) t += red[ww * 128 + 32 * ib + r32];
            mu[ib] = t * (1.f / 256.f); }
#pragma unroll
        for (int ib = 0; ib < 4; ++ib) { float t = 0.f;
#pragma unroll
            for (int i = 0; i < 16; ++i) { ot[ib][i] -= mu[ib]; t += ot[ib][i] * ot[ib][i]; }
            t += lx(t, lane, 32); if (half == 0) red[1024 + w * 128 + 32 * ib + r32] = t; }
        __syncthreads();
#pragma unroll
        for (int ib = 0; ib < 4; ++ib) { float t = 0.f;
#pragma unroll
            for (int ww = 0; ww < 8; ++ww) t += red[1024 + ww * 128 + 32 * ib + r32];
            const float rstd = 1.0f / sqrtf(t * (1.f / 256.f) + EPS);
            const int irow = tok0 + 32 * ib + r32;
            const bf16* SRG = (const bf16*)(ws + WS_SRG) + (size_t)irow * 1024 + hh * 256 + 32 * w + 4 * half;
            bf16* RIN = (bf16*)(ws + WS_RIN) + (size_t)irow * 1024 + hh * 256 + 32 * w + 4 * half;
            const float* gn = a.in(19) + hh * 256 + 32 * w + 4 * half;
#pragma unroll
            for (int gq = 0; gq < 4; ++gq) {
                const u32x2 sg = *(const u32x2*)(SRG + 8 * gq); const f32x4 gv = *(const f32x4*)(gn + 8 * gq);
                f32x4 o;
                o[0] = ot[ib][4 * gq + 0] * rstd * gv[0] * __uint_as_float(sg.x << 16); o[1] = ot[ib][4 * gq + 1] * rstd * gv[1] * __uint_as_float(sg.x & 0xffff0000u);
                o[2] = ot[ib][4 * gq + 2] * rstd * gv[2] * __uint_as_float(sg.y << 16); o[3] = ot[ib][4 * gq + 3] * rstd * gv[3] * __uint_as_float(sg.y & 0xffff0000u);
                *(u32x2*)(RIN + 8 * gq) = pack4(o);
            } }
        __syncthreads();
    }
#undef RC_FETCH_QK
#undef RC_BLK_IB
#undef RC_BLK_JB
    const int lane = tid_k & 63, r32 = lane & 31, half = lane >> 5;
#pragma unroll
    for (int db = 0; db < 4; ++db)
#pragma unroll
        for (int i = 0; i < 16; ++i) a.out()[OUT_SRP + ((size_t)bh * RDK + 32 * db + r32) * RDV + 32 * w + crow(i, half)] = S[db][i];
}
}
namespace mk {
constexpr int CW_FLAG = 8192;
__device__ __forceinline__ void st16_wt(void* p, v4u v) { asm volatile("global_store_dwordx4 %0, %1, off sc1\n\ts_nop 1" :: "v"(p), "v"(v) : "memory"); }
__device__ __forceinline__ void ret_state_unit(Frame& F, const Ptrs& a, int bh) {
    unsigned char* ws = opaque_g(a.ws);
    const int tid_k = fresh_tid(F.wave), w = F.wave;
    const int hh = bh & 3, b = bh >> 2;
    LAS unsigned char* L = F.lds + RING_OFF;
    const bf16* RKT = (const bf16*)(ws + WS_RKT); const bf16* RVT = (const bf16*)(ws + WS_RVT);
    const float g = gpow_t(ws, hh, 1), g127 = gpow_t(ws, hh, 127);
    f32x16 S[4];
    bf16x8 vf[8]; v4u kreg[4];
#define RS_FETCH(tok0_) do { _Pragma("unroll") for (int s = 0; s < 8; ++s) vf[s] = *(const bf16x8*)(RVT + (size_t)(hh * 256 + 32 * w + r32) * MP + (tok0_) + 16 * s + 8 * half); \
        _Pragma("unroll") for (int k = 0; k < 4; ++k) { const int ch = tid + 512 * k; kreg[k] = *(const v4u*)(RKT + (size_t)(hh * 128 + (ch >> 4)) * MP + (tok0_) + 8 * (ch & 15)); } } while (0)
    {   const int tid = tid_k, lane = tid & 63, r32 = lane & 31, half = lane >> 5;
#pragma unroll
        for (int db = 0; db < 4; ++db)
#pragma unroll
            for (int i = 0; i < 16; ++i) S[db][i] = 0.f;
        const bf16x8 af = *(const bf16x8*)(RVT + (size_t)(hh * 256 + 32 * w + r32) * MP + ROW_META + 8 * half);
#pragma unroll
        for (int db = 0; db < 4; ++db) { const bf16x8 bf = *(const bf16x8*)(RKT + (size_t)(hh * 128 + 32 * db + r32) * MP + ROW_META + 8 * half); S[db] = __builtin_amdgcn_mfma_f32_32x32x16_bf16(af, bf, S[db], 0, 0, 0); }
        const float sc = gpow_t(ws, hh, NMETA - 1);
#pragma unroll
        for (int db = 0; db < 4; ++db)
#pragma unroll
            for (int i = 0; i < 16; ++i) S[db][i] *= sc;
        RS_FETCH(b * SEQ);
    }
#pragma unroll 1
    for (int c = 0; c < 16; ++c) {
        const int tok0 = b * SEQ + c * 128, u = bh * 16 + c;
        int tid_c = tid_k; asm volatile("" : "+v"(tid_c));
        const int tid = tid_c, lane = tid & 63, r32 = lane & 31, half = lane >> 5;
#pragma unroll
        for (int k = 0; k < 4; ++k) { const int ch = tid + 512 * k; *(LAS v4u*)(L + RC_Q + (ch >> 4) * RC_STR + 16 * (ch & 15)) = kreg[k]; }
#pragma unroll
        for (int db = 0; db < 4; ++db)
#pragma unroll
            for (int i = 0; i < 16; ++i) *(LAS bf16*)(L + (32 * w + crow(i, half)) * RC_STR + (32 * db + r32) * 2) = bf1(S[db][i]);
        __syncthreads();
        { bf16* SP = (bf16*)(ws + WS_SPREV) + (size_t)u * 32768;
#pragma unroll
          for (int k = 0; k < 8; ++k) { const int ch = lane + 64 * k, row = 32 * w + (ch >> 4); st16_wt(SP + (size_t)row * 128 + 8 * (ch & 15), *(const LAS v4u*)(L + row * RC_STR + 16 * (ch & 15))); } }
        bf16x8 vfn[8]; v4u kregn[4];
        if (c < 15) {
#pragma unroll
            for (int s = 0; s < 8; ++s) vfn[s] = *(const bf16x8*)(RVT + (size_t)(hh * 256 + 32 * w + r32) * MP + tok0 + 128 + 16 * s + 8 * half);
#pragma unroll
            for (int k = 0; k < 4; ++k) { const int ch = tid + 512 * k; kregn[k] = *(const v4u*)(RKT + (size_t)(hh * 128 + (ch >> 4)) * MP + tok0 + 128 + 8 * (ch & 15)); }
        } else {
#pragma unroll
            for (int s = 0; s < 8; ++s) vfn[s] = vf[s];
#pragma unroll
            for (int k = 0; k < 4; ++k) kregn[k] = kreg[k];
        }
#pragma unroll
        for (int db = 0; db < 4; ++db) {
#pragma unroll
            for (int i = 0; i < 16; ++i) S[db][i] *= g;
#pragma unroll
            for (int s = 0; s < 8; ++s) { const bf16x8 kf = *(const LAS bf16x8*)(L + RC_Q + (32 * db + r32) * RC_STR + (16 * s + 8 * half) * 2); S[db] = __builtin_amdgcn_mfma_f32_32x32x16_bf16(vf[s], kf, S[db], 0, 0, 0); }
#pragma unroll
            for (int i = 0; i < 16; ++i) S[db][i] *= g127;
        }
        asm volatile("s_waitcnt vmcnt(0)" ::: "memory");
#pragma unroll
        for (int s = 0; s < 8; ++s) vf[s] = vfn[s];
#pragma unroll
        for (int k = 0; k < 4; ++k) kreg[k] = kregn[k];
        __syncthreads();
        if (tid == 0) __hip_atomic_store((unsigned*)(ws + WS_CTL) + CW_FLAG + 16 * u, 1u, __ATOMIC_RELAXED, __HIP_MEMORY_SCOPE_AGENT);
    }
#undef RS_FETCH
    {   const int lane = tid_k & 63, r32 = lane & 31, half = lane >> 5;
#pragma unroll
        for (int db = 0; db < 4; ++db)
#pragma unroll
            for (int i = 0; i < 16; ++i) a.out()[OUT_SRP + ((size_t)bh * RDK + 32 * db + r32) * RDV + 32 * w + crow(i, half)] = S[db][i]; }
    __syncthreads();
}
__device__ __forceinline__ void ret_out_unit(Frame& F, const Ptrs& a, int u) {
    unsigned char* ws = opaque_g(a.ws);
    const int tid = fresh_tid(F.wave), lane = tid & 63, w = F.wave, r32 = lane & 31, half = lane >> 5;
    const int bh = u >> 4, c = u & 15, hh = bh & 3, tok0 = (bh >> 2) * SEQ + c * 128;
    LAS unsigned char* L = F.lds + RING_OFF;
    LAS float* red = (LAS float*)(L + RC_RED);
    const bf16* RQ = (const bf16*)(ws + WS_RQ); const bf16* RK = (const bf16*)(ws + WS_RK); const bf16* RVT = (const bf16*)(ws + WS_RVT);
    v4u qreg[4], jreg[4];
#pragma unroll
    for (int k = 0; k < 4; ++k) { const int ch = tid + 512 * k; qreg[k] = *(const v4u*)(RQ + (size_t)(tok0 + (ch >> 4)) * 512 + hh * 128 + 8 * (ch & 15)); jreg[k] = *(const v4u*)(RK + (size_t)(tok0 + (ch >> 4)) * 512 + hh * 128 + 8 * (ch & 15)); }
    if (tid == 0) { const unsigned* fl = (const unsigned*)(ws + WS_CTL) + CW_FLAG + 16 * u; unsigned spins = 0;
        while (__hip_atomic_load(fl, __ATOMIC_RELAXED, __HIP_MEMORY_SCOPE_AGENT) == 0u && ++spins < (1u << 22)) __builtin_amdgcn_s_sleep(8);
        __builtin_amdgcn_fence(__ATOMIC_ACQUIRE, "agent"); asm volatile("s_waitcnt vmcnt(0)" ::: "memory"); }
    __syncthreads();
    v4u sreg[8];
    { const bf16* SP = (const bf16*)(ws + WS_SPREV) + (size_t)u * 32768;
#pragma unroll
      for (int k = 0; k < 8; ++k) { const int ch = tid + 512 * k; sreg[k] = *(const v4u*)(SP + (size_t)(ch >> 4) * 128 + 8 * (ch & 15)); } }
#pragma unroll
    for (int k = 0; k < 4; ++k) { const int ch = tid + 512 * k; *(LAS v4u*)(L + RC_Q + (ch >> 4) * RC_STR + 16 * (ch & 15)) = qreg[k]; *(LAS v4u*)(L + RC_S + (ch >> 4) * RC_STR + 16 * (ch & 15)) = jreg[k]; }
    __syncthreads();
#define RC_BLK_IB(n) ((n) < 1 ? 0 : (n) < 3 ? 1 : (n) < 6 ? 2 : 3)
#define RC_BLK_JB(n) ((n) - ((n) < 1 ? 0 : (n) < 3 ? 1 : (n) < 6 ? 3 : 6))
    for (int n = w; n < 10; n += 8) {
        const int ib_ = RC_BLK_IB(n), jb_ = RC_BLK_JB(n);
        f32x16 at;
#pragma unroll
        for (int i = 0; i < 16; ++i) at[i] = 0.f;
#pragma unroll
        for (int s = 0; s < 8; ++s) { const bf16x8 kf = *(const LAS bf16x8*)(L + RC_S + (32 * jb_ + r32) * RC_STR + (16 * s + 8 * half) * 2); const bf16x8 qf = *(const LAS bf16x8*)(L + RC_Q + (32 * ib_ + r32) * RC_STR + (16 * s + 8 * half) * 2); at = __builtin_amdgcn_mfma_f32_32x32x16_bf16(kf, qf, at, 0, 0, 0); }
        if (jb_ == ib_) {
#pragma unroll
            for (int i = 0; i < 16; ++i) if (crow(i, half) > r32) at[i] = 0.f; }
#pragma unroll
        for (int gq = 0; gq < 4; ++gq) { f32x4 o_; o_[0] = at[4 * gq]; o_[1] = at[4 * gq + 1]; o_[2] = at[4 * gq + 2]; o_[3] = at[4 * gq + 3];
            *(LAS u32x2*)(L + RC_A + (32 * ib_ + r32) * RC_STR + (32 * jb_ + 8 * gq + 4 * half) * 2) = pack4(o_); }
    }
#undef RC_BLK_IB
#undef RC_BLK_JB
    __syncthreads();
#pragma unroll
    for (int k = 0; k < 8; ++k) { const int ch = tid + 512 * k; *(LAS v4u*)(L + RC_S + (ch >> 4) * RC_STR + 16 * (ch & 15)) = sreg[k]; }
    __syncthreads();
    const float g = gpow_t(ws, hh, 1);
    f32x16 ot[4];
#pragma unroll
    for (int ib = 0; ib < 4; ++ib)
#pragma unroll
        for (int i = 0; i < 16; ++i) ot[ib][i] = 0.f;
#pragma unroll 2
    for (int s = 0; s < 8; ++s) {
        const bf16x8 sf = *(const LAS bf16x8*)(L + RC_S + (32 * w + r32) * RC_STR + (16 * s + 8 * half) * 2);
#pragma unroll
        for (int ib = 0; ib < 4; ++ib) { const bf16x8 qf = *(const LAS bf16x8*)(L + RC_Q + (32 * ib + r32) * RC_STR + (16 * s + 8 * half) * 2); ot[ib] = __builtin_amdgcn_mfma_f32_32x32x16_bf16(sf, qf, ot[ib], 0, 0, 0); }
    }
#pragma unroll
    for (int ib = 0; ib < 4; ++ib)
#pragma unroll
        for (int i = 0; i < 16; ++i) ot[ib][i] *= g;
    bf16x8 vf[8];
#pragma unroll
    for (int s = 0; s < 8; ++s) vf[s] = *(const bf16x8*)(RVT + (size_t)(hh * 256 + 32 * w + r32) * MP + tok0 + 16 * s + 8 * half);
#pragma unroll
    for (int ib = 0; ib < 4; ++ib)
#pragma unroll
        for (int s = 0; s < 2 * (ib + 1); ++s) { const bf16x8 af = *(const LAS bf16x8*)(L + RC_A + (32 * ib + r32) * RC_STR + (16 * s + 8 * half) * 2); ot[ib] = __builtin_amdgcn_mfma_f32_32x32x16_bf16(vf[s], af, ot[ib], 0, 0, 0); }
#pragma unroll
    for (int ib = 0; ib < 4; ++ib) { float t = 0.f;
#pragma unroll
        for (int i = 0; i < 16; ++i) t += ot[ib][i];
        t += lx(t, lane, 32); if (half == 0) red[w * 128 + 32 * ib + r32] = t; }
    __syncthreads();
    float mu[4];
#pragma unroll
    for (int ib = 0; ib < 4; ++ib) { float t = 0.f;
#pragma unroll
        for (int ww = 0; ww < 8; ++ww) t += red[ww * 128 + 32 * ib + r32];
        mu[ib] = t * (1.f / 256.f); }
#pragma unroll
    for (int ib = 0; ib < 4; ++ib) { float t = 0.f;
#pragma unroll
        for (int i = 0; i < 16; ++i) { ot[ib][i] -= mu[ib]; t += ot[ib][i] * ot[ib][i]; }
        t += lx(t, lane, 32); if (half == 0) red[1024 + w * 128 + 32 * ib + r32] = t; }
    __syncthreads();
#pragma unroll
    for (int ib = 0; ib < 4; ++ib) { float t = 0.f;
#pragma unroll
        for (int ww = 0; ww < 8; ++ww) t += red[1024 + ww * 128 + 32 * ib + r32];
        const float rstd = 1.0f / sqrtf(t * (1.f / 256.f) + EPS);
        const int irow = tok0 + 32 * ib + r32;
        const bf16* SRG = (const bf16*)(ws + WS_SRG) + (size_t)irow * 1024 + hh * 256 + 32 * w + 4 * half;
        bf16* RIN = (bf16*)(ws + WS_RIN) + (size_t)irow * 1024 + hh * 256 + 32 * w + 4 * half;
        const float* gn = a.in(19) + hh * 256 + 32 * w + 4 * half;
#pragma unroll
        for (int gq = 0; gq < 4; ++gq) {
            const u32x2 sg = *(const u32x2*)(SRG + 8 * gq); const f32x4 gv = *(const f32x4*)(gn + 8 * gq);
            f32x4 o;
            o[0] = ot[ib][4 * gq + 0] * rstd * gv[0] * __uint_as_float(sg.x << 16); o[1] = ot[ib][4 * gq + 1] * rstd * gv[1] * __uint_as_float(sg.x & 0xffff0000u);
            o[2] = ot[ib][4 * gq + 2] * rstd * gv[2] * __uint_as_float(sg.y << 16); o[3] = ot[ib][4 * gq + 3] * rstd * gv[3] * __uint_as_float(sg.y & 0xffff0000u);
            *(u32x2*)(RIN + 8 * gq) = pack4(o);
        } }
    __syncthreads();
}
}
namespace mk {
__global__ void __launch_bounds__(NWAVES * 64, 2) mega_fwd(Args args) {
    extern __shared__ __attribute__((aligned(16))) unsigned char lds[];
    Frame F;
    F.lds = (LAS unsigned char*)lds;
    F.MISC = (volatile LAS unsigned*)(F.lds + MISC_OFF);
    F.wave = __builtin_amdgcn_readfirstlane((int)threadIdx.x >> 6);
    F.G = gridDim.x; { const int bx = blockIdx.x; F.vcu = (F.G % 8 == 0) ? (bx % 8) * (F.G / 8) + bx / 8 : bx; }
    unsigned char* const ws_k = args.ws;
    unsigned char* ws = ws_k;
    for (int u = threadIdx.x; u < (LDS_BYTES - LDSCTL_OFF) / 4; u += NWAVES * 64) ((LAS unsigned*)(F.lds + LDSCTL_OFF))[u] = 0u;
    __syncthreads();
    {
        volatile LAS unsigned long long* pt = (volatile LAS unsigned long long*)(F.lds + PT_OFF);
        if (threadIdx.x == 0) {
#define PT_PUT(i) pt[i] = (unsigned long long)args.in[i]
            PT_PUT(0); PT_PUT(1); PT_PUT(2); PT_PUT(3); PT_PUT(4); PT_PUT(5); PT_PUT(6); PT_PUT(7); PT_PUT(8); PT_PUT(9); PT_PUT(10); PT_PUT(11); PT_PUT(12); PT_PUT(13);
            PT_PUT(14); PT_PUT(15); PT_PUT(16); PT_PUT(17); PT_PUT(18); PT_PUT(19); PT_PUT(20); PT_PUT(21); PT_PUT(22); PT_PUT(23); PT_PUT(24); PT_PUT(25); PT_PUT(26);
#undef PT_PUT
            pt[27] = (unsigned long long)args.out;
        }
        __syncthreads();
    }
    const Ptrs P{ws_k, (volatile LAS unsigned*)(F.lds + PT_OFF)};
    (void)xcd_barrier_post((unsigned*)(ws_k + WS_CTL) + CW_BAR, F.MISC + 8, F.wave);
#if MK_PROBE
#define STAMP(k) do { if (blockIdx.x == 0 && F.wave == 0 && lane_fresh() == 0) ((unsigned long long*)(ws_k + WS_CTL + 512 * 1024))[k] = __builtin_amdgcn_s_memrealtime(); } while (0)
    STAMP(0);
#else
#define STAMP(k) do { } while (0)
#endif
#define WS_FRESH() unsigned char* ws = opaque_g(ws_k)
#define GRID_BAR() do { XcdBarrier b_; b_.bar = (unsigned*)(ws_k + WS_CTL) + CW_BAR; b_.x = xb_xcc_id(); b_.st = F.MISC + 8; b_.wave = F.wave; xcd_barrier(b_); } while (0)

    p0_prologue(F, args);
    GRID_BAR(); STAMP(1);
    {
        WS_FRESH();
        { const int bx = (int)blockIdx.x; if (bx >= 128 && bx < 172) xjob_ffn_up(F, ws, bx - 128, WS_XB, WS_W1T, 0); }
        pg8::Gemm g{(const pg8::bf16_t*)(ws + WS_XB), (const pg8::bf16_t*)(ws + WS_W1T), MMAIN, 2 * FFN, D};
        pg8::StaticOrder S; S.init(MMAIN, 2 * FFN, F.G, (int)blockIdx.x);
        EpiSwiGLU E{(bf16*)(ws + WS_ACT), (const float*)(ws + WS_R1)};
        pg8::gemm_phase<EpiSwiGLU, pg8::StaticOrder, true, true>(F.lds + RING_OFF, g, S, E, F.wave);
    }
    GRID_BAR(); STAMP(2);
    {
        WS_FRESH();
        { const int bx = (int)blockIdx.x; if (bx < 16) xjob_resid(F, ws, bx, WS_ACT, FFN, WS_W1D, (const float*)(ws + WS_XE), 0.5f, WS_H, WS_HB, WS_SSQH); }
        pg8::Gemm g{(const pg8::bf16_t*)(ws + WS_ACT), (const pg8::bf16_t*)(ws + WS_W1D), MMAIN, D, FFN};
        pg8::StaticOrder S; S.init(MMAIN, D, F.G, (int)blockIdx.x);
        typedef EpiResid<(unsigned)WS_XE, true, (unsigned)WS_H, (unsigned)WS_HB, (unsigned)WS_SSQH, 1> EpiDown1;
        EpiDown1 E{ws, P.in(0)};
        pg8::gemm_phase<EpiDown1, pg8::StaticOrder, true, true>(F.lds + RING_OFF, g, S, E, F.wave);
    }
    GRID_BAR(); STAMP(3);
#ifndef NO_P3
    {
        WS_FRESH();
        { const int bx = (int)blockIdx.x; if (bx >= 192 && bx < 238) xjob_win(F, ws, bx - 192); }
        pg8::Gemm g{(const pg8::bf16_t*)(ws + WS_HB), (const pg8::bf16_t*)(ws + WS_WIN), MMAIN, NWIN, D};
        pg8::StaticOrder S; S.init(MMAIN, NWIN, F.G, (int)blockIdx.x);
        EpiWin E{ws};
        pg8::gemm_phase<EpiWin, pg8::StaticOrder, true, true>(F.lds + RING_OFF, g, S, E, F.wave);
    }
#endif
    GRID_BAR(); STAMP(4);
    {
        WS_FRESH();
        { const int jb = (int)blockIdx.x - 192; if (jb >= 0 && jb < 12) xjob_q(F, ws, jb); else if (jb >= 12 && jb < 20) xjob_kv(F, ws, jb - 12, false); else if (jb >= 20 && jb < 28) xjob_kv(F, ws, jb - 20, true); }
        finalize_ckv(F, P);
#ifndef NO_P4Q
        {   pg8::Gemm g{(const pg8::bf16_t*)(ws + WS_CQ), (const pg8::bf16_t*)(ws + WS_WUQ), MMAIN, 768, QR};
            pg8::StaticOrder S; S.init(MMAIN, 768, F.G, (int)blockIdx.x);
            EpiQ E{ws};
            pg8::gemm_phase<EpiQ, pg8::StaticOrder, true, true>(F.lds + RING_OFF, g, S, E, F.wave); }
#endif
#ifndef NO_P4K
        {   pg8::Gemm g{(const pg8::bf16_t*)(ws + WS_CKVB), (const pg8::bf16_t*)(ws + WS_WUK), MMAIN, 512, KVR};
            pg8::StaticOrder S; S.init(MMAIN, 512, F.G, (int)((blockIdx.x + 64) % F.G));
            EpiScaleBf16<true> E{(const float*)(ws + WS_SSQKV), (bf16*)(ws + WS_KN), 512};
            pg8::gemm_phase<EpiScaleBf16<true>, pg8::StaticOrder, true, true>(F.lds + RING_OFF, g, S, E, F.wave); }
#endif
#ifndef NO_P4V
        {   pg8::Gemm g{(const pg8::bf16_t*)(ws + WS_WUV), (const pg8::bf16_t*)(ws + WS_CKVB), 512, MMAIN, KVR};
            pg8::StaticOrder S; S.init(512, MMAIN, F.G, (int)((blockIdx.x + 192) % F.G));
            EpiScaleBf16<false> E{(const float*)(ws + WS_SSQKV), (bf16*)(ws + WS_VT), MP};
            pg8::gemm_phase<EpiScaleBf16<false>, pg8::StaticOrder, true, true>(F.lds + RING_OFF, g, S, E, F.wave); }
#endif
    }
    GRID_BAR(); STAMP(5);
    STAMP(32);
#define QUEUE_LOOP(qi, nitems, call) for (;;) { \
        if (F.wave == 0 && lane_fresh() == 0) F.MISC[16] = __hip_atomic_fetch_add((unsigned*)(ws_k + WS_CTL) + CW_QUEUE + 64 * (qi), 1u, __ATOMIC_RELAXED, __HIP_MEMORY_SCOPE_AGENT); \
        __syncthreads(); const int it = (int)F.MISC[16]; __syncthreads(); \
        if (it >= (nitems)) break; call; }
    if ((int)blockIdx.x < 32) ret_state_unit(F, P, (int)blockIdx.x);
    STAMP(33);
    QUEUE_LOOP(0, 512, attn_item(F, ws_k, it))
    STAMP(34);
    QUEUE_LOOP(3, 512, ret_out_unit(F, P, ((it & 31) << 4) | (it >> 5)))
    QUEUE_LOOP(1, 512, decode_unit(F, P, it))
    STAMP(35);
    QUEUE_LOOP(2, 128, ret_sample_unit(F, P, it))
#undef QUEUE_LOOP
    STAMP(36);
    GRID_BAR(); STAMP(6);
    STAMP(40);
    for (int u = (int)blockIdx.x; u < 256; u += F.G) decode_combine_unit(F, P, u);
    STAMP(42);
    GRID_BAR(); STAMP(7);
    {
        WS_FRESH();
        { const int bx = (int)blockIdx.x; if (bx < 16) xjob_mix(F, ws, bx); }
        {   pg8::Gemm g{(const pg8::bf16_t*)(ws + WS_AV), (const pg8::bf16_t*)(ws + WS_WMO), MMAIN, D, 512};
            pg8::StaticOrder S; S.init(MMAIN, D, F.G, (int)blockIdx.x);
            typedef EpiGate<0, (unsigned)WS_SGA> EpiGA; EpiGA E{ws};
            pg8::gemm_phase<EpiGA, pg8::StaticOrder, true, true>(F.lds + RING_OFF, g, S, E, F.wave); }
        {   pg8::Gemm g{(const pg8::bf16_t*)(ws + WS_RIN), (const pg8::bf16_t*)(ws + WS_WRO), MMAIN, D, D};
            pg8::StaticOrder S; S.init(MMAIN, D, F.G, (int)blockIdx.x);
            typedef EpiGate<1, (unsigned)WS_SGB> EpiGB; EpiGB E{ws};
            pg8::gemm_phase<EpiGB, pg8::StaticOrder, true, true>(F.lds + RING_OFF, g, S, E, F.wave); }
    }
    GRID_BAR(); STAMP(8);
    {
        WS_FRESH();
        { const int bx = (int)blockIdx.x; if (bx >= 16 && bx < 32) xjob_resid(F, ws, bx - 16, WS_MX, D, WS_WOUT, (const float*)(ws + WS_H) + (size_t)XROW0 * D, 1.0f, WS_H2, WS_H2B, WS_SSQH2); }
        pg8::Gemm g{(const pg8::bf16_t*)(ws + WS_MX), (const pg8::bf16_t*)(ws + WS_WOUT), MMAIN, D, D};
        pg8::StaticOrder S; S.init(MMAIN, D, F.G, (int)blockIdx.x);
        typedef EpiResid<(unsigned)WS_H, false, (unsigned)WS_H2, (unsigned)WS_H2B, (unsigned)WS_SSQH2, 2> EpiOut;
        EpiOut E{ws, nullptr};
        pg8::gemm_phase<EpiOut, pg8::StaticOrder, true, true>(F.lds + RING_OFF, g, S, E, F.wave);
    }
    GRID_BAR(); STAMP(9);
    {
        WS_FRESH();
        { const int bx = (int)blockIdx.x; if (bx >= 128 && bx < 172) xjob_ffn_up(F, ws, bx - 128, WS_H2B, WS_W2T, 1); }
        pg8::Gemm g{(const pg8::bf16_t*)(ws + WS_H2B), (const pg8::bf16_t*)(ws + WS_W2T), MMAIN, 2 * FFN, D};
        pg8::StaticOrder S; S.init(MMAIN, 2 * FFN, F.G, (int)blockIdx.x);
        EpiSwiGLU2 E{ws};
        pg8::gemm_phase<EpiSwiGLU2, pg8::StaticOrder, true, true>(F.lds + RING_OFF, g, S, E, F.wave);
    }
    GRID_BAR(); STAMP(10);
    {
        WS_FRESH();
        { const int bx = (int)blockIdx.x; if (bx >= 32 && bx < 48) xjob_resid(F, ws, bx - 32, WS_ACT, FFN, WS_W2D, (const float*)(ws + WS_H2) + (size_t)XROW0 * D, 0.5f, WS_H3, 0, WS_SSQH3); }
        pg8::Gemm g{(const pg8::bf16_t*)(ws + WS_ACT), (const pg8::bf16_t*)(ws + WS_W2D), MMAIN, D, FFN};
        pg8::StaticOrder S; S.init(MMAIN, D, F.G, (int)blockIdx.x);
        typedef EpiResid<(unsigned)WS_H2, false, (unsigned)WS_H3, 0u, (unsigned)WS_SSQH3, 1> EpiDown2;
        EpiDown2 E{ws, nullptr};
        pg8::gemm_phase<EpiDown2, pg8::StaticOrder, true, true>(F.lds + RING_OFF, g, S, E, F.wave);
    }
    GRID_BAR(); STAMP(11);
    final_norm_phase(F, P);
#if MK_PROBE
    GRID_BAR(); STAMP(12);
    if (blockIdx.x == 0) {
        asm volatile("s_waitcnt vmcnt(0)" ::: "memory"); __syncthreads();
        const unsigned long long* t = (const unsigned long long*)(ws_k + WS_CTL + 512 * 1024);
        const float dta = (float)(__hip_atomic_load(t + MK_PROBE_A + 1, __ATOMIC_RELAXED, __HIP_MEMORY_SCOPE_AGENT) - __hip_atomic_load(t + MK_PROBE_A, __ATOMIC_RELAXED, __HIP_MEMORY_SCOPE_AGENT)) * 0.01f;
        const float dtb = (float)(__hip_atomic_load(t + MK_PROBE_B + 1, __ATOMIC_RELAXED, __HIP_MEMORY_SCOPE_AGENT) - __hip_atomic_load(t + MK_PROBE_B, __ATOMIC_RELAXED, __HIP_MEMORY_SCOPE_AGENT)) * 0.01f;
        const float f = 1.f + sqrtf(dta / 20000.f);
        const int tid_p = fresh_tid(F.wave);
        for (int i = tid_p; i < NS * D; i += NWAVES * 64) P.out()[OUT_YS + i] *= f;
        if (tid_p == 0) P.out()[OUT_YP] += dtb / 5.f;
    }
#endif
#undef GRID_BAR
}
}
extern "C" void kernel_launch(void* const* d_in, const int* in_sizes, int n_in, void* d_out, int out_size, void* d_ws, size_t ws_size, hipStream_t stream) {
    static int grid = 0;
    if (grid == 0) {
        int dev = 0, cus = 0;
        if (n_in != 27 || out_size != (int)mk::OUT_END || ws_size < mk::WS_END6) { fprintf(stderr, "kernel_launch: unexpected problem shape (n_in %d, out %d, ws %zu); nothing launched\n", n_in, out_size, ws_size); grid = -1; return; }
        if (hipGetDevice(&dev) != hipSuccess || hipDeviceGetAttribute(&cus, hipDeviceAttributeMultiprocessorCount, dev) != hipSuccess) { fprintf(stderr, "kernel_launch: device query failed\n"); grid = -1; return; }
        if (hipFuncSetAttribute((const void*)mk::mega_fwd, hipFuncAttributeMaxDynamicSharedMemorySize, mk::LDS_BYTES) != hipSuccess) { fprintf(stderr, "kernel_launch: hipFuncSetAttribute failed\n"); grid = -1; return; }
        int per_cu = 0;
        if (hipOccupancyMaxActiveBlocksPerMultiprocessor(&per_cu, (const void*)mk::mega_fwd, mk::NWAVES * 64, mk::LDS_BYTES) != hipSuccess || per_cu < 1) fprintf(stderr, "kernel_launch: note: occupancy query reports %d workgroups per CU\n", per_cu);
        (void)hipGetLastError();
        grid = cus;
    }
    if (grid < 0) return;
    unsigned char* ws = (unsigned char*)d_ws;
    (void)hipMemsetAsync(ws + mk::WS_CTL, 0, mk::CTL_ZERO_BYTES, stream);
    mk::Args a{};
    for (int i = 0; i < 27; ++i) a.in[i] = (const float*)d_in[i];
    a.out = (float*)d_out; a.ws = ws;
    hipLaunchKernelGGL(mk::mega_fwd, dim3(grid), dim3(mk::NWAVES * 64), mk::LDS_BYTES, stream, a);
}
```

```cpp
#include <hip/hip_runtime.h>
#include <cstdio>
#include <cstdint>
#include <cmath>
#define MK_DEBUG 0
#ifndef MK_PROBE
#define MK_PROBE 0
#define MK_PROBE_A 0
#define MK_PROBE_B 1
#endif
__device__ __forceinline__ int lane_fresh() { int l; asm volatile("v_mbcnt_lo_u32_b32 %0, -1, 0\n\tv_mbcnt_hi_u32_b32 %0, -1, %0" : "=v"(l)); return l; }
__device__ __forceinline__ unsigned char* opaque_g(const unsigned char* p) { unsigned long long v = (unsigned long long)p; asm volatile("" : "+s"(v)); return (unsigned char*)(__attribute__((address_space(1))) unsigned char*)v; }
namespace pg8 {
#define PG8_LAS __attribute__((address_space(3)))
typedef unsigned short bf16_t;
typedef short bf16x8 __attribute__((ext_vector_type(8)));
typedef float f32x4 __attribute__((ext_vector_type(4)));
typedef unsigned u32x4 __attribute__((ext_vector_type(4)));
constexpr int BM = 256, BK = 64, HALF = 128, HTB = HALF * BK * 2  , STAGE_BYTES = 8 * HTB, NXCD = 8, WGM = 8;

__host__ __device__ __forceinline__ int lds_byte(int r, int c) { const int st = (r >> 4) * 2 + (c >> 5), rr = r & 15, cc = c & 31, ob = rr * 64 + cc * 2; return st * 1024 + (ob ^ (((ob >> 9) & 1) << 5)); }
__host__ __device__ __forceinline__ void stage_rc(int b, int& R, int& C) { const int st = b / 1024, sb = b % 1024, swz = sb ^ (((sb >> 9) & 1) << 5); R = (st >> 1) * 16 + swz / 64; C = (st & 1) * 32 + (swz % 64) / 2; }
__host__ __device__ __forceinline__ int perm32(int rho) { const int n = rho >> 4, i = rho & 15; return 8 * (i >> 2) + 4 * n + (i & 3); }

struct Unit { int pm, pn; };
struct Gemm { const bf16_t* A; const bf16_t* Bt; int M, N, K; };

struct StaticOrder {
    int nM, nN, nwg, G, c;
    __host__ __device__ void init(int M, int N, int G_, int c_) { nM = M / BM; nN = N / BM; nwg = nM * nN; G = G_; c = c_; }
    __host__ __device__ bool next(int i, Unit& u) const {
        const long L = (long)i * G + c; if (L >= nwg) return false;
        int wgid = (int)L; { const int q = nwg / NXCD, r = nwg % NXCD, xcd = wgid % NXCD, off = wgid / NXCD; wgid = (xcd < r ? xcd * (q + 1) : r * (q + 1) + (xcd - r) * q) + off; }
        const int nig = WGM * nN, gid = wgid / nig, fm = gid * WGM, gsz = (nM - fm) < WGM ? (nM - fm) : WGM;
        u.pm = fm + ((wgid % nig) % gsz); u.pn = (wgid % nig) / gsz; return true;
    }
    __device__ __forceinline__ void a_ready(const Unit&) const {}
    __device__ __forceinline__ void done(const Unit&) const {}
};

__device__ __forceinline__ unsigned cvt_pk_bf16(float lo, float hi) { unsigned r; asm volatile("v_cvt_pk_bf16_f32 %0, %1, %2" : "=v"(r) : "v"(lo), "v"(hi)); return r; }
typedef float f32x2 __attribute__((ext_vector_type(2)));
template <class Epi, class Sched, bool ALIGN_EPI = false, bool SP2 = false>
__device__ __forceinline__ void gemm_phase(PG8_LAS unsigned char* lds, const Gemm g, const Sched& S, const Epi& E, const int wave_in  ) {
    int tid_ = lane_fresh() + 64 * wave_in; asm volatile("" : "+v"(tid_));
    const int tid = tid_, wid = __builtin_amdgcn_readfirstlane(tid >> 6), lane = tid & 63, wr = wid >> 2, wc = wid & 3, fr = lane & 15, fq = lane >> 4;
    const int K = g.K, nt = K / BK;
    unsigned voffA[2], voffB[2];
#pragma unroll
    for (int i = 0; i < 2; ++i) { int R, C; stage_rc(tid * 16 + i * 8192, R, C); const int Rb = Epi::PERM ? ((R & ~31) + perm32(R & 31)) : R;
        voffA[i] = (unsigned)(R * K + C) * 2u; voffB[i] = (unsigned)(Rb * K + C) * 2u; }
    const size_t kstep = (size_t)(BK * 2);
    const size_t hstep = (size_t)HALF * K * 2;
    const size_t tstep = 2 * hstep;
    const unsigned ldsw = (unsigned)wid * 1024u;
    const int aoff = lds_byte(wr * 64 + fr, fq * 8), boff = lds_byte(wc * 32 + fr, fq * 8);
#define PG8_SA(b, h) (((b) * 2 + (h)) * HTB)
#define PG8_SB(b, h) ((4 + (b) * 2 + (h)) * HTB)
#define PG8_STAGE(bufoff, gbase, voff) do { _Pragma("unroll") for (int _i = 0; _i < 2; ++_i) \
        __builtin_amdgcn_global_load_lds((const unsigned*)((const char*)(gbase) + (voff)[_i]), (PG8_LAS unsigned*)(lds + (bufoff) + ldsw + _i * 8192), 16, 0, 0); } while (0)
#define PG8_LDA(dst, b, h) do { _Pragma("unroll") for (int m = 0; m < 4; ++m) _Pragma("unroll") for (int k = 0; k < 2; ++k) dst[m][k] = *(const PG8_LAS bf16x8*)(lds + PG8_SA(b, h) + aoff + m * 2048 + k * 1024); } while (0)
#define PG8_LDB(dst, b, h) do { _Pragma("unroll") for (int n = 0; n < 2; ++n) _Pragma("unroll") for (int k = 0; k < 2; ++k) dst[n][k] = *(const PG8_LAS bf16x8*)(lds + PG8_SB(b, h) + boff + n * 2048 + k * 1024); } while (0)
#define PG8_MMA(ai, bj, At, Bt) do { __builtin_amdgcn_s_setprio(1); _Pragma("unroll") for (int m = 0; m < 4; ++m) _Pragma("unroll") for (int n = 0; n < 2; ++n) _Pragma("unroll") for (int k = 0; k < 2; ++k) \
        acc[ai][bj][m][n] = __builtin_amdgcn_mfma_f32_16x16x32_bf16(Bt[n][k], At[m][k], acc[ai][bj][m][n], 0, 0, 0); __builtin_amdgcn_s_setprio(0); } while (0)
#define PG8_WAIT_V(n) asm volatile("s_waitcnt vmcnt(" #n ")" ::: "memory")
#define PG8_WAIT_L(n) asm volatile("s_waitcnt lgkmcnt(" #n ")" ::: "memory")
#define PG8_BAR __builtin_amdgcn_s_barrier()
#define PG8_SCHED __builtin_amdgcn_sched_barrier(0)
    Unit cur, nxt; int ui = 0;
    if (!S.next(0, cur)) return;
    f32x4 acc[2][2][4][2];
#pragma unroll
    for (int a = 0; a < 2; ++a)
#pragma unroll
        for (int b = 0; b < 2; ++b)
#pragma unroll
            for (int m = 0; m < 4; ++m)
#pragma unroll
                for (int n = 0; n < 2; ++n) acc[a][b][m][n] = (f32x4){0.f, 0.f, 0.f, 0.f};
    bf16x8 At[4][2], B0[2][2], B1[2][2];
    const char* cA = (const char*)g.A + (size_t)cur.pm * tstep; const char* cB = (const char*)g.Bt + (size_t)cur.pn * tstep;
    S.a_ready(cur);
    if constexpr (SP2) {
        PG8_STAGE(PG8_SB(0, 0), cB, voffB); PG8_STAGE(PG8_SB(0, 1), cB + hstep, voffB); PG8_STAGE(PG8_SA(0, 0), cA, voffA); PG8_STAGE(PG8_SA(0, 1), cA + hstep, voffA);
        if (wr == 1) PG8_BAR;
        PG8_WAIT_V(2); PG8_BAR;
        PG8_STAGE(PG8_SB(1, 0), cB + kstep, voffB); PG8_STAGE(PG8_SA(1, 0), cA + kstep, voffA); PG8_STAGE(PG8_SB(1, 1), cB + hstep + kstep, voffB);
        PG8_WAIT_V(6); PG8_BAR;
    } else {
        PG8_STAGE(PG8_SB(0, 0), cB, voffB); PG8_STAGE(PG8_SA(0, 0), cA, voffA); PG8_STAGE(PG8_SB(0, 1), cB + hstep, voffB); PG8_STAGE(PG8_SA(0, 1), cA + hstep, voffA);
        if (wr == 1) PG8_BAR;
        PG8_WAIT_V(4); PG8_BAR;
        PG8_STAGE(PG8_SB(1, 0), cB + kstep, voffB); PG8_STAGE(PG8_SA(1, 0), cA + kstep, voffA); PG8_STAGE(PG8_SB(1, 1), cB + hstep + kstep, voffB);
        PG8_WAIT_V(6); PG8_BAR;
    }
    for (;;) {
        const bool has_next = S.next(ui + 1, nxt);
        const char* nA = has_next ? (const char*)g.A + (size_t)nxt.pm * tstep : cA; const char* nB = has_next ? (const char*)g.Bt + (size_t)nxt.pn * tstep : cB;
        for (int t = 0; t < nt; t += 2) {
            const bool last = (t == nt - 2);
            const char* a1 = cA + (size_t)(t + 1) * kstep;
            const char* a2 = last ? nA : cA + (size_t)(t + 2) * kstep; const char* b2 = last ? nB : cB + (size_t)(t + 2) * kstep;
            const char* a3 = a2 + kstep; const char* b3 = b2 + kstep;
            if (last && has_next) S.a_ready(nxt);
            if constexpr (SP2) {
            PG8_LDB(B0, 0, 0); PG8_LDB(B1, 0, 1); PG8_SCHED; PG8_LDA(At, 0, 0); PG8_STAGE(PG8_SA(1, 1), a1 + hstep, voffA);
            PG8_WAIT_V(8); PG8_WAIT_L(0); PG8_BAR; PG8_MMA(0, 0, At, B0); PG8_MMA(0, 1, At, B1); PG8_BAR; PG8_SCHED;
            PG8_LDA(At, 0, 1); PG8_STAGE(PG8_SB(0, 0), b2, voffB); PG8_STAGE(PG8_SB(0, 1), b2 + hstep, voffB); PG8_STAGE(PG8_SA(0, 0), a2, voffA);
            PG8_WAIT_V(8); PG8_WAIT_L(0); PG8_BAR; PG8_MMA(1, 0, At, B0); PG8_MMA(1, 1, At, B1); PG8_BAR; PG8_SCHED;
            PG8_LDB(B0, 1, 0); PG8_LDB(B1, 1, 1); PG8_SCHED; PG8_LDA(At, 1, 0); PG8_STAGE(PG8_SA(0, 1), a2 + hstep, voffA);
            PG8_WAIT_V(8); PG8_WAIT_L(0); PG8_BAR; PG8_MMA(0, 0, At, B0); PG8_MMA(0, 1, At, B1); PG8_BAR; PG8_SCHED;
            PG8_LDA(At, 1, 1); PG8_STAGE(PG8_SB(1, 0), b3, voffB); PG8_STAGE(PG8_SB(1, 1), b3 + hstep, voffB); PG8_STAGE(PG8_SA(1, 0), a3, voffA);
            PG8_WAIT_V(8); PG8_WAIT_L(0); PG8_BAR; PG8_MMA(1, 0, At, B0); PG8_MMA(1, 1, At, B1); PG8_BAR; PG8_SCHED;
            } else {
            PG8_LDB(B0, 0, 0); PG8_SCHED; PG8_LDA(At, 0, 0); PG8_STAGE(PG8_SA(1, 1), a1 + hstep, voffA);
            PG8_WAIT_L(8); PG8_BAR; PG8_WAIT_L(0); PG8_MMA(0, 0, At, B0); PG8_BAR; PG8_SCHED;
            PG8_LDB(B1, 0, 1); PG8_STAGE(PG8_SB(0, 0), b2, voffB);
            PG8_BAR; PG8_WAIT_L(0); PG8_MMA(0, 1, At, B1); PG8_BAR;
            PG8_LDA(At, 0, 1); PG8_STAGE(PG8_SA(0, 0), a2, voffA);
            PG8_BAR; PG8_WAIT_L(0); PG8_MMA(1, 0, At, B0); PG8_BAR; PG8_SCHED;
            PG8_STAGE(PG8_SB(0, 1), b2 + hstep, voffB);
            PG8_WAIT_V(6); PG8_BAR; PG8_MMA(1, 1, At, B1); PG8_BAR;
            PG8_LDB(B0, 1, 0); PG8_SCHED; PG8_LDA(At, 1, 0); PG8_STAGE(PG8_SA(0, 1), a2 + hstep, voffA);
            PG8_WAIT_L(8); PG8_BAR; PG8_WAIT_L(0); PG8_MMA(0, 0, At, B0); PG8_BAR; PG8_SCHED;
            PG8_LDB(B1, 1, 1); PG8_STAGE(PG8_SB(1, 0), b3, voffB);
            PG8_BAR; PG8_WAIT_L(0); PG8_MMA(0, 1, At, B1); PG8_BAR;
            PG8_LDA(At, 1, 1); PG8_STAGE(PG8_SA(1, 0), a3, voffA);
            PG8_BAR; PG8_WAIT_L(0); PG8_MMA(1, 0, At, B0); PG8_BAR; PG8_SCHED;
            PG8_STAGE(PG8_SB(1, 1), b3 + hstep, voffB);
            PG8_WAIT_V(6); PG8_BAR; PG8_MMA(1, 1, At, B1); PG8_BAR;
            }
        }
        if constexpr (ALIGN_EPI) { if (wr == 0) PG8_BAR; }
        if constexpr (!Epi::AFTER_DRAIN) { E(acc, cur, wr, wc, fr, fq); S.done(cur); }
        if (!has_next) break;
#pragma unroll
        for (int a = 0; a < 2; ++a)
#pragma unroll
            for (int b = 0; b < 2; ++b)
#pragma unroll
                for (int m = 0; m < 4; ++m)
#pragma unroll
                    for (int n = 0; n < 2; ++n) acc[a][b][m][n] = (f32x4){0.f, 0.f, 0.f, 0.f};
        cur = nxt; cA = nA; cB = nB; ++ui;
        if constexpr (ALIGN_EPI) { if (wr == 1) PG8_BAR; }
    }
    PG8_WAIT_V(0);
    if constexpr (!ALIGN_EPI) { if (wr == 0) PG8_BAR; }
    PG8_BAR;
    if constexpr (Epi::AFTER_DRAIN) { E.fused(acc, cur, wr, wc, fr, fq, lds, wid, lane); S.done(cur); }
#undef PG8_SA
#undef PG8_SB
#undef PG8_STAGE
#undef PG8_LDA
#undef PG8_LDB
#undef PG8_MMA
#undef PG8_WAIT_V
#undef PG8_WAIT_L
#undef PG8_BAR
#undef PG8_SCHED
}
}
#define GAS __attribute__((address_space(1)))
#define LAS __attribute__((address_space(3)))
typedef unsigned short bf16;
typedef unsigned v4u __attribute__((ext_vector_type(4)));
typedef float f32x4 __attribute__((ext_vector_type(4)));
typedef short bf16x8 __attribute__((ext_vector_type(8)));
typedef GAS unsigned gu32;
typedef GAS unsigned long long gu64;
#define RLX_AGENT __ATOMIC_RELAXED, __HIP_MEMORY_SCOPE_AGENT
#define LDS_WAIT() asm volatile("s_waitcnt lgkmcnt(0)" ::: "memory")
#define VM_WAIT() asm volatile("s_waitcnt vmcnt(0)" ::: "memory")
__device__ __forceinline__ unsigned long long rt() { return __builtin_amdgcn_s_memrealtime(); }
__device__ __forceinline__ unsigned f2bf(float f) { unsigned u = __builtin_bit_cast(unsigned, f); return (u + 0x7fffu + ((u >> 16) & 1u)) >> 16; }
__device__ __forceinline__ unsigned pk2(float lo, float hi) { return f2bf(lo) | (f2bf(hi) << 16); }

#define XB_TMO      128
#define XB_XCNT(j)  (256  + 64 * (j))
#define XB_XSUB(j)  (1280 + 64 * (j))
#define XB_XGEN(j)  (2304 + 64 * (j))
#define XB_TOP      3328
#define XB_TOPGEN   3392
#define XCD_BAR_WORDS 3456
#define XB_SPIN_CAP (1u << 18)

__device__ __forceinline__ unsigned xb_ld(unsigned* p)              { return __hip_atomic_load(p, __ATOMIC_RELAXED, __HIP_MEMORY_SCOPE_AGENT); }
__device__ __forceinline__ unsigned xb_add(unsigned* p, unsigned v) { return __hip_atomic_fetch_add(p, v, __ATOMIC_RELAXED, __HIP_MEMORY_SCOPE_AGENT); }
__device__ __forceinline__ unsigned xb_xcc_id() { return (unsigned)__builtin_amdgcn_s_getreg((3 << 11) | 20) & 0xFu; }
#define XB_SPIN(cond, bar) do { unsigned _sp = 0; while (cond) { __builtin_amdgcn_s_sleep(1); \
    if ((++_sp & 255u) == 0u) { if (xb_ld(&(bar)[XB_TMO])) break; if (_sp > XB_SPIN_CAP) { atomicAdd(&(bar)[XB_TMO], 1u); break; } } } } while (0)

struct XcdBarrier {
    unsigned* bar; unsigned x; int wave;
    volatile LAS unsigned* st;
};

#define XB_IS_T0(wave) ((wave) == 0 && lane_fresh() == 0)
__device__ __forceinline__ XcdBarrier xcd_barrier_post(unsigned* bar, volatile LAS unsigned* st, int wave) {
    XcdBarrier b; b.bar = bar; b.x = xb_xcc_id(); b.st = st; b.wave = wave;
    if (XB_IS_T0(wave)) (void)xb_add(&bar[XB_XCNT(b.x)], 1u);
    return b;
}
__device__ __forceinline__ void xcd_barrier_complete(unsigned* bar, unsigned x, unsigned& nloc, unsigned& nx) {
    const unsigned G = gridDim.x * gridDim.y * gridDim.z;
    unsigned sum, cnt, mine, sp = 0u;
    for (;;) {
        sum = 0u; cnt = 0u; mine = 0u;
#pragma unroll
        for (unsigned j = 0; j < 16; ++j) { const unsigned c = xb_ld(&bar[XB_XCNT(j)]); sum += c; cnt += (c > 0u) ? 1u : 0u; mine = (j == x) ? c : mine; }
        if (sum == G) break;
        __builtin_amdgcn_s_sleep(1);
        if ((++sp & 255u) == 0u) { if (xb_ld(&bar[XB_TMO])) break; if (sp > XB_SPIN_CAP) { atomicAdd(&bar[XB_TMO], 1u); break; } }
    }
    nloc = mine > 0u ? mine : 1u; nx = cnt > 0u ? cnt : 1u;
}

__device__ __forceinline__ void xcd_barrier(const XcdBarrier& b) {
    asm volatile("s_waitcnt vmcnt(0)" ::: "memory");
    __syncthreads();
    if (XB_IS_T0(b.wave)) {
        unsigned* bar = b.bar;
        __builtin_amdgcn_s_waitcnt(0);
        unsigned nloc = b.st[0], nx = b.st[1];
        if (nloc == 0u) { xcd_barrier_complete(bar, b.x, nloc, nx); b.st[0] = nloc; b.st[1] = nx; }
        const unsigned old = xb_add(&bar[XB_XSUB(b.x)], 1u);
        const unsigned gen = old / nloc;
        if (old + 1u == (gen + 1u) * nloc) {
            __builtin_amdgcn_fence(__ATOMIC_RELEASE, "agent");
            asm volatile("s_waitcnt vmcnt(0)" ::: "memory");
            const unsigned og = xb_add(&bar[XB_TOP], 1u);
            const unsigned tg = og / nx;
            if (og + 1u == (tg + 1u) * nx) xb_add(&bar[XB_TOPGEN], 1u);
            else XB_SPIN(xb_ld(&bar[XB_TOPGEN]) == tg, bar);
            __builtin_amdgcn_fence(__ATOMIC_ACQUIRE, "agent");
            xb_add(&bar[XB_XGEN(b.x)], 1u);
            asm volatile("s_waitcnt vmcnt(0)" ::: "memory");
        } else {
            XB_SPIN(xb_ld(&bar[XB_XGEN(b.x)]) == gen, bar);
            __builtin_amdgcn_fence(__ATOMIC_ACQUIRE, "agent");
            asm volatile("s_waitcnt vmcnt(0)" ::: "memory");
        }
    }
    __syncthreads();
}
namespace mk {
constexpr int D = 1024, NB = 8, SEQ = 2048, NMETA = 16, T = SEQ + NMETA, NS = 32, PAST = 16384, PAGE = 128, NPAGES = PAST / PAGE;
constexpr int FFN = 2816, NH = 8, QR = 384, KVR = 256, RH = 4, RDK = 128, RDV = 256, IN_DIM = 5792;
constexpr int O_CQ = 0, O_CKV = 384, O_KR = 640, O_RQ = 672, O_RK = 1184, O_RV = 1696, O_RG = 2720, O_GA = 3744, O_GB = 4768;
constexpr int MMAIN = NB * SEQ;
constexpr int ROW_META = MMAIN;
constexpr int ROW_SMP = MMAIN + NMETA;
constexpr int ROW_PAD = ROW_SMP + NS;
constexpr int MP = MMAIN + 256;
constexpr int NWIN = 5888;
constexpr int NPOS = T + 1;
constexpr float EPS = 1e-6f;
constexpr int NWAVES = 8;

constexpr size_t MiB = 1u << 20;
constexpr size_t al(size_t x) { return (x + 255) / 256 * 256; }
constexpr size_t WS_CTL = 0, CTL_ZERO_BYTES = 1 * MiB;
constexpr size_t WS_W1T = 1 * MiB;
constexpr size_t WS_W1D = WS_W1T + al((size_t)2 * FFN * D * 2);
constexpr size_t WS_WIN = WS_W1D + al((size_t)D * FFN * 2);
constexpr size_t WS_WUQ = WS_WIN + al((size_t)NWIN * D * 2);
constexpr size_t WS_WUK = WS_WUQ + al((size_t)768 * QR * 2);
constexpr size_t WS_WUV = WS_WUK + al((size_t)512 * KVR * 2);
constexpr size_t WS_WMO = WS_WUV + al((size_t)512 * KVR * 2);
constexpr size_t WS_WRO = WS_WMO + al((size_t)D * 512 * 2);
constexpr size_t WS_WOUT = WS_WRO + al((size_t)D * D * 2);
constexpr size_t WS_W2T = WS_WOUT + al((size_t)D * D * 2);
constexpr size_t WS_W2D = WS_W2T + al((size_t)2 * FFN * D * 2);
constexpr size_t WS_WQL = WS_W2D + al((size_t)D * FFN * 2);
constexpr size_t WS_TAB = WS_WQL + al((size_t)2048 * QR * 2);
constexpr size_t TAB_C64 = 0, TAB_S64 = (size_t)NPOS * 64 * 4, TAB_C16 = 2 * TAB_S64, TAB_S16 = TAB_C16 + (size_t)NPOS * 16 * 4, TAB_GP = TAB_S16 + (size_t)NPOS * 16 * 4, TAB_GN = TAB_GP + 512 * 4, TAB_END = TAB_GN + 512 * 4;
constexpr size_t WS_XB = WS_TAB + al(TAB_END);
constexpr size_t WS_XE = WS_XB + al((size_t)MP * D * 2);
constexpr size_t WS_R1 = WS_XE + al((size_t)256 * D * 4);
constexpr size_t WS_ACT = WS_R1 + al((size_t)MP * 4);
constexpr size_t WS_H = WS_ACT + al((size_t)MP * FFN * 2);
constexpr size_t WS_HB = WS_H + al((size_t)MP * D * 4);
constexpr size_t WS_SSQH = WS_HB + al((size_t)MP * D * 2);
constexpr size_t WS_END1 = WS_SSQH + al((size_t)MP * 16 * 4);

constexpr int CW_BAR = 4096, CW_QUEUE = 64;

constexpr int RING_OFF = 0, RING_BYTES = 131072, SCR_BYTES = 155648  , LDSCTL_OFF = SCR_BYTES, MISC_OFF = LDSCTL_OFF + 320, LDS_BYTES = 163840;

struct Args {
    const float* in[27]; float* out; unsigned char* ws;
};

struct Frame {
    LAS unsigned char* lds;
    volatile LAS unsigned* MISC;
    int wave, vcu, G;
};

constexpr int PT_OFF = MISC_OFF + 256;
struct Ptrs {
    unsigned char* ws; volatile LAS unsigned* tab;
    __device__ __forceinline__ unsigned long long raw(int k) const { volatile LAS unsigned* t = tab; asm volatile("" : "+v"(t));
        const unsigned lo = __builtin_amdgcn_readfirstlane(t[2 * k]), hi = __builtin_amdgcn_readfirstlane(t[2 * k + 1]); return ((unsigned long long)hi << 32) | lo; }
    __device__ __forceinline__ const float* in(int k) const { return (const float*)(GAS const float*)raw(k); }
    __device__ __forceinline__ float* out() const { return (float*)(GAS float*)raw(27); }
};
__device__ __forceinline__ int fresh_tid(int wave) { int t = lane_fresh() + 64 * wave; asm volatile("" : "+v"(t)); return t; }

__device__ __forceinline__ float lx(float v, int lane, int mask) { return __int_as_float(__builtin_amdgcn_ds_bpermute((lane ^ mask) << 2, __float_as_int(v))); }
__device__ __forceinline__ float wave_sum(float v, int lane) {
#pragma unroll
    for (int o = 1; o < 64; o <<= 1) v += lx(v, lane, o);
    return v;
}
__device__ __forceinline__ int row_pos(int row) { return row < MMAIN ? (row & (SEQ - 1)) + NMETA : (row < ROW_SMP ? row - ROW_META : (row < ROW_PAD ? PAST : 0)); }
__device__ __forceinline__ int row_pidx(int row) { return row < MMAIN ? (row & (SEQ - 1)) + NMETA : (row < ROW_SMP ? row - ROW_META : (row < ROW_PAD ? T : 0)); }
__device__ __forceinline__ int row_jtok(int row) { return row < MMAIN ? (row & 127) : (row < ROW_SMP ? row - ROW_META : 0); }

struct WSrc { const float* W; int ld; int col0; const float* g; };
__device__ __forceinline__ void wmat_dims(int id, int& K, int& ngrp) {
    switch (id) {
        case 0: case 9: K = D; ngrp = 2 * FFN / 32; break;
        case 1: case 10: K = FFN; ngrp = D / 32; break;
        case 2: K = D; ngrp = NWIN / 32; break;
        case 3: K = QR; ngrp = 768 / 32; break;
        case 4: case 5: K = KVR; ngrp = 512 / 32; break;
        case 6: K = 512; ngrp = D / 32; break;
        default: K = D; ngrp = D / 32; break;
    }
}
__device__ __forceinline__ size_t wmat_off(int id) {
    switch (id) { case 0: return WS_W1T; case 1: return WS_W1D; case 2: return WS_WIN; case 3: return WS_WUQ; case 4: return WS_WUK; case 5: return WS_WUV;
                  case 6: return WS_WMO; case 7: return WS_WRO; case 8: return WS_WOUT; case 9: return WS_W2T; default: return WS_W2D; }
}
__device__ __forceinline__ WSrc wmat_src(const Args& a, int id, int g) {
    WSrc s; s.W = nullptr; s.ld = 0; s.col0 = 0; s.g = nullptr;
    switch (id) {
        case 0: case 9: { const int pn = g >> 3, gg = g & 7; const int o = id == 0 ? 7 : 22;
            s.W = gg < 4 ? a.in[o + 1] : a.in[o + 2]; s.ld = FFN; s.col0 = 128 * pn + 32 * (gg & 3); s.g = a.in[o]; break; }
        case 1: s.W = a.in[10]; s.ld = D; s.col0 = 32 * g; break;
        case 10: s.W = a.in[25]; s.ld = D; s.col0 = 32 * g; break;
        case 2: { s.ld = IN_DIM; s.g = a.in[11]; int zc = -1;
            if (g < 8) zc = 32 * g;
            else if (g < 16) { const int gg = g - 8; zc = gg < 4 ? 256 + 32 * gg : (gg == 4 ? O_KR : -1); }
            else if (g < 24) zc = O_CKV + 32 * (g - 16);
            else if (g < 56) { const int base = g < 40 ? O_RQ : O_RK; const int q = (g - 24) & 15, t = q >> 3, gg = q & 7;
                const int h = 2 * t + ((gg >> 1) & 1), part = (gg >> 2) * 64 + (gg & 1) * 32; zc = base + h * 128 + part; }
            else if (g < 88) zc = O_RV + 32 * (g - 56);
            else if (g < 120) zc = O_RG + 32 * (g - 88);
            else if (g < 152) zc = O_GA + 32 * (g - 120);
            else zc = O_GB + 32 * (g - 152);
            if (zc >= 0) { s.W = a.in[12]; s.col0 = zc; }
            break; }
        case 3: s.W = a.in[15]; s.ld = 768; s.col0 = 32 * g; s.g = a.in[13]; break;
        case 4: s.W = a.in[16]; s.ld = 512; s.col0 = 32 * g; s.g = a.in[14]; break;
        case 5: s.W = a.in[17]; s.ld = 512; s.col0 = 32 * g; s.g = a.in[14]; break;
        case 6: s.W = a.in[18]; s.ld = D; s.col0 = 32 * g; break;
        case 7: s.W = a.in[20]; s.ld = D; s.col0 = 32 * g; break;
        default: s.W = a.in[21]; s.ld = D; s.col0 = 32 * g; break;
    }
    return s;
}
__device__ __forceinline__ void p0_transpose_item(const WSrc s, int K, bf16* WT, int n0, int k0, LAS float* scr, int lane) {
    if (s.W) {
        float v[32];
        const float* wp = s.W + (size_t)(k0 + (lane >> 5)) * s.ld + s.col0 + (lane & 31);
#pragma unroll
        for (int i = 0; i < 32; ++i) v[i] = wp[(size_t)(2 * i) * s.ld];
        if (s.g) { const float* gp = s.g + k0 + (lane >> 5);
#pragma unroll
            for (int i = 0; i < 32; ++i) v[i] *= gp[2 * i]; }
#pragma unroll
        for (int i = 0; i < 32; ++i) scr[(2 * i + (lane >> 5)) * 33 + (lane & 31)] = v[i];
    } else {
#pragma unroll 8
        for (int i = 0; i < 32; ++i) { const int kk = 2 * i + (lane >> 5); scr[kk * 33 + (lane & 31)] = 0.f; }
    }
    LDS_WAIT(); asm volatile("" ::: "memory");
    const int c = lane & 7;
#pragma unroll
    for (int j = 0; j < 4; ++j) { const int n = (lane >> 3) + 8 * j; const LAS float* sp = scr + (8 * c) * 33 + n;
        v4u o; o.x = pk2(sp[0 * 33], sp[1 * 33]); o.y = pk2(sp[2 * 33], sp[3 * 33]); o.z = pk2(sp[4 * 33], sp[5 * 33]); o.w = pk2(sp[6 * 33], sp[7 * 33]);
        *(GAS v4u*)(WT + (size_t)(n0 + n) * K + k0 + 8 * c) = o; }
    LDS_WAIT(); asm volatile("" ::: "memory");
}
__device__ __forceinline__ const float* x_src(const Args& a, int row) {
    if (row < MMAIN) return a.in[0] + (size_t)row * D;
    if (row < ROW_SMP) return a.in[6] + (size_t)(row - ROW_META) * D;
    if (row < ROW_PAD) return a.in[1] + (size_t)(row - ROW_SMP) * D;
    return nullptr;
}
__device__ __forceinline__ void p0_prologue(Frame& F, const Args& a) {
    const int lane = fresh_tid(F.wave) & 63;
    LAS float* scr = (LAS float*)(F.lds + RING_OFF + F.wave * 16384);
    const int gw = F.vcu * NWAVES + F.wave, NGW = F.G * NWAVES;
    unsigned char* ws = a.ws;
    int base = 0;
#pragma unroll 1
    for (int id = 0; id < 11; ++id) {
        int K, ngrp; wmat_dims(id, K, ngrp);
        const int nk = K / 64, nitems = nk * ngrp;
        bf16* WT = (bf16*)(ws + wmat_off(id));
        int first = (gw - (base % NGW) + NGW) % NGW;
        for (int it = first; it < nitems; it += NGW) { const int g = it % ngrp, kb = it / ngrp; p0_transpose_item(wmat_src(a, id, g), K, WT, 32 * g, 64 * kb, scr, lane); }
        base += nitems;
    }
    bf16* XB = (bf16*)(ws + WS_XB); float* XE = (float*)(ws + WS_XE); float* R1 = (float*)(ws + WS_R1);
    for (int m0 = gw; m0 < MP; m0 += 2 * NGW) {
        f32x4 v[2][4];
#pragma unroll
        for (int t = 0; t < 2; ++t) { const int m = m0 + t * NGW; const float* xr = m < MP ? x_src(a, m) : nullptr;
#pragma unroll
            for (int j = 0; j < 4; ++j) v[t][j] = xr ? *((const GAS f32x4*)xr + lane + 64 * j) : (f32x4){0.f, 0.f, 0.f, 0.f}; }
#pragma unroll
        for (int t = 0; t < 2; ++t) { const int m = m0 + t * NGW; if (m >= MP) break;
            float s = 0.f;
#pragma unroll
            for (int j = 0; j < 4; ++j) s += (v[t][j].x * v[t][j].x + v[t][j].y * v[t][j].y) + (v[t][j].z * v[t][j].z + v[t][j].w * v[t][j].w);
            s = wave_sum(s, lane);
            if (lane == 0) R1[m] = 1.0f / sqrtf(s * (1.f / D) + EPS);
            GAS unsigned long long* o8 = (GAS unsigned long long*)(XB + (size_t)m * D) + lane;
#pragma unroll
            for (int j = 0; j < 4; ++j) o8[64 * j] = (unsigned long long)pk2(v[t][j].x, v[t][j].y) | ((unsigned long long)pk2(v[t][j].z, v[t][j].w) << 32);
            if (m >= MMAIN) {
#pragma unroll
                for (int j = 0; j < 4; ++j) *((GAS f32x4*)(XE + (size_t)(m - MMAIN) * D) + lane + 64 * j) = v[t][j];
            } }
    }
    {   const float* wuq = a.in[15]; const float* wuk = a.in[16]; const float* qn = a.in[13]; bf16* WQL = (bf16*)(ws + WS_WQL);
        LAS float* U = (LAS float*)(F.lds + RING_OFF);
        const int tid = F.wave * 64 + lane;
        for (int it = F.vcu; it < 256; it += F.G) {
            const int h = it >> 5, r0 = (it & 31) * 8;
            __syncthreads();
            for (int e = tid; e < QR * 64; e += NWAVES * 64) { const int k = e >> 6, n = e & 63; U[k * 65 + n] = wuq[(size_t)k * 768 + h * 96 + n]; }
            { const int rr = tid >> 6, n = tid & 63; U[QR * 65 + rr * 64 + n] = wuk[(size_t)(r0 + rr) * 512 + h * 64 + n]; }
            __syncthreads();
            if (tid < QR) { const float g = qn[tid]; float acc[8];
#pragma unroll
                for (int rr = 0; rr < 8; ++rr) acc[rr] = 0.f;
                for (int n = 0; n < 64; ++n) { const float u = U[tid * 65 + n];
#pragma unroll
                    for (int rr = 0; rr < 8; ++rr) acc[rr] += u * U[QR * 65 + rr * 64 + n]; }
#pragma unroll
                for (int rr = 0; rr < 8; ++rr) WQL[(size_t)(h * 256 + r0 + rr) * QR + tid] = (bf16)f2bf(acc[rr] * g); }
        }
        __syncthreads();
    }
    float* TAB = (float*)(ws + WS_TAB);
    const int gt = (F.vcu * NWAVES + F.wave) * 64 + lane, NGT = NGW * 64;
    for (int e = gt; e < NPOS * 64; e += NGT) { const int p = e >> 6, i = e & 63; const int pos = p < T ? p : PAST;
        const float invf = (float)pow(10000.0, -(double)i / 64.0); const float ang = (float)pos * invf;
        TAB[TAB_C64 / 4 + e] = (float)cos((double)ang); TAB[TAB_S64 / 4 + e] = (float)sin((double)ang); }
    for (int e = gt; e < NPOS * 16; e += NGT) { const int p = e >> 4, i = e & 15; const int pos = p < T ? p : PAST;
        const float invf = (float)pow(10000.0, -(double)i / 16.0); const float ang = (float)pos * invf;
        TAB[TAB_C16 / 4 + e] = (float)cos((double)ang); TAB[TAB_S16 / 4 + e] = (float)sin((double)ang); }
    for (int e = gt; e < 512; e += NGT) { const int h = e >> 7, j = e & 127; const double lg = log1p(-exp2(-5.0 - (double)h));
        TAB[TAB_GP / 4 + e] = (float)exp(lg * (double)j); TAB[TAB_GN / 4 + e] = (float)exp(-lg * (double)j); }
}

using pg8::f32x4; using pg8::u32x4; using pg8::Unit; using pg8::BM; using pg8::HALF;
typedef unsigned u32x2 __attribute__((ext_vector_type(2)));
__device__ __forceinline__ float fast_sigmoid(float x) { return __builtin_amdgcn_rcpf(1.f + __builtin_amdgcn_exp2f(-1.4426950408889634f * x)); }
__device__ __forceinline__ float fast_silu(float x) { return x * fast_sigmoid(x); }

struct EpiSwiGLU {
    static constexpr bool PERM = true, AFTER_DRAIN = false;
    bf16* ACT; const float* rs;
    __device__ __forceinline__ void operator()(const f32x4 (&acc)[2][2][4][2], const Unit& u, int wr, int wc, int fr, int fq) const {
        int l_ = lane_fresh(); asm volatile("" : "+v"(l_)); fr = l_ & 15; fq = l_ >> 4;
        const int row0 = u.pm * BM + wr * 64 + fr, col0 = u.pn * HALF + wc * 32 + 8 * fq;
#pragma unroll
        for (int ai = 0; ai < 2; ++ai)
#pragma unroll
            for (int m = 0; m < 4; ++m) { const int row = row0 + ai * HALF + m * 16; const float r = rs[row];
                f32x4 o[2];
#pragma unroll
                for (int n = 0; n < 2; ++n)
#pragma unroll
                    for (int j = 0; j < 4; ++j) { const float g = acc[ai][0][m][n][j] * r, up = acc[ai][1][m][n][j] * r; o[n][j] = fast_silu(g) * up; }
                u32x4 w; w.x = pg8::cvt_pk_bf16(o[0][0], o[0][1]); w.y = pg8::cvt_pk_bf16(o[0][2], o[0][3]); w.z = pg8::cvt_pk_bf16(o[1][0], o[1][1]); w.w = pg8::cvt_pk_bf16(o[1][2], o[1][3]);
                *(u32x4*)(ACT + (size_t)row * FFN + col0) = w; }
    }
};
template <class T> __device__ __forceinline__ T* at(unsigned char* w, unsigned byte_off) { return (T*)(w + byte_off); }
template <unsigned RES_OFF, bool RES_X, unsigned OUT_OFF, unsigned OUTB_OFF, unsigned SSQ_OFF, int SCALE2  > struct EpiResid {
    static constexpr bool PERM = false, AFTER_DRAIN = false;
    unsigned char* ws_; const float* xin;
    __device__ __forceinline__ void operator()(const f32x4 (&acc)[2][2][4][2], const Unit& u, int wr, int wc, int fr, int fq) const {
        int l_ = lane_fresh(); asm volatile("" : "+v"(l_)); fr = l_ & 15; fq = l_ >> 4;
        unsigned char* w = opaque_g(ws_);
        const unsigned row0 = u.pm * BM + wr * 64 + fr, col0 = u.pn * BM + wc * 32 + 4 * fq;
        constexpr float scale = 0.5f * SCALE2;
#pragma unroll
        for (int ai = 0; ai < 2; ++ai)
#pragma unroll
            for (int m = 0; m < 4; ++m) { unsigned row = row0 + ai * HALF + m * 16; asm volatile("" : "+v"(row));
                const float* rp;
                if (RES_X) rp = row < (unsigned)MMAIN ? xin + row * D + col0 : at<const float>(w, RES_OFF + ((row - MMAIN) * D + col0) * 4);
                else rp = at<const float>(w, RES_OFF + (row * D + col0) * 4);
                float ss = 0.f;
#pragma unroll
                for (int bj = 0; bj < 2; ++bj)
#pragma unroll
                    for (int n = 0; n < 2; ++n) { const f32x4 b = *(const f32x4*)(rp + bj * HALF + n * 16); const f32x4 o = b + acc[ai][bj][m][n] * scale;
                        const unsigned e = row * D + col0 + bj * HALF + n * 16;
                        *at<f32x4>(w, OUT_OFF + e * 4) = o;
                        ss += (o[0] * o[0] + o[1] * o[1]) + (o[2] * o[2] + o[3] * o[3]);
                        if (OUTB_OFF) { u32x2 pk; pk.x = pg8::cvt_pk_bf16(o[0], o[1]); pk.y = pg8::cvt_pk_bf16(o[2], o[3]); *at<u32x2>(w, OUTB_OFF + e * 2) = pk; } }
                ss += lx(ss, l_, 16); ss += lx(ss, l_, 32);
                if (fq == 0) *at<float>(w, SSQ_OFF + (row * 16 + u.pn * 4 + wc) * 4) = ss;
                asm volatile("" ::: "memory"); }
    }
};
}
namespace mk {
constexpr size_t WS_CQ = WS_END1;
constexpr size_t WS_SSQCQ = WS_CQ + al((size_t)MP * QR * 2);
constexpr size_t WS_CKVF = WS_SSQCQ + al((size_t)MP * 8 * 4);
constexpr size_t WS_CKVB = WS_CKVF + al((size_t)MP * KVR * 4);
constexpr size_t WS_SSQKV = WS_CKVB + al((size_t)MP * KVR * 2);
constexpr size_t WS_KRB = WS_SSQKV + al((size_t)MP * 4 * 4);
constexpr size_t WS_RQ = WS_KRB + al((size_t)MP * 32 * 2);
constexpr size_t WS_RK = WS_RQ + al((size_t)MP * 512 * 2);
constexpr size_t WS_RKT = WS_RK + al((size_t)MP * 512 * 2);
constexpr size_t WS_RVT = WS_RKT + al((size_t)MP * 512 * 2);
constexpr size_t WS_SRG = WS_RVT + al((size_t)MP * 1024 * 2);
constexpr size_t WS_SGA = WS_SRG + al((size_t)MP * 1024 * 2);
constexpr size_t WS_SGB = WS_SGA + al((size_t)MP * 1024 * 2);
constexpr size_t WS_QA = WS_SGB + al((size_t)MP * 1024 * 2);
constexpr size_t WS_KN = WS_QA + al((size_t)MP * 768 * 2);
constexpr size_t WS_VT = WS_KN + al((size_t)MP * 512 * 2);
constexpr size_t WS_KRF = WS_VT + al((size_t)MP * 512 * 2);
constexpr size_t WS_END2 = WS_KRF + al((size_t)MP * 32 * 4);
constexpr float SC_Q = 0.14724444348433683f;
constexpr float RK_SCALE = 0.08838834764831845f;

constexpr size_t OUT_YP = 0, OUT_YS = OUT_YP + (size_t)NB * SEQ * D, OUT_CKVP = OUT_YS + (size_t)NS * D, OUT_KRP = OUT_CKVP + (size_t)NB * T * KVR,
                 OUT_SRP = OUT_KRP + (size_t)NB * T * 32, OUT_CKVS = OUT_SRP + (size_t)NB * RH * RDK * RDV, OUT_KRS = OUT_CKVS + (size_t)NS * KVR, OUT_SRS = OUT_KRS + (size_t)NS * 32,
                 OUT_END = OUT_SRS + (size_t)NS * RH * RDK * RDV;

__device__ __forceinline__ float row_rscale16(const float* SSQ, int row, float inv_n) {
    const f32x4* p = (const f32x4*)(SSQ + (size_t)row * 16); const f32x4 a = p[0], b = p[1], c = p[2], d = p[3];
    const float s = ((a[0] + a[1]) + (a[2] + a[3])) + ((b[0] + b[1]) + (b[2] + b[3])) + ((c[0] + c[1]) + (c[2] + c[3])) + ((d[0] + d[1]) + (d[2] + d[3]));
    return 1.0f / sqrtf(s * inv_n + EPS);
}
__device__ __forceinline__ float row_rscale8(const float* SSQ, int row, float inv_n) {
    const f32x4* p = (const f32x4*)(SSQ + (size_t)row * 8); const f32x4 a = p[0], b = p[1];
    return 1.0f / sqrtf((((a[0] + a[1]) + (a[2] + a[3])) + ((b[0] + b[1]) + (b[2] + b[3]))) * inv_n + EPS);
}
__device__ __forceinline__ float row_rscale4(const float* SSQ, int row, float inv_n) {
    const f32x4 a = *(const f32x4*)(SSQ + (size_t)row * 4);
    return 1.0f / sqrtf(((a[0] + a[1]) + (a[2] + a[3])) * inv_n + EPS);
}
__device__ __forceinline__ u32x2 pack4(const f32x4 v) { u32x2 w; w.x = pg8::cvt_pk_bf16(v[0], v[1]); w.y = pg8::cvt_pk_bf16(v[2], v[3]); return w; }
__device__ __forceinline__ float ssq4(const f32x4 v) { return (v[0] * v[0] + v[1] * v[1]) + (v[2] * v[2] + v[3] * v[3]); }
__device__ __forceinline__ bf16 bf1(float x) { return (bf16)f2bf(x); }

static_assert(WS_END2 < ((size_t)1 << 31), "32-bit workspace offsets");
struct EpiWin {
    static constexpr bool PERM = false, AFTER_DRAIN = false;
    unsigned char* ws_;
#define MK_WS(var) unsigned char* var = opaque_g(ws_)
#define MK_ROWS_BEGIN _Pragma("unroll") for (int ai = 0; ai < 2; ++ai) _Pragma("unroll") for (int m = 0; m < 4; ++m) { \
        unsigned row = row0 + ai * HALF + m * 16; asm volatile("" : "+v"(row)); const float r = row_rscale16(at<const float>(w, (unsigned)WS_SSQH), (int)row, 1.f / D);
#define MK_ROWS_END asm volatile("" ::: "memory"); }
    __device__ __forceinline__ void operator()(const f32x4 (&acc)[2][2][4][2], const Unit& u, int wr, int wc, int fr, int fq) const {
        int l_ = lane_fresh(); asm volatile("" : "+v"(l_)); fr = l_ & 15; fq = l_ >> 4;
        const unsigned row0 = u.pm * BM + wr * 64 + fr; const int pn = u.pn;
        MK_WS(w);
        if (pn == 0) {
            MK_ROWS_BEGIN
                float ss = 0.f;
#pragma unroll
                for (int bj = 0; bj < 2; ++bj)
#pragma unroll
                    for (int n = 0; n < 2; ++n) { const f32x4 v = acc[ai][bj][m][n] * r; ss += ssq4(v); *at<u32x2>(w, (unsigned)WS_CQ + (row * QR + bj * HALF + wc * 32 + n * 16 + 4 * fq) * 2) = pack4(v); }
                ss += lx(ss, l_, 16); ss += lx(ss, l_, 32);
                if (fq == 0) *at<float>(w, (unsigned)WS_SSQCQ + (row * 8 + wc) * 4) = ss;
            MK_ROWS_END
        } else if (pn == 1) {
            MK_ROWS_BEGIN
                float ss = 0.f;
#pragma unroll
                for (int n = 0; n < 2; ++n) { const f32x4 v = acc[ai][0][m][n] * r; ss += ssq4(v); *at<u32x2>(w, (unsigned)WS_CQ + (row * QR + 256 + wc * 32 + n * 16 + 4 * fq) * 2) = pack4(v); }
                ss += lx(ss, l_, 16); ss += lx(ss, l_, 32);
                if (fq == 0) *at<float>(w, (unsigned)WS_SSQCQ + (row * 8 + 4 + wc) * 4) = ss;
                if (wc == 0) {
                    const f32x4 x1 = acc[ai][1][m][0] * r, x2 = acc[ai][1][m][1] * r;
                    const unsigned pi = row_pidx((int)row);
                    const f32x4 c = *at<const f32x4>(w, (unsigned)(WS_TAB + TAB_C16) + (pi * 16 + 4 * fq) * 4), s = *at<const f32x4>(w, (unsigned)(WS_TAB + TAB_S16) + (pi * 16 + 4 * fq) * 4);
                    const f32x4 y1 = x1 * c - x2 * s, y2 = x1 * s + x2 * c;
                    *at<u32x2>(w, (unsigned)WS_KRB + (row * 32 + 4 * fq) * 2) = pack4(y1); *at<u32x2>(w, (unsigned)WS_KRB + (row * 32 + 16 + 4 * fq) * 2) = pack4(y2);
                    *at<f32x4>(w, (unsigned)WS_KRF + (row * 32 + 4 * fq) * 4) = y1; *at<f32x4>(w, (unsigned)WS_KRF + (row * 32 + 16 + 4 * fq) * 4) = y2;
                }
            MK_ROWS_END
        } else if (pn == 2) {
            MK_ROWS_BEGIN
                float ss = 0.f;
#pragma unroll
                for (int bj = 0; bj < 2; ++bj)
#pragma unroll
                    for (int n = 0; n < 2; ++n) { const f32x4 v = acc[ai][bj][m][n] * r; ss += ssq4(v); const unsigned e = row * KVR + bj * HALF + wc * 32 + n * 16 + 4 * fq;
                        *at<f32x4>(w, (unsigned)WS_CKVF + e * 4) = v; *at<u32x2>(w, (unsigned)WS_CKVB + e * 2) = pack4(v); }
                ss += lx(ss, l_, 16); ss += lx(ss, l_, 32);
                if (fq == 0) *at<float>(w, (unsigned)WS_SSQKV + (row * 4 + wc) * 4) = ss;
            MK_ROWS_END
        } else if (pn < 7) {
            const bool isk = pn >= 5; const unsigned hh = 2 * ((pn - 3) & 1) + (wc >> 1);
            const unsigned dbase = (unsigned)(isk ? WS_RK : WS_RQ) + hh * 256, gbase = (unsigned)(WS_TAB + (isk ? TAB_GN : TAB_GP)) + hh * 512;
            MK_ROWS_BEGIN
                const unsigned pi = row_pidx((int)row), jt = row_jtok((int)row);
                const float mult = *at<const float>(w, gbase + jt * 4) * (isk ? RK_SCALE : 1.f);
#pragma unroll
                for (int n = 0; n < 2; ++n) { const unsigned i0 = 32 * (wc & 1) + 16 * n + 4 * fq;
                    const f32x4 x1 = acc[ai][0][m][n] * r, x2 = acc[ai][1][m][n] * r;
                    const f32x4 c = *at<const f32x4>(w, (unsigned)(WS_TAB + TAB_C64) + (pi * 64 + i0) * 4), s = *at<const f32x4>(w, (unsigned)(WS_TAB + TAB_S64) + (pi * 64 + i0) * 4);
                    const f32x4 y1 = (x1 * c - x2 * s) * mult, y2 = (x1 * s + x2 * c) * mult;
                    *at<u32x2>(w, dbase + (row * 512 + i0) * 2) = pack4(y1); *at<u32x2>(w, dbase + (row * 512 + 64 + i0) * 2) = pack4(y2);
                    if (isk) {
#pragma unroll
                        for (int j = 0; j < 4; ++j) { *at<bf16>(w, (unsigned)WS_RKT + ((hh * 128 + i0 + j) * MP + row) * 2) = bf1(y1[j]); *at<bf16>(w, (unsigned)WS_RKT + ((hh * 128 + 64 + i0 + j) * MP + row) * 2) = bf1(y2[j]); } } }
            MK_ROWS_END
        } else if (pn < 11) {
            const unsigned cbase = (unsigned)WS_RVT + ((pn - 7) * 256 + wc * 32 + 4 * fq) * (MP * 2);
            MK_ROWS_BEGIN
#pragma unroll
                for (int bj = 0; bj < 2; ++bj)
#pragma unroll
                    for (int n = 0; n < 2; ++n) { const f32x4 v = acc[ai][bj][m][n] * r;
#pragma unroll
                        for (int j = 0; j < 4; ++j) *at<bf16>(w, cbase + ((bj * HALF + n * 16 + j) * MP + row) * 2) = bf1(v[j]); }
            MK_ROWS_END
        } else {
            const int t = (pn - 11) >> 2; const unsigned dbase = (unsigned)WS_SRG + (unsigned)t * (unsigned)(WS_SGA - WS_SRG) + (((pn - 11) & 3) * 256 + wc * 32 + 4 * fq) * 2;
            MK_ROWS_BEGIN
#pragma unroll
                for (int bj = 0; bj < 2; ++bj)
#pragma unroll
                    for (int n = 0; n < 2; ++n) { const f32x4 v = acc[ai][bj][m][n] * r; f32x4 o;
#pragma unroll
                        for (int j = 0; j < 4; ++j) { const float sg = fast_sigmoid(v[j]); o[j] = t == 0 ? v[j] * sg : sg; }
                        *at<u32x2>(w, dbase + (row * 1024 + bj * HALF + n * 16) * 2) = pack4(o); }
            MK_ROWS_END
        }
    }
};
static_assert(WS_SGB - WS_SGA == WS_SGA - WS_SRG, "gate arrays equally spaced");
struct EpiQ {
    static constexpr bool PERM = false, AFTER_DRAIN = false;
    unsigned char* ws;
    __device__ __forceinline__ void operator()(const f32x4 (&acc)[2][2][4][2], const Unit& u, int wr, int wc, int fr, int fq) const {
        int l_ = lane_fresh(); asm volatile("" : "+v"(l_)); fr = l_ & 15; fq = l_ >> 4;
        const float* SSQCQ = (const float*)(ws + WS_SSQCQ); bf16* QA = (bf16*)(ws + WS_QA); const float* TAB = (const float*)(ws + WS_TAB);
        const int row0 = u.pm * BM + wr * 64 + fr;
#pragma unroll
        for (int ai = 0; ai < 2; ++ai)
#pragma unroll
            for (int m = 0; m < 4; ++m) {
                int row = row0 + ai * HALF + m * 16; asm volatile("" : "+v"(row));
                const float r = row_rscale8(SSQCQ, row, 1.f / QR) * SC_Q;
#pragma unroll
                for (int bj = 0; bj < 2; ++bj) {
                    const int grp = 8 * u.pn + 4 * bj + wc;
                    bf16* dst = QA + (size_t)row * 768 + 32 * grp + 4 * fq;
                    const bool rope = (grp % 3) == 2;
                    const int pi = row_pidx(row);
                    f32x4 c = *(const f32x4*)(TAB + TAB_C16 / 4 + pi * 16 + 4 * fq), s = *(const f32x4*)(TAB + TAB_S16 / 4 + pi * 16 + 4 * fq);
                    if (!rope) { c = (f32x4){1.f, 1.f, 1.f, 1.f}; s = (f32x4){0.f, 0.f, 0.f, 0.f}; }
                    const f32x4 x1 = acc[ai][bj][m][0] * r, x2 = acc[ai][bj][m][1] * r;
                    *(u32x2*)dst = pack4(x1 * c - x2 * s); *(u32x2*)(dst + 16) = pack4(x1 * s + x2 * c);
                }
                asm volatile("" ::: "memory");
            }
    }
};
template <bool ROWS> struct EpiScaleBf16 {
    static constexpr bool PERM = true, AFTER_DRAIN = false;
    const float* SSQKV; bf16* O; int ldc;
    __device__ __forceinline__ void operator()(const f32x4 (&acc)[2][2][4][2], const Unit& u, int wr, int wc, int fr, int fq) const {
        int l_ = lane_fresh(); asm volatile("" : "+v"(l_)); fr = l_ & 15; fq = l_ >> 4;
        const int row0 = u.pm * BM + wr * 64 + fr, col0 = u.pn * BM + wc * 32 + 8 * fq;
        float cs[2][8];
        if (!ROWS) {
#pragma unroll
            for (int bj = 0; bj < 2; ++bj)
#pragma unroll
                for (int k = 0; k < 8; ++k) cs[bj][k] = row_rscale4(SSQKV, col0 + bj * HALF + k, 1.f / KVR);
        }
#pragma unroll
        for (int ai = 0; ai < 2; ++ai)
#pragma unroll
            for (int m = 0; m < 4; ++m) { int row = row0 + ai * HALF + m * 16; asm volatile("" : "+v"(row)); const float r = ROWS ? row_rscale4(SSQKV, row, 1.f / KVR) : 1.f;
#pragma unroll
                for (int bj = 0; bj < 2; ++bj) { f32x4 v0 = acc[ai][bj][m][0], v1 = acc[ai][bj][m][1];
                    if (ROWS) { v0 = v0 * r; v1 = v1 * r; }
                    else {
#pragma unroll
                        for (int j = 0; j < 4; ++j) { v0[j] *= cs[bj][j]; v1[j] *= cs[bj][4 + j]; } }
                    u32x4 w; w.x = pg8::cvt_pk_bf16(v0[0], v0[1]); w.y = pg8::cvt_pk_bf16(v0[2], v0[3]); w.z = pg8::cvt_pk_bf16(v1[0], v1[1]); w.w = pg8::cvt_pk_bf16(v1[2], v1[3]);
                    *(u32x4*)(O + (size_t)row * ldc + col0 + bj * HALF) = w; } }
    }
};
__device__ __forceinline__ void finalize_ckv(Frame& F, const Ptrs& a) {
    const int lane = fresh_tid(F.wave) & 63;
    const int gw = F.vcu * NWAVES + F.wave, NGW = F.G * NWAVES;
    const float* CKVF = (const float*)(a.ws + WS_CKVF); const float* SSQKV = (const float*)(a.ws + WS_SSQKV); const float* KRF = (const float*)(a.ws + WS_KRF);
    const f32x4 g = *((const f32x4*)a.in(14) + lane);
    for (int row = gw; row < ROW_PAD; row += NGW) {
        const float r = row_rscale4(SSQKV, row, 1.f / KVR);
        const f32x4 o = *((const f32x4*)(CKVF + (size_t)row * KVR) + lane) * r * g;
        const f32x4 kr = *((const f32x4*)(KRF + (size_t)row * 32) + (lane & 7));
        if (row < MMAIN) { const size_t t = (size_t)(row >> 11) * T + NMETA + (row & (SEQ - 1)); *((f32x4*)(a.out() + OUT_CKVP + t * KVR) + lane) = o; if (lane < 8) *((f32x4*)(a.out() + OUT_KRP + t * 32) + lane) = kr; }
        else if (row < ROW_SMP) { for (int b = 0; b < NB; ++b) { const size_t t = (size_t)b * T + (row - ROW_META); *((f32x4*)(a.out() + OUT_CKVP + t * KVR) + lane) = o; if (lane < 8) *((f32x4*)(a.out() + OUT_KRP + t * 32) + lane) = kr; } }
        else { *((f32x4*)(a.out() + OUT_CKVS + (size_t)(row - ROW_SMP) * KVR) + lane) = o; if (lane < 8) *((f32x4*)(a.out() + OUT_KRS + (size_t)(row - ROW_SMP) * 32) + lane) = kr; }
    }
}
}
namespace mk {
constexpr size_t WS_AV = WS_END2;
constexpr size_t WS_END3 = WS_AV + al((size_t)MP * 512 * 2);
typedef float f32x16 __attribute__((ext_vector_type(16)));
constexpr int AT_KSTR = 208, AT_VSTR = 144, AT_KBUF = 64 * AT_KSTR, AT_VBUF = 64 * AT_VSTR, AT_VOFF = 2 * AT_KBUF;
__device__ __forceinline__ int crow(int i, int half) { return (i & 3) + 8 * (i >> 2) + 4 * half; }

__device__ __forceinline__ void attn_unit(Frame& F, unsigned char* ws, int b, int h, int qb) {
    ws = opaque_g(ws);
    const int tid = fresh_tid(F.wave), lane = tid & 63, w = F.wave, q = lane & 31, half = lane >> 5;
    LAS unsigned char* L = F.lds + RING_OFF;
    const bf16* QA = (const bf16*)(ws + WS_QA); const bf16* KN = (const bf16*)(ws + WS_KN); const bf16* KRB = (const bf16*)(ws + WS_KRB); const bf16* VT = (const bf16*)(ws + WS_VT);
    const int qrow = b * SEQ + qb * 256 + w * 32 + q, q_main = qb * 256 + w * 32 + q, wq0 = qb * 256 + w * 32;
    bf16x8 qf[6];
#pragma unroll
    for (int s = 0; s < 6; ++s) qf[s] = *(const bf16x8*)(QA + (size_t)qrow * 768 + h * 96 + 16 * s + 8 * half);
    f32x16 ot[2];
#pragma unroll
    for (int i = 0; i < 16; ++i) { ot[0][i] = 0.f; ot[1][i] = 0.f; }
    float m = -INFINITY, l = 0.f;
    const int NT = 4 * (qb + 1);
    v4u kreg, rreg, vreg; rreg = (v4u){0u, 0u, 0u, 0u};
#define AT_LOAD(tt) do { const int t0_ = (tt) == 0 ? ROW_META : b * SEQ + 64 * ((tt) - 1); \
        kreg = *(const v4u*)(KN + (size_t)(t0_ + (tid >> 3)) * 512 + h * 64 + (tid & 7) * 8); \
        if (tid < 256) rreg = *(const v4u*)(KRB + (size_t)(t0_ + (tid >> 2)) * 32 + (tid & 3) * 8); \
        vreg = *(const v4u*)(VT + (size_t)(h * 64 + (tid >> 3)) * MP + t0_ + (tid & 7) * 8); } while (0)
#define AT_STORE(buf) do { LAS unsigned char* kb_ = L + (buf) * AT_KBUF; \
        *(LAS v4u*)(kb_ + (tid >> 3) * AT_KSTR + (tid & 7) * 16) = kreg; \
        if (tid < 256) *(LAS v4u*)(kb_ + (tid >> 2) * AT_KSTR + 128 + (tid & 3) * 16) = rreg; \
        LAS unsigned char* vb_ = L + AT_VOFF + (buf) * AT_VBUF + (tid >> 3) * AT_VSTR + (32 * ((tid & 7) >> 1) + 8 * (tid & 1)); \
        *(LAS u32x2*)(vb_) = (u32x2){vreg.x, vreg.y}; *(LAS u32x2*)(vb_ + 16) = (u32x2){vreg.z, vreg.w}; } while (0)
    AT_LOAD(0); AT_STORE(0);
    __syncthreads();
    for (int tt = 0; tt <= NT; ++tt) {
        const int buf = tt & 1;
        if (tt < NT) AT_LOAD(tt + 1);
        const int kmin = tt == 0 ? 0 : 64 * (tt - 1);
        if (tt == 0 || kmin <= wq0 + 31) {
            const LAS unsigned char* Kb = L + buf * AT_KBUF + q * AT_KSTR + 16 * half;
            const LAS unsigned char* Vb = L + AT_VOFF + buf * AT_VBUF + q * AT_VSTR + 16 * half;
            f32x16 st[2];
#pragma unroll
            for (int kb = 0; kb < 2; ++kb) {
#pragma unroll
                for (int i = 0; i < 16; ++i) st[kb][i] = 0.f;
#pragma unroll
                for (int s = 0; s < 6; ++s) { const bf16x8 kf = *(const LAS bf16x8*)(Kb + kb * 32 * AT_KSTR + 32 * s); st[kb] = __builtin_amdgcn_mfma_f32_32x32x16_bf16(kf, qf[s], st[kb], 0, 0, 0); }
            }
            if (tt == 0) {
#pragma unroll
                for (int kb = 0; kb < 2; ++kb)
#pragma unroll
                    for (int i = 0; i < 16; ++i) if (32 * kb + crow(i, half) >= NMETA) st[kb][i] = -INFINITY;
            } else if (kmin + 63 > wq0) {
#pragma unroll
                for (int kb = 0; kb < 2; ++kb)
#pragma unroll
                    for (int i = 0; i < 16; ++i) if (kmin + 32 * kb + crow(i, half) > q_main) st[kb][i] = -INFINITY;
            }
            float mx = st[0][0];
#pragma unroll
            for (int i = 1; i < 16; ++i) mx = fmaxf(mx, st[0][i]);
#pragma unroll
            for (int i = 0; i < 16; ++i) mx = fmaxf(mx, st[1][i]);
            mx = fmaxf(mx, lx(mx, lane, 32));
            const float mn = fmaxf(m, mx), alpha = __builtin_amdgcn_exp2f(m - mn);
            m = mn;
            float ps = 0.f;
#pragma unroll
            for (int kb = 0; kb < 2; ++kb)
#pragma unroll
                for (int i = 0; i < 16; ++i) { st[kb][i] = __builtin_amdgcn_exp2f(st[kb][i] - mn); ps += st[kb][i]; }
            l = l * alpha + ps;
#pragma unroll
            for (int i = 0; i < 16; ++i) { ot[0][i] *= alpha; ot[1][i] *= alpha; }
#pragma unroll
            for (int kb = 0; kb < 2; ++kb)
#pragma unroll
                for (int s2 = 0; s2 < 2; ++s2) {
                    u32x4 pw; pw.x = pg8::cvt_pk_bf16(st[kb][8 * s2 + 0], st[kb][8 * s2 + 1]); pw.y = pg8::cvt_pk_bf16(st[kb][8 * s2 + 2], st[kb][8 * s2 + 3]);
                    pw.z = pg8::cvt_pk_bf16(st[kb][8 * s2 + 4], st[kb][8 * s2 + 5]); pw.w = pg8::cvt_pk_bf16(st[kb][8 * s2 + 6], st[kb][8 * s2 + 7]);
                    const bf16x8 pf = __builtin_bit_cast(bf16x8, pw);
#pragma unroll
                    for (int vb = 0; vb < 2; ++vb) { const bf16x8 vf = *(const LAS bf16x8*)(Vb + vb * 32 * AT_VSTR + (32 * kb + 16 * s2) * 2); ot[vb] = __builtin_amdgcn_mfma_f32_32x32x16_bf16(vf, pf, ot[vb], 0, 0, 0); }
                }
        }
        if (tt < NT) AT_STORE(buf ^ 1);
        __syncthreads();
    }
#undef AT_LOAD
#undef AT_STORE
    l += lx(l, lane, 32);
    const float inv = 1.0f / l;
    bf16* AV = (bf16*)(ws + WS_AV) + (size_t)qrow * 512 + h * 64 + 4 * half;
#pragma unroll
    for (int vb = 0; vb < 2; ++vb)
#pragma unroll
        for (int g = 0; g < 4; ++g) { f32x4 o; o[0] = ot[vb][4 * g] * inv; o[1] = ot[vb][4 * g + 1] * inv; o[2] = ot[vb][4 * g + 2] * inv; o[3] = ot[vb][4 * g + 3] * inv; *(u32x2*)(AV + 32 * vb + 8 * g) = pack4(o); }
}
__device__ __forceinline__ void attn_item(Frame& F, unsigned char* ws, int i) { const int bh = i & 63; attn_unit(F, ws, bh >> 3, bh & 7, 7 - (i >> 6)); }
__device__ __forceinline__ void attn_phase(Frame& F, unsigned char* ws) {
    const int c = F.vcu;
    if (c >= 256) return;
    const int bh = c >> 2, p = c & 3;
    attn_unit(F, ws, bh >> 3, bh & 7, 7 - p);
    attn_unit(F, ws, bh >> 3, bh & 7, p);
}
}
namespace mk {
constexpr size_t WS_UMETA = WS_END3;
constexpr size_t WS_UT = WS_UMETA + al((size_t)RH * RDV * RDK * 4);
constexpr size_t WS_SPREV = WS_UT + al((size_t)32 * 16 * RDV * RDK * 4);
constexpr size_t WS_RIN = WS_SPREV + al((size_t)32 * 16 * RDV * RDK * 2);
constexpr size_t WS_DPART = WS_RIN + al((size_t)MP * 1024 * 2);
constexpr size_t WS_QL = WS_DPART + al((size_t)32 * 16 * 8 * 264 * 4);
constexpr size_t WS_END4 = WS_QL + al((size_t)64 * 2048 * 4);
static_assert(WS_END4 < ((size_t)1 << 31), "32-bit workspace offsets");
__device__ __forceinline__ float gpow_t(const unsigned char* ws, int h, int n) { return ((const float*)(ws + WS_TAB + TAB_GP))[h * 128 + n]; }

__device__ __forceinline__ void ret_u_unit(Frame& F, unsigned char* ws, int u) {
    ws = opaque_g(ws);
    const int tid = fresh_tid(F.wave), lane = tid & 63, w = F.wave, r32 = lane & 31, half = lane >> 5;
    const bool meta = u >= 512; const int hh = meta ? u - 512 : (u >> 4) & 3;
    const int tok0 = meta ? ROW_META : (u >> 6) * SEQ + (u & 15) * 128, nks = meta ? 1 : 8;
    const bf16* RVT = (const bf16*)(ws + WS_RVT); const bf16* RKT = (const bf16*)(ws + WS_RKT);
    f32x16 acc[4];
#pragma unroll
    for (int db = 0; db < 4; ++db)
#pragma unroll
        for (int i = 0; i < 16; ++i) acc[db][i] = 0.f;
    const bf16* ap = RVT + (size_t)(hh * 256 + 32 * w + r32) * MP + tok0 + 8 * half;
    const bf16* bp = RKT + (size_t)(hh * 128 + r32) * MP + tok0 + 8 * half;
    for (int s = 0; s < nks; ++s) {
        const bf16x8 af = *(const bf16x8*)(ap + 16 * s);
#pragma unroll
        for (int db = 0; db < 4; ++db) { const bf16x8 bf = *(const bf16x8*)(bp + (size_t)(32 * db) * MP + 16 * s); acc[db] = __builtin_amdgcn_mfma_f32_32x32x16_bf16(af, bf, acc[db], 0, 0, 0); }
    }
    const float sc = gpow_t(ws, hh, meta ? NMETA - 1 : 127);
    float* dst = meta ? (float*)(ws + WS_UMETA) + (size_t)hh * RDV * RDK : (float*)(ws + WS_UT) + (size_t)u * RDV * RDK;
#pragma unroll
    for (int db = 0; db < 4; ++db)
#pragma unroll
        for (int i = 0; i < 16; ++i) dst[(size_t)(32 * w + crow(i, half)) * RDK + 32 * db + r32] = acc[db][i] * sc;
}
__device__ __forceinline__ void ret_scan(Frame& F, const Ptrs& a) {
    const int tid = fresh_tid(F.wave);
    const int gt = (F.vcu * NWAVES * 64) + tid, NGT = F.G * NWAVES * 64;
    const float* UM = (const float*)(a.ws + WS_UMETA); const float* UT = (const float*)(a.ws + WS_UT); bf16* SP = (bf16*)(a.ws + WS_SPREV);
    for (int e = gt; e < 32 * RDV * RDK; e += NGT) {
        const int bh = e >> 15, idx = e & 32767, hh = bh & 3;
        const float g128 = gpow_t(a.ws, hh, 127) * gpow_t(a.ws, hh, 1);
        float S = UM[(size_t)hh * 32768 + idx];
        for (int c = 0; c < 16; ++c) { const size_t o = ((size_t)bh * 16 + c) * 32768 + idx; SP[o] = bf1(S); S = g128 * S + UT[o]; }
        const int ee = idx >> 7, d = idx & 127;
        a.out()[OUT_SRP + ((size_t)bh * RDK + d) * RDV + ee] = S;
    }
}
__device__ __forceinline__ void ret_o_unit(Frame& F, const Ptrs& a, int u) {
    unsigned char* ws = a.ws; ws = opaque_g(ws);
    const int tid = fresh_tid(F.wave), lane = tid & 63, w = F.wave, r32 = lane & 31, half = lane >> 5;
    const int bh = u >> 4, c = u & 15, hh = bh & 3, tok0 = (bh >> 2) * SEQ + c * 128;
    const int ib = w & 3, eh = w >> 2;
    LAS float* red = (LAS float*)(F.lds + RING_OFF);
    const bf16* RQ = (const bf16*)(ws + WS_RQ); const bf16* RK = (const bf16*)(ws + WS_RK); const bf16* RVT = (const bf16*)(ws + WS_RVT);
    const bf16* SP = (const bf16*)(ws + WS_SPREV) + (size_t)u * 32768;
    const int irow = tok0 + 32 * ib + r32;
    bf16x8 qf[8];
#pragma unroll
    for (int s = 0; s < 8; ++s) qf[s] = *(const bf16x8*)(RQ + (size_t)irow * 512 + hh * 128 + 16 * s + 8 * half);
    f32x16 ot[4];
#pragma unroll
    for (int eb = 0; eb < 4; ++eb) {
#pragma unroll
        for (int i = 0; i < 16; ++i) ot[eb][i] = 0.f;
        const bf16* sp = SP + (size_t)(128 * eh + 32 * eb + r32) * RDK + 8 * half;
#pragma unroll
        for (int s = 0; s < 8; ++s) { const bf16x8 sf = *(const bf16x8*)(sp + 16 * s); ot[eb] = __builtin_amdgcn_mfma_f32_32x32x16_bf16(sf, qf[s], ot[eb], 0, 0, 0); }
    }
    const float g = gpow_t(ws, hh, 1);
#pragma unroll
    for (int eb = 0; eb < 4; ++eb)
#pragma unroll
        for (int i = 0; i < 16; ++i) ot[eb][i] *= g;
    for (int jb = 0; jb <= ib; ++jb) {
        f32x16 at;
#pragma unroll
        for (int i = 0; i < 16; ++i) at[i] = 0.f;
        const bf16* kp = RK + (size_t)(tok0 + 32 * jb + r32) * 512 + hh * 128 + 8 * half;
#pragma unroll
        for (int s = 0; s < 8; ++s) { const bf16x8 kf = *(const bf16x8*)(kp + 16 * s); at = __builtin_amdgcn_mfma_f32_32x32x16_bf16(kf, qf[s], at, 0, 0, 0); }
        if (jb == ib) {
#pragma unroll
            for (int i = 0; i < 16; ++i) if (crow(i, half) > r32) at[i] = 0.f;
        }
#pragma unroll
        for (int s2 = 0; s2 < 2; ++s2) {
            u32x4 pw; pw.x = pg8::cvt_pk_bf16(at[8 * s2 + 0], at[8 * s2 + 1]); pw.y = pg8::cvt_pk_bf16(at[8 * s2 + 2], at[8 * s2 + 3]);
            pw.z = pg8::cvt_pk_bf16(at[8 * s2 + 4], at[8 * s2 + 5]); pw.w = pg8::cvt_pk_bf16(at[8 * s2 + 6], at[8 * s2 + 7]);
            const bf16x8 pf = __builtin_bit_cast(bf16x8, pw);
#pragma unroll
            for (int eb = 0; eb < 4; ++eb) {
                const bf16* vp = RVT + (size_t)(hh * 256 + 128 * eh + 32 * eb + r32) * MP + tok0 + 32 * jb + 16 * s2 + 4 * half;
                const u32x2 lo = *(const u32x2*)vp, hi = *(const u32x2*)(vp + 8);
                u32x4 vw; vw.x = lo.x; vw.y = lo.y; vw.z = hi.x; vw.w = hi.y;
                ot[eb] = __builtin_amdgcn_mfma_f32_32x32x16_bf16(__builtin_bit_cast(bf16x8, vw), pf, ot[eb], 0, 0, 0);
            }
        }
    }
    float s1 = 0.f;
#pragma unroll
    for (int eb = 0; eb < 4; ++eb)
#pragma unroll
        for (int i = 0; i < 16; ++i) s1 += ot[eb][i];
    s1 += lx(s1, lane, 32);
    if (half == 0) red[w * 32 + r32] = s1;
    __syncthreads();
    const float mu = (red[w * 32 + r32] + red[(w ^ 4) * 32 + r32]) * (1.f / 256.f);
    float s2 = 0.f;
#pragma unroll
    for (int eb = 0; eb < 4; ++eb)
#pragma unroll
        for (int i = 0; i < 16; ++i) { ot[eb][i] -= mu; s2 += ot[eb][i] * ot[eb][i]; }
    s2 += lx(s2, lane, 32);
    if (half == 0) red[256 + w * 32 + r32] = s2;
    __syncthreads();
    const float rstd = 1.0f / sqrtf((red[256 + w * 32 + r32] + red[256 + (w ^ 4) * 32 + r32]) * (1.f / 256.f) + EPS);
    __syncthreads();
    const bf16* SRG = (const bf16*)(ws + WS_SRG) + (size_t)irow * 1024 + hh * 256 + 128 * eh + 4 * half;
    bf16* RIN = (bf16*)(ws + WS_RIN) + (size_t)irow * 1024 + hh * 256 + 128 * eh + 4 * half;
    const float* gn = a.in(19) + hh * 256 + 128 * eh + 4 * half;
#pragma unroll
    for (int eb = 0; eb < 4; ++eb)
#pragma unroll
        for (int gq = 0; gq < 4; ++gq) {
            const int eo = 32 * eb + 8 * gq;
            const u32x2 sg = *(const u32x2*)(SRG + eo); const f32x4 gv = *(const f32x4*)(gn + eo);
            f32x4 o;
            o[0] = ot[eb][4 * gq + 0] * rstd * gv[0] * __uint_as_float(sg.x << 16); o[1] = ot[eb][4 * gq + 1] * rstd * gv[1] * __uint_as_float(sg.x & 0xffff0000u);
            o[2] = ot[eb][4 * gq + 2] * rstd * gv[2] * __uint_as_float(sg.y << 16); o[3] = ot[eb][4 * gq + 3] * rstd * gv[3] * __uint_as_float(sg.y & 0xffff0000u);
            *(u32x2*)(RIN + eo) = pack4(o);
        }
}
__device__ __forceinline__ void ret_sample_unit(Frame& F, const Ptrs& a, int u) {
    unsigned char* ws = a.ws; ws = opaque_g(ws);
    const int tid = fresh_tid(F.wave), lane = tid & 63, s = u >> 2, hh = u & 3, e = tid & 255, dh = tid >> 8, row = ROW_SMP + s;
    LAS float* sh = (LAS float*)(F.lds + RING_OFF);
    const bf16* RQ = (const bf16*)(ws + WS_RQ); const bf16* RK = (const bf16*)(ws + WS_RK); const bf16* RVT = (const bf16*)(ws + WS_RVT);
    if (tid < 128) sh[tid] = __uint_as_float((unsigned)RQ[(size_t)row * 512 + hh * 128 + tid] << 16);
    else if (tid < 256) sh[tid] = __uint_as_float((unsigned)RK[(size_t)row * 512 + hh * 128 + tid - 128] << 16);
    __syncthreads();
    const float v = __uint_as_float((unsigned)RVT[(size_t)(hh * 256 + e) * MP + row] << 16);
    const float g = gpow_t(ws, hh, 1);
    const float* S0 = a.in(4) + ((size_t)(s * RH + hh) * RDK) * RDV + e;
    float* S1 = a.out() + OUT_SRS + ((size_t)(s * RH + hh) * RDK) * RDV + e;
    float o = 0.f;
#pragma unroll 8
    for (int d = 64 * dh; d < 64 * dh + 64; ++d) { const float sn = g * S0[(size_t)d * RDV] + sh[128 + d] * v; S1[(size_t)d * RDV] = sn; o += sh[d] * sn; }
    sh[256 + dh * 256 + e] = o;
    __syncthreads();
    o = sh[256 + e] + sh[512 + e];
    float t1 = o;
#pragma unroll
    for (int off = 32; off > 0; off >>= 1) t1 += lx(t1, lane, off);
    if ((tid & 63) == 0) sh[768 + (tid >> 6)] = t1;
    __syncthreads();
    const float mu = (sh[768] + sh[769] + sh[770] + sh[771]) * (1.f / 256.f);
    const float dlt = o - mu;
    float t2 = dlt * dlt;
#pragma unroll
    for (int off = 32; off > 0; off >>= 1) t2 += lx(t2, lane, off);
    if ((tid & 63) == 0) sh[776 + (tid >> 6)] = t2;
    __syncthreads();
    const float rstd = 1.0f / sqrtf((sh[776] + sh[777] + sh[778] + sh[779]) * (1.f / 256.f) + EPS);
    if (dh == 0) { const float sg = __uint_as_float((unsigned)((const bf16*)(ws + WS_SRG))[(size_t)row * 1024 + hh * 256 + e] << 16);
        ((bf16*)(ws + WS_RIN))[(size_t)row * 1024 + hh * 256 + e] = bf1(dlt * rstd * a.in(19)[hh * 256 + e] * sg); }
    __syncthreads();
}
}
namespace mk {
template <int CTRL> __device__ __forceinline__ float dppf(float v) { return __int_as_float(__builtin_amdgcn_update_dpp(0, __float_as_int(v), CTRL, 0xF, 0xF, false)); }
__device__ __forceinline__ float swap32_add(float a, float b) { const auto r = __builtin_amdgcn_permlane32_swap(__float_as_uint(a), __float_as_uint(b), false, false); return __uint_as_float(r[0]) + __uint_as_float(r[1]); }
__device__ __forceinline__ float swap16_add(float a, float b) { const auto r = __builtin_amdgcn_permlane16_swap(__float_as_uint(a), __float_as_uint(b), false, false); return __uint_as_float(r[0]) + __uint_as_float(r[1]); }
__device__ __forceinline__ int dlane_of(int h) { return ((h >> 2) & 1) * 32 + ((h >> 1) & 1) * 16 + (h & 1) * 8; }
__device__ __forceinline__ void decode_unit(Frame& F, const Ptrs& a, int u) {
    unsigned char* ws = a.ws; ws = opaque_g(ws);
    const int tid = fresh_tid(F.wave), lane = tid & 63, w = F.wave, s = u >> 4, sp = u & 15, row = ROW_SMP + s;
    LAS float* sh = (LAS float*)(F.lds + RING_OFF);
    const bf16* QA = (const bf16*)(ws + WS_QA) + (size_t)row * 768;
    f32x4 ql[8]; float qr[8];
    { const float* QLr = (const float*)(ws + WS_QL) + (size_t)(row - MMAIN) * 2048;
#pragma unroll
      for (int h = 0; h < 8; ++h) { ql[h] = *(const f32x4*)(QLr + h * 256 + 4 * lane); qr[h] = lane < 32 ? __uint_as_float((unsigned)QA[h * 96 + 64 + lane] << 16) : 0.f; } }
    f32x4 O[8];
#pragma unroll
    for (int h = 0; h < 8; ++h) O[h] = (f32x4){0.f, 0.f, 0.f, 0.f};
    float m = -INFINITY, l = 0.f;
    const int page = ((const int*)a.in(5))[s * NPAGES + sp * 8 + w];
    const float* ck0 = a.in(2) + (size_t)page * PAGE * KVR + 4 * lane;
    const float* kr0 = a.in(3) + (size_t)page * PAGE * 32 + (lane & 31);
#define DC_LOAD(kv_, rv_, bi_) do { const float* c_ = ck0; const float* r_ = kr0; const int k0_ = (bi_) * 4; \
        _Pragma("unroll") for (int kk = 0; kk < 4; ++kk) { kv_[kk] = *(const f32x4*)(c_ + (size_t)(k0_ + kk) * KVR); rv_[kk] = r_[(size_t)(k0_ + kk) * 32]; } } while (0)
#define DC_COMPUTE(kv_, rv_) do { float sc[4]; \
        _Pragma("unroll") for (int kk = 0; kk < 4; ++kk) { float p[8]; \
            _Pragma("unroll") for (int h = 0; h < 8; ++h) p[h] = fmaf(ql[h][0], kv_[kk][0], fmaf(ql[h][1], kv_[kk][1], fmaf(ql[h][2], kv_[kk][2], fmaf(ql[h][3], kv_[kk][3], qr[h] * rv_[kk])))); \
              \
            const float a0 = swap32_add(p[0], p[4]), a1 = swap32_add(p[1], p[5]), a2 = swap32_add(p[2], p[6]), a3 = swap32_add(p[3], p[7]); \
            const float b0 = swap16_add(a0, a2), b1 = swap16_add(a1, a3); \
            const float c0 = b0 + dppf<0x128>(b0), c1 = b1 + dppf<0x128>(b1); \
            float v1 = (lane & 8) ? c1 : c0; \
            v1 += dppf<0xB1>(v1); v1 += dppf<0x4E>(v1); v1 += dppf<0x141>(v1); sc[kk] = v1; } \
        const float mx = fmaxf(fmaxf(sc[0], sc[1]), fmaxf(sc[2], sc[3])); \
        const float mn = fmaxf(m, mx), alpha = __builtin_amdgcn_exp2f(m - mn); m = mn; \
        float pe[4]; \
        _Pragma("unroll") for (int kk = 0; kk < 4; ++kk) pe[kk] = __builtin_amdgcn_exp2f(sc[kk] - mn); \
        l = l * alpha + ((pe[0] + pe[1]) + (pe[2] + pe[3])); \
        _Pragma("unroll") for (int h = 0; h < 8; ++h) { const int src = dlane_of(h); \
            const float ah = __int_as_float(__builtin_amdgcn_readlane(__float_as_int(alpha), src)), p0 = __int_as_float(__builtin_amdgcn_readlane(__float_as_int(pe[0]), src)), p1 = __int_as_float(__builtin_amdgcn_readlane(__float_as_int(pe[1]), src)), \
                        p2 = __int_as_float(__builtin_amdgcn_readlane(__float_as_int(pe[2]), src)), p3 = __int_as_float(__builtin_amdgcn_readlane(__float_as_int(pe[3]), src)); \
            O[h] = O[h] * ah + kv_[0] * p0 + kv_[1] * p1 + kv_[2] * p2 + kv_[3] * p3; } } while (0)
    f32x4 kvA[4], kvB[4], kvC[4]; float rvA[4], rvB[4], rvC[4];
#define DC_PIN() __builtin_amdgcn_sched_barrier(0)
    DC_LOAD(kvA, rvA, 0); DC_LOAD(kvB, rvB, 1); DC_PIN();
#pragma unroll 1
    for (int bi = 0; bi < 30; bi += 3) {
        DC_LOAD(kvC, rvC, bi + 2); DC_PIN();
        DC_COMPUTE(kvA, rvA); DC_PIN();
        DC_LOAD(kvA, rvA, bi + 3); DC_PIN();
        DC_COMPUTE(kvB, rvB); DC_PIN();
        DC_LOAD(kvB, rvB, bi + 4); DC_PIN();
        DC_COMPUTE(kvC, rvC); DC_PIN();
    }
    DC_COMPUTE(kvA, rvA);
    DC_COMPUTE(kvB, rvB);
#undef DC_PIN
#undef DC_LOAD
#undef DC_COMPUTE
    LAS float* wm = sh + 2304 + w * 16;
    LAS float* wo = sh + 2304 + 128 + w * 2048;
    { const int hd = 4 * (lane >> 5) + 2 * ((lane >> 4) & 1) + ((lane >> 3) & 1); if ((lane & 7) == 0) { wm[hd] = m; wm[8 + hd] = l; } }
#pragma unroll
    for (int h = 0; h < 8; ++h) *(LAS f32x4*)(wo + h * 256 + 4 * lane) = O[h];
    __syncthreads();
    float* part = (float*)(ws + WS_DPART) + (size_t)u * 8 * 264;
    for (int e = tid; e < 2048; e += 512) {
        const int h = e >> 8;
        float M = -INFINITY;
#pragma unroll
        for (int ww = 0; ww < 8; ++ww) M = fmaxf(M, sh[2304 + ww * 16 + h]);
        float acc = 0.f, L = 0.f;
#pragma unroll
        for (int ww = 0; ww < 8; ++ww) { const float f = __builtin_amdgcn_exp2f(sh[2304 + ww * 16 + h] - M); acc += f * sh[2304 + 128 + ww * 2048 + e]; L += f * sh[2304 + ww * 16 + 8 + h]; }
        part[h * 264 + (e & 255)] = acc;
        if ((e & 255) == 0) { part[h * 264 + 256] = M; part[h * 264 + 257] = L; }
    }
    __syncthreads();
}
__device__ __forceinline__ void decode_combine_unit(Frame& F, const Ptrs& a, int u) {
    unsigned char* ws = opaque_g(a.ws);
    const int tid = fresh_tid(F.wave), lane = tid & 63, s = u >> 3, h = u & 7, row = ROW_SMP + s;
    LAS float* sh = (LAS float*)(F.lds + RING_OFF);
    const bf16* QA = (const bf16*)(ws + WS_QA) + (size_t)row * 768;
    const float* part = (const float*)(ws + WS_DPART) + (size_t)s * 16 * 8 * 264;
    if (tid < 64) { const bf16* KNr = (const bf16*)(ws + WS_KN) + (size_t)row * 512;
        float acc = __uint_as_float((unsigned)QA[h * 96 + lane] << 16) * __uint_as_float((unsigned)KNr[h * 64 + lane] << 16);
        if (lane < 32) acc += __uint_as_float((unsigned)QA[h * 96 + 64 + lane] << 16) * ((const float*)(ws + WS_KRF))[(size_t)row * 32 + lane];
#pragma unroll
        for (int off = 32; off > 0; off >>= 1) acc += lx(acc, lane, off);
        if (lane == 0) sh[256] = acc; }
    __syncthreads();
    if (tid < 256) {
        const int r = tid;
        const float sn = sh[256];
        float pm[16];
#pragma unroll
        for (int p = 0; p < 16; ++p) pm[p] = part[(p * 8 + h) * 264 + 256];
        float M = sn;
#pragma unroll
        for (int p = 0; p < 16; ++p) M = fmaxf(M, pm[p]);
        const float rkv = row_rscale4((const float*)(ws + WS_SSQKV), row, 1.f / KVR);
        const float cn = ((const float*)(ws + WS_CKVF))[(size_t)row * KVR + r] * rkv * a.in(14)[r];
        const float fn = __builtin_amdgcn_exp2f(sn - M);
        float acc = fn * cn, Lq = fn;
#pragma unroll
        for (int p = 0; p < 16; ++p) { const float f = __builtin_amdgcn_exp2f(pm[p] - M); acc += f * part[(p * 8 + h) * 264 + r]; Lq += f * part[(p * 8 + h) * 264 + 257]; }
        sh[r] = acc / Lq;
    }
    __syncthreads();
    { const int v = tid & 63, rg = tid >> 6; const float* wuv = a.in(17) + (size_t)(32 * rg) * 512 + h * 64 + v;
      float wv[32];
#pragma unroll
      for (int k = 0; k < 32; ++k) wv[k] = wuv[(size_t)k * 512];
      float acc = 0.f;
#pragma unroll
      for (int k = 0; k < 32; ++k) acc += sh[32 * rg + k] * wv[k];
      sh[264 + rg * 64 + v] = acc; }
    __syncthreads();
    if (tid < 64) { float acc = 0.f;
#pragma unroll
        for (int rg = 0; rg < 8; ++rg) acc += sh[264 + rg * 64 + tid];
        ((bf16*)(ws + WS_AV))[(size_t)row * 512 + h * 64 + tid] = bf1(acc); }
    __syncthreads();
}
}
namespace mk {
constexpr size_t WS_TMP = WS_ACT;
constexpr size_t WS_MX = WS_RQ;
constexpr size_t WS_H2B = WS_MX + al((size_t)MP * 1024 * 2);
constexpr size_t WS_H2 = WS_UT;
constexpr size_t WS_SSQH2 = WS_END4;
constexpr size_t WS_SSQH3 = WS_SSQH2 + al((size_t)MP * 16 * 4);
constexpr size_t WS_H3 = WS_H;
constexpr size_t WS_END6 = WS_SSQH3 + al((size_t)MP * 16 * 4);
static_assert(WS_H2B + (size_t)MP * 1024 * 2 <= WS_SRG && WS_H2 + (size_t)MP * 1024 * 4 <= WS_RIN && (size_t)MP * 1024 * 4 <= (size_t)MP * FFN * 2, "overlays");
static_assert(WS_END6 < ((size_t)1 << 31), "32-bit workspace offsets");

template <int STEP, unsigned GATE_OFF> struct EpiGate {
    static constexpr bool PERM = false, AFTER_DRAIN = false;
    unsigned char* ws_;
    __device__ __forceinline__ void operator()(const f32x4 (&acc)[2][2][4][2], const Unit& u, int wr, int wc, int fr, int fq) const {
        int l_ = lane_fresh(); asm volatile("" : "+v"(l_)); fr = l_ & 15; fq = l_ >> 4;
        unsigned char* w = opaque_g(ws_);
        const unsigned row0 = u.pm * BM + wr * 64 + fr, col0 = u.pn * BM + wc * 32 + 4 * fq;
#pragma unroll
        for (int ai = 0; ai < 2; ++ai)
#pragma unroll
            for (int m = 0; m < 4; ++m) { unsigned row = row0 + ai * HALF + m * 16; asm volatile("" : "+v"(row));
#pragma unroll
                for (int bj = 0; bj < 2; ++bj)
#pragma unroll
                    for (int n = 0; n < 2; ++n) { const unsigned e = row * 1024 + col0 + bj * HALF + n * 16;
                        const u32x2 gw = *at<const u32x2>(w, GATE_OFF + e * 2);
                        f32x4 g; g[0] = __uint_as_float(gw.x << 16); g[1] = __uint_as_float(gw.x & 0xffff0000u); g[2] = __uint_as_float(gw.y << 16); g[3] = __uint_as_float(gw.y & 0xffff0000u);
                        f32x4 o = acc[ai][bj][m][n] * g;
                        if (STEP == 0) *at<f32x4>(w, (unsigned)WS_TMP + e * 4) = o;
                        else { o = o + *at<const f32x4>(w, (unsigned)WS_TMP + e * 4); *at<u32x2>(w, (unsigned)WS_MX + e * 2) = pack4(o); } }
                asm volatile("" ::: "memory"); }
    }
};
struct EpiSwiGLU2 {
    static constexpr bool PERM = true, AFTER_DRAIN = false;
    unsigned char* ws_;
    __device__ __forceinline__ void operator()(const f32x4 (&acc)[2][2][4][2], const Unit& u, int wr, int wc, int fr, int fq) const {
        int l_ = lane_fresh(); asm volatile("" : "+v"(l_)); fr = l_ & 15; fq = l_ >> 4;
        unsigned char* w = opaque_g(ws_);
        const unsigned row0 = u.pm * BM + wr * 64 + fr, col0 = u.pn * HALF + wc * 32 + 8 * fq;
#pragma unroll
        for (int ai = 0; ai < 2; ++ai)
#pragma unroll
            for (int m = 0; m < 4; ++m) { unsigned row = row0 + ai * HALF + m * 16; asm volatile("" : "+v"(row));
                const float r = row_rscale16(at<const float>(w, (unsigned)WS_SSQH2), (int)row, 1.f / D);
                f32x4 o[2];
#pragma unroll
                for (int n = 0; n < 2; ++n)
#pragma unroll
                    for (int j = 0; j < 4; ++j) { const float g = acc[ai][0][m][n][j] * r, up = acc[ai][1][m][n][j] * r; o[n][j] = fast_silu(g) * up; }
                u32x4 pk; pk.x = pg8::cvt_pk_bf16(o[0][0], o[0][1]); pk.y = pg8::cvt_pk_bf16(o[0][2], o[0][3]); pk.z = pg8::cvt_pk_bf16(o[1][0], o[1][1]); pk.w = pg8::cvt_pk_bf16(o[1][2], o[1][3]);
                *at<u32x4>(w, (unsigned)WS_ACT + (row * FFN + col0) * 2) = pk;
                asm volatile("" ::: "memory"); }
    }
};
__device__ __forceinline__ void final_norm_phase(Frame& F, const Ptrs& a) {
    const int lane = fresh_tid(F.wave) & 63;
    const int gw = F.vcu * NWAVES + F.wave, NGW = F.G * NWAVES;
    const float* H3 = (const float*)(a.ws + WS_H3); const float* SSQ = (const float*)(a.ws + WS_SSQH3);
    f32x4 g[4];
#pragma unroll
    for (int j = 0; j < 4; ++j) g[j] = *((const f32x4*)a.in(26) + lane + 64 * j);
    for (int row0 = gw; row0 < ROW_PAD; row0 += 2 * NGW) {
        f32x4 v[2][4]; float r[2];
#pragma unroll
        for (int t = 0; t < 2; ++t) { const int row = row0 + t * NGW; const bool ok = row < ROW_PAD && !(row >= MMAIN && row < ROW_SMP);
            r[t] = ok ? row_rscale16(SSQ, row, 1.f / D) : 0.f;
#pragma unroll
            for (int j = 0; j < 4; ++j) v[t][j] = ok ? *((const f32x4*)(H3 + (size_t)row * D) + lane + 64 * j) : (f32x4){0.f, 0.f, 0.f, 0.f}; }
#pragma unroll
        for (int t = 0; t < 2; ++t) { const int row = row0 + t * NGW; if (row >= ROW_PAD || (row >= MMAIN && row < ROW_SMP)) continue;
            float* dst = row < MMAIN ? a.out() + OUT_YP + (size_t)row * D : a.out() + OUT_YS + (size_t)(row - ROW_SMP) * D;
#pragma unroll
            for (int j = 0; j < 4; ++j) *((f32x4*)dst + lane + 64 * j) = v[t][j] * r[t] * g[j]; }
    }
}
}
namespace mk {
typedef float f32x4_t __attribute__((ext_vector_type(4)));
constexpr int XROW0 = MMAIN, SK_C = 64 * 64;
__device__ __forceinline__ void skinny64(int wave, int tid, const bf16* A, int K, const bf16* Bt, int brow0, LAS float* P, float (&out)[8]) {
    const int lane = tid & 63, r16 = lane & 15, kq = lane >> 4;
    const bf16* ap = A + (size_t)(XROW0 + r16) * K + 8 * kq;
    const bf16* bp = Bt + (size_t)(brow0 + r16) * K + 8 * kq;
    f32x4 acc[4][4];
#pragma unroll
    for (int mf = 0; mf < 4; ++mf)
#pragma unroll
        for (int nf = 0; nf < 4; ++nf) acc[mf][nf] = (f32x4){0.f, 0.f, 0.f, 0.f};
    const int KS = K / 32;
    bf16x8 a0[4], b0[4], a1[4], b1[4], a2[4], b2[4];
#define SK_LOAD(a_, b_, kk_) do { _Pragma("unroll") for (int f = 0; f < 4; ++f) { a_[f] = *(const bf16x8*)(ap + (size_t)(16 * f) * K + 32 * (kk_)); b_[f] = *(const bf16x8*)(bp + (size_t)(16 * f) * K + 32 * (kk_)); } } while (0)
#define SK_MMA(a_, b_) do { _Pragma("unroll") for (int mf = 0; mf < 4; ++mf) _Pragma("unroll") for (int nf = 0; nf < 4; ++nf) acc[mf][nf] = __builtin_amdgcn_mfma_f32_16x16x32_bf16(a_[mf], b_[nf], acc[mf][nf], 0, 0, 0); } while (0)
    int kk = wave;
    if (kk < KS) SK_LOAD(a0, b0, kk);
    if (kk + 8 < KS) SK_LOAD(a1, b1, kk + 8);
    if (kk + 16 < KS) SK_LOAD(a2, b2, kk + 16);
    for (; kk < KS; kk += 24) {
        SK_MMA(a0, b0); if (kk + 24 < KS) SK_LOAD(a0, b0, kk + 24);
        if (kk + 8 < KS) { SK_MMA(a1, b1); if (kk + 32 < KS) SK_LOAD(a1, b1, kk + 32); }
        if (kk + 16 < KS) { SK_MMA(a2, b2); if (kk + 40 < KS) SK_LOAD(a2, b2, kk + 40); }
    }
#undef SK_LOAD
#undef SK_MMA
    LAS float* Pw = P + wave * SK_C;
#pragma unroll
    for (int mf = 0; mf < 4; ++mf)
#pragma unroll
        for (int nf = 0; nf < 4; ++nf)
#pragma unroll
            for (int i = 0; i < 4; ++i) Pw[(16 * mf + 4 * kq + i) * 64 + 16 * nf + r16] = acc[mf][nf][i];
    __syncthreads();
    const LAS float* pr = P + (tid >> 3) * 64 + 8 * (tid & 7);
    f32x4 s0 = *(const LAS f32x4*)pr, s1 = *(const LAS f32x4*)(pr + 4);
#pragma unroll
    for (int w = 1; w < 8; ++w) { s0 = s0 + *(const LAS f32x4*)(pr + w * SK_C); s1 = s1 + *(const LAS f32x4*)(pr + w * SK_C + 4); }
    out[0] = s0[0]; out[1] = s0[1]; out[2] = s0[2]; out[3] = s0[3]; out[4] = s1[0]; out[5] = s1[1]; out[6] = s1[2]; out[7] = s1[3];
    __syncthreads();
}
__device__ __forceinline__ float sum8(float v, int lane) { v += lx(v, lane, 1); v += lx(v, lane, 2); v += lx(v, lane, 4); return v; }
__device__ __forceinline__ void st8_bf16(bf16* p, const float* v) { u32x4 w; w.x = pg8::cvt_pk_bf16(v[0], v[1]); w.y = pg8::cvt_pk_bf16(v[2], v[3]); w.z = pg8::cvt_pk_bf16(v[4], v[5]); w.w = pg8::cvt_pk_bf16(v[6], v[7]); *(u32x4*)p = w; }
__device__ __forceinline__ void ld8(const LAS float* p, float* v) { const f32x4 a = *(const LAS f32x4*)p, b = *(const LAS f32x4*)(p + 4); v[0] = a[0]; v[1] = a[1]; v[2] = a[2]; v[3] = a[3]; v[4] = b[0]; v[5] = b[1]; v[6] = b[2]; v[7] = b[3]; }

__device__ __forceinline__ void xjob_ffn_up(Frame& F, unsigned char* ws, int j, size_t a_off, size_t w_off, int rs_mode) {
    ws = opaque_g(ws);
    const int tid = fresh_tid(F.wave);
    LAS float* P = (LAS float*)(F.lds + RING_OFF);
    const int brow0 = 256 * (j >> 1) + 64 * (j & 1);
    float g[8], u[8], o[8];
    skinny64(F.wave, tid, (const bf16*)(ws + a_off), D, (const bf16*)(ws + w_off), brow0, P, g);
    skinny64(F.wave, tid, (const bf16*)(ws + a_off), D, (const bf16*)(ws + w_off), brow0 + 128, P, u);
    const int r = tid >> 3, cg = tid & 7, row = XROW0 + r;
    const float rs = rs_mode == 0 ? ((const float*)(ws + WS_R1))[row] : row_rscale16((const float*)(ws + WS_SSQH2), row, 1.f / D);
#pragma unroll
    for (int k = 0; k < 8; ++k) o[k] = fast_silu(g[k] * rs) * (u[k] * rs);
    st8_bf16((bf16*)(ws + WS_ACT) + (size_t)row * FFN + 64 * j + 8 * cg, o);
}
__device__ __forceinline__ void xjob_resid(Frame& F, unsigned char* ws, int j, size_t a_off, int K, size_t w_off, const float* res  , float scale, size_t out_off, size_t outb_off, size_t ssq_off) {
    ws = opaque_g(ws);
    const int tid = fresh_tid(F.wave), lane = tid & 63;
    LAS float* P = (LAS float*)(F.lds + RING_OFF);
    float v[8], o[8];
    skinny64(F.wave, tid, (const bf16*)(ws + a_off), K, (const bf16*)(ws + w_off), 64 * j, P, v);
    const int r = tid >> 3, cg = tid & 7, row = XROW0 + r, col = 64 * j + 8 * cg;
    const f32x4 b0 = *(const f32x4*)(res + (size_t)r * D + col), b1 = *(const f32x4*)(res + (size_t)r * D + col + 4);
    float ss = 0.f;
#pragma unroll
    for (int k = 0; k < 8; ++k) { o[k] = (k < 4 ? b0[k] : b1[k - 4]) + scale * v[k]; ss += o[k] * o[k]; }
    float* op = (float*)(ws + out_off) + (size_t)row * D + col;
    *(f32x4*)op = (f32x4){o[0], o[1], o[2], o[3]}; *(f32x4*)(op + 4) = (f32x4){o[4], o[5], o[6], o[7]};
    if (outb_off) st8_bf16((bf16*)(ws + outb_off) + (size_t)row * D + col, o);
    ss = sum8(ss, lane);
    if (cg == 0) ((float*)(ws + ssq_off))[(size_t)row * 16 + j] = ss;
}
__device__ __forceinline__ void xjob_win(Frame& F, unsigned char* ws, int j) {
    ws = opaque_g(ws);
    const int tid = fresh_tid(F.wave), lane = tid & 63;
    LAS float* P = (LAS float*)(F.lds + RING_OFF);
    const int pn = j >> 1, q = j & 1;
    float v0[8], v1[8];
    skinny64(F.wave, tid, (const bf16*)(ws + WS_HB), D, (const bf16*)(ws + WS_WIN), 256 * pn + 64 * q, P, v0);
    skinny64(F.wave, tid, (const bf16*)(ws + WS_HB), D, (const bf16*)(ws + WS_WIN), 256 * pn + 64 * q + 128, P, v1);
    const int r = tid >> 3, cg = tid & 7, row = XROW0 + r;
    const float rs = row_rscale16((const float*)(ws + WS_SSQH), row, 1.f / D);
    const float* TAB = (const float*)(ws + WS_TAB);
#pragma unroll
    for (int k = 0; k < 8; ++k) { v0[k] *= rs; v1[k] *= rs; }
    const int tc0 = 64 * q + 8 * cg;
    if (pn == 0) {
        bf16* CQ = (bf16*)(ws + WS_CQ) + (size_t)row * QR; float* SSQCQ = (float*)(ws + WS_SSQCQ) + (size_t)row * 8;
        st8_bf16(CQ + tc0, v0); st8_bf16(CQ + tc0 + 128, v1);
        float s0 = 0.f, s1 = 0.f;
#pragma unroll
        for (int k = 0; k < 8; ++k) { s0 += v0[k] * v0[k]; s1 += v1[k] * v1[k]; }
        s0 = sum8(s0, lane); s1 = sum8(s1, lane);
        if (cg == 0) { SSQCQ[2 * q] = s0; SSQCQ[2 * q + 1] = s1; }
    } else if (pn == 1) {
        bf16* CQ = (bf16*)(ws + WS_CQ) + (size_t)row * QR; float* SSQCQ = (float*)(ws + WS_SSQCQ) + (size_t)row * 8;
        st8_bf16(CQ + 256 + tc0, v0);
        float s0 = 0.f;
#pragma unroll
        for (int k = 0; k < 8; ++k) s0 += v0[k] * v0[k];
        s0 = sum8(s0, lane);
        if (cg == 0) { SSQCQ[4 + q] = s0; SSQCQ[6 + q] = 0.f; }
        float x2[8];
#pragma unroll
        for (int k = 0; k < 8; ++k) x2[k] = lx(v1[k], lane, 2);
        if (q == 0 && cg < 2) {
            const int pi = row_pidx(row), i0 = 8 * cg;
            float y1[8], y2[8];
#pragma unroll
            for (int k = 0; k < 8; ++k) { const float c = TAB[TAB_C16 / 4 + pi * 16 + i0 + k], s = TAB[TAB_S16 / 4 + pi * 16 + i0 + k]; y1[k] = v1[k] * c - x2[k] * s; y2[k] = v1[k] * s + x2[k] * c; }
            st8_bf16((bf16*)(ws + WS_KRB) + (size_t)row * 32 + i0, y1); st8_bf16((bf16*)(ws + WS_KRB) + (size_t)row * 32 + 16 + i0, y2);
            float* kf = (float*)(ws + WS_KRF) + (size_t)row * 32;
#pragma unroll
            for (int k = 0; k < 8; ++k) { kf[i0 + k] = y1[k]; kf[16 + i0 + k] = y2[k]; }
        }
    } else if (pn == 2) {
        float* CKVF = (float*)(ws + WS_CKVF) + (size_t)row * KVR; bf16* CKVB = (bf16*)(ws + WS_CKVB) + (size_t)row * KVR; float* SSQKV = (float*)(ws + WS_SSQKV) + (size_t)row * 4;
        float s0 = 0.f, s1 = 0.f;
#pragma unroll
        for (int k = 0; k < 8; ++k) { CKVF[tc0 + k] = v0[k]; CKVF[tc0 + 128 + k] = v1[k]; s0 += v0[k] * v0[k]; s1 += v1[k] * v1[k]; }
        st8_bf16(CKVB + tc0, v0); st8_bf16(CKVB + tc0 + 128, v1);
        s0 = sum8(s0, lane); s1 = sum8(s1, lane);
        if (cg == 0) { SSQKV[2 * q] = s0; SSQKV[2 * q + 1] = s1; }
    } else if (pn < 7) {
        const bool isk = pn >= 5; const int hh = 2 * ((pn - 3) & 1) + q, i0 = 8 * cg;
        const int pi = row_pidx(row), jt = row_jtok(row);
        const float mult = isk ? RK_SCALE * TAB[TAB_GN / 4 + hh * 128 + jt] : TAB[TAB_GP / 4 + hh * 128 + jt];
        float y1[8], y2[8];
#pragma unroll
        for (int k = 0; k < 8; ++k) { const float c = TAB[TAB_C64 / 4 + pi * 64 + i0 + k], s = TAB[TAB_S64 / 4 + pi * 64 + i0 + k]; y1[k] = (v0[k] * c - v1[k] * s) * mult; y2[k] = (v0[k] * s + v1[k] * c) * mult; }
        bf16* dst = (bf16*)(ws + (isk ? WS_RK : WS_RQ)) + (size_t)row * 512 + hh * 128;
        st8_bf16(dst + i0, y1); st8_bf16(dst + 64 + i0, y2);
        if (isk) { bf16* RKT = (bf16*)(ws + WS_RKT);
#pragma unroll
            for (int k = 0; k < 8; ++k) { RKT[(size_t)(hh * 128 + i0 + k) * MP + row] = bf1(y1[k]); RKT[(size_t)(hh * 128 + 64 + i0 + k) * MP + row] = bf1(y2[k]); } }
    } else if (pn < 11) {
        bf16* RVT = (bf16*)(ws + WS_RVT);
#pragma unroll
        for (int k = 0; k < 8; ++k) { RVT[(size_t)((pn - 7) * 256 + tc0 + k) * MP + row] = bf1(v0[k]); RVT[(size_t)((pn - 7) * 256 + tc0 + 128 + k) * MP + row] = bf1(v1[k]); }
    } else {
        const int t = (pn - 11) >> 2; bf16* dst = (bf16*)(ws + WS_SRG + (size_t)t * (WS_SGA - WS_SRG)) + (size_t)row * 1024 + ((pn - 11) & 3) * 256;
        float o0[8], o1[8];
#pragma unroll
        for (int k = 0; k < 8; ++k) { const float g0 = fast_sigmoid(v0[k]), g1 = fast_sigmoid(v1[k]); o0[k] = t == 0 ? v0[k] * g0 : g0; o1[k] = t == 0 ? v1[k] * g1 : g1; }
        st8_bf16(dst + tc0, o0); st8_bf16(dst + tc0 + 128, o1);
    }
}
__device__ __forceinline__ void xjob_q(Frame& F, unsigned char* ws, int j) {
    ws = opaque_g(ws);
    const int tid = fresh_tid(F.wave), lane = tid & 63;
    LAS float* P = (LAS float*)(F.lds + RING_OFF);
    float v[8], p[8], o[8];
    skinny64(F.wave, tid, (const bf16*)(ws + WS_CQ), QR, (const bf16*)(ws + WS_WUQ), 64 * j, P, v);
    const int r = tid >> 3, cg = tid & 7, row = XROW0 + r;
    const float rs = row_rscale8((const float*)(ws + WS_SSQCQ), row, 1.f / QR) * SC_Q;
    const float* TAB = (const float*)(ws + WS_TAB);
    const int pi = row_pidx(row), col = 64 * j + 8 * cg, grp = col >> 5, w32 = col & 31;
#pragma unroll
    for (int k = 0; k < 8; ++k) p[k] = lx(v[k], lane, 2);
    if (grp % 3 == 2) {
        const int i0 = w32 & 15;
#pragma unroll
        for (int k = 0; k < 8; ++k) { const float c = TAB[TAB_C16 / 4 + pi * 16 + i0 + k], sn = TAB[TAB_S16 / 4 + pi * 16 + i0 + k];
            o[k] = (w32 < 16 ? v[k] * c - p[k] * sn : p[k] * sn + v[k] * c) * rs; }
    } else {
#pragma unroll
        for (int k = 0; k < 8; ++k) o[k] = v[k] * rs;
    }
    st8_bf16((bf16*)(ws + WS_QA) + (size_t)row * 768 + col, o);
}
__device__ __forceinline__ void xjob_kv(Frame& F, unsigned char* ws, int j, bool is_v) {
    ws = opaque_g(ws);
    const int tid = fresh_tid(F.wave);
    LAS float* P = (LAS float*)(F.lds + RING_OFF);
    float v[8];
    skinny64(F.wave, tid, (const bf16*)(ws + WS_CKVB), KVR, (const bf16*)(ws + (is_v ? WS_WUV : WS_WUK)), 64 * j, P, v);
    const int r = tid >> 3, cg = tid & 7, row = XROW0 + r, col = 64 * j + 8 * cg;
    const float rs = row_rscale4((const float*)(ws + WS_SSQKV), row, 1.f / KVR);
#pragma unroll
    for (int k = 0; k < 8; ++k) v[k] *= rs;
    if (!is_v) st8_bf16((bf16*)(ws + WS_KN) + (size_t)row * 512 + col, v);
    else { bf16* VT = (bf16*)(ws + WS_VT);
#pragma unroll
        for (int k = 0; k < 8; ++k) VT[(size_t)(col + k) * MP + row] = bf1(v[k]); }
}
__device__ __forceinline__ void xjob_mix(Frame& F, unsigned char* ws, int j) {
    ws = opaque_g(ws);
    const int tid = fresh_tid(F.wave);
    LAS float* P = (LAS float*)(F.lds + RING_OFF);
    float a[8], b[8], o[8];
    skinny64(F.wave, tid, (const bf16*)(ws + WS_AV), 512, (const bf16*)(ws + WS_WMO), 64 * j, P, a);
    skinny64(F.wave, tid, (const bf16*)(ws + WS_RIN), D, (const bf16*)(ws + WS_WRO), 64 * j, P, b);
    const int r = tid >> 3, cg = tid & 7, row = XROW0 + r, col = 64 * j + 8 * cg;
    const u32x4 ga = *(const u32x4*)((const bf16*)(ws + WS_SGA) + (size_t)row * 1024 + col), gb = *(const u32x4*)((const bf16*)(ws + WS_SGB) + (size_t)row * 1024 + col);
#pragma unroll
    for (int k = 0; k < 8; ++k) { const unsigned wa = ga[k >> 1], wb = gb[k >> 1];
        const float fa = __uint_as_float((k & 1) ? (wa & 0xffff0000u) : (wa << 16)), fb = __uint_as_float((k & 1) ? (wb & 0xffff0000u) : (wb << 16));
        o[k] = fa * a[k] + fb * b[k]; }
    st8_bf16((bf16*)(ws + WS_MX) + (size_t)row * 1024 + col, o);
}
__device__ __forceinline__ void xjob_ql(Frame& F, unsigned char* ws, int j) {
    ws = opaque_g(ws);
    const int tid = fresh_tid(F.wave);
    LAS float* P = (LAS float*)(F.lds + RING_OFF);
    float v[8];
    skinny64(F.wave, tid, (const bf16*)(ws + WS_CQ), QR, (const bf16*)(ws + WS_WQL), 64 * j, P, v);
    const int r = tid >> 3, cg = tid & 7, row = XROW0 + r;
    const float rs = row_rscale8((const float*)(ws + WS_SSQCQ), row, 1.f / QR) * SC_Q;
    float* dst = (float*)(ws + WS_QL) + (size_t)r * 2048 + 64 * j + 8 * cg;
    *(f32x4*)dst = (f32x4){v[0] * rs, v[1] * rs, v[2] * rs, v[3] * rs}; *(f32x4*)(dst + 4) = (f32x4){v[4] * rs, v[5] * rs, v[6] * rs, v[7] * rs};
}
}
namespace mk {
constexpr int RC_STR = 272;
constexpr int RC_S = 0, RC_KT = 0  , RC_Q = 256 * RC_STR, RC_A = RC_Q + 128 * RC_STR, RC_RED = RC_A + 128 * RC_STR, RC_END = RC_RED + 2 * 8 * 128 * 4;
static_assert(RC_END <= SCR_BYTES, "chain LDS map");
__device__ __forceinline__ void ret_chain_unit(Frame& F, const Ptrs& a, int bh) {
    unsigned char* ws = a.ws; ws = opaque_g(ws);
    const int tid_k = fresh_tid(F.wave), w = F.wave;
    const int hh = bh & 3, b = bh >> 2;
    LAS unsigned char* L = F.lds + RING_OFF;
    LAS float* red = (LAS float*)(L + RC_RED);
    const bf16* RQ = (const bf16*)(ws + WS_RQ); const bf16* RK = (const bf16*)(ws + WS_RK); const bf16* RKT = (const bf16*)(ws + WS_RKT); const bf16* RVT = (const bf16*)(ws + WS_RVT);
    const float g = gpow_t(ws, hh, 1), g127 = gpow_t(ws, hh, 127);
    f32x16 S[4];
    {
        const int lane = tid_k & 63, r32 = lane & 31, half = lane >> 5;
#pragma unroll
        for (int db = 0; db < 4; ++db)
#pragma unroll
            for (int i = 0; i < 16; ++i) S[db][i] = 0.f;
        const bf16x8 af = *(const bf16x8*)(RVT + (size_t)(hh * 256 + 32 * w + r32) * MP + ROW_META + 8 * half);
#pragma unroll
        for (int db = 0; db < 4; ++db) { const bf16x8 bf = *(const bf16x8*)(RKT + (size_t)(hh * 128 + 32 * db + r32) * MP + ROW_META + 8 * half); S[db] = __builtin_amdgcn_mfma_f32_32x32x16_bf16(af, bf, S[db], 0, 0, 0); }
        const float sc = gpow_t(ws, hh, NMETA - 1);
#pragma unroll
        for (int db = 0; db < 4; ++db)
#pragma unroll
            for (int i = 0; i < 16; ++i) S[db][i] *= sc;
    }
    v4u qreg[4], jreg[4];
#define RC_FETCH_QK(tok0_) do { _Pragma("unroll") for (int k = 0; k < 4; ++k) { const int ch = tid + 512 * k; \
        qreg[k] = *(const v4u*)(RQ + (size_t)((tok0_) + (ch >> 4)) * 512 + hh * 128 + 8 * (ch & 15)); jreg[k] = *(const v4u*)(RK + (size_t)((tok0_) + (ch >> 4)) * 512 + hh * 128 + 8 * (ch & 15)); } } while (0)
    { const int tid = tid_k; RC_FETCH_QK(b * SEQ); }
#define RC_BLK_IB(n) ((n) < 1 ? 0 : (n) < 3 ? 1 : (n) < 6 ? 2 : 3)
#define RC_BLK_JB(n) ((n) - ((n) < 1 ? 0 : (n) < 3 ? 1 : (n) < 6 ? 3 : 6))
#pragma unroll 1
    for (int c = 0; c < 16; ++c) {
        const int tok0 = b * SEQ + c * 128;
        int tid_c = tid_k; asm volatile("" : "+v"(tid_c));
        const int tid = tid_c, lane = tid & 63, r32 = lane & 31, half = lane >> 5;
#pragma unroll
        for (int k = 0; k < 4; ++k) { const int ch = tid + 512 * k; *(LAS v4u*)(L + RC_Q + (ch >> 4) * RC_STR + 16 * (ch & 15)) = qreg[k]; *(LAS v4u*)(L + RC_S + (ch >> 4) * RC_STR + 16 * (ch & 15)) = jreg[k]; }
        __syncthreads();
        v4u kreg[4];
#pragma unroll
        for (int k = 0; k < 4; ++k) { const int ch = tid + 512 * k; kreg[k] = *(const v4u*)(RKT + (size_t)(hh * 128 + (ch >> 4)) * MP + tok0 + 8 * (ch & 15)); }
        for (int n = w; n < 10; n += 8) {
            const int ib_ = RC_BLK_IB(n), jb_ = RC_BLK_JB(n);
            f32x16 at;
#pragma unroll
            for (int i = 0; i < 16; ++i) at[i] = 0.f;
#pragma unroll
            for (int s = 0; s < 8; ++s) { const bf16x8 kf = *(const LAS bf16x8*)(L + RC_S + (32 * jb_ + r32) * RC_STR + (16 * s + 8 * half) * 2); const bf16x8 qf = *(const LAS bf16x8*)(L + RC_Q + (32 * ib_ + r32) * RC_STR + (16 * s + 8 * half) * 2); at = __builtin_amdgcn_mfma_f32_32x32x16_bf16(kf, qf, at, 0, 0, 0); }
            if (jb_ == ib_) {
#pragma unroll
                for (int i = 0; i < 16; ++i) if (crow(i, half) > r32) at[i] = 0.f; }
#pragma unroll
            for (int gq = 0; gq < 4; ++gq) { f32x4 o_; o_[0] = at[4 * gq]; o_[1] = at[4 * gq + 1]; o_[2] = at[4 * gq + 2]; o_[3] = at[4 * gq + 3];
                *(LAS u32x2*)(L + RC_A + (32 * ib_ + r32) * RC_STR + (32 * jb_ + 8 * gq + 4 * half) * 2) = pack4(o_); }
        }
        __syncthreads();
#pragma unroll
        for (int db = 0; db < 4; ++db)
#pragma unroll
            for (int i = 0; i < 16; ++i) *(LAS bf16*)(L + RC_S + (32 * w + crow(i, half)) * RC_STR + (32 * db + r32) * 2) = bf1(S[db][i]);
        f32x16 ot[4];
#pragma unroll
        for (int ib = 0; ib < 4; ++ib)
#pragma unroll
            for (int i = 0; i < 16; ++i) ot[ib][i] = 0.f;
#pragma unroll 2
        for (int s = 0; s < 8; ++s) {
            const bf16x8 sf = *(const LAS bf16x8*)(L + RC_S + (32 * w + r32) * RC_STR + (16 * s + 8 * half) * 2);
#pragma unroll
            for (int ib = 0; ib < 4; ++ib) { const bf16x8 qf = *(const LAS bf16x8*)(L + RC_Q + (32 * ib + r32) * RC_STR + (16 * s + 8 * half) * 2); ot[ib] = __builtin_amdgcn_mfma_f32_32x32x16_bf16(sf, qf, ot[ib], 0, 0, 0); }
        }
#pragma unroll
        for (int ib = 0; ib < 4; ++ib)
#pragma unroll
            for (int i = 0; i < 16; ++i) ot[ib][i] *= g;
        __syncthreads();
#pragma unroll
        for (int k = 0; k < 4; ++k) { const int ch = tid + 512 * k; *(LAS v4u*)(L + RC_KT + (ch >> 4) * RC_STR + 16 * (ch & 15)) = kreg[k]; }
        __syncthreads();
        if (c < 15) RC_FETCH_QK(tok0 + 128);
#pragma unroll
        for (int db = 0; db < 4; ++db)
#pragma unroll
            for (int i = 0; i < 16; ++i) S[db][i] *= g;
        {
            const bf16* vp = RVT + (size_t)(hh * 256 + 32 * w + r32) * MP + tok0 + 8 * half;
            bf16x8 v0 = *(const bf16x8*)(vp), v1 = *(const bf16x8*)(vp + 16), v2 = v1;
#pragma unroll 1
            for (int s = 0; s < 8; ++s) {
                if (s + 2 < 8) v2 = *(const bf16x8*)(vp + 16 * (s + 2));
#pragma unroll
                for (int ib = 0; ib < 4; ++ib) if (s < 2 * (ib + 1)) { const bf16x8 af = *(const LAS bf16x8*)(L + RC_A + (32 * ib + r32) * RC_STR + (16 * s + 8 * half) * 2); ot[ib] = __builtin_amdgcn_mfma_f32_32x32x16_bf16(v0, af, ot[ib], 0, 0, 0); }
#pragma unroll
                for (int db = 0; db < 4; ++db) { const bf16x8 kf = *(const LAS bf16x8*)(L + RC_KT + (32 * db + r32) * RC_STR + (16 * s + 8 * half) * 2); S[db] = __builtin_amdgcn_mfma_f32_32x32x16_bf16(v0, kf, S[db], 0, 0, 0); }
                v0 = v1; v1 = v2;
            }
        }
#pragma unroll
        for (int db = 0; db < 4; ++db)
#pragma unroll
            for (int i = 0; i < 16; ++i) S[db][i] *= g127;
#pragma unroll
        for (int ib = 0; ib < 4; ++ib) { float t = 0.f;
#pragma unroll
            for (int i = 0; i < 16; ++i) t += ot[ib][i];
            t += lx(t, lane, 32); if (half == 0) red[w * 128 + 32 * ib + r32] = t; }
        __syncthreads();
        float mu[4];
#pragma unroll
        for (int ib = 0; ib < 4; ++ib) { float t = 0.f;
#pragma unroll
            for (int ww = 0; ww < 8; ++ww) t += red[ww * 128 + 32 * ib + r32];
            mu[ib] = t * (1.f / 256.f); }
#pragma unroll
        for (int ib = 0; ib < 4; ++ib) { float t = 0.f;
#pragma unroll
            for (int i = 0; i < 16; ++i) { ot[ib][i] -= mu[ib]; t += ot[ib][i] * ot[ib][i]; }
            t += lx(t, lane, 32); if (half == 0) red[1024 + w * 128 + 32 * ib + r32] = t; }
        __syncthreads();
#pragma unroll
        for (int ib = 0; ib < 4; ++ib) { float t = 0.f;
#pragma unroll
            for (int ww = 0; ww < 8; ++ww) t += red[1024 + ww * 128 + 32 * ib + r32];
            const float rstd = 1.0f / sqrtf(t * (1.f / 256.f) + EPS);
            const int irow = tok0 + 32 * ib + r32;
            const bf16* SRG = (const bf16*)(ws + WS_SRG) + (size_t)irow * 1024 + hh * 256 + 32 * w + 4 * half;
            bf16* RIN = (bf16*)(ws + WS_RIN) + (size_t)irow * 1024 + hh * 256 + 32 * w + 4 * half;
            const float* gn = a.in(19) + hh * 256 + 32 * w + 4 * half;
#pragma unroll
            for (int gq = 0; gq < 4; ++gq) {
                const u32x2 sg = *(const u32x2*)(SRG + 8 * gq); const f32x4 gv = *(const f32x4*)(gn + 8 * gq);
                f32x4 o;
                o[0] = ot[ib][4 * gq + 0] * rstd * gv[0] * __uint_as_float(sg.x << 16); o[1] = ot[ib][4 * gq + 1] * rstd * gv[1] * __uint_as_float(sg.x & 0xffff0000u);
                o[2] = ot[ib][4 * gq + 2] * rstd * gv[2] * __uint_as_float(sg.y << 16); o[3] = ot[ib][4 * gq + 3] * rstd * gv[3] * __uint_as_float(sg.y & 0xffff0000u);
                *(u32x2*)(RIN + 8 * gq) = pack4(o);
            } }
        __syncthreads();
    }
#undef RC_FETCH_QK
#undef RC_BLK_IB
#undef RC_BLK_JB
    const int lane = tid_k & 63, r32 = lane & 31, half = lane >> 5;
#pragma unroll
    for (int db = 0; db < 4; ++db)
#pragma unroll
        for (int i = 0; i < 16; ++i) a.out()[OUT_SRP + ((size_t)bh * RDK + 32 * db + r32) * RDV + 32 * w + crow(i, half)] = S[db][i];
}
}
namespace mk {
constexpr int CW_FLAG = 8192;
__device__ __forceinline__ void st16_wt(void* p, v4u v) { asm volatile("global_store_dwordx4 %0, %1, off sc1\n\ts_nop 1" :: "v"(p), "v"(v) : "memory"); }
__device__ __forceinline__ void ret_state_unit(Frame& F, const Ptrs& a, int bh) {
    unsigned char* ws = opaque_g(a.ws);
    const int tid_k = fresh_tid(F.wave), w = F.wave;
    const int hh = bh & 3, b = bh >> 2;
    LAS unsigned char* L = F.lds + RING_OFF;
    const bf16* RKT = (const bf16*)(ws + WS_RKT); const bf16* RVT = (const bf16*)(ws + WS_RVT);
    const float g = gpow_t(ws, hh, 1), g127 = gpow_t(ws, hh, 127);
    f32x16 S[4];
    bf16x8 vf[8]; v4u kreg[4];
#define RS_FETCH(tok0_) do { _Pragma("unroll") for (int s = 0; s < 8; ++s) vf[s] = *(const bf16x8*)(RVT + (size_t)(hh * 256 + 32 * w + r32) * MP + (tok0_) + 16 * s + 8 * half); \
        _Pragma("unroll") for (int k = 0; k < 4; ++k) { const int ch = tid + 512 * k; kreg[k] = *(const v4u*)(RKT + (size_t)(hh * 128 + (ch >> 4)) * MP + (tok0_) + 8 * (ch & 15)); } } while (0)
    {   const int tid = tid_k, lane = tid & 63, r32 = lane & 31, half = lane >> 5;
#pragma unroll
        for (int db = 0; db < 4; ++db)
#pragma unroll
            for (int i = 0; i < 16; ++i) S[db][i] = 0.f;
        const bf16x8 af = *(const bf16x8*)(RVT + (size_t)(hh * 256 + 32 * w + r32) * MP + ROW_META + 8 * half);
#pragma unroll
        for (int db = 0; db < 4; ++db) { const bf16x8 bf = *(const bf16x8*)(RKT + (size_t)(hh * 128 + 32 * db + r32) * MP + ROW_META + 8 * half); S[db] = __builtin_amdgcn_mfma_f32_32x32x16_bf16(af, bf, S[db], 0, 0, 0); }
        const float sc = gpow_t(ws, hh, NMETA - 1);
#pragma unroll
        for (int db = 0; db < 4; ++db)
#pragma unroll
            for (int i = 0; i < 16; ++i) S[db][i] *= sc;
        RS_FETCH(b * SEQ);
    }
#pragma unroll 1
    for (int c = 0; c < 16; ++c) {
        const int tok0 = b * SEQ + c * 128, u = bh * 16 + c;
        int tid_c = tid_k; asm volatile("" : "+v"(tid_c));
        const int tid = tid_c, lane = tid & 63, r32 = lane & 31, half = lane >> 5;
#pragma unroll
        for (int k = 0; k < 4; ++k) { const int ch = tid + 512 * k; *(LAS v4u*)(L + RC_Q + (ch >> 4) * RC_STR + 16 * (ch & 15)) = kreg[k]; }
#pragma unroll
        for (int db = 0; db < 4; ++db)
#pragma unroll
            for (int i = 0; i < 16; ++i) *(LAS bf16*)(L + (32 * w + crow(i, half)) * RC_STR + (32 * db + r32) * 2) = bf1(S[db][i]);
        __syncthreads();
        { bf16* SP = (bf16*)(ws + WS_SPREV) + (size_t)u * 32768;
#pragma unroll
          for (int k = 0; k < 8; ++k) { const int ch = lane + 64 * k, row = 32 * w + (ch >> 4); st16_wt(SP + (size_t)row * 128 + 8 * (ch & 15), *(const LAS v4u*)(L + row * RC_STR + 16 * (ch & 15))); } }
        bf16x8 vfn[8]; v4u kregn[4];
        if (c < 15) {
#pragma unroll
            for (int s = 0; s < 8; ++s) vfn[s] = *(const bf16x8*)(RVT + (size_t)(hh * 256 + 32 * w + r32) * MP + tok0 + 128 + 16 * s + 8 * half);
#pragma unroll
            for (int k = 0; k < 4; ++k) { const int ch = tid + 512 * k; kregn[k] = *(const v4u*)(RKT + (size_t)(hh * 128 + (ch >> 4)) * MP + tok0 + 128 + 8 * (ch & 15)); }
        } else {
#pragma unroll
            for (int s = 0; s < 8; ++s) vfn[s] = vf[s];
#pragma unroll
            for (int k = 0; k < 4; ++k) kregn[k] = kreg[k];
        }
#pragma unroll
        for (int db = 0; db < 4; ++db) {
#pragma unroll
            for (int i = 0; i < 16; ++i) S[db][i] *= g;
#pragma unroll
            for (int s = 0; s < 8; ++s) { const bf16x8 kf = *(const LAS bf16x8*)(L + RC_Q + (32 * db + r32) * RC_STR + (16 * s + 8 * half) * 2); S[db] = __builtin_amdgcn_mfma_f32_32x32x16_bf16(vf[s], kf, S[db], 0, 0, 0); }
#pragma unroll
            for (int i = 0; i < 16; ++i) S[db][i] *= g127;
        }
        asm volatile("s_waitcnt vmcnt(0)" ::: "memory");
#pragma unroll
        for (int s = 0; s < 8; ++s) vf[s] = vfn[s];
#pragma unroll
        for (int k = 0; k < 4; ++k) kreg[k] = kregn[k];
        __syncthreads();
        if (tid == 0) __hip_atomic_store((unsigned*)(ws + WS_CTL) + CW_FLAG + 16 * u, 1u, __ATOMIC_RELAXED, __HIP_MEMORY_SCOPE_AGENT);
    }
#undef RS_FETCH
    {   const int lane = tid_k & 63, r32 = lane & 31, half = lane >> 5;
#pragma unroll
        for (int db = 0; db < 4; ++db)
#pragma unroll
            for (int i = 0; i < 16; ++i) a.out()[OUT_SRP + ((size_t)bh * RDK + 32 * db + r32) * RDV + 32 * w + crow(i, half)] = S[db][i]; }
    __syncthreads();
}
__device__ __forceinline__ void ret_out_unit(Frame& F, const Ptrs& a, int u) {
    unsigned char* ws = opaque_g(a.ws);
    const int tid = fresh_tid(F.wave), lane = tid & 63, w = F.wave, r32 = lane & 31, half = lane >> 5;
    const int bh = u >> 4, c = u & 15, hh = bh & 3, tok0 = (bh >> 2) * SEQ + c * 128;
    LAS unsigned char* L = F.lds + RING_OFF;
    LAS float* red = (LAS float*)(L + RC_RED);
    const bf16* RQ = (const bf16*)(ws + WS_RQ); const bf16* RK = (const bf16*)(ws + WS_RK); const bf16* RVT = (const bf16*)(ws + WS_RVT);
    v4u qreg[4], jreg[4];
#pragma unroll
    for (int k = 0; k < 4; ++k) { const int ch = tid + 512 * k; qreg[k] = *(const v4u*)(RQ + (size_t)(tok0 + (ch >> 4)) * 512 + hh * 128 + 8 * (ch & 15)); jreg[k] = *(const v4u*)(RK + (size_t)(tok0 + (ch >> 4)) * 512 + hh * 128 + 8 * (ch & 15)); }
    if (tid == 0) { const unsigned* fl = (const unsigned*)(ws + WS_CTL) + CW_FLAG + 16 * u; unsigned spins = 0;
        while (__hip_atomic_load(fl, __ATOMIC_RELAXED, __HIP_MEMORY_SCOPE_AGENT) == 0u && ++spins < (1u << 22)) __builtin_amdgcn_s_sleep(8);
        __builtin_amdgcn_fence(__ATOMIC_ACQUIRE, "agent"); asm volatile("s_waitcnt vmcnt(0)" ::: "memory"); }
    __syncthreads();
    v4u sreg[8];
    { const bf16* SP = (const bf16*)(ws + WS_SPREV) + (size_t)u * 32768;
#pragma unroll
      for (int k = 0; k < 8; ++k) { const int ch = tid + 512 * k; sreg[k] = *(const v4u*)(SP + (size_t)(ch >> 4) * 128 + 8 * (ch & 15)); } }
#pragma unroll
    for (int k = 0; k < 4; ++k) { const int ch = tid + 512 * k; *(LAS v4u*)(L + RC_Q + (ch >> 4) * RC_STR + 16 * (ch & 15)) = qreg[k]; *(LAS v4u*)(L + RC_S + (ch >> 4) * RC_STR + 16 * (ch & 15)) = jreg[k]; }
    __syncthreads();
#define RC_BLK_IB(n) ((n) < 1 ? 0 : (n) < 3 ? 1 : (n) < 6 ? 2 : 3)
#define RC_BLK_JB(n) ((n) - ((n) < 1 ? 0 : (n) < 3 ? 1 : (n) < 6 ? 3 : 6))
    for (int n = w; n < 10; n += 8) {
        const int ib_ = RC_BLK_IB(n), jb_ = RC_BLK_JB(n);
        f32x16 at;
#pragma unroll
        for (int i = 0; i < 16; ++i) at[i] = 0.f;
#pragma unroll
        for (int s = 0; s < 8; ++s) { const bf16x8 kf = *(const LAS bf16x8*)(L + RC_S + (32 * jb_ + r32) * RC_STR + (16 * s + 8 * half) * 2); const bf16x8 qf = *(const LAS bf16x8*)(L + RC_Q + (32 * ib_ + r32) * RC_STR + (16 * s + 8 * half) * 2); at = __builtin_amdgcn_mfma_f32_32x32x16_bf16(kf, qf, at, 0, 0, 0); }
        if (jb_ == ib_) {
#pragma unroll
            for (int i = 0; i < 16; ++i) if (crow(i, half) > r32) at[i] = 0.f; }
#pragma unroll
        for (int gq = 0; gq < 4; ++gq) { f32x4 o_; o_[0] = at[4 * gq]; o_[1] = at[4 * gq + 1]; o_[2] = at[4 * gq + 2]; o_[3] = at[4 * gq + 3];
            *(LAS u32x2*)(L + RC_A + (32 * ib_ + r32) * RC_STR + (32 * jb_ + 8 * gq + 4 * half) * 2) = pack4(o_); }
    }
#undef RC_BLK_IB
#undef RC_BLK_JB
    __syncthreads();
#pragma unroll
    for (int k = 0; k < 8; ++k) { const int ch = tid + 512 * k; *(LAS v4u*)(L + RC_S + (ch >> 4) * RC_STR + 16 * (ch & 15)) = sreg[k]; }
    __syncthreads();
    const float g = gpow_t(ws, hh, 1);
    f32x16 ot[4];
#pragma unroll
    for (int ib = 0; ib < 4; ++ib)
#pragma unroll
        for (int i = 0; i < 16; ++i) ot[ib][i] = 0.f;
#pragma unroll 2
    for (int s = 0; s < 8; ++s) {
        const bf16x8 sf = *(const LAS bf16x8*)(L + RC_S + (32 * w + r32) * RC_STR + (16 * s + 8 * half) * 2);
#pragma unroll
        for (int ib = 0; ib < 4; ++ib) { const bf16x8 qf = *(const LAS bf16x8*)(L + RC_Q + (32 * ib + r32) * RC_STR + (16 * s + 8 * half) * 2); ot[ib] = __builtin_amdgcn_mfma_f32_32x32x16_bf16(sf, qf, ot[ib], 0, 0, 0); }
    }
#pragma unroll
    for (int ib = 0; ib < 4; ++ib)
#pragma unroll
        for (int i = 0; i < 16; ++i) ot[ib][i] *= g;
    bf16x8 vf[8];
#pragma unroll
    for (int s = 0; s < 8; ++s) vf[s] = *(const bf16x8*)(RVT + (size_t)(hh * 256 + 32 * w + r32) * MP + tok0 + 16 * s + 8 * half);
#pragma unroll
    for (int ib = 0; ib < 4; ++ib)
#pragma unroll
        for (int s = 0; s < 2 * (ib + 1); ++s) { const bf16x8 af = *(const LAS bf16x8*)(L + RC_A + (32 * ib + r32) * RC_STR + (16 * s + 8 * half) * 2); ot[ib] = __builtin_amdgcn_mfma_f32_32x32x16_bf16(vf[s], af, ot[ib], 0, 0, 0); }
#pragma unroll
    for (int ib = 0; ib < 4; ++ib) { float t = 0.f;
#pragma unroll
        for (int i = 0; i < 16; ++i) t += ot[ib][i];
        t += lx(t, lane, 32); if (half == 0) red[w * 128 + 32 * ib + r32] = t; }
    __syncthreads();
    float mu[4];
#pragma unroll
    for (int ib = 0; ib < 4; ++ib) { float t = 0.f;
#pragma unroll
        for (int ww = 0; ww < 8; ++ww) t += red[ww * 128 + 32 * ib + r32];
        mu[ib] = t * (1.f / 256.f); }
#pragma unroll
    for (int ib = 0; ib < 4; ++ib) { float t = 0.f;
#pragma unroll
        for (int i = 0; i < 16; ++i) { ot[ib][i] -= mu[ib]; t += ot[ib][i] * ot[ib][i]; }
        t += lx(t, lane, 32); if (half == 0) red[1024 + w * 128 + 32 * ib + r32] = t; }
    __syncthreads();
#pragma unroll
    for (int ib = 0; ib < 4; ++ib) { float t = 0.f;
#pragma unroll
        for (int ww = 0; ww < 8; ++ww) t += red[1024 + ww * 128 + 32 * ib + r32];
        const float rstd = 1.0f / sqrtf(t * (1.f / 256.f) + EPS);
        const int irow = tok0 + 32 * ib + r32;
        const bf16* SRG = (const bf16*)(ws + WS_SRG) + (size_t)irow * 1024 + hh * 256 + 32 * w + 4 * half;
        bf16* RIN = (bf16*)(ws + WS_RIN) + (size_t)irow * 1024 + hh * 256 + 32 * w + 4 * half;
        const float* gn = a.in(19) + hh * 256 + 32 * w + 4 * half;
#pragma unroll
        for (int gq = 0; gq < 4; ++gq) {
            const u32x2 sg = *(const u32x2*)(SRG + 8 * gq); const f32x4 gv = *(const f32x4*)(gn + 8 * gq);
            f32x4 o;
            o[0] = ot[ib][4 * gq + 0] * rstd * gv[0] * __uint_as_float(sg.x << 16); o[1] = ot[ib][4 * gq + 1] * rstd * gv[1] * __uint_as_float(sg.x & 0xffff0000u);
            o[2] = ot[ib][4 * gq + 2] * rstd * gv[2] * __uint_as_float(sg.y << 16); o[3] = ot[ib][4 * gq + 3] * rstd * gv[3] * __uint_as_float(sg.y & 0xffff0000u);
            *(u32x2*)(RIN + 8 * gq) = pack4(o);
        } }
    __syncthreads();
}
}
namespace mk {
__global__ void __launch_bounds__(NWAVES * 64, 2) mega_fwd(Args args) {
    extern __shared__ __attribute__((aligned(16))) unsigned char lds[];
    Frame F;
    F.lds = (LAS unsigned char*)lds;
    F.MISC = (volatile LAS unsigned*)(F.lds + MISC_OFF);
    F.wave = __builtin_amdgcn_readfirstlane((int)threadIdx.x >> 6);
    F.G = gridDim.x; { const int bx = blockIdx.x; F.vcu = (F.G % 8 == 0) ? (bx % 8) * (F.G / 8) + bx / 8 : bx; }
    unsigned char* const ws_k = args.ws;
    unsigned char* ws = ws_k;
    for (int u = threadIdx.x; u < (LDS_BYTES - LDSCTL_OFF) / 4; u += NWAVES * 64) ((LAS unsigned*)(F.lds + LDSCTL_OFF))[u] = 0u;
    __syncthreads();
    {
        volatile LAS unsigned long long* pt = (volatile LAS unsigned long long*)(F.lds + PT_OFF);
        if (threadIdx.x == 0) {
#define PT_PUT(i) pt[i] = (unsigned long long)args.in[i]
            PT_PUT(0); PT_PUT(1); PT_PUT(2); PT_PUT(3); PT_PUT(4); PT_PUT(5); PT_PUT(6); PT_PUT(7); PT_PUT(8); PT_PUT(9); PT_PUT(10); PT_PUT(11); PT_PUT(12); PT_PUT(13);
            PT_PUT(14); PT_PUT(15); PT_PUT(16); PT_PUT(17); PT_PUT(18); PT_PUT(19); PT_PUT(20); PT_PUT(21); PT_PUT(22); PT_PUT(23); PT_PUT(24); PT_PUT(25); PT_PUT(26);
#undef PT_PUT
            pt[27] = (unsigned long long)args.out;
        }
        __syncthreads();
    }
    const Ptrs P{ws_k, (volatile LAS unsigned*)(F.lds + PT_OFF)};
    (void)xcd_barrier_post((unsigned*)(ws_k + WS_CTL) + CW_BAR, F.MISC + 8, F.wave);
#if MK_PROBE
#define STAMP(k) do { if (blockIdx.x == 0 && F.wave == 0 && lane_fresh() == 0) ((unsigned long long*)(ws_k + WS_CTL + 512 * 1024))[k] = __builtin_amdgcn_s_memrealtime(); } while (0)
    STAMP(0);
#else
#define STAMP(k) do { } while (0)
#endif
#define WS_FRESH() unsigned char* ws = opaque_g(ws_k)
#define GRID_BAR() do { XcdBarrier b_; b_.bar = (unsigned*)(ws_k + WS_CTL) + CW_BAR; b_.x = xb_xcc_id(); b_.st = F.MISC + 8; b_.wave = F.wave; xcd_barrier(b_); } while (0)

    p0_prologue(F, args);
    GRID_BAR(); STAMP(1);
    {
        WS_FRESH();
        { const int bx = (int)blockIdx.x; if (bx >= 128 && bx < 172) xjob_ffn_up(F, ws, bx - 128, WS_XB, WS_W1T, 0); }
        pg8::Gemm g{(const pg8::bf16_t*)(ws + WS_XB), (const pg8::bf16_t*)(ws + WS_W1T), MMAIN, 2 * FFN, D};
        pg8::StaticOrder S; S.init(MMAIN, 2 * FFN, F.G, (int)blockIdx.x);
        EpiSwiGLU E{(bf16*)(ws + WS_ACT), (const float*)(ws + WS_R1)};
        pg8::gemm_phase<EpiSwiGLU, pg8::StaticOrder, true, true>(F.lds + RING_OFF, g, S, E, F.wave);
    }
    GRID_BAR(); STAMP(2);
    {
        WS_FRESH();
        { const int bx = (int)blockIdx.x; if (bx < 16) xjob_resid(F, ws, bx, WS_ACT, FFN, WS_W1D, (const float*)(ws + WS_XE), 0.5f, WS_H, WS_HB, WS_SSQH); }
        pg8::Gemm g{(const pg8::bf16_t*)(ws + WS_ACT), (const pg8::bf16_t*)(ws + WS_W1D), MMAIN, D, FFN};
        pg8::StaticOrder S; S.init(MMAIN, D, F.G, (int)blockIdx.x);
        typedef EpiResid<(unsigned)WS_XE, true, (unsigned)WS_H, (unsigned)WS_HB, (unsigned)WS_SSQH, 1> EpiDown1;
        EpiDown1 E{ws, P.in(0)};
        pg8::gemm_phase<EpiDown1, pg8::StaticOrder, true, true>(F.lds + RING_OFF, g, S, E, F.wave);
    }
    GRID_BAR(); STAMP(3);
#ifndef NO_P3
    {
        WS_FRESH();
        { const int bx = (int)blockIdx.x; if (bx >= 192 && bx < 238) xjob_win(F, ws, bx - 192); }
        pg8::Gemm g{(const pg8::bf16_t*)(ws + WS_HB), (const pg8::bf16_t*)(ws + WS_WIN), MMAIN, NWIN, D};
        pg8::StaticOrder S; S.init(MMAIN, NWIN, F.G, (int)blockIdx.x);
        EpiWin E{ws};
        pg8::gemm_phase<EpiWin, pg8::StaticOrder, true, true>(F.lds + RING_OFF, g, S, E, F.wave);
    }
#endif
    GRID_BAR(); STAMP(4);
    {
        WS_FRESH();
        { const int jb = (int)blockIdx.x - 192; if (jb >= 0 && jb < 12) xjob_q(F, ws, jb); else if (jb >= 12 && jb < 20) xjob_kv(F, ws, jb - 12, false); else if (jb >= 20 && jb < 28) xjob_kv(F, ws, jb - 20, true); else if (jb >= 28 && jb < 60) xjob_ql(F, ws, jb - 28); }
        finalize_ckv(F, P);
#ifndef NO_P4Q
        {   pg8::Gemm g{(const pg8::bf16_t*)(ws + WS_CQ), (const pg8::bf16_t*)(ws + WS_WUQ), MMAIN, 768, QR};
            pg8::StaticOrder S; S.init(MMAIN, 768, F.G, (int)blockIdx.x);
            EpiQ E{ws};
            pg8::gemm_phase<EpiQ, pg8::StaticOrder, true, true>(F.lds + RING_OFF, g, S, E, F.wave); }
#endif
#ifndef NO_P4K
        {   pg8::Gemm g{(const pg8::bf16_t*)(ws + WS_CKVB), (const pg8::bf16_t*)(ws + WS_WUK), MMAIN, 512, KVR};
            pg8::StaticOrder S; S.init(MMAIN, 512, F.G, (int)((blockIdx.x + 64) % F.G));
            EpiScaleBf16<true> E{(const float*)(ws + WS_SSQKV), (bf16*)(ws + WS_KN), 512};
            pg8::gemm_phase<EpiScaleBf16<true>, pg8::StaticOrder, true, true>(F.lds + RING_OFF, g, S, E, F.wave); }
#endif
#ifndef NO_P4V
        {   pg8::Gemm g{(const pg8::bf16_t*)(ws + WS_WUV), (const pg8::bf16_t*)(ws + WS_CKVB), 512, MMAIN, KVR};
            pg8::StaticOrder S; S.init(512, MMAIN, F.G, (int)((blockIdx.x + 192) % F.G));
            EpiScaleBf16<false> E{(const float*)(ws + WS_SSQKV), (bf16*)(ws + WS_VT), MP};
            pg8::gemm_phase<EpiScaleBf16<false>, pg8::StaticOrder, true, true>(F.lds + RING_OFF, g, S, E, F.wave); }
#endif
    }
    GRID_BAR(); STAMP(5);
    STAMP(32);
#define QUEUE_LOOP(qi, nitems, call) for (;;) { \
        if (F.wave == 0 && lane_fresh() == 0) F.MISC[16] = __hip_atomic_fetch_add((unsigned*)(ws_k + WS_CTL) + CW_QUEUE + 64 * (qi), 1u, __ATOMIC_RELAXED, __HIP_MEMORY_SCOPE_AGENT); \
        __syncthreads(); const int it = (int)F.MISC[16]; __syncthreads(); \
        if (it >= (nitems)) break; call; }
    if ((int)blockIdx.x < 32) ret_state_unit(F, P, (int)blockIdx.x);
    STAMP(33);
    if (((int)blockIdx.x & 1) == 0) {
        QUEUE_LOOP(0, 512, attn_item(F, ws_k, it))
        QUEUE_LOOP(3, 512, ret_out_unit(F, P, ((it & 31) << 4) | (it >> 5)))
    }
    STAMP(34);
    QUEUE_LOOP(1, 512, decode_unit(F, P, it))
    STAMP(35);
    QUEUE_LOOP(2, 128, ret_sample_unit(F, P, it))
    STAMP(36);
    if (((int)blockIdx.x & 1) != 0) {
        QUEUE_LOOP(0, 512, attn_item(F, ws_k, it))
        QUEUE_LOOP(3, 512, ret_out_unit(F, P, ((it & 31) << 4) | (it >> 5)))
    }
    STAMP(37);
#undef QUEUE_LOOP
    GRID_BAR(); STAMP(6);
    STAMP(40);
    for (int u = (int)blockIdx.x; u < 256; u += F.G) decode_combine_unit(F, P, u);
    STAMP(42);
    GRID_BAR(); STAMP(7);
    {
        WS_FRESH();
        { const int bx = (int)blockIdx.x; if (bx < 16) xjob_mix(F, ws, bx); }
        {   pg8::Gemm g{(const pg8::bf16_t*)(ws + WS_AV), (const pg8::bf16_t*)(ws + WS_WMO), MMAIN, D, 512};
            pg8::StaticOrder S; S.init(MMAIN, D, F.G, (int)blockIdx.x);
            typedef EpiGate<0, (unsigned)WS_SGA> EpiGA; EpiGA E{ws};
            pg8::gemm_phase<EpiGA, pg8::StaticOrder, true, true>(F.lds + RING_OFF, g, S, E, F.wave); }
        {   pg8::Gemm g{(const pg8::bf16_t*)(ws + WS_RIN), (const pg8::bf16_t*)(ws + WS_WRO), MMAIN, D, D};
            pg8::StaticOrder S; S.init(MMAIN, D, F.G, (int)blockIdx.x);
            typedef EpiGate<1, (unsigned)WS_SGB> EpiGB; EpiGB E{ws};
            pg8::gemm_phase<EpiGB, pg8::StaticOrder, true, true>(F.lds + RING_OFF, g, S, E, F.wave); }
    }
    GRID_BAR(); STAMP(8);
    {
        WS_FRESH();
        { const int bx = (int)blockIdx.x; if (bx >= 16 && bx < 32) xjob_resid(F, ws, bx - 16, WS_MX, D, WS_WOUT, (const float*)(ws + WS_H) + (size_t)XROW0 * D, 1.0f, WS_H2, WS_H2B, WS_SSQH2); }
        pg8::Gemm g{(const pg8::bf16_t*)(ws + WS_MX), (const pg8::bf16_t*)(ws + WS_WOUT), MMAIN, D, D};
        pg8::StaticOrder S; S.init(MMAIN, D, F.G, (int)blockIdx.x);
        typedef EpiResid<(unsigned)WS_H, false, (unsigned)WS_H2, (unsigned)WS_H2B, (unsigned)WS_SSQH2, 2> EpiOut;
        EpiOut E{ws, nullptr};
        pg8::gemm_phase<EpiOut, pg8::StaticOrder, true, true>(F.lds + RING_OFF, g, S, E, F.wave);
    }
    GRID_BAR(); STAMP(9);
    {
        WS_FRESH();
        { const int bx = (int)blockIdx.x; if (bx >= 128 && bx < 172) xjob_ffn_up(F, ws, bx - 128, WS_H2B, WS_W2T, 1); }
        pg8::Gemm g{(const pg8::bf16_t*)(ws + WS_H2B), (const pg8::bf16_t*)(ws + WS_W2T), MMAIN, 2 * FFN, D};
        pg8::StaticOrder S; S.init(MMAIN, 2 * FFN, F.G, (int)blockIdx.x);
        EpiSwiGLU2 E{ws};
        pg8::gemm_phase<EpiSwiGLU2, pg8::StaticOrder, true, true>(F.lds + RING_OFF, g, S, E, F.wave);
    }
    GRID_BAR(); STAMP(10);
    {
        WS_FRESH();
        { const int bx = (int)blockIdx.x; if (bx >= 32 && bx < 48) xjob_resid(F, ws, bx - 32, WS_ACT, FFN, WS_W2D, (const float*)(ws + WS_H2) + (size_t)XROW0 * D, 0.5f, WS_H3, 0, WS_SSQH3); }
        pg8::Gemm g{(const pg8::bf16_t*)(ws + WS_ACT), (const pg8::bf16_t*)(ws + WS_W2D), MMAIN, D, FFN};
        pg8::StaticOrder S; S.init(MMAIN, D, F.G, (int)blockIdx.x);
        typedef EpiResid<(unsigned)WS_H2, false, (unsigned)WS_H3, 0u, (unsigned)WS_SSQH3, 1> EpiDown2;
        EpiDown2 E{ws, nullptr};
        pg8::gemm_phase<EpiDown2, pg8::StaticOrder, true, true>(F.lds + RING_OFF, g, S, E, F.wave);
    }
    GRID_BAR(); STAMP(11);
    final_norm_phase(F, P);
#if MK_PROBE
    GRID_BAR(); STAMP(12);
    if (blockIdx.x == 0) {
        asm volatile("s_waitcnt vmcnt(0)" ::: "memory"); __syncthreads();
        const unsigned long long* t = (const unsigned long long*)(ws_k + WS_CTL + 512 * 1024);
        const float dta = (float)(__hip_atomic_load(t + MK_PROBE_A + 1, __ATOMIC_RELAXED, __HIP_MEMORY_SCOPE_AGENT) - __hip_atomic_load(t + MK_PROBE_A, __ATOMIC_RELAXED, __HIP_MEMORY_SCOPE_AGENT)) * 0.01f;
        const float dtb = (float)(__hip_atomic_load(t + MK_PROBE_B + 1, __ATOMIC_RELAXED, __HIP_MEMORY_SCOPE_AGENT) - __hip_atomic_load(t + MK_PROBE_B, __ATOMIC_RELAXED, __HIP_MEMORY_SCOPE_AGENT)) * 0.01f;
        const float f = 1.f + sqrtf(dta / 20000.f);
        const int tid_p = fresh_tid(F.wave);
        for (int i = tid_p; i < NS * D; i += NWAVES * 64) P.out()[OUT_YS + i] *= f;
        if (tid_p == 0) P.out()[OUT_YP] += dtb / 5.f;
    }
#endif
#undef GRID_BAR
}
}
extern "C" void kernel_launch(void* const* d_in, const int* in_sizes, int n_in, void* d_out, int out_size, void* d_ws, size_t ws_size, hipStream_t stream) {
    static int grid = 0;
    if (grid == 0) {
        int dev = 0, cus = 0;
        if (n_in != 27 || out_size != (int)mk::OUT_END || ws_size < mk::WS_END6) { fprintf(stderr, "kernel_launch: unexpected problem shape (n_in %d, out %d, ws %zu); nothing launched\n", n_in, out_size, ws_size); grid = -1; return; }
        if (hipGetDevice(&dev) != hipSuccess || hipDeviceGetAttribute(&cus, hipDeviceAttributeMultiprocessorCount, dev) != hipSuccess) { fprintf(stderr, "kernel_launch: device query failed\n"); grid = -1; return; }
        if (hipFuncSetAttribute((const void*)mk::mega_fwd, hipFuncAttributeMaxDynamicSharedMemorySize, mk::LDS_BYTES) != hipSuccess) { fprintf(stderr, "kernel_launch: hipFuncSetAttribute failed\n"); grid = -1; return; }
        int per_cu = 0;
        if (hipOccupancyMaxActiveBlocksPerMultiprocessor(&per_cu, (const void*)mk::mega_fwd, mk::NWAVES * 64, mk::LDS_BYTES) != hipSuccess || per_cu < 1) fprintf(stderr, "kernel_launch: note: occupancy query reports %d workgroups per CU\n", per_cu);
        (void)hipGetLastError();
        grid = cus;
    }
    if (grid < 0) return;
    unsigned char* ws = (unsigned char*)d_ws;
    (void)hipMemsetAsync(ws + mk::WS_CTL, 0, mk::CTL_ZERO_BYTES, stream);
    mk::Args a{};
    for (int i = 0; i < 27; ++i) a.in[i] = (const float*)d_in[i];
    a.out = (float*)d_out; a.ws = ws;
    hipLaunchKernelGGL(mk::mega_fwd, dim3(grid), dim3(mk::NWAVES * 64), mk::LDS_BYTES, stream, a);
}
```

```cpp
#include <hip/hip_runtime.h>
#include <cstdio>
#include <cstdint>
#include <cmath>
#define MK_DEBUG 0
#ifndef MK_PROBE
#define MK_PROBE 0
#define MK_PROBE_A 0
#define MK_PROBE_B 1
#endif
__device__ __forceinline__ int lane_fresh() { int l; asm volatile("v_mbcnt_lo_u32_b32 %0, -1, 0\n\tv_mbcnt_hi_u32_b32 %0, -1, %0" : "=v"(l)); return l; }
__device__ __forceinline__ unsigned char* opaque_g(const unsigned char* p) { unsigned long long v = (unsigned long long)p; asm volatile("" : "+s"(v)); return (unsigned char*)(__attribute__((address_space(1))) unsigned char*)v; }
namespace pg8 {
#define PG8_LAS __attribute__((address_space(3)))
typedef unsigned short bf16_t;
typedef short bf16x8 __attribute__((ext_vector_type(8)));
typedef float f32x4 __attribute__((ext_vector_type(4)));
typedef unsigned u32x4 __attribute__((ext_vector_type(4)));
constexpr int BM = 256, BK = 64, HALF = 128, HTB = HALF * BK * 2  , STAGE_BYTES = 8 * HTB, NXCD = 8, WGM = 8;

__host__ __device__ __forceinline__ int lds_byte(int r, int c) { const int st = (r >> 4) * 2 + (c >> 5), rr = r & 15, cc = c & 31, ob = rr * 64 + cc * 2; return st * 1024 + (ob ^ (((ob >> 9) & 1) << 5)); }
__host__ __device__ __forceinline__ void stage_rc(int b, int& R, int& C) { const int st = b / 1024, sb = b % 1024, swz = sb ^ (((sb >> 9) & 1) << 5); R = (st >> 1) * 16 + swz / 64; C = (st & 1) * 32 + (swz % 64) / 2; }
__host__ __device__ __forceinline__ int perm32(int rho) { const int n = rho >> 4, i = rho & 15; return 8 * (i >> 2) + 4 * n + (i & 3); }

struct Unit { int pm, pn; };
struct Gemm { const bf16_t* A; const bf16_t* Bt; int M, N, K; };

struct StaticOrder {
    int nM, nN, nwg, G, c;
    __host__ __device__ void init(int M, int N, int G_, int c_) { nM = M / BM; nN = N / BM; nwg = nM * nN; G = G_; c = c_; }
    __host__ __device__ bool next(int i, Unit& u) const {
        const long L = (long)i * G + c; if (L >= nwg) return false;
        int wgid = (int)L; { const int q = nwg / NXCD, r = nwg % NXCD, xcd = wgid % NXCD, off = wgid / NXCD; wgid = (xcd < r ? xcd * (q + 1) : r * (q + 1) + (xcd - r) * q) + off; }
        const int nig = WGM * nN, gid = wgid / nig, fm = gid * WGM, gsz = (nM - fm) < WGM ? (nM - fm) : WGM;
        u.pm = fm + ((wgid % nig) % gsz); u.pn = (wgid % nig) / gsz; return true;
    }
    __device__ __forceinline__ void a_ready(const Unit&) const {}
    __device__ __forceinline__ void done(const Unit&) const {}
};

__device__ __forceinline__ unsigned cvt_pk_bf16(float lo, float hi) { unsigned r; asm volatile("v_cvt_pk_bf16_f32 %0, %1, %2" : "=v"(r) : "v"(lo), "v"(hi)); return r; }
typedef float f32x2 __attribute__((ext_vector_type(2)));
template <class Epi, class Sched, bool ALIGN_EPI = false, bool SP2 = false>
__device__ __forceinline__ void gemm_phase(PG8_LAS unsigned char* lds, const Gemm g, const Sched& S, const Epi& E, const int wave_in  ) {
    int tid_ = lane_fresh() + 64 * wave_in; asm volatile("" : "+v"(tid_));
    const int tid = tid_, wid = __builtin_amdgcn_readfirstlane(tid >> 6), lane = tid & 63, wr = wid >> 2, wc = wid & 3, fr = lane & 15, fq = lane >> 4;
    const int K = g.K, nt = K / BK;
    unsigned voffA[2], voffB[2];
#pragma unroll
    for (int i = 0; i < 2; ++i) { int R, C; stage_rc(tid * 16 + i * 8192, R, C); const int Rb = Epi::PERM ? ((R & ~31) + perm32(R & 31)) : R;
        voffA[i] = (unsigned)(R * K + C) * 2u; voffB[i] = (unsigned)(Rb * K + C) * 2u; }
    const size_t kstep = (size_t)(BK * 2);
    const size_t hstep = (size_t)HALF * K * 2;
    const size_t tstep = 2 * hstep;
    const unsigned ldsw = (unsigned)wid * 1024u;
    const int aoff = lds_byte(wr * 64 + fr, fq * 8), boff = lds_byte(wc * 32 + fr, fq * 8);
#define PG8_SA(b, h) (((b) * 2 + (h)) * HTB)
#define PG8_SB(b, h) ((4 + (b) * 2 + (h)) * HTB)
#define PG8_STAGE(bufoff, gbase, voff) do { _Pragma("unroll") for (int _i = 0; _i < 2; ++_i) \
        __builtin_amdgcn_global_load_lds((const unsigned*)((const char*)(gbase) + (voff)[_i]), (PG8_LAS unsigned*)(lds + (bufoff) + ldsw + _i * 8192), 16, 0, 0); } while (0)
#define PG8_LDA(dst, b, h) do { _Pragma("unroll") for (int m = 0; m < 4; ++m) _Pragma("unroll") for (int k = 0; k < 2; ++k) dst[m][k] = *(const PG8_LAS bf16x8*)(lds + PG8_SA(b, h) + aoff + m * 2048 + k * 1024); } while (0)
#define PG8_LDB(dst, b, h) do { _Pragma("unroll") for (int n = 0; n < 2; ++n) _Pragma("unroll") for (int k = 0; k < 2; ++k) dst[n][k] = *(const PG8_LAS bf16x8*)(lds + PG8_SB(b, h) + boff + n * 2048 + k * 1024); } while (0)
#define PG8_MMA(ai, bj, At, Bt) do { __builtin_amdgcn_s_setprio(1); _Pragma("unroll") for (int m = 0; m < 4; ++m) _Pragma("unroll") for (int n = 0; n < 2; ++n) _Pragma("unroll") for (int k = 0; k < 2; ++k) \
        acc[ai][bj][m][n] = __builtin_amdgcn_mfma_f32_16x16x32_bf16(Bt[n][k], At[m][k], acc[ai][bj][m][n], 0, 0, 0); __builtin_amdgcn_s_setprio(0); } while (0)
#define PG8_WAIT_V(n) asm volatile("s_waitcnt vmcnt(" #n ")" ::: "memory")
#define PG8_WAIT_L(n) asm volatile("s_waitcnt lgkmcnt(" #n ")" ::: "memory")
#define PG8_BAR __builtin_amdgcn_s_barrier()
#define PG8_SCHED __builtin_amdgcn_sched_barrier(0)
    Unit cur, nxt; int ui = 0;
    if (!S.next(0, cur)) return;
    f32x4 acc[2][2][4][2];
#pragma unroll
    for (int a = 0; a < 2; ++a)
#pragma unroll
        for (int b = 0; b < 2; ++b)
#pragma unroll
            for (int m = 0; m < 4; ++m)
#pragma unroll
                for (int n = 0; n < 2; ++n) acc[a][b][m][n] = (f32x4){0.f, 0.f, 0.f, 0.f};
    bf16x8 At[4][2], B0[2][2], B1[2][2];
    const char* cA = (const char*)g.A + (size_t)cur.pm * tstep; const char* cB = (const char*)g.Bt + (size_t)cur.pn * tstep;
    S.a_ready(cur);
    if constexpr (SP2) {
        PG8_STAGE(PG8_SB(0, 0), cB, voffB); PG8_STAGE(PG8_SB(0, 1), cB + hstep, voffB); PG8_STAGE(PG8_SA(0, 0), cA, voffA); PG8_STAGE(PG8_SA(0, 1), cA + hstep, voffA);
        if (wr == 1) PG8_BAR;
        PG8_WAIT_V(2); PG8_BAR;
        PG8_STAGE(PG8_SB(1, 0), cB + kstep, voffB); PG8_STAGE(PG8_SA(1, 0), cA + kstep, voffA); PG8_STAGE(PG8_SB(1, 1), cB + hstep + kstep, voffB);
        PG8_WAIT_V(6); PG8_BAR;
    } else {
        PG8_STAGE(PG8_SB(0, 0), cB, voffB); PG8_STAGE(PG8_SA(0, 0), cA, voffA); PG8_STAGE(PG8_SB(0, 1), cB + hstep, voffB); PG8_STAGE(PG8_SA(0, 1), cA + hstep, voffA);
        if (wr == 1) PG8_BAR;
        PG8_WAIT_V(4); PG8_BAR;
        PG8_STAGE(PG8_SB(1, 0), cB + kstep, voffB); PG8_STAGE(PG8_SA(1, 0), cA + kstep, voffA); PG8_STAGE(PG8_SB(1, 1), cB + hstep + kstep, voffB);
        PG8_WAIT_V(6); PG8_BAR;
    }
    for (;;) {
        const bool has_next = S.next(ui + 1, nxt);
        const char* nA = has_next ? (const char*)g.A + (size_t)nxt.pm * tstep : cA; const char* nB = has_next ? (const char*)g.Bt + (size_t)nxt.pn * tstep : cB;
        for (int t = 0; t < nt; t += 2) {
            const bool last = (t == nt - 2);
            const char* a1 = cA + (size_t)(t + 1) * kstep;
            const char* a2 = last ? nA : cA + (size_t)(t + 2) * kstep; const char* b2 = last ? nB : cB + (size_t)(t + 2) * kstep;
            const char* a3 = a2 + kstep; const char* b3 = b2 + kstep;
            if (last && has_next) S.a_ready(nxt);
            if constexpr (SP2) {
            PG8_LDB(B0, 0, 0); PG8_LDB(B1, 0, 1); PG8_SCHED; PG8_LDA(At, 0, 0); PG8_STAGE(PG8_SA(1, 1), a1 + hstep, voffA);
            PG8_WAIT_V(8); PG8_WAIT_L(0); PG8_BAR; PG8_MMA(0, 0, At, B0); PG8_MMA(0, 1, At, B1); PG8_BAR; PG8_SCHED;
            PG8_LDA(At, 0, 1); PG8_STAGE(PG8_SB(0, 0), b2, voffB); PG8_STAGE(PG8_SB(0, 1), b2 + hstep, voffB); PG8_STAGE(PG8_SA(0, 0), a2, voffA);
            PG8_WAIT_V(8); PG8_WAIT_L(0); PG8_BAR; PG8_MMA(1, 0, At, B0); PG8_MMA(1, 1, At, B1); PG8_BAR; PG8_SCHED;
            PG8_LDB(B0, 1, 0); PG8_LDB(B1, 1, 1); PG8_SCHED; PG8_LDA(At, 1, 0); PG8_STAGE(PG8_SA(0, 1), a2 + hstep, voffA);
            PG8_WAIT_V(8); PG8_WAIT_L(0); PG8_BAR; PG8_MMA(0, 0, At, B0); PG8_MMA(0, 1, At, B1); PG8_BAR; PG8_SCHED;
            PG8_LDA(At, 1, 1); PG8_STAGE(PG8_SB(1, 0), b3, voffB); PG8_STAGE(PG8_SB(1, 1), b3 + hstep, voffB); PG8_STAGE(PG8_SA(1, 0), a3, voffA);
            PG8_WAIT_V(8); PG8_WAIT_L(0); PG8_BAR; PG8_MMA(1, 0, At, B0); PG8_MMA(1, 1, At, B1); PG8_BAR; PG8_SCHED;
            } else {
            PG8_LDB(B0, 0, 0); PG8_SCHED; PG8_LDA(At, 0, 0); PG8_STAGE(PG8_SA(1, 1), a1 + hstep, voffA);
            PG8_WAIT_L(8); PG8_BAR; PG8_WAIT_L(0); PG8_MMA(0, 0, At, B0); PG8_BAR; PG8_SCHED;
            PG8_LDB(B1, 0, 1); PG8_STAGE(PG8_SB(0, 0), b2, voffB);
            PG8_BAR; PG8_WAIT_L(0); PG8_MMA(0, 1, At, B1); PG8_BAR;
            PG8_LDA(At, 0, 1); PG8_STAGE(PG8_SA(0, 0), a2, voffA);
            PG8_BAR; PG8_WAIT_L(0); PG8_MMA(1, 0, At, B0); PG8_BAR; PG8_SCHED;
            PG8_STAGE(PG8_SB(0, 1), b2 + hstep, voffB);
            PG8_WAIT_V(6); PG8_BAR; PG8_MMA(1, 1, At, B1); PG8_BAR;
            PG8_LDB(B0, 1, 0); PG8_SCHED; PG8_LDA(At, 1, 0); PG8_STAGE(PG8_SA(0, 1), a2 + hstep, voffA);
            PG8_WAIT_L(8); PG8_BAR; PG8_WAIT_L(0); PG8_MMA(0, 0, At, B0); PG8_BAR; PG8_SCHED;
            PG8_LDB(B1, 1, 1); PG8_STAGE(PG8_SB(1, 0), b3, voffB);
            PG8_BAR; PG8_WAIT_L(0); PG8_MMA(0, 1, At, B1); PG8_BAR;
            PG8_LDA(At, 1, 1); PG8_STAGE(PG8_SA(1, 0), a3, voffA);
            PG8_BAR; PG8_WAIT_L(0); PG8_MMA(1, 0, At, B0); PG8_BAR; PG8_SCHED;
            PG8_STAGE(PG8_SB(1, 1), b3 + hstep, voffB);
            PG8_WAIT_V(6); PG8_BAR; PG8_MMA(1, 1, At, B1); PG8_BAR;
            }
        }
        if constexpr (ALIGN_EPI) { if (wr == 0) PG8_BAR; }
        if constexpr (!Epi::AFTER_DRAIN) { E(acc, cur, wr, wc, fr, fq); S.done(cur); }
        if (!has_next) break;
#pragma unroll
        for (int a = 0; a < 2; ++a)
#pragma unroll
            for (int b = 0; b < 2; ++b)
#pragma unroll
                for (int m = 0; m < 4; ++m)
#pragma unroll
                    for (int n = 0; n < 2; ++n) acc[a][b][m][n] = (f32x4){0.f, 0.f, 0.f, 0.f};
        cur = nxt; cA = nA; cB = nB; ++ui;
        if constexpr (ALIGN_EPI) { if (wr == 1) PG8_BAR; }
    }
    PG8_WAIT_V(0);
    if constexpr (!ALIGN_EPI) { if (wr == 0) PG8_BAR; }
    PG8_BAR;
    if constexpr (Epi::AFTER_DRAIN) { E.fused(acc, cur, wr, wc, fr, fq, lds, wid, lane); S.done(cur); }
#undef PG8_SA
#undef PG8_SB
#undef PG8_STAGE
#undef PG8_LDA
#undef PG8_LDB
#undef PG8_MMA
#undef PG8_WAIT_V
#undef PG8_WAIT_L
#undef PG8_BAR
#undef PG8_SCHED
}
}
#define GAS __attribute__((address_space(1)))
#define LAS __attribute__((address_space(3)))
typedef unsigned short bf16;
typedef unsigned v4u __attribute__((ext_vector_type(4)));
typedef float f32x4 __attribute__((ext_vector_type(4)));
typedef short bf16x8 __attribute__((ext_vector_type(8)));
typedef GAS unsigned gu32;
typedef GAS unsigned long long gu64;
#define RLX_AGENT __ATOMIC_RELAXED, __HIP_MEMORY_SCOPE_AGENT
#define LDS_WAIT() asm volatile("s_waitcnt lgkmcnt(0)" ::: "memory")
#define VM_WAIT() asm volatile("s_waitcnt vmcnt(0)" ::: "memory")
__device__ __forceinline__ unsigned long long rt() { return __builtin_amdgcn_s_memrealtime(); }
__device__ __forceinline__ unsigned f2bf(float f) { unsigned u = __builtin_bit_cast(unsigned, f); return (u + 0x7fffu + ((u >> 16) & 1u)) >> 16; }
__device__ __forceinline__ unsigned pk2(float lo, float hi) { return f2bf(lo) | (f2bf(hi) << 16); }

#define XB_TMO      128
#define XB_XCNT(j)  (256  + 64 * (j))
#define XB_XSUB(j)  (1280 + 64 * (j))
#define XB_XGEN(j)  (2304 + 64 * (j))
#define XB_TOP      3328
#define XB_TOPGEN   3392
#define XCD_BAR_WORDS 3456
#define XB_SPIN_CAP (1u << 18)

__device__ __forceinline__ unsigned xb_ld(unsigned* p)              { return __hip_atomic_load(p, __ATOMIC_RELAXED, __HIP_MEMORY_SCOPE_AGENT); }
__device__ __forceinline__ unsigned xb_add(unsigned* p, unsigned v) { return __hip_atomic_fetch_add(p, v, __ATOMIC_RELAXED, __HIP_MEMORY_SCOPE_AGENT); }
__device__ __forceinline__ unsigned xb_xcc_id() { return (unsigned)__builtin_amdgcn_s_getreg((3 << 11) | 20) & 0xFu; }
#define XB_SPIN(cond, bar) do { unsigned _sp = 0; while (cond) { __builtin_amdgcn_s_sleep(1); \
    if ((++_sp & 255u) == 0u) { if (xb_ld(&(bar)[XB_TMO])) break; if (_sp > XB_SPIN_CAP) { atomicAdd(&(bar)[XB_TMO], 1u); break; } } } } while (0)

struct XcdBarrier {
    unsigned* bar; unsigned x; int wave;
    volatile LAS unsigned* st;
};

#define XB_IS_T0(wave) ((wave) == 0 && lane_fresh() == 0)
__device__ __forceinline__ XcdBarrier xcd_barrier_post(unsigned* bar, volatile LAS unsigned* st, int wave) {
    XcdBarrier b; b.bar = bar; b.x = xb_xcc_id(); b.st = st; b.wave = wave;
    if (XB_IS_T0(wave)) (void)xb_add(&bar[XB_XCNT(b.x)], 1u);
    return b;
}
__device__ __forceinline__ void xcd_barrier_complete(unsigned* bar, unsigned x, unsigned& nloc, unsigned& nx) {
    const unsigned G = gridDim.x * gridDim.y * gridDim.z;
    unsigned sum, cnt, mine, sp = 0u;
    for (;;) {
        sum = 0u; cnt = 0u; mine = 0u;
#pragma unroll
        for (unsigned j = 0; j < 16; ++j) { const unsigned c = xb_ld(&bar[XB_XCNT(j)]); sum += c; cnt += (c > 0u) ? 1u : 0u; mine = (j == x) ? c : mine; }
        if (sum == G) break;
        __builtin_amdgcn_s_sleep(1);
        if ((++sp & 255u) == 0u) { if (xb_ld(&bar[XB_TMO])) break; if (sp > XB_SPIN_CAP) { atomicAdd(&bar[XB_TMO], 1u); break; } }
    }
    nloc = mine > 0u ? mine : 1u; nx = cnt > 0u ? cnt : 1u;
}

__device__ __forceinline__ void xcd_barrier(const XcdBarrier& b) {
    asm volatile("s_waitcnt vmcnt(0)" ::: "memory");
    __syncthreads();
    if (XB_IS_T0(b.wave)) {
        unsigned* bar = b.bar;
        __builtin_amdgcn_s_waitcnt(0);
        unsigned nloc = b.st[0], nx = b.st[1];
        if (nloc == 0u) { xcd_barrier_complete(bar, b.x, nloc, nx); b.st[0] = nloc; b.st[1] = nx; }
        const unsigned old = xb_add(&bar[XB_XSUB(b.x)], 1u);
        const unsigned gen = old / nloc;
        if (old + 1u == (gen + 1u) * nloc) {
            __builtin_amdgcn_fence(__ATOMIC_RELEASE, "agent");
            asm volatile("s_waitcnt vmcnt(0)" ::: "memory");
            const unsigned og = xb_add(&bar[XB_TOP], 1u);
            const unsigned tg = og / nx;
            if (og + 1u == (tg + 1u) * nx) xb_add(&bar[XB_TOPGEN], 1u);
            else XB_SPIN(xb_ld(&bar[XB_TOPGEN]) == tg, bar);
            __builtin_amdgcn_fence(__ATOMIC_ACQUIRE, "agent");
            xb_add(&bar[XB_XGEN(b.x)], 1u);
            asm volatile("s_waitcnt vmcnt(0)" ::: "memory");
        } else {
            XB_SPIN(xb_ld(&bar[XB_XGEN(b.x)]) == gen, bar);
            __builtin_amdgcn_fence(__ATOMIC_ACQUIRE, "agent");
            asm volatile("s_waitcnt vmcnt(0)" ::: "memory");
        }
    }
    __syncthreads();
}
namespace mk {
constexpr int D = 1024, NB = 8, SEQ = 2048, NMETA = 16, T = SEQ + NMETA, NS = 32, PAST = 16384, PAGE = 128, NPAGES = PAST / PAGE;
constexpr int FFN = 2816, NH = 8, QR = 384, KVR = 256, RH = 4, RDK = 128, RDV = 256, IN_DIM = 5792;
constexpr int O_CQ = 0, O_CKV = 384, O_KR = 640, O_RQ = 672, O_RK = 1184, O_RV = 1696, O_RG = 2720, O_GA = 3744, O_GB = 4768;
constexpr int MMAIN = NB * SEQ;
constexpr int ROW_META = MMAIN;
constexpr int ROW_SMP = MMAIN + NMETA;
constexpr int ROW_PAD = ROW_SMP + NS;
constexpr int MP = MMAIN + 256;
constexpr int NWIN = 5888;
constexpr int NPOS = T + 1;
constexpr float EPS = 1e-6f;
constexpr int NWAVES = 8;

constexpr size_t MiB = 1u << 20;
constexpr size_t al(size_t x) { return (x + 255) / 256 * 256; }
constexpr size_t WS_CTL = 0, CTL_ZERO_BYTES = 1 * MiB;
constexpr size_t WS_W1T = 1 * MiB;
constexpr size_t WS_W1D = WS_W1T + al((size_t)2 * FFN * D * 2);
constexpr size_t WS_WIN = WS_W1D + al((size_t)D * FFN * 2);
constexpr size_t WS_WUQ = WS_WIN + al((size_t)NWIN * D * 2);
constexpr size_t WS_WUK = WS_WUQ + al((size_t)768 * QR * 2);
constexpr size_t WS_WUV = WS_WUK + al((size_t)512 * KVR * 2);
constexpr size_t WS_WMO = WS_WUV + al((size_t)512 * KVR * 2);
constexpr size_t WS_WRO = WS_WMO + al((size_t)D * 512 * 2);
constexpr size_t WS_WOUT = WS_WRO + al((size_t)D * D * 2);
constexpr size_t WS_W2T = WS_WOUT + al((size_t)D * D * 2);
constexpr size_t WS_W2D = WS_W2T + al((size_t)2 * FFN * D * 2);
constexpr size_t WS_WQL = WS_W2D + al((size_t)D * FFN * 2);
constexpr size_t WS_TAB = WS_WQL + al((size_t)2048 * QR * 2);
constexpr size_t TAB_C64 = 0, TAB_S64 = (size_t)NPOS * 64 * 4, TAB_C16 = 2 * TAB_S64, TAB_S16 = TAB_C16 + (size_t)NPOS * 16 * 4, TAB_GP = TAB_S16 + (size_t)NPOS * 16 * 4, TAB_GN = TAB_GP + 512 * 4, TAB_END = TAB_GN + 512 * 4;
constexpr size_t WS_XB = WS_TAB + al(TAB_END);
constexpr size_t WS_XE = WS_XB + al((size_t)MP * D * 2);
constexpr size_t WS_R1 = WS_XE + al((size_t)256 * D * 4);
constexpr size_t WS_ACT = WS_R1 + al((size_t)MP * 4);
constexpr size_t WS_H = WS_ACT + al((size_t)MP * FFN * 2);
constexpr size_t WS_HB = WS_H + al((size_t)MP * D * 4);
constexpr size_t WS_SSQH = WS_HB + al((size_t)MP * D * 2);
constexpr size_t WS_SSQ2_ = WS_SSQH + al((size_t)MP * 4), WS_SSQ3_ = WS_SSQ2_ + al((size_t)MP * 4);
constexpr size_t WS_END1 = WS_SSQH + al((size_t)MP * 16 * 4);

constexpr int CW_BAR = 4096, CW_QUEUE = 64, CW_DCNT = 24576  ;

constexpr int RING_OFF = 0, RING_BYTES = 131072, SCR_BYTES = 155648  , LDSCTL_OFF = SCR_BYTES, MISC_OFF = LDSCTL_OFF + 320, LDS_BYTES = 163840;

struct Args {
    const float* in[27]; float* out; unsigned char* ws;
};

struct Frame {
    LAS unsigned char* lds;
    volatile LAS unsigned* MISC;
    int wave, vcu, G;
};

constexpr int PT_OFF = MISC_OFF + 256;
struct Ptrs {
    unsigned char* ws; volatile LAS unsigned* tab;
    __device__ __forceinline__ unsigned long long raw(int k) const { volatile LAS unsigned* t = tab; asm volatile("" : "+v"(t));
        const unsigned lo = __builtin_amdgcn_readfirstlane(t[2 * k]), hi = __builtin_amdgcn_readfirstlane(t[2 * k + 1]); return ((unsigned long long)hi << 32) | lo; }
    __device__ __forceinline__ const float* in(int k) const { return (const float*)(GAS const float*)raw(k); }
    __device__ __forceinline__ float* out() const { return (float*)(GAS float*)raw(27); }
};
__device__ __forceinline__ int fresh_tid(int wave) { int t = lane_fresh() + 64 * wave; asm volatile("" : "+v"(t)); return t; }

__device__ __forceinline__ float lx(float v, int lane, int mask) { return __int_as_float(__builtin_amdgcn_ds_bpermute((lane ^ mask) << 2, __float_as_int(v))); }
__device__ __forceinline__ float wave_sum(float v, int lane) {
#pragma unroll
    for (int o = 1; o < 64; o <<= 1) v += lx(v, lane, o);
    return v;
}
__device__ __forceinline__ int row_pos(int row) { return row < MMAIN ? (row & (SEQ - 1)) + NMETA : (row < ROW_SMP ? row - ROW_META : (row < ROW_PAD ? PAST : 0)); }
__device__ __forceinline__ int row_pidx(int row) { return row < MMAIN ? (row & (SEQ - 1)) + NMETA : (row < ROW_SMP ? row - ROW_META : (row < ROW_PAD ? T : 0)); }
__device__ __forceinline__ int row_jtok(int row) { return row < MMAIN ? (row & 127) : (row < ROW_SMP ? row - ROW_META : 0); }

struct WSrc { const float* W; int ld; int col0; const float* g; };
__device__ __forceinline__ void wmat_dims(int id, int& K, int& ngrp) {
    switch (id) {
        case 0: case 9: K = D; ngrp = 2 * FFN / 32; break;
        case 1: case 10: K = FFN; ngrp = D / 32; break;
        case 2: K = D; ngrp = NWIN / 32; break;
        case 3: K = QR; ngrp = 768 / 32; break;
        case 4: case 5: K = KVR; ngrp = 512 / 32; break;
        case 6: K = 512; ngrp = D / 32; break;
        default: K = D; ngrp = D / 32; break;
    }
}
__device__ __forceinline__ size_t wmat_off(int id) {
    switch (id) { case 0: return WS_W1T; case 1: return WS_W1D; case 2: return WS_WIN; case 3: return WS_WUQ; case 4: return WS_WUK; case 5: return WS_WUV;
                  case 6: return WS_WMO; case 7: return WS_WRO; case 8: return WS_WOUT; case 9: return WS_W2T; default: return WS_W2D; }
}
__device__ __forceinline__ WSrc wmat_src(const Args& a, int id, int g) {
    WSrc s; s.W = nullptr; s.ld = 0; s.col0 = 0; s.g = nullptr;
    switch (id) {
        case 0: case 9: { const int pn = g >> 3, gg = g & 7; const int o = id == 0 ? 7 : 22;
            s.W = gg < 4 ? a.in[o + 1] : a.in[o + 2]; s.ld = FFN; s.col0 = 128 * pn + 32 * (gg & 3); s.g = a.in[o]; break; }
        case 1: s.W = a.in[10]; s.ld = D; s.col0 = 32 * g; break;
        case 10: s.W = a.in[25]; s.ld = D; s.col0 = 32 * g; break;
        case 2: { s.ld = IN_DIM; s.g = a.in[11]; int zc = -1;
            if (g < 8) zc = 32 * g;
            else if (g < 16) { const int gg = g - 8; zc = gg < 4 ? 256 + 32 * gg : (gg == 4 ? O_KR : -1); }
            else if (g < 24) zc = O_CKV + 32 * (g - 16);
            else if (g < 56) { const int base = g < 40 ? O_RQ : O_RK; const int q = (g - 24) & 15, t = q >> 3, gg = q & 7;
                const int h = 2 * t + ((gg >> 1) & 1), part = (gg >> 2) * 64 + (gg & 1) * 32; zc = base + h * 128 + part; }
            else if (g < 88) zc = O_RV + 32 * (g - 56);
            else if (g < 120) zc = O_RG + 32 * (g - 88);
            else if (g < 152) zc = O_GA + 32 * (g - 120);
            else zc = O_GB + 32 * (g - 152);
            if (zc >= 0) { s.W = a.in[12]; s.col0 = zc; }
            break; }
        case 3: s.W = a.in[15]; s.ld = 768; s.col0 = 32 * g; s.g = a.in[13]; break;
        case 4: s.W = a.in[16]; s.ld = 512; s.col0 = 32 * g; s.g = a.in[14]; break;
        case 5: s.W = a.in[17]; s.ld = 512; s.col0 = 32 * g; s.g = a.in[14]; break;
        case 6: s.W = a.in[18]; s.ld = D; s.col0 = 32 * g; break;
        case 7: s.W = a.in[20]; s.ld = D; s.col0 = 32 * g; break;
        default: s.W = a.in[21]; s.ld = D; s.col0 = 32 * g; break;
    }
    return s;
}
__device__ __forceinline__ void p0_transpose_item(const WSrc s, int K, bf16* WT, int n0, int k0, LAS float* scr, int lane) {
    if (s.W) {
        float v[32];
        const float* wp = s.W + (size_t)(k0 + (lane >> 5)) * s.ld + s.col0 + (lane & 31);
#pragma unroll
        for (int i = 0; i < 32; ++i) v[i] = wp[(size_t)(2 * i) * s.ld];
        if (s.g) { const float* gp = s.g + k0 + (lane >> 5);
#pragma unroll
            for (int i = 0; i < 32; ++i) v[i] *= gp[2 * i]; }
#pragma unroll
        for (int i = 0; i < 32; ++i) scr[(2 * i + (lane >> 5)) * 33 + (lane & 31)] = v[i];
    } else {
#pragma unroll 8
        for (int i = 0; i < 32; ++i) { const int kk = 2 * i + (lane >> 5); scr[kk * 33 + (lane & 31)] = 0.f; }
    }
    LDS_WAIT(); asm volatile("" ::: "memory");
    const int c = lane & 7;
#pragma unroll
    for (int j = 0; j < 4; ++j) { const int n = (lane >> 3) + 8 * j; const LAS float* sp = scr + (8 * c) * 33 + n;
        v4u o; o.x = pk2(sp[0 * 33], sp[1 * 33]); o.y = pk2(sp[2 * 33], sp[3 * 33]); o.z = pk2(sp[4 * 33], sp[5 * 33]); o.w = pk2(sp[6 * 33], sp[7 * 33]);
        *(GAS v4u*)(WT + (size_t)(n0 + n) * K + k0 + 8 * c) = o; }
    LDS_WAIT(); asm volatile("" ::: "memory");
}
__device__ __forceinline__ const float* x_src(const Args& a, int row) {
    if (row < MMAIN) return a.in[0] + (size_t)row * D;
    if (row < ROW_SMP) return a.in[6] + (size_t)(row - ROW_META) * D;
    if (row < ROW_PAD) return a.in[1] + (size_t)(row - ROW_SMP) * D;
    return nullptr;
}
__device__ __forceinline__ void p0_weights(const Args& a, unsigned id_mask, int gw, int NGW, LAS float* scr, int lane) {
    unsigned char* ws = a.ws;
    int base = 0;
#pragma unroll 1
    for (int id = 0; id < 11; ++id) {
        if (!((id_mask >> id) & 1u)) continue;
        int K, ngrp; wmat_dims(id, K, ngrp);
        const int nk = K / 64, nitems = nk * ngrp;
        bf16* WT = (bf16*)(ws + wmat_off(id));
        int first = (gw - (base % NGW) + NGW) % NGW;
        for (int it = first; it < nitems; it += NGW) { const int g = it % ngrp, kb = it / ngrp; p0_transpose_item(wmat_src(a, id, g), K, WT, 32 * g, 64 * kb, scr, lane); }
        base += nitems;
    }
}
__device__ __forceinline__ void p0_weights_late(Frame& F, const Args& a) {
    const int bx = (int)blockIdx.x; if (bx < 172) return;
    const int lane = fresh_tid(F.wave) & 63;
    LAS float* scr = (LAS float*)(F.lds + RING_OFF + F.wave * 16384);
    p0_weights(a, 0x7C6u  , (bx - 172) * NWAVES + F.wave, 84 * NWAVES, scr, lane);
    __syncthreads();
}
__device__ __forceinline__ void p0_prologue(Frame& F, const Args& a) {
    const int lane = fresh_tid(F.wave) & 63;
    LAS float* scr = (LAS float*)(F.lds + RING_OFF + F.wave * 16384);
    const int gw = F.vcu * NWAVES + F.wave, NGW = F.G * NWAVES;
    unsigned char* ws = a.ws;
    p0_weights(a, 0x039u  , gw, NGW, scr, lane);
    bf16* XB = (bf16*)(ws + WS_XB); float* XE = (float*)(ws + WS_XE); float* R1 = (float*)(ws + WS_R1);
    for (int m0 = gw; m0 < MP; m0 += 2 * NGW) {
        f32x4 v[2][4];
#pragma unroll
        for (int t = 0; t < 2; ++t) { const int m = m0 + t * NGW; const float* xr = m < MP ? x_src(a, m) : nullptr;
#pragma unroll
            for (int j = 0; j < 4; ++j) v[t][j] = xr ? *((const GAS f32x4*)xr + lane + 64 * j) : (f32x4){0.f, 0.f, 0.f, 0.f}; }
#pragma unroll
        for (int t = 0; t < 2; ++t) { const int m = m0 + t * NGW; if (m >= MP) break;
            float s = 0.f;
#pragma unroll
            for (int j = 0; j < 4; ++j) s += (v[t][j].x * v[t][j].x + v[t][j].y * v[t][j].y) + (v[t][j].z * v[t][j].z + v[t][j].w * v[t][j].w);
            s = wave_sum(s, lane);
            if (lane == 0) R1[m] = 1.0f / sqrtf(s * (1.f / D) + EPS);
            GAS unsigned long long* o8 = (GAS unsigned long long*)(XB + (size_t)m * D) + lane;
#pragma unroll
            for (int j = 0; j < 4; ++j) o8[64 * j] = (unsigned long long)pk2(v[t][j].x, v[t][j].y) | ((unsigned long long)pk2(v[t][j].z, v[t][j].w) << 32);
            if (m >= MMAIN) {
#pragma unroll
                for (int j = 0; j < 4; ++j) *((GAS f32x4*)(XE + (size_t)(m - MMAIN) * D) + lane + 64 * j) = v[t][j];
            } }
    }
    {   const float* wuq = a.in[15]; const float* wuk = a.in[16]; const float* qn = a.in[13]; bf16* WQL = (bf16*)(ws + WS_WQL);
        LAS float* U = (LAS float*)(F.lds + RING_OFF);
        const int tid = F.wave * 64 + lane;
        for (int it = F.vcu; it < 256; it += F.G) {
            const int h = it >> 5, r0 = (it & 31) * 8;
            __syncthreads();
            for (int e = tid; e < QR * 64; e += NWAVES * 64) { const int k = e >> 6, n = e & 63; U[k * 65 + n] = wuq[(size_t)k * 768 + h * 96 + n]; }
            { const int rr = tid >> 6, n = tid & 63; U[QR * 65 + rr * 64 + n] = wuk[(size_t)(r0 + rr) * 512 + h * 64 + n]; }
            __syncthreads();
            if (tid < QR) { const float g = qn[tid]; float acc[8];
#pragma unroll
                for (int rr = 0; rr < 8; ++rr) acc[rr] = 0.f;
                for (int n = 0; n < 64; ++n) { const float u = U[tid * 65 + n];
#pragma unroll
                    for (int rr = 0; rr < 8; ++rr) acc[rr] += u * U[QR * 65 + rr * 64 + n]; }
#pragma unroll
                for (int rr = 0; rr < 8; ++rr) WQL[(size_t)(h * 256 + r0 + rr) * QR + tid] = (bf16)f2bf(acc[rr] * g); }
        }
        __syncthreads();
    }
    { const int gt_ = (F.vcu * NWAVES + F.wave) * 64 + lane, NGT_ = NGW * 64;
      for (int e = gt_; e < MP; e += NGT_) { ((float*)(ws + WS_SSQH))[e] = 0.f; ((float*)(ws + WS_SSQ2_))[e] = 0.f; ((float*)(ws + WS_SSQ3_))[e] = 0.f; } }
    float* TAB = (float*)(ws + WS_TAB);
    const int gt = (F.vcu * NWAVES + F.wave) * 64 + lane, NGT = NGW * 64;
    for (int e = gt; e < NPOS * 64; e += NGT) { const int p = e >> 6, i = e & 63; const int pos = p < T ? p : PAST;
        const float invf = (float)pow(10000.0, -(double)i / 64.0); const float ang = (float)pos * invf;
        TAB[TAB_C64 / 4 + e] = (float)cos((double)ang); TAB[TAB_S64 / 4 + e] = (float)sin((double)ang); }
    for (int e = gt; e < NPOS * 16; e += NGT) { const int p = e >> 4, i = e & 15; const int pos = p < T ? p : PAST;
        const float invf = (float)pow(10000.0, -(double)i / 16.0); const float ang = (float)pos * invf;
        TAB[TAB_C16 / 4 + e] = (float)cos((double)ang); TAB[TAB_S16 / 4 + e] = (float)sin((double)ang); }
    for (int e = gt; e < 512; e += NGT) { const int h = e >> 7, j = e & 127; const double lg = log1p(-exp2(-5.0 - (double)h));
        TAB[TAB_GP / 4 + e] = (float)exp(lg * (double)j); TAB[TAB_GN / 4 + e] = (float)exp(-lg * (double)j); }
}

using pg8::f32x4; using pg8::u32x4; using pg8::Unit; using pg8::BM; using pg8::HALF;
typedef unsigned u32x2 __attribute__((ext_vector_type(2)));
__device__ __forceinline__ float fast_sigmoid(float x) { return __builtin_amdgcn_rcpf(1.f + __builtin_amdgcn_exp2f(-1.4426950408889634f * x)); }
__device__ __forceinline__ float fast_silu(float x) { return x * fast_sigmoid(x); }

struct EpiSwiGLU {
    static constexpr bool PERM = true, AFTER_DRAIN = false;
    bf16* ACT; const float* rs;
    __device__ __forceinline__ void operator()(const f32x4 (&acc)[2][2][4][2], const Unit& u, int wr, int wc, int fr, int fq) const {
        int l_ = lane_fresh(); asm volatile("" : "+v"(l_)); fr = l_ & 15; fq = l_ >> 4;
        const int row0 = u.pm * BM + wr * 64 + fr, col0 = u.pn * HALF + wc * 32 + 8 * fq;
#pragma unroll
        for (int ai = 0; ai < 2; ++ai)
#pragma unroll
            for (int m = 0; m < 4; ++m) { const int row = row0 + ai * HALF + m * 16; const float r = rs[row];
                f32x4 o[2];
#pragma unroll
                for (int n = 0; n < 2; ++n)
#pragma unroll
                    for (int j = 0; j < 4; ++j) { const float g = acc[ai][0][m][n][j] * r, up = acc[ai][1][m][n][j] * r; o[n][j] = fast_silu(g) * up; }
                u32x4 w; w.x = pg8::cvt_pk_bf16(o[0][0], o[0][1]); w.y = pg8::cvt_pk_bf16(o[0][2], o[0][3]); w.z = pg8::cvt_pk_bf16(o[1][0], o[1][1]); w.w = pg8::cvt_pk_bf16(o[1][2], o[1][3]);
                *(u32x4*)(ACT + (size_t)row * FFN + col0) = w; }
    }
};
template <class T> __device__ __forceinline__ T* at(unsigned char* w, unsigned byte_off) { return (T*)(w + byte_off); }
template <unsigned RES_OFF, bool RES_X, unsigned OUT_OFF, unsigned OUTB_OFF, unsigned SSQ_OFF, int SCALE2  > struct EpiResid {
    static constexpr bool PERM = false, AFTER_DRAIN = false;
    unsigned char* ws_; const float* xin;
    __device__ __forceinline__ void operator()(const f32x4 (&acc)[2][2][4][2], const Unit& u, int wr, int wc, int fr, int fq) const {
        int l_ = lane_fresh(); asm volatile("" : "+v"(l_)); fr = l_ & 15; fq = l_ >> 4;
        unsigned char* w = opaque_g(ws_);
        const unsigned row0 = u.pm * BM + wr * 64 + fr, col0 = u.pn * BM + wc * 32 + 4 * fq;
        constexpr float scale = 0.5f * SCALE2;
#pragma unroll
        for (int ai = 0; ai < 2; ++ai)
#pragma unroll
            for (int m = 0; m < 4; ++m) { unsigned row = row0 + ai * HALF + m * 16; asm volatile("" : "+v"(row));
                const float* rp;
                if (RES_X) rp = row < (unsigned)MMAIN ? xin + row * D + col0 : at<const float>(w, RES_OFF + ((row - MMAIN) * D + col0) * 4);
                else rp = at<const float>(w, RES_OFF + (row * D + col0) * 4);
                float ss = 0.f;
#pragma unroll
                for (int bj = 0; bj < 2; ++bj)
#pragma unroll
                    for (int n = 0; n < 2; ++n) { const f32x4 b = *(const f32x4*)(rp + bj * HALF + n * 16); const f32x4 o = b + acc[ai][bj][m][n] * scale;
                        const unsigned e = row * D + col0 + bj * HALF + n * 16;
                        *at<f32x4>(w, OUT_OFF + e * 4) = o;
                        ss += (o[0] * o[0] + o[1] * o[1]) + (o[2] * o[2] + o[3] * o[3]);
                        if (OUTB_OFF) { u32x2 pk; pk.x = pg8::cvt_pk_bf16(o[0], o[1]); pk.y = pg8::cvt_pk_bf16(o[2], o[3]); *at<u32x2>(w, OUTB_OFF + e * 2) = pk; } }
                ss += lx(ss, l_, 16); ss += lx(ss, l_, 32);
                if (fq == 0) atomicAdd(at<float>(w, SSQ_OFF + row * 4), ss);
                asm volatile("" ::: "memory"); }
    }
};
}
namespace mk {
constexpr size_t WS_CQ = WS_END1;
constexpr size_t WS_SSQCQ = WS_CQ + al((size_t)MP * QR * 2);
constexpr size_t WS_CKVF = WS_SSQCQ + al((size_t)MP * 8 * 4);
constexpr size_t WS_CKVB = WS_CKVF + al((size_t)MP * KVR * 4);
constexpr size_t WS_SSQKV = WS_CKVB + al((size_t)MP * KVR * 2);
constexpr size_t WS_KRB = WS_SSQKV + al((size_t)MP * 4 * 4);
constexpr size_t WS_RQ = WS_KRB + al((size_t)MP * 32 * 2);
constexpr size_t WS_RK = WS_RQ + al((size_t)MP * 512 * 2);
constexpr size_t WS_RKT = WS_RK + al((size_t)MP * 512 * 2);
constexpr size_t WS_RVT = WS_RKT + al((size_t)MP * 512 * 2);
constexpr size_t WS_SRG = WS_RVT + al((size_t)MP * 1024 * 2);
constexpr size_t WS_SGA = WS_SRG + al((size_t)MP * 1024 * 2);
constexpr size_t WS_SGB = WS_SGA + al((size_t)MP * 1024 * 2);
constexpr size_t WS_QA = WS_SGB + al((size_t)MP * 1024 * 2);
constexpr size_t WS_KN = WS_QA + al((size_t)MP * 768 * 2);
constexpr size_t WS_VT = WS_KN + al((size_t)MP * 512 * 2);
constexpr size_t WS_KRF = WS_VT + al((size_t)MP * 512 * 2);
constexpr size_t WS_END2 = WS_KRF + al((size_t)MP * 32 * 4);
constexpr float SC_Q = 0.14724444348433683f;
constexpr float RK_SCALE = 0.08838834764831845f;

constexpr size_t OUT_YP = 0, OUT_YS = OUT_YP + (size_t)NB * SEQ * D, OUT_CKVP = OUT_YS + (size_t)NS * D, OUT_KRP = OUT_CKVP + (size_t)NB * T * KVR,
                 OUT_SRP = OUT_KRP + (size_t)NB * T * 32, OUT_CKVS = OUT_SRP + (size_t)NB * RH * RDK * RDV, OUT_KRS = OUT_CKVS + (size_t)NS * KVR, OUT_SRS = OUT_KRS + (size_t)NS * 32,
                 OUT_END = OUT_SRS + (size_t)NS * RH * RDK * RDV;

__device__ __forceinline__ float row_rscale16(const float* SSQ, int row, float inv_n) { return 1.0f / sqrtf(SSQ[row] * inv_n + EPS); }
__device__ __forceinline__ float row_rscale8(const float* SSQ, int row, float inv_n) {
    const f32x4* p = (const f32x4*)(SSQ + (size_t)row * 8); const f32x4 a = p[0], b = p[1];
    return 1.0f / sqrtf((((a[0] + a[1]) + (a[2] + a[3])) + ((b[0] + b[1]) + (b[2] + b[3]))) * inv_n + EPS);
}
__device__ __forceinline__ float row_rscale4(const float* SSQ, int row, float inv_n) {
    const f32x4 a = *(const f32x4*)(SSQ + (size_t)row * 4);
    return 1.0f / sqrtf(((a[0] + a[1]) + (a[2] + a[3])) * inv_n + EPS);
}
__device__ __forceinline__ u32x2 pack4(const f32x4 v) { u32x2 w; w.x = pg8::cvt_pk_bf16(v[0], v[1]); w.y = pg8::cvt_pk_bf16(v[2], v[3]); return w; }
__device__ __forceinline__ float ssq4(const f32x4 v) { return (v[0] * v[0] + v[1] * v[1]) + (v[2] * v[2] + v[3] * v[3]); }
__device__ __forceinline__ bf16 bf1(float x) { return (bf16)f2bf(x); }

static_assert(WS_END2 < ((size_t)1 << 31), "32-bit workspace offsets");
__device__ __forceinline__ void tr_store16(LAS unsigned char* T, int fr, int fq, int lane, const f32x4 (&v)[4], unsigned char* w, unsigned dst_off) {
#pragma unroll
    for (int m = 0; m < 4; ++m)
#pragma unroll
        for (int j = 0; j < 4; ++j) *(LAS bf16*)(T + (4 * fq + j) * 144 + (16 * m + fr) * 2) = bf1(v[m][j]);
    asm volatile("s_waitcnt lgkmcnt(0)" ::: "memory");
#pragma unroll
    for (int k = 0; k < 2; ++k) { const int id = lane + 64 * k, c = id >> 3, part = id & 7; const v4u x = *(const LAS v4u*)(T + c * 144 + part * 16); *at<v4u>(w, dst_off + (unsigned)(c * MP + 8 * part) * 2u) = x; }
    asm volatile("s_waitcnt lgkmcnt(0)" ::: "memory");
}
constexpr int EPI_LDS_OFF = RING_BYTES, EPI_LDS_WAVE = 3072;
static_assert(EPI_LDS_OFF + 8 * EPI_LDS_WAVE <= SCR_BYTES && 16 * 144 <= EPI_LDS_WAVE, "epilogue LDS scratch");
struct EpiWin {
    static constexpr bool PERM = false, AFTER_DRAIN = false;
    unsigned char* ws_; LAS unsigned char* lds_;
#define MK_WS(var) unsigned char* var = opaque_g(ws_)
#define MK_ROWS_BEGIN _Pragma("unroll") for (int ai = 0; ai < 2; ++ai) _Pragma("unroll") for (int m = 0; m < 4; ++m) { \
        unsigned row = row0 + ai * HALF + m * 16; asm volatile("" : "+v"(row)); const float r = row_rscale16(at<const float>(w, (unsigned)WS_SSQH), (int)row, 1.f / D);
#define MK_ROWS_END asm volatile("" ::: "memory"); }
    __device__ __forceinline__ void operator()(const f32x4 (&acc)[2][2][4][2], const Unit& u, int wr, int wc, int fr, int fq) const {
        int l_ = lane_fresh(); asm volatile("" : "+v"(l_)); fr = l_ & 15; fq = l_ >> 4;
        const unsigned row0 = u.pm * BM + wr * 64 + fr; const int pn = u.pn;
        MK_WS(w);
        if (pn == 0) {
            MK_ROWS_BEGIN
                float ss = 0.f;
#pragma unroll
                for (int bj = 0; bj < 2; ++bj)
#pragma unroll
                    for (int n = 0; n < 2; ++n) { const f32x4 v = acc[ai][bj][m][n] * r; ss += ssq4(v); *at<u32x2>(w, (unsigned)WS_CQ + (row * QR + bj * HALF + wc * 32 + n * 16 + 4 * fq) * 2) = pack4(v); }
                ss += lx(ss, l_, 16); ss += lx(ss, l_, 32);
                if (fq == 0) *at<float>(w, (unsigned)WS_SSQCQ + (row * 8 + wc) * 4) = ss;
            MK_ROWS_END
        } else if (pn == 1) {
            MK_ROWS_BEGIN
                float ss = 0.f;
#pragma unroll
                for (int n = 0; n < 2; ++n) { const f32x4 v = acc[ai][0][m][n] * r; ss += ssq4(v); *at<u32x2>(w, (unsigned)WS_CQ + (row * QR + 256 + wc * 32 + n * 16 + 4 * fq) * 2) = pack4(v); }
                ss += lx(ss, l_, 16); ss += lx(ss, l_, 32);
                if (fq == 0) *at<float>(w, (unsigned)WS_SSQCQ + (row * 8 + 4 + wc) * 4) = ss;
                if (wc == 0) {
                    const f32x4 x1 = acc[ai][1][m][0] * r, x2 = acc[ai][1][m][1] * r;
                    const unsigned pi = row_pidx((int)row);
                    const f32x4 c = *at<const f32x4>(w, (unsigned)(WS_TAB + TAB_C16) + (pi * 16 + 4 * fq) * 4), s = *at<const f32x4>(w, (unsigned)(WS_TAB + TAB_S16) + (pi * 16 + 4 * fq) * 4);
                    const f32x4 y1 = x1 * c - x2 * s, y2 = x1 * s + x2 * c;
                    *at<u32x2>(w, (unsigned)WS_KRB + (row * 32 + 4 * fq) * 2) = pack4(y1); *at<u32x2>(w, (unsigned)WS_KRB + (row * 32 + 16 + 4 * fq) * 2) = pack4(y2);
                    *at<f32x4>(w, (unsigned)WS_KRF + (row * 32 + 4 * fq) * 4) = y1; *at<f32x4>(w, (unsigned)WS_KRF + (row * 32 + 16 + 4 * fq) * 4) = y2;
                }
            MK_ROWS_END
        } else if (pn == 2) {
            MK_ROWS_BEGIN
                float ss = 0.f;
#pragma unroll
                for (int bj = 0; bj < 2; ++bj)
#pragma unroll
                    for (int n = 0; n < 2; ++n) { const f32x4 v = acc[ai][bj][m][n] * r; ss += ssq4(v); const unsigned e = row * KVR + bj * HALF + wc * 32 + n * 16 + 4 * fq;
                        *at<f32x4>(w, (unsigned)WS_CKVF + e * 4) = v; *at<u32x2>(w, (unsigned)WS_CKVB + e * 2) = pack4(v); }
                ss += lx(ss, l_, 16); ss += lx(ss, l_, 32);
                if (fq == 0) *at<float>(w, (unsigned)WS_SSQKV + (row * 4 + wc) * 4) = ss;
            MK_ROWS_END
        } else if (pn < 7) {
            const bool isk = pn >= 5; const unsigned hh = 2 * ((pn - 3) & 1) + (wc >> 1);
            const unsigned dbase = (unsigned)(isk ? WS_RK : WS_RQ) + hh * 256, gbase = (unsigned)(WS_TAB + (isk ? TAB_GN : TAB_GP)) + hh * 512;
            LAS unsigned char* T = lds_ + EPI_LDS_OFF + (wr * 4 + wc) * EPI_LDS_WAVE;
#pragma unroll
            for (int ai = 0; ai < 2; ++ai) {
                f32x4 y1s[2][4], y2s[2][4];
#pragma unroll
                for (int m = 0; m < 4; ++m) {
                    unsigned row = row0 + ai * HALF + m * 16; asm volatile("" : "+v"(row)); const float r = row_rscale16(at<const float>(w, (unsigned)WS_SSQH), (int)row, 1.f / D);
                    const unsigned pi = row_pidx((int)row), jt = row_jtok((int)row);
                    const float mult = *at<const float>(w, gbase + jt * 4) * (isk ? RK_SCALE : 1.f);
#pragma unroll
                    for (int n = 0; n < 2; ++n) { const unsigned i0 = 32 * (wc & 1) + 16 * n + 4 * fq;
                        const f32x4 x1 = acc[ai][0][m][n] * r, x2 = acc[ai][1][m][n] * r;
                        const f32x4 c = *at<const f32x4>(w, (unsigned)(WS_TAB + TAB_C64) + (pi * 64 + i0) * 4), s = *at<const f32x4>(w, (unsigned)(WS_TAB + TAB_S64) + (pi * 64 + i0) * 4);
                        const f32x4 y1 = (x1 * c - x2 * s) * mult, y2 = (x1 * s + x2 * c) * mult;
                        *at<u32x2>(w, dbase + (row * 512 + i0) * 2) = pack4(y1); *at<u32x2>(w, dbase + (row * 512 + 64 + i0) * 2) = pack4(y2);
                        y1s[n][m] = y1; y2s[n][m] = y2; }
                    asm volatile("" ::: "memory");
                }
                if (isk) {
                    const unsigned rb = u.pm * BM + ai * HALF + wr * 64;
#pragma unroll
                    for (int n = 0; n < 2; ++n) { const unsigned c0 = hh * 128 + 32 * (wc & 1) + 16 * n;
                        tr_store16(T, fr, fq, l_, y1s[n], w, (unsigned)WS_RKT + (c0 * MP + rb) * 2u); tr_store16(T, fr, fq, l_, y2s[n], w, (unsigned)WS_RKT + ((c0 + 64) * MP + rb) * 2u); }
                }
            }
        } else if (pn < 11) {
            LAS unsigned char* T = lds_ + EPI_LDS_OFF + (wr * 4 + wc) * EPI_LDS_WAVE;
#pragma unroll
            for (int ai = 0; ai < 2; ++ai) {
                float rr[4];
#pragma unroll
                for (int m = 0; m < 4; ++m) { unsigned row = row0 + ai * HALF + m * 16; asm volatile("" : "+v"(row)); rr[m] = row_rscale16(at<const float>(w, (unsigned)WS_SSQH), (int)row, 1.f / D); }
                const unsigned rb = u.pm * BM + ai * HALF + wr * 64;
#pragma unroll
                for (int bj = 0; bj < 2; ++bj)
#pragma unroll
                    for (int n = 0; n < 2; ++n) { f32x4 vv[4];
#pragma unroll
                        for (int m = 0; m < 4; ++m) vv[m] = acc[ai][bj][m][n] * rr[m];
                        tr_store16(T, fr, fq, l_, vv, w, (unsigned)WS_RVT + (((pn - 7) * 256 + bj * HALF + wc * 32 + n * 16) * MP + rb) * 2u); }
                asm volatile("" ::: "memory");
            }
        } else {
            const int t = (pn - 11) >> 2; const unsigned dbase = (unsigned)WS_SRG + (unsigned)t * (unsigned)(WS_SGA - WS_SRG) + (((pn - 11) & 3) * 256 + wc * 32 + 4 * fq) * 2;
            MK_ROWS_BEGIN
#pragma unroll
                for (int bj = 0; bj < 2; ++bj)
#pragma unroll
                    for (int n = 0; n < 2; ++n) { const f32x4 v = acc[ai][bj][m][n] * r; f32x4 o;
#pragma unroll
                        for (int j = 0; j < 4; ++j) { const float sg = fast_sigmoid(v[j]); o[j] = t == 0 ? v[j] * sg : sg; }
                        *at<u32x2>(w, dbase + (row * 1024 + bj * HALF + n * 16) * 2) = pack4(o); }
            MK_ROWS_END
        }
    }
};
static_assert(WS_SGB - WS_SGA == WS_SGA - WS_SRG, "gate arrays equally spaced");
struct EpiQ {
    static constexpr bool PERM = false, AFTER_DRAIN = false;
    unsigned char* ws;
    __device__ __forceinline__ void operator()(const f32x4 (&acc)[2][2][4][2], const Unit& u, int wr, int wc, int fr, int fq) const {
        int l_ = lane_fresh(); asm volatile("" : "+v"(l_)); fr = l_ & 15; fq = l_ >> 4;
        const float* SSQCQ = (const float*)(ws + WS_SSQCQ); bf16* QA = (bf16*)(ws + WS_QA); const float* TAB = (const float*)(ws + WS_TAB);
        const int row0 = u.pm * BM + wr * 64 + fr;
#pragma unroll
        for (int ai = 0; ai < 2; ++ai)
#pragma unroll
            for (int m = 0; m < 4; ++m) {
                int row = row0 + ai * HALF + m * 16; asm volatile("" : "+v"(row));
                const float r = row_rscale8(SSQCQ, row, 1.f / QR) * SC_Q;
#pragma unroll
                for (int bj = 0; bj < 2; ++bj) {
                    const int grp = 8 * u.pn + 4 * bj + wc;
                    bf16* dst = QA + (size_t)row * 768 + 32 * grp + 4 * fq;
                    const bool rope = (grp % 3) == 2;
                    const int pi = row_pidx(row);
                    f32x4 c = *(const f32x4*)(TAB + TAB_C16 / 4 + pi * 16 + 4 * fq), s = *(const f32x4*)(TAB + TAB_S16 / 4 + pi * 16 + 4 * fq);
                    if (!rope) { c = (f32x4){1.f, 1.f, 1.f, 1.f}; s = (f32x4){0.f, 0.f, 0.f, 0.f}; }
                    const f32x4 x1 = acc[ai][bj][m][0] * r, x2 = acc[ai][bj][m][1] * r;
                    *(u32x2*)dst = pack4(x1 * c - x2 * s); *(u32x2*)(dst + 16) = pack4(x1 * s + x2 * c);
                }
                asm volatile("" ::: "memory");
            }
    }
};
template <bool ROWS> struct EpiScaleBf16 {
    static constexpr bool PERM = true, AFTER_DRAIN = false;
    const float* SSQKV; bf16* O; int ldc;
    __device__ __forceinline__ void operator()(const f32x4 (&acc)[2][2][4][2], const Unit& u, int wr, int wc, int fr, int fq) const {
        int l_ = lane_fresh(); asm volatile("" : "+v"(l_)); fr = l_ & 15; fq = l_ >> 4;
        const int row0 = u.pm * BM + wr * 64 + fr, col0 = u.pn * BM + wc * 32 + 8 * fq;
        float cs[2][8];
        if (!ROWS) {
#pragma unroll
            for (int bj = 0; bj < 2; ++bj)
#pragma unroll
                for (int k = 0; k < 8; ++k) cs[bj][k] = row_rscale4(SSQKV, col0 + bj * HALF + k, 1.f / KVR);
        }
#pragma unroll
        for (int ai = 0; ai < 2; ++ai)
#pragma unroll
            for (int m = 0; m < 4; ++m) { int row = row0 + ai * HALF + m * 16; asm volatile("" : "+v"(row)); const float r = ROWS ? row_rscale4(SSQKV, row, 1.f / KVR) : 1.f;
#pragma unroll
                for (int bj = 0; bj < 2; ++bj) { f32x4 v0 = acc[ai][bj][m][0], v1 = acc[ai][bj][m][1];
                    if (ROWS) { v0 = v0 * r; v1 = v1 * r; }
                    else {
#pragma unroll
                        for (int j = 0; j < 4; ++j) { v0[j] *= cs[bj][j]; v1[j] *= cs[bj][4 + j]; } }
                    u32x4 w; w.x = pg8::cvt_pk_bf16(v0[0], v0[1]); w.y = pg8::cvt_pk_bf16(v0[2], v0[3]); w.z = pg8::cvt_pk_bf16(v1[0], v1[1]); w.w = pg8::cvt_pk_bf16(v1[2], v1[3]);
                    *(u32x4*)(O + (size_t)row * ldc + col0 + bj * HALF) = w; } }
    }
};
__device__ __forceinline__ void finalize_ckv(Frame& F, const Ptrs& a) {
    const int lane = fresh_tid(F.wave) & 63;
    const int gw = F.vcu * NWAVES + F.wave, NGW = F.G * NWAVES;
    const float* CKVF = (const float*)(a.ws + WS_CKVF); const float* SSQKV = (const float*)(a.ws + WS_SSQKV); const float* KRF = (const float*)(a.ws + WS_KRF);
    const f32x4 g = *((const f32x4*)a.in(14) + lane);
    for (int row = gw; row < ROW_PAD; row += NGW) {
        const float r = row_rscale4(SSQKV, row, 1.f / KVR);
        const f32x4 o = *((const f32x4*)(CKVF + (size_t)row * KVR) + lane) * r * g;
        const f32x4 kr = *((const f32x4*)(KRF + (size_t)row * 32) + (lane & 7));
        if (row < MMAIN) { const size_t t = (size_t)(row >> 11) * T + NMETA + (row & (SEQ - 1)); *((f32x4*)(a.out() + OUT_CKVP + t * KVR) + lane) = o; if (lane < 8) *((f32x4*)(a.out() + OUT_KRP + t * 32) + lane) = kr; }
        else if (row < ROW_SMP) { for (int b = 0; b < NB; ++b) { const size_t t = (size_t)b * T + (row - ROW_META); *((f32x4*)(a.out() + OUT_CKVP + t * KVR) + lane) = o; if (lane < 8) *((f32x4*)(a.out() + OUT_KRP + t * 32) + lane) = kr; } }
        else { *((f32x4*)(a.out() + OUT_CKVS + (size_t)(row - ROW_SMP) * KVR) + lane) = o; if (lane < 8) *((f32x4*)(a.out() + OUT_KRS + (size_t)(row - ROW_SMP) * 32) + lane) = kr; }
    }
}
}
namespace mk {
constexpr size_t WS_AV = WS_END2;
constexpr size_t WS_END3 = WS_AV + al((size_t)MP * 512 * 2);
typedef float f32x16 __attribute__((ext_vector_type(16)));
constexpr int AT_KSTR = 208, AT_VSTR = 144, AT_KBUF = 64 * AT_KSTR, AT_VBUF = 64 * AT_VSTR, AT_VOFF = 2 * AT_KBUF;
__device__ __forceinline__ int crow(int i, int half) { return (i & 3) + 8 * (i >> 2) + 4 * half; }

__device__ __forceinline__ void attn_unit(Frame& F, unsigned char* ws, int b, int h, int qb) {
    ws = opaque_g(ws);
    const int tid = fresh_tid(F.wave), lane = tid & 63, w = F.wave, q = lane & 31, half = lane >> 5;
    LAS unsigned char* L = F.lds + RING_OFF;
    const bf16* QA = (const bf16*)(ws + WS_QA); const bf16* KN = (const bf16*)(ws + WS_KN); const bf16* KRB = (const bf16*)(ws + WS_KRB); const bf16* VT = (const bf16*)(ws + WS_VT);
    const int qrow = b * SEQ + qb * 256 + w * 32 + q, q_main = qb * 256 + w * 32 + q, wq0 = qb * 256 + w * 32;
    bf16x8 qf[6];
#pragma unroll
    for (int s = 0; s < 6; ++s) qf[s] = *(const bf16x8*)(QA + (size_t)qrow * 768 + h * 96 + 16 * s + 8 * half);
    f32x16 ot[2];
#pragma unroll
    for (int i = 0; i < 16; ++i) { ot[0][i] = 0.f; ot[1][i] = 0.f; }
    float m = -INFINITY, l = 0.f;
    const int NT = 4 * (qb + 1);
    v4u kreg, rreg, vreg; rreg = (v4u){0u, 0u, 0u, 0u};
#define AT_LOAD(tt) do { const int t0_ = (tt) == 0 ? ROW_META : b * SEQ + 64 * ((tt) - 1); \
        kreg = *(const v4u*)(KN + (size_t)(t0_ + (tid >> 3)) * 512 + h * 64 + (tid & 7) * 8); \
        if (tid < 256) rreg = *(const v4u*)(KRB + (size_t)(t0_ + (tid >> 2)) * 32 + (tid & 3) * 8); \
        vreg = *(const v4u*)(VT + (size_t)(h * 64 + (tid >> 3)) * MP + t0_ + (tid & 7) * 8); } while (0)
#define AT_STORE(buf) do { LAS unsigned char* kb_ = L + (buf) * AT_KBUF; \
        *(LAS v4u*)(kb_ + (tid >> 3) * AT_KSTR + (tid & 7) * 16) = kreg; \
        if (tid < 256) *(LAS v4u*)(kb_ + (tid >> 2) * AT_KSTR + 128 + (tid & 3) * 16) = rreg; \
        LAS unsigned char* vb_ = L + AT_VOFF + (buf) * AT_VBUF + (tid >> 3) * AT_VSTR + (32 * ((tid & 7) >> 1) + 8 * (tid & 1)); \
        *(LAS u32x2*)(vb_) = (u32x2){vreg.x, vreg.y}; *(LAS u32x2*)(vb_ + 16) = (u32x2){vreg.z, vreg.w}; } while (0)
    AT_LOAD(0); AT_STORE(0);
    __syncthreads();
    for (int tt = 0; tt <= NT; ++tt) {
        const int buf = tt & 1;
        if (tt < NT) AT_LOAD(tt + 1);
        const int kmin = tt == 0 ? 0 : 64 * (tt - 1);
        if (tt == 0 || kmin <= wq0 + 31) {
            const LAS unsigned char* Kb = L + buf * AT_KBUF + q * AT_KSTR + 16 * half;
            const LAS unsigned char* Vb = L + AT_VOFF + buf * AT_VBUF + q * AT_VSTR + 16 * half;
            f32x16 st[2];
#pragma unroll
            for (int kb = 0; kb < 2; ++kb) {
#pragma unroll
                for (int i = 0; i < 16; ++i) st[kb][i] = 0.f;
#pragma unroll
                for (int s = 0; s < 6; ++s) { const bf16x8 kf = *(const LAS bf16x8*)(Kb + kb * 32 * AT_KSTR + 32 * s); st[kb] = __builtin_amdgcn_mfma_f32_32x32x16_bf16(kf, qf[s], st[kb], 0, 0, 0); }
            }
            if (tt == 0) {
#pragma unroll
                for (int kb = 0; kb < 2; ++kb)
#pragma unroll
                    for (int i = 0; i < 16; ++i) if (32 * kb + crow(i, half) >= NMETA) st[kb][i] = -INFINITY;
            } else if (kmin + 63 > wq0) {
#pragma unroll
                for (int kb = 0; kb < 2; ++kb)
#pragma unroll
                    for (int i = 0; i < 16; ++i) if (kmin + 32 * kb + crow(i, half) > q_main) st[kb][i] = -INFINITY;
            }
            float mx = st[0][0];
#pragma unroll
            for (int i = 1; i < 16; ++i) mx = fmaxf(mx, st[0][i]);
#pragma unroll
            for (int i = 0; i < 16; ++i) mx = fmaxf(mx, st[1][i]);
            mx = fmaxf(mx, lx(mx, lane, 32));
            const float mn = fmaxf(m, mx), alpha = __builtin_amdgcn_exp2f(m - mn);
            m = mn;
            float ps = 0.f;
#pragma unroll
            for (int kb = 0; kb < 2; ++kb)
#pragma unroll
                for (int i = 0; i < 16; ++i) { st[kb][i] = __builtin_amdgcn_exp2f(st[kb][i] - mn); ps += st[kb][i]; }
            l = l * alpha + ps;
#pragma unroll
            for (int i = 0; i < 16; ++i) { ot[0][i] *= alpha; ot[1][i] *= alpha; }
#pragma unroll
            for (int kb = 0; kb < 2; ++kb)
#pragma unroll
                for (int s2 = 0; s2 < 2; ++s2) {
                    u32x4 pw; pw.x = pg8::cvt_pk_bf16(st[kb][8 * s2 + 0], st[kb][8 * s2 + 1]); pw.y = pg8::cvt_pk_bf16(st[kb][8 * s2 + 2], st[kb][8 * s2 + 3]);
                    pw.z = pg8::cvt_pk_bf16(st[kb][8 * s2 + 4], st[kb][8 * s2 + 5]); pw.w = pg8::cvt_pk_bf16(st[kb][8 * s2 + 6], st[kb][8 * s2 + 7]);
                    const bf16x8 pf = __builtin_bit_cast(bf16x8, pw);
#pragma unroll
                    for (int vb = 0; vb < 2; ++vb) { const bf16x8 vf = *(const LAS bf16x8*)(Vb + vb * 32 * AT_VSTR + (32 * kb + 16 * s2) * 2); ot[vb] = __builtin_amdgcn_mfma_f32_32x32x16_bf16(vf, pf, ot[vb], 0, 0, 0); }
                }
        }
        if (tt < NT) AT_STORE(buf ^ 1);
        __syncthreads();
    }
#undef AT_LOAD
#undef AT_STORE
    l += lx(l, lane, 32);
    const float inv = 1.0f / l;
    bf16* AV = (bf16*)(ws + WS_AV) + (size_t)qrow * 512 + h * 64 + 4 * half;
#pragma unroll
    for (int vb = 0; vb < 2; ++vb)
#pragma unroll
        for (int g = 0; g < 4; ++g) { f32x4 o; o[0] = ot[vb][4 * g] * inv; o[1] = ot[vb][4 * g + 1] * inv; o[2] = ot[vb][4 * g + 2] * inv; o[3] = ot[vb][4 * g + 3] * inv; *(u32x2*)(AV + 32 * vb + 8 * g) = pack4(o); }
}
__device__ __forceinline__ void attn_item(Frame& F, unsigned char* ws, int i) { const int bh = i & 63; attn_unit(F, ws, bh >> 3, bh & 7, 7 - (i >> 6)); }
__device__ __forceinline__ void attn_phase(Frame& F, unsigned char* ws) {
    const int c = F.vcu;
    if (c >= 256) return;
    const int bh = c >> 2, p = c & 3;
    attn_unit(F, ws, bh >> 3, bh & 7, 7 - p);
    attn_unit(F, ws, bh >> 3, bh & 7, p);
}
}
namespace mk {
constexpr size_t WS_UMETA = WS_END3;
constexpr size_t WS_UT = WS_UMETA + al((size_t)RH * RDV * RDK * 4);
constexpr size_t WS_SPREV = WS_UT + al((size_t)32 * 16 * RDV * RDK * 4);
constexpr size_t WS_RIN = WS_SPREV + al((size_t)32 * 16 * RDV * RDK * 2);
constexpr size_t WS_DPART = WS_RIN + al((size_t)MP * 1024 * 2);
constexpr size_t WS_QL = WS_DPART + al((size_t)32 * 16 * 8 * 264 * 4);
constexpr size_t WS_END4 = WS_QL + al((size_t)64 * 2048 * 4);
static_assert(WS_END4 < ((size_t)1 << 31), "32-bit workspace offsets");
__device__ __forceinline__ float gpow_t(const unsigned char* ws, int h, int n) { return ((const float*)(ws + WS_TAB + TAB_GP))[h * 128 + n]; }

__device__ __forceinline__ void ret_u_unit(Frame& F, unsigned char* ws, int u) {
    ws = opaque_g(ws);
    const int tid = fresh_tid(F.wave), lane = tid & 63, w = F.wave, r32 = lane & 31, half = lane >> 5;
    const bool meta = u >= 512; const int hh = meta ? u - 512 : (u >> 4) & 3;
    const int tok0 = meta ? ROW_META : (u >> 6) * SEQ + (u & 15) * 128, nks = meta ? 1 : 8;
    const bf16* RVT = (const bf16*)(ws + WS_RVT); const bf16* RKT = (const bf16*)(ws + WS_RKT);
    f32x16 acc[4];
#pragma unroll
    for (int db = 0; db < 4; ++db)
#pragma unroll
        for (int i = 0; i < 16; ++i) acc[db][i] = 0.f;
    const bf16* ap = RVT + (size_t)(hh * 256 + 32 * w + r32) * MP + tok0 + 8 * half;
    const bf16* bp = RKT + (size_t)(hh * 128 + r32) * MP + tok0 + 8 * half;
    for (int s = 0; s < nks; ++s) {
        const bf16x8 af = *(const bf16x8*)(ap + 16 * s);
#pragma unroll
        for (int db = 0; db < 4; ++db) { const bf16x8 bf = *(const bf16x8*)(bp + (size_t)(32 * db) * MP + 16 * s); acc[db] = __builtin_amdgcn_mfma_f32_32x32x16_bf16(af, bf, acc[db], 0, 0, 0); }
    }
    const float sc = gpow_t(ws, hh, meta ? NMETA - 1 : 127);
    float* dst = meta ? (float*)(ws + WS_UMETA) + (size_t)hh * RDV * RDK : (float*)(ws + WS_UT) + (size_t)u * RDV * RDK;
#pragma unroll
    for (int db = 0; db < 4; ++db)
#pragma unroll
        for (int i = 0; i < 16; ++i) dst[(size_t)(32 * w + crow(i, half)) * RDK + 32 * db + r32] = acc[db][i] * sc;
}
__device__ __forceinline__ void ret_scan(Frame& F, const Ptrs& a) {
    const int tid = fresh_tid(F.wave);
    const int gt = (F.vcu * NWAVES * 64) + tid, NGT = F.G * NWAVES * 64;
    const float* UM = (const float*)(a.ws + WS_UMETA); const float* UT = (const float*)(a.ws + WS_UT); bf16* SP = (bf16*)(a.ws + WS_SPREV);
    for (int e = gt; e < 32 * RDV * RDK; e += NGT) {
        const int bh = e >> 15, idx = e & 32767, hh = bh & 3;
        const float g128 = gpow_t(a.ws, hh, 127) * gpow_t(a.ws, hh, 1);
        float S = UM[(size_t)hh * 32768 + idx];
        for (int c = 0; c < 16; ++c) { const size_t o = ((size_t)bh * 16 + c) * 32768 + idx; SP[o] = bf1(S); S = g128 * S + UT[o]; }
        const int ee = idx >> 7, d = idx & 127;
        a.out()[OUT_SRP + ((size_t)bh * RDK + d) * RDV + ee] = S;
    }
}
__device__ __forceinline__ void ret_o_unit(Frame& F, const Ptrs& a, int u) {
    unsigned char* ws = a.ws; ws = opaque_g(ws);
    const int tid = fresh_tid(F.wave), lane = tid & 63, w = F.wave, r32 = lane & 31, half = lane >> 5;
    const int bh = u >> 4, c = u & 15, hh = bh & 3, tok0 = (bh >> 2) * SEQ + c * 128;
    const int ib = w & 3, eh = w >> 2;
    LAS float* red = (LAS float*)(F.lds + RING_OFF);
    const bf16* RQ = (const bf16*)(ws + WS_RQ); const bf16* RK = (const bf16*)(ws + WS_RK); const bf16* RVT = (const bf16*)(ws + WS_RVT);
    const bf16* SP = (const bf16*)(ws + WS_SPREV) + (size_t)u * 32768;
    const int irow = tok0 + 32 * ib + r32;
    bf16x8 qf[8];
#pragma unroll
    for (int s = 0; s < 8; ++s) qf[s] = *(const bf16x8*)(RQ + (size_t)irow * 512 + hh * 128 + 16 * s + 8 * half);
    f32x16 ot[4];
#pragma unroll
    for (int eb = 0; eb < 4; ++eb) {
#pragma unroll
        for (int i = 0; i < 16; ++i) ot[eb][i] = 0.f;
        const bf16* sp = SP + (size_t)(128 * eh + 32 * eb + r32) * RDK + 8 * half;
#pragma unroll
        for (int s = 0; s < 8; ++s) { const bf16x8 sf = *(const bf16x8*)(sp + 16 * s); ot[eb] = __builtin_amdgcn_mfma_f32_32x32x16_bf16(sf, qf[s], ot[eb], 0, 0, 0); }
    }
    const float g = gpow_t(ws, hh, 1);
#pragma unroll
    for (int eb = 0; eb < 4; ++eb)
#pragma unroll
        for (int i = 0; i < 16; ++i) ot[eb][i] *= g;
    for (int jb = 0; jb <= ib; ++jb) {
        f32x16 at;
#pragma unroll
        for (int i = 0; i < 16; ++i) at[i] = 0.f;
        const bf16* kp = RK + (size_t)(tok0 + 32 * jb + r32) * 512 + hh * 128 + 8 * half;
#pragma unroll
        for (int s = 0; s < 8; ++s) { const bf16x8 kf = *(const bf16x8*)(kp + 16 * s); at = __builtin_amdgcn_mfma_f32_32x32x16_bf16(kf, qf[s], at, 0, 0, 0); }
        if (jb == ib) {
#pragma unroll
            for (int i = 0; i < 16; ++i) if (crow(i, half) > r32) at[i] = 0.f;
        }
#pragma unroll
        for (int s2 = 0; s2 < 2; ++s2) {
            u32x4 pw; pw.x = pg8::cvt_pk_bf16(at[8 * s2 + 0], at[8 * s2 + 1]); pw.y = pg8::cvt_pk_bf16(at[8 * s2 + 2], at[8 * s2 + 3]);
            pw.z = pg8::cvt_pk_bf16(at[8 * s2 + 4], at[8 * s2 + 5]); pw.w = pg8::cvt_pk_bf16(at[8 * s2 + 6], at[8 * s2 + 7]);
            const bf16x8 pf = __builtin_bit_cast(bf16x8, pw);
#pragma unroll
            for (int eb = 0; eb < 4; ++eb) {
                const bf16* vp = RVT + (size_t)(hh * 256 + 128 * eh + 32 * eb + r32) * MP + tok0 + 32 * jb + 16 * s2 + 4 * half;
                const u32x2 lo = *(const u32x2*)vp, hi = *(const u32x2*)(vp + 8);
                u32x4 vw; vw.x = lo.x; vw.y = lo.y; vw.z = hi.x; vw.w = hi.y;
                ot[eb] = __builtin_amdgcn_mfma_f32_32x32x16_bf16(__builtin_bit_cast(bf16x8, vw), pf, ot[eb], 0, 0, 0);
            }
        }
    }
    float s1 = 0.f;
#pragma unroll
    for (int eb = 0; eb < 4; ++eb)
#pragma unroll
        for (int i = 0; i < 16; ++i) s1 += ot[eb][i];
    s1 += lx(s1, lane, 32);
    if (half == 0) red[w * 32 + r32] = s1;
    __syncthreads();
    const float mu = (red[w * 32 + r32] + red[(w ^ 4) * 32 + r32]) * (1.f / 256.f);
    float s2 = 0.f;
#pragma unroll
    for (int eb = 0; eb < 4; ++eb)
#pragma unroll
        for (int i = 0; i < 16; ++i) { ot[eb][i] -= mu; s2 += ot[eb][i] * ot[eb][i]; }
    s2 += lx(s2, lane, 32);
    if (half == 0) red[256 + w * 32 + r32] = s2;
    __syncthreads();
    const float rstd = 1.0f / sqrtf((red[256 + w * 32 + r32] + red[256 + (w ^ 4) * 32 + r32]) * (1.f / 256.f) + EPS);
    __syncthreads();
    const bf16* SRG = (const bf16*)(ws + WS_SRG) + (size_t)irow * 1024 + hh * 256 + 128 * eh + 4 * half;
    bf16* RIN = (bf16*)(ws + WS_RIN) + (size_t)irow * 1024 + hh * 256 + 128 * eh + 4 * half;
    const float* gn = a.in(19) + hh * 256 + 128 * eh + 4 * half;
#pragma unroll
    for (int eb = 0; eb < 4; ++eb)
#pragma unroll
        for (int gq = 0; gq < 4; ++gq) {
            const int eo = 32 * eb + 8 * gq;
            const u32x2 sg = *(const u32x2*)(SRG + eo); const f32x4 gv = *(const f32x4*)(gn + eo);
            f32x4 o;
            o[0] = ot[eb][4 * gq + 0] * rstd * gv[0] * __uint_as_float(sg.x << 16); o[1] = ot[eb][4 * gq + 1] * rstd * gv[1] * __uint_as_float(sg.x & 0xffff0000u);
            o[2] = ot[eb][4 * gq + 2] * rstd * gv[2] * __uint_as_float(sg.y << 16); o[3] = ot[eb][4 * gq + 3] * rstd * gv[3] * __uint_as_float(sg.y & 0xffff0000u);
            *(u32x2*)(RIN + eo) = pack4(o);
        }
}
__device__ __forceinline__ void ret_sample_unit(Frame& F, const Ptrs& a, int u) {
    unsigned char* ws = a.ws; ws = opaque_g(ws);
    const int tid = fresh_tid(F.wave), lane = tid & 63, s = u >> 2, hh = u & 3, e = tid & 255, dh = tid >> 8, row = ROW_SMP + s;
    LAS float* sh = (LAS float*)(F.lds + RING_OFF);
    const bf16* RQ = (const bf16*)(ws + WS_RQ); const bf16* RK = (const bf16*)(ws + WS_RK); const bf16* RVT = (const bf16*)(ws + WS_RVT);
    if (tid < 128) sh[tid] = __uint_as_float((unsigned)RQ[(size_t)row * 512 + hh * 128 + tid] << 16);
    else if (tid < 256) sh[tid] = __uint_as_float((unsigned)RK[(size_t)row * 512 + hh * 128 + tid - 128] << 16);
    __syncthreads();
    const float v = __uint_as_float((unsigned)RVT[(size_t)(hh * 256 + e) * MP + row] << 16);
    const float g = gpow_t(ws, hh, 1);
    const float* S0 = a.in(4) + ((size_t)(s * RH + hh) * RDK) * RDV + e;
    float* S1 = a.out() + OUT_SRS + ((size_t)(s * RH + hh) * RDK) * RDV + e;
    float o = 0.f;
    {   float s0[64];
#pragma unroll
        for (int k = 0; k < 64; ++k) s0[k] = S0[(size_t)(64 * dh + k) * RDV];
#pragma unroll
        for (int k = 0; k < 64; ++k) { const int d = 64 * dh + k; const float sn = g * s0[k] + sh[128 + d] * v; S1[(size_t)d * RDV] = sn; o += sh[d] * sn; } }
    sh[256 + dh * 256 + e] = o;
    __syncthreads();
    o = sh[256 + e] + sh[512 + e];
    float t1 = o;
#pragma unroll
    for (int off = 32; off > 0; off >>= 1) t1 += lx(t1, lane, off);
    if ((tid & 63) == 0) sh[768 + (tid >> 6)] = t1;
    __syncthreads();
    const float mu = (sh[768] + sh[769] + sh[770] + sh[771]) * (1.f / 256.f);
    const float dlt = o - mu;
    float t2 = dlt * dlt;
#pragma unroll
    for (int off = 32; off > 0; off >>= 1) t2 += lx(t2, lane, off);
    if ((tid & 63) == 0) sh[776 + (tid >> 6)] = t2;
    __syncthreads();
    const float rstd = 1.0f / sqrtf((sh[776] + sh[777] + sh[778] + sh[779]) * (1.f / 256.f) + EPS);
    if (dh == 0) { const float sg = __uint_as_float((unsigned)((const bf16*)(ws + WS_SRG))[(size_t)row * 1024 + hh * 256 + e] << 16);
        ((bf16*)(ws + WS_RIN))[(size_t)row * 1024 + hh * 256 + e] = bf1(dlt * rstd * a.in(19)[hh * 256 + e] * sg); }
    __syncthreads();
}
}
namespace mk {
template <int CTRL> __device__ __forceinline__ float dppf(float v) { return __int_as_float(__builtin_amdgcn_update_dpp(0, __float_as_int(v), CTRL, 0xF, 0xF, false)); }
__device__ __forceinline__ float swap32_add(float a, float b) { const auto r = __builtin_amdgcn_permlane32_swap(__float_as_uint(a), __float_as_uint(b), false, false); return __uint_as_float(r[0]) + __uint_as_float(r[1]); }
__device__ __forceinline__ float swap16_add(float a, float b) { const auto r = __builtin_amdgcn_permlane16_swap(__float_as_uint(a), __float_as_uint(b), false, false); return __uint_as_float(r[0]) + __uint_as_float(r[1]); }
__device__ __forceinline__ int dlane_of(int h) { return ((h >> 2) & 1) * 32 + ((h >> 1) & 1) * 16 + (h & 1) * 8; }
__device__ __forceinline__ void decode_unit(Frame& F, const Ptrs& a, int u) {
    unsigned char* ws = a.ws; ws = opaque_g(ws);
    const int tid = fresh_tid(F.wave), lane = tid & 63, w = F.wave, s = u >> 4, sp = u & 15, row = ROW_SMP + s;
    LAS float* sh = (LAS float*)(F.lds + RING_OFF);
    const bf16* QA = (const bf16*)(ws + WS_QA) + (size_t)row * 768;
    f32x4 ql[8]; float qr[8];
    { const float* QLr = (const float*)(ws + WS_QL) + (size_t)(row - MMAIN) * 2048;
#pragma unroll
      for (int h = 0; h < 8; ++h) { ql[h] = *(const f32x4*)(QLr + h * 256 + 4 * lane); qr[h] = lane < 32 ? __uint_as_float((unsigned)QA[h * 96 + 64 + lane] << 16) : 0.f; } }
    f32x4 O[8];
#pragma unroll
    for (int h = 0; h < 8; ++h) O[h] = (f32x4){0.f, 0.f, 0.f, 0.f};
    float m = -INFINITY, l = 0.f;
    const int page = ((const int*)a.in(5))[s * NPAGES + sp * 8 + w];
    const float* ck0 = a.in(2) + (size_t)page * PAGE * KVR + 4 * lane;
    const float* kr0 = a.in(3) + (size_t)page * PAGE * 32 + (lane & 31);
#define DC_LOAD(kv_, rv_, bi_) do { const float* c_ = ck0; const float* r_ = kr0; const int k0_ = (bi_) * 4; \
        _Pragma("unroll") for (int kk = 0; kk < 4; ++kk) { kv_[kk] = *(const f32x4*)(c_ + (size_t)(k0_ + kk) * KVR); rv_[kk] = r_[(size_t)(k0_ + kk) * 32]; } } while (0)
#define DC_COMPUTE(kv_, rv_) do { float sc[4]; \
        _Pragma("unroll") for (int kk = 0; kk < 4; ++kk) { float p[8]; \
            _Pragma("unroll") for (int h = 0; h < 8; ++h) p[h] = fmaf(ql[h][0], kv_[kk][0], fmaf(ql[h][1], kv_[kk][1], fmaf(ql[h][2], kv_[kk][2], fmaf(ql[h][3], kv_[kk][3], qr[h] * rv_[kk])))); \
              \
            const float a0 = swap32_add(p[0], p[4]), a1 = swap32_add(p[1], p[5]), a2 = swap32_add(p[2], p[6]), a3 = swap32_add(p[3], p[7]); \
            const float b0 = swap16_add(a0, a2), b1 = swap16_add(a1, a3); \
            const float c0 = b0 + dppf<0x128>(b0), c1 = b1 + dppf<0x128>(b1); \
            float v1 = (lane & 8) ? c1 : c0; \
            v1 += dppf<0xB1>(v1); v1 += dppf<0x4E>(v1); v1 += dppf<0x141>(v1); sc[kk] = v1; } \
        const float mx = fmaxf(fmaxf(sc[0], sc[1]), fmaxf(sc[2], sc[3])); \
        const float mn = fmaxf(m, mx), alpha = __builtin_amdgcn_exp2f(m - mn); m = mn; \
        float pe[4]; \
        _Pragma("unroll") for (int kk = 0; kk < 4; ++kk) pe[kk] = __builtin_amdgcn_exp2f(sc[kk] - mn); \
        l = l * alpha + ((pe[0] + pe[1]) + (pe[2] + pe[3])); \
        _Pragma("unroll") for (int h = 0; h < 8; ++h) { const int src = dlane_of(h); \
            const float ah = __int_as_float(__builtin_amdgcn_readlane(__float_as_int(alpha), src)), p0 = __int_as_float(__builtin_amdgcn_readlane(__float_as_int(pe[0]), src)), p1 = __int_as_float(__builtin_amdgcn_readlane(__float_as_int(pe[1]), src)), \
                        p2 = __int_as_float(__builtin_amdgcn_readlane(__float_as_int(pe[2]), src)), p3 = __int_as_float(__builtin_amdgcn_readlane(__float_as_int(pe[3]), src)); \
            O[h] = O[h] * ah + kv_[0] * p0 + kv_[1] * p1 + kv_[2] * p2 + kv_[3] * p3; } } while (0)
    f32x4 kvA[4], kvB[4], kvC[4]; float rvA[4], rvB[4], rvC[4];
#define DC_PIN() __builtin_amdgcn_sched_barrier(0)
    DC_LOAD(kvA, rvA, 0); DC_LOAD(kvB, rvB, 1); DC_PIN();
#pragma unroll 1
    for (int bi = 0; bi < 30; bi += 3) {
        DC_LOAD(kvC, rvC, bi + 2); DC_PIN();
        DC_COMPUTE(kvA, rvA); DC_PIN();
        DC_LOAD(kvA, rvA, bi + 3); DC_PIN();
        DC_COMPUTE(kvB, rvB); DC_PIN();
        DC_LOAD(kvB, rvB, bi + 4); DC_PIN();
        DC_COMPUTE(kvC, rvC); DC_PIN();
    }
    DC_COMPUTE(kvA, rvA);
    DC_COMPUTE(kvB, rvB);
#undef DC_PIN
#undef DC_LOAD
#undef DC_COMPUTE
    LAS float* wm = sh + 2304 + w * 16;
    LAS float* wo = sh + 2304 + 128 + w * 2048;
    { const int hd = 4 * (lane >> 5) + 2 * ((lane >> 4) & 1) + ((lane >> 3) & 1); if ((lane & 7) == 0) { wm[hd] = m; wm[8 + hd] = l; } }
#pragma unroll
    for (int h = 0; h < 8; ++h) *(LAS f32x4*)(wo + h * 256 + 4 * lane) = O[h];
    __syncthreads();
    float* part = (float*)(ws + WS_DPART) + (size_t)u * 8 * 264;
    for (int e = tid; e < 2048; e += 512) {
        const int h = e >> 8;
        float M = -INFINITY;
#pragma unroll
        for (int ww = 0; ww < 8; ++ww) M = fmaxf(M, sh[2304 + ww * 16 + h]);
        float acc = 0.f, L = 0.f;
#pragma unroll
        for (int ww = 0; ww < 8; ++ww) { const float f = __builtin_amdgcn_exp2f(sh[2304 + ww * 16 + h] - M); acc += f * sh[2304 + 128 + ww * 2048 + e]; L += f * sh[2304 + ww * 16 + 8 + h]; }
        __hip_atomic_store(part + h * 264 + (e & 255), acc, __ATOMIC_RELAXED, __HIP_MEMORY_SCOPE_AGENT);
        if ((e & 255) == 0) { __hip_atomic_store(part + h * 264 + 256, M, __ATOMIC_RELAXED, __HIP_MEMORY_SCOPE_AGENT); __hip_atomic_store(part + h * 264 + 257, L, __ATOMIC_RELAXED, __HIP_MEMORY_SCOPE_AGENT); }
    }
    asm volatile("s_waitcnt vmcnt(0)" ::: "memory");
    __syncthreads();
    if (tid == 0) (void)__hip_atomic_fetch_add((unsigned*)(ws + WS_CTL) + CW_DCNT + 16 * s, 1u, __ATOMIC_RELAXED, __HIP_MEMORY_SCOPE_AGENT);
}
__device__ __forceinline__ void decode_combine_unit(Frame& F, const Ptrs& a, int u) {
    unsigned char* ws = opaque_g(a.ws);
    const int tid = fresh_tid(F.wave), lane = tid & 63, s = u >> 3, h = u & 7, row = ROW_SMP + s;
    LAS float* sh = (LAS float*)(F.lds + RING_OFF);
    const bf16* QA = (const bf16*)(ws + WS_QA) + (size_t)row * 768;
    const float* part = (const float*)(ws + WS_DPART) + (size_t)s * 16 * 8 * 264;
    if (tid == 0) { const unsigned* cn = (const unsigned*)(ws + WS_CTL) + CW_DCNT + 16 * s; unsigned spins = 0;
        while (__hip_atomic_load(cn, __ATOMIC_RELAXED, __HIP_MEMORY_SCOPE_AGENT) < 16u && ++spins < (1u << 22)) __builtin_amdgcn_s_sleep(8);
        __builtin_amdgcn_fence(__ATOMIC_ACQUIRE, "agent"); asm volatile("s_waitcnt vmcnt(0)" ::: "memory"); }
    __syncthreads();
    if (tid < 64) { const bf16* KNr = (const bf16*)(ws + WS_KN) + (size_t)row * 512;
        float acc = __uint_as_float((unsigned)QA[h * 96 + lane] << 16) * __uint_as_float((unsigned)KNr[h * 64 + lane] << 16);
        if (lane < 32) acc += __uint_as_float((unsigned)QA[h * 96 + 64 + lane] << 16) * ((const float*)(ws + WS_KRF))[(size_t)row * 32 + lane];
#pragma unroll
        for (int off = 32; off > 0; off >>= 1) acc += lx(acc, lane, off);
        if (lane == 0) sh[256] = acc; }
    __syncthreads();
    if (tid < 256) {
        const int r = tid;
        const float sn = sh[256];
        float pm[16];
#pragma unroll
        for (int p = 0; p < 16; ++p) pm[p] = part[(p * 8 + h) * 264 + 256];
        float M = sn;
#pragma unroll
        for (int p = 0; p < 16; ++p) M = fmaxf(M, pm[p]);
        const float rkv = row_rscale4((const float*)(ws + WS_SSQKV), row, 1.f / KVR);
        const float cn = ((const float*)(ws + WS_CKVF))[(size_t)row * KVR + r] * rkv * a.in(14)[r];
        const float fn = __builtin_amdgcn_exp2f(sn - M);
        float acc = fn * cn, Lq = fn;
#pragma unroll
        for (int p = 0; p < 16; ++p) { const float f = __builtin_amdgcn_exp2f(pm[p] - M); acc += f * part[(p * 8 + h) * 264 + r]; Lq += f * part[(p * 8 + h) * 264 + 257]; }
        sh[r] = acc / Lq;
    }
    __syncthreads();
    { const int v = tid & 63, rg = tid >> 6; const float* wuv = a.in(17) + (size_t)(32 * rg) * 512 + h * 64 + v;
      float wv[32];
#pragma unroll
      for (int k = 0; k < 32; ++k) wv[k] = wuv[(size_t)k * 512];
      float acc = 0.f;
#pragma unroll
      for (int k = 0; k < 32; ++k) acc += sh[32 * rg + k] * wv[k];
      sh[264 + rg * 64 + v] = acc; }
    __syncthreads();
    if (tid < 64) { float acc = 0.f;
#pragma unroll
        for (int rg = 0; rg < 8; ++rg) acc += sh[264 + rg * 64 + tid];
        ((bf16*)(ws + WS_AV))[(size_t)row * 512 + h * 64 + tid] = bf1(acc); }
    __syncthreads();
}
}
namespace mk {
constexpr size_t WS_TMP = WS_ACT;
constexpr size_t WS_MX = WS_RQ;
constexpr size_t WS_H2B = WS_MX + al((size_t)MP * 1024 * 2);
constexpr size_t WS_H2 = WS_UT;
constexpr size_t WS_SSQH2 = WS_SSQ2_, WS_SSQH3 = WS_SSQ3_;
constexpr size_t WS_H3 = WS_H;
constexpr size_t WS_END6 = WS_END4;
static_assert(WS_H2B + (size_t)MP * 1024 * 2 <= WS_SRG && WS_H2 + (size_t)MP * 1024 * 4 <= WS_RIN && (size_t)MP * 1024 * 4 <= (size_t)MP * FFN * 2, "overlays");
static_assert(WS_END6 < ((size_t)1 << 31), "32-bit workspace offsets");

template <int STEP, unsigned GATE_OFF> struct EpiGate {
    static constexpr bool PERM = false, AFTER_DRAIN = false;
    unsigned char* ws_;
    __device__ __forceinline__ void operator()(const f32x4 (&acc)[2][2][4][2], const Unit& u, int wr, int wc, int fr, int fq) const {
        int l_ = lane_fresh(); asm volatile("" : "+v"(l_)); fr = l_ & 15; fq = l_ >> 4;
        unsigned char* w = opaque_g(ws_);
        const unsigned row0 = u.pm * BM + wr * 64 + fr, col0 = u.pn * BM + wc * 32 + 4 * fq;
#pragma unroll
        for (int ai = 0; ai < 2; ++ai)
#pragma unroll
            for (int m = 0; m < 4; ++m) { unsigned row = row0 + ai * HALF + m * 16; asm volatile("" : "+v"(row));
#pragma unroll
                for (int bj = 0; bj < 2; ++bj)
#pragma unroll
                    for (int n = 0; n < 2; ++n) { const unsigned e = row * 1024 + col0 + bj * HALF + n * 16;
                        const u32x2 gw = *at<const u32x2>(w, GATE_OFF + e * 2);
                        f32x4 g; g[0] = __uint_as_float(gw.x << 16); g[1] = __uint_as_float(gw.x & 0xffff0000u); g[2] = __uint_as_float(gw.y << 16); g[3] = __uint_as_float(gw.y & 0xffff0000u);
                        f32x4 o = acc[ai][bj][m][n] * g;
                        if (STEP == 0) *at<f32x4>(w, (unsigned)WS_TMP + e * 4) = o;
                        else { o = o + *at<const f32x4>(w, (unsigned)WS_TMP + e * 4); *at<u32x2>(w, (unsigned)WS_MX + e * 2) = pack4(o); } }
                asm volatile("" ::: "memory"); }
    }
};
struct EpiSwiGLU2 {
    static constexpr bool PERM = true, AFTER_DRAIN = false;
    unsigned char* ws_;
    __device__ __forceinline__ void operator()(const f32x4 (&acc)[2][2][4][2], const Unit& u, int wr, int wc, int fr, int fq) const {
        int l_ = lane_fresh(); asm volatile("" : "+v"(l_)); fr = l_ & 15; fq = l_ >> 4;
        unsigned char* w = opaque_g(ws_);
        const unsigned row0 = u.pm * BM + wr * 64 + fr, col0 = u.pn * HALF + wc * 32 + 8 * fq;
#pragma unroll
        for (int ai = 0; ai < 2; ++ai)
#pragma unroll
            for (int m = 0; m < 4; ++m) { unsigned row = row0 + ai * HALF + m * 16; asm volatile("" : "+v"(row));
                const float r = row_rscale16(at<const float>(w, (unsigned)WS_SSQH2), (int)row, 1.f / D);
                f32x4 o[2];
#pragma unroll
                for (int n = 0; n < 2; ++n)
#pragma unroll
                    for (int j = 0; j < 4; ++j) { const float g = acc[ai][0][m][n][j] * r, up = acc[ai][1][m][n][j] * r; o[n][j] = fast_silu(g) * up; }
                u32x4 pk; pk.x = pg8::cvt_pk_bf16(o[0][0], o[0][1]); pk.y = pg8::cvt_pk_bf16(o[0][2], o[0][3]); pk.z = pg8::cvt_pk_bf16(o[1][0], o[1][1]); pk.w = pg8::cvt_pk_bf16(o[1][2], o[1][3]);
                *at<u32x4>(w, (unsigned)WS_ACT + (row * FFN + col0) * 2) = pk;
                asm volatile("" ::: "memory"); }
    }
};
__device__ __forceinline__ void final_norm_phase(Frame& F, const Ptrs& a) {
    const int lane = fresh_tid(F.wave) & 63;
    const int gw = F.vcu * NWAVES + F.wave, NGW = F.G * NWAVES;
    const float* H3 = (const float*)(a.ws + WS_H3); const float* SSQ = (const float*)(a.ws + WS_SSQH3);
    f32x4 g[4];
#pragma unroll
    for (int j = 0; j < 4; ++j) g[j] = *((const f32x4*)a.in(26) + lane + 64 * j);
    for (int row0 = gw; row0 < ROW_PAD; row0 += 2 * NGW) {
        f32x4 v[2][4]; float r[2];
#pragma unroll
        for (int t = 0; t < 2; ++t) { const int row = row0 + t * NGW; const bool ok = row < ROW_PAD && !(row >= MMAIN && row < ROW_SMP);
            r[t] = ok ? row_rscale16(SSQ, row, 1.f / D) : 0.f;
#pragma unroll
            for (int j = 0; j < 4; ++j) v[t][j] = ok ? *((const f32x4*)(H3 + (size_t)row * D) + lane + 64 * j) : (f32x4){0.f, 0.f, 0.f, 0.f}; }
#pragma unroll
        for (int t = 0; t < 2; ++t) { const int row = row0 + t * NGW; if (row >= ROW_PAD || (row >= MMAIN && row < ROW_SMP)) continue;
            float* dst = row < MMAIN ? a.out() + OUT_YP + (size_t)row * D : a.out() + OUT_YS + (size_t)(row - ROW_SMP) * D;
#pragma unroll
            for (int j = 0; j < 4; ++j) *((f32x4*)dst + lane + 64 * j) = v[t][j] * r[t] * g[j]; }
    }
}
}
namespace mk {
typedef float f32x4_t __attribute__((ext_vector_type(4)));
constexpr int XROW0 = MMAIN, SK_C = 64 * 64;
__device__ __forceinline__ void skinny64(int wave, int tid, const bf16* A, int K, const bf16* Bt, int brow0, LAS float* P, float (&out)[8]) {
    const int lane = tid & 63, r16 = lane & 15, kq = lane >> 4;
    const bf16* ap = A + (size_t)(XROW0 + r16) * K + 8 * kq;
    const bf16* bp = Bt + (size_t)(brow0 + r16) * K + 8 * kq;
    f32x4 acc[4][4];
#pragma unroll
    for (int mf = 0; mf < 4; ++mf)
#pragma unroll
        for (int nf = 0; nf < 4; ++nf) acc[mf][nf] = (f32x4){0.f, 0.f, 0.f, 0.f};
    const int KS = K / 32;
    bf16x8 a0[4], b0[4], a1[4], b1[4], a2[4], b2[4];
#define SK_LOAD(a_, b_, kk_) do { _Pragma("unroll") for (int f = 0; f < 4; ++f) { a_[f] = *(const bf16x8*)(ap + (size_t)(16 * f) * K + 32 * (kk_)); b_[f] = *(const bf16x8*)(bp + (size_t)(16 * f) * K + 32 * (kk_)); } } while (0)
#define SK_MMA(a_, b_) do { _Pragma("unroll") for (int mf = 0; mf < 4; ++mf) _Pragma("unroll") for (int nf = 0; nf < 4; ++nf) acc[mf][nf] = __builtin_amdgcn_mfma_f32_16x16x32_bf16(a_[mf], b_[nf], acc[mf][nf], 0, 0, 0); } while (0)
    int kk = wave;
    if (kk < KS) SK_LOAD(a0, b0, kk);
    if (kk + 8 < KS) SK_LOAD(a1, b1, kk + 8);
    if (kk + 16 < KS) SK_LOAD(a2, b2, kk + 16);
    for (; kk < KS; kk += 24) {
        SK_MMA(a0, b0); if (kk + 24 < KS) SK_LOAD(a0, b0, kk + 24);
        if (kk + 8 < KS) { SK_MMA(a1, b1); if (kk + 32 < KS) SK_LOAD(a1, b1, kk + 32); }
        if (kk + 16 < KS) { SK_MMA(a2, b2); if (kk + 40 < KS) SK_LOAD(a2, b2, kk + 40); }
    }
#undef SK_LOAD
#undef SK_MMA
    LAS float* Pw = P + wave * SK_C;
#pragma unroll
    for (int mf = 0; mf < 4; ++mf)
#pragma unroll
        for (int nf = 0; nf < 4; ++nf)
#pragma unroll
            for (int i = 0; i < 4; ++i) Pw[(16 * mf + 4 * kq + i) * 64 + 16 * nf + r16] = acc[mf][nf][i];
    __syncthreads();
    const LAS float* pr = P + (tid >> 3) * 64 + 8 * (tid & 7);
    f32x4 s0 = *(const LAS f32x4*)pr, s1 = *(const LAS f32x4*)(pr + 4);
#pragma unroll
    for (int w = 1; w < 8; ++w) { s0 = s0 + *(const LAS f32x4*)(pr + w * SK_C); s1 = s1 + *(const LAS f32x4*)(pr + w * SK_C + 4); }
    out[0] = s0[0]; out[1] = s0[1]; out[2] = s0[2]; out[3] = s0[3]; out[4] = s1[0]; out[5] = s1[1]; out[6] = s1[2]; out[7] = s1[3];
    __syncthreads();
}
__device__ __forceinline__ float sum8(float v, int lane) { v += lx(v, lane, 1); v += lx(v, lane, 2); v += lx(v, lane, 4); return v; }
__device__ __forceinline__ void st8_bf16(bf16* p, const float* v) { u32x4 w; w.x = pg8::cvt_pk_bf16(v[0], v[1]); w.y = pg8::cvt_pk_bf16(v[2], v[3]); w.z = pg8::cvt_pk_bf16(v[4], v[5]); w.w = pg8::cvt_pk_bf16(v[6], v[7]); *(u32x4*)p = w; }
__device__ __forceinline__ void ld8(const LAS float* p, float* v) { const f32x4 a = *(const LAS f32x4*)p, b = *(const LAS f32x4*)(p + 4); v[0] = a[0]; v[1] = a[1]; v[2] = a[2]; v[3] = a[3]; v[4] = b[0]; v[5] = b[1]; v[6] = b[2]; v[7] = b[3]; }

__device__ __forceinline__ void xjob_ffn_up(Frame& F, unsigned char* ws, int j, size_t a_off, size_t w_off, int rs_mode) {
    ws = opaque_g(ws);
    const int tid = fresh_tid(F.wave);
    LAS float* P = (LAS float*)(F.lds + RING_OFF);
    const int brow0 = 256 * (j >> 1) + 64 * (j & 1);
    float g[8], u[8], o[8];
    skinny64(F.wave, tid, (const bf16*)(ws + a_off), D, (const bf16*)(ws + w_off), brow0, P, g);
    skinny64(F.wave, tid, (const bf16*)(ws + a_off), D, (const bf16*)(ws + w_off), brow0 + 128, P, u);
    const int r = tid >> 3, cg = tid & 7, row = XROW0 + r;
    const float rs = rs_mode == 0 ? ((const float*)(ws + WS_R1))[row] : row_rscale16((const float*)(ws + WS_SSQH2), row, 1.f / D);
#pragma unroll
    for (int k = 0; k < 8; ++k) o[k] = fast_silu(g[k] * rs) * (u[k] * rs);
    st8_bf16((bf16*)(ws + WS_ACT) + (size_t)row * FFN + 64 * j + 8 * cg, o);
}
__device__ __forceinline__ void xjob_resid(Frame& F, unsigned char* ws, int j, size_t a_off, int K, size_t w_off, const float* res  , float scale, size_t out_off, size_t outb_off, size_t ssq_off) {
    ws = opaque_g(ws);
    const int tid = fresh_tid(F.wave), lane = tid & 63;
    LAS float* P = (LAS float*)(F.lds + RING_OFF);
    float v[8], o[8];
    skinny64(F.wave, tid, (const bf16*)(ws + a_off), K, (const bf16*)(ws + w_off), 64 * j, P, v);
    const int r = tid >> 3, cg = tid & 7, row = XROW0 + r, col = 64 * j + 8 * cg;
    const f32x4 b0 = *(const f32x4*)(res + (size_t)r * D + col), b1 = *(const f32x4*)(res + (size_t)r * D + col + 4);
    float ss = 0.f;
#pragma unroll
    for (int k = 0; k < 8; ++k) { o[k] = (k < 4 ? b0[k] : b1[k - 4]) + scale * v[k]; ss += o[k] * o[k]; }
    float* op = (float*)(ws + out_off) + (size_t)row * D + col;
    *(f32x4*)op = (f32x4){o[0], o[1], o[2], o[3]}; *(f32x4*)(op + 4) = (f32x4){o[4], o[5], o[6], o[7]};
    if (outb_off) st8_bf16((bf16*)(ws + outb_off) + (size_t)row * D + col, o);
    ss = sum8(ss, lane);
    if (cg == 0) atomicAdd((float*)(ws + ssq_off) + row, ss);
}
__device__ __forceinline__ void xjob_win(Frame& F, unsigned char* ws, int j) {
    ws = opaque_g(ws);
    const int tid = fresh_tid(F.wave), lane = tid & 63;
    LAS float* P = (LAS float*)(F.lds + RING_OFF);
    const int pn = j >> 1, q = j & 1;
    float v0[8], v1[8];
    skinny64(F.wave, tid, (const bf16*)(ws + WS_HB), D, (const bf16*)(ws + WS_WIN), 256 * pn + 64 * q, P, v0);
    skinny64(F.wave, tid, (const bf16*)(ws + WS_HB), D, (const bf16*)(ws + WS_WIN), 256 * pn + 64 * q + 128, P, v1);
    const int r = tid >> 3, cg = tid & 7, row = XROW0 + r;
    const float rs = row_rscale16((const float*)(ws + WS_SSQH), row, 1.f / D);
    const float* TAB = (const float*)(ws + WS_TAB);
#pragma unroll
    for (int k = 0; k < 8; ++k) { v0[k] *= rs; v1[k] *= rs; }
    const int tc0 = 64 * q + 8 * cg;
    if (pn == 0) {
        bf16* CQ = (bf16*)(ws + WS_CQ) + (size_t)row * QR; float* SSQCQ = (float*)(ws + WS_SSQCQ) + (size_t)row * 8;
        st8_bf16(CQ + tc0, v0); st8_bf16(CQ + tc0 + 128, v1);
        float s0 = 0.f, s1 = 0.f;
#pragma unroll
        for (int k = 0; k < 8; ++k) { s0 += v0[k] * v0[k]; s1 += v1[k] * v1[k]; }
        s0 = sum8(s0, lane); s1 = sum8(s1, lane);
        if (cg == 0) { SSQCQ[2 * q] = s0; SSQCQ[2 * q + 1] = s1; }
    } else if (pn == 1) {
        bf16* CQ = (bf16*)(ws + WS_CQ) + (size_t)row * QR; float* SSQCQ = (float*)(ws + WS_SSQCQ) + (size_t)row * 8;
        st8_bf16(CQ + 256 + tc0, v0);
        float s0 = 0.f;
#pragma unroll
        for (int k = 0; k < 8; ++k) s0 += v0[k] * v0[k];
        s0 = sum8(s0, lane);
        if (cg == 0) { SSQCQ[4 + q] = s0; SSQCQ[6 + q] = 0.f; }
        float x2[8];
#pragma unroll
        for (int k = 0; k < 8; ++k) x2[k] = lx(v1[k], lane, 2);
        if (q == 0 && cg < 2) {
            const int pi = row_pidx(row), i0 = 8 * cg;
            float y1[8], y2[8];
#pragma unroll
            for (int k = 0; k < 8; ++k) { const float c = TAB[TAB_C16 / 4 + pi * 16 + i0 + k], s = TAB[TAB_S16 / 4 + pi * 16 + i0 + k]; y1[k] = v1[k] * c - x2[k] * s; y2[k] = v1[k] * s + x2[k] * c; }
            st8_bf16((bf16*)(ws + WS_KRB) + (size_t)row * 32 + i0, y1); st8_bf16((bf16*)(ws + WS_KRB) + (size_t)row * 32 + 16 + i0, y2);
            float* kf = (float*)(ws + WS_KRF) + (size_t)row * 32;
#pragma unroll
            for (int k = 0; k < 8; ++k) { kf[i0 + k] = y1[k]; kf[16 + i0 + k] = y2[k]; }
        }
    } else if (pn == 2) {
        float* CKVF = (float*)(ws + WS_CKVF) + (size_t)row * KVR; bf16* CKVB = (bf16*)(ws + WS_CKVB) + (size_t)row * KVR; float* SSQKV = (float*)(ws + WS_SSQKV) + (size_t)row * 4;
        float s0 = 0.f, s1 = 0.f;
#pragma unroll
        for (int k = 0; k < 8; ++k) { CKVF[tc0 + k] = v0[k]; CKVF[tc0 + 128 + k] = v1[k]; s0 += v0[k] * v0[k]; s1 += v1[k] * v1[k]; }
        st8_bf16(CKVB + tc0, v0); st8_bf16(CKVB + tc0 + 128, v1);
        s0 = sum8(s0, lane); s1 = sum8(s1, lane);
        if (cg == 0) { SSQKV[2 * q] = s0; SSQKV[2 * q + 1] = s1; }
    } else if (pn < 7) {
        const bool isk = pn >= 5; const int hh = 2 * ((pn - 3) & 1) + q, i0 = 8 * cg;
        const int pi = row_pidx(row), jt = row_jtok(row);
        const float mult = isk ? RK_SCALE * TAB[TAB_GN / 4 + hh * 128 + jt] : TAB[TAB_GP / 4 + hh * 128 + jt];
        float y1[8], y2[8];
#pragma unroll
        for (int k = 0; k < 8; ++k) { const float c = TAB[TAB_C64 / 4 + pi * 64 + i0 + k], s = TAB[TAB_S64 / 4 + pi * 64 + i0 + k]; y1[k] = (v0[k] * c - v1[k] * s) * mult; y2[k] = (v0[k] * s + v1[k] * c) * mult; }
        bf16* dst = (bf16*)(ws + (isk ? WS_RK : WS_RQ)) + (size_t)row * 512 + hh * 128;
        st8_bf16(dst + i0, y1); st8_bf16(dst + 64 + i0, y2);
        if (isk) { bf16* RKT = (bf16*)(ws + WS_RKT);
#pragma unroll
            for (int k = 0; k < 8; ++k) { RKT[(size_t)(hh * 128 + i0 + k) * MP + row] = bf1(y1[k]); RKT[(size_t)(hh * 128 + 64 + i0 + k) * MP + row] = bf1(y2[k]); } }
    } else if (pn < 11) {
        bf16* RVT = (bf16*)(ws + WS_RVT);
#pragma unroll
        for (int k = 0; k < 8; ++k) { RVT[(size_t)((pn - 7) * 256 + tc0 + k) * MP + row] = bf1(v0[k]); RVT[(size_t)((pn - 7) * 256 + tc0 + 128 + k) * MP + row] = bf1(v1[k]); }
    } else {
        const int t = (pn - 11) >> 2; bf16* dst = (bf16*)(ws + WS_SRG + (size_t)t * (WS_SGA - WS_SRG)) + (size_t)row * 1024 + ((pn - 11) & 3) * 256;
        float o0[8], o1[8];
#pragma unroll
        for (int k = 0; k < 8; ++k) { const float g0 = fast_sigmoid(v0[k]), g1 = fast_sigmoid(v1[k]); o0[k] = t == 0 ? v0[k] * g0 : g0; o1[k] = t == 0 ? v1[k] * g1 : g1; }
        st8_bf16(dst + tc0, o0); st8_bf16(dst + tc0 + 128, o1);
    }
}
__device__ __forceinline__ void xjob_q(Frame& F, unsigned char* ws, int j) {
    ws = opaque_g(ws);
    const int tid = fresh_tid(F.wave), lane = tid & 63;
    LAS float* P = (LAS float*)(F.lds + RING_OFF);
    float v[8], p[8], o[8];
    skinny64(F.wave, tid, (const bf16*)(ws + WS_CQ), QR, (const bf16*)(ws + WS_WUQ), 64 * j, P, v);
    const int r = tid >> 3, cg = tid & 7, row = XROW0 + r;
    const float rs = row_rscale8((const float*)(ws + WS_SSQCQ), row, 1.f / QR) * SC_Q;
    const float* TAB = (const float*)(ws + WS_TAB);
    const int pi = row_pidx(row), col = 64 * j + 8 * cg, grp = col >> 5, w32 = col & 31;
#pragma unroll
    for (int k = 0; k < 8; ++k) p[k] = lx(v[k], lane, 2);
    if (grp % 3 == 2) {
        const int i0 = w32 & 15;
#pragma unroll
        for (int k = 0; k < 8; ++k) { const float c = TAB[TAB_C16 / 4 + pi * 16 + i0 + k], sn = TAB[TAB_S16 / 4 + pi * 16 + i0 + k];
            o[k] = (w32 < 16 ? v[k] * c - p[k] * sn : p[k] * sn + v[k] * c) * rs; }
    } else {
#pragma unroll
        for (int k = 0; k < 8; ++k) o[k] = v[k] * rs;
    }
    st8_bf16((bf16*)(ws + WS_QA) + (size_t)row * 768 + col, o);
}
__device__ __forceinline__ void xjob_kv(Frame& F, unsigned char* ws, int j, bool is_v) {
    ws = opaque_g(ws);
    const int tid = fresh_tid(F.wave);
    LAS float* P = (LAS float*)(F.lds + RING_OFF);
    float v[8];
    skinny64(F.wave, tid, (const bf16*)(ws + WS_CKVB), KVR, (const bf16*)(ws + (is_v ? WS_WUV : WS_WUK)), 64 * j, P, v);
    const int r = tid >> 3, cg = tid & 7, row = XROW0 + r, col = 64 * j + 8 * cg;
    const float rs = row_rscale4((const float*)(ws + WS_SSQKV), row, 1.f / KVR);
#pragma unroll
    for (int k = 0; k < 8; ++k) v[k] *= rs;
    if (!is_v) st8_bf16((bf16*)(ws + WS_KN) + (size_t)row * 512 + col, v);
    else { bf16* VT = (bf16*)(ws + WS_VT);
#pragma unroll
        for (int k = 0; k < 8; ++k) VT[(size_t)(col + k) * MP + row] = bf1(v[k]); }
}
__device__ __forceinline__ void xjob_mix(Frame& F, unsigned char* ws, int j) {
    ws = opaque_g(ws);
    const int tid = fresh_tid(F.wave);
    LAS float* P = (LAS float*)(F.lds + RING_OFF);
    float a[8], b[8], o[8];
    skinny64(F.wave, tid, (const bf16*)(ws + WS_AV), 512, (const bf16*)(ws + WS_WMO), 64 * j, P, a);
    skinny64(F.wave, tid, (const bf16*)(ws + WS_RIN), D, (const bf16*)(ws + WS_WRO), 64 * j, P, b);
    const int r = tid >> 3, cg = tid & 7, row = XROW0 + r, col = 64 * j + 8 * cg;
    const u32x4 ga = *(const u32x4*)((const bf16*)(ws + WS_SGA) + (size_t)row * 1024 + col), gb = *(const u32x4*)((const bf16*)(ws + WS_SGB) + (size_t)row * 1024 + col);
#pragma unroll
    for (int k = 0; k < 8; ++k) { const unsigned wa = ga[k >> 1], wb = gb[k >> 1];
        const float fa = __uint_as_float((k & 1) ? (wa & 0xffff0000u) : (wa << 16)), fb = __uint_as_float((k & 1) ? (wb & 0xffff0000u) : (wb << 16));
        o[k] = fa * a[k] + fb * b[k]; }
    st8_bf16((bf16*)(ws + WS_MX) + (size_t)row * 1024 + col, o);
}
__device__ __forceinline__ void xjob_ql(Frame& F, unsigned char* ws, int j) {
    ws = opaque_g(ws);
    const int tid = fresh_tid(F.wave);
    LAS float* P = (LAS float*)(F.lds + RING_OFF);
    float v[8];
    skinny64(F.wave, tid, (const bf16*)(ws + WS_CQ), QR, (const bf16*)(ws + WS_WQL), 64 * j, P, v);
    const int r = tid >> 3, cg = tid & 7, row = XROW0 + r;
    const float rs = row_rscale8((const float*)(ws + WS_SSQCQ), row, 1.f / QR) * SC_Q;
    float* dst = (float*)(ws + WS_QL) + (size_t)r * 2048 + 64 * j + 8 * cg;
    *(f32x4*)dst = (f32x4){v[0] * rs, v[1] * rs, v[2] * rs, v[3] * rs}; *(f32x4*)(dst + 4) = (f32x4){v[4] * rs, v[5] * rs, v[6] * rs, v[7] * rs};
}
}
namespace mk {
constexpr int RC_STR = 272;
constexpr int RC_S = 0, RC_KT = 0  , RC_Q = 256 * RC_STR, RC_A = RC_Q + 128 * RC_STR, RC_RED = RC_A + 128 * RC_STR, RC_END = RC_RED + 2 * 8 * 128 * 4;
static_assert(RC_END <= SCR_BYTES, "chain LDS map");
__device__ __forceinline__ void ret_chain_unit(Frame& F, const Ptrs& a, int bh) {
    unsigned char* ws = a.ws; ws = opaque_g(ws);
    const int tid_k = fresh_tid(F.wave), w = F.wave;
    const int hh = bh & 3, b = bh >> 2;
    LAS unsigned char* L = F.lds + RING_OFF;
    LAS float* red = (LAS float*)(L + RC_RED);
    const bf16* RQ = (const bf16*)(ws + WS_RQ); const bf16* RK = (const bf16*)(ws + WS_RK); const bf16* RKT = (const bf16*)(ws + WS_RKT); const bf16* RVT = (const bf16*)(ws + WS_RVT);
    const float g = gpow_t(ws, hh, 1), g127 = gpow_t(ws, hh, 127);
    f32x16 S[4];
    {
        const int lane = tid_k & 63, r32 = lane & 31, half = lane >> 5;
#pragma unroll
        for (int db = 0; db < 4; ++db)
#pragma unroll
            for (int i = 0; i < 16; ++i) S[db][i] = 0.f;
        const bf16x8 af = *(const bf16x8*)(RVT + (size_t)(hh * 256 + 32 * w + r32) * MP + ROW_META + 8 * half);
#pragma unroll
        for (int db = 0; db < 4; ++db) { const bf16x8 bf = *(const bf16x8*)(RKT + (size_t)(hh * 128 + 32 * db + r32) * MP + ROW_META + 8 * half); S[db] = __builtin_amdgcn_mfma_f32_32x32x16_bf16(af, bf, S[db], 0, 0, 0); }
        const float sc = gpow_t(ws, hh, NMETA - 1);
#pragma unroll
        for (int db = 0; db < 4; ++db)
#pragma unroll
            for (int i = 0; i < 16; ++i) S[db][i] *= sc;
    }
    v4u qreg[4], jreg[4];
#define RC_FETCH_QK(tok0_) do { _Pragma("unroll") for (int k = 0; k < 4; ++k) { const int ch = tid + 512 * k; \
        qreg[k] = *(const v4u*)(RQ + (size_t)((tok0_) + (ch >> 4)) * 512 + hh * 128 + 8 * (ch & 15)); jreg[k] = *(const v4u*)(RK + (size_t)((tok0_) + (ch >> 4)) * 512 + hh * 128 + 8 * (ch & 15)); } } while (0)
    { const int tid = tid_k; RC_FETCH_QK(b * SEQ); }
#define RC_BLK_IB(n) ((n) < 1 ? 0 : (n) < 3 ? 1 : (n) < 6 ? 2 : 3)
#define RC_BLK_JB(n) ((n) - ((n) < 1 ? 0 : (n) < 3 ? 1 : (n) < 6 ? 3 : 6))
#pragma unroll 1
    for (int c = 0; c < 16; ++c) {
        const int tok0 = b * SEQ + c * 128;
        int tid_c = tid_k; asm volatile("" : "+v"(tid_c));
        const int tid = tid_c, lane = tid & 63, r32 = lane & 31, half = lane >> 5;
#pragma unroll
        for (int k = 0; k < 4; ++k) { const int ch = tid + 512 * k; *(LAS v4u*)(L + RC_Q + (ch >> 4) * RC_STR + 16 * (ch & 15)) = qreg[k]; *(LAS v4u*)(L + RC_S + (ch >> 4) * RC_STR + 16 * (ch & 15)) = jreg[k]; }
        __syncthreads();
        v4u kreg[4];
#pragma unroll
        for (int k = 0; k < 4; ++k) { const int ch = tid + 512 * k; kreg[k] = *(const v4u*)(RKT + (size_t)(hh * 128 + (ch >> 4)) * MP + tok0 + 8 * (ch & 15)); }
        for (int n = w; n < 10; n += 8) {
            const int ib_ = RC_BLK_IB(n), jb_ = RC_BLK_JB(n);
            f32x16 at;
#pragma unroll
            for (int i = 0; i < 16; ++i) at[i] = 0.f;
#pragma unroll
            for (int s = 0; s < 8; ++s) { const bf16x8 kf = *(const LAS bf16x8*)(L + RC_S + (32 * jb_ + r32) * RC_STR + (16 * s + 8 * half) * 2); const bf16x8 qf = *(const LAS bf16x8*)(L + RC_Q + (32 * ib_ + r32) * RC_STR + (16 * s + 8 * half) * 2); at = __builtin_amdgcn_mfma_f32_32x32x16_bf16(kf, qf, at, 0, 0, 0); }
            if (jb_ == ib_) {
#pragma unroll
                for (int i = 0; i < 16; ++i) if (crow(i, half) > r32) at[i] = 0.f; }
#pragma unroll
            for (int gq = 0; gq < 4; ++gq) { f32x4 o_; o_[0] = at[4 * gq]; o_[1] = at[4 * gq + 1]; o_[2] = at[4 * gq + 2]; o_[3] = at[4 * gq + 3];
                *(LAS u32x2*)(L + RC_A + (32 * ib_ + r32) * RC_STR + (32 * jb_ + 8 * gq + 4 * half) * 2) = pack4(o_); }
        }
        __syncthreads();
#pragma unroll
        for (int db = 0; db < 4; ++db)
#pragma unroll
            for (int i = 0; i < 16; ++i) *(LAS bf16*)(L + RC_S + (32 * w + crow(i, half)) * RC_STR + (32 * db + r32) * 2) = bf1(S[db][i]);
        f32x16 ot[4];
#pragma unroll
        for (int ib = 0; ib < 4; ++ib)
#pragma unroll
            for (int i = 0; i < 16; ++i) ot[ib][i] = 0.f;
#pragma unroll 2
        for (int s = 0; s < 8; ++s) {
            const bf16x8 sf = *(const LAS bf16x8*)(L + RC_S + (32 * w + r32) * RC_STR + (16 * s + 8 * half) * 2);
#pragma unroll
            for (int ib = 0; ib < 4; ++ib) { const bf16x8 qf = *(const LAS bf16x8*)(L + RC_Q + (32 * ib + r32) * RC_STR + (16 * s + 8 * half) * 2); ot[ib] = __builtin_amdgcn_mfma_f32_32x32x16_bf16(sf, qf, ot[ib], 0, 0, 0); }
        }
#pragma unroll
        for (int ib = 0; ib < 4; ++ib)
#pragma unroll
            for (int i = 0; i < 16; ++i) ot[ib][i] *= g;
        __syncthreads();
#pragma unroll
        for (int k = 0; k < 4; ++k) { const int ch = tid + 512 * k; *(LAS v4u*)(L + RC_KT + (ch >> 4) * RC_STR + 16 * (ch & 15)) = kreg[k]; }
        __syncthreads();
        if (c < 15) RC_FETCH_QK(tok0 + 128);
#pragma unroll
        for (int db = 0; db < 4; ++db)
#pragma unroll
            for (int i = 0; i < 16; ++i) S[db][i] *= g;
        {
            const bf16* vp = RVT + (size_t)(hh * 256 + 32 * w + r32) * MP + tok0 + 8 * half;
            bf16x8 v0 = *(const bf16x8*)(vp), v1 = *(const bf16x8*)(vp + 16), v2 = v1;
#pragma unroll 1
            for (int s = 0; s < 8; ++s) {
                if (s + 2 < 8) v2 = *(const bf16x8*)(vp + 16 * (s + 2));
#pragma unroll
                for (int ib = 0; ib < 4; ++ib) if (s < 2 * (ib + 1)) { const bf16x8 af = *(const LAS bf16x8*)(L + RC_A + (32 * ib + r32) * RC_STR + (16 * s + 8 * half) * 2); ot[ib] = __builtin_amdgcn_mfma_f32_32x32x16_bf16(v0, af, ot[ib], 0, 0, 0); }
#pragma unroll
                for (int db = 0; db < 4; ++db) { const bf16x8 kf = *(const LAS bf16x8*)(L + RC_KT + (32 * db + r32) * RC_STR + (16 * s + 8 * half) * 2); S[db] = __builtin_amdgcn_mfma_f32_32x32x16_bf16(v0, kf, S[db], 0, 0, 0); }
                v0 = v1; v1 = v2;
            }
        }
#pragma unroll
        for (int db = 0; db < 4; ++db)
#pragma unroll
            for (int i = 0; i < 16; ++i) S[db][i] *= g127;
#pragma unroll
        for (int ib = 0; ib < 4; ++ib) { float t = 0.f;
#pragma unroll
            for (int i = 0; i < 16; ++i) t += ot[ib][i];
            t += lx(t, lane, 32); if (half == 0) red[w * 128 + 32 * ib + r32] = t; }
        __syncthreads();
        float mu[4];
#pragma unroll
        for (int ib = 0; ib < 4; ++ib) { float t = 0.f;
#pragma unroll
            for (int ww = 0; ww < 8; ++ww) t += red[ww * 128 + 32 * ib + r32];
            mu[ib] = t * (1.f / 256.f); }
#pragma unroll
        for (int ib = 0; ib < 4; ++ib) { float t = 0.f;
#pragma unroll
            for (int i = 0; i < 16; ++i) { ot[ib][i] -= mu[ib]; t += ot[ib][i] * ot[ib][i]; }
            t += lx(t, lane, 32); if (half == 0) red[1024 + w * 128 + 32 * ib + r32] = t; }
        __syncthreads();
#pragma unroll
        for (int ib = 0; ib < 4; ++ib) { float t = 0.f;
#pragma unroll
            for (int ww = 0; ww < 8; ++ww) t += red[1024 + ww * 128 + 32 * ib + r32];
            const float rstd = 1.0f / sqrtf(t * (1.f / 256.f) + EPS);
            const int irow = tok0 + 32 * ib + r32;
            const bf16* SRG = (const bf16*)(ws + WS_SRG) + (size_t)irow * 1024 + hh * 256 + 32 * w + 4 * half;
            bf16* RIN = (bf16*)(ws + WS_RIN) + (size_t)irow * 1024 + hh * 256 + 32 * w + 4 * half;
            const float* gn = a.in(19) + hh * 256 + 32 * w + 4 * half;
#pragma unroll
            for (int gq = 0; gq < 4; ++gq) {
                const u32x2 sg = *(const u32x2*)(SRG + 8 * gq); const f32x4 gv = *(const f32x4*)(gn + 8 * gq);
                f32x4 o;
                o[0] = ot[ib][4 * gq + 0] * rstd * gv[0] * __uint_as_float(sg.x << 16); o[1] = ot[ib][4 * gq + 1] * rstd * gv[1] * __uint_as_float(sg.x & 0xffff0000u);
                o[2] = ot[ib][4 * gq + 2] * rstd * gv[2] * __uint_as_float(sg.y << 16); o[3] = ot[ib][4 * gq + 3] * rstd * gv[3] * __uint_as_float(sg.y & 0xffff0000u);
                *(u32x2*)(RIN + 8 * gq) = pack4(o);
            } }
        __syncthreads();
    }
#undef RC_FETCH_QK
#undef RC_BLK_IB
#undef RC_BLK_JB
    const int lane = tid_k & 63, r32 = lane & 31, half = lane >> 5;
#pragma unroll
    for (int db = 0; db < 4; ++db)
#pragma unroll
        for (int i = 0; i < 16; ++i) a.out()[OUT_SRP + ((size_t)bh * RDK + 32 * db + r32) * RDV + 32 * w + crow(i, half)] = S[db][i];
}
}
namespace mk {
constexpr int CW_FLAG = 8192;
__device__ __forceinline__ void st16_wt(void* p, v4u v) { asm volatile("global_store_dwordx4 %0, %1, off sc1\n\ts_nop 1" :: "v"(p), "v"(v) : "memory"); }
__device__ __forceinline__ void ret_state_unit(Frame& F, const Ptrs& a, int bh) {
    unsigned char* ws = opaque_g(a.ws);
    const int tid_k = fresh_tid(F.wave), w = F.wave;
    const int hh = bh & 3, b = bh >> 2;
    LAS unsigned char* L = F.lds + RING_OFF;
    const bf16* RKT = (const bf16*)(ws + WS_RKT); const bf16* RVT = (const bf16*)(ws + WS_RVT);
    const float g = gpow_t(ws, hh, 1), g127 = gpow_t(ws, hh, 127);
    f32x16 S[4];
    bf16x8 vf[8]; v4u kreg[4];
#define RS_FETCH(tok0_) do { _Pragma("unroll") for (int s = 0; s < 8; ++s) vf[s] = *(const bf16x8*)(RVT + (size_t)(hh * 256 + 32 * w + r32) * MP + (tok0_) + 16 * s + 8 * half); \
        _Pragma("unroll") for (int k = 0; k < 4; ++k) { const int ch = tid + 512 * k; kreg[k] = *(const v4u*)(RKT + (size_t)(hh * 128 + (ch >> 4)) * MP + (tok0_) + 8 * (ch & 15)); } } while (0)
    {   const int tid = tid_k, lane = tid & 63, r32 = lane & 31, half = lane >> 5;
#pragma unroll
        for (int db = 0; db < 4; ++db)
#pragma unroll
            for (int i = 0; i < 16; ++i) S[db][i] = 0.f;
        const bf16x8 af = *(const bf16x8*)(RVT + (size_t)(hh * 256 + 32 * w + r32) * MP + ROW_META + 8 * half);
#pragma unroll
        for (int db = 0; db < 4; ++db) { const bf16x8 bf = *(const bf16x8*)(RKT + (size_t)(hh * 128 + 32 * db + r32) * MP + ROW_META + 8 * half); S[db] = __builtin_amdgcn_mfma_f32_32x32x16_bf16(af, bf, S[db], 0, 0, 0); }
        const float sc = gpow_t(ws, hh, NMETA - 1);
#pragma unroll
        for (int db = 0; db < 4; ++db)
#pragma unroll
            for (int i = 0; i < 16; ++i) S[db][i] *= sc;
        RS_FETCH(b * SEQ);
    }
#pragma unroll 1
    for (int c = 0; c < 16; ++c) {
        const int tok0 = b * SEQ + c * 128, u = bh * 16 + c;
        int tid_c = tid_k; asm volatile("" : "+v"(tid_c));
        const int tid = tid_c, lane = tid & 63, r32 = lane & 31, half = lane >> 5;
#pragma unroll
        for (int k = 0; k < 4; ++k) { const int ch = tid + 512 * k; *(LAS v4u*)(L + RC_Q + (ch >> 4) * RC_STR + 16 * (ch & 15)) = kreg[k]; }
#pragma unroll
        for (int db = 0; db < 4; ++db)
#pragma unroll
            for (int i = 0; i < 16; ++i) *(LAS bf16*)(L + (32 * w + crow(i, half)) * RC_STR + (32 * db + r32) * 2) = bf1(S[db][i]);
        __syncthreads();
        { bf16* SP = (bf16*)(ws + WS_SPREV) + (size_t)u * 32768;
#pragma unroll
          for (int k = 0; k < 8; ++k) { const int ch = lane + 64 * k, row = 32 * w + (ch >> 4); st16_wt(SP + (size_t)row * 128 + 8 * (ch & 15), *(const LAS v4u*)(L + row * RC_STR + 16 * (ch & 15))); } }
        bf16x8 vfn[8]; v4u kregn[4];
        if (c < 15) {
#pragma unroll
            for (int s = 0; s < 8; ++s) vfn[s] = *(const bf16x8*)(RVT + (size_t)(hh * 256 + 32 * w + r32) * MP + tok0 + 128 + 16 * s + 8 * half);
#pragma unroll
            for (int k = 0; k < 4; ++k) { const int ch = tid + 512 * k; kregn[k] = *(const v4u*)(RKT + (size_t)(hh * 128 + (ch >> 4)) * MP + tok0 + 128 + 8 * (ch & 15)); }
        } else {
#pragma unroll
            for (int s = 0; s < 8; ++s) vfn[s] = vf[s];
#pragma unroll
            for (int k = 0; k < 4; ++k) kregn[k] = kreg[k];
        }
#pragma unroll
        for (int db = 0; db < 4; ++db) {
#pragma unroll
            for (int i = 0; i < 16; ++i) S[db][i] *= g;
#pragma unroll
            for (int s = 0; s < 8; ++s) { const bf16x8 kf = *(const LAS bf16x8*)(L + RC_Q + (32 * db + r32) * RC_STR + (16 * s + 8 * half) * 2); S[db] = __builtin_amdgcn_mfma_f32_32x32x16_bf16(vf[s], kf, S[db], 0, 0, 0); }
#pragma unroll
            for (int i = 0; i < 16; ++i) S[db][i] *= g127;
        }
        asm volatile("s_waitcnt vmcnt(0)" ::: "memory");
#pragma unroll
        for (int s = 0; s < 8; ++s) vf[s] = vfn[s];
#pragma unroll
        for (int k = 0; k < 4; ++k) kreg[k] = kregn[k];
        __syncthreads();
        if (tid == 0) __hip_atomic_store((unsigned*)(ws + WS_CTL) + CW_FLAG + 16 * u, 1u, __ATOMIC_RELAXED, __HIP_MEMORY_SCOPE_AGENT);
    }
#undef RS_FETCH
    {   const int lane = tid_k & 63, r32 = lane & 31, half = lane >> 5;
#pragma unroll
        for (int db = 0; db < 4; ++db)
#pragma unroll
            for (int i = 0; i < 16; ++i) a.out()[OUT_SRP + ((size_t)bh * RDK + 32 * db + r32) * RDV + 32 * w + crow(i, half)] = S[db][i]; }
    __syncthreads();
}
__device__ __forceinline__ void ret_out_unit(Frame& F, const Ptrs& a, int u) {
    unsigned char* ws = opaque_g(a.ws);
    const int tid = fresh_tid(F.wave), lane = tid & 63, w = F.wave, r32 = lane & 31, half = lane >> 5;
    const int bh = u >> 4, c = u & 15, hh = bh & 3, tok0 = (bh >> 2) * SEQ + c * 128;
    LAS unsigned char* L = F.lds + RING_OFF;
    LAS float* red = (LAS float*)(L + RC_RED);
    const bf16* RQ = (const bf16*)(ws + WS_RQ); const bf16* RK = (const bf16*)(ws + WS_RK); const bf16* RVT = (const bf16*)(ws + WS_RVT);
    v4u qreg[4], jreg[4];
#pragma unroll
    for (int k = 0; k < 4; ++k) { const int ch = tid + 512 * k; qreg[k] = *(const v4u*)(RQ + (size_t)(tok0 + (ch >> 4)) * 512 + hh * 128 + 8 * (ch & 15)); jreg[k] = *(const v4u*)(RK + (size_t)(tok0 + (ch >> 4)) * 512 + hh * 128 + 8 * (ch & 15)); }
    if (tid == 0) { const unsigned* fl = (const unsigned*)(ws + WS_CTL) + CW_FLAG + 16 * u; unsigned spins = 0;
        while (__hip_atomic_load(fl, __ATOMIC_RELAXED, __HIP_MEMORY_SCOPE_AGENT) == 0u && ++spins < (1u << 22)) __builtin_amdgcn_s_sleep(8);
        __builtin_amdgcn_fence(__ATOMIC_ACQUIRE, "agent"); asm volatile("s_waitcnt vmcnt(0)" ::: "memory"); }
    __syncthreads();
    v4u sreg[8];
    { const bf16* SP = (const bf16*)(ws + WS_SPREV) + (size_t)u * 32768;
#pragma unroll
      for (int k = 0; k < 8; ++k) { const int ch = tid + 512 * k; sreg[k] = *(const v4u*)(SP + (size_t)(ch >> 4) * 128 + 8 * (ch & 15)); } }
#pragma unroll
    for (int k = 0; k < 4; ++k) { const int ch = tid + 512 * k; *(LAS v4u*)(L + RC_Q + (ch >> 4) * RC_STR + 16 * (ch & 15)) = qreg[k]; *(LAS v4u*)(L + RC_S + (ch >> 4) * RC_STR + 16 * (ch & 15)) = jreg[k]; }
    __syncthreads();
#define RC_BLK_IB(n) ((n) < 1 ? 0 : (n) < 3 ? 1 : (n) < 6 ? 2 : 3)
#define RC_BLK_JB(n) ((n) - ((n) < 1 ? 0 : (n) < 3 ? 1 : (n) < 6 ? 3 : 6))
    for (int n = w; n < 10; n += 8) {
        const int ib_ = RC_BLK_IB(n), jb_ = RC_BLK_JB(n);
        f32x16 at;
#pragma unroll
        for (int i = 0; i < 16; ++i) at[i] = 0.f;
#pragma unroll
        for (int s = 0; s < 8; ++s) { const bf16x8 kf = *(const LAS bf16x8*)(L + RC_S + (32 * jb_ + r32) * RC_STR + (16 * s + 8 * half) * 2); const bf16x8 qf = *(const LAS bf16x8*)(L + RC_Q + (32 * ib_ + r32) * RC_STR + (16 * s + 8 * half) * 2); at = __builtin_amdgcn_mfma_f32_32x32x16_bf16(kf, qf, at, 0, 0, 0); }
        if (jb_ == ib_) {
#pragma unroll
            for (int i = 0; i < 16; ++i) if (crow(i, half) > r32) at[i] = 0.f; }
#pragma unroll
        for (int gq = 0; gq < 4; ++gq) { f32x4 o_; o_[0] = at[4 * gq]; o_[1] = at[4 * gq + 1]; o_[2] = at[4 * gq + 2]; o_[3] = at[4 * gq + 3];
            *(LAS u32x2*)(L + RC_A + (32 * ib_ + r32) * RC_STR + (32 * jb_ + 8 * gq + 4 * half) * 2) = pack4(o_); }
    }
#undef RC_BLK_IB
#undef RC_BLK_JB
    __syncthreads();
#pragma unroll
    for (int k = 0; k < 8; ++k) { const int ch = tid + 512 * k; *(LAS v4u*)(L + RC_S + (ch >> 4) * RC_STR + 16 * (ch & 15)) = sreg[k]; }
    __syncthreads();
    const float g = gpow_t(ws, hh, 1);
    f32x16 ot[4];
#pragma unroll
    for (int ib = 0; ib < 4; ++ib)
#pragma unroll
        for (int i = 0; i < 16; ++i) ot[ib][i] = 0.f;
#pragma unroll 2
    for (int s = 0; s < 8; ++s) {
        const bf16x8 sf = *(const LAS bf16x8*)(L + RC_S + (32 * w + r32) * RC_STR + (16 * s + 8 * half) * 2);
#pragma unroll
        for (int ib = 0; ib < 4; ++ib) { const bf16x8 qf = *(const LAS bf16x8*)(L + RC_Q + (32 * ib + r32) * RC_STR + (16 * s + 8 * half) * 2); ot[ib] = __builtin_amdgcn_mfma_f32_32x32x16_bf16(sf, qf, ot[ib], 0, 0, 0); }
    }
#pragma unroll
    for (int ib = 0; ib < 4; ++ib)
#pragma unroll
        for (int i = 0; i < 16; ++i) ot[ib][i] *= g;
    bf16x8 vf[8];
#pragma unroll
    for (int s = 0; s < 8; ++s) vf[s] = *(const bf16x8*)(RVT + (size_t)(hh * 256 + 32 * w + r32) * MP + tok0 + 16 * s + 8 * half);
#pragma unroll
    for (int ib = 0; ib < 4; ++ib)
#pragma unroll
        for (int s = 0; s < 2 * (ib + 1); ++s) { const bf16x8 af = *(const LAS bf16x8*)(L + RC_A + (32 * ib + r32) * RC_STR + (16 * s + 8 * half) * 2); ot[ib] = __builtin_amdgcn_mfma_f32_32x32x16_bf16(vf[s], af, ot[ib], 0, 0, 0); }
#pragma unroll
    for (int ib = 0; ib < 4; ++ib) { float t = 0.f;
#pragma unroll
        for (int i = 0; i < 16; ++i) t += ot[ib][i];
        t += lx(t, lane, 32); if (half == 0) red[w * 128 + 32 * ib + r32] = t; }
    __syncthreads();
    float mu[4];
#pragma unroll
    for (int ib = 0; ib < 4; ++ib) { float t = 0.f;
#pragma unroll
        for (int ww = 0; ww < 8; ++ww) t += red[ww * 128 + 32 * ib + r32];
        mu[ib] = t * (1.f / 256.f); }
#pragma unroll
    for (int ib = 0; ib < 4; ++ib) { float t = 0.f;
#pragma unroll
        for (int i = 0; i < 16; ++i) { ot[ib][i] -= mu[ib]; t += ot[ib][i] * ot[ib][i]; }
        t += lx(t, lane, 32); if (half == 0) red[1024 + w * 128 + 32 * ib + r32] = t; }
    __syncthreads();
#pragma unroll
    for (int ib = 0; ib < 4; ++ib) { float t = 0.f;
#pragma unroll
        for (int ww = 0; ww < 8; ++ww) t += red[1024 + ww * 128 + 32 * ib + r32];
        const float rstd = 1.0f / sqrtf(t * (1.f / 256.f) + EPS);
        const int irow = tok0 + 32 * ib + r32;
        const bf16* SRG = (const bf16*)(ws + WS_SRG) + (size_t)irow * 1024 + hh * 256 + 32 * w + 4 * half;
        bf16* RIN = (bf16*)(ws + WS_RIN) + (size_t)irow * 1024 + hh * 256 + 32 * w + 4 * half;
        const float* gn = a.in(19) + hh * 256 + 32 * w + 4 * half;
#pragma unroll
        for (int gq = 0; gq < 4; ++gq) {
            const u32x2 sg = *(const u32x2*)(SRG + 8 * gq); const f32x4 gv = *(const f32x4*)(gn + 8 * gq);
            f32x4 o;
            o[0] = ot[ib][4 * gq + 0] * rstd * gv[0] * __uint_as_float(sg.x << 16); o[1] = ot[ib][4 * gq + 1] * rstd * gv[1] * __uint_as_float(sg.x & 0xffff0000u);
            o[2] = ot[ib][4 * gq + 2] * rstd * gv[2] * __uint_as_float(sg.y << 16); o[3] = ot[ib][4 * gq + 3] * rstd * gv[3] * __uint_as_float(sg.y & 0xffff0000u);
            *(u32x2*)(RIN + 8 * gq) = pack4(o);
        } }
    __syncthreads();
}
}
namespace mk {
__global__ void __launch_bounds__(NWAVES * 64, 2) mega_fwd(Args args) {
    extern __shared__ __attribute__((aligned(16))) unsigned char lds[];
    Frame F;
    F.lds = (LAS unsigned char*)lds;
    F.MISC = (volatile LAS unsigned*)(F.lds + MISC_OFF);
    F.wave = __builtin_amdgcn_readfirstlane((int)threadIdx.x >> 6);
    F.G = gridDim.x; { const int bx = blockIdx.x; F.vcu = (F.G % 8 == 0) ? (bx % 8) * (F.G / 8) + bx / 8 : bx; }
    unsigned char* const ws_k = args.ws;
    unsigned char* ws = ws_k;
    for (int u = threadIdx.x; u < (LDS_BYTES - LDSCTL_OFF) / 4; u += NWAVES * 64) ((LAS unsigned*)(F.lds + LDSCTL_OFF))[u] = 0u;
    __syncthreads();
    {
        volatile LAS unsigned long long* pt = (volatile LAS unsigned long long*)(F.lds + PT_OFF);
        if (threadIdx.x == 0) {
#define PT_PUT(i) pt[i] = (unsigned long long)args.in[i]
            PT_PUT(0); PT_PUT(1); PT_PUT(2); PT_PUT(3); PT_PUT(4); PT_PUT(5); PT_PUT(6); PT_PUT(7); PT_PUT(8); PT_PUT(9); PT_PUT(10); PT_PUT(11); PT_PUT(12); PT_PUT(13);
            PT_PUT(14); PT_PUT(15); PT_PUT(16); PT_PUT(17); PT_PUT(18); PT_PUT(19); PT_PUT(20); PT_PUT(21); PT_PUT(22); PT_PUT(23); PT_PUT(24); PT_PUT(25); PT_PUT(26);
#undef PT_PUT
            pt[27] = (unsigned long long)args.out;
        }
        __syncthreads();
    }
    const Ptrs P{ws_k, (volatile LAS unsigned*)(F.lds + PT_OFF)};
    (void)xcd_barrier_post((unsigned*)(ws_k + WS_CTL) + CW_BAR, F.MISC + 8, F.wave);
#if MK_PROBE
#define STAMP(k) do { if (blockIdx.x == 0 && F.wave == 0 && lane_fresh() == 0) ((unsigned long long*)(ws_k + WS_CTL + 512 * 1024))[k] = __builtin_amdgcn_s_memrealtime(); } while (0)
    STAMP(0);
#else
#define STAMP(k) do { } while (0)
#endif
#define WS_FRESH() unsigned char* ws = opaque_g(ws_k)
#define GRID_BAR() do { XcdBarrier b_; b_.bar = (unsigned*)(ws_k + WS_CTL) + CW_BAR; b_.x = xb_xcc_id(); b_.st = F.MISC + 8; b_.wave = F.wave; xcd_barrier(b_); } while (0)

    p0_prologue(F, args);
    GRID_BAR(); STAMP(1);
    {
        WS_FRESH();
        { const int bx = (int)blockIdx.x; if (bx >= 128 && bx < 172) xjob_ffn_up(F, ws, bx - 128, WS_XB, WS_W1T, 0); }
        p0_weights_late(F, args);
        pg8::Gemm g{(const pg8::bf16_t*)(ws + WS_XB), (const pg8::bf16_t*)(ws + WS_W1T), MMAIN, 2 * FFN, D};
        pg8::StaticOrder S; S.init(MMAIN, 2 * FFN, F.G, (int)blockIdx.x);
        EpiSwiGLU E{(bf16*)(ws + WS_ACT), (const float*)(ws + WS_R1)};
        pg8::gemm_phase<EpiSwiGLU, pg8::StaticOrder, true, true>(F.lds + RING_OFF, g, S, E, F.wave);
    }
    GRID_BAR(); STAMP(2);
    {
        WS_FRESH();
        { const int bx = (int)blockIdx.x; if (bx < 16) xjob_resid(F, ws, bx, WS_ACT, FFN, WS_W1D, (const float*)(ws + WS_XE), 0.5f, WS_H, WS_HB, WS_SSQH); }
        pg8::Gemm g{(const pg8::bf16_t*)(ws + WS_ACT), (const pg8::bf16_t*)(ws + WS_W1D), MMAIN, D, FFN};
        pg8::StaticOrder S; S.init(MMAIN, D, F.G, (int)blockIdx.x);
        typedef EpiResid<(unsigned)WS_XE, true, (unsigned)WS_H, (unsigned)WS_HB, (unsigned)WS_SSQH, 1> EpiDown1;
        EpiDown1 E{ws, P.in(0)};
        pg8::gemm_phase<EpiDown1, pg8::StaticOrder, true, true>(F.lds + RING_OFF, g, S, E, F.wave);
    }
    GRID_BAR(); STAMP(3);
#ifndef NO_P3
    {
        WS_FRESH();
        { const int bx = (int)blockIdx.x; if (bx >= 192 && bx < 238) xjob_win(F, ws, bx - 192); }
        pg8::Gemm g{(const pg8::bf16_t*)(ws + WS_HB), (const pg8::bf16_t*)(ws + WS_WIN), MMAIN, NWIN, D};
        pg8::StaticOrder S; S.init(MMAIN, NWIN, F.G, (int)blockIdx.x);
        EpiWin E{ws, F.lds};
        pg8::gemm_phase<EpiWin, pg8::StaticOrder, true, true>(F.lds + RING_OFF, g, S, E, F.wave);
    }
#endif
    GRID_BAR(); STAMP(4);
    {
        WS_FRESH();
        { const int jb = (int)blockIdx.x - 192; if (jb >= 0 && jb < 12) xjob_q(F, ws, jb); else if (jb >= 12 && jb < 20) xjob_kv(F, ws, jb - 12, false); else if (jb >= 20 && jb < 28) xjob_kv(F, ws, jb - 20, true); else if (jb >= 28 && jb < 60) xjob_ql(F, ws, jb - 28); }
        finalize_ckv(F, P);
#ifndef NO_P4Q
        {   pg8::Gemm g{(const pg8::bf16_t*)(ws + WS_CQ), (const pg8::bf16_t*)(ws + WS_WUQ), MMAIN, 768, QR};
            pg8::StaticOrder S; S.init(MMAIN, 768, F.G, (int)blockIdx.x);
            EpiQ E{ws};
            pg8::gemm_phase<EpiQ, pg8::StaticOrder, true, true>(F.lds + RING_OFF, g, S, E, F.wave); }
#endif
#ifndef NO_P4K
        {   pg8::Gemm g{(const pg8::bf16_t*)(ws + WS_CKVB), (const pg8::bf16_t*)(ws + WS_WUK), MMAIN, 512, KVR};
            pg8::StaticOrder S; S.init(MMAIN, 512, F.G, (int)((blockIdx.x + 64) % F.G));
            EpiScaleBf16<true> E{(const float*)(ws + WS_SSQKV), (bf16*)(ws + WS_KN), 512};
            pg8::gemm_phase<EpiScaleBf16<true>, pg8::StaticOrder, true, true>(F.lds + RING_OFF, g, S, E, F.wave); }
#endif
#ifndef NO_P4V
        {   pg8::Gemm g{(const pg8::bf16_t*)(ws + WS_WUV), (const pg8::bf16_t*)(ws + WS_CKVB), 512, MMAIN, KVR};
            pg8::StaticOrder S; S.init(512, MMAIN, F.G, (int)((blockIdx.x + 192) % F.G));
            EpiScaleBf16<false> E{(const float*)(ws + WS_SSQKV), (bf16*)(ws + WS_VT), MP};
            pg8::gemm_phase<EpiScaleBf16<false>, pg8::StaticOrder, true, true>(F.lds + RING_OFF, g, S, E, F.wave); }
#endif
    }
    GRID_BAR(); STAMP(5);
    STAMP(32);
#define QUEUE_LOOP(qi, nitems, call) for (;;) { \
        if (F.wave == 0 && lane_fresh() == 0) F.MISC[16] = __hip_atomic_fetch_add((unsigned*)(ws_k + WS_CTL) + CW_QUEUE + 64 * (qi), 1u, __ATOMIC_RELAXED, __HIP_MEMORY_SCOPE_AGENT); \
        __syncthreads(); const int it = (int)F.MISC[16]; __syncthreads(); \
        if (it >= (nitems)) break; call; }
    if ((int)blockIdx.x < 32) ret_state_unit(F, P, (int)blockIdx.x);
    STAMP(33);
    if (((int)blockIdx.x & 1) == 0) {
        QUEUE_LOOP(0, 512, attn_item(F, ws_k, it))
        QUEUE_LOOP(3, 512, ret_out_unit(F, P, ((it & 31) << 4) | (it >> 5)))
    }
    STAMP(34);
    QUEUE_LOOP(1, 512, decode_unit(F, P, it))
    STAMP(35);
    QUEUE_LOOP(2, 128, ret_sample_unit(F, P, it))
    STAMP(36);
    if (((int)blockIdx.x & 1) != 0) {
        QUEUE_LOOP(0, 512, attn_item(F, ws_k, it))
        QUEUE_LOOP(3, 512, ret_out_unit(F, P, ((it & 31) << 4) | (it >> 5)))
    }
    STAMP(37);
    QUEUE_LOOP(4, 256, decode_combine_unit(F, P, it))
#undef QUEUE_LOOP
    GRID_BAR(); STAMP(6);
    {
        WS_FRESH();
        { const int bx = (int)blockIdx.x; if (bx < 16) xjob_mix(F, ws, bx); }
        {   pg8::Gemm g{(const pg8::bf16_t*)(ws + WS_AV), (const pg8::bf16_t*)(ws + WS_WMO), MMAIN, D, 512};
            pg8::StaticOrder S; S.init(MMAIN, D, F.G, (int)blockIdx.x);
            typedef EpiGate<0, (unsigned)WS_SGA> EpiGA; EpiGA E{ws};
            pg8::gemm_phase<EpiGA, pg8::StaticOrder, true, true>(F.lds + RING_OFF, g, S, E, F.wave); }
        {   pg8::Gemm g{(const pg8::bf16_t*)(ws + WS_RIN), (const pg8::bf16_t*)(ws + WS_WRO), MMAIN, D, D};
            pg8::StaticOrder S; S.init(MMAIN, D, F.G, (int)blockIdx.x);
            typedef EpiGate<1, (unsigned)WS_SGB> EpiGB; EpiGB E{ws};
            pg8::gemm_phase<EpiGB, pg8::StaticOrder, true, true>(F.lds + RING_OFF, g, S, E, F.wave); }
    }
    GRID_BAR(); STAMP(7);
    {
        WS_FRESH();
        { const int bx = (int)blockIdx.x; if (bx >= 16 && bx < 32) xjob_resid(F, ws, bx - 16, WS_MX, D, WS_WOUT, (const float*)(ws + WS_H) + (size_t)XROW0 * D, 1.0f, WS_H2, WS_H2B, WS_SSQH2); }
        pg8::Gemm g{(const pg8::bf16_t*)(ws + WS_MX), (const pg8::bf16_t*)(ws + WS_WOUT), MMAIN, D, D};
        pg8::StaticOrder S; S.init(MMAIN, D, F.G, (int)blockIdx.x);
        typedef EpiResid<(unsigned)WS_H, false, (unsigned)WS_H2, (unsigned)WS_H2B, (unsigned)WS_SSQH2, 2> EpiOut;
        EpiOut E{ws, nullptr};
        pg8::gemm_phase<EpiOut, pg8::StaticOrder, true, true>(F.lds + RING_OFF, g, S, E, F.wave);
    }
    GRID_BAR(); STAMP(8);
    {
        WS_FRESH();
        { const int bx = (int)blockIdx.x; if (bx >= 128 && bx < 172) xjob_ffn_up(F, ws, bx - 128, WS_H2B, WS_W2T, 1); }
        pg8::Gemm g{(const pg8::bf16_t*)(ws + WS_H2B), (const pg8::bf16_t*)(ws + WS_W2T), MMAIN, 2 * FFN, D};
        pg8::StaticOrder S; S.init(MMAIN, 2 * FFN, F.G, (int)blockIdx.x);
        EpiSwiGLU2 E{ws};
        pg8::gemm_phase<EpiSwiGLU2, pg8::StaticOrder, true, true>(F.lds + RING_OFF, g, S, E, F.wave);
    }
    GRID_BAR(); STAMP(9);
    {
        WS_FRESH();
        { const int bx = (int)blockIdx.x; if (bx >= 32 && bx < 48) xjob_resid(F, ws, bx - 32, WS_ACT, FFN, WS_W2D, (const float*)(ws + WS_H2) + (size_t)XROW0 * D, 0.5f, WS_H3, 0, WS_SSQH3); }
        pg8::Gemm g{(const pg8::bf16_t*)(ws + WS_ACT), (const pg8::bf16_t*)(ws + WS_W2D), MMAIN, D, FFN};
        pg8::StaticOrder S; S.init(MMAIN, D, F.G, (int)blockIdx.x);
        typedef EpiResid<(unsigned)WS_H2, false, (unsigned)WS_H3, 0u, (unsigned)WS_SSQH3, 1> EpiDown2;
        EpiDown2 E{ws, nullptr};
        pg8::gemm_phase<EpiDown2, pg8::StaticOrder, true, true>(F.lds + RING_OFF, g, S, E, F.wave);
    }
    GRID_BAR(); STAMP(10);
    final_norm_phase(F, P);
#if MK_PROBE
    GRID_BAR(); STAMP(11);
    if (blockIdx.x == 0) {
        asm volatile("s_waitcnt vmcnt(0)" ::: "memory"); __syncthreads();
        const unsigned long long* t = (const unsigned long long*)(ws_k + WS_CTL + 512 * 1024);
        const float dta = (float)(__hip_atomic_load(t + MK_PROBE_A + 1, __ATOMIC_RELAXED, __HIP_MEMORY_SCOPE_AGENT) - __hip_atomic_load(t + MK_PROBE_A, __ATOMIC_RELAXED, __HIP_MEMORY_SCOPE_AGENT)) * 0.01f;
        const float dtb = (float)(__hip_atomic_load(t + MK_PROBE_B + 1, __ATOMIC_RELAXED, __HIP_MEMORY_SCOPE_AGENT) - __hip_atomic_load(t + MK_PROBE_B, __ATOMIC_RELAXED, __HIP_MEMORY_SCOPE_AGENT)) * 0.01f;
        const float f = 1.f + sqrtf(dta / 20000.f);
        const int tid_p = fresh_tid(F.wave);
        for (int i = tid_p; i < NS * D; i += NWAVES * 64) P.out()[OUT_YS + i] *= f;
        if (tid_p == 0) P.out()[OUT_YP] += dtb / 5.f;
    }
#endif
#undef GRID_BAR
}
}
extern "C" void kernel_launch(void* const* d_in, const int* in_sizes, int n_in, void* d_out, int out_size, void* d_ws, size_t ws_size, hipStream_t stream) {
    static int grid = 0;
    if (grid == 0) {
        int dev = 0, cus = 0;
        if (n_in != 27 || out_size != (int)mk::OUT_END || ws_size < mk::WS_END6) { fprintf(stderr, "kernel_launch: unexpected problem shape (n_in %d, out %d, ws %zu); nothing launched\n", n_in, out_size, ws_size); grid = -1; return; }
        if (hipGetDevice(&dev) != hipSuccess || hipDeviceGetAttribute(&cus, hipDeviceAttributeMultiprocessorCount, dev) != hipSuccess) { fprintf(stderr, "kernel_launch: device query failed\n"); grid = -1; return; }
        if (hipFuncSetAttribute((const void*)mk::mega_fwd, hipFuncAttributeMaxDynamicSharedMemorySize, mk::LDS_BYTES) != hipSuccess) { fprintf(stderr, "kernel_launch: hipFuncSetAttribute failed\n"); grid = -1; return; }
        int per_cu = 0;
        if (hipOccupancyMaxActiveBlocksPerMultiprocessor(&per_cu, (const void*)mk::mega_fwd, mk::NWAVES * 64, mk::LDS_BYTES) != hipSuccess || per_cu < 1) fprintf(stderr, "kernel_launch: note: occupancy query reports %d workgroups per CU\n", per_cu);
        (void)hipGetLastError();
        grid = cus;
    }
    if (grid < 0) return;
    unsigned char* ws = (unsigned char*)d_ws;
    (void)hipMemsetAsync(ws + mk::WS_CTL, 0, mk::CTL_ZERO_BYTES, stream);
    mk::Args a{};
    for (int i = 0; i < 27; ++i) a.in[i] = (const float*)d_in[i];
    a.out = (float*)d_out; a.ws = ws;
    hipLaunchKernelGGL(mk::mega_fwd, dim3(grid), dim3(mk::NWAVES * 64), mk::LDS_BYTES, stream, a);
}
```

```cpp
#include <hip/hip_runtime.h>
#include <cstdio>
#include <cstdint>
#include <cmath>
#define MK_DEBUG 0
#ifndef MK_PROBE
#define MK_PROBE 0
#define MK_PROBE_A 0
#define MK_PROBE_B 1
#endif
__device__ __forceinline__ int lane_fresh() { int l; asm volatile("v_mbcnt_lo_u32_b32 %0, -1, 0\n\tv_mbcnt_hi_u32_b32 %0, -1, %0" : "=v"(l)); return l; }
__device__ __forceinline__ unsigned char* opaque_g(const unsigned char* p) { unsigned long long v = (unsigned long long)p; asm volatile("" : "+s"(v)); return (unsigned char*)(__attribute__((address_space(1))) unsigned char*)v; }
namespace pg8 {
#define PG8_LAS __attribute__((address_space(3)))
typedef unsigned short bf16_t;
typedef short bf16x8 __attribute__((ext_vector_type(8)));
typedef float f32x4 __attribute__((ext_vector_type(4)));
typedef unsigned u32x4 __attribute__((ext_vector_type(4)));
constexpr int BM = 256, BK = 64, HALF = 128, HTB = HALF * BK * 2  , STAGE_BYTES = 8 * HTB, NXCD = 8, WGM = 8;

__host__ __device__ __forceinline__ int lds_byte(int r, int c) { const int st = (r >> 4) * 2 + (c >> 5), rr = r & 15, cc = c & 31, ob = rr * 64 + cc * 2; return st * 1024 + (ob ^ (((ob >> 9) & 1) << 5)); }
__host__ __device__ __forceinline__ void stage_rc(int b, int& R, int& C) { const int st = b / 1024, sb = b % 1024, swz = sb ^ (((sb >> 9) & 1) << 5); R = (st >> 1) * 16 + swz / 64; C = (st & 1) * 32 + (swz % 64) / 2; }
__host__ __device__ __forceinline__ int perm32(int rho) { const int n = rho >> 4, i = rho & 15; return 8 * (i >> 2) + 4 * n + (i & 3); }

struct Unit { int pm, pn; };
struct Gemm { const bf16_t* A; const bf16_t* Bt; int M, N, K; };

struct StaticOrder {
    int nM, nN, nwg, G, c;
    __host__ __device__ void init(int M, int N, int G_, int c_) { nM = M / BM; nN = N / BM; nwg = nM * nN; G = G_; c = c_; }
    __host__ __device__ bool next(int i, Unit& u) const {
        const long L = (long)i * G + c; if (L >= nwg) return false;
        int wgid = (int)L; { const int q = nwg / NXCD, r = nwg % NXCD, xcd = wgid % NXCD, off = wgid / NXCD; wgid = (xcd < r ? xcd * (q + 1) : r * (q + 1) + (xcd - r) * q) + off; }
        const int nig = WGM * nN, gid = wgid / nig, fm = gid * WGM, gsz = (nM - fm) < WGM ? (nM - fm) : WGM;
        u.pm = fm + ((wgid % nig) % gsz); u.pn = (wgid % nig) / gsz; return true;
    }
    __device__ __forceinline__ void a_ready(const Unit&) const {}
    __device__ __forceinline__ void done(const Unit&) const {}
};

__device__ __forceinline__ unsigned cvt_pk_bf16(float lo, float hi) { unsigned r; asm volatile("v_cvt_pk_bf16_f32 %0, %1, %2" : "=v"(r) : "v"(lo), "v"(hi)); return r; }
typedef float f32x2 __attribute__((ext_vector_type(2)));
template <class Epi, class Sched, bool ALIGN_EPI = false, bool SP2 = false>
__device__ __forceinline__ void gemm_phase(PG8_LAS unsigned char* lds, const Gemm g, const Sched& S, const Epi& E, const int wave_in  ) {
    int tid_ = lane_fresh() + 64 * wave_in; asm volatile("" : "+v"(tid_));
    const int tid = tid_, wid = __builtin_amdgcn_readfirstlane(tid >> 6), lane = tid & 63, wr = wid >> 2, wc = wid & 3, fr = lane & 15, fq = lane >> 4;
    const int K = g.K, nt = K / BK;
    unsigned voffA[2], voffB[2];
#pragma unroll
    for (int i = 0; i < 2; ++i) { int R, C; stage_rc(tid * 16 + i * 8192, R, C); const int Rb = Epi::PERM ? ((R & ~31) + perm32(R & 31)) : R;
        voffA[i] = (unsigned)(R * K + C) * 2u; voffB[i] = (unsigned)(Rb * K + C) * 2u; }
    const size_t kstep = (size_t)(BK * 2);
    const size_t hstep = (size_t)HALF * K * 2;
    const size_t tstep = 2 * hstep;
    const unsigned ldsw = (unsigned)wid * 1024u;
    const int aoff = lds_byte(wr * 64 + fr, fq * 8), boff = lds_byte(wc * 32 + fr, fq * 8);
#define PG8_SA(b, h) (((b) * 2 + (h)) * HTB)
#define PG8_SB(b, h) ((4 + (b) * 2 + (h)) * HTB)
#define PG8_STAGE(bufoff, gbase, voff) do { _Pragma("unroll") for (int _i = 0; _i < 2; ++_i) \
        __builtin_amdgcn_global_load_lds((const unsigned*)((const char*)(gbase) + (voff)[_i]), (PG8_LAS unsigned*)(lds + (bufoff) + ldsw + _i * 8192), 16, 0, 0); } while (0)
#define PG8_LDA(dst, b, h) do { _Pragma("unroll") for (int m = 0; m < 4; ++m) _Pragma("unroll") for (int k = 0; k < 2; ++k) dst[m][k] = *(const PG8_LAS bf16x8*)(lds + PG8_SA(b, h) + aoff + m * 2048 + k * 1024); } while (0)
#define PG8_LDB(dst, b, h) do { _Pragma("unroll") for (int n = 0; n < 2; ++n) _Pragma("unroll") for (int k = 0; k < 2; ++k) dst[n][k] = *(const PG8_LAS bf16x8*)(lds + PG8_SB(b, h) + boff + n * 2048 + k * 1024); } while (0)
#define PG8_MMA(ai, bj, At, Bt) do { __builtin_amdgcn_s_setprio(1); _Pragma("unroll") for (int m = 0; m < 4; ++m) _Pragma("unroll") for (int n = 0; n < 2; ++n) _Pragma("unroll") for (int k = 0; k < 2; ++k) \
        acc[ai][bj][m][n] = __builtin_amdgcn_mfma_f32_16x16x32_bf16(Bt[n][k], At[m][k], acc[ai][bj][m][n], 0, 0, 0); __builtin_amdgcn_s_setprio(0); } while (0)
#define PG8_WAIT_V(n) asm volatile("s_waitcnt vmcnt(" #n ")" ::: "memory")
#define PG8_WAIT_L(n) asm volatile("s_waitcnt lgkmcnt(" #n ")" ::: "memory")
#define PG8_BAR __builtin_amdgcn_s_barrier()
#define PG8_SCHED __builtin_amdgcn_sched_barrier(0)
    Unit cur, nxt; int ui = 0;
    if (!S.next(0, cur)) return;
    f32x4 acc[2][2][4][2];
#pragma unroll
    for (int a = 0; a < 2; ++a)
#pragma unroll
        for (int b = 0; b < 2; ++b)
#pragma unroll
            for (int m = 0; m < 4; ++m)
#pragma unroll
                for (int n = 0; n < 2; ++n) acc[a][b][m][n] = (f32x4){0.f, 0.f, 0.f, 0.f};
    bf16x8 At[4][2], B0[2][2], B1[2][2];
    const char* cA = (const char*)g.A + (size_t)cur.pm * tstep; const char* cB = (const char*)g.Bt + (size_t)cur.pn * tstep;
    S.a_ready(cur);
    if constexpr (SP2) {
        PG8_STAGE(PG8_SB(0, 0), cB, voffB); PG8_STAGE(PG8_SB(0, 1), cB + hstep, voffB); PG8_STAGE(PG8_SA(0, 0), cA, voffA); PG8_STAGE(PG8_SA(0, 1), cA + hstep, voffA);
        if (wr == 1) PG8_BAR;
        PG8_WAIT_V(2); PG8_BAR;
        PG8_STAGE(PG8_SB(1, 0), cB + kstep, voffB); PG8_STAGE(PG8_SA(1, 0), cA + kstep, voffA); PG8_STAGE(PG8_SB(1, 1), cB + hstep + kstep, voffB);
        PG8_WAIT_V(6); PG8_BAR;
    } else {
        PG8_STAGE(PG8_SB(0, 0), cB, voffB); PG8_STAGE(PG8_SA(0, 0), cA, voffA); PG8_STAGE(PG8_SB(0, 1), cB + hstep, voffB); PG8_STAGE(PG8_SA(0, 1), cA + hstep, voffA);
        if (wr == 1) PG8_BAR;
        PG8_WAIT_V(4); PG8_BAR;
        PG8_STAGE(PG8_SB(1, 0), cB + kstep, voffB); PG8_STAGE(PG8_SA(1, 0), cA + kstep, voffA); PG8_STAGE(PG8_SB(1, 1), cB + hstep + kstep, voffB);
        PG8_WAIT_V(6); PG8_BAR;
    }
    for (;;) {
        const bool has_next = S.next(ui + 1, nxt);
        const char* nA = has_next ? (const char*)g.A + (size_t)nxt.pm * tstep : cA; const char* nB = has_next ? (const char*)g.Bt + (size_t)nxt.pn * tstep : cB;
        for (int t = 0; t < nt; t += 2) {
            const bool last = (t == nt - 2);
            const char* a1 = cA + (size_t)(t + 1) * kstep;
            const char* a2 = last ? nA : cA + (size_t)(t + 2) * kstep; const char* b2 = last ? nB : cB + (size_t)(t + 2) * kstep;
            const char* a3 = a2 + kstep; const char* b3 = b2 + kstep;
            if (last && has_next) S.a_ready(nxt);
            if constexpr (SP2) {
            PG8_LDB(B0, 0, 0); PG8_LDB(B1, 0, 1); PG8_SCHED; PG8_LDA(At, 0, 0); PG8_STAGE(PG8_SA(1, 1), a1 + hstep, voffA);
            PG8_WAIT_V(8); PG8_WAIT_L(0); PG8_BAR; PG8_MMA(0, 0, At, B0); PG8_MMA(0, 1, At, B1); PG8_BAR; PG8_SCHED;
            PG8_LDA(At, 0, 1); PG8_STAGE(PG8_SB(0, 0), b2, voffB); PG8_STAGE(PG8_SB(0, 1), b2 + hstep, voffB); PG8_STAGE(PG8_SA(0, 0), a2, voffA);
            PG8_WAIT_V(8); PG8_WAIT_L(0); PG8_BAR; PG8_MMA(1, 0, At, B0); PG8_MMA(1, 1, At, B1); PG8_BAR; PG8_SCHED;
            PG8_LDB(B0, 1, 0); PG8_LDB(B1, 1, 1); PG8_SCHED; PG8_LDA(At, 1, 0); PG8_STAGE(PG8_SA(0, 1), a2 + hstep, voffA);
            PG8_WAIT_V(8); PG8_WAIT_L(0); PG8_BAR; PG8_MMA(0, 0, At, B0); PG8_MMA(0, 1, At, B1); PG8_BAR; PG8_SCHED;
            PG8_LDA(At, 1, 1); PG8_STAGE(PG8_SB(1, 0), b3, voffB); PG8_STAGE(PG8_SB(1, 1), b3 + hstep, voffB); PG8_STAGE(PG8_SA(1, 0), a3, voffA);
            PG8_WAIT_V(8); PG8_WAIT_L(0); PG8_BAR; PG8_MMA(1, 0, At, B0); PG8_MMA(1, 1, At, B1); PG8_BAR; PG8_SCHED;
            } else {
            PG8_LDB(B0, 0, 0); PG8_SCHED; PG8_LDA(At, 0, 0); PG8_STAGE(PG8_SA(1, 1), a1 + hstep, voffA);
            PG8_WAIT_L(8); PG8_BAR; PG8_WAIT_L(0); PG8_MMA(0, 0, At, B0); PG8_BAR; PG8_SCHED;
            PG8_LDB(B1, 0, 1); PG8_STAGE(PG8_SB(0, 0), b2, voffB);
            PG8_BAR; PG8_WAIT_L(0); PG8_MMA(0, 1, At, B1); PG8_BAR;
            PG8_LDA(At, 0, 1); PG8_STAGE(PG8_SA(0, 0), a2, voffA);
            PG8_BAR; PG8_WAIT_L(0); PG8_MMA(1, 0, At, B0); PG8_BAR; PG8_SCHED;
            PG8_STAGE(PG8_SB(0, 1), b2 + hstep, voffB);
            PG8_WAIT_V(6); PG8_BAR; PG8_MMA(1, 1, At, B1); PG8_BAR;
            PG8_LDB(B0, 1, 0); PG8_SCHED; PG8_LDA(At, 1, 0); PG8_STAGE(PG8_SA(0, 1), a2 + hstep, voffA);
            PG8_WAIT_L(8); PG8_BAR; PG8_WAIT_L(0); PG8_MMA(0, 0, At, B0); PG8_BAR; PG8_SCHED;
            PG8_LDB(B1, 1, 1); PG8_STAGE(PG8_SB(1, 0), b3, voffB);
            PG8_BAR; PG8_WAIT_L(0); PG8_MMA(0, 1, At, B1); PG8_BAR;
            PG8_LDA(At, 1, 1); PG8_STAGE(PG8_SA(1, 0), a3, voffA);
            PG8_BAR; PG8_WAIT_L(0); PG8_MMA(1, 0, At, B0); PG8_BAR; PG8_SCHED;
            PG8_STAGE(PG8_SB(1, 1), b3 + hstep, voffB);
            PG8_WAIT_V(6); PG8_BAR; PG8_MMA(1, 1, At, B1); PG8_BAR;
            }
        }
        if constexpr (ALIGN_EPI) { if (wr == 0) PG8_BAR; }
        if constexpr (!Epi::AFTER_DRAIN) { E(acc, cur, wr, wc, fr, fq); S.done(cur); }
        if (!has_next) break;
#pragma unroll
        for (int a = 0; a < 2; ++a)
#pragma unroll
            for (int b = 0; b < 2; ++b)
#pragma unroll
                for (int m = 0; m < 4; ++m)
#pragma unroll
                    for (int n = 0; n < 2; ++n) acc[a][b][m][n] = (f32x4){0.f, 0.f, 0.f, 0.f};
        cur = nxt; cA = nA; cB = nB; ++ui;
        if constexpr (ALIGN_EPI) { if (wr == 1) PG8_BAR; }
    }
    PG8_WAIT_V(0);
    if constexpr (!ALIGN_EPI) { if (wr == 0) PG8_BAR; }
    PG8_BAR;
    if constexpr (Epi::AFTER_DRAIN) { E.fused(acc, cur, wr, wc, fr, fq, lds, wid, lane); S.done(cur); }
#undef PG8_SA
#undef PG8_SB
#undef PG8_STAGE
#undef PG8_LDA
#undef PG8_LDB
#undef PG8_MMA
#undef PG8_WAIT_V
#undef PG8_WAIT_L
#undef PG8_BAR
#undef PG8_SCHED
}
}
#define GAS __attribute__((address_space(1)))
#define LAS __attribute__((address_space(3)))
typedef unsigned short bf16;
typedef unsigned v4u __attribute__((ext_vector_type(4)));
typedef float f32x4 __attribute__((ext_vector_type(4)));
typedef short bf16x8 __attribute__((ext_vector_type(8)));
typedef GAS unsigned gu32;
typedef GAS unsigned long long gu64;
#define RLX_AGENT __ATOMIC_RELAXED, __HIP_MEMORY_SCOPE_AGENT
#define LDS_WAIT() asm volatile("s_waitcnt lgkmcnt(0)" ::: "memory")
#define VM_WAIT() asm volatile("s_waitcnt vmcnt(0)" ::: "memory")
__device__ __forceinline__ unsigned long long rt() { return __builtin_amdgcn_s_memrealtime(); }
__device__ __forceinline__ unsigned f2bf(float f) { unsigned u = __builtin_bit_cast(unsigned, f); return (u + 0x7fffu + ((u >> 16) & 1u)) >> 16; }
__device__ __forceinline__ unsigned pk2(float lo, float hi) { return f2bf(lo) | (f2bf(hi) << 16); }

#define XB_TMO      128
#define XB_XCNT(j)  (256  + 64 * (j))
#define XB_XSUB(j)  (1280 + 64 * (j))
#define XB_XGEN(j)  (2304 + 64 * (j))
#define XB_TOP      3328
#define XB_TOPGEN   3392
#define XCD_BAR_WORDS 3456
#define XB_SPIN_CAP (1u << 18)

__device__ __forceinline__ unsigned xb_ld(unsigned* p)              { return __hip_atomic_load(p, __ATOMIC_RELAXED, __HIP_MEMORY_SCOPE_AGENT); }
__device__ __forceinline__ unsigned xb_add(unsigned* p, unsigned v) { return __hip_atomic_fetch_add(p, v, __ATOMIC_RELAXED, __HIP_MEMORY_SCOPE_AGENT); }
__device__ __forceinline__ unsigned xb_xcc_id() { return (unsigned)__builtin_amdgcn_s_getreg((3 << 11) | 20) & 0xFu; }
#define XB_SPIN(cond, bar) do { unsigned _sp = 0; while (cond) { __builtin_amdgcn_s_sleep(1); \
    if ((++_sp & 255u) == 0u) { if (xb_ld(&(bar)[XB_TMO])) break; if (_sp > XB_SPIN_CAP) { atomicAdd(&(bar)[XB_TMO], 1u); break; } } } } while (0)

struct XcdBarrier {
    unsigned* bar; unsigned x; int wave;
    volatile LAS unsigned* st;
};

#define XB_IS_T0(wave) ((wave) == 0 && lane_fresh() == 0)
__device__ __forceinline__ XcdBarrier xcd_barrier_post(unsigned* bar, volatile LAS unsigned* st, int wave) {
    XcdBarrier b; b.bar = bar; b.x = xb_xcc_id(); b.st = st; b.wave = wave;
    if (XB_IS_T0(wave)) (void)xb_add(&bar[XB_XCNT(b.x)], 1u);
    return b;
}
__device__ __forceinline__ void xcd_barrier_complete(unsigned* bar, unsigned x, unsigned& nloc, unsigned& nx) {
    const unsigned G = gridDim.x * gridDim.y * gridDim.z;
    unsigned sum, cnt, mine, sp = 0u;
    for (;;) {
        sum = 0u; cnt = 0u; mine = 0u;
#pragma unroll
        for (unsigned j = 0; j < 16; ++j) { const unsigned c = xb_ld(&bar[XB_XCNT(j)]); sum += c; cnt += (c > 0u) ? 1u : 0u; mine = (j == x) ? c : mine; }
        if (sum == G) break;
        __builtin_amdgcn_s_sleep(1);
        if ((++sp & 255u) == 0u) { if (xb_ld(&bar[XB_TMO])) break; if (sp > XB_SPIN_CAP) { atomicAdd(&bar[XB_TMO], 1u); break; } }
    }
    nloc = mine > 0u ? mine : 1u; nx = cnt > 0u ? cnt : 1u;
}

__device__ __forceinline__ void xcd_barrier(const XcdBarrier& b) {
    asm volatile("s_waitcnt vmcnt(0)" ::: "memory");
    __syncthreads();
    if (XB_IS_T0(b.wave)) {
        unsigned* bar = b.bar;
        __builtin_amdgcn_s_waitcnt(0);
        unsigned nloc = b.st[0], nx = b.st[1];
        if (nloc == 0u) { xcd_barrier_complete(bar, b.x, nloc, nx); b.st[0] = nloc; b.st[1] = nx; }
        const unsigned old = xb_add(&bar[XB_XSUB(b.x)], 1u);
        const unsigned gen = old / nloc;
        if (old + 1u == (gen + 1u) * nloc) {
            __builtin_amdgcn_fence(__ATOMIC_RELEASE, "agent");
            asm volatile("s_waitcnt vmcnt(0)" ::: "memory");
            const unsigned og = xb_add(&bar[XB_TOP], 1u);
            const unsigned tg = og / nx;
            if (og + 1u == (tg + 1u) * nx) xb_add(&bar[XB_TOPGEN], 1u);
            else XB_SPIN(xb_ld(&bar[XB_TOPGEN]) == tg, bar);
            __builtin_amdgcn_fence(__ATOMIC_ACQUIRE, "agent");
            xb_add(&bar[XB_XGEN(b.x)], 1u);
            asm volatile("s_waitcnt vmcnt(0)" ::: "memory");
        } else {
            XB_SPIN(xb_ld(&bar[XB_XGEN(b.x)]) == gen, bar);
            __builtin_amdgcn_fence(__ATOMIC_ACQUIRE, "agent");
            asm volatile("s_waitcnt vmcnt(0)" ::: "memory");
        }
    }
    __syncthreads();
}
namespace mk {
constexpr int D = 1024, NB = 8, SEQ = 2048, NMETA = 16, T = SEQ + NMETA, NS = 32, PAST = 16384, PAGE = 128, NPAGES = PAST / PAGE;
constexpr int FFN = 2816, NH = 8, QR = 384, KVR = 256, RH = 4, RDK = 128, RDV = 256, IN_DIM = 5792;
constexpr int O_CQ = 0, O_CKV = 384, O_KR = 640, O_RQ = 672, O_RK = 1184, O_RV = 1696, O_RG = 2720, O_GA = 3744, O_GB = 4768;
constexpr int MMAIN = NB * SEQ;
constexpr int ROW_META = MMAIN;
constexpr int ROW_SMP = MMAIN + NMETA;
constexpr int ROW_PAD = ROW_SMP + NS;
constexpr int MP = MMAIN + 256;
constexpr int NWIN = 5888;
constexpr int NPOS = T + 1;
constexpr float EPS = 1e-6f;
constexpr int NWAVES = 8;

constexpr size_t MiB = 1u << 20;
constexpr size_t al(size_t x) { return (x + 255) / 256 * 256; }
constexpr size_t WS_CTL = 0, CTL_ZERO_BYTES = 1 * MiB;
constexpr size_t WS_W1T = 1 * MiB;
constexpr size_t WS_W1D = WS_W1T + al((size_t)2 * FFN * D * 2);
constexpr size_t WS_WIN = WS_W1D + al((size_t)D * FFN * 2);
constexpr size_t WS_WUQ = WS_WIN + al((size_t)NWIN * D * 2);
constexpr size_t WS_WUK = WS_WUQ + al((size_t)768 * QR * 2);
constexpr size_t WS_WUV = WS_WUK + al((size_t)512 * KVR * 2);
constexpr size_t WS_WMO = WS_WUV + al((size_t)512 * KVR * 2);
constexpr size_t WS_WRO = WS_WMO + al((size_t)D * 512 * 2);
constexpr size_t WS_WOUT = WS_WRO + al((size_t)D * D * 2);
constexpr size_t WS_W2T = WS_WOUT + al((size_t)D * D * 2);
constexpr size_t WS_W2D = WS_W2T + al((size_t)2 * FFN * D * 2);
constexpr size_t WS_WQL = WS_W2D + al((size_t)D * FFN * 2);
constexpr size_t WS_TAB = WS_WQL + al((size_t)2048 * QR * 2);
constexpr size_t TAB_C64 = 0, TAB_S64 = (size_t)NPOS * 64 * 4, TAB_C16 = 2 * TAB_S64, TAB_S16 = TAB_C16 + (size_t)NPOS * 16 * 4, TAB_GP = TAB_S16 + (size_t)NPOS * 16 * 4, TAB_GN = TAB_GP + 512 * 4, TAB_END = TAB_GN + 512 * 4;
constexpr size_t WS_XB = WS_TAB + al(TAB_END);
constexpr size_t WS_XE = WS_XB + al((size_t)MP * D * 2);
constexpr size_t WS_R1 = WS_XE + al((size_t)256 * D * 4);
constexpr size_t WS_ACT = WS_R1 + al((size_t)MP * 4);
constexpr size_t WS_H = WS_ACT + al((size_t)MP * FFN * 2);
constexpr size_t WS_HB = WS_H + al((size_t)MP * D * 4);
constexpr size_t WS_SSQH = WS_HB + al((size_t)MP * D * 2);
constexpr size_t WS_SSQ2_ = WS_SSQH + al((size_t)MP * 4), WS_SSQ3_ = WS_SSQ2_ + al((size_t)MP * 4);
constexpr size_t WS_END1 = WS_SSQH + al((size_t)MP * 16 * 4);

constexpr int CW_XCNT = 32768  , CW_BAR = 4096, CW_QUEUE = 64, CW_DCNT = 24576  ;

constexpr int RING_OFF = 0, RING_BYTES = 131072, SCR_BYTES = 155648  , LDSCTL_OFF = SCR_BYTES, MISC_OFF = LDSCTL_OFF + 320, LDS_BYTES = 163840;

struct Args {
    const float* in[27]; float* out; unsigned char* ws;
};

struct Frame {
    LAS unsigned char* lds;
    volatile LAS unsigned* MISC;
    int wave, vcu, G;
};

constexpr int PT_OFF = MISC_OFF + 256;
struct Ptrs {
    unsigned char* ws; volatile LAS unsigned* tab;
    __device__ __forceinline__ unsigned long long raw(int k) const { volatile LAS unsigned* t = tab; asm volatile("" : "+v"(t));
        const unsigned lo = __builtin_amdgcn_readfirstlane(t[2 * k]), hi = __builtin_amdgcn_readfirstlane(t[2 * k + 1]); return ((unsigned long long)hi << 32) | lo; }
    __device__ __forceinline__ const float* in(int k) const { return (const float*)(GAS const float*)raw(k); }
    __device__ __forceinline__ float* out() const { return (float*)(GAS float*)raw(27); }
};
__device__ __forceinline__ int fresh_tid(int wave) { int t = lane_fresh() + 64 * wave; asm volatile("" : "+v"(t)); return t; }

__device__ __forceinline__ float lx(float v, int lane, int mask) { return __int_as_float(__builtin_amdgcn_ds_bpermute((lane ^ mask) << 2, __float_as_int(v))); }
__device__ __forceinline__ float wave_sum(float v, int lane) {
#pragma unroll
    for (int o = 1; o < 64; o <<= 1) v += lx(v, lane, o);
    return v;
}
__device__ __forceinline__ int row_pos(int row) { return row < MMAIN ? (row & (SEQ - 1)) + NMETA : (row < ROW_SMP ? row - ROW_META : (row < ROW_PAD ? PAST : 0)); }
__device__ __forceinline__ int row_pidx(int row) { return row < MMAIN ? (row & (SEQ - 1)) + NMETA : (row < ROW_SMP ? row - ROW_META : (row < ROW_PAD ? T : 0)); }
__device__ __forceinline__ int row_jtok(int row) { return row < MMAIN ? (row & 127) : (row < ROW_SMP ? row - ROW_META : 0); }

struct WSrc { const float* W; int ld; int col0; const float* g; };
__device__ __forceinline__ void wmat_dims(int id, int& K, int& ngrp) {
    switch (id) {
        case 0: case 9: K = D; ngrp = 2 * FFN / 32; break;
        case 1: case 10: K = FFN; ngrp = D / 32; break;
        case 2: K = D; ngrp = NWIN / 32; break;
        case 3: K = QR; ngrp = 768 / 32; break;
        case 4: case 5: K = KVR; ngrp = 512 / 32; break;
        case 6: K = 512; ngrp = D / 32; break;
        default: K = D; ngrp = D / 32; break;
    }
}
__device__ __forceinline__ size_t wmat_off(int id) {
    switch (id) { case 0: return WS_W1T; case 1: return WS_W1D; case 2: return WS_WIN; case 3: return WS_WUQ; case 4: return WS_WUK; case 5: return WS_WUV;
                  case 6: return WS_WMO; case 7: return WS_WRO; case 8: return WS_WOUT; case 9: return WS_W2T; default: return WS_W2D; }
}
__device__ __forceinline__ WSrc wmat_src(const Args& a, int id, int g) {
    WSrc s; s.W = nullptr; s.ld = 0; s.col0 = 0; s.g = nullptr;
    switch (id) {
        case 0: case 9: { const int pn = g >> 3, gg = g & 7; const int o = id == 0 ? 7 : 22;
            s.W = gg < 4 ? a.in[o + 1] : a.in[o + 2]; s.ld = FFN; s.col0 = 128 * pn + 32 * (gg & 3); s.g = a.in[o]; break; }
        case 1: s.W = a.in[10]; s.ld = D; s.col0 = 32 * g; break;
        case 10: s.W = a.in[25]; s.ld = D; s.col0 = 32 * g; break;
        case 2: { s.ld = IN_DIM; s.g = a.in[11]; int zc = -1;
            if (g < 8) zc = 32 * g;
            else if (g < 16) { const int gg = g - 8; zc = gg < 4 ? 256 + 32 * gg : (gg == 4 ? O_KR : -1); }
            else if (g < 24) zc = O_CKV + 32 * (g - 16);
            else if (g < 56) { const int base = g < 40 ? O_RQ : O_RK; const int q = (g - 24) & 15, t = q >> 3, gg = q & 7;
                const int h = 2 * t + ((gg >> 1) & 1), part = (gg >> 2) * 64 + (gg & 1) * 32; zc = base + h * 128 + part; }
            else if (g < 88) zc = O_RV + 32 * (g - 56);
            else if (g < 120) zc = O_RG + 32 * (g - 88);
            else if (g < 152) zc = O_GA + 32 * (g - 120);
            else zc = O_GB + 32 * (g - 152);
            if (zc >= 0) { s.W = a.in[12]; s.col0 = zc; }
            break; }
        case 3: s.W = a.in[15]; s.ld = 768; s.col0 = 32 * g; s.g = a.in[13]; break;
        case 4: s.W = a.in[16]; s.ld = 512; s.col0 = 32 * g; s.g = a.in[14]; break;
        case 5: s.W = a.in[17]; s.ld = 512; s.col0 = 32 * g; s.g = a.in[14]; break;
        case 6: s.W = a.in[18]; s.ld = D; s.col0 = 32 * g; break;
        case 7: s.W = a.in[20]; s.ld = D; s.col0 = 32 * g; break;
        default: s.W = a.in[21]; s.ld = D; s.col0 = 32 * g; break;
    }
    return s;
}
__device__ __forceinline__ void p0_transpose_item(const WSrc s, int K, bf16* WT, int n0, int k0, LAS float* scr, int lane) {
    if (s.W) {
        float v[32];
        const float* wp = s.W + (size_t)(k0 + (lane >> 5)) * s.ld + s.col0 + (lane & 31);
#pragma unroll
        for (int i = 0; i < 32; ++i) v[i] = wp[(size_t)(2 * i) * s.ld];
        if (s.g) { const float* gp = s.g + k0 + (lane >> 5);
#pragma unroll
            for (int i = 0; i < 32; ++i) v[i] *= gp[2 * i]; }
#pragma unroll
        for (int i = 0; i < 32; ++i) scr[(2 * i + (lane >> 5)) * 33 + (lane & 31)] = v[i];
    } else {
#pragma unroll 8
        for (int i = 0; i < 32; ++i) { const int kk = 2 * i + (lane >> 5); scr[kk * 33 + (lane & 31)] = 0.f; }
    }
    LDS_WAIT(); asm volatile("" ::: "memory");
    const int c = lane & 7;
#pragma unroll
    for (int j = 0; j < 4; ++j) { const int n = (lane >> 3) + 8 * j; const LAS float* sp = scr + (8 * c) * 33 + n;
        v4u o; o.x = pk2(sp[0 * 33], sp[1 * 33]); o.y = pk2(sp[2 * 33], sp[3 * 33]); o.z = pk2(sp[4 * 33], sp[5 * 33]); o.w = pk2(sp[6 * 33], sp[7 * 33]);
        *(GAS v4u*)(WT + (size_t)(n0 + n) * K + k0 + 8 * c) = o; }
    LDS_WAIT(); asm volatile("" ::: "memory");
}
__device__ __forceinline__ const float* x_src(const Args& a, int row) {
    if (row < MMAIN) return a.in[0] + (size_t)row * D;
    if (row < ROW_SMP) return a.in[6] + (size_t)(row - ROW_META) * D;
    if (row < ROW_PAD) return a.in[1] + (size_t)(row - ROW_SMP) * D;
    return nullptr;
}
__device__ __forceinline__ void p0_weights(const Args& a, unsigned id_mask, int gw, int NGW, LAS float* scr, int lane) {
    unsigned char* ws = a.ws;
    int base = 0;
#pragma unroll 1
    for (int id = 0; id < 11; ++id) {
        if (!((id_mask >> id) & 1u)) continue;
        int K, ngrp; wmat_dims(id, K, ngrp);
        const int nk = K / 64, nitems = nk * ngrp;
        bf16* WT = (bf16*)(ws + wmat_off(id));
        int first = (gw - (base % NGW) + NGW) % NGW;
        for (int it = first; it < nitems; it += NGW) { const int g = it % ngrp, kb = it / ngrp; p0_transpose_item(wmat_src(a, id, g), K, WT, 32 * g, 64 * kb, scr, lane); }
        base += nitems;
    }
}
__device__ __forceinline__ void p0_weights_late(Frame& F, const Args& a) {
    const int bx = (int)blockIdx.x; if (bx < 188) return;
    const int lane = fresh_tid(F.wave) & 63;
    LAS float* scr = (LAS float*)(F.lds + RING_OFF + F.wave * 16384);
    p0_weights(a, 0x380u  , (bx - 188) * NWAVES + F.wave, 68 * NWAVES, scr, lane);
    __syncthreads();
}
__device__ __forceinline__ void p0_prologue(Frame& F, const Args& a) {
    const int lane = fresh_tid(F.wave) & 63;
    LAS float* scr = (LAS float*)(F.lds + RING_OFF + F.wave * 16384);
    const int gw = F.vcu * NWAVES + F.wave, NGW = F.G * NWAVES;
    unsigned char* ws = a.ws;
    p0_weights(a, 0x47Fu  , gw, NGW, scr, lane);
    bf16* XB = (bf16*)(ws + WS_XB); float* XE = (float*)(ws + WS_XE); float* R1 = (float*)(ws + WS_R1);
    for (int m0 = gw; m0 < MP; m0 += 2 * NGW) {
        f32x4 v[2][4];
#pragma unroll
        for (int t = 0; t < 2; ++t) { const int m = m0 + t * NGW; const float* xr = m < MP ? x_src(a, m) : nullptr;
#pragma unroll
            for (int j = 0; j < 4; ++j) v[t][j] = xr ? *((const GAS f32x4*)xr + lane + 64 * j) : (f32x4){0.f, 0.f, 0.f, 0.f}; }
#pragma unroll
        for (int t = 0; t < 2; ++t) { const int m = m0 + t * NGW; if (m >= MP) break;
            float s = 0.f;
#pragma unroll
            for (int j = 0; j < 4; ++j) s += (v[t][j].x * v[t][j].x + v[t][j].y * v[t][j].y) + (v[t][j].z * v[t][j].z + v[t][j].w * v[t][j].w);
            s = wave_sum(s, lane);
            if (lane == 0) R1[m] = 1.0f / sqrtf(s * (1.f / D) + EPS);
            GAS unsigned long long* o8 = (GAS unsigned long long*)(XB + (size_t)m * D) + lane;
#pragma unroll
            for (int j = 0; j < 4; ++j) o8[64 * j] = (unsigned long long)pk2(v[t][j].x, v[t][j].y) | ((unsigned long long)pk2(v[t][j].z, v[t][j].w) << 32);
            if (m >= MMAIN) {
#pragma unroll
                for (int j = 0; j < 4; ++j) *((GAS f32x4*)(XE + (size_t)(m - MMAIN) * D) + lane + 64 * j) = v[t][j];
            } }
    }
    {   const float* wuq = a.in[15]; const float* wuk = a.in[16]; const float* qn = a.in[13]; bf16* WQL = (bf16*)(ws + WS_WQL);
        LAS float* U = (LAS float*)(F.lds + RING_OFF);
        const int tid = F.wave * 64 + lane;
        for (int it = F.vcu; it < 256; it += F.G) {
            const int h = it >> 5, r0 = (it & 31) * 8;
            __syncthreads();
            for (int e = tid; e < QR * 64; e += NWAVES * 64) { const int k = e >> 6, n = e & 63; U[k * 65 + n] = wuq[(size_t)k * 768 + h * 96 + n]; }
            { const int rr = tid >> 6, n = tid & 63; U[QR * 65 + rr * 64 + n] = wuk[(size_t)(r0 + rr) * 512 + h * 64 + n]; }
            __syncthreads();
            if (tid < QR) { const float g = qn[tid]; float acc[8];
#pragma unroll
                for (int rr = 0; rr < 8; ++rr) acc[rr] = 0.f;
                for (int n = 0; n < 64; ++n) { const float u = U[tid * 65 + n];
#pragma unroll
                    for (int rr = 0; rr < 8; ++rr) acc[rr] += u * U[QR * 65 + rr * 64 + n]; }
#pragma unroll
                for (int rr = 0; rr < 8; ++rr) WQL[(size_t)(h * 256 + r0 + rr) * QR + tid] = (bf16)f2bf(acc[rr] * g); }
        }
        __syncthreads();
    }
    { const int gt_ = (F.vcu * NWAVES + F.wave) * 64 + lane, NGT_ = NGW * 64;
      for (int e = gt_; e < MP; e += NGT_) { ((float*)(ws + WS_SSQH))[e] = 0.f; ((float*)(ws + WS_SSQ2_))[e] = 0.f; ((float*)(ws + WS_SSQ3_))[e] = 0.f; } }
    float* TAB = (float*)(ws + WS_TAB);
    const int gt = (F.vcu * NWAVES + F.wave) * 64 + lane, NGT = NGW * 64;
    for (int e = gt; e < NPOS * 64; e += NGT) { const int p = e >> 6, i = e & 63; const int pos = p < T ? p : PAST;
        const float invf = (float)pow(10000.0, -(double)i / 64.0); const float ang = (float)pos * invf;
        TAB[TAB_C64 / 4 + e] = (float)cos((double)ang); TAB[TAB_S64 / 4 + e] = (float)sin((double)ang); }
    for (int e = gt; e < NPOS * 16; e += NGT) { const int p = e >> 4, i = e & 15; const int pos = p < T ? p : PAST;
        const float invf = (float)pow(10000.0, -(double)i / 16.0); const float ang = (float)pos * invf;
        TAB[TAB_C16 / 4 + e] = (float)cos((double)ang); TAB[TAB_S16 / 4 + e] = (float)sin((double)ang); }
    for (int e = gt; e < 512; e += NGT) { const int h = e >> 7, j = e & 127; const double lg = log1p(-exp2(-5.0 - (double)h));
        TAB[TAB_GP / 4 + e] = (float)exp(lg * (double)j); TAB[TAB_GN / 4 + e] = (float)exp(-lg * (double)j); }
}

using pg8::f32x4; using pg8::u32x4; using pg8::Unit; using pg8::BM; using pg8::HALF;
typedef unsigned u32x2 __attribute__((ext_vector_type(2)));
__device__ __forceinline__ float fast_sigmoid(float x) { return __builtin_amdgcn_rcpf(1.f + __builtin_amdgcn_exp2f(-1.4426950408889634f * x)); }
__device__ __forceinline__ float fast_silu(float x) { return x * fast_sigmoid(x); }

struct EpiSwiGLU {
    static constexpr bool PERM = true, AFTER_DRAIN = false;
    bf16* ACT; const float* rs;
    __device__ __forceinline__ void operator()(const f32x4 (&acc)[2][2][4][2], const Unit& u, int wr, int wc, int fr, int fq) const {
        int l_ = lane_fresh(); asm volatile("" : "+v"(l_)); fr = l_ & 15; fq = l_ >> 4;
        const int row0 = u.pm * BM + wr * 64 + fr, col0 = u.pn * HALF + wc * 32 + 8 * fq;
#pragma unroll
        for (int ai = 0; ai < 2; ++ai)
#pragma unroll
            for (int m = 0; m < 4; ++m) { const int row = row0 + ai * HALF + m * 16; const float r = rs[row];
                f32x4 o[2];
#pragma unroll
                for (int n = 0; n < 2; ++n)
#pragma unroll
                    for (int j = 0; j < 4; ++j) { const float g = acc[ai][0][m][n][j] * r, up = acc[ai][1][m][n][j] * r; o[n][j] = fast_silu(g) * up; }
                u32x4 w; w.x = pg8::cvt_pk_bf16(o[0][0], o[0][1]); w.y = pg8::cvt_pk_bf16(o[0][2], o[0][3]); w.z = pg8::cvt_pk_bf16(o[1][0], o[1][1]); w.w = pg8::cvt_pk_bf16(o[1][2], o[1][3]);
                *(u32x4*)(ACT + (size_t)row * FFN + col0) = w; }
    }
};
template <class T> __device__ __forceinline__ T* at(unsigned char* w, unsigned byte_off) { return (T*)(w + byte_off); }
template <unsigned RES_OFF, bool RES_X, unsigned OUT_OFF, unsigned OUTB_OFF, unsigned SSQ_OFF, int SCALE2  > struct EpiResid {
    static constexpr bool PERM = false, AFTER_DRAIN = false;
    unsigned char* ws_; const float* xin;
    __device__ __forceinline__ void operator()(const f32x4 (&acc)[2][2][4][2], const Unit& u, int wr, int wc, int fr, int fq) const {
        int l_ = lane_fresh(); asm volatile("" : "+v"(l_)); fr = l_ & 15; fq = l_ >> 4;
        unsigned char* w = opaque_g(ws_);
        const unsigned row0 = u.pm * BM + wr * 64 + fr, col0 = u.pn * BM + wc * 32 + 4 * fq;
        constexpr float scale = 0.5f * SCALE2;
#pragma unroll
        for (int ai = 0; ai < 2; ++ai)
#pragma unroll
            for (int m = 0; m < 4; ++m) { unsigned row = row0 + ai * HALF + m * 16; asm volatile("" : "+v"(row));
                const float* rp;
                if (RES_X) rp = row < (unsigned)MMAIN ? xin + row * D + col0 : at<const float>(w, RES_OFF + ((row - MMAIN) * D + col0) * 4);
                else rp = at<const float>(w, RES_OFF + (row * D + col0) * 4);
                float ss = 0.f;
#pragma unroll
                for (int bj = 0; bj < 2; ++bj)
#pragma unroll
                    for (int n = 0; n < 2; ++n) { const f32x4 b = *(const f32x4*)(rp + bj * HALF + n * 16); const f32x4 o = b + acc[ai][bj][m][n] * scale;
                        const unsigned e = row * D + col0 + bj * HALF + n * 16;
                        *at<f32x4>(w, OUT_OFF + e * 4) = o;
                        ss += (o[0] * o[0] + o[1] * o[1]) + (o[2] * o[2] + o[3] * o[3]);
                        if (OUTB_OFF) { u32x2 pk; pk.x = pg8::cvt_pk_bf16(o[0], o[1]); pk.y = pg8::cvt_pk_bf16(o[2], o[3]); *at<u32x2>(w, OUTB_OFF + e * 2) = pk; } }
                ss += lx(ss, l_, 16); ss += lx(ss, l_, 32);
                if (fq == 0) atomicAdd(at<float>(w, SSQ_OFF + row * 4), ss);
                asm volatile("" ::: "memory"); }
    }
};
}
namespace mk {
constexpr size_t WS_CQ = WS_END1;
constexpr size_t WS_SSQCQ = WS_CQ + al((size_t)MP * QR * 2);
constexpr size_t WS_CKVF = WS_SSQCQ + al((size_t)MP * 8 * 4);
constexpr size_t WS_CKVB = WS_CKVF + al((size_t)MP * KVR * 4);
constexpr size_t WS_SSQKV = WS_CKVB + al((size_t)MP * KVR * 2);
constexpr size_t WS_KRB = WS_SSQKV + al((size_t)MP * 4 * 4);
constexpr size_t WS_RQ = WS_KRB + al((size_t)MP * 32 * 2);
constexpr size_t WS_RK = WS_RQ + al((size_t)MP * 512 * 2);
constexpr size_t WS_RKT = WS_RK + al((size_t)MP * 512 * 2);
constexpr size_t WS_RVT = WS_RKT + al((size_t)MP * 512 * 2);
constexpr size_t WS_SRG = WS_RVT + al((size_t)MP * 1024 * 2);
constexpr size_t WS_SGA = WS_SRG + al((size_t)MP * 1024 * 2);
constexpr size_t WS_SGB = WS_SGA + al((size_t)MP * 1024 * 2);
constexpr size_t WS_QA = WS_SGB + al((size_t)MP * 1024 * 2);
constexpr size_t WS_KN = WS_QA + al((size_t)MP * 768 * 2);
constexpr size_t WS_VT = WS_KN + al((size_t)MP * 512 * 2);
constexpr size_t WS_KRF = WS_VT + al((size_t)MP * 512 * 2);
constexpr size_t WS_END2 = WS_KRF + al((size_t)MP * 32 * 4);
constexpr float SC_Q = 0.14724444348433683f;
constexpr float RK_SCALE = 0.08838834764831845f;

constexpr size_t OUT_YP = 0, OUT_YS = OUT_YP + (size_t)NB * SEQ * D, OUT_CKVP = OUT_YS + (size_t)NS * D, OUT_KRP = OUT_CKVP + (size_t)NB * T * KVR,
                 OUT_SRP = OUT_KRP + (size_t)NB * T * 32, OUT_CKVS = OUT_SRP + (size_t)NB * RH * RDK * RDV, OUT_KRS = OUT_CKVS + (size_t)NS * KVR, OUT_SRS = OUT_KRS + (size_t)NS * 32,
                 OUT_END = OUT_SRS + (size_t)NS * RH * RDK * RDV;

__device__ __forceinline__ float row_rscale16(const float* SSQ, int row, float inv_n) { return 1.0f / sqrtf(SSQ[row] * inv_n + EPS); }
__device__ __forceinline__ float row_rscale8(const float* SSQ, int row, float inv_n) {
    const f32x4* p = (const f32x4*)(SSQ + (size_t)row * 8); const f32x4 a = p[0], b = p[1];
    return 1.0f / sqrtf((((a[0] + a[1]) + (a[2] + a[3])) + ((b[0] + b[1]) + (b[2] + b[3]))) * inv_n + EPS);
}
__device__ __forceinline__ float row_rscale4(const float* SSQ, int row, float inv_n) {
    const f32x4 a = *(const f32x4*)(SSQ + (size_t)row * 4);
    return 1.0f / sqrtf(((a[0] + a[1]) + (a[2] + a[3])) * inv_n + EPS);
}
__device__ __forceinline__ u32x2 pack4(const f32x4 v) { u32x2 w; w.x = pg8::cvt_pk_bf16(v[0], v[1]); w.y = pg8::cvt_pk_bf16(v[2], v[3]); return w; }
__device__ __forceinline__ float ssq4(const f32x4 v) { return (v[0] * v[0] + v[1] * v[1]) + (v[2] * v[2] + v[3] * v[3]); }
__device__ __forceinline__ bf16 bf1(float x) { return (bf16)f2bf(x); }

static_assert(WS_END2 < ((size_t)1 << 31), "32-bit workspace offsets");
__device__ __forceinline__ void tr_store16(LAS unsigned char* T, int fr, int fq, int lane, const f32x4 (&v)[4], unsigned char* w, unsigned dst_off) {
#pragma unroll
    for (int m = 0; m < 4; ++m)
#pragma unroll
        for (int j = 0; j < 4; ++j) *(LAS bf16*)(T + (4 * fq + j) * 144 + (16 * m + fr) * 2) = bf1(v[m][j]);
    asm volatile("s_waitcnt lgkmcnt(0)" ::: "memory");
#pragma unroll
    for (int k = 0; k < 2; ++k) { const int id = lane + 64 * k, c = id >> 3, part = id & 7; const v4u x = *(const LAS v4u*)(T + c * 144 + part * 16); *at<v4u>(w, dst_off + (unsigned)(c * MP + 8 * part) * 2u) = x; }
    asm volatile("s_waitcnt lgkmcnt(0)" ::: "memory");
}
constexpr int EPI_LDS_OFF = RING_BYTES, EPI_LDS_WAVE = 3072;
static_assert(EPI_LDS_OFF + 8 * EPI_LDS_WAVE <= SCR_BYTES && 16 * 144 <= EPI_LDS_WAVE, "epilogue LDS scratch");
struct EpiWin {
    static constexpr bool PERM = false, AFTER_DRAIN = false;
    unsigned char* ws_; LAS unsigned char* lds_;
#define MK_WS(var) unsigned char* var = opaque_g(ws_)
#define MK_ROWS_BEGIN _Pragma("unroll") for (int ai = 0; ai < 2; ++ai) _Pragma("unroll") for (int m = 0; m < 4; ++m) { \
        unsigned row = row0 + ai * HALF + m * 16; asm volatile("" : "+v"(row)); const float r = row_rscale16(at<const float>(w, (unsigned)WS_SSQH), (int)row, 1.f / D);
#define MK_ROWS_END asm volatile("" ::: "memory"); }
    __device__ __forceinline__ void operator()(const f32x4 (&acc)[2][2][4][2], const Unit& u, int wr, int wc, int fr, int fq) const {
        int l_ = lane_fresh(); asm volatile("" : "+v"(l_)); fr = l_ & 15; fq = l_ >> 4;
        const unsigned row0 = u.pm * BM + wr * 64 + fr; const int pn = u.pn;
        MK_WS(w);
        if (pn == 0) {
            MK_ROWS_BEGIN
                float ss = 0.f;
#pragma unroll
                for (int bj = 0; bj < 2; ++bj)
#pragma unroll
                    for (int n = 0; n < 2; ++n) { const f32x4 v = acc[ai][bj][m][n] * r; ss += ssq4(v); *at<u32x2>(w, (unsigned)WS_CQ + (row * QR + bj * HALF + wc * 32 + n * 16 + 4 * fq) * 2) = pack4(v); }
                ss += lx(ss, l_, 16); ss += lx(ss, l_, 32);
                if (fq == 0) *at<float>(w, (unsigned)WS_SSQCQ + (row * 8 + wc) * 4) = ss;
            MK_ROWS_END
        } else if (pn == 1) {
            MK_ROWS_BEGIN
                float ss = 0.f;
#pragma unroll
                for (int n = 0; n < 2; ++n) { const f32x4 v = acc[ai][0][m][n] * r; ss += ssq4(v); *at<u32x2>(w, (unsigned)WS_CQ + (row * QR + 256 + wc * 32 + n * 16 + 4 * fq) * 2) = pack4(v); }
                ss += lx(ss, l_, 16); ss += lx(ss, l_, 32);
                if (fq == 0) *at<float>(w, (unsigned)WS_SSQCQ + (row * 8 + 4 + wc) * 4) = ss;
                if (wc == 0) {
                    const f32x4 x1 = acc[ai][1][m][0] * r, x2 = acc[ai][1][m][1] * r;
                    const unsigned pi = row_pidx((int)row);
                    const f32x4 c = *at<const f32x4>(w, (unsigned)(WS_TAB + TAB_C16) + (pi * 16 + 4 * fq) * 4), s = *at<const f32x4>(w, (unsigned)(WS_TAB + TAB_S16) + (pi * 16 + 4 * fq) * 4);
                    const f32x4 y1 = x1 * c - x2 * s, y2 = x1 * s + x2 * c;
                    *at<u32x2>(w, (unsigned)WS_KRB + (row * 32 + 4 * fq) * 2) = pack4(y1); *at<u32x2>(w, (unsigned)WS_KRB + (row * 32 + 16 + 4 * fq) * 2) = pack4(y2);
                    *at<f32x4>(w, (unsigned)WS_KRF + (row * 32 + 4 * fq) * 4) = y1; *at<f32x4>(w, (unsigned)WS_KRF + (row * 32 + 16 + 4 * fq) * 4) = y2;
                }
            MK_ROWS_END
        } else if (pn == 2) {
            MK_ROWS_BEGIN
                float ss = 0.f;
#pragma unroll
                for (int bj = 0; bj < 2; ++bj)
#pragma unroll
                    for (int n = 0; n < 2; ++n) { const f32x4 v = acc[ai][bj][m][n] * r; ss += ssq4(v); const unsigned e = row * KVR + bj * HALF + wc * 32 + n * 16 + 4 * fq;
                        *at<f32x4>(w, (unsigned)WS_CKVF + e * 4) = v; *at<u32x2>(w, (unsigned)WS_CKVB + e * 2) = pack4(v); }
                ss += lx(ss, l_, 16); ss += lx(ss, l_, 32);
                if (fq == 0) *at<float>(w, (unsigned)WS_SSQKV + (row * 4 + wc) * 4) = ss;
            MK_ROWS_END
        } else if (pn < 7) {
            const bool isk = pn >= 5; const unsigned hh = 2 * ((pn - 3) & 1) + (wc >> 1);
            const unsigned dbase = (unsigned)(isk ? WS_RK : WS_RQ) + hh * 256, gbase = (unsigned)(WS_TAB + (isk ? TAB_GN : TAB_GP)) + hh * 512;
            LAS unsigned char* T = lds_ + EPI_LDS_OFF + (wr * 4 + wc) * EPI_LDS_WAVE;
#pragma unroll
            for (int ai = 0; ai < 2; ++ai) {
                f32x4 y1s[2][4], y2s[2][4];
#pragma unroll
                for (int m = 0; m < 4; ++m) {
                    unsigned row = row0 + ai * HALF + m * 16; asm volatile("" : "+v"(row)); const float r = row_rscale16(at<const float>(w, (unsigned)WS_SSQH), (int)row, 1.f / D);
                    const unsigned pi = row_pidx((int)row), jt = row_jtok((int)row);
                    const float mult = *at<const float>(w, gbase + jt * 4) * (isk ? RK_SCALE : 1.f);
#pragma unroll
                    for (int n = 0; n < 2; ++n) { const unsigned i0 = 32 * (wc & 1) + 16 * n + 4 * fq;
                        const f32x4 x1 = acc[ai][0][m][n] * r, x2 = acc[ai][1][m][n] * r;
                        const f32x4 c = *at<const f32x4>(w, (unsigned)(WS_TAB + TAB_C64) + (pi * 64 + i0) * 4), s = *at<const f32x4>(w, (unsigned)(WS_TAB + TAB_S64) + (pi * 64 + i0) * 4);
                        const f32x4 y1 = (x1 * c - x2 * s) * mult, y2 = (x1 * s + x2 * c) * mult;
                        *at<u32x2>(w, dbase + (row * 512 + i0) * 2) = pack4(y1); *at<u32x2>(w, dbase + (row * 512 + 64 + i0) * 2) = pack4(y2);
                        y1s[n][m] = y1; y2s[n][m] = y2; }
                    asm volatile("" ::: "memory");
                }
                if (isk) {
                    const unsigned rb = u.pm * BM + ai * HALF + wr * 64;
#pragma unroll
                    for (int n = 0; n < 2; ++n) { const unsigned c0 = hh * 128 + 32 * (wc & 1) + 16 * n;
                        tr_store16(T, fr, fq, l_, y1s[n], w, (unsigned)WS_RKT + (c0 * MP + rb) * 2u); tr_store16(T, fr, fq, l_, y2s[n], w, (unsigned)WS_RKT + ((c0 + 64) * MP + rb) * 2u); }
                }
            }
        } else if (pn < 11) {
            LAS unsigned char* T = lds_ + EPI_LDS_OFF + (wr * 4 + wc) * EPI_LDS_WAVE;
#pragma unroll
            for (int ai = 0; ai < 2; ++ai) {
                float rr[4];
#pragma unroll
                for (int m = 0; m < 4; ++m) { unsigned row = row0 + ai * HALF + m * 16; asm volatile("" : "+v"(row)); rr[m] = row_rscale16(at<const float>(w, (unsigned)WS_SSQH), (int)row, 1.f / D); }
                const unsigned rb = u.pm * BM + ai * HALF + wr * 64;
#pragma unroll
                for (int bj = 0; bj < 2; ++bj)
#pragma unroll
                    for (int n = 0; n < 2; ++n) { f32x4 vv[4];
#pragma unroll
                        for (int m = 0; m < 4; ++m) vv[m] = acc[ai][bj][m][n] * rr[m];
                        tr_store16(T, fr, fq, l_, vv, w, (unsigned)WS_RVT + (((pn - 7) * 256 + bj * HALF + wc * 32 + n * 16) * MP + rb) * 2u); }
                asm volatile("" ::: "memory");
            }
        } else {
            const int t = (pn - 11) >> 2; const unsigned dbase = (unsigned)WS_SRG + (unsigned)t * (unsigned)(WS_SGA - WS_SRG) + (((pn - 11) & 3) * 256 + wc * 32 + 4 * fq) * 2;
            MK_ROWS_BEGIN
#pragma unroll
                for (int bj = 0; bj < 2; ++bj)
#pragma unroll
                    for (int n = 0; n < 2; ++n) { const f32x4 v = acc[ai][bj][m][n] * r; f32x4 o;
#pragma unroll
                        for (int j = 0; j < 4; ++j) { const float sg = fast_sigmoid(v[j]); o[j] = t == 0 ? v[j] * sg : sg; }
                        *at<u32x2>(w, dbase + (row * 1024 + bj * HALF + n * 16) * 2) = pack4(o); }
            MK_ROWS_END
        }
    }
};
static_assert(WS_SGB - WS_SGA == WS_SGA - WS_SRG, "gate arrays equally spaced");
struct EpiQ {
    static constexpr bool PERM = false, AFTER_DRAIN = false;
    unsigned char* ws;
    __device__ __forceinline__ void operator()(const f32x4 (&acc)[2][2][4][2], const Unit& u, int wr, int wc, int fr, int fq) const {
        int l_ = lane_fresh(); asm volatile("" : "+v"(l_)); fr = l_ & 15; fq = l_ >> 4;
        const float* SSQCQ = (const float*)(ws + WS_SSQCQ); bf16* QA = (bf16*)(ws + WS_QA); const float* TAB = (const float*)(ws + WS_TAB);
        const int row0 = u.pm * BM + wr * 64 + fr;
#pragma unroll
        for (int ai = 0; ai < 2; ++ai)
#pragma unroll
            for (int m = 0; m < 4; ++m) {
                int row = row0 + ai * HALF + m * 16; asm volatile("" : "+v"(row));
                const float r = row_rscale8(SSQCQ, row, 1.f / QR) * SC_Q;
#pragma unroll
                for (int bj = 0; bj < 2; ++bj) {
                    const int grp = 8 * u.pn + 4 * bj + wc;
                    bf16* dst = QA + (size_t)row * 768 + 32 * grp + 4 * fq;
                    const bool rope = (grp % 3) == 2;
                    const int pi = row_pidx(row);
                    f32x4 c = *(const f32x4*)(TAB + TAB_C16 / 4 + pi * 16 + 4 * fq), s = *(const f32x4*)(TAB + TAB_S16 / 4 + pi * 16 + 4 * fq);
                    if (!rope) { c = (f32x4){1.f, 1.f, 1.f, 1.f}; s = (f32x4){0.f, 0.f, 0.f, 0.f}; }
                    const f32x4 x1 = acc[ai][bj][m][0] * r, x2 = acc[ai][bj][m][1] * r;
                    *(u32x2*)dst = pack4(x1 * c - x2 * s); *(u32x2*)(dst + 16) = pack4(x1 * s + x2 * c);
                }
                asm volatile("" ::: "memory");
            }
    }
};
template <bool ROWS> struct EpiScaleBf16 {
    static constexpr bool PERM = true, AFTER_DRAIN = false;
    const float* SSQKV; bf16* O; int ldc;
    __device__ __forceinline__ void operator()(const f32x4 (&acc)[2][2][4][2], const Unit& u, int wr, int wc, int fr, int fq) const {
        int l_ = lane_fresh(); asm volatile("" : "+v"(l_)); fr = l_ & 15; fq = l_ >> 4;
        const int row0 = u.pm * BM + wr * 64 + fr, col0 = u.pn * BM + wc * 32 + 8 * fq;
        float cs[2][8];
        if (!ROWS) {
#pragma unroll
            for (int bj = 0; bj < 2; ++bj)
#pragma unroll
                for (int k = 0; k < 8; ++k) cs[bj][k] = row_rscale4(SSQKV, col0 + bj * HALF + k, 1.f / KVR);
        }
#pragma unroll
        for (int ai = 0; ai < 2; ++ai)
#pragma unroll
            for (int m = 0; m < 4; ++m) { int row = row0 + ai * HALF + m * 16; asm volatile("" : "+v"(row)); const float r = ROWS ? row_rscale4(SSQKV, row, 1.f / KVR) : 1.f;
#pragma unroll
                for (int bj = 0; bj < 2; ++bj) { f32x4 v0 = acc[ai][bj][m][0], v1 = acc[ai][bj][m][1];
                    if (ROWS) { v0 = v0 * r; v1 = v1 * r; }
                    else {
#pragma unroll
                        for (int j = 0; j < 4; ++j) { v0[j] *= cs[bj][j]; v1[j] *= cs[bj][4 + j]; } }
                    u32x4 w; w.x = pg8::cvt_pk_bf16(v0[0], v0[1]); w.y = pg8::cvt_pk_bf16(v0[2], v0[3]); w.z = pg8::cvt_pk_bf16(v1[0], v1[1]); w.w = pg8::cvt_pk_bf16(v1[2], v1[3]);
                    *(u32x4*)(O + (size_t)row * ldc + col0 + bj * HALF) = w; } }
    }
};
__device__ __forceinline__ void finalize_ckv(Frame& F, const Ptrs& a) {
    const int lane = fresh_tid(F.wave) & 63;
    const int gw = F.vcu * NWAVES + F.wave, NGW = F.G * NWAVES;
    const float* CKVF = (const float*)(a.ws + WS_CKVF); const float* SSQKV = (const float*)(a.ws + WS_SSQKV); const float* KRF = (const float*)(a.ws + WS_KRF);
    const f32x4 g = *((const f32x4*)a.in(14) + lane);
    for (int row = gw; row < ROW_PAD; row += NGW) {
        const float r = row_rscale4(SSQKV, row, 1.f / KVR);
        const f32x4 o = *((const f32x4*)(CKVF + (size_t)row * KVR) + lane) * r * g;
        const f32x4 kr = *((const f32x4*)(KRF + (size_t)row * 32) + (lane & 7));
        if (row < MMAIN) { const size_t t = (size_t)(row >> 11) * T + NMETA + (row & (SEQ - 1)); *((f32x4*)(a.out() + OUT_CKVP + t * KVR) + lane) = o; if (lane < 8) *((f32x4*)(a.out() + OUT_KRP + t * 32) + lane) = kr; }
        else if (row < ROW_SMP) { for (int b = 0; b < NB; ++b) { const size_t t = (size_t)b * T + (row - ROW_META); *((f32x4*)(a.out() + OUT_CKVP + t * KVR) + lane) = o; if (lane < 8) *((f32x4*)(a.out() + OUT_KRP + t * 32) + lane) = kr; } }
        else { *((f32x4*)(a.out() + OUT_CKVS + (size_t)(row - ROW_SMP) * KVR) + lane) = o; if (lane < 8) *((f32x4*)(a.out() + OUT_KRS + (size_t)(row - ROW_SMP) * 32) + lane) = kr; }
    }
}
}
namespace mk {
constexpr size_t WS_AV = WS_END2;
constexpr size_t WS_END3 = WS_AV + al((size_t)MP * 512 * 2);
typedef float f32x16 __attribute__((ext_vector_type(16)));
constexpr int AT_KSTR = 208, AT_VSTR = 144, AT_KBUF = 64 * AT_KSTR, AT_VBUF = 64 * AT_VSTR, AT_VOFF = 2 * AT_KBUF;
__device__ __forceinline__ int crow(int i, int half) { return (i & 3) + 8 * (i >> 2) + 4 * half; }

__device__ __forceinline__ void attn_unit(Frame& F, unsigned char* ws, int b, int h, int qb) {
    ws = opaque_g(ws);
    const int tid = fresh_tid(F.wave), lane = tid & 63, w = F.wave, q = lane & 31, half = lane >> 5;
    LAS unsigned char* L = F.lds + RING_OFF;
    const bf16* QA = (const bf16*)(ws + WS_QA); const bf16* KN = (const bf16*)(ws + WS_KN); const bf16* KRB = (const bf16*)(ws + WS_KRB); const bf16* VT = (const bf16*)(ws + WS_VT);
    const int qrow = b * SEQ + qb * 256 + w * 32 + q, q_main = qb * 256 + w * 32 + q, wq0 = qb * 256 + w * 32;
    bf16x8 qf[6];
#pragma unroll
    for (int s = 0; s < 6; ++s) qf[s] = *(const bf16x8*)(QA + (size_t)qrow * 768 + h * 96 + 16 * s + 8 * half);
    f32x16 ot[2];
#pragma unroll
    for (int i = 0; i < 16; ++i) { ot[0][i] = 0.f; ot[1][i] = 0.f; }
    float m = -INFINITY, l = 0.f;
    const int NT = 4 * (qb + 1);
    v4u kreg, rreg, vreg; rreg = (v4u){0u, 0u, 0u, 0u};
#define AT_LOAD(tt) do { const int t0_ = (tt) == 0 ? ROW_META : b * SEQ + 64 * ((tt) - 1); \
        kreg = *(const v4u*)(KN + (size_t)(t0_ + (tid >> 3)) * 512 + h * 64 + (tid & 7) * 8); \
        if (tid < 256) rreg = *(const v4u*)(KRB + (size_t)(t0_ + (tid >> 2)) * 32 + (tid & 3) * 8); \
        vreg = *(const v4u*)(VT + (size_t)(h * 64 + (tid >> 3)) * MP + t0_ + (tid & 7) * 8); } while (0)
#define AT_STORE(buf) do { LAS unsigned char* kb_ = L + (buf) * AT_KBUF; \
        *(LAS v4u*)(kb_ + (tid >> 3) * AT_KSTR + (tid & 7) * 16) = kreg; \
        if (tid < 256) *(LAS v4u*)(kb_ + (tid >> 2) * AT_KSTR + 128 + (tid & 3) * 16) = rreg; \
        LAS unsigned char* vb_ = L + AT_VOFF + (buf) * AT_VBUF + (tid >> 3) * AT_VSTR + (32 * ((tid & 7) >> 1) + 8 * (tid & 1)); \
        *(LAS u32x2*)(vb_) = (u32x2){vreg.x, vreg.y}; *(LAS u32x2*)(vb_ + 16) = (u32x2){vreg.z, vreg.w}; } while (0)
    AT_LOAD(0); AT_STORE(0);
    __syncthreads();
    for (int tt = 0; tt <= NT; ++tt) {
        const int buf = tt & 1;
        if (tt < NT) AT_LOAD(tt + 1);
        const int kmin = tt == 0 ? 0 : 64 * (tt - 1);
        if (tt == 0 || kmin <= wq0 + 31) {
            const LAS unsigned char* Kb = L + buf * AT_KBUF + q * AT_KSTR + 16 * half;
            const LAS unsigned char* Vb = L + AT_VOFF + buf * AT_VBUF + q * AT_VSTR + 16 * half;
            f32x16 st[2];
#pragma unroll
            for (int kb = 0; kb < 2; ++kb) {
#pragma unroll
                for (int i = 0; i < 16; ++i) st[kb][i] = 0.f;
#pragma unroll
                for (int s = 0; s < 6; ++s) { const bf16x8 kf = *(const LAS bf16x8*)(Kb + kb * 32 * AT_KSTR + 32 * s); st[kb] = __builtin_amdgcn_mfma_f32_32x32x16_bf16(kf, qf[s], st[kb], 0, 0, 0); }
            }
            if (tt == 0) {
#pragma unroll
                for (int kb = 0; kb < 2; ++kb)
#pragma unroll
                    for (int i = 0; i < 16; ++i) if (32 * kb + crow(i, half) >= NMETA) st[kb][i] = -INFINITY;
            } else if (kmin + 63 > wq0) {
#pragma unroll
                for (int kb = 0; kb < 2; ++kb)
#pragma unroll
                    for (int i = 0; i < 16; ++i) if (kmin + 32 * kb + crow(i, half) > q_main) st[kb][i] = -INFINITY;
            }
            float mx = st[0][0];
#pragma unroll
            for (int i = 1; i < 16; ++i) mx = fmaxf(mx, st[0][i]);
#pragma unroll
            for (int i = 0; i < 16; ++i) mx = fmaxf(mx, st[1][i]);
            mx = fmaxf(mx, lx(mx, lane, 32));
            const float mn = fmaxf(m, mx), alpha = __builtin_amdgcn_exp2f(m - mn);
            m = mn;
            float ps = 0.f;
#pragma unroll
            for (int kb = 0; kb < 2; ++kb)
#pragma unroll
                for (int i = 0; i < 16; ++i) { st[kb][i] = __builtin_amdgcn_exp2f(st[kb][i] - mn); ps += st[kb][i]; }
            l = l * alpha + ps;
#pragma unroll
            for (int i = 0; i < 16; ++i) { ot[0][i] *= alpha; ot[1][i] *= alpha; }
#pragma unroll
            for (int kb = 0; kb < 2; ++kb)
#pragma unroll
                for (int s2 = 0; s2 < 2; ++s2) {
                    u32x4 pw; pw.x = pg8::cvt_pk_bf16(st[kb][8 * s2 + 0], st[kb][8 * s2 + 1]); pw.y = pg8::cvt_pk_bf16(st[kb][8 * s2 + 2], st[kb][8 * s2 + 3]);
                    pw.z = pg8::cvt_pk_bf16(st[kb][8 * s2 + 4], st[kb][8 * s2 + 5]); pw.w = pg8::cvt_pk_bf16(st[kb][8 * s2 + 6], st[kb][8 * s2 + 7]);
                    const bf16x8 pf = __builtin_bit_cast(bf16x8, pw);
#pragma unroll
                    for (int vb = 0; vb < 2; ++vb) { const bf16x8 vf = *(const LAS bf16x8*)(Vb + vb * 32 * AT_VSTR + (32 * kb + 16 * s2) * 2); ot[vb] = __builtin_amdgcn_mfma_f32_32x32x16_bf16(vf, pf, ot[vb], 0, 0, 0); }
                }
        }
        if (tt < NT) AT_STORE(buf ^ 1);
        __syncthreads();
    }
#undef AT_LOAD
#undef AT_STORE
    l += lx(l, lane, 32);
    const float inv = 1.0f / l;
    bf16* AV = (bf16*)(ws + WS_AV) + (size_t)qrow * 512 + h * 64 + 4 * half;
#pragma unroll
    for (int vb = 0; vb < 2; ++vb)
#pragma unroll
        for (int g = 0; g < 4; ++g) { f32x4 o; o[0] = ot[vb][4 * g] * inv; o[1] = ot[vb][4 * g + 1] * inv; o[2] = ot[vb][4 * g + 2] * inv; o[3] = ot[vb][4 * g + 3] * inv; *(u32x2*)(AV + 32 * vb + 8 * g) = pack4(o); }
}
__device__ __forceinline__ void attn_item(Frame& F, unsigned char* ws, int i) { const int bh = i & 63; attn_unit(F, ws, bh >> 3, bh & 7, 7 - (i >> 6)); }
__device__ __forceinline__ void attn_phase(Frame& F, unsigned char* ws) {
    const int c = F.vcu;
    if (c >= 256) return;
    const int bh = c >> 2, p = c & 3;
    attn_unit(F, ws, bh >> 3, bh & 7, 7 - p);
    attn_unit(F, ws, bh >> 3, bh & 7, p);
}
}
namespace mk {
constexpr size_t WS_UMETA = WS_END3;
constexpr size_t WS_UT = WS_UMETA + al((size_t)RH * RDV * RDK * 4);
constexpr size_t WS_SPREV = WS_UT + al((size_t)32 * 16 * RDV * RDK * 4);
constexpr size_t WS_RIN = WS_SPREV + al((size_t)32 * 16 * RDV * RDK * 2);
constexpr size_t WS_DPART = WS_RIN + al((size_t)MP * 1024 * 2);
constexpr size_t WS_QL = WS_DPART + al((size_t)32 * 16 * 8 * 264 * 4);
constexpr size_t WS_END4 = WS_QL + al((size_t)64 * 2048 * 4);
static_assert(WS_END4 < ((size_t)1 << 31), "32-bit workspace offsets");
__device__ __forceinline__ float gpow_t(const unsigned char* ws, int h, int n) { return ((const float*)(ws + WS_TAB + TAB_GP))[h * 128 + n]; }

__device__ __forceinline__ void ret_u_unit(Frame& F, unsigned char* ws, int u) {
    ws = opaque_g(ws);
    const int tid = fresh_tid(F.wave), lane = tid & 63, w = F.wave, r32 = lane & 31, half = lane >> 5;
    const bool meta = u >= 512; const int hh = meta ? u - 512 : (u >> 4) & 3;
    const int tok0 = meta ? ROW_META : (u >> 6) * SEQ + (u & 15) * 128, nks = meta ? 1 : 8;
    const bf16* RVT = (const bf16*)(ws + WS_RVT); const bf16* RKT = (const bf16*)(ws + WS_RKT);
    f32x16 acc[4];
#pragma unroll
    for (int db = 0; db < 4; ++db)
#pragma unroll
        for (int i = 0; i < 16; ++i) acc[db][i] = 0.f;
    const bf16* ap = RVT + (size_t)(hh * 256 + 32 * w + r32) * MP + tok0 + 8 * half;
    const bf16* bp = RKT + (size_t)(hh * 128 + r32) * MP + tok0 + 8 * half;
    for (int s = 0; s < nks; ++s) {
        const bf16x8 af = *(const bf16x8*)(ap + 16 * s);
#pragma unroll
        for (int db = 0; db < 4; ++db) { const bf16x8 bf = *(const bf16x8*)(bp + (size_t)(32 * db) * MP + 16 * s); acc[db] = __builtin_amdgcn_mfma_f32_32x32x16_bf16(af, bf, acc[db], 0, 0, 0); }
    }
    const float sc = gpow_t(ws, hh, meta ? NMETA - 1 : 127);
    float* dst = meta ? (float*)(ws + WS_UMETA) + (size_t)hh * RDV * RDK : (float*)(ws + WS_UT) + (size_t)u * RDV * RDK;
#pragma unroll
    for (int db = 0; db < 4; ++db)
#pragma unroll
        for (int i = 0; i < 16; ++i) dst[(size_t)(32 * w + crow(i, half)) * RDK + 32 * db + r32] = acc[db][i] * sc;
}
__device__ __forceinline__ void ret_scan(Frame& F, const Ptrs& a) {
    const int tid = fresh_tid(F.wave);
    const int gt = (F.vcu * NWAVES * 64) + tid, NGT = F.G * NWAVES * 64;
    const float* UM = (const float*)(a.ws + WS_UMETA); const float* UT = (const float*)(a.ws + WS_UT); bf16* SP = (bf16*)(a.ws + WS_SPREV);
    for (int e = gt; e < 32 * RDV * RDK; e += NGT) {
        const int bh = e >> 15, idx = e & 32767, hh = bh & 3;
        const float g128 = gpow_t(a.ws, hh, 127) * gpow_t(a.ws, hh, 1);
        float S = UM[(size_t)hh * 32768 + idx];
        for (int c = 0; c < 16; ++c) { const size_t o = ((size_t)bh * 16 + c) * 32768 + idx; SP[o] = bf1(S); S = g128 * S + UT[o]; }
        const int ee = idx >> 7, d = idx & 127;
        a.out()[OUT_SRP + ((size_t)bh * RDK + d) * RDV + ee] = S;
    }
}
__device__ __forceinline__ void ret_o_unit(Frame& F, const Ptrs& a, int u) {
    unsigned char* ws = a.ws; ws = opaque_g(ws);
    const int tid = fresh_tid(F.wave), lane = tid & 63, w = F.wave, r32 = lane & 31, half = lane >> 5;
    const int bh = u >> 4, c = u & 15, hh = bh & 3, tok0 = (bh >> 2) * SEQ + c * 128;
    const int ib = w & 3, eh = w >> 2;
    LAS float* red = (LAS float*)(F.lds + RING_OFF);
    const bf16* RQ = (const bf16*)(ws + WS_RQ); const bf16* RK = (const bf16*)(ws + WS_RK); const bf16* RVT = (const bf16*)(ws + WS_RVT);
    const bf16* SP = (const bf16*)(ws + WS_SPREV) + (size_t)u * 32768;
    const int irow = tok0 + 32 * ib + r32;
    bf16x8 qf[8];
#pragma unroll
    for (int s = 0; s < 8; ++s) qf[s] = *(const bf16x8*)(RQ + (size_t)irow * 512 + hh * 128 + 16 * s + 8 * half);
    f32x16 ot[4];
#pragma unroll
    for (int eb = 0; eb < 4; ++eb) {
#pragma unroll
        for (int i = 0; i < 16; ++i) ot[eb][i] = 0.f;
        const bf16* sp = SP + (size_t)(128 * eh + 32 * eb + r32) * RDK + 8 * half;
#pragma unroll
        for (int s = 0; s < 8; ++s) { const bf16x8 sf = *(const bf16x8*)(sp + 16 * s); ot[eb] = __builtin_amdgcn_mfma_f32_32x32x16_bf16(sf, qf[s], ot[eb], 0, 0, 0); }
    }
    const float g = gpow_t(ws, hh, 1);
#pragma unroll
    for (int eb = 0; eb < 4; ++eb)
#pragma unroll
        for (int i = 0; i < 16; ++i) ot[eb][i] *= g;
    for (int jb = 0; jb <= ib; ++jb) {
        f32x16 at;
#pragma unroll
        for (int i = 0; i < 16; ++i) at[i] = 0.f;
        const bf16* kp = RK + (size_t)(tok0 + 32 * jb + r32) * 512 + hh * 128 + 8 * half;
#pragma unroll
        for (int s = 0; s < 8; ++s) { const bf16x8 kf = *(const bf16x8*)(kp + 16 * s); at = __builtin_amdgcn_mfma_f32_32x32x16_bf16(kf, qf[s], at, 0, 0, 0); }
        if (jb == ib) {
#pragma unroll
            for (int i = 0; i < 16; ++i) if (crow(i, half) > r32) at[i] = 0.f;
        }
#pragma unroll
        for (int s2 = 0; s2 < 2; ++s2) {
            u32x4 pw; pw.x = pg8::cvt_pk_bf16(at[8 * s2 + 0], at[8 * s2 + 1]); pw.y = pg8::cvt_pk_bf16(at[8 * s2 + 2], at[8 * s2 + 3]);
            pw.z = pg8::cvt_pk_bf16(at[8 * s2 + 4], at[8 * s2 + 5]); pw.w = pg8::cvt_pk_bf16(at[8 * s2 + 6], at[8 * s2 + 7]);
            const bf16x8 pf = __builtin_bit_cast(bf16x8, pw);
#pragma unroll
            for (int eb = 0; eb < 4; ++eb) {
                const bf16* vp = RVT + (size_t)(hh * 256 + 128 * eh + 32 * eb + r32) * MP + tok0 + 32 * jb + 16 * s2 + 4 * half;
                const u32x2 lo = *(const u32x2*)vp, hi = *(const u32x2*)(vp + 8);
                u32x4 vw; vw.x = lo.x; vw.y = lo.y; vw.z = hi.x; vw.w = hi.y;
                ot[eb] = __builtin_amdgcn_mfma_f32_32x32x16_bf16(__builtin_bit_cast(bf16x8, vw), pf, ot[eb], 0, 0, 0);
            }
        }
    }
    float s1 = 0.f;
#pragma unroll
    for (int eb = 0; eb < 4; ++eb)
#pragma unroll
        for (int i = 0; i < 16; ++i) s1 += ot[eb][i];
    s1 += lx(s1, lane, 32);
    if (half == 0) red[w * 32 + r32] = s1;
    __syncthreads();
    const float mu = (red[w * 32 + r32] + red[(w ^ 4) * 32 + r32]) * (1.f / 256.f);
    float s2 = 0.f;
#pragma unroll
    for (int eb = 0; eb < 4; ++eb)
#pragma unroll
        for (int i = 0; i < 16; ++i) { ot[eb][i] -= mu; s2 += ot[eb][i] * ot[eb][i]; }
    s2 += lx(s2, lane, 32);
    if (half == 0) red[256 + w * 32 + r32] = s2;
    __syncthreads();
    const float rstd = 1.0f / sqrtf((red[256 + w * 32 + r32] + red[256 + (w ^ 4) * 32 + r32]) * (1.f / 256.f) + EPS);
    __syncthreads();
    const bf16* SRG = (const bf16*)(ws + WS_SRG) + (size_t)irow * 1024 + hh * 256 + 128 * eh + 4 * half;
    bf16* RIN = (bf16*)(ws + WS_RIN) + (size_t)irow * 1024 + hh * 256 + 128 * eh + 4 * half;
    const float* gn = a.in(19) + hh * 256 + 128 * eh + 4 * half;
#pragma unroll
    for (int eb = 0; eb < 4; ++eb)
#pragma unroll
        for (int gq = 0; gq < 4; ++gq) {
            const int eo = 32 * eb + 8 * gq;
            const u32x2 sg = *(const u32x2*)(SRG + eo); const f32x4 gv = *(const f32x4*)(gn + eo);
            f32x4 o;
            o[0] = ot[eb][4 * gq + 0] * rstd * gv[0] * __uint_as_float(sg.x << 16); o[1] = ot[eb][4 * gq + 1] * rstd * gv[1] * __uint_as_float(sg.x & 0xffff0000u);
            o[2] = ot[eb][4 * gq + 2] * rstd * gv[2] * __uint_as_float(sg.y << 16); o[3] = ot[eb][4 * gq + 3] * rstd * gv[3] * __uint_as_float(sg.y & 0xffff0000u);
            *(u32x2*)(RIN + eo) = pack4(o);
        }
}
__device__ __forceinline__ void ret_sample_unit(Frame& F, const Ptrs& a, int u) {
    unsigned char* ws = a.ws; ws = opaque_g(ws);
    const int tid = fresh_tid(F.wave), lane = tid & 63, s = u >> 2, hh = u & 3, e = tid & 255, dh = tid >> 8, row = ROW_SMP + s;
    LAS float* sh = (LAS float*)(F.lds + RING_OFF);
    const bf16* RQ = (const bf16*)(ws + WS_RQ); const bf16* RK = (const bf16*)(ws + WS_RK); const bf16* RVT = (const bf16*)(ws + WS_RVT);
    if (tid < 128) sh[tid] = __uint_as_float((unsigned)RQ[(size_t)row * 512 + hh * 128 + tid] << 16);
    else if (tid < 256) sh[tid] = __uint_as_float((unsigned)RK[(size_t)row * 512 + hh * 128 + tid - 128] << 16);
    __syncthreads();
    const float v = __uint_as_float((unsigned)RVT[(size_t)(hh * 256 + e) * MP + row] << 16);
    const float g = gpow_t(ws, hh, 1);
    const float* S0 = a.in(4) + ((size_t)(s * RH + hh) * RDK) * RDV + e;
    float* S1 = a.out() + OUT_SRS + ((size_t)(s * RH + hh) * RDK) * RDV + e;
    float o = 0.f;
    {   float s0[64];
#pragma unroll
        for (int k = 0; k < 64; ++k) s0[k] = S0[(size_t)(64 * dh + k) * RDV];
#pragma unroll
        for (int k = 0; k < 64; ++k) { const int d = 64 * dh + k; const float sn = g * s0[k] + sh[128 + d] * v; S1[(size_t)d * RDV] = sn; o += sh[d] * sn; } }
    sh[256 + dh * 256 + e] = o;
    __syncthreads();
    o = sh[256 + e] + sh[512 + e];
    float t1 = o;
#pragma unroll
    for (int off = 32; off > 0; off >>= 1) t1 += lx(t1, lane, off);
    if ((tid & 63) == 0) sh[768 + (tid >> 6)] = t1;
    __syncthreads();
    const float mu = (sh[768] + sh[769] + sh[770] + sh[771]) * (1.f / 256.f);
    const float dlt = o - mu;
    float t2 = dlt * dlt;
#pragma unroll
    for (int off = 32; off > 0; off >>= 1) t2 += lx(t2, lane, off);
    if ((tid & 63) == 0) sh[776 + (tid >> 6)] = t2;
    __syncthreads();
    const float rstd = 1.0f / sqrtf((sh[776] + sh[777] + sh[778] + sh[779]) * (1.f / 256.f) + EPS);
    if (dh == 0) { const float sg = __uint_as_float((unsigned)((const bf16*)(ws + WS_SRG))[(size_t)row * 1024 + hh * 256 + e] << 16);
        ((bf16*)(ws + WS_RIN))[(size_t)row * 1024 + hh * 256 + e] = bf1(dlt * rstd * a.in(19)[hh * 256 + e] * sg); }
    __syncthreads();
}
}
namespace mk {
template <int CTRL> __device__ __forceinline__ float dppf(float v) { return __int_as_float(__builtin_amdgcn_update_dpp(0, __float_as_int(v), CTRL, 0xF, 0xF, false)); }
__device__ __forceinline__ float swap32_add(float a, float b) { const auto r = __builtin_amdgcn_permlane32_swap(__float_as_uint(a), __float_as_uint(b), false, false); return __uint_as_float(r[0]) + __uint_as_float(r[1]); }
__device__ __forceinline__ float swap16_add(float a, float b) { const auto r = __builtin_amdgcn_permlane16_swap(__float_as_uint(a), __float_as_uint(b), false, false); return __uint_as_float(r[0]) + __uint_as_float(r[1]); }
__device__ __forceinline__ int dlane_of(int h) { return ((h >> 2) & 1) * 32 + ((h >> 1) & 1) * 16 + (h & 1) * 8; }
__device__ __forceinline__ void decode_unit(Frame& F, const Ptrs& a, int u) {
    unsigned char* ws = a.ws; ws = opaque_g(ws);
    const int tid = fresh_tid(F.wave), lane = tid & 63, w = F.wave, s = u >> 4, sp = u & 15, row = ROW_SMP + s;
    LAS float* sh = (LAS float*)(F.lds + RING_OFF);
    const bf16* QA = (const bf16*)(ws + WS_QA) + (size_t)row * 768;
    f32x4 ql[8]; float qr[8];
    { const float* QLr = (const float*)(ws + WS_QL) + (size_t)(row - MMAIN) * 2048;
#pragma unroll
      for (int h = 0; h < 8; ++h) { ql[h] = *(const f32x4*)(QLr + h * 256 + 4 * lane); qr[h] = lane < 32 ? __uint_as_float((unsigned)QA[h * 96 + 64 + lane] << 16) : 0.f; } }
    f32x4 O[8];
#pragma unroll
    for (int h = 0; h < 8; ++h) O[h] = (f32x4){0.f, 0.f, 0.f, 0.f};
    float m = -INFINITY, l = 0.f;
    const int page = ((const int*)a.in(5))[s * NPAGES + sp * 8 + w];
    const float* ck0 = a.in(2) + (size_t)page * PAGE * KVR + 4 * lane;
    const float* kr0 = a.in(3) + (size_t)page * PAGE * 32 + (lane & 31);
#define DC_LOAD(kv_, rv_, bi_) do { const float* c_ = ck0; const float* r_ = kr0; const int k0_ = (bi_) * 4; \
        _Pragma("unroll") for (int kk = 0; kk < 4; ++kk) { kv_[kk] = *(const f32x4*)(c_ + (size_t)(k0_ + kk) * KVR); rv_[kk] = r_[(size_t)(k0_ + kk) * 32]; } } while (0)
#define DC_COMPUTE(kv_, rv_) do { float sc[4]; \
        _Pragma("unroll") for (int kk = 0; kk < 4; ++kk) { float p[8]; \
            _Pragma("unroll") for (int h = 0; h < 8; ++h) p[h] = fmaf(ql[h][0], kv_[kk][0], fmaf(ql[h][1], kv_[kk][1], fmaf(ql[h][2], kv_[kk][2], fmaf(ql[h][3], kv_[kk][3], qr[h] * rv_[kk])))); \
              \
            const float a0 = swap32_add(p[0], p[4]), a1 = swap32_add(p[1], p[5]), a2 = swap32_add(p[2], p[6]), a3 = swap32_add(p[3], p[7]); \
            const float b0 = swap16_add(a0, a2), b1 = swap16_add(a1, a3); \
            const float c0 = b0 + dppf<0x128>(b0), c1 = b1 + dppf<0x128>(b1); \
            float v1 = (lane & 8) ? c1 : c0; \
            v1 += dppf<0xB1>(v1); v1 += dppf<0x4E>(v1); v1 += dppf<0x141>(v1); sc[kk] = v1; } \
        const float mx = fmaxf(fmaxf(sc[0], sc[1]), fmaxf(sc[2], sc[3])); \
        const float mn = fmaxf(m, mx), alpha = __builtin_amdgcn_exp2f(m - mn); m = mn; \
        float pe[4]; \
        _Pragma("unroll") for (int kk = 0; kk < 4; ++kk) pe[kk] = __builtin_amdgcn_exp2f(sc[kk] - mn); \
        l = l * alpha + ((pe[0] + pe[1]) + (pe[2] + pe[3])); \
        _Pragma("unroll") for (int h = 0; h < 8; ++h) { const int src = dlane_of(h); \
            const float ah = __int_as_float(__builtin_amdgcn_readlane(__float_as_int(alpha), src)), p0 = __int_as_float(__builtin_amdgcn_readlane(__float_as_int(pe[0]), src)), p1 = __int_as_float(__builtin_amdgcn_readlane(__float_as_int(pe[1]), src)), \
                        p2 = __int_as_float(__builtin_amdgcn_readlane(__float_as_int(pe[2]), src)), p3 = __int_as_float(__builtin_amdgcn_readlane(__float_as_int(pe[3]), src)); \
            O[h] = O[h] * ah + kv_[0] * p0 + kv_[1] * p1 + kv_[2] * p2 + kv_[3] * p3; } } while (0)
    f32x4 kvA[4], kvB[4], kvC[4]; float rvA[4], rvB[4], rvC[4];
#define DC_PIN() __builtin_amdgcn_sched_barrier(0)
    DC_LOAD(kvA, rvA, 0); DC_LOAD(kvB, rvB, 1); DC_PIN();
#pragma unroll 1
    for (int bi = 0; bi < 30; bi += 3) {
        DC_LOAD(kvC, rvC, bi + 2); DC_PIN();
        DC_COMPUTE(kvA, rvA); DC_PIN();
        DC_LOAD(kvA, rvA, bi + 3); DC_PIN();
        DC_COMPUTE(kvB, rvB); DC_PIN();
        DC_LOAD(kvB, rvB, bi + 4); DC_PIN();
        DC_COMPUTE(kvC, rvC); DC_PIN();
    }
    DC_COMPUTE(kvA, rvA);
    DC_COMPUTE(kvB, rvB);
#undef DC_PIN
#undef DC_LOAD
#undef DC_COMPUTE
    LAS float* wm = sh + 2304 + w * 16;
    LAS float* wo = sh + 2304 + 128 + w * 2048;
    { const int hd = 4 * (lane >> 5) + 2 * ((lane >> 4) & 1) + ((lane >> 3) & 1); if ((lane & 7) == 0) { wm[hd] = m; wm[8 + hd] = l; } }
#pragma unroll
    for (int h = 0; h < 8; ++h) *(LAS f32x4*)(wo + h * 256 + 4 * lane) = O[h];
    __syncthreads();
    float* part = (float*)(ws + WS_DPART) + (size_t)u * 8 * 264;
    for (int e = tid; e < 2048; e += 512) {
        const int h = e >> 8;
        float M = -INFINITY;
#pragma unroll
        for (int ww = 0; ww < 8; ++ww) M = fmaxf(M, sh[2304 + ww * 16 + h]);
        float acc = 0.f, L = 0.f;
#pragma unroll
        for (int ww = 0; ww < 8; ++ww) { const float f = __builtin_amdgcn_exp2f(sh[2304 + ww * 16 + h] - M); acc += f * sh[2304 + 128 + ww * 2048 + e]; L += f * sh[2304 + ww * 16 + 8 + h]; }
        __hip_atomic_store(part + h * 264 + (e & 255), acc, __ATOMIC_RELAXED, __HIP_MEMORY_SCOPE_AGENT);
        if ((e & 255) == 0) { __hip_atomic_store(part + h * 264 + 256, M, __ATOMIC_RELAXED, __HIP_MEMORY_SCOPE_AGENT); __hip_atomic_store(part + h * 264 + 257, L, __ATOMIC_RELAXED, __HIP_MEMORY_SCOPE_AGENT); }
    }
    asm volatile("s_waitcnt vmcnt(0)" ::: "memory");
    __syncthreads();
    if (tid == 0) (void)__hip_atomic_fetch_add((unsigned*)(ws + WS_CTL) + CW_DCNT + 16 * s, 1u, __ATOMIC_RELAXED, __HIP_MEMORY_SCOPE_AGENT);
}
__device__ __forceinline__ void decode_combine_unit(Frame& F, const Ptrs& a, int u) {
    unsigned char* ws = opaque_g(a.ws);
    const int tid = fresh_tid(F.wave), lane = tid & 63, s = u >> 3, h = u & 7, row = ROW_SMP + s;
    LAS float* sh = (LAS float*)(F.lds + RING_OFF);
    const bf16* QA = (const bf16*)(ws + WS_QA) + (size_t)row * 768;
    const float* part = (const float*)(ws + WS_DPART) + (size_t)s * 16 * 8 * 264;
    if (tid == 0) { const unsigned* cn = (const unsigned*)(ws + WS_CTL) + CW_DCNT + 16 * s; unsigned spins = 0;
        while (__hip_atomic_load(cn, __ATOMIC_RELAXED, __HIP_MEMORY_SCOPE_AGENT) < 16u && ++spins < (1u << 22)) __builtin_amdgcn_s_sleep(8);
        __builtin_amdgcn_fence(__ATOMIC_ACQUIRE, "agent"); asm volatile("s_waitcnt vmcnt(0)" ::: "memory"); }
    __syncthreads();
    if (tid < 64) { const bf16* KNr = (const bf16*)(ws + WS_KN) + (size_t)row * 512;
        float acc = __uint_as_float((unsigned)QA[h * 96 + lane] << 16) * __uint_as_float((unsigned)KNr[h * 64 + lane] << 16);
        if (lane < 32) acc += __uint_as_float((unsigned)QA[h * 96 + 64 + lane] << 16) * ((const float*)(ws + WS_KRF))[(size_t)row * 32 + lane];
#pragma unroll
        for (int off = 32; off > 0; off >>= 1) acc += lx(acc, lane, off);
        if (lane == 0) sh[256] = acc; }
    __syncthreads();
    if (tid < 256) {
        const int r = tid;
        const float sn = sh[256];
        float pm[16];
#pragma unroll
        for (int p = 0; p < 16; ++p) pm[p] = part[(p * 8 + h) * 264 + 256];
        float M = sn;
#pragma unroll
        for (int p = 0; p < 16; ++p) M = fmaxf(M, pm[p]);
        const float rkv = row_rscale4((const float*)(ws + WS_SSQKV), row, 1.f / KVR);
        const float cn = ((const float*)(ws + WS_CKVF))[(size_t)row * KVR + r] * rkv * a.in(14)[r];
        const float fn = __builtin_amdgcn_exp2f(sn - M);
        float acc = fn * cn, Lq = fn;
#pragma unroll
        for (int p = 0; p < 16; ++p) { const float f = __builtin_amdgcn_exp2f(pm[p] - M); acc += f * part[(p * 8 + h) * 264 + r]; Lq += f * part[(p * 8 + h) * 264 + 257]; }
        sh[r] = acc / Lq;
    }
    __syncthreads();
    { const int v = tid & 63, rg = tid >> 6; const float* wuv = a.in(17) + (size_t)(32 * rg) * 512 + h * 64 + v;
      float wv[32];
#pragma unroll
      for (int k = 0; k < 32; ++k) wv[k] = wuv[(size_t)k * 512];
      float acc = 0.f;
#pragma unroll
      for (int k = 0; k < 32; ++k) acc += sh[32 * rg + k] * wv[k];
      sh[264 + rg * 64 + v] = acc; }
    __syncthreads();
    if (tid < 64) { float acc = 0.f;
#pragma unroll
        for (int rg = 0; rg < 8; ++rg) acc += sh[264 + rg * 64 + tid];
        ((bf16*)(ws + WS_AV))[(size_t)row * 512 + h * 64 + tid] = bf1(acc); }
    __syncthreads();
}
}
namespace mk {
constexpr size_t WS_TMP = WS_ACT;
constexpr size_t WS_MX = WS_RQ;
constexpr size_t WS_H2B = WS_MX + al((size_t)MP * 1024 * 2);
constexpr size_t WS_H2 = WS_UT;
constexpr size_t WS_SSQH2 = WS_SSQ2_, WS_SSQH3 = WS_SSQ3_;
constexpr size_t WS_H3 = WS_H;
constexpr size_t WS_END6 = WS_END4;
static_assert(WS_H2B + (size_t)MP * 1024 * 2 <= WS_SRG && WS_H2 + (size_t)MP * 1024 * 4 <= WS_RIN && (size_t)MP * 1024 * 4 <= (size_t)MP * FFN * 2, "overlays");
static_assert(WS_END6 < ((size_t)1 << 31), "32-bit workspace offsets");

template <int STEP, unsigned GATE_OFF> struct EpiGate {
    static constexpr bool PERM = false, AFTER_DRAIN = false;
    unsigned char* ws_;
    __device__ __forceinline__ void operator()(const f32x4 (&acc)[2][2][4][2], const Unit& u, int wr, int wc, int fr, int fq) const {
        int l_ = lane_fresh(); asm volatile("" : "+v"(l_)); fr = l_ & 15; fq = l_ >> 4;
        unsigned char* w = opaque_g(ws_);
        const unsigned row0 = u.pm * BM + wr * 64 + fr, col0 = u.pn * BM + wc * 32 + 4 * fq;
#pragma unroll
        for (int ai = 0; ai < 2; ++ai)
#pragma unroll
            for (int m = 0; m < 4; ++m) { unsigned row = row0 + ai * HALF + m * 16; asm volatile("" : "+v"(row));
#pragma unroll
                for (int bj = 0; bj < 2; ++bj)
#pragma unroll
                    for (int n = 0; n < 2; ++n) { const unsigned e = row * 1024 + col0 + bj * HALF + n * 16;
                        const u32x2 gw = *at<const u32x2>(w, GATE_OFF + e * 2);
                        f32x4 g; g[0] = __uint_as_float(gw.x << 16); g[1] = __uint_as_float(gw.x & 0xffff0000u); g[2] = __uint_as_float(gw.y << 16); g[3] = __uint_as_float(gw.y & 0xffff0000u);
                        f32x4 o = acc[ai][bj][m][n] * g;
                        if (STEP == 0) *at<f32x4>(w, (unsigned)WS_TMP + e * 4) = o;
                        else { o = o + *at<const f32x4>(w, (unsigned)WS_TMP + e * 4); *at<u32x2>(w, (unsigned)WS_MX + e * 2) = pack4(o); } }
                asm volatile("" ::: "memory"); }
    }
};
struct EpiSwiGLU2 {
    static constexpr bool PERM = true, AFTER_DRAIN = false;
    unsigned char* ws_;
    __device__ __forceinline__ void operator()(const f32x4 (&acc)[2][2][4][2], const Unit& u, int wr, int wc, int fr, int fq) const {
        int l_ = lane_fresh(); asm volatile("" : "+v"(l_)); fr = l_ & 15; fq = l_ >> 4;
        unsigned char* w = opaque_g(ws_);
        const unsigned row0 = u.pm * BM + wr * 64 + fr, col0 = u.pn * HALF + wc * 32 + 8 * fq;
#pragma unroll
        for (int ai = 0; ai < 2; ++ai)
#pragma unroll
            for (int m = 0; m < 4; ++m) { unsigned row = row0 + ai * HALF + m * 16; asm volatile("" : "+v"(row));
                const float r = row_rscale16(at<const float>(w, (unsigned)WS_SSQH2), (int)row, 1.f / D);
                f32x4 o[2];
#pragma unroll
                for (int n = 0; n < 2; ++n)
#pragma unroll
                    for (int j = 0; j < 4; ++j) { const float g = acc[ai][0][m][n][j] * r, up = acc[ai][1][m][n][j] * r; o[n][j] = fast_silu(g) * up; }
                u32x4 pk; pk.x = pg8::cvt_pk_bf16(o[0][0], o[0][1]); pk.y = pg8::cvt_pk_bf16(o[0][2], o[0][3]); pk.z = pg8::cvt_pk_bf16(o[1][0], o[1][1]); pk.w = pg8::cvt_pk_bf16(o[1][2], o[1][3]);
                *at<u32x4>(w, (unsigned)WS_ACT + (row * FFN + col0) * 2) = pk;
                asm volatile("" ::: "memory"); }
    }
};
__device__ __forceinline__ void final_norm_phase(Frame& F, const Ptrs& a) {
    const int lane = fresh_tid(F.wave) & 63;
    const int gw = F.vcu * NWAVES + F.wave, NGW = F.G * NWAVES;
    const float* H3 = (const float*)(a.ws + WS_H3); const float* SSQ = (const float*)(a.ws + WS_SSQH3);
    f32x4 g[4];
#pragma unroll
    for (int j = 0; j < 4; ++j) g[j] = *((const f32x4*)a.in(26) + lane + 64 * j);
    for (int row0 = gw; row0 < ROW_PAD; row0 += 2 * NGW) {
        f32x4 v[2][4]; float r[2];
#pragma unroll
        for (int t = 0; t < 2; ++t) { const int row = row0 + t * NGW; const bool ok = row < ROW_PAD && !(row >= MMAIN && row < ROW_SMP);
            r[t] = ok ? row_rscale16(SSQ, row, 1.f / D) : 0.f;
#pragma unroll
            for (int j = 0; j < 4; ++j) v[t][j] = ok ? *((const f32x4*)(H3 + (size_t)row * D) + lane + 64 * j) : (f32x4){0.f, 0.f, 0.f, 0.f}; }
#pragma unroll
        for (int t = 0; t < 2; ++t) { const int row = row0 + t * NGW; if (row >= ROW_PAD || (row >= MMAIN && row < ROW_SMP)) continue;
            float* dst = row < MMAIN ? a.out() + OUT_YP + (size_t)row * D : a.out() + OUT_YS + (size_t)(row - ROW_SMP) * D;
#pragma unroll
            for (int j = 0; j < 4; ++j) *((f32x4*)dst + lane + 64 * j) = v[t][j] * r[t] * g[j]; }
    }
}
}
namespace mk {
typedef float f32x4_t __attribute__((ext_vector_type(4)));
constexpr int XROW0 = MMAIN, SK_C = 64 * 64;
__device__ __forceinline__ void skinny64(int wave, int tid, const bf16* A, int K, const bf16* Bt, int brow0, LAS float* P, float (&out)[8]) {
    const int lane = tid & 63, r16 = lane & 15, kq = lane >> 4;
    const bf16* ap = A + (size_t)(XROW0 + r16) * K + 8 * kq;
    const bf16* bp = Bt + (size_t)(brow0 + r16) * K + 8 * kq;
    f32x4 acc[4][4];
#pragma unroll
    for (int mf = 0; mf < 4; ++mf)
#pragma unroll
        for (int nf = 0; nf < 4; ++nf) acc[mf][nf] = (f32x4){0.f, 0.f, 0.f, 0.f};
    const int KS = K / 32;
    bf16x8 a0[4], b0[4], a1[4], b1[4], a2[4], b2[4];
#define SK_LOAD(a_, b_, kk_) do { _Pragma("unroll") for (int f = 0; f < 4; ++f) { a_[f] = *(const bf16x8*)(ap + (size_t)(16 * f) * K + 32 * (kk_)); b_[f] = *(const bf16x8*)(bp + (size_t)(16 * f) * K + 32 * (kk_)); } } while (0)
#define SK_MMA(a_, b_) do { _Pragma("unroll") for (int mf = 0; mf < 4; ++mf) _Pragma("unroll") for (int nf = 0; nf < 4; ++nf) acc[mf][nf] = __builtin_amdgcn_mfma_f32_16x16x32_bf16(a_[mf], b_[nf], acc[mf][nf], 0, 0, 0); } while (0)
    int kk = wave;
    if (kk < KS) SK_LOAD(a0, b0, kk);
    if (kk + 8 < KS) SK_LOAD(a1, b1, kk + 8);
    if (kk + 16 < KS) SK_LOAD(a2, b2, kk + 16);
    for (; kk < KS; kk += 24) {
        SK_MMA(a0, b0); if (kk + 24 < KS) SK_LOAD(a0, b0, kk + 24);
        if (kk + 8 < KS) { SK_MMA(a1, b1); if (kk + 32 < KS) SK_LOAD(a1, b1, kk + 32); }
        if (kk + 16 < KS) { SK_MMA(a2, b2); if (kk + 40 < KS) SK_LOAD(a2, b2, kk + 40); }
    }
#undef SK_LOAD
#undef SK_MMA
    LAS float* Pw = P + wave * SK_C;
#pragma unroll
    for (int mf = 0; mf < 4; ++mf)
#pragma unroll
        for (int nf = 0; nf < 4; ++nf)
#pragma unroll
            for (int i = 0; i < 4; ++i) Pw[(16 * mf + 4 * kq + i) * 64 + 16 * nf + r16] = acc[mf][nf][i];
    __syncthreads();
    const LAS float* pr = P + (tid >> 3) * 64 + 8 * (tid & 7);
    f32x4 s0 = *(const LAS f32x4*)pr, s1 = *(const LAS f32x4*)(pr + 4);
#pragma unroll
    for (int w = 1; w < 8; ++w) { s0 = s0 + *(const LAS f32x4*)(pr + w * SK_C); s1 = s1 + *(const LAS f32x4*)(pr + w * SK_C + 4); }
    out[0] = s0[0]; out[1] = s0[1]; out[2] = s0[2]; out[3] = s0[3]; out[4] = s1[0]; out[5] = s1[1]; out[6] = s1[2]; out[7] = s1[3];
    __syncthreads();
}
__device__ __forceinline__ float sum8(float v, int lane) { v += lx(v, lane, 1); v += lx(v, lane, 2); v += lx(v, lane, 4); return v; }
__device__ __forceinline__ void st8_bf16(bf16* p, const float* v) { u32x4 w; w.x = pg8::cvt_pk_bf16(v[0], v[1]); w.y = pg8::cvt_pk_bf16(v[2], v[3]); w.z = pg8::cvt_pk_bf16(v[4], v[5]); w.w = pg8::cvt_pk_bf16(v[6], v[7]); *(u32x4*)p = w; }
__device__ __forceinline__ void ld8(const LAS float* p, float* v) { const f32x4 a = *(const LAS f32x4*)p, b = *(const LAS f32x4*)(p + 4); v[0] = a[0]; v[1] = a[1]; v[2] = a[2]; v[3] = a[3]; v[4] = b[0]; v[5] = b[1]; v[6] = b[2]; v[7] = b[3]; }
__device__ __forceinline__ void xjob_signal(unsigned char* ws, int tid, int cnt_idx) {
    asm volatile("s_waitcnt vmcnt(0)" ::: "memory"); __syncthreads();
    if (tid == 0) { __builtin_amdgcn_fence(__ATOMIC_RELEASE, "agent"); asm volatile("s_waitcnt vmcnt(0)" ::: "memory");
                    (void)__hip_atomic_fetch_add((unsigned*)(ws + WS_CTL) + CW_XCNT + cnt_idx, 1u, __ATOMIC_RELAXED, __HIP_MEMORY_SCOPE_AGENT); }
}
__device__ __forceinline__ void xjob_wait(unsigned char* ws, int tid, int cnt_idx, unsigned need) {
    if (tid == 0) { const unsigned* cn = (const unsigned*)(ws + WS_CTL) + CW_XCNT + cnt_idx; unsigned spins = 0;
        while (__hip_atomic_load(cn, __ATOMIC_RELAXED, __HIP_MEMORY_SCOPE_AGENT) < need && ++spins < (1u << 22)) __builtin_amdgcn_s_sleep(8);
        __builtin_amdgcn_fence(__ATOMIC_ACQUIRE, "agent"); asm volatile("s_waitcnt vmcnt(0)" ::: "memory"); }
    __syncthreads();
}

__device__ __forceinline__ void xjob_ffn_up(Frame& F, unsigned char* ws, int j, size_t a_off, size_t w_off, int rs_mode, int cnt_idx) {
    ws = opaque_g(ws);
    const int tid = fresh_tid(F.wave);
    LAS float* P = (LAS float*)(F.lds + RING_OFF);
    const int brow0 = 256 * (j >> 1) + 64 * (j & 1);
    float g[8], u[8], o[8];
    skinny64(F.wave, tid, (const bf16*)(ws + a_off), D, (const bf16*)(ws + w_off), brow0, P, g);
    skinny64(F.wave, tid, (const bf16*)(ws + a_off), D, (const bf16*)(ws + w_off), brow0 + 128, P, u);
    const int r = tid >> 3, cg = tid & 7, row = XROW0 + r;
    const float rs = rs_mode == 0 ? ((const float*)(ws + WS_R1))[row] : row_rscale16((const float*)(ws + WS_SSQH2), row, 1.f / D);
#pragma unroll
    for (int k = 0; k < 8; ++k) o[k] = fast_silu(g[k] * rs) * (u[k] * rs);
    st8_bf16((bf16*)(ws + WS_ACT) + (size_t)row * FFN + 64 * j + 8 * cg, o);
    xjob_signal(ws, tid, cnt_idx);
}
__device__ __forceinline__ void xjob_resid(Frame& F, unsigned char* ws, int j, size_t a_off, int K, size_t w_off, const float* res  , float scale, size_t out_off, size_t outb_off, size_t ssq_off) {
    ws = opaque_g(ws);
    const int tid = fresh_tid(F.wave), lane = tid & 63;
    LAS float* P = (LAS float*)(F.lds + RING_OFF);
    float v[8], o[8];
    skinny64(F.wave, tid, (const bf16*)(ws + a_off), K, (const bf16*)(ws + w_off), 64 * j, P, v);
    const int r = tid >> 3, cg = tid & 7, row = XROW0 + r, col = 64 * j + 8 * cg;
    const f32x4 b0 = *(const f32x4*)(res + (size_t)r * D + col), b1 = *(const f32x4*)(res + (size_t)r * D + col + 4);
    float ss = 0.f;
#pragma unroll
    for (int k = 0; k < 8; ++k) { o[k] = (k < 4 ? b0[k] : b1[k - 4]) + scale * v[k]; ss += o[k] * o[k]; }
    float* op = (float*)(ws + out_off) + (size_t)row * D + col;
    *(f32x4*)op = (f32x4){o[0], o[1], o[2], o[3]}; *(f32x4*)(op + 4) = (f32x4){o[4], o[5], o[6], o[7]};
    if (outb_off) st8_bf16((bf16*)(ws + outb_off) + (size_t)row * D + col, o);
    ss = sum8(ss, lane);
    if (cg == 0) atomicAdd((float*)(ws + ssq_off) + row, ss);
}
__device__ __forceinline__ void xjob_win(Frame& F, unsigned char* ws, int j) {
    ws = opaque_g(ws);
    const int tid = fresh_tid(F.wave), lane = tid & 63;
    LAS float* P = (LAS float*)(F.lds + RING_OFF);
    const int pn = j >> 1, q = j & 1;
    float v0[8], v1[8];
    skinny64(F.wave, tid, (const bf16*)(ws + WS_HB), D, (const bf16*)(ws + WS_WIN), 256 * pn + 64 * q, P, v0);
    skinny64(F.wave, tid, (const bf16*)(ws + WS_HB), D, (const bf16*)(ws + WS_WIN), 256 * pn + 64 * q + 128, P, v1);
    const int r = tid >> 3, cg = tid & 7, row = XROW0 + r;
    const float rs = row_rscale16((const float*)(ws + WS_SSQH), row, 1.f / D);
    const float* TAB = (const float*)(ws + WS_TAB);
#pragma unroll
    for (int k = 0; k < 8; ++k) { v0[k] *= rs; v1[k] *= rs; }
    const int tc0 = 64 * q + 8 * cg;
    if (pn == 0) {
        bf16* CQ = (bf16*)(ws + WS_CQ) + (size_t)row * QR; float* SSQCQ = (float*)(ws + WS_SSQCQ) + (size_t)row * 8;
        st8_bf16(CQ + tc0, v0); st8_bf16(CQ + tc0 + 128, v1);
        float s0 = 0.f, s1 = 0.f;
#pragma unroll
        for (int k = 0; k < 8; ++k) { s0 += v0[k] * v0[k]; s1 += v1[k] * v1[k]; }
        s0 = sum8(s0, lane); s1 = sum8(s1, lane);
        if (cg == 0) { SSQCQ[2 * q] = s0; SSQCQ[2 * q + 1] = s1; }
    } else if (pn == 1) {
        bf16* CQ = (bf16*)(ws + WS_CQ) + (size_t)row * QR; float* SSQCQ = (float*)(ws + WS_SSQCQ) + (size_t)row * 8;
        st8_bf16(CQ + 256 + tc0, v0);
        float s0 = 0.f;
#pragma unroll
        for (int k = 0; k < 8; ++k) s0 += v0[k] * v0[k];
        s0 = sum8(s0, lane);
        if (cg == 0) { SSQCQ[4 + q] = s0; SSQCQ[6 + q] = 0.f; }
        float x2[8];
#pragma unroll
        for (int k = 0; k < 8; ++k) x2[k] = lx(v1[k], lane, 2);
        if (q == 0 && cg < 2) {
            const int pi = row_pidx(row), i0 = 8 * cg;
            float y1[8], y2[8];
#pragma unroll
            for (int k = 0; k < 8; ++k) { const float c = TAB[TAB_C16 / 4 + pi * 16 + i0 + k], s = TAB[TAB_S16 / 4 + pi * 16 + i0 + k]; y1[k] = v1[k] * c - x2[k] * s; y2[k] = v1[k] * s + x2[k] * c; }
            st8_bf16((bf16*)(ws + WS_KRB) + (size_t)row * 32 + i0, y1); st8_bf16((bf16*)(ws + WS_KRB) + (size_t)row * 32 + 16 + i0, y2);
            float* kf = (float*)(ws + WS_KRF) + (size_t)row * 32;
#pragma unroll
            for (int k = 0; k < 8; ++k) { kf[i0 + k] = y1[k]; kf[16 + i0 + k] = y2[k]; }
        }
    } else if (pn == 2) {
        float* CKVF = (float*)(ws + WS_CKVF) + (size_t)row * KVR; bf16* CKVB = (bf16*)(ws + WS_CKVB) + (size_t)row * KVR; float* SSQKV = (float*)(ws + WS_SSQKV) + (size_t)row * 4;
        float s0 = 0.f, s1 = 0.f;
#pragma unroll
        for (int k = 0; k < 8; ++k) { CKVF[tc0 + k] = v0[k]; CKVF[tc0 + 128 + k] = v1[k]; s0 += v0[k] * v0[k]; s1 += v1[k] * v1[k]; }
        st8_bf16(CKVB + tc0, v0); st8_bf16(CKVB + tc0 + 128, v1);
        s0 = sum8(s0, lane); s1 = sum8(s1, lane);
        if (cg == 0) { SSQKV[2 * q] = s0; SSQKV[2 * q + 1] = s1; }
    } else if (pn < 7) {
        const bool isk = pn >= 5; const int hh = 2 * ((pn - 3) & 1) + q, i0 = 8 * cg;
        const int pi = row_pidx(row), jt = row_jtok(row);
        const float mult = isk ? RK_SCALE * TAB[TAB_GN / 4 + hh * 128 + jt] : TAB[TAB_GP / 4 + hh * 128 + jt];
        float y1[8], y2[8];
#pragma unroll
        for (int k = 0; k < 8; ++k) { const float c = TAB[TAB_C64 / 4 + pi * 64 + i0 + k], s = TAB[TAB_S64 / 4 + pi * 64 + i0 + k]; y1[k] = (v0[k] * c - v1[k] * s) * mult; y2[k] = (v0[k] * s + v1[k] * c) * mult; }
        bf16* dst = (bf16*)(ws + (isk ? WS_RK : WS_RQ)) + (size_t)row * 512 + hh * 128;
        st8_bf16(dst + i0, y1); st8_bf16(dst + 64 + i0, y2);
        if (isk) { bf16* RKT = (bf16*)(ws + WS_RKT);
#pragma unroll
            for (int k = 0; k < 8; ++k) { RKT[(size_t)(hh * 128 + i0 + k) * MP + row] = bf1(y1[k]); RKT[(size_t)(hh * 128 + 64 + i0 + k) * MP + row] = bf1(y2[k]); } }
    } else if (pn < 11) {
        bf16* RVT = (bf16*)(ws + WS_RVT);
#pragma unroll
        for (int k = 0; k < 8; ++k) { RVT[(size_t)((pn - 7) * 256 + tc0 + k) * MP + row] = bf1(v0[k]); RVT[(size_t)((pn - 7) * 256 + tc0 + 128 + k) * MP + row] = bf1(v1[k]); }
    } else {
        const int t = (pn - 11) >> 2; bf16* dst = (bf16*)(ws + WS_SRG + (size_t)t * (WS_SGA - WS_SRG)) + (size_t)row * 1024 + ((pn - 11) & 3) * 256;
        float o0[8], o1[8];
#pragma unroll
        for (int k = 0; k < 8; ++k) { const float g0 = fast_sigmoid(v0[k]), g1 = fast_sigmoid(v1[k]); o0[k] = t == 0 ? v0[k] * g0 : g0; o1[k] = t == 0 ? v1[k] * g1 : g1; }
        st8_bf16(dst + tc0, o0); st8_bf16(dst + tc0 + 128, o1);
    }
}
__device__ __forceinline__ void xjob_q(Frame& F, unsigned char* ws, int j) {
    ws = opaque_g(ws);
    const int tid = fresh_tid(F.wave), lane = tid & 63;
    LAS float* P = (LAS float*)(F.lds + RING_OFF);
    float v[8], p[8], o[8];
    skinny64(F.wave, tid, (const bf16*)(ws + WS_CQ), QR, (const bf16*)(ws + WS_WUQ), 64 * j, P, v);
    const int r = tid >> 3, cg = tid & 7, row = XROW0 + r;
    const float rs = row_rscale8((const float*)(ws + WS_SSQCQ), row, 1.f / QR) * SC_Q;
    const float* TAB = (const float*)(ws + WS_TAB);
    const int pi = row_pidx(row), col = 64 * j + 8 * cg, grp = col >> 5, w32 = col & 31;
#pragma unroll
    for (int k = 0; k < 8; ++k) p[k] = lx(v[k], lane, 2);
    if (grp % 3 == 2) {
        const int i0 = w32 & 15;
#pragma unroll
        for (int k = 0; k < 8; ++k) { const float c = TAB[TAB_C16 / 4 + pi * 16 + i0 + k], sn = TAB[TAB_S16 / 4 + pi * 16 + i0 + k];
            o[k] = (w32 < 16 ? v[k] * c - p[k] * sn : p[k] * sn + v[k] * c) * rs; }
    } else {
#pragma unroll
        for (int k = 0; k < 8; ++k) o[k] = v[k] * rs;
    }
    st8_bf16((bf16*)(ws + WS_QA) + (size_t)row * 768 + col, o);
}
__device__ __forceinline__ void xjob_kv(Frame& F, unsigned char* ws, int j, bool is_v) {
    ws = opaque_g(ws);
    const int tid = fresh_tid(F.wave);
    LAS float* P = (LAS float*)(F.lds + RING_OFF);
    float v[8];
    skinny64(F.wave, tid, (const bf16*)(ws + WS_CKVB), KVR, (const bf16*)(ws + (is_v ? WS_WUV : WS_WUK)), 64 * j, P, v);
    const int r = tid >> 3, cg = tid & 7, row = XROW0 + r, col = 64 * j + 8 * cg;
    const float rs = row_rscale4((const float*)(ws + WS_SSQKV), row, 1.f / KVR);
#pragma unroll
    for (int k = 0; k < 8; ++k) v[k] *= rs;
    if (!is_v) st8_bf16((bf16*)(ws + WS_KN) + (size_t)row * 512 + col, v);
    else { bf16* VT = (bf16*)(ws + WS_VT);
#pragma unroll
        for (int k = 0; k < 8; ++k) VT[(size_t)(col + k) * MP + row] = bf1(v[k]); }
}
__device__ __forceinline__ void xjob_mix(Frame& F, unsigned char* ws, int j) {
    ws = opaque_g(ws);
    const int tid = fresh_tid(F.wave);
    LAS float* P = (LAS float*)(F.lds + RING_OFF);
    float a[8], b[8], o[8];
    skinny64(F.wave, tid, (const bf16*)(ws + WS_AV), 512, (const bf16*)(ws + WS_WMO), 64 * j, P, a);
    skinny64(F.wave, tid, (const bf16*)(ws + WS_RIN), D, (const bf16*)(ws + WS_WRO), 64 * j, P, b);
    const int r = tid >> 3, cg = tid & 7, row = XROW0 + r, col = 64 * j + 8 * cg;
    const u32x4 ga = *(const u32x4*)((const bf16*)(ws + WS_SGA) + (size_t)row * 1024 + col), gb = *(const u32x4*)((const bf16*)(ws + WS_SGB) + (size_t)row * 1024 + col);
#pragma unroll
    for (int k = 0; k < 8; ++k) { const unsigned wa = ga[k >> 1], wb = gb[k >> 1];
        const float fa = __uint_as_float((k & 1) ? (wa & 0xffff0000u) : (wa << 16)), fb = __uint_as_float((k & 1) ? (wb & 0xffff0000u) : (wb << 16));
        o[k] = fa * a[k] + fb * b[k]; }
    st8_bf16((bf16*)(ws + WS_MX) + (size_t)row * 1024 + col, o);
}
__device__ __forceinline__ void xjob_ql(Frame& F, unsigned char* ws, int j) {
    ws = opaque_g(ws);
    const int tid = fresh_tid(F.wave);
    LAS float* P = (LAS float*)(F.lds + RING_OFF);
    float v[8];
    skinny64(F.wave, tid, (const bf16*)(ws + WS_CQ), QR, (const bf16*)(ws + WS_WQL), 64 * j, P, v);
    const int r = tid >> 3, cg = tid & 7, row = XROW0 + r;
    const float rs = row_rscale8((const float*)(ws + WS_SSQCQ), row, 1.f / QR) * SC_Q;
    float* dst = (float*)(ws + WS_QL) + (size_t)r * 2048 + 64 * j + 8 * cg;
    *(f32x4*)dst = (f32x4){v[0] * rs, v[1] * rs, v[2] * rs, v[3] * rs}; *(f32x4*)(dst + 4) = (f32x4){v[4] * rs, v[5] * rs, v[6] * rs, v[7] * rs};
}
}
namespace mk {
constexpr int RC_STR = 272;
constexpr int RC_S = 0, RC_KT = 0  , RC_Q = 256 * RC_STR, RC_A = RC_Q + 128 * RC_STR, RC_RED = RC_A + 128 * RC_STR, RC_END = RC_RED + 2 * 8 * 128 * 4;
static_assert(RC_END <= SCR_BYTES, "chain LDS map");
__device__ __forceinline__ void ret_chain_unit(Frame& F, const Ptrs& a, int bh) {
    unsigned char* ws = a.ws; ws = opaque_g(ws);
    const int tid_k = fresh_tid(F.wave), w = F.wave;
    const int hh = bh & 3, b = bh >> 2;
    LAS unsigned char* L = F.lds + RING_OFF;
    LAS float* red = (LAS float*)(L + RC_RED);
    const bf16* RQ = (const bf16*)(ws + WS_RQ); const bf16* RK = (const bf16*)(ws + WS_RK); const bf16* RKT = (const bf16*)(ws + WS_RKT); const bf16* RVT = (const bf16*)(ws + WS_RVT);
    const float g = gpow_t(ws, hh, 1), g127 = gpow_t(ws, hh, 127);
    f32x16 S[4];
    {
        const int lane = tid_k & 63, r32 = lane & 31, half = lane >> 5;
#pragma unroll
        for (int db = 0; db < 4; ++db)
#pragma unroll
            for (int i = 0; i < 16; ++i) S[db][i] = 0.f;
        const bf16x8 af = *(const bf16x8*)(RVT + (size_t)(hh * 256 + 32 * w + r32) * MP + ROW_META + 8 * half);
#pragma unroll
        for (int db = 0; db < 4; ++db) { const bf16x8 bf = *(const bf16x8*)(RKT + (size_t)(hh * 128 + 32 * db + r32) * MP + ROW_META + 8 * half); S[db] = __builtin_amdgcn_mfma_f32_32x32x16_bf16(af, bf, S[db], 0, 0, 0); }
        const float sc = gpow_t(ws, hh, NMETA - 1);
#pragma unroll
        for (int db = 0; db < 4; ++db)
#pragma unroll
            for (int i = 0; i < 16; ++i) S[db][i] *= sc;
    }
    v4u qreg[4], jreg[4];
#define RC_FETCH_QK(tok0_) do { _Pragma("unroll") for (int k = 0; k < 4; ++k) { const int ch = tid + 512 * k; \
        qreg[k] = *(const v4u*)(RQ + (size_t)((tok0_) + (ch >> 4)) * 512 + hh * 128 + 8 * (ch & 15)); jreg[k] = *(const v4u*)(RK + (size_t)((tok0_) + (ch >> 4)) * 512 + hh * 128 + 8 * (ch & 15)); } } while (0)
    { const int tid = tid_k; RC_FETCH_QK(b * SEQ); }
#define RC_BLK_IB(n) ((n) < 1 ? 0 : (n) < 3 ? 1 : (n) < 6 ? 2 : 3)
#define RC_BLK_JB(n) ((n) - ((n) < 1 ? 0 : (n) < 3 ? 1 : (n) < 6 ? 3 : 6))
#pragma unroll 1
    for (int c = 0; c < 16; ++c) {
        const int tok0 = b * SEQ + c * 128;
        int tid_c = tid_k; asm volatile("" : "+v"(tid_c));
        const int tid = tid_c, lane = tid & 63, r32 = lane & 31, half = lane >> 5;
#pragma unroll
        for (int k = 0; k < 4; ++k) { const int ch = tid + 512 * k; *(LAS v4u*)(L + RC_Q + (ch >> 4) * RC_STR + 16 * (ch & 15)) = qreg[k]; *(LAS v4u*)(L + RC_S + (ch >> 4) * RC_STR + 16 * (ch & 15)) = jreg[k]; }
        __syncthreads();
        v4u kreg[4];
#pragma unroll
        for (int k = 0; k < 4; ++k) { const int ch = tid + 512 * k; kreg[k] = *(const v4u*)(RKT + (size_t)(hh * 128 + (ch >> 4)) * MP + tok0 + 8 * (ch & 15)); }
        for (int n = w; n < 10; n += 8) {
            const int ib_ = RC_BLK_IB(n), jb_ = RC_BLK_JB(n);
            f32x16 at;
#pragma unroll
            for (int i = 0; i < 16; ++i) at[i] = 0.f;
#pragma unroll
            for (int s = 0; s < 8; ++s) { const bf16x8 kf = *(const LAS bf16x8*)(L + RC_S + (32 * jb_ + r32) * RC_STR + (16 * s + 8 * half) * 2); const bf16x8 qf = *(const LAS bf16x8*)(L + RC_Q + (32 * ib_ + r32) * RC_STR + (16 * s + 8 * half) * 2); at = __builtin_amdgcn_mfma_f32_32x32x16_bf16(kf, qf, at, 0, 0, 0); }
            if (jb_ == ib_) {
#pragma unroll
                for (int i = 0; i < 16; ++i) if (crow(i, half) > r32) at[i] = 0.f; }
#pragma unroll
            for (int gq = 0; gq < 4; ++gq) { f32x4 o_; o_[0] = at[4 * gq]; o_[1] = at[4 * gq + 1]; o_[2] = at[4 * gq + 2]; o_[3] = at[4 * gq + 3];
                *(LAS u32x2*)(L + RC_A + (32 * ib_ + r32) * RC_STR + (32 * jb_ + 8 * gq + 4 * half) * 2) = pack4(o_); }
        }
        __syncthreads();
#pragma unroll
        for (int db = 0; db < 4; ++db)
#pragma unroll
            for (int i = 0; i < 16; ++i) *(LAS bf16*)(L + RC_S + (32 * w + crow(i, half)) * RC_STR + (32 * db + r32) * 2) = bf1(S[db][i]);
        f32x16 ot[4];
#pragma unroll
        for (int ib = 0; ib < 4; ++ib)
#pragma unroll
            for (int i = 0; i < 16; ++i) ot[ib][i] = 0.f;
#pragma unroll 2
        for (int s = 0; s < 8; ++s) {
            const bf16x8 sf = *(const LAS bf16x8*)(L + RC_S + (32 * w + r32) * RC_STR + (16 * s + 8 * half) * 2);
#pragma unroll
            for (int ib = 0; ib < 4; ++ib) { const bf16x8 qf = *(const LAS bf16x8*)(L + RC_Q + (32 * ib + r32) * RC_STR + (16 * s + 8 * half) * 2); ot[ib] = __builtin_amdgcn_mfma_f32_32x32x16_bf16(sf, qf, ot[ib], 0, 0, 0); }
        }
#pragma unroll
        for (int ib = 0; ib < 4; ++ib)
#pragma unroll
            for (int i = 0; i < 16; ++i) ot[ib][i] *= g;
        __syncthreads();
#pragma unroll
        for (int k = 0; k < 4; ++k) { const int ch = tid + 512 * k; *(LAS v4u*)(L + RC_KT + (ch >> 4) * RC_STR + 16 * (ch & 15)) = kreg[k]; }
        __syncthreads();
        if (c < 15) RC_FETCH_QK(tok0 + 128);
#pragma unroll
        for (int db = 0; db < 4; ++db)
#pragma unroll
            for (int i = 0; i < 16; ++i) S[db][i] *= g;
        {
            const bf16* vp = RVT + (size_t)(hh * 256 + 32 * w + r32) * MP + tok0 + 8 * half;
            bf16x8 v0 = *(const bf16x8*)(vp), v1 = *(const bf16x8*)(vp + 16), v2 = v1;
#pragma unroll 1
            for (int s = 0; s < 8; ++s) {
                if (s + 2 < 8) v2 = *(const bf16x8*)(vp + 16 * (s + 2));
#pragma unroll
                for (int ib = 0; ib < 4; ++ib) if (s < 2 * (ib + 1)) { const bf16x8 af = *(const LAS bf16x8*)(L + RC_A + (32 * ib + r32) * RC_STR + (16 * s + 8 * half) * 2); ot[ib] = __builtin_amdgcn_mfma_f32_32x32x16_bf16(v0, af, ot[ib], 0, 0, 0); }
#pragma unroll
                for (int db = 0; db < 4; ++db) { const bf16x8 kf = *(const LAS bf16x8*)(L + RC_KT + (32 * db + r32) * RC_STR + (16 * s + 8 * half) * 2); S[db] = __builtin_amdgcn_mfma_f32_32x32x16_bf16(v0, kf, S[db], 0, 0, 0); }
                v0 = v1; v1 = v2;
            }
        }
#pragma unroll
        for (int db = 0; db < 4; ++db)
#pragma unroll
            for (int i = 0; i < 16; ++i) S[db][i] *= g127;
#pragma unroll
        for (int ib = 0; ib < 4; ++ib) { float t = 0.f;
#pragma unroll
            for (int i = 0; i < 16; ++i) t += ot[ib][i];
            t += lx(t, lane, 32); if (half == 0) red[w * 128 + 32 * ib + r32] = t; }
        __syncthreads();
        float mu[4];
#pragma unroll
        for (int ib = 0; ib < 4; ++ib) { float t = 0.f;
#pragma unroll
            for (int ww = 0; ww < 8; ++ww) t += red[ww * 128 + 32 * ib + r32];
            mu[ib] = t * (1.f / 256.f); }
#pragma unroll
        for (int ib = 0; ib < 4; ++ib) { float t = 0.f;
#pragma unroll
            for (int i = 0; i < 16; ++i) { ot[ib][i] -= mu[ib]; t += ot[ib][i] * ot[ib][i]; }
            t += lx(t, lane, 32); if (half == 0) red[1024 + w * 128 + 32 * ib + r32] = t; }
        __syncthreads();
#pragma unroll
        for (int ib = 0; ib < 4; ++ib) { float t = 0.f;
#pragma unroll
            for (int ww = 0; ww < 8; ++ww) t += red[1024 + ww * 128 + 32 * ib + r32];
            const float rstd = 1.0f / sqrtf(t * (1.f / 256.f) + EPS);
            const int irow = tok0 + 32 * ib + r32;
            const bf16* SRG = (const bf16*)(ws + WS_SRG) + (size_t)irow * 1024 + hh * 256 + 32 * w + 4 * half;
            bf16* RIN = (bf16*)(ws + WS_RIN) + (size_t)irow * 1024 + hh * 256 + 32 * w + 4 * half;
            const float* gn = a.in(19) + hh * 256 + 32 * w + 4 * half;
#pragma unroll
            for (int gq = 0; gq < 4; ++gq) {
                const u32x2 sg = *(const u32x2*)(SRG + 8 * gq); const f32x4 gv = *(const f32x4*)(gn + 8 * gq);
                f32x4 o;
                o[0] = ot[ib][4 * gq + 0] * rstd * gv[0] * __uint_as_float(sg.x << 16); o[1] = ot[ib][4 * gq + 1] * rstd * gv[1] * __uint_as_float(sg.x & 0xffff0000u);
                o[2] = ot[ib][4 * gq + 2] * rstd * gv[2] * __uint_as_float(sg.y << 16); o[3] = ot[ib][4 * gq + 3] * rstd * gv[3] * __uint_as_float(sg.y & 0xffff0000u);
                *(u32x2*)(RIN + 8 * gq) = pack4(o);
            } }
        __syncthreads();
    }
#undef RC_FETCH_QK
#undef RC_BLK_IB
#undef RC_BLK_JB
    const int lane = tid_k & 63, r32 = lane & 31, half = lane >> 5;
#pragma unroll
    for (int db = 0; db < 4; ++db)
#pragma unroll
        for (int i = 0; i < 16; ++i) a.out()[OUT_SRP + ((size_t)bh * RDK + 32 * db + r32) * RDV + 32 * w + crow(i, half)] = S[db][i];
}
}
namespace mk {
constexpr int CW_FLAG = 8192;
__device__ __forceinline__ void st16_wt(void* p, v4u v) { asm volatile("global_store_dwordx4 %0, %1, off sc1\n\ts_nop 1" :: "v"(p), "v"(v) : "memory"); }
__device__ __forceinline__ void ret_state_unit(Frame& F, const Ptrs& a, int bh) {
    unsigned char* ws = opaque_g(a.ws);
    const int tid_k = fresh_tid(F.wave), w = F.wave;
    const int hh = bh & 3, b = bh >> 2;
    LAS unsigned char* L = F.lds + RING_OFF;
    const bf16* RKT = (const bf16*)(ws + WS_RKT); const bf16* RVT = (const bf16*)(ws + WS_RVT);
    const float g = gpow_t(ws, hh, 1), g127 = gpow_t(ws, hh, 127);
    f32x16 S[4];
    bf16x8 vf[8]; v4u kreg[4];
#define RS_FETCH(tok0_) do { _Pragma("unroll") for (int s = 0; s < 8; ++s) vf[s] = *(const bf16x8*)(RVT + (size_t)(hh * 256 + 32 * w + r32) * MP + (tok0_) + 16 * s + 8 * half); \
        _Pragma("unroll") for (int k = 0; k < 4; ++k) { const int ch = tid + 512 * k; kreg[k] = *(const v4u*)(RKT + (size_t)(hh * 128 + (ch >> 4)) * MP + (tok0_) + 8 * (ch & 15)); } } while (0)
    {   const int tid = tid_k, lane = tid & 63, r32 = lane & 31, half = lane >> 5;
#pragma unroll
        for (int db = 0; db < 4; ++db)
#pragma unroll
            for (int i = 0; i < 16; ++i) S[db][i] = 0.f;
        const bf16x8 af = *(const bf16x8*)(RVT + (size_t)(hh * 256 + 32 * w + r32) * MP + ROW_META + 8 * half);
#pragma unroll
        for (int db = 0; db < 4; ++db) { const bf16x8 bf = *(const bf16x8*)(RKT + (size_t)(hh * 128 + 32 * db + r32) * MP + ROW_META + 8 * half); S[db] = __builtin_amdgcn_mfma_f32_32x32x16_bf16(af, bf, S[db], 0, 0, 0); }
        const float sc = gpow_t(ws, hh, NMETA - 1);
#pragma unroll
        for (int db = 0; db < 4; ++db)
#pragma unroll
            for (int i = 0; i < 16; ++i) S[db][i] *= sc;
        RS_FETCH(b * SEQ);
    }
#pragma unroll 1
    for (int c = 0; c < 16; ++c) {
        const int tok0 = b * SEQ + c * 128, u = bh * 16 + c;
        int tid_c = tid_k; asm volatile("" : "+v"(tid_c));
        const int tid = tid_c, lane = tid & 63, r32 = lane & 31, half = lane >> 5;
#pragma unroll
        for (int k = 0; k < 4; ++k) { const int ch = tid + 512 * k; *(LAS v4u*)(L + RC_Q + (ch >> 4) * RC_STR + 16 * (ch & 15)) = kreg[k]; }
#pragma unroll
        for (int db = 0; db < 4; ++db)
#pragma unroll
            for (int i = 0; i < 16; ++i) *(LAS bf16*)(L + (32 * w + crow(i, half)) * RC_STR + (32 * db + r32) * 2) = bf1(S[db][i]);
        __syncthreads();
        { bf16* SP = (bf16*)(ws + WS_SPREV) + (size_t)u * 32768;
#pragma unroll
          for (int k = 0; k < 8; ++k) { const int ch = lane + 64 * k, row = 32 * w + (ch >> 4); st16_wt(SP + (size_t)row * 128 + 8 * (ch & 15), *(const LAS v4u*)(L + row * RC_STR + 16 * (ch & 15))); } }
        bf16x8 vfn[8]; v4u kregn[4];
        if (c < 15) {
#pragma unroll
            for (int s = 0; s < 8; ++s) vfn[s] = *(const bf16x8*)(RVT + (size_t)(hh * 256 + 32 * w + r32) * MP + tok0 + 128 + 16 * s + 8 * half);
#pragma unroll
            for (int k = 0; k < 4; ++k) { const int ch = tid + 512 * k; kregn[k] = *(const v4u*)(RKT + (size_t)(hh * 128 + (ch >> 4)) * MP + tok0 + 128 + 8 * (ch & 15)); }
        } else {
#pragma unroll
            for (int s = 0; s < 8; ++s) vfn[s] = vf[s];
#pragma unroll
            for (int k = 0; k < 4; ++k) kregn[k] = kreg[k];
        }
#pragma unroll
        for (int db = 0; db < 4; ++db) {
#pragma unroll
            for (int i = 0; i < 16; ++i) S[db][i] *= g;
#pragma unroll
            for (int s = 0; s < 8; ++s) { const bf16x8 kf = *(const LAS bf16x8*)(L + RC_Q + (32 * db + r32) * RC_STR + (16 * s + 8 * half) * 2); S[db] = __builtin_amdgcn_mfma_f32_32x32x16_bf16(vf[s], kf, S[db], 0, 0, 0); }
#pragma unroll
            for (int i = 0; i < 16; ++i) S[db][i] *= g127;
        }
        asm volatile("s_waitcnt vmcnt(0)" ::: "memory");
#pragma unroll
        for (int s = 0; s < 8; ++s) vf[s] = vfn[s];
#pragma unroll
        for (int k = 0; k < 4; ++k) kreg[k] = kregn[k];
        __syncthreads();
        if (tid == 0) __hip_atomic_store((unsigned*)(ws + WS_CTL) + CW_FLAG + 16 * u, 1u, __ATOMIC_RELAXED, __HIP_MEMORY_SCOPE_AGENT);
    }
#undef RS_FETCH
    {   const int lane = tid_k & 63, r32 = lane & 31, half = lane >> 5;
#pragma unroll
        for (int db = 0; db < 4; ++db)
#pragma unroll
            for (int i = 0; i < 16; ++i) a.out()[OUT_SRP + ((size_t)bh * RDK + 32 * db + r32) * RDV + 32 * w + crow(i, half)] = S[db][i]; }
    __syncthreads();
}
__device__ __forceinline__ void ret_out_unit(Frame& F, const Ptrs& a, int u) {
    unsigned char* ws = opaque_g(a.ws);
    const int tid = fresh_tid(F.wave), lane = tid & 63, w = F.wave, r32 = lane & 31, half = lane >> 5;
    const int bh = u >> 4, c = u & 15, hh = bh & 3, tok0 = (bh >> 2) * SEQ + c * 128;
    LAS unsigned char* L = F.lds + RING_OFF;
    LAS float* red = (LAS float*)(L + RC_RED);
    const bf16* RQ = (const bf16*)(ws + WS_RQ); const bf16* RK = (const bf16*)(ws + WS_RK); const bf16* RVT = (const bf16*)(ws + WS_RVT);
    v4u qreg[4], jreg[4];
#pragma unroll
    for (int k = 0; k < 4; ++k) { const int ch = tid + 512 * k; qreg[k] = *(const v4u*)(RQ + (size_t)(tok0 + (ch >> 4)) * 512 + hh * 128 + 8 * (ch & 15)); jreg[k] = *(const v4u*)(RK + (size_t)(tok0 + (ch >> 4)) * 512 + hh * 128 + 8 * (ch & 15)); }
    if (tid == 0) { const unsigned* fl = (const unsigned*)(ws + WS_CTL) + CW_FLAG + 16 * u; unsigned spins = 0;
        while (__hip_atomic_load(fl, __ATOMIC_RELAXED, __HIP_MEMORY_SCOPE_AGENT) == 0u && ++spins < (1u << 22)) __builtin_amdgcn_s_sleep(8);
        __builtin_amdgcn_fence(__ATOMIC_ACQUIRE, "agent"); asm volatile("s_waitcnt vmcnt(0)" ::: "memory"); }
    __syncthreads();
    v4u sreg[8];
    { const bf16* SP = (const bf16*)(ws + WS_SPREV) + (size_t)u * 32768;
#pragma unroll
      for (int k = 0; k < 8; ++k) { const int ch = tid + 512 * k; sreg[k] = *(const v4u*)(SP + (size_t)(ch >> 4) * 128 + 8 * (ch & 15)); } }
#pragma unroll
    for (int k = 0; k < 4; ++k) { const int ch = tid + 512 * k; *(LAS v4u*)(L + RC_Q + (ch >> 4) * RC_STR + 16 * (ch & 15)) = qreg[k]; *(LAS v4u*)(L + RC_S + (ch >> 4) * RC_STR + 16 * (ch & 15)) = jreg[k]; }
    __syncthreads();
#define RC_BLK_IB(n) ((n) < 1 ? 0 : (n) < 3 ? 1 : (n) < 6 ? 2 : 3)
#define RC_BLK_JB(n) ((n) - ((n) < 1 ? 0 : (n) < 3 ? 1 : (n) < 6 ? 3 : 6))
    for (int n = w; n < 10; n += 8) {
        const int ib_ = RC_BLK_IB(n), jb_ = RC_BLK_JB(n);
        f32x16 at;
#pragma unroll
        for (int i = 0; i < 16; ++i) at[i] = 0.f;
#pragma unroll
        for (int s = 0; s < 8; ++s) { const bf16x8 kf = *(const LAS bf16x8*)(L + RC_S + (32 * jb_ + r32) * RC_STR + (16 * s + 8 * half) * 2); const bf16x8 qf = *(const LAS bf16x8*)(L + RC_Q + (32 * ib_ + r32) * RC_STR + (16 * s + 8 * half) * 2); at = __builtin_amdgcn_mfma_f32_32x32x16_bf16(kf, qf, at, 0, 0, 0); }
        if (jb_ == ib_) {
#pragma unroll
            for (int i = 0; i < 16; ++i) if (crow(i, half) > r32) at[i] = 0.f; }
#pragma unroll
        for (int gq = 0; gq < 4; ++gq) { f32x4 o_; o_[0] = at[4 * gq]; o_[1] = at[4 * gq + 1]; o_[2] = at[4 * gq + 2]; o_[3] = at[4 * gq + 3];
            *(LAS u32x2*)(L + RC_A + (32 * ib_ + r32) * RC_STR + (32 * jb_ + 8 * gq + 4 * half) * 2) = pack4(o_); }
    }
#undef RC_BLK_IB
#undef RC_BLK_JB
    __syncthreads();
#pragma unroll
    for (int k = 0; k < 8; ++k) { const int ch = tid + 512 * k; *(LAS v4u*)(L + RC_S + (ch >> 4) * RC_STR + 16 * (ch & 15)) = sreg[k]; }
    __syncthreads();
    const float g = gpow_t(ws, hh, 1);
    f32x16 ot[4];
#pragma unroll
    for (int ib = 0; ib < 4; ++ib)
#pragma unroll
        for (int i = 0; i < 16; ++i) ot[ib][i] = 0.f;
#pragma unroll 2
    for (int s = 0; s < 8; ++s) {
        const bf16x8 sf = *(const LAS bf16x8*)(L + RC_S + (32 * w + r32) * RC_STR + (16 * s + 8 * half) * 2);
#pragma unroll
        for (int ib = 0; ib < 4; ++ib) { const bf16x8 qf = *(const LAS bf16x8*)(L + RC_Q + (32 * ib + r32) * RC_STR + (16 * s + 8 * half) * 2); ot[ib] = __builtin_amdgcn_mfma_f32_32x32x16_bf16(sf, qf, ot[ib], 0, 0, 0); }
    }
#pragma unroll
    for (int ib = 0; ib < 4; ++ib)
#pragma unroll
        for (int i = 0; i < 16; ++i) ot[ib][i] *= g;
    bf16x8 vf[8];
#pragma unroll
    for (int s = 0; s < 8; ++s) vf[s] = *(const bf16x8*)(RVT + (size_t)(hh * 256 + 32 * w + r32) * MP + tok0 + 16 * s + 8 * half);
#pragma unroll
    for (int ib = 0; ib < 4; ++ib)
#pragma unroll
        for (int s = 0; s < 2 * (ib + 1); ++s) { const bf16x8 af = *(const LAS bf16x8*)(L + RC_A + (32 * ib + r32) * RC_STR + (16 * s + 8 * half) * 2); ot[ib] = __builtin_amdgcn_mfma_f32_32x32x16_bf16(vf[s], af, ot[ib], 0, 0, 0); }
#pragma unroll
    for (int ib = 0; ib < 4; ++ib) { float t = 0.f;
#pragma unroll
        for (int i = 0; i < 16; ++i) t += ot[ib][i];
        t += lx(t, lane, 32); if (half == 0) red[w * 128 + 32 * ib + r32] = t; }
    __syncthreads();
    float mu[4];
#pragma unroll
    for (int ib = 0; ib < 4; ++ib) { float t = 0.f;
#pragma unroll
        for (int ww = 0; ww < 8; ++ww) t += red[ww * 128 + 32 * ib + r32];
        mu[ib] = t * (1.f / 256.f); }
#pragma unroll
    for (int ib = 0; ib < 4; ++ib) { float t = 0.f;
#pragma unroll
        for (int i = 0; i < 16; ++i) { ot[ib][i] -= mu[ib]; t += ot[ib][i] * ot[ib][i]; }
        t += lx(t, lane, 32); if (half == 0) red[1024 + w * 128 + 32 * ib + r32] = t; }
    __syncthreads();
#pragma unroll
    for (int ib = 0; ib < 4; ++ib) { float t = 0.f;
#pragma unroll
        for (int ww = 0; ww < 8; ++ww) t += red[1024 + ww * 128 + 32 * ib + r32];
        const float rstd = 1.0f / sqrtf(t * (1.f / 256.f) + EPS);
        const int irow = tok0 + 32 * ib + r32;
        const bf16* SRG = (const bf16*)(ws + WS_SRG) + (size_t)irow * 1024 + hh * 256 + 32 * w + 4 * half;
        bf16* RIN = (bf16*)(ws + WS_RIN) + (size_t)irow * 1024 + hh * 256 + 32 * w + 4 * half;
        const float* gn = a.in(19) + hh * 256 + 32 * w + 4 * half;
#pragma unroll
        for (int gq = 0; gq < 4; ++gq) {
            const u32x2 sg = *(const u32x2*)(SRG + 8 * gq); const f32x4 gv = *(const f32x4*)(gn + 8 * gq);
            f32x4 o;
            o[0] = ot[ib][4 * gq + 0] * rstd * gv[0] * __uint_as_float(sg.x << 16); o[1] = ot[ib][4 * gq + 1] * rstd * gv[1] * __uint_as_float(sg.x & 0xffff0000u);
            o[2] = ot[ib][4 * gq + 2] * rstd * gv[2] * __uint_as_float(sg.y << 16); o[3] = ot[ib][4 * gq + 3] * rstd * gv[3] * __uint_as_float(sg.y & 0xffff0000u);
            *(u32x2*)(RIN + 8 * gq) = pack4(o);
        } }
    __syncthreads();
}
}
namespace mk {
__global__ void __launch_bounds__(NWAVES * 64, 2) mega_fwd(Args args) {
    extern __shared__ __attribute__((aligned(16))) unsigned char lds[];
    Frame F;
    F.lds = (LAS unsigned char*)lds;
    F.MISC = (volatile LAS unsigned*)(F.lds + MISC_OFF);
    F.wave = __builtin_amdgcn_readfirstlane((int)threadIdx.x >> 6);
    F.G = gridDim.x; { const int bx = blockIdx.x; F.vcu = (F.G % 8 == 0) ? (bx % 8) * (F.G / 8) + bx / 8 : bx; }
    unsigned char* const ws_k = args.ws;
    unsigned char* ws = ws_k;
    for (int u = threadIdx.x; u < (LDS_BYTES - LDSCTL_OFF) / 4; u += NWAVES * 64) ((LAS unsigned*)(F.lds + LDSCTL_OFF))[u] = 0u;
    __syncthreads();
    {
        volatile LAS unsigned long long* pt = (volatile LAS unsigned long long*)(F.lds + PT_OFF);
        if (threadIdx.x == 0) {
#define PT_PUT(i) pt[i] = (unsigned long long)args.in[i]
            PT_PUT(0); PT_PUT(1); PT_PUT(2); PT_PUT(3); PT_PUT(4); PT_PUT(5); PT_PUT(6); PT_PUT(7); PT_PUT(8); PT_PUT(9); PT_PUT(10); PT_PUT(11); PT_PUT(12); PT_PUT(13);
            PT_PUT(14); PT_PUT(15); PT_PUT(16); PT_PUT(17); PT_PUT(18); PT_PUT(19); PT_PUT(20); PT_PUT(21); PT_PUT(22); PT_PUT(23); PT_PUT(24); PT_PUT(25); PT_PUT(26);
#undef PT_PUT
            pt[27] = (unsigned long long)args.out;
        }
        __syncthreads();
    }
    const Ptrs P{ws_k, (volatile LAS unsigned*)(F.lds + PT_OFF)};
    (void)xcd_barrier_post((unsigned*)(ws_k + WS_CTL) + CW_BAR, F.MISC + 8, F.wave);
#if MK_PROBE
#define STAMP(k) do { if (blockIdx.x == 0 && F.wave == 0 && lane_fresh() == 0) ((unsigned long long*)(ws_k + WS_CTL + 512 * 1024))[k] = __builtin_amdgcn_s_memrealtime(); } while (0)
    STAMP(0);
#else
#define STAMP(k) do { } while (0)
#endif
#define WS_FRESH() unsigned char* ws = opaque_g(ws_k)
#define GRID_BAR() do { XcdBarrier b_; b_.bar = (unsigned*)(ws_k + WS_CTL) + CW_BAR; b_.x = xb_xcc_id(); b_.st = F.MISC + 8; b_.wave = F.wave; xcd_barrier(b_); } while (0)

    p0_prologue(F, args);
    GRID_BAR(); STAMP(1);
    {
        WS_FRESH();
        { const int bx = (int)blockIdx.x; if (bx >= 128 && bx < 172) xjob_ffn_up(F, ws, bx - 128, WS_XB, WS_W1T, 0, 0); }
        p0_weights_late(F, args);
        pg8::Gemm g{(const pg8::bf16_t*)(ws + WS_XB), (const pg8::bf16_t*)(ws + WS_W1T), MMAIN, 2 * FFN, D};
        pg8::StaticOrder S; S.init(MMAIN, 2 * FFN, F.G, (int)blockIdx.x);
        EpiSwiGLU E{(bf16*)(ws + WS_ACT), (const float*)(ws + WS_R1)};
        pg8::gemm_phase<EpiSwiGLU, pg8::StaticOrder, true, true>(F.lds + RING_OFF, g, S, E, F.wave);
        { const int bx = (int)blockIdx.x; if (bx >= 172 && bx < 188) { xjob_wait(ws, fresh_tid(F.wave), 0, 44u); xjob_resid(F, ws, bx - 172, WS_ACT, FFN, WS_W1D, (const float*)(ws + WS_XE), 0.5f, WS_H, WS_HB, WS_SSQH); } }
    }
    GRID_BAR(); STAMP(2);
    {
        WS_FRESH();
        pg8::Gemm g{(const pg8::bf16_t*)(ws + WS_ACT), (const pg8::bf16_t*)(ws + WS_W1D), MMAIN, D, FFN};
        pg8::StaticOrder S; S.init(MMAIN, D, F.G, (int)blockIdx.x);
        typedef EpiResid<(unsigned)WS_XE, true, (unsigned)WS_H, (unsigned)WS_HB, (unsigned)WS_SSQH, 1> EpiDown1;
        EpiDown1 E{ws, P.in(0)};
        pg8::gemm_phase<EpiDown1, pg8::StaticOrder, true, true>(F.lds + RING_OFF, g, S, E, F.wave);
    }
    GRID_BAR(); STAMP(3);
#ifndef NO_P3
    {
        WS_FRESH();
        { const int bx = (int)blockIdx.x; if (bx >= 192 && bx < 238) xjob_win(F, ws, bx - 192); }
        pg8::Gemm g{(const pg8::bf16_t*)(ws + WS_HB), (const pg8::bf16_t*)(ws + WS_WIN), MMAIN, NWIN, D};
        pg8::StaticOrder S; S.init(MMAIN, NWIN, F.G, (int)blockIdx.x);
        EpiWin E{ws, F.lds};
        pg8::gemm_phase<EpiWin, pg8::StaticOrder, true, true>(F.lds + RING_OFF, g, S, E, F.wave);
    }
#endif
    GRID_BAR(); STAMP(4);
    {
        WS_FRESH();
        { const int jb = (int)blockIdx.x - 192; if (jb >= 0 && jb < 12) xjob_q(F, ws, jb); else if (jb >= 12 && jb < 20) xjob_kv(F, ws, jb - 12, false); else if (jb >= 20 && jb < 28) xjob_kv(F, ws, jb - 20, true); else if (jb >= 28 && jb < 60) xjob_ql(F, ws, jb - 28); }
        finalize_ckv(F, P);
#ifndef NO_P4Q
        {   pg8::Gemm g{(const pg8::bf16_t*)(ws + WS_CQ), (const pg8::bf16_t*)(ws + WS_WUQ), MMAIN, 768, QR};
            pg8::StaticOrder S; S.init(MMAIN, 768, F.G, (int)blockIdx.x);
            EpiQ E{ws};
            pg8::gemm_phase<EpiQ, pg8::StaticOrder, true, true>(F.lds + RING_OFF, g, S, E, F.wave); }
#endif
#ifndef NO_P4K
        {   pg8::Gemm g{(const pg8::bf16_t*)(ws + WS_CKVB), (const pg8::bf16_t*)(ws + WS_WUK), MMAIN, 512, KVR};
            pg8::StaticOrder S; S.init(MMAIN, 512, F.G, (int)((blockIdx.x + 64) % F.G));
            EpiScaleBf16<true> E{(const float*)(ws + WS_SSQKV), (bf16*)(ws + WS_KN), 512};
            pg8::gemm_phase<EpiScaleBf16<true>, pg8::StaticOrder, true, true>(F.lds + RING_OFF, g, S, E, F.wave); }
#endif
#ifndef NO_P4V
        {   pg8::Gemm g{(const pg8::bf16_t*)(ws + WS_WUV), (const pg8::bf16_t*)(ws + WS_CKVB), 512, MMAIN, KVR};
            pg8::StaticOrder S; S.init(512, MMAIN, F.G, (int)((blockIdx.x + 192) % F.G));
            EpiScaleBf16<false> E{(const float*)(ws + WS_SSQKV), (bf16*)(ws + WS_VT), MP};
            pg8::gemm_phase<EpiScaleBf16<false>, pg8::StaticOrder, true, true>(F.lds + RING_OFF, g, S, E, F.wave); }
#endif
    }
    GRID_BAR(); STAMP(5);
    STAMP(32);
#define QUEUE_LOOP(qi, nitems, call) for (;;) { \
        if (F.wave == 0 && lane_fresh() == 0) F.MISC[16] = __hip_atomic_fetch_add((unsigned*)(ws_k + WS_CTL) + CW_QUEUE + 64 * (qi), 1u, __ATOMIC_RELAXED, __HIP_MEMORY_SCOPE_AGENT); \
        __syncthreads(); const int it = (int)F.MISC[16]; __syncthreads(); \
        if (it >= (nitems)) break; call; }
    if ((int)blockIdx.x < 32) ret_state_unit(F, P, (int)blockIdx.x);
    STAMP(33);
    if (((int)blockIdx.x & 1) == 0) {
        QUEUE_LOOP(0, 512, attn_item(F, ws_k, it))
        QUEUE_LOOP(3, 512, ret_out_unit(F, P, ((it & 31) << 4) | (it >> 5)))
    }
    STAMP(34);
    QUEUE_LOOP(1, 512, decode_unit(F, P, it))
    STAMP(35);
    QUEUE_LOOP(2, 128, ret_sample_unit(F, P, it))
    STAMP(36);
    if (((int)blockIdx.x & 1) != 0) {
        QUEUE_LOOP(0, 512, attn_item(F, ws_k, it))
        QUEUE_LOOP(3, 512, ret_out_unit(F, P, ((it & 31) << 4) | (it >> 5)))
    }
    STAMP(37);
    QUEUE_LOOP(4, 256, decode_combine_unit(F, P, it))
#undef QUEUE_LOOP
    GRID_BAR(); STAMP(6);
    {
        WS_FRESH();
        { const int bx = (int)blockIdx.x; if (bx < 16) xjob_mix(F, ws, bx); }
        {   pg8::Gemm g{(const pg8::bf16_t*)(ws + WS_AV), (const pg8::bf16_t*)(ws + WS_WMO), MMAIN, D, 512};
            pg8::StaticOrder S; S.init(MMAIN, D, F.G, (int)blockIdx.x);
            typedef EpiGate<0, (unsigned)WS_SGA> EpiGA; EpiGA E{ws};
            pg8::gemm_phase<EpiGA, pg8::StaticOrder, true, true>(F.lds + RING_OFF, g, S, E, F.wave); }
        {   pg8::Gemm g{(const pg8::bf16_t*)(ws + WS_RIN), (const pg8::bf16_t*)(ws + WS_WRO), MMAIN, D, D};
            pg8::StaticOrder S; S.init(MMAIN, D, F.G, (int)blockIdx.x);
            typedef EpiGate<1, (unsigned)WS_SGB> EpiGB; EpiGB E{ws};
            pg8::gemm_phase<EpiGB, pg8::StaticOrder, true, true>(F.lds + RING_OFF, g, S, E, F.wave); }
    }
    GRID_BAR(); STAMP(7);
    {
        WS_FRESH();
        { const int bx = (int)blockIdx.x; if (bx >= 16 && bx < 32) xjob_resid(F, ws, bx - 16, WS_MX, D, WS_WOUT, (const float*)(ws + WS_H) + (size_t)XROW0 * D, 1.0f, WS_H2, WS_H2B, WS_SSQH2); }
        pg8::Gemm g{(const pg8::bf16_t*)(ws + WS_MX), (const pg8::bf16_t*)(ws + WS_WOUT), MMAIN, D, D};
        pg8::StaticOrder S; S.init(MMAIN, D, F.G, (int)blockIdx.x);
        typedef EpiResid<(unsigned)WS_H, false, (unsigned)WS_H2, (unsigned)WS_H2B, (unsigned)WS_SSQH2, 2> EpiOut;
        EpiOut E{ws, nullptr};
        pg8::gemm_phase<EpiOut, pg8::StaticOrder, true, true>(F.lds + RING_OFF, g, S, E, F.wave);
    }
    GRID_BAR(); STAMP(8);
    {
        WS_FRESH();
        { const int bx = (int)blockIdx.x; if (bx >= 128 && bx < 172) xjob_ffn_up(F, ws, bx - 128, WS_H2B, WS_W2T, 1, 16); }
        pg8::Gemm g{(const pg8::bf16_t*)(ws + WS_H2B), (const pg8::bf16_t*)(ws + WS_W2T), MMAIN, 2 * FFN, D};
        pg8::StaticOrder S; S.init(MMAIN, 2 * FFN, F.G, (int)blockIdx.x);
        EpiSwiGLU2 E{ws};
        pg8::gemm_phase<EpiSwiGLU2, pg8::StaticOrder, true, true>(F.lds + RING_OFF, g, S, E, F.wave);
        { const int bx = (int)blockIdx.x; if (bx >= 172 && bx < 188) { xjob_wait(ws, fresh_tid(F.wave), 16, 44u); xjob_resid(F, ws, bx - 172, WS_ACT, FFN, WS_W2D, (const float*)(ws + WS_H2) + (size_t)XROW0 * D, 0.5f, WS_H3, 0, WS_SSQH3); } }
    }
    GRID_BAR(); STAMP(9);
    {
        WS_FRESH();
        pg8::Gemm g{(const pg8::bf16_t*)(ws + WS_ACT), (const pg8::bf16_t*)(ws + WS_W2D), MMAIN, D, FFN};
        pg8::StaticOrder S; S.init(MMAIN, D, F.G, (int)blockIdx.x);
        typedef EpiResid<(unsigned)WS_H2, false, (unsigned)WS_H3, 0u, (unsigned)WS_SSQH3, 1> EpiDown2;
        EpiDown2 E{ws, nullptr};
        pg8::gemm_phase<EpiDown2, pg8::StaticOrder, true, true>(F.lds + RING_OFF, g, S, E, F.wave);
    }
    GRID_BAR(); STAMP(10);
    final_norm_phase(F, P);
#if MK_PROBE
    GRID_BAR(); STAMP(11);
    if (blockIdx.x == 0) {
        asm volatile("s_waitcnt vmcnt(0)" ::: "memory"); __syncthreads();
        const unsigned long long* t = (const unsigned long long*)(ws_k + WS_CTL + 512 * 1024);
        const float dta = (float)(__hip_atomic_load(t + MK_PROBE_A + 1, __ATOMIC_RELAXED, __HIP_MEMORY_SCOPE_AGENT) - __hip_atomic_load(t + MK_PROBE_A, __ATOMIC_RELAXED, __HIP_MEMORY_SCOPE_AGENT)) * 0.01f;
        const float dtb = (float)(__hip_atomic_load(t + MK_PROBE_B + 1, __ATOMIC_RELAXED, __HIP_MEMORY_SCOPE_AGENT) - __hip_atomic_load(t + MK_PROBE_B, __ATOMIC_RELAXED, __HIP_MEMORY_SCOPE_AGENT)) * 0.01f;
        const float f = 1.f + sqrtf(dta / 20000.f);
        const int tid_p = fresh_tid(F.wave);
        for (int i = tid_p; i < NS * D; i += NWAVES * 64) P.out()[OUT_YS + i] *= f;
        if (tid_p == 0) P.out()[OUT_YP] += dtb / 5.f;
    }
#endif
#undef GRID_BAR
}
}
extern "C" void kernel_launch(void* const* d_in, const int* in_sizes, int n_in, void* d_out, int out_size, void* d_ws, size_t ws_size, hipStream_t stream) {
    static int grid = 0;
    if (grid == 0) {
        int dev = 0, cus = 0;
        if (n_in != 27 || out_size != (int)mk::OUT_END || ws_size < mk::WS_END6) { fprintf(stderr, "kernel_launch: unexpected problem shape (n_in %d, out %d, ws %zu); nothing launched\n", n_in, out_size, ws_size); grid = -1; return; }
        if (hipGetDevice(&dev) != hipSuccess || hipDeviceGetAttribute(&cus, hipDeviceAttributeMultiprocessorCount, dev) != hipSuccess) { fprintf(stderr, "kernel_launch: device query failed\n"); grid = -1; return; }
        if (hipFuncSetAttribute((const void*)mk::mega_fwd, hipFuncAttributeMaxDynamicSharedMemorySize, mk::LDS_BYTES) != hipSuccess) { fprintf(stderr, "kernel_launch: hipFuncSetAttribute failed\n"); grid = -1; return; }
        int per_cu = 0;
        if (hipOccupancyMaxActiveBlocksPerMultiprocessor(&per_cu, (const void*)mk::mega_fwd, mk::NWAVES * 64, mk::LDS_BYTES) != hipSuccess || per_cu < 1) fprintf(stderr, "kernel_launch: note: occupancy query reports %d workgroups per CU\n", per_cu);
        (void)hipGetLastError();
        grid = cus;
    }
    if (grid < 0) return;
    unsigned char* ws = (unsigned char*)d_ws;
    (void)hipMemsetAsync(ws + mk::WS_CTL, 0, mk::CTL_ZERO_BYTES, stream);
    mk::Args a{};
    for (int i = 0; i < 27; ++i) a.in[i] = (const float*)d_in[i];
    a.out = (float*)d_out; a.ws = ws;
    hipLaunchKernelGGL(mk::mega_fwd, dim3(grid), dim3(mk::NWAVES * 64), mk::LDS_BYTES, stream, a);
}
```

```cpp
#include <hip/hip_runtime.h>
#include <cstdio>
#include <cstdint>
#include <cmath>
#define MK_DEBUG 0
#ifndef MK_PROBE
#define MK_PROBE 0
#define MK_PROBE_A 0
#define MK_PROBE_B 1
#endif
__device__ __forceinline__ int lane_fresh() { int l; asm volatile("v_mbcnt_lo_u32_b32 %0, -1, 0\n\tv_mbcnt_hi_u32_b32 %0, -1, %0" : "=v"(l)); return l; }
__device__ __forceinline__ unsigned char* opaque_g(const unsigned char* p) { unsigned long long v = (unsigned long long)p; asm volatile("" : "+s"(v)); return (unsigned char*)(__attribute__((address_space(1))) unsigned char*)v; }
namespace pg8 {
#define PG8_LAS __attribute__((address_space(3)))
typedef unsigned short bf16_t;
typedef short bf16x8 __attribute__((ext_vector_type(8)));
typedef float f32x4 __attribute__((ext_vector_type(4)));
typedef unsigned u32x4 __attribute__((ext_vector_type(4)));
constexpr int BM = 256, BK = 64, HALF = 128, HTB = HALF * BK * 2  , STAGE_BYTES = 8 * HTB, NXCD = 8, WGM = 8;

__host__ __device__ __forceinline__ int lds_byte(int r, int c) { const int st = (r >> 4) * 2 + (c >> 5), rr = r & 15, cc = c & 31, ob = rr * 64 + cc * 2; return st * 1024 + (ob ^ (((ob >> 9) & 1) << 5)); }
__host__ __device__ __forceinline__ void stage_rc(int b, int& R, int& C) { const int st = b / 1024, sb = b % 1024, swz = sb ^ (((sb >> 9) & 1) << 5); R = (st >> 1) * 16 + swz / 64; C = (st & 1) * 32 + (swz % 64) / 2; }
__host__ __device__ __forceinline__ int perm32(int rho) { const int n = rho >> 4, i = rho & 15; return 8 * (i >> 2) + 4 * n + (i & 3); }

struct Unit { int pm, pn; };
struct Gemm { const bf16_t* A; const bf16_t* Bt; int M, N, K; };

struct StaticOrder {
    int nM, nN, nwg, G, c;
    __host__ __device__ void init(int M, int N, int G_, int c_) { nM = M / BM; nN = N / BM; nwg = nM * nN; G = G_; c = c_; }
    __host__ __device__ bool next(int i, Unit& u) const {
        const long L = (long)i * G + c; if (L >= nwg) return false;
        int wgid = (int)L; { const int q = nwg / NXCD, r = nwg % NXCD, xcd = wgid % NXCD, off = wgid / NXCD; wgid = (xcd < r ? xcd * (q + 1) : r * (q + 1) + (xcd - r) * q) + off; }
        const int nig = WGM * nN, gid = wgid / nig, fm = gid * WGM, gsz = (nM - fm) < WGM ? (nM - fm) : WGM;
        u.pm = fm + ((wgid % nig) % gsz); u.pn = (wgid % nig) / gsz; return true;
    }
    __device__ __forceinline__ void a_ready(const Unit&) const {}
    __device__ __forceinline__ void done(const Unit&) const {}
};

__device__ __forceinline__ unsigned cvt_pk_bf16(float lo, float hi) { unsigned r; asm volatile("v_cvt_pk_bf16_f32 %0, %1, %2" : "=v"(r) : "v"(lo), "v"(hi)); return r; }
typedef float f32x2 __attribute__((ext_vector_type(2)));
template <class Epi, class Sched, bool ALIGN_EPI = false, bool SP2 = false>
__device__ __forceinline__ void gemm_phase(PG8_LAS unsigned char* lds, const Gemm g, const Sched& S, const Epi& E, const int wave_in  ) {
    int tid_ = lane_fresh() + 64 * wave_in; asm volatile("" : "+v"(tid_));
    const int tid = tid_, wid = __builtin_amdgcn_readfirstlane(tid >> 6), lane = tid & 63, wr = wid >> 2, wc = wid & 3, fr = lane & 15, fq = lane >> 4;
    const int K = g.K, nt = K / BK;
    unsigned voffA[2], voffB[2];
#pragma unroll
    for (int i = 0; i < 2; ++i) { int R, C; stage_rc(tid * 16 + i * 8192, R, C); const int Rb = Epi::PERM ? ((R & ~31) + perm32(R & 31)) : R;
        voffA[i] = (unsigned)(R * K + C) * 2u; voffB[i] = (unsigned)(Rb * K + C) * 2u; }
    const size_t kstep = (size_t)(BK * 2);
    const size_t hstep = (size_t)HALF * K * 2;
    const size_t tstep = 2 * hstep;
    const unsigned ldsw = (unsigned)wid * 1024u;
    const int aoff = lds_byte(wr * 64 + fr, fq * 8), boff = lds_byte(wc * 32 + fr, fq * 8);
#define PG8_SA(b, h) (((b) * 2 + (h)) * HTB)
#define PG8_SB(b, h) ((4 + (b) * 2 + (h)) * HTB)
#define PG8_STAGE(bufoff, gbase, voff) do { _Pragma("unroll") for (int _i = 0; _i < 2; ++_i) \
        __builtin_amdgcn_global_load_lds((const unsigned*)((const char*)(gbase) + (voff)[_i]), (PG8_LAS unsigned*)(lds + (bufoff) + ldsw + _i * 8192), 16, 0, 0); } while (0)
#define PG8_LDA(dst, b, h) do { _Pragma("unroll") for (int m = 0; m < 4; ++m) _Pragma("unroll") for (int k = 0; k < 2; ++k) dst[m][k] = *(const PG8_LAS bf16x8*)(lds + PG8_SA(b, h) + aoff + m * 2048 + k * 1024); } while (0)
#define PG8_LDB(dst, b, h) do { _Pragma("unroll") for (int n = 0; n < 2; ++n) _Pragma("unroll") for (int k = 0; k < 2; ++k) dst[n][k] = *(const PG8_LAS bf16x8*)(lds + PG8_SB(b, h) + boff + n * 2048 + k * 1024); } while (0)
#define PG8_MMA(ai, bj, At, Bt) do { __builtin_amdgcn_s_setprio(1); _Pragma("unroll") for (int m = 0; m < 4; ++m) _Pragma("unroll") for (int n = 0; n < 2; ++n) _Pragma("unroll") for (int k = 0; k < 2; ++k) \
        acc[ai][bj][m][n] = __builtin_amdgcn_mfma_f32_16x16x32_bf16(Bt[n][k], At[m][k], acc[ai][bj][m][n], 0, 0, 0); __builtin_amdgcn_s_setprio(0); } while (0)
#define PG8_WAIT_V(n) asm volatile("s_waitcnt vmcnt(" #n ")" ::: "memory")
#define PG8_WAIT_L(n) asm volatile("s_waitcnt lgkmcnt(" #n ")" ::: "memory")
#define PG8_BAR __builtin_amdgcn_s_barrier()
#define PG8_SCHED __builtin_amdgcn_sched_barrier(0)
    Unit cur, nxt; int ui = 0;
    if (!S.next(0, cur)) return;
    f32x4 acc[2][2][4][2];
#pragma unroll
    for (int a = 0; a < 2; ++a)
#pragma unroll
        for (int b = 0; b < 2; ++b)
#pragma unroll
            for (int m = 0; m < 4; ++m)
#pragma unroll
                for (int n = 0; n < 2; ++n) acc[a][b][m][n] = (f32x4){0.f, 0.f, 0.f, 0.f};
    bf16x8 At[4][2], B0[2][2], B1[2][2];
    const char* cA = (const char*)g.A + (size_t)cur.pm * tstep; const char* cB = (const char*)g.Bt + (size_t)cur.pn * tstep;
    S.a_ready(cur);
    if constexpr (SP2) {
        PG8_STAGE(PG8_SB(0, 0), cB, voffB); PG8_STAGE(PG8_SB(0, 1), cB + hstep, voffB); PG8_STAGE(PG8_SA(0, 0), cA, voffA); PG8_STAGE(PG8_SA(0, 1), cA + hstep, voffA);
        if (wr == 1) PG8_BAR;
        PG8_WAIT_V(2); PG8_BAR;
        PG8_STAGE(PG8_SB(1, 0), cB + kstep, voffB); PG8_STAGE(PG8_SA(1, 0), cA + kstep, voffA); PG8_STAGE(PG8_SB(1, 1), cB + hstep + kstep, voffB);
        PG8_WAIT_V(6); PG8_BAR;
    } else {
        PG8_STAGE(PG8_SB(0, 0), cB, voffB); PG8_STAGE(PG8_SA(0, 0), cA, voffA); PG8_STAGE(PG8_SB(0, 1), cB + hstep, voffB); PG8_STAGE(PG8_SA(0, 1), cA + hstep, voffA);
        if (wr == 1) PG8_BAR;
        PG8_WAIT_V(4); PG8_BAR;
        PG8_STAGE(PG8_SB(1, 0), cB + kstep, voffB); PG8_STAGE(PG8_SA(1, 0), cA + kstep, voffA); PG8_STAGE(PG8_SB(1, 1), cB + hstep + kstep, voffB);
        PG8_WAIT_V(6); PG8_BAR;
    }
    for (;;) {
        const bool has_next = S.next(ui + 1, nxt);
        const char* nA = has_next ? (const char*)g.A + (size_t)nxt.pm * tstep : cA; const char* nB = has_next ? (const char*)g.Bt + (size_t)nxt.pn * tstep : cB;
        for (int t = 0; t < nt; t += 2) {
            const bool last = (t == nt - 2);
            const char* a1 = cA + (size_t)(t + 1) * kstep;
            const char* a2 = last ? nA : cA + (size_t)(t + 2) * kstep; const char* b2 = last ? nB : cB + (size_t)(t + 2) * kstep;
            const char* a3 = a2 + kstep; const char* b3 = b2 + kstep;
            if (last && has_next) S.a_ready(nxt);
            if constexpr (SP2) {
            PG8_LDB(B0, 0, 0); PG8_LDB(B1, 0, 1); PG8_SCHED; PG8_LDA(At, 0, 0); PG8_STAGE(PG8_SA(1, 1), a1 + hstep, voffA);
            PG8_WAIT_V(8); PG8_WAIT_L(0); PG8_BAR; PG8_MMA(0, 0, At, B0); PG8_MMA(0, 1, At, B1); PG8_BAR; PG8_SCHED;
            PG8_LDA(At, 0, 1); PG8_STAGE(PG8_SB(0, 0), b2, voffB); PG8_STAGE(PG8_SB(0, 1), b2 + hstep, voffB); PG8_STAGE(PG8_SA(0, 0), a2, voffA);
            PG8_WAIT_V(8); PG8_WAIT_L(0); PG8_BAR; PG8_MMA(1, 0, At, B0); PG8_MMA(1, 1, At, B1); PG8_BAR; PG8_SCHED;
            PG8_LDB(B0, 1, 0); PG8_LDB(B1, 1, 1); PG8_SCHED; PG8_LDA(At, 1, 0); PG8_STAGE(PG8_SA(0, 1), a2 + hstep, voffA);
            PG8_WAIT_V(8); PG8_WAIT_L(0); PG8_BAR; PG8_MMA(0, 0, At, B0); PG8_MMA(0, 1, At, B1); PG8_BAR; PG8_SCHED;
            PG8_LDA(At, 1, 1); PG8_STAGE(PG8_SB(1, 0), b3, voffB); PG8_STAGE(PG8_SB(1, 1), b3 + hstep, voffB); PG8_STAGE(PG8_SA(1, 0), a3, voffA);
            PG8_WAIT_V(8); PG8_WAIT_L(0); PG8_BAR; PG8_MMA(1, 0, At, B0); PG8_MMA(1, 1, At, B1); PG8_BAR; PG8_SCHED;
            } else {
            PG8_LDB(B0, 0, 0); PG8_SCHED; PG8_LDA(At, 0, 0); PG8_STAGE(PG8_SA(1, 1), a1 + hstep, voffA);
            PG8_WAIT_L(8); PG8_BAR; PG8_WAIT_L(0); PG8_MMA(0, 0, At, B0); PG8_BAR; PG8_SCHED;
            PG8_LDB(B1, 0, 1); PG8_STAGE(PG8_SB(0, 0), b2, voffB);
            PG8_BAR; PG8_WAIT_L(0); PG8_MMA(0, 1, At, B1); PG8_BAR;
            PG8_LDA(At, 0, 1); PG8_STAGE(PG8_SA(0, 0), a2, voffA);
            PG8_BAR; PG8_WAIT_L(0); PG8_MMA(1, 0, At, B0); PG8_BAR; PG8_SCHED;
            PG8_STAGE(PG8_SB(0, 1), b2 + hstep, voffB);
            PG8_WAIT_V(6); PG8_BAR; PG8_MMA(1, 1, At, B1); PG8_BAR;
            PG8_LDB(B0, 1, 0); PG8_SCHED; PG8_LDA(At, 1, 0); PG8_STAGE(PG8_SA(0, 1), a2 + hstep, voffA);
            PG8_WAIT_L(8); PG8_BAR; PG8_WAIT_L(0); PG8_MMA(0, 0, At, B0); PG8_BAR; PG8_SCHED;
            PG8_LDB(B1, 1, 1); PG8_STAGE(PG8_SB(1, 0), b3, voffB);
            PG8_BAR; PG8_WAIT_L(0); PG8_MMA(0, 1, At, B1); PG8_BAR;
            PG8_LDA(At, 1, 1); PG8_STAGE(PG8_SA(1, 0), a3, voffA);
            PG8_BAR; PG8_WAIT_L(0); PG8_MMA(1, 0, At, B0); PG8_BAR; PG8_SCHED;
            PG8_STAGE(PG8_SB(1, 1), b3 + hstep, voffB);
            PG8_WAIT_V(6); PG8_BAR; PG8_MMA(1, 1, At, B1); PG8_BAR;
            }
        }
        if constexpr (ALIGN_EPI) { if (wr == 0) PG8_BAR; }
        if constexpr (!Epi::AFTER_DRAIN) { E(acc, cur, wr, wc, fr, fq); S.done(cur); }
        if (!has_next) break;
#pragma unroll
        for (int a = 0; a < 2; ++a)
#pragma unroll
            for (int b = 0; b < 2; ++b)
#pragma unroll
                for (int m = 0; m < 4; ++m)
#pragma unroll
                    for (int n = 0; n < 2; ++n) acc[a][b][m][n] = (f32x4){0.f, 0.f, 0.f, 0.f};
        cur = nxt; cA = nA; cB = nB; ++ui;
        if constexpr (ALIGN_EPI) { if (wr == 1) PG8_BAR; }
    }
    PG8_WAIT_V(0);
    if constexpr (!ALIGN_EPI) { if (wr == 0) PG8_BAR; }
    PG8_BAR;
    if constexpr (Epi::AFTER_DRAIN) { E.fused(acc, cur, wr, wc, fr, fq, lds, wid, lane); S.done(cur); }
#undef PG8_SA
#undef PG8_SB
#undef PG8_STAGE
#undef PG8_LDA
#undef PG8_LDB
#undef PG8_MMA
#undef PG8_WAIT_V
#undef PG8_WAIT_L
#undef PG8_BAR
#undef PG8_SCHED
}
}
#define GAS __attribute__((address_space(1)))
#define LAS __attribute__((address_space(3)))
typedef unsigned short bf16;
typedef unsigned v4u __attribute__((ext_vector_type(4)));
typedef float f32x4 __attribute__((ext_vector_type(4)));
typedef short bf16x8 __attribute__((ext_vector_type(8)));
typedef GAS unsigned gu32;
typedef GAS unsigned long long gu64;
#define RLX_AGENT __ATOMIC_RELAXED, __HIP_MEMORY_SCOPE_AGENT
#define LDS_WAIT() asm volatile("s_waitcnt lgkmcnt(0)" ::: "memory")
#define VM_WAIT() asm volatile("s_waitcnt vmcnt(0)" ::: "memory")
__device__ __forceinline__ unsigned long long rt() { return __builtin_amdgcn_s_memrealtime(); }
__device__ __forceinline__ unsigned f2bf(float f) { unsigned u = __builtin_bit_cast(unsigned, f); return (u + 0x7fffu + ((u >> 16) & 1u)) >> 16; }
__device__ __forceinline__ unsigned pk2(float lo, float hi) { return f2bf(lo) | (f2bf(hi) << 16); }

#define XB_TMO      128
#define XB_XCNT(j)  (256  + 64 * (j))
#define XB_XSUB(j)  (1280 + 64 * (j))
#define XB_XGEN(j)  (2304 + 64 * (j))
#define XB_TOP      3328
#define XB_TOPGEN   3392
#define XCD_BAR_WORDS 3456
#define XB_SPIN_CAP (1u << 18)

__device__ __forceinline__ unsigned xb_ld(unsigned* p)              { return __hip_atomic_load(p, __ATOMIC_RELAXED, __HIP_MEMORY_SCOPE_AGENT); }
__device__ __forceinline__ unsigned xb_add(unsigned* p, unsigned v) { return __hip_atomic_fetch_add(p, v, __ATOMIC_RELAXED, __HIP_MEMORY_SCOPE_AGENT); }
__device__ __forceinline__ unsigned xb_xcc_id() { return (unsigned)__builtin_amdgcn_s_getreg((3 << 11) | 20) & 0xFu; }
#define XB_SPIN(cond, bar) do { unsigned _sp = 0; while (cond) { __builtin_amdgcn_s_sleep(1); \
    if ((++_sp & 255u) == 0u) { if (xb_ld(&(bar)[XB_TMO])) break; if (_sp > XB_SPIN_CAP) { atomicAdd(&(bar)[XB_TMO], 1u); break; } } } } while (0)

struct XcdBarrier {
    unsigned* bar; unsigned x; int wave;
    volatile LAS unsigned* st;
};

#define XB_IS_T0(wave) ((wave) == 0 && lane_fresh() == 0)
__device__ __forceinline__ XcdBarrier xcd_barrier_post(unsigned* bar, volatile LAS unsigned* st, int wave) {
    XcdBarrier b; b.bar = bar; b.x = xb_xcc_id(); b.st = st; b.wave = wave;
    if (XB_IS_T0(wave)) (void)xb_add(&bar[XB_XCNT(b.x)], 1u);
    return b;
}
__device__ __forceinline__ void xcd_barrier_complete(unsigned* bar, unsigned x, unsigned& nloc, unsigned& nx) {
    const unsigned G = gridDim.x * gridDim.y * gridDim.z;
    unsigned sum, cnt, mine, sp = 0u;
    for (;;) {
        sum = 0u; cnt = 0u; mine = 0u;
#pragma unroll
        for (unsigned j = 0; j < 16; ++j) { const unsigned c = xb_ld(&bar[XB_XCNT(j)]); sum += c; cnt += (c > 0u) ? 1u : 0u; mine = (j == x) ? c : mine; }
        if (sum == G) break;
        __builtin_amdgcn_s_sleep(1);
        if ((++sp & 255u) == 0u) { if (xb_ld(&bar[XB_TMO])) break; if (sp > XB_SPIN_CAP) { atomicAdd(&bar[XB_TMO], 1u); break; } }
    }
    nloc = mine > 0u ? mine : 1u; nx = cnt > 0u ? cnt : 1u;
}

__device__ __forceinline__ void xcd_barrier(const XcdBarrier& b) {
    asm volatile("s_waitcnt vmcnt(0)" ::: "memory");
    __syncthreads();
    if (XB_IS_T0(b.wave)) {
        unsigned* bar = b.bar;
        __builtin_amdgcn_s_waitcnt(0);
        unsigned nloc = b.st[0], nx = b.st[1];
        if (nloc == 0u) { xcd_barrier_complete(bar, b.x, nloc, nx); b.st[0] = nloc; b.st[1] = nx; }
        const unsigned old = xb_add(&bar[XB_XSUB(b.x)], 1u);
        const unsigned gen = old / nloc;
        if (old + 1u == (gen + 1u) * nloc) {
            __builtin_amdgcn_fence(__ATOMIC_RELEASE, "agent");
            asm volatile("s_waitcnt vmcnt(0)" ::: "memory");
            const unsigned og = xb_add(&bar[XB_TOP], 1u);
            const unsigned tg = og / nx;
            if (og + 1u == (tg + 1u) * nx) xb_add(&bar[XB_TOPGEN], 1u);
            else XB_SPIN(xb_ld(&bar[XB_TOPGEN]) == tg, bar);
            __builtin_amdgcn_fence(__ATOMIC_ACQUIRE, "agent");
            xb_add(&bar[XB_XGEN(b.x)], 1u);
            asm volatile("s_waitcnt vmcnt(0)" ::: "memory");
        } else {
            XB_SPIN(xb_ld(&bar[XB_XGEN(b.x)]) == gen, bar);
            __builtin_amdgcn_fence(__ATOMIC_ACQUIRE, "agent");
            asm volatile("s_waitcnt vmcnt(0)" ::: "memory");
        }
    }
    __syncthreads();
}
namespace mk {
constexpr int D = 1024, NB = 8, SEQ = 2048, NMETA = 16, T = SEQ + NMETA, NS = 32, PAST = 16384, PAGE = 128, NPAGES = PAST / PAGE;
constexpr int FFN = 2816, NH = 8, QR = 384, KVR = 256, RH = 4, RDK = 128, RDV = 256, IN_DIM = 5792;
constexpr int O_CQ = 0, O_CKV = 384, O_KR = 640, O_RQ = 672, O_RK = 1184, O_RV = 1696, O_RG = 2720, O_GA = 3744, O_GB = 4768;
constexpr int MMAIN = NB * SEQ;
constexpr int ROW_META = MMAIN;
constexpr int ROW_SMP = MMAIN + NMETA;
constexpr int ROW_PAD = ROW_SMP + NS;
constexpr int MP = MMAIN + 256;
constexpr int NWIN = 5888;
constexpr int NPOS = T + 1;
constexpr float EPS = 1e-6f;
constexpr int NWAVES = 8;

constexpr size_t MiB = 1u << 20;
constexpr size_t al(size_t x) { return (x + 255) / 256 * 256; }
constexpr size_t WS_CTL = 0, CTL_ZERO_BYTES = 1 * MiB;
constexpr size_t WS_W1T = 1 * MiB;
constexpr size_t WS_W1D = WS_W1T + al((size_t)2 * FFN * D * 2);
constexpr size_t WS_WIN = WS_W1D + al((size_t)D * FFN * 2);
constexpr size_t WS_WUQ = WS_WIN + al((size_t)NWIN * D * 2);
constexpr size_t WS_WUK = WS_WUQ + al((size_t)768 * QR * 2);
constexpr size_t WS_WUV = WS_WUK + al((size_t)512 * KVR * 2);
constexpr size_t WS_WMO = WS_WUV + al((size_t)512 * KVR * 2);
constexpr size_t WS_WRO = WS_WMO + al((size_t)D * 512 * 2);
constexpr size_t WS_WOUT = WS_WRO + al((size_t)D * D * 2);
constexpr size_t WS_W2T = WS_WOUT + al((size_t)D * D * 2);
constexpr size_t WS_W2D = WS_W2T + al((size_t)2 * FFN * D * 2);
constexpr size_t WS_WQL = WS_W2D + al((size_t)D * FFN * 2);
constexpr size_t WS_TAB = WS_WQL + al((size_t)2048 * QR * 2);
constexpr size_t TAB_C64 = 0, TAB_S64 = (size_t)NPOS * 64 * 4, TAB_C16 = 2 * TAB_S64, TAB_S16 = TAB_C16 + (size_t)NPOS * 16 * 4, TAB_GP = TAB_S16 + (size_t)NPOS * 16 * 4, TAB_GN = TAB_GP + 512 * 4, TAB_END = TAB_GN + 512 * 4;
constexpr size_t WS_XB = WS_TAB + al(TAB_END);
constexpr size_t WS_XE = WS_XB + al((size_t)MP * D * 2);
constexpr size_t WS_R1 = WS_XE + al((size_t)256 * D * 4);
constexpr size_t WS_ACT = WS_R1 + al((size_t)MP * 4);
constexpr size_t WS_H = WS_ACT + al((size_t)MP * FFN * 2);
constexpr size_t WS_HB = WS_H + al((size_t)MP * D * 4);
constexpr size_t WS_SSQH = WS_HB + al((size_t)MP * D * 2);
constexpr size_t WS_SSQ2_ = WS_SSQH + al((size_t)MP * 4), WS_SSQ3_ = WS_SSQ2_ + al((size_t)MP * 4);
constexpr size_t WS_END1 = WS_SSQH + al((size_t)MP * 16 * 4);

constexpr int CW_XCNT = 32768  , CW_BAR = 4096, CW_QUEUE = 64, CW_DCNT = 24576  ;

constexpr int RING_OFF = 0, RING_BYTES = 131072, SCR_BYTES = 155648  , LDSCTL_OFF = SCR_BYTES, MISC_OFF = LDSCTL_OFF + 320, LDS_BYTES = 163840;

struct Args {
    const float* in[27]; float* out; unsigned char* ws;
};

struct Frame {
    LAS unsigned char* lds;
    volatile LAS unsigned* MISC;
    int wave, vcu, G;
};

constexpr int PT_OFF = MISC_OFF + 256;
struct Ptrs {
    unsigned char* ws; volatile LAS unsigned* tab;
    __device__ __forceinline__ unsigned long long raw(int k) const { volatile LAS unsigned* t = tab; asm volatile("" : "+v"(t));
        const unsigned lo = __builtin_amdgcn_readfirstlane(t[2 * k]), hi = __builtin_amdgcn_readfirstlane(t[2 * k + 1]); return ((unsigned long long)hi << 32) | lo; }
    __device__ __forceinline__ const float* in(int k) const { return (const float*)(GAS const float*)raw(k); }
    __device__ __forceinline__ float* out() const { return (float*)(GAS float*)raw(27); }
};
__device__ __forceinline__ int fresh_tid(int wave) { int t = lane_fresh() + 64 * wave; asm volatile("" : "+v"(t)); return t; }

__device__ __forceinline__ float lx(float v, int lane, int mask) { return __int_as_float(__builtin_amdgcn_ds_bpermute((lane ^ mask) << 2, __float_as_int(v))); }
__device__ __forceinline__ float wave_sum(float v, int lane) {
#pragma unroll
    for (int o = 1; o < 64; o <<= 1) v += lx(v, lane, o);
    return v;
}
__device__ __forceinline__ int row_pos(int row) { return row < MMAIN ? (row & (SEQ - 1)) + NMETA : (row < ROW_SMP ? row - ROW_META : (row < ROW_PAD ? PAST : 0)); }
__device__ __forceinline__ int row_pidx(int row) { return row < MMAIN ? (row & (SEQ - 1)) + NMETA : (row < ROW_SMP ? row - ROW_META : (row < ROW_PAD ? T : 0)); }
__device__ __forceinline__ int row_jtok(int row) { return row < MMAIN ? (row & 127) : (row < ROW_SMP ? row - ROW_META : 0); }

struct WSrc { const float* W; int ld; int col0; const float* g; };
__device__ __forceinline__ void wmat_dims(int id, int& K, int& ngrp) {
    switch (id) {
        case 0: case 9: K = D; ngrp = 2 * FFN / 32; break;
        case 1: case 10: K = FFN; ngrp = D / 32; break;
        case 2: K = D; ngrp = NWIN / 32; break;
        case 3: K = QR; ngrp = 768 / 32; break;
        case 4: case 5: K = KVR; ngrp = 512 / 32; break;
        case 6: K = 512; ngrp = D / 32; break;
        default: K = D; ngrp = D / 32; break;
    }
}
__device__ __forceinline__ size_t wmat_off(int id) {
    switch (id) { case 0: return WS_W1T; case 1: return WS_W1D; case 2: return WS_WIN; case 3: return WS_WUQ; case 4: return WS_WUK; case 5: return WS_WUV;
                  case 6: return WS_WMO; case 7: return WS_WRO; case 8: return WS_WOUT; case 9: return WS_W2T; default: return WS_W2D; }
}
__device__ __forceinline__ WSrc wmat_src(const Args& a, int id, int g) {
    WSrc s; s.W = nullptr; s.ld = 0; s.col0 = 0; s.g = nullptr;
    switch (id) {
        case 0: case 9: { const int pn = g >> 3, gg = g & 7; const int o = id == 0 ? 7 : 22;
            s.W = gg < 4 ? a.in[o + 1] : a.in[o + 2]; s.ld = FFN; s.col0 = 128 * pn + 32 * (gg & 3); s.g = a.in[o]; break; }
        case 1: s.W = a.in[10]; s.ld = D; s.col0 = 32 * g; break;
        case 10: s.W = a.in[25]; s.ld = D; s.col0 = 32 * g; break;
        case 2: { s.ld = IN_DIM; s.g = a.in[11]; int zc = -1;
            if (g < 8) zc = 32 * g;
            else if (g < 16) { const int gg = g - 8; zc = gg < 4 ? 256 + 32 * gg : (gg == 4 ? O_KR : -1); }
            else if (g < 24) zc = O_CKV + 32 * (g - 16);
            else if (g < 56) { const int base = g < 40 ? O_RQ : O_RK; const int q = (g - 24) & 15, t = q >> 3, gg = q & 7;
                const int h = 2 * t + ((gg >> 1) & 1), part = (gg >> 2) * 64 + (gg & 1) * 32; zc = base + h * 128 + part; }
            else if (g < 88) zc = O_RV + 32 * (g - 56);
            else if (g < 120) zc = O_RG + 32 * (g - 88);
            else if (g < 152) zc = O_GA + 32 * (g - 120);
            else zc = O_GB + 32 * (g - 152);
            if (zc >= 0) { s.W = a.in[12]; s.col0 = zc; }
            break; }
        case 3: s.W = a.in[15]; s.ld = 768; s.col0 = 32 * g; s.g = a.in[13]; break;
        case 4: s.W = a.in[16]; s.ld = 512; s.col0 = 32 * g; s.g = a.in[14]; break;
        case 5: s.W = a.in[17]; s.ld = 512; s.col0 = 32 * g; s.g = a.in[14]; break;
        case 6: s.W = a.in[18]; s.ld = D; s.col0 = 32 * g; break;
        case 7: s.W = a.in[20]; s.ld = D; s.col0 = 32 * g; break;
        default: s.W = a.in[21]; s.ld = D; s.col0 = 32 * g; break;
    }
    return s;
}
__device__ __forceinline__ void p0_transpose_item(const WSrc s, int K, bf16* WT, int n0, int k0, LAS float* scr, int lane) {
    if (s.W) {
        float v[32];
        const float* wp = s.W + (size_t)(k0 + (lane >> 5)) * s.ld + s.col0 + (lane & 31);
#pragma unroll
        for (int i = 0; i < 32; ++i) v[i] = wp[(size_t)(2 * i) * s.ld];
        if (s.g) { const float* gp = s.g + k0 + (lane >> 5);
#pragma unroll
            for (int i = 0; i < 32; ++i) v[i] *= gp[2 * i]; }
#pragma unroll
        for (int i = 0; i < 32; ++i) scr[(2 * i + (lane >> 5)) * 33 + (lane & 31)] = v[i];
    } else {
#pragma unroll 8
        for (int i = 0; i < 32; ++i) { const int kk = 2 * i + (lane >> 5); scr[kk * 33 + (lane & 31)] = 0.f; }
    }
    LDS_WAIT(); asm volatile("" ::: "memory");
    const int c = lane & 7;
#pragma unroll
    for (int j = 0; j < 4; ++j) { const int n = (lane >> 3) + 8 * j; const LAS float* sp = scr + (8 * c) * 33 + n;
        v4u o; o.x = pk2(sp[0 * 33], sp[1 * 33]); o.y = pk2(sp[2 * 33], sp[3 * 33]); o.z = pk2(sp[4 * 33], sp[5 * 33]); o.w = pk2(sp[6 * 33], sp[7 * 33]);
        *(GAS v4u*)(WT + (size_t)(n0 + n) * K + k0 + 8 * c) = o; }
    LDS_WAIT(); asm volatile("" ::: "memory");
}
__device__ __forceinline__ const float* x_src(const Args& a, int row) {
    if (row < MMAIN) return a.in[0] + (size_t)row * D;
    if (row < ROW_SMP) return a.in[6] + (size_t)(row - ROW_META) * D;
    if (row < ROW_PAD) return a.in[1] + (size_t)(row - ROW_SMP) * D;
    return nullptr;
}
__device__ __forceinline__ void p0_weights(const Args& a, unsigned id_mask, int gw, int NGW, LAS float* scr, int lane) {
    unsigned char* ws = a.ws;
    int base = 0;
#pragma unroll 1
    for (int id = 0; id < 11; ++id) {
        if (!((id_mask >> id) & 1u)) continue;
        int K, ngrp; wmat_dims(id, K, ngrp);
        const int nk = K / 64, nitems = nk * ngrp;
        bf16* WT = (bf16*)(ws + wmat_off(id));
        int first = (gw - (base % NGW) + NGW) % NGW;
        for (int it = first; it < nitems; it += NGW) { const int g = it % ngrp, kb = it / ngrp; p0_transpose_item(wmat_src(a, id, g), K, WT, 32 * g, 64 * kb, scr, lane); }
        base += nitems;
    }
}
__device__ __forceinline__ void p0_weights_late(Frame& F, const Args& a) {
    const int bx = (int)blockIdx.x; if (bx < 188) return;
    const int lane = fresh_tid(F.wave) & 63;
    LAS float* scr = (LAS float*)(F.lds + RING_OFF + F.wave * 16384);
    p0_weights(a, 0x380u  , (bx - 188) * NWAVES + F.wave, 68 * NWAVES, scr, lane);
    __syncthreads();
}
__device__ __forceinline__ void p0_prologue(Frame& F, const Args& a) {
    const int lane = fresh_tid(F.wave) & 63;
    LAS float* scr = (LAS float*)(F.lds + RING_OFF + F.wave * 16384);
    const int gw = F.vcu * NWAVES + F.wave, NGW = F.G * NWAVES;
    unsigned char* ws = a.ws;
    p0_weights(a, 0x47Fu  , gw, NGW, scr, lane);
    bf16* XB = (bf16*)(ws + WS_XB); float* XE = (float*)(ws + WS_XE); float* R1 = (float*)(ws + WS_R1);
    for (int m0 = gw; m0 < MP; m0 += 2 * NGW) {
        f32x4 v[2][4];
#pragma unroll
        for (int t = 0; t < 2; ++t) { const int m = m0 + t * NGW; const float* xr = m < MP ? x_src(a, m) : nullptr;
#pragma unroll
            for (int j = 0; j < 4; ++j) v[t][j] = xr ? *((const GAS f32x4*)xr + lane + 64 * j) : (f32x4){0.f, 0.f, 0.f, 0.f}; }
#pragma unroll
        for (int t = 0; t < 2; ++t) { const int m = m0 + t * NGW; if (m >= MP) break;
            float s = 0.f;
#pragma unroll
            for (int j = 0; j < 4; ++j) s += (v[t][j].x * v[t][j].x + v[t][j].y * v[t][j].y) + (v[t][j].z * v[t][j].z + v[t][j].w * v[t][j].w);
            s = wave_sum(s, lane);
            if (lane == 0) R1[m] = 1.0f / sqrtf(s * (1.f / D) + EPS);
            GAS unsigned long long* o8 = (GAS unsigned long long*)(XB + (size_t)m * D) + lane;
#pragma unroll
            for (int j = 0; j < 4; ++j) o8[64 * j] = (unsigned long long)pk2(v[t][j].x, v[t][j].y) | ((unsigned long long)pk2(v[t][j].z, v[t][j].w) << 32);
            if (m >= MMAIN) {
#pragma unroll
                for (int j = 0; j < 4; ++j) *((GAS f32x4*)(XE + (size_t)(m - MMAIN) * D) + lane + 64 * j) = v[t][j];
            } }
    }
    {   const float* wuq = a.in[15]; const float* wuk = a.in[16]; const float* qn = a.in[13]; bf16* WQL = (bf16*)(ws + WS_WQL);
        LAS float* U = (LAS float*)(F.lds + RING_OFF);
        const int tid = F.wave * 64 + lane;
        for (int it = F.vcu; it < 256; it += F.G) {
            const int h = it >> 5, r0 = (it & 31) * 8;
            __syncthreads();
            for (int e = tid; e < QR * 64; e += NWAVES * 64) { const int k = e >> 6, n = e & 63; U[k * 65 + n] = wuq[(size_t)k * 768 + h * 96 + n]; }
            { const int rr = tid >> 6, n = tid & 63; U[QR * 65 + rr * 64 + n] = wuk[(size_t)(r0 + rr) * 512 + h * 64 + n]; }
            __syncthreads();
            if (tid < QR) { const float g = qn[tid]; float acc[8];
#pragma unroll
                for (int rr = 0; rr < 8; ++rr) acc[rr] = 0.f;
                for (int n = 0; n < 64; ++n) { const float u = U[tid * 65 + n];
#pragma unroll
                    for (int rr = 0; rr < 8; ++rr) acc[rr] += u * U[QR * 65 + rr * 64 + n]; }
#pragma unroll
                for (int rr = 0; rr < 8; ++rr) WQL[(size_t)(h * 256 + r0 + rr) * QR + tid] = (bf16)f2bf(acc[rr] * g); }
        }
        __syncthreads();
    }
    { const int gt_ = (F.vcu * NWAVES + F.wave) * 64 + lane, NGT_ = NGW * 64;
      for (int e = gt_; e < MP; e += NGT_) { ((float*)(ws + WS_SSQH))[e] = 0.f; ((float*)(ws + WS_SSQ2_))[e] = 0.f; ((float*)(ws + WS_SSQ3_))[e] = 0.f; } }
    float* TAB = (float*)(ws + WS_TAB);
    const int gt = (F.vcu * NWAVES + F.wave) * 64 + lane, NGT = NGW * 64;
    for (int e = gt; e < NPOS * 64; e += NGT) { const int p = e >> 6, i = e & 63; const int pos = p < T ? p : PAST;
        const float invf = (float)pow(10000.0, -(double)i / 64.0); const float ang = (float)pos * invf;
        TAB[TAB_C64 / 4 + e] = (float)cos((double)ang); TAB[TAB_S64 / 4 + e] = (float)sin((double)ang); }
    for (int e = gt; e < NPOS * 16; e += NGT) { const int p = e >> 4, i = e & 15; const int pos = p < T ? p : PAST;
        const float invf = (float)pow(10000.0, -(double)i / 16.0); const float ang = (float)pos * invf;
        TAB[TAB_C16 / 4 + e] = (float)cos((double)ang); TAB[TAB_S16 / 4 + e] = (float)sin((double)ang); }
    for (int e = gt; e < 512; e += NGT) { const int h = e >> 7, j = e & 127; const double lg = log1p(-exp2(-5.0 - (double)h));
        TAB[TAB_GP / 4 + e] = (float)exp(lg * (double)j); TAB[TAB_GN / 4 + e] = (float)exp(-lg * (double)j); }
}

using pg8::f32x4; using pg8::u32x4; using pg8::Unit; using pg8::BM; using pg8::HALF;
typedef unsigned u32x2 __attribute__((ext_vector_type(2)));
__device__ __forceinline__ float fast_sigmoid(float x) { return __builtin_amdgcn_rcpf(1.f + __builtin_amdgcn_exp2f(-1.4426950408889634f * x)); }
__device__ __forceinline__ float fast_silu(float x) { return x * fast_sigmoid(x); }

struct EpiSwiGLU {
    static constexpr bool PERM = true, AFTER_DRAIN = false;
    bf16* ACT; const float* rs;
    __device__ __forceinline__ void operator()(const f32x4 (&acc)[2][2][4][2], const Unit& u, int wr, int wc, int fr, int fq) const {
        int l_ = lane_fresh(); asm volatile("" : "+v"(l_)); fr = l_ & 15; fq = l_ >> 4;
        const int row0 = u.pm * BM + wr * 64 + fr, col0 = u.pn * HALF + wc * 32 + 8 * fq;
#pragma unroll
        for (int ai = 0; ai < 2; ++ai)
#pragma unroll
            for (int m = 0; m < 4; ++m) { const int row = row0 + ai * HALF + m * 16; const float r = rs[row];
                f32x4 o[2];
#pragma unroll
                for (int n = 0; n < 2; ++n)
#pragma unroll
                    for (int j = 0; j < 4; ++j) { const float g = acc[ai][0][m][n][j] * r, up = acc[ai][1][m][n][j] * r; o[n][j] = fast_silu(g) * up; }
                u32x4 w; w.x = pg8::cvt_pk_bf16(o[0][0], o[0][1]); w.y = pg8::cvt_pk_bf16(o[0][2], o[0][3]); w.z = pg8::cvt_pk_bf16(o[1][0], o[1][1]); w.w = pg8::cvt_pk_bf16(o[1][2], o[1][3]);
                *(u32x4*)(ACT + (size_t)row * FFN + col0) = w; }
    }
};
template <class T> __device__ __forceinline__ T* at(unsigned char* w, unsigned byte_off) { return (T*)(w + byte_off); }
template <unsigned RES_OFF, bool RES_X, unsigned OUT_OFF, unsigned OUTB_OFF, unsigned SSQ_OFF, int SCALE2  > struct EpiResid {
    static constexpr bool PERM = false, AFTER_DRAIN = false;
    unsigned char* ws_; const float* xin;
    __device__ __forceinline__ void operator()(const f32x4 (&acc)[2][2][4][2], const Unit& u, int wr, int wc, int fr, int fq) const {
        int l_ = lane_fresh(); asm volatile("" : "+v"(l_)); fr = l_ & 15; fq = l_ >> 4;
        unsigned char* w = opaque_g(ws_);
        const unsigned row0 = u.pm * BM + wr * 64 + fr, col0 = u.pn * BM + wc * 32 + 4 * fq;
        constexpr float scale = 0.5f * SCALE2;
#pragma unroll
        for (int ai = 0; ai < 2; ++ai)
#pragma unroll
            for (int m = 0; m < 4; ++m) { unsigned row = row0 + ai * HALF + m * 16; asm volatile("" : "+v"(row));
                const float* rp;
                if (RES_X) rp = row < (unsigned)MMAIN ? xin + row * D + col0 : at<const float>(w, RES_OFF + ((row - MMAIN) * D + col0) * 4);
                else rp = at<const float>(w, RES_OFF + (row * D + col0) * 4);
                float ss = 0.f;
#pragma unroll
                for (int bj = 0; bj < 2; ++bj)
#pragma unroll
                    for (int n = 0; n < 2; ++n) { const f32x4 b = *(const f32x4*)(rp + bj * HALF + n * 16); const f32x4 o = b + acc[ai][bj][m][n] * scale;
                        const unsigned e = row * D + col0 + bj * HALF + n * 16;
                        *at<f32x4>(w, OUT_OFF + e * 4) = o;
                        ss += (o[0] * o[0] + o[1] * o[1]) + (o[2] * o[2] + o[3] * o[3]);
                        if (OUTB_OFF) { u32x2 pk; pk.x = pg8::cvt_pk_bf16(o[0], o[1]); pk.y = pg8::cvt_pk_bf16(o[2], o[3]); *at<u32x2>(w, OUTB_OFF + e * 2) = pk; } }
                ss += lx(ss, l_, 16); ss += lx(ss, l_, 32);
                if (fq == 0) atomicAdd(at<float>(w, SSQ_OFF + row * 4), ss);
                asm volatile("" ::: "memory"); }
    }
};
}
namespace mk {
constexpr size_t WS_CQ = WS_END1;
constexpr size_t WS_SSQCQ = WS_CQ + al((size_t)MP * QR * 2);
constexpr size_t WS_CKVF = WS_SSQCQ + al((size_t)MP * 8 * 4);
constexpr size_t WS_CKVB = WS_CKVF + al((size_t)MP * KVR * 4);
constexpr size_t WS_SSQKV = WS_CKVB + al((size_t)MP * KVR * 2);
constexpr size_t WS_KRB = WS_SSQKV + al((size_t)MP * 4 * 4);
constexpr size_t WS_RQ = WS_KRB + al((size_t)MP * 32 * 2);
constexpr size_t WS_RK = WS_RQ + al((size_t)MP * 512 * 2);
constexpr size_t WS_RKT = WS_RK + al((size_t)MP * 512 * 2);
constexpr size_t WS_RVT = WS_RKT + al((size_t)MP * 512 * 2);
constexpr size_t WS_SRG = WS_RVT + al((size_t)MP * 1024 * 2);
constexpr size_t WS_SGA = WS_SRG + al((size_t)MP * 1024 * 2);
constexpr size_t WS_SGB = WS_SGA + al((size_t)MP * 1024 * 2);
constexpr size_t WS_QA = WS_SGB + al((size_t)MP * 1024 * 2);
constexpr size_t WS_KN = WS_QA + al((size_t)MP * 768 * 2);
constexpr size_t WS_VT = WS_KN + al((size_t)MP * 512 * 2);
constexpr size_t WS_KRF = WS_VT + al((size_t)MP * 512 * 2);
constexpr size_t WS_END2 = WS_KRF + al((size_t)MP * 32 * 4);
constexpr float SC_Q = 0.14724444348433683f;
constexpr float RK_SCALE = 0.08838834764831845f;

constexpr size_t OUT_YP = 0, OUT_YS = OUT_YP + (size_t)NB * SEQ * D, OUT_CKVP = OUT_YS + (size_t)NS * D, OUT_KRP = OUT_CKVP + (size_t)NB * T * KVR,
                 OUT_SRP = OUT_KRP + (size_t)NB * T * 32, OUT_CKVS = OUT_SRP + (size_t)NB * RH * RDK * RDV, OUT_KRS = OUT_CKVS + (size_t)NS * KVR, OUT_SRS = OUT_KRS + (size_t)NS * 32,
                 OUT_END = OUT_SRS + (size_t)NS * RH * RDK * RDV;

__device__ __forceinline__ float row_rscale16(const float* SSQ, int row, float inv_n) { return 1.0f / sqrtf(SSQ[row] * inv_n + EPS); }
__device__ __forceinline__ float row_rscale8(const float* SSQ, int row, float inv_n) {
    const f32x4* p = (const f32x4*)(SSQ + (size_t)row * 8); const f32x4 a = p[0], b = p[1];
    return 1.0f / sqrtf((((a[0] + a[1]) + (a[2] + a[3])) + ((b[0] + b[1]) + (b[2] + b[3]))) * inv_n + EPS);
}
__device__ __forceinline__ float row_rscale4(const float* SSQ, int row, float inv_n) {
    const f32x4 a = *(const f32x4*)(SSQ + (size_t)row * 4);
    return 1.0f / sqrtf(((a[0] + a[1]) + (a[2] + a[3])) * inv_n + EPS);
}
__device__ __forceinline__ u32x2 pack4(const f32x4 v) { u32x2 w; w.x = pg8::cvt_pk_bf16(v[0], v[1]); w.y = pg8::cvt_pk_bf16(v[2], v[3]); return w; }
__device__ __forceinline__ float ssq4(const f32x4 v) { return (v[0] * v[0] + v[1] * v[1]) + (v[2] * v[2] + v[3] * v[3]); }
__device__ __forceinline__ bf16 bf1(float x) { return (bf16)f2bf(x); }

static_assert(WS_END2 < ((size_t)1 << 31), "32-bit workspace offsets");
__device__ __forceinline__ void tr_store16(LAS unsigned char* T, int fr, int fq, int lane, const f32x4 (&v)[4], unsigned char* w, unsigned dst_off) {
#pragma unroll
    for (int m = 0; m < 4; ++m)
#pragma unroll
        for (int j = 0; j < 4; ++j) *(LAS bf16*)(T + (4 * fq + j) * 144 + (16 * m + fr) * 2) = bf1(v[m][j]);
    asm volatile("s_waitcnt lgkmcnt(0)" ::: "memory");
#pragma unroll
    for (int k = 0; k < 2; ++k) { const int id = lane + 64 * k, c = id >> 3, part = id & 7; const v4u x = *(const LAS v4u*)(T + c * 144 + part * 16); *at<v4u>(w, dst_off + (unsigned)(((c >> 2) * 8 + (c & 3)) * MP + 8 * part) * 2u) = x; }
    asm volatile("s_waitcnt lgkmcnt(0)" ::: "memory");
}
constexpr int EPI_LDS_OFF = RING_BYTES, EPI_LDS_WAVE = 3072;
static_assert(EPI_LDS_OFF + 8 * EPI_LDS_WAVE <= SCR_BYTES && 16 * 144 <= EPI_LDS_WAVE, "epilogue LDS scratch");
__device__ __forceinline__ u32x4 pack8(const f32x4 a, const f32x4 b) { u32x4 w; w.x = pg8::cvt_pk_bf16(a[0], a[1]); w.y = pg8::cvt_pk_bf16(a[2], a[3]); w.z = pg8::cvt_pk_bf16(b[0], b[1]); w.w = pg8::cvt_pk_bf16(b[2], b[3]); return w; }
struct EpiWin {
    static constexpr bool PERM = true, AFTER_DRAIN = false;
    unsigned char* ws_; LAS unsigned char* lds_;
#define MK_WS(var) unsigned char* var = opaque_g(ws_)
#define MK_ROWS_BEGIN _Pragma("unroll") for (int ai = 0; ai < 2; ++ai) _Pragma("unroll") for (int m = 0; m < 4; ++m) { \
        unsigned row = row0 + ai * HALF + m * 16; asm volatile("" : "+v"(row)); const float r = rsc[ai * 4 + m];
#define MK_ROWS_END asm volatile("" ::: "memory"); }
    __device__ __forceinline__ void operator()(const f32x4 (&acc)[2][2][4][2], const Unit& u, int wr, int wc, int fr, int fq) const {
        int l_ = lane_fresh(); asm volatile("" : "+v"(l_)); fr = l_ & 15; fq = l_ >> 4;
        const unsigned row0 = u.pm * BM + wr * 64 + fr; const int pn = u.pn;
        const unsigned c8 = wc * 32 + 8 * fq;
        MK_WS(w);
        float rsc[8];
#pragma unroll
        for (int k = 0; k < 8; ++k) rsc[k] = row_rscale16(at<const float>(w, (unsigned)WS_SSQH), (int)(row0 + (k >> 2) * HALF + (k & 3) * 16), 1.f / D);
        if (pn == 0) {
            MK_ROWS_BEGIN
                float ss = 0.f;
#pragma unroll
                for (int bj = 0; bj < 2; ++bj) { const f32x4 v0 = acc[ai][bj][m][0] * r, v1 = acc[ai][bj][m][1] * r; ss += ssq4(v0) + ssq4(v1); *at<u32x4>(w, (unsigned)WS_CQ + (row * QR + bj * HALF + c8) * 2) = pack8(v0, v1); }
                ss += lx(ss, l_, 16); ss += lx(ss, l_, 32);
                if (fq == 0) *at<float>(w, (unsigned)WS_SSQCQ + (row * 8 + wc) * 4) = ss;
            MK_ROWS_END
        } else if (pn == 1) {
            MK_ROWS_BEGIN
                const f32x4 v0 = acc[ai][0][m][0] * r, v1 = acc[ai][0][m][1] * r;
                float ss = ssq4(v0) + ssq4(v1);
                *at<u32x4>(w, (unsigned)WS_CQ + (row * QR + 256 + c8) * 2) = pack8(v0, v1);
                ss += lx(ss, l_, 16); ss += lx(ss, l_, 32);
                if (fq == 0) *at<float>(w, (unsigned)WS_SSQCQ + (row * 8 + 4 + wc) * 4) = ss;
                if (wc == 0) {
                    const f32x4 a0 = acc[ai][1][m][0] * r, a1 = acc[ai][1][m][1] * r;
                    f32x4 p0, p1;
#pragma unroll
                    for (int j = 0; j < 4; ++j) { p0[j] = lx(a0[j], l_, 32); p1[j] = lx(a1[j], l_, 32); }
                    const unsigned pi = row_pidx((int)row), i0 = 8 * (fq & 1);
                    const f32x4 c0 = *at<const f32x4>(w, (unsigned)(WS_TAB + TAB_C16) + (pi * 16 + i0) * 4), c1 = *at<const f32x4>(w, (unsigned)(WS_TAB + TAB_C16) + (pi * 16 + i0 + 4) * 4);
                    const f32x4 s0 = *at<const f32x4>(w, (unsigned)(WS_TAB + TAB_S16) + (pi * 16 + i0) * 4), s1 = *at<const f32x4>(w, (unsigned)(WS_TAB + TAB_S16) + (pi * 16 + i0 + 4) * 4);
                    const f32x4 y0 = fq < 2 ? a0 * c0 - p0 * s0 : p0 * s0 + a0 * c0, y1 = fq < 2 ? a1 * c1 - p1 * s1 : p1 * s1 + a1 * c1;
                    *at<u32x4>(w, (unsigned)WS_KRB + (row * 32 + 8 * fq) * 2) = pack8(y0, y1);
                    *at<f32x4>(w, (unsigned)WS_KRF + (row * 32 + 8 * fq) * 4) = y0; *at<f32x4>(w, (unsigned)WS_KRF + (row * 32 + 8 * fq + 4) * 4) = y1;
                }
            MK_ROWS_END
        } else if (pn == 2) {
            MK_ROWS_BEGIN
                float ss = 0.f;
#pragma unroll
                for (int bj = 0; bj < 2; ++bj) { const f32x4 v0 = acc[ai][bj][m][0] * r, v1 = acc[ai][bj][m][1] * r; ss += ssq4(v0) + ssq4(v1); const unsigned e = row * KVR + bj * HALF + c8;
                    *at<f32x4>(w, (unsigned)WS_CKVF + e * 4) = v0; *at<f32x4>(w, (unsigned)WS_CKVF + (e + 4) * 4) = v1; *at<u32x4>(w, (unsigned)WS_CKVB + e * 2) = pack8(v0, v1); }
                ss += lx(ss, l_, 16); ss += lx(ss, l_, 32);
                if (fq == 0) *at<float>(w, (unsigned)WS_SSQKV + (row * 4 + wc) * 4) = ss;
            MK_ROWS_END
        } else if (pn < 7) {
            const bool isk = pn >= 5; const unsigned hh = 2 * ((pn - 3) & 1) + (wc >> 1), i0 = 32 * (wc & 1) + 8 * fq;
            const unsigned dbase = (unsigned)(isk ? WS_RK : WS_RQ) + hh * 256, gbase = (unsigned)(WS_TAB + (isk ? TAB_GN : TAB_GP)) + hh * 512;
            LAS unsigned char* T = lds_ + EPI_LDS_OFF + (wr * 4 + wc) * EPI_LDS_WAVE;
#pragma unroll
            for (int ai = 0; ai < 2; ++ai) {
                f32x4 y1s[2][4], y2s[2][4];
#pragma unroll
                for (int m = 0; m < 4; ++m) {
                    unsigned row = row0 + ai * HALF + m * 16; asm volatile("" : "+v"(row)); const float r = rsc[ai * 4 + m];
                    const unsigned pi = row_pidx((int)row), jt = row_jtok((int)row);
                    const float mult = *at<const float>(w, gbase + jt * 4) * (isk ? RK_SCALE : 1.f);
#pragma unroll
                    for (int n = 0; n < 2; ++n) {
                        const f32x4 x1 = acc[ai][0][m][n] * r, x2 = acc[ai][1][m][n] * r;
                        const f32x4 c = *at<const f32x4>(w, (unsigned)(WS_TAB + TAB_C64) + (pi * 64 + i0 + 4 * n) * 4), s = *at<const f32x4>(w, (unsigned)(WS_TAB + TAB_S64) + (pi * 64 + i0 + 4 * n) * 4);
                        y1s[n][m] = (x1 * c - x2 * s) * mult; y2s[n][m] = (x1 * s + x2 * c) * mult; }
                    *at<u32x4>(w, dbase + (row * 512 + i0) * 2) = pack8(y1s[0][m], y1s[1][m]); *at<u32x4>(w, dbase + (row * 512 + 64 + i0) * 2) = pack8(y2s[0][m], y2s[1][m]);
                    asm volatile("" ::: "memory");
                }
                if (isk) {
                    const unsigned rb = u.pm * BM + ai * HALF + wr * 64, cb = hh * 128 + 32 * (wc & 1);
#pragma unroll
                    for (int n = 0; n < 2; ++n) {
                        tr_store16(T, fr, fq, l_, y1s[n], w, (unsigned)WS_RKT + ((cb + 4 * n) * MP + rb) * 2u); tr_store16(T, fr, fq, l_, y2s[n], w, (unsigned)WS_RKT + ((cb + 64 + 4 * n) * MP + rb) * 2u); }
                }
            }
        } else if (pn < 11) {
            LAS unsigned char* T = lds_ + EPI_LDS_OFF + (wr * 4 + wc) * EPI_LDS_WAVE;
#pragma unroll
            for (int ai = 0; ai < 2; ++ai) {
                const unsigned rb = u.pm * BM + ai * HALF + wr * 64;
#pragma unroll
                for (int bj = 0; bj < 2; ++bj)
#pragma unroll
                    for (int n = 0; n < 2; ++n) { f32x4 vv[4];
#pragma unroll
                        for (int m = 0; m < 4; ++m) vv[m] = acc[ai][bj][m][n] * rsc[ai * 4 + m];
                        tr_store16(T, fr, fq, l_, vv, w, (unsigned)WS_RVT + (((pn - 7) * 256 + bj * HALF + wc * 32 + 4 * n) * MP + rb) * 2u); }
                asm volatile("" ::: "memory");
            }
        } else {
            const int t = (pn - 11) >> 2; const unsigned dbase = (unsigned)WS_SRG + (unsigned)t * (unsigned)(WS_SGA - WS_SRG) + (((pn - 11) & 3) * 256 + c8) * 2;
            MK_ROWS_BEGIN
#pragma unroll
                for (int bj = 0; bj < 2; ++bj) { const f32x4 v0 = acc[ai][bj][m][0] * r, v1 = acc[ai][bj][m][1] * r; f32x4 o0, o1;
#pragma unroll
                    for (int j = 0; j < 4; ++j) { const float g0 = fast_sigmoid(v0[j]), g1 = fast_sigmoid(v1[j]); o0[j] = t == 0 ? v0[j] * g0 : g0; o1[j] = t == 0 ? v1[j] * g1 : g1; }
                    *at<u32x4>(w, dbase + (row * 1024 + bj * HALF) * 2) = pack8(o0, o1); }
            MK_ROWS_END
        }
    }
};
static_assert(WS_SGB - WS_SGA == WS_SGA - WS_SRG, "gate arrays equally spaced");
struct EpiQ {
    static constexpr bool PERM = false, AFTER_DRAIN = false;
    unsigned char* ws;
    __device__ __forceinline__ void operator()(const f32x4 (&acc)[2][2][4][2], const Unit& u, int wr, int wc, int fr, int fq) const {
        int l_ = lane_fresh(); asm volatile("" : "+v"(l_)); fr = l_ & 15; fq = l_ >> 4;
        const float* SSQCQ = (const float*)(ws + WS_SSQCQ); bf16* QA = (bf16*)(ws + WS_QA); const float* TAB = (const float*)(ws + WS_TAB);
        const int row0 = u.pm * BM + wr * 64 + fr;
#pragma unroll
        for (int ai = 0; ai < 2; ++ai)
#pragma unroll
            for (int m = 0; m < 4; ++m) {
                int row = row0 + ai * HALF + m * 16; asm volatile("" : "+v"(row));
                const float r = row_rscale8(SSQCQ, row, 1.f / QR) * SC_Q;
#pragma unroll
                for (int bj = 0; bj < 2; ++bj) {
                    const int grp = 8 * u.pn + 4 * bj + wc;
                    bf16* dst = QA + (size_t)row * 768 + 32 * grp + 4 * fq;
                    const bool rope = (grp % 3) == 2;
                    const int pi = row_pidx(row);
                    f32x4 c = *(const f32x4*)(TAB + TAB_C16 / 4 + pi * 16 + 4 * fq), s = *(const f32x4*)(TAB + TAB_S16 / 4 + pi * 16 + 4 * fq);
                    if (!rope) { c = (f32x4){1.f, 1.f, 1.f, 1.f}; s = (f32x4){0.f, 0.f, 0.f, 0.f}; }
                    const f32x4 x1 = acc[ai][bj][m][0] * r, x2 = acc[ai][bj][m][1] * r;
                    *(u32x2*)dst = pack4(x1 * c - x2 * s); *(u32x2*)(dst + 16) = pack4(x1 * s + x2 * c);
                }
                asm volatile("" ::: "memory");
            }
    }
};
template <bool ROWS> struct EpiScaleBf16 {
    static constexpr bool PERM = true, AFTER_DRAIN = false;
    const float* SSQKV; bf16* O; int ldc;
    __device__ __forceinline__ void operator()(const f32x4 (&acc)[2][2][4][2], const Unit& u, int wr, int wc, int fr, int fq) const {
        int l_ = lane_fresh(); asm volatile("" : "+v"(l_)); fr = l_ & 15; fq = l_ >> 4;
        const int row0 = u.pm * BM + wr * 64 + fr, col0 = u.pn * BM + wc * 32 + 8 * fq;
        float cs[2][8];
        if (!ROWS) {
#pragma unroll
            for (int bj = 0; bj < 2; ++bj)
#pragma unroll
                for (int k = 0; k < 8; ++k) cs[bj][k] = row_rscale4(SSQKV, col0 + bj * HALF + k, 1.f / KVR);
        }
#pragma unroll
        for (int ai = 0; ai < 2; ++ai)
#pragma unroll
            for (int m = 0; m < 4; ++m) { int row = row0 + ai * HALF + m * 16; asm volatile("" : "+v"(row)); const float r = ROWS ? row_rscale4(SSQKV, row, 1.f / KVR) : 1.f;
#pragma unroll
                for (int bj = 0; bj < 2; ++bj) { f32x4 v0 = acc[ai][bj][m][0], v1 = acc[ai][bj][m][1];
                    if (ROWS) { v0 = v0 * r; v1 = v1 * r; }
                    else {
#pragma unroll
                        for (int j = 0; j < 4; ++j) { v0[j] *= cs[bj][j]; v1[j] *= cs[bj][4 + j]; } }
                    u32x4 w; w.x = pg8::cvt_pk_bf16(v0[0], v0[1]); w.y = pg8::cvt_pk_bf16(v0[2], v0[3]); w.z = pg8::cvt_pk_bf16(v1[0], v1[1]); w.w = pg8::cvt_pk_bf16(v1[2], v1[3]);
                    *(u32x4*)(O + (size_t)row * ldc + col0 + bj * HALF) = w; } }
    }
};
__device__ __forceinline__ void finalize_ckv(Frame& F, const Ptrs& a) {
    const int lane = fresh_tid(F.wave) & 63;
    const int gw = F.vcu * NWAVES + F.wave, NGW = F.G * NWAVES;
    const float* CKVF = (const float*)(a.ws + WS_CKVF); const float* SSQKV = (const float*)(a.ws + WS_SSQKV); const float* KRF = (const float*)(a.ws + WS_KRF);
    const f32x4 g = *((const f32x4*)a.in(14) + lane);
    for (int row = gw; row < ROW_PAD; row += NGW) {
        const float r = row_rscale4(SSQKV, row, 1.f / KVR);
        const f32x4 o = *((const f32x4*)(CKVF + (size_t)row * KVR) + lane) * r * g;
        const f32x4 kr = *((const f32x4*)(KRF + (size_t)row * 32) + (lane & 7));
        if (row < MMAIN) { const size_t t = (size_t)(row >> 11) * T + NMETA + (row & (SEQ - 1)); *((f32x4*)(a.out() + OUT_CKVP + t * KVR) + lane) = o; if (lane < 8) *((f32x4*)(a.out() + OUT_KRP + t * 32) + lane) = kr; }
        else if (row < ROW_SMP) { for (int b = 0; b < NB; ++b) { const size_t t = (size_t)b * T + (row - ROW_META); *((f32x4*)(a.out() + OUT_CKVP + t * KVR) + lane) = o; if (lane < 8) *((f32x4*)(a.out() + OUT_KRP + t * 32) + lane) = kr; } }
        else { *((f32x4*)(a.out() + OUT_CKVS + (size_t)(row - ROW_SMP) * KVR) + lane) = o; if (lane < 8) *((f32x4*)(a.out() + OUT_KRS + (size_t)(row - ROW_SMP) * 32) + lane) = kr; }
    }
}
}
namespace mk {
constexpr size_t WS_AV = WS_END2;
constexpr size_t WS_END3 = WS_AV + al((size_t)MP * 512 * 2);
typedef float f32x16 __attribute__((ext_vector_type(16)));
constexpr int AT_KSTR = 208, AT_VSTR = 144, AT_KBUF = 64 * AT_KSTR, AT_VBUF = 64 * AT_VSTR, AT_VOFF = 2 * AT_KBUF;
__device__ __forceinline__ int crow(int i, int half) { return (i & 3) + 8 * (i >> 2) + 4 * half; }

__device__ __forceinline__ void attn_unit(Frame& F, unsigned char* ws, int b, int h, int qb) {
    ws = opaque_g(ws);
    const int tid = fresh_tid(F.wave), lane = tid & 63, w = F.wave, q = lane & 31, half = lane >> 5;
    LAS unsigned char* L = F.lds + RING_OFF;
    const bf16* QA = (const bf16*)(ws + WS_QA); const bf16* KN = (const bf16*)(ws + WS_KN); const bf16* KRB = (const bf16*)(ws + WS_KRB); const bf16* VT = (const bf16*)(ws + WS_VT);
    const int qrow = b * SEQ + qb * 256 + w * 32 + q, q_main = qb * 256 + w * 32 + q, wq0 = qb * 256 + w * 32;
    bf16x8 qf[6];
#pragma unroll
    for (int s = 0; s < 6; ++s) qf[s] = *(const bf16x8*)(QA + (size_t)qrow * 768 + h * 96 + 16 * s + 8 * half);
    f32x16 ot[2];
#pragma unroll
    for (int i = 0; i < 16; ++i) { ot[0][i] = 0.f; ot[1][i] = 0.f; }
    float m = -INFINITY, l = 0.f;
    const int NT = 4 * (qb + 1);
    v4u kreg, rreg, vreg; rreg = (v4u){0u, 0u, 0u, 0u};
#define AT_LOAD(tt) do { const int t0_ = (tt) == 0 ? ROW_META : b * SEQ + 64 * ((tt) - 1); \
        kreg = *(const v4u*)(KN + (size_t)(t0_ + (tid >> 3)) * 512 + h * 64 + (tid & 7) * 8); \
        if (tid < 256) rreg = *(const v4u*)(KRB + (size_t)(t0_ + (tid >> 2)) * 32 + (tid & 3) * 8); \
        vreg = *(const v4u*)(VT + (size_t)(h * 64 + (tid >> 3)) * MP + t0_ + (tid & 7) * 8); } while (0)
#define AT_STORE(buf) do { LAS unsigned char* kb_ = L + (buf) * AT_KBUF; \
        *(LAS v4u*)(kb_ + (tid >> 3) * AT_KSTR + (tid & 7) * 16) = kreg; \
        if (tid < 256) *(LAS v4u*)(kb_ + (tid >> 2) * AT_KSTR + 128 + (tid & 3) * 16) = rreg; \
        LAS unsigned char* vb_ = L + AT_VOFF + (buf) * AT_VBUF + (tid >> 3) * AT_VSTR + (32 * ((tid & 7) >> 1) + 8 * (tid & 1)); \
        *(LAS u32x2*)(vb_) = (u32x2){vreg.x, vreg.y}; *(LAS u32x2*)(vb_ + 16) = (u32x2){vreg.z, vreg.w}; } while (0)
    AT_LOAD(0); AT_STORE(0);
    __syncthreads();
    for (int tt = 0; tt <= NT; ++tt) {
        const int buf = tt & 1;
        if (tt < NT) AT_LOAD(tt + 1);
        const int kmin = tt == 0 ? 0 : 64 * (tt - 1);
        if (tt == 0 || kmin <= wq0 + 31) {
            const LAS unsigned char* Kb = L + buf * AT_KBUF + q * AT_KSTR + 16 * half;
            const LAS unsigned char* Vb = L + AT_VOFF + buf * AT_VBUF + q * AT_VSTR + 16 * half;
            f32x16 st[2];
#pragma unroll
            for (int kb = 0; kb < 2; ++kb) {
#pragma unroll
                for (int i = 0; i < 16; ++i) st[kb][i] = 0.f;
#pragma unroll
                for (int s = 0; s < 6; ++s) { const bf16x8 kf = *(const LAS bf16x8*)(Kb + kb * 32 * AT_KSTR + 32 * s); st[kb] = __builtin_amdgcn_mfma_f32_32x32x16_bf16(kf, qf[s], st[kb], 0, 0, 0); }
            }
            if (tt == 0) {
#pragma unroll
                for (int kb = 0; kb < 2; ++kb)
#pragma unroll
                    for (int i = 0; i < 16; ++i) if (32 * kb + crow(i, half) >= NMETA) st[kb][i] = -INFINITY;
            } else if (kmin + 63 > wq0) {
#pragma unroll
                for (int kb = 0; kb < 2; ++kb)
#pragma unroll
                    for (int i = 0; i < 16; ++i) if (kmin + 32 * kb + crow(i, half) > q_main) st[kb][i] = -INFINITY;
            }
            float mx = st[0][0];
#pragma unroll
            for (int i = 1; i < 16; ++i) mx = fmaxf(mx, st[0][i]);
#pragma unroll
            for (int i = 0; i < 16; ++i) mx = fmaxf(mx, st[1][i]);
            mx = fmaxf(mx, lx(mx, lane, 32));
            const float mn = fmaxf(m, mx), alpha = __builtin_amdgcn_exp2f(m - mn);
            m = mn;
            float ps = 0.f;
#pragma unroll
            for (int kb = 0; kb < 2; ++kb)
#pragma unroll
                for (int i = 0; i < 16; ++i) { st[kb][i] = __builtin_amdgcn_exp2f(st[kb][i] - mn); ps += st[kb][i]; }
            l = l * alpha + ps;
#pragma unroll
            for (int i = 0; i < 16; ++i) { ot[0][i] *= alpha; ot[1][i] *= alpha; }
#pragma unroll
            for (int kb = 0; kb < 2; ++kb)
#pragma unroll
                for (int s2 = 0; s2 < 2; ++s2) {
                    u32x4 pw; pw.x = pg8::cvt_pk_bf16(st[kb][8 * s2 + 0], st[kb][8 * s2 + 1]); pw.y = pg8::cvt_pk_bf16(st[kb][8 * s2 + 2], st[kb][8 * s2 + 3]);
                    pw.z = pg8::cvt_pk_bf16(st[kb][8 * s2 + 4], st[kb][8 * s2 + 5]); pw.w = pg8::cvt_pk_bf16(st[kb][8 * s2 + 6], st[kb][8 * s2 + 7]);
                    const bf16x8 pf = __builtin_bit_cast(bf16x8, pw);
#pragma unroll
                    for (int vb = 0; vb < 2; ++vb) { const bf16x8 vf = *(const LAS bf16x8*)(Vb + vb * 32 * AT_VSTR + (32 * kb + 16 * s2) * 2); ot[vb] = __builtin_amdgcn_mfma_f32_32x32x16_bf16(vf, pf, ot[vb], 0, 0, 0); }
                }
        }
        if (tt < NT) AT_STORE(buf ^ 1);
        __syncthreads();
    }
#undef AT_LOAD
#undef AT_STORE
    l += lx(l, lane, 32);
    const float inv = 1.0f / l;
    bf16* AV = (bf16*)(ws + WS_AV) + (size_t)qrow * 512 + h * 64 + 4 * half;
#pragma unroll
    for (int vb = 0; vb < 2; ++vb)
#pragma unroll
        for (int g = 0; g < 4; ++g) { f32x4 o; o[0] = ot[vb][4 * g] * inv; o[1] = ot[vb][4 * g + 1] * inv; o[2] = ot[vb][4 * g + 2] * inv; o[3] = ot[vb][4 * g + 3] * inv; *(u32x2*)(AV + 32 * vb + 8 * g) = pack4(o); }
}
__device__ __forceinline__ void attn_item(Frame& F, unsigned char* ws, int i) { const int bh = i & 63; attn_unit(F, ws, bh >> 3, bh & 7, 7 - (i >> 6)); }
__device__ __forceinline__ void attn_phase(Frame& F, unsigned char* ws) {
    const int c = F.vcu;
    if (c >= 256) return;
    const int bh = c >> 2, p = c & 3;
    attn_unit(F, ws, bh >> 3, bh & 7, 7 - p);
    attn_unit(F, ws, bh >> 3, bh & 7, p);
}
}
namespace mk {
constexpr size_t WS_UMETA = WS_END3;
constexpr size_t WS_UT = WS_UMETA + al((size_t)RH * RDV * RDK * 4);
constexpr size_t WS_SPREV = WS_UT + al((size_t)32 * 16 * RDV * RDK * 4);
constexpr size_t WS_RIN = WS_SPREV + al((size_t)32 * 16 * RDV * RDK * 2);
constexpr size_t WS_DPART = WS_RIN + al((size_t)MP * 1024 * 2);
constexpr size_t WS_QL = WS_DPART + al((size_t)32 * 16 * 8 * 264 * 4);
constexpr size_t WS_END4 = WS_QL + al((size_t)64 * 2048 * 4);
static_assert(WS_END4 < ((size_t)1 << 31), "32-bit workspace offsets");
__device__ __forceinline__ float gpow_t(const unsigned char* ws, int h, int n) { return ((const float*)(ws + WS_TAB + TAB_GP))[h * 128 + n]; }

__device__ __forceinline__ void ret_u_unit(Frame& F, unsigned char* ws, int u) {
    ws = opaque_g(ws);
    const int tid = fresh_tid(F.wave), lane = tid & 63, w = F.wave, r32 = lane & 31, half = lane >> 5;
    const bool meta = u >= 512; const int hh = meta ? u - 512 : (u >> 4) & 3;
    const int tok0 = meta ? ROW_META : (u >> 6) * SEQ + (u & 15) * 128, nks = meta ? 1 : 8;
    const bf16* RVT = (const bf16*)(ws + WS_RVT); const bf16* RKT = (const bf16*)(ws + WS_RKT);
    f32x16 acc[4];
#pragma unroll
    for (int db = 0; db < 4; ++db)
#pragma unroll
        for (int i = 0; i < 16; ++i) acc[db][i] = 0.f;
    const bf16* ap = RVT + (size_t)(hh * 256 + 32 * w + r32) * MP + tok0 + 8 * half;
    const bf16* bp = RKT + (size_t)(hh * 128 + r32) * MP + tok0 + 8 * half;
    for (int s = 0; s < nks; ++s) {
        const bf16x8 af = *(const bf16x8*)(ap + 16 * s);
#pragma unroll
        for (int db = 0; db < 4; ++db) { const bf16x8 bf = *(const bf16x8*)(bp + (size_t)(32 * db) * MP + 16 * s); acc[db] = __builtin_amdgcn_mfma_f32_32x32x16_bf16(af, bf, acc[db], 0, 0, 0); }
    }
    const float sc = gpow_t(ws, hh, meta ? NMETA - 1 : 127);
    float* dst = meta ? (float*)(ws + WS_UMETA) + (size_t)hh * RDV * RDK : (float*)(ws + WS_UT) + (size_t)u * RDV * RDK;
#pragma unroll
    for (int db = 0; db < 4; ++db)
#pragma unroll
        for (int i = 0; i < 16; ++i) dst[(size_t)(32 * w + crow(i, half)) * RDK + 32 * db + r32] = acc[db][i] * sc;
}
__device__ __forceinline__ void ret_scan(Frame& F, const Ptrs& a) {
    const int tid = fresh_tid(F.wave);
    const int gt = (F.vcu * NWAVES * 64) + tid, NGT = F.G * NWAVES * 64;
    const float* UM = (const float*)(a.ws + WS_UMETA); const float* UT = (const float*)(a.ws + WS_UT); bf16* SP = (bf16*)(a.ws + WS_SPREV);
    for (int e = gt; e < 32 * RDV * RDK; e += NGT) {
        const int bh = e >> 15, idx = e & 32767, hh = bh & 3;
        const float g128 = gpow_t(a.ws, hh, 127) * gpow_t(a.ws, hh, 1);
        float S = UM[(size_t)hh * 32768 + idx];
        for (int c = 0; c < 16; ++c) { const size_t o = ((size_t)bh * 16 + c) * 32768 + idx; SP[o] = bf1(S); S = g128 * S + UT[o]; }
        const int ee = idx >> 7, d = idx & 127;
        a.out()[OUT_SRP + ((size_t)bh * RDK + d) * RDV + ee] = S;
    }
}
__device__ __forceinline__ void ret_o_unit(Frame& F, const Ptrs& a, int u) {
    unsigned char* ws = a.ws; ws = opaque_g(ws);
    const int tid = fresh_tid(F.wave), lane = tid & 63, w = F.wave, r32 = lane & 31, half = lane >> 5;
    const int bh = u >> 4, c = u & 15, hh = bh & 3, tok0 = (bh >> 2) * SEQ + c * 128;
    const int ib = w & 3, eh = w >> 2;
    LAS float* red = (LAS float*)(F.lds + RING_OFF);
    const bf16* RQ = (const bf16*)(ws + WS_RQ); const bf16* RK = (const bf16*)(ws + WS_RK); const bf16* RVT = (const bf16*)(ws + WS_RVT);
    const bf16* SP = (const bf16*)(ws + WS_SPREV) + (size_t)u * 32768;
    const int irow = tok0 + 32 * ib + r32;
    bf16x8 qf[8];
#pragma unroll
    for (int s = 0; s < 8; ++s) qf[s] = *(const bf16x8*)(RQ + (size_t)irow * 512 + hh * 128 + 16 * s + 8 * half);
    f32x16 ot[4];
#pragma unroll
    for (int eb = 0; eb < 4; ++eb) {
#pragma unroll
        for (int i = 0; i < 16; ++i) ot[eb][i] = 0.f;
        const bf16* sp = SP + (size_t)(128 * eh + 32 * eb + r32) * RDK + 8 * half;
#pragma unroll
        for (int s = 0; s < 8; ++s) { const bf16x8 sf = *(const bf16x8*)(sp + 16 * s); ot[eb] = __builtin_amdgcn_mfma_f32_32x32x16_bf16(sf, qf[s], ot[eb], 0, 0, 0); }
    }
    const float g = gpow_t(ws, hh, 1);
#pragma unroll
    for (int eb = 0; eb < 4; ++eb)
#pragma unroll
        for (int i = 0; i < 16; ++i) ot[eb][i] *= g;
    for (int jb = 0; jb <= ib; ++jb) {
        f32x16 at;
#pragma unroll
        for (int i = 0; i < 16; ++i) at[i] = 0.f;
        const bf16* kp = RK + (size_t)(tok0 + 32 * jb + r32) * 512 + hh * 128 + 8 * half;
#pragma unroll
        for (int s = 0; s < 8; ++s) { const bf16x8 kf = *(const bf16x8*)(kp + 16 * s); at = __builtin_amdgcn_mfma_f32_32x32x16_bf16(kf, qf[s], at, 0, 0, 0); }
        if (jb == ib) {
#pragma unroll
            for (int i = 0; i < 16; ++i) if (crow(i, half) > r32) at[i] = 0.f;
        }
#pragma unroll
        for (int s2 = 0; s2 < 2; ++s2) {
            u32x4 pw; pw.x = pg8::cvt_pk_bf16(at[8 * s2 + 0], at[8 * s2 + 1]); pw.y = pg8::cvt_pk_bf16(at[8 * s2 + 2], at[8 * s2 + 3]);
            pw.z = pg8::cvt_pk_bf16(at[8 * s2 + 4], at[8 * s2 + 5]); pw.w = pg8::cvt_pk_bf16(at[8 * s2 + 6], at[8 * s2 + 7]);
            const bf16x8 pf = __builtin_bit_cast(bf16x8, pw);
#pragma unroll
            for (int eb = 0; eb < 4; ++eb) {
                const bf16* vp = RVT + (size_t)(hh * 256 + 128 * eh + 32 * eb + r32) * MP + tok0 + 32 * jb + 16 * s2 + 4 * half;
                const u32x2 lo = *(const u32x2*)vp, hi = *(const u32x2*)(vp + 8);
                u32x4 vw; vw.x = lo.x; vw.y = lo.y; vw.z = hi.x; vw.w = hi.y;
                ot[eb] = __builtin_amdgcn_mfma_f32_32x32x16_bf16(__builtin_bit_cast(bf16x8, vw), pf, ot[eb], 0, 0, 0);
            }
        }
    }
    float s1 = 0.f;
#pragma unroll
    for (int eb = 0; eb < 4; ++eb)
#pragma unroll
        for (int i = 0; i < 16; ++i) s1 += ot[eb][i];
    s1 += lx(s1, lane, 32);
    if (half == 0) red[w * 32 + r32] = s1;
    __syncthreads();
    const float mu = (red[w * 32 + r32] + red[(w ^ 4) * 32 + r32]) * (1.f / 256.f);
    float s2 = 0.f;
#pragma unroll
    for (int eb = 0; eb < 4; ++eb)
#pragma unroll
        for (int i = 0; i < 16; ++i) { ot[eb][i] -= mu; s2 += ot[eb][i] * ot[eb][i]; }
    s2 += lx(s2, lane, 32);
    if (half == 0) red[256 + w * 32 + r32] = s2;
    __syncthreads();
    const float rstd = 1.0f / sqrtf((red[256 + w * 32 + r32] + red[256 + (w ^ 4) * 32 + r32]) * (1.f / 256.f) + EPS);
    __syncthreads();
    const bf16* SRG = (const bf16*)(ws + WS_SRG) + (size_t)irow * 1024 + hh * 256 + 128 * eh + 4 * half;
    bf16* RIN = (bf16*)(ws + WS_RIN) + (size_t)irow * 1024 + hh * 256 + 128 * eh + 4 * half;
    const float* gn = a.in(19) + hh * 256 + 128 * eh + 4 * half;
#pragma unroll
    for (int eb = 0; eb < 4; ++eb)
#pragma unroll
        for (int gq = 0; gq < 4; ++gq) {
            const int eo = 32 * eb + 8 * gq;
            const u32x2 sg = *(const u32x2*)(SRG + eo); const f32x4 gv = *(const f32x4*)(gn + eo);
            f32x4 o;
            o[0] = ot[eb][4 * gq + 0] * rstd * gv[0] * __uint_as_float(sg.x << 16); o[1] = ot[eb][4 * gq + 1] * rstd * gv[1] * __uint_as_float(sg.x & 0xffff0000u);
            o[2] = ot[eb][4 * gq + 2] * rstd * gv[2] * __uint_as_float(sg.y << 16); o[3] = ot[eb][4 * gq + 3] * rstd * gv[3] * __uint_as_float(sg.y & 0xffff0000u);
            *(u32x2*)(RIN + eo) = pack4(o);
        }
}
__device__ __forceinline__ void ret_sample_unit(Frame& F, const Ptrs& a, int u) {
    unsigned char* ws = a.ws; ws = opaque_g(ws);
    const int tid = fresh_tid(F.wave), lane = tid & 63, s = u >> 2, hh = u & 3, e = tid & 255, dh = tid >> 8, row = ROW_SMP + s;
    LAS float* sh = (LAS float*)(F.lds + RING_OFF);
    const bf16* RQ = (const bf16*)(ws + WS_RQ); const bf16* RK = (const bf16*)(ws + WS_RK); const bf16* RVT = (const bf16*)(ws + WS_RVT);
    if (tid < 128) sh[tid] = __uint_as_float((unsigned)RQ[(size_t)row * 512 + hh * 128 + tid] << 16);
    else if (tid < 256) sh[tid] = __uint_as_float((unsigned)RK[(size_t)row * 512 + hh * 128 + tid - 128] << 16);
    __syncthreads();
    const float v = __uint_as_float((unsigned)RVT[(size_t)(hh * 256 + e) * MP + row] << 16);
    const float g = gpow_t(ws, hh, 1);
    const float* S0 = a.in(4) + ((size_t)(s * RH + hh) * RDK) * RDV + e;
    float* S1 = a.out() + OUT_SRS + ((size_t)(s * RH + hh) * RDK) * RDV + e;
    float o = 0.f;
    {   float s0[64];
#pragma unroll
        for (int k = 0; k < 64; ++k) s0[k] = S0[(size_t)(64 * dh + k) * RDV];
#pragma unroll
        for (int k = 0; k < 64; ++k) { const int d = 64 * dh + k; const float sn = g * s0[k] + sh[128 + d] * v; S1[(size_t)d * RDV] = sn; o += sh[d] * sn; } }
    sh[256 + dh * 256 + e] = o;
    __syncthreads();
    o = sh[256 + e] + sh[512 + e];
    float t1 = o;
#pragma unroll
    for (int off = 32; off > 0; off >>= 1) t1 += lx(t1, lane, off);
    if ((tid & 63) == 0) sh[768 + (tid >> 6)] = t1;
    __syncthreads();
    const float mu = (sh[768] + sh[769] + sh[770] + sh[771]) * (1.f / 256.f);
    const float dlt = o - mu;
    float t2 = dlt * dlt;
#pragma unroll
    for (int off = 32; off > 0; off >>= 1) t2 += lx(t2, lane, off);
    if ((tid & 63) == 0) sh[776 + (tid >> 6)] = t2;
    __syncthreads();
    const float rstd = 1.0f / sqrtf((sh[776] + sh[777] + sh[778] + sh[779]) * (1.f / 256.f) + EPS);
    if (dh == 0) { const float sg = __uint_as_float((unsigned)((const bf16*)(ws + WS_SRG))[(size_t)row * 1024 + hh * 256 + e] << 16);
        ((bf16*)(ws + WS_RIN))[(size_t)row * 1024 + hh * 256 + e] = bf1(dlt * rstd * a.in(19)[hh * 256 + e] * sg); }
    __syncthreads();
}
}
namespace mk {
template <int CTRL> __device__ __forceinline__ float dppf(float v) { return __int_as_float(__builtin_amdgcn_update_dpp(0, __float_as_int(v), CTRL, 0xF, 0xF, false)); }
__device__ __forceinline__ float swap32_add(float a, float b) { const auto r = __builtin_amdgcn_permlane32_swap(__float_as_uint(a), __float_as_uint(b), false, false); return __uint_as_float(r[0]) + __uint_as_float(r[1]); }
__device__ __forceinline__ float swap16_add(float a, float b) { const auto r = __builtin_amdgcn_permlane16_swap(__float_as_uint(a), __float_as_uint(b), false, false); return __uint_as_float(r[0]) + __uint_as_float(r[1]); }
__device__ __forceinline__ int dlane_of(int h) { return ((h >> 2) & 1) * 32 + ((h >> 1) & 1) * 16 + (h & 1) * 8; }
__device__ __forceinline__ void decode_unit(Frame& F, const Ptrs& a, int u) {
    unsigned char* ws = a.ws; ws = opaque_g(ws);
    const int tid = fresh_tid(F.wave), lane = tid & 63, w = F.wave, s = u >> 4, sp = u & 15, row = ROW_SMP + s;
    LAS float* sh = (LAS float*)(F.lds + RING_OFF);
    const bf16* QA = (const bf16*)(ws + WS_QA) + (size_t)row * 768;
    f32x4 ql[8]; float qr[8];
    { const float* QLr = (const float*)(ws + WS_QL) + (size_t)(row - MMAIN) * 2048;
#pragma unroll
      for (int h = 0; h < 8; ++h) { ql[h] = *(const f32x4*)(QLr + h * 256 + 4 * lane); qr[h] = lane < 32 ? __uint_as_float((unsigned)QA[h * 96 + 64 + lane] << 16) : 0.f; } }
    f32x4 O[8];
#pragma unroll
    for (int h = 0; h < 8; ++h) O[h] = (f32x4){0.f, 0.f, 0.f, 0.f};
    float m = -INFINITY, l = 0.f;
    const int page = ((const int*)a.in(5))[s * NPAGES + sp * 8 + w];
    const float* ck0 = a.in(2) + (size_t)page * PAGE * KVR + 4 * lane;
    const float* kr0 = a.in(3) + (size_t)page * PAGE * 32 + (lane & 31);
#define DC_LOAD(kv_, rv_, bi_) do { const float* c_ = ck0; const float* r_ = kr0; const int k0_ = (bi_) * 4; \
        _Pragma("unroll") for (int kk = 0; kk < 4; ++kk) { kv_[kk] = *(const f32x4*)(c_ + (size_t)(k0_ + kk) * KVR); rv_[kk] = r_[(size_t)(k0_ + kk) * 32]; } } while (0)
#define DC_COMPUTE(kv_, rv_) do { float sc[4]; \
        _Pragma("unroll") for (int kk = 0; kk < 4; ++kk) { float p[8]; \
            _Pragma("unroll") for (int h = 0; h < 8; ++h) p[h] = fmaf(ql[h][0], kv_[kk][0], fmaf(ql[h][1], kv_[kk][1], fmaf(ql[h][2], kv_[kk][2], fmaf(ql[h][3], kv_[kk][3], qr[h] * rv_[kk])))); \
              \
            const float a0 = swap32_add(p[0], p[4]), a1 = swap32_add(p[1], p[5]), a2 = swap32_add(p[2], p[6]), a3 = swap32_add(p[3], p[7]); \
            const float b0 = swap16_add(a0, a2), b1 = swap16_add(a1, a3); \
            const float c0 = b0 + dppf<0x128>(b0), c1 = b1 + dppf<0x128>(b1); \
            float v1 = (lane & 8) ? c1 : c0; \
            v1 += dppf<0xB1>(v1); v1 += dppf<0x4E>(v1); v1 += dppf<0x141>(v1); sc[kk] = v1; } \
        const float mx = fmaxf(fmaxf(sc[0], sc[1]), fmaxf(sc[2], sc[3])); \
        const float mn = fmaxf(m, mx), alpha = __builtin_amdgcn_exp2f(m - mn); m = mn; \
        float pe[4]; \
        _Pragma("unroll") for (int kk = 0; kk < 4; ++kk) pe[kk] = __builtin_amdgcn_exp2f(sc[kk] - mn); \
        l = l * alpha + ((pe[0] + pe[1]) + (pe[2] + pe[3])); \
        _Pragma("unroll") for (int h = 0; h < 8; ++h) { const int src = dlane_of(h); \
            const float ah = __int_as_float(__builtin_amdgcn_readlane(__float_as_int(alpha), src)), p0 = __int_as_float(__builtin_amdgcn_readlane(__float_as_int(pe[0]), src)), p1 = __int_as_float(__builtin_amdgcn_readlane(__float_as_int(pe[1]), src)), \
                        p2 = __int_as_float(__builtin_amdgcn_readlane(__float_as_int(pe[2]), src)), p3 = __int_as_float(__builtin_amdgcn_readlane(__float_as_int(pe[3]), src)); \
            O[h] = O[h] * ah + kv_[0] * p0 + kv_[1] * p1 + kv_[2] * p2 + kv_[3] * p3; } } while (0)
    f32x4 kvA[4], kvB[4], kvC[4]; float rvA[4], rvB[4], rvC[4];
#define DC_PIN() __builtin_amdgcn_sched_barrier(0)
    DC_LOAD(kvA, rvA, 0); DC_LOAD(kvB, rvB, 1); DC_PIN();
#pragma unroll 1
    for (int bi = 0; bi < 30; bi += 3) {
        DC_LOAD(kvC, rvC, bi + 2); DC_PIN();
        DC_COMPUTE(kvA, rvA); DC_PIN();
        DC_LOAD(kvA, rvA, bi + 3); DC_PIN();
        DC_COMPUTE(kvB, rvB); DC_PIN();
        DC_LOAD(kvB, rvB, bi + 4); DC_PIN();
        DC_COMPUTE(kvC, rvC); DC_PIN();
    }
    DC_COMPUTE(kvA, rvA);
    DC_COMPUTE(kvB, rvB);
#undef DC_PIN
#undef DC_LOAD
#undef DC_COMPUTE
    LAS float* wm = sh + 2304 + w * 16;
    LAS float* wo = sh + 2304 + 128 + w * 2048;
    { const int hd = 4 * (lane >> 5) + 2 * ((lane >> 4) & 1) + ((lane >> 3) & 1); if ((lane & 7) == 0) { wm[hd] = m; wm[8 + hd] = l; } }
#pragma unroll
    for (int h = 0; h < 8; ++h) *(LAS f32x4*)(wo + h * 256 + 4 * lane) = O[h];
    __syncthreads();
    float* part = (float*)(ws + WS_DPART) + (size_t)u * 8 * 264;
    for (int e = tid; e < 2048; e += 512) {
        const int h = e >> 8;
        float M = -INFINITY;
#pragma unroll
        for (int ww = 0; ww < 8; ++ww) M = fmaxf(M, sh[2304 + ww * 16 + h]);
        float acc = 0.f, L = 0.f;
#pragma unroll
        for (int ww = 0; ww < 8; ++ww) { const float f = __builtin_amdgcn_exp2f(sh[2304 + ww * 16 + h] - M); acc += f * sh[2304 + 128 + ww * 2048 + e]; L += f * sh[2304 + ww * 16 + 8 + h]; }
        __hip_atomic_store(part + h * 264 + (e & 255), acc, __ATOMIC_RELAXED, __HIP_MEMORY_SCOPE_AGENT);
        if ((e & 255) == 0) { __hip_atomic_store(part + h * 264 + 256, M, __ATOMIC_RELAXED, __HIP_MEMORY_SCOPE_AGENT); __hip_atomic_store(part + h * 264 + 257, L, __ATOMIC_RELAXED, __HIP_MEMORY_SCOPE_AGENT); }
    }
    asm volatile("s_waitcnt vmcnt(0)" ::: "memory");
    __syncthreads();
    if (tid == 0) (void)__hip_atomic_fetch_add((unsigned*)(ws + WS_CTL) + CW_DCNT + 16 * s, 1u, __ATOMIC_RELAXED, __HIP_MEMORY_SCOPE_AGENT);
}
__device__ __forceinline__ void decode_combine_unit(Frame& F, const Ptrs& a, int u) {
    unsigned char* ws = opaque_g(a.ws);
    const int tid = fresh_tid(F.wave), lane = tid & 63, s = u >> 3, h = u & 7, row = ROW_SMP + s;
    LAS float* sh = (LAS float*)(F.lds + RING_OFF);
    const bf16* QA = (const bf16*)(ws + WS_QA) + (size_t)row * 768;
    const float* part = (const float*)(ws + WS_DPART) + (size_t)s * 16 * 8 * 264;
    if (tid == 0) { const unsigned* cn = (const unsigned*)(ws + WS_CTL) + CW_DCNT + 16 * s; unsigned spins = 0;
        while (__hip_atomic_load(cn, __ATOMIC_RELAXED, __HIP_MEMORY_SCOPE_AGENT) < 16u && ++spins < (1u << 22)) __builtin_amdgcn_s_sleep(8);
        __builtin_amdgcn_fence(__ATOMIC_ACQUIRE, "agent"); asm volatile("s_waitcnt vmcnt(0)" ::: "memory"); }
    __syncthreads();
    if (tid < 64) { const bf16* KNr = (const bf16*)(ws + WS_KN) + (size_t)row * 512;
        float acc = __uint_as_float((unsigned)QA[h * 96 + lane] << 16) * __uint_as_float((unsigned)KNr[h * 64 + lane] << 16);
        if (lane < 32) acc += __uint_as_float((unsigned)QA[h * 96 + 64 + lane] << 16) * ((const float*)(ws + WS_KRF))[(size_t)row * 32 + lane];
#pragma unroll
        for (int off = 32; off > 0; off >>= 1) acc += lx(acc, lane, off);
        if (lane == 0) sh[256] = acc; }
    __syncthreads();
    if (tid < 256) {
        const int r = tid;
        const float sn = sh[256];
        float pm[16];
#pragma unroll
        for (int p = 0; p < 16; ++p) pm[p] = part[(p * 8 + h) * 264 + 256];
        float M = sn;
#pragma unroll
        for (int p = 0; p < 16; ++p) M = fmaxf(M, pm[p]);
        const float rkv = row_rscale4((const float*)(ws + WS_SSQKV), row, 1.f / KVR);
        const float cn = ((const float*)(ws + WS_CKVF))[(size_t)row * KVR + r] * rkv * a.in(14)[r];
        const float fn = __builtin_amdgcn_exp2f(sn - M);
        float acc = fn * cn, Lq = fn;
#pragma unroll
        for (int p = 0; p < 16; ++p) { const float f = __builtin_amdgcn_exp2f(pm[p] - M); acc += f * part[(p * 8 + h) * 264 + r]; Lq += f * part[(p * 8 + h) * 264 + 257]; }
        sh[r] = acc / Lq;
    }
    __syncthreads();
    { const int v = tid & 63, rg = tid >> 6; const float* wuv = a.in(17) + (size_t)(32 * rg) * 512 + h * 64 + v;
      float wv[32];
#pragma unroll
      for (int k = 0; k < 32; ++k) wv[k] = wuv[(size_t)k * 512];
      float acc = 0.f;
#pragma unroll
      for (int k = 0; k < 32; ++k) acc += sh[32 * rg + k] * wv[k];
      sh[264 + rg * 64 + v] = acc; }
    __syncthreads();
    if (tid < 64) { float acc = 0.f;
#pragma unroll
        for (int rg = 0; rg < 8; ++rg) acc += sh[264 + rg * 64 + tid];
        ((bf16*)(ws + WS_AV))[(size_t)row * 512 + h * 64 + tid] = bf1(acc); }
    __syncthreads();
}
}
namespace mk {
constexpr size_t WS_TMP = WS_ACT;
constexpr size_t WS_MX = WS_RQ;
constexpr size_t WS_H2B = WS_MX + al((size_t)MP * 1024 * 2);
constexpr size_t WS_H2 = WS_UT;
constexpr size_t WS_SSQH2 = WS_SSQ2_, WS_SSQH3 = WS_SSQ3_;
constexpr size_t WS_H3 = WS_H;
constexpr size_t WS_END6 = WS_END4;
static_assert(WS_H2B + (size_t)MP * 1024 * 2 <= WS_SRG && WS_H2 + (size_t)MP * 1024 * 4 <= WS_RIN && (size_t)MP * 1024 * 4 <= (size_t)MP * FFN * 2, "overlays");
static_assert(WS_END6 < ((size_t)1 << 31), "32-bit workspace offsets");

template <int STEP, unsigned GATE_OFF> struct EpiGate {
    static constexpr bool PERM = false, AFTER_DRAIN = false;
    unsigned char* ws_;
    __device__ __forceinline__ void operator()(const f32x4 (&acc)[2][2][4][2], const Unit& u, int wr, int wc, int fr, int fq) const {
        int l_ = lane_fresh(); asm volatile("" : "+v"(l_)); fr = l_ & 15; fq = l_ >> 4;
        unsigned char* w = opaque_g(ws_);
        const unsigned row0 = u.pm * BM + wr * 64 + fr, col0 = u.pn * BM + wc * 32 + 4 * fq;
#pragma unroll
        for (int ai = 0; ai < 2; ++ai)
#pragma unroll
            for (int m = 0; m < 4; ++m) { unsigned row = row0 + ai * HALF + m * 16; asm volatile("" : "+v"(row));
#pragma unroll
                for (int bj = 0; bj < 2; ++bj)
#pragma unroll
                    for (int n = 0; n < 2; ++n) { const unsigned e = row * 1024 + col0 + bj * HALF + n * 16;
                        const u32x2 gw = *at<const u32x2>(w, GATE_OFF + e * 2);
                        f32x4 g; g[0] = __uint_as_float(gw.x << 16); g[1] = __uint_as_float(gw.x & 0xffff0000u); g[2] = __uint_as_float(gw.y << 16); g[3] = __uint_as_float(gw.y & 0xffff0000u);
                        f32x4 o = acc[ai][bj][m][n] * g;
                        if (STEP == 0) *at<f32x4>(w, (unsigned)WS_TMP + e * 4) = o;
                        else { o = o + *at<const f32x4>(w, (unsigned)WS_TMP + e * 4); *at<u32x2>(w, (unsigned)WS_MX + e * 2) = pack4(o); } }
                asm volatile("" ::: "memory"); }
    }
};
struct EpiSwiGLU2 {
    static constexpr bool PERM = true, AFTER_DRAIN = false;
    unsigned char* ws_;
    __device__ __forceinline__ void operator()(const f32x4 (&acc)[2][2][4][2], const Unit& u, int wr, int wc, int fr, int fq) const {
        int l_ = lane_fresh(); asm volatile("" : "+v"(l_)); fr = l_ & 15; fq = l_ >> 4;
        unsigned char* w = opaque_g(ws_);
        const unsigned row0 = u.pm * BM + wr * 64 + fr, col0 = u.pn * HALF + wc * 32 + 8 * fq;
        float rsc[8];
#pragma unroll
        for (int k = 0; k < 8; ++k) rsc[k] = row_rscale16(at<const float>(w, (unsigned)WS_SSQH2), (int)(row0 + (k >> 2) * HALF + (k & 3) * 16), 1.f / D);
#pragma unroll
        for (int ai = 0; ai < 2; ++ai)
#pragma unroll
            for (int m = 0; m < 4; ++m) { unsigned row = row0 + ai * HALF + m * 16; asm volatile("" : "+v"(row));
                const float r = rsc[ai * 4 + m];
                f32x4 o[2];
#pragma unroll
                for (int n = 0; n < 2; ++n)
#pragma unroll
                    for (int j = 0; j < 4; ++j) { const float g = acc[ai][0][m][n][j] * r, up = acc[ai][1][m][n][j] * r; o[n][j] = fast_silu(g) * up; }
                u32x4 pk; pk.x = pg8::cvt_pk_bf16(o[0][0], o[0][1]); pk.y = pg8::cvt_pk_bf16(o[0][2], o[0][3]); pk.z = pg8::cvt_pk_bf16(o[1][0], o[1][1]); pk.w = pg8::cvt_pk_bf16(o[1][2], o[1][3]);
                *at<u32x4>(w, (unsigned)WS_ACT + (row * FFN + col0) * 2) = pk;
                asm volatile("" ::: "memory"); }
    }
};
__device__ __forceinline__ void final_norm_phase(Frame& F, const Ptrs& a) {
    const int lane = fresh_tid(F.wave) & 63;
    const int gw = F.vcu * NWAVES + F.wave, NGW = F.G * NWAVES;
    const float* H3 = (const float*)(a.ws + WS_H3); const float* SSQ = (const float*)(a.ws + WS_SSQH3);
    f32x4 g[4];
#pragma unroll
    for (int j = 0; j < 4; ++j) g[j] = *((const f32x4*)a.in(26) + lane + 64 * j);
    for (int row0 = gw; row0 < ROW_PAD; row0 += 2 * NGW) {
        f32x4 v[2][4]; float r[2];
#pragma unroll
        for (int t = 0; t < 2; ++t) { const int row = row0 + t * NGW; const bool ok = row < ROW_PAD && !(row >= MMAIN && row < ROW_SMP);
            r[t] = ok ? row_rscale16(SSQ, row, 1.f / D) : 0.f;
#pragma unroll
            for (int j = 0; j < 4; ++j) v[t][j] = ok ? *((const f32x4*)(H3 + (size_t)row * D) + lane + 64 * j) : (f32x4){0.f, 0.f, 0.f, 0.f}; }
#pragma unroll
        for (int t = 0; t < 2; ++t) { const int row = row0 + t * NGW; if (row >= ROW_PAD || (row >= MMAIN && row < ROW_SMP)) continue;
            float* dst = row < MMAIN ? a.out() + OUT_YP + (size_t)row * D : a.out() + OUT_YS + (size_t)(row - ROW_SMP) * D;
#pragma unroll
            for (int j = 0; j < 4; ++j) *((f32x4*)dst + lane + 64 * j) = v[t][j] * r[t] * g[j]; }
    }
}
}
namespace mk {
typedef float f32x4_t __attribute__((ext_vector_type(4)));
constexpr int XROW0 = MMAIN, SK_C = 64 * 64;
__device__ __forceinline__ void skinny64(int wave, int tid, const bf16* A, int K, const bf16* Bt, int brow0, LAS float* P, float (&out)[8]) {
    const int lane = tid & 63, r16 = lane & 15, kq = lane >> 4;
    const bf16* ap = A + (size_t)(XROW0 + r16) * K + 8 * kq;
    const bf16* bp = Bt + (size_t)(brow0 + r16) * K + 8 * kq;
    f32x4 acc[4][4];
#pragma unroll
    for (int mf = 0; mf < 4; ++mf)
#pragma unroll
        for (int nf = 0; nf < 4; ++nf) acc[mf][nf] = (f32x4){0.f, 0.f, 0.f, 0.f};
    const int KS = K / 32;
    bf16x8 a0[4], b0[4], a1[4], b1[4], a2[4], b2[4];
#define SK_LOAD(a_, b_, kk_) do { _Pragma("unroll") for (int f = 0; f < 4; ++f) { a_[f] = *(const bf16x8*)(ap + (size_t)(16 * f) * K + 32 * (kk_)); b_[f] = *(const bf16x8*)(bp + (size_t)(16 * f) * K + 32 * (kk_)); } } while (0)
#define SK_MMA(a_, b_) do { _Pragma("unroll") for (int mf = 0; mf < 4; ++mf) _Pragma("unroll") for (int nf = 0; nf < 4; ++nf) acc[mf][nf] = __builtin_amdgcn_mfma_f32_16x16x32_bf16(a_[mf], b_[nf], acc[mf][nf], 0, 0, 0); } while (0)
    int kk = wave;
    if (kk < KS) SK_LOAD(a0, b0, kk);
    if (kk + 8 < KS) SK_LOAD(a1, b1, kk + 8);
    if (kk + 16 < KS) SK_LOAD(a2, b2, kk + 16);
    for (; kk < KS; kk += 24) {
        SK_MMA(a0, b0); if (kk + 24 < KS) SK_LOAD(a0, b0, kk + 24);
        if (kk + 8 < KS) { SK_MMA(a1, b1); if (kk + 32 < KS) SK_LOAD(a1, b1, kk + 32); }
        if (kk + 16 < KS) { SK_MMA(a2, b2); if (kk + 40 < KS) SK_LOAD(a2, b2, kk + 40); }
    }
#undef SK_LOAD
#undef SK_MMA
    LAS float* Pw = P + wave * SK_C;
#pragma unroll
    for (int mf = 0; mf < 4; ++mf)
#pragma unroll
        for (int nf = 0; nf < 4; ++nf)
#pragma unroll
            for (int i = 0; i < 4; ++i) Pw[(16 * mf + 4 * kq + i) * 64 + 16 * nf + r16] = acc[mf][nf][i];
    __syncthreads();
    const LAS float* pr = P + (tid >> 3) * 64 + 8 * (tid & 7);
    f32x4 s0 = *(const LAS f32x4*)pr, s1 = *(const LAS f32x4*)(pr + 4);
#pragma unroll
    for (int w = 1; w < 8; ++w) { s0 = s0 + *(const LAS f32x4*)(pr + w * SK_C); s1 = s1 + *(const LAS f32x4*)(pr + w * SK_C + 4); }
    out[0] = s0[0]; out[1] = s0[1]; out[2] = s0[2]; out[3] = s0[3]; out[4] = s1[0]; out[5] = s1[1]; out[6] = s1[2]; out[7] = s1[3];
    __syncthreads();
}
__device__ __forceinline__ float sum8(float v, int lane) { v += lx(v, lane, 1); v += lx(v, lane, 2); v += lx(v, lane, 4); return v; }
__device__ __forceinline__ void st8_bf16(bf16* p, const float* v) { u32x4 w; w.x = pg8::cvt_pk_bf16(v[0], v[1]); w.y = pg8::cvt_pk_bf16(v[2], v[3]); w.z = pg8::cvt_pk_bf16(v[4], v[5]); w.w = pg8::cvt_pk_bf16(v[6], v[7]); *(u32x4*)p = w; }
__device__ __forceinline__ void ld8(const LAS float* p, float* v) { const f32x4 a = *(const LAS f32x4*)p, b = *(const LAS f32x4*)(p + 4); v[0] = a[0]; v[1] = a[1]; v[2] = a[2]; v[3] = a[3]; v[4] = b[0]; v[5] = b[1]; v[6] = b[2]; v[7] = b[3]; }
__device__ __forceinline__ void xjob_signal(unsigned char* ws, int tid, int cnt_idx) {
    asm volatile("s_waitcnt vmcnt(0)" ::: "memory"); __syncthreads();
    if (tid == 0) { __builtin_amdgcn_fence(__ATOMIC_RELEASE, "agent"); asm volatile("s_waitcnt vmcnt(0)" ::: "memory");
                    (void)__hip_atomic_fetch_add((unsigned*)(ws + WS_CTL) + CW_XCNT + cnt_idx, 1u, __ATOMIC_RELAXED, __HIP_MEMORY_SCOPE_AGENT); }
}
__device__ __forceinline__ void xjob_wait(unsigned char* ws, int tid, int cnt_idx, unsigned need) {
    if (tid == 0) { const unsigned* cn = (const unsigned*)(ws + WS_CTL) + CW_XCNT + cnt_idx; unsigned spins = 0;
        while (__hip_atomic_load(cn, __ATOMIC_RELAXED, __HIP_MEMORY_SCOPE_AGENT) < need && ++spins < (1u << 22)) __builtin_amdgcn_s_sleep(8);
        __builtin_amdgcn_fence(__ATOMIC_ACQUIRE, "agent"); asm volatile("s_waitcnt vmcnt(0)" ::: "memory"); }
    __syncthreads();
}

__device__ __forceinline__ void xjob_ffn_up(Frame& F, unsigned char* ws, int j, size_t a_off, size_t w_off, int rs_mode, int cnt_idx) {
    ws = opaque_g(ws);
    const int tid = fresh_tid(F.wave);
    LAS float* P = (LAS float*)(F.lds + RING_OFF);
    const int brow0 = 256 * (j >> 1) + 64 * (j & 1);
    float g[8], u[8], o[8];
    skinny64(F.wave, tid, (const bf16*)(ws + a_off), D, (const bf16*)(ws + w_off), brow0, P, g);
    skinny64(F.wave, tid, (const bf16*)(ws + a_off), D, (const bf16*)(ws + w_off), brow0 + 128, P, u);
    const int r = tid >> 3, cg = tid & 7, row = XROW0 + r;
    const float rs = rs_mode == 0 ? ((const float*)(ws + WS_R1))[row] : row_rscale16((const float*)(ws + WS_SSQH2), row, 1.f / D);
#pragma unroll
    for (int k = 0; k < 8; ++k) o[k] = fast_silu(g[k] * rs) * (u[k] * rs);
    st8_bf16((bf16*)(ws + WS_ACT) + (size_t)row * FFN + 64 * j + 8 * cg, o);
    xjob_signal(ws, tid, cnt_idx);
}
__device__ __forceinline__ void xjob_resid(Frame& F, unsigned char* ws, int j, size_t a_off, int K, size_t w_off, const float* res  , float scale, size_t out_off, size_t outb_off, size_t ssq_off) {
    ws = opaque_g(ws);
    const int tid = fresh_tid(F.wave), lane = tid & 63;
    LAS float* P = (LAS float*)(F.lds + RING_OFF);
    float v[8], o[8];
    skinny64(F.wave, tid, (const bf16*)(ws + a_off), K, (const bf16*)(ws + w_off), 64 * j, P, v);
    const int r = tid >> 3, cg = tid & 7, row = XROW0 + r, col = 64 * j + 8 * cg;
    const f32x4 b0 = *(const f32x4*)(res + (size_t)r * D + col), b1 = *(const f32x4*)(res + (size_t)r * D + col + 4);
    float ss = 0.f;
#pragma unroll
    for (int k = 0; k < 8; ++k) { o[k] = (k < 4 ? b0[k] : b1[k - 4]) + scale * v[k]; ss += o[k] * o[k]; }
    float* op = (float*)(ws + out_off) + (size_t)row * D + col;
    *(f32x4*)op = (f32x4){o[0], o[1], o[2], o[3]}; *(f32x4*)(op + 4) = (f32x4){o[4], o[5], o[6], o[7]};
    if (outb_off) st8_bf16((bf16*)(ws + outb_off) + (size_t)row * D + col, o);
    ss = sum8(ss, lane);
    if (cg == 0) atomicAdd((float*)(ws + ssq_off) + row, ss);
}
__device__ __forceinline__ void xjob_win(Frame& F, unsigned char* ws, int j) {
    ws = opaque_g(ws);
    const int tid = fresh_tid(F.wave), lane = tid & 63;
    LAS float* P = (LAS float*)(F.lds + RING_OFF);
    const int pn = j >> 1, q = j & 1;
    float v0[8], v1[8];
    skinny64(F.wave, tid, (const bf16*)(ws + WS_HB), D, (const bf16*)(ws + WS_WIN), 256 * pn + 64 * q, P, v0);
    skinny64(F.wave, tid, (const bf16*)(ws + WS_HB), D, (const bf16*)(ws + WS_WIN), 256 * pn + 64 * q + 128, P, v1);
    const int r = tid >> 3, cg = tid & 7, row = XROW0 + r;
    const float rs = row_rscale16((const float*)(ws + WS_SSQH), row, 1.f / D);
    const float* TAB = (const float*)(ws + WS_TAB);
#pragma unroll
    for (int k = 0; k < 8; ++k) { v0[k] *= rs; v1[k] *= rs; }
    const int tc0 = 64 * q + 8 * cg;
    if (pn == 0) {
        bf16* CQ = (bf16*)(ws + WS_CQ) + (size_t)row * QR; float* SSQCQ = (float*)(ws + WS_SSQCQ) + (size_t)row * 8;
        st8_bf16(CQ + tc0, v0); st8_bf16(CQ + tc0 + 128, v1);
        float s0 = 0.f, s1 = 0.f;
#pragma unroll
        for (int k = 0; k < 8; ++k) { s0 += v0[k] * v0[k]; s1 += v1[k] * v1[k]; }
        s0 = sum8(s0, lane); s1 = sum8(s1, lane);
        if (cg == 0) { SSQCQ[2 * q] = s0; SSQCQ[2 * q + 1] = s1; }
    } else if (pn == 1) {
        bf16* CQ = (bf16*)(ws + WS_CQ) + (size_t)row * QR; float* SSQCQ = (float*)(ws + WS_SSQCQ) + (size_t)row * 8;
        st8_bf16(CQ + 256 + tc0, v0);
        float s0 = 0.f;
#pragma unroll
        for (int k = 0; k < 8; ++k) s0 += v0[k] * v0[k];
        s0 = sum8(s0, lane);
        if (cg == 0) { SSQCQ[4 + q] = s0; SSQCQ[6 + q] = 0.f; }
        float x2[8];
#pragma unroll
        for (int k = 0; k < 8; ++k) x2[k] = lx(v1[k], lane, 2);
        if (q == 0 && cg < 2) {
            const int pi = row_pidx(row), i0 = 8 * cg;
            float y1[8], y2[8];
#pragma unroll
            for (int k = 0; k < 8; ++k) { const float c = TAB[TAB_C16 / 4 + pi * 16 + i0 + k], s = TAB[TAB_S16 / 4 + pi * 16 + i0 + k]; y1[k] = v1[k] * c - x2[k] * s; y2[k] = v1[k] * s + x2[k] * c; }
            st8_bf16((bf16*)(ws + WS_KRB) + (size_t)row * 32 + i0, y1); st8_bf16((bf16*)(ws + WS_KRB) + (size_t)row * 32 + 16 + i0, y2);
            float* kf = (float*)(ws + WS_KRF) + (size_t)row * 32;
#pragma unroll
            for (int k = 0; k < 8; ++k) { kf[i0 + k] = y1[k]; kf[16 + i0 + k] = y2[k]; }
        }
    } else if (pn == 2) {
        float* CKVF = (float*)(ws + WS_CKVF) + (size_t)row * KVR; bf16* CKVB = (bf16*)(ws + WS_CKVB) + (size_t)row * KVR; float* SSQKV = (float*)(ws + WS_SSQKV) + (size_t)row * 4;
        float s0 = 0.f, s1 = 0.f;
#pragma unroll
        for (int k = 0; k < 8; ++k) { CKVF[tc0 + k] = v0[k]; CKVF[tc0 + 128 + k] = v1[k]; s0 += v0[k] * v0[k]; s1 += v1[k] * v1[k]; }
        st8_bf16(CKVB + tc0, v0); st8_bf16(CKVB + tc0 + 128, v1);
        s0 = sum8(s0, lane); s1 = sum8(s1, lane);
        if (cg == 0) { SSQKV[2 * q] = s0; SSQKV[2 * q + 1] = s1; }
    } else if (pn < 7) {
        const bool isk = pn >= 5; const int hh = 2 * ((pn - 3) & 1) + q, i0 = 8 * cg;
        const int pi = row_pidx(row), jt = row_jtok(row);
        const float mult = isk ? RK_SCALE * TAB[TAB_GN / 4 + hh * 128 + jt] : TAB[TAB_GP / 4 + hh * 128 + jt];
        float y1[8], y2[8];
#pragma unroll
        for (int k = 0; k < 8; ++k) { const float c = TAB[TAB_C64 / 4 + pi * 64 + i0 + k], s = TAB[TAB_S64 / 4 + pi * 64 + i0 + k]; y1[k] = (v0[k] * c - v1[k] * s) * mult; y2[k] = (v0[k] * s + v1[k] * c) * mult; }
        bf16* dst = (bf16*)(ws + (isk ? WS_RK : WS_RQ)) + (size_t)row * 512 + hh * 128;
        st8_bf16(dst + i0, y1); st8_bf16(dst + 64 + i0, y2);
        if (isk) { bf16* RKT = (bf16*)(ws + WS_RKT);
#pragma unroll
            for (int k = 0; k < 8; ++k) { RKT[(size_t)(hh * 128 + i0 + k) * MP + row] = bf1(y1[k]); RKT[(size_t)(hh * 128 + 64 + i0 + k) * MP + row] = bf1(y2[k]); } }
    } else if (pn < 11) {
        bf16* RVT = (bf16*)(ws + WS_RVT);
#pragma unroll
        for (int k = 0; k < 8; ++k) { RVT[(size_t)((pn - 7) * 256 + tc0 + k) * MP + row] = bf1(v0[k]); RVT[(size_t)((pn - 7) * 256 + tc0 + 128 + k) * MP + row] = bf1(v1[k]); }
    } else {
        const int t = (pn - 11) >> 2; bf16* dst = (bf16*)(ws + WS_SRG + (size_t)t * (WS_SGA - WS_SRG)) + (size_t)row * 1024 + ((pn - 11) & 3) * 256;
        float o0[8], o1[8];
#pragma unroll
        for (int k = 0; k < 8; ++k) { const float g0 = fast_sigmoid(v0[k]), g1 = fast_sigmoid(v1[k]); o0[k] = t == 0 ? v0[k] * g0 : g0; o1[k] = t == 0 ? v1[k] * g1 : g1; }
        st8_bf16(dst + tc0, o0); st8_bf16(dst + tc0 + 128, o1);
    }
}
__device__ __forceinline__ void xjob_q(Frame& F, unsigned char* ws, int j) {
    ws = opaque_g(ws);
    const int tid = fresh_tid(F.wave), lane = tid & 63;
    LAS float* P = (LAS float*)(F.lds + RING_OFF);
    float v[8], p[8], o[8];
    skinny64(F.wave, tid, (const bf16*)(ws + WS_CQ), QR, (const bf16*)(ws + WS_WUQ), 64 * j, P, v);
    const int r = tid >> 3, cg = tid & 7, row = XROW0 + r;
    const float rs = row_rscale8((const float*)(ws + WS_SSQCQ), row, 1.f / QR) * SC_Q;
    const float* TAB = (const float*)(ws + WS_TAB);
    const int pi = row_pidx(row), col = 64 * j + 8 * cg, grp = col >> 5, w32 = col & 31;
#pragma unroll
    for (int k = 0; k < 8; ++k) p[k] = lx(v[k], lane, 2);
    if (grp % 3 == 2) {
        const int i0 = w32 & 15;
#pragma unroll
        for (int k = 0; k < 8; ++k) { const float c = TAB[TAB_C16 / 4 + pi * 16 + i0 + k], sn = TAB[TAB_S16 / 4 + pi * 16 + i0 + k];
            o[k] = (w32 < 16 ? v[k] * c - p[k] * sn : p[k] * sn + v[k] * c) * rs; }
    } else {
#pragma unroll
        for (int k = 0; k < 8; ++k) o[k] = v[k] * rs;
    }
    st8_bf16((bf16*)(ws + WS_QA) + (size_t)row * 768 + col, o);
}
__device__ __forceinline__ void xjob_kv(Frame& F, unsigned char* ws, int j, bool is_v) {
    ws = opaque_g(ws);
    const int tid = fresh_tid(F.wave);
    LAS float* P = (LAS float*)(F.lds + RING_OFF);
    float v[8];
    skinny64(F.wave, tid, (const bf16*)(ws + WS_CKVB), KVR, (const bf16*)(ws + (is_v ? WS_WUV : WS_WUK)), 64 * j, P, v);
    const int r = tid >> 3, cg = tid & 7, row = XROW0 + r, col = 64 * j + 8 * cg;
    const float rs = row_rscale4((const float*)(ws + WS_SSQKV), row, 1.f / KVR);
#pragma unroll
    for (int k = 0; k < 8; ++k) v[k] *= rs;
    if (!is_v) st8_bf16((bf16*)(ws + WS_KN) + (size_t)row * 512 + col, v);
    else { bf16* VT = (bf16*)(ws + WS_VT);
#pragma unroll
        for (int k = 0; k < 8; ++k) VT[(size_t)(col + k) * MP + row] = bf1(v[k]); }
}
__device__ __forceinline__ void xjob_mix(Frame& F, unsigned char* ws, int j) {
    ws = opaque_g(ws);
    const int tid = fresh_tid(F.wave);
    LAS float* P = (LAS float*)(F.lds + RING_OFF);
    float a[8], b[8], o[8];
    skinny64(F.wave, tid, (const bf16*)(ws + WS_AV), 512, (const bf16*)(ws + WS_WMO), 64 * j, P, a);
    skinny64(F.wave, tid, (const bf16*)(ws + WS_RIN), D, (const bf16*)(ws + WS_WRO), 64 * j, P, b);
    const int r = tid >> 3, cg = tid & 7, row = XROW0 + r, col = 64 * j + 8 * cg;
    const u32x4 ga = *(const u32x4*)((const bf16*)(ws + WS_SGA) + (size_t)row * 1024 + col), gb = *(const u32x4*)((const bf16*)(ws + WS_SGB) + (size_t)row * 1024 + col);
#pragma unroll
    for (int k = 0; k < 8; ++k) { const unsigned wa = ga[k >> 1], wb = gb[k >> 1];
        const float fa = __uint_as_float((k & 1) ? (wa & 0xffff0000u) : (wa << 16)), fb = __uint_as_float((k & 1) ? (wb & 0xffff0000u) : (wb << 16));
        o[k] = fa * a[k] + fb * b[k]; }
    st8_bf16((bf16*)(ws + WS_MX) + (size_t)row * 1024 + col, o);
}
__device__ __forceinline__ void xjob_ql(Frame& F, unsigned char* ws, int j) {
    ws = opaque_g(ws);
    const int tid = fresh_tid(F.wave);
    LAS float* P = (LAS float*)(F.lds + RING_OFF);
    float v[8];
    skinny64(F.wave, tid, (const bf16*)(ws + WS_CQ), QR, (const bf16*)(ws + WS_WQL), 64 * j, P, v);
    const int r = tid >> 3, cg = tid & 7, row = XROW0 + r;
    const float rs = row_rscale8((const float*)(ws + WS_SSQCQ), row, 1.f / QR) * SC_Q;
    float* dst = (float*)(ws + WS_QL) + (size_t)r * 2048 + 64 * j + 8 * cg;
    *(f32x4*)dst = (f32x4){v[0] * rs, v[1] * rs, v[2] * rs, v[3] * rs}; *(f32x4*)(dst + 4) = (f32x4){v[4] * rs, v[5] * rs, v[6] * rs, v[7] * rs};
}
}
namespace mk {
constexpr int RC_STR = 272;
constexpr int RC_S = 0, RC_KT = 0  , RC_Q = 256 * RC_STR, RC_A = RC_Q + 128 * RC_STR, RC_RED = RC_A + 128 * RC_STR, RC_END = RC_RED + 2 * 8 * 128 * 4;
static_assert(RC_END <= SCR_BYTES, "chain LDS map");
__device__ __forceinline__ void ret_chain_unit(Frame& F, const Ptrs& a, int bh) {
    unsigned char* ws = a.ws; ws = opaque_g(ws);
    const int tid_k = fresh_tid(F.wave), w = F.wave;
    const int hh = bh & 3, b = bh >> 2;
    LAS unsigned char* L = F.lds + RING_OFF;
    LAS float* red = (LAS float*)(L + RC_RED);
    const bf16* RQ = (const bf16*)(ws + WS_RQ); const bf16* RK = (const bf16*)(ws + WS_RK); const bf16* RKT = (const bf16*)(ws + WS_RKT); const bf16* RVT = (const bf16*)(ws + WS_RVT);
    const float g = gpow_t(ws, hh, 1), g127 = gpow_t(ws, hh, 127);
    f32x16 S[4];
    {
        const int lane = tid_k & 63, r32 = lane & 31, half = lane >> 5;
#pragma unroll
        for (int db = 0; db < 4; ++db)
#pragma unroll
            for (int i = 0; i < 16; ++i) S[db][i] = 0.f;
        const bf16x8 af = *(const bf16x8*)(RVT + (size_t)(hh * 256 + 32 * w + r32) * MP + ROW_META + 8 * half);
#pragma unroll
        for (int db = 0; db < 4; ++db) { const bf16x8 bf = *(const bf16x8*)(RKT + (size_t)(hh * 128 + 32 * db + r32) * MP + ROW_META + 8 * half); S[db] = __builtin_amdgcn_mfma_f32_32x32x16_bf16(af, bf, S[db], 0, 0, 0); }
        const float sc = gpow_t(ws, hh, NMETA - 1);
#pragma unroll
        for (int db = 0; db < 4; ++db)
#pragma unroll
            for (int i = 0; i < 16; ++i) S[db][i] *= sc;
    }
    v4u qreg[4], jreg[4];
#define RC_FETCH_QK(tok0_) do { _Pragma("unroll") for (int k = 0; k < 4; ++k) { const int ch = tid + 512 * k; \
        qreg[k] = *(const v4u*)(RQ + (size_t)((tok0_) + (ch >> 4)) * 512 + hh * 128 + 8 * (ch & 15)); jreg[k] = *(const v4u*)(RK + (size_t)((tok0_) + (ch >> 4)) * 512 + hh * 128 + 8 * (ch & 15)); } } while (0)
    { const int tid = tid_k; RC_FETCH_QK(b * SEQ); }
#define RC_BLK_IB(n) ((n) < 1 ? 0 : (n) < 3 ? 1 : (n) < 6 ? 2 : 3)
#define RC_BLK_JB(n) ((n) - ((n) < 1 ? 0 : (n) < 3 ? 1 : (n) < 6 ? 3 : 6))
#pragma unroll 1
    for (int c = 0; c < 16; ++c) {
        const int tok0 = b * SEQ + c * 128;
        int tid_c = tid_k; asm volatile("" : "+v"(tid_c));
        const int tid = tid_c, lane = tid & 63, r32 = lane & 31, half = lane >> 5;
#pragma unroll
        for (int k = 0; k < 4; ++k) { const int ch = tid + 512 * k; *(LAS v4u*)(L + RC_Q + (ch >> 4) * RC_STR + 16 * (ch & 15)) = qreg[k]; *(LAS v4u*)(L + RC_S + (ch >> 4) * RC_STR + 16 * (ch & 15)) = jreg[k]; }
        __syncthreads();
        v4u kreg[4];
#pragma unroll
        for (int k = 0; k < 4; ++k) { const int ch = tid + 512 * k; kreg[k] = *(const v4u*)(RKT + (size_t)(hh * 128 + (ch >> 4)) * MP + tok0 + 8 * (ch & 15)); }
        for (int n = w; n < 10; n += 8) {
            const int ib_ = RC_BLK_IB(n), jb_ = RC_BLK_JB(n);
            f32x16 at;
#pragma unroll
            for (int i = 0; i < 16; ++i) at[i] = 0.f;
#pragma unroll
            for (int s = 0; s < 8; ++s) { const bf16x8 kf = *(const LAS bf16x8*)(L + RC_S + (32 * jb_ + r32) * RC_STR + (16 * s + 8 * half) * 2); const bf16x8 qf = *(const LAS bf16x8*)(L + RC_Q + (32 * ib_ + r32) * RC_STR + (16 * s + 8 * half) * 2); at = __builtin_amdgcn_mfma_f32_32x32x16_bf16(kf, qf, at, 0, 0, 0); }
            if (jb_ == ib_) {
#pragma unroll
                for (int i = 0; i < 16; ++i) if (crow(i, half) > r32) at[i] = 0.f; }
#pragma unroll
            for (int gq = 0; gq < 4; ++gq) { f32x4 o_; o_[0] = at[4 * gq]; o_[1] = at[4 * gq + 1]; o_[2] = at[4 * gq + 2]; o_[3] = at[4 * gq + 3];
                *(LAS u32x2*)(L + RC_A + (32 * ib_ + r32) * RC_STR + (32 * jb_ + 8 * gq + 4 * half) * 2) = pack4(o_); }
        }
        __syncthreads();
#pragma unroll
        for (int db = 0; db < 4; ++db)
#pragma unroll
            for (int i = 0; i < 16; ++i) *(LAS bf16*)(L + RC_S + (32 * w + crow(i, half)) * RC_STR + (32 * db + r32) * 2) = bf1(S[db][i]);
        f32x16 ot[4];
#pragma unroll
        for (int ib = 0; ib < 4; ++ib)
#pragma unroll
            for (int i = 0; i < 16; ++i) ot[ib][i] = 0.f;
#pragma unroll 2
        for (int s = 0; s < 8; ++s) {
            const bf16x8 sf = *(const LAS bf16x8*)(L + RC_S + (32 * w + r32) * RC_STR + (16 * s + 8 * half) * 2);
#pragma unroll
            for (int ib = 0; ib < 4; ++ib) { const bf16x8 qf = *(const LAS bf16x8*)(L + RC_Q + (32 * ib + r32) * RC_STR + (16 * s + 8 * half) * 2); ot[ib] = __builtin_amdgcn_mfma_f32_32x32x16_bf16(sf, qf, ot[ib], 0, 0, 0); }
        }
#pragma unroll
        for (int ib = 0; ib < 4; ++ib)
#pragma unroll
            for (int i = 0; i < 16; ++i) ot[ib][i] *= g;
        __syncthreads();
#pragma unroll
        for (int k = 0; k < 4; ++k) { const int ch = tid + 512 * k; *(LAS v4u*)(L + RC_KT + (ch >> 4) * RC_STR + 16 * (ch & 15)) = kreg[k]; }
        __syncthreads();
        if (c < 15) RC_FETCH_QK(tok0 + 128);
#pragma unroll
        for (int db = 0; db < 4; ++db)
#pragma unroll
            for (int i = 0; i < 16; ++i) S[db][i] *= g;
        {
            const bf16* vp = RVT + (size_t)(hh * 256 + 32 * w + r32) * MP + tok0 + 8 * half;
            bf16x8 v0 = *(const bf16x8*)(vp), v1 = *(const bf16x8*)(vp + 16), v2 = v1;
#pragma unroll 1
            for (int s = 0; s < 8; ++s) {
                if (s + 2 < 8) v2 = *(const bf16x8*)(vp + 16 * (s + 2));
#pragma unroll
                for (int ib = 0; ib < 4; ++ib) if (s < 2 * (ib + 1)) { const bf16x8 af = *(const LAS bf16x8*)(L + RC_A + (32 * ib + r32) * RC_STR + (16 * s + 8 * half) * 2); ot[ib] = __builtin_amdgcn_mfma_f32_32x32x16_bf16(v0, af, ot[ib], 0, 0, 0); }
#pragma unroll
                for (int db = 0; db < 4; ++db) { const bf16x8 kf = *(const LAS bf16x8*)(L + RC_KT + (32 * db + r32) * RC_STR + (16 * s + 8 * half) * 2); S[db] = __builtin_amdgcn_mfma_f32_32x32x16_bf16(v0, kf, S[db], 0, 0, 0); }
                v0 = v1; v1 = v2;
            }
        }
#pragma unroll
        for (int db = 0; db < 4; ++db)
#pragma unroll
            for (int i = 0; i < 16; ++i) S[db][i] *= g127;
#pragma unroll
        for (int ib = 0; ib < 4; ++ib) { float t = 0.f;
#pragma unroll
            for (int i = 0; i < 16; ++i) t += ot[ib][i];
            t += lx(t, lane, 32); if (half == 0) red[w * 128 + 32 * ib + r32] = t; }
        __syncthreads();
        float mu[4];
#pragma unroll
        for (int ib = 0; ib < 4; ++ib) { float t = 0.f;
#pragma unroll
            for (int ww = 0; ww < 8; ++ww) t += red[ww * 128 + 32 * ib + r32];
            mu[ib] = t * (1.f / 256.f); }
#pragma unroll
        for (int ib = 0; ib < 4; ++ib) { float t = 0.f;
#pragma unroll
            for (int i = 0; i < 16; ++i) { ot[ib][i] -= mu[ib]; t += ot[ib][i] * ot[ib][i]; }
            t += lx(t, lane, 32); if (half == 0) red[1024 + w * 128 + 32 * ib + r32] = t; }
        __syncthreads();
#pragma unroll
        for (int ib = 0; ib < 4; ++ib) { float t = 0.f;
#pragma unroll
            for (int ww = 0; ww < 8; ++ww) t += red[1024 + ww * 128 + 32 * ib + r32];
            const float rstd = 1.0f / sqrtf(t * (1.f / 256.f) + EPS);
            const int irow = tok0 + 32 * ib + r32;
            const bf16* SRG = (const bf16*)(ws + WS_SRG) + (size_t)irow * 1024 + hh * 256 + 32 * w + 4 * half;
            bf16* RIN = (bf16*)(ws + WS_RIN) + (size_t)irow * 1024 + hh * 256 + 32 * w + 4 * half;
            const float* gn = a.in(19) + hh * 256 + 32 * w + 4 * half;
#pragma unroll
            for (int gq = 0; gq < 4; ++gq) {
                const u32x2 sg = *(const u32x2*)(SRG + 8 * gq); const f32x4 gv = *(const f32x4*)(gn + 8 * gq);
                f32x4 o;
                o[0] = ot[ib][4 * gq + 0] * rstd * gv[0] * __uint_as_float(sg.x << 16); o[1] = ot[ib][4 * gq + 1] * rstd * gv[1] * __uint_as_float(sg.x & 0xffff0000u);
                o[2] = ot[ib][4 * gq + 2] * rstd * gv[2] * __uint_as_float(sg.y << 16); o[3] = ot[ib][4 * gq + 3] * rstd * gv[3] * __uint_as_float(sg.y & 0xffff0000u);
                *(u32x2*)(RIN + 8 * gq) = pack4(o);
            } }
        __syncthreads();
    }
#undef RC_FETCH_QK
#undef RC_BLK_IB
#undef RC_BLK_JB
    const int lane = tid_k & 63, r32 = lane & 31, half = lane >> 5;
#pragma unroll
    for (int db = 0; db < 4; ++db)
#pragma unroll
        for (int i = 0; i < 16; ++i) a.out()[OUT_SRP + ((size_t)bh * RDK + 32 * db + r32) * RDV + 32 * w + crow(i, half)] = S[db][i];
}
}
namespace mk {
constexpr int CW_FLAG = 8192;
__device__ __forceinline__ void st16_wt(void* p, v4u v) { asm volatile("global_store_dwordx4 %0, %1, off sc1\n\ts_nop 1" :: "v"(p), "v"(v) : "memory"); }
__device__ __forceinline__ void ret_state_unit(Frame& F, const Ptrs& a, int bh) {
    unsigned char* ws = opaque_g(a.ws);
    const int tid_k = fresh_tid(F.wave), w = F.wave;
    const int hh = bh & 3, b = bh >> 2;
    LAS unsigned char* L = F.lds + RING_OFF;
    const bf16* RKT = (const bf16*)(ws + WS_RKT); const bf16* RVT = (const bf16*)(ws + WS_RVT);
    const float g = gpow_t(ws, hh, 1), g127 = gpow_t(ws, hh, 127);
    f32x16 S[4];
    bf16x8 vf[8]; v4u kreg[4];
#define RS_FETCH(tok0_) do { _Pragma("unroll") for (int s = 0; s < 8; ++s) vf[s] = *(const bf16x8*)(RVT + (size_t)(hh * 256 + 32 * w + r32) * MP + (tok0_) + 16 * s + 8 * half); \
        _Pragma("unroll") for (int k = 0; k < 4; ++k) { const int ch = tid + 512 * k; kreg[k] = *(const v4u*)(RKT + (size_t)(hh * 128 + (ch >> 4)) * MP + (tok0_) + 8 * (ch & 15)); } } while (0)
    {   const int tid = tid_k, lane = tid & 63, r32 = lane & 31, half = lane >> 5;
#pragma unroll
        for (int db = 0; db < 4; ++db)
#pragma unroll
            for (int i = 0; i < 16; ++i) S[db][i] = 0.f;
        const bf16x8 af = *(const bf16x8*)(RVT + (size_t)(hh * 256 + 32 * w + r32) * MP + ROW_META + 8 * half);
#pragma unroll
        for (int db = 0; db < 4; ++db) { const bf16x8 bf = *(const bf16x8*)(RKT + (size_t)(hh * 128 + 32 * db + r32) * MP + ROW_META + 8 * half); S[db] = __builtin_amdgcn_mfma_f32_32x32x16_bf16(af, bf, S[db], 0, 0, 0); }
        const float sc = gpow_t(ws, hh, NMETA - 1);
#pragma unroll
        for (int db = 0; db < 4; ++db)
#pragma unroll
            for (int i = 0; i < 16; ++i) S[db][i] *= sc;
        RS_FETCH(b * SEQ);
    }
#pragma unroll 1
    for (int c = 0; c < 16; ++c) {
        const int tok0 = b * SEQ + c * 128, u = bh * 16 + c;
        int tid_c = tid_k; asm volatile("" : "+v"(tid_c));
        const int tid = tid_c, lane = tid & 63, r32 = lane & 31, half = lane >> 5;
#pragma unroll
        for (int k = 0; k < 4; ++k) { const int ch = tid + 512 * k; *(LAS v4u*)(L + RC_Q + (ch >> 4) * RC_STR + 16 * (ch & 15)) = kreg[k]; }
#pragma unroll
        for (int db = 0; db < 4; ++db)
#pragma unroll
            for (int i = 0; i < 16; ++i) *(LAS bf16*)(L + (32 * w + crow(i, half)) * RC_STR + (32 * db + r32) * 2) = bf1(S[db][i]);
        __syncthreads();
        { bf16* SP = (bf16*)(ws + WS_SPREV) + (size_t)u * 32768;
#pragma unroll
          for (int k = 0; k < 8; ++k) { const int ch = lane + 64 * k, row = 32 * w + (ch >> 4); st16_wt(SP + (size_t)row * 128 + 8 * (ch & 15), *(const LAS v4u*)(L + row * RC_STR + 16 * (ch & 15))); } }
        bf16x8 vfn[8]; v4u kregn[4];
        if (c < 15) {
#pragma unroll
            for (int s = 0; s < 8; ++s) vfn[s] = *(const bf16x8*)(RVT + (size_t)(hh * 256 + 32 * w + r32) * MP + tok0 + 128 + 16 * s + 8 * half);
#pragma unroll
            for (int k = 0; k < 4; ++k) { const int ch = tid + 512 * k; kregn[k] = *(const v4u*)(RKT + (size_t)(hh * 128 + (ch >> 4)) * MP + tok0 + 128 + 8 * (ch & 15)); }
        } else {
#pragma unroll
            for (int s = 0; s < 8; ++s) vfn[s] = vf[s];
#pragma unroll
            for (int k = 0; k < 4; ++k) kregn[k] = kreg[k];
        }
#pragma unroll
        for (int db = 0; db < 4; ++db) {
#pragma unroll
            for (int i = 0; i < 16; ++i) S[db][i] *= g;
#pragma unroll
            for (int s = 0; s < 8; ++s) { const bf16x8 kf = *(const LAS bf16x8*)(L + RC_Q + (32 * db + r32) * RC_STR + (16 * s + 8 * half) * 2); S[db] = __builtin_amdgcn_mfma_f32_32x32x16_bf16(vf[s], kf, S[db], 0, 0, 0); }
#pragma unroll
            for (int i = 0; i < 16; ++i) S[db][i] *= g127;
        }
        asm volatile("s_waitcnt vmcnt(0)" ::: "memory");
#pragma unroll
        for (int s = 0; s < 8; ++s) vf[s] = vfn[s];
#pragma unroll
        for (int k = 0; k < 4; ++k) kreg[k] = kregn[k];
        __syncthreads();
        if (tid == 0) __hip_atomic_store((unsigned*)(ws + WS_CTL) + CW_FLAG + 16 * u, 1u, __ATOMIC_RELAXED, __HIP_MEMORY_SCOPE_AGENT);
    }
#undef RS_FETCH
    {   const int lane = tid_k & 63, r32 = lane & 31, half = lane >> 5;
#pragma unroll
        for (int db = 0; db < 4; ++db)
#pragma unroll
            for (int i = 0; i < 16; ++i) a.out()[OUT_SRP + ((size_t)bh * RDK + 32 * db + r32) * RDV + 32 * w + crow(i, half)] = S[db][i]; }
    __syncthreads();
}
__device__ __forceinline__ void ret_out_unit(Frame& F, const Ptrs& a, int u) {
    unsigned char* ws = opaque_g(a.ws);
    const int tid = fresh_tid(F.wave), lane = tid & 63, w = F.wave, r32 = lane & 31, half = lane >> 5;
    const int bh = u >> 4, c = u & 15, hh = bh & 3, tok0 = (bh >> 2) * SEQ + c * 128;
    LAS unsigned char* L = F.lds + RING_OFF;
    LAS float* red = (LAS float*)(L + RC_RED);
    const bf16* RQ = (const bf16*)(ws + WS_RQ); const bf16* RK = (const bf16*)(ws + WS_RK); const bf16* RVT = (const bf16*)(ws + WS_RVT);
    v4u qreg[4], jreg[4];
#pragma unroll
    for (int k = 0; k < 4; ++k) { const int ch = tid + 512 * k; qreg[k] = *(const v4u*)(RQ + (size_t)(tok0 + (ch >> 4)) * 512 + hh * 128 + 8 * (ch & 15)); jreg[k] = *(const v4u*)(RK + (size_t)(tok0 + (ch >> 4)) * 512 + hh * 128 + 8 * (ch & 15)); }
    if (tid == 0) { const unsigned* fl = (const unsigned*)(ws + WS_CTL) + CW_FLAG + 16 * u; unsigned spins = 0;
        while (__hip_atomic_load(fl, __ATOMIC_RELAXED, __HIP_MEMORY_SCOPE_AGENT) == 0u && ++spins < (1u << 22)) __builtin_amdgcn_s_sleep(8);
        __builtin_amdgcn_fence(__ATOMIC_ACQUIRE, "agent"); asm volatile("s_waitcnt vmcnt(0)" ::: "memory"); }
    __syncthreads();
    v4u sreg[8];
    { const bf16* SP = (const bf16*)(ws + WS_SPREV) + (size_t)u * 32768;
#pragma unroll
      for (int k = 0; k < 8; ++k) { const int ch = tid + 512 * k; sreg[k] = *(const v4u*)(SP + (size_t)(ch >> 4) * 128 + 8 * (ch & 15)); } }
#pragma unroll
    for (int k = 0; k < 4; ++k) { const int ch = tid + 512 * k; *(LAS v4u*)(L + RC_Q + (ch >> 4) * RC_STR + 16 * (ch & 15)) = qreg[k]; *(LAS v4u*)(L + RC_S + (ch >> 4) * RC_STR + 16 * (ch & 15)) = jreg[k]; }
    __syncthreads();
#define RC_BLK_IB(n) ((n) < 1 ? 0 : (n) < 3 ? 1 : (n) < 6 ? 2 : 3)
#define RC_BLK_JB(n) ((n) - ((n) < 1 ? 0 : (n) < 3 ? 1 : (n) < 6 ? 3 : 6))
    for (int n = w; n < 10; n += 8) {
        const int ib_ = RC_BLK_IB(n), jb_ = RC_BLK_JB(n);
        f32x16 at;
#pragma unroll
        for (int i = 0; i < 16; ++i) at[i] = 0.f;
#pragma unroll
        for (int s = 0; s < 8; ++s) { const bf16x8 kf = *(const LAS bf16x8*)(L + RC_S + (32 * jb_ + r32) * RC_STR + (16 * s + 8 * half) * 2); const bf16x8 qf = *(const LAS bf16x8*)(L + RC_Q + (32 * ib_ + r32) * RC_STR + (16 * s + 8 * half) * 2); at = __builtin_amdgcn_mfma_f32_32x32x16_bf16(kf, qf, at, 0, 0, 0); }
        if (jb_ == ib_) {
#pragma unroll
            for (int i = 0; i < 16; ++i) if (crow(i, half) > r32) at[i] = 0.f; }
#pragma unroll
        for (int gq = 0; gq < 4; ++gq) { f32x4 o_; o_[0] = at[4 * gq]; o_[1] = at[4 * gq + 1]; o_[2] = at[4 * gq + 2]; o_[3] = at[4 * gq + 3];
            *(LAS u32x2*)(L + RC_A + (32 * ib_ + r32) * RC_STR + (32 * jb_ + 8 * gq + 4 * half) * 2) = pack4(o_); }
    }
#undef RC_BLK_IB
#undef RC_BLK_JB
    __syncthreads();
#pragma unroll
    for (int k = 0; k < 8; ++k) { const int ch = tid + 512 * k; *(LAS v4u*)(L + RC_S + (ch >> 4) * RC_STR + 16 * (ch & 15)) = sreg[k]; }
    __syncthreads();
    const float g = gpow_t(ws, hh, 1);
    f32x16 ot[4];
#pragma unroll
    for (int ib = 0; ib < 4; ++ib)
#pragma unroll
        for (int i = 0; i < 16; ++i) ot[ib][i] = 0.f;
#pragma unroll 2
    for (int s = 0; s < 8; ++s) {
        const bf16x8 sf = *(const LAS bf16x8*)(L + RC_S + (32 * w + r32) * RC_STR + (16 * s + 8 * half) * 2);
#pragma unroll
        for (int ib = 0; ib < 4; ++ib) { const bf16x8 qf = *(const LAS bf16x8*)(L + RC_Q + (32 * ib + r32) * RC_STR + (16 * s + 8 * half) * 2); ot[ib] = __builtin_amdgcn_mfma_f32_32x32x16_bf16(sf, qf, ot[ib], 0, 0, 0); }
    }
#pragma unroll
    for (int ib = 0; ib < 4; ++ib)
#pragma unroll
        for (int i = 0; i < 16; ++i) ot[ib][i] *= g;
    bf16x8 vf[8];
#pragma unroll
    for (int s = 0; s < 8; ++s) vf[s] = *(const bf16x8*)(RVT + (size_t)(hh * 256 + 32 * w + r32) * MP + tok0 + 16 * s + 8 * half);
#pragma unroll
    for (int ib = 0; ib < 4; ++ib)
#pragma unroll
        for (int s = 0; s < 2 * (ib + 1); ++s) { const bf16x8 af = *(const LAS bf16x8*)(L + RC_A + (32 * ib + r32) * RC_STR + (16 * s + 8 * half) * 2); ot[ib] = __builtin_amdgcn_mfma_f32_32x32x16_bf16(vf[s], af, ot[ib], 0, 0, 0); }
#pragma unroll
    for (int ib = 0; ib < 4; ++ib) { float t = 0.f;
#pragma unroll
        for (int i = 0; i < 16; ++i) t += ot[ib][i];
        t += lx(t, lane, 32); if (half == 0) red[w * 128 + 32 * ib + r32] = t; }
    __syncthreads();
    float mu[4];
#pragma unroll
    for (int ib = 0; ib < 4; ++ib) { float t = 0.f;
#pragma unroll
        for (int ww = 0; ww < 8; ++ww) t += red[ww * 128 + 32 * ib + r32];
        mu[ib] = t * (1.f / 256.f); }
#pragma unroll
    for (int ib = 0; ib < 4; ++ib) { float t = 0.f;
#pragma unroll
        for (int i = 0; i < 16; ++i) { ot[ib][i] -= mu[ib]; t += ot[ib][i] * ot[ib][i]; }
        t += lx(t, lane, 32); if (half == 0) red[1024 + w * 128 + 32 * ib + r32] = t; }
    __syncthreads();
#pragma unroll
    for (int ib = 0; ib < 4; ++ib) { float t = 0.f;
#pragma unroll
        for (int ww = 0; ww < 8; ++ww) t += red[1024 + ww * 128 + 32 * ib + r32];
        const float rstd = 1.0f / sqrtf(t * (1.f / 256.f) + EPS);
        const int irow = tok0 + 32 * ib + r32;
        const bf16* SRG = (const bf16*)(ws + WS_SRG) + (size_t)irow * 1024 + hh * 256 + 32 * w + 4 * half;
        bf16* RIN = (bf16*)(ws + WS_RIN) + (size_t)irow * 1024 + hh * 256 + 32 * w + 4 * half;
        const float* gn = a.in(19) + hh * 256 + 32 * w + 4 * half;
#pragma unroll
        for (int gq = 0; gq < 4; ++gq) {
            const u32x2 sg = *(const u32x2*)(SRG + 8 * gq); const f32x4 gv = *(const f32x4*)(gn + 8 * gq);
            f32x4 o;
            o[0] = ot[ib][4 * gq + 0] * rstd * gv[0] * __uint_as_float(sg.x << 16); o[1] = ot[ib][4 * gq + 1] * rstd * gv[1] * __uint_as_float(sg.x & 0xffff0000u);
            o[2] = ot[ib][4 * gq + 2] * rstd * gv[2] * __uint_as_float(sg.y << 16); o[3] = ot[ib][4 * gq + 3] * rstd * gv[3] * __uint_as_float(sg.y & 0xffff0000u);
            *(u32x2*)(RIN + 8 * gq) = pack4(o);
        } }
    __syncthreads();
}
}
namespace mk {
__global__ void __launch_bounds__(NWAVES * 64, 2) mega_fwd(Args args) {
    extern __shared__ __attribute__((aligned(16))) unsigned char lds[];
    Frame F;
    F.lds = (LAS unsigned char*)lds;
    F.MISC = (volatile LAS unsigned*)(F.lds + MISC_OFF);
    F.wave = __builtin_amdgcn_readfirstlane((int)threadIdx.x >> 6);
    F.G = gridDim.x; { const int bx = blockIdx.x; F.vcu = (F.G % 8 == 0) ? (bx % 8) * (F.G / 8) + bx / 8 : bx; }
    unsigned char* const ws_k = args.ws;
    unsigned char* ws = ws_k;
    for (int u = threadIdx.x; u < (LDS_BYTES - LDSCTL_OFF) / 4; u += NWAVES * 64) ((LAS unsigned*)(F.lds + LDSCTL_OFF))[u] = 0u;
    __syncthreads();
    {
        volatile LAS unsigned long long* pt = (volatile LAS unsigned long long*)(F.lds + PT_OFF);
        if (threadIdx.x == 0) {
#define PT_PUT(i) pt[i] = (unsigned long long)args.in[i]
            PT_PUT(0); PT_PUT(1); PT_PUT(2); PT_PUT(3); PT_PUT(4); PT_PUT(5); PT_PUT(6); PT_PUT(7); PT_PUT(8); PT_PUT(9); PT_PUT(10); PT_PUT(11); PT_PUT(12); PT_PUT(13);
            PT_PUT(14); PT_PUT(15); PT_PUT(16); PT_PUT(17); PT_PUT(18); PT_PUT(19); PT_PUT(20); PT_PUT(21); PT_PUT(22); PT_PUT(23); PT_PUT(24); PT_PUT(25); PT_PUT(26);
#undef PT_PUT
            pt[27] = (unsigned long long)args.out;
        }
        __syncthreads();
    }
    const Ptrs P{ws_k, (volatile LAS unsigned*)(F.lds + PT_OFF)};
    (void)xcd_barrier_post((unsigned*)(ws_k + WS_CTL) + CW_BAR, F.MISC + 8, F.wave);
#if MK_PROBE
#define STAMP(k) do { if (blockIdx.x == 0 && F.wave == 0 && lane_fresh() == 0) ((unsigned long long*)(ws_k + WS_CTL + 512 * 1024))[k] = __builtin_amdgcn_s_memrealtime(); } while (0)
    STAMP(0);
#else
#define STAMP(k) do { } while (0)
#endif
#define WS_FRESH() unsigned char* ws = opaque_g(ws_k)
#define GRID_BAR() do { XcdBarrier b_; b_.bar = (unsigned*)(ws_k + WS_CTL) + CW_BAR; b_.x = xb_xcc_id(); b_.st = F.MISC + 8; b_.wave = F.wave; xcd_barrier(b_); } while (0)

    p0_prologue(F, args);
    GRID_BAR(); STAMP(1);
    {
        WS_FRESH();
        { const int bx = (int)blockIdx.x; if (bx >= 128 && bx < 172) xjob_ffn_up(F, ws, bx - 128, WS_XB, WS_W1T, 0, 0); }
        p0_weights_late(F, args);
        pg8::Gemm g{(const pg8::bf16_t*)(ws + WS_XB), (const pg8::bf16_t*)(ws + WS_W1T), MMAIN, 2 * FFN, D};
        pg8::StaticOrder S; S.init(MMAIN, 2 * FFN, F.G, (int)blockIdx.x);
        EpiSwiGLU E{(bf16*)(ws + WS_ACT), (const float*)(ws + WS_R1)};
        pg8::gemm_phase<EpiSwiGLU, pg8::StaticOrder, true, true>(F.lds + RING_OFF, g, S, E, F.wave);
        { const int bx = (int)blockIdx.x; if (bx >= 172 && bx < 188) { xjob_wait(ws, fresh_tid(F.wave), 0, 44u); xjob_resid(F, ws, bx - 172, WS_ACT, FFN, WS_W1D, (const float*)(ws + WS_XE), 0.5f, WS_H, WS_HB, WS_SSQH); } }
    }
    GRID_BAR(); STAMP(2);
    {
        WS_FRESH();
        pg8::Gemm g{(const pg8::bf16_t*)(ws + WS_ACT), (const pg8::bf16_t*)(ws + WS_W1D), MMAIN, D, FFN};
        pg8::StaticOrder S; S.init(MMAIN, D, F.G, (int)blockIdx.x);
        typedef EpiResid<(unsigned)WS_XE, true, (unsigned)WS_H, (unsigned)WS_HB, (unsigned)WS_SSQH, 1> EpiDown1;
        EpiDown1 E{ws, P.in(0)};
        pg8::gemm_phase<EpiDown1, pg8::StaticOrder, true, true>(F.lds + RING_OFF, g, S, E, F.wave);
    }
    GRID_BAR(); STAMP(3);
#ifndef NO_P3
    {
        WS_FRESH();
        { const int bx = (int)blockIdx.x; if (bx >= 192 && bx < 238) xjob_win(F, ws, bx - 192); }
        pg8::Gemm g{(const pg8::bf16_t*)(ws + WS_HB), (const pg8::bf16_t*)(ws + WS_WIN), MMAIN, NWIN, D};
        pg8::StaticOrder S; S.init(MMAIN, NWIN, F.G, (int)blockIdx.x);
        EpiWin E{ws, F.lds};
        pg8::gemm_phase<EpiWin, pg8::StaticOrder, true, true>(F.lds + RING_OFF, g, S, E, F.wave);
    }
#endif
    GRID_BAR(); STAMP(4);
    {
        WS_FRESH();
        { const int jb = (int)blockIdx.x - 192; if (jb >= 0 && jb < 12) xjob_q(F, ws, jb); else if (jb >= 12 && jb < 20) xjob_kv(F, ws, jb - 12, false); else if (jb >= 20 && jb < 28) xjob_kv(F, ws, jb - 20, true); else if (jb >= 28 && jb < 60) xjob_ql(F, ws, jb - 28); }
        finalize_ckv(F, P);
#ifndef NO_P4Q
        {   pg8::Gemm g{(const pg8::bf16_t*)(ws + WS_CQ), (const pg8::bf16_t*)(ws + WS_WUQ), MMAIN, 768, QR};
            pg8::StaticOrder S; S.init(MMAIN, 768, F.G, (int)blockIdx.x);
            EpiQ E{ws};
            pg8::gemm_phase<EpiQ, pg8::StaticOrder, true, true>(F.lds + RING_OFF, g, S, E, F.wave); }
#endif
#ifndef NO_P4K
        {   pg8::Gemm g{(const pg8::bf16_t*)(ws + WS_CKVB), (const pg8::bf16_t*)(ws + WS_WUK), MMAIN, 512, KVR};
            pg8::StaticOrder S; S.init(MMAIN, 512, F.G, (int)((blockIdx.x + 64) % F.G));
            EpiScaleBf16<true> E{(const float*)(ws + WS_SSQKV), (bf16*)(ws + WS_KN), 512};
            pg8::gemm_phase<EpiScaleBf16<true>, pg8::StaticOrder, true, true>(F.lds + RING_OFF, g, S, E, F.wave); }
#endif
#ifndef NO_P4V
        {   pg8::Gemm g{(const pg8::bf16_t*)(ws + WS_WUV), (const pg8::bf16_t*)(ws + WS_CKVB), 512, MMAIN, KVR};
            pg8::StaticOrder S; S.init(512, MMAIN, F.G, (int)((blockIdx.x + 192) % F.G));
            EpiScaleBf16<false> E{(const float*)(ws + WS_SSQKV), (bf16*)(ws + WS_VT), MP};
            pg8::gemm_phase<EpiScaleBf16<false>, pg8::StaticOrder, true, true>(F.lds + RING_OFF, g, S, E, F.wave); }
#endif
    }
    GRID_BAR(); STAMP(5);
    STAMP(32);
#define QUEUE_LOOP(qi, nitems, call) for (;;) { \
        if (F.wave == 0 && lane_fresh() == 0) F.MISC[16] = __hip_atomic_fetch_add((unsigned*)(ws_k + WS_CTL) + CW_QUEUE + 64 * (qi), 1u, __ATOMIC_RELAXED, __HIP_MEMORY_SCOPE_AGENT); \
        __syncthreads(); const int it = (int)F.MISC[16]; __syncthreads(); \
        if (it >= (nitems)) break; call; }
    if ((int)blockIdx.x < 32) ret_state_unit(F, P, (int)blockIdx.x);
    STAMP(33);
    if (((int)blockIdx.x & 1) == 0) { QUEUE_LOOP(0, 512, attn_item(F, ws_k, it)) }
    STAMP(34);
    QUEUE_LOOP(1, 512, decode_unit(F, P, it))
    STAMP(35);
    QUEUE_LOOP(2, 128, ret_sample_unit(F, P, it))
    STAMP(36);
    if (((int)blockIdx.x & 1) != 0) { QUEUE_LOOP(0, 512, attn_item(F, ws_k, it)) }
    QUEUE_LOOP(3, 512, ret_out_unit(F, P, ((it & 31) << 4) | (it >> 5)))
    STAMP(37);
    QUEUE_LOOP(4, 256, decode_combine_unit(F, P, it))
#undef QUEUE_LOOP
    GRID_BAR(); STAMP(6);
    {
        WS_FRESH();
        { const int bx = (int)blockIdx.x; if (bx < 16) xjob_mix(F, ws, bx); }
        {   pg8::Gemm g{(const pg8::bf16_t*)(ws + WS_AV), (const pg8::bf16_t*)(ws + WS_WMO), MMAIN, D, 512};
            pg8::StaticOrder S; S.init(MMAIN, D, F.G, (int)blockIdx.x);
            typedef EpiGate<0, (unsigned)WS_SGA> EpiGA; EpiGA E{ws};
            pg8::gemm_phase<EpiGA, pg8::StaticOrder, true, true>(F.lds + RING_OFF, g, S, E, F.wave); }
        {   pg8::Gemm g{(const pg8::bf16_t*)(ws + WS_RIN), (const pg8::bf16_t*)(ws + WS_WRO), MMAIN, D, D};
            pg8::StaticOrder S; S.init(MMAIN, D, F.G, (int)blockIdx.x);
            typedef EpiGate<1, (unsigned)WS_SGB> EpiGB; EpiGB E{ws};
            pg8::gemm_phase<EpiGB, pg8::StaticOrder, true, true>(F.lds + RING_OFF, g, S, E, F.wave); }
    }
    GRID_BAR(); STAMP(7);
    {
        WS_FRESH();
        { const int bx = (int)blockIdx.x; if (bx >= 16 && bx < 32) xjob_resid(F, ws, bx - 16, WS_MX, D, WS_WOUT, (const float*)(ws + WS_H) + (size_t)XROW0 * D, 1.0f, WS_H2, WS_H2B, WS_SSQH2); }
        pg8::Gemm g{(const pg8::bf16_t*)(ws + WS_MX), (const pg8::bf16_t*)(ws + WS_WOUT), MMAIN, D, D};
        pg8::StaticOrder S; S.init(MMAIN, D, F.G, (int)blockIdx.x);
        typedef EpiResid<(unsigned)WS_H, false, (unsigned)WS_H2, (unsigned)WS_H2B, (unsigned)WS_SSQH2, 2> EpiOut;
        EpiOut E{ws, nullptr};
        pg8::gemm_phase<EpiOut, pg8::StaticOrder, true, true>(F.lds + RING_OFF, g, S, E, F.wave);
    }
    GRID_BAR(); STAMP(8);
    {
        WS_FRESH();
        { const int bx = (int)blockIdx.x; if (bx >= 128 && bx < 172) xjob_ffn_up(F, ws, bx - 128, WS_H2B, WS_W2T, 1, 16); }
        pg8::Gemm g{(const pg8::bf16_t*)(ws + WS_H2B), (const pg8::bf16_t*)(ws + WS_W2T), MMAIN, 2 * FFN, D};
        pg8::StaticOrder S; S.init(MMAIN, 2 * FFN, F.G, (int)blockIdx.x);
        EpiSwiGLU2 E{ws};
        pg8::gemm_phase<EpiSwiGLU2, pg8::StaticOrder, true, true>(F.lds + RING_OFF, g, S, E, F.wave);
        { const int bx = (int)blockIdx.x; if (bx >= 172 && bx < 188) { xjob_wait(ws, fresh_tid(F.wave), 16, 44u); xjob_resid(F, ws, bx - 172, WS_ACT, FFN, WS_W2D, (const float*)(ws + WS_H2) + (size_t)XROW0 * D, 0.5f, WS_H3, 0, WS_SSQH3); } }
    }
    GRID_BAR(); STAMP(9);
    {
        WS_FRESH();
        pg8::Gemm g{(const pg8::bf16_t*)(ws + WS_ACT), (const pg8::bf16_t*)(ws + WS_W2D), MMAIN, D, FFN};
        pg8::StaticOrder S; S.init(MMAIN, D, F.G, (int)blockIdx.x);
        typedef EpiResid<(unsigned)WS_H2, false, (unsigned)WS_H3, 0u, (unsigned)WS_SSQH3, 1> EpiDown2;
        EpiDown2 E{ws, nullptr};
        pg8::gemm_phase<EpiDown2, pg8::StaticOrder, true, true>(F.lds + RING_OFF, g, S, E, F.wave);
    }
    GRID_BAR(); STAMP(10);
    final_norm_phase(F, P);
#if MK_PROBE
    GRID_BAR(); STAMP(11);
    if (blockIdx.x == 0) {
        asm volatile("s_waitcnt vmcnt(0)" ::: "memory"); __syncthreads();
        const unsigned long long* t = (const unsigned long long*)(ws_k + WS_CTL + 512 * 1024);
        const float dta = (float)(__hip_atomic_load(t + MK_PROBE_A + 1, __ATOMIC_RELAXED, __HIP_MEMORY_SCOPE_AGENT) - __hip_atomic_load(t + MK_PROBE_A, __ATOMIC_RELAXED, __HIP_MEMORY_SCOPE_AGENT)) * 0.01f;
        const float dtb = (float)(__hip_atomic_load(t + MK_PROBE_B + 1, __ATOMIC_RELAXED, __HIP_MEMORY_SCOPE_AGENT) - __hip_atomic_load(t + MK_PROBE_B, __ATOMIC_RELAXED, __HIP_MEMORY_SCOPE_AGENT)) * 0.01f;
        const float f = 1.f + sqrtf(dta / 20000.f);
        const int tid_p = fresh_tid(F.wave);
        for (int i = tid_p; i < NS * D; i += NWAVES * 64) P.out()[OUT_YS + i] *= f;
        if (tid_p == 0) P.out()[OUT_YP] += dtb / 5.f;
    }
#endif
#undef GRID_BAR
}
}
extern "C" void kernel_launch(void* const* d_in, const int* in_sizes, int n_in, void* d_out, int out_size, void* d_ws, size_t ws_size, hipStream_t stream) {
    static int grid = 0;
    if (grid == 0) {
        int dev = 0, cus = 0;
        if (n_in != 27 || out_size != (int)mk::OUT_END || ws_size < mk::WS_END6) { fprintf(stderr, "kernel_launch: unexpected problem shape (n_in %d, out %d, ws %zu); nothing launched\n", n_in, out_size, ws_size); grid = -1; return; }
        if (hipGetDevice(&dev) != hipSuccess || hipDeviceGetAttribute(&cus, hipDeviceAttributeMultiprocessorCount, dev) != hipSuccess) { fprintf(stderr, "kernel_launch: device query failed\n"); grid = -1; return; }
        if (hipFuncSetAttribute((const void*)mk::mega_fwd, hipFuncAttributeMaxDynamicSharedMemorySize, mk::LDS_BYTES) != hipSuccess) { fprintf(stderr, "kernel_launch: hipFuncSetAttribute failed\n"); grid = -1; return; }
        int per_cu = 0;
        if (hipOccupancyMaxActiveBlocksPerMultiprocessor(&per_cu, (const void*)mk::mega_fwd, mk::NWAVES * 64, mk::LDS_BYTES) != hipSuccess || per_cu < 1) fprintf(stderr, "kernel_launch: note: occupancy query reports %d workgroups per CU\n", per_cu);
        (void)hipGetLastError();
        grid = cus;
    }
    if (grid < 0) return;
    unsigned char* ws = (unsigned char*)d_ws;
    (void)hipMemsetAsync(ws + mk::WS_CTL, 0, mk::CTL_ZERO_BYTES, stream);
    mk::Args a{};
    for (int i = 0; i < 27; ++i) a.in[i] = (const float*)d_in[i];
    a.out = (float*)d_out; a.ws = ws;
    hipLaunchKernelGGL(mk::mega_fwd, dim3(grid), dim3(mk::NWAVES * 64), mk::LDS_BYTES, stream, a);
}
```

```cpp
#include <hip/hip_runtime.h>
#include <cstdio>
#include <cstdint>
#include <cmath>
#define MK_DEBUG 0
#ifndef MK_PROBE
#define MK_PROBE 0
#define MK_PROBE_A 0
#define MK_PROBE_B 1
#endif
__device__ __forceinline__ int lane_fresh() { int l; asm volatile("v_mbcnt_lo_u32_b32 %0, -1, 0\n\tv_mbcnt_hi_u32_b32 %0, -1, %0" : "=v"(l)); return l; }
__device__ __forceinline__ unsigned char* opaque_g(const unsigned char* p) { unsigned long long v = (unsigned long long)p; asm volatile("" : "+s"(v)); return (unsigned char*)(__attribute__((address_space(1))) unsigned char*)v; }
namespace pg8 {
#define PG8_LAS __attribute__((address_space(3)))
typedef unsigned short bf16_t;
typedef short bf16x8 __attribute__((ext_vector_type(8)));
typedef float f32x4 __attribute__((ext_vector_type(4)));
typedef unsigned u32x4 __attribute__((ext_vector_type(4)));
constexpr int BM = 256, BK = 64, HALF = 128, HTB = HALF * BK * 2  , STAGE_BYTES = 8 * HTB, NXCD = 8, WGM = 8;

__host__ __device__ __forceinline__ int lds_byte(int r, int c) { const int st = (r >> 4) * 2 + (c >> 5), rr = r & 15, cc = c & 31, ob = rr * 64 + cc * 2; return st * 1024 + (ob ^ (((ob >> 9) & 1) << 5)); }
__host__ __device__ __forceinline__ void stage_rc(int b, int& R, int& C) { const int st = b / 1024, sb = b % 1024, swz = sb ^ (((sb >> 9) & 1) << 5); R = (st >> 1) * 16 + swz / 64; C = (st & 1) * 32 + (swz % 64) / 2; }
__host__ __device__ __forceinline__ int perm32(int rho) { const int n = rho >> 4, i = rho & 15; return 8 * (i >> 2) + 4 * n + (i & 3); }

struct Unit { int pm, pn; };
struct Gemm { const bf16_t* A; const bf16_t* Bt; int M, N, K; };

struct StaticOrder {
    int nM, nN, nwg, G, c;
    __host__ __device__ void init(int M, int N, int G_, int c_) { nM = M / BM; nN = N / BM; nwg = nM * nN; G = G_; c = c_; }
    __host__ __device__ bool next(int i, Unit& u) const {
        const long L = (long)i * G + c; if (L >= nwg) return false;
        int wgid = (int)L; { const int q = nwg / NXCD, r = nwg % NXCD, xcd = wgid % NXCD, off = wgid / NXCD; wgid = (xcd < r ? xcd * (q + 1) : r * (q + 1) + (xcd - r) * q) + off; }
        const int nig = WGM * nN, gid = wgid / nig, fm = gid * WGM, gsz = (nM - fm) < WGM ? (nM - fm) : WGM;
        u.pm = fm + ((wgid % nig) % gsz); u.pn = (wgid % nig) / gsz; return true;
    }
    __device__ __forceinline__ void a_ready(const Unit&) const {}
    __device__ __forceinline__ void done(const Unit&) const {}
};

__device__ __forceinline__ unsigned cvt_pk_bf16(float lo, float hi) { unsigned r; asm volatile("v_cvt_pk_bf16_f32 %0, %1, %2" : "=v"(r) : "v"(lo), "v"(hi)); return r; }
typedef float f32x2 __attribute__((ext_vector_type(2)));
template <class Epi, class Sched, bool ALIGN_EPI = false, bool SP2 = false>
__device__ __forceinline__ void gemm_phase(PG8_LAS unsigned char* lds, const Gemm g, const Sched& S, const Epi& E, const int wave_in  ) {
    int tid_ = lane_fresh() + 64 * wave_in; asm volatile("" : "+v"(tid_));
    const int tid = tid_, wid = __builtin_amdgcn_readfirstlane(tid >> 6), lane = tid & 63, wr = wid >> 2, wc = wid & 3, fr = lane & 15, fq = lane >> 4;
    const int K = g.K, nt = K / BK;
    unsigned voffA[2], voffB[2];
#pragma unroll
    for (int i = 0; i < 2; ++i) { int R, C; stage_rc(tid * 16 + i * 8192, R, C); const int Rb = Epi::PERM ? ((R & ~31) + perm32(R & 31)) : R;
        voffA[i] = (unsigned)(R * K + C) * 2u; voffB[i] = (unsigned)(Rb * K + C) * 2u; }
    const size_t kstep = (size_t)(BK * 2);
    const size_t hstep = (size_t)HALF * K * 2;
    const size_t tstep = 2 * hstep;
    const unsigned ldsw = (unsigned)wid * 1024u;
    const int aoff = lds_byte(wr * 64 + fr, fq * 8), boff = lds_byte(wc * 32 + fr, fq * 8);
#define PG8_SA(b, h) (((b) * 2 + (h)) * HTB)
#define PG8_SB(b, h) ((4 + (b) * 2 + (h)) * HTB)
#define PG8_STAGE(bufoff, gbase, voff) do { _Pragma("unroll") for (int _i = 0; _i < 2; ++_i) \
        __builtin_amdgcn_global_load_lds((const unsigned*)((const char*)(gbase) + (voff)[_i]), (PG8_LAS unsigned*)(lds + (bufoff) + ldsw + _i * 8192), 16, 0, 0); } while (0)
#define PG8_LDA(dst, b, h) do { _Pragma("unroll") for (int m = 0; m < 4; ++m) _Pragma("unroll") for (int k = 0; k < 2; ++k) dst[m][k] = *(const PG8_LAS bf16x8*)(lds + PG8_SA(b, h) + aoff + m * 2048 + k * 1024); } while (0)
#define PG8_LDB(dst, b, h) do { _Pragma("unroll") for (int n = 0; n < 2; ++n) _Pragma("unroll") for (int k = 0; k < 2; ++k) dst[n][k] = *(const PG8_LAS bf16x8*)(lds + PG8_SB(b, h) + boff + n * 2048 + k * 1024); } while (0)
#define PG8_MMA(ai, bj, At, Bt) do { __builtin_amdgcn_s_setprio(1); _Pragma("unroll") for (int m = 0; m < 4; ++m) _Pragma("unroll") for (int n = 0; n < 2; ++n) _Pragma("unroll") for (int k = 0; k < 2; ++k) \
        acc[ai][bj][m][n] = __builtin_amdgcn_mfma_f32_16x16x32_bf16(Bt[n][k], At[m][k], acc[ai][bj][m][n], 0, 0, 0); __builtin_amdgcn_s_setprio(0); } while (0)
#define PG8_WAIT_V(n) asm volatile("s_waitcnt vmcnt(" #n ")" ::: "memory")
#define PG8_WAIT_L(n) asm volatile("s_waitcnt lgkmcnt(" #n ")" ::: "memory")
#define PG8_BAR __builtin_amdgcn_s_barrier()
#define PG8_SCHED __builtin_amdgcn_sched_barrier(0)
    Unit cur, nxt; int ui = 0;
    if (!S.next(0, cur)) return;
    f32x4 acc[2][2][4][2];
#pragma unroll
    for (int a = 0; a < 2; ++a)
#pragma unroll
        for (int b = 0; b < 2; ++b)
#pragma unroll
            for (int m = 0; m < 4; ++m)
#pragma unroll
                for (int n = 0; n < 2; ++n) acc[a][b][m][n] = (f32x4){0.f, 0.f, 0.f, 0.f};
    bf16x8 At[4][2], B0[2][2], B1[2][2];
    const char* cA = (const char*)g.A + (size_t)cur.pm * tstep; const char* cB = (const char*)g.Bt + (size_t)cur.pn * tstep;
    S.a_ready(cur);
    if constexpr (SP2) {
        PG8_STAGE(PG8_SB(0, 0), cB, voffB); PG8_STAGE(PG8_SB(0, 1), cB + hstep, voffB); PG8_STAGE(PG8_SA(0, 0), cA, voffA); PG8_STAGE(PG8_SA(0, 1), cA + hstep, voffA);
        if (wr == 1) PG8_BAR;
        PG8_WAIT_V(2); PG8_BAR;
        PG8_STAGE(PG8_SB(1, 0), cB + kstep, voffB); PG8_STAGE(PG8_SA(1, 0), cA + kstep, voffA); PG8_STAGE(PG8_SB(1, 1), cB + hstep + kstep, voffB);
        PG8_WAIT_V(6); PG8_BAR;
    } else {
        PG8_STAGE(PG8_SB(0, 0), cB, voffB); PG8_STAGE(PG8_SA(0, 0), cA, voffA); PG8_STAGE(PG8_SB(0, 1), cB + hstep, voffB); PG8_STAGE(PG8_SA(0, 1), cA + hstep, voffA);
        if (wr == 1) PG8_BAR;
        PG8_WAIT_V(4); PG8_BAR;
        PG8_STAGE(PG8_SB(1, 0), cB + kstep, voffB); PG8_STAGE(PG8_SA(1, 0), cA + kstep, voffA); PG8_STAGE(PG8_SB(1, 1), cB + hstep + kstep, voffB);
        PG8_WAIT_V(6); PG8_BAR;
    }
    for (;;) {
        const bool has_next = S.next(ui + 1, nxt);
        const char* nA = has_next ? (const char*)g.A + (size_t)nxt.pm * tstep : cA; const char* nB = has_next ? (const char*)g.Bt + (size_t)nxt.pn * tstep : cB;
        for (int t = 0; t < nt; t += 2) {
            const bool last = (t == nt - 2);
            const char* a1 = cA + (size_t)(t + 1) * kstep;
            const char* a2 = last ? nA : cA + (size_t)(t + 2) * kstep; const char* b2 = last ? nB : cB + (size_t)(t + 2) * kstep;
            const char* a3 = a2 + kstep; const char* b3 = b2 + kstep;
            if (last && has_next) S.a_ready(nxt);
            if constexpr (SP2) {
            PG8_LDB(B0, 0, 0); PG8_LDB(B1, 0, 1); PG8_SCHED; PG8_LDA(At, 0, 0); PG8_STAGE(PG8_SA(1, 1), a1 + hstep, voffA);
            PG8_WAIT_V(8); PG8_WAIT_L(0); PG8_BAR; PG8_MMA(0, 0, At, B0); PG8_MMA(0, 1, At, B1); PG8_BAR; PG8_SCHED;
            PG8_LDA(At, 0, 1); PG8_STAGE(PG8_SB(0, 0), b2, voffB); PG8_STAGE(PG8_SB(0, 1), b2 + hstep, voffB); PG8_STAGE(PG8_SA(0, 0), a2, voffA);
            PG8_WAIT_V(8); PG8_WAIT_L(0); PG8_BAR; PG8_MMA(1, 0, At, B0); PG8_MMA(1, 1, At, B1); PG8_BAR; PG8_SCHED;
            PG8_LDB(B0, 1, 0); PG8_LDB(B1, 1, 1); PG8_SCHED; PG8_LDA(At, 1, 0); PG8_STAGE(PG8_SA(0, 1), a2 + hstep, voffA);
            PG8_WAIT_V(8); PG8_WAIT_L(0); PG8_BAR; PG8_MMA(0, 0, At, B0); PG8_MMA(0, 1, At, B1); PG8_BAR; PG8_SCHED;
            PG8_LDA(At, 1, 1); PG8_STAGE(PG8_SB(1, 0), b3, voffB); PG8_STAGE(PG8_SB(1, 1), b3 + hstep, voffB); PG8_STAGE(PG8_SA(1, 0), a3, voffA);
            PG8_WAIT_V(8); PG8_WAIT_L(0); PG8_BAR; PG8_MMA(1, 0, At, B0); PG8_MMA(1, 1, At, B1); PG8_BAR; PG8_SCHED;
            } else {
            PG8_LDB(B0, 0, 0); PG8_SCHED; PG8_LDA(At, 0, 0); PG8_STAGE(PG8_SA(1, 1), a1 + hstep, voffA);
            PG8_WAIT_L(8); PG8_BAR; PG8_WAIT_L(0); PG8_MMA(0, 0, At, B0); PG8_BAR; PG8_SCHED;
            PG8_LDB(B1, 0, 1); PG8_STAGE(PG8_SB(0, 0), b2, voffB);
            PG8_BAR; PG8_WAIT_L(0); PG8_MMA(0, 1, At, B1); PG8_BAR;
            PG8_LDA(At, 0, 1); PG8_STAGE(PG8_SA(0, 0), a2, voffA);
            PG8_BAR; PG8_WAIT_L(0); PG8_MMA(1, 0, At, B0); PG8_BAR; PG8_SCHED;
            PG8_STAGE(PG8_SB(0, 1), b2 + hstep, voffB);
            PG8_WAIT_V(6); PG8_BAR; PG8_MMA(1, 1, At, B1); PG8_BAR;
            PG8_LDB(B0, 1, 0); PG8_SCHED; PG8_LDA(At, 1, 0); PG8_STAGE(PG8_SA(0, 1), a2 + hstep, voffA);
            PG8_WAIT_L(8); PG8_BAR; PG8_WAIT_L(0); PG8_MMA(0, 0, At, B0); PG8_BAR; PG8_SCHED;
            PG8_LDB(B1, 1, 1); PG8_STAGE(PG8_SB(1, 0), b3, voffB);
            PG8_BAR; PG8_WAIT_L(0); PG8_MMA(0, 1, At, B1); PG8_BAR;
            PG8_LDA(At, 1, 1); PG8_STAGE(PG8_SA(1, 0), a3, voffA);
            PG8_BAR; PG8_WAIT_L(0); PG8_MMA(1, 0, At, B0); PG8_BAR; PG8_SCHED;
            PG8_STAGE(PG8_SB(1, 1), b3 + hstep, voffB);
            PG8_WAIT_V(6); PG8_BAR; PG8_MMA(1, 1, At, B1); PG8_BAR;
            }
        }
        if constexpr (ALIGN_EPI) { if (wr == 0) PG8_BAR; }
        if constexpr (!Epi::AFTER_DRAIN) { E(acc, cur, wr, wc, fr, fq); S.done(cur); }
        if (!has_next) break;
#pragma unroll
        for (int a = 0; a < 2; ++a)
#pragma unroll
            for (int b = 0; b < 2; ++b)
#pragma unroll
                for (int m = 0; m < 4; ++m)
#pragma unroll
                    for (int n = 0; n < 2; ++n) acc[a][b][m][n] = (f32x4){0.f, 0.f, 0.f, 0.f};
        cur = nxt; cA = nA; cB = nB; ++ui;
        if constexpr (ALIGN_EPI) { if (wr == 1) PG8_BAR; }
    }
    PG8_WAIT_V(0);
    if constexpr (!ALIGN_EPI) { if (wr == 0) PG8_BAR; }
    PG8_BAR;
    if constexpr (Epi::AFTER_DRAIN) { E.fused(acc, cur, wr, wc, fr, fq, lds, wid, lane); S.done(cur); }
#undef PG8_SA
#undef PG8_SB
#undef PG8_STAGE
#undef PG8_LDA
#undef PG8_LDB
#undef PG8_MMA
#undef PG8_WAIT_V
#undef PG8_WAIT_L
#undef PG8_BAR
#undef PG8_SCHED
}
}
#define GAS __attribute__((address_space(1)))
#define LAS __attribute__((address_space(3)))
typedef unsigned short bf16;
typedef unsigned v4u __attribute__((ext_vector_type(4)));
typedef float f32x4 __attribute__((ext_vector_type(4)));
typedef short bf16x8 __attribute__((ext_vector_type(8)));
typedef GAS unsigned gu32;
typedef GAS unsigned long long gu64;
#define RLX_AGENT __ATOMIC_RELAXED, __HIP_MEMORY_SCOPE_AGENT
#define LDS_WAIT() asm volatile("s_waitcnt lgkmcnt(0)" ::: "memory")
#define VM_WAIT() asm volatile("s_waitcnt vmcnt(0)" ::: "memory")
__device__ __forceinline__ unsigned long long rt() { return __builtin_amdgcn_s_memrealtime(); }
__device__ __forceinline__ unsigned f2bf(float f) { unsigned u = __builtin_bit_cast(unsigned, f); return (u + 0x7fffu + ((u >> 16) & 1u)) >> 16; }
__device__ __forceinline__ unsigned pk2(float lo, float hi) { return f2bf(lo) | (f2bf(hi) << 16); }

#define XB_TMO      128
#define XB_XCNT(j)  (256  + 64 * (j))
#define XB_XSUB(j)  (1280 + 64 * (j))
#define XB_XGEN(j)  (2304 + 64 * (j))
#define XB_TOP      3328
#define XB_TOPGEN   3392
#define XCD_BAR_WORDS 3456
#define XB_SPIN_CAP (1u << 18)

__device__ __forceinline__ unsigned xb_ld(unsigned* p)              { return __hip_atomic_load(p, __ATOMIC_RELAXED, __HIP_MEMORY_SCOPE_AGENT); }
__device__ __forceinline__ unsigned xb_add(unsigned* p, unsigned v) { return __hip_atomic_fetch_add(p, v, __ATOMIC_RELAXED, __HIP_MEMORY_SCOPE_AGENT); }
__device__ __forceinline__ unsigned xb_xcc_id() { return (unsigned)__builtin_amdgcn_s_getreg((3 << 11) | 20) & 0xFu; }
#define XB_SPIN(cond, bar) do { unsigned _sp = 0; while (cond) { __builtin_amdgcn_s_sleep(1); \
    if ((++_sp & 255u) == 0u) { if (xb_ld(&(bar)[XB_TMO])) break; if (_sp > XB_SPIN_CAP) { atomicAdd(&(bar)[XB_TMO], 1u); break; } } } } while (0)

struct XcdBarrier {
    unsigned* bar; unsigned x; int wave;
    volatile LAS unsigned* st;
};

#define XB_IS_T0(wave) ((wave) == 0 && lane_fresh() == 0)
__device__ __forceinline__ XcdBarrier xcd_barrier_post(unsigned* bar, volatile LAS unsigned* st, int wave) {
    XcdBarrier b; b.bar = bar; b.x = xb_xcc_id(); b.st = st; b.wave = wave;
    if (XB_IS_T0(wave)) (void)xb_add(&bar[XB_XCNT(b.x)], 1u);
    return b;
}
__device__ __forceinline__ void xcd_barrier_complete(unsigned* bar, unsigned x, unsigned& nloc, unsigned& nx) {
    const unsigned G = gridDim.x * gridDim.y * gridDim.z;
    unsigned sum, cnt, mine, sp = 0u;
    for (;;) {
        sum = 0u; cnt = 0u; mine = 0u;
#pragma unroll
        for (unsigned j = 0; j < 16; ++j) { const unsigned c = xb_ld(&bar[XB_XCNT(j)]); sum += c; cnt += (c > 0u) ? 1u : 0u; mine = (j == x) ? c : mine; }
        if (sum == G) break;
        __builtin_amdgcn_s_sleep(1);
        if ((++sp & 255u) == 0u) { if (xb_ld(&bar[XB_TMO])) break; if (sp > XB_SPIN_CAP) { atomicAdd(&bar[XB_TMO], 1u); break; } }
    }
    nloc = mine > 0u ? mine : 1u; nx = cnt > 0u ? cnt : 1u;
}

__device__ __forceinline__ void xcd_barrier(const XcdBarrier& b) {
    asm volatile("s_waitcnt vmcnt(0)" ::: "memory");
    __syncthreads();
    if (XB_IS_T0(b.wave)) {
        unsigned* bar = b.bar;
        __builtin_amdgcn_s_waitcnt(0);
        unsigned nloc = b.st[0], nx = b.st[1];
        if (nloc == 0u) { xcd_barrier_complete(bar, b.x, nloc, nx); b.st[0] = nloc; b.st[1] = nx; }
        const unsigned old = xb_add(&bar[XB_XSUB(b.x)], 1u);
        const unsigned gen = old / nloc;
        if (old + 1u == (gen + 1u) * nloc) {
            __builtin_amdgcn_fence(__ATOMIC_RELEASE, "agent");
            asm volatile("s_waitcnt vmcnt(0)" ::: "memory");
            const unsigned og = xb_add(&bar[XB_TOP], 1u);
            const unsigned tg = og / nx;
            if (og + 1u == (tg + 1u) * nx) xb_add(&bar[XB_TOPGEN], 1u);
            else XB_SPIN(xb_ld(&bar[XB_TOPGEN]) == tg, bar);
            __builtin_amdgcn_fence(__ATOMIC_ACQUIRE, "agent");
            xb_add(&bar[XB_XGEN(b.x)], 1u);
            asm volatile("s_waitcnt vmcnt(0)" ::: "memory");
        } else {
            XB_SPIN(xb_ld(&bar[XB_XGEN(b.x)]) == gen, bar);
            __builtin_amdgcn_fence(__ATOMIC_ACQUIRE, "agent");
            asm volatile("s_waitcnt vmcnt(0)" ::: "memory");
        }
    }
    __syncthreads();
}
namespace mk {
constexpr int D = 1024, NB = 8, SEQ = 2048, NMETA = 16, T = SEQ + NMETA, NS = 32, PAST = 16384, PAGE = 128, NPAGES = PAST / PAGE;
constexpr int FFN = 2816, NH = 8, QR = 384, KVR = 256, RH = 4, RDK = 128, RDV = 256, IN_DIM = 5792;
constexpr int O_CQ = 0, O_CKV = 384, O_KR = 640, O_RQ = 672, O_RK = 1184, O_RV = 1696, O_RG = 2720, O_GA = 3744, O_GB = 4768;
constexpr int MMAIN = NB * SEQ;
constexpr int ROW_META = MMAIN;
constexpr int ROW_SMP = MMAIN + NMETA;
constexpr int ROW_PAD = ROW_SMP + NS;
constexpr int MP = MMAIN + 256;
constexpr int NWIN = 5888;
constexpr int NPOS = T + 1;
constexpr float EPS = 1e-6f;
constexpr int NWAVES = 8;

constexpr size_t MiB = 1u << 20;
constexpr size_t al(size_t x) { return (x + 255) / 256 * 256; }
constexpr size_t WS_CTL = 0, CTL_ZERO_BYTES = 1 * MiB;
constexpr size_t WS_W1T = 1 * MiB;
constexpr size_t WS_W1D = WS_W1T + al((size_t)2 * FFN * D * 2);
constexpr size_t WS_WIN = WS_W1D + al((size_t)D * FFN * 2);
constexpr size_t WS_WUQ = WS_WIN + al((size_t)NWIN * D * 2);
constexpr size_t WS_WUK = WS_WUQ + al((size_t)768 * QR * 2);
constexpr size_t WS_WUV = WS_WUK + al((size_t)512 * KVR * 2);
constexpr size_t WS_WMO = WS_WUV + al((size_t)512 * KVR * 2);
constexpr size_t WS_WRO = WS_WMO + al((size_t)D * 512 * 2);
constexpr size_t WS_WOUT = WS_WRO + al((size_t)D * D * 2);
constexpr size_t WS_W2T = WS_WOUT + al((size_t)D * D * 2);
constexpr size_t WS_W2D = WS_W2T + al((size_t)2 * FFN * D * 2);
constexpr size_t WS_WQL = WS_W2D + al((size_t)D * FFN * 2);
constexpr size_t WS_TAB = WS_WQL + al((size_t)2048 * QR * 2);
constexpr size_t TAB_C64 = 0, TAB_S64 = (size_t)NPOS * 64 * 4, TAB_C16 = 2 * TAB_S64, TAB_S16 = TAB_C16 + (size_t)NPOS * 16 * 4, TAB_GP = TAB_S16 + (size_t)NPOS * 16 * 4, TAB_GN = TAB_GP + 512 * 4, TAB_END = TAB_GN + 512 * 4;
constexpr size_t WS_XB = WS_TAB + al(TAB_END);
constexpr size_t WS_XE = WS_XB + al((size_t)MP * D * 2);
constexpr size_t WS_R1 = WS_XE + al((size_t)256 * D * 4);
constexpr size_t WS_ACT = WS_R1 + al((size_t)MP * 4);
constexpr size_t WS_H = WS_ACT + al((size_t)MP * FFN * 2);
constexpr size_t WS_HB = WS_H + al((size_t)MP * D * 4);
constexpr size_t WS_SSQH = WS_HB + al((size_t)MP * D * 2);
constexpr size_t WS_SSQ2_ = WS_SSQH + al((size_t)MP * 4), WS_SSQ3_ = WS_SSQ2_ + al((size_t)MP * 4);
constexpr size_t WS_END1 = WS_SSQH + al((size_t)MP * 16 * 4);

constexpr int CW_XCNT = 32768  , CW_BAR = 4096, CW_QUEUE = 64, CW_DCNT = 24576  ;

constexpr int RING_OFF = 0, RING_BYTES = 131072, SCR_BYTES = 155648  , LDSCTL_OFF = SCR_BYTES, MISC_OFF = LDSCTL_OFF + 320, LDS_BYTES = 163840;

struct Args {
    const float* in[27]; float* out; unsigned char* ws;
};

struct Frame {
    LAS unsigned char* lds;
    volatile LAS unsigned* MISC;
    int wave, vcu, G;
};

constexpr int PT_OFF = MISC_OFF + 256;
struct Ptrs {
    unsigned char* ws; volatile LAS unsigned* tab;
    __device__ __forceinline__ unsigned long long raw(int k) const { volatile LAS unsigned* t = tab; asm volatile("" : "+v"(t));
        const unsigned lo = __builtin_amdgcn_readfirstlane(t[2 * k]), hi = __builtin_amdgcn_readfirstlane(t[2 * k + 1]); return ((unsigned long long)hi << 32) | lo; }
    __device__ __forceinline__ const float* in(int k) const { return (const float*)(GAS const float*)raw(k); }
    __device__ __forceinline__ float* out() const { return (float*)(GAS float*)raw(27); }
};
__device__ __forceinline__ int fresh_tid(int wave) { int t = lane_fresh() + 64 * wave; asm volatile("" : "+v"(t)); return t; }

__device__ __forceinline__ float lx(float v, int lane, int mask) { return __int_as_float(__builtin_amdgcn_ds_bpermute((lane ^ mask) << 2, __float_as_int(v))); }
__device__ __forceinline__ float wave_sum(float v, int lane) {
#pragma unroll
    for (int o = 1; o < 64; o <<= 1) v += lx(v, lane, o);
    return v;
}
__device__ __forceinline__ int row_pos(int row) { return row < MMAIN ? (row & (SEQ - 1)) + NMETA : (row < ROW_SMP ? row - ROW_META : (row < ROW_PAD ? PAST : 0)); }
__device__ __forceinline__ int row_pidx(int row) { return row < MMAIN ? (row & (SEQ - 1)) + NMETA : (row < ROW_SMP ? row - ROW_META : (row < ROW_PAD ? T : 0)); }
__device__ __forceinline__ int row_jtok(int row) { return row < MMAIN ? (row & 127) : (row < ROW_SMP ? row - ROW_META : 0); }

struct WSrc { const float* W; int ld; int col0; const float* g; };
__device__ __forceinline__ void wmat_dims(int id, int& K, int& ngrp) {
    switch (id) {
        case 0: case 9: K = D; ngrp = 2 * FFN / 32; break;
        case 1: case 10: K = FFN; ngrp = D / 32; break;
        case 2: K = D; ngrp = NWIN / 32; break;
        case 3: K = QR; ngrp = 768 / 32; break;
        case 4: case 5: K = KVR; ngrp = 512 / 32; break;
        case 6: K = 512; ngrp = D / 32; break;
        default: K = D; ngrp = D / 32; break;
    }
}
__device__ __forceinline__ size_t wmat_off(int id) {
    switch (id) { case 0: return WS_W1T; case 1: return WS_W1D; case 2: return WS_WIN; case 3: return WS_WUQ; case 4: return WS_WUK; case 5: return WS_WUV;
                  case 6: return WS_WMO; case 7: return WS_WRO; case 8: return WS_WOUT; case 9: return WS_W2T; default: return WS_W2D; }
}
__device__ __forceinline__ WSrc wmat_src(const Args& a, int id, int g) {
    WSrc s; s.W = nullptr; s.ld = 0; s.col0 = 0; s.g = nullptr;
    switch (id) {
        case 0: case 9: { const int pn = g >> 3, gg = g & 7; const int o = id == 0 ? 7 : 22;
            s.W = gg < 4 ? a.in[o + 1] : a.in[o + 2]; s.ld = FFN; s.col0 = 128 * pn + 32 * (gg & 3); s.g = a.in[o]; break; }
        case 1: s.W = a.in[10]; s.ld = D; s.col0 = 32 * g; break;
        case 10: s.W = a.in[25]; s.ld = D; s.col0 = 32 * g; break;
        case 2: { s.ld = IN_DIM; s.g = a.in[11]; int zc = -1;
            if (g < 8) zc = 32 * g;
            else if (g < 16) { const int gg = g - 8; zc = gg < 4 ? 256 + 32 * gg : (gg == 4 ? O_KR : -1); }
            else if (g < 24) zc = O_CKV + 32 * (g - 16);
            else if (g < 56) { const int base = g < 40 ? O_RQ : O_RK; const int q = (g - 24) & 15, t = q >> 3, gg = q & 7;
                const int h = 2 * t + ((gg >> 1) & 1), part = (gg >> 2) * 64 + (gg & 1) * 32; zc = base + h * 128 + part; }
            else if (g < 88) zc = O_RV + 32 * (g - 56);
            else if (g < 120) zc = O_RG + 32 * (g - 88);
            else if (g < 152) zc = O_GA + 32 * (g - 120);
            else zc = O_GB + 32 * (g - 152);
            if (zc >= 0) { s.W = a.in[12]; s.col0 = zc; }
            break; }
        case 3: s.W = a.in[15]; s.ld = 768; s.col0 = 32 * g; s.g = a.in[13]; break;
        case 4: s.W = a.in[16]; s.ld = 512; s.col0 = 32 * g; s.g = a.in[14]; break;
        case 5: s.W = a.in[17]; s.ld = 512; s.col0 = 32 * g; s.g = a.in[14]; break;
        case 6: s.W = a.in[18]; s.ld = D; s.col0 = 32 * g; break;
        case 7: s.W = a.in[20]; s.ld = D; s.col0 = 32 * g; break;
        default: s.W = a.in[21]; s.ld = D; s.col0 = 32 * g; break;
    }
    return s;
}
__device__ __forceinline__ void p0_transpose_item(const WSrc s, int K, bf16* WT, int n0, int k0, LAS float* scr, int lane) {
    if (s.W) {
        float v[32];
        const float* wp = s.W + (size_t)(k0 + (lane >> 5)) * s.ld + s.col0 + (lane & 31);
#pragma unroll
        for (int i = 0; i < 32; ++i) v[i] = wp[(size_t)(2 * i) * s.ld];
        if (s.g) { const float* gp = s.g + k0 + (lane >> 5);
#pragma unroll
            for (int i = 0; i < 32; ++i) v[i] *= gp[2 * i]; }
#pragma unroll
        for (int i = 0; i < 32; ++i) scr[(2 * i + (lane >> 5)) * 33 + (lane & 31)] = v[i];
    } else {
#pragma unroll 8
        for (int i = 0; i < 32; ++i) { const int kk = 2 * i + (lane >> 5); scr[kk * 33 + (lane & 31)] = 0.f; }
    }
    LDS_WAIT(); asm volatile("" ::: "memory");
    const int c = lane & 7;
#pragma unroll
    for (int j = 0; j < 4; ++j) { const int n = (lane >> 3) + 8 * j; const LAS float* sp = scr + (8 * c) * 33 + n;
        v4u o; o.x = pk2(sp[0 * 33], sp[1 * 33]); o.y = pk2(sp[2 * 33], sp[3 * 33]); o.z = pk2(sp[4 * 33], sp[5 * 33]); o.w = pk2(sp[6 * 33], sp[7 * 33]);
        *(GAS v4u*)(WT + (size_t)(n0 + n) * K + k0 + 8 * c) = o; }
    LDS_WAIT(); asm volatile("" ::: "memory");
}
__device__ __forceinline__ const float* x_src(const Args& a, int row) {
    if (row < MMAIN) return a.in[0] + (size_t)row * D;
    if (row < ROW_SMP) return a.in[6] + (size_t)(row - ROW_META) * D;
    if (row < ROW_PAD) return a.in[1] + (size_t)(row - ROW_SMP) * D;
    return nullptr;
}
__device__ __forceinline__ void p0_weights(const Args& a, unsigned id_mask, int gw, int NGW, LAS float* scr, int lane) {
    unsigned char* ws = a.ws;
    int base = 0;
#pragma unroll 1
    for (int id = 0; id < 11; ++id) {
        if (!((id_mask >> id) & 1u)) continue;
        int K, ngrp; wmat_dims(id, K, ngrp);
        const int nk = K / 64, nitems = nk * ngrp;
        bf16* WT = (bf16*)(ws + wmat_off(id));
        int first = (gw - (base % NGW) + NGW) % NGW;
        for (int it = first; it < nitems; it += NGW) { const int g = it % ngrp, kb = it / ngrp; p0_transpose_item(wmat_src(a, id, g), K, WT, 32 * g, 64 * kb, scr, lane); }
        base += nitems;
    }
}
__device__ __forceinline__ void p0_weights_late(Frame& F, const Args& a) {
    const int bx = (int)blockIdx.x; if (bx < 188) return;
    const int lane = fresh_tid(F.wave) & 63;
    LAS float* scr = (LAS float*)(F.lds + RING_OFF + F.wave * 16384);
    p0_weights(a, 0x380u  , (bx - 188) * NWAVES + F.wave, 68 * NWAVES, scr, lane);
    __syncthreads();
}
__device__ __forceinline__ void p0_prologue(Frame& F, const Args& a) {
    const int lane = fresh_tid(F.wave) & 63;
    LAS float* scr = (LAS float*)(F.lds + RING_OFF + F.wave * 16384);
    const int gw = F.vcu * NWAVES + F.wave, NGW = F.G * NWAVES;
    unsigned char* ws = a.ws;
    p0_weights(a, 0x47Fu  , gw, NGW, scr, lane);
    bf16* XB = (bf16*)(ws + WS_XB); float* XE = (float*)(ws + WS_XE); float* R1 = (float*)(ws + WS_R1);
    for (int m0 = gw; m0 < MP; m0 += 2 * NGW) {
        f32x4 v[2][4];
#pragma unroll
        for (int t = 0; t < 2; ++t) { const int m = m0 + t * NGW; const float* xr = m < MP ? x_src(a, m) : nullptr;
#pragma unroll
            for (int j = 0; j < 4; ++j) v[t][j] = xr ? *((const GAS f32x4*)xr + lane + 64 * j) : (f32x4){0.f, 0.f, 0.f, 0.f}; }
#pragma unroll
        for (int t = 0; t < 2; ++t) { const int m = m0 + t * NGW; if (m >= MP) break;
            float s = 0.f;
#pragma unroll
            for (int j = 0; j < 4; ++j) s += (v[t][j].x * v[t][j].x + v[t][j].y * v[t][j].y) + (v[t][j].z * v[t][j].z + v[t][j].w * v[t][j].w);
            s = wave_sum(s, lane);
            if (lane == 0) R1[m] = 1.0f / sqrtf(s * (1.f / D) + EPS);
            GAS unsigned long long* o8 = (GAS unsigned long long*)(XB + (size_t)m * D) + lane;
#pragma unroll
            for (int j = 0; j < 4; ++j) o8[64 * j] = (unsigned long long)pk2(v[t][j].x, v[t][j].y) | ((unsigned long long)pk2(v[t][j].z, v[t][j].w) << 32);
            if (m >= MMAIN) {
#pragma unroll
                for (int j = 0; j < 4; ++j) *((GAS f32x4*)(XE + (size_t)(m - MMAIN) * D) + lane + 64 * j) = v[t][j];
            } }
    }
    {   const float* wuq = a.in[15]; const float* wuk = a.in[16]; const float* qn = a.in[13]; bf16* WQL = (bf16*)(ws + WS_WQL);
        LAS float* U = (LAS float*)(F.lds + RING_OFF);
        const int tid = F.wave * 64 + lane;
        for (int it = F.vcu; it < 256; it += F.G) {
            const int h = it >> 5, r0 = (it & 31) * 8;
            __syncthreads();
            for (int e = tid; e < QR * 64; e += NWAVES * 64) { const int k = e >> 6, n = e & 63; U[k * 65 + n] = wuq[(size_t)k * 768 + h * 96 + n]; }
            { const int rr = tid >> 6, n = tid & 63; U[QR * 65 + rr * 64 + n] = wuk[(size_t)(r0 + rr) * 512 + h * 64 + n]; }
            __syncthreads();
            if (tid < QR) { const float g = qn[tid]; float acc[8];
#pragma unroll
                for (int rr = 0; rr < 8; ++rr) acc[rr] = 0.f;
                for (int n = 0; n < 64; ++n) { const float u = U[tid * 65 + n];
#pragma unroll
                    for (int rr = 0; rr < 8; ++rr) acc[rr] += u * U[QR * 65 + rr * 64 + n]; }
#pragma unroll
                for (int rr = 0; rr < 8; ++rr) WQL[(size_t)(h * 256 + r0 + rr) * QR + tid] = (bf16)f2bf(acc[rr] * g); }
        }
        __syncthreads();
    }
    { const int gt_ = (F.vcu * NWAVES + F.wave) * 64 + lane, NGT_ = NGW * 64;
      for (int e = gt_; e < MP; e += NGT_) { ((float*)(ws + WS_SSQH))[e] = 0.f; ((float*)(ws + WS_SSQ2_))[e] = 0.f; ((float*)(ws + WS_SSQ3_))[e] = 0.f; } }
    float* TAB = (float*)(ws + WS_TAB);
    const int gt = (F.vcu * NWAVES + F.wave) * 64 + lane, NGT = NGW * 64;
    for (int e = gt; e < NPOS * 64; e += NGT) { const int p = e >> 6, i = e & 63; const int pos = p < T ? p : PAST;
        const float invf = (float)pow(10000.0, -(double)i / 64.0); const float ang = (float)pos * invf;
        TAB[TAB_C64 / 4 + e] = (float)cos((double)ang); TAB[TAB_S64 / 4 + e] = (float)sin((double)ang); }
    for (int e = gt; e < NPOS * 16; e += NGT) { const int p = e >> 4, i = e & 15; const int pos = p < T ? p : PAST;
        const float invf = (float)pow(10000.0, -(double)i / 16.0); const float ang = (float)pos * invf;
        TAB[TAB_C16 / 4 + e] = (float)cos((double)ang); TAB[TAB_S16 / 4 + e] = (float)sin((double)ang); }
    for (int e = gt; e < 512; e += NGT) { const int h = e >> 7, j = e & 127; const double lg = log1p(-exp2(-5.0 - (double)h));
        TAB[TAB_GP / 4 + e] = (float)exp(lg * (double)j); TAB[TAB_GN / 4 + e] = (float)exp(-lg * (double)j); }
}

using pg8::f32x4; using pg8::u32x4; using pg8::Unit; using pg8::BM; using pg8::HALF;
typedef unsigned u32x2 __attribute__((ext_vector_type(2)));
__device__ __forceinline__ float fast_sigmoid(float x) { return __builtin_amdgcn_rcpf(1.f + __builtin_amdgcn_exp2f(-1.4426950408889634f * x)); }
__device__ __forceinline__ float fast_silu(float x) { return x * fast_sigmoid(x); }

struct EpiSwiGLU {
    static constexpr bool PERM = true, AFTER_DRAIN = false;
    bf16* ACT; const float* rs;
    __device__ __forceinline__ void operator()(const f32x4 (&acc)[2][2][4][2], const Unit& u, int wr, int wc, int fr, int fq) const {
        int l_ = lane_fresh(); asm volatile("" : "+v"(l_)); fr = l_ & 15; fq = l_ >> 4;
        const int row0 = u.pm * BM + wr * 64 + fr, col0 = u.pn * HALF + wc * 32 + 8 * fq;
#pragma unroll
        for (int ai = 0; ai < 2; ++ai)
#pragma unroll
            for (int m = 0; m < 4; ++m) { const int row = row0 + ai * HALF + m * 16; const float r = rs[row];
                f32x4 o[2];
#pragma unroll
                for (int n = 0; n < 2; ++n)
#pragma unroll
                    for (int j = 0; j < 4; ++j) { const float g = acc[ai][0][m][n][j] * r, up = acc[ai][1][m][n][j] * r; o[n][j] = fast_silu(g) * up; }
                u32x4 w; w.x = pg8::cvt_pk_bf16(o[0][0], o[0][1]); w.y = pg8::cvt_pk_bf16(o[0][2], o[0][3]); w.z = pg8::cvt_pk_bf16(o[1][0], o[1][1]); w.w = pg8::cvt_pk_bf16(o[1][2], o[1][3]);
                *(u32x4*)(ACT + (size_t)row * FFN + col0) = w; }
    }
};
template <class T> __device__ __forceinline__ T* at(unsigned char* w, unsigned byte_off) { return (T*)(w + byte_off); }
template <unsigned RES_OFF, bool RES_X, unsigned OUT_OFF, unsigned OUTB_OFF, unsigned SSQ_OFF, int SCALE2  > struct EpiResid {
    static constexpr bool PERM = false, AFTER_DRAIN = false;
    unsigned char* ws_; const float* xin;
    __device__ __forceinline__ void operator()(const f32x4 (&acc)[2][2][4][2], const Unit& u, int wr, int wc, int fr, int fq) const {
        int l_ = lane_fresh(); asm volatile("" : "+v"(l_)); fr = l_ & 15; fq = l_ >> 4;
        unsigned char* w = opaque_g(ws_);
        const unsigned row0 = u.pm * BM + wr * 64 + fr, col0 = u.pn * BM + wc * 32 + 4 * fq;
        constexpr float scale = 0.5f * SCALE2;
#pragma unroll
        for (int ai = 0; ai < 2; ++ai)
#pragma unroll
            for (int m = 0; m < 4; ++m) { unsigned row = row0 + ai * HALF + m * 16; asm volatile("" : "+v"(row));
                const float* rp;
                if (RES_X) rp = row < (unsigned)MMAIN ? xin + row * D + col0 : at<const float>(w, RES_OFF + ((row - MMAIN) * D + col0) * 4);
                else rp = at<const float>(w, RES_OFF + (row * D + col0) * 4);
                float ss = 0.f;
#pragma unroll
                for (int bj = 0; bj < 2; ++bj)
#pragma unroll
                    for (int n = 0; n < 2; ++n) { const f32x4 b = *(const f32x4*)(rp + bj * HALF + n * 16); const f32x4 o = b + acc[ai][bj][m][n] * scale;
                        const unsigned e = row * D + col0 + bj * HALF + n * 16;
                        *at<f32x4>(w, OUT_OFF + e * 4) = o;
                        ss += (o[0] * o[0] + o[1] * o[1]) + (o[2] * o[2] + o[3] * o[3]);
                        if (OUTB_OFF) { u32x2 pk; pk.x = pg8::cvt_pk_bf16(o[0], o[1]); pk.y = pg8::cvt_pk_bf16(o[2], o[3]); *at<u32x2>(w, OUTB_OFF + e * 2) = pk; } }
                ss += lx(ss, l_, 16); ss += lx(ss, l_, 32);
                if (fq == 0) atomicAdd(at<float>(w, SSQ_OFF + row * 4), ss);
                asm volatile("" ::: "memory"); }
    }
};
}
namespace mk {
constexpr size_t WS_CQ = WS_END1;
constexpr size_t WS_SSQCQ = WS_CQ + al((size_t)MP * QR * 2);
constexpr size_t WS_CKVF = WS_SSQCQ + al((size_t)MP * 8 * 4);
constexpr size_t WS_CKVB = WS_CKVF + al((size_t)MP * KVR * 4);
constexpr size_t WS_SSQKV = WS_CKVB + al((size_t)MP * KVR * 2);
constexpr size_t WS_KRB = WS_SSQKV + al((size_t)MP * 4 * 4);
constexpr size_t WS_RQ = WS_KRB + al((size_t)MP * 32 * 2);
constexpr size_t WS_RK = WS_RQ + al((size_t)MP * 512 * 2);
constexpr size_t WS_RKT = WS_RK + al((size_t)MP * 512 * 2);
constexpr size_t WS_RVT = WS_RKT + al((size_t)MP * 512 * 2);
constexpr size_t WS_SRG = WS_RVT + al((size_t)MP * 1024 * 2);
constexpr size_t WS_SGA = WS_SRG + al((size_t)MP * 1024 * 2);
constexpr size_t WS_SGB = WS_SGA + al((size_t)MP * 1024 * 2);
constexpr size_t WS_QA = WS_SGB + al((size_t)MP * 1024 * 2);
constexpr size_t WS_KN = WS_QA + al((size_t)MP * 768 * 2);
constexpr size_t WS_VT = WS_KN + al((size_t)MP * 512 * 2);
constexpr size_t WS_KRF = WS_VT + al((size_t)MP * 512 * 2);
constexpr size_t WS_END2 = WS_KRF + al((size_t)MP * 32 * 4);
constexpr float SC_Q = 0.14724444348433683f;
constexpr float RK_SCALE = 0.08838834764831845f;

constexpr size_t OUT_YP = 0, OUT_YS = OUT_YP + (size_t)NB * SEQ * D, OUT_CKVP = OUT_YS + (size_t)NS * D, OUT_KRP = OUT_CKVP + (size_t)NB * T * KVR,
                 OUT_SRP = OUT_KRP + (size_t)NB * T * 32, OUT_CKVS = OUT_SRP + (size_t)NB * RH * RDK * RDV, OUT_KRS = OUT_CKVS + (size_t)NS * KVR, OUT_SRS = OUT_KRS + (size_t)NS * 32,
                 OUT_END = OUT_SRS + (size_t)NS * RH * RDK * RDV;

__device__ __forceinline__ float row_rscale16(const float* SSQ, int row, float inv_n) { return 1.0f / sqrtf(SSQ[row] * inv_n + EPS); }
__device__ __forceinline__ float row_rscale8(const float* SSQ, int row, float inv_n) {
    const f32x4* p = (const f32x4*)(SSQ + (size_t)row * 8); const f32x4 a = p[0], b = p[1];
    return 1.0f / sqrtf((((a[0] + a[1]) + (a[2] + a[3])) + ((b[0] + b[1]) + (b[2] + b[3]))) * inv_n + EPS);
}
__device__ __forceinline__ float row_rscale4(const float* SSQ, int row, float inv_n) {
    const f32x4 a = *(const f32x4*)(SSQ + (size_t)row * 4);
    return 1.0f / sqrtf(((a[0] + a[1]) + (a[2] + a[3])) * inv_n + EPS);
}
__device__ __forceinline__ u32x2 pack4(const f32x4 v) { u32x2 w; w.x = pg8::cvt_pk_bf16(v[0], v[1]); w.y = pg8::cvt_pk_bf16(v[2], v[3]); return w; }
__device__ __forceinline__ float ssq4(const f32x4 v) { return (v[0] * v[0] + v[1] * v[1]) + (v[2] * v[2] + v[3] * v[3]); }
__device__ __forceinline__ bf16 bf1(float x) { return (bf16)f2bf(x); }

static_assert(WS_END2 < ((size_t)1 << 31), "32-bit workspace offsets");
__device__ __forceinline__ void tr_store16(LAS unsigned char* T, int fr, int fq, int lane, const f32x4 (&v)[4], unsigned char* w, unsigned dst_off) {
#pragma unroll
    for (int m = 0; m < 4; ++m)
#pragma unroll
        for (int j = 0; j < 4; ++j) *(LAS bf16*)(T + (4 * fq + j) * 144 + (16 * m + fr) * 2) = bf1(v[m][j]);
    asm volatile("s_waitcnt lgkmcnt(0)" ::: "memory");
#pragma unroll
    for (int k = 0; k < 2; ++k) { const int id = lane + 64 * k, c = id >> 3, part = id & 7; const v4u x = *(const LAS v4u*)(T + c * 144 + part * 16); *at<v4u>(w, dst_off + (unsigned)(((c >> 2) * 8 + (c & 3)) * MP + 8 * part) * 2u) = x; }
    asm volatile("s_waitcnt lgkmcnt(0)" ::: "memory");
}
constexpr int EPI_LDS_OFF = RING_BYTES, EPI_LDS_WAVE = 3072;
static_assert(EPI_LDS_OFF + 8 * EPI_LDS_WAVE <= SCR_BYTES && 16 * 144 <= EPI_LDS_WAVE, "epilogue LDS scratch");
__device__ __forceinline__ u32x4 pack8(const f32x4 a, const f32x4 b) { u32x4 w; w.x = pg8::cvt_pk_bf16(a[0], a[1]); w.y = pg8::cvt_pk_bf16(a[2], a[3]); w.z = pg8::cvt_pk_bf16(b[0], b[1]); w.w = pg8::cvt_pk_bf16(b[2], b[3]); return w; }
struct EpiWin {
    static constexpr bool PERM = true, AFTER_DRAIN = false;
    unsigned char* ws_; LAS unsigned char* lds_;
#define MK_WS(var) unsigned char* var = opaque_g(ws_)
#define MK_ROWS_BEGIN _Pragma("unroll") for (int ai = 0; ai < 2; ++ai) _Pragma("unroll") for (int m = 0; m < 4; ++m) { \
        unsigned row = row0 + ai * HALF + m * 16; asm volatile("" : "+v"(row)); const float r = rsc[ai * 4 + m];
#define MK_ROWS_END asm volatile("" ::: "memory"); }
    __device__ __forceinline__ void operator()(const f32x4 (&acc)[2][2][4][2], const Unit& u, int wr, int wc, int fr, int fq) const {
        int l_ = lane_fresh(); asm volatile("" : "+v"(l_)); fr = l_ & 15; fq = l_ >> 4;
        const unsigned row0 = u.pm * BM + wr * 64 + fr; const int pn = u.pn;
        const unsigned c8 = wc * 32 + 8 * fq;
        MK_WS(w);
        float rsc[8];
#pragma unroll
        for (int k = 0; k < 8; ++k) rsc[k] = row_rscale16(at<const float>(w, (unsigned)WS_SSQH), (int)(row0 + (k >> 2) * HALF + (k & 3) * 16), 1.f / D);
        if (pn == 0) {
            MK_ROWS_BEGIN
                float ss = 0.f;
#pragma unroll
                for (int bj = 0; bj < 2; ++bj) { const f32x4 v0 = acc[ai][bj][m][0] * r, v1 = acc[ai][bj][m][1] * r; ss += ssq4(v0) + ssq4(v1); *at<u32x4>(w, (unsigned)WS_CQ + (row * QR + bj * HALF + c8) * 2) = pack8(v0, v1); }
                ss += lx(ss, l_, 16); ss += lx(ss, l_, 32);
                if (fq == 0) *at<float>(w, (unsigned)WS_SSQCQ + (row * 8 + wc) * 4) = ss;
            MK_ROWS_END
        } else if (pn == 1) {
            MK_ROWS_BEGIN
                const f32x4 v0 = acc[ai][0][m][0] * r, v1 = acc[ai][0][m][1] * r;
                float ss = ssq4(v0) + ssq4(v1);
                *at<u32x4>(w, (unsigned)WS_CQ + (row * QR + 256 + c8) * 2) = pack8(v0, v1);
                ss += lx(ss, l_, 16); ss += lx(ss, l_, 32);
                if (fq == 0) *at<float>(w, (unsigned)WS_SSQCQ + (row * 8 + 4 + wc) * 4) = ss;
                if (wc == 0) {
                    const f32x4 a0 = acc[ai][1][m][0] * r, a1 = acc[ai][1][m][1] * r;
                    f32x4 p0, p1;
#pragma unroll
                    for (int j = 0; j < 4; ++j) { p0[j] = lx(a0[j], l_, 32); p1[j] = lx(a1[j], l_, 32); }
                    const unsigned pi = row_pidx((int)row), i0 = 8 * (fq & 1);
                    const f32x4 c0 = *at<const f32x4>(w, (unsigned)(WS_TAB + TAB_C16) + (pi * 16 + i0) * 4), c1 = *at<const f32x4>(w, (unsigned)(WS_TAB + TAB_C16) + (pi * 16 + i0 + 4) * 4);
                    const f32x4 s0 = *at<const f32x4>(w, (unsigned)(WS_TAB + TAB_S16) + (pi * 16 + i0) * 4), s1 = *at<const f32x4>(w, (unsigned)(WS_TAB + TAB_S16) + (pi * 16 + i0 + 4) * 4);
                    const f32x4 y0 = fq < 2 ? a0 * c0 - p0 * s0 : p0 * s0 + a0 * c0, y1 = fq < 2 ? a1 * c1 - p1 * s1 : p1 * s1 + a1 * c1;
                    *at<u32x4>(w, (unsigned)WS_KRB + (row * 32 + 8 * fq) * 2) = pack8(y0, y1);
                    *at<f32x4>(w, (unsigned)WS_KRF + (row * 32 + 8 * fq) * 4) = y0; *at<f32x4>(w, (unsigned)WS_KRF + (row * 32 + 8 * fq + 4) * 4) = y1;
                }
            MK_ROWS_END
        } else if (pn == 2) {
            MK_ROWS_BEGIN
                float ss = 0.f;
#pragma unroll
                for (int bj = 0; bj < 2; ++bj) { const f32x4 v0 = acc[ai][bj][m][0] * r, v1 = acc[ai][bj][m][1] * r; ss += ssq4(v0) + ssq4(v1); const unsigned e = row * KVR + bj * HALF + c8;
                    *at<f32x4>(w, (unsigned)WS_CKVF + e * 4) = v0; *at<f32x4>(w, (unsigned)WS_CKVF + (e + 4) * 4) = v1; *at<u32x4>(w, (unsigned)WS_CKVB + e * 2) = pack8(v0, v1); }
                ss += lx(ss, l_, 16); ss += lx(ss, l_, 32);
                if (fq == 0) *at<float>(w, (unsigned)WS_SSQKV + (row * 4 + wc) * 4) = ss;
            MK_ROWS_END
        } else if (pn < 7) {
            const bool isk = pn >= 5; const unsigned hh = 2 * ((pn - 3) & 1) + (wc >> 1), i0 = 32 * (wc & 1) + 8 * fq;
            const unsigned dbase = (unsigned)(isk ? WS_RK : WS_RQ) + hh * 256, gbase = (unsigned)(WS_TAB + (isk ? TAB_GN : TAB_GP)) + hh * 512;
            LAS unsigned char* T = lds_ + EPI_LDS_OFF + (wr * 4 + wc) * EPI_LDS_WAVE;
#pragma unroll
            for (int ai = 0; ai < 2; ++ai) {
                f32x4 y1s[2][4], y2s[2][4];
#pragma unroll
                for (int m = 0; m < 4; ++m) {
                    unsigned row = row0 + ai * HALF + m * 16; asm volatile("" : "+v"(row)); const float r = rsc[ai * 4 + m];
                    const unsigned pi = row_pidx((int)row), jt = row_jtok((int)row);
                    const float mult = *at<const float>(w, gbase + jt * 4) * (isk ? RK_SCALE : 1.f);
#pragma unroll
                    for (int n = 0; n < 2; ++n) {
                        const f32x4 x1 = acc[ai][0][m][n] * r, x2 = acc[ai][1][m][n] * r;
                        const f32x4 c = *at<const f32x4>(w, (unsigned)(WS_TAB + TAB_C64) + (pi * 64 + i0 + 4 * n) * 4), s = *at<const f32x4>(w, (unsigned)(WS_TAB + TAB_S64) + (pi * 64 + i0 + 4 * n) * 4);
                        y1s[n][m] = (x1 * c - x2 * s) * mult; y2s[n][m] = (x1 * s + x2 * c) * mult; }
                    *at<u32x4>(w, dbase + (row * 512 + i0) * 2) = pack8(y1s[0][m], y1s[1][m]); *at<u32x4>(w, dbase + (row * 512 + 64 + i0) * 2) = pack8(y2s[0][m], y2s[1][m]);
                    asm volatile("" ::: "memory");
                }
                if (isk) {
                    const unsigned rb = u.pm * BM + ai * HALF + wr * 64, cb = hh * 128 + 32 * (wc & 1);
#pragma unroll
                    for (int n = 0; n < 2; ++n) {
                        tr_store16(T, fr, fq, l_, y1s[n], w, (unsigned)WS_RKT + ((cb + 4 * n) * MP + rb) * 2u); tr_store16(T, fr, fq, l_, y2s[n], w, (unsigned)WS_RKT + ((cb + 64 + 4 * n) * MP + rb) * 2u); }
                }
            }
        } else if (pn < 11) {
            LAS unsigned char* T = lds_ + EPI_LDS_OFF + (wr * 4 + wc) * EPI_LDS_WAVE;
#pragma unroll
            for (int ai = 0; ai < 2; ++ai) {
                const unsigned rb = u.pm * BM + ai * HALF + wr * 64;
#pragma unroll
                for (int bj = 0; bj < 2; ++bj)
#pragma unroll
                    for (int n = 0; n < 2; ++n) { f32x4 vv[4];
#pragma unroll
                        for (int m = 0; m < 4; ++m) vv[m] = acc[ai][bj][m][n] * rsc[ai * 4 + m];
                        tr_store16(T, fr, fq, l_, vv, w, (unsigned)WS_RVT + (((pn - 7) * 256 + bj * HALF + wc * 32 + 4 * n) * MP + rb) * 2u); }
                asm volatile("" ::: "memory");
            }
        } else {
            const int t = (pn - 11) >> 2; const unsigned dbase = (unsigned)WS_SRG + (unsigned)t * (unsigned)(WS_SGA - WS_SRG) + (((pn - 11) & 3) * 256 + c8) * 2;
            MK_ROWS_BEGIN
#pragma unroll
                for (int bj = 0; bj < 2; ++bj) { const f32x4 v0 = acc[ai][bj][m][0] * r, v1 = acc[ai][bj][m][1] * r; f32x4 o0, o1;
#pragma unroll
                    for (int j = 0; j < 4; ++j) { const float g0 = fast_sigmoid(v0[j]), g1 = fast_sigmoid(v1[j]); o0[j] = t == 0 ? v0[j] * g0 : g0; o1[j] = t == 0 ? v1[j] * g1 : g1; }
                    *at<u32x4>(w, dbase + (row * 1024 + bj * HALF) * 2) = pack8(o0, o1); }
            MK_ROWS_END
        }
    }
};
static_assert(WS_SGB - WS_SGA == WS_SGA - WS_SRG, "gate arrays equally spaced");
struct EpiQ {
    static constexpr bool PERM = false, AFTER_DRAIN = false;
    unsigned char* ws;
    __device__ __forceinline__ void operator()(const f32x4 (&acc)[2][2][4][2], const Unit& u, int wr, int wc, int fr, int fq) const {
        int l_ = lane_fresh(); asm volatile("" : "+v"(l_)); fr = l_ & 15; fq = l_ >> 4;
        const float* SSQCQ = (const float*)(ws + WS_SSQCQ); bf16* QA = (bf16*)(ws + WS_QA); const float* TAB = (const float*)(ws + WS_TAB);
        const int row0 = u.pm * BM + wr * 64 + fr;
#pragma unroll
        for (int ai = 0; ai < 2; ++ai)
#pragma unroll
            for (int m = 0; m < 4; ++m) {
                int row = row0 + ai * HALF + m * 16; asm volatile("" : "+v"(row));
                const float r = row_rscale8(SSQCQ, row, 1.f / QR) * SC_Q;
#pragma unroll
                for (int bj = 0; bj < 2; ++bj) {
                    const int grp = 8 * u.pn + 4 * bj + wc;
                    bf16* dst = QA + (size_t)row * 768 + 32 * grp + 4 * fq;
                    const bool rope = (grp % 3) == 2;
                    const int pi = row_pidx(row);
                    f32x4 c = *(const f32x4*)(TAB + TAB_C16 / 4 + pi * 16 + 4 * fq), s = *(const f32x4*)(TAB + TAB_S16 / 4 + pi * 16 + 4 * fq);
                    if (!rope) { c = (f32x4){1.f, 1.f, 1.f, 1.f}; s = (f32x4){0.f, 0.f, 0.f, 0.f}; }
                    const f32x4 x1 = acc[ai][bj][m][0] * r, x2 = acc[ai][bj][m][1] * r;
                    *(u32x2*)dst = pack4(x1 * c - x2 * s); *(u32x2*)(dst + 16) = pack4(x1 * s + x2 * c);
                }
                asm volatile("" ::: "memory");
            }
    }
};
template <bool ROWS> struct EpiScaleBf16 {
    static constexpr bool PERM = true, AFTER_DRAIN = false;
    const float* SSQKV; bf16* O; int ldc;
    __device__ __forceinline__ void operator()(const f32x4 (&acc)[2][2][4][2], const Unit& u, int wr, int wc, int fr, int fq) const {
        int l_ = lane_fresh(); asm volatile("" : "+v"(l_)); fr = l_ & 15; fq = l_ >> 4;
        const int row0 = u.pm * BM + wr * 64 + fr, col0 = u.pn * BM + wc * 32 + 8 * fq;
        float cs[2][8];
        if (!ROWS) {
#pragma unroll
            for (int bj = 0; bj < 2; ++bj)
#pragma unroll
                for (int k = 0; k < 8; ++k) cs[bj][k] = row_rscale4(SSQKV, col0 + bj * HALF + k, 1.f / KVR);
        }
#pragma unroll
        for (int ai = 0; ai < 2; ++ai)
#pragma unroll
            for (int m = 0; m < 4; ++m) { int row = row0 + ai * HALF + m * 16; asm volatile("" : "+v"(row)); const float r = ROWS ? row_rscale4(SSQKV, row, 1.f / KVR) : 1.f;
#pragma unroll
                for (int bj = 0; bj < 2; ++bj) { f32x4 v0 = acc[ai][bj][m][0], v1 = acc[ai][bj][m][1];
                    if (ROWS) { v0 = v0 * r; v1 = v1 * r; }
                    else {
#pragma unroll
                        for (int j = 0; j < 4; ++j) { v0[j] *= cs[bj][j]; v1[j] *= cs[bj][4 + j]; } }
                    u32x4 w; w.x = pg8::cvt_pk_bf16(v0[0], v0[1]); w.y = pg8::cvt_pk_bf16(v0[2], v0[3]); w.z = pg8::cvt_pk_bf16(v1[0], v1[1]); w.w = pg8::cvt_pk_bf16(v1[2], v1[3]);
                    *(u32x4*)(O + (size_t)row * ldc + col0 + bj * HALF) = w; } }
    }
};
__device__ __forceinline__ void finalize_ckv(Frame& F, const Ptrs& a) {
    const int lane = fresh_tid(F.wave) & 63;
    const int gw = F.vcu * NWAVES + F.wave, NGW = F.G * NWAVES;
    const float* CKVF = (const float*)(a.ws + WS_CKVF); const float* SSQKV = (const float*)(a.ws + WS_SSQKV); const float* KRF = (const float*)(a.ws + WS_KRF);
    const f32x4 g = *((const f32x4*)a.in(14) + lane);
    for (int row = gw; row < ROW_PAD; row += NGW) {
        const float r = row_rscale4(SSQKV, row, 1.f / KVR);
        const f32x4 o = *((const f32x4*)(CKVF + (size_t)row * KVR) + lane) * r * g;
        const f32x4 kr = *((const f32x4*)(KRF + (size_t)row * 32) + (lane & 7));
        if (row < MMAIN) { const size_t t = (size_t)(row >> 11) * T + NMETA + (row & (SEQ - 1)); *((f32x4*)(a.out() + OUT_CKVP + t * KVR) + lane) = o; if (lane < 8) *((f32x4*)(a.out() + OUT_KRP + t * 32) + lane) = kr; }
        else if (row < ROW_SMP) { for (int b = 0; b < NB; ++b) { const size_t t = (size_t)b * T + (row - ROW_META); *((f32x4*)(a.out() + OUT_CKVP + t * KVR) + lane) = o; if (lane < 8) *((f32x4*)(a.out() + OUT_KRP + t * 32) + lane) = kr; } }
        else { *((f32x4*)(a.out() + OUT_CKVS + (size_t)(row - ROW_SMP) * KVR) + lane) = o; if (lane < 8) *((f32x4*)(a.out() + OUT_KRS + (size_t)(row - ROW_SMP) * 32) + lane) = kr; }
    }
}
}
namespace mk {
constexpr size_t WS_AV = WS_END2;
constexpr size_t WS_END3 = WS_AV + al((size_t)MP * 512 * 2);
typedef float f32x16 __attribute__((ext_vector_type(16)));
constexpr int AT_KSTR = 208, AT_VSTR = 144, AT_KBUF = 64 * AT_KSTR, AT_VBUF = 64 * AT_VSTR, AT_VOFF = 2 * AT_KBUF;
__device__ __forceinline__ int crow(int i, int half) { return (i & 3) + 8 * (i >> 2) + 4 * half; }

__device__ __forceinline__ void attn_unit(Frame& F, unsigned char* ws, int b, int h, int qb) {
    ws = opaque_g(ws);
    const int tid = fresh_tid(F.wave), lane = tid & 63, w = F.wave, q = lane & 31, half = lane >> 5;
    LAS unsigned char* L = F.lds + RING_OFF;
    const bf16* QA = (const bf16*)(ws + WS_QA); const bf16* KN = (const bf16*)(ws + WS_KN); const bf16* KRB = (const bf16*)(ws + WS_KRB); const bf16* VT = (const bf16*)(ws + WS_VT);
    const int qrow = b * SEQ + qb * 256 + w * 32 + q, q_main = qb * 256 + w * 32 + q, wq0 = qb * 256 + w * 32;
    bf16x8 qf[6];
#pragma unroll
    for (int s = 0; s < 6; ++s) qf[s] = *(const bf16x8*)(QA + (size_t)qrow * 768 + h * 96 + 16 * s + 8 * half);
    f32x16 ot[2];
#pragma unroll
    for (int i = 0; i < 16; ++i) { ot[0][i] = 0.f; ot[1][i] = 0.f; }
    float m = -INFINITY, l = 0.f;
    const int NT = 4 * (qb + 1);
    v4u kreg, rreg, vreg; rreg = (v4u){0u, 0u, 0u, 0u};
#define AT_LOAD(tt) do { const int t0_ = (tt) == 0 ? ROW_META : b * SEQ + 64 * ((tt) - 1); \
        kreg = *(const v4u*)(KN + (size_t)(t0_ + (tid >> 3)) * 512 + h * 64 + (tid & 7) * 8); \
        if (tid < 256) rreg = *(const v4u*)(KRB + (size_t)(t0_ + (tid >> 2)) * 32 + (tid & 3) * 8); \
        vreg = *(const v4u*)(VT + (size_t)(h * 64 + (tid >> 3)) * MP + t0_ + (tid & 7) * 8); } while (0)
#define AT_STORE(buf) do { LAS unsigned char* kb_ = L + (buf) * AT_KBUF; \
        *(LAS v4u*)(kb_ + (tid >> 3) * AT_KSTR + (tid & 7) * 16) = kreg; \
        if (tid < 256) *(LAS v4u*)(kb_ + (tid >> 2) * AT_KSTR + 128 + (tid & 3) * 16) = rreg; \
        LAS unsigned char* vb_ = L + AT_VOFF + (buf) * AT_VBUF + (tid >> 3) * AT_VSTR + (32 * ((tid & 7) >> 1) + 8 * (tid & 1)); \
        *(LAS u32x2*)(vb_) = (u32x2){vreg.x, vreg.y}; *(LAS u32x2*)(vb_ + 16) = (u32x2){vreg.z, vreg.w}; } while (0)
    AT_LOAD(0); AT_STORE(0);
    __syncthreads();
    for (int tt = 0; tt <= NT; ++tt) {
        const int buf = tt & 1;
        if (tt < NT) AT_LOAD(tt + 1);
        const int kmin = tt == 0 ? 0 : 64 * (tt - 1);
        if (tt == 0 || kmin <= wq0 + 31) {
            const LAS unsigned char* Kb = L + buf * AT_KBUF + q * AT_KSTR + 16 * half;
            const LAS unsigned char* Vb = L + AT_VOFF + buf * AT_VBUF + q * AT_VSTR + 16 * half;
            f32x16 st[2];
#pragma unroll
            for (int kb = 0; kb < 2; ++kb) {
#pragma unroll
                for (int i = 0; i < 16; ++i) st[kb][i] = 0.f;
#pragma unroll
                for (int s = 0; s < 6; ++s) { const bf16x8 kf = *(const LAS bf16x8*)(Kb + kb * 32 * AT_KSTR + 32 * s); st[kb] = __builtin_amdgcn_mfma_f32_32x32x16_bf16(kf, qf[s], st[kb], 0, 0, 0); }
            }
            if (tt == 0) {
#pragma unroll
                for (int kb = 0; kb < 2; ++kb)
#pragma unroll
                    for (int i = 0; i < 16; ++i) if (32 * kb + crow(i, half) >= NMETA) st[kb][i] = -INFINITY;
            } else if (kmin + 63 > wq0) {
#pragma unroll
                for (int kb = 0; kb < 2; ++kb)
#pragma unroll
                    for (int i = 0; i < 16; ++i) if (kmin + 32 * kb + crow(i, half) > q_main) st[kb][i] = -INFINITY;
            }
            float mx = st[0][0];
#pragma unroll
            for (int i = 1; i < 16; ++i) mx = fmaxf(mx, st[0][i]);
#pragma unroll
            for (int i = 0; i < 16; ++i) mx = fmaxf(mx, st[1][i]);
            mx = fmaxf(mx, lx(mx, lane, 32));
            const float mn = fmaxf(m, mx), alpha = __builtin_amdgcn_exp2f(m - mn);
            m = mn;
            float ps = 0.f;
#pragma unroll
            for (int kb = 0; kb < 2; ++kb)
#pragma unroll
                for (int i = 0; i < 16; ++i) { st[kb][i] = __builtin_amdgcn_exp2f(st[kb][i] - mn); ps += st[kb][i]; }
            l = l * alpha + ps;
#pragma unroll
            for (int i = 0; i < 16; ++i) { ot[0][i] *= alpha; ot[1][i] *= alpha; }
#pragma unroll
            for (int kb = 0; kb < 2; ++kb)
#pragma unroll
                for (int s2 = 0; s2 < 2; ++s2) {
                    u32x4 pw; pw.x = pg8::cvt_pk_bf16(st[kb][8 * s2 + 0], st[kb][8 * s2 + 1]); pw.y = pg8::cvt_pk_bf16(st[kb][8 * s2 + 2], st[kb][8 * s2 + 3]);
                    pw.z = pg8::cvt_pk_bf16(st[kb][8 * s2 + 4], st[kb][8 * s2 + 5]); pw.w = pg8::cvt_pk_bf16(st[kb][8 * s2 + 6], st[kb][8 * s2 + 7]);
                    const bf16x8 pf = __builtin_bit_cast(bf16x8, pw);
#pragma unroll
                    for (int vb = 0; vb < 2; ++vb) { const bf16x8 vf = *(const LAS bf16x8*)(Vb + vb * 32 * AT_VSTR + (32 * kb + 16 * s2) * 2); ot[vb] = __builtin_amdgcn_mfma_f32_32x32x16_bf16(vf, pf, ot[vb], 0, 0, 0); }
                }
        }
        if (tt < NT) AT_STORE(buf ^ 1);
        __syncthreads();
    }
#undef AT_LOAD
#undef AT_STORE
    l += lx(l, lane, 32);
    const float inv = 1.0f / l;
    bf16* AV = (bf16*)(ws + WS_AV) + (size_t)qrow * 512 + h * 64 + 4 * half;
#pragma unroll
    for (int vb = 0; vb < 2; ++vb)
#pragma unroll
        for (int g = 0; g < 4; ++g) { f32x4 o; o[0] = ot[vb][4 * g] * inv; o[1] = ot[vb][4 * g + 1] * inv; o[2] = ot[vb][4 * g + 2] * inv; o[3] = ot[vb][4 * g + 3] * inv; *(u32x2*)(AV + 32 * vb + 8 * g) = pack4(o); }
}
__device__ __forceinline__ void attn_item(Frame& F, unsigned char* ws, int i) { const int bh = i & 63; attn_unit(F, ws, bh >> 3, bh & 7, 7 - (i >> 6)); }
__device__ __forceinline__ void attn_phase(Frame& F, unsigned char* ws) {
    const int c = F.vcu;
    if (c >= 256) return;
    const int bh = c >> 2, p = c & 3;
    attn_unit(F, ws, bh >> 3, bh & 7, 7 - p);
    attn_unit(F, ws, bh >> 3, bh & 7, p);
}
}
namespace mk {
constexpr size_t WS_UMETA = WS_END3;
constexpr size_t WS_UT = WS_UMETA + al((size_t)RH * RDV * RDK * 4);
constexpr size_t WS_SPREV = WS_UT + al((size_t)32 * 16 * RDV * RDK * 4);
constexpr size_t WS_RIN = WS_SPREV + al((size_t)32 * 16 * RDV * RDK * 2);
constexpr size_t WS_DPART = WS_RIN + al((size_t)MP * 1024 * 2);
constexpr size_t WS_QL = WS_DPART + al((size_t)32 * 16 * 8 * 264 * 4);
constexpr size_t WS_END4 = WS_QL + al((size_t)64 * 2048 * 4);
static_assert(WS_END4 < ((size_t)1 << 31), "32-bit workspace offsets");
__device__ __forceinline__ float gpow_t(const unsigned char* ws, int h, int n) { return ((const float*)(ws + WS_TAB + TAB_GP))[h * 128 + n]; }

__device__ __forceinline__ void ret_u_unit(Frame& F, unsigned char* ws, int u) {
    ws = opaque_g(ws);
    const int tid = fresh_tid(F.wave), lane = tid & 63, w = F.wave, r32 = lane & 31, half = lane >> 5;
    const bool meta = u >= 512; const int hh = meta ? u - 512 : (u >> 4) & 3;
    const int tok0 = meta ? ROW_META : (u >> 6) * SEQ + (u & 15) * 128, nks = meta ? 1 : 8;
    const bf16* RVT = (const bf16*)(ws + WS_RVT); const bf16* RKT = (const bf16*)(ws + WS_RKT);
    f32x16 acc[4];
#pragma unroll
    for (int db = 0; db < 4; ++db)
#pragma unroll
        for (int i = 0; i < 16; ++i) acc[db][i] = 0.f;
    const bf16* ap = RVT + (size_t)(hh * 256 + 32 * w + r32) * MP + tok0 + 8 * half;
    const bf16* bp = RKT + (size_t)(hh * 128 + r32) * MP + tok0 + 8 * half;
    for (int s = 0; s < nks; ++s) {
        const bf16x8 af = *(const bf16x8*)(ap + 16 * s);
#pragma unroll
        for (int db = 0; db < 4; ++db) { const bf16x8 bf = *(const bf16x8*)(bp + (size_t)(32 * db) * MP + 16 * s); acc[db] = __builtin_amdgcn_mfma_f32_32x32x16_bf16(af, bf, acc[db], 0, 0, 0); }
    }
    const float sc = gpow_t(ws, hh, meta ? NMETA - 1 : 127);
    float* dst = meta ? (float*)(ws + WS_UMETA) + (size_t)hh * RDV * RDK : (float*)(ws + WS_UT) + (size_t)u * RDV * RDK;
#pragma unroll
    for (int db = 0; db < 4; ++db)
#pragma unroll
        for (int i = 0; i < 16; ++i) dst[(size_t)(32 * w + crow(i, half)) * RDK + 32 * db + r32] = acc[db][i] * sc;
}
__device__ __forceinline__ void ret_scan(Frame& F, const Ptrs& a) {
    const int tid = fresh_tid(F.wave);
    const int gt = (F.vcu * NWAVES * 64) + tid, NGT = F.G * NWAVES * 64;
    const float* UM = (const float*)(a.ws + WS_UMETA); const float* UT = (const float*)(a.ws + WS_UT); bf16* SP = (bf16*)(a.ws + WS_SPREV);
    for (int e = gt; e < 32 * RDV * RDK; e += NGT) {
        const int bh = e >> 15, idx = e & 32767, hh = bh & 3;
        const float g128 = gpow_t(a.ws, hh, 127) * gpow_t(a.ws, hh, 1);
        float S = UM[(size_t)hh * 32768 + idx];
        for (int c = 0; c < 16; ++c) { const size_t o = ((size_t)bh * 16 + c) * 32768 + idx; SP[o] = bf1(S); S = g128 * S + UT[o]; }
        const int ee = idx >> 7, d = idx & 127;
        a.out()[OUT_SRP + ((size_t)bh * RDK + d) * RDV + ee] = S;
    }
}
__device__ __forceinline__ void ret_o_unit(Frame& F, const Ptrs& a, int u) {
    unsigned char* ws = a.ws; ws = opaque_g(ws);
    const int tid = fresh_tid(F.wave), lane = tid & 63, w = F.wave, r32 = lane & 31, half = lane >> 5;
    const int bh = u >> 4, c = u & 15, hh = bh & 3, tok0 = (bh >> 2) * SEQ + c * 128;
    const int ib = w & 3, eh = w >> 2;
    LAS float* red = (LAS float*)(F.lds + RING_OFF);
    const bf16* RQ = (const bf16*)(ws + WS_RQ); const bf16* RK = (const bf16*)(ws + WS_RK); const bf16* RVT = (const bf16*)(ws + WS_RVT);
    const bf16* SP = (const bf16*)(ws + WS_SPREV) + (size_t)u * 32768;
    const int irow = tok0 + 32 * ib + r32;
    bf16x8 qf[8];
#pragma unroll
    for (int s = 0; s < 8; ++s) qf[s] = *(const bf16x8*)(RQ + (size_t)irow * 512 + hh * 128 + 16 * s + 8 * half);
    f32x16 ot[4];
#pragma unroll
    for (int eb = 0; eb < 4; ++eb) {
#pragma unroll
        for (int i = 0; i < 16; ++i) ot[eb][i] = 0.f;
        const bf16* sp = SP + (size_t)(128 * eh + 32 * eb + r32) * RDK + 8 * half;
#pragma unroll
        for (int s = 0; s < 8; ++s) { const bf16x8 sf = *(const bf16x8*)(sp + 16 * s); ot[eb] = __builtin_amdgcn_mfma_f32_32x32x16_bf16(sf, qf[s], ot[eb], 0, 0, 0); }
    }
    const float g = gpow_t(ws, hh, 1);
#pragma unroll
    for (int eb = 0; eb < 4; ++eb)
#pragma unroll
        for (int i = 0; i < 16; ++i) ot[eb][i] *= g;
    for (int jb = 0; jb <= ib; ++jb) {
        f32x16 at;
#pragma unroll
        for (int i = 0; i < 16; ++i) at[i] = 0.f;
        const bf16* kp = RK + (size_t)(tok0 + 32 * jb + r32) * 512 + hh * 128 + 8 * half;
#pragma unroll
        for (int s = 0; s < 8; ++s) { const bf16x8 kf = *(const bf16x8*)(kp + 16 * s); at = __builtin_amdgcn_mfma_f32_32x32x16_bf16(kf, qf[s], at, 0, 0, 0); }
        if (jb == ib) {
#pragma unroll
            for (int i = 0; i < 16; ++i) if (crow(i, half) > r32) at[i] = 0.f;
        }
#pragma unroll
        for (int s2 = 0; s2 < 2; ++s2) {
            u32x4 pw; pw.x = pg8::cvt_pk_bf16(at[8 * s2 + 0], at[8 * s2 + 1]); pw.y = pg8::cvt_pk_bf16(at[8 * s2 + 2], at[8 * s2 + 3]);
            pw.z = pg8::cvt_pk_bf16(at[8 * s2 + 4], at[8 * s2 + 5]); pw.w = pg8::cvt_pk_bf16(at[8 * s2 + 6], at[8 * s2 + 7]);
            const bf16x8 pf = __builtin_bit_cast(bf16x8, pw);
#pragma unroll
            for (int eb = 0; eb < 4; ++eb) {
                const bf16* vp = RVT + (size_t)(hh * 256 + 128 * eh + 32 * eb + r32) * MP + tok0 + 32 * jb + 16 * s2 + 4 * half;
                const u32x2 lo = *(const u32x2*)vp, hi = *(const u32x2*)(vp + 8);
                u32x4 vw; vw.x = lo.x; vw.y = lo.y; vw.z = hi.x; vw.w = hi.y;
                ot[eb] = __builtin_amdgcn_mfma_f32_32x32x16_bf16(__builtin_bit_cast(bf16x8, vw), pf, ot[eb], 0, 0, 0);
            }
        }
    }
    float s1 = 0.f;
#pragma unroll
    for (int eb = 0; eb < 4; ++eb)
#pragma unroll
        for (int i = 0; i < 16; ++i) s1 += ot[eb][i];
    s1 += lx(s1, lane, 32);
    if (half == 0) red[w * 32 + r32] = s1;
    __syncthreads();
    const float mu = (red[w * 32 + r32] + red[(w ^ 4) * 32 + r32]) * (1.f / 256.f);
    float s2 = 0.f;
#pragma unroll
    for (int eb = 0; eb < 4; ++eb)
#pragma unroll
        for (int i = 0; i < 16; ++i) { ot[eb][i] -= mu; s2 += ot[eb][i] * ot[eb][i]; }
    s2 += lx(s2, lane, 32);
    if (half == 0) red[256 + w * 32 + r32] = s2;
    __syncthreads();
    const float rstd = 1.0f / sqrtf((red[256 + w * 32 + r32] + red[256 + (w ^ 4) * 32 + r32]) * (1.f / 256.f) + EPS);
    __syncthreads();
    const bf16* SRG = (const bf16*)(ws + WS_SRG) + (size_t)irow * 1024 + hh * 256 + 128 * eh + 4 * half;
    bf16* RIN = (bf16*)(ws + WS_RIN) + (size_t)irow * 1024 + hh * 256 + 128 * eh + 4 * half;
    const float* gn = a.in(19) + hh * 256 + 128 * eh + 4 * half;
#pragma unroll
    for (int eb = 0; eb < 4; ++eb)
#pragma unroll
        for (int gq = 0; gq < 4; ++gq) {
            const int eo = 32 * eb + 8 * gq;
            const u32x2 sg = *(const u32x2*)(SRG + eo); const f32x4 gv = *(const f32x4*)(gn + eo);
            f32x4 o;
            o[0] = ot[eb][4 * gq + 0] * rstd * gv[0] * __uint_as_float(sg.x << 16); o[1] = ot[eb][4 * gq + 1] * rstd * gv[1] * __uint_as_float(sg.x & 0xffff0000u);
            o[2] = ot[eb][4 * gq + 2] * rstd * gv[2] * __uint_as_float(sg.y << 16); o[3] = ot[eb][4 * gq + 3] * rstd * gv[3] * __uint_as_float(sg.y & 0xffff0000u);
            *(u32x2*)(RIN + eo) = pack4(o);
        }
}
__device__ __forceinline__ void ret_sample_unit(Frame& F, const Ptrs& a, int u) {
    unsigned char* ws = a.ws; ws = opaque_g(ws);
    const int tid = fresh_tid(F.wave), lane = tid & 63, s = u >> 2, hh = u & 3, e = tid & 255, dh = tid >> 8, row = ROW_SMP + s;
    LAS float* sh = (LAS float*)(F.lds + RING_OFF);
    const bf16* RQ = (const bf16*)(ws + WS_RQ); const bf16* RK = (const bf16*)(ws + WS_RK); const bf16* RVT = (const bf16*)(ws + WS_RVT);
    if (tid < 128) sh[tid] = __uint_as_float((unsigned)RQ[(size_t)row * 512 + hh * 128 + tid] << 16);
    else if (tid < 256) sh[tid] = __uint_as_float((unsigned)RK[(size_t)row * 512 + hh * 128 + tid - 128] << 16);
    __syncthreads();
    const float v = __uint_as_float((unsigned)RVT[(size_t)(hh * 256 + e) * MP + row] << 16);
    const float g = gpow_t(ws, hh, 1);
    const float* S0 = a.in(4) + ((size_t)(s * RH + hh) * RDK) * RDV + e;
    float* S1 = a.out() + OUT_SRS + ((size_t)(s * RH + hh) * RDK) * RDV + e;
    float o = 0.f;
    {   float s0[64];
#pragma unroll
        for (int k = 0; k < 64; ++k) s0[k] = S0[(size_t)(64 * dh + k) * RDV];
#pragma unroll
        for (int k = 0; k < 64; ++k) { const int d = 64 * dh + k; const float sn = g * s0[k] + sh[128 + d] * v; S1[(size_t)d * RDV] = sn; o += sh[d] * sn; } }
    sh[256 + dh * 256 + e] = o;
    __syncthreads();
    o = sh[256 + e] + sh[512 + e];
    float t1 = o;
#pragma unroll
    for (int off = 32; off > 0; off >>= 1) t1 += lx(t1, lane, off);
    if ((tid & 63) == 0) sh[768 + (tid >> 6)] = t1;
    __syncthreads();
    const float mu = (sh[768] + sh[769] + sh[770] + sh[771]) * (1.f / 256.f);
    const float dlt = o - mu;
    float t2 = dlt * dlt;
#pragma unroll
    for (int off = 32; off > 0; off >>= 1) t2 += lx(t2, lane, off);
    if ((tid & 63) == 0) sh[776 + (tid >> 6)] = t2;
    __syncthreads();
    const float rstd = 1.0f / sqrtf((sh[776] + sh[777] + sh[778] + sh[779]) * (1.f / 256.f) + EPS);
    if (dh == 0) { const float sg = __uint_as_float((unsigned)((const bf16*)(ws + WS_SRG))[(size_t)row * 1024 + hh * 256 + e] << 16);
        ((bf16*)(ws + WS_RIN))[(size_t)row * 1024 + hh * 256 + e] = bf1(dlt * rstd * a.in(19)[hh * 256 + e] * sg); }
    __syncthreads();
}
}
namespace mk {
template <int CTRL> __device__ __forceinline__ float dppf(float v) { return __int_as_float(__builtin_amdgcn_update_dpp(0, __float_as_int(v), CTRL, 0xF, 0xF, false)); }
__device__ __forceinline__ float swap32_add(float a, float b) { const auto r = __builtin_amdgcn_permlane32_swap(__float_as_uint(a), __float_as_uint(b), false, false); return __uint_as_float(r[0]) + __uint_as_float(r[1]); }
__device__ __forceinline__ float swap16_add(float a, float b) { const auto r = __builtin_amdgcn_permlane16_swap(__float_as_uint(a), __float_as_uint(b), false, false); return __uint_as_float(r[0]) + __uint_as_float(r[1]); }
__device__ __forceinline__ int dlane_of(int h) { return ((h >> 2) & 1) * 32 + ((h >> 1) & 1) * 16 + (h & 1) * 8; }
__device__ __forceinline__ void decode_unit(Frame& F, const Ptrs& a, int u) {
    unsigned char* ws = a.ws; ws = opaque_g(ws);
    const int tid = fresh_tid(F.wave), lane = tid & 63, w = F.wave, s = u >> 4, sp = u & 15, row = ROW_SMP + s;
    LAS float* sh = (LAS float*)(F.lds + RING_OFF);
    const bf16* QA = (const bf16*)(ws + WS_QA) + (size_t)row * 768;
    f32x4 ql[8]; float qr[8];
    { const float* QLr = (const float*)(ws + WS_QL) + (size_t)(row - MMAIN) * 2048;
#pragma unroll
      for (int h = 0; h < 8; ++h) { ql[h] = *(const f32x4*)(QLr + h * 256 + 4 * lane); qr[h] = lane < 32 ? __uint_as_float((unsigned)QA[h * 96 + 64 + lane] << 16) : 0.f; } }
    f32x4 O[8];
#pragma unroll
    for (int h = 0; h < 8; ++h) O[h] = (f32x4){0.f, 0.f, 0.f, 0.f};
    float m = -INFINITY, l = 0.f;
    const int page = ((const int*)a.in(5))[s * NPAGES + sp * 8 + w];
    const float* ck0 = a.in(2) + (size_t)page * PAGE * KVR + 4 * lane;
    const float* kr0 = a.in(3) + (size_t)page * PAGE * 32 + (lane & 31);
#define DC_LOAD(kv_, rv_, bi_) do { const float* c_ = ck0; const float* r_ = kr0; const int k0_ = (bi_) * 4; \
        _Pragma("unroll") for (int kk = 0; kk < 4; ++kk) { kv_[kk] = *(const f32x4*)(c_ + (size_t)(k0_ + kk) * KVR); rv_[kk] = r_[(size_t)(k0_ + kk) * 32]; } } while (0)
#define DC_COMPUTE(kv_, rv_) do { float sc[4]; \
        _Pragma("unroll") for (int kk = 0; kk < 4; ++kk) { float p[8]; \
            _Pragma("unroll") for (int h = 0; h < 8; ++h) p[h] = fmaf(ql[h][0], kv_[kk][0], fmaf(ql[h][1], kv_[kk][1], fmaf(ql[h][2], kv_[kk][2], fmaf(ql[h][3], kv_[kk][3], qr[h] * rv_[kk])))); \
              \
            const float a0 = swap32_add(p[0], p[4]), a1 = swap32_add(p[1], p[5]), a2 = swap32_add(p[2], p[6]), a3 = swap32_add(p[3], p[7]); \
            const float b0 = swap16_add(a0, a2), b1 = swap16_add(a1, a3); \
            const float c0 = b0 + dppf<0x128>(b0), c1 = b1 + dppf<0x128>(b1); \
            float v1 = (lane & 8) ? c1 : c0; \
            v1 += dppf<0xB1>(v1); v1 += dppf<0x4E>(v1); v1 += dppf<0x141>(v1); sc[kk] = v1; } \
        const float mx = fmaxf(fmaxf(sc[0], sc[1]), fmaxf(sc[2], sc[3])); \
        const float mn = fmaxf(m, mx), alpha = __builtin_amdgcn_exp2f(m - mn); m = mn; \
        float pe[4]; \
        _Pragma("unroll") for (int kk = 0; kk < 4; ++kk) pe[kk] = __builtin_amdgcn_exp2f(sc[kk] - mn); \
        l = l * alpha + ((pe[0] + pe[1]) + (pe[2] + pe[3])); \
        _Pragma("unroll") for (int h = 0; h < 8; ++h) { const int src = dlane_of(h); \
            const float ah = __int_as_float(__builtin_amdgcn_readlane(__float_as_int(alpha), src)), p0 = __int_as_float(__builtin_amdgcn_readlane(__float_as_int(pe[0]), src)), p1 = __int_as_float(__builtin_amdgcn_readlane(__float_as_int(pe[1]), src)), \
                        p2 = __int_as_float(__builtin_amdgcn_readlane(__float_as_int(pe[2]), src)), p3 = __int_as_float(__builtin_amdgcn_readlane(__float_as_int(pe[3]), src)); \
            O[h] = O[h] * ah + kv_[0] * p0 + kv_[1] * p1 + kv_[2] * p2 + kv_[3] * p3; } } while (0)
    f32x4 kvA[4], kvB[4], kvC[4]; float rvA[4], rvB[4], rvC[4];
#define DC_PIN() __builtin_amdgcn_sched_barrier(0)
    DC_LOAD(kvA, rvA, 0); DC_LOAD(kvB, rvB, 1); DC_PIN();
#pragma unroll 1
    for (int bi = 0; bi < 30; bi += 3) {
        DC_LOAD(kvC, rvC, bi + 2); DC_PIN();
        DC_COMPUTE(kvA, rvA); DC_PIN();
        DC_LOAD(kvA, rvA, bi + 3); DC_PIN();
        DC_COMPUTE(kvB, rvB); DC_PIN();
        DC_LOAD(kvB, rvB, bi + 4); DC_PIN();
        DC_COMPUTE(kvC, rvC); DC_PIN();
    }
    DC_COMPUTE(kvA, rvA);
    DC_COMPUTE(kvB, rvB);
#undef DC_PIN
#undef DC_LOAD
#undef DC_COMPUTE
    LAS float* wm = sh + 2304 + w * 16;
    LAS float* wo = sh + 2304 + 128 + w * 2048;
    { const int hd = 4 * (lane >> 5) + 2 * ((lane >> 4) & 1) + ((lane >> 3) & 1); if ((lane & 7) == 0) { wm[hd] = m; wm[8 + hd] = l; } }
#pragma unroll
    for (int h = 0; h < 8; ++h) *(LAS f32x4*)(wo + h * 256 + 4 * lane) = O[h];
    __syncthreads();
    float* part = (float*)(ws + WS_DPART) + (size_t)u * 8 * 264;
    for (int e = tid; e < 2048; e += 512) {
        const int h = e >> 8;
        float M = -INFINITY;
#pragma unroll
        for (int ww = 0; ww < 8; ++ww) M = fmaxf(M, sh[2304 + ww * 16 + h]);
        float acc = 0.f, L = 0.f;
#pragma unroll
        for (int ww = 0; ww < 8; ++ww) { const float f = __builtin_amdgcn_exp2f(sh[2304 + ww * 16 + h] - M); acc += f * sh[2304 + 128 + ww * 2048 + e]; L += f * sh[2304 + ww * 16 + 8 + h]; }
        __hip_atomic_store(part + h * 264 + (e & 255), acc, __ATOMIC_RELAXED, __HIP_MEMORY_SCOPE_AGENT);
        if ((e & 255) == 0) { __hip_atomic_store(part + h * 264 + 256, M, __ATOMIC_RELAXED, __HIP_MEMORY_SCOPE_AGENT); __hip_atomic_store(part + h * 264 + 257, L, __ATOMIC_RELAXED, __HIP_MEMORY_SCOPE_AGENT); }
    }
    asm volatile("s_waitcnt vmcnt(0)" ::: "memory");
    __syncthreads();
    if (tid == 0) (void)__hip_atomic_fetch_add((unsigned*)(ws + WS_CTL) + CW_DCNT + 16 * s, 1u, __ATOMIC_RELAXED, __HIP_MEMORY_SCOPE_AGENT);
}
__device__ __forceinline__ void decode_combine_unit(Frame& F, const Ptrs& a, int u) {
    unsigned char* ws = opaque_g(a.ws);
    const int tid = fresh_tid(F.wave), lane = tid & 63, s = u >> 3, h = u & 7, row = ROW_SMP + s;
    LAS float* sh = (LAS float*)(F.lds + RING_OFF);
    const bf16* QA = (const bf16*)(ws + WS_QA) + (size_t)row * 768;
    const float* part = (const float*)(ws + WS_DPART) + (size_t)s * 16 * 8 * 264;
    if (tid == 0) { const unsigned* cn = (const unsigned*)(ws + WS_CTL) + CW_DCNT + 16 * s; unsigned spins = 0;
        while (__hip_atomic_load(cn, __ATOMIC_RELAXED, __HIP_MEMORY_SCOPE_AGENT) < 16u && ++spins < (1u << 22)) __builtin_amdgcn_s_sleep(8);
        __builtin_amdgcn_fence(__ATOMIC_ACQUIRE, "agent"); asm volatile("s_waitcnt vmcnt(0)" ::: "memory"); }
    __syncthreads();
    if (tid < 64) { const bf16* KNr = (const bf16*)(ws + WS_KN) + (size_t)row * 512;
        float acc = __uint_as_float((unsigned)QA[h * 96 + lane] << 16) * __uint_as_float((unsigned)KNr[h * 64 + lane] << 16);
        if (lane < 32) acc += __uint_as_float((unsigned)QA[h * 96 + 64 + lane] << 16) * ((const float*)(ws + WS_KRF))[(size_t)row * 32 + lane];
#pragma unroll
        for (int off = 32; off > 0; off >>= 1) acc += lx(acc, lane, off);
        if (lane == 0) sh[256] = acc; }
    __syncthreads();
    if (tid < 256) {
        const int r = tid;
        const float sn = sh[256];
        float pm[16];
#pragma unroll
        for (int p = 0; p < 16; ++p) pm[p] = part[(p * 8 + h) * 264 + 256];
        float M = sn;
#pragma unroll
        for (int p = 0; p < 16; ++p) M = fmaxf(M, pm[p]);
        const float rkv = row_rscale4((const float*)(ws + WS_SSQKV), row, 1.f / KVR);
        const float cn = ((const float*)(ws + WS_CKVF))[(size_t)row * KVR + r] * rkv * a.in(14)[r];
        const float fn = __builtin_amdgcn_exp2f(sn - M);
        float acc = fn * cn, Lq = fn;
#pragma unroll
        for (int p = 0; p < 16; ++p) { const float f = __builtin_amdgcn_exp2f(pm[p] - M); acc += f * part[(p * 8 + h) * 264 + r]; Lq += f * part[(p * 8 + h) * 264 + 257]; }
        sh[r] = acc / Lq;
    }
    __syncthreads();
    { const int v = tid & 63, rg = tid >> 6; const float* wuv = a.in(17) + (size_t)(32 * rg) * 512 + h * 64 + v;
      float wv[32];
#pragma unroll
      for (int k = 0; k < 32; ++k) wv[k] = wuv[(size_t)k * 512];
      float acc = 0.f;
#pragma unroll
      for (int k = 0; k < 32; ++k) acc += sh[32 * rg + k] * wv[k];
      sh[264 + rg * 64 + v] = acc; }
    __syncthreads();
    if (tid < 64) { float acc = 0.f;
#pragma unroll
        for (int rg = 0; rg < 8; ++rg) acc += sh[264 + rg * 64 + tid];
        ((bf16*)(ws + WS_AV))[(size_t)row * 512 + h * 64 + tid] = bf1(acc); }
    __syncthreads();
}
}
namespace mk {
constexpr size_t WS_TMP = WS_ACT;
constexpr size_t WS_MX = WS_RQ;
constexpr size_t WS_H2B = WS_MX + al((size_t)MP * 1024 * 2);
constexpr size_t WS_H2 = WS_UT;
constexpr size_t WS_SSQH2 = WS_SSQ2_, WS_SSQH3 = WS_SSQ3_;
constexpr size_t WS_H3 = WS_H;
constexpr size_t WS_END6 = WS_END4;
static_assert(WS_H2B + (size_t)MP * 1024 * 2 <= WS_SRG && WS_H2 + (size_t)MP * 1024 * 4 <= WS_RIN && (size_t)MP * 1024 * 4 <= (size_t)MP * FFN * 2, "overlays");
static_assert(WS_END6 < ((size_t)1 << 31), "32-bit workspace offsets");

template <int STEP, unsigned GATE_OFF> struct EpiGate {
    static constexpr bool PERM = false, AFTER_DRAIN = false;
    unsigned char* ws_;
    __device__ __forceinline__ void operator()(const f32x4 (&acc)[2][2][4][2], const Unit& u, int wr, int wc, int fr, int fq) const {
        int l_ = lane_fresh(); asm volatile("" : "+v"(l_)); fr = l_ & 15; fq = l_ >> 4;
        unsigned char* w = opaque_g(ws_);
        const unsigned row0 = u.pm * BM + wr * 64 + fr, col0 = u.pn * BM + wc * 32 + 4 * fq;
#pragma unroll
        for (int ai = 0; ai < 2; ++ai)
#pragma unroll
            for (int m = 0; m < 4; ++m) { unsigned row = row0 + ai * HALF + m * 16; asm volatile("" : "+v"(row));
#pragma unroll
                for (int bj = 0; bj < 2; ++bj)
#pragma unroll
                    for (int n = 0; n < 2; ++n) { const unsigned e = row * 1024 + col0 + bj * HALF + n * 16;
                        const u32x2 gw = *at<const u32x2>(w, GATE_OFF + e * 2);
                        f32x4 g; g[0] = __uint_as_float(gw.x << 16); g[1] = __uint_as_float(gw.x & 0xffff0000u); g[2] = __uint_as_float(gw.y << 16); g[3] = __uint_as_float(gw.y & 0xffff0000u);
                        f32x4 o = acc[ai][bj][m][n] * g;
                        if (STEP == 0) *at<f32x4>(w, (unsigned)WS_TMP + e * 4) = o;
                        else { o = o + *at<const f32x4>(w, (unsigned)WS_TMP + e * 4); *at<u32x2>(w, (unsigned)WS_MX + e * 2) = pack4(o); } }
                asm volatile("" ::: "memory"); }
    }
};
struct EpiSwiGLU2 {
    static constexpr bool PERM = true, AFTER_DRAIN = false;
    unsigned char* ws_;
    __device__ __forceinline__ void operator()(const f32x4 (&acc)[2][2][4][2], const Unit& u, int wr, int wc, int fr, int fq) const {
        int l_ = lane_fresh(); asm volatile("" : "+v"(l_)); fr = l_ & 15; fq = l_ >> 4;
        unsigned char* w = opaque_g(ws_);
        const unsigned row0 = u.pm * BM + wr * 64 + fr, col0 = u.pn * HALF + wc * 32 + 8 * fq;
        float rsc[8];
#pragma unroll
        for (int k = 0; k < 8; ++k) rsc[k] = row_rscale16(at<const float>(w, (unsigned)WS_SSQH2), (int)(row0 + (k >> 2) * HALF + (k & 3) * 16), 1.f / D);
#pragma unroll
        for (int ai = 0; ai < 2; ++ai)
#pragma unroll
            for (int m = 0; m < 4; ++m) { unsigned row = row0 + ai * HALF + m * 16; asm volatile("" : "+v"(row));
                const float r = rsc[ai * 4 + m];
                f32x4 o[2];
#pragma unroll
                for (int n = 0; n < 2; ++n)
#pragma unroll
                    for (int j = 0; j < 4; ++j) { const float g = acc[ai][0][m][n][j] * r, up = acc[ai][1][m][n][j] * r; o[n][j] = fast_silu(g) * up; }
                u32x4 pk; pk.x = pg8::cvt_pk_bf16(o[0][0], o[0][1]); pk.y = pg8::cvt_pk_bf16(o[0][2], o[0][3]); pk.z = pg8::cvt_pk_bf16(o[1][0], o[1][1]); pk.w = pg8::cvt_pk_bf16(o[1][2], o[1][3]);
                *at<u32x4>(w, (unsigned)WS_ACT + (row * FFN + col0) * 2) = pk;
                asm volatile("" ::: "memory"); }
    }
};
__device__ __forceinline__ void final_norm_phase(Frame& F, const Ptrs& a) {
    const int lane = fresh_tid(F.wave) & 63;
    const int gw = F.vcu * NWAVES + F.wave, NGW = F.G * NWAVES;
    const float* H3 = (const float*)(a.ws + WS_H3); const float* SSQ = (const float*)(a.ws + WS_SSQH3);
    f32x4 g[4];
#pragma unroll
    for (int j = 0; j < 4; ++j) g[j] = *((const f32x4*)a.in(26) + lane + 64 * j);
    for (int row0 = gw; row0 < ROW_PAD; row0 += 2 * NGW) {
        f32x4 v[2][4]; float r[2];
#pragma unroll
        for (int t = 0; t < 2; ++t) { const int row = row0 + t * NGW; const bool ok = row < ROW_PAD && !(row >= MMAIN && row < ROW_SMP);
            r[t] = ok ? row_rscale16(SSQ, row, 1.f / D) : 0.f;
#pragma unroll
            for (int j = 0; j < 4; ++j) v[t][j] = ok ? *((const f32x4*)(H3 + (size_t)row * D) + lane + 64 * j) : (f32x4){0.f, 0.f, 0.f, 0.f}; }
#pragma unroll
        for (int t = 0; t < 2; ++t) { const int row = row0 + t * NGW; if (row >= ROW_PAD || (row >= MMAIN && row < ROW_SMP)) continue;
            float* dst = row < MMAIN ? a.out() + OUT_YP + (size_t)row * D : a.out() + OUT_YS + (size_t)(row - ROW_SMP) * D;
#pragma unroll
            for (int j = 0; j < 4; ++j) *((f32x4*)dst + lane + 64 * j) = v[t][j] * r[t] * g[j]; }
    }
}
}
namespace mk {
typedef float f32x4_t __attribute__((ext_vector_type(4)));
constexpr int XROW0 = MMAIN, SK_C = 64 * 64;
__device__ __forceinline__ void skinny64(int wave, int tid, const bf16* A, int K, const bf16* Bt, int brow0, LAS float* P, float (&out)[8]) {
    const int lane = tid & 63, r16 = lane & 15, kq = lane >> 4;
    const bf16* ap = A + (size_t)(XROW0 + r16) * K + 8 * kq;
    const bf16* bp = Bt + (size_t)(brow0 + r16) * K + 8 * kq;
    f32x4 acc[4][4];
#pragma unroll
    for (int mf = 0; mf < 4; ++mf)
#pragma unroll
        for (int nf = 0; nf < 4; ++nf) acc[mf][nf] = (f32x4){0.f, 0.f, 0.f, 0.f};
    const int KS = K / 32;
    bf16x8 a0[4], b0[4], a1[4], b1[4], a2[4], b2[4];
#define SK_LOAD(a_, b_, kk_) do { _Pragma("unroll") for (int f = 0; f < 4; ++f) { a_[f] = *(const bf16x8*)(ap + (size_t)(16 * f) * K + 32 * (kk_)); b_[f] = *(const bf16x8*)(bp + (size_t)(16 * f) * K + 32 * (kk_)); } } while (0)
#define SK_MMA(a_, b_) do { _Pragma("unroll") for (int mf = 0; mf < 4; ++mf) _Pragma("unroll") for (int nf = 0; nf < 4; ++nf) acc[mf][nf] = __builtin_amdgcn_mfma_f32_16x16x32_bf16(a_[mf], b_[nf], acc[mf][nf], 0, 0, 0); } while (0)
    int kk = wave;
    if (kk < KS) SK_LOAD(a0, b0, kk);
    if (kk + 8 < KS) SK_LOAD(a1, b1, kk + 8);
    if (kk + 16 < KS) SK_LOAD(a2, b2, kk + 16);
    for (; kk < KS; kk += 24) {
        SK_MMA(a0, b0); if (kk + 24 < KS) SK_LOAD(a0, b0, kk + 24);
        if (kk + 8 < KS) { SK_MMA(a1, b1); if (kk + 32 < KS) SK_LOAD(a1, b1, kk + 32); }
        if (kk + 16 < KS) { SK_MMA(a2, b2); if (kk + 40 < KS) SK_LOAD(a2, b2, kk + 40); }
    }
#undef SK_LOAD
#undef SK_MMA
    LAS float* Pw = P + wave * SK_C;
#pragma unroll
    for (int mf = 0; mf < 4; ++mf)
#pragma unroll
        for (int nf = 0; nf < 4; ++nf)
#pragma unroll
            for (int i = 0; i < 4; ++i) Pw[(16 * mf + 4 * kq + i) * 64 + 16 * nf + r16] = acc[mf][nf][i];
    __syncthreads();
    const LAS float* pr = P + (tid >> 3) * 64 + 8 * (tid & 7);
    f32x4 s0 = *(const LAS f32x4*)pr, s1 = *(const LAS f32x4*)(pr + 4);
#pragma unroll
    for (int w = 1; w < 8; ++w) { s0 = s0 + *(const LAS f32x4*)(pr + w * SK_C); s1 = s1 + *(const LAS f32x4*)(pr + w * SK_C + 4); }
    out[0] = s0[0]; out[1] = s0[1]; out[2] = s0[2]; out[3] = s0[3]; out[4] = s1[0]; out[5] = s1[1]; out[6] = s1[2]; out[7] = s1[3];
    __syncthreads();
}
__device__ __forceinline__ float sum8(float v, int lane) { v += lx(v, lane, 1); v += lx(v, lane, 2); v += lx(v, lane, 4); return v; }
__device__ __forceinline__ void st8_bf16(bf16* p, const float* v) { u32x4 w; w.x = pg8::cvt_pk_bf16(v[0], v[1]); w.y = pg8::cvt_pk_bf16(v[2], v[3]); w.z = pg8::cvt_pk_bf16(v[4], v[5]); w.w = pg8::cvt_pk_bf16(v[6], v[7]); *(u32x4*)p = w; }
__device__ __forceinline__ void ld8(const LAS float* p, float* v) { const f32x4 a = *(const LAS f32x4*)p, b = *(const LAS f32x4*)(p + 4); v[0] = a[0]; v[1] = a[1]; v[2] = a[2]; v[3] = a[3]; v[4] = b[0]; v[5] = b[1]; v[6] = b[2]; v[7] = b[3]; }
__device__ __forceinline__ void xjob_signal(unsigned char* ws, int tid, int cnt_idx) {
    asm volatile("s_waitcnt vmcnt(0)" ::: "memory"); __syncthreads();
    if (tid == 0) { __builtin_amdgcn_fence(__ATOMIC_RELEASE, "agent"); asm volatile("s_waitcnt vmcnt(0)" ::: "memory");
                    (void)__hip_atomic_fetch_add((unsigned*)(ws + WS_CTL) + CW_XCNT + cnt_idx, 1u, __ATOMIC_RELAXED, __HIP_MEMORY_SCOPE_AGENT); }
}
__device__ __forceinline__ void xjob_wait(unsigned char* ws, int tid, int cnt_idx, unsigned need) {
    if (tid == 0) { const unsigned* cn = (const unsigned*)(ws + WS_CTL) + CW_XCNT + cnt_idx; unsigned spins = 0;
        while (__hip_atomic_load(cn, __ATOMIC_RELAXED, __HIP_MEMORY_SCOPE_AGENT) < need && ++spins < (1u << 22)) __builtin_amdgcn_s_sleep(8);
        __builtin_amdgcn_fence(__ATOMIC_ACQUIRE, "agent"); asm volatile("s_waitcnt vmcnt(0)" ::: "memory"); }
    __syncthreads();
}

__device__ __forceinline__ void xjob_ffn_up(Frame& F, unsigned char* ws, int j, size_t a_off, size_t w_off, int rs_mode, int cnt_idx) {
    ws = opaque_g(ws);
    const int tid = fresh_tid(F.wave);
    LAS float* P = (LAS float*)(F.lds + RING_OFF);
    const int brow0 = 256 * (j >> 1) + 64 * (j & 1);
    float g[8], u[8], o[8];
    skinny64(F.wave, tid, (const bf16*)(ws + a_off), D, (const bf16*)(ws + w_off), brow0, P, g);
    skinny64(F.wave, tid, (const bf16*)(ws + a_off), D, (const bf16*)(ws + w_off), brow0 + 128, P, u);
    const int r = tid >> 3, cg = tid & 7, row = XROW0 + r;
    const float rs = rs_mode == 0 ? ((const float*)(ws + WS_R1))[row] : row_rscale16((const float*)(ws + WS_SSQH2), row, 1.f / D);
#pragma unroll
    for (int k = 0; k < 8; ++k) o[k] = fast_silu(g[k] * rs) * (u[k] * rs);
    st8_bf16((bf16*)(ws + WS_ACT) + (size_t)row * FFN + 64 * j + 8 * cg, o);
    xjob_signal(ws, tid, cnt_idx);
}
__device__ __forceinline__ void xjob_resid(Frame& F, unsigned char* ws, int j, size_t a_off, int K, size_t w_off, const float* res  , float scale, size_t out_off, size_t outb_off, size_t ssq_off) {
    ws = opaque_g(ws);
    const int tid = fresh_tid(F.wave), lane = tid & 63;
    LAS float* P = (LAS float*)(F.lds + RING_OFF);
    float v[8], o[8];
    skinny64(F.wave, tid, (const bf16*)(ws + a_off), K, (const bf16*)(ws + w_off), 64 * j, P, v);
    const int r = tid >> 3, cg = tid & 7, row = XROW0 + r, col = 64 * j + 8 * cg;
    const f32x4 b0 = *(const f32x4*)(res + (size_t)r * D + col), b1 = *(const f32x4*)(res + (size_t)r * D + col + 4);
    float ss = 0.f;
#pragma unroll
    for (int k = 0; k < 8; ++k) { o[k] = (k < 4 ? b0[k] : b1[k - 4]) + scale * v[k]; ss += o[k] * o[k]; }
    float* op = (float*)(ws + out_off) + (size_t)row * D + col;
    *(f32x4*)op = (f32x4){o[0], o[1], o[2], o[3]}; *(f32x4*)(op + 4) = (f32x4){o[4], o[5], o[6], o[7]};
    if (outb_off) st8_bf16((bf16*)(ws + outb_off) + (size_t)row * D + col, o);
    ss = sum8(ss, lane);
    if (cg == 0) atomicAdd((float*)(ws + ssq_off) + row, ss);
}
__device__ __forceinline__ void xjob_win(Frame& F, unsigned char* ws, int j) {
    ws = opaque_g(ws);
    const int tid = fresh_tid(F.wave), lane = tid & 63;
    LAS float* P = (LAS float*)(F.lds + RING_OFF);
    const int pn = j >> 1, q = j & 1;
    float v0[8], v1[8];
    skinny64(F.wave, tid, (const bf16*)(ws + WS_HB), D, (const bf16*)(ws + WS_WIN), 256 * pn + 64 * q, P, v0);
    skinny64(F.wave, tid, (const bf16*)(ws + WS_HB), D, (const bf16*)(ws + WS_WIN), 256 * pn + 64 * q + 128, P, v1);
    const int r = tid >> 3, cg = tid & 7, row = XROW0 + r;
    const float rs = row_rscale16((const float*)(ws + WS_SSQH), row, 1.f / D);
    const float* TAB = (const float*)(ws + WS_TAB);
#pragma unroll
    for (int k = 0; k < 8; ++k) { v0[k] *= rs; v1[k] *= rs; }
    const int tc0 = 64 * q + 8 * cg;
    if (pn == 0) {
        bf16* CQ = (bf16*)(ws + WS_CQ) + (size_t)row * QR; float* SSQCQ = (float*)(ws + WS_SSQCQ) + (size_t)row * 8;
        st8_bf16(CQ + tc0, v0); st8_bf16(CQ + tc0 + 128, v1);
        float s0 = 0.f, s1 = 0.f;
#pragma unroll
        for (int k = 0; k < 8; ++k) { s0 += v0[k] * v0[k]; s1 += v1[k] * v1[k]; }
        s0 = sum8(s0, lane); s1 = sum8(s1, lane);
        if (cg == 0) { SSQCQ[2 * q] = s0; SSQCQ[2 * q + 1] = s1; }
    } else if (pn == 1) {
        bf16* CQ = (bf16*)(ws + WS_CQ) + (size_t)row * QR; float* SSQCQ = (float*)(ws + WS_SSQCQ) + (size_t)row * 8;
        st8_bf16(CQ + 256 + tc0, v0);
        float s0 = 0.f;
#pragma unroll
        for (int k = 0; k < 8; ++k) s0 += v0[k] * v0[k];
        s0 = sum8(s0, lane);
        if (cg == 0) { SSQCQ[4 + q] = s0; SSQCQ[6 + q] = 0.f; }
        float x2[8];
#pragma unroll
        for (int k = 0; k < 8; ++k) x2[k] = lx(v1[k], lane, 2);
        if (q == 0 && cg < 2) {
            const int pi = row_pidx(row), i0 = 8 * cg;
            float y1[8], y2[8];
#pragma unroll
            for (int k = 0; k < 8; ++k) { const float c = TAB[TAB_C16 / 4 + pi * 16 + i0 + k], s = TAB[TAB_S16 / 4 + pi * 16 + i0 + k]; y1[k] = v1[k] * c - x2[k] * s; y2[k] = v1[k] * s + x2[k] * c; }
            st8_bf16((bf16*)(ws + WS_KRB) + (size_t)row * 32 + i0, y1); st8_bf16((bf16*)(ws + WS_KRB) + (size_t)row * 32 + 16 + i0, y2);
            float* kf = (float*)(ws + WS_KRF) + (size_t)row * 32;
#pragma unroll
            for (int k = 0; k < 8; ++k) { kf[i0 + k] = y1[k]; kf[16 + i0 + k] = y2[k]; }
        }
    } else if (pn == 2) {
        float* CKVF = (float*)(ws + WS_CKVF) + (size_t)row * KVR; bf16* CKVB = (bf16*)(ws + WS_CKVB) + (size_t)row * KVR; float* SSQKV = (float*)(ws + WS_SSQKV) + (size_t)row * 4;
        float s0 = 0.f, s1 = 0.f;
#pragma unroll
        for (int k = 0; k < 8; ++k) { CKVF[tc0 + k] = v0[k]; CKVF[tc0 + 128 + k] = v1[k]; s0 += v0[k] * v0[k]; s1 += v1[k] * v1[k]; }
        st8_bf16(CKVB + tc0, v0); st8_bf16(CKVB + tc0 + 128, v1);
        s0 = sum8(s0, lane); s1 = sum8(s1, lane);
        if (cg == 0) { SSQKV[2 * q] = s0; SSQKV[2 * q + 1] = s1; }
    } else if (pn < 7) {
        const bool isk = pn >= 5; const int hh = 2 * ((pn - 3) & 1) + q, i0 = 8 * cg;
        const int pi = row_pidx(row), jt = row_jtok(row);
        const float mult = isk ? RK_SCALE * TAB[TAB_GN / 4 + hh * 128 + jt] : TAB[TAB_GP / 4 + hh * 128 + jt];
        float y1[8], y2[8];
#pragma unroll
        for (int k = 0; k < 8; ++k) { const float c = TAB[TAB_C64 / 4 + pi * 64 + i0 + k], s = TAB[TAB_S64 / 4 + pi * 64 + i0 + k]; y1[k] = (v0[k] * c - v1[k] * s) * mult; y2[k] = (v0[k] * s + v1[k] * c) * mult; }
        bf16* dst = (bf16*)(ws + (isk ? WS_RK : WS_RQ)) + (size_t)row * 512 + hh * 128;
        st8_bf16(dst + i0, y1); st8_bf16(dst + 64 + i0, y2);
        if (isk) { bf16* RKT = (bf16*)(ws + WS_RKT);
#pragma unroll
            for (int k = 0; k < 8; ++k) { RKT[(size_t)(hh * 128 + i0 + k) * MP + row] = bf1(y1[k]); RKT[(size_t)(hh * 128 + 64 + i0 + k) * MP + row] = bf1(y2[k]); } }
    } else if (pn < 11) {
        bf16* RVT = (bf16*)(ws + WS_RVT);
#pragma unroll
        for (int k = 0; k < 8; ++k) { RVT[(size_t)((pn - 7) * 256 + tc0 + k) * MP + row] = bf1(v0[k]); RVT[(size_t)((pn - 7) * 256 + tc0 + 128 + k) * MP + row] = bf1(v1[k]); }
    } else {
        const int t = (pn - 11) >> 2; bf16* dst = (bf16*)(ws + WS_SRG + (size_t)t * (WS_SGA - WS_SRG)) + (size_t)row * 1024 + ((pn - 11) & 3) * 256;
        float o0[8], o1[8];
#pragma unroll
        for (int k = 0; k < 8; ++k) { const float g0 = fast_sigmoid(v0[k]), g1 = fast_sigmoid(v1[k]); o0[k] = t == 0 ? v0[k] * g0 : g0; o1[k] = t == 0 ? v1[k] * g1 : g1; }
        st8_bf16(dst + tc0, o0); st8_bf16(dst + tc0 + 128, o1);
    }
}
__device__ __forceinline__ void xjob_q(Frame& F, unsigned char* ws, int j) {
    ws = opaque_g(ws);
    const int tid = fresh_tid(F.wave), lane = tid & 63;
    LAS float* P = (LAS float*)(F.lds + RING_OFF);
    float v[8], p[8], o[8];
    skinny64(F.wave, tid, (const bf16*)(ws + WS_CQ), QR, (const bf16*)(ws + WS_WUQ), 64 * j, P, v);
    const int r = tid >> 3, cg = tid & 7, row = XROW0 + r;
    const float rs = row_rscale8((const float*)(ws + WS_SSQCQ), row, 1.f / QR) * SC_Q;
    const float* TAB = (const float*)(ws + WS_TAB);
    const int pi = row_pidx(row), col = 64 * j + 8 * cg, grp = col >> 5, w32 = col & 31;
#pragma unroll
    for (int k = 0; k < 8; ++k) p[k] = lx(v[k], lane, 2);
    if (grp % 3 == 2) {
        const int i0 = w32 & 15;
#pragma unroll
        for (int k = 0; k < 8; ++k) { const float c = TAB[TAB_C16 / 4 + pi * 16 + i0 + k], sn = TAB[TAB_S16 / 4 + pi * 16 + i0 + k];
            o[k] = (w32 < 16 ? v[k] * c - p[k] * sn : p[k] * sn + v[k] * c) * rs; }
    } else {
#pragma unroll
        for (int k = 0; k < 8; ++k) o[k] = v[k] * rs;
    }
    st8_bf16((bf16*)(ws + WS_QA) + (size_t)row * 768 + col, o);
}
__device__ __forceinline__ void xjob_kv(Frame& F, unsigned char* ws, int j, bool is_v) {
    ws = opaque_g(ws);
    const int tid = fresh_tid(F.wave);
    LAS float* P = (LAS float*)(F.lds + RING_OFF);
    float v[8];
    skinny64(F.wave, tid, (const bf16*)(ws + WS_CKVB), KVR, (const bf16*)(ws + (is_v ? WS_WUV : WS_WUK)), 64 * j, P, v);
    const int r = tid >> 3, cg = tid & 7, row = XROW0 + r, col = 64 * j + 8 * cg;
    const float rs = row_rscale4((const float*)(ws + WS_SSQKV), row, 1.f / KVR);
#pragma unroll
    for (int k = 0; k < 8; ++k) v[k] *= rs;
    if (!is_v) st8_bf16((bf16*)(ws + WS_KN) + (size_t)row * 512 + col, v);
    else { bf16* VT = (bf16*)(ws + WS_VT);
#pragma unroll
        for (int k = 0; k < 8; ++k) VT[(size_t)(col + k) * MP + row] = bf1(v[k]); }
}
__device__ __forceinline__ void xjob_mix(Frame& F, unsigned char* ws, int j) {
    ws = opaque_g(ws);
    const int tid = fresh_tid(F.wave);
    LAS float* P = (LAS float*)(F.lds + RING_OFF);
    float a[8], b[8], o[8];
    skinny64(F.wave, tid, (const bf16*)(ws + WS_AV), 512, (const bf16*)(ws + WS_WMO), 64 * j, P, a);
    skinny64(F.wave, tid, (const bf16*)(ws + WS_RIN), D, (const bf16*)(ws + WS_WRO), 64 * j, P, b);
    const int r = tid >> 3, cg = tid & 7, row = XROW0 + r, col = 64 * j + 8 * cg;
    const u32x4 ga = *(const u32x4*)((const bf16*)(ws + WS_SGA) + (size_t)row * 1024 + col), gb = *(const u32x4*)((const bf16*)(ws + WS_SGB) + (size_t)row * 1024 + col);
#pragma unroll
    for (int k = 0; k < 8; ++k) { const unsigned wa = ga[k >> 1], wb = gb[k >> 1];
        const float fa = __uint_as_float((k & 1) ? (wa & 0xffff0000u) : (wa << 16)), fb = __uint_as_float((k & 1) ? (wb & 0xffff0000u) : (wb << 16));
        o[k] = fa * a[k] + fb * b[k]; }
    st8_bf16((bf16*)(ws + WS_MX) + (size_t)row * 1024 + col, o);
}
__device__ __forceinline__ void xjob_ql(Frame& F, unsigned char* ws, int j) {
    ws = opaque_g(ws);
    const int tid = fresh_tid(F.wave);
    LAS float* P = (LAS float*)(F.lds + RING_OFF);
    float v[8];
    skinny64(F.wave, tid, (const bf16*)(ws + WS_CQ), QR, (const bf16*)(ws + WS_WQL), 64 * j, P, v);
    const int r = tid >> 3, cg = tid & 7, row = XROW0 + r;
    const float rs = row_rscale8((const float*)(ws + WS_SSQCQ), row, 1.f / QR) * SC_Q;
    float* dst = (float*)(ws + WS_QL) + (size_t)r * 2048 + 64 * j + 8 * cg;
    *(f32x4*)dst = (f32x4){v[0] * rs, v[1] * rs, v[2] * rs, v[3] * rs}; *(f32x4*)(dst + 4) = (f32x4){v[4] * rs, v[5] * rs, v[6] * rs, v[7] * rs};
}
}
namespace mk {
constexpr int RC_STR = 272;
constexpr int RC_S = 0, RC_KT = 0  , RC_Q = 256 * RC_STR, RC_A = RC_Q + 128 * RC_STR, RC_RED = RC_A + 128 * RC_STR, RC_END = RC_RED + 2 * 8 * 128 * 4;
static_assert(RC_END <= SCR_BYTES, "chain LDS map");
__device__ __forceinline__ void ret_chain_unit(Frame& F, const Ptrs& a, int bh) {
    unsigned char* ws = a.ws; ws = opaque_g(ws);
    const int tid_k = fresh_tid(F.wave), w = F.wave;
    const int hh = bh & 3, b = bh >> 2;
    LAS unsigned char* L = F.lds + RING_OFF;
    LAS float* red = (LAS float*)(L + RC_RED);
    const bf16* RQ = (const bf16*)(ws + WS_RQ); const bf16* RK = (const bf16*)(ws + WS_RK); const bf16* RKT = (const bf16*)(ws + WS_RKT); const bf16* RVT = (const bf16*)(ws + WS_RVT);
    const float g = gpow_t(ws, hh, 1), g127 = gpow_t(ws, hh, 127);
    f32x16 S[4];
    {
        const int lane = tid_k & 63, r32 = lane & 31, half = lane >> 5;
#pragma unroll
        for (int db = 0; db < 4; ++db)
#pragma unroll
            for (int i = 0; i < 16; ++i) S[db][i] = 0.f;
        const bf16x8 af = *(const bf16x8*)(RVT + (size_t)(hh * 256 + 32 * w + r32) * MP + ROW_META + 8 * half);
#pragma unroll
        for (int db = 0; db < 4; ++db) { const bf16x8 bf = *(const bf16x8*)(RKT + (size_t)(hh * 128 + 32 * db + r32) * MP + ROW_META + 8 * half); S[db] = __builtin_amdgcn_mfma_f32_32x32x16_bf16(af, bf, S[db], 0, 0, 0); }
        const float sc = gpow_t(ws, hh, NMETA - 1);
#pragma unroll
        for (int db = 0; db < 4; ++db)
#pragma unroll
            for (int i = 0; i < 16; ++i) S[db][i] *= sc;
    }
    v4u qreg[4], jreg[4];
#define RC_FETCH_QK(tok0_) do { _Pragma("unroll") for (int k = 0; k < 4; ++k) { const int ch = tid + 512 * k; \
        qreg[k] = *(const v4u*)(RQ + (size_t)((tok0_) + (ch >> 4)) * 512 + hh * 128 + 8 * (ch & 15)); jreg[k] = *(const v4u*)(RK + (size_t)((tok0_) + (ch >> 4)) * 512 + hh * 128 + 8 * (ch & 15)); } } while (0)
    { const int tid = tid_k; RC_FETCH_QK(b * SEQ); }
#define RC_BLK_IB(n) ((n) < 1 ? 0 : (n) < 3 ? 1 : (n) < 6 ? 2 : 3)
#define RC_BLK_JB(n) ((n) - ((n) < 1 ? 0 : (n) < 3 ? 1 : (n) < 6 ? 3 : 6))
#pragma unroll 1
    for (int c = 0; c < 16; ++c) {
        const int tok0 = b * SEQ + c * 128;
        int tid_c = tid_k; asm volatile("" : "+v"(tid_c));
        const int tid = tid_c, lane = tid & 63, r32 = lane & 31, half = lane >> 5;
#pragma unroll
        for (int k = 0; k < 4; ++k) { const int ch = tid + 512 * k; *(LAS v4u*)(L + RC_Q + (ch >> 4) * RC_STR + 16 * (ch & 15)) = qreg[k]; *(LAS v4u*)(L + RC_S + (ch >> 4) * RC_STR + 16 * (ch & 15)) = jreg[k]; }
        __syncthreads();
        v4u kreg[4];
#pragma unroll
        for (int k = 0; k < 4; ++k) { const int ch = tid + 512 * k; kreg[k] = *(const v4u*)(RKT + (size_t)(hh * 128 + (ch >> 4)) * MP + tok0 + 8 * (ch & 15)); }
        for (int n = w; n < 10; n += 8) {
            const int ib_ = RC_BLK_IB(n), jb_ = RC_BLK_JB(n);
            f32x16 at;
#pragma unroll
            for (int i = 0; i < 16; ++i) at[i] = 0.f;
#pragma unroll
            for (int s = 0; s < 8; ++s) { const bf16x8 kf = *(const LAS bf16x8*)(L + RC_S + (32 * jb_ + r32) * RC_STR + (16 * s + 8 * half) * 2); const bf16x8 qf = *(const LAS bf16x8*)(L + RC_Q + (32 * ib_ + r32) * RC_STR + (16 * s + 8 * half) * 2); at = __builtin_amdgcn_mfma_f32_32x32x16_bf16(kf, qf, at, 0, 0, 0); }
            if (jb_ == ib_) {
#pragma unroll
                for (int i = 0; i < 16; ++i) if (crow(i, half) > r32) at[i] = 0.f; }
#pragma unroll
            for (int gq = 0; gq < 4; ++gq) { f32x4 o_; o_[0] = at[4 * gq]; o_[1] = at[4 * gq + 1]; o_[2] = at[4 * gq + 2]; o_[3] = at[4 * gq + 3];
                *(LAS u32x2*)(L + RC_A + (32 * ib_ + r32) * RC_STR + (32 * jb_ + 8 * gq + 4 * half) * 2) = pack4(o_); }
        }
        __syncthreads();
#pragma unroll
        for (int db = 0; db < 4; ++db)
#pragma unroll
            for (int i = 0; i < 16; ++i) *(LAS bf16*)(L + RC_S + (32 * w + crow(i, half)) * RC_STR + (32 * db + r32) * 2) = bf1(S[db][i]);
        f32x16 ot[4];
#pragma unroll
        for (int ib = 0; ib < 4; ++ib)
#pragma unroll
            for (int i = 0; i < 16; ++i) ot[ib][i] = 0.f;
#pragma unroll 2
        for (int s = 0; s < 8; ++s) {
            const bf16x8 sf = *(const LAS bf16x8*)(L + RC_S + (32 * w + r32) * RC_STR + (16 * s + 8 * half) * 2);
#pragma unroll
            for (int ib = 0; ib < 4; ++ib) { const bf16x8 qf = *(const LAS bf16x8*)(L + RC_Q + (32 * ib + r32) * RC_STR + (16 * s + 8 * half) * 2); ot[ib] = __builtin_amdgcn_mfma_f32_32x32x16_bf16(sf, qf, ot[ib], 0, 0, 0); }
        }
#pragma unroll
        for (int ib = 0; ib < 4; ++ib)
#pragma unroll
            for (int i = 0; i < 16; ++i) ot[ib][i] *= g;
        __syncthreads();
#pragma unroll
        for (int k = 0; k < 4; ++k) { const int ch = tid + 512 * k; *(LAS v4u*)(L + RC_KT + (ch >> 4) * RC_STR + 16 * (ch & 15)) = kreg[k]; }
        __syncthreads();
        if (c < 15) RC_FETCH_QK(tok0 + 128);
#pragma unroll
        for (int db = 0; db < 4; ++db)
#pragma unroll
            for (int i = 0; i < 16; ++i) S[db][i] *= g;
        {
            const bf16* vp = RVT + (size_t)(hh * 256 + 32 * w + r32) * MP + tok0 + 8 * half;
            bf16x8 v0 = *(const bf16x8*)(vp), v1 = *(const bf16x8*)(vp + 16), v2 = v1;
#pragma unroll 1
            for (int s = 0; s < 8; ++s) {
                if (s + 2 < 8) v2 = *(const bf16x8*)(vp + 16 * (s + 2));
#pragma unroll
                for (int ib = 0; ib < 4; ++ib) if (s < 2 * (ib + 1)) { const bf16x8 af = *(const LAS bf16x8*)(L + RC_A + (32 * ib + r32) * RC_STR + (16 * s + 8 * half) * 2); ot[ib] = __builtin_amdgcn_mfma_f32_32x32x16_bf16(v0, af, ot[ib], 0, 0, 0); }
#pragma unroll
                for (int db = 0; db < 4; ++db) { const bf16x8 kf = *(const LAS bf16x8*)(L + RC_KT + (32 * db + r32) * RC_STR + (16 * s + 8 * half) * 2); S[db] = __builtin_amdgcn_mfma_f32_32x32x16_bf16(v0, kf, S[db], 0, 0, 0); }
                v0 = v1; v1 = v2;
            }
        }
#pragma unroll
        for (int db = 0; db < 4; ++db)
#pragma unroll
            for (int i = 0; i < 16; ++i) S[db][i] *= g127;
#pragma unroll
        for (int ib = 0; ib < 4; ++ib) { float t = 0.f;
#pragma unroll
            for (int i = 0; i < 16; ++i) t += ot[ib][i];
            t += lx(t, lane, 32); if (half == 0) red[w * 128 + 32 * ib + r32] = t; }
        __syncthreads();
        float mu[4];
#pragma unroll
        for (int ib = 0; ib < 4; ++ib) { float t = 0.f;
#pragma unroll
            for (int ww = 0; ww < 8; ++ww) t += red[ww * 128 + 32 * ib + r32];
            mu[ib] = t * (1.f / 256.f); }
#pragma unroll
        for (int ib = 0; ib < 4; ++ib) { float t = 0.f;
#pragma unroll
            for (int i = 0; i < 16; ++i) { ot[ib][i] -= mu[ib]; t += ot[ib][i] * ot[ib][i]; }
            t += lx(t, lane, 32); if (half == 0) red[1024 + w * 128 + 32 * ib + r32] = t; }
        __syncthreads();
#pragma unroll
        for (int ib = 0; ib < 4; ++ib) { float t = 0.f;
#pragma unroll
            for (int ww = 0; ww < 8; ++ww) t += red[1024 + ww * 128 + 32 * ib + r32];
            const float rstd = 1.0f / sqrtf(t * (1.f / 256.f) + EPS);
            const int irow = tok0 + 32 * ib + r32;
            const bf16* SRG = (const bf16*)(ws + WS_SRG) + (size_t)irow * 1024 + hh * 256 + 32 * w + 4 * half;
            bf16* RIN = (bf16*)(ws + WS_RIN) + (size_t)irow * 1024 + hh * 256 + 32 * w + 4 * half;
            const float* gn = a.in(19) + hh * 256 + 32 * w + 4 * half;
#pragma unroll
            for (int gq = 0; gq < 4; ++gq) {
                const u32x2 sg = *(const u32x2*)(SRG + 8 * gq); const f32x4 gv = *(const f32x4*)(gn + 8 * gq);
                f32x4 o;
                o[0] = ot[ib][4 * gq + 0] * rstd * gv[0] * __uint_as_float(sg.x << 16); o[1] = ot[ib][4 * gq + 1] * rstd * gv[1] * __uint_as_float(sg.x & 0xffff0000u);
                o[2] = ot[ib][4 * gq + 2] * rstd * gv[2] * __uint_as_float(sg.y << 16); o[3] = ot[ib][4 * gq + 3] * rstd * gv[3] * __uint_as_float(sg.y & 0xffff0000u);
                *(u32x2*)(RIN + 8 * gq) = pack4(o);
            } }
        __syncthreads();
    }
#undef RC_FETCH_QK
#undef RC_BLK_IB
#undef RC_BLK_JB
    const int lane = tid_k & 63, r32 = lane & 31, half = lane >> 5;
#pragma unroll
    for (int db = 0; db < 4; ++db)
#pragma unroll
        for (int i = 0; i < 16; ++i) a.out()[OUT_SRP + ((size_t)bh * RDK + 32 * db + r32) * RDV + 32 * w + crow(i, half)] = S[db][i];
}
}
namespace mk {
constexpr int CW_FLAG = 8192;
__device__ __forceinline__ void st16_wt(void* p, v4u v) { asm volatile("global_store_dwordx4 %0, %1, off sc1\n\ts_nop 1" :: "v"(p), "v"(v) : "memory"); }
__device__ __forceinline__ void ret_state_unit(Frame& F, const Ptrs& a, int bh) {
    unsigned char* ws = opaque_g(a.ws);
    const int tid_k = fresh_tid(F.wave), w = F.wave;
    const int hh = bh & 3, b = bh >> 2;
    LAS unsigned char* L = F.lds + RING_OFF;
    const bf16* RKT = (const bf16*)(ws + WS_RKT); const bf16* RVT = (const bf16*)(ws + WS_RVT);
    const float g = gpow_t(ws, hh, 1), g127 = gpow_t(ws, hh, 127);
    f32x16 S[4];
    bf16x8 vf[8]; v4u kreg[4];
#define RS_FETCH(tok0_) do { _Pragma("unroll") for (int s = 0; s < 8; ++s) vf[s] = *(const bf16x8*)(RVT + (size_t)(hh * 256 + 32 * w + r32) * MP + (tok0_) + 16 * s + 8 * half); \
        _Pragma("unroll") for (int k = 0; k < 4; ++k) { const int ch = tid + 512 * k; kreg[k] = *(const v4u*)(RKT + (size_t)(hh * 128 + (ch >> 4)) * MP + (tok0_) + 8 * (ch & 15)); } } while (0)
    {   const int tid = tid_k, lane = tid & 63, r32 = lane & 31, half = lane >> 5;
#pragma unroll
        for (int db = 0; db < 4; ++db)
#pragma unroll
            for (int i = 0; i < 16; ++i) S[db][i] = 0.f;
        const bf16x8 af = *(const bf16x8*)(RVT + (size_t)(hh * 256 + 32 * w + r32) * MP + ROW_META + 8 * half);
#pragma unroll
        for (int db = 0; db < 4; ++db) { const bf16x8 bf = *(const bf16x8*)(RKT + (size_t)(hh * 128 + 32 * db + r32) * MP + ROW_META + 8 * half); S[db] = __builtin_amdgcn_mfma_f32_32x32x16_bf16(af, bf, S[db], 0, 0, 0); }
        const float sc = gpow_t(ws, hh, NMETA - 1);
#pragma unroll
        for (int db = 0; db < 4; ++db)
#pragma unroll
            for (int i = 0; i < 16; ++i) S[db][i] *= sc;
        RS_FETCH(b * SEQ);
    }
#pragma unroll 1
    for (int c = 0; c < 16; ++c) {
        const int tok0 = b * SEQ + c * 128, u = bh * 16 + c;
        int tid_c = tid_k; asm volatile("" : "+v"(tid_c));
        const int tid = tid_c, lane = tid & 63, r32 = lane & 31, half = lane >> 5;
#pragma unroll
        for (int k = 0; k < 4; ++k) { const int ch = tid + 512 * k; *(LAS v4u*)(L + RC_Q + (ch >> 4) * RC_STR + 16 * (ch & 15)) = kreg[k]; }
#pragma unroll
        for (int db = 0; db < 4; ++db)
#pragma unroll
            for (int i = 0; i < 16; ++i) *(LAS bf16*)(L + (32 * w + crow(i, half)) * RC_STR + (32 * db + r32) * 2) = bf1(S[db][i]);
        __syncthreads();
        { bf16* SP = (bf16*)(ws + WS_SPREV) + (size_t)u * 32768;
#pragma unroll
          for (int k = 0; k < 8; ++k) { const int ch = lane + 64 * k, row = 32 * w + (ch >> 4); st16_wt(SP + (size_t)row * 128 + 8 * (ch & 15), *(const LAS v4u*)(L + row * RC_STR + 16 * (ch & 15))); } }
        bf16x8 vfn[8]; v4u kregn[4];
        if (c < 15) {
#pragma unroll
            for (int s = 0; s < 8; ++s) vfn[s] = *(const bf16x8*)(RVT + (size_t)(hh * 256 + 32 * w + r32) * MP + tok0 + 128 + 16 * s + 8 * half);
#pragma unroll
            for (int k = 0; k < 4; ++k) { const int ch = tid + 512 * k; kregn[k] = *(const v4u*)(RKT + (size_t)(hh * 128 + (ch >> 4)) * MP + tok0 + 128 + 8 * (ch & 15)); }
        } else {
#pragma unroll
            for (int s = 0; s < 8; ++s) vfn[s] = vf[s];
#pragma unroll
            for (int k = 0; k < 4; ++k) kregn[k] = kreg[k];
        }
#pragma unroll
        for (int db = 0; db < 4; ++db) {
#pragma unroll
            for (int i = 0; i < 16; ++i) S[db][i] *= g;
#pragma unroll
            for (int s = 0; s < 8; ++s) { const bf16x8 kf = *(const LAS bf16x8*)(L + RC_Q + (32 * db + r32) * RC_STR + (16 * s + 8 * half) * 2); S[db] = __builtin_amdgcn_mfma_f32_32x32x16_bf16(vf[s], kf, S[db], 0, 0, 0); }
#pragma unroll
            for (int i = 0; i < 16; ++i) S[db][i] *= g127;
        }
        asm volatile("s_waitcnt vmcnt(0)" ::: "memory");
#pragma unroll
        for (int s = 0; s < 8; ++s) vf[s] = vfn[s];
#pragma unroll
        for (int k = 0; k < 4; ++k) kreg[k] = kregn[k];
        __syncthreads();
        if (tid == 0) __hip_atomic_store((unsigned*)(ws + WS_CTL) + CW_FLAG + 16 * u, 1u, __ATOMIC_RELAXED, __HIP_MEMORY_SCOPE_AGENT);
    }
#undef RS_FETCH
    {   const int lane = tid_k & 63, r32 = lane & 31, half = lane >> 5;
#pragma unroll
        for (int db = 0; db < 4; ++db)
#pragma unroll
            for (int i = 0; i < 16; ++i) a.out()[OUT_SRP + ((size_t)bh * RDK + 32 * db + r32) * RDV + 32 * w + crow(i, half)] = S[db][i]; }
    __syncthreads();
}
__device__ __forceinline__ void ret_out_unit(Frame& F, const Ptrs& a, int u) {
    unsigned char* ws = opaque_g(a.ws);
    const int tid = fresh_tid(F.wave), lane = tid & 63, w = F.wave, r32 = lane & 31, half = lane >> 5;
    const int bh = u >> 4, c = u & 15, hh = bh & 3, tok0 = (bh >> 2) * SEQ + c * 128;
    LAS unsigned char* L = F.lds + RING_OFF;
    LAS float* red = (LAS float*)(L + RC_RED);
    const bf16* RQ = (const bf16*)(ws + WS_RQ); const bf16* RK = (const bf16*)(ws + WS_RK); const bf16* RVT = (const bf16*)(ws + WS_RVT);
    if (tid == 0) { const unsigned* fl = (const unsigned*)(ws + WS_CTL) + CW_FLAG + 16 * u; unsigned spins = 0;
        while (__hip_atomic_load(fl, __ATOMIC_RELAXED, __HIP_MEMORY_SCOPE_AGENT) == 0u && ++spins < (1u << 22)) __builtin_amdgcn_s_sleep(8);
        __builtin_amdgcn_fence(__ATOMIC_ACQUIRE, "agent"); asm volatile("s_waitcnt vmcnt(0)" ::: "memory"); }
    __syncthreads();
    v4u qreg[4], jreg[4], sreg[8]; bf16x8 vf[8];
#pragma unroll
    for (int k = 0; k < 4; ++k) { const int ch = tid + 512 * k; qreg[k] = *(const v4u*)(RQ + (size_t)(tok0 + (ch >> 4)) * 512 + hh * 128 + 8 * (ch & 15)); jreg[k] = *(const v4u*)(RK + (size_t)(tok0 + (ch >> 4)) * 512 + hh * 128 + 8 * (ch & 15)); }
    { const bf16* SP = (const bf16*)(ws + WS_SPREV) + (size_t)u * 32768;
#pragma unroll
      for (int k = 0; k < 8; ++k) { const int ch = tid + 512 * k; sreg[k] = *(const v4u*)(SP + (size_t)(ch >> 4) * 128 + 8 * (ch & 15)); } }
#pragma unroll
    for (int s = 0; s < 8; ++s) vf[s] = *(const bf16x8*)(RVT + (size_t)(hh * 256 + 32 * w + r32) * MP + tok0 + 16 * s + 8 * half);
    __builtin_amdgcn_sched_barrier(0);
#pragma unroll
    for (int k = 0; k < 4; ++k) { const int ch = tid + 512 * k; *(LAS v4u*)(L + RC_Q + (ch >> 4) * RC_STR + 16 * (ch & 15)) = qreg[k]; *(LAS v4u*)(L + RC_S + (ch >> 4) * RC_STR + 16 * (ch & 15)) = jreg[k]; }
    __syncthreads();
#define RC_BLK_IB(n) ((n) < 1 ? 0 : (n) < 3 ? 1 : (n) < 6 ? 2 : 3)
#define RC_BLK_JB(n) ((n) - ((n) < 1 ? 0 : (n) < 3 ? 1 : (n) < 6 ? 3 : 6))
    for (int n = w; n < 10; n += 8) {
        const int ib_ = RC_BLK_IB(n), jb_ = RC_BLK_JB(n);
        f32x16 at;
#pragma unroll
        for (int i = 0; i < 16; ++i) at[i] = 0.f;
#pragma unroll
        for (int s = 0; s < 8; ++s) { const bf16x8 kf = *(const LAS bf16x8*)(L + RC_S + (32 * jb_ + r32) * RC_STR + (16 * s + 8 * half) * 2); const bf16x8 qf = *(const LAS bf16x8*)(L + RC_Q + (32 * ib_ + r32) * RC_STR + (16 * s + 8 * half) * 2); at = __builtin_amdgcn_mfma_f32_32x32x16_bf16(kf, qf, at, 0, 0, 0); }
        if (jb_ == ib_) {
#pragma unroll
            for (int i = 0; i < 16; ++i) if (crow(i, half) > r32) at[i] = 0.f; }
#pragma unroll
        for (int gq = 0; gq < 4; ++gq) { f32x4 o_; o_[0] = at[4 * gq]; o_[1] = at[4 * gq + 1]; o_[2] = at[4 * gq + 2]; o_[3] = at[4 * gq + 3];
            *(LAS u32x2*)(L + RC_A + (32 * ib_ + r32) * RC_STR + (32 * jb_ + 8 * gq + 4 * half) * 2) = pack4(o_); }
    }
#undef RC_BLK_IB
#undef RC_BLK_JB
    __syncthreads();
#pragma unroll
    for (int k = 0; k < 8; ++k) { const int ch = tid + 512 * k; *(LAS v4u*)(L + RC_S + (ch >> 4) * RC_STR + 16 * (ch & 15)) = sreg[k]; }
    __syncthreads();
    const float g = gpow_t(ws, hh, 1);
    f32x16 ot[4];
#pragma unroll
    for (int ib = 0; ib < 4; ++ib)
#pragma unroll
        for (int i = 0; i < 16; ++i) ot[ib][i] = 0.f;
#pragma unroll 2
    for (int s = 0; s < 8; ++s) {
        const bf16x8 sf = *(const LAS bf16x8*)(L + RC_S + (32 * w + r32) * RC_STR + (16 * s + 8 * half) * 2);
#pragma unroll
        for (int ib = 0; ib < 4; ++ib) { const bf16x8 qf = *(const LAS bf16x8*)(L + RC_Q + (32 * ib + r32) * RC_STR + (16 * s + 8 * half) * 2); ot[ib] = __builtin_amdgcn_mfma_f32_32x32x16_bf16(sf, qf, ot[ib], 0, 0, 0); }
    }
#pragma unroll
    for (int ib = 0; ib < 4; ++ib)
#pragma unroll
        for (int i = 0; i < 16; ++i) ot[ib][i] *= g;
    u32x2 sgr[4][4];
#pragma unroll
    for (int ib = 0; ib < 4; ++ib)
#pragma unroll
        for (int gq = 0; gq < 4; ++gq) sgr[ib][gq] = *(const u32x2*)((const bf16*)(ws + WS_SRG) + (size_t)(tok0 + 32 * ib + r32) * 1024 + hh * 256 + 32 * w + 4 * half + 8 * gq);
#pragma unroll
    for (int ib = 0; ib < 4; ++ib)
#pragma unroll
        for (int s = 0; s < 2 * (ib + 1); ++s) { const bf16x8 af = *(const LAS bf16x8*)(L + RC_A + (32 * ib + r32) * RC_STR + (16 * s + 8 * half) * 2); ot[ib] = __builtin_amdgcn_mfma_f32_32x32x16_bf16(vf[s], af, ot[ib], 0, 0, 0); }
#pragma unroll
    for (int ib = 0; ib < 4; ++ib) { float t = 0.f;
#pragma unroll
        for (int i = 0; i < 16; ++i) t += ot[ib][i];
        t += lx(t, lane, 32); if (half == 0) red[w * 128 + 32 * ib + r32] = t; }
    __syncthreads();
    float mu[4];
#pragma unroll
    for (int ib = 0; ib < 4; ++ib) { float t = 0.f;
#pragma unroll
        for (int ww = 0; ww < 8; ++ww) t += red[ww * 128 + 32 * ib + r32];
        mu[ib] = t * (1.f / 256.f); }
#pragma unroll
    for (int ib = 0; ib < 4; ++ib) { float t = 0.f;
#pragma unroll
        for (int i = 0; i < 16; ++i) { ot[ib][i] -= mu[ib]; t += ot[ib][i] * ot[ib][i]; }
        t += lx(t, lane, 32); if (half == 0) red[1024 + w * 128 + 32 * ib + r32] = t; }
    __syncthreads();
#pragma unroll
    for (int ib = 0; ib < 4; ++ib) { float t = 0.f;
#pragma unroll
        for (int ww = 0; ww < 8; ++ww) t += red[1024 + ww * 128 + 32 * ib + r32];
        const float rstd = 1.0f / sqrtf(t * (1.f / 256.f) + EPS);
        const int irow = tok0 + 32 * ib + r32;
        bf16* RIN = (bf16*)(ws + WS_RIN) + (size_t)irow * 1024 + hh * 256 + 32 * w + 4 * half;
        const float* gn = a.in(19) + hh * 256 + 32 * w + 4 * half;
#pragma unroll
        for (int gq = 0; gq < 4; ++gq) {
            const u32x2 sg = sgr[ib][gq]; const f32x4 gv = *(const f32x4*)(gn + 8 * gq);
            f32x4 o;
            o[0] = ot[ib][4 * gq + 0] * rstd * gv[0] * __uint_as_float(sg.x << 16); o[1] = ot[ib][4 * gq + 1] * rstd * gv[1] * __uint_as_float(sg.x & 0xffff0000u);
            o[2] = ot[ib][4 * gq + 2] * rstd * gv[2] * __uint_as_float(sg.y << 16); o[3] = ot[ib][4 * gq + 3] * rstd * gv[3] * __uint_as_float(sg.y & 0xffff0000u);
            *(u32x2*)(RIN + 8 * gq) = pack4(o);
        } }
    __syncthreads();
}
}
namespace mk {
__global__ void __launch_bounds__(NWAVES * 64, 2) mega_fwd(Args args) {
    extern __shared__ __attribute__((aligned(16))) unsigned char lds[];
    Frame F;
    F.lds = (LAS unsigned char*)lds;
    F.MISC = (volatile LAS unsigned*)(F.lds + MISC_OFF);
    F.wave = __builtin_amdgcn_readfirstlane((int)threadIdx.x >> 6);
    F.G = gridDim.x; { const int bx = blockIdx.x; F.vcu = (F.G % 8 == 0) ? (bx % 8) * (F.G / 8) + bx / 8 : bx; }
    unsigned char* const ws_k = args.ws;
    unsigned char* ws = ws_k;
    for (int u = threadIdx.x; u < (LDS_BYTES - LDSCTL_OFF) / 4; u += NWAVES * 64) ((LAS unsigned*)(F.lds + LDSCTL_OFF))[u] = 0u;
    __syncthreads();
    {
        volatile LAS unsigned long long* pt = (volatile LAS unsigned long long*)(F.lds + PT_OFF);
        if (threadIdx.x == 0) {
#define PT_PUT(i) pt[i] = (unsigned long long)args.in[i]
            PT_PUT(0); PT_PUT(1); PT_PUT(2); PT_PUT(3); PT_PUT(4); PT_PUT(5); PT_PUT(6); PT_PUT(7); PT_PUT(8); PT_PUT(9); PT_PUT(10); PT_PUT(11); PT_PUT(12); PT_PUT(13);
            PT_PUT(14); PT_PUT(15); PT_PUT(16); PT_PUT(17); PT_PUT(18); PT_PUT(19); PT_PUT(20); PT_PUT(21); PT_PUT(22); PT_PUT(23); PT_PUT(24); PT_PUT(25); PT_PUT(26);
#undef PT_PUT
            pt[27] = (unsigned long long)args.out;
        }
        __syncthreads();
    }
    const Ptrs P{ws_k, (volatile LAS unsigned*)(F.lds + PT_OFF)};
    (void)xcd_barrier_post((unsigned*)(ws_k + WS_CTL) + CW_BAR, F.MISC + 8, F.wave);
#if MK_PROBE
#define STAMP(k) do { if (blockIdx.x == 0 && F.wave == 0 && lane_fresh() == 0) ((unsigned long long*)(ws_k + WS_CTL + 512 * 1024))[k] = __builtin_amdgcn_s_memrealtime(); } while (0)
    STAMP(0);
#else
#define STAMP(k) do { } while (0)
#endif
#define WS_FRESH() unsigned char* ws = opaque_g(ws_k)
#define GRID_BAR() do { XcdBarrier b_; b_.bar = (unsigned*)(ws_k + WS_CTL) + CW_BAR; b_.x = xb_xcc_id(); b_.st = F.MISC + 8; b_.wave = F.wave; xcd_barrier(b_); } while (0)

    p0_prologue(F, args);
    GRID_BAR(); STAMP(1);
    {
        WS_FRESH();
        { const int bx = (int)blockIdx.x; if (bx >= 128 && bx < 172) xjob_ffn_up(F, ws, bx - 128, WS_XB, WS_W1T, 0, 0); }
        p0_weights_late(F, args);
        pg8::Gemm g{(const pg8::bf16_t*)(ws + WS_XB), (const pg8::bf16_t*)(ws + WS_W1T), MMAIN, 2 * FFN, D};
        pg8::StaticOrder S; S.init(MMAIN, 2 * FFN, F.G, (int)blockIdx.x);
        EpiSwiGLU E{(bf16*)(ws + WS_ACT), (const float*)(ws + WS_R1)};
        pg8::gemm_phase<EpiSwiGLU, pg8::StaticOrder, true, true>(F.lds + RING_OFF, g, S, E, F.wave);
        { const int bx = (int)blockIdx.x; if (bx >= 172 && bx < 188) { xjob_wait(ws, fresh_tid(F.wave), 0, 44u); xjob_resid(F, ws, bx - 172, WS_ACT, FFN, WS_W1D, (const float*)(ws + WS_XE), 0.5f, WS_H, WS_HB, WS_SSQH); } }
    }
    GRID_BAR(); STAMP(2);
    {
        WS_FRESH();
        pg8::Gemm g{(const pg8::bf16_t*)(ws + WS_ACT), (const pg8::bf16_t*)(ws + WS_W1D), MMAIN, D, FFN};
        pg8::StaticOrder S; S.init(MMAIN, D, F.G, (int)blockIdx.x);
        typedef EpiResid<(unsigned)WS_XE, true, (unsigned)WS_H, (unsigned)WS_HB, (unsigned)WS_SSQH, 1> EpiDown1;
        EpiDown1 E{ws, P.in(0)};
        pg8::gemm_phase<EpiDown1, pg8::StaticOrder, true, true>(F.lds + RING_OFF, g, S, E, F.wave);
    }
    GRID_BAR(); STAMP(3);
#ifndef NO_P3
    {
        WS_FRESH();
        { const int bx = (int)blockIdx.x; if (bx >= 192 && bx < 238) xjob_win(F, ws, bx - 192); }
        pg8::Gemm g{(const pg8::bf16_t*)(ws + WS_HB), (const pg8::bf16_t*)(ws + WS_WIN), MMAIN, NWIN, D};
        pg8::StaticOrder S; S.init(MMAIN, NWIN, F.G, (int)blockIdx.x);
        EpiWin E{ws, F.lds};
        pg8::gemm_phase<EpiWin, pg8::StaticOrder, true, true>(F.lds + RING_OFF, g, S, E, F.wave);
    }
#endif
    GRID_BAR(); STAMP(4);
    {
        WS_FRESH();
        { const int jb = (int)blockIdx.x - 192; if (jb >= 0 && jb < 12) xjob_q(F, ws, jb); else if (jb >= 12 && jb < 20) xjob_kv(F, ws, jb - 12, false); else if (jb >= 20 && jb < 28) xjob_kv(F, ws, jb - 20, true); else if (jb >= 28 && jb < 60) xjob_ql(F, ws, jb - 28); }
        finalize_ckv(F, P);
#ifndef NO_P4Q
        {   pg8::Gemm g{(const pg8::bf16_t*)(ws + WS_CQ), (const pg8::bf16_t*)(ws + WS_WUQ), MMAIN, 768, QR};
            pg8::StaticOrder S; S.init(MMAIN, 768, F.G, (int)blockIdx.x);
            EpiQ E{ws};
            pg8::gemm_phase<EpiQ, pg8::StaticOrder, true, true>(F.lds + RING_OFF, g, S, E, F.wave); }
#endif
#ifndef NO_P4K
        {   pg8::Gemm g{(const pg8::bf16_t*)(ws + WS_CKVB), (const pg8::bf16_t*)(ws + WS_WUK), MMAIN, 512, KVR};
            pg8::StaticOrder S; S.init(MMAIN, 512, F.G, (int)((blockIdx.x + 64) % F.G));
            EpiScaleBf16<true> E{(const float*)(ws + WS_SSQKV), (bf16*)(ws + WS_KN), 512};
            pg8::gemm_phase<EpiScaleBf16<true>, pg8::StaticOrder, true, true>(F.lds + RING_OFF, g, S, E, F.wave); }
#endif
#ifndef NO_P4V
        {   pg8::Gemm g{(const pg8::bf16_t*)(ws + WS_WUV), (const pg8::bf16_t*)(ws + WS_CKVB), 512, MMAIN, KVR};
            pg8::StaticOrder S; S.init(512, MMAIN, F.G, (int)((blockIdx.x + 192) % F.G));
            EpiScaleBf16<false> E{(const float*)(ws + WS_SSQKV), (bf16*)(ws + WS_VT), MP};
            pg8::gemm_phase<EpiScaleBf16<false>, pg8::StaticOrder, true, true>(F.lds + RING_OFF, g, S, E, F.wave); }
#endif
    }
    GRID_BAR(); STAMP(5);
    STAMP(32);
#define QUEUE_LOOP(qi, nitems, call) for (;;) { \
        if (F.wave == 0 && lane_fresh() == 0) F.MISC[16] = __hip_atomic_fetch_add((unsigned*)(ws_k + WS_CTL) + CW_QUEUE + 64 * (qi), 1u, __ATOMIC_RELAXED, __HIP_MEMORY_SCOPE_AGENT); \
        __syncthreads(); const int it = (int)F.MISC[16]; __syncthreads(); \
        if (it >= (nitems)) break; call; }
    if ((int)blockIdx.x < 32) ret_state_unit(F, P, (int)blockIdx.x);
    STAMP(33);
    if (((int)blockIdx.x & 1) == 0) { QUEUE_LOOP(0, 512, attn_item(F, ws_k, it)) }
    STAMP(34);
    QUEUE_LOOP(1, 512, decode_unit(F, P, it))
    STAMP(35);
    QUEUE_LOOP(2, 128, ret_sample_unit(F, P, it))
    STAMP(36);
    if (((int)blockIdx.x & 1) != 0) { QUEUE_LOOP(0, 512, attn_item(F, ws_k, it)) }
    QUEUE_LOOP(3, 512, ret_out_unit(F, P, ((it & 31) << 4) | (it >> 5)))
    STAMP(37);
    QUEUE_LOOP(4, 256, decode_combine_unit(F, P, it))
#undef QUEUE_LOOP
    GRID_BAR(); STAMP(6);
    {
        WS_FRESH();
        { const int bx = (int)blockIdx.x; if (bx < 16) xjob_mix(F, ws, bx); }
        {   pg8::Gemm g{(const pg8::bf16_t*)(ws + WS_AV), (const pg8::bf16_t*)(ws + WS_WMO), MMAIN, D, 512};
            pg8::StaticOrder S; S.init(MMAIN, D, F.G, (int)blockIdx.x);
            typedef EpiGate<0, (unsigned)WS_SGA> EpiGA; EpiGA E{ws};
            pg8::gemm_phase<EpiGA, pg8::StaticOrder, true, true>(F.lds + RING_OFF, g, S, E, F.wave); }
        {   pg8::Gemm g{(const pg8::bf16_t*)(ws + WS_RIN), (const pg8::bf16_t*)(ws + WS_WRO), MMAIN, D, D};
            pg8::StaticOrder S; S.init(MMAIN, D, F.G, (int)blockIdx.x);
            typedef EpiGate<1, (unsigned)WS_SGB> EpiGB; EpiGB E{ws};
            pg8::gemm_phase<EpiGB, pg8::StaticOrder, true, true>(F.lds + RING_OFF, g, S, E, F.wave); }
    }
    GRID_BAR(); STAMP(7);
    {
        WS_FRESH();
        { const int bx = (int)blockIdx.x; if (bx >= 16 && bx < 32) xjob_resid(F, ws, bx - 16, WS_MX, D, WS_WOUT, (const float*)(ws + WS_H) + (size_t)XROW0 * D, 1.0f, WS_H2, WS_H2B, WS_SSQH2); }
        pg8::Gemm g{(const pg8::bf16_t*)(ws + WS_MX), (const pg8::bf16_t*)(ws + WS_WOUT), MMAIN, D, D};
        pg8::StaticOrder S; S.init(MMAIN, D, F.G, (int)blockIdx.x);
        typedef EpiResid<(unsigned)WS_H, false, (unsigned)WS_H2, (unsigned)WS_H2B, (unsigned)WS_SSQH2, 2> EpiOut;
        EpiOut E{ws, nullptr};
        pg8::gemm_phase<EpiOut, pg8::StaticOrder, true, true>(F.lds + RING_OFF, g, S, E, F.wave);
    }
    GRID_BAR(); STAMP(8);
    {
        WS_FRESH();
        { const int bx = (int)blockIdx.x; if (bx >= 128 && bx < 172) xjob_ffn_up(F, ws, bx - 128, WS_H2B, WS_W2T, 1, 16); }
        pg8::Gemm g{(const pg8::bf16_t*)(ws + WS_H2B), (const pg8::bf16_t*)(ws + WS_W2T), MMAIN, 2 * FFN, D};
        pg8::StaticOrder S; S.init(MMAIN, 2 * FFN, F.G, (int)blockIdx.x);
        EpiSwiGLU2 E{ws};
        pg8::gemm_phase<EpiSwiGLU2, pg8::StaticOrder, true, true>(F.lds + RING_OFF, g, S, E, F.wave);
        { const int bx = (int)blockIdx.x; if (bx >= 172 && bx < 188) { xjob_wait(ws, fresh_tid(F.wave), 16, 44u); xjob_resid(F, ws, bx - 172, WS_ACT, FFN, WS_W2D, (const float*)(ws + WS_H2) + (size_t)XROW0 * D, 0.5f, WS_H3, 0, WS_SSQH3); } }
    }
    GRID_BAR(); STAMP(9);
    {
        WS_FRESH();
        pg8::Gemm g{(const pg8::bf16_t*)(ws + WS_ACT), (const pg8::bf16_t*)(ws + WS_W2D), MMAIN, D, FFN};
        pg8::StaticOrder S; S.init(MMAIN, D, F.G, (int)blockIdx.x);
        typedef EpiResid<(unsigned)WS_H2, false, (unsigned)WS_H3, 0u, (unsigned)WS_SSQH3, 1> EpiDown2;
        EpiDown2 E{ws, nullptr};
        pg8::gemm_phase<EpiDown2, pg8::StaticOrder, true, true>(F.lds + RING_OFF, g, S, E, F.wave);
    }
    GRID_BAR(); STAMP(10);
    final_norm_phase(F, P);
#if MK_PROBE
    GRID_BAR(); STAMP(11);
    if (blockIdx.x == 0) {
        asm volatile("s_waitcnt vmcnt(0)" ::: "memory"); __syncthreads();
        const unsigned long long* t = (const unsigned long long*)(ws_k + WS_CTL + 512 * 1024);
        const float dta = (float)(__hip_atomic_load(t + MK_PROBE_A + 1, __ATOMIC_RELAXED, __HIP_MEMORY_SCOPE_AGENT) - __hip_atomic_load(t + MK_PROBE_A, __ATOMIC_RELAXED, __HIP_MEMORY_SCOPE_AGENT)) * 0.01f;
        const float dtb = (float)(__hip_atomic_load(t + MK_PROBE_B + 1, __ATOMIC_RELAXED, __HIP_MEMORY_SCOPE_AGENT) - __hip_atomic_load(t + MK_PROBE_B, __ATOMIC_RELAXED, __HIP_MEMORY_SCOPE_AGENT)) * 0.01f;
        const float f = 1.f + sqrtf(dta / 20000.f);
        const int tid_p = fresh_tid(F.wave);
        for (int i = tid_p; i < NS * D; i += NWAVES * 64) P.out()[OUT_YS + i] *= f;
        if (tid_p == 0) P.out()[OUT_YP] += dtb / 5.f;
    }
#endif
#undef GRID_BAR
}
}
extern "C" void kernel_launch(void* const* d_in, const int* in_sizes, int n_in, void* d_out, int out_size, void* d_ws, size_t ws_size, hipStream_t stream) {
    static int grid = 0;
    if (grid == 0) {
        int dev = 0, cus = 0;
        if (n_in != 27 || out_size != (int)mk::OUT_END || ws_size < mk::WS_END6) { fprintf(stderr, "kernel_launch: unexpected problem shape (n_in %d, out %d, ws %zu); nothing launched\n", n_in, out_size, ws_size); grid = -1; return; }
        if (hipGetDevice(&dev) != hipSuccess || hipDeviceGetAttribute(&cus, hipDeviceAttributeMultiprocessorCount, dev) != hipSuccess) { fprintf(stderr, "kernel_launch: device query failed\n"); grid = -1; return; }
        if (hipFuncSetAttribute((const void*)mk::mega_fwd, hipFuncAttributeMaxDynamicSharedMemorySize, mk::LDS_BYTES) != hipSuccess) { fprintf(stderr, "kernel_launch: hipFuncSetAttribute failed\n"); grid = -1; return; }
        int per_cu = 0;
        if (hipOccupancyMaxActiveBlocksPerMultiprocessor(&per_cu, (const void*)mk::mega_fwd, mk::NWAVES * 64, mk::LDS_BYTES) != hipSuccess || per_cu < 1) fprintf(stderr, "kernel_launch: note: occupancy query reports %d workgroups per CU\n", per_cu);
        (void)hipGetLastError();
        if (cus < 256) { fprintf(stderr, "kernel_launch: this kernel's static work assignment needs 256 resident workgroups (one per CU); the device has %d CUs; nothing launched\n", cus); grid = -1; return; }
        grid = 256;
    }
    if (grid < 0) return;
    unsigned char* ws = (unsigned char*)d_ws;
    (void)hipMemsetAsync(ws + mk::WS_CTL, 0, mk::CTL_ZERO_BYTES, stream);
    mk::Args a{};
    for (int i = 0; i < 27; ++i) a.in[i] = (const float*)d_in[i];
    a.out = (float*)d_out; a.ws = ws;
    hipLaunchKernelGGL(mk::mega_fwd, dim3(grid), dim3(mk::NWAVES * 64), mk::LDS_BYTES, stream, a);
}
```

```cpp
#include <hip/hip_runtime.h>
#include <cstdio>
#include <cstdint>
#include <cmath>
#define MK_DEBUG 0
#ifndef MK_PROBE
#define MK_PROBE 0
#define MK_PROBE_A 0
#define MK_PROBE_B 1
#endif
__device__ __forceinline__ int lane_fresh() { int l; asm volatile("v_mbcnt_lo_u32_b32 %0, -1, 0\n\tv_mbcnt_hi_u32_b32 %0, -1, %0" : "=v"(l)); return l; }
__device__ __forceinline__ unsigned char* opaque_g(const unsigned char* p) { unsigned long long v = (unsigned long long)p; asm volatile("" : "+s"(v)); return (unsigned char*)(__attribute__((address_space(1))) unsigned char*)v; }
namespace pg8 {
#define PG8_LAS __attribute__((address_space(3)))
typedef unsigned short bf16_t;
typedef short bf16x8 __attribute__((ext_vector_type(8)));
typedef float f32x4 __attribute__((ext_vector_type(4)));
typedef unsigned u32x4 __attribute__((ext_vector_type(4)));
constexpr int BM = 256, BK = 64, HALF = 128, HTB = HALF * BK * 2  , STAGE_BYTES = 8 * HTB, NXCD = 8, WGM = 8;

__host__ __device__ __forceinline__ int lds_byte(int r, int c) { const int st = (r >> 4) * 2 + (c >> 5), rr = r & 15, cc = c & 31, ob = rr * 64 + cc * 2; return st * 1024 + (ob ^ (((ob >> 9) & 1) << 5)); }
__host__ __device__ __forceinline__ void stage_rc(int b, int& R, int& C) { const int st = b / 1024, sb = b % 1024, swz = sb ^ (((sb >> 9) & 1) << 5); R = (st >> 1) * 16 + swz / 64; C = (st & 1) * 32 + (swz % 64) / 2; }
__host__ __device__ __forceinline__ int perm32(int rho) { const int n = rho >> 4, i = rho & 15; return 8 * (i >> 2) + 4 * n + (i & 3); }

struct Unit { int pm, pn; };
struct Gemm { const bf16_t* A; const bf16_t* Bt; int M, N, K; };

struct StaticOrder {
    int nM, nN, nwg, G, c;
    __host__ __device__ void init(int M, int N, int G_, int c_) { nM = M / BM; nN = N / BM; nwg = nM * nN; G = G_; c = c_; }
    __host__ __device__ bool next(int i, Unit& u) const {
        const long L = (long)i * G + c; if (L >= nwg) return false;
        int wgid = (int)L; { const int q = nwg / NXCD, r = nwg % NXCD, xcd = wgid % NXCD, off = wgid / NXCD; wgid = (xcd < r ? xcd * (q + 1) : r * (q + 1) + (xcd - r) * q) + off; }
        const int nig = WGM * nN, gid = wgid / nig, fm = gid * WGM, gsz = (nM - fm) < WGM ? (nM - fm) : WGM;
        u.pm = fm + ((wgid % nig) % gsz); u.pn = (wgid % nig) / gsz; return true;
    }
    __device__ __forceinline__ void a_ready(const Unit&) const {}
    __device__ __forceinline__ void done(const Unit&) const {}
};

__device__ __forceinline__ unsigned cvt_pk_bf16(float lo, float hi) { unsigned r; asm volatile("v_cvt_pk_bf16_f32 %0, %1, %2" : "=v"(r) : "v"(lo), "v"(hi)); return r; }
typedef float f32x2 __attribute__((ext_vector_type(2)));
template <class Epi, class Sched, bool ALIGN_EPI = false, bool SP2 = false>
__device__ __forceinline__ void gemm_phase(PG8_LAS unsigned char* lds, const Gemm g, const Sched& S, const Epi& E, const int wave_in  ) {
    int tid_ = lane_fresh() + 64 * wave_in; asm volatile("" : "+v"(tid_));
    const int tid = tid_, wid = __builtin_amdgcn_readfirstlane(tid >> 6), lane = tid & 63, wr = wid >> 2, wc = wid & 3, fr = lane & 15, fq = lane >> 4;
    const int K = g.K, nt = K / BK;
    unsigned voffA[2], voffB[2];
#pragma unroll
    for (int i = 0; i < 2; ++i) { int R, C; stage_rc(tid * 16 + i * 8192, R, C); const int Rb = Epi::PERM ? ((R & ~31) + perm32(R & 31)) : R;
        voffA[i] = (unsigned)(R * K + C) * 2u; voffB[i] = (unsigned)(Rb * K + C) * 2u; }
    const size_t kstep = (size_t)(BK * 2);
    const size_t hstep = (size_t)HALF * K * 2;
    const size_t tstep = 2 * hstep;
    const unsigned ldsw = (unsigned)wid * 1024u;
    const int aoff = lds_byte(wr * 64 + fr, fq * 8), boff = lds_byte(wc * 32 + fr, fq * 8);
#define PG8_SA(b, h) (((b) * 2 + (h)) * HTB)
#define PG8_SB(b, h) ((4 + (b) * 2 + (h)) * HTB)
#define PG8_STAGE(bufoff, gbase, voff) do { _Pragma("unroll") for (int _i = 0; _i < 2; ++_i) \
        __builtin_amdgcn_global_load_lds((const unsigned*)((const char*)(gbase) + (voff)[_i]), (PG8_LAS unsigned*)(lds + (bufoff) + ldsw + _i * 8192), 16, 0, 0); } while (0)
#define PG8_LDA(dst, b, h) do { _Pragma("unroll") for (int m = 0; m < 4; ++m) _Pragma("unroll") for (int k = 0; k < 2; ++k) dst[m][k] = *(const PG8_LAS bf16x8*)(lds + PG8_SA(b, h) + aoff + m * 2048 + k * 1024); } while (0)
#define PG8_LDB(dst, b, h) do { _Pragma("unroll") for (int n = 0; n < 2; ++n) _Pragma("unroll") for (int k = 0; k < 2; ++k) dst[n][k] = *(const PG8_LAS bf16x8*)(lds + PG8_SB(b, h) + boff + n * 2048 + k * 1024); } while (0)
#define PG8_MMA(ai, bj, At, Bt) do { __builtin_amdgcn_s_setprio(1); _Pragma("unroll") for (int m = 0; m < 4; ++m) _Pragma("unroll") for (int n = 0; n < 2; ++n) _Pragma("unroll") for (int k = 0; k < 2; ++k) \
        acc[ai][bj][m][n] = __builtin_amdgcn_mfma_f32_16x16x32_bf16(Bt[n][k], At[m][k], acc[ai][bj][m][n], 0, 0, 0); __builtin_amdgcn_s_setprio(0); } while (0)
#define PG8_WAIT_V(n) asm volatile("s_waitcnt vmcnt(" #n ")" ::: "memory")
#define PG8_WAIT_L(n) asm volatile("s_waitcnt lgkmcnt(" #n ")" ::: "memory")
#define PG8_BAR __builtin_amdgcn_s_barrier()
#define PG8_SCHED __builtin_amdgcn_sched_barrier(0)
    Unit cur, nxt; int ui = 0;
    if (!S.next(0, cur)) return;
    f32x4 acc[2][2][4][2];
#pragma unroll
    for (int a = 0; a < 2; ++a)
#pragma unroll
        for (int b = 0; b < 2; ++b)
#pragma unroll
            for (int m = 0; m < 4; ++m)
#pragma unroll
                for (int n = 0; n < 2; ++n) acc[a][b][m][n] = (f32x4){0.f, 0.f, 0.f, 0.f};
    bf16x8 At[4][2], B0[2][2], B1[2][2];
    const char* cA = (const char*)g.A + (size_t)cur.pm * tstep; const char* cB = (const char*)g.Bt + (size_t)cur.pn * tstep;
    S.a_ready(cur);
    if constexpr (SP2) {
        PG8_STAGE(PG8_SB(0, 0), cB, voffB); PG8_STAGE(PG8_SB(0, 1), cB + hstep, voffB); PG8_STAGE(PG8_SA(0, 0), cA, voffA); PG8_STAGE(PG8_SA(0, 1), cA + hstep, voffA);
        if (wr == 1) PG8_BAR;
        PG8_WAIT_V(2); PG8_BAR;
        PG8_STAGE(PG8_SB(1, 0), cB + kstep, voffB); PG8_STAGE(PG8_SA(1, 0), cA + kstep, voffA); PG8_STAGE(PG8_SB(1, 1), cB + hstep + kstep, voffB);
        PG8_WAIT_V(6); PG8_BAR;
    } else {
        PG8_STAGE(PG8_SB(0, 0), cB, voffB); PG8_STAGE(PG8_SA(0, 0), cA, voffA); PG8_STAGE(PG8_SB(0, 1), cB + hstep, voffB); PG8_STAGE(PG8_SA(0, 1), cA + hstep, voffA);
        if (wr == 1) PG8_BAR;
        PG8_WAIT_V(4); PG8_BAR;
        PG8_STAGE(PG8_SB(1, 0), cB + kstep, voffB); PG8_STAGE(PG8_SA(1, 0), cA + kstep, voffA); PG8_STAGE(PG8_SB(1, 1), cB + hstep + kstep, voffB);
        PG8_WAIT_V(6); PG8_BAR;
    }
    for (;;) {
        const bool has_next = S.next(ui + 1, nxt);
        const char* nA = has_next ? (const char*)g.A + (size_t)nxt.pm * tstep : cA; const char* nB = has_next ? (const char*)g.Bt + (size_t)nxt.pn * tstep : cB;
        for (int t = 0; t < nt; t += 2) {
            const bool last = (t == nt - 2);
            const char* a1 = cA + (size_t)(t + 1) * kstep;
            const char* a2 = last ? nA : cA + (size_t)(t + 2) * kstep; const char* b2 = last ? nB : cB + (size_t)(t + 2) * kstep;
            const char* a3 = a2 + kstep; const char* b3 = b2 + kstep;
            if (last && has_next) S.a_ready(nxt);
            if constexpr (SP2) {
            PG8_LDB(B0, 0, 0); PG8_LDB(B1, 0, 1); PG8_SCHED; PG8_LDA(At, 0, 0); PG8_STAGE(PG8_SA(1, 1), a1 + hstep, voffA);
            PG8_WAIT_V(8); PG8_WAIT_L(0); PG8_BAR; PG8_MMA(0, 0, At, B0); PG8_MMA(0, 1, At, B1); PG8_BAR; PG8_SCHED;
            PG8_LDA(At, 0, 1); PG8_STAGE(PG8_SB(0, 0), b2, voffB); PG8_STAGE(PG8_SB(0, 1), b2 + hstep, voffB); PG8_STAGE(PG8_SA(0, 0), a2, voffA);
            PG8_WAIT_V(8); PG8_WAIT_L(0); PG8_BAR; PG8_MMA(1, 0, At, B0); PG8_MMA(1, 1, At, B1); PG8_BAR; PG8_SCHED;
            PG8_LDB(B0, 1, 0); PG8_LDB(B1, 1, 1); PG8_SCHED; PG8_LDA(At, 1, 0); PG8_STAGE(PG8_SA(0, 1), a2 + hstep, voffA);
            PG8_WAIT_V(8); PG8_WAIT_L(0); PG8_BAR; PG8_MMA(0, 0, At, B0); PG8_MMA(0, 1, At, B1); PG8_BAR; PG8_SCHED;
            PG8_LDA(At, 1, 1); PG8_STAGE(PG8_SB(1, 0), b3, voffB); PG8_STAGE(PG8_SB(1, 1), b3 + hstep, voffB); PG8_STAGE(PG8_SA(1, 0), a3, voffA);
            PG8_WAIT_V(8); PG8_WAIT_L(0); PG8_BAR; PG8_MMA(1, 0, At, B0); PG8_MMA(1, 1, At, B1); PG8_BAR; PG8_SCHED;
            } else {
            PG8_LDB(B0, 0, 0); PG8_SCHED; PG8_LDA(At, 0, 0); PG8_STAGE(PG8_SA(1, 1), a1 + hstep, voffA);
            PG8_WAIT_L(8); PG8_BAR; PG8_WAIT_L(0); PG8_MMA(0, 0, At, B0); PG8_BAR; PG8_SCHED;
            PG8_LDB(B1, 0, 1); PG8_STAGE(PG8_SB(0, 0), b2, voffB);
            PG8_BAR; PG8_WAIT_L(0); PG8_MMA(0, 1, At, B1); PG8_BAR;
            PG8_LDA(At, 0, 1); PG8_STAGE(PG8_SA(0, 0), a2, voffA);
            PG8_BAR; PG8_WAIT_L(0); PG8_MMA(1, 0, At, B0); PG8_BAR; PG8_SCHED;
            PG8_STAGE(PG8_SB(0, 1), b2 + hstep, voffB);
            PG8_WAIT_V(6); PG8_BAR; PG8_MMA(1, 1, At, B1); PG8_BAR;
            PG8_LDB(B0, 1, 0); PG8_SCHED; PG8_LDA(At, 1, 0); PG8_STAGE(PG8_SA(0, 1), a2 + hstep, voffA);
            PG8_WAIT_L(8); PG8_BAR; PG8_WAIT_L(0); PG8_MMA(0, 0, At, B0); PG8_BAR; PG8_SCHED;
            PG8_LDB(B1, 1, 1); PG8_STAGE(PG8_SB(1, 0), b3, voffB);
            PG8_BAR; PG8_WAIT_L(0); PG8_MMA(0, 1, At, B1); PG8_BAR;
            PG8_LDA(At, 1, 1); PG8_STAGE(PG8_SA(1, 0), a3, voffA);
            PG8_BAR; PG8_WAIT_L(0); PG8_MMA(1, 0, At, B0); PG8_BAR; PG8_SCHED;
            PG8_STAGE(PG8_SB(1, 1), b3 + hstep, voffB);
            PG8_WAIT_V(6); PG8_BAR; PG8_MMA(1, 1, At, B1); PG8_BAR;
            }
        }
        if constexpr (ALIGN_EPI) { if (wr == 0) PG8_BAR; }
        if constexpr (!Epi::AFTER_DRAIN) { E(acc, cur, wr, wc, fr, fq); S.done(cur); }
        if (!has_next) break;
#pragma unroll
        for (int a = 0; a < 2; ++a)
#pragma unroll
            for (int b = 0; b < 2; ++b)
#pragma unroll
                for (int m = 0; m < 4; ++m)
#pragma unroll
                    for (int n = 0; n < 2; ++n) acc[a][b][m][n] = (f32x4){0.f, 0.f, 0.f, 0.f};
        cur = nxt; cA = nA; cB = nB; ++ui;
        if constexpr (ALIGN_EPI) { if (wr == 1) PG8_BAR; }
    }
    PG8_WAIT_V(0);
    if constexpr (!ALIGN_EPI) { if (wr == 0) PG8_BAR; }
    PG8_BAR;
    if constexpr (Epi::AFTER_DRAIN) { E.fused(acc, cur, wr, wc, fr, fq, lds, wid, lane); S.done(cur); }
#undef PG8_SA
#undef PG8_SB
#undef PG8_STAGE
#undef PG8_LDA
#undef PG8_LDB
#undef PG8_MMA
#undef PG8_WAIT_V
#undef PG8_WAIT_L
#undef PG8_BAR
#undef PG8_SCHED
}
}
#define GAS __attribute__((address_space(1)))
#define LAS __attribute__((address_space(3)))
typedef unsigned short bf16;
typedef unsigned v4u __attribute__((ext_vector_type(4)));
typedef float f32x4 __attribute__((ext_vector_type(4)));
typedef short bf16x8 __attribute__((ext_vector_type(8)));
typedef GAS unsigned gu32;
typedef GAS unsigned long long gu64;
#define RLX_AGENT __ATOMIC_RELAXED, __HIP_MEMORY_SCOPE_AGENT
#define LDS_WAIT() asm volatile("s_waitcnt lgkmcnt(0)" ::: "memory")
#define VM_WAIT() asm volatile("s_waitcnt vmcnt(0)" ::: "memory")
__device__ __forceinline__ unsigned long long rt() { return __builtin_amdgcn_s_memrealtime(); }
__device__ __forceinline__ unsigned f2bf(float f) { unsigned u = __builtin_bit_cast(unsigned, f); return (u + 0x7fffu + ((u >> 16) & 1u)) >> 16; }
__device__ __forceinline__ unsigned pk2(float lo, float hi) { return f2bf(lo) | (f2bf(hi) << 16); }

#define XB_TMO      128
#define XB_XCNT(j)  (256  + 64 * (j))
#define XB_XSUB(j)  (1280 + 64 * (j))
#define XB_XGEN(j)  (2304 + 64 * (j))
#define XB_TOP      3328
#define XB_TOPGEN   3392
#define XCD_BAR_WORDS 3456
#define XB_SPIN_CAP (1u << 18)

__device__ __forceinline__ unsigned xb_ld(unsigned* p)              { return __hip_atomic_load(p, __ATOMIC_RELAXED, __HIP_MEMORY_SCOPE_AGENT); }
__device__ __forceinline__ unsigned xb_add(unsigned* p, unsigned v) { return __hip_atomic_fetch_add(p, v, __ATOMIC_RELAXED, __HIP_MEMORY_SCOPE_AGENT); }
__device__ __forceinline__ unsigned xb_xcc_id() { return (unsigned)__builtin_amdgcn_s_getreg((3 << 11) | 20) & 0xFu; }
#define XB_SPIN(cond, bar) do { unsigned _sp = 0; while (cond) { __builtin_amdgcn_s_sleep(1); \
    if ((++_sp & 255u) == 0u) { if (xb_ld(&(bar)[XB_TMO])) break; if (_sp > XB_SPIN_CAP) { atomicAdd(&(bar)[XB_TMO], 1u); break; } } } } while (0)

struct XcdBarrier {
    unsigned* bar; unsigned x; int wave;
    volatile LAS unsigned* st;
};

#define XB_IS_T0(wave) ((wave) == 0 && lane_fresh() == 0)
__device__ __forceinline__ XcdBarrier xcd_barrier_post(unsigned* bar, volatile LAS unsigned* st, int wave) {
    XcdBarrier b; b.bar = bar; b.x = xb_xcc_id(); b.st = st; b.wave = wave;
    if (XB_IS_T0(wave)) (void)xb_add(&bar[XB_XCNT(b.x)], 1u);
    return b;
}
__device__ __forceinline__ void xcd_barrier_complete(unsigned* bar, unsigned x, unsigned& nloc, unsigned& nx) {
    const unsigned G = gridDim.x * gridDim.y * gridDim.z;
    unsigned sum, cnt, mine, sp = 0u;
    for (;;) {
        sum = 0u; cnt = 0u; mine = 0u;
#pragma unroll
        for (unsigned j = 0; j < 16; ++j) { const unsigned c = xb_ld(&bar[XB_XCNT(j)]); sum += c; cnt += (c > 0u) ? 1u : 0u; mine = (j == x) ? c : mine; }
        if (sum == G) break;
        __builtin_amdgcn_s_sleep(1);
        if ((++sp & 255u) == 0u) { if (xb_ld(&bar[XB_TMO])) break; if (sp > XB_SPIN_CAP) { atomicAdd(&bar[XB_TMO], 1u); break; } }
    }
    nloc = mine > 0u ? mine : 1u; nx = cnt > 0u ? cnt : 1u;
}

__device__ __forceinline__ void xcd_barrier(const XcdBarrier& b) {
    asm volatile("s_waitcnt vmcnt(0)" ::: "memory");
    __syncthreads();
    if (XB_IS_T0(b.wave)) {
        unsigned* bar = b.bar;
        __builtin_amdgcn_s_waitcnt(0);
        unsigned nloc = b.st[0], nx = b.st[1];
        if (nloc == 0u) { xcd_barrier_complete(bar, b.x, nloc, nx); b.st[0] = nloc; b.st[1] = nx; }
        const unsigned old = xb_add(&bar[XB_XSUB(b.x)], 1u);
        const unsigned gen = old / nloc;
        if (old + 1u == (gen + 1u) * nloc) {
            __builtin_amdgcn_fence(__ATOMIC_RELEASE, "agent");
            asm volatile("s_waitcnt vmcnt(0)" ::: "memory");
            const unsigned og = xb_add(&bar[XB_TOP], 1u);
            const unsigned tg = og / nx;
            if (og + 1u == (tg + 1u) * nx) xb_add(&bar[XB_TOPGEN], 1u);
            else XB_SPIN(xb_ld(&bar[XB_TOPGEN]) == tg, bar);
            __builtin_amdgcn_fence(__ATOMIC_ACQUIRE, "agent");
            xb_add(&bar[XB_XGEN(b.x)], 1u);
            asm volatile("s_waitcnt vmcnt(0)" ::: "memory");
        } else {
            XB_SPIN(xb_ld(&bar[XB_XGEN(b.x)]) == gen, bar);
            __builtin_amdgcn_fence(__ATOMIC_ACQUIRE, "agent");
            asm volatile("s_waitcnt vmcnt(0)" ::: "memory");
        }
    }
    __syncthreads();
}
namespace mk {
constexpr int D = 1024, NB = 8, SEQ = 2048, NMETA = 16, T = SEQ + NMETA, NS = 32, PAST = 16384, PAGE = 128, NPAGES = PAST / PAGE;
constexpr int FFN = 2816, NH = 8, QR = 384, KVR = 256, RH = 4, RDK = 128, RDV = 256, IN_DIM = 5792;
constexpr int O_CQ = 0, O_CKV = 384, O_KR = 640, O_RQ = 672, O_RK = 1184, O_RV = 1696, O_RG = 2720, O_GA = 3744, O_GB = 4768;
constexpr int MMAIN = NB * SEQ;
constexpr int ROW_META = MMAIN;
constexpr int ROW_SMP = MMAIN + NMETA;
constexpr int ROW_PAD = ROW_SMP + NS;
constexpr int MP = MMAIN + 256;
constexpr int NWIN = 5888;
constexpr int NPOS = T + 1;
constexpr float EPS = 1e-6f;
constexpr int NWAVES = 8;

constexpr size_t MiB = 1u << 20;
constexpr size_t al(size_t x) { return (x + 255) / 256 * 256; }
constexpr size_t WS_CTL = 0, CTL_ZERO_BYTES = 1 * MiB;
constexpr size_t WS_W1T = 1 * MiB;
constexpr size_t WS_W1D = WS_W1T + al((size_t)2 * FFN * D * 2);
constexpr size_t WS_WIN = WS_W1D + al((size_t)D * FFN * 2);
constexpr size_t WS_WUQ = WS_WIN + al((size_t)NWIN * D * 2);
constexpr size_t WS_WUK = WS_WUQ + al((size_t)768 * QR * 2);
constexpr size_t WS_WUV = WS_WUK + al((size_t)512 * KVR * 2);
constexpr size_t WS_WMO = WS_WUV + al((size_t)512 * KVR * 2);
constexpr size_t WS_WRO = WS_WMO + al((size_t)D * 512 * 2);
constexpr size_t WS_WOUT = WS_WRO + al((size_t)D * D * 2);
constexpr size_t WS_W2T = WS_WOUT + al((size_t)D * D * 2);
constexpr size_t WS_W2D = WS_W2T + al((size_t)2 * FFN * D * 2);
constexpr size_t WS_WQL = WS_W2D + al((size_t)D * FFN * 2);
constexpr size_t WS_TAB = WS_WQL + al((size_t)2048 * QR * 2);
constexpr size_t TAB_C64 = 0, TAB_S64 = (size_t)NPOS * 64 * 4, TAB_C16 = 2 * TAB_S64, TAB_S16 = TAB_C16 + (size_t)NPOS * 16 * 4, TAB_GP = TAB_S16 + (size_t)NPOS * 16 * 4, TAB_GN = TAB_GP + 512 * 4, TAB_END = TAB_GN + 512 * 4;
constexpr size_t WS_XB = WS_TAB + al(TAB_END);
constexpr size_t WS_XE = WS_XB + al((size_t)MP * D * 2);
constexpr size_t WS_R1 = WS_XE + al((size_t)256 * D * 4);
constexpr size_t WS_ACT = WS_R1 + al((size_t)MP * 4);
constexpr size_t WS_H = WS_ACT + al((size_t)MP * FFN * 2);
constexpr size_t WS_HB = WS_H + al((size_t)MP * D * 4);
constexpr size_t WS_SSQH = WS_HB + al((size_t)MP * D * 2);
constexpr size_t WS_SSQ2_ = WS_SSQH + al((size_t)MP * 4), WS_SSQ3_ = WS_SSQ2_ + al((size_t)MP * 4);
constexpr size_t WS_END1 = WS_SSQH + al((size_t)MP * 16 * 4);

constexpr int CW_XCNT = 32768  , CW_BAR = 4096, CW_QUEUE = 64, CW_DCNT = 24576  ;

constexpr int RING_OFF = 0, RING_BYTES = 131072, SCR_BYTES = 155648  , LDSCTL_OFF = SCR_BYTES, MISC_OFF = LDSCTL_OFF + 320, LDS_BYTES = 163840;

struct Args {
    const float* in[27]; float* out; unsigned char* ws;
};

struct Frame {
    LAS unsigned char* lds;
    volatile LAS unsigned* MISC;
    int wave, vcu, G;
};

constexpr int PT_OFF = MISC_OFF + 256;
struct Ptrs {
    unsigned char* ws; volatile LAS unsigned* tab;
    __device__ __forceinline__ unsigned long long raw(int k) const { volatile LAS unsigned* t = tab; asm volatile("" : "+v"(t));
        const unsigned lo = __builtin_amdgcn_readfirstlane(t[2 * k]), hi = __builtin_amdgcn_readfirstlane(t[2 * k + 1]); return ((unsigned long long)hi << 32) | lo; }
    __device__ __forceinline__ const float* in(int k) const { return (const float*)(GAS const float*)raw(k); }
    __device__ __forceinline__ float* out() const { return (float*)(GAS float*)raw(27); }
};
__device__ __forceinline__ int fresh_tid(int wave) { int t = lane_fresh() + 64 * wave; asm volatile("" : "+v"(t)); return t; }

__device__ __forceinline__ float lx(float v, int lane, int mask) { return __int_as_float(__builtin_amdgcn_ds_bpermute((lane ^ mask) << 2, __float_as_int(v))); }
__device__ __forceinline__ float wave_sum(float v, int lane) {
#pragma unroll
    for (int o = 1; o < 64; o <<= 1) v += lx(v, lane, o);
    return v;
}
__device__ __forceinline__ int row_pos(int row) { return row < MMAIN ? (row & (SEQ - 1)) + NMETA : (row < ROW_SMP ? row - ROW_META : (row < ROW_PAD ? PAST : 0)); }
__device__ __forceinline__ int row_pidx(int row) { return row < MMAIN ? (row & (SEQ - 1)) + NMETA : (row < ROW_SMP ? row - ROW_META : (row < ROW_PAD ? T : 0)); }
__device__ __forceinline__ int row_jtok(int row) { return row < MMAIN ? (row & 127) : (row < ROW_SMP ? row - ROW_META : 0); }

struct WSrc { const float* W; int ld; int col0; const float* g; };
__device__ __forceinline__ void wmat_dims(int id, int& K, int& ngrp) {
    switch (id) {
        case 0: case 9: K = D; ngrp = 2 * FFN / 32; break;
        case 1: case 10: K = FFN; ngrp = D / 32; break;
        case 2: K = D; ngrp = NWIN / 32; break;
        case 3: K = QR; ngrp = 768 / 32; break;
        case 4: case 5: K = KVR; ngrp = 512 / 32; break;
        case 6: K = 512; ngrp = D / 32; break;
        default: K = D; ngrp = D / 32; break;
    }
}
__device__ __forceinline__ size_t wmat_off(int id) {
    switch (id) { case 0: return WS_W1T; case 1: return WS_W1D; case 2: return WS_WIN; case 3: return WS_WUQ; case 4: return WS_WUK; case 5: return WS_WUV;
                  case 6: return WS_WMO; case 7: return WS_WRO; case 8: return WS_WOUT; case 9: return WS_W2T; default: return WS_W2D; }
}
__device__ __forceinline__ WSrc wmat_src(const Args& a, int id, int g) {
    WSrc s; s.W = nullptr; s.ld = 0; s.col0 = 0; s.g = nullptr;
    switch (id) {
        case 0: case 9: { const int pn = g >> 3, gg = g & 7; const int o = id == 0 ? 7 : 22;
            s.W = gg < 4 ? a.in[o + 1] : a.in[o + 2]; s.ld = FFN; s.col0 = 128 * pn + 32 * (gg & 3); s.g = a.in[o]; break; }
        case 1: s.W = a.in[10]; s.ld = D; s.col0 = 32 * g; break;
        case 10: s.W = a.in[25]; s.ld = D; s.col0 = 32 * g; break;
        case 2: { s.ld = IN_DIM; s.g = a.in[11]; int zc = -1;
            if (g < 8) zc = 32 * g;
            else if (g < 16) { const int gg = g - 8; zc = gg < 4 ? 256 + 32 * gg : (gg == 4 ? O_KR : -1); }
            else if (g < 24) zc = O_CKV + 32 * (g - 16);
            else if (g < 56) { const int base = g < 40 ? O_RQ : O_RK; const int q = (g - 24) & 15, t = q >> 3, gg = q & 7;
                const int h = 2 * t + ((gg >> 1) & 1), part = (gg >> 2) * 64 + (gg & 1) * 32; zc = base + h * 128 + part; }
            else if (g < 88) zc = O_RV + 32 * (g - 56);
            else if (g < 120) zc = O_RG + 32 * (g - 88);
            else if (g < 152) zc = O_GA + 32 * (g - 120);
            else zc = O_GB + 32 * (g - 152);
            if (zc >= 0) { s.W = a.in[12]; s.col0 = zc; }
            break; }
        case 3: s.W = a.in[15]; s.ld = 768; s.col0 = 32 * g; s.g = a.in[13]; break;
        case 4: s.W = a.in[16]; s.ld = 512; s.col0 = 32 * g; s.g = a.in[14]; break;
        case 5: s.W = a.in[17]; s.ld = 512; s.col0 = 32 * g; s.g = a.in[14]; break;
        case 6: s.W = a.in[18]; s.ld = D; s.col0 = 32 * g; break;
        case 7: s.W = a.in[20]; s.ld = D; s.col0 = 32 * g; break;
        default: s.W = a.in[21]; s.ld = D; s.col0 = 32 * g; break;
    }
    return s;
}
__device__ __forceinline__ void p0_transpose_item(const WSrc s, int K, bf16* WT, int n0, int k0, LAS float* scr, int lane) {
    if (s.W) {
        float v[32];
        const float* wp = s.W + (size_t)(k0 + (lane >> 5)) * s.ld + s.col0 + (lane & 31);
#pragma unroll
        for (int i = 0; i < 32; ++i) v[i] = wp[(size_t)(2 * i) * s.ld];
        if (s.g) { const float* gp = s.g + k0 + (lane >> 5);
#pragma unroll
            for (int i = 0; i < 32; ++i) v[i] *= gp[2 * i]; }
#pragma unroll
        for (int i = 0; i < 32; ++i) scr[(2 * i + (lane >> 5)) * 33 + (lane & 31)] = v[i];
    } else {
#pragma unroll 8
        for (int i = 0; i < 32; ++i) { const int kk = 2 * i + (lane >> 5); scr[kk * 33 + (lane & 31)] = 0.f; }
    }
    LDS_WAIT(); asm volatile("" ::: "memory");
    const int c = lane & 7;
#pragma unroll
    for (int j = 0; j < 4; ++j) { const int n = (lane >> 3) + 8 * j; const LAS float* sp = scr + (8 * c) * 33 + n;
        v4u o; o.x = pk2(sp[0 * 33], sp[1 * 33]); o.y = pk2(sp[2 * 33], sp[3 * 33]); o.z = pk2(sp[4 * 33], sp[5 * 33]); o.w = pk2(sp[6 * 33], sp[7 * 33]);
        *(GAS v4u*)(WT + (size_t)(n0 + n) * K + k0 + 8 * c) = o; }
    LDS_WAIT(); asm volatile("" ::: "memory");
}
__device__ __forceinline__ const float* x_src(const Args& a, int row) {
    if (row < MMAIN) return a.in[0] + (size_t)row * D;
    if (row < ROW_SMP) return a.in[6] + (size_t)(row - ROW_META) * D;
    if (row < ROW_PAD) return a.in[1] + (size_t)(row - ROW_SMP) * D;
    return nullptr;
}
__device__ __forceinline__ void p0_weights(const Args& a, unsigned id_mask, int gw, int NGW, LAS float* scr, int lane) {
    unsigned char* ws = a.ws;
    int base = 0;
#pragma unroll 1
    for (int id = 0; id < 11; ++id) {
        if (!((id_mask >> id) & 1u)) continue;
        int K, ngrp; wmat_dims(id, K, ngrp);
        const int nk = K / 64, nitems = nk * ngrp;
        bf16* WT = (bf16*)(ws + wmat_off(id));
        int first = (gw - (base % NGW) + NGW) % NGW;
        for (int it = first; it < nitems; it += NGW) { const int g = it % ngrp, kb = it / ngrp; p0_transpose_item(wmat_src(a, id, g), K, WT, 32 * g, 64 * kb, scr, lane); }
        base += nitems;
    }
}
__device__ __forceinline__ void p0_weights_late(Frame& F, const Args& a) {
    const int bx = (int)blockIdx.x; if (bx < 188) return;
    const int lane = fresh_tid(F.wave) & 63;
    LAS float* scr = (LAS float*)(F.lds + RING_OFF + F.wave * 16384);
    p0_weights(a, 0x380u  , (bx - 188) * NWAVES + F.wave, 68 * NWAVES, scr, lane);
    __syncthreads();
}
__device__ __forceinline__ void p0_prologue(Frame& F, const Args& a) {
    const int lane = fresh_tid(F.wave) & 63;
    LAS float* scr = (LAS float*)(F.lds + RING_OFF + F.wave * 16384);
    const int gw = F.vcu * NWAVES + F.wave, NGW = F.G * NWAVES;
    unsigned char* ws = a.ws;
    p0_weights(a, 0x47Fu  , gw, NGW, scr, lane);
    bf16* XB = (bf16*)(ws + WS_XB); float* XE = (float*)(ws + WS_XE); float* R1 = (float*)(ws + WS_R1);
    for (int m0 = gw; m0 < MP; m0 += 2 * NGW) {
        f32x4 v[2][4];
#pragma unroll
        for (int t = 0; t < 2; ++t) { const int m = m0 + t * NGW; const float* xr = m < MP ? x_src(a, m) : nullptr;
#pragma unroll
            for (int j = 0; j < 4; ++j) v[t][j] = xr ? *((const GAS f32x4*)xr + lane + 64 * j) : (f32x4){0.f, 0.f, 0.f, 0.f}; }
#pragma unroll
        for (int t = 0; t < 2; ++t) { const int m = m0 + t * NGW; if (m >= MP) break;
            float s = 0.f;
#pragma unroll
            for (int j = 0; j < 4; ++j) s += (v[t][j].x * v[t][j].x + v[t][j].y * v[t][j].y) + (v[t][j].z * v[t][j].z + v[t][j].w * v[t][j].w);
            s = wave_sum(s, lane);
            if (lane == 0) R1[m] = 1.0f / sqrtf(s * (1.f / D) + EPS);
            GAS unsigned long long* o8 = (GAS unsigned long long*)(XB + (size_t)m * D) + lane;
#pragma unroll
            for (int j = 0; j < 4; ++j) o8[64 * j] = (unsigned long long)pk2(v[t][j].x, v[t][j].y) | ((unsigned long long)pk2(v[t][j].z, v[t][j].w) << 32);
            if (m >= MMAIN) {
#pragma unroll
                for (int j = 0; j < 4; ++j) *((GAS f32x4*)(XE + (size_t)(m - MMAIN) * D) + lane + 64 * j) = v[t][j];
            } }
    }
    {   const float* wuq = a.in[15]; const float* wuk = a.in[16]; const float* qn = a.in[13]; bf16* WQL = (bf16*)(ws + WS_WQL);
        LAS float* U = (LAS float*)(F.lds + RING_OFF);
        const int tid = F.wave * 64 + lane;
        for (int it = F.vcu; it < 256; it += F.G) {
            const int h = it >> 5, r0 = (it & 31) * 8;
            __syncthreads();
            for (int e = tid; e < QR * 64; e += NWAVES * 64) { const int k = e >> 6, n = e & 63; U[k * 65 + n] = wuq[(size_t)k * 768 + h * 96 + n]; }
            { const int rr = tid >> 6, n = tid & 63; U[QR * 65 + rr * 64 + n] = wuk[(size_t)(r0 + rr) * 512 + h * 64 + n]; }
            __syncthreads();
            if (tid < QR) { const float g = qn[tid]; float acc[8];
#pragma unroll
                for (int rr = 0; rr < 8; ++rr) acc[rr] = 0.f;
                for (int n = 0; n < 64; ++n) { const float u = U[tid * 65 + n];
#pragma unroll
                    for (int rr = 0; rr < 8; ++rr) acc[rr] += u * U[QR * 65 + rr * 64 + n]; }
#pragma unroll
                for (int rr = 0; rr < 8; ++rr) WQL[(size_t)(h * 256 + r0 + rr) * QR + tid] = (bf16)f2bf(acc[rr] * g); }
        }
        __syncthreads();
    }
    { const int gt_ = (F.vcu * NWAVES + F.wave) * 64 + lane, NGT_ = NGW * 64;
      for (int e = gt_; e < MP; e += NGT_) { ((float*)(ws + WS_SSQH))[e] = 0.f; ((float*)(ws + WS_SSQ2_))[e] = 0.f; ((float*)(ws + WS_SSQ3_))[e] = 0.f; } }
    float* TAB = (float*)(ws + WS_TAB);
    const int gt = (F.vcu * NWAVES + F.wave) * 64 + lane, NGT = NGW * 64;
    for (int e = gt; e < NPOS * 64; e += NGT) { const int p = e >> 6, i = e & 63; const int pos = p < T ? p : PAST;
        const float invf = (float)pow(10000.0, -(double)i / 64.0); const float ang = (float)pos * invf;
        TAB[TAB_C64 / 4 + e] = (float)cos((double)ang); TAB[TAB_S64 / 4 + e] = (float)sin((double)ang); }
    for (int e = gt; e < NPOS * 16; e += NGT) { const int p = e >> 4, i = e & 15; const int pos = p < T ? p : PAST;
        const float invf = (float)pow(10000.0, -(double)i / 16.0); const float ang = (float)pos * invf;
        TAB[TAB_C16 / 4 + e] = (float)cos((double)ang); TAB[TAB_S16 / 4 + e] = (float)sin((double)ang); }
    for (int e = gt; e < 512; e += NGT) { const int h = e >> 7, j = e & 127; const double lg = log1p(-exp2(-5.0 - (double)h));
        TAB[TAB_GP / 4 + e] = (float)exp(lg * (double)j); TAB[TAB_GN / 4 + e] = (float)exp(-lg * (double)j); }
}

using pg8::f32x4; using pg8::u32x4; using pg8::Unit; using pg8::BM; using pg8::HALF;
typedef unsigned u32x2 __attribute__((ext_vector_type(2)));
__device__ __forceinline__ float fast_sigmoid(float x) { return __builtin_amdgcn_rcpf(1.f + __builtin_amdgcn_exp2f(-1.4426950408889634f * x)); }
__device__ __forceinline__ float fast_silu(float x) { return x * fast_sigmoid(x); }

struct EpiSwiGLU {
    static constexpr bool PERM = true, AFTER_DRAIN = false;
    bf16* ACT; const float* rs;
    __device__ __forceinline__ void operator()(const f32x4 (&acc)[2][2][4][2], const Unit& u, int wr, int wc, int fr, int fq) const {
        int l_ = lane_fresh(); asm volatile("" : "+v"(l_)); fr = l_ & 15; fq = l_ >> 4;
        const int row0 = u.pm * BM + wr * 64 + fr, col0 = u.pn * HALF + wc * 32 + 8 * fq;
#pragma unroll
        for (int ai = 0; ai < 2; ++ai)
#pragma unroll
            for (int m = 0; m < 4; ++m) { const int row = row0 + ai * HALF + m * 16; const float r = rs[row];
                f32x4 o[2];
#pragma unroll
                for (int n = 0; n < 2; ++n)
#pragma unroll
                    for (int j = 0; j < 4; ++j) { const float g = acc[ai][0][m][n][j] * r, up = acc[ai][1][m][n][j] * r; o[n][j] = fast_silu(g) * up; }
                u32x4 w; w.x = pg8::cvt_pk_bf16(o[0][0], o[0][1]); w.y = pg8::cvt_pk_bf16(o[0][2], o[0][3]); w.z = pg8::cvt_pk_bf16(o[1][0], o[1][1]); w.w = pg8::cvt_pk_bf16(o[1][2], o[1][3]);
                *(u32x4*)(ACT + (size_t)row * FFN + col0) = w; }
    }
};
template <class T> __device__ __forceinline__ T* at(unsigned char* w, unsigned byte_off) { return (T*)(w + byte_off); }
template <unsigned RES_OFF, bool RES_X, unsigned OUTB_OFF, unsigned SSQ_OFF, int SCALE2  > struct EpiResid {
    static constexpr bool PERM = true, AFTER_DRAIN = false;
    unsigned char* ws_; const float* xin;
    __device__ __forceinline__ void operator()(const f32x4 (&acc)[2][2][4][2], const Unit& u, int wr, int wc, int fr, int fq) const {
        int l_ = lane_fresh(); asm volatile("" : "+v"(l_)); fr = l_ & 15; fq = l_ >> 4;
        unsigned char* w = opaque_g(ws_);
        const unsigned row0 = u.pm * BM + wr * 64 + fr, col0 = u.pn * BM + wc * 32 + 8 * fq;
        constexpr float scale = 0.5f * SCALE2;
#pragma unroll
        for (int ai = 0; ai < 2; ++ai)
#pragma unroll
            for (int m = 0; m < 4; ++m) { unsigned row = row0 + ai * HALF + m * 16; asm volatile("" : "+v"(row));
                float ss = 0.f;
#pragma unroll
                for (int bj = 0; bj < 2; ++bj) {
                    const unsigned e = row * D + col0 + bj * HALF;
                    f32x4 b0, b1;
                    if (RES_X) { const float* rp = row < (unsigned)MMAIN ? xin + e : at<const float>(w, RES_OFF + (e - MMAIN * D) * 4); b0 = *(const f32x4*)rp; b1 = *(const f32x4*)(rp + 4); }
                    else { const u32x4 rb = *at<const u32x4>(w, RES_OFF + e * 2);
                        b0 = (f32x4){__uint_as_float(rb.x << 16), __uint_as_float(rb.x & 0xffff0000u), __uint_as_float(rb.y << 16), __uint_as_float(rb.y & 0xffff0000u)};
                        b1 = (f32x4){__uint_as_float(rb.z << 16), __uint_as_float(rb.z & 0xffff0000u), __uint_as_float(rb.w << 16), __uint_as_float(rb.w & 0xffff0000u)}; }
                    const f32x4 o0 = b0 + acc[ai][bj][m][0] * scale, o1 = b1 + acc[ai][bj][m][1] * scale;
                    ss += ((o0[0] * o0[0] + o0[1] * o0[1]) + (o0[2] * o0[2] + o0[3] * o0[3])) + ((o1[0] * o1[0] + o1[1] * o1[1]) + (o1[2] * o1[2] + o1[3] * o1[3]));
                    u32x4 pk; pk.x = pg8::cvt_pk_bf16(o0[0], o0[1]); pk.y = pg8::cvt_pk_bf16(o0[2], o0[3]); pk.z = pg8::cvt_pk_bf16(o1[0], o1[1]); pk.w = pg8::cvt_pk_bf16(o1[2], o1[3]);
                    *at<u32x4>(w, OUTB_OFF + e * 2) = pk; }
                ss += lx(ss, l_, 16); ss += lx(ss, l_, 32);
                if (fq == 0) atomicAdd(at<float>(w, SSQ_OFF + row * 4), ss);
                asm volatile("" ::: "memory"); }
    }
};
}
namespace mk {
constexpr size_t WS_CQ = WS_END1;
constexpr size_t WS_SSQCQ = WS_CQ + al((size_t)MP * QR * 2);
constexpr size_t WS_CKVF = WS_SSQCQ + al((size_t)MP * 8 * 4);
constexpr size_t WS_CKVB = WS_CKVF + al((size_t)MP * KVR * 4);
constexpr size_t WS_SSQKV = WS_CKVB + al((size_t)MP * KVR * 2);
constexpr size_t WS_KRB = WS_SSQKV + al((size_t)MP * 4 * 4);
constexpr size_t WS_RQ = WS_KRB + al((size_t)MP * 32 * 2);
constexpr size_t WS_RK = WS_RQ + al((size_t)MP * 512 * 2);
constexpr size_t WS_RKT = WS_RK + al((size_t)MP * 512 * 2);
constexpr size_t WS_RVT = WS_RKT + al((size_t)MP * 512 * 2);
constexpr size_t WS_SRG = WS_RVT + al((size_t)MP * 1024 * 2);
constexpr size_t WS_SGA = WS_SRG + al((size_t)MP * 1024 * 2);
constexpr size_t WS_SGB = WS_SGA + al((size_t)MP * 1024 * 2);
constexpr size_t WS_QA = WS_SGB + al((size_t)MP * 1024 * 2);
constexpr size_t WS_KN = WS_QA + al((size_t)MP * 768 * 2);
constexpr size_t WS_VT = WS_KN + al((size_t)MP * 512 * 2);
constexpr size_t WS_KRF = WS_VT + al((size_t)MP * 512 * 2);
constexpr size_t WS_END2 = WS_KRF + al((size_t)MP * 32 * 4);
constexpr float SC_Q = 0.14724444348433683f;
constexpr float RK_SCALE = 0.08838834764831845f;

constexpr size_t OUT_YP = 0, OUT_YS = OUT_YP + (size_t)NB * SEQ * D, OUT_CKVP = OUT_YS + (size_t)NS * D, OUT_KRP = OUT_CKVP + (size_t)NB * T * KVR,
                 OUT_SRP = OUT_KRP + (size_t)NB * T * 32, OUT_CKVS = OUT_SRP + (size_t)NB * RH * RDK * RDV, OUT_KRS = OUT_CKVS + (size_t)NS * KVR, OUT_SRS = OUT_KRS + (size_t)NS * 32,
                 OUT_END = OUT_SRS + (size_t)NS * RH * RDK * RDV;

__device__ __forceinline__ float row_rscale16(const float* SSQ, int row, float inv_n) { return 1.0f / sqrtf(SSQ[row] * inv_n + EPS); }
__device__ __forceinline__ float row_rscale8(const float* SSQ, int row, float inv_n) {
    const f32x4* p = (const f32x4*)(SSQ + (size_t)row * 8); const f32x4 a = p[0], b = p[1];
    return 1.0f / sqrtf((((a[0] + a[1]) + (a[2] + a[3])) + ((b[0] + b[1]) + (b[2] + b[3]))) * inv_n + EPS);
}
__device__ __forceinline__ float row_rscale4(const float* SSQ, int row, float inv_n) {
    const f32x4 a = *(const f32x4*)(SSQ + (size_t)row * 4);
    return 1.0f / sqrtf(((a[0] + a[1]) + (a[2] + a[3])) * inv_n + EPS);
}
__device__ __forceinline__ u32x2 pack4(const f32x4 v) { u32x2 w; w.x = pg8::cvt_pk_bf16(v[0], v[1]); w.y = pg8::cvt_pk_bf16(v[2], v[3]); return w; }
__device__ __forceinline__ float ssq4(const f32x4 v) { return (v[0] * v[0] + v[1] * v[1]) + (v[2] * v[2] + v[3] * v[3]); }
__device__ __forceinline__ bf16 bf1(float x) { return (bf16)f2bf(x); }

static_assert(WS_END2 < ((size_t)1 << 31), "32-bit workspace offsets");
__device__ __forceinline__ void tr_store16(LAS unsigned char* T, int fr, int fq, int lane, const f32x4 (&v)[4], unsigned char* w, unsigned dst_off) {
#pragma unroll
    for (int m = 0; m < 4; ++m)
#pragma unroll
        for (int j = 0; j < 4; ++j) *(LAS bf16*)(T + (4 * fq + j) * 144 + (16 * m + fr) * 2) = bf1(v[m][j]);
    asm volatile("s_waitcnt lgkmcnt(0)" ::: "memory");
#pragma unroll
    for (int k = 0; k < 2; ++k) { const int id = lane + 64 * k, c = id >> 3, part = id & 7; const v4u x = *(const LAS v4u*)(T + c * 144 + part * 16); *at<v4u>(w, dst_off + (unsigned)(((c >> 2) * 8 + (c & 3)) * MP + 8 * part) * 2u) = x; }
    asm volatile("s_waitcnt lgkmcnt(0)" ::: "memory");
}
constexpr int EPI_LDS_OFF = RING_BYTES, EPI_LDS_WAVE = 3072;
static_assert(EPI_LDS_OFF + 8 * EPI_LDS_WAVE <= SCR_BYTES && 16 * 144 <= EPI_LDS_WAVE, "epilogue LDS scratch");
__device__ __forceinline__ u32x4 pack8(const f32x4 a, const f32x4 b) { u32x4 w; w.x = pg8::cvt_pk_bf16(a[0], a[1]); w.y = pg8::cvt_pk_bf16(a[2], a[3]); w.z = pg8::cvt_pk_bf16(b[0], b[1]); w.w = pg8::cvt_pk_bf16(b[2], b[3]); return w; }
struct EpiWin {
    static constexpr bool PERM = true, AFTER_DRAIN = false;
    unsigned char* ws_; LAS unsigned char* lds_;
#define MK_WS(var) unsigned char* var = opaque_g(ws_)
#define MK_ROWS_BEGIN _Pragma("unroll") for (int ai = 0; ai < 2; ++ai) _Pragma("unroll") for (int m = 0; m < 4; ++m) { \
        unsigned row = row0 + ai * HALF + m * 16; asm volatile("" : "+v"(row)); const float r = rsc[ai * 4 + m];
#define MK_ROWS_END asm volatile("" ::: "memory"); }
    __device__ __forceinline__ void operator()(const f32x4 (&acc)[2][2][4][2], const Unit& u, int wr, int wc, int fr, int fq) const {
        int l_ = lane_fresh(); asm volatile("" : "+v"(l_)); fr = l_ & 15; fq = l_ >> 4;
        const unsigned row0 = u.pm * BM + wr * 64 + fr; const int pn = u.pn;
        const unsigned c8 = wc * 32 + 8 * fq;
        MK_WS(w);
        float rsc[8];
#pragma unroll
        for (int k = 0; k < 8; ++k) rsc[k] = row_rscale16(at<const float>(w, (unsigned)WS_SSQH), (int)(row0 + (k >> 2) * HALF + (k & 3) * 16), 1.f / D);
        if (pn == 0) {
            MK_ROWS_BEGIN
                float ss = 0.f;
#pragma unroll
                for (int bj = 0; bj < 2; ++bj) { const f32x4 v0 = acc[ai][bj][m][0] * r, v1 = acc[ai][bj][m][1] * r; ss += ssq4(v0) + ssq4(v1); *at<u32x4>(w, (unsigned)WS_CQ + (row * QR + bj * HALF + c8) * 2) = pack8(v0, v1); }
                ss += lx(ss, l_, 16); ss += lx(ss, l_, 32);
                if (fq == 0) *at<float>(w, (unsigned)WS_SSQCQ + (row * 8 + wc) * 4) = ss;
            MK_ROWS_END
        } else if (pn == 1) {
            MK_ROWS_BEGIN
                const f32x4 v0 = acc[ai][0][m][0] * r, v1 = acc[ai][0][m][1] * r;
                float ss = ssq4(v0) + ssq4(v1);
                *at<u32x4>(w, (unsigned)WS_CQ + (row * QR + 256 + c8) * 2) = pack8(v0, v1);
                ss += lx(ss, l_, 16); ss += lx(ss, l_, 32);
                if (fq == 0) *at<float>(w, (unsigned)WS_SSQCQ + (row * 8 + 4 + wc) * 4) = ss;
                if (wc == 0) {
                    const f32x4 a0 = acc[ai][1][m][0] * r, a1 = acc[ai][1][m][1] * r;
                    f32x4 p0, p1;
#pragma unroll
                    for (int j = 0; j < 4; ++j) { p0[j] = lx(a0[j], l_, 32); p1[j] = lx(a1[j], l_, 32); }
                    const unsigned pi = row_pidx((int)row), i0 = 8 * (fq & 1);
                    const f32x4 c0 = *at<const f32x4>(w, (unsigned)(WS_TAB + TAB_C16) + (pi * 16 + i0) * 4), c1 = *at<const f32x4>(w, (unsigned)(WS_TAB + TAB_C16) + (pi * 16 + i0 + 4) * 4);
                    const f32x4 s0 = *at<const f32x4>(w, (unsigned)(WS_TAB + TAB_S16) + (pi * 16 + i0) * 4), s1 = *at<const f32x4>(w, (unsigned)(WS_TAB + TAB_S16) + (pi * 16 + i0 + 4) * 4);
                    const f32x4 y0 = fq < 2 ? a0 * c0 - p0 * s0 : p0 * s0 + a0 * c0, y1 = fq < 2 ? a1 * c1 - p1 * s1 : p1 * s1 + a1 * c1;
                    *at<u32x4>(w, (unsigned)WS_KRB + (row * 32 + 8 * fq) * 2) = pack8(y0, y1);
                    *at<f32x4>(w, (unsigned)WS_KRF + (row * 32 + 8 * fq) * 4) = y0; *at<f32x4>(w, (unsigned)WS_KRF + (row * 32 + 8 * fq + 4) * 4) = y1;
                }
            MK_ROWS_END
        } else if (pn == 2) {
            MK_ROWS_BEGIN
                float ss = 0.f;
#pragma unroll
                for (int bj = 0; bj < 2; ++bj) { const f32x4 v0 = acc[ai][bj][m][0] * r, v1 = acc[ai][bj][m][1] * r; ss += ssq4(v0) + ssq4(v1); const unsigned e = row * KVR + bj * HALF + c8;
                    *at<f32x4>(w, (unsigned)WS_CKVF + e * 4) = v0; *at<f32x4>(w, (unsigned)WS_CKVF + (e + 4) * 4) = v1; *at<u32x4>(w, (unsigned)WS_CKVB + e * 2) = pack8(v0, v1); }
                ss += lx(ss, l_, 16); ss += lx(ss, l_, 32);
                if (fq == 0) *at<float>(w, (unsigned)WS_SSQKV + (row * 4 + wc) * 4) = ss;
            MK_ROWS_END
        } else if (pn < 7) {
            const bool isk = pn >= 5; const unsigned hh = 2 * ((pn - 3) & 1) + (wc >> 1), i0 = 32 * (wc & 1) + 8 * fq;
            const unsigned dbase = (unsigned)(isk ? WS_RK : WS_RQ) + hh * 256, gbase = (unsigned)(WS_TAB + (isk ? TAB_GN : TAB_GP)) + hh * 512;
            LAS unsigned char* T = lds_ + EPI_LDS_OFF + (wr * 4 + wc) * EPI_LDS_WAVE;
#pragma unroll
            for (int ai = 0; ai < 2; ++ai) {
                f32x4 y1s[2][4], y2s[2][4];
#pragma unroll
                for (int m = 0; m < 4; ++m) {
                    unsigned row = row0 + ai * HALF + m * 16; asm volatile("" : "+v"(row)); const float r = rsc[ai * 4 + m];
                    const unsigned pi = row_pidx((int)row), jt = row_jtok((int)row);
                    const float mult = *at<const float>(w, gbase + jt * 4) * (isk ? RK_SCALE : 1.f);
#pragma unroll
                    for (int n = 0; n < 2; ++n) {
                        const f32x4 x1 = acc[ai][0][m][n] * r, x2 = acc[ai][1][m][n] * r;
                        const f32x4 c = *at<const f32x4>(w, (unsigned)(WS_TAB + TAB_C64) + (pi * 64 + i0 + 4 * n) * 4), s = *at<const f32x4>(w, (unsigned)(WS_TAB + TAB_S64) + (pi * 64 + i0 + 4 * n) * 4);
                        y1s[n][m] = (x1 * c - x2 * s) * mult; y2s[n][m] = (x1 * s + x2 * c) * mult; }
                    *at<u32x4>(w, dbase + (row * 512 + i0) * 2) = pack8(y1s[0][m], y1s[1][m]); *at<u32x4>(w, dbase + (row * 512 + 64 + i0) * 2) = pack8(y2s[0][m], y2s[1][m]);
                    asm volatile("" ::: "memory");
                }
                if (isk) {
                    const unsigned rb = u.pm * BM + ai * HALF + wr * 64, cb = hh * 128 + 32 * (wc & 1);
#pragma unroll
                    for (int n = 0; n < 2; ++n) {
                        tr_store16(T, fr, fq, l_, y1s[n], w, (unsigned)WS_RKT + ((cb + 4 * n) * MP + rb) * 2u); tr_store16(T, fr, fq, l_, y2s[n], w, (unsigned)WS_RKT + ((cb + 64 + 4 * n) * MP + rb) * 2u); }
                }
            }
        } else if (pn < 11) {
            LAS unsigned char* T = lds_ + EPI_LDS_OFF + (wr * 4 + wc) * EPI_LDS_WAVE;
#pragma unroll
            for (int ai = 0; ai < 2; ++ai) {
                const unsigned rb = u.pm * BM + ai * HALF + wr * 64;
#pragma unroll
                for (int bj = 0; bj < 2; ++bj)
#pragma unroll
                    for (int n = 0; n < 2; ++n) { f32x4 vv[4];
#pragma unroll
                        for (int m = 0; m < 4; ++m) vv[m] = acc[ai][bj][m][n] * rsc[ai * 4 + m];
                        tr_store16(T, fr, fq, l_, vv, w, (unsigned)WS_RVT + (((pn - 7) * 256 + bj * HALF + wc * 32 + 4 * n) * MP + rb) * 2u); }
                asm volatile("" ::: "memory");
            }
        } else {
            const int t = (pn - 11) >> 2; const unsigned dbase = (unsigned)WS_SRG + (unsigned)t * (unsigned)(WS_SGA - WS_SRG) + (((pn - 11) & 3) * 256 + c8) * 2;
            MK_ROWS_BEGIN
#pragma unroll
                for (int bj = 0; bj < 2; ++bj) { const f32x4 v0 = acc[ai][bj][m][0] * r, v1 = acc[ai][bj][m][1] * r; f32x4 o0, o1;
#pragma unroll
                    for (int j = 0; j < 4; ++j) { const float g0 = fast_sigmoid(v0[j]), g1 = fast_sigmoid(v1[j]); o0[j] = t == 0 ? v0[j] * g0 : g0; o1[j] = t == 0 ? v1[j] * g1 : g1; }
                    *at<u32x4>(w, dbase + (row * 1024 + bj * HALF) * 2) = pack8(o0, o1); }
            MK_ROWS_END
        }
    }
};
static_assert(WS_SGB - WS_SGA == WS_SGA - WS_SRG, "gate arrays equally spaced");
struct EpiQ {
    static constexpr bool PERM = false, AFTER_DRAIN = false;
    unsigned char* ws;
    __device__ __forceinline__ void operator()(const f32x4 (&acc)[2][2][4][2], const Unit& u, int wr, int wc, int fr, int fq) const {
        int l_ = lane_fresh(); asm volatile("" : "+v"(l_)); fr = l_ & 15; fq = l_ >> 4;
        const float* SSQCQ = (const float*)(ws + WS_SSQCQ); bf16* QA = (bf16*)(ws + WS_QA); const float* TAB = (const float*)(ws + WS_TAB);
        const int row0 = u.pm * BM + wr * 64 + fr;
#pragma unroll
        for (int ai = 0; ai < 2; ++ai)
#pragma unroll
            for (int m = 0; m < 4; ++m) {
                int row = row0 + ai * HALF + m * 16; asm volatile("" : "+v"(row));
                const float r = row_rscale8(SSQCQ, row, 1.f / QR) * SC_Q;
#pragma unroll
                for (int bj = 0; bj < 2; ++bj) {
                    const int grp = 8 * u.pn + 4 * bj + wc;
                    bf16* dst = QA + (size_t)row * 768 + 32 * grp + 4 * fq;
                    const bool rope = (grp % 3) == 2;
                    const int pi = row_pidx(row);
                    f32x4 c = *(const f32x4*)(TAB + TAB_C16 / 4 + pi * 16 + 4 * fq), s = *(const f32x4*)(TAB + TAB_S16 / 4 + pi * 16 + 4 * fq);
                    if (!rope) { c = (f32x4){1.f, 1.f, 1.f, 1.f}; s = (f32x4){0.f, 0.f, 0.f, 0.f}; }
                    const f32x4 x1 = acc[ai][bj][m][0] * r, x2 = acc[ai][bj][m][1] * r;
                    *(u32x2*)dst = pack4(x1 * c - x2 * s); *(u32x2*)(dst + 16) = pack4(x1 * s + x2 * c);
                }
                asm volatile("" ::: "memory");
            }
    }
};
template <bool ROWS> struct EpiScaleBf16 {
    static constexpr bool PERM = true, AFTER_DRAIN = false;
    const float* SSQKV; bf16* O; int ldc;
    __device__ __forceinline__ void operator()(const f32x4 (&acc)[2][2][4][2], const Unit& u, int wr, int wc, int fr, int fq) const {
        int l_ = lane_fresh(); asm volatile("" : "+v"(l_)); fr = l_ & 15; fq = l_ >> 4;
        const int row0 = u.pm * BM + wr * 64 + fr, col0 = u.pn * BM + wc * 32 + 8 * fq;
        float cs[2][8];
        if (!ROWS) {
#pragma unroll
            for (int bj = 0; bj < 2; ++bj)
#pragma unroll
                for (int k = 0; k < 8; ++k) cs[bj][k] = row_rscale4(SSQKV, col0 + bj * HALF + k, 1.f / KVR);
        }
#pragma unroll
        for (int ai = 0; ai < 2; ++ai)
#pragma unroll
            for (int m = 0; m < 4; ++m) { int row = row0 + ai * HALF + m * 16; asm volatile("" : "+v"(row)); const float r = ROWS ? row_rscale4(SSQKV, row, 1.f / KVR) : 1.f;
#pragma unroll
                for (int bj = 0; bj < 2; ++bj) { f32x4 v0 = acc[ai][bj][m][0], v1 = acc[ai][bj][m][1];
                    if (ROWS) { v0 = v0 * r; v1 = v1 * r; }
                    else {
#pragma unroll
                        for (int j = 0; j < 4; ++j) { v0[j] *= cs[bj][j]; v1[j] *= cs[bj][4 + j]; } }
                    u32x4 w; w.x = pg8::cvt_pk_bf16(v0[0], v0[1]); w.y = pg8::cvt_pk_bf16(v0[2], v0[3]); w.z = pg8::cvt_pk_bf16(v1[0], v1[1]); w.w = pg8::cvt_pk_bf16(v1[2], v1[3]);
                    *(u32x4*)(O + (size_t)row * ldc + col0 + bj * HALF) = w; } }
    }
};
__device__ __forceinline__ void finalize_ckv(Frame& F, const Ptrs& a) {
    const int lane = fresh_tid(F.wave) & 63;
    const int gw = F.vcu * NWAVES + F.wave, NGW = F.G * NWAVES;
    const float* CKVF = (const float*)(a.ws + WS_CKVF); const float* SSQKV = (const float*)(a.ws + WS_SSQKV); const float* KRF = (const float*)(a.ws + WS_KRF);
    const f32x4 g = *((const f32x4*)a.in(14) + lane);
    for (int row = gw; row < ROW_PAD; row += NGW) {
        const float r = row_rscale4(SSQKV, row, 1.f / KVR);
        const f32x4 o = *((const f32x4*)(CKVF + (size_t)row * KVR) + lane) * r * g;
        const f32x4 kr = *((const f32x4*)(KRF + (size_t)row * 32) + (lane & 7));
        if (row < MMAIN) { const size_t t = (size_t)(row >> 11) * T + NMETA + (row & (SEQ - 1)); *((f32x4*)(a.out() + OUT_CKVP + t * KVR) + lane) = o; if (lane < 8) *((f32x4*)(a.out() + OUT_KRP + t * 32) + lane) = kr; }
        else if (row < ROW_SMP) { for (int b = 0; b < NB; ++b) { const size_t t = (size_t)b * T + (row - ROW_META); *((f32x4*)(a.out() + OUT_CKVP + t * KVR) + lane) = o; if (lane < 8) *((f32x4*)(a.out() + OUT_KRP + t * 32) + lane) = kr; } }
        else { *((f32x4*)(a.out() + OUT_CKVS + (size_t)(row - ROW_SMP) * KVR) + lane) = o; if (lane < 8) *((f32x4*)(a.out() + OUT_KRS + (size_t)(row - ROW_SMP) * 32) + lane) = kr; }
    }
}
}
namespace mk {
constexpr size_t WS_AV = WS_END2;
constexpr size_t WS_END3 = WS_AV + al((size_t)MP * 512 * 2);
typedef float f32x16 __attribute__((ext_vector_type(16)));
constexpr int AT_KSTR = 208, AT_VSTR = 144, AT_KBUF = 64 * AT_KSTR, AT_VBUF = 64 * AT_VSTR, AT_VOFF = 2 * AT_KBUF;
__device__ __forceinline__ int crow(int i, int half) { return (i & 3) + 8 * (i >> 2) + 4 * half; }

__device__ __forceinline__ void attn_unit(Frame& F, unsigned char* ws, int b, int h, int qb) {
    ws = opaque_g(ws);
    const int tid = fresh_tid(F.wave), lane = tid & 63, w = F.wave, q = lane & 31, half = lane >> 5;
    LAS unsigned char* L = F.lds + RING_OFF;
    const bf16* QA = (const bf16*)(ws + WS_QA); const bf16* KN = (const bf16*)(ws + WS_KN); const bf16* KRB = (const bf16*)(ws + WS_KRB); const bf16* VT = (const bf16*)(ws + WS_VT);
    const int qrow = b * SEQ + qb * 256 + w * 32 + q, q_main = qb * 256 + w * 32 + q, wq0 = qb * 256 + w * 32;
    bf16x8 qf[6];
#pragma unroll
    for (int s = 0; s < 6; ++s) qf[s] = *(const bf16x8*)(QA + (size_t)qrow * 768 + h * 96 + 16 * s + 8 * half);
    f32x16 ot[2];
#pragma unroll
    for (int i = 0; i < 16; ++i) { ot[0][i] = 0.f; ot[1][i] = 0.f; }
    float m = -INFINITY, l = 0.f;
    const int NT = 4 * (qb + 1);
    v4u kreg, rreg, vreg; rreg = (v4u){0u, 0u, 0u, 0u};
#define AT_LOAD(tt) do { const int t0_ = (tt) == 0 ? ROW_META : b * SEQ + 64 * ((tt) - 1); \
        kreg = *(const v4u*)(KN + (size_t)(t0_ + (tid >> 3)) * 512 + h * 64 + (tid & 7) * 8); \
        if (tid < 256) rreg = *(const v4u*)(KRB + (size_t)(t0_ + (tid >> 2)) * 32 + (tid & 3) * 8); \
        vreg = *(const v4u*)(VT + (size_t)(h * 64 + (tid >> 3)) * MP + t0_ + (tid & 7) * 8); } while (0)
#define AT_STORE(buf) do { LAS unsigned char* kb_ = L + (buf) * AT_KBUF; \
        *(LAS v4u*)(kb_ + (tid >> 3) * AT_KSTR + (tid & 7) * 16) = kreg; \
        if (tid < 256) *(LAS v4u*)(kb_ + (tid >> 2) * AT_KSTR + 128 + (tid & 3) * 16) = rreg; \
        LAS unsigned char* vb_ = L + AT_VOFF + (buf) * AT_VBUF + (tid >> 3) * AT_VSTR + (32 * ((tid & 7) >> 1) + 8 * (tid & 1)); \
        *(LAS u32x2*)(vb_) = (u32x2){vreg.x, vreg.y}; *(LAS u32x2*)(vb_ + 16) = (u32x2){vreg.z, vreg.w}; } while (0)
    AT_LOAD(0); AT_STORE(0);
    __syncthreads();
    for (int tt = 0; tt <= NT; ++tt) {
        const int buf = tt & 1;
        if (tt < NT) AT_LOAD(tt + 1);
        const int kmin = tt == 0 ? 0 : 64 * (tt - 1);
        if (tt == 0 || kmin <= wq0 + 31) {
            const LAS unsigned char* Kb = L + buf * AT_KBUF + q * AT_KSTR + 16 * half;
            const LAS unsigned char* Vb = L + AT_VOFF + buf * AT_VBUF + q * AT_VSTR + 16 * half;
            f32x16 st[2];
#pragma unroll
            for (int kb = 0; kb < 2; ++kb) {
#pragma unroll
                for (int i = 0; i < 16; ++i) st[kb][i] = 0.f;
#pragma unroll
                for (int s = 0; s < 6; ++s) { const bf16x8 kf = *(const LAS bf16x8*)(Kb + kb * 32 * AT_KSTR + 32 * s); st[kb] = __builtin_amdgcn_mfma_f32_32x32x16_bf16(kf, qf[s], st[kb], 0, 0, 0); }
            }
            if (tt == 0) {
#pragma unroll
                for (int kb = 0; kb < 2; ++kb)
#pragma unroll
                    for (int i = 0; i < 16; ++i) if (32 * kb + crow(i, half) >= NMETA) st[kb][i] = -INFINITY;
            } else if (kmin + 63 > wq0) {
#pragma unroll
                for (int kb = 0; kb < 2; ++kb)
#pragma unroll
                    for (int i = 0; i < 16; ++i) if (kmin + 32 * kb + crow(i, half) > q_main) st[kb][i] = -INFINITY;
            }
            float mx = st[0][0];
#pragma unroll
            for (int i = 1; i < 16; ++i) mx = fmaxf(mx, st[0][i]);
#pragma unroll
            for (int i = 0; i < 16; ++i) mx = fmaxf(mx, st[1][i]);
            mx = fmaxf(mx, lx(mx, lane, 32));
            const float mn = fmaxf(m, mx), alpha = __builtin_amdgcn_exp2f(m - mn);
            m = mn;
            float ps = 0.f;
#pragma unroll
            for (int kb = 0; kb < 2; ++kb)
#pragma unroll
                for (int i = 0; i < 16; ++i) { st[kb][i] = __builtin_amdgcn_exp2f(st[kb][i] - mn); ps += st[kb][i]; }
            l = l * alpha + ps;
#pragma unroll
            for (int i = 0; i < 16; ++i) { ot[0][i] *= alpha; ot[1][i] *= alpha; }
#pragma unroll
            for (int kb = 0; kb < 2; ++kb)
#pragma unroll
                for (int s2 = 0; s2 < 2; ++s2) {
                    u32x4 pw; pw.x = pg8::cvt_pk_bf16(st[kb][8 * s2 + 0], st[kb][8 * s2 + 1]); pw.y = pg8::cvt_pk_bf16(st[kb][8 * s2 + 2], st[kb][8 * s2 + 3]);
                    pw.z = pg8::cvt_pk_bf16(st[kb][8 * s2 + 4], st[kb][8 * s2 + 5]); pw.w = pg8::cvt_pk_bf16(st[kb][8 * s2 + 6], st[kb][8 * s2 + 7]);
                    const bf16x8 pf = __builtin_bit_cast(bf16x8, pw);
#pragma unroll
                    for (int vb = 0; vb < 2; ++vb) { const bf16x8 vf = *(const LAS bf16x8*)(Vb + vb * 32 * AT_VSTR + (32 * kb + 16 * s2) * 2); ot[vb] = __builtin_amdgcn_mfma_f32_32x32x16_bf16(vf, pf, ot[vb], 0, 0, 0); }
                }
        }
        if (tt < NT) AT_STORE(buf ^ 1);
        __syncthreads();
    }
#undef AT_LOAD
#undef AT_STORE
    l += lx(l, lane, 32);
    const float inv = 1.0f / l;
    bf16* AV = (bf16*)(ws + WS_AV) + (size_t)qrow * 512 + h * 64 + 4 * half;
#pragma unroll
    for (int vb = 0; vb < 2; ++vb)
#pragma unroll
        for (int g = 0; g < 4; ++g) { f32x4 o; o[0] = ot[vb][4 * g] * inv; o[1] = ot[vb][4 * g + 1] * inv; o[2] = ot[vb][4 * g + 2] * inv; o[3] = ot[vb][4 * g + 3] * inv; *(u32x2*)(AV + 32 * vb + 8 * g) = pack4(o); }
}
__device__ __forceinline__ void attn_item(Frame& F, unsigned char* ws, int i) { const int bh = i & 63; attn_unit(F, ws, bh >> 3, bh & 7, 7 - (i >> 6)); }
__device__ __forceinline__ void attn_phase(Frame& F, unsigned char* ws) {
    const int c = F.vcu;
    if (c >= 256) return;
    const int bh = c >> 2, p = c & 3;
    attn_unit(F, ws, bh >> 3, bh & 7, 7 - p);
    attn_unit(F, ws, bh >> 3, bh & 7, p);
}
}
namespace mk {
constexpr size_t WS_UMETA = WS_END3;
constexpr size_t WS_UT = WS_UMETA + al((size_t)RH * RDV * RDK * 4);
constexpr size_t WS_SPREV = WS_UT + al((size_t)32 * 16 * RDV * RDK * 4);
constexpr size_t WS_RIN = WS_SPREV + al((size_t)32 * 16 * RDV * RDK * 2);
constexpr size_t WS_DPART = WS_RIN + al((size_t)MP * 1024 * 2);
constexpr size_t WS_QL = WS_DPART + al((size_t)32 * 16 * 8 * 264 * 4);
constexpr size_t WS_END4 = WS_QL + al((size_t)64 * 2048 * 4);
static_assert(WS_END4 < ((size_t)1 << 31), "32-bit workspace offsets");
__device__ __forceinline__ float gpow_t(const unsigned char* ws, int h, int n) { return ((const float*)(ws + WS_TAB + TAB_GP))[h * 128 + n]; }

__device__ __forceinline__ void ret_u_unit(Frame& F, unsigned char* ws, int u) {
    ws = opaque_g(ws);
    const int tid = fresh_tid(F.wave), lane = tid & 63, w = F.wave, r32 = lane & 31, half = lane >> 5;
    const bool meta = u >= 512; const int hh = meta ? u - 512 : (u >> 4) & 3;
    const int tok0 = meta ? ROW_META : (u >> 6) * SEQ + (u & 15) * 128, nks = meta ? 1 : 8;
    const bf16* RVT = (const bf16*)(ws + WS_RVT); const bf16* RKT = (const bf16*)(ws + WS_RKT);
    f32x16 acc[4];
#pragma unroll
    for (int db = 0; db < 4; ++db)
#pragma unroll
        for (int i = 0; i < 16; ++i) acc[db][i] = 0.f;
    const bf16* ap = RVT + (size_t)(hh * 256 + 32 * w + r32) * MP + tok0 + 8 * half;
    const bf16* bp = RKT + (size_t)(hh * 128 + r32) * MP + tok0 + 8 * half;
    for (int s = 0; s < nks; ++s) {
        const bf16x8 af = *(const bf16x8*)(ap + 16 * s);
#pragma unroll
        for (int db = 0; db < 4; ++db) { const bf16x8 bf = *(const bf16x8*)(bp + (size_t)(32 * db) * MP + 16 * s); acc[db] = __builtin_amdgcn_mfma_f32_32x32x16_bf16(af, bf, acc[db], 0, 0, 0); }
    }
    const float sc = gpow_t(ws, hh, meta ? NMETA - 1 : 127);
    float* dst = meta ? (float*)(ws + WS_UMETA) + (size_t)hh * RDV * RDK : (float*)(ws + WS_UT) + (size_t)u * RDV * RDK;
#pragma unroll
    for (int db = 0; db < 4; ++db)
#pragma unroll
        for (int i = 0; i < 16; ++i) dst[(size_t)(32 * w + crow(i, half)) * RDK + 32 * db + r32] = acc[db][i] * sc;
}
__device__ __forceinline__ void ret_scan(Frame& F, const Ptrs& a) {
    const int tid = fresh_tid(F.wave);
    const int gt = (F.vcu * NWAVES * 64) + tid, NGT = F.G * NWAVES * 64;
    const float* UM = (const float*)(a.ws + WS_UMETA); const float* UT = (const float*)(a.ws + WS_UT); bf16* SP = (bf16*)(a.ws + WS_SPREV);
    for (int e = gt; e < 32 * RDV * RDK; e += NGT) {
        const int bh = e >> 15, idx = e & 32767, hh = bh & 3;
        const float g128 = gpow_t(a.ws, hh, 127) * gpow_t(a.ws, hh, 1);
        float S = UM[(size_t)hh * 32768 + idx];
        for (int c = 0; c < 16; ++c) { const size_t o = ((size_t)bh * 16 + c) * 32768 + idx; SP[o] = bf1(S); S = g128 * S + UT[o]; }
        const int ee = idx >> 7, d = idx & 127;
        a.out()[OUT_SRP + ((size_t)bh * RDK + d) * RDV + ee] = S;
    }
}
__device__ __forceinline__ void ret_o_unit(Frame& F, const Ptrs& a, int u) {
    unsigned char* ws = a.ws; ws = opaque_g(ws);
    const int tid = fresh_tid(F.wave), lane = tid & 63, w = F.wave, r32 = lane & 31, half = lane >> 5;
    const int bh = u >> 4, c = u & 15, hh = bh & 3, tok0 = (bh >> 2) * SEQ + c * 128;
    const int ib = w & 3, eh = w >> 2;
    LAS float* red = (LAS float*)(F.lds + RING_OFF);
    const bf16* RQ = (const bf16*)(ws + WS_RQ); const bf16* RK = (const bf16*)(ws + WS_RK); const bf16* RVT = (const bf16*)(ws + WS_RVT);
    const bf16* SP = (const bf16*)(ws + WS_SPREV) + (size_t)u * 32768;
    const int irow = tok0 + 32 * ib + r32;
    bf16x8 qf[8];
#pragma unroll
    for (int s = 0; s < 8; ++s) qf[s] = *(const bf16x8*)(RQ + (size_t)irow * 512 + hh * 128 + 16 * s + 8 * half);
    f32x16 ot[4];
#pragma unroll
    for (int eb = 0; eb < 4; ++eb) {
#pragma unroll
        for (int i = 0; i < 16; ++i) ot[eb][i] = 0.f;
        const bf16* sp = SP + (size_t)(128 * eh + 32 * eb + r32) * RDK + 8 * half;
#pragma unroll
        for (int s = 0; s < 8; ++s) { const bf16x8 sf = *(const bf16x8*)(sp + 16 * s); ot[eb] = __builtin_amdgcn_mfma_f32_32x32x16_bf16(sf, qf[s], ot[eb], 0, 0, 0); }
    }
    const float g = gpow_t(ws, hh, 1);
#pragma unroll
    for (int eb = 0; eb < 4; ++eb)
#pragma unroll
        for (int i = 0; i < 16; ++i) ot[eb][i] *= g;
    for (int jb = 0; jb <= ib; ++jb) {
        f32x16 at;
#pragma unroll
        for (int i = 0; i < 16; ++i) at[i] = 0.f;
        const bf16* kp = RK + (size_t)(tok0 + 32 * jb + r32) * 512 + hh * 128 + 8 * half;
#pragma unroll
        for (int s = 0; s < 8; ++s) { const bf16x8 kf = *(const bf16x8*)(kp + 16 * s); at = __builtin_amdgcn_mfma_f32_32x32x16_bf16(kf, qf[s], at, 0, 0, 0); }
        if (jb == ib) {
#pragma unroll
            for (int i = 0; i < 16; ++i) if (crow(i, half) > r32) at[i] = 0.f;
        }
#pragma unroll
        for (int s2 = 0; s2 < 2; ++s2) {
            u32x4 pw; pw.x = pg8::cvt_pk_bf16(at[8 * s2 + 0], at[8 * s2 + 1]); pw.y = pg8::cvt_pk_bf16(at[8 * s2 + 2], at[8 * s2 + 3]);
            pw.z = pg8::cvt_pk_bf16(at[8 * s2 + 4], at[8 * s2 + 5]); pw.w = pg8::cvt_pk_bf16(at[8 * s2 + 6], at[8 * s2 + 7]);
            const bf16x8 pf = __builtin_bit_cast(bf16x8, pw);
#pragma unroll
            for (int eb = 0; eb < 4; ++eb) {
                const bf16* vp = RVT + (size_t)(hh * 256 + 128 * eh + 32 * eb + r32) * MP + tok0 + 32 * jb + 16 * s2 + 4 * half;
                const u32x2 lo = *(const u32x2*)vp, hi = *(const u32x2*)(vp + 8);
                u32x4 vw; vw.x = lo.x; vw.y = lo.y; vw.z = hi.x; vw.w = hi.y;
                ot[eb] = __builtin_amdgcn_mfma_f32_32x32x16_bf16(__builtin_bit_cast(bf16x8, vw), pf, ot[eb], 0, 0, 0);
            }
        }
    }
    float s1 = 0.f;
#pragma unroll
    for (int eb = 0; eb < 4; ++eb)
#pragma unroll
        for (int i = 0; i < 16; ++i) s1 += ot[eb][i];
    s1 += lx(s1, lane, 32);
    if (half == 0) red[w * 32 + r32] = s1;
    __syncthreads();
    const float mu = (red[w * 32 + r32] + red[(w ^ 4) * 32 + r32]) * (1.f / 256.f);
    float s2 = 0.f;
#pragma unroll
    for (int eb = 0; eb < 4; ++eb)
#pragma unroll
        for (int i = 0; i < 16; ++i) { ot[eb][i] -= mu; s2 += ot[eb][i] * ot[eb][i]; }
    s2 += lx(s2, lane, 32);
    if (half == 0) red[256 + w * 32 + r32] = s2;
    __syncthreads();
    const float rstd = 1.0f / sqrtf((red[256 + w * 32 + r32] + red[256 + (w ^ 4) * 32 + r32]) * (1.f / 256.f) + EPS);
    __syncthreads();
    const bf16* SRG = (const bf16*)(ws + WS_SRG) + (size_t)irow * 1024 + hh * 256 + 128 * eh + 4 * half;
    bf16* RIN = (bf16*)(ws + WS_RIN) + (size_t)irow * 1024 + hh * 256 + 128 * eh + 4 * half;
    const float* gn = a.in(19) + hh * 256 + 128 * eh + 4 * half;
#pragma unroll
    for (int eb = 0; eb < 4; ++eb)
#pragma unroll
        for (int gq = 0; gq < 4; ++gq) {
            const int eo = 32 * eb + 8 * gq;
            const u32x2 sg = *(const u32x2*)(SRG + eo); const f32x4 gv = *(const f32x4*)(gn + eo);
            f32x4 o;
            o[0] = ot[eb][4 * gq + 0] * rstd * gv[0] * __uint_as_float(sg.x << 16); o[1] = ot[eb][4 * gq + 1] * rstd * gv[1] * __uint_as_float(sg.x & 0xffff0000u);
            o[2] = ot[eb][4 * gq + 2] * rstd * gv[2] * __uint_as_float(sg.y << 16); o[3] = ot[eb][4 * gq + 3] * rstd * gv[3] * __uint_as_float(sg.y & 0xffff0000u);
            *(u32x2*)(RIN + eo) = pack4(o);
        }
}
__device__ __forceinline__ void ret_sample_unit(Frame& F, const Ptrs& a, int u) {
    unsigned char* ws = a.ws; ws = opaque_g(ws);
    const int tid = fresh_tid(F.wave), lane = tid & 63, s = u >> 2, hh = u & 3, e = tid & 255, dh = tid >> 8, row = ROW_SMP + s;
    LAS float* sh = (LAS float*)(F.lds + RING_OFF);
    const bf16* RQ = (const bf16*)(ws + WS_RQ); const bf16* RK = (const bf16*)(ws + WS_RK); const bf16* RVT = (const bf16*)(ws + WS_RVT);
    if (tid < 128) sh[tid] = __uint_as_float((unsigned)RQ[(size_t)row * 512 + hh * 128 + tid] << 16);
    else if (tid < 256) sh[tid] = __uint_as_float((unsigned)RK[(size_t)row * 512 + hh * 128 + tid - 128] << 16);
    __syncthreads();
    const float v = __uint_as_float((unsigned)RVT[(size_t)(hh * 256 + e) * MP + row] << 16);
    const float g = gpow_t(ws, hh, 1);
    const float* S0 = a.in(4) + ((size_t)(s * RH + hh) * RDK) * RDV + e;
    float* S1 = a.out() + OUT_SRS + ((size_t)(s * RH + hh) * RDK) * RDV + e;
    float o = 0.f;
    {   float s0[64];
#pragma unroll
        for (int k = 0; k < 64; ++k) s0[k] = S0[(size_t)(64 * dh + k) * RDV];
#pragma unroll
        for (int k = 0; k < 64; ++k) { const int d = 64 * dh + k; const float sn = g * s0[k] + sh[128 + d] * v; S1[(size_t)d * RDV] = sn; o += sh[d] * sn; } }
    sh[256 + dh * 256 + e] = o;
    __syncthreads();
    o = sh[256 + e] + sh[512 + e];
    float t1 = o;
#pragma unroll
    for (int off = 32; off > 0; off >>= 1) t1 += lx(t1, lane, off);
    if ((tid & 63) == 0) sh[768 + (tid >> 6)] = t1;
    __syncthreads();
    const float mu = (sh[768] + sh[769] + sh[770] + sh[771]) * (1.f / 256.f);
    const float dlt = o - mu;
    float t2 = dlt * dlt;
#pragma unroll
    for (int off = 32; off > 0; off >>= 1) t2 += lx(t2, lane, off);
    if ((tid & 63) == 0) sh[776 + (tid >> 6)] = t2;
    __syncthreads();
    const float rstd = 1.0f / sqrtf((sh[776] + sh[777] + sh[778] + sh[779]) * (1.f / 256.f) + EPS);
    if (dh == 0) { const float sg = __uint_as_float((unsigned)((const bf16*)(ws + WS_SRG))[(size_t)row * 1024 + hh * 256 + e] << 16);
        ((bf16*)(ws + WS_RIN))[(size_t)row * 1024 + hh * 256 + e] = bf1(dlt * rstd * a.in(19)[hh * 256 + e] * sg); }
    __syncthreads();
}
}
namespace mk {
template <int CTRL> __device__ __forceinline__ float dppf(float v) { return __int_as_float(__builtin_amdgcn_update_dpp(0, __float_as_int(v), CTRL, 0xF, 0xF, false)); }
__device__ __forceinline__ float swap32_add(float a, float b) { const auto r = __builtin_amdgcn_permlane32_swap(__float_as_uint(a), __float_as_uint(b), false, false); return __uint_as_float(r[0]) + __uint_as_float(r[1]); }
__device__ __forceinline__ float swap16_add(float a, float b) { const auto r = __builtin_amdgcn_permlane16_swap(__float_as_uint(a), __float_as_uint(b), false, false); return __uint_as_float(r[0]) + __uint_as_float(r[1]); }
__device__ __forceinline__ int dlane_of(int h) { return ((h >> 2) & 1) * 32 + ((h >> 1) & 1) * 16 + (h & 1) * 8; }
__device__ __forceinline__ void decode_unit(Frame& F, const Ptrs& a, int u) {
    unsigned char* ws = a.ws; ws = opaque_g(ws);
    const int tid = fresh_tid(F.wave), lane = tid & 63, w = F.wave, s = u >> 4, sp = u & 15, row = ROW_SMP + s;
    LAS float* sh = (LAS float*)(F.lds + RING_OFF);
    const bf16* QA = (const bf16*)(ws + WS_QA) + (size_t)row * 768;
    f32x4 ql[8]; float qr[8];
    { const float* QLr = (const float*)(ws + WS_QL) + (size_t)(row - MMAIN) * 2048;
#pragma unroll
      for (int h = 0; h < 8; ++h) { ql[h] = *(const f32x4*)(QLr + h * 256 + 4 * lane); qr[h] = lane < 32 ? __uint_as_float((unsigned)QA[h * 96 + 64 + lane] << 16) : 0.f; } }
    f32x4 O[8];
#pragma unroll
    for (int h = 0; h < 8; ++h) O[h] = (f32x4){0.f, 0.f, 0.f, 0.f};
    float m = -INFINITY, l = 0.f;
    const int page = ((const int*)a.in(5))[s * NPAGES + sp * 8 + w];
    const float* ck0 = a.in(2) + (size_t)page * PAGE * KVR + 4 * lane;
    const float* kr0 = a.in(3) + (size_t)page * PAGE * 32 + (lane & 31);
#define DC_LOAD(kv_, rv_, bi_) do { const float* c_ = ck0; const float* r_ = kr0; const int k0_ = (bi_) * 4; \
        _Pragma("unroll") for (int kk = 0; kk < 4; ++kk) { kv_[kk] = *(const f32x4*)(c_ + (size_t)(k0_ + kk) * KVR); rv_[kk] = r_[(size_t)(k0_ + kk) * 32]; } } while (0)
#define DC_COMPUTE(kv_, rv_) do { float sc[4]; \
        _Pragma("unroll") for (int kk = 0; kk < 4; ++kk) { float p[8]; \
            _Pragma("unroll") for (int h = 0; h < 8; ++h) p[h] = fmaf(ql[h][0], kv_[kk][0], fmaf(ql[h][1], kv_[kk][1], fmaf(ql[h][2], kv_[kk][2], fmaf(ql[h][3], kv_[kk][3], qr[h] * rv_[kk])))); \
              \
            const float a0 = swap32_add(p[0], p[4]), a1 = swap32_add(p[1], p[5]), a2 = swap32_add(p[2], p[6]), a3 = swap32_add(p[3], p[7]); \
            const float b0 = swap16_add(a0, a2), b1 = swap16_add(a1, a3); \
            const float c0 = b0 + dppf<0x128>(b0), c1 = b1 + dppf<0x128>(b1); \
            float v1 = (lane & 8) ? c1 : c0; \
            v1 += dppf<0xB1>(v1); v1 += dppf<0x4E>(v1); v1 += dppf<0x141>(v1); sc[kk] = v1; } \
        const float mx = fmaxf(fmaxf(sc[0], sc[1]), fmaxf(sc[2], sc[3])); \
        const float mn = fmaxf(m, mx), alpha = __builtin_amdgcn_exp2f(m - mn); m = mn; \
        float pe[4]; \
        _Pragma("unroll") for (int kk = 0; kk < 4; ++kk) pe[kk] = __builtin_amdgcn_exp2f(sc[kk] - mn); \
        l = l * alpha + ((pe[0] + pe[1]) + (pe[2] + pe[3])); \
        _Pragma("unroll") for (int h = 0; h < 8; ++h) { const int src = dlane_of(h); \
            const float ah = __int_as_float(__builtin_amdgcn_readlane(__float_as_int(alpha), src)), p0 = __int_as_float(__builtin_amdgcn_readlane(__float_as_int(pe[0]), src)), p1 = __int_as_float(__builtin_amdgcn_readlane(__float_as_int(pe[1]), src)), \
                        p2 = __int_as_float(__builtin_amdgcn_readlane(__float_as_int(pe[2]), src)), p3 = __int_as_float(__builtin_amdgcn_readlane(__float_as_int(pe[3]), src)); \
            O[h] = O[h] * ah + kv_[0] * p0 + kv_[1] * p1 + kv_[2] * p2 + kv_[3] * p3; } } while (0)
    f32x4 kvA[4], kvB[4], kvC[4]; float rvA[4], rvB[4], rvC[4];
#define DC_PIN() __builtin_amdgcn_sched_barrier(0)
    DC_LOAD(kvA, rvA, 0); DC_LOAD(kvB, rvB, 1); DC_PIN();
#pragma unroll 1
    for (int bi = 0; bi < 30; bi += 3) {
        DC_LOAD(kvC, rvC, bi + 2); DC_PIN();
        DC_COMPUTE(kvA, rvA); DC_PIN();
        DC_LOAD(kvA, rvA, bi + 3); DC_PIN();
        DC_COMPUTE(kvB, rvB); DC_PIN();
        DC_LOAD(kvB, rvB, bi + 4); DC_PIN();
        DC_COMPUTE(kvC, rvC); DC_PIN();
    }
    DC_COMPUTE(kvA, rvA);
    DC_COMPUTE(kvB, rvB);
#undef DC_PIN
#undef DC_LOAD
#undef DC_COMPUTE
    LAS float* wm = sh + 2304 + w * 16;
    LAS float* wo = sh + 2304 + 128 + w * 2048;
    { const int hd = 4 * (lane >> 5) + 2 * ((lane >> 4) & 1) + ((lane >> 3) & 1); if ((lane & 7) == 0) { wm[hd] = m; wm[8 + hd] = l; } }
#pragma unroll
    for (int h = 0; h < 8; ++h) *(LAS f32x4*)(wo + h * 256 + 4 * lane) = O[h];
    __syncthreads();
    float* part = (float*)(ws + WS_DPART) + (size_t)u * 8 * 264;
    for (int e = tid; e < 2048; e += 512) {
        const int h = e >> 8;
        float M = -INFINITY;
#pragma unroll
        for (int ww = 0; ww < 8; ++ww) M = fmaxf(M, sh[2304 + ww * 16 + h]);
        float acc = 0.f, L = 0.f;
#pragma unroll
        for (int ww = 0; ww < 8; ++ww) { const float f = __builtin_amdgcn_exp2f(sh[2304 + ww * 16 + h] - M); acc += f * sh[2304 + 128 + ww * 2048 + e]; L += f * sh[2304 + ww * 16 + 8 + h]; }
        __hip_atomic_store(part + h * 264 + (e & 255), acc, __ATOMIC_RELAXED, __HIP_MEMORY_SCOPE_AGENT);
        if ((e & 255) == 0) { __hip_atomic_store(part + h * 264 + 256, M, __ATOMIC_RELAXED, __HIP_MEMORY_SCOPE_AGENT); __hip_atomic_store(part + h * 264 + 257, L, __ATOMIC_RELAXED, __HIP_MEMORY_SCOPE_AGENT); }
    }
    asm volatile("s_waitcnt vmcnt(0)" ::: "memory");
    __syncthreads();
    if (tid == 0) (void)__hip_atomic_fetch_add((unsigned*)(ws + WS_CTL) + CW_DCNT + 16 * s, 1u, __ATOMIC_RELAXED, __HIP_MEMORY_SCOPE_AGENT);
}
__device__ __forceinline__ void decode_combine_unit(Frame& F, const Ptrs& a, int u) {
    unsigned char* ws = opaque_g(a.ws);
    const int tid = fresh_tid(F.wave), lane = tid & 63, s = u >> 3, h = u & 7, row = ROW_SMP + s;
    LAS float* sh = (LAS float*)(F.lds + RING_OFF);
    const bf16* QA = (const bf16*)(ws + WS_QA) + (size_t)row * 768;
    const float* part = (const float*)(ws + WS_DPART) + (size_t)s * 16 * 8 * 264;
    if (tid == 0) { const unsigned* cn = (const unsigned*)(ws + WS_CTL) + CW_DCNT + 16 * s; unsigned spins = 0;
        while (__hip_atomic_load(cn, __ATOMIC_RELAXED, __HIP_MEMORY_SCOPE_AGENT) < 16u && ++spins < (1u << 22)) __builtin_amdgcn_s_sleep(8);
        __builtin_amdgcn_fence(__ATOMIC_ACQUIRE, "agent"); asm volatile("s_waitcnt vmcnt(0)" ::: "memory"); }
    __syncthreads();
    if (tid < 64) { const bf16* KNr = (const bf16*)(ws + WS_KN) + (size_t)row * 512;
        float acc = __uint_as_float((unsigned)QA[h * 96 + lane] << 16) * __uint_as_float((unsigned)KNr[h * 64 + lane] << 16);
        if (lane < 32) acc += __uint_as_float((unsigned)QA[h * 96 + 64 + lane] << 16) * ((const float*)(ws + WS_KRF))[(size_t)row * 32 + lane];
#pragma unroll
        for (int off = 32; off > 0; off >>= 1) acc += lx(acc, lane, off);
        if (lane == 0) sh[256] = acc; }
    __syncthreads();
    if (tid < 256) {
        const int r = tid;
        const float sn = sh[256];
        float pm[16];
#pragma unroll
        for (int p = 0; p < 16; ++p) pm[p] = part[(p * 8 + h) * 264 + 256];
        float M = sn;
#pragma unroll
        for (int p = 0; p < 16; ++p) M = fmaxf(M, pm[p]);
        const float rkv = row_rscale4((const float*)(ws + WS_SSQKV), row, 1.f / KVR);
        const float cn = ((const float*)(ws + WS_CKVF))[(size_t)row * KVR + r] * rkv * a.in(14)[r];
        const float fn = __builtin_amdgcn_exp2f(sn - M);
        float acc = fn * cn, Lq = fn;
#pragma unroll
        for (int p = 0; p < 16; ++p) { const float f = __builtin_amdgcn_exp2f(pm[p] - M); acc += f * part[(p * 8 + h) * 264 + r]; Lq += f * part[(p * 8 + h) * 264 + 257]; }
        sh[r] = acc / Lq;
    }
    __syncthreads();
    { const int v = tid & 63, rg = tid >> 6; const float* wuv = a.in(17) + (size_t)(32 * rg) * 512 + h * 64 + v;
      float wv[32];
#pragma unroll
      for (int k = 0; k < 32; ++k) wv[k] = wuv[(size_t)k * 512];
      float acc = 0.f;
#pragma unroll
      for (int k = 0; k < 32; ++k) acc += sh[32 * rg + k] * wv[k];
      sh[264 + rg * 64 + v] = acc; }
    __syncthreads();
    if (tid < 64) { float acc = 0.f;
#pragma unroll
        for (int rg = 0; rg < 8; ++rg) acc += sh[264 + rg * 64 + tid];
        ((bf16*)(ws + WS_AV))[(size_t)row * 512 + h * 64 + tid] = bf1(acc); }
    __syncthreads();
}
}
namespace mk {
constexpr size_t WS_TMP = WS_ACT;
constexpr size_t WS_MX = WS_RQ;
constexpr size_t WS_H2B = WS_MX + al((size_t)MP * 1024 * 2);
constexpr size_t WS_H2 = WS_UT;
constexpr size_t WS_SSQH2 = WS_SSQ2_, WS_SSQH3 = WS_SSQ3_;
constexpr size_t WS_H3B = WS_H;
constexpr size_t WS_END6 = WS_END4;
static_assert(WS_H2B + (size_t)MP * 1024 * 2 <= WS_SRG && WS_H2 + (size_t)MP * 1024 * 4 <= WS_RIN && (size_t)MP * 1024 * 4 <= (size_t)MP * FFN * 2, "overlays");
static_assert(WS_END6 < ((size_t)1 << 31), "32-bit workspace offsets");

template <int STEP, unsigned GATE_OFF> struct EpiGate {
    static constexpr bool PERM = false, AFTER_DRAIN = false;
    unsigned char* ws_;
    __device__ __forceinline__ void operator()(const f32x4 (&acc)[2][2][4][2], const Unit& u, int wr, int wc, int fr, int fq) const {
        int l_ = lane_fresh(); asm volatile("" : "+v"(l_)); fr = l_ & 15; fq = l_ >> 4;
        unsigned char* w = opaque_g(ws_);
        const unsigned row0 = u.pm * BM + wr * 64 + fr, col0 = u.pn * BM + wc * 32 + 4 * fq;
#pragma unroll
        for (int ai = 0; ai < 2; ++ai)
#pragma unroll
            for (int m = 0; m < 4; ++m) { unsigned row = row0 + ai * HALF + m * 16; asm volatile("" : "+v"(row));
#pragma unroll
                for (int bj = 0; bj < 2; ++bj)
#pragma unroll
                    for (int n = 0; n < 2; ++n) { const unsigned e = row * 1024 + col0 + bj * HALF + n * 16;
                        const u32x2 gw = *at<const u32x2>(w, GATE_OFF + e * 2);
                        f32x4 g; g[0] = __uint_as_float(gw.x << 16); g[1] = __uint_as_float(gw.x & 0xffff0000u); g[2] = __uint_as_float(gw.y << 16); g[3] = __uint_as_float(gw.y & 0xffff0000u);
                        f32x4 o = acc[ai][bj][m][n] * g;
                        if (STEP == 0) *at<f32x4>(w, (unsigned)WS_TMP + e * 4) = o;
                        else { o = o + *at<const f32x4>(w, (unsigned)WS_TMP + e * 4); *at<u32x2>(w, (unsigned)WS_MX + e * 2) = pack4(o); } }
                asm volatile("" ::: "memory"); }
    }
};
struct EpiSwiGLU2 {
    static constexpr bool PERM = true, AFTER_DRAIN = false;
    unsigned char* ws_;
    __device__ __forceinline__ void operator()(const f32x4 (&acc)[2][2][4][2], const Unit& u, int wr, int wc, int fr, int fq) const {
        int l_ = lane_fresh(); asm volatile("" : "+v"(l_)); fr = l_ & 15; fq = l_ >> 4;
        unsigned char* w = opaque_g(ws_);
        const unsigned row0 = u.pm * BM + wr * 64 + fr, col0 = u.pn * HALF + wc * 32 + 8 * fq;
        float rsc[8];
#pragma unroll
        for (int k = 0; k < 8; ++k) rsc[k] = row_rscale16(at<const float>(w, (unsigned)WS_SSQH2), (int)(row0 + (k >> 2) * HALF + (k & 3) * 16), 1.f / D);
#pragma unroll
        for (int ai = 0; ai < 2; ++ai)
#pragma unroll
            for (int m = 0; m < 4; ++m) { unsigned row = row0 + ai * HALF + m * 16; asm volatile("" : "+v"(row));
                const float r = rsc[ai * 4 + m];
                f32x4 o[2];
#pragma unroll
                for (int n = 0; n < 2; ++n)
#pragma unroll
                    for (int j = 0; j < 4; ++j) { const float g = acc[ai][0][m][n][j] * r, up = acc[ai][1][m][n][j] * r; o[n][j] = fast_silu(g) * up; }
                u32x4 pk; pk.x = pg8::cvt_pk_bf16(o[0][0], o[0][1]); pk.y = pg8::cvt_pk_bf16(o[0][2], o[0][3]); pk.z = pg8::cvt_pk_bf16(o[1][0], o[1][1]); pk.w = pg8::cvt_pk_bf16(o[1][2], o[1][3]);
                *at<u32x4>(w, (unsigned)WS_ACT + (row * FFN + col0) * 2) = pk;
                asm volatile("" ::: "memory"); }
    }
};
__device__ __forceinline__ void final_norm_phase(Frame& F, const Ptrs& a) {
    const int lane = fresh_tid(F.wave) & 63;
    const int gw = F.vcu * NWAVES + F.wave, NGW = F.G * NWAVES;
    const bf16* H3 = (const bf16*)(a.ws + WS_H3B); const float* SSQ = (const float*)(a.ws + WS_SSQH3);
    f32x4 g[4];
#pragma unroll
    for (int j = 0; j < 4; ++j) g[j] = *((const f32x4*)a.in(26) + 2 * lane + (j & 1) + 128 * (j >> 1));
    float* outp = a.out();
    for (int row0 = gw; row0 < ROW_PAD; row0 += 2 * NGW) {
        u32x4 v[2][2]; float r[2];
#pragma unroll
        for (int t = 0; t < 2; ++t) { const int row = row0 + t * NGW; const bool ok = row < ROW_PAD && !(row >= MMAIN && row < ROW_SMP);
            r[t] = ok ? row_rscale16(SSQ, row, 1.f / D) : 0.f;
#pragma unroll
            for (int h = 0; h < 2; ++h) v[t][h] = ok ? *((const u32x4*)(H3 + (size_t)row * D) + lane + 64 * h) : (u32x4){0u, 0u, 0u, 0u}; }
#pragma unroll
        for (int t = 0; t < 2; ++t) { const int row = row0 + t * NGW; if (row >= ROW_PAD || (row >= MMAIN && row < ROW_SMP)) continue;
            float* dst = row < MMAIN ? outp + OUT_YP + (size_t)row * D : outp + OUT_YS + (size_t)(row - ROW_SMP) * D;
#pragma unroll
            for (int h = 0; h < 2; ++h) { const u32x4 x = v[t][h];
                const f32x4 lo = (f32x4){__uint_as_float(x.x << 16), __uint_as_float(x.x & 0xffff0000u), __uint_as_float(x.y << 16), __uint_as_float(x.y & 0xffff0000u)};
                const f32x4 hi = (f32x4){__uint_as_float(x.z << 16), __uint_as_float(x.z & 0xffff0000u), __uint_as_float(x.w << 16), __uint_as_float(x.w & 0xffff0000u)};
                *((f32x4*)dst + 2 * lane + 128 * h) = lo * r[t] * g[2 * h]; *((f32x4*)dst + 2 * lane + 1 + 128 * h) = hi * r[t] * g[2 * h + 1]; } }
    }
}
}
namespace mk {
typedef float f32x4_t __attribute__((ext_vector_type(4)));
constexpr int XROW0 = MMAIN, SK_C = 64 * 64;
__device__ __forceinline__ void skinny64(int wave, int tid, const bf16* A, int K, const bf16* Bt, int brow0, LAS float* P, float (&out)[8]) {
    const int lane = tid & 63, r16 = lane & 15, kq = lane >> 4;
    const bf16* ap = A + (size_t)(XROW0 + r16) * K + 8 * kq;
    const bf16* bp = Bt + (size_t)(brow0 + r16) * K + 8 * kq;
    f32x4 acc[4][4];
#pragma unroll
    for (int mf = 0; mf < 4; ++mf)
#pragma unroll
        for (int nf = 0; nf < 4; ++nf) acc[mf][nf] = (f32x4){0.f, 0.f, 0.f, 0.f};
    const int KS = K / 32;
    bf16x8 a0[4], b0[4], a1[4], b1[4], a2[4], b2[4];
#define SK_LOAD(a_, b_, kk_) do { _Pragma("unroll") for (int f = 0; f < 4; ++f) { a_[f] = *(const bf16x8*)(ap + (size_t)(16 * f) * K + 32 * (kk_)); b_[f] = *(const bf16x8*)(bp + (size_t)(16 * f) * K + 32 * (kk_)); } } while (0)
#define SK_MMA(a_, b_) do { _Pragma("unroll") for (int mf = 0; mf < 4; ++mf) _Pragma("unroll") for (int nf = 0; nf < 4; ++nf) acc[mf][nf] = __builtin_amdgcn_mfma_f32_16x16x32_bf16(a_[mf], b_[nf], acc[mf][nf], 0, 0, 0); } while (0)
    int kk = wave;
    if (kk < KS) SK_LOAD(a0, b0, kk);
    if (kk + 8 < KS) SK_LOAD(a1, b1, kk + 8);
    if (kk + 16 < KS) SK_LOAD(a2, b2, kk + 16);
    for (; kk < KS; kk += 24) {
        SK_MMA(a0, b0); if (kk + 24 < KS) SK_LOAD(a0, b0, kk + 24);
        if (kk + 8 < KS) { SK_MMA(a1, b1); if (kk + 32 < KS) SK_LOAD(a1, b1, kk + 32); }
        if (kk + 16 < KS) { SK_MMA(a2, b2); if (kk + 40 < KS) SK_LOAD(a2, b2, kk + 40); }
    }
#undef SK_LOAD
#undef SK_MMA
    LAS float* Pw = P + wave * SK_C;
#pragma unroll
    for (int mf = 0; mf < 4; ++mf)
#pragma unroll
        for (int nf = 0; nf < 4; ++nf)
#pragma unroll
            for (int i = 0; i < 4; ++i) Pw[(16 * mf + 4 * kq + i) * 64 + 16 * nf + r16] = acc[mf][nf][i];
    __syncthreads();
    const LAS float* pr = P + (tid >> 3) * 64 + 8 * (tid & 7);
    f32x4 s0 = *(const LAS f32x4*)pr, s1 = *(const LAS f32x4*)(pr + 4);
#pragma unroll
    for (int w = 1; w < 8; ++w) { s0 = s0 + *(const LAS f32x4*)(pr + w * SK_C); s1 = s1 + *(const LAS f32x4*)(pr + w * SK_C + 4); }
    out[0] = s0[0]; out[1] = s0[1]; out[2] = s0[2]; out[3] = s0[3]; out[4] = s1[0]; out[5] = s1[1]; out[6] = s1[2]; out[7] = s1[3];
    __syncthreads();
}
__device__ __forceinline__ float sum8(float v, int lane) { v += lx(v, lane, 1); v += lx(v, lane, 2); v += lx(v, lane, 4); return v; }
__device__ __forceinline__ void st8_bf16(bf16* p, const float* v) { u32x4 w; w.x = pg8::cvt_pk_bf16(v[0], v[1]); w.y = pg8::cvt_pk_bf16(v[2], v[3]); w.z = pg8::cvt_pk_bf16(v[4], v[5]); w.w = pg8::cvt_pk_bf16(v[6], v[7]); *(u32x4*)p = w; }
__device__ __forceinline__ void ld8(const LAS float* p, float* v) { const f32x4 a = *(const LAS f32x4*)p, b = *(const LAS f32x4*)(p + 4); v[0] = a[0]; v[1] = a[1]; v[2] = a[2]; v[3] = a[3]; v[4] = b[0]; v[5] = b[1]; v[6] = b[2]; v[7] = b[3]; }
__device__ __forceinline__ void st16_wt7(void* p, u32x4 v) { asm volatile("global_store_dwordx4 %0, %1, off sc1\n\ts_nop 1" :: "v"(p), "v"(v) : "memory"); }
__device__ __forceinline__ void xjob_signal(unsigned char* ws, int tid, int cnt_idx) {
    asm volatile("s_waitcnt vmcnt(0)" ::: "memory"); __syncthreads();
    if (tid == 0) (void)__hip_atomic_fetch_add((unsigned*)(ws + WS_CTL) + CW_XCNT + cnt_idx, 1u, __ATOMIC_RELAXED, __HIP_MEMORY_SCOPE_AGENT);
}
__device__ __forceinline__ void xjob_wait(unsigned char* ws, int tid, int cnt_idx, unsigned need) {
    if (tid == 0) { const unsigned* cn = (const unsigned*)(ws + WS_CTL) + CW_XCNT + cnt_idx; unsigned spins = 0;
        while (__hip_atomic_load(cn, __ATOMIC_RELAXED, __HIP_MEMORY_SCOPE_AGENT) < need && ++spins < (1u << 22)) __builtin_amdgcn_s_sleep(8);
        __builtin_amdgcn_fence(__ATOMIC_ACQUIRE, "agent"); asm volatile("s_waitcnt vmcnt(0)" ::: "memory"); }
    __syncthreads();
}

__device__ __forceinline__ void xjob_ffn_up(Frame& F, unsigned char* ws, int j, size_t a_off, size_t w_off, int rs_mode, int cnt_idx) {
    ws = opaque_g(ws);
    const int tid = fresh_tid(F.wave);
    LAS float* P = (LAS float*)(F.lds + RING_OFF);
    const int brow0 = 256 * (j >> 1) + 64 * (j & 1);
    float g[8], u[8], o[8];
    skinny64(F.wave, tid, (const bf16*)(ws + a_off), D, (const bf16*)(ws + w_off), brow0, P, g);
    skinny64(F.wave, tid, (const bf16*)(ws + a_off), D, (const bf16*)(ws + w_off), brow0 + 128, P, u);
    const int r = tid >> 3, cg = tid & 7, row = XROW0 + r;
    const float rs = rs_mode == 0 ? ((const float*)(ws + WS_R1))[row] : row_rscale16((const float*)(ws + WS_SSQH2), row, 1.f / D);
#pragma unroll
    for (int k = 0; k < 8; ++k) o[k] = fast_silu(g[k] * rs) * (u[k] * rs);
    { u32x4 pk; pk.x = pg8::cvt_pk_bf16(o[0], o[1]); pk.y = pg8::cvt_pk_bf16(o[2], o[3]); pk.z = pg8::cvt_pk_bf16(o[4], o[5]); pk.w = pg8::cvt_pk_bf16(o[6], o[7]);
      st16_wt7((bf16*)(ws + WS_ACT) + (size_t)row * FFN + 64 * j + 8 * cg, pk); }
    xjob_signal(ws, tid, cnt_idx);
}
__device__ __forceinline__ void xjob_resid(Frame& F, unsigned char* ws, int j, size_t a_off, int K, size_t w_off, const void* res  , bool res_f32, float scale, size_t outb_off, size_t ssq_off) {
    ws = opaque_g(ws);
    const int tid = fresh_tid(F.wave), lane = tid & 63;
    LAS float* P = (LAS float*)(F.lds + RING_OFF);
    float v[8], o[8];
    skinny64(F.wave, tid, (const bf16*)(ws + a_off), K, (const bf16*)(ws + w_off), 64 * j, P, v);
    const int r = tid >> 3, cg = tid & 7, row = XROW0 + r, col = 64 * j + 8 * cg;
    float b[8];
    if (res_f32) { const float* rp = (const float*)res + (size_t)r * D + col; const f32x4 b0 = *(const f32x4*)rp, b1 = *(const f32x4*)(rp + 4); b[0] = b0[0]; b[1] = b0[1]; b[2] = b0[2]; b[3] = b0[3]; b[4] = b1[0]; b[5] = b1[1]; b[6] = b1[2]; b[7] = b1[3]; }
    else { const u32x4 rb = *(const u32x4*)((const bf16*)res + (size_t)r * D + col);
#pragma unroll
        for (int k = 0; k < 8; ++k) { const unsigned wv = rb[k >> 1]; b[k] = __uint_as_float((k & 1) ? (wv & 0xffff0000u) : (wv << 16)); } }
    float ss = 0.f;
#pragma unroll
    for (int k = 0; k < 8; ++k) { o[k] = b[k] + scale * v[k]; ss += o[k] * o[k]; }
    st8_bf16((bf16*)(ws + outb_off) + (size_t)row * D + col, o);
    ss = sum8(ss, lane);
    if (cg == 0) atomicAdd((float*)(ws + ssq_off) + row, ss);
}
__device__ __forceinline__ void xjob_win(Frame& F, unsigned char* ws, int j) {
    ws = opaque_g(ws);
    const int tid = fresh_tid(F.wave), lane = tid & 63;
    LAS float* P = (LAS float*)(F.lds + RING_OFF);
    const int pn = j >> 1, q = j & 1;
    float v0[8], v1[8];
    skinny64(F.wave, tid, (const bf16*)(ws + WS_HB), D, (const bf16*)(ws + WS_WIN), 256 * pn + 64 * q, P, v0);
    skinny64(F.wave, tid, (const bf16*)(ws + WS_HB), D, (const bf16*)(ws + WS_WIN), 256 * pn + 64 * q + 128, P, v1);
    const int r = tid >> 3, cg = tid & 7, row = XROW0 + r;
    const float rs = row_rscale16((const float*)(ws + WS_SSQH), row, 1.f / D);
    const float* TAB = (const float*)(ws + WS_TAB);
#pragma unroll
    for (int k = 0; k < 8; ++k) { v0[k] *= rs; v1[k] *= rs; }
    const int tc0 = 64 * q + 8 * cg;
    if (pn == 0) {
        bf16* CQ = (bf16*)(ws + WS_CQ) + (size_t)row * QR; float* SSQCQ = (float*)(ws + WS_SSQCQ) + (size_t)row * 8;
        st8_bf16(CQ + tc0, v0); st8_bf16(CQ + tc0 + 128, v1);
        float s0 = 0.f, s1 = 0.f;
#pragma unroll
        for (int k = 0; k < 8; ++k) { s0 += v0[k] * v0[k]; s1 += v1[k] * v1[k]; }
        s0 = sum8(s0, lane); s1 = sum8(s1, lane);
        if (cg == 0) { SSQCQ[2 * q] = s0; SSQCQ[2 * q + 1] = s1; }
    } else if (pn == 1) {
        bf16* CQ = (bf16*)(ws + WS_CQ) + (size_t)row * QR; float* SSQCQ = (float*)(ws + WS_SSQCQ) + (size_t)row * 8;
        st8_bf16(CQ + 256 + tc0, v0);
        float s0 = 0.f;
#pragma unroll
        for (int k = 0; k < 8; ++k) s0 += v0[k] * v0[k];
        s0 = sum8(s0, lane);
        if (cg == 0) { SSQCQ[4 + q] = s0; SSQCQ[6 + q] = 0.f; }
        float x2[8];
#pragma unroll
        for (int k = 0; k < 8; ++k) x2[k] = lx(v1[k], lane, 2);
        if (q == 0 && cg < 2) {
            const int pi = row_pidx(row), i0 = 8 * cg;
            float y1[8], y2[8];
#pragma unroll
            for (int k = 0; k < 8; ++k) { const float c = TAB[TAB_C16 / 4 + pi * 16 + i0 + k], s = TAB[TAB_S16 / 4 + pi * 16 + i0 + k]; y1[k] = v1[k] * c - x2[k] * s; y2[k] = v1[k] * s + x2[k] * c; }
            st8_bf16((bf16*)(ws + WS_KRB) + (size_t)row * 32 + i0, y1); st8_bf16((bf16*)(ws + WS_KRB) + (size_t)row * 32 + 16 + i0, y2);
            float* kf = (float*)(ws + WS_KRF) + (size_t)row * 32;
#pragma unroll
            for (int k = 0; k < 8; ++k) { kf[i0 + k] = y1[k]; kf[16 + i0 + k] = y2[k]; }
        }
    } else if (pn == 2) {
        float* CKVF = (float*)(ws + WS_CKVF) + (size_t)row * KVR; bf16* CKVB = (bf16*)(ws + WS_CKVB) + (size_t)row * KVR; float* SSQKV = (float*)(ws + WS_SSQKV) + (size_t)row * 4;
        float s0 = 0.f, s1 = 0.f;
#pragma unroll
        for (int k = 0; k < 8; ++k) { CKVF[tc0 + k] = v0[k]; CKVF[tc0 + 128 + k] = v1[k]; s0 += v0[k] * v0[k]; s1 += v1[k] * v1[k]; }
        st8_bf16(CKVB + tc0, v0); st8_bf16(CKVB + tc0 + 128, v1);
        s0 = sum8(s0, lane); s1 = sum8(s1, lane);
        if (cg == 0) { SSQKV[2 * q] = s0; SSQKV[2 * q + 1] = s1; }
    } else if (pn < 7) {
        const bool isk = pn >= 5; const int hh = 2 * ((pn - 3) & 1) + q, i0 = 8 * cg;
        const int pi = row_pidx(row), jt = row_jtok(row);
        const float mult = isk ? RK_SCALE * TAB[TAB_GN / 4 + hh * 128 + jt] : TAB[TAB_GP / 4 + hh * 128 + jt];
        float y1[8], y2[8];
#pragma unroll
        for (int k = 0; k < 8; ++k) { const float c = TAB[TAB_C64 / 4 + pi * 64 + i0 + k], s = TAB[TAB_S64 / 4 + pi * 64 + i0 + k]; y1[k] = (v0[k] * c - v1[k] * s) * mult; y2[k] = (v0[k] * s + v1[k] * c) * mult; }
        bf16* dst = (bf16*)(ws + (isk ? WS_RK : WS_RQ)) + (size_t)row * 512 + hh * 128;
        st8_bf16(dst + i0, y1); st8_bf16(dst + 64 + i0, y2);
        if (isk) { bf16* RKT = (bf16*)(ws + WS_RKT);
#pragma unroll
            for (int k = 0; k < 8; ++k) { RKT[(size_t)(hh * 128 + i0 + k) * MP + row] = bf1(y1[k]); RKT[(size_t)(hh * 128 + 64 + i0 + k) * MP + row] = bf1(y2[k]); } }
    } else if (pn < 11) {
        bf16* RVT = (bf16*)(ws + WS_RVT);
#pragma unroll
        for (int k = 0; k < 8; ++k) { RVT[(size_t)((pn - 7) * 256 + tc0 + k) * MP + row] = bf1(v0[k]); RVT[(size_t)((pn - 7) * 256 + tc0 + 128 + k) * MP + row] = bf1(v1[k]); }
    } else {
        const int t = (pn - 11) >> 2; bf16* dst = (bf16*)(ws + WS_SRG + (size_t)t * (WS_SGA - WS_SRG)) + (size_t)row * 1024 + ((pn - 11) & 3) * 256;
        float o0[8], o1[8];
#pragma unroll
        for (int k = 0; k < 8; ++k) { const float g0 = fast_sigmoid(v0[k]), g1 = fast_sigmoid(v1[k]); o0[k] = t == 0 ? v0[k] * g0 : g0; o1[k] = t == 0 ? v1[k] * g1 : g1; }
        st8_bf16(dst + tc0, o0); st8_bf16(dst + tc0 + 128, o1);
    }
}
__device__ __forceinline__ void xjob_q(Frame& F, unsigned char* ws, int j) {
    ws = opaque_g(ws);
    const int tid = fresh_tid(F.wave), lane = tid & 63;
    LAS float* P = (LAS float*)(F.lds + RING_OFF);
    float v[8], p[8], o[8];
    skinny64(F.wave, tid, (const bf16*)(ws + WS_CQ), QR, (const bf16*)(ws + WS_WUQ), 64 * j, P, v);
    const int r = tid >> 3, cg = tid & 7, row = XROW0 + r;
    const float rs = row_rscale8((const float*)(ws + WS_SSQCQ), row, 1.f / QR) * SC_Q;
    const float* TAB = (const float*)(ws + WS_TAB);
    const int pi = row_pidx(row), col = 64 * j + 8 * cg, grp = col >> 5, w32 = col & 31;
#pragma unroll
    for (int k = 0; k < 8; ++k) p[k] = lx(v[k], lane, 2);
    if (grp % 3 == 2) {
        const int i0 = w32 & 15;
#pragma unroll
        for (int k = 0; k < 8; ++k) { const float c = TAB[TAB_C16 / 4 + pi * 16 + i0 + k], sn = TAB[TAB_S16 / 4 + pi * 16 + i0 + k];
            o[k] = (w32 < 16 ? v[k] * c - p[k] * sn : p[k] * sn + v[k] * c) * rs; }
    } else {
#pragma unroll
        for (int k = 0; k < 8; ++k) o[k] = v[k] * rs;
    }
    st8_bf16((bf16*)(ws + WS_QA) + (size_t)row * 768 + col, o);
}
__device__ __forceinline__ void xjob_kv(Frame& F, unsigned char* ws, int j, bool is_v) {
    ws = opaque_g(ws);
    const int tid = fresh_tid(F.wave);
    LAS float* P = (LAS float*)(F.lds + RING_OFF);
    float v[8];
    skinny64(F.wave, tid, (const bf16*)(ws + WS_CKVB), KVR, (const bf16*)(ws + (is_v ? WS_WUV : WS_WUK)), 64 * j, P, v);
    const int r = tid >> 3, cg = tid & 7, row = XROW0 + r, col = 64 * j + 8 * cg;
    const float rs = row_rscale4((const float*)(ws + WS_SSQKV), row, 1.f / KVR);
#pragma unroll
    for (int k = 0; k < 8; ++k) v[k] *= rs;
    if (!is_v) st8_bf16((bf16*)(ws + WS_KN) + (size_t)row * 512 + col, v);
    else { bf16* VT = (bf16*)(ws + WS_VT);
#pragma unroll
        for (int k = 0; k < 8; ++k) VT[(size_t)(col + k) * MP + row] = bf1(v[k]); }
}
__device__ __forceinline__ void xjob_mix(Frame& F, unsigned char* ws, int j) {
    ws = opaque_g(ws);
    const int tid = fresh_tid(F.wave);
    LAS float* P = (LAS float*)(F.lds + RING_OFF);
    float a[8], b[8], o[8];
    skinny64(F.wave, tid, (const bf16*)(ws + WS_AV), 512, (const bf16*)(ws + WS_WMO), 64 * j, P, a);
    skinny64(F.wave, tid, (const bf16*)(ws + WS_RIN), D, (const bf16*)(ws + WS_WRO), 64 * j, P, b);
    const int r = tid >> 3, cg = tid & 7, row = XROW0 + r, col = 64 * j + 8 * cg;
    const u32x4 ga = *(const u32x4*)((const bf16*)(ws + WS_SGA) + (size_t)row * 1024 + col), gb = *(const u32x4*)((const bf16*)(ws + WS_SGB) + (size_t)row * 1024 + col);
#pragma unroll
    for (int k = 0; k < 8; ++k) { const unsigned wa = ga[k >> 1], wb = gb[k >> 1];
        const float fa = __uint_as_float((k & 1) ? (wa & 0xffff0000u) : (wa << 16)), fb = __uint_as_float((k & 1) ? (wb & 0xffff0000u) : (wb << 16));
        o[k] = fa * a[k] + fb * b[k]; }
    st8_bf16((bf16*)(ws + WS_MX) + (size_t)row * 1024 + col, o);
}
__device__ __forceinline__ void xjob_ql(Frame& F, unsigned char* ws, int j) {
    ws = opaque_g(ws);
    const int tid = fresh_tid(F.wave);
    LAS float* P = (LAS float*)(F.lds + RING_OFF);
    float v[8];
    skinny64(F.wave, tid, (const bf16*)(ws + WS_CQ), QR, (const bf16*)(ws + WS_WQL), 64 * j, P, v);
    const int r = tid >> 3, cg = tid & 7, row = XROW0 + r;
    const float rs = row_rscale8((const float*)(ws + WS_SSQCQ), row, 1.f / QR) * SC_Q;
    float* dst = (float*)(ws + WS_QL) + (size_t)r * 2048 + 64 * j + 8 * cg;
    *(f32x4*)dst = (f32x4){v[0] * rs, v[1] * rs, v[2] * rs, v[3] * rs}; *(f32x4*)(dst + 4) = (f32x4){v[4] * rs, v[5] * rs, v[6] * rs, v[7] * rs};
}
}
namespace mk {
constexpr int RC_STR = 272;
constexpr int RC_S = 0, RC_KT = 0  , RC_Q = 256 * RC_STR, RC_A = RC_Q + 128 * RC_STR, RC_RED = RC_A + 128 * RC_STR, RC_END = RC_RED + 2 * 8 * 128 * 4;
static_assert(RC_END <= SCR_BYTES, "chain LDS map");
__device__ __forceinline__ void ret_chain_unit(Frame& F, const Ptrs& a, int bh) {
    unsigned char* ws = a.ws; ws = opaque_g(ws);
    const int tid_k = fresh_tid(F.wave), w = F.wave;
    const int hh = bh & 3, b = bh >> 2;
    LAS unsigned char* L = F.lds + RING_OFF;
    LAS float* red = (LAS float*)(L + RC_RED);
    const bf16* RQ = (const bf16*)(ws + WS_RQ); const bf16* RK = (const bf16*)(ws + WS_RK); const bf16* RKT = (const bf16*)(ws + WS_RKT); const bf16* RVT = (const bf16*)(ws + WS_RVT);
    const float g = gpow_t(ws, hh, 1), g127 = gpow_t(ws, hh, 127);
    f32x16 S[4];
    {
        const int lane = tid_k & 63, r32 = lane & 31, half = lane >> 5;
#pragma unroll
        for (int db = 0; db < 4; ++db)
#pragma unroll
            for (int i = 0; i < 16; ++i) S[db][i] = 0.f;
        const bf16x8 af = *(const bf16x8*)(RVT + (size_t)(hh * 256 + 32 * w + r32) * MP + ROW_META + 8 * half);
#pragma unroll
        for (int db = 0; db < 4; ++db) { const bf16x8 bf = *(const bf16x8*)(RKT + (size_t)(hh * 128 + 32 * db + r32) * MP + ROW_META + 8 * half); S[db] = __builtin_amdgcn_mfma_f32_32x32x16_bf16(af, bf, S[db], 0, 0, 0); }
        const float sc = gpow_t(ws, hh, NMETA - 1);
#pragma unroll
        for (int db = 0; db < 4; ++db)
#pragma unroll
            for (int i = 0; i < 16; ++i) S[db][i] *= sc;
    }
    v4u qreg[4], jreg[4];
#define RC_FETCH_QK(tok0_) do { _Pragma("unroll") for (int k = 0; k < 4; ++k) { const int ch = tid + 512 * k; \
        qreg[k] = *(const v4u*)(RQ + (size_t)((tok0_) + (ch >> 4)) * 512 + hh * 128 + 8 * (ch & 15)); jreg[k] = *(const v4u*)(RK + (size_t)((tok0_) + (ch >> 4)) * 512 + hh * 128 + 8 * (ch & 15)); } } while (0)
    { const int tid = tid_k; RC_FETCH_QK(b * SEQ); }
#define RC_BLK_IB(n) ((n) < 1 ? 0 : (n) < 3 ? 1 : (n) < 6 ? 2 : 3)
#define RC_BLK_JB(n) ((n) - ((n) < 1 ? 0 : (n) < 3 ? 1 : (n) < 6 ? 3 : 6))
#pragma unroll 1
    for (int c = 0; c < 16; ++c) {
        const int tok0 = b * SEQ + c * 128;
        int tid_c = tid_k; asm volatile("" : "+v"(tid_c));
        const int tid = tid_c, lane = tid & 63, r32 = lane & 31, half = lane >> 5;
#pragma unroll
        for (int k = 0; k < 4; ++k) { const int ch = tid + 512 * k; *(LAS v4u*)(L + RC_Q + (ch >> 4) * RC_STR + 16 * (ch & 15)) = qreg[k]; *(LAS v4u*)(L + RC_S + (ch >> 4) * RC_STR + 16 * (ch & 15)) = jreg[k]; }
        __syncthreads();
        v4u kreg[4];
#pragma unroll
        for (int k = 0; k < 4; ++k) { const int ch = tid + 512 * k; kreg[k] = *(const v4u*)(RKT + (size_t)(hh * 128 + (ch >> 4)) * MP + tok0 + 8 * (ch & 15)); }
        for (int n = w; n < 10; n += 8) {
            const int ib_ = RC_BLK_IB(n), jb_ = RC_BLK_JB(n);
            f32x16 at;
#pragma unroll
            for (int i = 0; i < 16; ++i) at[i] = 0.f;
#pragma unroll
            for (int s = 0; s < 8; ++s) { const bf16x8 kf = *(const LAS bf16x8*)(L + RC_S + (32 * jb_ + r32) * RC_STR + (16 * s + 8 * half) * 2); const bf16x8 qf = *(const LAS bf16x8*)(L + RC_Q + (32 * ib_ + r32) * RC_STR + (16 * s + 8 * half) * 2); at = __builtin_amdgcn_mfma_f32_32x32x16_bf16(kf, qf, at, 0, 0, 0); }
            if (jb_ == ib_) {
#pragma unroll
                for (int i = 0; i < 16; ++i) if (crow(i, half) > r32) at[i] = 0.f; }
#pragma unroll
            for (int gq = 0; gq < 4; ++gq) { f32x4 o_; o_[0] = at[4 * gq]; o_[1] = at[4 * gq + 1]; o_[2] = at[4 * gq + 2]; o_[3] = at[4 * gq + 3];
                *(LAS u32x2*)(L + RC_A + (32 * ib_ + r32) * RC_STR + (32 * jb_ + 8 * gq + 4 * half) * 2) = pack4(o_); }
        }
        __syncthreads();
#pragma unroll
        for (int db = 0; db < 4; ++db)
#pragma unroll
            for (int i = 0; i < 16; ++i) *(LAS bf16*)(L + RC_S + (32 * w + crow(i, half)) * RC_STR + (32 * db + r32) * 2) = bf1(S[db][i]);
        f32x16 ot[4];
#pragma unroll
        for (int ib = 0; ib < 4; ++ib)
#pragma unroll
            for (int i = 0; i < 16; ++i) ot[ib][i] = 0.f;
#pragma unroll 2
        for (int s = 0; s < 8; ++s) {
            const bf16x8 sf = *(const LAS bf16x8*)(L + RC_S + (32 * w + r32) * RC_STR + (16 * s + 8 * half) * 2);
#pragma unroll
            for (int ib = 0; ib < 4; ++ib) { const bf16x8 qf = *(const LAS bf16x8*)(L + RC_Q + (32 * ib + r32) * RC_STR + (16 * s + 8 * half) * 2); ot[ib] = __builtin_amdgcn_mfma_f32_32x32x16_bf16(sf, qf, ot[ib], 0, 0, 0); }
        }
#pragma unroll
        for (int ib = 0; ib < 4; ++ib)
#pragma unroll
            for (int i = 0; i < 16; ++i) ot[ib][i] *= g;
        __syncthreads();
#pragma unroll
        for (int k = 0; k < 4; ++k) { const int ch = tid + 512 * k; *(LAS v4u*)(L + RC_KT + (ch >> 4) * RC_STR + 16 * (ch & 15)) = kreg[k]; }
        __syncthreads();
        if (c < 15) RC_FETCH_QK(tok0 + 128);
#pragma unroll
        for (int db = 0; db < 4; ++db)
#pragma unroll
            for (int i = 0; i < 16; ++i) S[db][i] *= g;
        {
            const bf16* vp = RVT + (size_t)(hh * 256 + 32 * w + r32) * MP + tok0 + 8 * half;
            bf16x8 v0 = *(const bf16x8*)(vp), v1 = *(const bf16x8*)(vp + 16), v2 = v1;
#pragma unroll 1
            for (int s = 0; s < 8; ++s) {
                if (s + 2 < 8) v2 = *(const bf16x8*)(vp + 16 * (s + 2));
#pragma unroll
                for (int ib = 0; ib < 4; ++ib) if (s < 2 * (ib + 1)) { const bf16x8 af = *(const LAS bf16x8*)(L + RC_A + (32 * ib + r32) * RC_STR + (16 * s + 8 * half) * 2); ot[ib] = __builtin_amdgcn_mfma_f32_32x32x16_bf16(v0, af, ot[ib], 0, 0, 0); }
#pragma unroll
                for (int db = 0; db < 4; ++db) { const bf16x8 kf = *(const LAS bf16x8*)(L + RC_KT + (32 * db + r32) * RC_STR + (16 * s + 8 * half) * 2); S[db] = __builtin_amdgcn_mfma_f32_32x32x16_bf16(v0, kf, S[db], 0, 0, 0); }
                v0 = v1; v1 = v2;
            }
        }
#pragma unroll
        for (int db = 0; db < 4; ++db)
#pragma unroll
            for (int i = 0; i < 16; ++i) S[db][i] *= g127;
#pragma unroll
        for (int ib = 0; ib < 4; ++ib) { float t = 0.f;
#pragma unroll
            for (int i = 0; i < 16; ++i) t += ot[ib][i];
            t += lx(t, lane, 32); if (half == 0) red[w * 128 + 32 * ib + r32] = t; }
        __syncthreads();
        float mu[4];
#pragma unroll
        for (int ib = 0; ib < 4; ++ib) { float t = 0.f;
#pragma unroll
            for (int ww = 0; ww < 8; ++ww) t += red[ww * 128 + 32 * ib + r32];
            mu[ib] = t * (1.f / 256.f); }
#pragma unroll
        for (int ib = 0; ib < 4; ++ib) { float t = 0.f;
#pragma unroll
            for (int i = 0; i < 16; ++i) { ot[ib][i] -= mu[ib]; t += ot[ib][i] * ot[ib][i]; }
            t += lx(t, lane, 32); if (half == 0) red[1024 + w * 128 + 32 * ib + r32] = t; }
        __syncthreads();
#pragma unroll
        for (int ib = 0; ib < 4; ++ib) { float t = 0.f;
#pragma unroll
            for (int ww = 0; ww < 8; ++ww) t += red[1024 + ww * 128 + 32 * ib + r32];
            const float rstd = 1.0f / sqrtf(t * (1.f / 256.f) + EPS);
            const int irow = tok0 + 32 * ib + r32;
            const bf16* SRG = (const bf16*)(ws + WS_SRG) + (size_t)irow * 1024 + hh * 256 + 32 * w + 4 * half;
            bf16* RIN = (bf16*)(ws + WS_RIN) + (size_t)irow * 1024 + hh * 256 + 32 * w + 4 * half;
            const float* gn = a.in(19) + hh * 256 + 32 * w + 4 * half;
#pragma unroll
            for (int gq = 0; gq < 4; ++gq) {
                const u32x2 sg = *(const u32x2*)(SRG + 8 * gq); const f32x4 gv = *(const f32x4*)(gn + 8 * gq);
                f32x4 o;
                o[0] = ot[ib][4 * gq + 0] * rstd * gv[0] * __uint_as_float(sg.x << 16); o[1] = ot[ib][4 * gq + 1] * rstd * gv[1] * __uint_as_float(sg.x & 0xffff0000u);
                o[2] = ot[ib][4 * gq + 2] * rstd * gv[2] * __uint_as_float(sg.y << 16); o[3] = ot[ib][4 * gq + 3] * rstd * gv[3] * __uint_as_float(sg.y & 0xffff0000u);
                *(u32x2*)(RIN + 8 * gq) = pack4(o);
            } }
        __syncthreads();
    }
#undef RC_FETCH_QK
#undef RC_BLK_IB
#undef RC_BLK_JB
    const int lane = tid_k & 63, r32 = lane & 31, half = lane >> 5;
#pragma unroll
    for (int db = 0; db < 4; ++db)
#pragma unroll
        for (int i = 0; i < 16; ++i) a.out()[OUT_SRP + ((size_t)bh * RDK + 32 * db + r32) * RDV + 32 * w + crow(i, half)] = S[db][i];
}
}
namespace mk {
constexpr int CW_FLAG = 8192;
__device__ __forceinline__ void st16_wt(void* p, v4u v) { asm volatile("global_store_dwordx4 %0, %1, off sc1\n\ts_nop 1" :: "v"(p), "v"(v) : "memory"); }
__device__ __forceinline__ void ret_state_unit(Frame& F, const Ptrs& a, int bh) {
    unsigned char* ws = opaque_g(a.ws);
    const int tid_k = fresh_tid(F.wave), w = F.wave;
    const int hh = bh & 3, b = bh >> 2;
    LAS unsigned char* L = F.lds + RING_OFF;
    const bf16* RKT = (const bf16*)(ws + WS_RKT); const bf16* RVT = (const bf16*)(ws + WS_RVT);
    const float g = gpow_t(ws, hh, 1), g127 = gpow_t(ws, hh, 127);
    f32x16 S[4];
    bf16x8 vf[8]; v4u kreg[4];
#define RS_FETCH(tok0_) do { _Pragma("unroll") for (int s = 0; s < 8; ++s) vf[s] = *(const bf16x8*)(RVT + (size_t)(hh * 256 + 32 * w + r32) * MP + (tok0_) + 16 * s + 8 * half); \
        _Pragma("unroll") for (int k = 0; k < 4; ++k) { const int ch = tid + 512 * k; kreg[k] = *(const v4u*)(RKT + (size_t)(hh * 128 + (ch >> 4)) * MP + (tok0_) + 8 * (ch & 15)); } } while (0)
    {   const int tid = tid_k, lane = tid & 63, r32 = lane & 31, half = lane >> 5;
#pragma unroll
        for (int db = 0; db < 4; ++db)
#pragma unroll
            for (int i = 0; i < 16; ++i) S[db][i] = 0.f;
        const bf16x8 af = *(const bf16x8*)(RVT + (size_t)(hh * 256 + 32 * w + r32) * MP + ROW_META + 8 * half);
#pragma unroll
        for (int db = 0; db < 4; ++db) { const bf16x8 bf = *(const bf16x8*)(RKT + (size_t)(hh * 128 + 32 * db + r32) * MP + ROW_META + 8 * half); S[db] = __builtin_amdgcn_mfma_f32_32x32x16_bf16(af, bf, S[db], 0, 0, 0); }
        const float sc = gpow_t(ws, hh, NMETA - 1);
#pragma unroll
        for (int db = 0; db < 4; ++db)
#pragma unroll
            for (int i = 0; i < 16; ++i) S[db][i] *= sc;
        RS_FETCH(b * SEQ);
    }
#pragma unroll 1
    for (int c = 0; c < 16; ++c) {
        const int tok0 = b * SEQ + c * 128, u = bh * 16 + c;
        int tid_c = tid_k; asm volatile("" : "+v"(tid_c));
        const int tid = tid_c, lane = tid & 63, r32 = lane & 31, half = lane >> 5;
#pragma unroll
        for (int k = 0; k < 4; ++k) { const int ch = tid + 512 * k; *(LAS v4u*)(L + RC_Q + (ch >> 4) * RC_STR + 16 * (ch & 15)) = kreg[k]; }
#pragma unroll
        for (int db = 0; db < 4; ++db)
#pragma unroll
            for (int i = 0; i < 16; ++i) *(LAS bf16*)(L + (32 * w + crow(i, half)) * RC_STR + (32 * db + r32) * 2) = bf1(S[db][i]);
        __syncthreads();
        { bf16* SP = (bf16*)(ws + WS_SPREV) + (size_t)u * 32768;
#pragma unroll
          for (int k = 0; k < 8; ++k) { const int ch = lane + 64 * k, row = 32 * w + (ch >> 4); st16_wt(SP + (size_t)row * 128 + 8 * (ch & 15), *(const LAS v4u*)(L + row * RC_STR + 16 * (ch & 15))); } }
        bf16x8 vfn[8]; v4u kregn[4];
        if (c < 15) {
#pragma unroll
            for (int s = 0; s < 8; ++s) vfn[s] = *(const bf16x8*)(RVT + (size_t)(hh * 256 + 32 * w + r32) * MP + tok0 + 128 + 16 * s + 8 * half);
#pragma unroll
            for (int k = 0; k < 4; ++k) { const int ch = tid + 512 * k; kregn[k] = *(const v4u*)(RKT + (size_t)(hh * 128 + (ch >> 4)) * MP + tok0 + 128 + 8 * (ch & 15)); }
        } else {
#pragma unroll
            for (int s = 0; s < 8; ++s) vfn[s] = vf[s];
#pragma unroll
            for (int k = 0; k < 4; ++k) kregn[k] = kreg[k];
        }
#pragma unroll
        for (int db = 0; db < 4; ++db) {
#pragma unroll
            for (int i = 0; i < 16; ++i) S[db][i] *= g;
#pragma unroll
            for (int s = 0; s < 8; ++s) { const bf16x8 kf = *(const LAS bf16x8*)(L + RC_Q + (32 * db + r32) * RC_STR + (16 * s + 8 * half) * 2); S[db] = __builtin_amdgcn_mfma_f32_32x32x16_bf16(vf[s], kf, S[db], 0, 0, 0); }
#pragma unroll
            for (int i = 0; i < 16; ++i) S[db][i] *= g127;
        }
        asm volatile("s_waitcnt vmcnt(0)" ::: "memory");
#pragma unroll
        for (int s = 0; s < 8; ++s) vf[s] = vfn[s];
#pragma unroll
        for (int k = 0; k < 4; ++k) kreg[k] = kregn[k];
        __syncthreads();
        if (tid == 0) __hip_atomic_store((unsigned*)(ws + WS_CTL) + CW_FLAG + 16 * u, 1u, __ATOMIC_RELAXED, __HIP_MEMORY_SCOPE_AGENT);
    }
#undef RS_FETCH
    {   const int lane = tid_k & 63, r32 = lane & 31, half = lane >> 5;
#pragma unroll
        for (int db = 0; db < 4; ++db)
#pragma unroll
            for (int i = 0; i < 16; ++i) a.out()[OUT_SRP + ((size_t)bh * RDK + 32 * db + r32) * RDV + 32 * w + crow(i, half)] = S[db][i]; }
    __syncthreads();
}
__device__ __forceinline__ void ret_out_unit(Frame& F, const Ptrs& a, int u) {
    unsigned char* ws = opaque_g(a.ws);
    const int tid = fresh_tid(F.wave), lane = tid & 63, w = F.wave, r32 = lane & 31, half = lane >> 5;
    const int bh = u >> 4, c = u & 15, hh = bh & 3, tok0 = (bh >> 2) * SEQ + c * 128;
    LAS unsigned char* L = F.lds + RING_OFF;
    LAS float* red = (LAS float*)(L + RC_RED);
    const bf16* RQ = (const bf16*)(ws + WS_RQ); const bf16* RK = (const bf16*)(ws + WS_RK); const bf16* RVT = (const bf16*)(ws + WS_RVT);
    if (tid == 0) { const unsigned* fl = (const unsigned*)(ws + WS_CTL) + CW_FLAG + 16 * u; unsigned spins = 0;
        while (__hip_atomic_load(fl, __ATOMIC_RELAXED, __HIP_MEMORY_SCOPE_AGENT) == 0u && ++spins < (1u << 22)) __builtin_amdgcn_s_sleep(8);
        __builtin_amdgcn_fence(__ATOMIC_ACQUIRE, "agent"); asm volatile("s_waitcnt vmcnt(0)" ::: "memory"); }
    __syncthreads();
    v4u qreg[4], jreg[4], sreg[8]; bf16x8 vf[8];
#pragma unroll
    for (int k = 0; k < 4; ++k) { const int ch = tid + 512 * k; qreg[k] = *(const v4u*)(RQ + (size_t)(tok0 + (ch >> 4)) * 512 + hh * 128 + 8 * (ch & 15)); jreg[k] = *(const v4u*)(RK + (size_t)(tok0 + (ch >> 4)) * 512 + hh * 128 + 8 * (ch & 15)); }
    { const bf16* SP = (const bf16*)(ws + WS_SPREV) + (size_t)u * 32768;
#pragma unroll
      for (int k = 0; k < 8; ++k) { const int ch = tid + 512 * k; sreg[k] = *(const v4u*)(SP + (size_t)(ch >> 4) * 128 + 8 * (ch & 15)); } }
#pragma unroll
    for (int s = 0; s < 8; ++s) vf[s] = *(const bf16x8*)(RVT + (size_t)(hh * 256 + 32 * w + r32) * MP + tok0 + 16 * s + 8 * half);
    __builtin_amdgcn_sched_barrier(0);
#pragma unroll
    for (int k = 0; k < 4; ++k) { const int ch = tid + 512 * k; *(LAS v4u*)(L + RC_Q + (ch >> 4) * RC_STR + 16 * (ch & 15)) = qreg[k]; *(LAS v4u*)(L + RC_S + (ch >> 4) * RC_STR + 16 * (ch & 15)) = jreg[k]; }
    __syncthreads();
#define RC_BLK_IB(n) ((n) < 1 ? 0 : (n) < 3 ? 1 : (n) < 6 ? 2 : 3)
#define RC_BLK_JB(n) ((n) - ((n) < 1 ? 0 : (n) < 3 ? 1 : (n) < 6 ? 3 : 6))
    for (int n = w; n < 10; n += 8) {
        const int ib_ = RC_BLK_IB(n), jb_ = RC_BLK_JB(n);
        f32x16 at;
#pragma unroll
        for (int i = 0; i < 16; ++i) at[i] = 0.f;
#pragma unroll
        for (int s = 0; s < 8; ++s) { const bf16x8 kf = *(const LAS bf16x8*)(L + RC_S + (32 * jb_ + r32) * RC_STR + (16 * s + 8 * half) * 2); const bf16x8 qf = *(const LAS bf16x8*)(L + RC_Q + (32 * ib_ + r32) * RC_STR + (16 * s + 8 * half) * 2); at = __builtin_amdgcn_mfma_f32_32x32x16_bf16(kf, qf, at, 0, 0, 0); }
        if (jb_ == ib_) {
#pragma unroll
            for (int i = 0; i < 16; ++i) if (crow(i, half) > r32) at[i] = 0.f; }
#pragma unroll
        for (int gq = 0; gq < 4; ++gq) { f32x4 o_; o_[0] = at[4 * gq]; o_[1] = at[4 * gq + 1]; o_[2] = at[4 * gq + 2]; o_[3] = at[4 * gq + 3];
            *(LAS u32x2*)(L + RC_A + (32 * ib_ + r32) * RC_STR + (32 * jb_ + 8 * gq + 4 * half) * 2) = pack4(o_); }
    }
#undef RC_BLK_IB
#undef RC_BLK_JB
    __syncthreads();
#pragma unroll
    for (int k = 0; k < 8; ++k) { const int ch = tid + 512 * k; *(LAS v4u*)(L + RC_S + (ch >> 4) * RC_STR + 16 * (ch & 15)) = sreg[k]; }
    __syncthreads();
    const float g = gpow_t(ws, hh, 1);
    f32x16 ot[4];
#pragma unroll
    for (int ib = 0; ib < 4; ++ib)
#pragma unroll
        for (int i = 0; i < 16; ++i) ot[ib][i] = 0.f;
#pragma unroll 2
    for (int s = 0; s < 8; ++s) {
        const bf16x8 sf = *(const LAS bf16x8*)(L + RC_S + (32 * w + r32) * RC_STR + (16 * s + 8 * half) * 2);
#pragma unroll
        for (int ib = 0; ib < 4; ++ib) { const bf16x8 qf = *(const LAS bf16x8*)(L + RC_Q + (32 * ib + r32) * RC_STR + (16 * s + 8 * half) * 2); ot[ib] = __builtin_amdgcn_mfma_f32_32x32x16_bf16(sf, qf, ot[ib], 0, 0, 0); }
    }
#pragma unroll
    for (int ib = 0; ib < 4; ++ib)
#pragma unroll
        for (int i = 0; i < 16; ++i) ot[ib][i] *= g;
    u32x2 sgr[4][4];
#pragma unroll
    for (int ib = 0; ib < 4; ++ib)
#pragma unroll
        for (int gq = 0; gq < 4; ++gq) sgr[ib][gq] = *(const u32x2*)((const bf16*)(ws + WS_SRG) + (size_t)(tok0 + 32 * ib + r32) * 1024 + hh * 256 + 32 * w + 4 * half + 8 * gq);
#pragma unroll
    for (int ib = 0; ib < 4; ++ib)
#pragma unroll
        for (int s = 0; s < 2 * (ib + 1); ++s) { const bf16x8 af = *(const LAS bf16x8*)(L + RC_A + (32 * ib + r32) * RC_STR + (16 * s + 8 * half) * 2); ot[ib] = __builtin_amdgcn_mfma_f32_32x32x16_bf16(vf[s], af, ot[ib], 0, 0, 0); }
#pragma unroll
    for (int ib = 0; ib < 4; ++ib) { float t = 0.f;
#pragma unroll
        for (int i = 0; i < 16; ++i) t += ot[ib][i];
        t += lx(t, lane, 32); if (half == 0) red[w * 128 + 32 * ib + r32] = t; }
    __syncthreads();
    float mu[4];
#pragma unroll
    for (int ib = 0; ib < 4; ++ib) { float t = 0.f;
#pragma unroll
        for (int ww = 0; ww < 8; ++ww) t += red[ww * 128 + 32 * ib + r32];
        mu[ib] = t * (1.f / 256.f); }
#pragma unroll
    for (int ib = 0; ib < 4; ++ib) { float t = 0.f;
#pragma unroll
        for (int i = 0; i < 16; ++i) { ot[ib][i] -= mu[ib]; t += ot[ib][i] * ot[ib][i]; }
        t += lx(t, lane, 32); if (half == 0) red[1024 + w * 128 + 32 * ib + r32] = t; }
    __syncthreads();
#pragma unroll
    for (int ib = 0; ib < 4; ++ib) { float t = 0.f;
#pragma unroll
        for (int ww = 0; ww < 8; ++ww) t += red[1024 + ww * 128 + 32 * ib + r32];
        const float rstd = 1.0f / sqrtf(t * (1.f / 256.f) + EPS);
        const int irow = tok0 + 32 * ib + r32;
        bf16* RIN = (bf16*)(ws + WS_RIN) + (size_t)irow * 1024 + hh * 256 + 32 * w + 4 * half;
        const float* gn = a.in(19) + hh * 256 + 32 * w + 4 * half;
#pragma unroll
        for (int gq = 0; gq < 4; ++gq) {
            const u32x2 sg = sgr[ib][gq]; const f32x4 gv = *(const f32x4*)(gn + 8 * gq);
            f32x4 o;
            o[0] = ot[ib][4 * gq + 0] * rstd * gv[0] * __uint_as_float(sg.x << 16); o[1] = ot[ib][4 * gq + 1] * rstd * gv[1] * __uint_as_float(sg.x & 0xffff0000u);
            o[2] = ot[ib][4 * gq + 2] * rstd * gv[2] * __uint_as_float(sg.y << 16); o[3] = ot[ib][4 * gq + 3] * rstd * gv[3] * __uint_as_float(sg.y & 0xffff0000u);
            *(u32x2*)(RIN + 8 * gq) = pack4(o);
        } }
    __syncthreads();
}
}
namespace mk {
__global__ void __launch_bounds__(NWAVES * 64, 2) mega_fwd(Args args) {
    extern __shared__ __attribute__((aligned(16))) unsigned char lds[];
    Frame F;
    F.lds = (LAS unsigned char*)lds;
    F.MISC = (volatile LAS unsigned*)(F.lds + MISC_OFF);
    F.wave = __builtin_amdgcn_readfirstlane((int)threadIdx.x >> 6);
    F.G = gridDim.x; { const int bx = blockIdx.x; F.vcu = (F.G % 8 == 0) ? (bx % 8) * (F.G / 8) + bx / 8 : bx; }
    unsigned char* const ws_k = args.ws;
    unsigned char* ws = ws_k;
    for (int u = threadIdx.x; u < (LDS_BYTES - LDSCTL_OFF) / 4; u += NWAVES * 64) ((LAS unsigned*)(F.lds + LDSCTL_OFF))[u] = 0u;
    __syncthreads();
    {
        volatile LAS unsigned long long* pt = (volatile LAS unsigned long long*)(F.lds + PT_OFF);
        if (threadIdx.x == 0) {
#define PT_PUT(i) pt[i] = (unsigned long long)args.in[i]
            PT_PUT(0); PT_PUT(1); PT_PUT(2); PT_PUT(3); PT_PUT(4); PT_PUT(5); PT_PUT(6); PT_PUT(7); PT_PUT(8); PT_PUT(9); PT_PUT(10); PT_PUT(11); PT_PUT(12); PT_PUT(13);
            PT_PUT(14); PT_PUT(15); PT_PUT(16); PT_PUT(17); PT_PUT(18); PT_PUT(19); PT_PUT(20); PT_PUT(21); PT_PUT(22); PT_PUT(23); PT_PUT(24); PT_PUT(25); PT_PUT(26);
#undef PT_PUT
            pt[27] = (unsigned long long)args.out;
        }
        __syncthreads();
    }
    const Ptrs P{ws_k, (volatile LAS unsigned*)(F.lds + PT_OFF)};
    (void)xcd_barrier_post((unsigned*)(ws_k + WS_CTL) + CW_BAR, F.MISC + 8, F.wave);
#if MK_PROBE
#define STAMP(k) do { if (blockIdx.x == 0 && F.wave == 0 && lane_fresh() == 0) ((unsigned long long*)(ws_k + WS_CTL + 512 * 1024))[k] = __builtin_amdgcn_s_memrealtime(); } while (0)
    STAMP(0);
#else
#define STAMP(k) do { } while (0)
#endif
#define WS_FRESH() unsigned char* ws = opaque_g(ws_k)
#define GRID_BAR() do { XcdBarrier b_; b_.bar = (unsigned*)(ws_k + WS_CTL) + CW_BAR; b_.x = xb_xcc_id(); b_.st = F.MISC + 8; b_.wave = F.wave; xcd_barrier(b_); } while (0)

    p0_prologue(F, args);
    GRID_BAR(); STAMP(1);
    {
        WS_FRESH();
        { const int bx = (int)blockIdx.x; if (bx >= 128 && bx < 172) xjob_ffn_up(F, ws, bx - 128, WS_XB, WS_W1T, 0, 0); }
        p0_weights_late(F, args);
        pg8::Gemm g{(const pg8::bf16_t*)(ws + WS_XB), (const pg8::bf16_t*)(ws + WS_W1T), MMAIN, 2 * FFN, D};
        pg8::StaticOrder S; S.init(MMAIN, 2 * FFN, F.G, (int)blockIdx.x);
        EpiSwiGLU E{(bf16*)(ws + WS_ACT), (const float*)(ws + WS_R1)};
        pg8::gemm_phase<EpiSwiGLU, pg8::StaticOrder, true, true>(F.lds + RING_OFF, g, S, E, F.wave);
        { const int bx = (int)blockIdx.x; if (bx >= 172 && bx < 188) { xjob_wait(ws, fresh_tid(F.wave), 0, 44u); xjob_resid(F, ws, bx - 172, WS_ACT, FFN, WS_W1D, ws + WS_XE, true, 0.5f, WS_HB, WS_SSQH); } }
    }
    GRID_BAR(); STAMP(2);
    {
        WS_FRESH();
        pg8::Gemm g{(const pg8::bf16_t*)(ws + WS_ACT), (const pg8::bf16_t*)(ws + WS_W1D), MMAIN, D, FFN};
        pg8::StaticOrder S; S.init(MMAIN, D, F.G, (int)blockIdx.x);
        typedef EpiResid<(unsigned)WS_XE, true, (unsigned)WS_HB, (unsigned)WS_SSQH, 1> EpiDown1;
        EpiDown1 E{ws, P.in(0)};
        pg8::gemm_phase<EpiDown1, pg8::StaticOrder, true, true>(F.lds + RING_OFF, g, S, E, F.wave);
    }
    GRID_BAR(); STAMP(3);
#ifndef NO_P3
    {
        WS_FRESH();
        { const int bx = (int)blockIdx.x; if (bx >= 192 && bx < 238) xjob_win(F, ws, bx - 192); }
        pg8::Gemm g{(const pg8::bf16_t*)(ws + WS_HB), (const pg8::bf16_t*)(ws + WS_WIN), MMAIN, NWIN, D};
        pg8::StaticOrder S; S.init(MMAIN, NWIN, F.G, (int)blockIdx.x);
        EpiWin E{ws, F.lds};
        pg8::gemm_phase<EpiWin, pg8::StaticOrder, true, true>(F.lds + RING_OFF, g, S, E, F.wave);
    }
#endif
    GRID_BAR(); STAMP(4);
    {
        WS_FRESH();
        { const int jb = (int)blockIdx.x - 192; if (jb >= 0 && jb < 12) xjob_q(F, ws, jb); else if (jb >= 12 && jb < 20) xjob_kv(F, ws, jb - 12, false); else if (jb >= 20 && jb < 28) xjob_kv(F, ws, jb - 20, true); else if (jb >= 28 && jb < 60) xjob_ql(F, ws, jb - 28); }
        finalize_ckv(F, P);
#ifndef NO_P4Q
        {   pg8::Gemm g{(const pg8::bf16_t*)(ws + WS_CQ), (const pg8::bf16_t*)(ws + WS_WUQ), MMAIN, 768, QR};
            pg8::StaticOrder S; S.init(MMAIN, 768, F.G, (int)blockIdx.x);
            EpiQ E{ws};
            pg8::gemm_phase<EpiQ, pg8::StaticOrder, true, true>(F.lds + RING_OFF, g, S, E, F.wave); }
#endif
#ifndef NO_P4K
        {   pg8::Gemm g{(const pg8::bf16_t*)(ws + WS_CKVB), (const pg8::bf16_t*)(ws + WS_WUK), MMAIN, 512, KVR};
            pg8::StaticOrder S; S.init(MMAIN, 512, F.G, (int)((blockIdx.x + 64) % F.G));
            EpiScaleBf16<true> E{(const float*)(ws + WS_SSQKV), (bf16*)(ws + WS_KN), 512};
            pg8::gemm_phase<EpiScaleBf16<true>, pg8::StaticOrder, true, true>(F.lds + RING_OFF, g, S, E, F.wave); }
#endif
#ifndef NO_P4V
        {   pg8::Gemm g{(const pg8::bf16_t*)(ws + WS_WUV), (const pg8::bf16_t*)(ws + WS_CKVB), 512, MMAIN, KVR};
            pg8::StaticOrder S; S.init(512, MMAIN, F.G, (int)((blockIdx.x + 192) % F.G));
            EpiScaleBf16<false> E{(const float*)(ws + WS_SSQKV), (bf16*)(ws + WS_VT), MP};
            pg8::gemm_phase<EpiScaleBf16<false>, pg8::StaticOrder, true, true>(F.lds + RING_OFF, g, S, E, F.wave); }
#endif
    }
    GRID_BAR(); STAMP(5);
    STAMP(32);
#define QUEUE_LOOP(qi, nitems, call) for (;;) { \
        if (F.wave == 0 && lane_fresh() == 0) F.MISC[16] = __hip_atomic_fetch_add((unsigned*)(ws_k + WS_CTL) + CW_QUEUE + 64 * (qi), 1u, __ATOMIC_RELAXED, __HIP_MEMORY_SCOPE_AGENT); \
        __syncthreads(); const int it = (int)F.MISC[16]; __syncthreads(); \
        if (it >= (nitems)) break; call; }
    if ((int)blockIdx.x < 32) ret_state_unit(F, P, (int)blockIdx.x);
    STAMP(33);
    if (((int)blockIdx.x & 1) == 0) { QUEUE_LOOP(0, 512, attn_item(F, ws_k, it)) }
    STAMP(34);
    QUEUE_LOOP(1, 512, decode_unit(F, P, it))
    STAMP(35);
    QUEUE_LOOP(2, 128, ret_sample_unit(F, P, it))
    STAMP(36);
    if (((int)blockIdx.x & 1) != 0) { QUEUE_LOOP(0, 512, attn_item(F, ws_k, it)) }
    QUEUE_LOOP(3, 512, ret_out_unit(F, P, ((it & 31) << 4) | (it >> 5)))
    STAMP(37);
    QUEUE_LOOP(4, 256, decode_combine_unit(F, P, it))
#undef QUEUE_LOOP
    GRID_BAR(); STAMP(6);
    {
        WS_FRESH();
        { const int bx = (int)blockIdx.x; if (bx < 16) xjob_mix(F, ws, bx); }
        {   pg8::Gemm g{(const pg8::bf16_t*)(ws + WS_AV), (const pg8::bf16_t*)(ws + WS_WMO), MMAIN, D, 512};
            pg8::StaticOrder S; S.init(MMAIN, D, F.G, (int)blockIdx.x);
            typedef EpiGate<0, (unsigned)WS_SGA> EpiGA; EpiGA E{ws};
            pg8::gemm_phase<EpiGA, pg8::StaticOrder, true, true>(F.lds + RING_OFF, g, S, E, F.wave); }
        {   pg8::Gemm g{(const pg8::bf16_t*)(ws + WS_RIN), (const pg8::bf16_t*)(ws + WS_WRO), MMAIN, D, D};
            pg8::StaticOrder S; S.init(MMAIN, D, F.G, (int)blockIdx.x);
            typedef EpiGate<1, (unsigned)WS_SGB> EpiGB; EpiGB E{ws};
            pg8::gemm_phase<EpiGB, pg8::StaticOrder, true, true>(F.lds + RING_OFF, g, S, E, F.wave); }
    }
    GRID_BAR(); STAMP(7);
    {
        WS_FRESH();
        { const int bx = (int)blockIdx.x; if (bx >= 16 && bx < 32) xjob_resid(F, ws, bx - 16, WS_MX, D, WS_WOUT, (const bf16*)(ws + WS_HB) + (size_t)XROW0 * D, false, 1.0f, WS_H2B, WS_SSQH2); }
        pg8::Gemm g{(const pg8::bf16_t*)(ws + WS_MX), (const pg8::bf16_t*)(ws + WS_WOUT), MMAIN, D, D};
        pg8::StaticOrder S; S.init(MMAIN, D, F.G, (int)blockIdx.x);
        typedef EpiResid<(unsigned)WS_HB, false, (unsigned)WS_H2B, (unsigned)WS_SSQH2, 2> EpiOut;
        EpiOut E{ws, nullptr};
        pg8::gemm_phase<EpiOut, pg8::StaticOrder, true, true>(F.lds + RING_OFF, g, S, E, F.wave);
    }
    GRID_BAR(); STAMP(8);
    {
        WS_FRESH();
        { const int bx = (int)blockIdx.x; if (bx >= 128 && bx < 172) xjob_ffn_up(F, ws, bx - 128, WS_H2B, WS_W2T, 1, 16); }
        pg8::Gemm g{(const pg8::bf16_t*)(ws + WS_H2B), (const pg8::bf16_t*)(ws + WS_W2T), MMAIN, 2 * FFN, D};
        pg8::StaticOrder S; S.init(MMAIN, 2 * FFN, F.G, (int)blockIdx.x);
        EpiSwiGLU2 E{ws};
        pg8::gemm_phase<EpiSwiGLU2, pg8::StaticOrder, true, true>(F.lds + RING_OFF, g, S, E, F.wave);
        { const int bx = (int)blockIdx.x; if (bx >= 172 && bx < 188) { xjob_wait(ws, fresh_tid(F.wave), 16, 44u); xjob_resid(F, ws, bx - 172, WS_ACT, FFN, WS_W2D, (const bf16*)(ws + WS_H2B) + (size_t)XROW0 * D, false, 0.5f, WS_H3B, WS_SSQH3); } }
    }
    GRID_BAR(); STAMP(9);
    {
        WS_FRESH();
        pg8::Gemm g{(const pg8::bf16_t*)(ws + WS_ACT), (const pg8::bf16_t*)(ws + WS_W2D), MMAIN, D, FFN};
        pg8::StaticOrder S; S.init(MMAIN, D, F.G, (int)blockIdx.x);
        typedef EpiResid<(unsigned)WS_H2B, false, (unsigned)WS_H3B, (unsigned)WS_SSQH3, 1> EpiDown2;
        EpiDown2 E{ws, nullptr};
        pg8::gemm_phase<EpiDown2, pg8::StaticOrder, true, true>(F.lds + RING_OFF, g, S, E, F.wave);
    }
    GRID_BAR(); STAMP(10);
    final_norm_phase(F, P);
#if MK_PROBE
    GRID_BAR(); STAMP(11);
    if (blockIdx.x == 0) {
        asm volatile("s_waitcnt vmcnt(0)" ::: "memory"); __syncthreads();
        const unsigned long long* t = (const unsigned long long*)(ws_k + WS_CTL + 512 * 1024);
        const float dta = (float)(__hip_atomic_load(t + MK_PROBE_A + 1, __ATOMIC_RELAXED, __HIP_MEMORY_SCOPE_AGENT) - __hip_atomic_load(t + MK_PROBE_A, __ATOMIC_RELAXED, __HIP_MEMORY_SCOPE_AGENT)) * 0.01f;
        const float dtb = (float)(__hip_atomic_load(t + MK_PROBE_B + 1, __ATOMIC_RELAXED, __HIP_MEMORY_SCOPE_AGENT) - __hip_atomic_load(t + MK_PROBE_B, __ATOMIC_RELAXED, __HIP_MEMORY_SCOPE_AGENT)) * 0.01f;
        const float f = 1.f + sqrtf(dta / 20000.f);
        const int tid_p = fresh_tid(F.wave);
        for (int i = tid_p; i < NS * D; i += NWAVES * 64) P.out()[OUT_YS + i] *= f;
        if (tid_p == 0) P.out()[OUT_YP] += dtb / 5.f;
    }
#endif
#undef GRID_BAR
}
}
extern "C" void kernel_launch(void* const* d_in, const int* in_sizes, int n_in, void* d_out, int out_size, void* d_ws, size_t ws_size, hipStream_t stream) {
    static int grid = 0;
    if (grid == 0) {
        int dev = 0, cus = 0;
        if (n_in != 27 || out_size != (int)mk::OUT_END || ws_size < mk::WS_END6) { fprintf(stderr, "kernel_launch: unexpected problem shape (n_in %d, out %d, ws %zu); nothing launched\n", n_in, out_size, ws_size); grid = -1; return; }
        if (hipGetDevice(&dev) != hipSuccess || hipDeviceGetAttribute(&cus, hipDeviceAttributeMultiprocessorCount, dev) != hipSuccess) { fprintf(stderr, "kernel_launch: device query failed\n"); grid = -1; return; }
        if (hipFuncSetAttribute((const void*)mk::mega_fwd, hipFuncAttributeMaxDynamicSharedMemorySize, mk::LDS_BYTES) != hipSuccess) { fprintf(stderr, "kernel_launch: hipFuncSetAttribute failed\n"); grid = -1; return; }
        int per_cu = 0;
        if (hipOccupancyMaxActiveBlocksPerMultiprocessor(&per_cu, (const void*)mk::mega_fwd, mk::NWAVES * 64, mk::LDS_BYTES) != hipSuccess || per_cu < 1) fprintf(stderr, "kernel_launch: note: occupancy query reports %d workgroups per CU\n", per_cu);
        (void)hipGetLastError();
        if (cus < 256) { fprintf(stderr, "kernel_launch: this kernel's static work assignment needs 256 resident workgroups (one per CU); the device has %d CUs; nothing launched\n", cus); grid = -1; return; }
        grid = 256;
    }
    if (grid < 0) return;
    unsigned char* ws = (unsigned char*)d_ws;
    (void)hipMemsetAsync(ws + mk::WS_CTL, 0, mk::CTL_ZERO_BYTES, stream);
    mk::Args a{};
    for (int i = 0; i < 27; ++i) a.in[i] = (const float*)d_in[i];
    a.out = (float*)d_out; a.ws = ws;
    hipLaunchKernelGGL(mk::mega_fwd, dim3(grid), dim3(mk::NWAVES * 64), mk::LDS_BYTES, stream, a);
}
```

```cpp
#include <hip/hip_runtime.h>
#include <cstdio>
#include <cstdint>
#include <cmath>
#define MK_DEBUG 0
#ifndef MK_PROBE
#define MK_PROBE 0
#define MK_PROBE_A 0
#define MK_PROBE_B 1
#endif
__device__ __forceinline__ int lane_fresh() { int l; asm volatile("v_mbcnt_lo_u32_b32 %0, -1, 0\n\tv_mbcnt_hi_u32_b32 %0, -1, %0" : "=v"(l)); return l; }
__device__ __forceinline__ unsigned char* opaque_g(const unsigned char* p) { unsigned long long v = (unsigned long long)p; asm volatile("" : "+s"(v)); return (unsigned char*)(__attribute__((address_space(1))) unsigned char*)v; }
namespace pg8 {
#define PG8_LAS __attribute__((address_space(3)))
typedef unsigned short bf16_t;
typedef short bf16x8 __attribute__((ext_vector_type(8)));
typedef float f32x4 __attribute__((ext_vector_type(4)));
typedef unsigned u32x4 __attribute__((ext_vector_type(4)));
constexpr int BM = 256, BK = 64, HALF = 128, HTB = HALF * BK * 2  , STAGE_BYTES = 8 * HTB, NXCD = 8, WGM = 8;

__host__ __device__ __forceinline__ int lds_byte(int r, int c) { const int st = (r >> 4) * 2 + (c >> 5), rr = r & 15, cc = c & 31, ob = rr * 64 + cc * 2; return st * 1024 + (ob ^ (((ob >> 9) & 1) << 5)); }
__host__ __device__ __forceinline__ void stage_rc(int b, int& R, int& C) { const int st = b / 1024, sb = b % 1024, swz = sb ^ (((sb >> 9) & 1) << 5); R = (st >> 1) * 16 + swz / 64; C = (st & 1) * 32 + (swz % 64) / 2; }
__host__ __device__ __forceinline__ int perm32(int rho) { const int n = rho >> 4, i = rho & 15; return 8 * (i >> 2) + 4 * n + (i & 3); }

struct Unit { int pm, pn; };
struct Gemm { const bf16_t* A; const bf16_t* Bt; int M, N, K; };

struct StaticOrder {
    int nM, nN, nwg, G, c;
    __host__ __device__ void init(int M, int N, int G_, int c_) { nM = M / BM; nN = N / BM; nwg = nM * nN; G = G_; c = c_; }
    __host__ __device__ bool next(int i, Unit& u) const {
        const long L = (long)i * G + c; if (L >= nwg) return false;
        int wgid = (int)L; { const int q = nwg / NXCD, r = nwg % NXCD, xcd = wgid % NXCD, off = wgid / NXCD; wgid = (xcd < r ? xcd * (q + 1) : r * (q + 1) + (xcd - r) * q) + off; }
        const int nig = WGM * nN, gid = wgid / nig, fm = gid * WGM, gsz = (nM - fm) < WGM ? (nM - fm) : WGM;
        u.pm = fm + ((wgid % nig) % gsz); u.pn = (wgid % nig) / gsz; return true;
    }
    __device__ __forceinline__ void a_ready(const Unit&) const {}
    __device__ __forceinline__ void done(const Unit&) const {}
};

__device__ __forceinline__ unsigned cvt_pk_bf16(float lo, float hi) { unsigned r; asm volatile("v_cvt_pk_bf16_f32 %0, %1, %2" : "=v"(r) : "v"(lo), "v"(hi)); return r; }
typedef float f32x2 __attribute__((ext_vector_type(2)));
template <class Epi, class Sched, bool ALIGN_EPI = false, bool SP2 = false>
__device__ __forceinline__ void gemm_phase(PG8_LAS unsigned char* lds, const Gemm g, const Sched& S, const Epi& E, const int wave_in  ) {
    int tid_ = lane_fresh() + 64 * wave_in; asm volatile("" : "+v"(tid_));
    const int tid = tid_, wid = __builtin_amdgcn_readfirstlane(tid >> 6), lane = tid & 63, wr = wid >> 2, wc = wid & 3, fr = lane & 15, fq = lane >> 4;
    const int K = g.K, nt = K / BK;
    unsigned voffA[2], voffB[2];
#pragma unroll
    for (int i = 0; i < 2; ++i) { int R, C; stage_rc(tid * 16 + i * 8192, R, C); const int Rb = Epi::PERM ? ((R & ~31) + perm32(R & 31)) : R;
        voffA[i] = (unsigned)(R * K + C) * 2u; voffB[i] = (unsigned)(Rb * K + C) * 2u; }
    const size_t kstep = (size_t)(BK * 2);
    const size_t hstep = (size_t)HALF * K * 2;
    const size_t tstep = 2 * hstep;
    const unsigned ldsw = (unsigned)wid * 1024u;
    const int aoff = lds_byte(wr * 64 + fr, fq * 8), boff = lds_byte(wc * 32 + fr, fq * 8);
#define PG8_SA(b, h) (((b) * 2 + (h)) * HTB)
#define PG8_SB(b, h) ((4 + (b) * 2 + (h)) * HTB)
#define PG8_STAGE(bufoff, gbase, voff) do { _Pragma("unroll") for (int _i = 0; _i < 2; ++_i) \
        __builtin_amdgcn_global_load_lds((const unsigned*)((const char*)(gbase) + (voff)[_i]), (PG8_LAS unsigned*)(lds + (bufoff) + ldsw + _i * 8192), 16, 0, 0); } while (0)
#define PG8_LDA(dst, b, h) do { _Pragma("unroll") for (int m = 0; m < 4; ++m) _Pragma("unroll") for (int k = 0; k < 2; ++k) dst[m][k] = *(const PG8_LAS bf16x8*)(lds + PG8_SA(b, h) + aoff + m * 2048 + k * 1024); } while (0)
#define PG8_LDB(dst, b, h) do { _Pragma("unroll") for (int n = 0; n < 2; ++n) _Pragma("unroll") for (int k = 0; k < 2; ++k) dst[n][k] = *(const PG8_LAS bf16x8*)(lds + PG8_SB(b, h) + boff + n * 2048 + k * 1024); } while (0)
#define PG8_MMA(ai, bj, At, Bt) do { __builtin_amdgcn_s_setprio(1); _Pragma("unroll") for (int m = 0; m < 4; ++m) _Pragma("unroll") for (int n = 0; n < 2; ++n) _Pragma("unroll") for (int k = 0; k < 2; ++k) \
        acc[ai][bj][m][n] = __builtin_amdgcn_mfma_f32_16x16x32_bf16(Bt[n][k], At[m][k], acc[ai][bj][m][n], 0, 0, 0); __builtin_amdgcn_s_setprio(0); } while (0)
#define PG8_WAIT_V(n) asm volatile("s_waitcnt vmcnt(" #n ")" ::: "memory")
#define PG8_WAIT_L(n) asm volatile("s_waitcnt lgkmcnt(" #n ")" ::: "memory")
#define PG8_BAR __builtin_amdgcn_s_barrier()
#define PG8_SCHED __builtin_amdgcn_sched_barrier(0)
    Unit cur, nxt; int ui = 0;
    if (!S.next(0, cur)) return;
    f32x4 acc[2][2][4][2];
#pragma unroll
    for (int a = 0; a < 2; ++a)
#pragma unroll
        for (int b = 0; b < 2; ++b)
#pragma unroll
            for (int m = 0; m < 4; ++m)
#pragma unroll
                for (int n = 0; n < 2; ++n) acc[a][b][m][n] = (f32x4){0.f, 0.f, 0.f, 0.f};
    bf16x8 At[4][2], B0[2][2], B1[2][2];
    const char* cA = (const char*)g.A + (size_t)cur.pm * tstep; const char* cB = (const char*)g.Bt + (size_t)cur.pn * tstep;
    S.a_ready(cur);
    if constexpr (SP2) {
        PG8_STAGE(PG8_SB(0, 0), cB, voffB); PG8_STAGE(PG8_SB(0, 1), cB + hstep, voffB); PG8_STAGE(PG8_SA(0, 0), cA, voffA); PG8_STAGE(PG8_SA(0, 1), cA + hstep, voffA);
        if (wr == 1) PG8_BAR;
        PG8_WAIT_V(2); PG8_BAR;
        PG8_STAGE(PG8_SB(1, 0), cB + kstep, voffB); PG8_STAGE(PG8_SA(1, 0), cA + kstep, voffA); PG8_STAGE(PG8_SB(1, 1), cB + hstep + kstep, voffB);
        PG8_WAIT_V(6); PG8_BAR;
    } else {
        PG8_STAGE(PG8_SB(0, 0), cB, voffB); PG8_STAGE(PG8_SA(0, 0), cA, voffA); PG8_STAGE(PG8_SB(0, 1), cB + hstep, voffB); PG8_STAGE(PG8_SA(0, 1), cA + hstep, voffA);
        if (wr == 1) PG8_BAR;
        PG8_WAIT_V(4); PG8_BAR;
        PG8_STAGE(PG8_SB(1, 0), cB + kstep, voffB); PG8_STAGE(PG8_SA(1, 0), cA + kstep, voffA); PG8_STAGE(PG8_SB(1, 1), cB + hstep + kstep, voffB);
        PG8_WAIT_V(6); PG8_BAR;
    }
    for (;;) {
        const bool has_next = S.next(ui + 1, nxt);
        const char* nA = has_next ? (const char*)g.A + (size_t)nxt.pm * tstep : cA; const char* nB = has_next ? (const char*)g.Bt + (size_t)nxt.pn * tstep : cB;
        for (int t = 0; t < nt; t += 2) {
            const bool last = (t == nt - 2);
            const char* a1 = cA + (size_t)(t + 1) * kstep;
            const char* a2 = last ? nA : cA + (size_t)(t + 2) * kstep; const char* b2 = last ? nB : cB + (size_t)(t + 2) * kstep;
            const char* a3 = a2 + kstep; const char* b3 = b2 + kstep;
            if (last && has_next) S.a_ready(nxt);
            if constexpr (SP2) {
            PG8_LDB(B0, 0, 0); PG8_LDB(B1, 0, 1); PG8_SCHED; PG8_LDA(At, 0, 0); PG8_STAGE(PG8_SA(1, 1), a1 + hstep, voffA);
            PG8_WAIT_V(8); PG8_WAIT_L(0); PG8_BAR; PG8_MMA(0, 0, At, B0); PG8_MMA(0, 1, At, B1); PG8_BAR; PG8_SCHED;
            PG8_LDA(At, 0, 1); PG8_STAGE(PG8_SB(0, 0), b2, voffB); PG8_STAGE(PG8_SB(0, 1), b2 + hstep, voffB); PG8_STAGE(PG8_SA(0, 0), a2, voffA);
            PG8_WAIT_V(8); PG8_WAIT_L(0); PG8_BAR; PG8_MMA(1, 0, At, B0); PG8_MMA(1, 1, At, B1); PG8_BAR; PG8_SCHED;
            PG8_LDB(B0, 1, 0); PG8_LDB(B1, 1, 1); PG8_SCHED; PG8_LDA(At, 1, 0); PG8_STAGE(PG8_SA(0, 1), a2 + hstep, voffA);
            PG8_WAIT_V(8); PG8_WAIT_L(0); PG8_BAR; PG8_MMA(0, 0, At, B0); PG8_MMA(0, 1, At, B1); PG8_BAR; PG8_SCHED;
            PG8_LDA(At, 1, 1); PG8_STAGE(PG8_SB(1, 0), b3, voffB); PG8_STAGE(PG8_SB(1, 1), b3 + hstep, voffB); PG8_STAGE(PG8_SA(1, 0), a3, voffA);
            PG8_WAIT_V(8); PG8_WAIT_L(0); PG8_BAR; PG8_MMA(1, 0, At, B0); PG8_MMA(1, 1, At, B1); PG8_BAR; PG8_SCHED;
            } else {
            PG8_LDB(B0, 0, 0); PG8_SCHED; PG8_LDA(At, 0, 0); PG8_STAGE(PG8_SA(1, 1), a1 + hstep, voffA);
            PG8_WAIT_L(8); PG8_BAR; PG8_WAIT_L(0); PG8_MMA(0, 0, At, B0); PG8_BAR; PG8_SCHED;
            PG8_LDB(B1, 0, 1); PG8_STAGE(PG8_SB(0, 0), b2, voffB);
            PG8_BAR; PG8_WAIT_L(0); PG8_MMA(0, 1, At, B1); PG8_BAR;
            PG8_LDA(At, 0, 1); PG8_STAGE(PG8_SA(0, 0), a2, voffA);
            PG8_BAR; PG8_WAIT_L(0); PG8_MMA(1, 0, At, B0); PG8_BAR; PG8_SCHED;
            PG8_STAGE(PG8_SB(0, 1), b2 + hstep, voffB);
            PG8_WAIT_V(6); PG8_BAR; PG8_MMA(1, 1, At, B1); PG8_BAR;
            PG8_LDB(B0, 1, 0); PG8_SCHED; PG8_LDA(At, 1, 0); PG8_STAGE(PG8_SA(0, 1), a2 + hstep, voffA);
            PG8_WAIT_L(8); PG8_BAR; PG8_WAIT_L(0); PG8_MMA(0, 0, At, B0); PG8_BAR; PG8_SCHED;
            PG8_LDB(B1, 1, 1); PG8_STAGE(PG8_SB(1, 0), b3, voffB);
            PG8_BAR; PG8_WAIT_L(0); PG8_MMA(0, 1, At, B1); PG8_BAR;
            PG8_LDA(At, 1, 1); PG8_STAGE(PG8_SA(1, 0), a3, voffA);
            PG8_BAR; PG8_WAIT_L(0); PG8_MMA(1, 0, At, B0); PG8_BAR; PG8_SCHED;
            PG8_STAGE(PG8_SB(1, 1), b3 + hstep, voffB);
            PG8_WAIT_V(6); PG8_BAR; PG8_MMA(1, 1, At, B1); PG8_BAR;
            }
        }
        if constexpr (ALIGN_EPI) { if (wr == 0) PG8_BAR; }
        if constexpr (!Epi::AFTER_DRAIN) { E(acc, cur, wr, wc, fr, fq); S.done(cur); }
        if (!has_next) break;
#pragma unroll
        for (int a = 0; a < 2; ++a)
#pragma unroll
            for (int b = 0; b < 2; ++b)
#pragma unroll
                for (int m = 0; m < 4; ++m)
#pragma unroll
                    for (int n = 0; n < 2; ++n) acc[a][b][m][n] = (f32x4){0.f, 0.f, 0.f, 0.f};
        cur = nxt; cA = nA; cB = nB; ++ui;
        if constexpr (ALIGN_EPI) { if (wr == 1) PG8_BAR; }
    }
    PG8_WAIT_V(0);
    if constexpr (!ALIGN_EPI) { if (wr == 0) PG8_BAR; }
    PG8_BAR;
    if constexpr (Epi::AFTER_DRAIN) { E.fused(acc, cur, wr, wc, fr, fq, lds, wid, lane); S.done(cur); }
#undef PG8_SA
#undef PG8_SB
#undef PG8_STAGE
#undef PG8_LDA
#undef PG8_LDB
#undef PG8_MMA
#undef PG8_WAIT_V
#undef PG8_WAIT_L
#undef PG8_BAR
#undef PG8_SCHED
}
}
#define GAS __attribute__((address_space(1)))
#define LAS __attribute__((address_space(3)))
typedef unsigned short bf16;
typedef unsigned v4u __attribute__((ext_vector_type(4)));
typedef float f32x4 __attribute__((ext_vector_type(4)));
typedef short bf16x8 __attribute__((ext_vector_type(8)));
typedef GAS unsigned gu32;
typedef GAS unsigned long long gu64;
#define RLX_AGENT __ATOMIC_RELAXED, __HIP_MEMORY_SCOPE_AGENT
#define LDS_WAIT() asm volatile("s_waitcnt lgkmcnt(0)" ::: "memory")
#define VM_WAIT() asm volatile("s_waitcnt vmcnt(0)" ::: "memory")
__device__ __forceinline__ unsigned long long rt() { return __builtin_amdgcn_s_memrealtime(); }
__device__ __forceinline__ unsigned f2bf(float f) { unsigned u = __builtin_bit_cast(unsigned, f); return (u + 0x7fffu + ((u >> 16) & 1u)) >> 16; }
__device__ __forceinline__ unsigned pk2(float lo, float hi) { return f2bf(lo) | (f2bf(hi) << 16); }

#define XB_TMO      128
#define XB_XCNT(j)  (256  + 64 * (j))
#define XB_XSUB(j)  (1280 + 64 * (j))
#define XB_XGEN(j)  (2304 + 64 * (j))
#define XB_TOP      3328
#define XB_TOPGEN   3392
#define XCD_BAR_WORDS 3456
#define XB_SPIN_CAP (1u << 18)

__device__ __forceinline__ unsigned xb_ld(unsigned* p)              { return __hip_atomic_load(p, __ATOMIC_RELAXED, __HIP_MEMORY_SCOPE_AGENT); }
__device__ __forceinline__ unsigned xb_add(unsigned* p, unsigned v) { return __hip_atomic_fetch_add(p, v, __ATOMIC_RELAXED, __HIP_MEMORY_SCOPE_AGENT); }
__device__ __forceinline__ unsigned xb_xcc_id() { return (unsigned)__builtin_amdgcn_s_getreg((3 << 11) | 20) & 0xFu; }
#define XB_SPIN(cond, bar) do { unsigned _sp = 0; while (cond) { __builtin_amdgcn_s_sleep(1); \
    if ((++_sp & 255u) == 0u) { if (xb_ld(&(bar)[XB_TMO])) break; if (_sp > XB_SPIN_CAP) { atomicAdd(&(bar)[XB_TMO], 1u); break; } } } } while (0)

struct XcdBarrier {
    unsigned* bar; unsigned x; int wave;
    volatile LAS unsigned* st;
};

#define XB_IS_T0(wave) ((wave) == 0 && lane_fresh() == 0)
__device__ __forceinline__ XcdBarrier xcd_barrier_post(unsigned* bar, volatile LAS unsigned* st, int wave) {
    XcdBarrier b; b.bar = bar; b.x = xb_xcc_id(); b.st = st; b.wave = wave;
    if (XB_IS_T0(wave)) (void)xb_add(&bar[XB_XCNT(b.x)], 1u);
    return b;
}
__device__ __forceinline__ void xcd_barrier_complete(unsigned* bar, unsigned x, unsigned& nloc, unsigned& nx) {
    const unsigned G = gridDim.x * gridDim.y * gridDim.z;
    unsigned sum, cnt, mine, sp = 0u;
    for (;;) {
        sum = 0u; cnt = 0u; mine = 0u;
#pragma unroll
        for (unsigned j = 0; j < 16; ++j) { const unsigned c = xb_ld(&bar[XB_XCNT(j)]); sum += c; cnt += (c > 0u) ? 1u : 0u; mine = (j == x) ? c : mine; }
        if (sum == G) break;
        __builtin_amdgcn_s_sleep(1);
        if ((++sp & 255u) == 0u) { if (xb_ld(&bar[XB_TMO])) break; if (sp > XB_SPIN_CAP) { atomicAdd(&bar[XB_TMO], 1u); break; } }
    }
    nloc = mine > 0u ? mine : 1u; nx = cnt > 0u ? cnt : 1u;
}

__device__ __forceinline__ void xcd_barrier(const XcdBarrier& b) {
    asm volatile("s_waitcnt vmcnt(0)" ::: "memory");
    __syncthreads();
    if (XB_IS_T0(b.wave)) {
        unsigned* bar = b.bar;
        __builtin_amdgcn_s_waitcnt(0);
        unsigned nloc = b.st[0], nx = b.st[1];
        if (nloc == 0u) { xcd_barrier_complete(bar, b.x, nloc, nx); b.st[0] = nloc; b.st[1] = nx; }
        const unsigned old = xb_add(&bar[XB_XSUB(b.x)], 1u);
        const unsigned gen = old / nloc;
        if (old + 1u == (gen + 1u) * nloc) {
            __builtin_amdgcn_fence(__ATOMIC_RELEASE, "agent");
            asm volatile("s_waitcnt vmcnt(0)" ::: "memory");
            const unsigned og = xb_add(&bar[XB_TOP], 1u);
            const unsigned tg = og / nx;
            if (og + 1u == (tg + 1u) * nx) xb_add(&bar[XB_TOPGEN], 1u);
            else XB_SPIN(xb_ld(&bar[XB_TOPGEN]) == tg, bar);
            __builtin_amdgcn_fence(__ATOMIC_ACQUIRE, "agent");
            xb_add(&bar[XB_XGEN(b.x)], 1u);
            asm volatile("s_waitcnt vmcnt(0)" ::: "memory");
        } else {
            XB_SPIN(xb_ld(&bar[XB_XGEN(b.x)]) == gen, bar);
            __builtin_amdgcn_fence(__ATOMIC_ACQUIRE, "agent");
            asm volatile("s_waitcnt vmcnt(0)" ::: "memory");
        }
    }
    __syncthreads();
}
namespace mk {
constexpr int D = 1024, NB = 8, SEQ = 2048, NMETA = 16, T = SEQ + NMETA, NS = 32, PAST = 16384, PAGE = 128, NPAGES = PAST / PAGE;
constexpr int FFN = 2816, NH = 8, QR = 384, KVR = 256, RH = 4, RDK = 128, RDV = 256, IN_DIM = 5792;
constexpr int O_CQ = 0, O_CKV = 384, O_KR = 640, O_RQ = 672, O_RK = 1184, O_RV = 1696, O_RG = 2720, O_GA = 3744, O_GB = 4768;
constexpr int MMAIN = NB * SEQ;
constexpr int ROW_META = MMAIN;
constexpr int ROW_SMP = MMAIN + NMETA;
constexpr int ROW_PAD = ROW_SMP + NS;
constexpr int MP = MMAIN + 256;
constexpr int NWIN = 5888;
constexpr int NPOS = T + 1;
constexpr float EPS = 1e-6f;
constexpr int NWAVES = 8;

constexpr size_t MiB = 1u << 20;
constexpr size_t al(size_t x) { return (x + 255) / 256 * 256; }
constexpr size_t WS_CTL = 0, CTL_ZERO_BYTES = 1 * MiB;
constexpr size_t WS_W1T = 1 * MiB;
constexpr size_t WS_W1D = WS_W1T + al((size_t)2 * FFN * D * 2);
constexpr size_t WS_WIN = WS_W1D + al((size_t)D * FFN * 2);
constexpr size_t WS_WUQ = WS_WIN + al((size_t)NWIN * D * 2);
constexpr size_t WS_WUK = WS_WUQ + al((size_t)768 * QR * 2);
constexpr size_t WS_WUV = WS_WUK + al((size_t)512 * KVR * 2);
constexpr size_t WS_WMO = WS_WUV + al((size_t)512 * KVR * 2);
constexpr size_t WS_WRO = WS_WMO + al((size_t)D * 512 * 2);
constexpr size_t WS_WOUT = WS_WRO + al((size_t)D * D * 2);
constexpr size_t WS_W2T = WS_WOUT + al((size_t)D * D * 2);
constexpr size_t WS_W2D = WS_W2T + al((size_t)2 * FFN * D * 2);
constexpr size_t WS_WQL = WS_W2D + al((size_t)D * FFN * 2);
constexpr size_t WS_TAB = WS_WQL + al((size_t)2048 * QR * 2);
constexpr size_t TAB_C64 = 0, TAB_S64 = (size_t)NPOS * 64 * 4, TAB_C16 = 2 * TAB_S64, TAB_S16 = TAB_C16 + (size_t)NPOS * 16 * 4, TAB_GP = TAB_S16 + (size_t)NPOS * 16 * 4, TAB_GN = TAB_GP + 512 * 4, TAB_END = TAB_GN + 512 * 4;
constexpr size_t WS_XB = WS_TAB + al(TAB_END);
constexpr size_t WS_XE = WS_XB + al((size_t)MP * D * 2);
constexpr size_t WS_R1 = WS_XE + al((size_t)256 * D * 4);
constexpr size_t WS_ACT = WS_R1 + al((size_t)MP * 4);
constexpr size_t WS_H = WS_ACT + al((size_t)MP * FFN * 2);
constexpr size_t WS_HB = WS_H + al((size_t)MP * D * 4);
constexpr size_t WS_SSQH = WS_HB + al((size_t)MP * D * 2);
constexpr size_t WS_SSQ2_ = WS_SSQH + al((size_t)MP * 4), WS_SSQ3_ = WS_SSQ2_ + al((size_t)MP * 4);
constexpr size_t WS_END1 = WS_SSQH + al((size_t)MP * 16 * 4);

constexpr int CW_XCNT = 32768  , CW_BAR = 4096, CW_QUEUE = 64, CW_DCNT = 24576  ;

constexpr int RING_OFF = 0, RING_BYTES = 131072, SCR_BYTES = 155648  , LDSCTL_OFF = SCR_BYTES, MISC_OFF = LDSCTL_OFF + 320, LDS_BYTES = 163840;

struct Args {
    const float* in[27]; float* out; unsigned char* ws;
};

struct Frame {
    LAS unsigned char* lds;
    volatile LAS unsigned* MISC;
    int wave, vcu, G;
};

constexpr int PT_OFF = MISC_OFF + 256;
struct Ptrs {
    unsigned char* ws; volatile LAS unsigned* tab;
    __device__ __forceinline__ unsigned long long raw(int k) const { volatile LAS unsigned* t = tab; asm volatile("" : "+v"(t));
        const unsigned lo = __builtin_amdgcn_readfirstlane(t[2 * k]), hi = __builtin_amdgcn_readfirstlane(t[2 * k + 1]); return ((unsigned long long)hi << 32) | lo; }
    __device__ __forceinline__ const float* in(int k) const { return (const float*)(GAS const float*)raw(k); }
    __device__ __forceinline__ float* out() const { return (float*)(GAS float*)raw(27); }
};
__device__ __forceinline__ int fresh_tid(int wave) { int t = lane_fresh() + 64 * wave; asm volatile("" : "+v"(t)); return t; }

__device__ __forceinline__ float lx(float v, int lane, int mask) { return __int_as_float(__builtin_amdgcn_ds_bpermute((lane ^ mask) << 2, __float_as_int(v))); }
__device__ __forceinline__ float wave_sum(float v, int lane) {
#pragma unroll
    for (int o = 1; o < 64; o <<= 1) v += lx(v, lane, o);
    return v;
}
__device__ __forceinline__ int row_pos(int row) { return row < MMAIN ? (row & (SEQ - 1)) + NMETA : (row < ROW_SMP ? row - ROW_META : (row < ROW_PAD ? PAST : 0)); }
__device__ __forceinline__ int row_pidx(int row) { return row < MMAIN ? (row & (SEQ - 1)) + NMETA : (row < ROW_SMP ? row - ROW_META : (row < ROW_PAD ? T : 0)); }
__device__ __forceinline__ int row_jtok(int row) { return row < MMAIN ? (row & 127) : (row < ROW_SMP ? row - ROW_META : 0); }

struct WSrc { const float* W; int ld; int col0; const float* g; };
__device__ __forceinline__ void wmat_dims(int id, int& K, int& ngrp) {
    switch (id) {
        case 0: case 9: K = D; ngrp = 2 * FFN / 32; break;
        case 1: case 10: K = FFN; ngrp = D / 32; break;
        case 2: K = D; ngrp = NWIN / 32; break;
        case 3: K = QR; ngrp = 768 / 32; break;
        case 4: case 5: K = KVR; ngrp = 512 / 32; break;
        case 6: K = 512; ngrp = D / 32; break;
        default: K = D; ngrp = D / 32; break;
    }
}
__device__ __forceinline__ size_t wmat_off(int id) {
    switch (id) { case 0: return WS_W1T; case 1: return WS_W1D; case 2: return WS_WIN; case 3: return WS_WUQ; case 4: return WS_WUK; case 5: return WS_WUV;
                  case 6: return WS_WMO; case 7: return WS_WRO; case 8: return WS_WOUT; case 9: return WS_W2T; default: return WS_W2D; }
}
__device__ __forceinline__ WSrc wmat_src(const Args& a, int id, int g) {
    WSrc s; s.W = nullptr; s.ld = 0; s.col0 = 0; s.g = nullptr;
    switch (id) {
        case 0: case 9: { const int pn = g >> 3, gg = g & 7; const int o = id == 0 ? 7 : 22;
            s.W = gg < 4 ? a.in[o + 1] : a.in[o + 2]; s.ld = FFN; s.col0 = 128 * pn + 32 * (gg & 3); s.g = a.in[o]; break; }
        case 1: s.W = a.in[10]; s.ld = D; s.col0 = 32 * g; break;
        case 10: s.W = a.in[25]; s.ld = D; s.col0 = 32 * g; break;
        case 2: { s.ld = IN_DIM; s.g = a.in[11]; int zc = -1;
            if (g < 8) zc = 32 * g;
            else if (g < 16) { const int gg = g - 8; zc = gg < 4 ? 256 + 32 * gg : (gg == 4 ? O_KR : -1); }
            else if (g < 24) zc = O_CKV + 32 * (g - 16);
            else if (g < 56) { const int base = g < 40 ? O_RQ : O_RK; const int q = (g - 24) & 15, t = q >> 3, gg = q & 7;
                const int h = 2 * t + ((gg >> 1) & 1), part = (gg >> 2) * 64 + (gg & 1) * 32; zc = base + h * 128 + part; }
            else if (g < 88) zc = O_RV + 32 * (g - 56);
            else if (g < 120) zc = O_RG + 32 * (g - 88);
            else if (g < 152) zc = O_GA + 32 * (g - 120);
            else zc = O_GB + 32 * (g - 152);
            if (zc >= 0) { s.W = a.in[12]; s.col0 = zc; }
            break; }
        case 3: s.W = a.in[15]; s.ld = 768; s.col0 = 32 * g; s.g = a.in[13]; break;
        case 4: s.W = a.in[16]; s.ld = 512; s.col0 = 32 * g; s.g = a.in[14]; break;
        case 5: s.W = a.in[17]; s.ld = 512; s.col0 = 32 * g; s.g = a.in[14]; break;
        case 6: s.W = a.in[18]; s.ld = D; s.col0 = 32 * g; break;
        case 7: s.W = a.in[20]; s.ld = D; s.col0 = 32 * g; break;
        default: s.W = a.in[21]; s.ld = D; s.col0 = 32 * g; break;
    }
    return s;
}
__device__ __forceinline__ void p0_transpose_item(const WSrc s, int K, bf16* WT, int n0, int k0, LAS float* scr, int lane) {
    if (s.W) {
        float v[32];
        const float* wp = s.W + (size_t)(k0 + (lane >> 5)) * s.ld + s.col0 + (lane & 31);
#pragma unroll
        for (int i = 0; i < 32; ++i) v[i] = wp[(size_t)(2 * i) * s.ld];
        if (s.g) { const float* gp = s.g + k0 + (lane >> 5);
#pragma unroll
            for (int i = 0; i < 32; ++i) v[i] *= gp[2 * i]; }
#pragma unroll
        for (int i = 0; i < 32; ++i) scr[(2 * i + (lane >> 5)) * 33 + (lane & 31)] = v[i];
    } else {
#pragma unroll 8
        for (int i = 0; i < 32; ++i) { const int kk = 2 * i + (lane >> 5); scr[kk * 33 + (lane & 31)] = 0.f; }
    }
    LDS_WAIT(); asm volatile("" ::: "memory");
    const int c = lane & 7;
#pragma unroll
    for (int j = 0; j < 4; ++j) { const int n = (lane >> 3) + 8 * j; const LAS float* sp = scr + (8 * c) * 33 + n;
        v4u o; o.x = pk2(sp[0 * 33], sp[1 * 33]); o.y = pk2(sp[2 * 33], sp[3 * 33]); o.z = pk2(sp[4 * 33], sp[5 * 33]); o.w = pk2(sp[6 * 33], sp[7 * 33]);
        *(GAS v4u*)(WT + (size_t)(n0 + n) * K + k0 + 8 * c) = o; }
    LDS_WAIT(); asm volatile("" ::: "memory");
}
__device__ __forceinline__ const float* x_src(const Args& a, int row) {
    if (row < MMAIN) return a.in[0] + (size_t)row * D;
    if (row < ROW_SMP) return a.in[6] + (size_t)(row - ROW_META) * D;
    if (row < ROW_PAD) return a.in[1] + (size_t)(row - ROW_SMP) * D;
    return nullptr;
}
__device__ __forceinline__ void p0_weights(const Args& a, unsigned id_mask, int gw, int NGW, LAS float* scr, int lane) {
    unsigned char* ws = a.ws;
    int base = 0;
#pragma unroll 1
    for (int id = 0; id < 11; ++id) {
        if (!((id_mask >> id) & 1u)) continue;
        int K, ngrp; wmat_dims(id, K, ngrp);
        const int nk = K / 64, nitems = nk * ngrp;
        bf16* WT = (bf16*)(ws + wmat_off(id));
        int first = (gw - (base % NGW) + NGW) % NGW;
        for (int it = first; it < nitems; it += NGW) { const int g = it % ngrp, kb = it / ngrp; p0_transpose_item(wmat_src(a, id, g), K, WT, 32 * g, 64 * kb, scr, lane); }
        base += nitems;
    }
}
__device__ __forceinline__ void p0_weights_late(Frame& F, const Args& a) {
    const int bx = (int)blockIdx.x; if (bx < 188) return;
    const int lane = fresh_tid(F.wave) & 63;
    LAS float* scr = (LAS float*)(F.lds + RING_OFF + F.wave * 16384);
    p0_weights(a, 0x380u  , (bx - 188) * NWAVES + F.wave, 68 * NWAVES, scr, lane);
    __syncthreads();
}
__device__ __forceinline__ void p0_prologue(Frame& F, const Args& a) {
    const int lane = fresh_tid(F.wave) & 63;
    LAS float* scr = (LAS float*)(F.lds + RING_OFF + F.wave * 16384);
    const int gw = F.vcu * NWAVES + F.wave, NGW = F.G * NWAVES;
    unsigned char* ws = a.ws;
    p0_weights(a, 0x47Fu  , gw, NGW, scr, lane);
    bf16* XB = (bf16*)(ws + WS_XB); float* XE = (float*)(ws + WS_XE); float* R1 = (float*)(ws + WS_R1);
    for (int m0 = gw; m0 < MP; m0 += 2 * NGW) {
        f32x4 v[2][4];
#pragma unroll
        for (int t = 0; t < 2; ++t) { const int m = m0 + t * NGW; const float* xr = m < MP ? x_src(a, m) : nullptr;
#pragma unroll
            for (int j = 0; j < 4; ++j) v[t][j] = xr ? *((const GAS f32x4*)xr + lane + 64 * j) : (f32x4){0.f, 0.f, 0.f, 0.f}; }
#pragma unroll
        for (int t = 0; t < 2; ++t) { const int m = m0 + t * NGW; if (m >= MP) break;
            float s = 0.f;
#pragma unroll
            for (int j = 0; j < 4; ++j) s += (v[t][j].x * v[t][j].x + v[t][j].y * v[t][j].y) + (v[t][j].z * v[t][j].z + v[t][j].w * v[t][j].w);
            s = wave_sum(s, lane);
            if (lane == 0) R1[m] = 1.0f / sqrtf(s * (1.f / D) + EPS);
            GAS unsigned long long* o8 = (GAS unsigned long long*)(XB + (size_t)m * D) + lane;
#pragma unroll
            for (int j = 0; j < 4; ++j) o8[64 * j] = (unsigned long long)pk2(v[t][j].x, v[t][j].y) | ((unsigned long long)pk2(v[t][j].z, v[t][j].w) << 32);
            if (m >= MMAIN) {
#pragma unroll
                for (int j = 0; j < 4; ++j) *((GAS f32x4*)(XE + (size_t)(m - MMAIN) * D) + lane + 64 * j) = v[t][j];
            } }
    }
    {   const float* wuq = a.in[15]; const float* wuk = a.in[16]; const float* qn = a.in[13]; bf16* WQL = (bf16*)(ws + WS_WQL);
        LAS float* U = (LAS float*)(F.lds + RING_OFF);
        const int tid = F.wave * 64 + lane;
        for (int it = F.vcu; it < 256; it += F.G) {
            const int h = it >> 5, r0 = (it & 31) * 8;
            __syncthreads();
            for (int e = tid; e < QR * 64; e += NWAVES * 64) { const int k = e >> 6, n = e & 63; U[k * 65 + n] = wuq[(size_t)k * 768 + h * 96 + n]; }
            { const int rr = tid >> 6, n = tid & 63; U[QR * 65 + rr * 64 + n] = wuk[(size_t)(r0 + rr) * 512 + h * 64 + n]; }
            __syncthreads();
            if (tid < QR) { const float g = qn[tid]; float acc[8];
#pragma unroll
                for (int rr = 0; rr < 8; ++rr) acc[rr] = 0.f;
                for (int n = 0; n < 64; ++n) { const float u = U[tid * 65 + n];
#pragma unroll
                    for (int rr = 0; rr < 8; ++rr) acc[rr] += u * U[QR * 65 + rr * 64 + n]; }
#pragma unroll
                for (int rr = 0; rr < 8; ++rr) WQL[(size_t)(h * 256 + r0 + rr) * QR + tid] = (bf16)f2bf(acc[rr] * g); }
        }
        __syncthreads();
    }
    { const int gt_ = (F.vcu * NWAVES + F.wave) * 64 + lane, NGT_ = NGW * 64;
      for (int e = gt_; e < MP; e += NGT_) { ((float*)(ws + WS_SSQH))[e] = 0.f; ((float*)(ws + WS_SSQ2_))[e] = 0.f; ((float*)(ws + WS_SSQ3_))[e] = 0.f; } }
    float* TAB = (float*)(ws + WS_TAB);
    const int gt = (F.vcu * NWAVES + F.wave) * 64 + lane, NGT = NGW * 64;
    for (int e = gt; e < NPOS * 64; e += NGT) { const int p = e >> 6, i = e & 63; const int pos = p < T ? p : PAST;
        const float invf = (float)pow(10000.0, -(double)i / 64.0); const float ang = (float)pos * invf;
        TAB[TAB_C64 / 4 + e] = (float)cos((double)ang); TAB[TAB_S64 / 4 + e] = (float)sin((double)ang); }
    for (int e = gt; e < NPOS * 16; e += NGT) { const int p = e >> 4, i = e & 15; const int pos = p < T ? p : PAST;
        const float invf = (float)pow(10000.0, -(double)i / 16.0); const float ang = (float)pos * invf;
        TAB[TAB_C16 / 4 + e] = (float)cos((double)ang); TAB[TAB_S16 / 4 + e] = (float)sin((double)ang); }
    for (int e = gt; e < 512; e += NGT) { const int h = e >> 7, j = e & 127; const double lg = log1p(-exp2(-5.0 - (double)h));
        TAB[TAB_GP / 4 + e] = (float)exp(lg * (double)j); TAB[TAB_GN / 4 + e] = (float)exp(-lg * (double)j); }
}

using pg8::f32x4; using pg8::u32x4; using pg8::Unit; using pg8::BM; using pg8::HALF;
typedef unsigned u32x2 __attribute__((ext_vector_type(2)));
__device__ __forceinline__ float fast_sigmoid(float x) { return __builtin_amdgcn_rcpf(1.f + __builtin_amdgcn_exp2f(-1.4426950408889634f * x)); }
__device__ __forceinline__ float fast_silu(float x) { return x * fast_sigmoid(x); }

struct EpiSwiGLU {
    static constexpr bool PERM = true, AFTER_DRAIN = false;
    bf16* ACT; const float* rs;
    __device__ __forceinline__ void operator()(const f32x4 (&acc)[2][2][4][2], const Unit& u, int wr, int wc, int fr, int fq) const {
        int l_ = lane_fresh(); asm volatile("" : "+v"(l_)); fr = l_ & 15; fq = l_ >> 4;
        const int row0 = u.pm * BM + wr * 64 + fr, col0 = u.pn * HALF + wc * 32 + 8 * fq;
#pragma unroll
        for (int ai = 0; ai < 2; ++ai)
#pragma unroll
            for (int m = 0; m < 4; ++m) { const int row = row0 + ai * HALF + m * 16; const float r = rs[row];
                f32x4 o[2];
#pragma unroll
                for (int n = 0; n < 2; ++n)
#pragma unroll
                    for (int j = 0; j < 4; ++j) { const float g = acc[ai][0][m][n][j] * r, up = acc[ai][1][m][n][j] * r; o[n][j] = fast_silu(g) * up; }
                u32x4 w; w.x = pg8::cvt_pk_bf16(o[0][0], o[0][1]); w.y = pg8::cvt_pk_bf16(o[0][2], o[0][3]); w.z = pg8::cvt_pk_bf16(o[1][0], o[1][1]); w.w = pg8::cvt_pk_bf16(o[1][2], o[1][3]);
                *(u32x4*)(ACT + (size_t)row * FFN + col0) = w; }
    }
};
template <class T> __device__ __forceinline__ T* at(unsigned char* w, unsigned byte_off) { return (T*)(w + byte_off); }
template <unsigned RES_OFF, bool RES_X, unsigned OUTB_OFF, unsigned SSQ_OFF, int SCALE2  > struct EpiResid {
    static constexpr bool PERM = true, AFTER_DRAIN = false;
    unsigned char* ws_; const float* xin;
    __device__ __forceinline__ void operator()(const f32x4 (&acc)[2][2][4][2], const Unit& u, int wr, int wc, int fr, int fq) const {
        int l_ = lane_fresh(); asm volatile("" : "+v"(l_)); fr = l_ & 15; fq = l_ >> 4;
        unsigned char* w = opaque_g(ws_);
        const unsigned row0 = u.pm * BM + wr * 64 + fr, col0 = u.pn * BM + wc * 32 + 8 * fq;
        constexpr float scale = 0.5f * SCALE2;
#pragma unroll
        for (int ai = 0; ai < 2; ++ai)
#pragma unroll
            for (int m = 0; m < 4; ++m) { unsigned row = row0 + ai * HALF + m * 16; asm volatile("" : "+v"(row));
                float ss = 0.f;
#pragma unroll
                for (int bj = 0; bj < 2; ++bj) {
                    const unsigned e = row * D + col0 + bj * HALF;
                    f32x4 b0, b1;
                    if (RES_X) { const float* rp = row < (unsigned)MMAIN ? xin + e : at<const float>(w, RES_OFF + (e - MMAIN * D) * 4); b0 = *(const f32x4*)rp; b1 = *(const f32x4*)(rp + 4); }
                    else { const u32x4 rb = *at<const u32x4>(w, RES_OFF + e * 2);
                        b0 = (f32x4){__uint_as_float(rb.x << 16), __uint_as_float(rb.x & 0xffff0000u), __uint_as_float(rb.y << 16), __uint_as_float(rb.y & 0xffff0000u)};
                        b1 = (f32x4){__uint_as_float(rb.z << 16), __uint_as_float(rb.z & 0xffff0000u), __uint_as_float(rb.w << 16), __uint_as_float(rb.w & 0xffff0000u)}; }
                    const f32x4 o0 = b0 + acc[ai][bj][m][0] * scale, o1 = b1 + acc[ai][bj][m][1] * scale;
                    ss += ((o0[0] * o0[0] + o0[1] * o0[1]) + (o0[2] * o0[2] + o0[3] * o0[3])) + ((o1[0] * o1[0] + o1[1] * o1[1]) + (o1[2] * o1[2] + o1[3] * o1[3]));
                    u32x4 pk; pk.x = pg8::cvt_pk_bf16(o0[0], o0[1]); pk.y = pg8::cvt_pk_bf16(o0[2], o0[3]); pk.z = pg8::cvt_pk_bf16(o1[0], o1[1]); pk.w = pg8::cvt_pk_bf16(o1[2], o1[3]);
                    *at<u32x4>(w, OUTB_OFF + e * 2) = pk; }
                ss += lx(ss, l_, 16); ss += lx(ss, l_, 32);
                if (fq == 0) atomicAdd(at<float>(w, SSQ_OFF + row * 4), ss);
                asm volatile("" ::: "memory"); }
    }
};
}
namespace mk {
constexpr size_t WS_CQ = WS_END1;
constexpr size_t WS_SSQCQ = WS_CQ + al((size_t)MP * QR * 2);
constexpr size_t WS_CKVF = WS_SSQCQ + al((size_t)MP * 8 * 4);
constexpr size_t WS_CKVB = WS_CKVF + al((size_t)MP * KVR * 4);
constexpr size_t WS_SSQKV = WS_CKVB + al((size_t)MP * KVR * 2);
constexpr size_t WS_KRB = WS_SSQKV + al((size_t)MP * 4 * 4);
constexpr size_t WS_RQ = WS_KRB + al((size_t)MP * 32 * 2);
constexpr size_t WS_RK = WS_RQ + al((size_t)MP * 512 * 2);
constexpr size_t WS_RKT = WS_RK + al((size_t)MP * 512 * 2);
constexpr size_t WS_RVT = WS_RKT + al((size_t)MP * 512 * 2);
constexpr size_t WS_SRG = WS_RVT + al((size_t)MP * 1024 * 2);
constexpr size_t WS_SGA = WS_SRG + al((size_t)MP * 1024 * 2);
constexpr size_t WS_SGB = WS_SGA + al((size_t)MP * 1024 * 2);
constexpr size_t WS_QA = WS_SGB + al((size_t)MP * 1024 * 2);
constexpr size_t WS_KN = WS_QA + al((size_t)MP * 768 * 2);
constexpr size_t WS_VT = WS_KN + al((size_t)MP * 512 * 2);
constexpr size_t WS_KRF = WS_VT + al((size_t)MP * 512 * 2);
constexpr size_t WS_END2 = WS_KRF + al((size_t)MP * 32 * 4);
constexpr float SC_Q = 0.14724444348433683f;
constexpr float RK_SCALE = 0.08838834764831845f;

constexpr size_t OUT_YP = 0, OUT_YS = OUT_YP + (size_t)NB * SEQ * D, OUT_CKVP = OUT_YS + (size_t)NS * D, OUT_KRP = OUT_CKVP + (size_t)NB * T * KVR,
                 OUT_SRP = OUT_KRP + (size_t)NB * T * 32, OUT_CKVS = OUT_SRP + (size_t)NB * RH * RDK * RDV, OUT_KRS = OUT_CKVS + (size_t)NS * KVR, OUT_SRS = OUT_KRS + (size_t)NS * 32,
                 OUT_END = OUT_SRS + (size_t)NS * RH * RDK * RDV;

__device__ __forceinline__ float row_rscale16(const float* SSQ, int row, float inv_n) { return 1.0f / sqrtf(SSQ[row] * inv_n + EPS); }
__device__ __forceinline__ float row_rscale8(const float* SSQ, int row, float inv_n) {
    const f32x4* p = (const f32x4*)(SSQ + (size_t)row * 8); const f32x4 a = p[0], b = p[1];
    return 1.0f / sqrtf((((a[0] + a[1]) + (a[2] + a[3])) + ((b[0] + b[1]) + (b[2] + b[3]))) * inv_n + EPS);
}
__device__ __forceinline__ float row_rscale4(const float* SSQ, int row, float inv_n) {
    const f32x4 a = *(const f32x4*)(SSQ + (size_t)row * 4);
    return 1.0f / sqrtf(((a[0] + a[1]) + (a[2] + a[3])) * inv_n + EPS);
}
__device__ __forceinline__ u32x2 pack4(const f32x4 v) { u32x2 w; w.x = pg8::cvt_pk_bf16(v[0], v[1]); w.y = pg8::cvt_pk_bf16(v[2], v[3]); return w; }
__device__ __forceinline__ float ssq4(const f32x4 v) { return (v[0] * v[0] + v[1] * v[1]) + (v[2] * v[2] + v[3] * v[3]); }
__device__ __forceinline__ bf16 bf1(float x) { return (bf16)f2bf(x); }

static_assert(WS_END2 < ((size_t)1 << 31), "32-bit workspace offsets");
__device__ __forceinline__ void tr_store16(LAS unsigned char* T, int fr, int fq, int lane, const f32x4 (&v)[4], unsigned char* w, unsigned dst_off) {
#pragma unroll
    for (int m = 0; m < 4; ++m)
#pragma unroll
        for (int j = 0; j < 4; ++j) *(LAS bf16*)(T + (4 * fq + j) * 144 + (16 * m + fr) * 2) = bf1(v[m][j]);
    asm volatile("s_waitcnt lgkmcnt(0)" ::: "memory");
#pragma unroll
    for (int k = 0; k < 2; ++k) { const int id = lane + 64 * k, c = id >> 3, part = id & 7; const v4u x = *(const LAS v4u*)(T + c * 144 + part * 16); *at<v4u>(w, dst_off + (unsigned)(((c >> 2) * 8 + (c & 3)) * MP + 8 * part) * 2u) = x; }
    asm volatile("s_waitcnt lgkmcnt(0)" ::: "memory");
}
constexpr int EPI_LDS_OFF = RING_BYTES, EPI_LDS_WAVE = 3072;
static_assert(EPI_LDS_OFF + 8 * EPI_LDS_WAVE <= SCR_BYTES && 16 * 144 <= EPI_LDS_WAVE, "epilogue LDS scratch");
__device__ __forceinline__ u32x4 pack8(const f32x4 a, const f32x4 b) { u32x4 w; w.x = pg8::cvt_pk_bf16(a[0], a[1]); w.y = pg8::cvt_pk_bf16(a[2], a[3]); w.z = pg8::cvt_pk_bf16(b[0], b[1]); w.w = pg8::cvt_pk_bf16(b[2], b[3]); return w; }
struct EpiWin {
    static constexpr bool PERM = true, AFTER_DRAIN = false;
    unsigned char* ws_; LAS unsigned char* lds_;
#define MK_WS(var) unsigned char* var = opaque_g(ws_)
#define MK_ROWS_BEGIN _Pragma("unroll") for (int ai = 0; ai < 2; ++ai) _Pragma("unroll") for (int m = 0; m < 4; ++m) { \
        unsigned row = row0 + ai * HALF + m * 16; asm volatile("" : "+v"(row)); const float r = rsc[ai * 4 + m];
#define MK_ROWS_END asm volatile("" ::: "memory"); }
    __device__ __forceinline__ void operator()(const f32x4 (&acc)[2][2][4][2], const Unit& u, int wr, int wc, int fr, int fq) const {
        int l_ = lane_fresh(); asm volatile("" : "+v"(l_)); fr = l_ & 15; fq = l_ >> 4;
        const unsigned row0 = u.pm * BM + wr * 64 + fr; const int pn = u.pn;
        const unsigned c8 = wc * 32 + 8 * fq;
        MK_WS(w);
        float rsc[8];
#pragma unroll
        for (int k = 0; k < 8; ++k) rsc[k] = row_rscale16(at<const float>(w, (unsigned)WS_SSQH), (int)(row0 + (k >> 2) * HALF + (k & 3) * 16), 1.f / D);
        if (pn == 0) {
            MK_ROWS_BEGIN
                float ss = 0.f;
#pragma unroll
                for (int bj = 0; bj < 2; ++bj) { const f32x4 v0 = acc[ai][bj][m][0] * r, v1 = acc[ai][bj][m][1] * r; ss += ssq4(v0) + ssq4(v1); *at<u32x4>(w, (unsigned)WS_CQ + (row * QR + bj * HALF + c8) * 2) = pack8(v0, v1); }
                ss += lx(ss, l_, 16); ss += lx(ss, l_, 32);
                if (fq == 0) *at<float>(w, (unsigned)WS_SSQCQ + (row * 8 + wc) * 4) = ss;
            MK_ROWS_END
        } else if (pn == 1) {
            MK_ROWS_BEGIN
                const f32x4 v0 = acc[ai][0][m][0] * r, v1 = acc[ai][0][m][1] * r;
                float ss = ssq4(v0) + ssq4(v1);
                *at<u32x4>(w, (unsigned)WS_CQ + (row * QR + 256 + c8) * 2) = pack8(v0, v1);
                ss += lx(ss, l_, 16); ss += lx(ss, l_, 32);
                if (fq == 0) *at<float>(w, (unsigned)WS_SSQCQ + (row * 8 + 4 + wc) * 4) = ss;
                if (wc == 0) {
                    const f32x4 a0 = acc[ai][1][m][0] * r, a1 = acc[ai][1][m][1] * r;
                    f32x4 p0, p1;
#pragma unroll
                    for (int j = 0; j < 4; ++j) { p0[j] = lx(a0[j], l_, 32); p1[j] = lx(a1[j], l_, 32); }
                    const unsigned pi = row_pidx((int)row), i0 = 8 * (fq & 1);
                    const f32x4 c0 = *at<const f32x4>(w, (unsigned)(WS_TAB + TAB_C16) + (pi * 16 + i0) * 4), c1 = *at<const f32x4>(w, (unsigned)(WS_TAB + TAB_C16) + (pi * 16 + i0 + 4) * 4);
                    const f32x4 s0 = *at<const f32x4>(w, (unsigned)(WS_TAB + TAB_S16) + (pi * 16 + i0) * 4), s1 = *at<const f32x4>(w, (unsigned)(WS_TAB + TAB_S16) + (pi * 16 + i0 + 4) * 4);
                    const f32x4 y0 = fq < 2 ? a0 * c0 - p0 * s0 : p0 * s0 + a0 * c0, y1 = fq < 2 ? a1 * c1 - p1 * s1 : p1 * s1 + a1 * c1;
                    *at<u32x4>(w, (unsigned)WS_KRB + (row * 32 + 8 * fq) * 2) = pack8(y0, y1);
                    *at<f32x4>(w, (unsigned)WS_KRF + (row * 32 + 8 * fq) * 4) = y0; *at<f32x4>(w, (unsigned)WS_KRF + (row * 32 + 8 * fq + 4) * 4) = y1;
                }
            MK_ROWS_END
        } else if (pn == 2) {
            MK_ROWS_BEGIN
                float ss = 0.f;
#pragma unroll
                for (int bj = 0; bj < 2; ++bj) { const f32x4 v0 = acc[ai][bj][m][0] * r, v1 = acc[ai][bj][m][1] * r; ss += ssq4(v0) + ssq4(v1); const unsigned e = row * KVR + bj * HALF + c8;
                    *at<f32x4>(w, (unsigned)WS_CKVF + e * 4) = v0; *at<f32x4>(w, (unsigned)WS_CKVF + (e + 4) * 4) = v1; *at<u32x4>(w, (unsigned)WS_CKVB + e * 2) = pack8(v0, v1); }
                ss += lx(ss, l_, 16); ss += lx(ss, l_, 32);
                if (fq == 0) *at<float>(w, (unsigned)WS_SSQKV + (row * 4 + wc) * 4) = ss;
            MK_ROWS_END
        } else if (pn < 7) {
            const bool isk = pn >= 5; const unsigned hh = 2 * ((pn - 3) & 1) + (wc >> 1), i0 = 32 * (wc & 1) + 8 * fq;
            const unsigned dbase = (unsigned)(isk ? WS_RK : WS_RQ) + hh * 256, gbase = (unsigned)(WS_TAB + (isk ? TAB_GN : TAB_GP)) + hh * 512;
            LAS unsigned char* T = lds_ + EPI_LDS_OFF + (wr * 4 + wc) * EPI_LDS_WAVE;
#pragma unroll
            for (int ai = 0; ai < 2; ++ai) {
                f32x4 y1s[2][4], y2s[2][4];
#pragma unroll
                for (int m = 0; m < 4; ++m) {
                    unsigned row = row0 + ai * HALF + m * 16; asm volatile("" : "+v"(row)); const float r = rsc[ai * 4 + m];
                    const unsigned pi = row_pidx((int)row), jt = row_jtok((int)row);
                    const float mult = *at<const float>(w, gbase + jt * 4) * (isk ? RK_SCALE : 1.f);
#pragma unroll
                    for (int n = 0; n < 2; ++n) {
                        const f32x4 x1 = acc[ai][0][m][n] * r, x2 = acc[ai][1][m][n] * r;
                        const f32x4 c = *at<const f32x4>(w, (unsigned)(WS_TAB + TAB_C64) + (pi * 64 + i0 + 4 * n) * 4), s = *at<const f32x4>(w, (unsigned)(WS_TAB + TAB_S64) + (pi * 64 + i0 + 4 * n) * 4);
                        y1s[n][m] = (x1 * c - x2 * s) * mult; y2s[n][m] = (x1 * s + x2 * c) * mult; }
                    *at<u32x4>(w, dbase + (row * 512 + i0) * 2) = pack8(y1s[0][m], y1s[1][m]); *at<u32x4>(w, dbase + (row * 512 + 64 + i0) * 2) = pack8(y2s[0][m], y2s[1][m]);
                    asm volatile("" ::: "memory");
                }
                if (isk) {
                    const unsigned rb = u.pm * BM + ai * HALF + wr * 64, cb = hh * 128 + 32 * (wc & 1);
#pragma unroll
                    for (int n = 0; n < 2; ++n) {
                        tr_store16(T, fr, fq, l_, y1s[n], w, (unsigned)WS_RKT + ((cb + 4 * n) * MP + rb) * 2u); tr_store16(T, fr, fq, l_, y2s[n], w, (unsigned)WS_RKT + ((cb + 64 + 4 * n) * MP + rb) * 2u); }
                }
            }
        } else if (pn < 11) {
            LAS unsigned char* T = lds_ + EPI_LDS_OFF + (wr * 4 + wc) * EPI_LDS_WAVE;
#pragma unroll
            for (int ai = 0; ai < 2; ++ai) {
                const unsigned rb = u.pm * BM + ai * HALF + wr * 64;
#pragma unroll
                for (int bj = 0; bj < 2; ++bj)
#pragma unroll
                    for (int n = 0; n < 2; ++n) { f32x4 vv[4];
#pragma unroll
                        for (int m = 0; m < 4; ++m) vv[m] = acc[ai][bj][m][n] * rsc[ai * 4 + m];
                        tr_store16(T, fr, fq, l_, vv, w, (unsigned)WS_RVT + (((pn - 7) * 256 + bj * HALF + wc * 32 + 4 * n) * MP + rb) * 2u); }
                asm volatile("" ::: "memory");
            }
        } else {
            const int t = (pn - 11) >> 2; const unsigned dbase = (unsigned)WS_SRG + (unsigned)t * (unsigned)(WS_SGA - WS_SRG) + (((pn - 11) & 3) * 256 + c8) * 2;
            MK_ROWS_BEGIN
#pragma unroll
                for (int bj = 0; bj < 2; ++bj) { const f32x4 v0 = acc[ai][bj][m][0] * r, v1 = acc[ai][bj][m][1] * r; f32x4 o0, o1;
#pragma unroll
                    for (int j = 0; j < 4; ++j) { const float g0 = fast_sigmoid(v0[j]), g1 = fast_sigmoid(v1[j]); o0[j] = t == 0 ? v0[j] * g0 : g0; o1[j] = t == 0 ? v1[j] * g1 : g1; }
                    *at<u32x4>(w, dbase + (row * 1024 + bj * HALF) * 2) = pack8(o0, o1); }
            MK_ROWS_END
        }
    }
};
static_assert(WS_SGB - WS_SGA == WS_SGA - WS_SRG, "gate arrays equally spaced");
struct EpiQ {
    static constexpr bool PERM = false, AFTER_DRAIN = false;
    unsigned char* ws;
    __device__ __forceinline__ void operator()(const f32x4 (&acc)[2][2][4][2], const Unit& u, int wr, int wc, int fr, int fq) const {
        int l_ = lane_fresh(); asm volatile("" : "+v"(l_)); fr = l_ & 15; fq = l_ >> 4;
        const float* SSQCQ = (const float*)(ws + WS_SSQCQ); bf16* QA = (bf16*)(ws + WS_QA); const float* TAB = (const float*)(ws + WS_TAB);
        const int row0 = u.pm * BM + wr * 64 + fr;
#pragma unroll
        for (int ai = 0; ai < 2; ++ai)
#pragma unroll
            for (int m = 0; m < 4; ++m) {
                int row = row0 + ai * HALF + m * 16; asm volatile("" : "+v"(row));
                const float r = row_rscale8(SSQCQ, row, 1.f / QR) * SC_Q;
#pragma unroll
                for (int bj = 0; bj < 2; ++bj) {
                    const int grp = 8 * u.pn + 4 * bj + wc;
                    bf16* dst = QA + (size_t)row * 768 + 32 * grp + 4 * fq;
                    const bool rope = (grp % 3) == 2;
                    const int pi = row_pidx(row);
                    f32x4 c = *(const f32x4*)(TAB + TAB_C16 / 4 + pi * 16 + 4 * fq), s = *(const f32x4*)(TAB + TAB_S16 / 4 + pi * 16 + 4 * fq);
                    if (!rope) { c = (f32x4){1.f, 1.f, 1.f, 1.f}; s = (f32x4){0.f, 0.f, 0.f, 0.f}; }
                    const f32x4 x1 = acc[ai][bj][m][0] * r, x2 = acc[ai][bj][m][1] * r;
                    *(u32x2*)dst = pack4(x1 * c - x2 * s); *(u32x2*)(dst + 16) = pack4(x1 * s + x2 * c);
                }
                asm volatile("" ::: "memory");
            }
    }
};
template <bool ROWS> struct EpiScaleBf16 {
    static constexpr bool PERM = true, AFTER_DRAIN = false;
    const float* SSQKV; bf16* O; int ldc;
    __device__ __forceinline__ void operator()(const f32x4 (&acc)[2][2][4][2], const Unit& u, int wr, int wc, int fr, int fq) const {
        int l_ = lane_fresh(); asm volatile("" : "+v"(l_)); fr = l_ & 15; fq = l_ >> 4;
        const int row0 = u.pm * BM + wr * 64 + fr, col0 = u.pn * BM + wc * 32 + 8 * fq;
        float cs[2][8];
        if (!ROWS) {
#pragma unroll
            for (int bj = 0; bj < 2; ++bj)
#pragma unroll
                for (int k = 0; k < 8; ++k) cs[bj][k] = row_rscale4(SSQKV, col0 + bj * HALF + k, 1.f / KVR);
        }
#pragma unroll
        for (int ai = 0; ai < 2; ++ai)
#pragma unroll
            for (int m = 0; m < 4; ++m) { int row = row0 + ai * HALF + m * 16; asm volatile("" : "+v"(row)); const float r = ROWS ? row_rscale4(SSQKV, row, 1.f / KVR) : 1.f;
#pragma unroll
                for (int bj = 0; bj < 2; ++bj) { f32x4 v0 = acc[ai][bj][m][0], v1 = acc[ai][bj][m][1];
                    if (ROWS) { v0 = v0 * r; v1 = v1 * r; }
                    else {
#pragma unroll
                        for (int j = 0; j < 4; ++j) { v0[j] *= cs[bj][j]; v1[j] *= cs[bj][4 + j]; } }
                    u32x4 w; w.x = pg8::cvt_pk_bf16(v0[0], v0[1]); w.y = pg8::cvt_pk_bf16(v0[2], v0[3]); w.z = pg8::cvt_pk_bf16(v1[0], v1[1]); w.w = pg8::cvt_pk_bf16(v1[2], v1[3]);
                    *(u32x4*)(O + (size_t)row * ldc + col0 + bj * HALF) = w; } }
    }
};
__device__ __forceinline__ void finalize_ckv(Frame& F, const Ptrs& a) {
    const int lane = fresh_tid(F.wave) & 63;
    const int gw = F.vcu * NWAVES + F.wave, NGW = F.G * NWAVES;
    const float* CKVF = (const float*)(a.ws + WS_CKVF); const float* SSQKV = (const float*)(a.ws + WS_SSQKV); const float* KRF = (const float*)(a.ws + WS_KRF);
    const f32x4 g = *((const f32x4*)a.in(14) + lane);
    for (int row = gw; row < ROW_PAD; row += NGW) {
        const float r = row_rscale4(SSQKV, row, 1.f / KVR);
        const f32x4 o = *((const f32x4*)(CKVF + (size_t)row * KVR) + lane) * r * g;
        const f32x4 kr = *((const f32x4*)(KRF + (size_t)row * 32) + (lane & 7));
        if (row < MMAIN) { const size_t t = (size_t)(row >> 11) * T + NMETA + (row & (SEQ - 1)); *((f32x4*)(a.out() + OUT_CKVP + t * KVR) + lane) = o; if (lane < 8) *((f32x4*)(a.out() + OUT_KRP + t * 32) + lane) = kr; }
        else if (row < ROW_SMP) { for (int b = 0; b < NB; ++b) { const size_t t = (size_t)b * T + (row - ROW_META); *((f32x4*)(a.out() + OUT_CKVP + t * KVR) + lane) = o; if (lane < 8) *((f32x4*)(a.out() + OUT_KRP + t * 32) + lane) = kr; } }
        else { *((f32x4*)(a.out() + OUT_CKVS + (size_t)(row - ROW_SMP) * KVR) + lane) = o; if (lane < 8) *((f32x4*)(a.out() + OUT_KRS + (size_t)(row - ROW_SMP) * 32) + lane) = kr; }
    }
}
}
namespace mk {
constexpr size_t WS_AV = WS_END2;
constexpr size_t WS_END3 = WS_AV + al((size_t)MP * 512 * 2);
typedef float f32x16 __attribute__((ext_vector_type(16)));
constexpr int AT_KSTR = 208, AT_VSTR = 144, AT_KBUF = 64 * AT_KSTR, AT_VBUF = 64 * AT_VSTR, AT_VOFF = 2 * AT_KBUF;
__device__ __forceinline__ int crow(int i, int half) { return (i & 3) + 8 * (i >> 2) + 4 * half; }

__device__ __forceinline__ void attn_unit(Frame& F, unsigned char* ws, int b, int h, int qb) {
    ws = opaque_g(ws);
    const int tid = fresh_tid(F.wave), lane = tid & 63, w = F.wave, q = lane & 31, half = lane >> 5;
    LAS unsigned char* L = F.lds + RING_OFF;
    const bf16* QA = (const bf16*)(ws + WS_QA); const bf16* KN = (const bf16*)(ws + WS_KN); const bf16* KRB = (const bf16*)(ws + WS_KRB); const bf16* VT = (const bf16*)(ws + WS_VT);
    const int qrow = b * SEQ + qb * 256 + w * 32 + q, q_main = qb * 256 + w * 32 + q, wq0 = qb * 256 + w * 32;
    bf16x8 qf[6];
#pragma unroll
    for (int s = 0; s < 6; ++s) qf[s] = *(const bf16x8*)(QA + (size_t)qrow * 768 + h * 96 + 16 * s + 8 * half);
    f32x16 ot[2];
#pragma unroll
    for (int i = 0; i < 16; ++i) { ot[0][i] = 0.f; ot[1][i] = 0.f; }
    float m = -INFINITY, l = 0.f;
    const int NT = 4 * (qb + 1);
    v4u kreg, rreg, vreg; rreg = (v4u){0u, 0u, 0u, 0u};
#define AT_LOAD(tt) do { const int t0_ = (tt) == 0 ? ROW_META : b * SEQ + 64 * ((tt) - 1); \
        kreg = *(const v4u*)(KN + (size_t)(t0_ + (tid >> 3)) * 512 + h * 64 + (tid & 7) * 8); \
        if (tid < 256) rreg = *(const v4u*)(KRB + (size_t)(t0_ + (tid >> 2)) * 32 + (tid & 3) * 8); \
        vreg = *(const v4u*)(VT + (size_t)(h * 64 + (tid >> 3)) * MP + t0_ + (tid & 7) * 8); } while (0)
#define AT_STORE(buf) do { LAS unsigned char* kb_ = L + (buf) * AT_KBUF; \
        *(LAS v4u*)(kb_ + (tid >> 3) * AT_KSTR + (tid & 7) * 16) = kreg; \
        if (tid < 256) *(LAS v4u*)(kb_ + (tid >> 2) * AT_KSTR + 128 + (tid & 3) * 16) = rreg; \
        LAS unsigned char* vb_ = L + AT_VOFF + (buf) * AT_VBUF + (tid >> 3) * AT_VSTR + (32 * ((tid & 7) >> 1) + 8 * (tid & 1)); \
        *(LAS u32x2*)(vb_) = (u32x2){vreg.x, vreg.y}; *(LAS u32x2*)(vb_ + 16) = (u32x2){vreg.z, vreg.w}; } while (0)
    AT_LOAD(0); AT_STORE(0);
    __syncthreads();
    for (int tt = 0; tt <= NT; ++tt) {
        const int buf = tt & 1;
        if (tt < NT) AT_LOAD(tt + 1);
        const int kmin = tt == 0 ? 0 : 64 * (tt - 1);
        if (tt == 0 || kmin <= wq0 + 31) {
            const LAS unsigned char* Kb = L + buf * AT_KBUF + q * AT_KSTR + 16 * half;
            const LAS unsigned char* Vb = L + AT_VOFF + buf * AT_VBUF + q * AT_VSTR + 16 * half;
            f32x16 st[2];
#pragma unroll
            for (int kb = 0; kb < 2; ++kb) {
#pragma unroll
                for (int i = 0; i < 16; ++i) st[kb][i] = 0.f;
#pragma unroll
                for (int s = 0; s < 6; ++s) { const bf16x8 kf = *(const LAS bf16x8*)(Kb + kb * 32 * AT_KSTR + 32 * s); st[kb] = __builtin_amdgcn_mfma_f32_32x32x16_bf16(kf, qf[s], st[kb], 0, 0, 0); }
            }
            if (tt == 0) {
#pragma unroll
                for (int kb = 0; kb < 2; ++kb)
#pragma unroll
                    for (int i = 0; i < 16; ++i) if (32 * kb + crow(i, half) >= NMETA) st[kb][i] = -INFINITY;
            } else if (kmin + 63 > wq0) {
#pragma unroll
                for (int kb = 0; kb < 2; ++kb)
#pragma unroll
                    for (int i = 0; i < 16; ++i) if (kmin + 32 * kb + crow(i, half) > q_main) st[kb][i] = -INFINITY;
            }
            float mx = st[0][0];
#pragma unroll
            for (int i = 1; i < 16; ++i) mx = fmaxf(mx, st[0][i]);
#pragma unroll
            for (int i = 0; i < 16; ++i) mx = fmaxf(mx, st[1][i]);
            mx = fmaxf(mx, lx(mx, lane, 32));
            const float mn = fmaxf(m, mx), alpha = __builtin_amdgcn_exp2f(m - mn);
            m = mn;
            float ps = 0.f;
#pragma unroll
            for (int kb = 0; kb < 2; ++kb)
#pragma unroll
                for (int i = 0; i < 16; ++i) { st[kb][i] = __builtin_amdgcn_exp2f(st[kb][i] - mn); ps += st[kb][i]; }
            l = l * alpha + ps;
#pragma unroll
            for (int i = 0; i < 16; ++i) { ot[0][i] *= alpha; ot[1][i] *= alpha; }
#pragma unroll
            for (int kb = 0; kb < 2; ++kb)
#pragma unroll
                for (int s2 = 0; s2 < 2; ++s2) {
                    u32x4 pw; pw.x = pg8::cvt_pk_bf16(st[kb][8 * s2 + 0], st[kb][8 * s2 + 1]); pw.y = pg8::cvt_pk_bf16(st[kb][8 * s2 + 2], st[kb][8 * s2 + 3]);
                    pw.z = pg8::cvt_pk_bf16(st[kb][8 * s2 + 4], st[kb][8 * s2 + 5]); pw.w = pg8::cvt_pk_bf16(st[kb][8 * s2 + 6], st[kb][8 * s2 + 7]);
                    const bf16x8 pf = __builtin_bit_cast(bf16x8, pw);
#pragma unroll
                    for (int vb = 0; vb < 2; ++vb) { const bf16x8 vf = *(const LAS bf16x8*)(Vb + vb * 32 * AT_VSTR + (32 * kb + 16 * s2) * 2); ot[vb] = __builtin_amdgcn_mfma_f32_32x32x16_bf16(vf, pf, ot[vb], 0, 0, 0); }
                }
        }
        if (tt < NT) AT_STORE(buf ^ 1);
        __syncthreads();
    }
#undef AT_LOAD
#undef AT_STORE
    l += lx(l, lane, 32);
    const float inv = 1.0f / l;
    bf16* AV = (bf16*)(ws + WS_AV) + (size_t)qrow * 512 + h * 64 + 4 * half;
#pragma unroll
    for (int vb = 0; vb < 2; ++vb)
#pragma unroll
        for (int g = 0; g < 4; ++g) { f32x4 o; o[0] = ot[vb][4 * g] * inv; o[1] = ot[vb][4 * g + 1] * inv; o[2] = ot[vb][4 * g + 2] * inv; o[3] = ot[vb][4 * g + 3] * inv; *(u32x2*)(AV + 32 * vb + 8 * g) = pack4(o); }
}
__device__ __forceinline__ void attn_item(Frame& F, unsigned char* ws, int i) { const int bh = i & 63; attn_unit(F, ws, bh >> 3, bh & 7, 7 - (i >> 6)); }
__device__ __forceinline__ void attn_phase(Frame& F, unsigned char* ws) {
    const int c = F.vcu;
    if (c >= 256) return;
    const int bh = c >> 2, p = c & 3;
    attn_unit(F, ws, bh >> 3, bh & 7, 7 - p);
    attn_unit(F, ws, bh >> 3, bh & 7, p);
}
}
namespace mk {
constexpr size_t WS_UMETA = WS_END3;
constexpr size_t WS_UT = WS_UMETA + al((size_t)RH * RDV * RDK * 4);
constexpr size_t WS_SPREV = WS_UT + al((size_t)32 * 16 * RDV * RDK * 4);
constexpr size_t WS_RIN = WS_SPREV + al((size_t)32 * 16 * RDV * RDK * 2);
constexpr size_t WS_DPART = WS_RIN + al((size_t)MP * 1024 * 2);
constexpr size_t WS_QL = WS_DPART + al((size_t)32 * 16 * 8 * 264 * 4);
constexpr size_t WS_END4 = WS_QL + al((size_t)64 * 2048 * 4);
static_assert(WS_END4 < ((size_t)1 << 31), "32-bit workspace offsets");
__device__ __forceinline__ float gpow_t(const unsigned char* ws, int h, int n) { return ((const float*)(ws + WS_TAB + TAB_GP))[h * 128 + n]; }

__device__ __forceinline__ void ret_u_unit(Frame& F, unsigned char* ws, int u) {
    ws = opaque_g(ws);
    const int tid = fresh_tid(F.wave), lane = tid & 63, w = F.wave, r32 = lane & 31, half = lane >> 5;
    const bool meta = u >= 512; const int hh = meta ? u - 512 : (u >> 4) & 3;
    const int tok0 = meta ? ROW_META : (u >> 6) * SEQ + (u & 15) * 128, nks = meta ? 1 : 8;
    const bf16* RVT = (const bf16*)(ws + WS_RVT); const bf16* RKT = (const bf16*)(ws + WS_RKT);
    f32x16 acc[4];
#pragma unroll
    for (int db = 0; db < 4; ++db)
#pragma unroll
        for (int i = 0; i < 16; ++i) acc[db][i] = 0.f;
    const bf16* ap = RVT + (size_t)(hh * 256 + 32 * w + r32) * MP + tok0 + 8 * half;
    const bf16* bp = RKT + (size_t)(hh * 128 + r32) * MP + tok0 + 8 * half;
    for (int s = 0; s < nks; ++s) {
        const bf16x8 af = *(const bf16x8*)(ap + 16 * s);
#pragma unroll
        for (int db = 0; db < 4; ++db) { const bf16x8 bf = *(const bf16x8*)(bp + (size_t)(32 * db) * MP + 16 * s); acc[db] = __builtin_amdgcn_mfma_f32_32x32x16_bf16(af, bf, acc[db], 0, 0, 0); }
    }
    const float sc = gpow_t(ws, hh, meta ? NMETA - 1 : 127);
    float* dst = meta ? (float*)(ws + WS_UMETA) + (size_t)hh * RDV * RDK : (float*)(ws + WS_UT) + (size_t)u * RDV * RDK;
#pragma unroll
    for (int db = 0; db < 4; ++db)
#pragma unroll
        for (int i = 0; i < 16; ++i) dst[(size_t)(32 * w + crow(i, half)) * RDK + 32 * db + r32] = acc[db][i] * sc;
}
__device__ __forceinline__ void ret_scan(Frame& F, const Ptrs& a) {
    const int tid = fresh_tid(F.wave);
    const int gt = (F.vcu * NWAVES * 64) + tid, NGT = F.G * NWAVES * 64;
    const float* UM = (const float*)(a.ws + WS_UMETA); const float* UT = (const float*)(a.ws + WS_UT); bf16* SP = (bf16*)(a.ws + WS_SPREV);
    for (int e = gt; e < 32 * RDV * RDK; e += NGT) {
        const int bh = e >> 15, idx = e & 32767, hh = bh & 3;
        const float g128 = gpow_t(a.ws, hh, 127) * gpow_t(a.ws, hh, 1);
        float S = UM[(size_t)hh * 32768 + idx];
        for (int c = 0; c < 16; ++c) { const size_t o = ((size_t)bh * 16 + c) * 32768 + idx; SP[o] = bf1(S); S = g128 * S + UT[o]; }
        const int ee = idx >> 7, d = idx & 127;
        a.out()[OUT_SRP + ((size_t)bh * RDK + d) * RDV + ee] = S;
    }
}
__device__ __forceinline__ void ret_o_unit(Frame& F, const Ptrs& a, int u) {
    unsigned char* ws = a.ws; ws = opaque_g(ws);
    const int tid = fresh_tid(F.wave), lane = tid & 63, w = F.wave, r32 = lane & 31, half = lane >> 5;
    const int bh = u >> 4, c = u & 15, hh = bh & 3, tok0 = (bh >> 2) * SEQ + c * 128;
    const int ib = w & 3, eh = w >> 2;
    LAS float* red = (LAS float*)(F.lds + RING_OFF);
    const bf16* RQ = (const bf16*)(ws + WS_RQ); const bf16* RK = (const bf16*)(ws + WS_RK); const bf16* RVT = (const bf16*)(ws + WS_RVT);
    const bf16* SP = (const bf16*)(ws + WS_SPREV) + (size_t)u * 32768;
    const int irow = tok0 + 32 * ib + r32;
    bf16x8 qf[8];
#pragma unroll
    for (int s = 0; s < 8; ++s) qf[s] = *(const bf16x8*)(RQ + (size_t)irow * 512 + hh * 128 + 16 * s + 8 * half);
    f32x16 ot[4];
#pragma unroll
    for (int eb = 0; eb < 4; ++eb) {
#pragma unroll
        for (int i = 0; i < 16; ++i) ot[eb][i] = 0.f;
        const bf16* sp = SP + (size_t)(128 * eh + 32 * eb + r32) * RDK + 8 * half;
#pragma unroll
        for (int s = 0; s < 8; ++s) { const bf16x8 sf = *(const bf16x8*)(sp + 16 * s); ot[eb] = __builtin_amdgcn_mfma_f32_32x32x16_bf16(sf, qf[s], ot[eb], 0, 0, 0); }
    }
    const float g = gpow_t(ws, hh, 1);
#pragma unroll
    for (int eb = 0; eb < 4; ++eb)
#pragma unroll
        for (int i = 0; i < 16; ++i) ot[eb][i] *= g;
    for (int jb = 0; jb <= ib; ++jb) {
        f32x16 at;
#pragma unroll
        for (int i = 0; i < 16; ++i) at[i] = 0.f;
        const bf16* kp = RK + (size_t)(tok0 + 32 * jb + r32) * 512 + hh * 128 + 8 * half;
#pragma unroll
        for (int s = 0; s < 8; ++s) { const bf16x8 kf = *(const bf16x8*)(kp + 16 * s); at = __builtin_amdgcn_mfma_f32_32x32x16_bf16(kf, qf[s], at, 0, 0, 0); }
        if (jb == ib) {
#pragma unroll
            for (int i = 0; i < 16; ++i) if (crow(i, half) > r32) at[i] = 0.f;
        }
#pragma unroll
        for (int s2 = 0; s2 < 2; ++s2) {
            u32x4 pw; pw.x = pg8::cvt_pk_bf16(at[8 * s2 + 0], at[8 * s2 + 1]); pw.y = pg8::cvt_pk_bf16(at[8 * s2 + 2], at[8 * s2 + 3]);
            pw.z = pg8::cvt_pk_bf16(at[8 * s2 + 4], at[8 * s2 + 5]); pw.w = pg8::cvt_pk_bf16(at[8 * s2 + 6], at[8 * s2 + 7]);
            const bf16x8 pf = __builtin_bit_cast(bf16x8, pw);
#pragma unroll
            for (int eb = 0; eb < 4; ++eb) {
                const bf16* vp = RVT + (size_t)(hh * 256 + 128 * eh + 32 * eb + r32) * MP + tok0 + 32 * jb + 16 * s2 + 4 * half;
                const u32x2 lo = *(const u32x2*)vp, hi = *(const u32x2*)(vp + 8);
                u32x4 vw; vw.x = lo.x; vw.y = lo.y; vw.z = hi.x; vw.w = hi.y;
                ot[eb] = __builtin_amdgcn_mfma_f32_32x32x16_bf16(__builtin_bit_cast(bf16x8, vw), pf, ot[eb], 0, 0, 0);
            }
        }
    }
    float s1 = 0.f;
#pragma unroll
    for (int eb = 0; eb < 4; ++eb)
#pragma unroll
        for (int i = 0; i < 16; ++i) s1 += ot[eb][i];
    s1 += lx(s1, lane, 32);
    if (half == 0) red[w * 32 + r32] = s1;
    __syncthreads();
    const float mu = (red[w * 32 + r32] + red[(w ^ 4) * 32 + r32]) * (1.f / 256.f);
    float s2 = 0.f;
#pragma unroll
    for (int eb = 0; eb < 4; ++eb)
#pragma unroll
        for (int i = 0; i < 16; ++i) { ot[eb][i] -= mu; s2 += ot[eb][i] * ot[eb][i]; }
    s2 += lx(s2, lane, 32);
    if (half == 0) red[256 + w * 32 + r32] = s2;
    __syncthreads();
    const float rstd = 1.0f / sqrtf((red[256 + w * 32 + r32] + red[256 + (w ^ 4) * 32 + r32]) * (1.f / 256.f) + EPS);
    __syncthreads();
    const bf16* SRG = (const bf16*)(ws + WS_SRG) + (size_t)irow * 1024 + hh * 256 + 128 * eh + 4 * half;
    bf16* RIN = (bf16*)(ws + WS_RIN) + (size_t)irow * 1024 + hh * 256 + 128 * eh + 4 * half;
    const float* gn = a.in(19) + hh * 256 + 128 * eh + 4 * half;
#pragma unroll
    for (int eb = 0; eb < 4; ++eb)
#pragma unroll
        for (int gq = 0; gq < 4; ++gq) {
            const int eo = 32 * eb + 8 * gq;
            const u32x2 sg = *(const u32x2*)(SRG + eo); const f32x4 gv = *(const f32x4*)(gn + eo);
            f32x4 o;
            o[0] = ot[eb][4 * gq + 0] * rstd * gv[0] * __uint_as_float(sg.x << 16); o[1] = ot[eb][4 * gq + 1] * rstd * gv[1] * __uint_as_float(sg.x & 0xffff0000u);
            o[2] = ot[eb][4 * gq + 2] * rstd * gv[2] * __uint_as_float(sg.y << 16); o[3] = ot[eb][4 * gq + 3] * rstd * gv[3] * __uint_as_float(sg.y & 0xffff0000u);
            *(u32x2*)(RIN + eo) = pack4(o);
        }
}
__device__ __forceinline__ void ret_sample_unit(Frame& F, const Ptrs& a, int u) {
    unsigned char* ws = a.ws; ws = opaque_g(ws);
    const int tid = fresh_tid(F.wave), lane = tid & 63, s = u >> 2, hh = u & 3, e = tid & 255, dh = tid >> 8, row = ROW_SMP + s;
    LAS float* sh = (LAS float*)(F.lds + RING_OFF);
    const bf16* RQ = (const bf16*)(ws + WS_RQ); const bf16* RK = (const bf16*)(ws + WS_RK); const bf16* RVT = (const bf16*)(ws + WS_RVT);
    if (tid < 128) sh[tid] = __uint_as_float((unsigned)RQ[(size_t)row * 512 + hh * 128 + tid] << 16);
    else if (tid < 256) sh[tid] = __uint_as_float((unsigned)RK[(size_t)row * 512 + hh * 128 + tid - 128] << 16);
    __syncthreads();
    const float v = __uint_as_float((unsigned)RVT[(size_t)(hh * 256 + e) * MP + row] << 16);
    const float g = gpow_t(ws, hh, 1);
    const float* S0 = a.in(4) + ((size_t)(s * RH + hh) * RDK) * RDV + e;
    float* S1 = a.out() + OUT_SRS + ((size_t)(s * RH + hh) * RDK) * RDV + e;
    float o = 0.f;
    {   float s0[64];
#pragma unroll
        for (int k = 0; k < 64; ++k) s0[k] = S0[(size_t)(64 * dh + k) * RDV];
#pragma unroll
        for (int k = 0; k < 64; ++k) { const int d = 64 * dh + k; const float sn = g * s0[k] + sh[128 + d] * v; S1[(size_t)d * RDV] = sn; o += sh[d] * sn; } }
    sh[256 + dh * 256 + e] = o;
    __syncthreads();
    o = sh[256 + e] + sh[512 + e];
    float t1 = o;
#pragma unroll
    for (int off = 32; off > 0; off >>= 1) t1 += lx(t1, lane, off);
    if ((tid & 63) == 0) sh[768 + (tid >> 6)] = t1;
    __syncthreads();
    const float mu = (sh[768] + sh[769] + sh[770] + sh[771]) * (1.f / 256.f);
    const float dlt = o - mu;
    float t2 = dlt * dlt;
#pragma unroll
    for (int off = 32; off > 0; off >>= 1) t2 += lx(t2, lane, off);
    if ((tid & 63) == 0) sh[776 + (tid >> 6)] = t2;
    __syncthreads();
    const float rstd = 1.0f / sqrtf((sh[776] + sh[777] + sh[778] + sh[779]) * (1.f / 256.f) + EPS);
    if (dh == 0) { const float sg = __uint_as_float((unsigned)((const bf16*)(ws + WS_SRG))[(size_t)row * 1024 + hh * 256 + e] << 16);
        ((bf16*)(ws + WS_RIN))[(size_t)row * 1024 + hh * 256 + e] = bf1(dlt * rstd * a.in(19)[hh * 256 + e] * sg); }
    __syncthreads();
}
}
namespace mk {
template <int CTRL> __device__ __forceinline__ float dppf(float v) { return __int_as_float(__builtin_amdgcn_update_dpp(0, __float_as_int(v), CTRL, 0xF, 0xF, false)); }
__device__ __forceinline__ float swap32_add(float a, float b) { const auto r = __builtin_amdgcn_permlane32_swap(__float_as_uint(a), __float_as_uint(b), false, false); return __uint_as_float(r[0]) + __uint_as_float(r[1]); }
__device__ __forceinline__ float swap16_add(float a, float b) { const auto r = __builtin_amdgcn_permlane16_swap(__float_as_uint(a), __float_as_uint(b), false, false); return __uint_as_float(r[0]) + __uint_as_float(r[1]); }
__device__ __forceinline__ int dlane_of(int h) { return ((h >> 2) & 1) * 32 + ((h >> 1) & 1) * 16 + (h & 1) * 8; }
__device__ __forceinline__ float swap32_max(float a) { const auto r = __builtin_amdgcn_permlane32_swap(__float_as_uint(a), __float_as_uint(a), false, false); return fmaxf(__uint_as_float(r[0]), __uint_as_float(r[1])); }
__device__ __forceinline__ float swap16_max(float a) { const auto r = __builtin_amdgcn_permlane16_swap(__float_as_uint(a), __float_as_uint(a), false, false); return fmaxf(__uint_as_float(r[0]), __uint_as_float(r[1])); }
__device__ __forceinline__ void decode_unit(Frame& F, const Ptrs& a, int u) {
    unsigned char* ws = a.ws; ws = opaque_g(ws);
    const int tid = fresh_tid(F.wave), lane = tid & 63, w = F.wave, s = u >> 4, sp = u & 15, row = ROW_SMP + s;
    LAS float* sh = (LAS float*)(F.lds + RING_OFF);
    LAS unsigned char* tile = F.lds + RING_OFF + w * 16384;
    LAS unsigned char* qb = F.lds + RING_OFF + 131072;
    { const float* QLr = (const float*)(ws + WS_QL) + (size_t)(row - MMAIN) * 2048; const bf16* QA = (const bf16*)(ws + WS_QA) + (size_t)row * 768;
      for (int e = tid; e < 576; e += 512) { const int ks = e >> 6, n = e & 15, g = (e >> 4) & 3; u32x4 pk = (u32x4){0u, 0u, 0u, 0u};
          if (n < 8) { if (ks < 8) pk = pack8(*(const f32x4*)(QLr + n * 256 + 32 * ks + 4 * g), *(const f32x4*)(QLr + n * 256 + 32 * ks + 16 + 4 * g));
                       else { const u32x2 r0 = *(const u32x2*)(QA + n * 96 + 64 + 4 * g), r1 = *(const u32x2*)(QA + n * 96 + 64 + 16 + 4 * g); pk = (u32x4){r0.x, r0.y, r1.x, r1.y}; } }
          *(LAS u32x4*)(qb + e * 16) = pk; } }
    __syncthreads();
    f32x4 O[8];
#pragma unroll
    for (int h = 0; h < 8; ++h) O[h] = (f32x4){0.f, 0.f, 0.f, 0.f};
    float m = -INFINITY, l = 0.f;
    const int i16 = lane & 15, g4 = lane >> 4;
    const int page = ((const int*)a.in(5))[s * NPAGES + sp * 8 + w];
    const float* ckp = a.in(2) + (size_t)page * PAGE * KVR + i16 * KVR + 4 * g4;
    const float* krp = a.in(3) + (size_t)page * PAGE * 32 + i16 * 32 + 4 * g4;
    LAS unsigned char* twr = tile + i16 * 1024;
    const int swz = i16 & 7;
    f32x4 R[18];
#define DC_PIN() __builtin_amdgcn_sched_barrier(0)
#define DC_LOAD(b_) do { const float* c_ = ckp + (size_t)(b_) * 16 * KVR; const float* r_ = krp + (size_t)(b_) * 16 * 32; \
        _Pragma("unroll") for (int ks = 0; ks < 8; ++ks) { R[2 * ks] = *(const f32x4*)(c_ + 32 * ks); R[2 * ks + 1] = *(const f32x4*)(c_ + 32 * ks + 16); } \
        R[16] = *(const f32x4*)r_; R[17] = *(const f32x4*)(r_ + 16); } while (0)
    DC_LOAD(0); DC_PIN();
#pragma unroll 1
    for (int b = 0; b < 8; ++b) {
        f32x4 S = (f32x4){0.f, 0.f, 0.f, 0.f};
#pragma unroll
        for (int ks = 0; ks < 9; ++ks) { const u32x4 pk = pack8(R[2 * ks], R[2 * ks + 1]); const bf16x8 bq = *(const LAS bf16x8*)(qb + (ks * 64 + lane) * 16);
            S = __builtin_amdgcn_mfma_f32_16x16x32_bf16(__builtin_bit_cast(bf16x8, pk), bq, S, 0, 0, 0); }
#pragma unroll
        for (int ks = 0; ks < 8; ++ks) { *(LAS f32x4*)(twr + (((8 * ks + g4) ^ swz) << 4)) = R[2 * ks]; *(LAS f32x4*)(twr + (((8 * ks + 4 + g4) ^ swz) << 4)) = R[2 * ks + 1]; }
        DC_PIN();
        { const int bn = b < 7 ? b + 1 : 7; DC_LOAD(bn); }
        DC_PIN();
        float mx = fmaxf(fmaxf(S[0], S[1]), fmaxf(S[2], S[3])); mx = swap32_max(mx); mx = swap16_max(mx);
        const float mn = fmaxf(m, mx), alpha = __builtin_amdgcn_exp2f(m - mn); m = mn;
        float pe[4];
#pragma unroll
        for (int j = 0; j < 4; ++j) pe[j] = __builtin_amdgcn_exp2f(S[j] - mn);
        l = l * alpha + ((pe[0] + pe[1]) + (pe[2] + pe[3]));
#pragma unroll
        for (int h = 0; h < 8; ++h) { const float ah = __int_as_float(__builtin_amdgcn_readlane(__float_as_int(alpha), h)); O[h] = O[h] * ah; }
#pragma unroll
        for (int kk = 0; kk < 16; ++kk) { const f32x4 v = *(const LAS f32x4*)(tile + kk * 1024 + ((lane ^ (kk & 7)) << 4));
#pragma unroll
            for (int h = 0; h < 8; ++h) { const float ph = __int_as_float(__builtin_amdgcn_readlane(__float_as_int(pe[kk & 3]), h + 16 * (kk >> 2))); O[h] = O[h] + v * ph; } }
        DC_PIN();
    }
#undef DC_PIN
#undef DC_LOAD
    l = swap32_add(l, l); l = swap16_add(l, l);
    LAS float* wo = (LAS float*)tile;
    LAS float* wm = (LAS float*)tile + 2048;
    if (lane < 8) { wm[lane] = m; wm[8 + lane] = l; }
#pragma unroll
    for (int h = 0; h < 8; ++h) *(LAS f32x4*)(wo + h * 256 + 4 * lane) = O[h];
    __syncthreads();
    float* part = (float*)(ws + WS_DPART) + (size_t)u * 8 * 264;
    for (int e = tid; e < 2048; e += 512) {
        const int h = e >> 8;
        float M = -INFINITY;
#pragma unroll
        for (int ww = 0; ww < 8; ++ww) M = fmaxf(M, sh[ww * 4096 + 2048 + h]);
        float acc = 0.f, L = 0.f;
#pragma unroll
        for (int ww = 0; ww < 8; ++ww) { const float f = __builtin_amdgcn_exp2f(sh[ww * 4096 + 2048 + h] - M); acc += f * sh[ww * 4096 + e]; L += f * sh[ww * 4096 + 2048 + 8 + h]; }
        __hip_atomic_store(part + h * 264 + (e & 255), acc, __ATOMIC_RELAXED, __HIP_MEMORY_SCOPE_AGENT);
        if ((e & 255) == 0) { __hip_atomic_store(part + h * 264 + 256, M, __ATOMIC_RELAXED, __HIP_MEMORY_SCOPE_AGENT); __hip_atomic_store(part + h * 264 + 257, L, __ATOMIC_RELAXED, __HIP_MEMORY_SCOPE_AGENT); }
    }
    asm volatile("s_waitcnt vmcnt(0)" ::: "memory");
    __syncthreads();
    if (tid == 0) (void)__hip_atomic_fetch_add((unsigned*)(ws + WS_CTL) + CW_DCNT + 16 * s, 1u, __ATOMIC_RELAXED, __HIP_MEMORY_SCOPE_AGENT);
}
__device__ __forceinline__ void decode_combine_unit(Frame& F, const Ptrs& a, int u) {
    unsigned char* ws = opaque_g(a.ws);
    const int tid = fresh_tid(F.wave), lane = tid & 63, s = u >> 3, h = u & 7, row = ROW_SMP + s;
    LAS float* sh = (LAS float*)(F.lds + RING_OFF);
    const bf16* QA = (const bf16*)(ws + WS_QA) + (size_t)row * 768;
    const float* part = (const float*)(ws + WS_DPART) + (size_t)s * 16 * 8 * 264;
    if (tid == 0) { const unsigned* cn = (const unsigned*)(ws + WS_CTL) + CW_DCNT + 16 * s; unsigned spins = 0;
        while (__hip_atomic_load(cn, __ATOMIC_RELAXED, __HIP_MEMORY_SCOPE_AGENT) < 16u && ++spins < (1u << 22)) __builtin_amdgcn_s_sleep(8);
        __builtin_amdgcn_fence(__ATOMIC_ACQUIRE, "agent"); asm volatile("s_waitcnt vmcnt(0)" ::: "memory"); }
    __syncthreads();
    if (tid < 64) { const bf16* KNr = (const bf16*)(ws + WS_KN) + (size_t)row * 512;
        float acc = __uint_as_float((unsigned)QA[h * 96 + lane] << 16) * __uint_as_float((unsigned)KNr[h * 64 + lane] << 16);
        if (lane < 32) acc += __uint_as_float((unsigned)QA[h * 96 + 64 + lane] << 16) * ((const float*)(ws + WS_KRF))[(size_t)row * 32 + lane];
#pragma unroll
        for (int off = 32; off > 0; off >>= 1) acc += lx(acc, lane, off);
        if (lane == 0) sh[256] = acc; }
    __syncthreads();
    if (tid < 256) {
        const int r = tid;
        const float sn = sh[256];
        float pm[16];
#pragma unroll
        for (int p = 0; p < 16; ++p) pm[p] = part[(p * 8 + h) * 264 + 256];
        float M = sn;
#pragma unroll
        for (int p = 0; p < 16; ++p) M = fmaxf(M, pm[p]);
        const float rkv = row_rscale4((const float*)(ws + WS_SSQKV), row, 1.f / KVR);
        const float cn = ((const float*)(ws + WS_CKVF))[(size_t)row * KVR + r] * rkv * a.in(14)[r];
        const float fn = __builtin_amdgcn_exp2f(sn - M);
        float acc = fn * cn, Lq = fn;
#pragma unroll
        for (int p = 0; p < 16; ++p) { const float f = __builtin_amdgcn_exp2f(pm[p] - M); acc += f * part[(p * 8 + h) * 264 + r]; Lq += f * part[(p * 8 + h) * 264 + 257]; }
        sh[r] = acc / Lq;
    }
    __syncthreads();
    { const int v = tid & 63, rg = tid >> 6; const float* wuv = a.in(17) + (size_t)(32 * rg) * 512 + h * 64 + v;
      float wv[32];
#pragma unroll
      for (int k = 0; k < 32; ++k) wv[k] = wuv[(size_t)k * 512];
      float acc = 0.f;
#pragma unroll
      for (int k = 0; k < 32; ++k) acc += sh[32 * rg + k] * wv[k];
      sh[264 + rg * 64 + v] = acc; }
    __syncthreads();
    if (tid < 64) { float acc = 0.f;
#pragma unroll
        for (int rg = 0; rg < 8; ++rg) acc += sh[264 + rg * 64 + tid];
        ((bf16*)(ws + WS_AV))[(size_t)row * 512 + h * 64 + tid] = bf1(acc); }
    __syncthreads();
}
}
namespace mk {
constexpr size_t WS_TMP = WS_ACT;
constexpr size_t WS_MX = WS_RQ;
constexpr size_t WS_H2B = WS_MX + al((size_t)MP * 1024 * 2);
constexpr size_t WS_H2 = WS_UT;
constexpr size_t WS_SSQH2 = WS_SSQ2_, WS_SSQH3 = WS_SSQ3_;
constexpr size_t WS_H3B = WS_H;
constexpr size_t WS_END6 = WS_END4;
static_assert(WS_H2B + (size_t)MP * 1024 * 2 <= WS_SRG && WS_H2 + (size_t)MP * 1024 * 4 <= WS_RIN && (size_t)MP * 1024 * 4 <= (size_t)MP * FFN * 2, "overlays");
static_assert(WS_END6 < ((size_t)1 << 31), "32-bit workspace offsets");

template <int STEP, unsigned GATE_OFF> struct EpiGate {
    static constexpr bool PERM = false, AFTER_DRAIN = false;
    unsigned char* ws_;
    __device__ __forceinline__ void operator()(const f32x4 (&acc)[2][2][4][2], const Unit& u, int wr, int wc, int fr, int fq) const {
        int l_ = lane_fresh(); asm volatile("" : "+v"(l_)); fr = l_ & 15; fq = l_ >> 4;
        unsigned char* w = opaque_g(ws_);
        const unsigned row0 = u.pm * BM + wr * 64 + fr, col0 = u.pn * BM + wc * 32 + 4 * fq;
#pragma unroll
        for (int ai = 0; ai < 2; ++ai)
#pragma unroll
            for (int m = 0; m < 4; ++m) { unsigned row = row0 + ai * HALF + m * 16; asm volatile("" : "+v"(row));
#pragma unroll
                for (int bj = 0; bj < 2; ++bj)
#pragma unroll
                    for (int n = 0; n < 2; ++n) { const unsigned e = row * 1024 + col0 + bj * HALF + n * 16;
                        const u32x2 gw = *at<const u32x2>(w, GATE_OFF + e * 2);
                        f32x4 g; g[0] = __uint_as_float(gw.x << 16); g[1] = __uint_as_float(gw.x & 0xffff0000u); g[2] = __uint_as_float(gw.y << 16); g[3] = __uint_as_float(gw.y & 0xffff0000u);
                        f32x4 o = acc[ai][bj][m][n] * g;
                        if (STEP == 0) *at<f32x4>(w, (unsigned)WS_TMP + e * 4) = o;
                        else { o = o + *at<const f32x4>(w, (unsigned)WS_TMP + e * 4); *at<u32x2>(w, (unsigned)WS_MX + e * 2) = pack4(o); } }
                asm volatile("" ::: "memory"); }
    }
};
struct EpiSwiGLU2 {
    static constexpr bool PERM = true, AFTER_DRAIN = false;
    unsigned char* ws_;
    __device__ __forceinline__ void operator()(const f32x4 (&acc)[2][2][4][2], const Unit& u, int wr, int wc, int fr, int fq) const {
        int l_ = lane_fresh(); asm volatile("" : "+v"(l_)); fr = l_ & 15; fq = l_ >> 4;
        unsigned char* w = opaque_g(ws_);
        const unsigned row0 = u.pm * BM + wr * 64 + fr, col0 = u.pn * HALF + wc * 32 + 8 * fq;
        float rsc[8];
#pragma unroll
        for (int k = 0; k < 8; ++k) rsc[k] = row_rscale16(at<const float>(w, (unsigned)WS_SSQH2), (int)(row0 + (k >> 2) * HALF + (k & 3) * 16), 1.f / D);
#pragma unroll
        for (int ai = 0; ai < 2; ++ai)
#pragma unroll
            for (int m = 0; m < 4; ++m) { unsigned row = row0 + ai * HALF + m * 16; asm volatile("" : "+v"(row));
                const float r = rsc[ai * 4 + m];
                f32x4 o[2];
#pragma unroll
                for (int n = 0; n < 2; ++n)
#pragma unroll
                    for (int j = 0; j < 4; ++j) { const float g = acc[ai][0][m][n][j] * r, up = acc[ai][1][m][n][j] * r; o[n][j] = fast_silu(g) * up; }
                u32x4 pk; pk.x = pg8::cvt_pk_bf16(o[0][0], o[0][1]); pk.y = pg8::cvt_pk_bf16(o[0][2], o[0][3]); pk.z = pg8::cvt_pk_bf16(o[1][0], o[1][1]); pk.w = pg8::cvt_pk_bf16(o[1][2], o[1][3]);
                *at<u32x4>(w, (unsigned)WS_ACT + (row * FFN + col0) * 2) = pk;
                asm volatile("" ::: "memory"); }
    }
};
__device__ __forceinline__ void final_norm_phase(Frame& F, const Ptrs& a) {
    const int lane = fresh_tid(F.wave) & 63;
    const int gw = F.vcu * NWAVES + F.wave, NGW = F.G * NWAVES;
    const bf16* H3 = (const bf16*)(a.ws + WS_H3B); const float* SSQ = (const float*)(a.ws + WS_SSQH3);
    f32x4 g[4];
#pragma unroll
    for (int j = 0; j < 4; ++j) g[j] = *((const f32x4*)a.in(26) + 2 * lane + (j & 1) + 128 * (j >> 1));
    float* outp = a.out();
    for (int row0 = gw; row0 < ROW_PAD; row0 += 2 * NGW) {
        u32x4 v[2][2]; float r[2];
#pragma unroll
        for (int t = 0; t < 2; ++t) { const int row = row0 + t * NGW; const bool ok = row < ROW_PAD && !(row >= MMAIN && row < ROW_SMP);
            r[t] = ok ? row_rscale16(SSQ, row, 1.f / D) : 0.f;
#pragma unroll
            for (int h = 0; h < 2; ++h) v[t][h] = ok ? *((const u32x4*)(H3 + (size_t)row * D) + lane + 64 * h) : (u32x4){0u, 0u, 0u, 0u}; }
#pragma unroll
        for (int t = 0; t < 2; ++t) { const int row = row0 + t * NGW; if (row >= ROW_PAD || (row >= MMAIN && row < ROW_SMP)) continue;
            float* dst = row < MMAIN ? outp + OUT_YP + (size_t)row * D : outp + OUT_YS + (size_t)(row - ROW_SMP) * D;
#pragma unroll
            for (int h = 0; h < 2; ++h) { const u32x4 x = v[t][h];
                const f32x4 lo = (f32x4){__uint_as_float(x.x << 16), __uint_as_float(x.x & 0xffff0000u), __uint_as_float(x.y << 16), __uint_as_float(x.y & 0xffff0000u)};
                const f32x4 hi = (f32x4){__uint_as_float(x.z << 16), __uint_as_float(x.z & 0xffff0000u), __uint_as_float(x.w << 16), __uint_as_float(x.w & 0xffff0000u)};
                *((f32x4*)dst + 2 * lane + 128 * h) = lo * r[t] * g[2 * h]; *((f32x4*)dst + 2 * lane + 1 + 128 * h) = hi * r[t] * g[2 * h + 1]; } }
    }
}
}
namespace mk {
typedef float f32x4_t __attribute__((ext_vector_type(4)));
constexpr int XROW0 = MMAIN, SK_C = 64 * 64;
__device__ __forceinline__ void skinny64(int wave, int tid, const bf16* A, int K, const bf16* Bt, int brow0, LAS float* P, float (&out)[8]) {
    const int lane = tid & 63, r16 = lane & 15, kq = lane >> 4;
    const bf16* ap = A + (size_t)(XROW0 + r16) * K + 8 * kq;
    const bf16* bp = Bt + (size_t)(brow0 + r16) * K + 8 * kq;
    f32x4 acc[4][4];
#pragma unroll
    for (int mf = 0; mf < 4; ++mf)
#pragma unroll
        for (int nf = 0; nf < 4; ++nf) acc[mf][nf] = (f32x4){0.f, 0.f, 0.f, 0.f};
    const int KS = K / 32;
    bf16x8 a0[4], b0[4], a1[4], b1[4], a2[4], b2[4];
#define SK_LOAD(a_, b_, kk_) do { _Pragma("unroll") for (int f = 0; f < 4; ++f) { a_[f] = *(const bf16x8*)(ap + (size_t)(16 * f) * K + 32 * (kk_)); b_[f] = *(const bf16x8*)(bp + (size_t)(16 * f) * K + 32 * (kk_)); } } while (0)
#define SK_MMA(a_, b_) do { _Pragma("unroll") for (int mf = 0; mf < 4; ++mf) _Pragma("unroll") for (int nf = 0; nf < 4; ++nf) acc[mf][nf] = __builtin_amdgcn_mfma_f32_16x16x32_bf16(a_[mf], b_[nf], acc[mf][nf], 0, 0, 0); } while (0)
    int kk = wave;
    if (kk < KS) SK_LOAD(a0, b0, kk);
    if (kk + 8 < KS) SK_LOAD(a1, b1, kk + 8);
    if (kk + 16 < KS) SK_LOAD(a2, b2, kk + 16);
    for (; kk < KS; kk += 24) {
        SK_MMA(a0, b0); if (kk + 24 < KS) SK_LOAD(a0, b0, kk + 24);
        if (kk + 8 < KS) { SK_MMA(a1, b1); if (kk + 32 < KS) SK_LOAD(a1, b1, kk + 32); }
        if (kk + 16 < KS) { SK_MMA(a2, b2); if (kk + 40 < KS) SK_LOAD(a2, b2, kk + 40); }
    }
#undef SK_LOAD
#undef SK_MMA
    LAS float* Pw = P + wave * SK_C;
#pragma unroll
    for (int mf = 0; mf < 4; ++mf)
#pragma unroll
        for (int nf = 0; nf < 4; ++nf)
#pragma unroll
            for (int i = 0; i < 4; ++i) Pw[(16 * mf + 4 * kq + i) * 64 + 16 * nf + r16] = acc[mf][nf][i];
    __syncthreads();
    const LAS float* pr = P + (tid >> 3) * 64 + 8 * (tid & 7);
    f32x4 s0 = *(const LAS f32x4*)pr, s1 = *(const LAS f32x4*)(pr + 4);
#pragma unroll
    for (int w = 1; w < 8; ++w) { s0 = s0 + *(const LAS f32x4*)(pr + w * SK_C); s1 = s1 + *(const LAS f32x4*)(pr + w * SK_C + 4); }
    out[0] = s0[0]; out[1] = s0[1]; out[2] = s0[2]; out[3] = s0[3]; out[4] = s1[0]; out[5] = s1[1]; out[6] = s1[2]; out[7] = s1[3];
    __syncthreads();
}
__device__ __forceinline__ float sum8(float v, int lane) { v += lx(v, lane, 1); v += lx(v, lane, 2); v += lx(v, lane, 4); return v; }
__device__ __forceinline__ void st8_bf16(bf16* p, const float* v) { u32x4 w; w.x = pg8::cvt_pk_bf16(v[0], v[1]); w.y = pg8::cvt_pk_bf16(v[2], v[3]); w.z = pg8::cvt_pk_bf16(v[4], v[5]); w.w = pg8::cvt_pk_bf16(v[6], v[7]); *(u32x4*)p = w; }
__device__ __forceinline__ void ld8(const LAS float* p, float* v) { const f32x4 a = *(const LAS f32x4*)p, b = *(const LAS f32x4*)(p + 4); v[0] = a[0]; v[1] = a[1]; v[2] = a[2]; v[3] = a[3]; v[4] = b[0]; v[5] = b[1]; v[6] = b[2]; v[7] = b[3]; }
__device__ __forceinline__ void st16_wt7(void* p, u32x4 v) { asm volatile("global_store_dwordx4 %0, %1, off sc1\n\ts_nop 1" :: "v"(p), "v"(v) : "memory"); }
__device__ __forceinline__ void xjob_signal(unsigned char* ws, int tid, int cnt_idx) {
    asm volatile("s_waitcnt vmcnt(0)" ::: "memory"); __syncthreads();
    if (tid == 0) (void)__hip_atomic_fetch_add((unsigned*)(ws + WS_CTL) + CW_XCNT + cnt_idx, 1u, __ATOMIC_RELAXED, __HIP_MEMORY_SCOPE_AGENT);
}
__device__ __forceinline__ void xjob_wait(unsigned char* ws, int tid, int cnt_idx, unsigned need) {
    if (tid == 0) { const unsigned* cn = (const unsigned*)(ws + WS_CTL) + CW_XCNT + cnt_idx; unsigned spins = 0;
        while (__hip_atomic_load(cn, __ATOMIC_RELAXED, __HIP_MEMORY_SCOPE_AGENT) < need && ++spins < (1u << 22)) __builtin_amdgcn_s_sleep(8);
        __builtin_amdgcn_fence(__ATOMIC_ACQUIRE, "agent"); asm volatile("s_waitcnt vmcnt(0)" ::: "memory"); }
    __syncthreads();
}

__device__ __forceinline__ void xjob_ffn_up(Frame& F, unsigned char* ws, int j, size_t a_off, size_t w_off, int rs_mode, int cnt_idx) {
    ws = opaque_g(ws);
    const int tid = fresh_tid(F.wave);
    LAS float* P = (LAS float*)(F.lds + RING_OFF);
    const int brow0 = 256 * (j >> 1) + 64 * (j & 1);
    float g[8], u[8], o[8];
    skinny64(F.wave, tid, (const bf16*)(ws + a_off), D, (const bf16*)(ws + w_off), brow0, P, g);
    skinny64(F.wave, tid, (const bf16*)(ws + a_off), D, (const bf16*)(ws + w_off), brow0 + 128, P, u);
    const int r = tid >> 3, cg = tid & 7, row = XROW0 + r;
    const float rs = rs_mode == 0 ? ((const float*)(ws + WS_R1))[row] : row_rscale16((const float*)(ws + WS_SSQH2), row, 1.f / D);
#pragma unroll
    for (int k = 0; k < 8; ++k) o[k] = fast_silu(g[k] * rs) * (u[k] * rs);
    { u32x4 pk; pk.x = pg8::cvt_pk_bf16(o[0], o[1]); pk.y = pg8::cvt_pk_bf16(o[2], o[3]); pk.z = pg8::cvt_pk_bf16(o[4], o[5]); pk.w = pg8::cvt_pk_bf16(o[6], o[7]);
      st16_wt7((bf16*)(ws + WS_ACT) + (size_t)row * FFN + 64 * j + 8 * cg, pk); }
    xjob_signal(ws, tid, cnt_idx);
}
__device__ __forceinline__ void xjob_resid(Frame& F, unsigned char* ws, int j, size_t a_off, int K, size_t w_off, const void* res  , bool res_f32, float scale, size_t outb_off, size_t ssq_off) {
    ws = opaque_g(ws);
    const int tid = fresh_tid(F.wave), lane = tid & 63;
    LAS float* P = (LAS float*)(F.lds + RING_OFF);
    float v[8], o[8];
    skinny64(F.wave, tid, (const bf16*)(ws + a_off), K, (const bf16*)(ws + w_off), 64 * j, P, v);
    const int r = tid >> 3, cg = tid & 7, row = XROW0 + r, col = 64 * j + 8 * cg;
    float b[8];
    if (res_f32) { const float* rp = (const float*)res + (size_t)r * D + col; const f32x4 b0 = *(const f32x4*)rp, b1 = *(const f32x4*)(rp + 4); b[0] = b0[0]; b[1] = b0[1]; b[2] = b0[2]; b[3] = b0[3]; b[4] = b1[0]; b[5] = b1[1]; b[6] = b1[2]; b[7] = b1[3]; }
    else { const u32x4 rb = *(const u32x4*)((const bf16*)res + (size_t)r * D + col);
#pragma unroll
        for (int k = 0; k < 8; ++k) { const unsigned wv = rb[k >> 1]; b[k] = __uint_as_float((k & 1) ? (wv & 0xffff0000u) : (wv << 16)); } }
    float ss = 0.f;
#pragma unroll
    for (int k = 0; k < 8; ++k) { o[k] = b[k] + scale * v[k]; ss += o[k] * o[k]; }
    st8_bf16((bf16*)(ws + outb_off) + (size_t)row * D + col, o);
    ss = sum8(ss, lane);
    if (cg == 0) atomicAdd((float*)(ws + ssq_off) + row, ss);
}
__device__ __forceinline__ void xjob_win(Frame& F, unsigned char* ws, int j) {
    ws = opaque_g(ws);
    const int tid = fresh_tid(F.wave), lane = tid & 63;
    LAS float* P = (LAS float*)(F.lds + RING_OFF);
    const int pn = j >> 1, q = j & 1;
    float v0[8], v1[8];
    skinny64(F.wave, tid, (const bf16*)(ws + WS_HB), D, (const bf16*)(ws + WS_WIN), 256 * pn + 64 * q, P, v0);
    skinny64(F.wave, tid, (const bf16*)(ws + WS_HB), D, (const bf16*)(ws + WS_WIN), 256 * pn + 64 * q + 128, P, v1);
    const int r = tid >> 3, cg = tid & 7, row = XROW0 + r;
    const float rs = row_rscale16((const float*)(ws + WS_SSQH), row, 1.f / D);
    const float* TAB = (const float*)(ws + WS_TAB);
#pragma unroll
    for (int k = 0; k < 8; ++k) { v0[k] *= rs; v1[k] *= rs; }
    const int tc0 = 64 * q + 8 * cg;
    if (pn == 0) {
        bf16* CQ = (bf16*)(ws + WS_CQ) + (size_t)row * QR; float* SSQCQ = (float*)(ws + WS_SSQCQ) + (size_t)row * 8;
        st8_bf16(CQ + tc0, v0); st8_bf16(CQ + tc0 + 128, v1);
        float s0 = 0.f, s1 = 0.f;
#pragma unroll
        for (int k = 0; k < 8; ++k) { s0 += v0[k] * v0[k]; s1 += v1[k] * v1[k]; }
        s0 = sum8(s0, lane); s1 = sum8(s1, lane);
        if (cg == 0) { SSQCQ[2 * q] = s0; SSQCQ[2 * q + 1] = s1; }
    } else if (pn == 1) {
        bf16* CQ = (bf16*)(ws + WS_CQ) + (size_t)row * QR; float* SSQCQ = (float*)(ws + WS_SSQCQ) + (size_t)row * 8;
        st8_bf16(CQ + 256 + tc0, v0);
        float s0 = 0.f;
#pragma unroll
        for (int k = 0; k < 8; ++k) s0 += v0[k] * v0[k];
        s0 = sum8(s0, lane);
        if (cg == 0) { SSQCQ[4 + q] = s0; SSQCQ[6 + q] = 0.f; }
        float x2[8];
#pragma unroll
        for (int k = 0; k < 8; ++k) x2[k] = lx(v1[k], lane, 2);
        if (q == 0 && cg < 2) {
            const int pi = row_pidx(row), i0 = 8 * cg;
            float y1[8], y2[8];
#pragma unroll
            for (int k = 0; k < 8; ++k) { const float c = TAB[TAB_C16 / 4 + pi * 16 + i0 + k], s = TAB[TAB_S16 / 4 + pi * 16 + i0 + k]; y1[k] = v1[k] * c - x2[k] * s; y2[k] = v1[k] * s + x2[k] * c; }
            st8_bf16((bf16*)(ws + WS_KRB) + (size_t)row * 32 + i0, y1); st8_bf16((bf16*)(ws + WS_KRB) + (size_t)row * 32 + 16 + i0, y2);
            float* kf = (float*)(ws + WS_KRF) + (size_t)row * 32;
#pragma unroll
            for (int k = 0; k < 8; ++k) { kf[i0 + k] = y1[k]; kf[16 + i0 + k] = y2[k]; }
        }
    } else if (pn == 2) {
        float* CKVF = (float*)(ws + WS_CKVF) + (size_t)row * KVR; bf16* CKVB = (bf16*)(ws + WS_CKVB) + (size_t)row * KVR; float* SSQKV = (float*)(ws + WS_SSQKV) + (size_t)row * 4;
        float s0 = 0.f, s1 = 0.f;
#pragma unroll
        for (int k = 0; k < 8; ++k) { CKVF[tc0 + k] = v0[k]; CKVF[tc0 + 128 + k] = v1[k]; s0 += v0[k] * v0[k]; s1 += v1[k] * v1[k]; }
        st8_bf16(CKVB + tc0, v0); st8_bf16(CKVB + tc0 + 128, v1);
        s0 = sum8(s0, lane); s1 = sum8(s1, lane);
        if (cg == 0) { SSQKV[2 * q] = s0; SSQKV[2 * q + 1] = s1; }
    } else if (pn < 7) {
        const bool isk = pn >= 5; const int hh = 2 * ((pn - 3) & 1) + q, i0 = 8 * cg;
        const int pi = row_pidx(row), jt = row_jtok(row);
        const float mult = isk ? RK_SCALE * TAB[TAB_GN / 4 + hh * 128 + jt] : TAB[TAB_GP / 4 + hh * 128 + jt];
        float y1[8], y2[8];
#pragma unroll
        for (int k = 0; k < 8; ++k) { const float c = TAB[TAB_C64 / 4 + pi * 64 + i0 + k], s = TAB[TAB_S64 / 4 + pi * 64 + i0 + k]; y1[k] = (v0[k] * c - v1[k] * s) * mult; y2[k] = (v0[k] * s + v1[k] * c) * mult; }
        bf16* dst = (bf16*)(ws + (isk ? WS_RK : WS_RQ)) + (size_t)row * 512 + hh * 128;
        st8_bf16(dst + i0, y1); st8_bf16(dst + 64 + i0, y2);
        if (isk) { bf16* RKT = (bf16*)(ws + WS_RKT);
#pragma unroll
            for (int k = 0; k < 8; ++k) { RKT[(size_t)(hh * 128 + i0 + k) * MP + row] = bf1(y1[k]); RKT[(size_t)(hh * 128 + 64 + i0 + k) * MP + row] = bf1(y2[k]); } }
    } else if (pn < 11) {
        bf16* RVT = (bf16*)(ws + WS_RVT);
#pragma unroll
        for (int k = 0; k < 8; ++k) { RVT[(size_t)((pn - 7) * 256 + tc0 + k) * MP + row] = bf1(v0[k]); RVT[(size_t)((pn - 7) * 256 + tc0 + 128 + k) * MP + row] = bf1(v1[k]); }
    } else {
        const int t = (pn - 11) >> 2; bf16* dst = (bf16*)(ws + WS_SRG + (size_t)t * (WS_SGA - WS_SRG)) + (size_t)row * 1024 + ((pn - 11) & 3) * 256;
        float o0[8], o1[8];
#pragma unroll
        for (int k = 0; k < 8; ++k) { const float g0 = fast_sigmoid(v0[k]), g1 = fast_sigmoid(v1[k]); o0[k] = t == 0 ? v0[k] * g0 : g0; o1[k] = t == 0 ? v1[k] * g1 : g1; }
        st8_bf16(dst + tc0, o0); st8_bf16(dst + tc0 + 128, o1);
    }
}
__device__ __forceinline__ void xjob_q(Frame& F, unsigned char* ws, int j) {
    ws = opaque_g(ws);
    const int tid = fresh_tid(F.wave), lane = tid & 63;
    LAS float* P = (LAS float*)(F.lds + RING_OFF);
    float v[8], p[8], o[8];
    skinny64(F.wave, tid, (const bf16*)(ws + WS_CQ), QR, (const bf16*)(ws + WS_WUQ), 64 * j, P, v);
    const int r = tid >> 3, cg = tid & 7, row = XROW0 + r;
    const float rs = row_rscale8((const float*)(ws + WS_SSQCQ), row, 1.f / QR) * SC_Q;
    const float* TAB = (const float*)(ws + WS_TAB);
    const int pi = row_pidx(row), col = 64 * j + 8 * cg, grp = col >> 5, w32 = col & 31;
#pragma unroll
    for (int k = 0; k < 8; ++k) p[k] = lx(v[k], lane, 2);
    if (grp % 3 == 2) {
        const int i0 = w32 & 15;
#pragma unroll
        for (int k = 0; k < 8; ++k) { const float c = TAB[TAB_C16 / 4 + pi * 16 + i0 + k], sn = TAB[TAB_S16 / 4 + pi * 16 + i0 + k];
            o[k] = (w32 < 16 ? v[k] * c - p[k] * sn : p[k] * sn + v[k] * c) * rs; }
    } else {
#pragma unroll
        for (int k = 0; k < 8; ++k) o[k] = v[k] * rs;
    }
    st8_bf16((bf16*)(ws + WS_QA) + (size_t)row * 768 + col, o);
}
__device__ __forceinline__ void xjob_kv(Frame& F, unsigned char* ws, int j, bool is_v) {
    ws = opaque_g(ws);
    const int tid = fresh_tid(F.wave);
    LAS float* P = (LAS float*)(F.lds + RING_OFF);
    float v[8];
    skinny64(F.wave, tid, (const bf16*)(ws + WS_CKVB), KVR, (const bf16*)(ws + (is_v ? WS_WUV : WS_WUK)), 64 * j, P, v);
    const int r = tid >> 3, cg = tid & 7, row = XROW0 + r, col = 64 * j + 8 * cg;
    const float rs = row_rscale4((const float*)(ws + WS_SSQKV), row, 1.f / KVR);
#pragma unroll
    for (int k = 0; k < 8; ++k) v[k] *= rs;
    if (!is_v) st8_bf16((bf16*)(ws + WS_KN) + (size_t)row * 512 + col, v);
    else { bf16* VT = (bf16*)(ws + WS_VT);
#pragma unroll
        for (int k = 0; k < 8; ++k) VT[(size_t)(col + k) * MP + row] = bf1(v[k]); }
}
__device__ __forceinline__ void xjob_mix(Frame& F, unsigned char* ws, int j) {
    ws = opaque_g(ws);
    const int tid = fresh_tid(F.wave);
    LAS float* P = (LAS float*)(F.lds + RING_OFF);
    float a[8], b[8], o[8];
    skinny64(F.wave, tid, (const bf16*)(ws + WS_AV), 512, (const bf16*)(ws + WS_WMO), 64 * j, P, a);
    skinny64(F.wave, tid, (const bf16*)(ws + WS_RIN), D, (const bf16*)(ws + WS_WRO), 64 * j, P, b);
    const int r = tid >> 3, cg = tid & 7, row = XROW0 + r, col = 64 * j + 8 * cg;
    const u32x4 ga = *(const u32x4*)((const bf16*)(ws + WS_SGA) + (size_t)row * 1024 + col), gb = *(const u32x4*)((const bf16*)(ws + WS_SGB) + (size_t)row * 1024 + col);
#pragma unroll
    for (int k = 0; k < 8; ++k) { const unsigned wa = ga[k >> 1], wb = gb[k >> 1];
        const float fa = __uint_as_float((k & 1) ? (wa & 0xffff0000u) : (wa << 16)), fb = __uint_as_float((k & 1) ? (wb & 0xffff0000u) : (wb << 16));
        o[k] = fa * a[k] + fb * b[k]; }
    st8_bf16((bf16*)(ws + WS_MX) + (size_t)row * 1024 + col, o);
}
__device__ __forceinline__ void xjob_ql(Frame& F, unsigned char* ws, int j) {
    ws = opaque_g(ws);
    const int tid = fresh_tid(F.wave);
    LAS float* P = (LAS float*)(F.lds + RING_OFF);
    float v[8];
    skinny64(F.wave, tid, (const bf16*)(ws + WS_CQ), QR, (const bf16*)(ws + WS_WQL), 64 * j, P, v);
    const int r = tid >> 3, cg = tid & 7, row = XROW0 + r;
    const float rs = row_rscale8((const float*)(ws + WS_SSQCQ), row, 1.f / QR) * SC_Q;
    float* dst = (float*)(ws + WS_QL) + (size_t)r * 2048 + 64 * j + 8 * cg;
    *(f32x4*)dst = (f32x4){v[0] * rs, v[1] * rs, v[2] * rs, v[3] * rs}; *(f32x4*)(dst + 4) = (f32x4){v[4] * rs, v[5] * rs, v[6] * rs, v[7] * rs};
}
}
namespace mk {
constexpr int RC_STR = 272;
constexpr int RC_S = 0, RC_KT = 0  , RC_Q = 256 * RC_STR, RC_A = RC_Q + 128 * RC_STR, RC_RED = RC_A + 128 * RC_STR, RC_END = RC_RED + 2 * 8 * 128 * 4;
static_assert(RC_END <= SCR_BYTES, "chain LDS map");
__device__ __forceinline__ void ret_chain_unit(Frame& F, const Ptrs& a, int bh) {
    unsigned char* ws = a.ws; ws = opaque_g(ws);
    const int tid_k = fresh_tid(F.wave), w = F.wave;
    const int hh = bh & 3, b = bh >> 2;
    LAS unsigned char* L = F.lds + RING_OFF;
    LAS float* red = (LAS float*)(L + RC_RED);
    const bf16* RQ = (const bf16*)(ws + WS_RQ); const bf16* RK = (const bf16*)(ws + WS_RK); const bf16* RKT = (const bf16*)(ws + WS_RKT); const bf16* RVT = (const bf16*)(ws + WS_RVT);
    const float g = gpow_t(ws, hh, 1), g127 = gpow_t(ws, hh, 127);
    f32x16 S[4];
    {
        const int lane = tid_k & 63, r32 = lane & 31, half = lane >> 5;
#pragma unroll
        for (int db = 0; db < 4; ++db)
#pragma unroll
            for (int i = 0; i < 16; ++i) S[db][i] = 0.f;
        const bf16x8 af = *(const bf16x8*)(RVT + (size_t)(hh * 256 + 32 * w + r32) * MP + ROW_META + 8 * half);
#pragma unroll
        for (int db = 0; db < 4; ++db) { const bf16x8 bf = *(const bf16x8*)(RKT + (size_t)(hh * 128 + 32 * db + r32) * MP + ROW_META + 8 * half); S[db] = __builtin_amdgcn_mfma_f32_32x32x16_bf16(af, bf, S[db], 0, 0, 0); }
        const float sc = gpow_t(ws, hh, NMETA - 1);
#pragma unroll
        for (int db = 0; db < 4; ++db)
#pragma unroll
            for (int i = 0; i < 16; ++i) S[db][i] *= sc;
    }
    v4u qreg[4], jreg[4];
#define RC_FETCH_QK(tok0_) do { _Pragma("unroll") for (int k = 0; k < 4; ++k) { const int ch = tid + 512 * k; \
        qreg[k] = *(const v4u*)(RQ + (size_t)((tok0_) + (ch >> 4)) * 512 + hh * 128 + 8 * (ch & 15)); jreg[k] = *(const v4u*)(RK + (size_t)((tok0_) + (ch >> 4)) * 512 + hh * 128 + 8 * (ch & 15)); } } while (0)
    { const int tid = tid_k; RC_FETCH_QK(b * SEQ); }
#define RC_BLK_IB(n) ((n) < 1 ? 0 : (n) < 3 ? 1 : (n) < 6 ? 2 : 3)
#define RC_BLK_JB(n) ((n) - ((n) < 1 ? 0 : (n) < 3 ? 1 : (n) < 6 ? 3 : 6))
#pragma unroll 1
    for (int c = 0; c < 16; ++c) {
        const int tok0 = b * SEQ + c * 128;
        int tid_c = tid_k; asm volatile("" : "+v"(tid_c));
        const int tid = tid_c, lane = tid & 63, r32 = lane & 31, half = lane >> 5;
#pragma unroll
        for (int k = 0; k < 4; ++k) { const int ch = tid + 512 * k; *(LAS v4u*)(L + RC_Q + (ch >> 4) * RC_STR + 16 * (ch & 15)) = qreg[k]; *(LAS v4u*)(L + RC_S + (ch >> 4) * RC_STR + 16 * (ch & 15)) = jreg[k]; }
        __syncthreads();
        v4u kreg[4];
#pragma unroll
        for (int k = 0; k < 4; ++k) { const int ch = tid + 512 * k; kreg[k] = *(const v4u*)(RKT + (size_t)(hh * 128 + (ch >> 4)) * MP + tok0 + 8 * (ch & 15)); }
        for (int n = w; n < 10; n += 8) {
            const int ib_ = RC_BLK_IB(n), jb_ = RC_BLK_JB(n);
            f32x16 at;
#pragma unroll
            for (int i = 0; i < 16; ++i) at[i] = 0.f;
#pragma unroll
            for (int s = 0; s < 8; ++s) { const bf16x8 kf = *(const LAS bf16x8*)(L + RC_S + (32 * jb_ + r32) * RC_STR + (16 * s + 8 * half) * 2); const bf16x8 qf = *(const LAS bf16x8*)(L + RC_Q + (32 * ib_ + r32) * RC_STR + (16 * s + 8 * half) * 2); at = __builtin_amdgcn_mfma_f32_32x32x16_bf16(kf, qf, at, 0, 0, 0); }
            if (jb_ == ib_) {
#pragma unroll
                for (int i = 0; i < 16; ++i) if (crow(i, half) > r32) at[i] = 0.f; }
#pragma unroll
            for (int gq = 0; gq < 4; ++gq) { f32x4 o_; o_[0] = at[4 * gq]; o_[1] = at[4 * gq + 1]; o_[2] = at[4 * gq + 2]; o_[3] = at[4 * gq + 3];
                *(LAS u32x2*)(L + RC_A + (32 * ib_ + r32) * RC_STR + (32 * jb_ + 8 * gq + 4 * half) * 2) = pack4(o_); }
        }
        __syncthreads();
#pragma unroll
        for (int db = 0; db < 4; ++db)
#pragma unroll
            for (int i = 0; i < 16; ++i) *(LAS bf16*)(L + RC_S + (32 * w + crow(i, half)) * RC_STR + (32 * db + r32) * 2) = bf1(S[db][i]);
        f32x16 ot[4];
#pragma unroll
        for (int ib = 0; ib < 4; ++ib)
#pragma unroll
            for (int i = 0; i < 16; ++i) ot[ib][i] = 0.f;
#pragma unroll 2
        for (int s = 0; s < 8; ++s) {
            const bf16x8 sf = *(const LAS bf16x8*)(L + RC_S + (32 * w + r32) * RC_STR + (16 * s + 8 * half) * 2);
#pragma unroll
            for (int ib = 0; ib < 4; ++ib) { const bf16x8 qf = *(const LAS bf16x8*)(L + RC_Q + (32 * ib + r32) * RC_STR + (16 * s + 8 * half) * 2); ot[ib] = __builtin_amdgcn_mfma_f32_32x32x16_bf16(sf, qf, ot[ib], 0, 0, 0); }
        }
#pragma unroll
        for (int ib = 0; ib < 4; ++ib)
#pragma unroll
            for (int i = 0; i < 16; ++i) ot[ib][i] *= g;
        __syncthreads();
#pragma unroll
        for (int k = 0; k < 4; ++k) { const int ch = tid + 512 * k; *(LAS v4u*)(L + RC_KT + (ch >> 4) * RC_STR + 16 * (ch & 15)) = kreg[k]; }
        __syncthreads();
        if (c < 15) RC_FETCH_QK(tok0 + 128);
#pragma unroll
        for (int db = 0; db < 4; ++db)
#pragma unroll
            for (int i = 0; i < 16; ++i) S[db][i] *= g;
        {
            const bf16* vp = RVT + (size_t)(hh * 256 + 32 * w + r32) * MP + tok0 + 8 * half;
            bf16x8 v0 = *(const bf16x8*)(vp), v1 = *(const bf16x8*)(vp + 16), v2 = v1;
#pragma unroll 1
            for (int s = 0; s < 8; ++s) {
                if (s + 2 < 8) v2 = *(const bf16x8*)(vp + 16 * (s + 2));
#pragma unroll
                for (int ib = 0; ib < 4; ++ib) if (s < 2 * (ib + 1)) { const bf16x8 af = *(const LAS bf16x8*)(L + RC_A + (32 * ib + r32) * RC_STR + (16 * s + 8 * half) * 2); ot[ib] = __builtin_amdgcn_mfma_f32_32x32x16_bf16(v0, af, ot[ib], 0, 0, 0); }
#pragma unroll
                for (int db = 0; db < 4; ++db) { const bf16x8 kf = *(const LAS bf16x8*)(L + RC_KT + (32 * db + r32) * RC_STR + (16 * s + 8 * half) * 2); S[db] = __builtin_amdgcn_mfma_f32_32x32x16_bf16(v0, kf, S[db], 0, 0, 0); }
                v0 = v1; v1 = v2;
            }
        }
#pragma unroll
        for (int db = 0; db < 4; ++db)
#pragma unroll
            for (int i = 0; i < 16; ++i) S[db][i] *= g127;
#pragma unroll
        for (int ib = 0; ib < 4; ++ib) { float t = 0.f;
#pragma unroll
            for (int i = 0; i < 16; ++i) t += ot[ib][i];
            t += lx(t, lane, 32); if (half == 0) red[w * 128 + 32 * ib + r32] = t; }
        __syncthreads();
        float mu[4];
#pragma unroll
        for (int ib = 0; ib < 4; ++ib) { float t = 0.f;
#pragma unroll
            for (int ww = 0; ww < 8; ++ww) t += red[ww * 128 + 32 * ib + r32];
            mu[ib] = t * (1.f / 256.f); }
#pragma unroll
        for (int ib = 0; ib < 4; ++ib) { float t = 0.f;
#pragma unroll
            for (int i = 0; i < 16; ++i) { ot[ib][i] -= mu[ib]; t += ot[ib][i] * ot[ib][i]; }
            t += lx(t, lane, 32); if (half == 0) red[1024 + w * 128 + 32 * ib + r32] = t; }
        __syncthreads();
#pragma unroll
        for (int ib = 0; ib < 4; ++ib) { float t = 0.f;
#pragma unroll
            for (int ww = 0; ww < 8; ++ww) t += red[1024 + ww * 128 + 32 * ib + r32];
            const float rstd = 1.0f / sqrtf(t * (1.f / 256.f) + EPS);
            const int irow = tok0 + 32 * ib + r32;
            const bf16* SRG = (const bf16*)(ws + WS_SRG) + (size_t)irow * 1024 + hh * 256 + 32 * w + 4 * half;
            bf16* RIN = (bf16*)(ws + WS_RIN) + (size_t)irow * 1024 + hh * 256 + 32 * w + 4 * half;
            const float* gn = a.in(19) + hh * 256 + 32 * w + 4 * half;
#pragma unroll
            for (int gq = 0; gq < 4; ++gq) {
                const u32x2 sg = *(const u32x2*)(SRG + 8 * gq); const f32x4 gv = *(const f32x4*)(gn + 8 * gq);
                f32x4 o;
                o[0] = ot[ib][4 * gq + 0] * rstd * gv[0] * __uint_as_float(sg.x << 16); o[1] = ot[ib][4 * gq + 1] * rstd * gv[1] * __uint_as_float(sg.x & 0xffff0000u);
                o[2] = ot[ib][4 * gq + 2] * rstd * gv[2] * __uint_as_float(sg.y << 16); o[3] = ot[ib][4 * gq + 3] * rstd * gv[3] * __uint_as_float(sg.y & 0xffff0000u);
                *(u32x2*)(RIN + 8 * gq) = pack4(o);
            } }
        __syncthreads();
    }
#undef RC_FETCH_QK
#undef RC_BLK_IB
#undef RC_BLK_JB
    const int lane = tid_k & 63, r32 = lane & 31, half = lane >> 5;
#pragma unroll
    for (int db = 0; db < 4; ++db)
#pragma unroll
        for (int i = 0; i < 16; ++i) a.out()[OUT_SRP + ((size_t)bh * RDK + 32 * db + r32) * RDV + 32 * w + crow(i, half)] = S[db][i];
}
}
namespace mk {
constexpr int CW_FLAG = 8192;
__device__ __forceinline__ void st16_wt(void* p, v4u v) { asm volatile("global_store_dwordx4 %0, %1, off sc1\n\ts_nop 1" :: "v"(p), "v"(v) : "memory"); }
__device__ __forceinline__ void ret_state_unit(Frame& F, const Ptrs& a, int bh) {
    unsigned char* ws = opaque_g(a.ws);
    const int tid_k = fresh_tid(F.wave), w = F.wave;
    const int hh = bh & 3, b = bh >> 2;
    LAS unsigned char* L = F.lds + RING_OFF;
    const bf16* RKT = (const bf16*)(ws + WS_RKT); const bf16* RVT = (const bf16*)(ws + WS_RVT);
    const float g = gpow_t(ws, hh, 1), g127 = gpow_t(ws, hh, 127);
    f32x16 S[4];
    bf16x8 vf[8]; v4u kreg[4];
#define RS_FETCH(tok0_) do { _Pragma("unroll") for (int s = 0; s < 8; ++s) vf[s] = *(const bf16x8*)(RVT + (size_t)(hh * 256 + 32 * w + r32) * MP + (tok0_) + 16 * s + 8 * half); \
        _Pragma("unroll") for (int k = 0; k < 4; ++k) { const int ch = tid + 512 * k; kreg[k] = *(const v4u*)(RKT + (size_t)(hh * 128 + (ch >> 4)) * MP + (tok0_) + 8 * (ch & 15)); } } while (0)
    {   const int tid = tid_k, lane = tid & 63, r32 = lane & 31, half = lane >> 5;
#pragma unroll
        for (int db = 0; db < 4; ++db)
#pragma unroll
            for (int i = 0; i < 16; ++i) S[db][i] = 0.f;
        const bf16x8 af = *(const bf16x8*)(RVT + (size_t)(hh * 256 + 32 * w + r32) * MP + ROW_META + 8 * half);
#pragma unroll
        for (int db = 0; db < 4; ++db) { const bf16x8 bf = *(const bf16x8*)(RKT + (size_t)(hh * 128 + 32 * db + r32) * MP + ROW_META + 8 * half); S[db] = __builtin_amdgcn_mfma_f32_32x32x16_bf16(af, bf, S[db], 0, 0, 0); }
        const float sc = gpow_t(ws, hh, NMETA - 1);
#pragma unroll
        for (int db = 0; db < 4; ++db)
#pragma unroll
            for (int i = 0; i < 16; ++i) S[db][i] *= sc;
        RS_FETCH(b * SEQ);
    }
#pragma unroll 1
    for (int c = 0; c < 16; ++c) {
        const int tok0 = b * SEQ + c * 128, u = bh * 16 + c;
        int tid_c = tid_k; asm volatile("" : "+v"(tid_c));
        const int tid = tid_c, lane = tid & 63, r32 = lane & 31, half = lane >> 5;
#pragma unroll
        for (int k = 0; k < 4; ++k) { const int ch = tid + 512 * k; *(LAS v4u*)(L + RC_Q + (ch >> 4) * RC_STR + 16 * (ch & 15)) = kreg[k]; }
#pragma unroll
        for (int db = 0; db < 4; ++db)
#pragma unroll
            for (int i = 0; i < 16; ++i) *(LAS bf16*)(L + (32 * w + crow(i, half)) * RC_STR + (32 * db + r32) * 2) = bf1(S[db][i]);
        __syncthreads();
        { bf16* SP = (bf16*)(ws + WS_SPREV) + (size_t)u * 32768;
#pragma unroll
          for (int k = 0; k < 8; ++k) { const int ch = lane + 64 * k, row = 32 * w + (ch >> 4); st16_wt(SP + (size_t)row * 128 + 8 * (ch & 15), *(const LAS v4u*)(L + row * RC_STR + 16 * (ch & 15))); } }
        bf16x8 vfn[8]; v4u kregn[4];
        if (c < 15) {
#pragma unroll
            for (int s = 0; s < 8; ++s) vfn[s] = *(const bf16x8*)(RVT + (size_t)(hh * 256 + 32 * w + r32) * MP + tok0 + 128 + 16 * s + 8 * half);
#pragma unroll
            for (int k = 0; k < 4; ++k) { const int ch = tid + 512 * k; kregn[k] = *(const v4u*)(RKT + (size_t)(hh * 128 + (ch >> 4)) * MP + tok0 + 128 + 8 * (ch & 15)); }
        } else {
#pragma unroll
            for (int s = 0; s < 8; ++s) vfn[s] = vf[s];
#pragma unroll
            for (int k = 0; k < 4; ++k) kregn[k] = kreg[k];
        }
#pragma unroll
        for (int db = 0; db < 4; ++db) {
#pragma unroll
            for (int i = 0; i < 16; ++i) S[db][i] *= g;
#pragma unroll
            for (int s = 0; s < 8; ++s) { const bf16x8 kf = *(const LAS bf16x8*)(L + RC_Q + (32 * db + r32) * RC_STR + (16 * s + 8 * half) * 2); S[db] = __builtin_amdgcn_mfma_f32_32x32x16_bf16(vf[s], kf, S[db], 0, 0, 0); }
#pragma unroll
            for (int i = 0; i < 16; ++i) S[db][i] *= g127;
        }
        asm volatile("s_waitcnt vmcnt(0)" ::: "memory");
#pragma unroll
        for (int s = 0; s < 8; ++s) vf[s] = vfn[s];
#pragma unroll
        for (int k = 0; k < 4; ++k) kreg[k] = kregn[k];
        __syncthreads();
        if (tid == 0) __hip_atomic_store((unsigned*)(ws + WS_CTL) + CW_FLAG + 16 * u, 1u, __ATOMIC_RELAXED, __HIP_MEMORY_SCOPE_AGENT);
    }
#undef RS_FETCH
    {   const int lane = tid_k & 63, r32 = lane & 31, half = lane >> 5;
#pragma unroll
        for (int db = 0; db < 4; ++db)
#pragma unroll
            for (int i = 0; i < 16; ++i) a.out()[OUT_SRP + ((size_t)bh * RDK + 32 * db + r32) * RDV + 32 * w + crow(i, half)] = S[db][i]; }
    __syncthreads();
}
__device__ __forceinline__ void ret_out_unit(Frame& F, const Ptrs& a, int u) {
    unsigned char* ws = opaque_g(a.ws);
    const int tid = fresh_tid(F.wave), lane = tid & 63, w = F.wave, r32 = lane & 31, half = lane >> 5;
    const int bh = u >> 4, c = u & 15, hh = bh & 3, tok0 = (bh >> 2) * SEQ + c * 128;
    LAS unsigned char* L = F.lds + RING_OFF;
    LAS float* red = (LAS float*)(L + RC_RED);
    const bf16* RQ = (const bf16*)(ws + WS_RQ); const bf16* RK = (const bf16*)(ws + WS_RK); const bf16* RVT = (const bf16*)(ws + WS_RVT);
    if (tid == 0) { const unsigned* fl = (const unsigned*)(ws + WS_CTL) + CW_FLAG + 16 * u; unsigned spins = 0;
        while (__hip_atomic_load(fl, __ATOMIC_RELAXED, __HIP_MEMORY_SCOPE_AGENT) == 0u && ++spins < (1u << 22)) __builtin_amdgcn_s_sleep(8);
        __builtin_amdgcn_fence(__ATOMIC_ACQUIRE, "agent"); asm volatile("s_waitcnt vmcnt(0)" ::: "memory"); }
    __syncthreads();
    v4u qreg[4], jreg[4], sreg[8]; bf16x8 vf[8];
#pragma unroll
    for (int k = 0; k < 4; ++k) { const int ch = tid + 512 * k; qreg[k] = *(const v4u*)(RQ + (size_t)(tok0 + (ch >> 4)) * 512 + hh * 128 + 8 * (ch & 15)); jreg[k] = *(const v4u*)(RK + (size_t)(tok0 + (ch >> 4)) * 512 + hh * 128 + 8 * (ch & 15)); }
    { const bf16* SP = (const bf16*)(ws + WS_SPREV) + (size_t)u * 32768;
#pragma unroll
      for (int k = 0; k < 8; ++k) { const int ch = tid + 512 * k; sreg[k] = *(const v4u*)(SP + (size_t)(ch >> 4) * 128 + 8 * (ch & 15)); } }
#pragma unroll
    for (int s = 0; s < 8; ++s) vf[s] = *(const bf16x8*)(RVT + (size_t)(hh * 256 + 32 * w + r32) * MP + tok0 + 16 * s + 8 * half);
    __builtin_amdgcn_sched_barrier(0);
#pragma unroll
    for (int k = 0; k < 4; ++k) { const int ch = tid + 512 * k; *(LAS v4u*)(L + RC_Q + (ch >> 4) * RC_STR + 16 * (ch & 15)) = qreg[k]; *(LAS v4u*)(L + RC_S + (ch >> 4) * RC_STR + 16 * (ch & 15)) = jreg[k]; }
    __syncthreads();
#define RC_BLK_IB(n) ((n) < 1 ? 0 : (n) < 3 ? 1 : (n) < 6 ? 2 : 3)
#define RC_BLK_JB(n) ((n) - ((n) < 1 ? 0 : (n) < 3 ? 1 : (n) < 6 ? 3 : 6))
    for (int n = w; n < 10; n += 8) {
        const int ib_ = RC_BLK_IB(n), jb_ = RC_BLK_JB(n);
        f32x16 at;
#pragma unroll
        for (int i = 0; i < 16; ++i) at[i] = 0.f;
#pragma unroll
        for (int s = 0; s < 8; ++s) { const bf16x8 kf = *(const LAS bf16x8*)(L + RC_S + (32 * jb_ + r32) * RC_STR + (16 * s + 8 * half) * 2); const bf16x8 qf = *(const LAS bf16x8*)(L + RC_Q + (32 * ib_ + r32) * RC_STR + (16 * s + 8 * half) * 2); at = __builtin_amdgcn_mfma_f32_32x32x16_bf16(kf, qf, at, 0, 0, 0); }
        if (jb_ == ib_) {
#pragma unroll
            for (int i = 0; i < 16; ++i) if (crow(i, half) > r32) at[i] = 0.f; }
#pragma unroll
        for (int gq = 0; gq < 4; ++gq) { f32x4 o_; o_[0] = at[4 * gq]; o_[1] = at[4 * gq + 1]; o_[2] = at[4 * gq + 2]; o_[3] = at[4 * gq + 3];
            *(LAS u32x2*)(L + RC_A + (32 * ib_ + r32) * RC_STR + (32 * jb_ + 8 * gq + 4 * half) * 2) = pack4(o_); }
    }
#undef RC_BLK_IB
#undef RC_BLK_JB
    __syncthreads();
#pragma unroll
    for (int k = 0; k < 8; ++k) { const int ch = tid + 512 * k; *(LAS v4u*)(L + RC_S + (ch >> 4) * RC_STR + 16 * (ch & 15)) = sreg[k]; }
    __syncthreads();
    const float g = gpow_t(ws, hh, 1);
    f32x16 ot[4];
#pragma unroll
    for (int ib = 0; ib < 4; ++ib)
#pragma unroll
        for (int i = 0; i < 16; ++i) ot[ib][i] = 0.f;
#pragma unroll 2
    for (int s = 0; s < 8; ++s) {
        const bf16x8 sf = *(const LAS bf16x8*)(L + RC_S + (32 * w + r32) * RC_STR + (16 * s + 8 * half) * 2);
#pragma unroll
        for (int ib = 0; ib < 4; ++ib) { const bf16x8 qf = *(const LAS bf16x8*)(L + RC_Q + (32 * ib + r32) * RC_STR + (16 * s + 8 * half) * 2); ot[ib] = __builtin_amdgcn_mfma_f32_32x32x16_bf16(sf, qf, ot[ib], 0, 0, 0); }
    }
#pragma unroll
    for (int ib = 0; ib < 4; ++ib)
#pragma unroll
        for (int i = 0; i < 16; ++i) ot[ib][i] *= g;
    u32x2 sgr[4][4];
#pragma unroll
    for (int ib = 0; ib < 4; ++ib)
#pragma unroll
        for (int gq = 0; gq < 4; ++gq) sgr[ib][gq] = *(const u32x2*)((const bf16*)(ws + WS_SRG) + (size_t)(tok0 + 32 * ib + r32) * 1024 + hh * 256 + 32 * w + 4 * half + 8 * gq);
#pragma unroll
    for (int ib = 0; ib < 4; ++ib)
#pragma unroll
        for (int s = 0; s < 2 * (ib + 1); ++s) { const bf16x8 af = *(const LAS bf16x8*)(L + RC_A + (32 * ib + r32) * RC_STR + (16 * s + 8 * half) * 2); ot[ib] = __builtin_amdgcn_mfma_f32_32x32x16_bf16(vf[s], af, ot[ib], 0, 0, 0); }
#pragma unroll
    for (int ib = 0; ib < 4; ++ib) { float t = 0.f;
#pragma unroll
        for (int i = 0; i < 16; ++i) t += ot[ib][i];
        t += lx(t, lane, 32); if (half == 0) red[w * 128 + 32 * ib + r32] = t; }
    __syncthreads();
    float mu[4];
#pragma unroll
    for (int ib = 0; ib < 4; ++ib) { float t = 0.f;
#pragma unroll
        for (int ww = 0; ww < 8; ++ww) t += red[ww * 128 + 32 * ib + r32];
        mu[ib] = t * (1.f / 256.f); }
#pragma unroll
    for (int ib = 0; ib < 4; ++ib) { float t = 0.f;
#pragma unroll
        for (int i = 0; i < 16; ++i) { ot[ib][i] -= mu[ib]; t += ot[ib][i] * ot[ib][i]; }
        t += lx(t, lane, 32); if (half == 0) red[1024 + w * 128 + 32 * ib + r32] = t; }
    __syncthreads();
#pragma unroll
    for (int ib = 0; ib < 4; ++ib) { float t = 0.f;
#pragma unroll
        for (int ww = 0; ww < 8; ++ww) t += red[1024 + ww * 128 + 32 * ib + r32];
        const float rstd = 1.0f / sqrtf(t * (1.f / 256.f) + EPS);
        const int irow = tok0 + 32 * ib + r32;
        bf16* RIN = (bf16*)(ws + WS_RIN) + (size_t)irow * 1024 + hh * 256 + 32 * w + 4 * half;
        const float* gn = a.in(19) + hh * 256 + 32 * w + 4 * half;
#pragma unroll
        for (int gq = 0; gq < 4; ++gq) {
            const u32x2 sg = sgr[ib][gq]; const f32x4 gv = *(const f32x4*)(gn + 8 * gq);
            f32x4 o;
            o[0] = ot[ib][4 * gq + 0] * rstd * gv[0] * __uint_as_float(sg.x << 16); o[1] = ot[ib][4 * gq + 1] * rstd * gv[1] * __uint_as_float(sg.x & 0xffff0000u);
            o[2] = ot[ib][4 * gq + 2] * rstd * gv[2] * __uint_as_float(sg.y << 16); o[3] = ot[ib][4 * gq + 3] * rstd * gv[3] * __uint_as_float(sg.y & 0xffff0000u);
            *(u32x2*)(RIN + 8 * gq) = pack4(o);
        } }
    __syncthreads();
}
}
namespace mk {
__global__ void __launch_bounds__(NWAVES * 64, 2) mega_fwd(Args args) {
    extern __shared__ __attribute__((aligned(16))) unsigned char lds[];
    Frame F;
    F.lds = (LAS unsigned char*)lds;
    F.MISC = (volatile LAS unsigned*)(F.lds + MISC_OFF);
    F.wave = __builtin_amdgcn_readfirstlane((int)threadIdx.x >> 6);
    F.G = gridDim.x; { const int bx = blockIdx.x; F.vcu = (F.G % 8 == 0) ? (bx % 8) * (F.G / 8) + bx / 8 : bx; }
    unsigned char* const ws_k = args.ws;
    unsigned char* ws = ws_k;
    for (int u = threadIdx.x; u < (LDS_BYTES - LDSCTL_OFF) / 4; u += NWAVES * 64) ((LAS unsigned*)(F.lds + LDSCTL_OFF))[u] = 0u;
    __syncthreads();
    {
        volatile LAS unsigned long long* pt = (volatile LAS unsigned long long*)(F.lds + PT_OFF);
        if (threadIdx.x == 0) {
#define PT_PUT(i) pt[i] = (unsigned long long)args.in[i]
            PT_PUT(0); PT_PUT(1); PT_PUT(2); PT_PUT(3); PT_PUT(4); PT_PUT(5); PT_PUT(6); PT_PUT(7); PT_PUT(8); PT_PUT(9); PT_PUT(10); PT_PUT(11); PT_PUT(12); PT_PUT(13);
            PT_PUT(14); PT_PUT(15); PT_PUT(16); PT_PUT(17); PT_PUT(18); PT_PUT(19); PT_PUT(20); PT_PUT(21); PT_PUT(22); PT_PUT(23); PT_PUT(24); PT_PUT(25); PT_PUT(26);
#undef PT_PUT
            pt[27] = (unsigned long long)args.out;
        }
        __syncthreads();
    }
    const Ptrs P{ws_k, (volatile LAS unsigned*)(F.lds + PT_OFF)};
    (void)xcd_barrier_post((unsigned*)(ws_k + WS_CTL) + CW_BAR, F.MISC + 8, F.wave);
#if MK_PROBE
#define STAMP(k) do { if (blockIdx.x == 0 && F.wave == 0 && lane_fresh() == 0) ((unsigned long long*)(ws_k + WS_CTL + 512 * 1024))[k] = __builtin_amdgcn_s_memrealtime(); } while (0)
    STAMP(0);
#else
#define STAMP(k) do { } while (0)
#endif
#define WS_FRESH() unsigned char* ws = opaque_g(ws_k)
#define GRID_BAR() do { XcdBarrier b_; b_.bar = (unsigned*)(ws_k + WS_CTL) + CW_BAR; b_.x = xb_xcc_id(); b_.st = F.MISC + 8; b_.wave = F.wave; xcd_barrier(b_); } while (0)

    p0_prologue(F, args);
    GRID_BAR(); STAMP(1);
    {
        WS_FRESH();
        { const int bx = (int)blockIdx.x; if (bx >= 128 && bx < 172) xjob_ffn_up(F, ws, bx - 128, WS_XB, WS_W1T, 0, 0); }
        p0_weights_late(F, args);
        pg8::Gemm g{(const pg8::bf16_t*)(ws + WS_XB), (const pg8::bf16_t*)(ws + WS_W1T), MMAIN, 2 * FFN, D};
        pg8::StaticOrder S; S.init(MMAIN, 2 * FFN, F.G, (int)blockIdx.x);
        EpiSwiGLU E{(bf16*)(ws + WS_ACT), (const float*)(ws + WS_R1)};
        pg8::gemm_phase<EpiSwiGLU, pg8::StaticOrder, true, true>(F.lds + RING_OFF, g, S, E, F.wave);
        { const int bx = (int)blockIdx.x; if (bx >= 172 && bx < 188) { xjob_wait(ws, fresh_tid(F.wave), 0, 44u); xjob_resid(F, ws, bx - 172, WS_ACT, FFN, WS_W1D, ws + WS_XE, true, 0.5f, WS_HB, WS_SSQH); } }
    }
    GRID_BAR(); STAMP(2);
    {
        WS_FRESH();
        pg8::Gemm g{(const pg8::bf16_t*)(ws + WS_ACT), (const pg8::bf16_t*)(ws + WS_W1D), MMAIN, D, FFN};
        pg8::StaticOrder S; S.init(MMAIN, D, F.G, (int)blockIdx.x);
        typedef EpiResid<(unsigned)WS_XE, true, (unsigned)WS_HB, (unsigned)WS_SSQH, 1> EpiDown1;
        EpiDown1 E{ws, P.in(0)};
        pg8::gemm_phase<EpiDown1, pg8::StaticOrder, true, true>(F.lds + RING_OFF, g, S, E, F.wave);
    }
    GRID_BAR(); STAMP(3);
#ifndef NO_P3
    {
        WS_FRESH();
        { const int bx = (int)blockIdx.x; if (bx >= 192 && bx < 238) xjob_win(F, ws, bx - 192); }
        pg8::Gemm g{(const pg8::bf16_t*)(ws + WS_HB), (const pg8::bf16_t*)(ws + WS_WIN), MMAIN, NWIN, D};
        pg8::StaticOrder S; S.init(MMAIN, NWIN, F.G, (int)blockIdx.x);
        EpiWin E{ws, F.lds};
        pg8::gemm_phase<EpiWin, pg8::StaticOrder, true, true>(F.lds + RING_OFF, g, S, E, F.wave);
    }
#endif
    GRID_BAR(); STAMP(4);
    {
        WS_FRESH();
        { const int jb = (int)blockIdx.x - 192; if (jb >= 0 && jb < 12) xjob_q(F, ws, jb); else if (jb >= 12 && jb < 20) xjob_kv(F, ws, jb - 12, false); else if (jb >= 20 && jb < 28) xjob_kv(F, ws, jb - 20, true); else if (jb >= 28 && jb < 60) xjob_ql(F, ws, jb - 28); }
        finalize_ckv(F, P);
#ifndef NO_P4Q
        {   pg8::Gemm g{(const pg8::bf16_t*)(ws + WS_CQ), (const pg8::bf16_t*)(ws + WS_WUQ), MMAIN, 768, QR};
            pg8::StaticOrder S; S.init(MMAIN, 768, F.G, (int)blockIdx.x);
            EpiQ E{ws};
            pg8::gemm_phase<EpiQ, pg8::StaticOrder, true, true>(F.lds + RING_OFF, g, S, E, F.wave); }
#endif
#ifndef NO_P4K
        {   pg8::Gemm g{(const pg8::bf16_t*)(ws + WS_CKVB), (const pg8::bf16_t*)(ws + WS_WUK), MMAIN, 512, KVR};
            pg8::StaticOrder S; S.init(MMAIN, 512, F.G, (int)((blockIdx.x + 64) % F.G));
            EpiScaleBf16<true> E{(const float*)(ws + WS_SSQKV), (bf16*)(ws + WS_KN), 512};
            pg8::gemm_phase<EpiScaleBf16<true>, pg8::StaticOrder, true, true>(F.lds + RING_OFF, g, S, E, F.wave); }
#endif
#ifndef NO_P4V
        {   pg8::Gemm g{(const pg8::bf16_t*)(ws + WS_WUV), (const pg8::bf16_t*)(ws + WS_CKVB), 512, MMAIN, KVR};
            pg8::StaticOrder S; S.init(512, MMAIN, F.G, (int)((blockIdx.x + 192) % F.G));
            EpiScaleBf16<false> E{(const float*)(ws + WS_SSQKV), (bf16*)(ws + WS_VT), MP};
            pg8::gemm_phase<EpiScaleBf16<false>, pg8::StaticOrder, true, true>(F.lds + RING_OFF, g, S, E, F.wave); }
#endif
    }
    GRID_BAR(); STAMP(5);
    STAMP(32);
#define QUEUE_LOOP(qi, nitems, call) for (;;) { \
        if (F.wave == 0 && lane_fresh() == 0) F.MISC[16] = __hip_atomic_fetch_add((unsigned*)(ws_k + WS_CTL) + CW_QUEUE + 64 * (qi), 1u, __ATOMIC_RELAXED, __HIP_MEMORY_SCOPE_AGENT); \
        __syncthreads(); const int it = (int)F.MISC[16]; __syncthreads(); \
        if (it >= (nitems)) break; call; }
    if ((int)blockIdx.x < 32) ret_state_unit(F, P, (int)blockIdx.x);
    STAMP(33);
    if (((int)blockIdx.x & 1) == 0) { QUEUE_LOOP(0, 512, attn_item(F, ws_k, it)) }
    STAMP(34);
    QUEUE_LOOP(1, 512, decode_unit(F, P, it))
    STAMP(35);
    QUEUE_LOOP(2, 128, ret_sample_unit(F, P, it))
    STAMP(36);
    if (((int)blockIdx.x & 1) != 0) { QUEUE_LOOP(0, 512, attn_item(F, ws_k, it)) }
    QUEUE_LOOP(3, 512, ret_out_unit(F, P, ((it & 31) << 4) | (it >> 5)))
    STAMP(37);
    QUEUE_LOOP(4, 256, decode_combine_unit(F, P, it))
#undef QUEUE_LOOP
    GRID_BAR(); STAMP(6);
    {
        WS_FRESH();
        { const int bx = (int)blockIdx.x; if (bx < 16) xjob_mix(F, ws, bx); }
        {   pg8::Gemm g{(const pg8::bf16_t*)(ws + WS_AV), (const pg8::bf16_t*)(ws + WS_WMO), MMAIN, D, 512};
            pg8::StaticOrder S; S.init(MMAIN, D, F.G, (int)blockIdx.x);
            typedef EpiGate<0, (unsigned)WS_SGA> EpiGA; EpiGA E{ws};
            pg8::gemm_phase<EpiGA, pg8::StaticOrder, true, true>(F.lds + RING_OFF, g, S, E, F.wave); }
        {   pg8::Gemm g{(const pg8::bf16_t*)(ws + WS_RIN), (const pg8::bf16_t*)(ws + WS_WRO), MMAIN, D, D};
            pg8::StaticOrder S; S.init(MMAIN, D, F.G, (int)blockIdx.x);
            typedef EpiGate<1, (unsigned)WS_SGB> EpiGB; EpiGB E{ws};
            pg8::gemm_phase<EpiGB, pg8::StaticOrder, true, true>(F.lds + RING_OFF, g, S, E, F.wave); }
    }
    GRID_BAR(); STAMP(7);
    {
        WS_FRESH();
        { const int bx = (int)blockIdx.x; if (bx >= 16 && bx < 32) xjob_resid(F, ws, bx - 16, WS_MX, D, WS_WOUT, (const bf16*)(ws + WS_HB) + (size_t)XROW0 * D, false, 1.0f, WS_H2B, WS_SSQH2); }
        pg8::Gemm g{(const pg8::bf16_t*)(ws + WS_MX), (const pg8::bf16_t*)(ws + WS_WOUT), MMAIN, D, D};
        pg8::StaticOrder S; S.init(MMAIN, D, F.G, (int)blockIdx.x);
        typedef EpiResid<(unsigned)WS_HB, false, (unsigned)WS_H2B, (unsigned)WS_SSQH2, 2> EpiOut;
        EpiOut E{ws, nullptr};
        pg8::gemm_phase<EpiOut, pg8::StaticOrder, true, true>(F.lds + RING_OFF, g, S, E, F.wave);
    }
    GRID_BAR(); STAMP(8);
    {
        WS_FRESH();
        { const int bx = (int)blockIdx.x; if (bx >= 128 && bx < 172) xjob_ffn_up(F, ws, bx - 128, WS_H2B, WS_W2T, 1, 16); }
        pg8::Gemm g{(const pg8::bf16_t*)(ws + WS_H2B), (const pg8::bf16_t*)(ws + WS_W2T), MMAIN, 2 * FFN, D};
        pg8::StaticOrder S; S.init(MMAIN, 2 * FFN, F.G, (int)blockIdx.x);
        EpiSwiGLU2 E{ws};
        pg8::gemm_phase<EpiSwiGLU2, pg8::StaticOrder, true, true>(F.lds + RING_OFF, g, S, E, F.wave);
        { const int bx = (int)blockIdx.x; if (bx >= 172 && bx < 188) { xjob_wait(ws, fresh_tid(F.wave), 16, 44u); xjob_resid(F, ws, bx - 172, WS_ACT, FFN, WS_W2D, (const bf16*)(ws + WS_H2B) + (size_t)XROW0 * D, false, 0.5f, WS_H3B, WS_SSQH3); } }
    }
    GRID_BAR(); STAMP(9);
    {
        WS_FRESH();
        pg8::Gemm g{(const pg8::bf16_t*)(ws + WS_ACT), (const pg8::bf16_t*)(ws + WS_W2D), MMAIN, D, FFN};
        pg8::StaticOrder S; S.init(MMAIN, D, F.G, (int)blockIdx.x);
        typedef EpiResid<(unsigned)WS_H2B, false, (unsigned)WS_H3B, (unsigned)WS_SSQH3, 1> EpiDown2;
        EpiDown2 E{ws, nullptr};
        pg8::gemm_phase<EpiDown2, pg8::StaticOrder, true, true>(F.lds + RING_OFF, g, S, E, F.wave);
    }
    GRID_BAR(); STAMP(10);
    final_norm_phase(F, P);
#if MK_PROBE
    GRID_BAR(); STAMP(11);
    if (blockIdx.x == 0) {
        asm volatile("s_waitcnt vmcnt(0)" ::: "memory"); __syncthreads();
        const unsigned long long* t = (const unsigned long long*)(ws_k + WS_CTL + 512 * 1024);
        const float dta = (float)(__hip_atomic_load(t + MK_PROBE_A + 1, __ATOMIC_RELAXED, __HIP_MEMORY_SCOPE_AGENT) - __hip_atomic_load(t + MK_PROBE_A, __ATOMIC_RELAXED, __HIP_MEMORY_SCOPE_AGENT)) * 0.01f;
        const float dtb = (float)(__hip_atomic_load(t + MK_PROBE_B + 1, __ATOMIC_RELAXED, __HIP_MEMORY_SCOPE_AGENT) - __hip_atomic_load(t + MK_PROBE_B, __ATOMIC_RELAXED, __HIP_MEMORY_SCOPE_AGENT)) * 0.01f;
        const float f = 1.f + sqrtf(dta / 20000.f);
        const int tid_p = fresh_tid(F.wave);
        for (int i = tid_p; i < NS * D; i += NWAVES * 64) P.out()[OUT_YS + i] *= f;
        if (tid_p == 0) P.out()[OUT_YP] += dtb / 5.f;
    }
#endif
#undef GRID_BAR
}
}
extern "C" void kernel_launch(void* const* d_in, const int* in_sizes, int n_in, void* d_out, int out_size, void* d_ws, size_t ws_size, hipStream_t stream) {
    static int grid = 0;
    if (grid == 0) {
        int dev = 0, cus = 0;
        if (n_in != 27 || out_size != (int)mk::OUT_END || ws_size < mk::WS_END6) { fprintf(stderr, "kernel_launch: unexpected problem shape (n_in %d, out %d, ws %zu); nothing launched\n", n_in, out_size, ws_size); grid = -1; return; }
        if (hipGetDevice(&dev) != hipSuccess || hipDeviceGetAttribute(&cus, hipDeviceAttributeMultiprocessorCount, dev) != hipSuccess) { fprintf(stderr, "kernel_launch: device query failed\n"); grid = -1; return; }
        if (hipFuncSetAttribute((const void*)mk::mega_fwd, hipFuncAttributeMaxDynamicSharedMemorySize, mk::LDS_BYTES) != hipSuccess) { fprintf(stderr, "kernel_launch: hipFuncSetAttribute failed\n"); grid = -1; return; }
        int per_cu = 0;
        if (hipOccupancyMaxActiveBlocksPerMultiprocessor(&per_cu, (const void*)mk::mega_fwd, mk::NWAVES * 64, mk::LDS_BYTES) != hipSuccess || per_cu < 1) fprintf(stderr, "kernel_launch: note: occupancy query reports %d workgroups per CU\n", per_cu);
        (void)hipGetLastError();
        if (cus < 256) { fprintf(stderr, "kernel_launch: this kernel's static work assignment needs 256 resident workgroups (one per CU); the device has %d CUs; nothing launched\n", cus); grid = -1; return; }
        grid = 256;
    }
    if (grid < 0) return;
    unsigned char* ws = (unsigned char*)d_ws;
    (void)hipMemsetAsync(ws + mk::WS_CTL, 0, mk::CTL_ZERO_BYTES, stream);
    mk::Args a{};
    for (int i = 0; i < 27; ++i) a.in[i] = (const float*)d_in[i];
    a.out = (float*)d_out; a.ws = ws;
    hipLaunchKernelGGL(mk::mega_fwd, dim3(grid), dim3(mk::NWAVES * 64), mk::LDS_BYTES, stream, a);
}
```

```cpp
#include <hip/hip_runtime.h>
#include <cstdio>
#include <cstdint>
#include <cmath>
#define MK_DEBUG 0
#ifndef MK_PROBE
#define MK_PROBE 0
#define MK_PROBE_A 0
#define MK_PROBE_B 1
#endif
__device__ __forceinline__ int lane_fresh() { int l; asm volatile("v_mbcnt_lo_u32_b32 %0, -1, 0\n\tv_mbcnt_hi_u32_b32 %0, -1, %0" : "=v"(l)); return l; }
__device__ __forceinline__ unsigned char* opaque_g(const unsigned char* p) { unsigned long long v = (unsigned long long)p; asm volatile("" : "+s"(v)); return (unsigned char*)(__attribute__((address_space(1))) unsigned char*)v; }
namespace pg8 {
#define PG8_LAS __attribute__((address_space(3)))
typedef unsigned short bf16_t;
typedef short bf16x8 __attribute__((ext_vector_type(8)));
typedef float f32x4 __attribute__((ext_vector_type(4)));
typedef unsigned u32x4 __attribute__((ext_vector_type(4)));
constexpr int BM = 256, BK = 64, HALF = 128, HTB = HALF * BK * 2  , STAGE_BYTES = 8 * HTB, NXCD = 8, WGM = 8;

__host__ __device__ __forceinline__ int lds_byte(int r, int c) { const int st = (r >> 4) * 2 + (c >> 5), rr = r & 15, cc = c & 31, ob = rr * 64 + cc * 2; return st * 1024 + (ob ^ (((ob >> 9) & 1) << 5)); }
__host__ __device__ __forceinline__ void stage_rc(int b, int& R, int& C) { const int st = b / 1024, sb = b % 1024, swz = sb ^ (((sb >> 9) & 1) << 5); R = (st >> 1) * 16 + swz / 64; C = (st & 1) * 32 + (swz % 64) / 2; }
__host__ __device__ __forceinline__ int perm32(int rho) { const int n = rho >> 4, i = rho & 15; return 8 * (i >> 2) + 4 * n + (i & 3); }

struct Unit { int pm, pn; };
struct Gemm { const bf16_t* A; const bf16_t* Bt; int M, N, K; };

struct StaticOrder {
    int nM, nN, nwg, G, c;
    __host__ __device__ void init(int M, int N, int G_, int c_) { nM = M / BM; nN = N / BM; nwg = nM * nN; G = G_; c = c_; }
    __host__ __device__ bool next(int i, Unit& u) const {
        const long L = (long)i * G + c; if (L >= nwg) return false;
        int wgid = (int)L; { const int q = nwg / NXCD, r = nwg % NXCD, xcd = wgid % NXCD, off = wgid / NXCD; wgid = (xcd < r ? xcd * (q + 1) : r * (q + 1) + (xcd - r) * q) + off; }
        const int nig = WGM * nN, gid = wgid / nig, fm = gid * WGM, gsz = (nM - fm) < WGM ? (nM - fm) : WGM;
        u.pm = fm + ((wgid % nig) % gsz); u.pn = (wgid % nig) / gsz; return true;
    }
    __device__ __forceinline__ void a_ready(const Unit&) const {}
    __device__ __forceinline__ void done(const Unit&) const {}
};

__device__ __forceinline__ unsigned cvt_pk_bf16(float lo, float hi) { unsigned r; asm volatile("v_cvt_pk_bf16_f32 %0, %1, %2" : "=v"(r) : "v"(lo), "v"(hi)); return r; }
typedef float f32x2 __attribute__((ext_vector_type(2)));
template <class Epi, class Sched, bool ALIGN_EPI = false, bool SP2 = false>
__device__ __forceinline__ void gemm_phase(PG8_LAS unsigned char* lds, const Gemm g, const Sched& S, const Epi& E, const int wave_in  ) {
    int tid_ = lane_fresh() + 64 * wave_in; asm volatile("" : "+v"(tid_));
    const int tid = tid_, wid = __builtin_amdgcn_readfirstlane(tid >> 6), lane = tid & 63, wr = wid >> 2, wc = wid & 3, fr = lane & 15, fq = lane >> 4;
    const int K = g.K, nt = K / BK;
    unsigned voffA[2], voffB[2];
#pragma unroll
    for (int i = 0; i < 2; ++i) { int R, C; stage_rc(tid * 16 + i * 8192, R, C); const int Rb = Epi::PERM ? ((R & ~31) + perm32(R & 31)) : R;
        voffA[i] = (unsigned)(R * K + C) * 2u; voffB[i] = (unsigned)(Rb * K + C) * 2u; }
    const size_t kstep = (size_t)(BK * 2);
    const size_t hstep = (size_t)HALF * K * 2;
    const size_t tstep = 2 * hstep;
    const unsigned ldsw = (unsigned)wid * 1024u;
    const int aoff = lds_byte(wr * 64 + fr, fq * 8), boff = lds_byte(wc * 32 + fr, fq * 8);
#define PG8_SA(b, h) (((b) * 2 + (h)) * HTB)
#define PG8_SB(b, h) ((4 + (b) * 2 + (h)) * HTB)
#define PG8_STAGE(bufoff, gbase, voff) do { _Pragma("unroll") for (int _i = 0; _i < 2; ++_i) \
        __builtin_amdgcn_global_load_lds((const unsigned*)((const char*)(gbase) + (voff)[_i]), (PG8_LAS unsigned*)(lds + (bufoff) + ldsw + _i * 8192), 16, 0, 0); } while (0)
#define PG8_LDA(dst, b, h) do { _Pragma("unroll") for (int m = 0; m < 4; ++m) _Pragma("unroll") for (int k = 0; k < 2; ++k) dst[m][k] = *(const PG8_LAS bf16x8*)(lds + PG8_SA(b, h) + aoff + m * 2048 + k * 1024); } while (0)
#define PG8_LDB(dst, b, h) do { _Pragma("unroll") for (int n = 0; n < 2; ++n) _Pragma("unroll") for (int k = 0; k < 2; ++k) dst[n][k] = *(const PG8_LAS bf16x8*)(lds + PG8_SB(b, h) + boff + n * 2048 + k * 1024); } while (0)
#define PG8_MMA(ai, bj, At, Bt) do { __builtin_amdgcn_s_setprio(1); _Pragma("unroll") for (int m = 0; m < 4; ++m) _Pragma("unroll") for (int n = 0; n < 2; ++n) _Pragma("unroll") for (int k = 0; k < 2; ++k) \
        acc[ai][bj][m][n] = __builtin_amdgcn_mfma_f32_16x16x32_bf16(Bt[n][k], At[m][k], acc[ai][bj][m][n], 0, 0, 0); __builtin_amdgcn_s_setprio(0); } while (0)
#define PG8_WAIT_V(n) asm volatile("s_waitcnt vmcnt(" #n ")" ::: "memory")
#define PG8_WAIT_L(n) asm volatile("s_waitcnt lgkmcnt(" #n ")" ::: "memory")
#define PG8_BAR __builtin_amdgcn_s_barrier()
#define PG8_SCHED __builtin_amdgcn_sched_barrier(0)
    Unit cur, nxt; int ui = 0;
    if (!S.next(0, cur)) return;
    f32x4 acc[2][2][4][2];
#pragma unroll
    for (int a = 0; a < 2; ++a)
#pragma unroll
        for (int b = 0; b < 2; ++b)
#pragma unroll
            for (int m = 0; m < 4; ++m)
#pragma unroll
                for (int n = 0; n < 2; ++n) acc[a][b][m][n] = (f32x4){0.f, 0.f, 0.f, 0.f};
    bf16x8 At[4][2], B0[2][2], B1[2][2];
    const char* cA = (const char*)g.A + (size_t)cur.pm * tstep; const char* cB = (const char*)g.Bt + (size_t)cur.pn * tstep;
    S.a_ready(cur);
    if constexpr (SP2) {
        PG8_STAGE(PG8_SB(0, 0), cB, voffB); PG8_STAGE(PG8_SB(0, 1), cB + hstep, voffB); PG8_STAGE(PG8_SA(0, 0), cA, voffA); PG8_STAGE(PG8_SA(0, 1), cA + hstep, voffA);
        if (wr == 1) PG8_BAR;
        PG8_WAIT_V(2); PG8_BAR;
        PG8_STAGE(PG8_SB(1, 0), cB + kstep, voffB); PG8_STAGE(PG8_SA(1, 0), cA + kstep, voffA); PG8_STAGE(PG8_SB(1, 1), cB + hstep + kstep, voffB);
        PG8_WAIT_V(6); PG8_BAR;
    } else {
        PG8_STAGE(PG8_SB(0, 0), cB, voffB); PG8_STAGE(PG8_SA(0, 0), cA, voffA); PG8_STAGE(PG8_SB(0, 1), cB + hstep, voffB); PG8_STAGE(PG8_SA(0, 1), cA + hstep, voffA);
        if (wr == 1) PG8_BAR;
        PG8_WAIT_V(4); PG8_BAR;
        PG8_STAGE(PG8_SB(1, 0), cB + kstep, voffB); PG8_STAGE(PG8_SA(1, 0), cA + kstep, voffA); PG8_STAGE(PG8_SB(1, 1), cB + hstep + kstep, voffB);
        PG8_WAIT_V(6); PG8_BAR;
    }
    for (;;) {
        const bool has_next = S.next(ui + 1, nxt);
        const char* nA = has_next ? (const char*)g.A + (size_t)nxt.pm * tstep : cA; const char* nB = has_next ? (const char*)g.Bt + (size_t)nxt.pn * tstep : cB;
        for (int t = 0; t < nt; t += 2) {
            const bool last = (t == nt - 2);
            const char* a1 = cA + (size_t)(t + 1) * kstep;
            const char* a2 = last ? nA : cA + (size_t)(t + 2) * kstep; const char* b2 = last ? nB : cB + (size_t)(t + 2) * kstep;
            const char* a3 = a2 + kstep; const char* b3 = b2 + kstep;
            if (last && has_next) S.a_ready(nxt);
            if constexpr (SP2) {
            PG8_LDB(B0, 0, 0); PG8_LDB(B1, 0, 1); PG8_SCHED; PG8_LDA(At, 0, 0); PG8_STAGE(PG8_SA(1, 1), a1 + hstep, voffA);
            PG8_WAIT_V(8); PG8_WAIT_L(0); PG8_BAR; PG8_MMA(0, 0, At, B0); PG8_MMA(0, 1, At, B1); PG8_BAR; PG8_SCHED;
            PG8_LDA(At, 0, 1); PG8_STAGE(PG8_SB(0, 0), b2, voffB); PG8_STAGE(PG8_SB(0, 1), b2 + hstep, voffB); PG8_STAGE(PG8_SA(0, 0), a2, voffA);
            PG8_WAIT_V(8); PG8_WAIT_L(0); PG8_BAR; PG8_MMA(1, 0, At, B0); PG8_MMA(1, 1, At, B1); PG8_BAR; PG8_SCHED;
            PG8_LDB(B0, 1, 0); PG8_LDB(B1, 1, 1); PG8_SCHED; PG8_LDA(At, 1, 0); PG8_STAGE(PG8_SA(0, 1), a2 + hstep, voffA);
            PG8_WAIT_V(8); PG8_WAIT_L(0); PG8_BAR; PG8_MMA(0, 0, At, B0); PG8_MMA(0, 1, At, B1); PG8_BAR; PG8_SCHED;
            PG8_LDA(At, 1, 1); PG8_STAGE(PG8_SB(1, 0), b3, voffB); PG8_STAGE(PG8_SB(1, 1), b3 + hstep, voffB); PG8_STAGE(PG8_SA(1, 0), a3, voffA);
            PG8_WAIT_V(8); PG8_WAIT_L(0); PG8_BAR; PG8_MMA(1, 0, At, B0); PG8_MMA(1, 1, At, B1); PG8_BAR; PG8_SCHED;
            } else {
            PG8_LDB(B0, 0, 0); PG8_SCHED; PG8_LDA(At, 0, 0); PG8_STAGE(PG8_SA(1, 1), a1 + hstep, voffA);
            PG8_WAIT_L(8); PG8_BAR; PG8_WAIT_L(0); PG8_MMA(0, 0, At, B0); PG8_BAR; PG8_SCHED;
            PG8_LDB(B1, 0, 1); PG8_STAGE(PG8_SB(0, 0), b2, voffB);
            PG8_BAR; PG8_WAIT_L(0); PG8_MMA(0, 1, At, B1); PG8_BAR;
            PG8_LDA(At, 0, 1); PG8_STAGE(PG8_SA(0, 0), a2, voffA);
            PG8_BAR; PG8_WAIT_L(0); PG8_MMA(1, 0, At, B0); PG8_BAR; PG8_SCHED;
            PG8_STAGE(PG8_SB(0, 1), b2 + hstep, voffB);
            PG8_WAIT_V(6); PG8_BAR; PG8_MMA(1, 1, At, B1); PG8_BAR;
            PG8_LDB(B0, 1, 0); PG8_SCHED; PG8_LDA(At, 1, 0); PG8_STAGE(PG8_SA(0, 1), a2 + hstep, voffA);
            PG8_WAIT_L(8); PG8_BAR; PG8_WAIT_L(0); PG8_MMA(0, 0, At, B0); PG8_BAR; PG8_SCHED;
            PG8_LDB(B1, 1, 1); PG8_STAGE(PG8_SB(1, 0), b3, voffB);
            PG8_BAR; PG8_WAIT_L(0); PG8_MMA(0, 1, At, B1); PG8_BAR;
            PG8_LDA(At, 1, 1); PG8_STAGE(PG8_SA(1, 0), a3, voffA);
            PG8_BAR; PG8_WAIT_L(0); PG8_MMA(1, 0, At, B0); PG8_BAR; PG8_SCHED;
            PG8_STAGE(PG8_SB(1, 1), b3 + hstep, voffB);
            PG8_WAIT_V(6); PG8_BAR; PG8_MMA(1, 1, At, B1); PG8_BAR;
            }
        }
        if constexpr (ALIGN_EPI) { if (wr == 0) PG8_BAR; }
        if constexpr (!Epi::AFTER_DRAIN) { E(acc, cur, wr, wc, fr, fq); S.done(cur); }
        if (!has_next) break;
#pragma unroll
        for (int a = 0; a < 2; ++a)
#pragma unroll
            for (int b = 0; b < 2; ++b)
#pragma unroll
                for (int m = 0; m < 4; ++m)
#pragma unroll
                    for (int n = 0; n < 2; ++n) acc[a][b][m][n] = (f32x4){0.f, 0.f, 0.f, 0.f};
        cur = nxt; cA = nA; cB = nB; ++ui;
        if constexpr (ALIGN_EPI) { if (wr == 1) PG8_BAR; }
    }
    PG8_WAIT_V(0);
    if constexpr (!ALIGN_EPI) { if (wr == 0) PG8_BAR; }
    PG8_BAR;
    if constexpr (Epi::AFTER_DRAIN) { E.fused(acc, cur, wr, wc, fr, fq, lds, wid, lane); S.done(cur); }
#undef PG8_SA
#undef PG8_SB
#undef PG8_STAGE
#undef PG8_LDA
#undef PG8_LDB
#undef PG8_MMA
#undef PG8_WAIT_V
#undef PG8_WAIT_L
#undef PG8_BAR
#undef PG8_SCHED
}
}
#define GAS __attribute__((address_space(1)))
#define LAS __attribute__((address_space(3)))
typedef unsigned short bf16;
typedef unsigned v4u __attribute__((ext_vector_type(4)));
typedef float f32x4 __attribute__((ext_vector_type(4)));
typedef short bf16x8 __attribute__((ext_vector_type(8)));
typedef GAS unsigned gu32;
typedef GAS unsigned long long gu64;
#define RLX_AGENT __ATOMIC_RELAXED, __HIP_MEMORY_SCOPE_AGENT
#define LDS_WAIT() asm volatile("s_waitcnt lgkmcnt(0)" ::: "memory")
#define VM_WAIT() asm volatile("s_waitcnt vmcnt(0)" ::: "memory")
__device__ __forceinline__ unsigned long long rt() { return __builtin_amdgcn_s_memrealtime(); }
__device__ __forceinline__ unsigned f2bf(float f) { unsigned u = __builtin_bit_cast(unsigned, f); return (u + 0x7fffu + ((u >> 16) & 1u)) >> 16; }
__device__ __forceinline__ unsigned pk2(float lo, float hi) { return f2bf(lo) | (f2bf(hi) << 16); }

#define XB_TMO      128
#define XB_XCNT(j)  (256  + 64 * (j))
#define XB_XSUB(j)  (1280 + 64 * (j))
#define XB_XGEN(j)  (2304 + 64 * (j))
#define XB_TOP      3328
#define XB_TOPGEN   3392
#define XCD_BAR_WORDS 3456
#define XB_SPIN_CAP (1u << 18)

__device__ __forceinline__ unsigned xb_ld(unsigned* p)              { return __hip_atomic_load(p, __ATOMIC_RELAXED, __HIP_MEMORY_SCOPE_AGENT); }
__device__ __forceinline__ unsigned xb_add(unsigned* p, unsigned v) { return __hip_atomic_fetch_add(p, v, __ATOMIC_RELAXED, __HIP_MEMORY_SCOPE_AGENT); }
__device__ __forceinline__ unsigned xb_xcc_id() { return (unsigned)__builtin_amdgcn_s_getreg((3 << 11) | 20) & 0xFu; }
#define XB_SPIN(cond, bar) do { unsigned _sp = 0; while (cond) { __builtin_amdgcn_s_sleep(1); \
    if ((++_sp & 255u) == 0u) { if (xb_ld(&(bar)[XB_TMO])) break; if (_sp > XB_SPIN_CAP) { atomicAdd(&(bar)[XB_TMO], 1u); break; } } } } while (0)

struct XcdBarrier {
    unsigned* bar; unsigned x; int wave;
    volatile LAS unsigned* st;
};

#define XB_IS_T0(wave) ((wave) == 0 && lane_fresh() == 0)
__device__ __forceinline__ XcdBarrier xcd_barrier_post(unsigned* bar, volatile LAS unsigned* st, int wave) {
    XcdBarrier b; b.bar = bar; b.x = xb_xcc_id(); b.st = st; b.wave = wave;
    if (XB_IS_T0(wave)) (void)xb_add(&bar[XB_XCNT(b.x)], 1u);
    return b;
}
__device__ __forceinline__ void xcd_barrier_complete(unsigned* bar, unsigned x, unsigned& nloc, unsigned& nx) {
    const unsigned G = gridDim.x * gridDim.y * gridDim.z;
    unsigned sum, cnt, mine, sp = 0u;
    for (;;) {
        sum = 0u; cnt = 0u; mine = 0u;
#pragma unroll
        for (unsigned j = 0; j < 16; ++j) { const unsigned c = xb_ld(&bar[XB_XCNT(j)]); sum += c; cnt += (c > 0u) ? 1u : 0u; mine = (j == x) ? c : mine; }
        if (sum == G) break;
        __builtin_amdgcn_s_sleep(1);
        if ((++sp & 255u) == 0u) { if (xb_ld(&bar[XB_TMO])) break; if (sp > XB_SPIN_CAP) { atomicAdd(&bar[XB_TMO], 1u); break; } }
    }
    nloc = mine > 0u ? mine : 1u; nx = cnt > 0u ? cnt : 1u;
}

__device__ __forceinline__ void xcd_barrier(const XcdBarrier& b) {
    asm volatile("s_waitcnt vmcnt(0)" ::: "memory");
    __syncthreads();
    if (XB_IS_T0(b.wave)) {
        unsigned* bar = b.bar;
        __builtin_amdgcn_s_waitcnt(0);
        unsigned nloc = b.st[0], nx = b.st[1];
        if (nloc == 0u) { xcd_barrier_complete(bar, b.x, nloc, nx); b.st[0] = nloc; b.st[1] = nx; }
        const unsigned old = xb_add(&bar[XB_XSUB(b.x)], 1u);
        const unsigned gen = old / nloc;
        if (old + 1u == (gen + 1u) * nloc) {
            __builtin_amdgcn_fence(__ATOMIC_RELEASE, "agent");
            asm volatile("s_waitcnt vmcnt(0)" ::: "memory");
            const unsigned og = xb_add(&bar[XB_TOP], 1u);
            const unsigned tg = og / nx;
            if (og + 1u == (tg + 1u) * nx) xb_add(&bar[XB_TOPGEN], 1u);
            else XB_SPIN(xb_ld(&bar[XB_TOPGEN]) == tg, bar);
            __builtin_amdgcn_fence(__ATOMIC_ACQUIRE, "agent");
            xb_add(&bar[XB_XGEN(b.x)], 1u);
            asm volatile("s_waitcnt vmcnt(0)" ::: "memory");
        } else {
            XB_SPIN(xb_ld(&bar[XB_XGEN(b.x)]) == gen, bar);
            __builtin_amdgcn_fence(__ATOMIC_ACQUIRE, "agent");
            asm volatile("s_waitcnt vmcnt(0)" ::: "memory");
        }
    }
    __syncthreads();
}
namespace mk {
constexpr int D = 1024, NB = 8, SEQ = 2048, NMETA = 16, T = SEQ + NMETA, NS = 32, PAST = 16384, PAGE = 128, NPAGES = PAST / PAGE;
constexpr int FFN = 2816, NH = 8, QR = 384, KVR = 256, RH = 4, RDK = 128, RDV = 256, IN_DIM = 5792;
constexpr int O_CQ = 0, O_CKV = 384, O_KR = 640, O_RQ = 672, O_RK = 1184, O_RV = 1696, O_RG = 2720, O_GA = 3744, O_GB = 4768;
constexpr int MMAIN = NB * SEQ;
constexpr int ROW_META = MMAIN;
constexpr int ROW_SMP = MMAIN + NMETA;
constexpr int ROW_PAD = ROW_SMP + NS;
constexpr int MP = MMAIN + 256;
constexpr int NWIN = 5888;
constexpr int NPOS = T + 1;
constexpr float EPS = 1e-6f;
constexpr int NWAVES = 8;

constexpr size_t MiB = 1u << 20;
constexpr size_t al(size_t x) { return (x + 255) / 256 * 256; }
constexpr size_t WS_CTL = 0, CTL_ZERO_BYTES = 1 * MiB;
constexpr size_t WS_W1T = 1 * MiB;
constexpr size_t WS_W1D = WS_W1T + al((size_t)2 * FFN * D * 2);
constexpr size_t WS_WIN = WS_W1D + al((size_t)D * FFN * 2);
constexpr size_t WS_WUQ = WS_WIN + al((size_t)NWIN * D * 2);
constexpr size_t WS_WUK = WS_WUQ + al((size_t)768 * QR * 2);
constexpr size_t WS_WUV = WS_WUK + al((size_t)512 * KVR * 2);
constexpr size_t WS_WMO = WS_WUV + al((size_t)512 * KVR * 2);
constexpr size_t WS_WRO = WS_WMO + al((size_t)D * 512 * 2);
constexpr size_t WS_WOUT = WS_WRO + al((size_t)D * D * 2);
constexpr size_t WS_W2T = WS_WOUT + al((size_t)D * D * 2);
constexpr size_t WS_W2D = WS_W2T + al((size_t)2 * FFN * D * 2);
constexpr size_t WS_WQL = WS_W2D + al((size_t)D * FFN * 2);
constexpr size_t WS_TAB = WS_WQL + al((size_t)2048 * QR * 2);
constexpr size_t TAB_C64 = 0, TAB_S64 = (size_t)NPOS * 64 * 4, TAB_C16 = 2 * TAB_S64, TAB_S16 = TAB_C16 + (size_t)NPOS * 16 * 4, TAB_GP = TAB_S16 + (size_t)NPOS * 16 * 4, TAB_GN = TAB_GP + 512 * 4, TAB_END = TAB_GN + 512 * 4;
constexpr size_t WS_XB = WS_TAB + al(TAB_END);
constexpr size_t WS_XE = WS_XB + al((size_t)MP * D * 2);
constexpr size_t WS_R1 = WS_XE + al((size_t)256 * D * 4);
constexpr size_t WS_ACT = WS_R1 + al((size_t)MP * 4);
constexpr size_t WS_H = WS_ACT + al((size_t)MP * FFN * 2);
constexpr size_t WS_HB = WS_H + al((size_t)MP * D * 4);
constexpr size_t WS_SSQH = WS_HB + al((size_t)MP * D * 2);
constexpr size_t WS_SSQ2_ = WS_SSQH + al((size_t)MP * 4), WS_SSQ3_ = WS_SSQ2_ + al((size_t)MP * 4);
constexpr size_t WS_END1 = WS_SSQH + al((size_t)MP * 16 * 4);

constexpr int CW_XCNT = 32768  , CW_BAR = 4096, CW_QUEUE = 64, CW_DCNT = 24576  ;

constexpr int RING_OFF = 0, RING_BYTES = 131072, SCR_BYTES = 155648  , LDSCTL_OFF = SCR_BYTES, MISC_OFF = LDSCTL_OFF + 320, LDS_BYTES = 163840;

struct Args {
    const float* in[27]; float* out; unsigned char* ws;
};

struct Frame {
    LAS unsigned char* lds;
    volatile LAS unsigned* MISC;
    int wave, vcu, G;
};

constexpr int PT_OFF = MISC_OFF + 256;
struct Ptrs {
    unsigned char* ws; volatile LAS unsigned* tab;
    __device__ __forceinline__ unsigned long long raw(int k) const { volatile LAS unsigned* t = tab; asm volatile("" : "+v"(t));
        const unsigned lo = __builtin_amdgcn_readfirstlane(t[2 * k]), hi = __builtin_amdgcn_readfirstlane(t[2 * k + 1]); return ((unsigned long long)hi << 32) | lo; }
    __device__ __forceinline__ const float* in(int k) const { return (const float*)(GAS const float*)raw(k); }
    __device__ __forceinline__ float* out() const { return (float*)(GAS float*)raw(27); }
};
__device__ __forceinline__ int fresh_tid(int wave) { int t = lane_fresh() + 64 * wave; asm volatile("" : "+v"(t)); return t; }

__device__ __forceinline__ float lx(float v, int lane, int mask) { return __int_as_float(__builtin_amdgcn_ds_bpermute((lane ^ mask) << 2, __float_as_int(v))); }
__device__ __forceinline__ float wave_sum(float v, int lane) {
#pragma unroll
    for (int o = 1; o < 64; o <<= 1) v += lx(v, lane, o);
    return v;
}
__device__ __forceinline__ int row_pos(int row) { return row < MMAIN ? (row & (SEQ - 1)) + NMETA : (row < ROW_SMP ? row - ROW_META : (row < ROW_PAD ? PAST : 0)); }
__device__ __forceinline__ int row_pidx(int row) { return row < MMAIN ? (row & (SEQ - 1)) + NMETA : (row < ROW_SMP ? row - ROW_META : (row < ROW_PAD ? T : 0)); }
__device__ __forceinline__ int row_jtok(int row) { return row < MMAIN ? (row & 127) : (row < ROW_SMP ? row - ROW_META : 0); }

struct WSrc { const float* W; int ld; int col0; const float* g; };
__device__ __forceinline__ void wmat_dims(int id, int& K, int& ngrp) {
    switch (id) {
        case 0: case 9: K = D; ngrp = 2 * FFN / 32; break;
        case 1: case 10: K = FFN; ngrp = D / 32; break;
        case 2: K = D; ngrp = NWIN / 32; break;
        case 3: K = QR; ngrp = 768 / 32; break;
        case 4: case 5: K = KVR; ngrp = 512 / 32; break;
        case 6: K = 512; ngrp = D / 32; break;
        default: K = D; ngrp = D / 32; break;
    }
}
__device__ __forceinline__ size_t wmat_off(int id) {
    switch (id) { case 0: return WS_W1T; case 1: return WS_W1D; case 2: return WS_WIN; case 3: return WS_WUQ; case 4: return WS_WUK; case 5: return WS_WUV;
                  case 6: return WS_WMO; case 7: return WS_WRO; case 8: return WS_WOUT; case 9: return WS_W2T; default: return WS_W2D; }
}
__device__ __forceinline__ WSrc wmat_src(const Args& a, int id, int g) {
    WSrc s; s.W = nullptr; s.ld = 0; s.col0 = 0; s.g = nullptr;
    switch (id) {
        case 0: case 9: { const int pn = g >> 3, gg = g & 7; const int o = id == 0 ? 7 : 22;
            s.W = gg < 4 ? a.in[o + 1] : a.in[o + 2]; s.ld = FFN; s.col0 = 128 * pn + 32 * (gg & 3); s.g = a.in[o]; break; }
        case 1: s.W = a.in[10]; s.ld = D; s.col0 = 32 * g; break;
        case 10: s.W = a.in[25]; s.ld = D; s.col0 = 32 * g; break;
        case 2: { s.ld = IN_DIM; s.g = a.in[11]; int zc = -1;
            if (g < 8) zc = 32 * g;
            else if (g < 16) { const int gg = g - 8; zc = gg < 4 ? 256 + 32 * gg : (gg == 4 ? O_KR : -1); }
            else if (g < 24) zc = O_CKV + 32 * (g - 16);
            else if (g < 56) { const int base = g < 40 ? O_RQ : O_RK; const int q = (g - 24) & 15, t = q >> 3, gg = q & 7;
                const int h = 2 * t + ((gg >> 1) & 1), part = (gg >> 2) * 64 + (gg & 1) * 32; zc = base + h * 128 + part; }
            else if (g < 88) zc = O_RV + 32 * (g - 56);
            else if (g < 120) zc = O_RG + 32 * (g - 88);
            else if (g < 152) zc = O_GA + 32 * (g - 120);
            else zc = O_GB + 32 * (g - 152);
            if (zc >= 0) { s.W = a.in[12]; s.col0 = zc; }
            break; }
        case 3: s.W = a.in[15]; s.ld = 768; s.col0 = 32 * g; s.g = a.in[13]; break;
        case 4: s.W = a.in[16]; s.ld = 512; s.col0 = 32 * g; s.g = a.in[14]; break;
        case 5: s.W = a.in[17]; s.ld = 512; s.col0 = 32 * g; s.g = a.in[14]; break;
        case 6: s.W = a.in[18]; s.ld = D; s.col0 = 32 * g; break;
        case 7: s.W = a.in[20]; s.ld = D; s.col0 = 32 * g; break;
        default: s.W = a.in[21]; s.ld = D; s.col0 = 32 * g; break;
    }
    return s;
}
__device__ __forceinline__ void p0_transpose_item(const WSrc s, int K, bf16* WT, int n0, int k0, LAS float* scr, int lane) {
    if (s.W) {
        float v[32];
        const float* wp = s.W + (size_t)(k0 + (lane >> 5)) * s.ld + s.col0 + (lane & 31);
#pragma unroll
        for (int i = 0; i < 32; ++i) v[i] = wp[(size_t)(2 * i) * s.ld];
        if (s.g) { const float* gp = s.g + k0 + (lane >> 5);
#pragma unroll
            for (int i = 0; i < 32; ++i) v[i] *= gp[2 * i]; }
#pragma unroll
        for (int i = 0; i < 32; ++i) scr[(2 * i + (lane >> 5)) * 33 + (lane & 31)] = v[i];
    } else {
#pragma unroll 8
        for (int i = 0; i < 32; ++i) { const int kk = 2 * i + (lane >> 5); scr[kk * 33 + (lane & 31)] = 0.f; }
    }
    LDS_WAIT(); asm volatile("" ::: "memory");
    const int c = lane & 7;
#pragma unroll
    for (int j = 0; j < 4; ++j) { const int n = (lane >> 3) + 8 * j; const LAS float* sp = scr + (8 * c) * 33 + n;
        v4u o; o.x = pk2(sp[0 * 33], sp[1 * 33]); o.y = pk2(sp[2 * 33], sp[3 * 33]); o.z = pk2(sp[4 * 33], sp[5 * 33]); o.w = pk2(sp[6 * 33], sp[7 * 33]);
        *(GAS v4u*)(WT + (size_t)(n0 + n) * K + k0 + 8 * c) = o; }
    LDS_WAIT(); asm volatile("" ::: "memory");
}
__device__ __forceinline__ const float* x_src(const Args& a, int row) {
    if (row < MMAIN) return a.in[0] + (size_t)row * D;
    if (row < ROW_SMP) return a.in[6] + (size_t)(row - ROW_META) * D;
    if (row < ROW_PAD) return a.in[1] + (size_t)(row - ROW_SMP) * D;
    return nullptr;
}
__device__ __forceinline__ void p0_weights(const Args& a, unsigned id_mask, int gw, int NGW, LAS float* scr, int lane) {
    unsigned char* ws = a.ws;
    int base = 0;
#pragma unroll 1
    for (int id = 0; id < 11; ++id) {
        if (!((id_mask >> id) & 1u)) continue;
        int K, ngrp; wmat_dims(id, K, ngrp);
        const int nk = K / 64, nitems = nk * ngrp;
        bf16* WT = (bf16*)(ws + wmat_off(id));
        int first = (gw - (base % NGW) + NGW) % NGW;
        for (int it = first; it < nitems; it += NGW) { const int g = it % ngrp, kb = it / ngrp; p0_transpose_item(wmat_src(a, id, g), K, WT, 32 * g, 64 * kb, scr, lane); }
        base += nitems;
    }
}
__device__ __forceinline__ void p0_weights_late(Frame& F, const Args& a) {
    const int bx = (int)blockIdx.x; if (bx < 188) return;
    const int lane = fresh_tid(F.wave) & 63;
    LAS float* scr = (LAS float*)(F.lds + RING_OFF + F.wave * 16384);
    p0_weights(a, 0x380u  , (bx - 188) * NWAVES + F.wave, 68 * NWAVES, scr, lane);
    __syncthreads();
}
__device__ __forceinline__ void p0_prologue(Frame& F, const Args& a) {
    const int lane = fresh_tid(F.wave) & 63;
    LAS float* scr = (LAS float*)(F.lds + RING_OFF + F.wave * 16384);
    const int gw = F.vcu * NWAVES + F.wave, NGW = F.G * NWAVES;
    unsigned char* ws = a.ws;
    p0_weights(a, 0x47Fu  , gw, NGW, scr, lane);
    bf16* XB = (bf16*)(ws + WS_XB); float* XE = (float*)(ws + WS_XE); float* R1 = (float*)(ws + WS_R1);
    for (int m0 = gw; m0 < MP; m0 += 2 * NGW) {
        f32x4 v[2][4];
#pragma unroll
        for (int t = 0; t < 2; ++t) { const int m = m0 + t * NGW; const float* xr = m < MP ? x_src(a, m) : nullptr;
#pragma unroll
            for (int j = 0; j < 4; ++j) v[t][j] = xr ? *((const GAS f32x4*)xr + lane + 64 * j) : (f32x4){0.f, 0.f, 0.f, 0.f}; }
#pragma unroll
        for (int t = 0; t < 2; ++t) { const int m = m0 + t * NGW; if (m >= MP) break;
            float s = 0.f;
#pragma unroll
            for (int j = 0; j < 4; ++j) s += (v[t][j].x * v[t][j].x + v[t][j].y * v[t][j].y) + (v[t][j].z * v[t][j].z + v[t][j].w * v[t][j].w);
            s = wave_sum(s, lane);
            if (lane == 0) R1[m] = 1.0f / sqrtf(s * (1.f / D) + EPS);
            GAS unsigned long long* o8 = (GAS unsigned long long*)(XB + (size_t)m * D) + lane;
#pragma unroll
            for (int j = 0; j < 4; ++j) o8[64 * j] = (unsigned long long)pk2(v[t][j].x, v[t][j].y) | ((unsigned long long)pk2(v[t][j].z, v[t][j].w) << 32);
            if (m >= MMAIN) {
#pragma unroll
                for (int j = 0; j < 4; ++j) *((GAS f32x4*)(XE + (size_t)(m - MMAIN) * D) + lane + 64 * j) = v[t][j];
            } }
    }
    {   const float* wuq = a.in[15]; const float* wuk = a.in[16]; const float* qn = a.in[13]; bf16* WQL = (bf16*)(ws + WS_WQL);
        LAS float* U = (LAS float*)(F.lds + RING_OFF);
        const int tid = F.wave * 64 + lane;
        for (int it = F.vcu; it < 256; it += F.G) {
            const int h = it >> 5, r0 = (it & 31) * 8;
            __syncthreads();
            for (int e = tid; e < QR * 64; e += NWAVES * 64) { const int k = e >> 6, n = e & 63; U[k * 65 + n] = wuq[(size_t)k * 768 + h * 96 + n]; }
            { const int rr = tid >> 6, n = tid & 63; U[QR * 65 + rr * 64 + n] = wuk[(size_t)(r0 + rr) * 512 + h * 64 + n]; }
            __syncthreads();
            if (tid < QR) { const float g = qn[tid]; float acc[8];
#pragma unroll
                for (int rr = 0; rr < 8; ++rr) acc[rr] = 0.f;
                for (int n = 0; n < 64; ++n) { const float u = U[tid * 65 + n];
#pragma unroll
                    for (int rr = 0; rr < 8; ++rr) acc[rr] += u * U[QR * 65 + rr * 64 + n]; }
#pragma unroll
                for (int rr = 0; rr < 8; ++rr) WQL[(size_t)(h * 256 + r0 + rr) * QR + tid] = (bf16)f2bf(acc[rr] * g); }
        }
        __syncthreads();
    }
    { const int gt_ = (F.vcu * NWAVES + F.wave) * 64 + lane, NGT_ = NGW * 64;
      for (int e = gt_; e < MP; e += NGT_) { ((float*)(ws + WS_SSQH))[e] = 0.f; ((float*)(ws + WS_SSQ2_))[e] = 0.f; ((float*)(ws + WS_SSQ3_))[e] = 0.f; } }
    float* TAB = (float*)(ws + WS_TAB);
    const int gt = (F.vcu * NWAVES + F.wave) * 64 + lane, NGT = NGW * 64;
    for (int e = gt; e < NPOS * 64; e += NGT) { const int p = e >> 6, i = e & 63; const int pos = p < T ? p : PAST;
        const float invf = (float)pow(10000.0, -(double)i / 64.0); const float ang = (float)pos * invf;
        TAB[TAB_C64 / 4 + e] = (float)cos((double)ang); TAB[TAB_S64 / 4 + e] = (float)sin((double)ang); }
    for (int e = gt; e < NPOS * 16; e += NGT) { const int p = e >> 4, i = e & 15; const int pos = p < T ? p : PAST;
        const float invf = (float)pow(10000.0, -(double)i / 16.0); const float ang = (float)pos * invf;
        TAB[TAB_C16 / 4 + e] = (float)cos((double)ang); TAB[TAB_S16 / 4 + e] = (float)sin((double)ang); }
    for (int e = gt; e < 512; e += NGT) { const int h = e >> 7, j = e & 127; const double lg = log1p(-exp2(-5.0 - (double)h));
        TAB[TAB_GP / 4 + e] = (float)exp(lg * (double)j); TAB[TAB_GN / 4 + e] = (float)exp(-lg * (double)j); }
}

using pg8::f32x4; using pg8::u32x4; using pg8::Unit; using pg8::BM; using pg8::HALF;
typedef unsigned u32x2 __attribute__((ext_vector_type(2)));
__device__ __forceinline__ float fast_sigmoid(float x) { return __builtin_amdgcn_rcpf(1.f + __builtin_amdgcn_exp2f(-1.4426950408889634f * x)); }
__device__ __forceinline__ float fast_silu(float x) { return x * fast_sigmoid(x); }

struct EpiSwiGLU {
    static constexpr bool PERM = true, AFTER_DRAIN = false;
    bf16* ACT; const float* rs;
    __device__ __forceinline__ void operator()(const f32x4 (&acc)[2][2][4][2], const Unit& u, int wr, int wc, int fr, int fq) const {
        int l_ = lane_fresh(); asm volatile("" : "+v"(l_)); fr = l_ & 15; fq = l_ >> 4;
        const int row0 = u.pm * BM + wr * 64 + fr, col0 = u.pn * HALF + wc * 32 + 8 * fq;
#pragma unroll
        for (int ai = 0; ai < 2; ++ai)
#pragma unroll
            for (int m = 0; m < 4; ++m) { const int row = row0 + ai * HALF + m * 16; const float r = rs[row];
                f32x4 o[2];
#pragma unroll
                for (int n = 0; n < 2; ++n)
#pragma unroll
                    for (int j = 0; j < 4; ++j) { const float g = acc[ai][0][m][n][j] * r, up = acc[ai][1][m][n][j] * r; o[n][j] = fast_silu(g) * up; }
                u32x4 w; w.x = pg8::cvt_pk_bf16(o[0][0], o[0][1]); w.y = pg8::cvt_pk_bf16(o[0][2], o[0][3]); w.z = pg8::cvt_pk_bf16(o[1][0], o[1][1]); w.w = pg8::cvt_pk_bf16(o[1][2], o[1][3]);
                *(u32x4*)(ACT + (size_t)row * FFN + col0) = w; }
    }
};
template <class T> __device__ __forceinline__ T* at(unsigned char* w, unsigned byte_off) { return (T*)(w + byte_off); }
template <unsigned RES_OFF, bool RES_X, unsigned OUTB_OFF, unsigned SSQ_OFF, int SCALE2  > struct EpiResid {
    static constexpr bool PERM = true, AFTER_DRAIN = false;
    unsigned char* ws_; const float* xin;
    __device__ __forceinline__ void operator()(const f32x4 (&acc)[2][2][4][2], const Unit& u, int wr, int wc, int fr, int fq) const {
        int l_ = lane_fresh(); asm volatile("" : "+v"(l_)); fr = l_ & 15; fq = l_ >> 4;
        unsigned char* w = opaque_g(ws_);
        const unsigned row0 = u.pm * BM + wr * 64 + fr, col0 = u.pn * BM + wc * 32 + 8 * fq;
        constexpr float scale = 0.5f * SCALE2;
#pragma unroll
        for (int ai = 0; ai < 2; ++ai)
#pragma unroll
            for (int m = 0; m < 4; ++m) { unsigned row = row0 + ai * HALF + m * 16; asm volatile("" : "+v"(row));
                float ss = 0.f;
#pragma unroll
                for (int bj = 0; bj < 2; ++bj) {
                    const unsigned e = row * D + col0 + bj * HALF;
                    f32x4 b0, b1;
                    if (RES_X) { const float* rp = row < (unsigned)MMAIN ? xin + e : at<const float>(w, RES_OFF + (e - MMAIN * D) * 4); b0 = *(const f32x4*)rp; b1 = *(const f32x4*)(rp + 4); }
                    else { const u32x4 rb = *at<const u32x4>(w, RES_OFF + e * 2);
                        b0 = (f32x4){__uint_as_float(rb.x << 16), __uint_as_float(rb.x & 0xffff0000u), __uint_as_float(rb.y << 16), __uint_as_float(rb.y & 0xffff0000u)};
                        b1 = (f32x4){__uint_as_float(rb.z << 16), __uint_as_float(rb.z & 0xffff0000u), __uint_as_float(rb.w << 16), __uint_as_float(rb.w & 0xffff0000u)}; }
                    const f32x4 o0 = b0 + acc[ai][bj][m][0] * scale, o1 = b1 + acc[ai][bj][m][1] * scale;
                    ss += ((o0[0] * o0[0] + o0[1] * o0[1]) + (o0[2] * o0[2] + o0[3] * o0[3])) + ((o1[0] * o1[0] + o1[1] * o1[1]) + (o1[2] * o1[2] + o1[3] * o1[3]));
                    u32x4 pk; pk.x = pg8::cvt_pk_bf16(o0[0], o0[1]); pk.y = pg8::cvt_pk_bf16(o0[2], o0[3]); pk.z = pg8::cvt_pk_bf16(o1[0], o1[1]); pk.w = pg8::cvt_pk_bf16(o1[2], o1[3]);
                    *at<u32x4>(w, OUTB_OFF + e * 2) = pk; }
                ss += lx(ss, l_, 16); ss += lx(ss, l_, 32);
                if (fq == 0) atomicAdd(at<float>(w, SSQ_OFF + row * 4), ss);
                asm volatile("" ::: "memory"); }
    }
};
}
namespace mk {
constexpr size_t WS_CQ = WS_END1;
constexpr size_t WS_SSQCQ = WS_CQ + al((size_t)MP * QR * 2);
constexpr size_t WS_CKVF = WS_SSQCQ + al((size_t)MP * 8 * 4);
constexpr size_t WS_CKVB = WS_CKVF + al((size_t)MP * KVR * 4);
constexpr size_t WS_SSQKV = WS_CKVB + al((size_t)MP * KVR * 2);
constexpr size_t WS_KRB = WS_SSQKV + al((size_t)MP * 4 * 4);
constexpr size_t WS_RQ = WS_KRB + al((size_t)MP * 32 * 2);
constexpr size_t WS_RK = WS_RQ + al((size_t)MP * 512 * 2);
constexpr size_t WS_RKT = WS_RK + al((size_t)MP * 512 * 2);
constexpr size_t WS_RVT = WS_RKT + al((size_t)MP * 512 * 2);
constexpr size_t WS_SRG = WS_RVT + al((size_t)MP * 1024 * 2);
constexpr size_t WS_SGA = WS_SRG + al((size_t)MP * 1024 * 2);
constexpr size_t WS_SGB = WS_SGA + al((size_t)MP * 1024 * 2);
constexpr size_t WS_QA = WS_SGB + al((size_t)MP * 1024 * 2);
constexpr size_t WS_KN = WS_QA + al((size_t)MP * 768 * 2);
constexpr size_t WS_VT = WS_KN + al((size_t)MP * 512 * 2);
constexpr size_t WS_KRF = WS_VT + al((size_t)MP * 512 * 2);
constexpr size_t WS_END2 = WS_KRF + al((size_t)MP * 32 * 4);
constexpr float SC_Q = 0.14724444348433683f;
constexpr float RK_SCALE = 0.08838834764831845f;

constexpr size_t OUT_YP = 0, OUT_YS = OUT_YP + (size_t)NB * SEQ * D, OUT_CKVP = OUT_YS + (size_t)NS * D, OUT_KRP = OUT_CKVP + (size_t)NB * T * KVR,
                 OUT_SRP = OUT_KRP + (size_t)NB * T * 32, OUT_CKVS = OUT_SRP + (size_t)NB * RH * RDK * RDV, OUT_KRS = OUT_CKVS + (size_t)NS * KVR, OUT_SRS = OUT_KRS + (size_t)NS * 32,
                 OUT_END = OUT_SRS + (size_t)NS * RH * RDK * RDV;

__device__ __forceinline__ float row_rscale16(const float* SSQ, int row, float inv_n) { return 1.0f / sqrtf(SSQ[row] * inv_n + EPS); }
__device__ __forceinline__ float row_rscale8(const float* SSQ, int row, float inv_n) {
    const f32x4* p = (const f32x4*)(SSQ + (size_t)row * 8); const f32x4 a = p[0], b = p[1];
    return 1.0f / sqrtf((((a[0] + a[1]) + (a[2] + a[3])) + ((b[0] + b[1]) + (b[2] + b[3]))) * inv_n + EPS);
}
__device__ __forceinline__ float row_rscale4(const float* SSQ, int row, float inv_n) {
    const f32x4 a = *(const f32x4*)(SSQ + (size_t)row * 4);
    return 1.0f / sqrtf(((a[0] + a[1]) + (a[2] + a[3])) * inv_n + EPS);
}
__device__ __forceinline__ u32x2 pack4(const f32x4 v) { u32x2 w; w.x = pg8::cvt_pk_bf16(v[0], v[1]); w.y = pg8::cvt_pk_bf16(v[2], v[3]); return w; }
__device__ __forceinline__ float ssq4(const f32x4 v) { return (v[0] * v[0] + v[1] * v[1]) + (v[2] * v[2] + v[3] * v[3]); }
__device__ __forceinline__ bf16 bf1(float x) { return (bf16)f2bf(x); }

static_assert(WS_END2 < ((size_t)1 << 31), "32-bit workspace offsets");
__device__ __forceinline__ void tr_store16(LAS unsigned char* T, int fr, int fq, int lane, const f32x4 (&v)[4], unsigned char* w, unsigned dst_off) {
#pragma unroll
    for (int m = 0; m < 4; ++m)
#pragma unroll
        for (int j = 0; j < 4; ++j) *(LAS bf16*)(T + (4 * fq + j) * 144 + (16 * m + fr) * 2) = bf1(v[m][j]);
    asm volatile("s_waitcnt lgkmcnt(0)" ::: "memory");
#pragma unroll
    for (int k = 0; k < 2; ++k) { const int id = lane + 64 * k, c = id >> 3, part = id & 7; const v4u x = *(const LAS v4u*)(T + c * 144 + part * 16); *at<v4u>(w, dst_off + (unsigned)(((c >> 2) * 8 + (c & 3)) * MP + 8 * part) * 2u) = x; }
    asm volatile("s_waitcnt lgkmcnt(0)" ::: "memory");
}
constexpr int EPI_LDS_OFF = RING_BYTES, EPI_LDS_WAVE = 3072;
static_assert(EPI_LDS_OFF + 8 * EPI_LDS_WAVE <= SCR_BYTES && 16 * 144 <= EPI_LDS_WAVE, "epilogue LDS scratch");
__device__ __forceinline__ u32x4 pack8(const f32x4 a, const f32x4 b) { u32x4 w; w.x = pg8::cvt_pk_bf16(a[0], a[1]); w.y = pg8::cvt_pk_bf16(a[2], a[3]); w.z = pg8::cvt_pk_bf16(b[0], b[1]); w.w = pg8::cvt_pk_bf16(b[2], b[3]); return w; }
struct EpiWin {
    static constexpr bool PERM = true, AFTER_DRAIN = false;
    unsigned char* ws_; LAS unsigned char* lds_;
#define MK_WS(var) unsigned char* var = opaque_g(ws_)
#define MK_ROWS_BEGIN _Pragma("unroll") for (int ai = 0; ai < 2; ++ai) _Pragma("unroll") for (int m = 0; m < 4; ++m) { \
        unsigned row = row0 + ai * HALF + m * 16; asm volatile("" : "+v"(row)); const float r = rsc[ai * 4 + m];
#define MK_ROWS_END asm volatile("" ::: "memory"); }
    __device__ __forceinline__ void operator()(const f32x4 (&acc)[2][2][4][2], const Unit& u, int wr, int wc, int fr, int fq) const {
        int l_ = lane_fresh(); asm volatile("" : "+v"(l_)); fr = l_ & 15; fq = l_ >> 4;
        const unsigned row0 = u.pm * BM + wr * 64 + fr; const int pn = u.pn;
        const unsigned c8 = wc * 32 + 8 * fq;
        MK_WS(w);
        float rsc[8];
#pragma unroll
        for (int k = 0; k < 8; ++k) rsc[k] = row_rscale16(at<const float>(w, (unsigned)WS_SSQH), (int)(row0 + (k >> 2) * HALF + (k & 3) * 16), 1.f / D);
        if (pn == 0) {
            MK_ROWS_BEGIN
                float ss = 0.f;
#pragma unroll
                for (int bj = 0; bj < 2; ++bj) { const f32x4 v0 = acc[ai][bj][m][0] * r, v1 = acc[ai][bj][m][1] * r; ss += ssq4(v0) + ssq4(v1); *at<u32x4>(w, (unsigned)WS_CQ + (row * QR + bj * HALF + c8) * 2) = pack8(v0, v1); }
                ss += lx(ss, l_, 16); ss += lx(ss, l_, 32);
                if (fq == 0) *at<float>(w, (unsigned)WS_SSQCQ + (row * 8 + wc) * 4) = ss;
            MK_ROWS_END
        } else if (pn == 1) {
            MK_ROWS_BEGIN
                const f32x4 v0 = acc[ai][0][m][0] * r, v1 = acc[ai][0][m][1] * r;
                float ss = ssq4(v0) + ssq4(v1);
                *at<u32x4>(w, (unsigned)WS_CQ + (row * QR + 256 + c8) * 2) = pack8(v0, v1);
                ss += lx(ss, l_, 16); ss += lx(ss, l_, 32);
                if (fq == 0) *at<float>(w, (unsigned)WS_SSQCQ + (row * 8 + 4 + wc) * 4) = ss;
                if (wc == 0) {
                    const f32x4 a0 = acc[ai][1][m][0] * r, a1 = acc[ai][1][m][1] * r;
                    f32x4 p0, p1;
#pragma unroll
                    for (int j = 0; j < 4; ++j) { p0[j] = lx(a0[j], l_, 32); p1[j] = lx(a1[j], l_, 32); }
                    const unsigned pi = row_pidx((int)row), i0 = 8 * (fq & 1);
                    const f32x4 c0 = *at<const f32x4>(w, (unsigned)(WS_TAB + TAB_C16) + (pi * 16 + i0) * 4), c1 = *at<const f32x4>(w, (unsigned)(WS_TAB + TAB_C16) + (pi * 16 + i0 + 4) * 4);
                    const f32x4 s0 = *at<const f32x4>(w, (unsigned)(WS_TAB + TAB_S16) + (pi * 16 + i0) * 4), s1 = *at<const f32x4>(w, (unsigned)(WS_TAB + TAB_S16) + (pi * 16 + i0 + 4) * 4);
                    const f32x4 y0 = fq < 2 ? a0 * c0 - p0 * s0 : p0 * s0 + a0 * c0, y1 = fq < 2 ? a1 * c1 - p1 * s1 : p1 * s1 + a1 * c1;
                    *at<u32x4>(w, (unsigned)WS_KRB + (row * 32 + 8 * fq) * 2) = pack8(y0, y1);
                    *at<f32x4>(w, (unsigned)WS_KRF + (row * 32 + 8 * fq) * 4) = y0; *at<f32x4>(w, (unsigned)WS_KRF + (row * 32 + 8 * fq + 4) * 4) = y1;
                }
            MK_ROWS_END
        } else if (pn == 2) {
            MK_ROWS_BEGIN
                float ss = 0.f;
#pragma unroll
                for (int bj = 0; bj < 2; ++bj) { const f32x4 v0 = acc[ai][bj][m][0] * r, v1 = acc[ai][bj][m][1] * r; ss += ssq4(v0) + ssq4(v1); const unsigned e = row * KVR + bj * HALF + c8;
                    *at<f32x4>(w, (unsigned)WS_CKVF + e * 4) = v0; *at<f32x4>(w, (unsigned)WS_CKVF + (e + 4) * 4) = v1; *at<u32x4>(w, (unsigned)WS_CKVB + e * 2) = pack8(v0, v1); }
                ss += lx(ss, l_, 16); ss += lx(ss, l_, 32);
                if (fq == 0) *at<float>(w, (unsigned)WS_SSQKV + (row * 4 + wc) * 4) = ss;
            MK_ROWS_END
        } else if (pn < 7) {
            const bool isk = pn >= 5; const unsigned hh = 2 * ((pn - 3) & 1) + (wc >> 1), i0 = 32 * (wc & 1) + 8 * fq;
            const unsigned dbase = (unsigned)(isk ? WS_RK : WS_RQ) + hh * 256, gbase = (unsigned)(WS_TAB + (isk ? TAB_GN : TAB_GP)) + hh * 512;
            LAS unsigned char* T = lds_ + EPI_LDS_OFF + (wr * 4 + wc) * EPI_LDS_WAVE;
#pragma unroll
            for (int ai = 0; ai < 2; ++ai) {
                f32x4 y1s[2][4], y2s[2][4];
#pragma unroll
                for (int m = 0; m < 4; ++m) {
                    unsigned row = row0 + ai * HALF + m * 16; asm volatile("" : "+v"(row)); const float r = rsc[ai * 4 + m];
                    const unsigned pi = row_pidx((int)row), jt = row_jtok((int)row);
                    const float mult = *at<const float>(w, gbase + jt * 4) * (isk ? RK_SCALE : 1.f);
#pragma unroll
                    for (int n = 0; n < 2; ++n) {
                        const f32x4 x1 = acc[ai][0][m][n] * r, x2 = acc[ai][1][m][n] * r;
                        const f32x4 c = *at<const f32x4>(w, (unsigned)(WS_TAB + TAB_C64) + (pi * 64 + i0 + 4 * n) * 4), s = *at<const f32x4>(w, (unsigned)(WS_TAB + TAB_S64) + (pi * 64 + i0 + 4 * n) * 4);
                        y1s[n][m] = (x1 * c - x2 * s) * mult; y2s[n][m] = (x1 * s + x2 * c) * mult; }
                    *at<u32x4>(w, dbase + (row * 512 + i0) * 2) = pack8(y1s[0][m], y1s[1][m]); *at<u32x4>(w, dbase + (row * 512 + 64 + i0) * 2) = pack8(y2s[0][m], y2s[1][m]);
                    asm volatile("" ::: "memory");
                }
                if (isk) {
                    const unsigned rb = u.pm * BM + ai * HALF + wr * 64, cb = hh * 128 + 32 * (wc & 1);
#pragma unroll
                    for (int n = 0; n < 2; ++n) {
                        tr_store16(T, fr, fq, l_, y1s[n], w, (unsigned)WS_RKT + ((cb + 4 * n) * MP + rb) * 2u); tr_store16(T, fr, fq, l_, y2s[n], w, (unsigned)WS_RKT + ((cb + 64 + 4 * n) * MP + rb) * 2u); }
                }
            }
        } else if (pn < 11) {
            LAS unsigned char* T = lds_ + EPI_LDS_OFF + (wr * 4 + wc) * EPI_LDS_WAVE;
#pragma unroll
            for (int ai = 0; ai < 2; ++ai) {
                const unsigned rb = u.pm * BM + ai * HALF + wr * 64;
#pragma unroll
                for (int bj = 0; bj < 2; ++bj)
#pragma unroll
                    for (int n = 0; n < 2; ++n) { f32x4 vv[4];
#pragma unroll
                        for (int m = 0; m < 4; ++m) vv[m] = acc[ai][bj][m][n] * rsc[ai * 4 + m];
                        tr_store16(T, fr, fq, l_, vv, w, (unsigned)WS_RVT + (((pn - 7) * 256 + bj * HALF + wc * 32 + 4 * n) * MP + rb) * 2u); }
                asm volatile("" ::: "memory");
            }
        } else {
            const int t = (pn - 11) >> 2; const unsigned dbase = (unsigned)WS_SRG + (unsigned)t * (unsigned)(WS_SGA - WS_SRG) + (((pn - 11) & 3) * 256 + c8) * 2;
            MK_ROWS_BEGIN
#pragma unroll
                for (int bj = 0; bj < 2; ++bj) { const f32x4 v0 = acc[ai][bj][m][0] * r, v1 = acc[ai][bj][m][1] * r; f32x4 o0, o1;
#pragma unroll
                    for (int j = 0; j < 4; ++j) { const float g0 = fast_sigmoid(v0[j]), g1 = fast_sigmoid(v1[j]); o0[j] = t == 0 ? v0[j] * g0 : g0; o1[j] = t == 0 ? v1[j] * g1 : g1; }
                    *at<u32x4>(w, dbase + (row * 1024 + bj * HALF) * 2) = pack8(o0, o1); }
            MK_ROWS_END
        }
    }
};
static_assert(WS_SGB - WS_SGA == WS_SGA - WS_SRG, "gate arrays equally spaced");
struct EpiQ {
    static constexpr bool PERM = false, AFTER_DRAIN = false;
    unsigned char* ws;
    __device__ __forceinline__ void operator()(const f32x4 (&acc)[2][2][4][2], const Unit& u, int wr, int wc, int fr, int fq) const {
        int l_ = lane_fresh(); asm volatile("" : "+v"(l_)); fr = l_ & 15; fq = l_ >> 4;
        const float* SSQCQ = (const float*)(ws + WS_SSQCQ); bf16* QA = (bf16*)(ws + WS_QA); const float* TAB = (const float*)(ws + WS_TAB);
        const int row0 = u.pm * BM + wr * 64 + fr;
#pragma unroll
        for (int ai = 0; ai < 2; ++ai)
#pragma unroll
            for (int m = 0; m < 4; ++m) {
                int row = row0 + ai * HALF + m * 16; asm volatile("" : "+v"(row));
                const float r = row_rscale8(SSQCQ, row, 1.f / QR) * SC_Q;
#pragma unroll
                for (int bj = 0; bj < 2; ++bj) {
                    const int grp = 8 * u.pn + 4 * bj + wc;
                    bf16* dst = QA + (size_t)row * 768 + 32 * grp + 4 * fq;
                    const bool rope = (grp % 3) == 2;
                    const int pi = row_pidx(row);
                    f32x4 c = *(const f32x4*)(TAB + TAB_C16 / 4 + pi * 16 + 4 * fq), s = *(const f32x4*)(TAB + TAB_S16 / 4 + pi * 16 + 4 * fq);
                    if (!rope) { c = (f32x4){1.f, 1.f, 1.f, 1.f}; s = (f32x4){0.f, 0.f, 0.f, 0.f}; }
                    const f32x4 x1 = acc[ai][bj][m][0] * r, x2 = acc[ai][bj][m][1] * r;
                    *(u32x2*)dst = pack4(x1 * c - x2 * s); *(u32x2*)(dst + 16) = pack4(x1 * s + x2 * c);
                }
                asm volatile("" ::: "memory");
            }
    }
};
template <bool ROWS> struct EpiScaleBf16 {
    static constexpr bool PERM = true, AFTER_DRAIN = false;
    const float* SSQKV; bf16* O; int ldc;
    __device__ __forceinline__ void operator()(const f32x4 (&acc)[2][2][4][2], const Unit& u, int wr, int wc, int fr, int fq) const {
        int l_ = lane_fresh(); asm volatile("" : "+v"(l_)); fr = l_ & 15; fq = l_ >> 4;
        const int row0 = u.pm * BM + wr * 64 + fr, col0 = u.pn * BM + wc * 32 + 8 * fq;
        float cs[2][8];
        if (!ROWS) {
#pragma unroll
            for (int bj = 0; bj < 2; ++bj)
#pragma unroll
                for (int k = 0; k < 8; ++k) cs[bj][k] = row_rscale4(SSQKV, col0 + bj * HALF + k, 1.f / KVR);
        }
#pragma unroll
        for (int ai = 0; ai < 2; ++ai)
#pragma unroll
            for (int m = 0; m < 4; ++m) { int row = row0 + ai * HALF + m * 16; asm volatile("" : "+v"(row)); const float r = ROWS ? row_rscale4(SSQKV, row, 1.f / KVR) : 1.f;
#pragma unroll
                for (int bj = 0; bj < 2; ++bj) { f32x4 v0 = acc[ai][bj][m][0], v1 = acc[ai][bj][m][1];
                    if (ROWS) { v0 = v0 * r; v1 = v1 * r; }
                    else {
#pragma unroll
                        for (int j = 0; j < 4; ++j) { v0[j] *= cs[bj][j]; v1[j] *= cs[bj][4 + j]; } }
                    u32x4 w; w.x = pg8::cvt_pk_bf16(v0[0], v0[1]); w.y = pg8::cvt_pk_bf16(v0[2], v0[3]); w.z = pg8::cvt_pk_bf16(v1[0], v1[1]); w.w = pg8::cvt_pk_bf16(v1[2], v1[3]);
                    *(u32x4*)(O + (size_t)row * ldc + col0 + bj * HALF) = w; } }
    }
};
__device__ __forceinline__ void finalize_ckv(Frame& F, const Ptrs& a) {
    const int lane = fresh_tid(F.wave) & 63;
    const int gw = F.vcu * NWAVES + F.wave, NGW = F.G * NWAVES;
    const float* CKVF = (const float*)(a.ws + WS_CKVF); const float* SSQKV = (const float*)(a.ws + WS_SSQKV); const float* KRF = (const float*)(a.ws + WS_KRF);
    const f32x4 g = *((const f32x4*)a.in(14) + lane);
    for (int row = gw; row < ROW_PAD; row += NGW) {
        const float r = row_rscale4(SSQKV, row, 1.f / KVR);
        const f32x4 o = *((const f32x4*)(CKVF + (size_t)row * KVR) + lane) * r * g;
        const f32x4 kr = *((const f32x4*)(KRF + (size_t)row * 32) + (lane & 7));
        if (row < MMAIN) { const size_t t = (size_t)(row >> 11) * T + NMETA + (row & (SEQ - 1)); *((f32x4*)(a.out() + OUT_CKVP + t * KVR) + lane) = o; if (lane < 8) *((f32x4*)(a.out() + OUT_KRP + t * 32) + lane) = kr; }
        else if (row < ROW_SMP) { for (int b = 0; b < NB; ++b) { const size_t t = (size_t)b * T + (row - ROW_META); *((f32x4*)(a.out() + OUT_CKVP + t * KVR) + lane) = o; if (lane < 8) *((f32x4*)(a.out() + OUT_KRP + t * 32) + lane) = kr; } }
        else { *((f32x4*)(a.out() + OUT_CKVS + (size_t)(row - ROW_SMP) * KVR) + lane) = o; if (lane < 8) *((f32x4*)(a.out() + OUT_KRS + (size_t)(row - ROW_SMP) * 32) + lane) = kr; }
    }
}
}
namespace mk {
constexpr size_t WS_AV = WS_END2;
constexpr size_t WS_END3 = WS_AV + al((size_t)MP * 512 * 2);
typedef float f32x16 __attribute__((ext_vector_type(16)));
constexpr int AT_KSTR = 208, AT_VSTR = 144, AT_KBUF = 64 * AT_KSTR, AT_VBUF = 64 * AT_VSTR, AT_VOFF = 2 * AT_KBUF;
__device__ __forceinline__ int crow(int i, int half) { return (i & 3) + 8 * (i >> 2) + 4 * half; }

__device__ __forceinline__ void attn_unit(Frame& F, unsigned char* ws, int b, int h, int qb) {
    ws = opaque_g(ws);
    const int tid = fresh_tid(F.wave), lane = tid & 63, w = F.wave, q = lane & 31, half = lane >> 5;
    LAS unsigned char* L = F.lds + RING_OFF;
    const bf16* QA = (const bf16*)(ws + WS_QA); const bf16* KN = (const bf16*)(ws + WS_KN); const bf16* KRB = (const bf16*)(ws + WS_KRB); const bf16* VT = (const bf16*)(ws + WS_VT);
    const int qrow = b * SEQ + qb * 256 + w * 32 + q, q_main = qb * 256 + w * 32 + q, wq0 = qb * 256 + w * 32;
    bf16x8 qf[6];
#pragma unroll
    for (int s = 0; s < 6; ++s) qf[s] = *(const bf16x8*)(QA + (size_t)qrow * 768 + h * 96 + 16 * s + 8 * half);
    f32x16 ot[2];
#pragma unroll
    for (int i = 0; i < 16; ++i) { ot[0][i] = 0.f; ot[1][i] = 0.f; }
    float m = -INFINITY, l = 0.f;
    const int NT = 4 * (qb + 1);
    v4u kreg, rreg, vreg; rreg = (v4u){0u, 0u, 0u, 0u};
#define AT_LOAD(tt) do { const int t0_ = (tt) == 0 ? ROW_META : b * SEQ + 64 * ((tt) - 1); \
        kreg = *(const v4u*)(KN + (size_t)(t0_ + (tid >> 3)) * 512 + h * 64 + (tid & 7) * 8); \
        if (tid < 256) rreg = *(const v4u*)(KRB + (size_t)(t0_ + (tid >> 2)) * 32 + (tid & 3) * 8); \
        vreg = *(const v4u*)(VT + (size_t)(h * 64 + (tid >> 3)) * MP + t0_ + (tid & 7) * 8); } while (0)
#define AT_STORE(buf) do { LAS unsigned char* kb_ = L + (buf) * AT_KBUF; \
        *(LAS v4u*)(kb_ + (tid >> 3) * AT_KSTR + (tid & 7) * 16) = kreg; \
        if (tid < 256) *(LAS v4u*)(kb_ + (tid >> 2) * AT_KSTR + 128 + (tid & 3) * 16) = rreg; \
        LAS unsigned char* vb_ = L + AT_VOFF + (buf) * AT_VBUF + (tid >> 3) * AT_VSTR + (32 * ((tid & 7) >> 1) + 8 * (tid & 1)); \
        *(LAS u32x2*)(vb_) = (u32x2){vreg.x, vreg.y}; *(LAS u32x2*)(vb_ + 16) = (u32x2){vreg.z, vreg.w}; } while (0)
    AT_LOAD(0); AT_STORE(0);
    __syncthreads();
    for (int tt = 0; tt <= NT; ++tt) {
        const int buf = tt & 1;
        if (tt < NT) AT_LOAD(tt + 1);
        const int kmin = tt == 0 ? 0 : 64 * (tt - 1);
        if (tt == 0 || kmin <= wq0 + 31) {
            const LAS unsigned char* Kb = L + buf * AT_KBUF + q * AT_KSTR + 16 * half;
            const LAS unsigned char* Vb = L + AT_VOFF + buf * AT_VBUF + q * AT_VSTR + 16 * half;
            f32x16 st[2];
#pragma unroll
            for (int kb = 0; kb < 2; ++kb) {
#pragma unroll
                for (int i = 0; i < 16; ++i) st[kb][i] = 0.f;
#pragma unroll
                for (int s = 0; s < 6; ++s) { const bf16x8 kf = *(const LAS bf16x8*)(Kb + kb * 32 * AT_KSTR + 32 * s); st[kb] = __builtin_amdgcn_mfma_f32_32x32x16_bf16(kf, qf[s], st[kb], 0, 0, 0); }
            }
            if (tt == 0) {
#pragma unroll
                for (int kb = 0; kb < 2; ++kb)
#pragma unroll
                    for (int i = 0; i < 16; ++i) if (32 * kb + crow(i, half) >= NMETA) st[kb][i] = -INFINITY;
            } else if (kmin + 63 > wq0) {
#pragma unroll
                for (int kb = 0; kb < 2; ++kb)
#pragma unroll
                    for (int i = 0; i < 16; ++i) if (kmin + 32 * kb + crow(i, half) > q_main) st[kb][i] = -INFINITY;
            }
            float mx = st[0][0];
#pragma unroll
            for (int i = 1; i < 16; ++i) mx = fmaxf(mx, st[0][i]);
#pragma unroll
            for (int i = 0; i < 16; ++i) mx = fmaxf(mx, st[1][i]);
            mx = fmaxf(mx, lx(mx, lane, 32));
            const float mn = fmaxf(m, mx), alpha = __builtin_amdgcn_exp2f(m - mn);
            m = mn;
            float ps = 0.f;
#pragma unroll
            for (int kb = 0; kb < 2; ++kb)
#pragma unroll
                for (int i = 0; i < 16; ++i) { st[kb][i] = __builtin_amdgcn_exp2f(st[kb][i] - mn); ps += st[kb][i]; }
            l = l * alpha + ps;
#pragma unroll
            for (int i = 0; i < 16; ++i) { ot[0][i] *= alpha; ot[1][i] *= alpha; }
#pragma unroll
            for (int kb = 0; kb < 2; ++kb)
#pragma unroll
                for (int s2 = 0; s2 < 2; ++s2) {
                    u32x4 pw; pw.x = pg8::cvt_pk_bf16(st[kb][8 * s2 + 0], st[kb][8 * s2 + 1]); pw.y = pg8::cvt_pk_bf16(st[kb][8 * s2 + 2], st[kb][8 * s2 + 3]);
                    pw.z = pg8::cvt_pk_bf16(st[kb][8 * s2 + 4], st[kb][8 * s2 + 5]); pw.w = pg8::cvt_pk_bf16(st[kb][8 * s2 + 6], st[kb][8 * s2 + 7]);
                    const bf16x8 pf = __builtin_bit_cast(bf16x8, pw);
#pragma unroll
                    for (int vb = 0; vb < 2; ++vb) { const bf16x8 vf = *(const LAS bf16x8*)(Vb + vb * 32 * AT_VSTR + (32 * kb + 16 * s2) * 2); ot[vb] = __builtin_amdgcn_mfma_f32_32x32x16_bf16(vf, pf, ot[vb], 0, 0, 0); }
                }
        }
        if (tt < NT) AT_STORE(buf ^ 1);
        __syncthreads();
    }
#undef AT_LOAD
#undef AT_STORE
    l += lx(l, lane, 32);
    const float inv = 1.0f / l;
    bf16* AV = (bf16*)(ws + WS_AV) + (size_t)qrow * 512 + h * 64 + 4 * half;
#pragma unroll
    for (int vb = 0; vb < 2; ++vb)
#pragma unroll
        for (int g = 0; g < 4; ++g) { f32x4 o; o[0] = ot[vb][4 * g] * inv; o[1] = ot[vb][4 * g + 1] * inv; o[2] = ot[vb][4 * g + 2] * inv; o[3] = ot[vb][4 * g + 3] * inv; *(u32x2*)(AV + 32 * vb + 8 * g) = pack4(o); }
}
__device__ __forceinline__ void attn_item(Frame& F, unsigned char* ws, int i) { const int bh = i & 63; attn_unit(F, ws, bh >> 3, bh & 7, 7 - (i >> 6)); }
__device__ __forceinline__ void attn_phase(Frame& F, unsigned char* ws) {
    const int c = F.vcu;
    if (c >= 256) return;
    const int bh = c >> 2, p = c & 3;
    attn_unit(F, ws, bh >> 3, bh & 7, 7 - p);
    attn_unit(F, ws, bh >> 3, bh & 7, p);
}
}
namespace mk {
constexpr size_t WS_UMETA = WS_END3;
constexpr size_t WS_UT = WS_UMETA + al((size_t)RH * RDV * RDK * 4);
constexpr size_t WS_SPREV = WS_UT + al((size_t)32 * 16 * RDV * RDK * 4);
constexpr size_t WS_RIN = WS_SPREV + al((size_t)32 * 16 * RDV * RDK * 2);
constexpr size_t WS_DPART = WS_RIN + al((size_t)MP * 1024 * 2);
constexpr size_t WS_QL = WS_DPART + al((size_t)32 * 16 * 8 * 264 * 4);
constexpr size_t WS_END4 = WS_QL + al((size_t)64 * 2048 * 4);
static_assert(WS_END4 < ((size_t)1 << 31), "32-bit workspace offsets");
__device__ __forceinline__ float gpow_t(const unsigned char* ws, int h, int n) { return ((const float*)(ws + WS_TAB + TAB_GP))[h * 128 + n]; }

__device__ __forceinline__ void ret_u_unit(Frame& F, unsigned char* ws, int u) {
    ws = opaque_g(ws);
    const int tid = fresh_tid(F.wave), lane = tid & 63, w = F.wave, r32 = lane & 31, half = lane >> 5;
    const bool meta = u >= 512; const int hh = meta ? u - 512 : (u >> 4) & 3;
    const int tok0 = meta ? ROW_META : (u >> 6) * SEQ + (u & 15) * 128, nks = meta ? 1 : 8;
    const bf16* RVT = (const bf16*)(ws + WS_RVT); const bf16* RKT = (const bf16*)(ws + WS_RKT);
    f32x16 acc[4];
#pragma unroll
    for (int db = 0; db < 4; ++db)
#pragma unroll
        for (int i = 0; i < 16; ++i) acc[db][i] = 0.f;
    const bf16* ap = RVT + (size_t)(hh * 256 + 32 * w + r32) * MP + tok0 + 8 * half;
    const bf16* bp = RKT + (size_t)(hh * 128 + r32) * MP + tok0 + 8 * half;
    for (int s = 0; s < nks; ++s) {
        const bf16x8 af = *(const bf16x8*)(ap + 16 * s);
#pragma unroll
        for (int db = 0; db < 4; ++db) { const bf16x8 bf = *(const bf16x8*)(bp + (size_t)(32 * db) * MP + 16 * s); acc[db] = __builtin_amdgcn_mfma_f32_32x32x16_bf16(af, bf, acc[db], 0, 0, 0); }
    }
    const float sc = gpow_t(ws, hh, meta ? NMETA - 1 : 127);
    float* dst = meta ? (float*)(ws + WS_UMETA) + (size_t)hh * RDV * RDK : (float*)(ws + WS_UT) + (size_t)u * RDV * RDK;
#pragma unroll
    for (int db = 0; db < 4; ++db)
#pragma unroll
        for (int i = 0; i < 16; ++i) dst[(size_t)(32 * w + crow(i, half)) * RDK + 32 * db + r32] = acc[db][i] * sc;
}
__device__ __forceinline__ void ret_scan(Frame& F, const Ptrs& a) {
    const int tid = fresh_tid(F.wave);
    const int gt = (F.vcu * NWAVES * 64) + tid, NGT = F.G * NWAVES * 64;
    const float* UM = (const float*)(a.ws + WS_UMETA); const float* UT = (const float*)(a.ws + WS_UT); bf16* SP = (bf16*)(a.ws + WS_SPREV);
    for (int e = gt; e < 32 * RDV * RDK; e += NGT) {
        const int bh = e >> 15, idx = e & 32767, hh = bh & 3;
        const float g128 = gpow_t(a.ws, hh, 127) * gpow_t(a.ws, hh, 1);
        float S = UM[(size_t)hh * 32768 + idx];
        for (int c = 0; c < 16; ++c) { const size_t o = ((size_t)bh * 16 + c) * 32768 + idx; SP[o] = bf1(S); S = g128 * S + UT[o]; }
        const int ee = idx >> 7, d = idx & 127;
        a.out()[OUT_SRP + ((size_t)bh * RDK + d) * RDV + ee] = S;
    }
}
__device__ __forceinline__ void ret_o_unit(Frame& F, const Ptrs& a, int u) {
    unsigned char* ws = a.ws; ws = opaque_g(ws);
    const int tid = fresh_tid(F.wave), lane = tid & 63, w = F.wave, r32 = lane & 31, half = lane >> 5;
    const int bh = u >> 4, c = u & 15, hh = bh & 3, tok0 = (bh >> 2) * SEQ + c * 128;
    const int ib = w & 3, eh = w >> 2;
    LAS float* red = (LAS float*)(F.lds + RING_OFF);
    const bf16* RQ = (const bf16*)(ws + WS_RQ); const bf16* RK = (const bf16*)(ws + WS_RK); const bf16* RVT = (const bf16*)(ws + WS_RVT);
    const bf16* SP = (const bf16*)(ws + WS_SPREV) + (size_t)u * 32768;
    const int irow = tok0 + 32 * ib + r32;
    bf16x8 qf[8];
#pragma unroll
    for (int s = 0; s < 8; ++s) qf[s] = *(const bf16x8*)(RQ + (size_t)irow * 512 + hh * 128 + 16 * s + 8 * half);
    f32x16 ot[4];
#pragma unroll
    for (int eb = 0; eb < 4; ++eb) {
#pragma unroll
        for (int i = 0; i < 16; ++i) ot[eb][i] = 0.f;
        const bf16* sp = SP + (size_t)(128 * eh + 32 * eb + r32) * RDK + 8 * half;
#pragma unroll
        for (int s = 0; s < 8; ++s) { const bf16x8 sf = *(const bf16x8*)(sp + 16 * s); ot[eb] = __builtin_amdgcn_mfma_f32_32x32x16_bf16(sf, qf[s], ot[eb], 0, 0, 0); }
    }
    const float g = gpow_t(ws, hh, 1);
#pragma unroll
    for (int eb = 0; eb < 4; ++eb)
#pragma unroll
        for (int i = 0; i < 16; ++i) ot[eb][i] *= g;
    for (int jb = 0; jb <= ib; ++jb) {
        f32x16 at;
#pragma unroll
        for (int i = 0; i < 16; ++i) at[i] = 0.f;
        const bf16* kp = RK + (size_t)(tok0 + 32 * jb + r32) * 512 + hh * 128 + 8 * half;
#pragma unroll
        for (int s = 0; s < 8; ++s) { const bf16x8 kf = *(const bf16x8*)(kp + 16 * s); at = __builtin_amdgcn_mfma_f32_32x32x16_bf16(kf, qf[s], at, 0, 0, 0); }
        if (jb == ib) {
#pragma unroll
            for (int i = 0; i < 16; ++i) if (crow(i, half) > r32) at[i] = 0.f;
        }
#pragma unroll
        for (int s2 = 0; s2 < 2; ++s2) {
            u32x4 pw; pw.x = pg8::cvt_pk_bf16(at[8 * s2 + 0], at[8 * s2 + 1]); pw.y = pg8::cvt_pk_bf16(at[8 * s2 + 2], at[8 * s2 + 3]);
            pw.z = pg8::cvt_pk_bf16(at[8 * s2 + 4], at[8 * s2 + 5]); pw.w = pg8::cvt_pk_bf16(at[8 * s2 + 6], at[8 * s2 + 7]);
            const bf16x8 pf = __builtin_bit_cast(bf16x8, pw);
#pragma unroll
            for (int eb = 0; eb < 4; ++eb) {
                const bf16* vp = RVT + (size_t)(hh * 256 + 128 * eh + 32 * eb + r32) * MP + tok0 + 32 * jb + 16 * s2 + 4 * half;
                const u32x2 lo = *(const u32x2*)vp, hi = *(const u32x2*)(vp + 8);
                u32x4 vw; vw.x = lo.x; vw.y = lo.y; vw.z = hi.x; vw.w = hi.y;
                ot[eb] = __builtin_amdgcn_mfma_f32_32x32x16_bf16(__builtin_bit_cast(bf16x8, vw), pf, ot[eb], 0, 0, 0);
            }
        }
    }
    float s1 = 0.f;
#pragma unroll
    for (int eb = 0; eb < 4; ++eb)
#pragma unroll
        for (int i = 0; i < 16; ++i) s1 += ot[eb][i];
    s1 += lx(s1, lane, 32);
    if (half == 0) red[w * 32 + r32] = s1;
    __syncthreads();
    const float mu = (red[w * 32 + r32] + red[(w ^ 4) * 32 + r32]) * (1.f / 256.f);
    float s2 = 0.f;
#pragma unroll
    for (int eb = 0; eb < 4; ++eb)
#pragma unroll
        for (int i = 0; i < 16; ++i) { ot[eb][i] -= mu; s2 += ot[eb][i] * ot[eb][i]; }
    s2 += lx(s2, lane, 32);
    if (half == 0) red[256 + w * 32 + r32] = s2;
    __syncthreads();
    const float rstd = 1.0f / sqrtf((red[256 + w * 32 + r32] + red[256 + (w ^ 4) * 32 + r32]) * (1.f / 256.f) + EPS);
    __syncthreads();
    const bf16* SRG = (const bf16*)(ws + WS_SRG) + (size_t)irow * 1024 + hh * 256 + 128 * eh + 4 * half;
    bf16* RIN = (bf16*)(ws + WS_RIN) + (size_t)irow * 1024 + hh * 256 + 128 * eh + 4 * half;
    const float* gn = a.in(19) + hh * 256 + 128 * eh + 4 * half;
#pragma unroll
    for (int eb = 0; eb < 4; ++eb)
#pragma unroll
        for (int gq = 0; gq < 4; ++gq) {
            const int eo = 32 * eb + 8 * gq;
            const u32x2 sg = *(const u32x2*)(SRG + eo); const f32x4 gv = *(const f32x4*)(gn + eo);
            f32x4 o;
            o[0] = ot[eb][4 * gq + 0] * rstd * gv[0] * __uint_as_float(sg.x << 16); o[1] = ot[eb][4 * gq + 1] * rstd * gv[1] * __uint_as_float(sg.x & 0xffff0000u);
            o[2] = ot[eb][4 * gq + 2] * rstd * gv[2] * __uint_as_float(sg.y << 16); o[3] = ot[eb][4 * gq + 3] * rstd * gv[3] * __uint_as_float(sg.y & 0xffff0000u);
            *(u32x2*)(RIN + eo) = pack4(o);
        }
}
__device__ __forceinline__ void ret_sample_unit(Frame& F, const Ptrs& a, int u) {
    unsigned char* ws = a.ws; ws = opaque_g(ws);
    const int tid = fresh_tid(F.wave), lane = tid & 63, s = u >> 2, hh = u & 3, e = tid & 255, dh = tid >> 8, row = ROW_SMP + s;
    LAS float* sh = (LAS float*)(F.lds + RING_OFF);
    const bf16* RQ = (const bf16*)(ws + WS_RQ); const bf16* RK = (const bf16*)(ws + WS_RK); const bf16* RVT = (const bf16*)(ws + WS_RVT);
    if (tid < 128) sh[tid] = __uint_as_float((unsigned)RQ[(size_t)row * 512 + hh * 128 + tid] << 16);
    else if (tid < 256) sh[tid] = __uint_as_float((unsigned)RK[(size_t)row * 512 + hh * 128 + tid - 128] << 16);
    __syncthreads();
    const float v = __uint_as_float((unsigned)RVT[(size_t)(hh * 256 + e) * MP + row] << 16);
    const float g = gpow_t(ws, hh, 1);
    const float* S0 = a.in(4) + ((size_t)(s * RH + hh) * RDK) * RDV + e;
    float* S1 = a.out() + OUT_SRS + ((size_t)(s * RH + hh) * RDK) * RDV + e;
    float o = 0.f;
    {   float s0[64];
#pragma unroll
        for (int k = 0; k < 64; ++k) s0[k] = S0[(size_t)(64 * dh + k) * RDV];
#pragma unroll
        for (int k = 0; k < 64; ++k) { const int d = 64 * dh + k; const float sn = g * s0[k] + sh[128 + d] * v; S1[(size_t)d * RDV] = sn; o += sh[d] * sn; } }
    sh[256 + dh * 256 + e] = o;
    __syncthreads();
    o = sh[256 + e] + sh[512 + e];
    float t1 = o;
#pragma unroll
    for (int off = 32; off > 0; off >>= 1) t1 += lx(t1, lane, off);
    if ((tid & 63) == 0) sh[768 + (tid >> 6)] = t1;
    __syncthreads();
    const float mu = (sh[768] + sh[769] + sh[770] + sh[771]) * (1.f / 256.f);
    const float dlt = o - mu;
    float t2 = dlt * dlt;
#pragma unroll
    for (int off = 32; off > 0; off >>= 1) t2 += lx(t2, lane, off);
    if ((tid & 63) == 0) sh[776 + (tid >> 6)] = t2;
    __syncthreads();
    const float rstd = 1.0f / sqrtf((sh[776] + sh[777] + sh[778] + sh[779]) * (1.f / 256.f) + EPS);
    if (dh == 0) { const float sg = __uint_as_float((unsigned)((const bf16*)(ws + WS_SRG))[(size_t)row * 1024 + hh * 256 + e] << 16);
        ((bf16*)(ws + WS_RIN))[(size_t)row * 1024 + hh * 256 + e] = bf1(dlt * rstd * a.in(19)[hh * 256 + e] * sg); }
    __syncthreads();
}
}
namespace mk {
template <int CTRL> __device__ __forceinline__ float dppf(float v) { return __int_as_float(__builtin_amdgcn_update_dpp(0, __float_as_int(v), CTRL, 0xF, 0xF, false)); }
__device__ __forceinline__ float swap32_add(float a, float b) { const auto r = __builtin_amdgcn_permlane32_swap(__float_as_uint(a), __float_as_uint(b), false, false); return __uint_as_float(r[0]) + __uint_as_float(r[1]); }
__device__ __forceinline__ float swap16_add(float a, float b) { const auto r = __builtin_amdgcn_permlane16_swap(__float_as_uint(a), __float_as_uint(b), false, false); return __uint_as_float(r[0]) + __uint_as_float(r[1]); }
__device__ __forceinline__ int dlane_of(int h) { return ((h >> 2) & 1) * 32 + ((h >> 1) & 1) * 16 + (h & 1) * 8; }
__device__ __forceinline__ float swap32_max(float a) { const auto r = __builtin_amdgcn_permlane32_swap(__float_as_uint(a), __float_as_uint(a), false, false); return fmaxf(__uint_as_float(r[0]), __uint_as_float(r[1])); }
__device__ __forceinline__ float swap16_max(float a) { const auto r = __builtin_amdgcn_permlane16_swap(__float_as_uint(a), __float_as_uint(a), false, false); return fmaxf(__uint_as_float(r[0]), __uint_as_float(r[1])); }
__device__ __forceinline__ void decode_unit(Frame& F, const Ptrs& a, int u) {
    unsigned char* ws = a.ws; ws = opaque_g(ws);
    const int tid = fresh_tid(F.wave), lane = tid & 63, w = F.wave, s = u >> 4, sp = u & 15, row = ROW_SMP + s;
    LAS float* sh = (LAS float*)(F.lds + RING_OFF);
    LAS unsigned char* tile = F.lds + RING_OFF + w * 16384;
    LAS unsigned char* qb = F.lds + RING_OFF + 131072;
    { const float* QLr = (const float*)(ws + WS_QL) + (size_t)(row - MMAIN) * 2048; const bf16* QA = (const bf16*)(ws + WS_QA) + (size_t)row * 768;
      for (int e = tid; e < 576; e += 512) { const int ks = e >> 6, n = e & 15, g = (e >> 4) & 3; u32x4 pk = (u32x4){0u, 0u, 0u, 0u};
          if (n < 8) { if (ks < 8) pk = pack8(*(const f32x4*)(QLr + n * 256 + 32 * ks + 4 * g), *(const f32x4*)(QLr + n * 256 + 32 * ks + 16 + 4 * g));
                       else { const u32x2 r0 = *(const u32x2*)(QA + n * 96 + 64 + 4 * g), r1 = *(const u32x2*)(QA + n * 96 + 64 + 16 + 4 * g); pk = (u32x4){r0.x, r0.y, r1.x, r1.y}; } }
          *(LAS u32x4*)(qb + e * 16) = pk; } }
    __syncthreads();
    f32x4 O[8];
#pragma unroll
    for (int h = 0; h < 8; ++h) O[h] = (f32x4){0.f, 0.f, 0.f, 0.f};
    float m = -INFINITY, l = 0.f;
    const int i16 = lane & 15, g4 = lane >> 4;
    const int page = ((const int*)a.in(5))[s * NPAGES + sp * 8 + w];
    const float* ckp = a.in(2) + (size_t)page * PAGE * KVR + i16 * KVR + 4 * g4;
    const float* krp = a.in(3) + (size_t)page * PAGE * 32 + i16 * 32 + 4 * g4;
    LAS unsigned char* twr = tile + i16 * 1024;
    const int swz = i16 & 7;
    f32x4 R[18];
#define DC_PIN() __builtin_amdgcn_sched_barrier(0)
#define DC_LOAD(b_) do { const float* c_ = ckp + (size_t)(b_) * 16 * KVR; const float* r_ = krp + (size_t)(b_) * 16 * 32; \
        _Pragma("unroll") for (int ks = 0; ks < 8; ++ks) { R[2 * ks] = *(const f32x4*)(c_ + 32 * ks); R[2 * ks + 1] = *(const f32x4*)(c_ + 32 * ks + 16); } \
        R[16] = *(const f32x4*)r_; R[17] = *(const f32x4*)(r_ + 16); } while (0)
    DC_LOAD(0); DC_PIN();
#pragma unroll 1
    for (int b = 0; b < 8; ++b) {
        f32x4 S = (f32x4){0.f, 0.f, 0.f, 0.f};
#pragma unroll
        for (int ks = 0; ks < 9; ++ks) { const u32x4 pk = pack8(R[2 * ks], R[2 * ks + 1]); const bf16x8 bq = *(const LAS bf16x8*)(qb + (ks * 64 + lane) * 16);
            S = __builtin_amdgcn_mfma_f32_16x16x32_bf16(__builtin_bit_cast(bf16x8, pk), bq, S, 0, 0, 0); }
#pragma unroll
        for (int ks = 0; ks < 8; ++ks) { *(LAS f32x4*)(twr + (((8 * ks + g4) ^ swz) << 4)) = R[2 * ks]; *(LAS f32x4*)(twr + (((8 * ks + 4 + g4) ^ swz) << 4)) = R[2 * ks + 1]; }
        DC_PIN();
        { const int bn = b < 7 ? b + 1 : 7; DC_LOAD(bn); }
        DC_PIN();
        float mx = fmaxf(fmaxf(S[0], S[1]), fmaxf(S[2], S[3])); mx = swap32_max(mx); mx = swap16_max(mx);
        const float mn = fmaxf(m, mx), alpha = __builtin_amdgcn_exp2f(m - mn); m = mn;
        float pe[4];
#pragma unroll
        for (int j = 0; j < 4; ++j) pe[j] = __builtin_amdgcn_exp2f(S[j] - mn);
        l = l * alpha + ((pe[0] + pe[1]) + (pe[2] + pe[3]));
#pragma unroll
        for (int h = 0; h < 8; ++h) { const float ah = __int_as_float(__builtin_amdgcn_readlane(__float_as_int(alpha), h)); O[h] = O[h] * ah; }
#pragma unroll
        for (int kk = 0; kk < 16; ++kk) { const f32x4 v = *(const LAS f32x4*)(tile + kk * 1024 + ((lane ^ (kk & 7)) << 4));
#pragma unroll
            for (int h = 0; h < 8; ++h) { const float ph = __int_as_float(__builtin_amdgcn_readlane(__float_as_int(pe[kk & 3]), h + 16 * (kk >> 2))); O[h] = O[h] + v * ph; } }
        DC_PIN();
    }
#undef DC_PIN
#undef DC_LOAD
    l = swap32_add(l, l); l = swap16_add(l, l);
    LAS float* wo = (LAS float*)tile;
    LAS float* wm = (LAS float*)tile + 2048;
    if (lane < 8) { wm[lane] = m; wm[8 + lane] = l; }
#pragma unroll
    for (int h = 0; h < 8; ++h) *(LAS f32x4*)(wo + h * 256 + 4 * lane) = O[h];
    __syncthreads();
    float* part = (float*)(ws + WS_DPART) + (size_t)u * 8 * 264;
    for (int e = tid; e < 2048; e += 512) {
        const int h = e >> 8;
        float M = -INFINITY;
#pragma unroll
        for (int ww = 0; ww < 8; ++ww) M = fmaxf(M, sh[ww * 4096 + 2048 + h]);
        float acc = 0.f, L = 0.f;
#pragma unroll
        for (int ww = 0; ww < 8; ++ww) { const float f = __builtin_amdgcn_exp2f(sh[ww * 4096 + 2048 + h] - M); acc += f * sh[ww * 4096 + e]; L += f * sh[ww * 4096 + 2048 + 8 + h]; }
        __hip_atomic_store(part + h * 264 + (e & 255), acc, __ATOMIC_RELAXED, __HIP_MEMORY_SCOPE_AGENT);
        if ((e & 255) == 0) { __hip_atomic_store(part + h * 264 + 256, M, __ATOMIC_RELAXED, __HIP_MEMORY_SCOPE_AGENT); __hip_atomic_store(part + h * 264 + 257, L, __ATOMIC_RELAXED, __HIP_MEMORY_SCOPE_AGENT); }
    }
    asm volatile("s_waitcnt vmcnt(0)" ::: "memory");
    __syncthreads();
    if (tid == 0) (void)__hip_atomic_fetch_add((unsigned*)(ws + WS_CTL) + CW_DCNT + 16 * s, 1u, __ATOMIC_RELAXED, __HIP_MEMORY_SCOPE_AGENT);
}
__device__ __forceinline__ void decode_combine_unit(Frame& F, const Ptrs& a, int u) {
    unsigned char* ws = opaque_g(a.ws);
    const int tid = fresh_tid(F.wave), lane = tid & 63, s = u >> 3, h = u & 7, row = ROW_SMP + s;
    LAS float* sh = (LAS float*)(F.lds + RING_OFF);
    const bf16* QA = (const bf16*)(ws + WS_QA) + (size_t)row * 768;
    const float* part = (const float*)(ws + WS_DPART) + (size_t)s * 16 * 8 * 264;
    if (tid == 0) { const unsigned* cn = (const unsigned*)(ws + WS_CTL) + CW_DCNT + 16 * s; unsigned spins = 0;
        while (__hip_atomic_load(cn, __ATOMIC_RELAXED, __HIP_MEMORY_SCOPE_AGENT) < 16u && ++spins < (1u << 22)) __builtin_amdgcn_s_sleep(8);
        __builtin_amdgcn_fence(__ATOMIC_ACQUIRE, "agent"); asm volatile("s_waitcnt vmcnt(0)" ::: "memory"); }
    __syncthreads();
    if (tid < 64) { const bf16* KNr = (const bf16*)(ws + WS_KN) + (size_t)row * 512;
        float acc = __uint_as_float((unsigned)QA[h * 96 + lane] << 16) * __uint_as_float((unsigned)KNr[h * 64 + lane] << 16);
        if (lane < 32) acc += __uint_as_float((unsigned)QA[h * 96 + 64 + lane] << 16) * ((const float*)(ws + WS_KRF))[(size_t)row * 32 + lane];
#pragma unroll
        for (int off = 32; off > 0; off >>= 1) acc += lx(acc, lane, off);
        if (lane == 0) sh[256] = acc; }
    __syncthreads();
    if (tid < 256) {
        const int r = tid;
        const float sn = sh[256];
        float pm[16];
#pragma unroll
        for (int p = 0; p < 16; ++p) pm[p] = part[(p * 8 + h) * 264 + 256];
        float M = sn;
#pragma unroll
        for (int p = 0; p < 16; ++p) M = fmaxf(M, pm[p]);
        const float rkv = row_rscale4((const float*)(ws + WS_SSQKV), row, 1.f / KVR);
        const float cn = ((const float*)(ws + WS_CKVF))[(size_t)row * KVR + r] * rkv * a.in(14)[r];
        const float fn = __builtin_amdgcn_exp2f(sn - M);
        float acc = fn * cn, Lq = fn;
#pragma unroll
        for (int p = 0; p < 16; ++p) { const float f = __builtin_amdgcn_exp2f(pm[p] - M); acc += f * part[(p * 8 + h) * 264 + r]; Lq += f * part[(p * 8 + h) * 264 + 257]; }
        sh[r] = acc / Lq;
    }
    __syncthreads();
    { const int v = tid & 63, rg = tid >> 6; const float* wuv = a.in(17) + (size_t)(32 * rg) * 512 + h * 64 + v;
      float wv[32];
#pragma unroll
      for (int k = 0; k < 32; ++k) wv[k] = wuv[(size_t)k * 512];
      float acc = 0.f;
#pragma unroll
      for (int k = 0; k < 32; ++k) acc += sh[32 * rg + k] * wv[k];
      sh[264 + rg * 64 + v] = acc; }
    __syncthreads();
    if (tid < 64) { float acc = 0.f;
#pragma unroll
        for (int rg = 0; rg < 8; ++rg) acc += sh[264 + rg * 64 + tid];
        ((bf16*)(ws + WS_AV))[(size_t)row * 512 + h * 64 + tid] = bf1(acc); }
    __syncthreads();
}
}
namespace mk {
constexpr size_t WS_TMP = WS_ACT;
constexpr size_t WS_MX = WS_RQ;
constexpr size_t WS_H2B = WS_MX + al((size_t)MP * 1024 * 2);
constexpr size_t WS_H2 = WS_UT;
constexpr size_t WS_SSQH2 = WS_SSQ2_, WS_SSQH3 = WS_SSQ3_;
constexpr size_t WS_H3B = WS_H;
constexpr size_t WS_END6 = WS_END4;
static_assert(WS_H2B + (size_t)MP * 1024 * 2 <= WS_SRG && WS_H2 + (size_t)MP * 1024 * 4 <= WS_RIN && (size_t)MP * 1024 * 4 <= (size_t)MP * FFN * 2, "overlays");
static_assert(WS_END6 < ((size_t)1 << 31), "32-bit workspace offsets");

template <int STEP, unsigned GATE_OFF> struct EpiGate {
    static constexpr bool PERM = true, AFTER_DRAIN = false;
    unsigned char* ws_;
    static __device__ __forceinline__ void unpack8(const u32x4 g, f32x4& lo, f32x4& hi) {
        lo = (f32x4){__uint_as_float(g.x << 16), __uint_as_float(g.x & 0xffff0000u), __uint_as_float(g.y << 16), __uint_as_float(g.y & 0xffff0000u)};
        hi = (f32x4){__uint_as_float(g.z << 16), __uint_as_float(g.z & 0xffff0000u), __uint_as_float(g.w << 16), __uint_as_float(g.w & 0xffff0000u)}; }
    __device__ __forceinline__ void operator()(const f32x4 (&acc)[2][2][4][2], const Unit& u, int wr, int wc, int fr, int fq) const {
        int l_ = lane_fresh(); asm volatile("" : "+v"(l_)); fr = l_ & 15; fq = l_ >> 4;
        unsigned char* w = opaque_g(ws_);
        const unsigned row0 = u.pm * BM + wr * 64 + fr, col0 = u.pn * BM + wc * 32 + 8 * fq;
#pragma unroll
        for (int ai = 0; ai < 2; ++ai)
#pragma unroll
            for (int m = 0; m < 4; ++m) { unsigned row = row0 + ai * HALF + m * 16; asm volatile("" : "+v"(row));
#pragma unroll
                for (int bj = 0; bj < 2; ++bj) { const unsigned e = row * 1024 + col0 + bj * HALF;
                    f32x4 g0, g1; unpack8(*at<const u32x4>(w, GATE_OFF + e * 2), g0, g1);
                    f32x4 o0 = acc[ai][bj][m][0] * g0, o1 = acc[ai][bj][m][1] * g1;
                    if (STEP == 0) *at<u32x4>(w, (unsigned)WS_TMP + e * 2) = pack8(o0, o1);
                    else { f32x4 t0, t1; unpack8(*at<const u32x4>(w, (unsigned)WS_TMP + e * 2), t0, t1); *at<u32x4>(w, (unsigned)WS_MX + e * 2) = pack8(o0 + t0, o1 + t1); } }
                asm volatile("" ::: "memory"); }
    }
};
struct EpiSwiGLU2 {
    static constexpr bool PERM = true, AFTER_DRAIN = false;
    unsigned char* ws_;
    __device__ __forceinline__ void operator()(const f32x4 (&acc)[2][2][4][2], const Unit& u, int wr, int wc, int fr, int fq) const {
        int l_ = lane_fresh(); asm volatile("" : "+v"(l_)); fr = l_ & 15; fq = l_ >> 4;
        unsigned char* w = opaque_g(ws_);
        const unsigned row0 = u.pm * BM + wr * 64 + fr, col0 = u.pn * HALF + wc * 32 + 8 * fq;
        float rsc[8];
#pragma unroll
        for (int k = 0; k < 8; ++k) rsc[k] = row_rscale16(at<const float>(w, (unsigned)WS_SSQH2), (int)(row0 + (k >> 2) * HALF + (k & 3) * 16), 1.f / D);
#pragma unroll
        for (int ai = 0; ai < 2; ++ai)
#pragma unroll
            for (int m = 0; m < 4; ++m) { unsigned row = row0 + ai * HALF + m * 16; asm volatile("" : "+v"(row));
                const float r = rsc[ai * 4 + m];
                f32x4 o[2];
#pragma unroll
                for (int n = 0; n < 2; ++n)
#pragma unroll
                    for (int j = 0; j < 4; ++j) { const float g = acc[ai][0][m][n][j] * r, up = acc[ai][1][m][n][j] * r; o[n][j] = fast_silu(g) * up; }
                u32x4 pk; pk.x = pg8::cvt_pk_bf16(o[0][0], o[0][1]); pk.y = pg8::cvt_pk_bf16(o[0][2], o[0][3]); pk.z = pg8::cvt_pk_bf16(o[1][0], o[1][1]); pk.w = pg8::cvt_pk_bf16(o[1][2], o[1][3]);
                *at<u32x4>(w, (unsigned)WS_ACT + (row * FFN + col0) * 2) = pk;
                asm volatile("" ::: "memory"); }
    }
};
__device__ __forceinline__ void final_norm_phase(Frame& F, const Ptrs& a) {
    const int lane = fresh_tid(F.wave) & 63;
    const int gw = F.vcu * NWAVES + F.wave, NGW = F.G * NWAVES;
    const bf16* H3 = (const bf16*)(a.ws + WS_H3B); const float* SSQ = (const float*)(a.ws + WS_SSQH3);
    f32x4 g[4];
#pragma unroll
    for (int j = 0; j < 4; ++j) g[j] = *((const f32x4*)a.in(26) + 2 * lane + (j & 1) + 128 * (j >> 1));
    float* outp = a.out();
    for (int row0 = gw; row0 < ROW_PAD; row0 += 2 * NGW) {
        u32x4 v[2][2]; float r[2];
#pragma unroll
        for (int t = 0; t < 2; ++t) { const int row = row0 + t * NGW; const bool ok = row < ROW_PAD && !(row >= MMAIN && row < ROW_SMP);
            r[t] = ok ? row_rscale16(SSQ, row, 1.f / D) : 0.f;
#pragma unroll
            for (int h = 0; h < 2; ++h) v[t][h] = ok ? *((const u32x4*)(H3 + (size_t)row * D) + lane + 64 * h) : (u32x4){0u, 0u, 0u, 0u}; }
#pragma unroll
        for (int t = 0; t < 2; ++t) { const int row = row0 + t * NGW; if (row >= ROW_PAD || (row >= MMAIN && row < ROW_SMP)) continue;
            float* dst = row < MMAIN ? outp + OUT_YP + (size_t)row * D : outp + OUT_YS + (size_t)(row - ROW_SMP) * D;
#pragma unroll
            for (int h = 0; h < 2; ++h) { const u32x4 x = v[t][h];
                const f32x4 lo = (f32x4){__uint_as_float(x.x << 16), __uint_as_float(x.x & 0xffff0000u), __uint_as_float(x.y << 16), __uint_as_float(x.y & 0xffff0000u)};
                const f32x4 hi = (f32x4){__uint_as_float(x.z << 16), __uint_as_float(x.z & 0xffff0000u), __uint_as_float(x.w << 16), __uint_as_float(x.w & 0xffff0000u)};
                *((f32x4*)dst + 2 * lane + 128 * h) = lo * r[t] * g[2 * h]; *((f32x4*)dst + 2 * lane + 1 + 128 * h) = hi * r[t] * g[2 * h + 1]; } }
    }
}
}
namespace mk {
typedef float f32x4_t __attribute__((ext_vector_type(4)));
constexpr int XROW0 = MMAIN, SK_C = 64 * 64;
__device__ __forceinline__ void skinny64(int wave, int tid, const bf16* A, int K, const bf16* Bt, int brow0, LAS float* P, float (&out)[8]) {
    const int lane = tid & 63, r16 = lane & 15, kq = lane >> 4;
    const bf16* ap = A + (size_t)(XROW0 + r16) * K + 8 * kq;
    const bf16* bp = Bt + (size_t)(brow0 + r16) * K + 8 * kq;
    f32x4 acc[4][4];
#pragma unroll
    for (int mf = 0; mf < 4; ++mf)
#pragma unroll
        for (int nf = 0; nf < 4; ++nf) acc[mf][nf] = (f32x4){0.f, 0.f, 0.f, 0.f};
    const int KS = K / 32;
    bf16x8 a0[4], b0[4], a1[4], b1[4], a2[4], b2[4];
#define SK_LOAD(a_, b_, kk_) do { _Pragma("unroll") for (int f = 0; f < 4; ++f) { a_[f] = *(const bf16x8*)(ap + (size_t)(16 * f) * K + 32 * (kk_)); b_[f] = *(const bf16x8*)(bp + (size_t)(16 * f) * K + 32 * (kk_)); } } while (0)
#define SK_MMA(a_, b_) do { _Pragma("unroll") for (int mf = 0; mf < 4; ++mf) _Pragma("unroll") for (int nf = 0; nf < 4; ++nf) acc[mf][nf] = __builtin_amdgcn_mfma_f32_16x16x32_bf16(a_[mf], b_[nf], acc[mf][nf], 0, 0, 0); } while (0)
    int kk = wave;
    if (kk < KS) SK_LOAD(a0, b0, kk);
    if (kk + 8 < KS) SK_LOAD(a1, b1, kk + 8);
    if (kk + 16 < KS) SK_LOAD(a2, b2, kk + 16);
    for (; kk < KS; kk += 24) {
        SK_MMA(a0, b0); if (kk + 24 < KS) SK_LOAD(a0, b0, kk + 24);
        if (kk + 8 < KS) { SK_MMA(a1, b1); if (kk + 32 < KS) SK_LOAD(a1, b1, kk + 32); }
        if (kk + 16 < KS) { SK_MMA(a2, b2); if (kk + 40 < KS) SK_LOAD(a2, b2, kk + 40); }
    }
#undef SK_LOAD
#undef SK_MMA
    LAS float* Pw = P + wave * SK_C;
#pragma unroll
    for (int mf = 0; mf < 4; ++mf)
#pragma unroll
        for (int nf = 0; nf < 4; ++nf)
#pragma unroll
            for (int i = 0; i < 4; ++i) Pw[(16 * mf + 4 * kq + i) * 64 + 16 * nf + r16] = acc[mf][nf][i];
    __syncthreads();
    const LAS float* pr = P + (tid >> 3) * 64 + 8 * (tid & 7);
    f32x4 s0 = *(const LAS f32x4*)pr, s1 = *(const LAS f32x4*)(pr + 4);
#pragma unroll
    for (int w = 1; w < 8; ++w) { s0 = s0 + *(const LAS f32x4*)(pr + w * SK_C); s1 = s1 + *(const LAS f32x4*)(pr + w * SK_C + 4); }
    out[0] = s0[0]; out[1] = s0[1]; out[2] = s0[2]; out[3] = s0[3]; out[4] = s1[0]; out[5] = s1[1]; out[6] = s1[2]; out[7] = s1[3];
    __syncthreads();
}
__device__ __forceinline__ float sum8(float v, int lane) { v += lx(v, lane, 1); v += lx(v, lane, 2); v += lx(v, lane, 4); return v; }
__device__ __forceinline__ void st8_bf16(bf16* p, const float* v) { u32x4 w; w.x = pg8::cvt_pk_bf16(v[0], v[1]); w.y = pg8::cvt_pk_bf16(v[2], v[3]); w.z = pg8::cvt_pk_bf16(v[4], v[5]); w.w = pg8::cvt_pk_bf16(v[6], v[7]); *(u32x4*)p = w; }
__device__ __forceinline__ void ld8(const LAS float* p, float* v) { const f32x4 a = *(const LAS f32x4*)p, b = *(const LAS f32x4*)(p + 4); v[0] = a[0]; v[1] = a[1]; v[2] = a[2]; v[3] = a[3]; v[4] = b[0]; v[5] = b[1]; v[6] = b[2]; v[7] = b[3]; }
__device__ __forceinline__ void st16_wt7(void* p, u32x4 v) { asm volatile("global_store_dwordx4 %0, %1, off sc1\n\ts_nop 1" :: "v"(p), "v"(v) : "memory"); }
__device__ __forceinline__ void xjob_signal(unsigned char* ws, int tid, int cnt_idx) {
    asm volatile("s_waitcnt vmcnt(0)" ::: "memory"); __syncthreads();
    if (tid == 0) (void)__hip_atomic_fetch_add((unsigned*)(ws + WS_CTL) + CW_XCNT + cnt_idx, 1u, __ATOMIC_RELAXED, __HIP_MEMORY_SCOPE_AGENT);
}
__device__ __forceinline__ void xjob_wait(unsigned char* ws, int tid, int cnt_idx, unsigned need) {
    if (tid == 0) { const unsigned* cn = (const unsigned*)(ws + WS_CTL) + CW_XCNT + cnt_idx; unsigned spins = 0;
        while (__hip_atomic_load(cn, __ATOMIC_RELAXED, __HIP_MEMORY_SCOPE_AGENT) < need && ++spins < (1u << 22)) __builtin_amdgcn_s_sleep(8);
        __builtin_amdgcn_fence(__ATOMIC_ACQUIRE, "agent"); asm volatile("s_waitcnt vmcnt(0)" ::: "memory"); }
    __syncthreads();
}

__device__ __forceinline__ void xjob_ffn_up(Frame& F, unsigned char* ws, int j, size_t a_off, size_t w_off, int rs_mode, int cnt_idx) {
    ws = opaque_g(ws);
    const int tid = fresh_tid(F.wave);
    LAS float* P = (LAS float*)(F.lds + RING_OFF);
    const int brow0 = 256 * (j >> 1) + 64 * (j & 1);
    float g[8], u[8], o[8];
    skinny64(F.wave, tid, (const bf16*)(ws + a_off), D, (const bf16*)(ws + w_off), brow0, P, g);
    skinny64(F.wave, tid, (const bf16*)(ws + a_off), D, (const bf16*)(ws + w_off), brow0 + 128, P, u);
    const int r = tid >> 3, cg = tid & 7, row = XROW0 + r;
    const float rs = rs_mode == 0 ? ((const float*)(ws + WS_R1))[row] : row_rscale16((const float*)(ws + WS_SSQH2), row, 1.f / D);
#pragma unroll
    for (int k = 0; k < 8; ++k) o[k] = fast_silu(g[k] * rs) * (u[k] * rs);
    { u32x4 pk; pk.x = pg8::cvt_pk_bf16(o[0], o[1]); pk.y = pg8::cvt_pk_bf16(o[2], o[3]); pk.z = pg8::cvt_pk_bf16(o[4], o[5]); pk.w = pg8::cvt_pk_bf16(o[6], o[7]);
      st16_wt7((bf16*)(ws + WS_ACT) + (size_t)row * FFN + 64 * j + 8 * cg, pk); }
    xjob_signal(ws, tid, cnt_idx);
}
__device__ __forceinline__ void xjob_resid(Frame& F, unsigned char* ws, int j, size_t a_off, int K, size_t w_off, const void* res  , bool res_f32, float scale, size_t outb_off, size_t ssq_off) {
    ws = opaque_g(ws);
    const int tid = fresh_tid(F.wave), lane = tid & 63;
    LAS float* P = (LAS float*)(F.lds + RING_OFF);
    float v[8], o[8];
    skinny64(F.wave, tid, (const bf16*)(ws + a_off), K, (const bf16*)(ws + w_off), 64 * j, P, v);
    const int r = tid >> 3, cg = tid & 7, row = XROW0 + r, col = 64 * j + 8 * cg;
    float b[8];
    if (res_f32) { const float* rp = (const float*)res + (size_t)r * D + col; const f32x4 b0 = *(const f32x4*)rp, b1 = *(const f32x4*)(rp + 4); b[0] = b0[0]; b[1] = b0[1]; b[2] = b0[2]; b[3] = b0[3]; b[4] = b1[0]; b[5] = b1[1]; b[6] = b1[2]; b[7] = b1[3]; }
    else { const u32x4 rb = *(const u32x4*)((const bf16*)res + (size_t)r * D + col);
#pragma unroll
        for (int k = 0; k < 8; ++k) { const unsigned wv = rb[k >> 1]; b[k] = __uint_as_float((k & 1) ? (wv & 0xffff0000u) : (wv << 16)); } }
    float ss = 0.f;
#pragma unroll
    for (int k = 0; k < 8; ++k) { o[k] = b[k] + scale * v[k]; ss += o[k] * o[k]; }
    st8_bf16((bf16*)(ws + outb_off) + (size_t)row * D + col, o);
    ss = sum8(ss, lane);
    if (cg == 0) atomicAdd((float*)(ws + ssq_off) + row, ss);
}
__device__ __forceinline__ void xjob_win(Frame& F, unsigned char* ws, int j) {
    ws = opaque_g(ws);
    const int tid = fresh_tid(F.wave), lane = tid & 63;
    LAS float* P = (LAS float*)(F.lds + RING_OFF);
    const int pn = j >> 1, q = j & 1;
    float v0[8], v1[8];
    skinny64(F.wave, tid, (const bf16*)(ws + WS_HB), D, (const bf16*)(ws + WS_WIN), 256 * pn + 64 * q, P, v0);
    skinny64(F.wave, tid, (const bf16*)(ws + WS_HB), D, (const bf16*)(ws + WS_WIN), 256 * pn + 64 * q + 128, P, v1);
    const int r = tid >> 3, cg = tid & 7, row = XROW0 + r;
    const float rs = row_rscale16((const float*)(ws + WS_SSQH), row, 1.f / D);
    const float* TAB = (const float*)(ws + WS_TAB);
#pragma unroll
    for (int k = 0; k < 8; ++k) { v0[k] *= rs; v1[k] *= rs; }
    const int tc0 = 64 * q + 8 * cg;
    if (pn == 0) {
        bf16* CQ = (bf16*)(ws + WS_CQ) + (size_t)row * QR; float* SSQCQ = (float*)(ws + WS_SSQCQ) + (size_t)row * 8;
        st8_bf16(CQ + tc0, v0); st8_bf16(CQ + tc0 + 128, v1);
        float s0 = 0.f, s1 = 0.f;
#pragma unroll
        for (int k = 0; k < 8; ++k) { s0 += v0[k] * v0[k]; s1 += v1[k] * v1[k]; }
        s0 = sum8(s0, lane); s1 = sum8(s1, lane);
        if (cg == 0) { SSQCQ[2 * q] = s0; SSQCQ[2 * q + 1] = s1; }
    } else if (pn == 1) {
        bf16* CQ = (bf16*)(ws + WS_CQ) + (size_t)row * QR; float* SSQCQ = (float*)(ws + WS_SSQCQ) + (size_t)row * 8;
        st8_bf16(CQ + 256 + tc0, v0);
        float s0 = 0.f;
#pragma unroll
        for (int k = 0; k < 8; ++k) s0 += v0[k] * v0[k];
        s0 = sum8(s0, lane);
        if (cg == 0) { SSQCQ[4 + q] = s0; SSQCQ[6 + q] = 0.f; }
        float x2[8];
#pragma unroll
        for (int k = 0; k < 8; ++k) x2[k] = lx(v1[k], lane, 2);
        if (q == 0 && cg < 2) {
            const int pi = row_pidx(row), i0 = 8 * cg;
            float y1[8], y2[8];
#pragma unroll
            for (int k = 0; k < 8; ++k) { const float c = TAB[TAB_C16 / 4 + pi * 16 + i0 + k], s = TAB[TAB_S16 / 4 + pi * 16 + i0 + k]; y1[k] = v1[k] * c - x2[k] * s; y2[k] = v1[k] * s + x2[k] * c; }
            st8_bf16((bf16*)(ws + WS_KRB) + (size_t)row * 32 + i0, y1); st8_bf16((bf16*)(ws + WS_KRB) + (size_t)row * 32 + 16 + i0, y2);
            float* kf = (float*)(ws + WS_KRF) + (size_t)row * 32;
#pragma unroll
            for (int k = 0; k < 8; ++k) { kf[i0 + k] = y1[k]; kf[16 + i0 + k] = y2[k]; }
        }
    } else if (pn == 2) {
        float* CKVF = (float*)(ws + WS_CKVF) + (size_t)row * KVR; bf16* CKVB = (bf16*)(ws + WS_CKVB) + (size_t)row * KVR; float* SSQKV = (float*)(ws + WS_SSQKV) + (size_t)row * 4;
        float s0 = 0.f, s1 = 0.f;
#pragma unroll
        for (int k = 0; k < 8; ++k) { CKVF[tc0 + k] = v0[k]; CKVF[tc0 + 128 + k] = v1[k]; s0 += v0[k] * v0[k]; s1 += v1[k] * v1[k]; }
        st8_bf16(CKVB + tc0, v0); st8_bf16(CKVB + tc0 + 128, v1);
        s0 = sum8(s0, lane); s1 = sum8(s1, lane);
        if (cg == 0) { SSQKV[2 * q] = s0; SSQKV[2 * q + 1] = s1; }
    } else if (pn < 7) {
        const bool isk = pn >= 5; const int hh = 2 * ((pn - 3) & 1) + q, i0 = 8 * cg;
        const int pi = row_pidx(row), jt = row_jtok(row);
        const float mult = isk ? RK_SCALE * TAB[TAB_GN / 4 + hh * 128 + jt] : TAB[TAB_GP / 4 + hh * 128 + jt];
        float y1[8], y2[8];
#pragma unroll
        for (int k = 0; k < 8; ++k) { const float c = TAB[TAB_C64 / 4 + pi * 64 + i0 + k], s = TAB[TAB_S64 / 4 + pi * 64 + i0 + k]; y1[k] = (v0[k] * c - v1[k] * s) * mult; y2[k] = (v0[k] * s + v1[k] * c) * mult; }
        bf16* dst = (bf16*)(ws + (isk ? WS_RK : WS_RQ)) + (size_t)row * 512 + hh * 128;
        st8_bf16(dst + i0, y1); st8_bf16(dst + 64 + i0, y2);
        if (isk) { bf16* RKT = (bf16*)(ws + WS_RKT);
#pragma unroll
            for (int k = 0; k < 8; ++k) { RKT[(size_t)(hh * 128 + i0 + k) * MP + row] = bf1(y1[k]); RKT[(size_t)(hh * 128 + 64 + i0 + k) * MP + row] = bf1(y2[k]); } }
    } else if (pn < 11) {
        bf16* RVT = (bf16*)(ws + WS_RVT);
#pragma unroll
        for (int k = 0; k < 8; ++k) { RVT[(size_t)((pn - 7) * 256 + tc0 + k) * MP + row] = bf1(v0[k]); RVT[(size_t)((pn - 7) * 256 + tc0 + 128 + k) * MP + row] = bf1(v1[k]); }
    } else {
        const int t = (pn - 11) >> 2; bf16* dst = (bf16*)(ws + WS_SRG + (size_t)t * (WS_SGA - WS_SRG)) + (size_t)row * 1024 + ((pn - 11) & 3) * 256;
        float o0[8], o1[8];
#pragma unroll
        for (int k = 0; k < 8; ++k) { const float g0 = fast_sigmoid(v0[k]), g1 = fast_sigmoid(v1[k]); o0[k] = t == 0 ? v0[k] * g0 : g0; o1[k] = t == 0 ? v1[k] * g1 : g1; }
        st8_bf16(dst + tc0, o0); st8_bf16(dst + tc0 + 128, o1);
    }
}
__device__ __forceinline__ void xjob_q(Frame& F, unsigned char* ws, int j) {
    ws = opaque_g(ws);
    const int tid = fresh_tid(F.wave), lane = tid & 63;
    LAS float* P = (LAS float*)(F.lds + RING_OFF);
    float v[8], p[8], o[8];
    skinny64(F.wave, tid, (const bf16*)(ws + WS_CQ), QR, (const bf16*)(ws + WS_WUQ), 64 * j, P, v);
    const int r = tid >> 3, cg = tid & 7, row = XROW0 + r;
    const float rs = row_rscale8((const float*)(ws + WS_SSQCQ), row, 1.f / QR) * SC_Q;
    const float* TAB = (const float*)(ws + WS_TAB);
    const int pi = row_pidx(row), col = 64 * j + 8 * cg, grp = col >> 5, w32 = col & 31;
#pragma unroll
    for (int k = 0; k < 8; ++k) p[k] = lx(v[k], lane, 2);
    if (grp % 3 == 2) {
        const int i0 = w32 & 15;
#pragma unroll
        for (int k = 0; k < 8; ++k) { const float c = TAB[TAB_C16 / 4 + pi * 16 + i0 + k], sn = TAB[TAB_S16 / 4 + pi * 16 + i0 + k];
            o[k] = (w32 < 16 ? v[k] * c - p[k] * sn : p[k] * sn + v[k] * c) * rs; }
    } else {
#pragma unroll
        for (int k = 0; k < 8; ++k) o[k] = v[k] * rs;
    }
    st8_bf16((bf16*)(ws + WS_QA) + (size_t)row * 768 + col, o);
}
__device__ __forceinline__ void xjob_kv(Frame& F, unsigned char* ws, int j, bool is_v) {
    ws = opaque_g(ws);
    const int tid = fresh_tid(F.wave);
    LAS float* P = (LAS float*)(F.lds + RING_OFF);
    float v[8];
    skinny64(F.wave, tid, (const bf16*)(ws + WS_CKVB), KVR, (const bf16*)(ws + (is_v ? WS_WUV : WS_WUK)), 64 * j, P, v);
    const int r = tid >> 3, cg = tid & 7, row = XROW0 + r, col = 64 * j + 8 * cg;
    const float rs = row_rscale4((const float*)(ws + WS_SSQKV), row, 1.f / KVR);
#pragma unroll
    for (int k = 0; k < 8; ++k) v[k] *= rs;
    if (!is_v) st8_bf16((bf16*)(ws + WS_KN) + (size_t)row * 512 + col, v);
    else { bf16* VT = (bf16*)(ws + WS_VT);
#pragma unroll
        for (int k = 0; k < 8; ++k) VT[(size_t)(col + k) * MP + row] = bf1(v[k]); }
}
__device__ __forceinline__ void xjob_mix(Frame& F, unsigned char* ws, int j) {
    ws = opaque_g(ws);
    const int tid = fresh_tid(F.wave);
    LAS float* P = (LAS float*)(F.lds + RING_OFF);
    float a[8], b[8], o[8];
    skinny64(F.wave, tid, (const bf16*)(ws + WS_AV), 512, (const bf16*)(ws + WS_WMO), 64 * j, P, a);
    skinny64(F.wave, tid, (const bf16*)(ws + WS_RIN), D, (const bf16*)(ws + WS_WRO), 64 * j, P, b);
    const int r = tid >> 3, cg = tid & 7, row = XROW0 + r, col = 64 * j + 8 * cg;
    const u32x4 ga = *(const u32x4*)((const bf16*)(ws + WS_SGA) + (size_t)row * 1024 + col), gb = *(const u32x4*)((const bf16*)(ws + WS_SGB) + (size_t)row * 1024 + col);
#pragma unroll
    for (int k = 0; k < 8; ++k) { const unsigned wa = ga[k >> 1], wb = gb[k >> 1];
        const float fa = __uint_as_float((k & 1) ? (wa & 0xffff0000u) : (wa << 16)), fb = __uint_as_float((k & 1) ? (wb & 0xffff0000u) : (wb << 16));
        o[k] = fa * a[k] + fb * b[k]; }
    st8_bf16((bf16*)(ws + WS_MX) + (size_t)row * 1024 + col, o);
}
__device__ __forceinline__ void xjob_ql(Frame& F, unsigned char* ws, int j) {
    ws = opaque_g(ws);
    const int tid = fresh_tid(F.wave);
    LAS float* P = (LAS float*)(F.lds + RING_OFF);
    float v[8];
    skinny64(F.wave, tid, (const bf16*)(ws + WS_CQ), QR, (const bf16*)(ws + WS_WQL), 64 * j, P, v);
    const int r = tid >> 3, cg = tid & 7, row = XROW0 + r;
    const float rs = row_rscale8((const float*)(ws + WS_SSQCQ), row, 1.f / QR) * SC_Q;
    float* dst = (float*)(ws + WS_QL) + (size_t)r * 2048 + 64 * j + 8 * cg;
    *(f32x4*)dst = (f32x4){v[0] * rs, v[1] * rs, v[2] * rs, v[3] * rs}; *(f32x4*)(dst + 4) = (f32x4){v[4] * rs, v[5] * rs, v[6] * rs, v[7] * rs};
}
}
namespace mk {
constexpr int RC_STR = 272;
constexpr int RC_S = 0, RC_KT = 0  , RC_Q = 256 * RC_STR, RC_A = RC_Q + 128 * RC_STR, RC_RED = RC_A + 128 * RC_STR, RC_END = RC_RED + 2 * 8 * 128 * 4;
static_assert(RC_END <= SCR_BYTES, "chain LDS map");
__device__ __forceinline__ void ret_chain_unit(Frame& F, const Ptrs& a, int bh) {
    unsigned char* ws = a.ws; ws = opaque_g(ws);
    const int tid_k = fresh_tid(F.wave), w = F.wave;
    const int hh = bh & 3, b = bh >> 2;
    LAS unsigned char* L = F.lds + RING_OFF;
    LAS float* red = (LAS float*)(L + RC_RED);
    const bf16* RQ = (const bf16*)(ws + WS_RQ); const bf16* RK = (const bf16*)(ws + WS_RK); const bf16* RKT = (const bf16*)(ws + WS_RKT); const bf16* RVT = (const bf16*)(ws + WS_RVT);
    const float g = gpow_t(ws, hh, 1), g127 = gpow_t(ws, hh, 127);
    f32x16 S[4];
    {
        const int lane = tid_k & 63, r32 = lane & 31, half = lane >> 5;
#pragma unroll
        for (int db = 0; db < 4; ++db)
#pragma unroll
            for (int i = 0; i < 16; ++i) S[db][i] = 0.f;
        const bf16x8 af = *(const bf16x8*)(RVT + (size_t)(hh * 256 + 32 * w + r32) * MP + ROW_META + 8 * half);
#pragma unroll
        for (int db = 0; db < 4; ++db) { const bf16x8 bf = *(const bf16x8*)(RKT + (size_t)(hh * 128 + 32 * db + r32) * MP + ROW_META + 8 * half); S[db] = __builtin_amdgcn_mfma_f32_32x32x16_bf16(af, bf, S[db], 0, 0, 0); }
        const float sc = gpow_t(ws, hh, NMETA - 1);
#pragma unroll
        for (int db = 0; db < 4; ++db)
#pragma unroll
            for (int i = 0; i < 16; ++i) S[db][i] *= sc;
    }
    v4u qreg[4], jreg[4];
#define RC_FETCH_QK(tok0_) do { _Pragma("unroll") for (int k = 0; k < 4; ++k) { const int ch = tid + 512 * k; \
        qreg[k] = *(const v4u*)(RQ + (size_t)((tok0_) + (ch >> 4)) * 512 + hh * 128 + 8 * (ch & 15)); jreg[k] = *(const v4u*)(RK + (size_t)((tok0_) + (ch >> 4)) * 512 + hh * 128 + 8 * (ch & 15)); } } while (0)
    { const int tid = tid_k; RC_FETCH_QK(b * SEQ); }
#define RC_BLK_IB(n) ((n) < 1 ? 0 : (n) < 3 ? 1 : (n) < 6 ? 2 : 3)
#define RC_BLK_JB(n) ((n) - ((n) < 1 ? 0 : (n) < 3 ? 1 : (n) < 6 ? 3 : 6))
#pragma unroll 1
    for (int c = 0; c < 16; ++c) {
        const int tok0 = b * SEQ + c * 128;
        int tid_c = tid_k; asm volatile("" : "+v"(tid_c));
        const int tid = tid_c, lane = tid & 63, r32 = lane & 31, half = lane >> 5;
#pragma unroll
        for (int k = 0; k < 4; ++k) { const int ch = tid + 512 * k; *(LAS v4u*)(L + RC_Q + (ch >> 4) * RC_STR + 16 * (ch & 15)) = qreg[k]; *(LAS v4u*)(L + RC_S + (ch >> 4) * RC_STR + 16 * (ch & 15)) = jreg[k]; }
        __syncthreads();
        v4u kreg[4];
#pragma unroll
        for (int k = 0; k < 4; ++k) { const int ch = tid + 512 * k; kreg[k] = *(const v4u*)(RKT + (size_t)(hh * 128 + (ch >> 4)) * MP + tok0 + 8 * (ch & 15)); }
        for (int n = w; n < 10; n += 8) {
            const int ib_ = RC_BLK_IB(n), jb_ = RC_BLK_JB(n);
            f32x16 at;
#pragma unroll
            for (int i = 0; i < 16; ++i) at[i] = 0.f;
#pragma unroll
            for (int s = 0; s < 8; ++s) { const bf16x8 kf = *(const LAS bf16x8*)(L + RC_S + (32 * jb_ + r32) * RC_STR + (16 * s + 8 * half) * 2); const bf16x8 qf = *(const LAS bf16x8*)(L + RC_Q + (32 * ib_ + r32) * RC_STR + (16 * s + 8 * half) * 2); at = __builtin_amdgcn_mfma_f32_32x32x16_bf16(kf, qf, at, 0, 0, 0); }
            if (jb_ == ib_) {
#pragma unroll
                for (int i = 0; i < 16; ++i) if (crow(i, half) > r32) at[i] = 0.f; }
#pragma unroll
            for (int gq = 0; gq < 4; ++gq) { f32x4 o_; o_[0] = at[4 * gq]; o_[1] = at[4 * gq + 1]; o_[2] = at[4 * gq + 2]; o_[3] = at[4 * gq + 3];
                *(LAS u32x2*)(L + RC_A + (32 * ib_ + r32) * RC_STR + (32 * jb_ + 8 * gq + 4 * half) * 2) = pack4(o_); }
        }
        __syncthreads();
#pragma unroll
        for (int db = 0; db < 4; ++db)
#pragma unroll
            for (int i = 0; i < 16; ++i) *(LAS bf16*)(L + RC_S + (32 * w + crow(i, half)) * RC_STR + (32 * db + r32) * 2) = bf1(S[db][i]);
        f32x16 ot[4];
#pragma unroll
        for (int ib = 0; ib < 4; ++ib)
#pragma unroll
            for (int i = 0; i < 16; ++i) ot[ib][i] = 0.f;
#pragma unroll 2
        for (int s = 0; s < 8; ++s) {
            const bf16x8 sf = *(const LAS bf16x8*)(L + RC_S + (32 * w + r32) * RC_STR + (16 * s + 8 * half) * 2);
#pragma unroll
            for (int ib = 0; ib < 4; ++ib) { const bf16x8 qf = *(const LAS bf16x8*)(L + RC_Q + (32 * ib + r32) * RC_STR + (16 * s + 8 * half) * 2); ot[ib] = __builtin_amdgcn_mfma_f32_32x32x16_bf16(sf, qf, ot[ib], 0, 0, 0); }
        }
#pragma unroll
        for (int ib = 0; ib < 4; ++ib)
#pragma unroll
            for (int i = 0; i < 16; ++i) ot[ib][i] *= g;
        __syncthreads();
#pragma unroll
        for (int k = 0; k < 4; ++k) { const int ch = tid + 512 * k; *(LAS v4u*)(L + RC_KT + (ch >> 4) * RC_STR + 16 * (ch & 15)) = kreg[k]; }
        __syncthreads();
        if (c < 15) RC_FETCH_QK(tok0 + 128);
#pragma unroll
        for (int db = 0; db < 4; ++db)
#pragma unroll
            for (int i = 0; i < 16; ++i) S[db][i] *= g;
        {
            const bf16* vp = RVT + (size_t)(hh * 256 + 32 * w + r32) * MP + tok0 + 8 * half;
            bf16x8 v0 = *(const bf16x8*)(vp), v1 = *(const bf16x8*)(vp + 16), v2 = v1;
#pragma unroll 1
            for (int s = 0; s < 8; ++s) {
                if (s + 2 < 8) v2 = *(const bf16x8*)(vp + 16 * (s + 2));
#pragma unroll
                for (int ib = 0; ib < 4; ++ib) if (s < 2 * (ib + 1)) { const bf16x8 af = *(const LAS bf16x8*)(L + RC_A + (32 * ib + r32) * RC_STR + (16 * s + 8 * half) * 2); ot[ib] = __builtin_amdgcn_mfma_f32_32x32x16_bf16(v0, af, ot[ib], 0, 0, 0); }
#pragma unroll
                for (int db = 0; db < 4; ++db) { const bf16x8 kf = *(const LAS bf16x8*)(L + RC_KT + (32 * db + r32) * RC_STR + (16 * s + 8 * half) * 2); S[db] = __builtin_amdgcn_mfma_f32_32x32x16_bf16(v0, kf, S[db], 0, 0, 0); }
                v0 = v1; v1 = v2;
            }
        }
#pragma unroll
        for (int db = 0; db < 4; ++db)
#pragma unroll
            for (int i = 0; i < 16; ++i) S[db][i] *= g127;
#pragma unroll
        for (int ib = 0; ib < 4; ++ib) { float t = 0.f;
#pragma unroll
            for (int i = 0; i < 16; ++i) t += ot[ib][i];
            t += lx(t, lane, 32); if (half == 0) red[w * 128 + 32 * ib + r32] = t; }
        __syncthreads();
        float mu[4];
#pragma unroll
        for (int ib = 0; ib < 4; ++ib) { float t = 0.f;
#pragma unroll
            for (int ww = 0; ww < 8; ++ww) t += red[ww * 128 + 32 * ib + r32];
            mu[ib] = t * (1.f / 256.f); }
#pragma unroll
        for (int ib = 0; ib < 4; ++ib) { float t = 0.f;
#pragma unroll
            for (int i = 0; i < 16; ++i) { ot[ib][i] -= mu[ib]; t += ot[ib][i] * ot[ib][i]; }
            t += lx(t, lane, 32); if (half == 0) red[1024 + w * 128 + 32 * ib + r32] = t; }
        __syncthreads();
#pragma unroll
        for (int ib = 0; ib < 4; ++ib) { float t = 0.f;
#pragma unroll
            for (int ww = 0; ww < 8; ++ww) t += red[1024 + ww * 128 + 32 * ib + r32];
            const float rstd = 1.0f / sqrtf(t * (1.f / 256.f) + EPS);
            const int irow = tok0 + 32 * ib + r32;
            const bf16* SRG = (const bf16*)(ws + WS_SRG) + (size_t)irow * 1024 + hh * 256 + 32 * w + 4 * half;
            bf16* RIN = (bf16*)(ws + WS_RIN) + (size_t)irow * 1024 + hh * 256 + 32 * w + 4 * half;
            const float* gn = a.in(19) + hh * 256 + 32 * w + 4 * half;
#pragma unroll
            for (int gq = 0; gq < 4; ++gq) {
                const u32x2 sg = *(const u32x2*)(SRG + 8 * gq); const f32x4 gv = *(const f32x4*)(gn + 8 * gq);
                f32x4 o;
                o[0] = ot[ib][4 * gq + 0] * rstd * gv[0] * __uint_as_float(sg.x << 16); o[1] = ot[ib][4 * gq + 1] * rstd * gv[1] * __uint_as_float(sg.x & 0xffff0000u);
                o[2] = ot[ib][4 * gq + 2] * rstd * gv[2] * __uint_as_float(sg.y << 16); o[3] = ot[ib][4 * gq + 3] * rstd * gv[3] * __uint_as_float(sg.y & 0xffff0000u);
                *(u32x2*)(RIN + 8 * gq) = pack4(o);
            } }
        __syncthreads();
    }
#undef RC_FETCH_QK
#undef RC_BLK_IB
#undef RC_BLK_JB
    const int lane = tid_k & 63, r32 = lane & 31, half = lane >> 5;
#pragma unroll
    for (int db = 0; db < 4; ++db)
#pragma unroll
        for (int i = 0; i < 16; ++i) a.out()[OUT_SRP + ((size_t)bh * RDK + 32 * db + r32) * RDV + 32 * w + crow(i, half)] = S[db][i];
}
}
namespace mk {
constexpr int CW_FLAG = 8192;
__device__ __forceinline__ void st16_wt(void* p, v4u v) { asm volatile("global_store_dwordx4 %0, %1, off sc1\n\ts_nop 1" :: "v"(p), "v"(v) : "memory"); }
__device__ __forceinline__ void ret_state_unit(Frame& F, const Ptrs& a, int bh) {
    unsigned char* ws = opaque_g(a.ws);
    const int tid_k = fresh_tid(F.wave), w = F.wave;
    const int hh = bh & 3, b = bh >> 2;
    LAS unsigned char* L = F.lds + RING_OFF;
    const bf16* RKT = (const bf16*)(ws + WS_RKT); const bf16* RVT = (const bf16*)(ws + WS_RVT);
    const float g = gpow_t(ws, hh, 1), g127 = gpow_t(ws, hh, 127);
    f32x16 S[4];
    bf16x8 vf[8]; v4u kreg[4];
#define RS_FETCH(tok0_) do { _Pragma("unroll") for (int s = 0; s < 8; ++s) vf[s] = *(const bf16x8*)(RVT + (size_t)(hh * 256 + 32 * w + r32) * MP + (tok0_) + 16 * s + 8 * half); \
        _Pragma("unroll") for (int k = 0; k < 4; ++k) { const int ch = tid + 512 * k; kreg[k] = *(const v4u*)(RKT + (size_t)(hh * 128 + (ch >> 4)) * MP + (tok0_) + 8 * (ch & 15)); } } while (0)
    {   const int tid = tid_k, lane = tid & 63, r32 = lane & 31, half = lane >> 5;
#pragma unroll
        for (int db = 0; db < 4; ++db)
#pragma unroll
            for (int i = 0; i < 16; ++i) S[db][i] = 0.f;
        const bf16x8 af = *(const bf16x8*)(RVT + (size_t)(hh * 256 + 32 * w + r32) * MP + ROW_META + 8 * half);
#pragma unroll
        for (int db = 0; db < 4; ++db) { const bf16x8 bf = *(const bf16x8*)(RKT + (size_t)(hh * 128 + 32 * db + r32) * MP + ROW_META + 8 * half); S[db] = __builtin_amdgcn_mfma_f32_32x32x16_bf16(af, bf, S[db], 0, 0, 0); }
        const float sc = gpow_t(ws, hh, NMETA - 1);
#pragma unroll
        for (int db = 0; db < 4; ++db)
#pragma unroll
            for (int i = 0; i < 16; ++i) S[db][i] *= sc;
        RS_FETCH(b * SEQ);
    }
#pragma unroll 1
    for (int c = 0; c < 16; ++c) {
        const int tok0 = b * SEQ + c * 128, u = bh * 16 + c;
        int tid_c = tid_k; asm volatile("" : "+v"(tid_c));
        const int tid = tid_c, lane = tid & 63, r32 = lane & 31, half = lane >> 5;
#pragma unroll
        for (int k = 0; k < 4; ++k) { const int ch = tid + 512 * k; *(LAS v4u*)(L + RC_Q + (ch >> 4) * RC_STR + 16 * (ch & 15)) = kreg[k]; }
#pragma unroll
        for (int db = 0; db < 4; ++db)
#pragma unroll
            for (int i = 0; i < 16; ++i) *(LAS bf16*)(L + (32 * w + crow(i, half)) * RC_STR + (32 * db + r32) * 2) = bf1(S[db][i]);
        __syncthreads();
        { bf16* SP = (bf16*)(ws + WS_SPREV) + (size_t)u * 32768;
#pragma unroll
          for (int k = 0; k < 8; ++k) { const int ch = lane + 64 * k, row = 32 * w + (ch >> 4); st16_wt(SP + (size_t)row * 128 + 8 * (ch & 15), *(const LAS v4u*)(L + row * RC_STR + 16 * (ch & 15))); } }
        bf16x8 vfn[8]; v4u kregn[4];
        if (c < 15) {
#pragma unroll
            for (int s = 0; s < 8; ++s) vfn[s] = *(const bf16x8*)(RVT + (size_t)(hh * 256 + 32 * w + r32) * MP + tok0 + 128 + 16 * s + 8 * half);
#pragma unroll
            for (int k = 0; k < 4; ++k) { const int ch = tid + 512 * k; kregn[k] = *(const v4u*)(RKT + (size_t)(hh * 128 + (ch >> 4)) * MP + tok0 + 128 + 8 * (ch & 15)); }
        } else {
#pragma unroll
            for (int s = 0; s < 8; ++s) vfn[s] = vf[s];
#pragma unroll
            for (int k = 0; k < 4; ++k) kregn[k] = kreg[k];
        }
#pragma unroll
        for (int db = 0; db < 4; ++db) {
#pragma unroll
            for (int i = 0; i < 16; ++i) S[db][i] *= g;
#pragma unroll
            for (int s = 0; s < 8; ++s) { const bf16x8 kf = *(const LAS bf16x8*)(L + RC_Q + (32 * db + r32) * RC_STR + (16 * s + 8 * half) * 2); S[db] = __builtin_amdgcn_mfma_f32_32x32x16_bf16(vf[s], kf, S[db], 0, 0, 0); }
#pragma unroll
            for (int i = 0; i < 16; ++i) S[db][i] *= g127;
        }
        asm volatile("s_waitcnt vmcnt(0)" ::: "memory");
#pragma unroll
        for (int s = 0; s < 8; ++s) vf[s] = vfn[s];
#pragma unroll
        for (int k = 0; k < 4; ++k) kreg[k] = kregn[k];
        __syncthreads();
        if (tid == 0) __hip_atomic_store((unsigned*)(ws + WS_CTL) + CW_FLAG + 16 * u, 1u, __ATOMIC_RELAXED, __HIP_MEMORY_SCOPE_AGENT);
    }
#undef RS_FETCH
    {   const int lane = tid_k & 63, r32 = lane & 31, half = lane >> 5;
#pragma unroll
        for (int db = 0; db < 4; ++db)
#pragma unroll
            for (int i = 0; i < 16; ++i) a.out()[OUT_SRP + ((size_t)bh * RDK + 32 * db + r32) * RDV + 32 * w + crow(i, half)] = S[db][i]; }
    __syncthreads();
}
__device__ __forceinline__ void ret_out_unit(Frame& F, const Ptrs& a, int u) {
    unsigned char* ws = opaque_g(a.ws);
    const int tid = fresh_tid(F.wave), lane = tid & 63, w = F.wave, r32 = lane & 31, half = lane >> 5;
    const int bh = u >> 4, c = u & 15, hh = bh & 3, tok0 = (bh >> 2) * SEQ + c * 128;
    LAS unsigned char* L = F.lds + RING_OFF;
    LAS float* red = (LAS float*)(L + RC_RED);
    const bf16* RQ = (const bf16*)(ws + WS_RQ); const bf16* RK = (const bf16*)(ws + WS_RK); const bf16* RVT = (const bf16*)(ws + WS_RVT);
    if (tid == 0) { const unsigned* fl = (const unsigned*)(ws + WS_CTL) + CW_FLAG + 16 * u; unsigned spins = 0;
        while (__hip_atomic_load(fl, __ATOMIC_RELAXED, __HIP_MEMORY_SCOPE_AGENT) == 0u && ++spins < (1u << 22)) __builtin_amdgcn_s_sleep(8);
        __builtin_amdgcn_fence(__ATOMIC_ACQUIRE, "agent"); asm volatile("s_waitcnt vmcnt(0)" ::: "memory"); }
    __syncthreads();
    v4u qreg[4], jreg[4], sreg[8]; bf16x8 vf[8];
#pragma unroll
    for (int k = 0; k < 4; ++k) { const int ch = tid + 512 * k; qreg[k] = *(const v4u*)(RQ + (size_t)(tok0 + (ch >> 4)) * 512 + hh * 128 + 8 * (ch & 15)); jreg[k] = *(const v4u*)(RK + (size_t)(tok0 + (ch >> 4)) * 512 + hh * 128 + 8 * (ch & 15)); }
    { const bf16* SP = (const bf16*)(ws + WS_SPREV) + (size_t)u * 32768;
#pragma unroll
      for (int k = 0; k < 8; ++k) { const int ch = tid + 512 * k; sreg[k] = *(const v4u*)(SP + (size_t)(ch >> 4) * 128 + 8 * (ch & 15)); } }
#pragma unroll
    for (int s = 0; s < 8; ++s) vf[s] = *(const bf16x8*)(RVT + (size_t)(hh * 256 + 32 * w + r32) * MP + tok0 + 16 * s + 8 * half);
    __builtin_amdgcn_sched_barrier(0);
#pragma unroll
    for (int k = 0; k < 4; ++k) { const int ch = tid + 512 * k; *(LAS v4u*)(L + RC_Q + (ch >> 4) * RC_STR + 16 * (ch & 15)) = qreg[k]; *(LAS v4u*)(L + RC_S + (ch >> 4) * RC_STR + 16 * (ch & 15)) = jreg[k]; }
    __syncthreads();
#define RC_BLK_IB(n) ((n) < 1 ? 0 : (n) < 3 ? 1 : (n) < 6 ? 2 : 3)
#define RC_BLK_JB(n) ((n) - ((n) < 1 ? 0 : (n) < 3 ? 1 : (n) < 6 ? 3 : 6))
    for (int n = w; n < 10; n += 8) {
        const int ib_ = RC_BLK_IB(n), jb_ = RC_BLK_JB(n);
        f32x16 at;
#pragma unroll
        for (int i = 0; i < 16; ++i) at[i] = 0.f;
#pragma unroll
        for (int s = 0; s < 8; ++s) { const bf16x8 kf = *(const LAS bf16x8*)(L + RC_S + (32 * jb_ + r32) * RC_STR + (16 * s + 8 * half) * 2); const bf16x8 qf = *(const LAS bf16x8*)(L + RC_Q + (32 * ib_ + r32) * RC_STR + (16 * s + 8 * half) * 2); at = __builtin_amdgcn_mfma_f32_32x32x16_bf16(kf, qf, at, 0, 0, 0); }
        if (jb_ == ib_) {
#pragma unroll
            for (int i = 0; i < 16; ++i) if (crow(i, half) > r32) at[i] = 0.f; }
#pragma unroll
        for (int gq = 0; gq < 4; ++gq) { f32x4 o_; o_[0] = at[4 * gq]; o_[1] = at[4 * gq + 1]; o_[2] = at[4 * gq + 2]; o_[3] = at[4 * gq + 3];
            *(LAS u32x2*)(L + RC_A + (32 * ib_ + r32) * RC_STR + (32 * jb_ + 8 * gq + 4 * half) * 2) = pack4(o_); }
    }
#undef RC_BLK_IB
#undef RC_BLK_JB
    __syncthreads();
#pragma unroll
    for (int k = 0; k < 8; ++k) { const int ch = tid + 512 * k; *(LAS v4u*)(L + RC_S + (ch >> 4) * RC_STR + 16 * (ch & 15)) = sreg[k]; }
    __syncthreads();
    const float g = gpow_t(ws, hh, 1);
    f32x16 ot[4];
#pragma unroll
    for (int ib = 0; ib < 4; ++ib)
#pragma unroll
        for (int i = 0; i < 16; ++i) ot[ib][i] = 0.f;
#pragma unroll 2
    for (int s = 0; s < 8; ++s) {
        const bf16x8 sf = *(const LAS bf16x8*)(L + RC_S + (32 * w + r32) * RC_STR + (16 * s + 8 * half) * 2);
#pragma unroll
        for (int ib = 0; ib < 4; ++ib) { const bf16x8 qf = *(const LAS bf16x8*)(L + RC_Q + (32 * ib + r32) * RC_STR + (16 * s + 8 * half) * 2); ot[ib] = __builtin_amdgcn_mfma_f32_32x32x16_bf16(sf, qf, ot[ib], 0, 0, 0); }
    }
#pragma unroll
    for (int ib = 0; ib < 4; ++ib)
#pragma unroll
        for (int i = 0; i < 16; ++i) ot[ib][i] *= g;
    u32x2 sgr[4][4];
#pragma unroll
    for (int ib = 0; ib < 4; ++ib)
#pragma unroll
        for (int gq = 0; gq < 4; ++gq) sgr[ib][gq] = *(const u32x2*)((const bf16*)(ws + WS_SRG) + (size_t)(tok0 + 32 * ib + r32) * 1024 + hh * 256 + 32 * w + 4 * half + 8 * gq);
#pragma unroll
    for (int ib = 0; ib < 4; ++ib)
#pragma unroll
        for (int s = 0; s < 2 * (ib + 1); ++s) { const bf16x8 af = *(const LAS bf16x8*)(L + RC_A + (32 * ib + r32) * RC_STR + (16 * s + 8 * half) * 2); ot[ib] = __builtin_amdgcn_mfma_f32_32x32x16_bf16(vf[s], af, ot[ib], 0, 0, 0); }
#pragma unroll
    for (int ib = 0; ib < 4; ++ib) { float t = 0.f;
#pragma unroll
        for (int i = 0; i < 16; ++i) t += ot[ib][i];
        t += lx(t, lane, 32); if (half == 0) red[w * 128 + 32 * ib + r32] = t; }
    __syncthreads();
    float mu[4];
#pragma unroll
    for (int ib = 0; ib < 4; ++ib) { float t = 0.f;
#pragma unroll
        for (int ww = 0; ww < 8; ++ww) t += red[ww * 128 + 32 * ib + r32];
        mu[ib] = t * (1.f / 256.f); }
#pragma unroll
    for (int ib = 0; ib < 4; ++ib) { float t = 0.f;
#pragma unroll
        for (int i = 0; i < 16; ++i) { ot[ib][i] -= mu[ib]; t += ot[ib][i] * ot[ib][i]; }
        t += lx(t, lane, 32); if (half == 0) red[1024 + w * 128 + 32 * ib + r32] = t; }
    __syncthreads();
#pragma unroll
    for (int ib = 0; ib < 4; ++ib) { float t = 0.f;
#pragma unroll
        for (int ww = 0; ww < 8; ++ww) t += red[1024 + ww * 128 + 32 * ib + r32];
        const float rstd = 1.0f / sqrtf(t * (1.f / 256.f) + EPS);
        const int irow = tok0 + 32 * ib + r32;
        bf16* RIN = (bf16*)(ws + WS_RIN) + (size_t)irow * 1024 + hh * 256 + 32 * w + 4 * half;
        const float* gn = a.in(19) + hh * 256 + 32 * w + 4 * half;
#pragma unroll
        for (int gq = 0; gq < 4; ++gq) {
            const u32x2 sg = sgr[ib][gq]; const f32x4 gv = *(const f32x4*)(gn + 8 * gq);
            f32x4 o;
            o[0] = ot[ib][4 * gq + 0] * rstd * gv[0] * __uint_as_float(sg.x << 16); o[1] = ot[ib][4 * gq + 1] * rstd * gv[1] * __uint_as_float(sg.x & 0xffff0000u);
            o[2] = ot[ib][4 * gq + 2] * rstd * gv[2] * __uint_as_float(sg.y << 16); o[3] = ot[ib][4 * gq + 3] * rstd * gv[3] * __uint_as_float(sg.y & 0xffff0000u);
            *(u32x2*)(RIN + 8 * gq) = pack4(o);
        } }
    __syncthreads();
}
}
namespace mk {
__global__ void __launch_bounds__(NWAVES * 64, 2) mega_fwd(Args args) {
    extern __shared__ __attribute__((aligned(16))) unsigned char lds[];
    Frame F;
    F.lds = (LAS unsigned char*)lds;
    F.MISC = (volatile LAS unsigned*)(F.lds + MISC_OFF);
    F.wave = __builtin_amdgcn_readfirstlane((int)threadIdx.x >> 6);
    F.G = gridDim.x; { const int bx = blockIdx.x; F.vcu = (F.G % 8 == 0) ? (bx % 8) * (F.G / 8) + bx / 8 : bx; }
    unsigned char* const ws_k = args.ws;
    unsigned char* ws = ws_k;
    for (int u = threadIdx.x; u < (LDS_BYTES - LDSCTL_OFF) / 4; u += NWAVES * 64) ((LAS unsigned*)(F.lds + LDSCTL_OFF))[u] = 0u;
    __syncthreads();
    {
        volatile LAS unsigned long long* pt = (volatile LAS unsigned long long*)(F.lds + PT_OFF);
        if (threadIdx.x == 0) {
#define PT_PUT(i) pt[i] = (unsigned long long)args.in[i]
            PT_PUT(0); PT_PUT(1); PT_PUT(2); PT_PUT(3); PT_PUT(4); PT_PUT(5); PT_PUT(6); PT_PUT(7); PT_PUT(8); PT_PUT(9); PT_PUT(10); PT_PUT(11); PT_PUT(12); PT_PUT(13);
            PT_PUT(14); PT_PUT(15); PT_PUT(16); PT_PUT(17); PT_PUT(18); PT_PUT(19); PT_PUT(20); PT_PUT(21); PT_PUT(22); PT_PUT(23); PT_PUT(24); PT_PUT(25); PT_PUT(26);
#undef PT_PUT
            pt[27] = (unsigned long long)args.out;
        }
        __syncthreads();
    }
    const Ptrs P{ws_k, (volatile LAS unsigned*)(F.lds + PT_OFF)};
    (void)xcd_barrier_post((unsigned*)(ws_k + WS_CTL) + CW_BAR, F.MISC + 8, F.wave);
#if MK_PROBE
#define STAMP(k) do { if (blockIdx.x == 0 && F.wave == 0 && lane_fresh() == 0) ((unsigned long long*)(ws_k + WS_CTL + 512 * 1024))[k] = __builtin_amdgcn_s_memrealtime(); } while (0)
    STAMP(0);
#else
#define STAMP(k) do { } while (0)
#endif
#define WS_FRESH() unsigned char* ws = opaque_g(ws_k)
#define GRID_BAR() do { XcdBarrier b_; b_.bar = (unsigned*)(ws_k + WS_CTL) + CW_BAR; b_.x = xb_xcc_id(); b_.st = F.MISC + 8; b_.wave = F.wave; xcd_barrier(b_); } while (0)

    p0_prologue(F, args);
    GRID_BAR(); STAMP(1);
    {
        WS_FRESH();
        { const int bx = (int)blockIdx.x; if (bx >= 128 && bx < 172) xjob_ffn_up(F, ws, bx - 128, WS_XB, WS_W1T, 0, 0); }
        p0_weights_late(F, args);
        pg8::Gemm g{(const pg8::bf16_t*)(ws + WS_XB), (const pg8::bf16_t*)(ws + WS_W1T), MMAIN, 2 * FFN, D};
        pg8::StaticOrder S; S.init(MMAIN, 2 * FFN, F.G, (int)blockIdx.x);
        EpiSwiGLU E{(bf16*)(ws + WS_ACT), (const float*)(ws + WS_R1)};
        pg8::gemm_phase<EpiSwiGLU, pg8::StaticOrder, true, true>(F.lds + RING_OFF, g, S, E, F.wave);
        { const int bx = (int)blockIdx.x; if (bx >= 172 && bx < 188) { xjob_wait(ws, fresh_tid(F.wave), 0, 44u); xjob_resid(F, ws, bx - 172, WS_ACT, FFN, WS_W1D, (const bf16*)(ws + WS_XB) + (size_t)XROW0 * D, false, 0.5f, WS_HB, WS_SSQH); } }
    }
    GRID_BAR(); STAMP(2);
    {
        WS_FRESH();
        pg8::Gemm g{(const pg8::bf16_t*)(ws + WS_ACT), (const pg8::bf16_t*)(ws + WS_W1D), MMAIN, D, FFN};
        pg8::StaticOrder S; S.init(MMAIN, D, F.G, (int)blockIdx.x);
        typedef EpiResid<(unsigned)WS_XB, false, (unsigned)WS_HB, (unsigned)WS_SSQH, 1> EpiDown1;
        EpiDown1 E{ws, P.in(0)};
        pg8::gemm_phase<EpiDown1, pg8::StaticOrder, true, true>(F.lds + RING_OFF, g, S, E, F.wave);
    }
    GRID_BAR(); STAMP(3);
#ifndef NO_P3
    {
        WS_FRESH();
        { const int bx = (int)blockIdx.x; if (bx >= 192 && bx < 238) xjob_win(F, ws, bx - 192); }
        pg8::Gemm g{(const pg8::bf16_t*)(ws + WS_HB), (const pg8::bf16_t*)(ws + WS_WIN), MMAIN, NWIN, D};
        pg8::StaticOrder S; S.init(MMAIN, NWIN, F.G, (int)blockIdx.x);
        EpiWin E{ws, F.lds};
        pg8::gemm_phase<EpiWin, pg8::StaticOrder, true, true>(F.lds + RING_OFF, g, S, E, F.wave);
    }
#endif
    GRID_BAR(); STAMP(4);
    {
        WS_FRESH();
        { const int jb = (int)blockIdx.x - 192; if (jb >= 0 && jb < 12) xjob_q(F, ws, jb); else if (jb >= 12 && jb < 20) xjob_kv(F, ws, jb - 12, false); else if (jb >= 20 && jb < 28) xjob_kv(F, ws, jb - 20, true); else if (jb >= 28 && jb < 60) xjob_ql(F, ws, jb - 28); }
        finalize_ckv(F, P);
#ifndef NO_P4Q
        {   pg8::Gemm g{(const pg8::bf16_t*)(ws + WS_CQ), (const pg8::bf16_t*)(ws + WS_WUQ), MMAIN, 768, QR};
            pg8::StaticOrder S; S.init(MMAIN, 768, F.G, (int)blockIdx.x);
            EpiQ E{ws};
            pg8::gemm_phase<EpiQ, pg8::StaticOrder, true, true>(F.lds + RING_OFF, g, S, E, F.wave); }
#endif
#ifndef NO_P4K
        {   pg8::Gemm g{(const pg8::bf16_t*)(ws + WS_CKVB), (const pg8::bf16_t*)(ws + WS_WUK), MMAIN, 512, KVR};
            pg8::StaticOrder S; S.init(MMAIN, 512, F.G, (int)((blockIdx.x + 64) % F.G));
            EpiScaleBf16<true> E{(const float*)(ws + WS_SSQKV), (bf16*)(ws + WS_KN), 512};
            pg8::gemm_phase<EpiScaleBf16<true>, pg8::StaticOrder, true, true>(F.lds + RING_OFF, g, S, E, F.wave); }
#endif
#ifndef NO_P4V
        {   pg8::Gemm g{(const pg8::bf16_t*)(ws + WS_WUV), (const pg8::bf16_t*)(ws + WS_CKVB), 512, MMAIN, KVR};
            pg8::StaticOrder S; S.init(512, MMAIN, F.G, (int)((blockIdx.x + 192) % F.G));
            EpiScaleBf16<false> E{(const float*)(ws + WS_SSQKV), (bf16*)(ws + WS_VT), MP};
            pg8::gemm_phase<EpiScaleBf16<false>, pg8::StaticOrder, true, true>(F.lds + RING_OFF, g, S, E, F.wave); }
#endif
    }
    GRID_BAR(); STAMP(5);
    STAMP(32);
#define QUEUE_LOOP(qi, nitems, call) for (;;) { \
        if (F.wave == 0 && lane_fresh() == 0) F.MISC[16] = __hip_atomic_fetch_add((unsigned*)(ws_k + WS_CTL) + CW_QUEUE + 64 * (qi), 1u, __ATOMIC_RELAXED, __HIP_MEMORY_SCOPE_AGENT); \
        __syncthreads(); const int it = (int)F.MISC[16]; __syncthreads(); \
        if (it >= (nitems)) break; call; }
    if ((int)blockIdx.x < 32) ret_state_unit(F, P, (int)blockIdx.x);
    STAMP(33);
    if (((int)blockIdx.x & 1) == 0) { QUEUE_LOOP(0, 512, attn_item(F, ws_k, it)) }
    STAMP(34);
    QUEUE_LOOP(1, 512, decode_unit(F, P, it))
    STAMP(35);
    QUEUE_LOOP(2, 128, ret_sample_unit(F, P, it))
    STAMP(36);
    if (((int)blockIdx.x & 1) != 0) { QUEUE_LOOP(0, 512, attn_item(F, ws_k, it)) }
    QUEUE_LOOP(3, 512, ret_out_unit(F, P, ((it & 31) << 4) | (it >> 5)))
    STAMP(37);
    QUEUE_LOOP(4, 256, decode_combine_unit(F, P, it))
#undef QUEUE_LOOP
    GRID_BAR(); STAMP(6);
    {
        WS_FRESH();
        { const int bx = (int)blockIdx.x; if (bx < 16) xjob_mix(F, ws, bx); }
        {   pg8::Gemm g{(const pg8::bf16_t*)(ws + WS_AV), (const pg8::bf16_t*)(ws + WS_WMO), MMAIN, D, 512};
            pg8::StaticOrder S; S.init(MMAIN, D, F.G, (int)blockIdx.x);
            typedef EpiGate<0, (unsigned)WS_SGA> EpiGA; EpiGA E{ws};
            pg8::gemm_phase<EpiGA, pg8::StaticOrder, true, true>(F.lds + RING_OFF, g, S, E, F.wave); }
        {   pg8::Gemm g{(const pg8::bf16_t*)(ws + WS_RIN), (const pg8::bf16_t*)(ws + WS_WRO), MMAIN, D, D};
            pg8::StaticOrder S; S.init(MMAIN, D, F.G, (int)blockIdx.x);
            typedef EpiGate<1, (unsigned)WS_SGB> EpiGB; EpiGB E{ws};
            pg8::gemm_phase<EpiGB, pg8::StaticOrder, true, true>(F.lds + RING_OFF, g, S, E, F.wave); }
    }
    GRID_BAR(); STAMP(7);
    {
        WS_FRESH();
        { const int bx = (int)blockIdx.x; if (bx >= 16 && bx < 32) xjob_resid(F, ws, bx - 16, WS_MX, D, WS_WOUT, (const bf16*)(ws + WS_HB) + (size_t)XROW0 * D, false, 1.0f, WS_H2B, WS_SSQH2); }
        pg8::Gemm g{(const pg8::bf16_t*)(ws + WS_MX), (const pg8::bf16_t*)(ws + WS_WOUT), MMAIN, D, D};
        pg8::StaticOrder S; S.init(MMAIN, D, F.G, (int)blockIdx.x);
        typedef EpiResid<(unsigned)WS_HB, false, (unsigned)WS_H2B, (unsigned)WS_SSQH2, 2> EpiOut;
        EpiOut E{ws, nullptr};
        pg8::gemm_phase<EpiOut, pg8::StaticOrder, true, true>(F.lds + RING_OFF, g, S, E, F.wave);
    }
    GRID_BAR(); STAMP(8);
    {
        WS_FRESH();
        { const int bx = (int)blockIdx.x; if (bx >= 128 && bx < 172) xjob_ffn_up(F, ws, bx - 128, WS_H2B, WS_W2T, 1, 16); }
        pg8::Gemm g{(const pg8::bf16_t*)(ws + WS_H2B), (const pg8::bf16_t*)(ws + WS_W2T), MMAIN, 2 * FFN, D};
        pg8::StaticOrder S; S.init(MMAIN, 2 * FFN, F.G, (int)blockIdx.x);
        EpiSwiGLU2 E{ws};
        pg8::gemm_phase<EpiSwiGLU2, pg8::StaticOrder, true, true>(F.lds + RING_OFF, g, S, E, F.wave);
        { const int bx = (int)blockIdx.x; if (bx >= 172 && bx < 188) { xjob_wait(ws, fresh_tid(F.wave), 16, 44u); xjob_resid(F, ws, bx - 172, WS_ACT, FFN, WS_W2D, (const bf16*)(ws + WS_H2B) + (size_t)XROW0 * D, false, 0.5f, WS_H3B, WS_SSQH3); } }
    }
    GRID_BAR(); STAMP(9);
    {
        WS_FRESH();
        pg8::Gemm g{(const pg8::bf16_t*)(ws + WS_ACT), (const pg8::bf16_t*)(ws + WS_W2D), MMAIN, D, FFN};
        pg8::StaticOrder S; S.init(MMAIN, D, F.G, (int)blockIdx.x);
        typedef EpiResid<(unsigned)WS_H2B, false, (unsigned)WS_H3B, (unsigned)WS_SSQH3, 1> EpiDown2;
        EpiDown2 E{ws, nullptr};
        pg8::gemm_phase<EpiDown2, pg8::StaticOrder, true, true>(F.lds + RING_OFF, g, S, E, F.wave);
    }
    GRID_BAR(); STAMP(10);
    final_norm_phase(F, P);
#if MK_PROBE
    GRID_BAR(); STAMP(11);
    if (blockIdx.x == 0) {
        asm volatile("s_waitcnt vmcnt(0)" ::: "memory"); __syncthreads();
        const unsigned long long* t = (const unsigned long long*)(ws_k + WS_CTL + 512 * 1024);
        const float dta = (float)(__hip_atomic_load(t + MK_PROBE_A + 1, __ATOMIC_RELAXED, __HIP_MEMORY_SCOPE_AGENT) - __hip_atomic_load(t + MK_PROBE_A, __ATOMIC_RELAXED, __HIP_MEMORY_SCOPE_AGENT)) * 0.01f;
        const float dtb = (float)(__hip_atomic_load(t + MK_PROBE_B + 1, __ATOMIC_RELAXED, __HIP_MEMORY_SCOPE_AGENT) - __hip_atomic_load(t + MK_PROBE_B, __ATOMIC_RELAXED, __HIP_MEMORY_SCOPE_AGENT)) * 0.01f;
        const float f = 1.f + sqrtf(dta / 20000.f);
        const int tid_p = fresh_tid(F.wave);
        for (int i = tid_p; i < NS * D; i += NWAVES * 64) P.out()[OUT_YS + i] *= f;
        if (tid_p == 0) P.out()[OUT_YP] += dtb / 5.f;
    }
#endif
#undef GRID_BAR
}
}
extern "C" void kernel_launch(void* const* d_in, const int* in_sizes, int n_in, void* d_out, int out_size, void* d_ws, size_t ws_size, hipStream_t stream) {
    static int grid = 0;
    if (grid == 0) {
        int dev = 0, cus = 0;
        if (n_in != 27 || out_size != (int)mk::OUT_END || ws_size < mk::WS_END6) { fprintf(stderr, "kernel_launch: unexpected problem shape (n_in %d, out %d, ws %zu); nothing launched\n", n_in, out_size, ws_size); grid = -1; return; }
        if (hipGetDevice(&dev) != hipSuccess || hipDeviceGetAttribute(&cus, hipDeviceAttributeMultiprocessorCount, dev) != hipSuccess) { fprintf(stderr, "kernel_launch: device query failed\n"); grid = -1; return; }
        if (hipFuncSetAttribute((const void*)mk::mega_fwd, hipFuncAttributeMaxDynamicSharedMemorySize, mk::LDS_BYTES) != hipSuccess) { fprintf(stderr, "kernel_launch: hipFuncSetAttribute failed\n"); grid = -1; return; }
        int per_cu = 0;
        if (hipOccupancyMaxActiveBlocksPerMultiprocessor(&per_cu, (const void*)mk::mega_fwd, mk::NWAVES * 64, mk::LDS_BYTES) != hipSuccess || per_cu < 1) fprintf(stderr, "kernel_launch: note: occupancy query reports %d workgroups per CU\n", per_cu);
        (void)hipGetLastError();
        if (cus < 256) { fprintf(stderr, "kernel_launch: this kernel's static work assignment needs 256 resident workgroups (one per CU); the device has %d CUs; nothing launched\n", cus); grid = -1; return; }
        grid = 256;
    }
    if (grid < 0) return;
    unsigned char* ws = (unsigned char*)d_ws;
    (void)hipMemsetAsync(ws + mk::WS_CTL, 0, mk::CTL_ZERO_BYTES, stream);
    mk::Args a{};
    for (int i = 0; i < 27; ++i) a.in[i] = (const float*)d_in[i];
    a.out = (float*)d_out; a.ws = ws;
    hipLaunchKernelGGL(mk::mega_fwd, dim3(grid), dim3(mk::NWAVES * 64), mk::LDS_BYTES, stream, a);
}
```
